# Optimizing an MI355X kernel written in HIP

```python
import jax, jax.numpy as jnp
from jax import lax
import numpy as np

D_MODEL = 1024
BATCH = 4
SEQ = 4096
DEPTH = 4

GRID_W = 64
CTX_LEN = 256

FOURIER_GROUPS = 4
FOURIER_GROUP_DIM = 128
FOURIER_DIM = FOURIER_GROUPS * FOURIER_GROUP_DIM

MLA_HEADS = 8
MLA_NOPE = 64
MLA_ROPE = 32
MLA_QK = MLA_NOPE + MLA_ROPE
MLA_V = 64
MLA_Q_LORA = 384
MLA_KV_LORA = 256
MLA_SCALE = MLA_QK ** -0.5
ROPE_PAIRS = MLA_ROPE // 4
ROPE_BASE = 10000.0
Q_BLOCK = 128

RWKV_HEADS = 8
RWKV_HEAD = 64
RWKV_DIM = RWKV_HEADS * RWKV_HEAD
DECAY_LORA = 64
AAA_LORA = 64
GATE_LORA = 128
RWKV_IN = 3 * RWKV_DIM + DECAY_LORA + AAA_LORA + GATE_LORA
GN_EPS = 64e-5

N_BRANCHES = 3
IN_SIZES = (FOURIER_DIM, MLA_Q_LORA, MLA_KV_LORA, MLA_ROPE, RWKV_IN, D_MODEL, D_MODEL, D_MODEL)
IN_DIM = FOURIER_DIM + MLA_Q_LORA + MLA_KV_LORA + MLA_ROPE + RWKV_IN + N_BRANCHES * D_MODEL

N_EXPERTS = 16
N_GROUPS = 4
EXPERTS_PER_GROUP = N_EXPERTS // N_GROUPS
GROUP_SCORE_TOPK = 2
TOP_K = 2
EXPERT_FF = 512
SHARED_FF = 512

NORM_EPS = 1e-6

kernel_name = "hybrid_fourier_mla_rwkv7_moe_dit"

F32 = jnp.float32


def rmsnorm(x, g):
    xf = x.astype(F32)
    return (xf * lax.rsqrt(jnp.mean(xf * xf, axis=-1, keepdims=True) + NORM_EPS)).astype(x.dtype) * g


def split_cols(p, sizes):
    return jnp.split(p, np.cumsum(sizes)[:-1].tolist(), axis=-1)


def axial_rope_tables(row, col):
    inv = ROPE_BASE ** (-jnp.arange(ROPE_PAIRS, dtype=F32) / ROPE_PAIRS)
    ang = jnp.stack([row, col], axis=-1).astype(F32)[..., None] * inv
    return jnp.cos(ang), jnp.sin(ang)


def rope_2d(x, cos, sin):
    xr = x.reshape(x.shape[:-1] + (2, 2, ROPE_PAIRS))
    x1, x2 = xr[..., 0, :], xr[..., 1, :]
    c, s = cos[None, :, None], sin[None, :, None]
    out = jnp.stack([x1 * c - x2 * s, x2 * c + x1 * s], axis=-2)
    return out.reshape(x.shape).astype(x.dtype)


def fourier_mix(p):
    B, T, _ = p.shape
    z = p.astype(F32).reshape(B, T, FOURIER_GROUPS, FOURIER_GROUP_DIM)
    f = jnp.fft.fft2(z, axes=(1, 3), norm="ortho").real
    return f.reshape(B, T, FOURIER_DIM).astype(p.dtype)


def mla_project(c_q, c_kv, k_r, q_norm_g, kv_norm_g, w_uq, w_ukv, cos=None, sin=None):
    B, T, _ = c_q.shape
    q = (rmsnorm(c_q, q_norm_g) @ w_uq).reshape(B, T, MLA_HEADS, MLA_QK)
    kv = (rmsnorm(c_kv, kv_norm_g) @ w_ukv).reshape(B, T, MLA_HEADS, MLA_NOPE + MLA_V)
    q_nope, q_rope = q[..., :MLA_NOPE], q[..., MLA_NOPE:]
    k_nope, v = kv[..., :MLA_NOPE], kv[..., MLA_NOPE:]
    k_rope = k_r[:, :, None, :]
    if cos is not None:
        q_rope = rope_2d(q_rope, cos, sin)
        k_rope = rope_2d(k_rope, cos, sin)
    q = jnp.concatenate([q_nope, q_rope], axis=-1)
    k = jnp.concatenate([k_nope, jnp.broadcast_to(k_rope, (B, T, MLA_HEADS, MLA_ROPE))], axis=-1)
    return q, k, v


def attend(q, k, v):
    s = jnp.einsum('bqhd,bkhd->bhqk', q, k).astype(F32) * MLA_SCALE
    p = jax.nn.softmax(s, axis=-1).astype(v.dtype)
    return jnp.einsum('bhqk,bkhd->bqhd', p, v)


def latent_attention(q, k_lat, v_lat, k_ctx, v_ctx):
    B, T, H, _ = q.shape
    k = jnp.concatenate([k_lat, k_ctx], axis=1)
    v = jnp.concatenate([v_lat, v_ctx], axis=1)
    qb = q.reshape(B, T // Q_BLOCK, Q_BLOCK, H, MLA_QK).transpose(1, 0, 2, 3, 4)
    o = lax.map(lambda qi: attend(qi, k, v), qb)
    return o.transpose(1, 0, 2, 3, 4).reshape(B, T, H * MLA_V)


def centred_shift(p):
    pad = jnp.pad(p, ((0, 0), (1, 1), (0, 0)))
    return 0.5 * (pad[:, :-2] + pad[:, 2:])


def wkv_scan(r, w, k, v, a, b, S0, reverse):
    xs = tuple(jnp.moveaxis(t, 1, 0) for t in (r, w, k, v, a, b))

    def step(S, inp):
        rt, wt, kt, vt, at, bt = inp
        sa = jnp.einsum('bhvk,bhk->bhv', S, at)
        S = S * wt[:, :, None, :] + sa[..., None] * bt[:, :, None, :] + vt[..., None] * kt[:, :, None, :]
        return S, jnp.einsum('bhvk,bhk->bhv', S, rt)

    S_fin, ys = lax.scan(step, S0, xs, reverse=reverse)
    return S_fin, jnp.moveaxis(ys, 0, 1)


def rwkv_mix(p, S0, mu, w0, w_up, a0, a_up, g_up, k_k, k_a, r_k, gn_g, gn_b):
    B, T, _ = p.shape
    H, N = RWKV_HEADS, RWKV_HEAD
    xs = (p + (centred_shift(p) - p) * mu).astype(F32)
    r, k, v, xw, xa, xg = split_cols(xs, (RWKV_DIM, RWKV_DIM, RWKV_DIM, DECAY_LORA, AAA_LORA, GATE_LORA))
    g = jax.nn.sigmoid(xg) @ g_up
    rh, vh = r.reshape(B, T, H, N), v.reshape(B, T, H, N)
    kk = (k * k_k).reshape(B, T, H, N)
    kk = kk * lax.rsqrt(jnp.sum(kk * kk, axis=-1, keepdims=True) + 1e-12)
    ys, bonuses, finals = [], [], []
    for d in range(2):
        w = -jax.nn.softplus(-(w0[d] + jnp.tanh(xw) @ w_up[d])) - 0.5
        decay = jnp.exp(-jnp.exp(w)).reshape(B, T, H, N)
        a = jax.nn.sigmoid(a0[d] + xa @ a_up[d]).reshape(B, T, H, N)
        kd = k.reshape(B, T, H, N) * (1.0 + (a - 1.0) * k_a.reshape(H, N))
        s_fin, yd = wkv_scan(rh, decay, kd, vh, -kk, kk * a, S0[d], reverse=(d == 1))
        ys.append(yd)
        bonuses.append(jnp.sum(rh * kd * r_k, axis=-1, keepdims=True) * vh)
        finals.append(s_fin)
    y = ys[0] + ys[1]
    mean = jnp.mean(y, axis=-1, keepdims=True)
    var = jnp.mean(jnp.square(y - mean), axis=-1, keepdims=True)
    y = ((y - mean) * lax.rsqrt(var + GN_EPS)).reshape(B, T, RWKV_DIM) * gn_g + gn_b
    y = (y + (bonuses[0] + bonuses[1]).reshape(B, T, RWKV_DIM)) * g
    return y.astype(p.dtype), jnp.stack(finals)


def merge_branches(fa, attn, rw, ga, gb, gc, w_a, w_b, w_c, w_out):
    merged = (jax.nn.sigmoid(ga) * (fa @ w_a) + jax.nn.sigmoid(gb) * (attn @ w_b)
              + jax.nn.sigmoid(gc) * (rw @ w_c))
    return merged @ w_out


def moe(h, router_w, router_b, w_gate, w_up, w_down, sw_gate, sw_up, sw_down):
    T = h.shape[0]
    scores = jax.nn.sigmoid((h @ router_w).astype(F32))
    sel = (scores + router_b.astype(F32)).reshape(T, N_GROUPS, EXPERTS_PER_GROUP)
    group_score = lax.top_k(sel, GROUP_SCORE_TOPK)[0].sum(-1)
    best = jnp.argmax(group_score, axis=-1)
    in_group = jax.nn.one_hot(best, N_GROUPS, dtype=F32)[..., None] > 0
    masked = jnp.where(in_group, sel, -jnp.inf).reshape(T, N_EXPERTS)
    _, idx = lax.top_k(masked, TOP_K)
    wts = jnp.take_along_axis(scores, idx, axis=-1)
    wts = wts / jnp.sum(wts, axis=-1, keepdims=True)
    combine = jnp.einsum('tk,tke->te', wts, jax.nn.one_hot(idx, N_EXPERTS, dtype=F32)).astype(h.dtype)
    y = (jax.nn.silu(h @ sw_gate) * (h @ sw_up)) @ sw_down
    for gi in range(N_GROUPS):
        e = slice(gi * EXPERTS_PER_GROUP, (gi + 1) * EXPERTS_PER_GROUP)
        hg = jnp.einsum('td,edf->tef', h, w_gate[e])
        hu = jnp.einsum('td,edf->tef', h, w_up[e])
        y = y + jnp.einsum('tef,efd->td', jax.nn.silu(hg) * hu * combine[:, e, None], w_down[e])
    return y


def setup_inputs(seed: int = 0) -> dict:
    key = jax.random.key(seed)
    ks = iter(jax.random.split(key, 40))

    def nrm(shape, scale):
        return jax.random.normal(next(ks), shape, F32) * scale

    def gain(shape):
        return 1.0 + nrm(shape, 0.01)

    D, L = D_MODEL, DEPTH
    return {
        "x": nrm((BATCH, SEQ, D), 1.0),
        "c": nrm((BATCH, D), 1.0),
        "ctx": nrm((BATCH, CTX_LEN, D), 1.0),
        "c_ctx": nrm((D,), 1.0),
        "w_ada": nrm((L, D, 6 * D), 0.5 * D ** -0.5),
        "b_ada": nrm((L, 6 * D), 0.01),
        "norm1_g": gain((L, D)),
        "norm2_g": gain((L, D)),
        "w_in": nrm((L, D, IN_DIM), D ** -0.5),
        "q_norm_g": gain((L, MLA_Q_LORA)),
        "kv_norm_g": gain((L, MLA_KV_LORA)),
        "w_uq": nrm((L, MLA_Q_LORA, MLA_HEADS * MLA_QK), MLA_Q_LORA ** -0.5),
        "w_ukv": nrm((L, MLA_KV_LORA, MLA_HEADS * (MLA_NOPE + MLA_V)), MLA_KV_LORA ** -0.5),
        "rwkv_mu": jax.random.uniform(next(ks), (L, RWKV_IN), F32),
        "rwkv_w0": nrm((L, 2, RWKV_DIM), 1.0),
        "rwkv_w_up": nrm((L, 2, DECAY_LORA, RWKV_DIM), 0.1 * DECAY_LORA ** -0.5),
        "rwkv_a0": nrm((L, 2, RWKV_DIM), 0.5),
        "rwkv_a_up": nrm((L, 2, AAA_LORA, RWKV_DIM), AAA_LORA ** -0.5),
        "rwkv_g_up": nrm((L, GATE_LORA, RWKV_DIM), GATE_LORA ** -0.5),
        "rwkv_k_k": 0.85 + nrm((L, RWKV_DIM), 0.05),
        "rwkv_k_a": 1.0 + nrm((L, RWKV_DIM), 0.05),
        "rwkv_r_k": nrm((L, RWKV_HEADS, RWKV_HEAD), 0.1),
        "rwkv_gn_g": gain((L, RWKV_DIM)),
        "rwkv_gn_b": nrm((L, RWKV_DIM), 0.01),
        "w_proj_a": nrm((L, FOURIER_DIM, D), FOURIER_DIM ** -0.5),
        "w_proj_b": nrm((L, MLA_HEADS * MLA_V, D), (MLA_HEADS * MLA_V) ** -0.5),
        "w_proj_c": nrm((L, RWKV_DIM, D), RWKV_DIM ** -0.5),
        "w_out": nrm((L, D, D), D ** -0.5),
        "router_w": nrm((D, N_EXPERTS), D ** -0.5),
        "router_b": nrm((N_EXPERTS,), 0.01),
        "exp_w_gate": nrm((L, N_EXPERTS, D, EXPERT_FF), D ** -0.5),
        "exp_w_up": nrm((L, N_EXPERTS, D, EXPERT_FF), D ** -0.5),
        "exp_w_down": nrm((L, N_EXPERTS, EXPERT_FF, D), EXPERT_FF ** -0.5),
        "sh_w_gate": nrm((L, D, SHARED_FF), D ** -0.5),
        "sh_w_up": nrm((L, D, SHARED_FF), D ** -0.5),
        "sh_w_down": nrm((L, SHARED_FF, D), SHARED_FF ** -0.5),
        "final_norm_g": gain((D,)),
    }


def reference(x, c, ctx, c_ctx, w_ada, b_ada, norm1_g, norm2_g, w_in, q_norm_g, kv_norm_g, w_uq, w_ukv,
              rwkv_mu, rwkv_w0, rwkv_w_up, rwkv_a0, rwkv_a_up, rwkv_g_up, rwkv_k_k, rwkv_k_a, rwkv_r_k,
              rwkv_gn_g, rwkv_gn_b, w_proj_a, w_proj_b, w_proj_c, w_out, router_w, router_b,
              exp_w_gate, exp_w_up, exp_w_down, sh_w_gate, sh_w_up, sh_w_down, final_norm_g):
    B, T, D = x.shape
    rows = T // GRID_W
    row = jnp.repeat(jnp.arange(rows), GRID_W)
    col = jnp.tile(jnp.arange(GRID_W), rows)
    cos, sin = axial_rope_tables(row, col)
    zero_state = jnp.zeros((2, B, RWKV_HEADS, RWKV_HEAD, RWKV_HEAD), F32)

    for l in range(DEPTH):
        last = l == DEPTH - 1
        mod_lat = (jax.nn.silu(c) @ w_ada[l] + b_ada[l])[:, None, :]
        mod_ctx = (jax.nn.silu(c_ctx) @ w_ada[l] + b_ada[l])[None, None, :]
        sh1, sc1, g1, sh2, sc2, g2 = jnp.split(mod_lat, 6, axis=-1)
        csh1, csc1, cg1, csh2, csc2, cg2 = jnp.split(mod_ctx, 6, axis=-1)

        h_lat = rmsnorm(x, norm1_g[l]) * (1.0 + sc1) + sh1
        h_ctx = rmsnorm(ctx, norm1_g[l]) * (1.0 + csc1) + csh1
        pf_l, pq_l, pkv_l, pkr_l, pr_l, ga_l, gb_l, gc_l = split_cols(h_lat @ w_in[l], IN_SIZES)
        pf_c, pq_c, pkv_c, pkr_c, pr_c, ga_c, gb_c, gc_c = split_cols(h_ctx @ w_in[l], IN_SIZES)

        q_l, k_l, v_l = mla_project(pq_l, pkv_l, pkr_l, q_norm_g[l], kv_norm_g[l], w_uq[l], w_ukv[l], cos, sin)
        q_c, k_c, v_c = mla_project(pq_c, pkv_c, pkr_c, q_norm_g[l], kv_norm_g[l], w_uq[l], w_ukv[l])
        attn_lat = latent_attention(q_l, k_l, v_l, k_c, v_c)

        rw = (rwkv_mu[l], rwkv_w0[l], rwkv_w_up[l], rwkv_a0[l], rwkv_a_up[l], rwkv_g_up[l],
              rwkv_k_k[l], rwkv_k_a[l], rwkv_r_k[l], rwkv_gn_g[l], rwkv_gn_b[l])
        y_ctx, s_ctx = rwkv_mix(pr_c, zero_state, *rw)
        y_lat, _ = rwkv_mix(pr_l, s_ctx, *rw)

        out_lat = merge_branches(fourier_mix(pf_l), attn_lat, y_lat, ga_l, gb_l, gc_l,
                                 w_proj_a[l], w_proj_b[l], w_proj_c[l], w_out[l])
        x = x + g1 * out_lat

        moe_w = (router_w, router_b, exp_w_gate[l], exp_w_up[l], exp_w_down[l],
                 sh_w_gate[l], sh_w_up[l], sh_w_down[l])
        m_lat = rmsnorm(x, norm2_g[l]) * (1.0 + sc2) + sh2
        x = x + g2 * moe(m_lat.reshape(B * T, D), *moe_w).reshape(B, T, D)

        if not last:
            attn_ctx = attend(q_c, k_c, v_c).reshape(B, CTX_LEN, MLA_HEADS * MLA_V)
            out_ctx = merge_branches(fourier_mix(pf_c), attn_ctx, y_ctx, ga_c, gb_c, gc_c,
                                     w_proj_a[l], w_proj_b[l], w_proj_c[l], w_out[l])
            ctx = ctx + cg1 * out_ctx
            m_ctx = rmsnorm(ctx, norm2_g[l]) * (1.0 + csc2) + csh2
            ctx = ctx + cg2 * moe(m_ctx.reshape(B * CTX_LEN, D), *moe_w).reshape(B, CTX_LEN, D)

    return rmsnorm(x, final_norm_g)
```

```cpp
#include <hip/hip_runtime.h>
#include <stdint.h>

#ifndef MEGA
#define MEGA 0
#endif

typedef unsigned short bf16_t;
typedef short bf16x8 __attribute__((ext_vector_type(8)));
typedef float f32x4 __attribute__((ext_vector_type(4)));
typedef float f32x2 __attribute__((ext_vector_type(2)));
typedef __bf16 bf16v2 __attribute__((ext_vector_type(2)));

constexpr int NLAYER = 4;
constexpr int DM = 1024;
constexpr int RL = 16384, RC = 1024, RT = RL + RC;
constexpr int SEQ = 4096, CTX = 256, KEYS = SEQ + CTX;
constexpr int LDP = 6144;
constexpr int PQ0 = 512, PKV0 = 896, PKR0 = 1152, PR0 = 1184, PG0 = 2976, PEND = 6048;
constexpr int NEXP = 16;
constexpr int EROWS = 54272;

enum { I_X = 0, I_C, I_CTX, I_CCTX, I_WADA, I_BADA, I_N1G, I_N2G, I_WIN, I_QNG, I_KVNG, I_WUQ, I_WUKV, I_MU, I_W0, I_WUP, I_A0, I_AUP, I_GUP,
       I_KK, I_KA, I_RK, I_GNG, I_GNB, I_WPA, I_WPB, I_WPC, I_WOUT, I_RW, I_RB, I_EG, I_EU, I_ED, I_SG, I_SU, I_SD, I_FNG, N_IN };

struct Params { const float* in[N_IN]; float* out; char* ws; };

constexpr size_t al256(size_t x) { return (x + 255) & ~(size_t)255; }
constexpr size_t O_BAR   = 0;
constexpr size_t O_CNT   = O_BAR + 16384;
constexpr size_t O_MOD   = O_CNT + 4096;
constexpr size_t O_ROPEC = O_MOD + (size_t)NLAYER * 5 * 6144 * 4;
constexpr size_t O_ROPES = O_ROPEC + (size_t)SEQ * 16 * 4;
constexpr size_t O_CSC   = O_ROPES + (size_t)SEQ * 16 * 4;
constexpr size_t O_CST256= O_CSC + 256 * 128 * 2;
constexpr size_t O_CST   = O_CST256 + 256 * 512 * 2;
constexpr size_t O_XCUR  = O_CST + (size_t)4096 * 8192 * 2;
constexpr size_t O_WB    = O_XCUR + (size_t)RT * DM * 4;
constexpr size_t W_IN   = 0;
constexpr size_t W_UQ   = W_IN + (size_t)6144 * 1024 * 2;
constexpr size_t W_UKV  = W_UQ + (size_t)768 * 384 * 2;
constexpr size_t W_WUP  = W_UKV + (size_t)1024 * 256 * 2;
constexpr size_t W_AUP  = W_WUP + (size_t)2 * 512 * 64 * 2;
constexpr size_t W_GUP  = W_AUP + (size_t)2 * 512 * 64 * 2;
constexpr size_t W_PA   = W_GUP + (size_t)512 * 128 * 2;
constexpr size_t W_PB   = W_PA + (size_t)1024 * 512 * 2;
constexpr size_t W_PC   = W_PB + (size_t)1024 * 512 * 2;
constexpr size_t W_OUT  = W_PC + (size_t)1024 * 512 * 2;
constexpr size_t W_GU   = W_OUT + (size_t)1024 * 1024 * 2;
constexpr size_t W_D    = W_GU + (size_t)17 * 1024 * 1024 * 2;
constexpr size_t W_END  = W_D + (size_t)17 * 1024 * 512 * 2;
constexpr size_t O_H    = O_WB + W_END;
constexpr size_t O_P    = O_H + (size_t)RT * DM * 2;
constexpr size_t O_ATT  = O_P + (size_t)RT * LDP * 2;
constexpr size_t O_RG   = O_ATT + (size_t)RT * 512 * 2;
constexpr size_t O_RWO  = O_RG + (size_t)RT * 512 * 2;
constexpr size_t O_FA   = O_RWO + (size_t)RT * 512 * 2;
constexpr size_t O_LTOK = O_FA + (size_t)RT * 512 * 2;
constexpr size_t O_LW   = O_LTOK + (size_t)NEXP * RT * 4;
constexpr size_t O_SLOT = O_LW + (size_t)NEXP * RT * 4;
constexpr size_t O_X    = al256(O_SLOT + (size_t)RT * 2 * 4);
constexpr size_t X_QRAW = 0;
constexpr size_t X_KVRAW= X_QRAW + (size_t)RT * 768 * 2;
constexpr size_t X_QA   = X_KVRAW + (size_t)RT * 1024 * 2;
constexpr size_t X_KA   = X_QA + (size_t)RT * 768 * 2;
constexpr size_t X_VA   = X_KA + (size_t)4 * KEYS * 768 * 2;
constexpr size_t X_DEC  = 0;
constexpr size_t X_AA   = X_DEC + (size_t)2 * RT * 512 * 4;
constexpr size_t X_KKN  = X_AA + (size_t)2 * RT * 512 * 2;
constexpr size_t X_YS   = X_KKN + (size_t)RT * 8 * 4;
constexpr size_t X_END  = X_YS + (size_t)2 * RT * 512 * 4;
constexpr size_t X_YT   = 0;
constexpr size_t X_YTC  = X_YT + (size_t)4 * 512 * 8192 * 2;
constexpr size_t X_YE   = 0;
constexpr size_t WS_NEED = O_X + X_END;

__device__ __forceinline__ float bf2f(bf16_t u) { return __builtin_bit_cast(float, (unsigned)u << 16); }
__device__ __forceinline__ float bflo(unsigned u) { return __builtin_bit_cast(float, u << 16); }
__device__ __forceinline__ float bfhi(unsigned u) { return __builtin_bit_cast(float, u & 0xffff0000u); }
__device__ __forceinline__ unsigned pack2(float lo, float hi) { f32x2 v = {lo, hi}; bf16v2 b = __builtin_convertvector(v, bf16v2); return __builtin_bit_cast(unsigned, b); }
__device__ __forceinline__ bf16_t f2bf(float f) { return (bf16_t)(pack2(f, 0.f) & 0xffffu); }
__device__ __forceinline__ float wsum(float v) {
#pragma unroll
    for (int o = 32; o > 0; o >>= 1) v += __shfl_xor(v, o);
    return v;
}
__device__ __forceinline__ float sigmoidf_(float x) { return 1.f / (1.f + __expf(-x)); }
__device__ __forceinline__ float siluf_(float x) { return x / (1.f + __expf(-x)); }
__device__ __forceinline__ int modidx(int row) { return row < RL ? (row >> 12) : 4; }
__device__ __forceinline__ void unpack8(const uint4& u, float (&f)[8]) {
    f[0] = bflo(u.x); f[1] = bfhi(u.x); f[2] = bflo(u.y); f[3] = bfhi(u.y); f[4] = bflo(u.z); f[5] = bfhi(u.z); f[6] = bflo(u.w); f[7] = bfhi(u.w);
}
__device__ __forceinline__ uint4 pack8(const float (&f)[8]) { return make_uint4(pack2(f[0], f[1]), pack2(f[2], f[3]), pack2(f[4], f[5]), pack2(f[6], f[7])); }

#define XB_TMO      128
#define XB_XCNT(j)  (256  + 64 * (j))
#define XB_XSUB(j)  (1280 + 64 * (j))
#define XB_XGEN(j)  (2304 + 64 * (j))
#define XB_TOP      3328
#define XB_TOPGEN   3392
#define XCD_BAR_WORDS 3456
#define XB_SPIN_CAP (1u << 22)
#define LAS __attribute__((address_space(3)))
__device__ __forceinline__ unsigned xb_ld(unsigned* p)              { return __hip_atomic_load(p, __ATOMIC_RELAXED, __HIP_MEMORY_SCOPE_AGENT); }
__device__ __forceinline__ unsigned xb_add(unsigned* p, unsigned v) { return __hip_atomic_fetch_add(p, v, __ATOMIC_RELAXED, __HIP_MEMORY_SCOPE_AGENT); }
__device__ __forceinline__ unsigned xb_xcc_id() { return (unsigned)__builtin_amdgcn_s_getreg((3 << 11) | 20) & 0xFu; }
#define XB_SPIN(cond, bar) do { unsigned _sp = 0; while (cond) { __builtin_amdgcn_s_sleep(1); \
    if ((++_sp & 255u) == 0u) { if (xb_ld(&(bar)[XB_TMO])) break; if (_sp > XB_SPIN_CAP) { atomicAdd(&(bar)[XB_TMO], 1u); break; } } } } while (0)
struct XcdBarrier { unsigned* bar; unsigned x; volatile LAS unsigned* st; };
__device__ __forceinline__ XcdBarrier xcd_barrier_post(unsigned* bar, volatile LAS unsigned* st) {
    XcdBarrier b; b.bar = bar; b.x = xb_xcc_id(); b.st = st;
    if (threadIdx.x == 0) (void)xb_add(&bar[XB_XCNT(b.x)], 1u);
    return b;
}
__device__ __forceinline__ void xcd_barrier_complete(unsigned* bar, unsigned x, unsigned& nloc, unsigned& nx) {
    const unsigned G = gridDim.x * gridDim.y * gridDim.z;
    unsigned sum, cnt, mine, sp = 0u;
    for (;;) {
        sum = 0u; cnt = 0u; mine = 0u;
#pragma unroll
        for (unsigned j = 0; j < 16; ++j) { const unsigned c = xb_ld(&bar[XB_XCNT(j)]); sum += c; cnt += (c > 0u) ? 1u : 0u; mine = (j == x) ? c : mine; }
        if (sum == G) break;
        __builtin_amdgcn_s_sleep(1);
        if ((++sp & 255u) == 0u) { if (xb_ld(&bar[XB_TMO])) break; if (sp > XB_SPIN_CAP) { atomicAdd(&bar[XB_TMO], 1u); break; } }
    }
    nloc = mine > 0u ? mine : 1u; nx = cnt > 0u ? cnt : 1u;
}
__device__ __forceinline__ void xcd_barrier(const XcdBarrier& b) {
    asm volatile("s_waitcnt vmcnt(0)" ::: "memory");
    __syncthreads();
    if (threadIdx.x == 0) {
        unsigned* bar = b.bar;
        __builtin_amdgcn_s_waitcnt(0);
        unsigned nloc = b.st[0], nx = b.st[1];
        if (nloc == 0u) { xcd_barrier_complete(bar, b.x, nloc, nx); b.st[0] = nloc; b.st[1] = nx; }
        const unsigned old = xb_add(&bar[XB_XSUB(b.x)], 1u);
        const unsigned gen = old / nloc;
        if (old + 1u == (gen + 1u) * nloc) {
            __builtin_amdgcn_fence(__ATOMIC_RELEASE, "agent");
            asm volatile("s_waitcnt vmcnt(0)" ::: "memory");
            const unsigned og = xb_add(&bar[XB_TOP], 1u);
            const unsigned tg = og / nx;
            if (og + 1u == (tg + 1u) * nx) xb_add(&bar[XB_TOPGEN], 1u);
            else XB_SPIN(xb_ld(&bar[XB_TOPGEN]) == tg, bar);
            __builtin_amdgcn_fence(__ATOMIC_ACQUIRE, "agent");
            xb_add(&bar[XB_XGEN(b.x)], 1u);
            asm volatile("s_waitcnt vmcnt(0)" ::: "memory");
        } else {
            XB_SPIN(xb_ld(&bar[XB_XGEN(b.x)]) == gen, bar);
            __builtin_amdgcn_fence(__ATOMIC_ACQUIRE, "agent");
            asm volatile("s_waitcnt vmcnt(0)" ::: "memory");
        }
    }
    __syncthreads();
}

constexpr int LDSROW = 40;
template <int MI, class AL>
__device__ __forceinline__ void gemm_core(const AL& al, const bf16_t* __restrict__ Bt, int ldb, int K, f32x4 (&acc)[MI][4], char* smem) {
    constexpr int TM = MI * 32;
    constexpr int NA = TM / 64;
    bf16_t* As = (bf16_t*)smem;
    bf16_t* Bs = As + 2 * TM * LDSROW;
    const int tid = threadIdx.x, lane = tid & 63, wave = tid >> 6;
    const int wr = wave >> 1, wc = wave & 1, fr = lane & 15, fq = lane >> 4;
    const int kc = (tid & 3) * 8;
#pragma unroll
    for (int i = 0; i < MI; ++i)
#pragma unroll
        for (int j = 0; j < 4; ++j) acc[i][j] = (f32x4){0.f, 0.f, 0.f, 0.f};
    uint4 ra[NA], rb[2];
    const bf16_t* bp0 = Bt + (size_t)(tid >> 2) * ldb + kc;
    const bf16_t* bp1 = Bt + (size_t)((tid >> 2) + 64) * ldb + kc;
    const int nk = K >> 5;
#pragma unroll
    for (int i = 0; i < NA; ++i) ra[i] = al.load(i, kc);
    rb[0] = *(const uint4*)(bp0); rb[1] = *(const uint4*)(bp1);
#pragma unroll
    for (int i = 0; i < NA; ++i) *(uint4*)(As + ((tid >> 2) + 64 * i) * LDSROW + kc) = ra[i];
    *(uint4*)(Bs + (tid >> 2) * LDSROW + kc) = rb[0];
    *(uint4*)(Bs + ((tid >> 2) + 64) * LDSROW + kc) = rb[1];
    __syncthreads();
    for (int kt = 0; kt < nk; ++kt) {
        const int cur = kt & 1;
        if (kt + 1 < nk) {
            const int k0 = (kt + 1) << 5;
#pragma unroll
            for (int i = 0; i < NA; ++i) ra[i] = al.load(i, k0 + kc);
            rb[0] = *(const uint4*)(bp0 + k0); rb[1] = *(const uint4*)(bp1 + k0);
        }
        const bf16_t* Ac = As + cur * TM * LDSROW + (wr * MI * 16 + fr) * LDSROW + fq * 8;
        const bf16_t* Bc = Bs + cur * 128 * LDSROW + (wc * 64 + fr) * LDSROW + fq * 8;
        bf16x8 af[MI], bfv[4];
#pragma unroll
        for (int i = 0; i < MI; ++i) af[i] = *(const bf16x8*)(Ac + i * 16 * LDSROW);
#pragma unroll
        for (int j = 0; j < 4; ++j) bfv[j] = *(const bf16x8*)(Bc + j * 16 * LDSROW);
#pragma unroll
        for (int i = 0; i < MI; ++i)
#pragma unroll
            for (int j = 0; j < 4; ++j) acc[i][j] = __builtin_amdgcn_mfma_f32_16x16x32_bf16(bfv[j], af[i], acc[i][j], 0, 0, 0);
        if (kt + 1 < nk) {
            const int nxt = cur ^ 1;
#pragma unroll
            for (int i = 0; i < NA; ++i) *(uint4*)(As + nxt * TM * LDSROW + ((tid >> 2) + 64 * i) * LDSROW + kc) = ra[i];
            *(uint4*)(Bs + nxt * 128 * LDSROW + (tid >> 2) * LDSROW + kc) = rb[0];
            *(uint4*)(Bs + nxt * 128 * LDSROW + ((tid >> 2) + 64) * LDSROW + kc) = rb[1];
        }
        __syncthreads();
    }
}
template <int MI, class F>
__device__ __forceinline__ void acc_foreach(const f32x4 (&acc)[MI][4], F f) {
    const int lane = threadIdx.x & 63, wave = threadIdx.x >> 6;
    const int wr = wave >> 1, wc = wave & 1, fr = lane & 15, fq = lane >> 4;
#pragma unroll
    for (int i = 0; i < MI; ++i)
#pragma unroll
        for (int j = 0; j < 4; ++j) f(wr * MI * 16 + i * 16 + fr, wc * 64 + j * 16 + fq * 4, acc[i][j]);
}
struct ALPlain {
    const bf16_t* p[2];
    __device__ __forceinline__ ALPlain(const bf16_t* A, int lda, int row0) {
        const int r = threadIdx.x >> 2;
        p[0] = A + (size_t)(row0 + r) * lda; p[1] = A + (size_t)(row0 + r + 64) * lda;
    }
    __device__ __forceinline__ uint4 load(int i, int k) const { return *(const uint4*)(p[i] + k); }
};
__device__ __forceinline__ void store_bf16x4(bf16_t* dst, const f32x4& v) { *(uint2*)dst = make_uint2(pack2(v[0], v[1]), pack2(v[2], v[3])); }

__device__ __forceinline__ void ph_pre(const Params& p, char* smem) {
    const int tid = threadIdx.x, nb = gridDim.x, bid = blockIdx.x;
    float* mod = (float*)(p.ws + O_MOD);
    {
        float* sv = (float*)smem;
        float* part = sv + 5 * 1024;
        for (int i = tid; i < 5 * 1024; i += 256) { const float v = (i < 4096) ? p.in[I_C][i] : p.in[I_CCTX][i - 4096]; sv[i] = siluf_(v); }
        __syncthreads();
        for (int it = bid; it < NLAYER * 96; it += nb) {
            const int l = it / 96, jb = it % 96;
            const int jj = tid & 63, kq = tid >> 6, j = jb * 64 + jj;
            const float* w = p.in[I_WADA] + (size_t)l * 1024 * 6144 + (size_t)(kq * 256) * 6144 + j;
            float a0 = 0.f, a1 = 0.f, a2 = 0.f, a3 = 0.f, a4 = 0.f;
#pragma unroll 8
            for (int k = 0; k < 256; ++k) {
                const float wv = w[(size_t)k * 6144]; const int kk = kq * 256 + k;
                a0 += sv[kk] * wv; a1 += sv[1024 + kk] * wv; a2 += sv[2048 + kk] * wv; a3 += sv[3072 + kk] * wv; a4 += sv[4096 + kk] * wv;
            }
            part[(kq * 5 + 0) * 64 + jj] = a0; part[(kq * 5 + 1) * 64 + jj] = a1; part[(kq * 5 + 2) * 64 + jj] = a2;
            part[(kq * 5 + 3) * 64 + jj] = a3; part[(kq * 5 + 4) * 64 + jj] = a4;
            __syncthreads();
            for (int o = tid; o < 320; o += 256) {
                const int i = o >> 6, c = o & 63;
                const float s = part[(0 * 5 + i) * 64 + c] + part[(1 * 5 + i) * 64 + c] + part[(2 * 5 + i) * 64 + c] + part[(3 * 5 + i) * 64 + c];
                mod[(size_t)(l * 5 + i) * 6144 + jb * 64 + c] = s + p.in[I_BADA][l * 6144 + jb * 64 + c];
            }
            __syncthreads();
        }
    }
    {
        float4* xc = (float4*)(p.ws + O_XCUR);
        const float4* x4 = (const float4*)p.in[I_X]; const float4* c4 = (const float4*)p.in[I_CTX];
        for (size_t i = (size_t)bid * 256 + tid; i < (size_t)RT * 256; i += (size_t)nb * 256) xc[i] = (i < (size_t)RL * 256) ? x4[i] : c4[i - (size_t)RL * 256];
    }
    {
        float* ct = (float*)smem;
        __syncthreads();
        for (int m = tid; m < 4096; m += 256) ct[m] = cospif((float)m * (1.f / 2048.f));
        __syncthreads();
        bf16_t* cst = (bf16_t*)(p.ws + O_CST);
        for (size_t ch = (size_t)bid * 256 + tid; ch < (size_t)4096 * 8192 / 8; ch += (size_t)nb * 256) {
            const int kt = (int)(ch >> 10), c0 = (int)(ch & 1023) * 8, part = c0 >> 12, t0 = c0 & 4095;
            float f[8];
#pragma unroll
            for (int e = 0; e < 8; ++e) { const int m = (kt * (t0 + e)) & 4095; f[e] = part == 0 ? ct[m] : -ct[(m - 1024) & 4095]; }
            *(uint4*)(cst + ch * 8) = pack8(f);
        }
        bf16_t* cst2 = (bf16_t*)(p.ws + O_CST256);
        for (int ch = bid * 256 + tid; ch < 256 * 512 / 8; ch += nb * 256) {
            const int ks = ch >> 6, c0 = (ch & 63) * 8, part = c0 >> 8, s0 = c0 & 255;
            float f[8];
#pragma unroll
            for (int e = 0; e < 8; ++e) { const int m = (16 * ks * (s0 + e)) & 4095; f[e] = part == 0 ? ct[m] : -ct[(m - 1024) & 4095]; }
            *(uint4*)(cst2 + ch * 8) = pack8(f);
        }
        bf16_t* csc = (bf16_t*)(p.ws + O_CSC);
        for (int ch = bid * 256 + tid; ch < 256 * 128 / 8; ch += nb * 256) {
            const int n = ch >> 4, c0 = (ch & 15) * 8, part = n >> 7, kc = n & 127;
            float f[8];
#pragma unroll
            for (int e = 0; e < 8; ++e) { const int m = (32 * kc * (c0 + e)) & 4095; f[e] = part == 0 ? ct[m] : ct[(m - 1024) & 4095]; }
            *(uint4*)(csc + ch * 8) = pack8(f);
        }
        float* rc = (float*)(p.ws + O_ROPEC); float* rs = (float*)(p.ws + O_ROPES);
        for (int i = bid * 256 + tid; i < SEQ * 16; i += nb * 256) {
            const int t = i >> 4, ax = (i >> 3) & 1, f = i & 7;
            const float inv = powf(10000.f, -(float)f / 8.f);
            const float pos = (float)(ax == 0 ? (t >> 6) : (t & 63));
            const float ang = pos * inv;
            rc[i] = cosf(ang); rs[i] = sinf(ang);
        }
    }
}

struct ConvTask { const float* src; const float* scale; bf16_t* dst; int K, Nsrc, Ndst; size_t sbs, dbs; };
__constant__ int c_conv_cum[17] = {0, 1536, 1608, 1672, 1688, 1704, 1720, 1848, 1976, 2104, 2360, 4408, 6456, 8504, 8632, 8760, 8888};
__device__ __forceinline__ ConvTask conv_task(const Params& p, int l, int t) {
    bf16_t* wb = (bf16_t*)(p.ws + O_WB);
    ConvTask c; c.scale = nullptr; c.sbs = 0; c.dbs = 0;
    switch (t) {
    case 0:  c.src = p.in[I_WIN] + (size_t)l * 1024 * 6048; c.K = 1024; c.Nsrc = 6048; c.Ndst = 6144; c.dst = wb + W_IN / 2; break;
    case 1:  c.src = p.in[I_WUQ] + (size_t)l * 384 * 768; c.K = 384; c.Nsrc = 768; c.Ndst = 768; c.dst = wb + W_UQ / 2; c.scale = p.in[I_QNG] + l * 384; break;
    case 2:  c.src = p.in[I_WUKV] + (size_t)l * 256 * 1024; c.K = 256; c.Nsrc = 1024; c.Ndst = 1024; c.dst = wb + W_UKV / 2; c.scale = p.in[I_KVNG] + l * 256; break;
    case 3:  c.src = p.in[I_WUP] + (size_t)l * 2 * 64 * 512; c.K = 64; c.Nsrc = 512; c.Ndst = 512; c.dst = wb + W_WUP / 2; c.sbs = 64 * 512; c.dbs = 512 * 64; break;
    case 4:  c.src = p.in[I_AUP] + (size_t)l * 2 * 64 * 512; c.K = 64; c.Nsrc = 512; c.Ndst = 512; c.dst = wb + W_AUP / 2; c.sbs = 64 * 512; c.dbs = 512 * 64; break;
    case 5:  c.src = p.in[I_GUP] + (size_t)l * 128 * 512; c.K = 128; c.Nsrc = 512; c.Ndst = 512; c.dst = wb + W_GUP / 2; break;
    case 6:  c.src = p.in[I_WPA] + (size_t)l * 512 * 1024; c.K = 512; c.Nsrc = 1024; c.Ndst = 1024; c.dst = wb + W_PA / 2; break;
    case 7:  c.src = p.in[I_WPB] + (size_t)l * 512 * 1024; c.K = 512; c.Nsrc = 1024; c.Ndst = 1024; c.dst = wb + W_PB / 2; break;
    case 8:  c.src = p.in[I_WPC] + (size_t)l * 512 * 1024; c.K = 512; c.Nsrc = 1024; c.Ndst = 1024; c.dst = wb + W_PC / 2; break;
    case 9:  c.src = p.in[I_WOUT] + (size_t)l * 1024 * 1024; c.K = 1024; c.Nsrc = 1024; c.Ndst = 1024; c.dst = wb + W_OUT / 2; break;
    case 10: c.src = p.in[I_EG] + (size_t)l * 16 * 1024 * 512; c.K = 1024; c.Nsrc = 512; c.Ndst = 512; c.dst = wb + W_GU / 2; c.sbs = 1024 * 512; c.dbs = 1024 * 1024; break;
    case 11: c.src = p.in[I_EU] + (size_t)l * 16 * 1024 * 512; c.K = 1024; c.Nsrc = 512; c.Ndst = 512; c.dst = wb + W_GU / 2 + 512 * 1024; c.sbs = 1024 * 512; c.dbs = 1024 * 1024; break;
    case 12: c.src = p.in[I_ED] + (size_t)l * 16 * 512 * 1024; c.K = 512; c.Nsrc = 1024; c.Ndst = 1024; c.dst = wb + W_D / 2; c.sbs = 512 * 1024; c.dbs = 1024 * 512; break;
    case 13: c.src = p.in[I_SG] + (size_t)l * 1024 * 512; c.K = 1024; c.Nsrc = 512; c.Ndst = 512; c.dst = wb + W_GU / 2 + (size_t)16 * 1024 * 1024; break;
    case 14: c.src = p.in[I_SU] + (size_t)l * 1024 * 512; c.K = 1024; c.Nsrc = 512; c.Ndst = 512; c.dst = wb + W_GU / 2 + (size_t)16 * 1024 * 1024 + 512 * 1024; break;
    default: c.src = p.in[I_SD] + (size_t)l * 512 * 1024; c.K = 512; c.Nsrc = 1024; c.Ndst = 1024; c.dst = wb + W_D / 2 + (size_t)16 * 1024 * 512; break;
    }
    return c;
}
__device__ __forceinline__ void ph_w(const Params& p, int l, char* smem) {
    const int tid = threadIdx.x;
    float* tl = (float*)smem;
    for (int g = blockIdx.x; g < 8888; g += gridDim.x) {
        int t = 0;
        while (g >= c_conv_cum[t + 1]) ++t;
        const ConvTask c = conv_task(p, l, t);
        int r = g - c_conv_cum[t];
        const int nkt = c.K >> 6, nnt = c.Ndst >> 6;
        const int bi = r / (nkt * nnt); r -= bi * nkt * nnt;
        const int k0 = (r / nnt) * 64, n0 = (r % nnt) * 64;
        const float* src = c.src + bi * c.sbs; bf16_t* dst = c.dst + bi * c.dbs;
#pragma unroll
        for (int i = 0; i < 4; ++i) {
            const int k = (tid >> 4) + 16 * i, n = n0 + (tid & 15) * 4;
            float4 v = make_float4(0.f, 0.f, 0.f, 0.f);
            if (n < c.Nsrc) v = *(const float4*)(src + (size_t)(k0 + k) * c.Nsrc + n);
            if (c.scale) { const float s = c.scale[k0 + k]; v.x *= s; v.y *= s; v.z *= s; v.w *= s; }
            float* d = tl + k * 65 + (tid & 15) * 4;
            d[0] = v.x; d[1] = v.y; d[2] = v.z; d[3] = v.w;
        }
        __syncthreads();
        {
            const int n = tid >> 2, kk0 = (tid & 3) * 16;
            float f[8], g2[8];
#pragma unroll
            for (int j = 0; j < 8; ++j) { f[j] = tl[(kk0 + j) * 65 + n]; g2[j] = tl[(kk0 + 8 + j) * 65 + n]; }
            bf16_t* d = dst + (size_t)(n0 + n) * c.K + k0 + kk0;
            *(uint4*)d = pack8(f); *(uint4*)(d + 8) = pack8(g2);
        }
        __syncthreads();
    }
}

__device__ __forceinline__ void ph_n1(const Params& p, int l) {
    const int lane = threadIdx.x & 63, wave = threadIdx.x >> 6;
    const float* xcur = (const float*)(p.ws + O_XCUR); const float* mod = (const float*)(p.ws + O_MOD);
    bf16_t* H = (bf16_t*)(p.ws + O_H);
    if (blockIdx.x == 0 && threadIdx.x < 64) ((unsigned*)(p.ws + O_CNT))[threadIdx.x] = 0u;
    const float* g = p.in[I_N1G] + l * 1024;
    for (int row = blockIdx.x * 4 + wave; row < RT; row += gridDim.x * 4) {
        const float* x = xcur + (size_t)row * 1024; const float* md = mod + (size_t)(l * 5 + modidx(row)) * 6144;
        float4 v[4]; float ss = 0.f;
#pragma unroll
        for (int i = 0; i < 4; ++i) { v[i] = *(const float4*)(x + lane * 4 + 256 * i); ss += v[i].x * v[i].x + v[i].y * v[i].y + v[i].z * v[i].z + v[i].w * v[i].w; }
        ss = wsum(ss);
        const float rstd = rsqrtf(ss * (1.f / 1024.f) + 1e-6f);
#pragma unroll
        for (int i = 0; i < 4; ++i) {
            const int c = lane * 4 + 256 * i;
            const float4 gg = *(const float4*)(g + c), sc = *(const float4*)(md + 1024 + c), sh = *(const float4*)(md + c);
            f32x4 h = {v[i].x * rstd * gg.x * (1.f + sc.x) + sh.x, v[i].y * rstd * gg.y * (1.f + sc.y) + sh.y,
                       v[i].z * rstd * gg.z * (1.f + sc.z) + sh.z, v[i].w * rstd * gg.w * (1.f + sc.w) + sh.w};
            store_bf16x4(H + (size_t)row * 1024 + c, h);
        }
    }
}

__device__ __forceinline__ void ph_g1(const Params& p, char* smem) {
    const bf16_t* H = (const bf16_t*)(p.ws + O_H); const bf16_t* W = (const bf16_t*)(p.ws + O_WB + W_IN);
    bf16_t* P = (bf16_t*)(p.ws + O_P);
    for (int it = blockIdx.x; it < 136 * 48; it += gridDim.x) {
        const int mt = it / 48, nt = it % 48;
        f32x4 acc[4][4];
        ALPlain al(H, 1024, mt * 128);
        gemm_core<4>(al, W + (size_t)nt * 128 * 1024, 1024, 1024, acc, smem);
        acc_foreach<4>(acc, [&](int m, int n, const f32x4& v) {
            const int col = nt * 128 + n; f32x4 o = v;
            if (col >= PG0 && col < PEND) { o[0] = sigmoidf_(v[0]); o[1] = sigmoidf_(v[1]); o[2] = sigmoidf_(v[2]); o[3] = sigmoidf_(v[3]); }
            store_bf16x4(P + (size_t)(mt * 128 + m) * LDP + col, o);
        });
    }
}

__device__ __forceinline__ void ph_qu(const Params& p, char* smem) {
    const bf16_t* P = (const bf16_t*)(p.ws + O_P);
    bf16_t* QR = (bf16_t*)(p.ws + O_X + X_QRAW); bf16_t* KVR = (bf16_t*)(p.ws + O_X + X_KVRAW);
    for (int it = blockIdx.x; it < 136 * 14; it += gridDim.x) {
        const int mt = it / 14, nn = it % 14;
        f32x4 acc[4][4];
        if (nn < 6) {
            ALPlain al(P + PQ0, LDP, mt * 128);
            gemm_core<4>(al, (const bf16_t*)(p.ws + O_WB + W_UQ) + (size_t)nn * 128 * 384, 384, 384, acc, smem);
            acc_foreach<4>(acc, [&](int m, int n, const f32x4& v) { store_bf16x4(QR + (size_t)(mt * 128 + m) * 768 + nn * 128 + n, v); });
        } else {
            const int nt = nn - 6;
            ALPlain al(P + PKV0, LDP, mt * 128);
            gemm_core<4>(al, (const bf16_t*)(p.ws + O_WB + W_UKV) + (size_t)nt * 128 * 256, 256, 256, acc, smem);
            acc_foreach<4>(acc, [&](int m, int n, const f32x4& v) { store_bf16x4(KVR + (size_t)(mt * 128 + m) * 1024 + nt * 128 + n, v); });
        }
    }
}

constexpr float QSCALE = 0.10206207261596575f * 1.4426950408889634f;
__device__ __forceinline__ void ph_m2(const Params& p) {
    const int lane = threadIdx.x & 63, wave = threadIdx.x >> 6;
    const bf16_t* P = (const bf16_t*)(p.ws + O_P);
    const bf16_t* QR = (const bf16_t*)(p.ws + O_X + X_QRAW); const bf16_t* KVR = (const bf16_t*)(p.ws + O_X + X_KVRAW);
    bf16_t* QA = (bf16_t*)(p.ws + O_X + X_QA); bf16_t* KA = (bf16_t*)(p.ws + O_X + X_KA); bf16_t* VA = (bf16_t*)(p.ws + O_X + X_VA);
    const float* rc = (const float*)(p.ws + O_ROPEC); const float* rs = (const float*)(p.ws + O_ROPES);
    for (int row = blockIdx.x * 4 + wave; row < RT; row += gridDim.x * 4) {
        const bool lat = row < RL;
        const int b = lat ? (row >> 12) : ((row - RL) >> 8), t = lat ? (row & 4095) : ((row - RL) & 255);
        const size_t keyrow = (size_t)b * KEYS + (lat ? t : SEQ + t);
        const bf16_t* pr = P + (size_t)row * LDP;
        float sq = 0.f, sk = 0.f;
#pragma unroll
        for (int i = 0; i < 6; ++i) { const float v = bf2f(pr[PQ0 + lane + 64 * i]); sq += v * v; }
#pragma unroll
        for (int i = 0; i < 4; ++i) { const float v = bf2f(pr[PKV0 + lane + 64 * i]); sk += v * v; }
        sq = wsum(sq); sk = wsum(sk);
        const float rq = rsqrtf(sq * (1.f / 384.f) + 1e-6f), rkv = rsqrtf(sk * (1.f / 256.f) + 1e-6f);
        const bf16_t* qr = QR + (size_t)row * 768; const bf16_t* kvr = KVR + (size_t)row * 1024;
        const float* rct = rc + t * 16; const float* rst = rs + t * 16;
#pragma unroll
        for (int i = 0; i < 12; ++i) {
            const int e = lane + 64 * i, h = e / 96, dd = e - h * 96;
            float xq = bf2f(qr[e]) * rq, xk;
            if (dd < 64) xk = bf2f(kvr[h * 128 + dd]) * rkv;
            else {
                const int ii = dd - 64;
                xk = bf2f(pr[PKR0 + ii]);
                if (lat) {
                    const int ax = ii >> 4, half = (ii >> 3) & 1, f = ii & 7;
                    const float c = rct[ax * 8 + f], s = rst[ax * 8 + f];
                    const float xqp = bf2f(qr[half ? e - 8 : e + 8]) * rq, xkp = bf2f(pr[PKR0 + (ii ^ 8)]);
                    xq = half ? (xq * c + xqp * s) : (xq * c - xqp * s);
                    xk = half ? (xk * c + xkp * s) : (xk * c - xkp * s);
                }
            }
            QA[(size_t)row * 768 + e] = f2bf(xq * QSCALE);
            KA[keyrow * 768 + e] = f2bf(xk);
        }
#pragma unroll
        for (int i = 0; i < 8; ++i) {
            const int e = lane + 64 * i, h = e >> 6, dd = e & 63;
            VA[keyrow * 512 + e] = f2bf(bf2f(kvr[h * 128 + 64 + dd]) * rkv);
        }
    }
}

constexpr int KS_LD = 104, VT_LD = 72;
constexpr int AT_BUF = 64 * KS_LD * 2 + 64 * VT_LD * 2;
__device__ __forceinline__ void ph_at(const Params& p, int l, char* smem) {
    const int tid = threadIdx.x, lane = tid & 63, wave = tid >> 6, fr = lane & 15, fq = lane >> 4;
    const bf16_t* QA = (const bf16_t*)(p.ws + O_X + X_QA); const bf16_t* KA = (const bf16_t*)(p.ws + O_X + X_KA); const bf16_t* VA = (const bf16_t*)(p.ws + O_X + X_VA);
    bf16_t* ATT = (bf16_t*)(p.ws + O_ATT);
    const int nitems = 2048 + (l < NLAYER - 1 ? 128 : 0);
    for (int it = blockIdx.x; it < nitems; it += gridDim.x) {
        int b, h, row0, ntile; size_t krow0;
        if (it < 2048) { b = it >> 9; h = (it >> 6) & 7; row0 = b * SEQ + (it & 63) * 64; krow0 = (size_t)b * KEYS; ntile = KEYS / 64; }
        else { const int j = it - 2048; b = j >> 5; h = (j >> 2) & 7; row0 = RL + b * CTX + (j & 3) * 64; krow0 = (size_t)b * KEYS + SEQ; ntile = CTX / 64; }
        const int qrow = row0 + wave * 16 + fr;
        bf16x8 qf[3];
#pragma unroll
        for (int ks = 0; ks < 3; ++ks) qf[ks] = *(const bf16x8*)(QA + (size_t)qrow * 768 + h * 96 + ks * 32 + fq * 8);
        f32x4 ot[4];
#pragma unroll
        for (int i = 0; i < 4; ++i) ot[i] = (f32x4){0.f, 0.f, 0.f, 0.f};
        float m_run = -1e30f, l_run = 0.f;
        uint4 rk[3], rv[2];
        auto gload = [&](int kt) {
            const size_t kr = krow0 + (size_t)kt * 64;
#pragma unroll
            for (int i = 0; i < 3; ++i) { const int c = tid + 256 * i, key = c / 12, part = c % 12; rk[i] = *(const uint4*)(KA + (kr + key) * 768 + h * 96 + part * 8); }
#pragma unroll
            for (int i = 0; i < 2; ++i) { const int c = tid + 256 * i, key = c >> 3, part = c & 7; rv[i] = *(const uint4*)(VA + (kr + key) * 512 + h * 64 + part * 8); }
        };
        auto sstore = [&](int buf) {
            bf16_t* Ks = (bf16_t*)(smem + buf * AT_BUF); bf16_t* Vt = Ks + 64 * KS_LD;
#pragma unroll
            for (int i = 0; i < 3; ++i) { const int c = tid + 256 * i, key = c / 12, part = c % 12; *(uint4*)(Ks + key * KS_LD + part * 8) = rk[i]; }
#pragma unroll
            for (int i = 0; i < 2; ++i) {
                const int c = tid + 256 * i, key = c >> 3, part = c & 7;
                const unsigned w[4] = {rv[i].x, rv[i].y, rv[i].z, rv[i].w};
#pragma unroll
                for (int e = 0; e < 4; ++e) { Vt[(part * 8 + 2 * e) * VT_LD + key] = (bf16_t)(w[e] & 0xffffu); Vt[(part * 8 + 2 * e + 1) * VT_LD + key] = (bf16_t)(w[e] >> 16); }
            }
        };
        gload(0); sstore(0);
        __syncthreads();
        for (int kt = 0; kt < ntile; ++kt) {
            const int cur = kt & 1;
            if (kt + 1 < ntile) gload(kt + 1);
            const bf16_t* Ks = (const bf16_t*)(smem + cur * AT_BUF); const bf16_t* Vt = Ks + 64 * KS_LD;
            f32x4 st[4];
#pragma unroll
            for (int j = 0; j < 4; ++j) {
                st[j] = (f32x4){0.f, 0.f, 0.f, 0.f};
#pragma unroll
                for (int ks = 0; ks < 3; ++ks) {
                    const bf16x8 kf = *(const bf16x8*)(Ks + (j * 16 + fr) * KS_LD + ks * 32 + fq * 8);
                    st[j] = __builtin_amdgcn_mfma_f32_16x16x32_bf16(kf, qf[ks], st[j], 0, 0, 0);
                }
            }
            float mx = st[0][0];
#pragma unroll
            for (int j = 0; j < 4; ++j)
#pragma unroll
                for (int r = 0; r < 4; ++r) mx = fmaxf(mx, st[j][r]);
            mx = fmaxf(mx, __shfl_xor(mx, 16)); mx = fmaxf(mx, __shfl_xor(mx, 32));
            const float m_new = fmaxf(m_run, mx);
            const float alpha = exp2f(m_run - m_new);
            m_run = m_new;
            float ps = 0.f;
#pragma unroll
            for (int j = 0; j < 4; ++j)
#pragma unroll
                for (int r = 0; r < 4; ++r) { st[j][r] = exp2f(st[j][r] - m_new); ps += st[j][r]; }
            l_run = l_run * alpha + ps;
#pragma unroll
            for (int i = 0; i < 4; ++i) ot[i] *= alpha;
#pragma unroll
            for (int k2 = 0; k2 < 2; ++k2) {
                const uint4 pu = make_uint4(pack2(st[2 * k2][0], st[2 * k2][1]), pack2(st[2 * k2][2], st[2 * k2][3]),
                                            pack2(st[2 * k2 + 1][0], st[2 * k2 + 1][1]), pack2(st[2 * k2 + 1][2], st[2 * k2 + 1][3]));
                const bf16x8 pb = __builtin_bit_cast(bf16x8, pu);
#pragma unroll
                for (int dt = 0; dt < 4; ++dt) {
                    const bf16_t* vp = Vt + (dt * 16 + fr) * VT_LD + k2 * 32 + fq * 4;
                    const uint2 v0 = *(const uint2*)vp, v1 = *(const uint2*)(vp + 16);
                    const bf16x8 vf = __builtin_bit_cast(bf16x8, make_uint4(v0.x, v0.y, v1.x, v1.y));
                    ot[dt] = __builtin_amdgcn_mfma_f32_16x16x32_bf16(vf, pb, ot[dt], 0, 0, 0);
                }
            }
            if (kt + 1 < ntile) sstore(cur ^ 1);
            __syncthreads();
        }
        float lt = l_run; lt += __shfl_xor(lt, 16); lt += __shfl_xor(lt, 32);
        const float inv = 1.f / lt;
#pragma unroll
        for (int dt = 0; dt < 4; ++dt) { f32x4 o = ot[dt] * inv; store_bf16x4(ATT + (size_t)qrow * 512 + h * 64 + dt * 16 + fq * 4, o); }
    }
}

__device__ __forceinline__ void row_edges(int row, bool& first, bool& last) {
    if (row < RL) { const int t = row & 4095; first = t == 0; last = t == 4095; }
    else { const int s = (row - RL) & 255; first = s == 0; last = s == 255; }
}
__device__ __forceinline__ float xs1(const bf16_t* P, const float* mu, int row, int col) {
    bool first, last; row_edges(row, first, last);
    const bf16_t* pc = P + (size_t)row * LDP + PR0 + col;
    const float c = bf2f(*pc), pv = first ? 0.f : bf2f(*(pc - LDP)), nx = last ? 0.f : bf2f(*(pc + LDP));
    return c + (0.5f * (pv + nx) - c) * mu[col];
}
__device__ __forceinline__ void xs8(const bf16_t* P, const float* mu, int row, int col, float (&o)[8]) {
    bool first, last; row_edges(row, first, last);
    const bf16_t* pc = P + (size_t)row * LDP + PR0 + col;
    const uint4 z = make_uint4(0u, 0u, 0u, 0u);
    const uint4 uc = *(const uint4*)pc, up = first ? z : *(const uint4*)(pc - LDP), un = last ? z : *(const uint4*)(pc + LDP);
    float c[8], pv[8], nx[8]; unpack8(uc, c); unpack8(up, pv); unpack8(un, nx);
    const float4 m0 = *(const float4*)(mu + col), m1 = *(const float4*)(mu + col + 4);
    const float m[8] = {m0.x, m0.y, m0.z, m0.w, m1.x, m1.y, m1.z, m1.w};
#pragma unroll
    for (int j = 0; j < 8; ++j) o[j] = c[j] + (0.5f * (pv[j] + nx[j]) - c[j]) * m[j];
}
struct ALRw {
    const bf16_t* P; const float* mu; int row[2]; int colbase, mode;
    __device__ __forceinline__ ALRw(const bf16_t* P_, const float* mu_, int row0, int colbase_, int mode_) : P(P_), mu(mu_), colbase(colbase_), mode(mode_) {
        row[0] = row0 + (threadIdx.x >> 2); row[1] = row[0] + 64;
    }
    __device__ __forceinline__ uint4 load(int i, int k) const {
        float o[8]; xs8(P, mu, row[i], colbase + k, o);
        if (mode == 0) {
#pragma unroll
            for (int j = 0; j < 8; ++j) o[j] = tanhf(o[j]);
        } else if (mode == 2) {
#pragma unroll
            for (int j = 0; j < 8; ++j) o[j] = sigmoidf_(o[j]);
        }
        return pack8(o);
    }
};
__device__ __forceinline__ void ph_rp1(const Params& p, int l, char* smem) {
    const bf16_t* P = (const bf16_t*)(p.ws + O_P); const float* mu = p.in[I_MU] + l * 1792;
    float* DEC = (float*)(p.ws + O_X + X_DEC); bf16_t* AA = (bf16_t*)(p.ws + O_X + X_AA); bf16_t* RG = (bf16_t*)(p.ws + O_RG);
    for (int it = blockIdx.x; it < 5 * 544; it += gridDim.x) {
        const int sub = it / 544, rem = it % 544, mt = rem >> 2, nt = rem & 3;
        f32x4 acc[4][4];
        if (sub < 2) {
            const int d = sub;
            ALRw al(P, mu, mt * 128, 1536, 0);
            gemm_core<4>(al, (const bf16_t*)(p.ws + O_WB + W_WUP) + (size_t)d * 512 * 64 + (size_t)nt * 128 * 64, 64, 64, acc, smem);
            const float* w0 = p.in[I_W0] + (l * 2 + d) * 512;
            acc_foreach<4>(acc, [&](int m, int n, const f32x4& v) {
                const int col = nt * 128 + n; const float4 wz = *(const float4*)(w0 + col);
                const float z[4] = {wz.x + v[0], wz.y + v[1], wz.z + v[2], wz.w + v[3]};
                float4 o; float* op = (float*)&o;
#pragma unroll
                for (int j = 0; j < 4; ++j) {
                    const float sp = fmaxf(-z[j], 0.f) + log1pf(expf(-fabsf(z[j])));
                    op[j] = expf(-expf(-sp - 0.5f));
                }
                *(float4*)(DEC + ((size_t)d * RT + mt * 128 + m) * 512 + col) = o;
            });
        } else if (sub < 4) {
            const int d = sub - 2;
            ALRw al(P, mu, mt * 128, 1600, 1);
            gemm_core<4>(al, (const bf16_t*)(p.ws + O_WB + W_AUP) + (size_t)d * 512 * 64 + (size_t)nt * 128 * 64, 64, 64, acc, smem);
            const float* a0 = p.in[I_A0] + (l * 2 + d) * 512;
            acc_foreach<4>(acc, [&](int m, int n, const f32x4& v) {
                const int col = nt * 128 + n; const float4 az = *(const float4*)(a0 + col);
                f32x4 o = {sigmoidf_(az.x + v[0]), sigmoidf_(az.y + v[1]), sigmoidf_(az.z + v[2]), sigmoidf_(az.w + v[3])};
                store_bf16x4(AA + ((size_t)d * RT + mt * 128 + m) * 512 + col, o);
            });
        } else {
            ALRw al(P, mu, mt * 128, 1664, 2);
            gemm_core<4>(al, (const bf16_t*)(p.ws + O_WB + W_GUP) + (size_t)nt * 128 * 128, 128, 128, acc, smem);
            acc_foreach<4>(acc, [&](int m, int n, const f32x4& v) { store_bf16x4(RG + (size_t)(mt * 128 + m) * 512 + nt * 128 + n, v); });
        }
    }
}
__device__ __forceinline__ void ph_rp2(const Params& p, int l) {
    const int lane = threadIdx.x & 63, wave = threadIdx.x >> 6;
    const bf16_t* P = (const bf16_t*)(p.ws + O_P); const float* mu = p.in[I_MU] + l * 1792; const float* kkw = p.in[I_KK] + l * 512;
    float* KKN = (float*)(p.ws + O_X + X_KKN);
    for (int row = blockIdx.x * 4 + wave; row < RT; row += gridDim.x * 4) {
        float k8[8]; xs8(P, mu, row, 512 + lane * 8, k8);
        float s = 0.f;
#pragma unroll
        for (int j = 0; j < 8; ++j) { const float v = k8[j] * kkw[lane * 8 + j]; s += v * v; }
        s += __shfl_xor(s, 1); s += __shfl_xor(s, 2); s += __shfl_xor(s, 4);
        if ((lane & 7) == 0) KKN[(size_t)row * 8 + (lane >> 3)] = rsqrtf(s + 1e-12f);
    }
}

__device__ __forceinline__ int scan_row(int b, int d, int n) {
    if (n < CTX) return RL + b * CTX + (d == 0 ? n : CTX - 1 - n);
    const int t = n - CTX; return b * SEQ + (d == 0 ? t : SEQ - 1 - t);
}
constexpr int SC_STEPS = 16;
__device__ __forceinline__ float4 lds_ld4(const float* p) { return *(const float4*)p; }
__device__ __forceinline__ void ph_sc(const Params& p, int l, char* smem) {
    const int tid = threadIdx.x, lane = tid & 63, wave = tid >> 6;
    const bf16_t* P = (const bf16_t*)(p.ws + O_P); const float* mu = p.in[I_MU] + l * 1792;
    const float* kkw = p.in[I_KK] + l * 512; const float* kaw = p.in[I_KA] + l * 512;
    const float* DEC = (const float*)(p.ws + O_X + X_DEC); const bf16_t* AA = (const bf16_t*)(p.ws + O_X + X_AA); const float* KKN = (const float*)(p.ws + O_X + X_KKN);
    float* YS = (float*)(p.ws + O_X + X_YS);
    float* buf = (float*)smem;
    for (int it = blockIdx.x; it < 64; it += gridDim.x) {
        const int b = it >> 4, h = (it >> 1) & 7, d = it & 1;
        auto stage = [&](int c, int bi) {
            float* dst = buf + bi * SC_STEPS * 384;
            for (int q = tid - 64; q < SC_STEPS * 64; q += 192) {
                const int s = q >> 6, k = q & 63, col = h * 64 + k;
                const int row = scan_row(b, d, c * SC_STEPS + s);
                const float xr = xs1(P, mu, row, col), xk = xs1(P, mu, row, 512 + col), xv = xs1(P, mu, row, 1024 + col);
                const float asg = bf2f(AA[((size_t)d * RT + row) * 512 + col]), dec = DEC[((size_t)d * RT + row) * 512 + col];
                const float kk = xk * kkw[col] * KKN[(size_t)row * 8 + h];
                float* o = dst + s * 384 + k;
                o[0] = -kk; o[64] = dec; o[128] = kk * asg; o[192] = xk * (1.f + (asg - 1.f) * kaw[col]); o[256] = xr; o[320] = xv;
            }
        };
        constexpr int NCH = (CTX + SEQ) / SC_STEPS;
        const int wave_u = __builtin_amdgcn_readfirstlane(tid >> 6);
        if (wave_u != 0) {
            stage(0, 0);
            __syncthreads();
            for (int c = 0; c < NCH; ++c) {
                if (c + 1 < NCH) stage(c + 1, (c + 1) & 1);
                __syncthreads();
            }
        } else {
            float st[64];
#pragma unroll
            for (int k = 0; k < 64; ++k) st[k] = 0.f;
            __syncthreads();
            for (int c = 0; c < NCH; ++c) {
                const float* src = buf + (c & 1) * SC_STEPS * 384;
#pragma unroll 1
                for (int s = 0; s < SC_STEPS; ++s) {
                    const float* sp = src + s * 384;
                    const float vv = sp[320 + lane];
                    float sa = 0.f;
#pragma unroll
                    for (int k4 = 0; k4 < 16; ++k4) {
                        const float4 a4 = lds_ld4(sp + k4 * 4);
                        sa += st[k4 * 4] * a4.x; sa += st[k4 * 4 + 1] * a4.y; sa += st[k4 * 4 + 2] * a4.z; sa += st[k4 * 4 + 3] * a4.w;
                        if ((k4 & 3) == 3) asm volatile("" : "+v"(sa));
                    }
                    float y = 0.f;
#pragma unroll
                    for (int k4 = 0; k4 < 16; ++k4) {
                        const float4 w4 = lds_ld4(sp + 64 + k4 * 4), b4 = lds_ld4(sp + 128 + k4 * 4);
                        const float4 k4v = lds_ld4(sp + 192 + k4 * 4), r4 = lds_ld4(sp + 256 + k4 * 4);
                        st[k4 * 4]     = st[k4 * 4] * w4.x     + (sa * b4.x + vv * k4v.x); y += st[k4 * 4] * r4.x;
                        st[k4 * 4 + 1] = st[k4 * 4 + 1] * w4.y + (sa * b4.y + vv * k4v.y); y += st[k4 * 4 + 1] * r4.y;
                        st[k4 * 4 + 2] = st[k4 * 4 + 2] * w4.z + (sa * b4.z + vv * k4v.z); y += st[k4 * 4 + 2] * r4.z;
                        st[k4 * 4 + 3] = st[k4 * 4 + 3] * w4.w + (sa * b4.w + vv * k4v.w); y += st[k4 * 4 + 3] * r4.w;
                        if ((k4 & 1) == 1) asm volatile("" : "+v"(y));
                    }
                    const int row = scan_row(b, d, c * SC_STEPS + s);
                    YS[((size_t)d * RT + row) * 512 + h * 64 + lane] = y;
                }
                __syncthreads();
            }
        }
    }
}

__device__ __forceinline__ void ph_rpost(const Params& p, int l) {
    const int lane = threadIdx.x & 63, wave = threadIdx.x >> 6;
    const bf16_t* P = (const bf16_t*)(p.ws + O_P); const float* mu = p.in[I_MU] + l * 1792;
    const float* kaw = p.in[I_KA] + l * 512; const float* rkw = p.in[I_RK] + l * 512;
    const float* gng = p.in[I_GNG] + l * 512; const float* gnb = p.in[I_GNB] + l * 512;
    const bf16_t* AA = (const bf16_t*)(p.ws + O_X + X_AA); const float* YS = (const float*)(p.ws + O_X + X_YS);
    const bf16_t* RG = (const bf16_t*)(p.ws + O_RG); bf16_t* RWO = (bf16_t*)(p.ws + O_RWO);
    for (int row = blockIdx.x * 4 + wave; row < RT; row += gridDim.x * 4) {
        const int col = lane * 8;
        float r8[8], k8[8], v8[8], a0[8], a1[8], g8[8];
        xs8(P, mu, row, col, r8); xs8(P, mu, row, 512 + col, k8); xs8(P, mu, row, 1024 + col, v8);
        unpack8(*(const uint4*)(AA + ((size_t)0 * RT + row) * 512 + col), a0);
        unpack8(*(const uint4*)(AA + ((size_t)1 * RT + row) * 512 + col), a1);
        unpack8(*(const uint4*)(RG + (size_t)row * 512 + col), g8);
        const float* y0p = YS + ((size_t)0 * RT + row) * 512 + col; const float* y1p = YS + ((size_t)1 * RT + row) * 512 + col;
        const float4 ya = *(const float4*)y0p, yb = *(const float4*)(y0p + 4), yc = *(const float4*)y1p, yd = *(const float4*)(y1p + 4);
        float y[8] = {ya.x + yc.x, ya.y + yc.y, ya.z + yc.z, ya.w + yc.w, yb.x + yd.x, yb.y + yd.y, yb.z + yd.z, yb.w + yd.w};
        float sm = 0.f, bs = 0.f;
#pragma unroll
        for (int j = 0; j < 8; ++j) {
            sm += y[j];
            const float ka = kaw[col + j];
            const float kd0 = k8[j] * (1.f + (a0[j] - 1.f) * ka), kd1 = k8[j] * (1.f + (a1[j] - 1.f) * ka);
            bs += r8[j] * rkw[col + j] * (kd0 + kd1);
        }
        sm += __shfl_xor(sm, 1); sm += __shfl_xor(sm, 2); sm += __shfl_xor(sm, 4);
        bs += __shfl_xor(bs, 1); bs += __shfl_xor(bs, 2); bs += __shfl_xor(bs, 4);
        const float mean = sm * (1.f / 64.f);
        float vs = 0.f;
#pragma unroll
        for (int j = 0; j < 8; ++j) { const float dlt = y[j] - mean; vs += dlt * dlt; }
        vs += __shfl_xor(vs, 1); vs += __shfl_xor(vs, 2); vs += __shfl_xor(vs, 4);
        const float rstd = rsqrtf(vs * (1.f / 64.f) + 64e-5f);
        float o[8];
#pragma unroll
        for (int j = 0; j < 8; ++j) o[j] = ((y[j] - mean) * rstd * gng[col + j] + gnb[col + j] + bs * v8[j]) * g8[j];
        *(uint4*)(RWO + (size_t)row * 512 + col) = pack8(o);
    }
}

__device__ __forceinline__ void ph_f1(const Params& p, int l, char* smem) {
    const bf16_t* P = (const bf16_t*)(p.ws + O_P); const bf16_t* CSC = (const bf16_t*)(p.ws + O_CSC);
    bf16_t* YT = (bf16_t*)(p.ws + O_X + X_YT); bf16_t* YTC = (bf16_t*)(p.ws + O_X + X_YTC);
    const int nitems = 1024 + (l < NLAYER - 1 ? 64 : 0);
    for (int it = blockIdx.x; it < nitems; it += gridDim.x) {
        f32x4 acc[4][4];
        if (it < 1024) {
            const int b = it >> 8, g = (it >> 6) & 3, mt = (it >> 5) & 1, nt = it & 31;
            ALPlain al(CSC, 128, mt * 128);
            gemm_core<4>(al, P + (size_t)(b * SEQ + nt * 128) * LDP + g * 128, LDP, 128, acc, smem);
            acc_foreach<4>(acc, [&](int m, int n, const f32x4& v) {
                store_bf16x4(YT + ((size_t)(b * 512 + g * 128 + m)) * 8192 + mt * 4096 + nt * 128 + n, v);
            });
        } else {
            const int j = it - 1024, b = j >> 4, g = (j >> 2) & 3, mt = (j >> 1) & 1, nt = j & 1;
            ALPlain al(CSC, 128, mt * 128);
            gemm_core<4>(al, P + (size_t)(RL + b * CTX + nt * 128) * LDP + g * 128, LDP, 128, acc, smem);
            acc_foreach<4>(acc, [&](int m, int n, const f32x4& v) {
                store_bf16x4(YTC + ((size_t)(b * 512 + g * 128 + m)) * 512 + mt * 256 + nt * 128 + n, v);
            });
        }
    }
}
__device__ __forceinline__ void ph_f2(const Params& p, int l, char* smem) {
    const bf16_t* CST = (const bf16_t*)(p.ws + O_CST); const bf16_t* CST2 = (const bf16_t*)(p.ws + O_CST256);
    const bf16_t* YT = (const bf16_t*)(p.ws + O_X + X_YT); const bf16_t* YTC = (const bf16_t*)(p.ws + O_X + X_YTC);
    bf16_t* FA = (bf16_t*)(p.ws + O_FA);
    const int nitems = 512 + (l < NLAYER - 1 ? 32 : 0);
    for (int it = blockIdx.x; it < nitems; it += gridDim.x) {
        f32x4 acc[4][4];
        if (it < 512) {
            const int b = it >> 7, mt = (it >> 2) & 31, nt = it & 3;
            ALPlain al(CST, 8192, mt * 128);
            gemm_core<4>(al, YT + ((size_t)b * 512 + nt * 128) * 8192, 8192, 8192, acc, smem);
            const float sc = 0.001381067932004975f;
            acc_foreach<4>(acc, [&](int m, int n, const f32x4& v) { f32x4 o = v * sc; store_bf16x4(FA + (size_t)(b * SEQ + mt * 128 + m) * 512 + nt * 128 + n, o); });
        } else {
            const int j = it - 512, b = j >> 3, mt = (j >> 2) & 1, nt = j & 3;
            ALPlain al(CST2, 512, mt * 128);
            gemm_core<4>(al, YTC + ((size_t)b * 512 + nt * 128) * 512, 512, 512, acc, smem);
            const float sc = 0.005524271728019903f;
            acc_foreach<4>(acc, [&](int m, int n, const f32x4& v) { f32x4 o = v * sc; store_bf16x4(FA + (size_t)(RL + b * CTX + mt * 128 + m) * 512 + nt * 128 + n, o); });
        }
    }
}

__device__ __forceinline__ void ph_mg(const Params& p, int l, char* smem) {
    const bf16_t* P = (const bf16_t*)(p.ws + O_P);
    const bf16_t* A[3] = {(const bf16_t*)(p.ws + O_FA), (const bf16_t*)(p.ws + O_ATT), (const bf16_t*)(p.ws + O_RWO)};
    const bf16_t* W[3] = {(const bf16_t*)(p.ws + O_WB + W_PA), (const bf16_t*)(p.ws + O_WB + W_PB), (const bf16_t*)(p.ws + O_WB + W_PC)};
    bf16_t* MG = (bf16_t*)(p.ws + O_H);
    const int nmt = (l < NLAYER - 1) ? RT / 64 : RL / 64;
    for (int it = blockIdx.x; it < nmt * 8; it += gridDim.x) {
        const int mt = it >> 3, nt = it & 7;
        f32x4 tot[2][4];
#pragma unroll
        for (int i = 0; i < 2; ++i)
#pragma unroll
            for (int j = 0; j < 4; ++j) tot[i][j] = (f32x4){0.f, 0.f, 0.f, 0.f};
#pragma unroll
        for (int br = 0; br < 3; ++br) {
            f32x4 acc[2][4];
            ALPlain al(A[br], 512, mt * 64);
            gemm_core<2>(al, W[br] + (size_t)nt * 128 * 512, 512, 512, acc, smem);
            const int lane = threadIdx.x & 63, wave = threadIdx.x >> 6, wr = wave >> 1, wc = wave & 1, fr = lane & 15, fq = lane >> 4;
#pragma unroll
            for (int i = 0; i < 2; ++i)
#pragma unroll
                for (int j = 0; j < 4; ++j) {
                    const int m = wr * 32 + i * 16 + fr, n = wc * 64 + j * 16 + fq * 4;
                    const uint2 gu = *(const uint2*)(P + (size_t)(mt * 64 + m) * LDP + PG0 + br * 1024 + nt * 128 + n);
                    tot[i][j][0] += bflo(gu.x) * acc[i][j][0]; tot[i][j][1] += bfhi(gu.x) * acc[i][j][1];
                    tot[i][j][2] += bflo(gu.y) * acc[i][j][2]; tot[i][j][3] += bfhi(gu.y) * acc[i][j][3];
                }
        }
        acc_foreach<2>(tot, [&](int m, int n, const f32x4& v) { store_bf16x4(MG + (size_t)(mt * 64 + m) * 1024 + nt * 128 + n, v); });
    }
}
__device__ __forceinline__ void ph_out(const Params& p, int l, char* smem) {
    const bf16_t* MG = (const bf16_t*)(p.ws + O_H); const bf16_t* W = (const bf16_t*)(p.ws + O_WB + W_OUT);
    float* xcur = (float*)(p.ws + O_XCUR); const float* mod = (const float*)(p.ws + O_MOD);
    const int nmt = (l < NLAYER - 1) ? RT / 128 : RL / 128;
    for (int it = blockIdx.x; it < nmt * 8; it += gridDim.x) {
        const int mt = it >> 3, nt = it & 7;
        f32x4 acc[4][4];
        ALPlain al(MG, 1024, mt * 128);
        gemm_core<4>(al, W + (size_t)nt * 128 * 1024, 1024, 1024, acc, smem);
        acc_foreach<4>(acc, [&](int m, int n, const f32x4& v) {
            const int row = mt * 128 + m, col = nt * 128 + n;
            const float4 g = *(const float4*)(mod + (size_t)(l * 5 + modidx(row)) * 6144 + 2048 + col);
            float4* xp = (float4*)(xcur + (size_t)row * 1024 + col);
            float4 x = *xp; x.x += g.x * v[0]; x.y += g.y * v[1]; x.z += g.z * v[2]; x.w += g.w * v[3]; *xp = x;
        });
    }
}

__device__ __forceinline__ void ph_n2(const Params& p, int l) {
    const int lane = threadIdx.x & 63, wave = threadIdx.x >> 6;
    const float* xcur = (const float*)(p.ws + O_XCUR); const float* mod = (const float*)(p.ws + O_MOD);
    bf16_t* H = (bf16_t*)(p.ws + O_H);
    unsigned* cnt = (unsigned*)(p.ws + O_CNT); int* LTOK = (int*)(p.ws + O_LTOK); float* LW = (float*)(p.ws + O_LW); int* SLOT = (int*)(p.ws + O_SLOT);
    const float* g = p.in[I_N2G] + l * 1024; const float* rw = p.in[I_RW]; const float* rb = p.in[I_RB];
    const int nrows = (l < NLAYER - 1) ? RT : RL;
    for (int row = blockIdx.x * 4 + wave; row < nrows; row += gridDim.x * 4) {
        const float* x = xcur + (size_t)row * 1024; const float* md = mod + (size_t)(l * 5 + modidx(row)) * 6144;
        float4 v[4]; float ss = 0.f;
#pragma unroll
        for (int i = 0; i < 4; ++i) { v[i] = *(const float4*)(x + lane * 4 + 256 * i); ss += v[i].x * v[i].x + v[i].y * v[i].y + v[i].z * v[i].z + v[i].w * v[i].w; }
        ss = wsum(ss);
        const float rstd = rsqrtf(ss * (1.f / 1024.f) + 1e-6f);
        float lg[16];
#pragma unroll
        for (int e = 0; e < 16; ++e) lg[e] = 0.f;
#pragma unroll
        for (int i = 0; i < 4; ++i) {
            const int c = lane * 4 + 256 * i;
            const float4 gg = *(const float4*)(g + c), sc = *(const float4*)(md + 4096 + c), sh = *(const float4*)(md + 3072 + c);
            const float hv[4] = {v[i].x * rstd * gg.x * (1.f + sc.x) + sh.x, v[i].y * rstd * gg.y * (1.f + sc.y) + sh.y,
                                 v[i].z * rstd * gg.z * (1.f + sc.z) + sh.z, v[i].w * rstd * gg.w * (1.f + sc.w) + sh.w};
            f32x4 h4 = {hv[0], hv[1], hv[2], hv[3]};
            store_bf16x4(H + (size_t)row * 1024 + c, h4);
#pragma unroll
            for (int j = 0; j < 4; ++j) {
                const float* wr_ = rw + (size_t)(c + j) * 16;
                const float4 w0 = *(const float4*)wr_, w1 = *(const float4*)(wr_ + 4), w2 = *(const float4*)(wr_ + 8), w3 = *(const float4*)(wr_ + 12);
                lg[0] += hv[j] * w0.x; lg[1] += hv[j] * w0.y; lg[2] += hv[j] * w0.z; lg[3] += hv[j] * w0.w;
                lg[4] += hv[j] * w1.x; lg[5] += hv[j] * w1.y; lg[6] += hv[j] * w1.z; lg[7] += hv[j] * w1.w;
                lg[8] += hv[j] * w2.x; lg[9] += hv[j] * w2.y; lg[10] += hv[j] * w2.z; lg[11] += hv[j] * w2.w;
                lg[12] += hv[j] * w3.x; lg[13] += hv[j] * w3.y; lg[14] += hv[j] * w3.z; lg[15] += hv[j] * w3.w;
            }
        }
        float sc_[16], sel[16];
#pragma unroll
        for (int e = 0; e < 16; ++e) { lg[e] = wsum(lg[e]); sc_[e] = 1.f / (1.f + expf(-lg[e])); sel[e] = sc_[e] + rb[e]; }
        int best = 0; float bestv = -1e30f;
#pragma unroll
        for (int gi = 0; gi < 4; ++gi) {
            float m1 = -1e30f, m2 = -1e30f;
#pragma unroll
            for (int j = 0; j < 4; ++j) { const float s = sel[gi * 4 + j]; if (s > m1) { m2 = m1; m1 = s; } else if (s > m2) m2 = s; }
            const float gs = m1 + m2;
            if (gs > bestv) { bestv = gs; best = gi; }
        }
        float s4[4] = {0.f, 0.f, 0.f, 0.f}, c4[4] = {0.f, 0.f, 0.f, 0.f};
#pragma unroll
        for (int gi = 0; gi < 4; ++gi)
#pragma unroll
            for (int j = 0; j < 4; ++j) if (gi == best) { s4[j] = sel[gi * 4 + j]; c4[j] = sc_[gi * 4 + j]; }
        int i1 = 0; float v1 = s4[0], w1 = c4[0];
#pragma unroll
        for (int j = 1; j < 4; ++j) if (s4[j] > v1) { v1 = s4[j]; i1 = j; w1 = c4[j]; }
        int i2 = -1; float v2 = -1e30f, w2 = 0.f;
#pragma unroll
        for (int j = 0; j < 4; ++j) if (j != i1 && s4[j] > v2) { v2 = s4[j]; i2 = j; w2 = c4[j]; }
        if (lane == 0) {
            const float inv = 1.f / (w1 + w2);
            const int e1 = best * 4 + i1, e2 = best * 4 + i2;
            const unsigned p1 = atomicAdd(&cnt[e1], 1u), p2 = atomicAdd(&cnt[e2], 1u);
            LTOK[(size_t)e1 * RT + p1] = row; LW[(size_t)e1 * RT + p1] = w1 * inv;
            LTOK[(size_t)e2 * RT + p2] = row; LW[(size_t)e2 * RT + p2] = w2 * inv;
            SLOT[row * 2] = (e1 << 20) | (int)p1; SLOT[row * 2 + 1] = (e2 << 20) | (int)p2;
        }
    }
}

struct MoeTiles { int tb[17]; int sm; };
__device__ __forceinline__ void moe_tiles(const Params& p, int l, int* s_tb) {
    if (threadIdx.x == 0) {
        const unsigned* cnt = (const unsigned*)(p.ws + O_CNT);
        int a = 0;
        for (int e = 0; e < 16; ++e) { s_tb[e] = a; a += ((int)cnt[e] + 127) >> 7; }
        s_tb[16] = a;
    }
    __syncthreads();
}
struct ALGather {
    const bf16_t* p[2]; bool ok[2];
    __device__ __forceinline__ uint4 load(int i, int k) const { return ok[i] ? *(const uint4*)(p[i] + k) : make_uint4(0u, 0u, 0u, 0u); }
};
struct ALSwiglu {
    const bf16_t* p[2]; float w[2];
    __device__ __forceinline__ uint4 load(int i, int k) const {
        float g[8], u[8], o[8]; unpack8(*(const uint4*)(p[i] + k), g); unpack8(*(const uint4*)(p[i] + 512 + k), u);
#pragma unroll
        for (int j = 0; j < 8; ++j) o[j] = siluf_(g[j]) * u[j] * w[i];
        return pack8(o);
    }
};
__device__ __forceinline__ void ph_e1(const Params& p, int l, char* smem) {
    int* s_tb = (int*)(smem + 48 * 1024);
    moe_tiles(p, l, s_tb);
    const bf16_t* H = (const bf16_t*)(p.ws + O_H); bf16_t* GU = (bf16_t*)(p.ws + O_P);
    const unsigned* cnt = (const unsigned*)(p.ws + O_CNT); const int* LTOK = (const int*)(p.ws + O_LTOK);
    const int sm = (l < NLAYER - 1) ? RT / 128 : RL / 128;
    const int total = (sm + s_tb[16]) * 8;
    for (int it = blockIdx.x; it < total; it += gridDim.x) {
        const int mt = it >> 3, nt = it & 7;
        int e = 16, erow0 = mt * 128, lt = 0;
        if (mt >= sm) { const int q = mt - sm; e = 0; while (q >= s_tb[e + 1]) ++e; lt = q - s_tb[e]; erow0 = RT + q * 128; }
        ALGather al;
#pragma unroll
        for (int i = 0; i < 2; ++i) {
            const int r = (threadIdx.x >> 2) + 64 * i;
            if (e == 16) { al.ok[i] = true; al.p[i] = H + (size_t)(mt * 128 + r) * 1024; }
            else { const int idx = lt * 128 + r; al.ok[i] = idx < (int)cnt[e]; const int tok = al.ok[i] ? LTOK[(size_t)e * RT + idx] : 0; al.p[i] = H + (size_t)tok * 1024; }
        }
        f32x4 acc[4][4];
        gemm_core<4>(al, (const bf16_t*)(p.ws + O_WB + W_GU) + (size_t)e * 1024 * 1024 + (size_t)nt * 128 * 1024, 1024, 1024, acc, smem);
        acc_foreach<4>(acc, [&](int m, int n, const f32x4& v) { store_bf16x4(GU + (size_t)(erow0 + m) * 1024 + nt * 128 + n, v); });
    }
}
__device__ __forceinline__ void ph_e2(const Params& p, int l, char* smem) {
    int* s_tb = (int*)(smem + 48 * 1024);
    moe_tiles(p, l, s_tb);
    const bf16_t* GU = (const bf16_t*)(p.ws + O_P); bf16_t* YE = (bf16_t*)(p.ws + O_X + X_YE);
    const unsigned* cnt = (const unsigned*)(p.ws + O_CNT); const float* LW = (const float*)(p.ws + O_LW);
    const int sm = (l < NLAYER - 1) ? RT / 128 : RL / 128;
    const int total = (sm + s_tb[16]) * 8;
    for (int it = blockIdx.x; it < total; it += gridDim.x) {
        const int mt = it >> 3, nt = it & 7;
        int e = 16, erow0 = mt * 128, lt = 0;
        if (mt >= sm) { const int q = mt - sm; e = 0; while (q >= s_tb[e + 1]) ++e; lt = q - s_tb[e]; erow0 = RT + q * 128; }
        ALSwiglu al;
#pragma unroll
        for (int i = 0; i < 2; ++i) {
            const int r = (threadIdx.x >> 2) + 64 * i;
            al.p[i] = GU + (size_t)(erow0 + r) * 1024;
            if (e == 16) al.w[i] = 1.f;
            else { const int idx = lt * 128 + r; al.w[i] = idx < (int)cnt[e] ? LW[(size_t)e * RT + idx] : 0.f; }
        }
        f32x4 acc[4][4];
        gemm_core<4>(al, (const bf16_t*)(p.ws + O_WB + W_D) + (size_t)e * 1024 * 512 + (size_t)nt * 128 * 512, 512, 512, acc, smem);
        acc_foreach<4>(acc, [&](int m, int n, const f32x4& v) { store_bf16x4(YE + (size_t)(erow0 + m) * 1024 + nt * 128 + n, v); });
    }
}
__device__ __forceinline__ void ph_e3(const Params& p, int l, char* smem) {
    int* s_tb = (int*)(smem + 48 * 1024);
    moe_tiles(p, l, s_tb);
    const int lane = threadIdx.x & 63, wave = threadIdx.x >> 6;
    const bf16_t* YE = (const bf16_t*)(p.ws + O_X + X_YE); const int* SLOT = (const int*)(p.ws + O_SLOT);
    float* xcur = (float*)(p.ws + O_XCUR); const float* mod = (const float*)(p.ws + O_MOD);
    const int nrows = (l < NLAYER - 1) ? RT : RL;
    for (int row = blockIdx.x * 4 + wave; row < nrows; row += gridDim.x * 4) {
        const int s1 = SLOT[row * 2], s2 = SLOT[row * 2 + 1];
        const size_t r0 = row, r1 = (size_t)RT + s_tb[s1 >> 20] * 128 + (s1 & 0xfffff), r2 = (size_t)RT + s_tb[s2 >> 20] * 128 + (s2 & 0xfffff);
        const float* g2 = mod + (size_t)(l * 5 + modidx(row)) * 6144 + 5120;
#pragma unroll
        for (int i = 0; i < 2; ++i) {
            const int c = lane * 8 + 512 * i;
            float a[8], b[8], d[8];
            unpack8(*(const uint4*)(YE + r0 * 1024 + c), a); unpack8(*(const uint4*)(YE + r1 * 1024 + c), b); unpack8(*(const uint4*)(YE + r2 * 1024 + c), d);
            float4* xp = (float4*)(xcur + (size_t)row * 1024 + c);
            float4 x0 = xp[0], x1 = xp[1];
            const float4 ga = *(const float4*)(g2 + c), gb = *(const float4*)(g2 + c + 4);
            x0.x += ga.x * (a[0] + b[0] + d[0]); x0.y += ga.y * (a[1] + b[1] + d[1]); x0.z += ga.z * (a[2] + b[2] + d[2]); x0.w += ga.w * (a[3] + b[3] + d[3]);
            x1.x += gb.x * (a[4] + b[4] + d[4]); x1.y += gb.y * (a[5] + b[5] + d[5]); x1.z += gb.z * (a[6] + b[6] + d[6]); x1.w += gb.w * (a[7] + b[7] + d[7]);
            xp[0] = x0; xp[1] = x1;
        }
    }
}
__device__ __forceinline__ void ph_final(const Params& p) {
    const int lane = threadIdx.x & 63, wave = threadIdx.x >> 6;
    const float* xcur = (const float*)(p.ws + O_XCUR); const float* g = p.in[I_FNG];
    for (int row = blockIdx.x * 4 + wave; row < RL; row += gridDim.x * 4) {
        const float* x = xcur + (size_t)row * 1024;
        float4 v[4]; float ss = 0.f;
#pragma unroll
        for (int i = 0; i < 4; ++i) { v[i] = *(const float4*)(x + lane * 4 + 256 * i); ss += v[i].x * v[i].x + v[i].y * v[i].y + v[i].z * v[i].z + v[i].w * v[i].w; }
        ss = wsum(ss);
        const float rstd = rsqrtf(ss * (1.f / 1024.f) + 1e-6f);
#pragma unroll
        for (int i = 0; i < 4; ++i) {
            const int c = lane * 4 + 256 * i; const float4 gg = *(const float4*)(g + c);
            *(float4*)(p.out + (size_t)row * 1024 + c) = make_float4(v[i].x * rstd * gg.x, v[i].y * rstd * gg.y, v[i].z * rstd * gg.z, v[i].w * rstd * gg.w);
        }
    }
}

constexpr int LDS_BYTES = 51200;
constexpr int NIV = 17;
extern __shared__ __attribute__((aligned(16))) char dynsmem[];
template <int ID> __device__ __forceinline__ void run_iv(const Params& p, int l, char* smem) {
    if constexpr (ID == 0) { ph_pre(p, smem); __syncthreads(); ph_w(p, 0, smem); }
    else if constexpr (ID == 1) ph_n1(p, l);
    else if constexpr (ID == 2) ph_g1(p, smem);
    else if constexpr (ID == 3) ph_qu(p, smem);
    else if constexpr (ID == 4) ph_m2(p);
    else if constexpr (ID == 5) ph_at(p, l, smem);
    else if constexpr (ID == 6) { ph_rp1(p, l, smem); ph_rp2(p, l); }
    else if constexpr (ID == 7) ph_sc(p, l, smem);
    else if constexpr (ID == 8) { ph_rpost(p, l); ph_f1(p, l, smem); }
    else if constexpr (ID == 9) ph_f2(p, l, smem);
    else if constexpr (ID == 10) ph_mg(p, l, smem);
    else if constexpr (ID == 11) ph_out(p, l, smem);
    else if constexpr (ID == 12) ph_n2(p, l);
    else if constexpr (ID == 13) ph_e1(p, l, smem);
    else if constexpr (ID == 14) ph_e2(p, l, smem);
    else if constexpr (ID == 15) { ph_e3(p, l, smem); __syncthreads(); if (l + 1 < NLAYER) ph_w(p, l + 1, smem); }
    else ph_final(p);
}
#if MEGA
#define IV(ID) run_iv<ID>(p, l, smem); xcd_barrier(bar);
__global__ void __launch_bounds__(256, 2) k_mega(Params p) {
    char* smem = dynsmem;
    volatile LAS unsigned* st = (volatile LAS unsigned*)(smem + LDS_BYTES - 16);
    if (threadIdx.x == 0) { st[0] = 0u; st[1] = 0u; }
    __syncthreads();
    XcdBarrier bar = xcd_barrier_post((unsigned*)(p.ws + O_BAR), st);
    { const int l = 0; IV(0) }
    for (int l = 0; l < NLAYER; ++l) {
        IV(1) IV(2) IV(3) IV(4) IV(5) IV(6) IV(7) IV(8) IV(9) IV(10) IV(11) IV(12) IV(13) IV(14) IV(15)
    }
    run_iv<16>(p, 0, smem);
}
#else
template <int ID> __global__ void __launch_bounds__(256, 2) k_iv(Params p, int l) { run_iv<ID>(p, l, dynsmem); }
template <int ID> static void launch_iv(const Params& p, int l, int grid, hipStream_t s) { hipLaunchKernelGGL(k_iv<ID>, dim3(grid), dim3(256), LDS_BYTES, s, p, l); }
#endif

extern "C" void kernel_launch(void* const* d_in, const int* in_sizes, int n_in, void* d_out, int out_size, void* d_ws, size_t ws_size, hipStream_t stream) {
    (void)in_sizes; (void)out_size;
    if (n_in < N_IN || ws_size < WS_NEED) return;
    Params p{};
    for (int i = 0; i < N_IN; ++i) p.in[i] = (const float*)d_in[i];
    p.out = (float*)d_out; p.ws = (char*)d_ws;
    static int grid = 0;
    if (!grid) {
        int dev = 0, cus = 0; hipGetDevice(&dev); hipDeviceGetAttribute(&cus, hipDeviceAttributeMultiprocessorCount, dev);
        int per_cu = 2;
#if MEGA
        int occ = 0; hipOccupancyMaxActiveBlocksPerMultiprocessor(&occ, k_mega, 256, LDS_BYTES);
        if (occ < per_cu) per_cu = occ;
        if (per_cu < 1) per_cu = 1;
#endif
        grid = cus * per_cu;
    }
#if MEGA
    hipMemsetAsync(p.ws + O_BAR, 0, 16384, stream);
    hipLaunchKernelGGL(k_mega, dim3(grid), dim3(256), LDS_BYTES, stream, p);
#else
    launch_iv<0>(p, 0, grid, stream);
    for (int l = 0; l < NLAYER; ++l) {
        launch_iv<1>(p, l, grid, stream); launch_iv<2>(p, l, grid, stream); launch_iv<3>(p, l, grid, stream); launch_iv<4>(p, l, grid, stream);
        launch_iv<5>(p, l, grid, stream); launch_iv<6>(p, l, grid, stream); launch_iv<7>(p, l, grid, stream); launch_iv<8>(p, l, grid, stream);
        launch_iv<9>(p, l, grid, stream); launch_iv<10>(p, l, grid, stream); launch_iv<11>(p, l, grid, stream); launch_iv<12>(p, l, grid, stream);
        launch_iv<13>(p, l, grid, stream); launch_iv<14>(p, l, grid, stream); launch_iv<15>(p, l, grid, stream);
    }
    launch_iv<16>(p, 0, grid, stream);
#endif
}
```

```cpp
#include <hip/hip_runtime.h>
#include <stdint.h>

#ifndef MEGA
#define MEGA 1
#endif

typedef unsigned short bf16_t;
typedef short bf16x8 __attribute__((ext_vector_type(8)));
typedef float f32x4 __attribute__((ext_vector_type(4)));
typedef float f32x2 __attribute__((ext_vector_type(2)));
typedef __bf16 bf16v2 __attribute__((ext_vector_type(2)));

constexpr int NLAYER = 4;
constexpr int DM = 1024;
constexpr int RL = 16384, RC = 1024, RT = RL + RC;
constexpr int SEQ = 4096, CTX = 256, KEYS = SEQ + CTX;
constexpr int LDP = 6144;
constexpr int PQ0 = 512, PKV0 = 896, PKR0 = 1152, PR0 = 1184, PG0 = 2976, PEND = 6048;
constexpr int NEXP = 16;
constexpr int EROWS = 54272;

enum { I_X = 0, I_C, I_CTX, I_CCTX, I_WADA, I_BADA, I_N1G, I_N2G, I_WIN, I_QNG, I_KVNG, I_WUQ, I_WUKV, I_MU, I_W0, I_WUP, I_A0, I_AUP, I_GUP,
       I_KK, I_KA, I_RK, I_GNG, I_GNB, I_WPA, I_WPB, I_WPC, I_WOUT, I_RW, I_RB, I_EG, I_EU, I_ED, I_SG, I_SU, I_SD, I_FNG, N_IN };

struct Params { const float* in[N_IN]; float* out; char* ws; };

constexpr size_t al256(size_t x) { return (x + 255) & ~(size_t)255; }
constexpr size_t O_BAR   = 0;
constexpr size_t O_CNT   = O_BAR + 16384;
constexpr size_t O_MOD   = O_CNT + 4096;
constexpr size_t O_ROPEC = O_MOD + (size_t)NLAYER * 5 * 6144 * 4;
constexpr size_t O_ROPES = O_ROPEC + (size_t)SEQ * 16 * 4;
constexpr size_t O_CSC   = O_ROPES + (size_t)SEQ * 16 * 4;
constexpr size_t O_CST256= O_CSC + 256 * 128 * 2;
constexpr size_t O_CST   = O_CST256 + 256 * 512 * 2;
constexpr size_t O_XCUR  = O_CST + (size_t)4096 * 8192 * 2;
constexpr size_t O_WB    = O_XCUR + (size_t)RT * DM * 4;
constexpr size_t W_IN   = 0;
constexpr size_t W_UQ   = W_IN + (size_t)6144 * 1024 * 2;
constexpr size_t W_UKV  = W_UQ + (size_t)768 * 384 * 2;
constexpr size_t W_WUP  = W_UKV + (size_t)1024 * 256 * 2;
constexpr size_t W_AUP  = W_WUP + (size_t)2 * 512 * 64 * 2;
constexpr size_t W_GUP  = W_AUP + (size_t)2 * 512 * 64 * 2;
constexpr size_t W_PA   = W_GUP + (size_t)512 * 128 * 2;
constexpr size_t W_PB   = W_PA + (size_t)1024 * 512 * 2;
constexpr size_t W_PC   = W_PB + (size_t)1024 * 512 * 2;
constexpr size_t W_OUT  = W_PC + (size_t)1024 * 512 * 2;
constexpr size_t W_GU   = W_OUT + (size_t)1024 * 1024 * 2;
constexpr size_t W_D    = W_GU + (size_t)17 * 1024 * 1024 * 2;
constexpr size_t W_END  = W_D + (size_t)17 * 1024 * 512 * 2;
constexpr size_t O_H    = O_WB + W_END;
constexpr size_t O_P    = O_H + (size_t)RT * DM * 2;
constexpr size_t O_ATT  = O_P + (size_t)RT * LDP * 2;
constexpr size_t O_RG   = O_ATT + (size_t)RT * 512 * 2;
constexpr size_t O_RWO  = O_RG + (size_t)RT * 512 * 2;
constexpr size_t O_FA   = O_RWO + (size_t)RT * 512 * 2;
constexpr size_t O_LTOK = O_FA + (size_t)RT * 512 * 2;
constexpr size_t O_LW   = O_LTOK + (size_t)NEXP * RT * 4;
constexpr size_t O_SLOT = O_LW + (size_t)NEXP * RT * 4;
constexpr size_t O_X    = al256(O_SLOT + (size_t)RT * 2 * 4);
constexpr size_t X_QRAW = 0;
constexpr size_t X_KVRAW= X_QRAW + (size_t)RT * 768 * 2;
constexpr size_t X_QA   = X_KVRAW + (size_t)RT * 1024 * 2;
constexpr size_t X_KA   = X_QA + (size_t)RT * 768 * 2;
constexpr size_t X_VA   = X_KA + (size_t)4 * KEYS * 768 * 2;
constexpr size_t X_DEC  = 0;
constexpr size_t X_AA   = X_DEC + (size_t)2 * RT * 512 * 4;
constexpr size_t X_KKN  = X_AA + (size_t)2 * RT * 512 * 2;
constexpr size_t X_YS   = X_KKN + (size_t)RT * 8 * 4;
constexpr size_t X_END  = X_YS + (size_t)2 * RT * 512 * 4;
constexpr size_t X_YT   = 0;
constexpr size_t X_YTC  = X_YT + (size_t)4 * 512 * 8192 * 2;
constexpr size_t X_YE   = 0;
constexpr size_t WS_NEED = O_X + X_END;

__device__ __forceinline__ float bf2f(bf16_t u) { return __builtin_bit_cast(float, (unsigned)u << 16); }
__device__ __forceinline__ float bflo(unsigned u) { return __builtin_bit_cast(float, u << 16); }
__device__ __forceinline__ float bfhi(unsigned u) { return __builtin_bit_cast(float, u & 0xffff0000u); }
__device__ __forceinline__ unsigned pack2(float lo, float hi) { f32x2 v = {lo, hi}; bf16v2 b = __builtin_convertvector(v, bf16v2); return __builtin_bit_cast(unsigned, b); }
__device__ __forceinline__ bf16_t f2bf(float f) { return (bf16_t)(pack2(f, 0.f) & 0xffffu); }
__device__ __forceinline__ float wsum(float v) {
#pragma unroll
    for (int o = 32; o > 0; o >>= 1) v += __shfl_xor(v, o);
    return v;
}
__device__ __forceinline__ float sigmoidf_(float x) { return 1.f / (1.f + __expf(-x)); }
__device__ __forceinline__ float siluf_(float x) { return x / (1.f + __expf(-x)); }
__device__ __forceinline__ int modidx(int row) { return row < RL ? (row >> 12) : 4; }
__device__ __forceinline__ void unpack8(const uint4& u, float (&f)[8]) {
    f[0] = bflo(u.x); f[1] = bfhi(u.x); f[2] = bflo(u.y); f[3] = bfhi(u.y); f[4] = bflo(u.z); f[5] = bfhi(u.z); f[6] = bflo(u.w); f[7] = bfhi(u.w);
}
__device__ __forceinline__ uint4 pack8(const float (&f)[8]) { return make_uint4(pack2(f[0], f[1]), pack2(f[2], f[3]), pack2(f[4], f[5]), pack2(f[6], f[7])); }

#define XB_TMO      128
#define XB_XCNT(j)  (256  + 64 * (j))
#define XB_XSUB(j)  (1280 + 64 * (j))
#define XB_XGEN(j)  (2304 + 64 * (j))
#define XB_TOP      3328
#define XB_TOPGEN   3392
#define XCD_BAR_WORDS 3456
#define XB_SPIN_CAP (1u << 22)
#define LAS __attribute__((address_space(3)))
__device__ __forceinline__ unsigned xb_ld(unsigned* p)              { return __hip_atomic_load(p, __ATOMIC_RELAXED, __HIP_MEMORY_SCOPE_AGENT); }
__device__ __forceinline__ unsigned xb_add(unsigned* p, unsigned v) { return __hip_atomic_fetch_add(p, v, __ATOMIC_RELAXED, __HIP_MEMORY_SCOPE_AGENT); }
__device__ __forceinline__ unsigned xb_xcc_id() { return (unsigned)__builtin_amdgcn_s_getreg((3 << 11) | 20) & 0xFu; }
#define XB_SPIN(cond, bar) do { unsigned _sp = 0; while (cond) { __builtin_amdgcn_s_sleep(1); \
    if ((++_sp & 255u) == 0u) { if (xb_ld(&(bar)[XB_TMO])) break; if (_sp > XB_SPIN_CAP) { atomicAdd(&(bar)[XB_TMO], 1u); break; } } } } while (0)
struct XcdBarrier { unsigned* bar; unsigned x; volatile LAS unsigned* st; };
__device__ __forceinline__ XcdBarrier xcd_barrier_post(unsigned* bar, volatile LAS unsigned* st) {
    XcdBarrier b; b.bar = bar; b.x = xb_xcc_id(); b.st = st;
    if (threadIdx.x == 0) (void)xb_add(&bar[XB_XCNT(b.x)], 1u);
    return b;
}
__device__ __forceinline__ void xcd_barrier_complete(unsigned* bar, unsigned x, unsigned& nloc, unsigned& nx) {
    const unsigned G = gridDim.x * gridDim.y * gridDim.z;
    unsigned sum, cnt, mine, sp = 0u;
    for (;;) {
        sum = 0u; cnt = 0u; mine = 0u;
#pragma unroll
        for (unsigned j = 0; j < 16; ++j) { const unsigned c = xb_ld(&bar[XB_XCNT(j)]); sum += c; cnt += (c > 0u) ? 1u : 0u; mine = (j == x) ? c : mine; }
        if (sum == G) break;
        __builtin_amdgcn_s_sleep(1);
        if ((++sp & 255u) == 0u) { if (xb_ld(&bar[XB_TMO])) break; if (sp > XB_SPIN_CAP) { atomicAdd(&bar[XB_TMO], 1u); break; } }
    }
    nloc = mine > 0u ? mine : 1u; nx = cnt > 0u ? cnt : 1u;
}
__device__ __forceinline__ void xcd_barrier(const XcdBarrier& b) {
    asm volatile("s_waitcnt vmcnt(0)" ::: "memory");
    __syncthreads();
    if (threadIdx.x == 0) {
        unsigned* bar = b.bar;
        __builtin_amdgcn_s_waitcnt(0);
        unsigned nloc = b.st[0], nx = b.st[1];
        if (nloc == 0u) { xcd_barrier_complete(bar, b.x, nloc, nx); b.st[0] = nloc; b.st[1] = nx; }
        const unsigned old = xb_add(&bar[XB_XSUB(b.x)], 1u);
        const unsigned gen = old / nloc;
        if (old + 1u == (gen + 1u) * nloc) {
            __builtin_amdgcn_fence(__ATOMIC_RELEASE, "agent");
            asm volatile("s_waitcnt vmcnt(0)" ::: "memory");
            const unsigned og = xb_add(&bar[XB_TOP], 1u);
            const unsigned tg = og / nx;
            if (og + 1u == (tg + 1u) * nx) xb_add(&bar[XB_TOPGEN], 1u);
            else XB_SPIN(xb_ld(&bar[XB_TOPGEN]) == tg, bar);
            __builtin_amdgcn_fence(__ATOMIC_ACQUIRE, "agent");
            xb_add(&bar[XB_XGEN(b.x)], 1u);
            asm volatile("s_waitcnt vmcnt(0)" ::: "memory");
        } else {
            XB_SPIN(xb_ld(&bar[XB_XGEN(b.x)]) == gen, bar);
            __builtin_amdgcn_fence(__ATOMIC_ACQUIRE, "agent");
            asm volatile("s_waitcnt vmcnt(0)" ::: "memory");
        }
    }
    __syncthreads();
}

__device__ __forceinline__ int tidx() { int t = threadIdx.x; asm volatile("" : "+v"(t)); return t; }
__device__ __forceinline__ char* launder(char* p) { size_t z = 0; asm volatile("" : "+s"(z)); return p + z; }

constexpr int LDSROW = 40;
template <int MI, class AL>
__device__ __forceinline__ void gemm_core(const AL& al, const bf16_t* __restrict__ Bt, int ldb, int K, f32x4 (&acc)[MI][4], char* smem) {
    constexpr int TM = MI * 32;
    constexpr int NA = TM / 64;
    bf16_t* As = (bf16_t*)smem;
    bf16_t* Bs = As + 2 * TM * LDSROW;
    const int tid = tidx(), lane = tid & 63, wave = tid >> 6;
    const int wr = wave >> 1, wc = wave & 1, fr = lane & 15, fq = lane >> 4;
    const int kc = (tid & 3) * 8;
#pragma unroll
    for (int i = 0; i < MI; ++i)
#pragma unroll
        for (int j = 0; j < 4; ++j) acc[i][j] = (f32x4){0.f, 0.f, 0.f, 0.f};
    uint4 ra[NA], rb[2];
    const bf16_t* bp0 = Bt + (size_t)(tid >> 2) * ldb + kc;
    const bf16_t* bp1 = Bt + (size_t)((tid >> 2) + 64) * ldb + kc;
    const int nk = K >> 5;
#pragma unroll
    for (int i = 0; i < NA; ++i) ra[i] = al.load(i, kc);
    rb[0] = *(const uint4*)(bp0); rb[1] = *(const uint4*)(bp1);
#pragma unroll
    for (int i = 0; i < NA; ++i) *(uint4*)(As + ((tid >> 2) + 64 * i) * LDSROW + kc) = ra[i];
    *(uint4*)(Bs + (tid >> 2) * LDSROW + kc) = rb[0];
    *(uint4*)(Bs + ((tid >> 2) + 64) * LDSROW + kc) = rb[1];
    __syncthreads();
    for (int kt = 0; kt < nk; ++kt) {
        const int cur = kt & 1;
        if (kt + 1 < nk) {
            const int k0 = (kt + 1) << 5;
#pragma unroll
            for (int i = 0; i < NA; ++i) ra[i] = al.load(i, k0 + kc);
            rb[0] = *(const uint4*)(bp0 + k0); rb[1] = *(const uint4*)(bp1 + k0);
        }
        const bf16_t* Ac = As + cur * TM * LDSROW + (wr * MI * 16 + fr) * LDSROW + fq * 8;
        const bf16_t* Bc = Bs + cur * 128 * LDSROW + (wc * 64 + fr) * LDSROW + fq * 8;
        bf16x8 af[MI], bfv[4];
#pragma unroll
        for (int i = 0; i < MI; ++i) af[i] = *(const bf16x8*)(Ac + i * 16 * LDSROW);
#pragma unroll
        for (int j = 0; j < 4; ++j) bfv[j] = *(const bf16x8*)(Bc + j * 16 * LDSROW);
#pragma unroll
        for (int i = 0; i < MI; ++i)
#pragma unroll
            for (int j = 0; j < 4; ++j) acc[i][j] = __builtin_amdgcn_mfma_f32_16x16x32_bf16(bfv[j], af[i], acc[i][j], 0, 0, 0);
        if (kt + 1 < nk) {
            const int nxt = cur ^ 1;
#pragma unroll
            for (int i = 0; i < NA; ++i) *(uint4*)(As + nxt * TM * LDSROW + ((tid >> 2) + 64 * i) * LDSROW + kc) = ra[i];
            *(uint4*)(Bs + nxt * 128 * LDSROW + (tid >> 2) * LDSROW + kc) = rb[0];
            *(uint4*)(Bs + nxt * 128 * LDSROW + ((tid >> 2) + 64) * LDSROW + kc) = rb[1];
        }
        __syncthreads();
    }
}
template <int MI, class F>
__device__ __forceinline__ void acc_foreach(const f32x4 (&acc)[MI][4], F f) {
    const int lane = tidx() & 63, wave = tidx() >> 6;
    const int wr = wave >> 1, wc = wave & 1, fr = lane & 15, fq = lane >> 4;
#pragma unroll
    for (int i = 0; i < MI; ++i)
#pragma unroll
        for (int j = 0; j < 4; ++j) f(wr * MI * 16 + i * 16 + fr, wc * 64 + j * 16 + fq * 4, acc[i][j]);
}
struct ALPlain {
    const bf16_t* p[2];
    __device__ __forceinline__ ALPlain(const bf16_t* A, int lda, int row0) {
        const int r = tidx() >> 2;
        p[0] = A + (size_t)(row0 + r) * lda; p[1] = A + (size_t)(row0 + r + 64) * lda;
    }
    __device__ __forceinline__ uint4 load(int i, int k) const { return *(const uint4*)(p[i] + k); }
};
__device__ __forceinline__ void store_bf16x4(bf16_t* dst, const f32x4& v) { *(uint2*)dst = make_uint2(pack2(v[0], v[1]), pack2(v[2], v[3])); }

__device__ __forceinline__ void ph_pre(const Params& p, char* smem) {
    const int tid = tidx(), nb = gridDim.x, bid = blockIdx.x;
    float* mod = (float*)(p.ws + O_MOD);
    {
        float* sv = (float*)smem;
        float* part = sv + 5 * 1024;
        for (int i = tid; i < 5 * 1024; i += 256) { const float v = (i < 4096) ? p.in[I_C][i] : p.in[I_CCTX][i - 4096]; sv[i] = siluf_(v); }
        __syncthreads();
        for (int it = bid; it < NLAYER * 96; it += nb) {
            const int l = it / 96, jb = it % 96;
            const int jj = tid & 63, kq = tid >> 6, j = jb * 64 + jj;
            const float* w = p.in[I_WADA] + (size_t)l * 1024 * 6144 + (size_t)(kq * 256) * 6144 + j;
            float a0 = 0.f, a1 = 0.f, a2 = 0.f, a3 = 0.f, a4 = 0.f;
#pragma unroll 8
            for (int k = 0; k < 256; ++k) {
                const float wv = w[(size_t)k * 6144]; const int kk = kq * 256 + k;
                a0 += sv[kk] * wv; a1 += sv[1024 + kk] * wv; a2 += sv[2048 + kk] * wv; a3 += sv[3072 + kk] * wv; a4 += sv[4096 + kk] * wv;
            }
            part[(kq * 5 + 0) * 64 + jj] = a0; part[(kq * 5 + 1) * 64 + jj] = a1; part[(kq * 5 + 2) * 64 + jj] = a2;
            part[(kq * 5 + 3) * 64 + jj] = a3; part[(kq * 5 + 4) * 64 + jj] = a4;
            __syncthreads();
            for (int o = tid; o < 320; o += 256) {
                const int i = o >> 6, c = o & 63;
                const float s = part[(0 * 5 + i) * 64 + c] + part[(1 * 5 + i) * 64 + c] + part[(2 * 5 + i) * 64 + c] + part[(3 * 5 + i) * 64 + c];
                mod[(size_t)(l * 5 + i) * 6144 + jb * 64 + c] = s + p.in[I_BADA][l * 6144 + jb * 64 + c];
            }
            __syncthreads();
        }
    }
    {
        float4* xc = (float4*)(p.ws + O_XCUR);
        const float4* x4 = (const float4*)p.in[I_X]; const float4* c4 = (const float4*)p.in[I_CTX];
        for (size_t i = (size_t)bid * 256 + tid; i < (size_t)RT * 256; i += (size_t)nb * 256) xc[i] = (i < (size_t)RL * 256) ? x4[i] : c4[i - (size_t)RL * 256];
    }
    {
        float* ct = (float*)smem;
        __syncthreads();
        for (int m = tid; m < 4096; m += 256) ct[m] = cospif((float)m * (1.f / 2048.f));
        __syncthreads();
        bf16_t* cst = (bf16_t*)(p.ws + O_CST);
        for (size_t ch = (size_t)bid * 256 + tid; ch < (size_t)4096 * 8192 / 8; ch += (size_t)nb * 256) {
            const int kt = (int)(ch >> 10), c0 = (int)(ch & 1023) * 8, part = c0 >> 12, t0 = c0 & 4095;
            float f[8];
#pragma unroll
            for (int e = 0; e < 8; ++e) { const int m = (kt * (t0 + e)) & 4095; f[e] = part == 0 ? ct[m] : -ct[(m - 1024) & 4095]; }
            *(uint4*)(cst + ch * 8) = pack8(f);
        }
        bf16_t* cst2 = (bf16_t*)(p.ws + O_CST256);
        for (int ch = bid * 256 + tid; ch < 256 * 512 / 8; ch += nb * 256) {
            const int ks = ch >> 6, c0 = (ch & 63) * 8, part = c0 >> 8, s0 = c0 & 255;
            float f[8];
#pragma unroll
            for (int e = 0; e < 8; ++e) { const int m = (16 * ks * (s0 + e)) & 4095; f[e] = part == 0 ? ct[m] : -ct[(m - 1024) & 4095]; }
            *(uint4*)(cst2 + ch * 8) = pack8(f);
        }
        bf16_t* csc = (bf16_t*)(p.ws + O_CSC);
        for (int ch = bid * 256 + tid; ch < 256 * 128 / 8; ch += nb * 256) {
            const int n = ch >> 4, c0 = (ch & 15) * 8, part = n >> 7, kc = n & 127;
            float f[8];
#pragma unroll
            for (int e = 0; e < 8; ++e) { const int m = (32 * kc * (c0 + e)) & 4095; f[e] = part == 0 ? ct[m] : ct[(m - 1024) & 4095]; }
            *(uint4*)(csc + ch * 8) = pack8(f);
        }
        float* rc = (float*)(p.ws + O_ROPEC); float* rs = (float*)(p.ws + O_ROPES);
        for (int i = bid * 256 + tid; i < SEQ * 16; i += nb * 256) {
            const int t = i >> 4, ax = (i >> 3) & 1, f = i & 7;
            const float inv = powf(10000.f, -(float)f / 8.f);
            const float pos = (float)(ax == 0 ? (t >> 6) : (t & 63));
            const float ang = pos * inv;
            rc[i] = cosf(ang); rs[i] = sinf(ang);
        }
    }
}

struct ConvTask { const float* src; const float* scale; bf16_t* dst; int K, Nsrc, Ndst; size_t sbs, dbs; };
__constant__ int c_conv_cum[17] = {0, 1536, 1608, 1672, 1688, 1704, 1720, 1848, 1976, 2104, 2360, 4408, 6456, 8504, 8632, 8760, 8888};
__device__ __forceinline__ ConvTask conv_task(const Params& p, int l, int t) {
    bf16_t* wb = (bf16_t*)(p.ws + O_WB);
    ConvTask c; c.scale = nullptr; c.sbs = 0; c.dbs = 0;
    switch (t) {
    case 0:  c.src = p.in[I_WIN] + (size_t)l * 1024 * 6048; c.K = 1024; c.Nsrc = 6048; c.Ndst = 6144; c.dst = wb + W_IN / 2; break;
    case 1:  c.src = p.in[I_WUQ] + (size_t)l * 384 * 768; c.K = 384; c.Nsrc = 768; c.Ndst = 768; c.dst = wb + W_UQ / 2; c.scale = p.in[I_QNG] + l * 384; break;
    case 2:  c.src = p.in[I_WUKV] + (size_t)l * 256 * 1024; c.K = 256; c.Nsrc = 1024; c.Ndst = 1024; c.dst = wb + W_UKV / 2; c.scale = p.in[I_KVNG] + l * 256; break;
    case 3:  c.src = p.in[I_WUP] + (size_t)l * 2 * 64 * 512; c.K = 64; c.Nsrc = 512; c.Ndst = 512; c.dst = wb + W_WUP / 2; c.sbs = 64 * 512; c.dbs = 512 * 64; break;
    case 4:  c.src = p.in[I_AUP] + (size_t)l * 2 * 64 * 512; c.K = 64; c.Nsrc = 512; c.Ndst = 512; c.dst = wb + W_AUP / 2; c.sbs = 64 * 512; c.dbs = 512 * 64; break;
    case 5:  c.src = p.in[I_GUP] + (size_t)l * 128 * 512; c.K = 128; c.Nsrc = 512; c.Ndst = 512; c.dst = wb + W_GUP / 2; break;
    case 6:  c.src = p.in[I_WPA] + (size_t)l * 512 * 1024; c.K = 512; c.Nsrc = 1024; c.Ndst = 1024; c.dst = wb + W_PA / 2; break;
    case 7:  c.src = p.in[I_WPB] + (size_t)l * 512 * 1024; c.K = 512; c.Nsrc = 1024; c.Ndst = 1024; c.dst = wb + W_PB / 2; break;
    case 8:  c.src = p.in[I_WPC] + (size_t)l * 512 * 1024; c.K = 512; c.Nsrc = 1024; c.Ndst = 1024; c.dst = wb + W_PC / 2; break;
    case 9:  c.src = p.in[I_WOUT] + (size_t)l * 1024 * 1024; c.K = 1024; c.Nsrc = 1024; c.Ndst = 1024; c.dst = wb + W_OUT / 2; break;
    case 10: c.src = p.in[I_EG] + (size_t)l * 16 * 1024 * 512; c.K = 1024; c.Nsrc = 512; c.Ndst = 512; c.dst = wb + W_GU / 2; c.sbs = 1024 * 512; c.dbs = 1024 * 1024; break;
    case 11: c.src = p.in[I_EU] + (size_t)l * 16 * 1024 * 512; c.K = 1024; c.Nsrc = 512; c.Ndst = 512; c.dst = wb + W_GU / 2 + 512 * 1024; c.sbs = 1024 * 512; c.dbs = 1024 * 1024; break;
    case 12: c.src = p.in[I_ED] + (size_t)l * 16 * 512 * 1024; c.K = 512; c.Nsrc = 1024; c.Ndst = 1024; c.dst = wb + W_D / 2; c.sbs = 512 * 1024; c.dbs = 1024 * 512; break;
    case 13: c.src = p.in[I_SG] + (size_t)l * 1024 * 512; c.K = 1024; c.Nsrc = 512; c.Ndst = 512; c.dst = wb + W_GU / 2 + (size_t)16 * 1024 * 1024; break;
    case 14: c.src = p.in[I_SU] + (size_t)l * 1024 * 512; c.K = 1024; c.Nsrc = 512; c.Ndst = 512; c.dst = wb + W_GU / 2 + (size_t)16 * 1024 * 1024 + 512 * 1024; break;
    default: c.src = p.in[I_SD] + (size_t)l * 512 * 1024; c.K = 512; c.Nsrc = 1024; c.Ndst = 1024; c.dst = wb + W_D / 2 + (size_t)16 * 1024 * 512; break;
    }
    return c;
}
__device__ __forceinline__ void ph_w(const Params& p, int l, char* smem) {
    const int tid = tidx();
    float* tl = (float*)smem;
    for (int g = blockIdx.x; g < 8888; g += gridDim.x) {
        int t = 0;
        while (g >= c_conv_cum[t + 1]) ++t;
        const ConvTask c = conv_task(p, l, t);
        int r = g - c_conv_cum[t];
        const int nkt = c.K >> 6, nnt = c.Ndst >> 6;
        const int bi = r / (nkt * nnt); r -= bi * nkt * nnt;
        const int k0 = (r / nnt) * 64, n0 = (r % nnt) * 64;
        const float* src = c.src + bi * c.sbs; bf16_t* dst = c.dst + bi * c.dbs;
#pragma unroll
        for (int i = 0; i < 4; ++i) {
            const int k = (tid >> 4) + 16 * i, n = n0 + (tid & 15) * 4;
            float4 v = make_float4(0.f, 0.f, 0.f, 0.f);
            if (n < c.Nsrc) v = *(const float4*)(src + (size_t)(k0 + k) * c.Nsrc + n);
            if (c.scale) { const float s = c.scale[k0 + k]; v.x *= s; v.y *= s; v.z *= s; v.w *= s; }
            float* d = tl + k * 65 + (tid & 15) * 4;
            d[0] = v.x; d[1] = v.y; d[2] = v.z; d[3] = v.w;
        }
        __syncthreads();
        {
            const int n = tid >> 2, kk0 = (tid & 3) * 16;
            float f[8], g2[8];
#pragma unroll
            for (int j = 0; j < 8; ++j) { f[j] = tl[(kk0 + j) * 65 + n]; g2[j] = tl[(kk0 + 8 + j) * 65 + n]; }
            bf16_t* d = dst + (size_t)(n0 + n) * c.K + k0 + kk0;
            *(uint4*)d = pack8(f); *(uint4*)(d + 8) = pack8(g2);
        }
        __syncthreads();
    }
}

__device__ __forceinline__ void ph_n1(const Params& p, int l) {
    const int lane = tidx() & 63, wave = tidx() >> 6;
    const float* xcur = (const float*)(p.ws + O_XCUR); const float* mod = (const float*)(p.ws + O_MOD);
    bf16_t* H = (bf16_t*)(p.ws + O_H);
    if (blockIdx.x == 0 && tidx() < 64) ((unsigned*)(p.ws + O_CNT))[tidx()] = 0u;
    const float* g = p.in[I_N1G] + l * 1024;
    for (int row = blockIdx.x * 4 + wave; row < RT; row += gridDim.x * 4) {
        const float* x = xcur + (size_t)row * 1024; const float* md = mod + (size_t)(l * 5 + modidx(row)) * 6144;
        float4 v[4]; float ss = 0.f;
#pragma unroll
        for (int i = 0; i < 4; ++i) { v[i] = *(const float4*)(x + lane * 4 + 256 * i); ss += v[i].x * v[i].x + v[i].y * v[i].y + v[i].z * v[i].z + v[i].w * v[i].w; }
        ss = wsum(ss);
        const float rstd = rsqrtf(ss * (1.f / 1024.f) + 1e-6f);
#pragma unroll
        for (int i = 0; i < 4; ++i) {
            const int c = lane * 4 + 256 * i;
            const float4 gg = *(const float4*)(g + c), sc = *(const float4*)(md + 1024 + c), sh = *(const float4*)(md + c);
            f32x4 h = {v[i].x * rstd * gg.x * (1.f + sc.x) + sh.x, v[i].y * rstd * gg.y * (1.f + sc.y) + sh.y,
                       v[i].z * rstd * gg.z * (1.f + sc.z) + sh.z, v[i].w * rstd * gg.w * (1.f + sc.w) + sh.w};
            store_bf16x4(H + (size_t)row * 1024 + c, h);
        }
    }
}

__device__ __forceinline__ void ph_g1(const Params& p, char* smem) {
    const bf16_t* H = (const bf16_t*)(p.ws + O_H); const bf16_t* W = (const bf16_t*)(p.ws + O_WB + W_IN);
    bf16_t* P = (bf16_t*)(p.ws + O_P);
    for (int it = blockIdx.x; it < 136 * 48; it += gridDim.x) {
        const int mt = it / 48, nt = it % 48;
        f32x4 acc[4][4];
        ALPlain al(H, 1024, mt * 128);
        gemm_core<4>(al, W + (size_t)nt * 128 * 1024, 1024, 1024, acc, smem);
        acc_foreach<4>(acc, [&](int m, int n, const f32x4& v) {
            const int col = nt * 128 + n; f32x4 o = v;
            if (col >= PG0 && col < PEND) { o[0] = sigmoidf_(v[0]); o[1] = sigmoidf_(v[1]); o[2] = sigmoidf_(v[2]); o[3] = sigmoidf_(v[3]); }
            store_bf16x4(P + (size_t)(mt * 128 + m) * LDP + col, o);
        });
    }
}

__device__ __forceinline__ void ph_qu(const Params& p, char* smem) {
    const bf16_t* P = (const bf16_t*)(p.ws + O_P);
    bf16_t* QR = (bf16_t*)(p.ws + O_X + X_QRAW); bf16_t* KVR = (bf16_t*)(p.ws + O_X + X_KVRAW);
    for (int it = blockIdx.x; it < 136 * 14; it += gridDim.x) {
        const int mt = it / 14, nn = it % 14;
        f32x4 acc[4][4];
        if (nn < 6) {
            ALPlain al(P + PQ0, LDP, mt * 128);
            gemm_core<4>(al, (const bf16_t*)(p.ws + O_WB + W_UQ) + (size_t)nn * 128 * 384, 384, 384, acc, smem);
            acc_foreach<4>(acc, [&](int m, int n, const f32x4& v) { store_bf16x4(QR + (size_t)(mt * 128 + m) * 768 + nn * 128 + n, v); });
        } else {
            const int nt = nn - 6;
            ALPlain al(P + PKV0, LDP, mt * 128);
            gemm_core<4>(al, (const bf16_t*)(p.ws + O_WB + W_UKV) + (size_t)nt * 128 * 256, 256, 256, acc, smem);
            acc_foreach<4>(acc, [&](int m, int n, const f32x4& v) { store_bf16x4(KVR + (size_t)(mt * 128 + m) * 1024 + nt * 128 + n, v); });
        }
    }
}

constexpr float QSCALE = 0.10206207261596575f * 1.4426950408889634f;
__device__ __forceinline__ void ph_m2(const Params& p) {
    const int lane = tidx() & 63, wave = tidx() >> 6;
    const bf16_t* P = (const bf16_t*)(p.ws + O_P);
    const bf16_t* QR = (const bf16_t*)(p.ws + O_X + X_QRAW); const bf16_t* KVR = (const bf16_t*)(p.ws + O_X + X_KVRAW);
    bf16_t* QA = (bf16_t*)(p.ws + O_X + X_QA); bf16_t* KA = (bf16_t*)(p.ws + O_X + X_KA); bf16_t* VA = (bf16_t*)(p.ws + O_X + X_VA);
    const float* rc = (const float*)(p.ws + O_ROPEC); const float* rs = (const float*)(p.ws + O_ROPES);
    for (int row = blockIdx.x * 4 + wave; row < RT; row += gridDim.x * 4) {
        const bool lat = row < RL;
        const int b = lat ? (row >> 12) : ((row - RL) >> 8), t = lat ? (row & 4095) : ((row - RL) & 255);
        const size_t keyrow = (size_t)b * KEYS + (lat ? t : SEQ + t);
        const bf16_t* pr = P + (size_t)row * LDP;
        float sq = 0.f, sk = 0.f;
#pragma unroll
        for (int i = 0; i < 6; ++i) { const float v = bf2f(pr[PQ0 + lane + 64 * i]); sq += v * v; }
#pragma unroll
        for (int i = 0; i < 4; ++i) { const float v = bf2f(pr[PKV0 + lane + 64 * i]); sk += v * v; }
        sq = wsum(sq); sk = wsum(sk);
        const float rq = rsqrtf(sq * (1.f / 384.f) + 1e-6f), rkv = rsqrtf(sk * (1.f / 256.f) + 1e-6f);
        const bf16_t* qr = QR + (size_t)row * 768; const bf16_t* kvr = KVR + (size_t)row * 1024;
        const float* rct = rc + t * 16; const float* rst = rs + t * 16;
#pragma unroll
        for (int i = 0; i < 12; ++i) {
            const int e = lane + 64 * i, h = e / 96, dd = e - h * 96;
            float xq = bf2f(qr[e]) * rq, xk;
            if (dd < 64) xk = bf2f(kvr[h * 128 + dd]) * rkv;
            else {
                const int ii = dd - 64;
                xk = bf2f(pr[PKR0 + ii]);
                if (lat) {
                    const int ax = ii >> 4, half = (ii >> 3) & 1, f = ii & 7;
                    const float c = rct[ax * 8 + f], s = rst[ax * 8 + f];
                    const float xqp = bf2f(qr[half ? e - 8 : e + 8]) * rq, xkp = bf2f(pr[PKR0 + (ii ^ 8)]);
                    xq = half ? (xq * c + xqp * s) : (xq * c - xqp * s);
                    xk = half ? (xk * c + xkp * s) : (xk * c - xkp * s);
                }
            }
            QA[(size_t)row * 768 + e] = f2bf(xq * QSCALE);
            KA[keyrow * 768 + e] = f2bf(xk);
        }
#pragma unroll
        for (int i = 0; i < 8; ++i) {
            const int e = lane + 64 * i, h = e >> 6, dd = e & 63;
            VA[keyrow * 512 + e] = f2bf(bf2f(kvr[h * 128 + 64 + dd]) * rkv);
        }
    }
}

constexpr int KS_LD = 104, VT_LD = 72;
constexpr int AT_BUF = 64 * KS_LD * 2 + 64 * VT_LD * 2;
__device__ __forceinline__ void ph_at(const Params& p, int l, char* smem) {
    const int tid = tidx(), lane = tid & 63, wave = tid >> 6, fr = lane & 15, fq = lane >> 4;
    const bf16_t* QA = (const bf16_t*)(p.ws + O_X + X_QA); const bf16_t* KA = (const bf16_t*)(p.ws + O_X + X_KA); const bf16_t* VA = (const bf16_t*)(p.ws + O_X + X_VA);
    bf16_t* ATT = (bf16_t*)(p.ws + O_ATT);
    const int nitems = 2048 + (l < NLAYER - 1 ? 128 : 0);
    for (int it = blockIdx.x; it < nitems; it += gridDim.x) {
        int b, h, row0, ntile; size_t krow0;
        if (it < 2048) { b = it >> 9; h = (it >> 6) & 7; row0 = b * SEQ + (it & 63) * 64; krow0 = (size_t)b * KEYS; ntile = KEYS / 64; }
        else { const int j = it - 2048; b = j >> 5; h = (j >> 2) & 7; row0 = RL + b * CTX + (j & 3) * 64; krow0 = (size_t)b * KEYS + SEQ; ntile = CTX / 64; }
        const int qrow = row0 + wave * 16 + fr;
        bf16x8 qf[3];
#pragma unroll
        for (int ks = 0; ks < 3; ++ks) qf[ks] = *(const bf16x8*)(QA + (size_t)qrow * 768 + h * 96 + ks * 32 + fq * 8);
        f32x4 ot[4];
#pragma unroll
        for (int i = 0; i < 4; ++i) ot[i] = (f32x4){0.f, 0.f, 0.f, 0.f};
        float m_run = -1e30f, l_run = 0.f;
        uint4 rk0, rk1, rk2, rv0, rv1;
#define AT_GLOAD(KT) do { const size_t kr_ = krow0 + (size_t)(KT) * 64; \
            { const int c = tid, key = c / 12, part = c % 12; rk0 = *(const uint4*)(KA + (kr_ + key) * 768 + h * 96 + part * 8); } \
            { const int c = tid + 256, key = c / 12, part = c % 12; rk1 = *(const uint4*)(KA + (kr_ + key) * 768 + h * 96 + part * 8); } \
            { const int c = tid + 512, key = c / 12, part = c % 12; rk2 = *(const uint4*)(KA + (kr_ + key) * 768 + h * 96 + part * 8); } \
            { const int c = tid, key = c >> 3, part = c & 7; rv0 = *(const uint4*)(VA + (kr_ + key) * 512 + h * 64 + part * 8); } \
            { const int c = tid + 256, key = c >> 3, part = c & 7; rv1 = *(const uint4*)(VA + (kr_ + key) * 512 + h * 64 + part * 8); } } while (0)
#define AT_VSTORE(RV, C) do { const int key = (C) >> 3, part = (C) & 7; bf16_t* vd_ = Vt_ + (part * 8) * VT_LD + key; \
            vd_[0 * VT_LD] = (bf16_t)(RV.x & 0xffffu); vd_[1 * VT_LD] = (bf16_t)(RV.x >> 16); vd_[2 * VT_LD] = (bf16_t)(RV.y & 0xffffu); vd_[3 * VT_LD] = (bf16_t)(RV.y >> 16); \
            vd_[4 * VT_LD] = (bf16_t)(RV.z & 0xffffu); vd_[5 * VT_LD] = (bf16_t)(RV.z >> 16); vd_[6 * VT_LD] = (bf16_t)(RV.w & 0xffffu); vd_[7 * VT_LD] = (bf16_t)(RV.w >> 16); } while (0)
#define AT_SSTORE(BUF) do { bf16_t* Ks_ = (bf16_t*)(smem + (BUF) * AT_BUF); bf16_t* Vt_ = Ks_ + 64 * KS_LD; \
            { const int c = tid, key = c / 12, part = c % 12; *(uint4*)(Ks_ + key * KS_LD + part * 8) = rk0; } \
            { const int c = tid + 256, key = c / 12, part = c % 12; *(uint4*)(Ks_ + key * KS_LD + part * 8) = rk1; } \
            { const int c = tid + 512, key = c / 12, part = c % 12; *(uint4*)(Ks_ + key * KS_LD + part * 8) = rk2; } \
            AT_VSTORE(rv0, tid); AT_VSTORE(rv1, tid + 256); } while (0)
        AT_GLOAD(0); AT_SSTORE(0);
        __syncthreads();
        for (int kt = 0; kt < ntile; ++kt) {
            const int cur = kt & 1;
            if (kt + 1 < ntile) AT_GLOAD(kt + 1);
            const bf16_t* Ks = (const bf16_t*)(smem + cur * AT_BUF); const bf16_t* Vt = Ks + 64 * KS_LD;
            f32x4 st[4];
#pragma unroll
            for (int j = 0; j < 4; ++j) {
                st[j] = (f32x4){0.f, 0.f, 0.f, 0.f};
#pragma unroll
                for (int ks = 0; ks < 3; ++ks) {
                    const bf16x8 kf = *(const bf16x8*)(Ks + (j * 16 + fr) * KS_LD + ks * 32 + fq * 8);
                    st[j] = __builtin_amdgcn_mfma_f32_16x16x32_bf16(kf, qf[ks], st[j], 0, 0, 0);
                }
            }
            float mx = st[0][0];
#pragma unroll
            for (int j = 0; j < 4; ++j)
#pragma unroll
                for (int r = 0; r < 4; ++r) mx = fmaxf(mx, st[j][r]);
            mx = fmaxf(mx, __shfl_xor(mx, 16)); mx = fmaxf(mx, __shfl_xor(mx, 32));
            const float m_new = fmaxf(m_run, mx);
            const float alpha = exp2f(m_run - m_new);
            m_run = m_new;
            float ps = 0.f;
#pragma unroll
            for (int j = 0; j < 4; ++j)
#pragma unroll
                for (int r = 0; r < 4; ++r) { st[j][r] = exp2f(st[j][r] - m_new); ps += st[j][r]; }
            l_run = l_run * alpha + ps;
#pragma unroll
            for (int i = 0; i < 4; ++i) ot[i] *= alpha;
#pragma unroll
            for (int k2 = 0; k2 < 2; ++k2) {
                const uint4 pu = make_uint4(pack2(st[2 * k2][0], st[2 * k2][1]), pack2(st[2 * k2][2], st[2 * k2][3]),
                                            pack2(st[2 * k2 + 1][0], st[2 * k2 + 1][1]), pack2(st[2 * k2 + 1][2], st[2 * k2 + 1][3]));
                const bf16x8 pb = __builtin_bit_cast(bf16x8, pu);
#pragma unroll
                for (int dt = 0; dt < 4; ++dt) {
                    const bf16_t* vp = Vt + (dt * 16 + fr) * VT_LD + k2 * 32 + fq * 4;
                    const uint2 v0 = *(const uint2*)vp, v1 = *(const uint2*)(vp + 16);
                    const bf16x8 vf = __builtin_bit_cast(bf16x8, make_uint4(v0.x, v0.y, v1.x, v1.y));
                    ot[dt] = __builtin_amdgcn_mfma_f32_16x16x32_bf16(vf, pb, ot[dt], 0, 0, 0);
                }
            }
            if (kt + 1 < ntile) AT_SSTORE(cur ^ 1);
            __syncthreads();
        }
        float lt = l_run; lt += __shfl_xor(lt, 16); lt += __shfl_xor(lt, 32);
        const float inv = 1.f / lt;
#pragma unroll
        for (int dt = 0; dt < 4; ++dt) { f32x4 o = ot[dt] * inv; store_bf16x4(ATT + (size_t)qrow * 512 + h * 64 + dt * 16 + fq * 4, o); }
    }
}

__device__ __forceinline__ void row_edges(int row, bool& first, bool& last) {
    if (row < RL) { const int t = row & 4095; first = t == 0; last = t == 4095; }
    else { const int s = (row - RL) & 255; first = s == 0; last = s == 255; }
}
__device__ __forceinline__ float xs1(const bf16_t* P, const float* mu, int row, int col) {
    bool first, last; row_edges(row, first, last);
    const bf16_t* pc = P + (size_t)row * LDP + PR0 + col;
    const float c = bf2f(*pc), pv = first ? 0.f : bf2f(*(pc - LDP)), nx = last ? 0.f : bf2f(*(pc + LDP));
    return c + (0.5f * (pv + nx) - c) * mu[col];
}
__device__ __forceinline__ void xs8(const bf16_t* P, const float* mu, int row, int col, float (&o)[8]) {
    bool first, last; row_edges(row, first, last);
    const bf16_t* pc = P + (size_t)row * LDP + PR0 + col;
    const uint4 z = make_uint4(0u, 0u, 0u, 0u);
    const uint4 uc = *(const uint4*)pc, up = first ? z : *(const uint4*)(pc - LDP), un = last ? z : *(const uint4*)(pc + LDP);
    float c[8], pv[8], nx[8]; unpack8(uc, c); unpack8(up, pv); unpack8(un, nx);
    const float4 m0 = *(const float4*)(mu + col), m1 = *(const float4*)(mu + col + 4);
    const float m[8] = {m0.x, m0.y, m0.z, m0.w, m1.x, m1.y, m1.z, m1.w};
#pragma unroll
    for (int j = 0; j < 8; ++j) o[j] = c[j] + (0.5f * (pv[j] + nx[j]) - c[j]) * m[j];
}
struct ALRw {
    const bf16_t* P; const float* mu; int row[2]; int colbase, mode;
    __device__ __forceinline__ ALRw(const bf16_t* P_, const float* mu_, int row0, int colbase_, int mode_) : P(P_), mu(mu_), colbase(colbase_), mode(mode_) {
        row[0] = row0 + (tidx() >> 2); row[1] = row[0] + 64;
    }
    __device__ __forceinline__ uint4 load(int i, int k) const {
        float o[8]; xs8(P, mu, row[i], colbase + k, o);
        if (mode == 0) {
#pragma unroll
            for (int j = 0; j < 8; ++j) o[j] = tanhf(o[j]);
        } else if (mode == 2) {
#pragma unroll
            for (int j = 0; j < 8; ++j) o[j] = sigmoidf_(o[j]);
        }
        return pack8(o);
    }
};
__device__ __forceinline__ void ph_rp1(const Params& p, int l, char* smem) {
    const bf16_t* P = (const bf16_t*)(p.ws + O_P); const float* mu = p.in[I_MU] + l * 1792;
    float* DEC = (float*)(p.ws + O_X + X_DEC); bf16_t* AA = (bf16_t*)(p.ws + O_X + X_AA); bf16_t* RG = (bf16_t*)(p.ws + O_RG);
    for (int it = blockIdx.x; it < 5 * 544; it += gridDim.x) {
        const int sub = it / 544, rem = it % 544, mt = rem >> 2, nt = rem & 3;
        f32x4 acc[4][4];
        if (sub < 2) {
            const int d = sub;
            ALRw al(P, mu, mt * 128, 1536, 0);
            gemm_core<4>(al, (const bf16_t*)(p.ws + O_WB + W_WUP) + (size_t)d * 512 * 64 + (size_t)nt * 128 * 64, 64, 64, acc, smem);
            const float* w0 = p.in[I_W0] + (l * 2 + d) * 512;
            acc_foreach<4>(acc, [&](int m, int n, const f32x4& v) {
                const int col = nt * 128 + n; const float4 wz = *(const float4*)(w0 + col);
                const float z[4] = {wz.x + v[0], wz.y + v[1], wz.z + v[2], wz.w + v[3]};
                float4 o; float* op = (float*)&o;
#pragma unroll
                for (int j = 0; j < 4; ++j) {
                    const float sp = fmaxf(-z[j], 0.f) + log1pf(expf(-fabsf(z[j])));
                    op[j] = expf(-expf(-sp - 0.5f));
                }
                *(float4*)(DEC + ((size_t)d * RT + mt * 128 + m) * 512 + col) = o;
            });
        } else if (sub < 4) {
            const int d = sub - 2;
            ALRw al(P, mu, mt * 128, 1600, 1);
            gemm_core<4>(al, (const bf16_t*)(p.ws + O_WB + W_AUP) + (size_t)d * 512 * 64 + (size_t)nt * 128 * 64, 64, 64, acc, smem);
            const float* a0 = p.in[I_A0] + (l * 2 + d) * 512;
            acc_foreach<4>(acc, [&](int m, int n, const f32x4& v) {
                const int col = nt * 128 + n; const float4 az = *(const float4*)(a0 + col);
                f32x4 o = {sigmoidf_(az.x + v[0]), sigmoidf_(az.y + v[1]), sigmoidf_(az.z + v[2]), sigmoidf_(az.w + v[3])};
                store_bf16x4(AA + ((size_t)d * RT + mt * 128 + m) * 512 + col, o);
            });
        } else {
            ALRw al(P, mu, mt * 128, 1664, 2);
            gemm_core<4>(al, (const bf16_t*)(p.ws + O_WB + W_GUP) + (size_t)nt * 128 * 128, 128, 128, acc, smem);
            acc_foreach<4>(acc, [&](int m, int n, const f32x4& v) { store_bf16x4(RG + (size_t)(mt * 128 + m) * 512 + nt * 128 + n, v); });
        }
    }
}
__device__ __forceinline__ void ph_rp2(const Params& p, int l) {
    const int lane = tidx() & 63, wave = tidx() >> 6;
    const bf16_t* P = (const bf16_t*)(p.ws + O_P); const float* mu = p.in[I_MU] + l * 1792; const float* kkw = p.in[I_KK] + l * 512;
    float* KKN = (float*)(p.ws + O_X + X_KKN);
    for (int row = blockIdx.x * 4 + wave; row < RT; row += gridDim.x * 4) {
        float k8[8]; xs8(P, mu, row, 512 + lane * 8, k8);
        float s = 0.f;
#pragma unroll
        for (int j = 0; j < 8; ++j) { const float v = k8[j] * kkw[lane * 8 + j]; s += v * v; }
        s += __shfl_xor(s, 1); s += __shfl_xor(s, 2); s += __shfl_xor(s, 4);
        if ((lane & 7) == 0) KKN[(size_t)row * 8 + (lane >> 3)] = rsqrtf(s + 1e-12f);
    }
}

__device__ __forceinline__ int scan_row(int b, int d, int n) {
    if (n < CTX) return RL + b * CTX + (d == 0 ? n : CTX - 1 - n);
    const int t = n - CTX; return b * SEQ + (d == 0 ? t : SEQ - 1 - t);
}
constexpr int SC_STEPS = 16;
__device__ __forceinline__ float4 lds_ld4(const float* p) { return *(const float4*)p; }
__device__ __forceinline__ void ph_sc(const Params& p, int l, char* smem) {
    const int tid = tidx(), lane = tid & 63, wave = tid >> 6;
    const bf16_t* P = (const bf16_t*)(p.ws + O_P); const float* mu = p.in[I_MU] + l * 1792;
    const float* kkw = p.in[I_KK] + l * 512; const float* kaw = p.in[I_KA] + l * 512;
    const float* DEC = (const float*)(p.ws + O_X + X_DEC); const bf16_t* AA = (const bf16_t*)(p.ws + O_X + X_AA); const float* KKN = (const float*)(p.ws + O_X + X_KKN);
    float* YS = (float*)(p.ws + O_X + X_YS);
    float* buf = (float*)smem;
    for (int it = blockIdx.x; it < 64; it += gridDim.x) {
        const int b = it >> 4, h = (it >> 1) & 7, d = it & 1;
        auto stage = [&](int c, int bi) {
            float* dst = buf + bi * SC_STEPS * 384;
            for (int q = tid - 64; q < SC_STEPS * 64; q += 192) {
                const int s = q >> 6, k = q & 63, col = h * 64 + k;
                const int row = scan_row(b, d, c * SC_STEPS + s);
                const float xr = xs1(P, mu, row, col), xk = xs1(P, mu, row, 512 + col), xv = xs1(P, mu, row, 1024 + col);
                const float asg = bf2f(AA[((size_t)d * RT + row) * 512 + col]), dec = DEC[((size_t)d * RT + row) * 512 + col];
                const float kk = xk * kkw[col] * KKN[(size_t)row * 8 + h];
                float* o = dst + s * 384 + k;
                o[0] = -kk; o[64] = dec; o[128] = kk * asg; o[192] = xk * (1.f + (asg - 1.f) * kaw[col]); o[256] = xr; o[320] = xv;
            }
        };
        constexpr int NCH = (CTX + SEQ) / SC_STEPS;
        const int wave_u = __builtin_amdgcn_readfirstlane(tid >> 6);
        if (wave_u != 0) {
            stage(0, 0);
            __syncthreads();
            for (int c = 0; c < NCH; ++c) {
                if (c + 1 < NCH) stage(c + 1, (c + 1) & 1);
                __syncthreads();
            }
        } else {
            float st[64];
#pragma unroll
            for (int k = 0; k < 64; ++k) st[k] = 0.f;
            __syncthreads();
            for (int c = 0; c < NCH; ++c) {
                const float* src = buf + (c & 1) * SC_STEPS * 384;
#pragma unroll 1
                for (int s = 0; s < SC_STEPS; ++s) {
                    const float* sp = src + s * 384;
                    const float vv = sp[320 + lane];
                    float sa = 0.f;
#pragma unroll
                    for (int k4 = 0; k4 < 16; ++k4) {
                        const float4 a4 = lds_ld4(sp + k4 * 4);
                        sa += st[k4 * 4] * a4.x; sa += st[k4 * 4 + 1] * a4.y; sa += st[k4 * 4 + 2] * a4.z; sa += st[k4 * 4 + 3] * a4.w;
                        if ((k4 & 3) == 3) asm volatile("" : "+v"(sa));
                    }
                    float y = 0.f;
#pragma unroll
                    for (int k4 = 0; k4 < 16; ++k4) {
                        const float4 w4 = lds_ld4(sp + 64 + k4 * 4), b4 = lds_ld4(sp + 128 + k4 * 4);
                        const float4 k4v = lds_ld4(sp + 192 + k4 * 4), r4 = lds_ld4(sp + 256 + k4 * 4);
                        st[k4 * 4]     = st[k4 * 4] * w4.x     + (sa * b4.x + vv * k4v.x); y += st[k4 * 4] * r4.x;
                        st[k4 * 4 + 1] = st[k4 * 4 + 1] * w4.y + (sa * b4.y + vv * k4v.y); y += st[k4 * 4 + 1] * r4.y;
                        st[k4 * 4 + 2] = st[k4 * 4 + 2] * w4.z + (sa * b4.z + vv * k4v.z); y += st[k4 * 4 + 2] * r4.z;
                        st[k4 * 4 + 3] = st[k4 * 4 + 3] * w4.w + (sa * b4.w + vv * k4v.w); y += st[k4 * 4 + 3] * r4.w;
                        if ((k4 & 1) == 1) asm volatile("" : "+v"(y));
                    }
                    const int row = scan_row(b, d, c * SC_STEPS + s);
                    YS[((size_t)d * RT + row) * 512 + h * 64 + lane] = y;
                }
                __syncthreads();
            }
        }
    }
}

__device__ __forceinline__ void ph_rpost(const Params& p, int l) {
    const int lane = tidx() & 63, wave = tidx() >> 6;
    const bf16_t* P = (const bf16_t*)(p.ws + O_P); const float* mu = p.in[I_MU] + l * 1792;
    const float* kaw = p.in[I_KA] + l * 512; const float* rkw = p.in[I_RK] + l * 512;
    const float* gng = p.in[I_GNG] + l * 512; const float* gnb = p.in[I_GNB] + l * 512;
    const bf16_t* AA = (const bf16_t*)(p.ws + O_X + X_AA); const float* YS = (const float*)(p.ws + O_X + X_YS);
    const bf16_t* RG = (const bf16_t*)(p.ws + O_RG); bf16_t* RWO = (bf16_t*)(p.ws + O_RWO);
    for (int row = blockIdx.x * 4 + wave; row < RT; row += gridDim.x * 4) {
        const int col = lane * 8;
        float r8[8], k8[8], v8[8], a0[8], a1[8], g8[8];
        xs8(P, mu, row, col, r8); xs8(P, mu, row, 512 + col, k8); xs8(P, mu, row, 1024 + col, v8);
        unpack8(*(const uint4*)(AA + ((size_t)0 * RT + row) * 512 + col), a0);
        unpack8(*(const uint4*)(AA + ((size_t)1 * RT + row) * 512 + col), a1);
        unpack8(*(const uint4*)(RG + (size_t)row * 512 + col), g8);
        const float* y0p = YS + ((size_t)0 * RT + row) * 512 + col; const float* y1p = YS + ((size_t)1 * RT + row) * 512 + col;
        const float4 ya = *(const float4*)y0p, yb = *(const float4*)(y0p + 4), yc = *(const float4*)y1p, yd = *(const float4*)(y1p + 4);
        float y[8] = {ya.x + yc.x, ya.y + yc.y, ya.z + yc.z, ya.w + yc.w, yb.x + yd.x, yb.y + yd.y, yb.z + yd.z, yb.w + yd.w};
        float sm = 0.f, bs = 0.f;
#pragma unroll
        for (int j = 0; j < 8; ++j) {
            sm += y[j];
            const float ka = kaw[col + j];
            const float kd0 = k8[j] * (1.f + (a0[j] - 1.f) * ka), kd1 = k8[j] * (1.f + (a1[j] - 1.f) * ka);
            bs += r8[j] * rkw[col + j] * (kd0 + kd1);
        }
        sm += __shfl_xor(sm, 1); sm += __shfl_xor(sm, 2); sm += __shfl_xor(sm, 4);
        bs += __shfl_xor(bs, 1); bs += __shfl_xor(bs, 2); bs += __shfl_xor(bs, 4);
        const float mean = sm * (1.f / 64.f);
        float vs = 0.f;
#pragma unroll
        for (int j = 0; j < 8; ++j) { const float dlt = y[j] - mean; vs += dlt * dlt; }
        vs += __shfl_xor(vs, 1); vs += __shfl_xor(vs, 2); vs += __shfl_xor(vs, 4);
        const float rstd = rsqrtf(vs * (1.f / 64.f) + 64e-5f);
        float o[8];
#pragma unroll
        for (int j = 0; j < 8; ++j) o[j] = ((y[j] - mean) * rstd * gng[col + j] + gnb[col + j] + bs * v8[j]) * g8[j];
        *(uint4*)(RWO + (size_t)row * 512 + col) = pack8(o);
    }
}

__device__ __forceinline__ void ph_f1(const Params& p, int l, char* smem) {
    const bf16_t* P = (const bf16_t*)(p.ws + O_P); const bf16_t* CSC = (const bf16_t*)(p.ws + O_CSC);
    bf16_t* YT = (bf16_t*)(p.ws + O_X + X_YT); bf16_t* YTC = (bf16_t*)(p.ws + O_X + X_YTC);
    const int nitems = 1024 + (l < NLAYER - 1 ? 64 : 0);
    for (int it = blockIdx.x; it < nitems; it += gridDim.x) {
        f32x4 acc[4][4];
        if (it < 1024) {
            const int b = it >> 8, g = (it >> 6) & 3, mt = (it >> 5) & 1, nt = it & 31;
            ALPlain al(CSC, 128, mt * 128);
            gemm_core<4>(al, P + (size_t)(b * SEQ + nt * 128) * LDP + g * 128, LDP, 128, acc, smem);
            acc_foreach<4>(acc, [&](int m, int n, const f32x4& v) {
                store_bf16x4(YT + ((size_t)(b * 512 + g * 128 + m)) * 8192 + mt * 4096 + nt * 128 + n, v);
            });
        } else {
            const int j = it - 1024, b = j >> 4, g = (j >> 2) & 3, mt = (j >> 1) & 1, nt = j & 1;
            ALPlain al(CSC, 128, mt * 128);
            gemm_core<4>(al, P + (size_t)(RL + b * CTX + nt * 128) * LDP + g * 128, LDP, 128, acc, smem);
            acc_foreach<4>(acc, [&](int m, int n, const f32x4& v) {
                store_bf16x4(YTC + ((size_t)(b * 512 + g * 128 + m)) * 512 + mt * 256 + nt * 128 + n, v);
            });
        }
    }
}
__device__ __forceinline__ void ph_f2(const Params& p, int l, char* smem) {
    const bf16_t* CST = (const bf16_t*)(p.ws + O_CST); const bf16_t* CST2 = (const bf16_t*)(p.ws + O_CST256);
    const bf16_t* YT = (const bf16_t*)(p.ws + O_X + X_YT); const bf16_t* YTC = (const bf16_t*)(p.ws + O_X + X_YTC);
    bf16_t* FA = (bf16_t*)(p.ws + O_FA);
    const int nitems = 512 + (l < NLAYER - 1 ? 32 : 0);
    for (int it = blockIdx.x; it < nitems; it += gridDim.x) {
        f32x4 acc[4][4];
        if (it < 512) {
            const int b = it >> 7, mt = (it >> 2) & 31, nt = it & 3;
            ALPlain al(CST, 8192, mt * 128);
            gemm_core<4>(al, YT + ((size_t)b * 512 + nt * 128) * 8192, 8192, 8192, acc, smem);
            const float sc = 0.001381067932004975f;
            acc_foreach<4>(acc, [&](int m, int n, const f32x4& v) { f32x4 o = v * sc; store_bf16x4(FA + (size_t)(b * SEQ + mt * 128 + m) * 512 + nt * 128 + n, o); });
        } else {
            const int j = it - 512, b = j >> 3, mt = (j >> 2) & 1, nt = j & 3;
            ALPlain al(CST2, 512, mt * 128);
            gemm_core<4>(al, YTC + ((size_t)b * 512 + nt * 128) * 512, 512, 512, acc, smem);
            const float sc = 0.005524271728019903f;
            acc_foreach<4>(acc, [&](int m, int n, const f32x4& v) { f32x4 o = v * sc; store_bf16x4(FA + (size_t)(RL + b * CTX + mt * 128 + m) * 512 + nt * 128 + n, o); });
        }
    }
}

__device__ __forceinline__ void ph_mg(const Params& p, int l, char* smem) {
    const bf16_t* P = (const bf16_t*)(p.ws + O_P);
    const bf16_t* A[3] = {(const bf16_t*)(p.ws + O_FA), (const bf16_t*)(p.ws + O_ATT), (const bf16_t*)(p.ws + O_RWO)};
    const bf16_t* W[3] = {(const bf16_t*)(p.ws + O_WB + W_PA), (const bf16_t*)(p.ws + O_WB + W_PB), (const bf16_t*)(p.ws + O_WB + W_PC)};
    bf16_t* MG = (bf16_t*)(p.ws + O_H);
    const int nmt = (l < NLAYER - 1) ? RT / 64 : RL / 64;
    for (int it = blockIdx.x; it < nmt * 8; it += gridDim.x) {
        const int mt = it >> 3, nt = it & 7;
        f32x4 tot[2][4];
#pragma unroll
        for (int i = 0; i < 2; ++i)
#pragma unroll
            for (int j = 0; j < 4; ++j) tot[i][j] = (f32x4){0.f, 0.f, 0.f, 0.f};
#pragma unroll
        for (int br = 0; br < 3; ++br) {
            f32x4 acc[2][4];
            ALPlain al(A[br], 512, mt * 64);
            gemm_core<2>(al, W[br] + (size_t)nt * 128 * 512, 512, 512, acc, smem);
            const int lane = tidx() & 63, wave = tidx() >> 6, wr = wave >> 1, wc = wave & 1, fr = lane & 15, fq = lane >> 4;
#pragma unroll
            for (int i = 0; i < 2; ++i)
#pragma unroll
                for (int j = 0; j < 4; ++j) {
                    const int m = wr * 32 + i * 16 + fr, n = wc * 64 + j * 16 + fq * 4;
                    const uint2 gu = *(const uint2*)(P + (size_t)(mt * 64 + m) * LDP + PG0 + br * 1024 + nt * 128 + n);
                    tot[i][j][0] += bflo(gu.x) * acc[i][j][0]; tot[i][j][1] += bfhi(gu.x) * acc[i][j][1];
                    tot[i][j][2] += bflo(gu.y) * acc[i][j][2]; tot[i][j][3] += bfhi(gu.y) * acc[i][j][3];
                }
        }
        acc_foreach<2>(tot, [&](int m, int n, const f32x4& v) { store_bf16x4(MG + (size_t)(mt * 64 + m) * 1024 + nt * 128 + n, v); });
    }
}
__device__ __forceinline__ void ph_out(const Params& p, int l, char* smem) {
    const bf16_t* MG = (const bf16_t*)(p.ws + O_H); const bf16_t* W = (const bf16_t*)(p.ws + O_WB + W_OUT);
    float* xcur = (float*)(p.ws + O_XCUR); const float* mod = (const float*)(p.ws + O_MOD);
    const int nmt = (l < NLAYER - 1) ? RT / 128 : RL / 128;
    for (int it = blockIdx.x; it < nmt * 8; it += gridDim.x) {
        const int mt = it >> 3, nt = it & 7;
        f32x4 acc[4][4];
        ALPlain al(MG, 1024, mt * 128);
        gemm_core<4>(al, W + (size_t)nt * 128 * 1024, 1024, 1024, acc, smem);
        acc_foreach<4>(acc, [&](int m, int n, const f32x4& v) {
            const int row = mt * 128 + m, col = nt * 128 + n;
            const float4 g = *(const float4*)(mod + (size_t)(l * 5 + modidx(row)) * 6144 + 2048 + col);
            float4* xp = (float4*)(xcur + (size_t)row * 1024 + col);
            float4 x = *xp; x.x += g.x * v[0]; x.y += g.y * v[1]; x.z += g.z * v[2]; x.w += g.w * v[3]; *xp = x;
        });
    }
}

__device__ __forceinline__ void ph_n2(const Params& p, int l) {
    const int lane = tidx() & 63, wave = tidx() >> 6;
    const float* xcur = (const float*)(p.ws + O_XCUR); const float* mod = (const float*)(p.ws + O_MOD);
    bf16_t* H = (bf16_t*)(p.ws + O_H);
    unsigned* cnt = (unsigned*)(p.ws + O_CNT); int* LTOK = (int*)(p.ws + O_LTOK); float* LW = (float*)(p.ws + O_LW); int* SLOT = (int*)(p.ws + O_SLOT);
    const float* g = p.in[I_N2G] + l * 1024; const float* rw = p.in[I_RW]; const float* rb = p.in[I_RB];
    const int nrows = (l < NLAYER - 1) ? RT : RL;
    for (int row = blockIdx.x * 4 + wave; row < nrows; row += gridDim.x * 4) {
        const float* x = xcur + (size_t)row * 1024; const float* md = mod + (size_t)(l * 5 + modidx(row)) * 6144;
        float4 v[4]; float ss = 0.f;
#pragma unroll
        for (int i = 0; i < 4; ++i) { v[i] = *(const float4*)(x + lane * 4 + 256 * i); ss += v[i].x * v[i].x + v[i].y * v[i].y + v[i].z * v[i].z + v[i].w * v[i].w; }
        ss = wsum(ss);
        const float rstd = rsqrtf(ss * (1.f / 1024.f) + 1e-6f);
        float lg[16];
#pragma unroll
        for (int e = 0; e < 16; ++e) lg[e] = 0.f;
#pragma unroll
        for (int i = 0; i < 4; ++i) {
            const int c = lane * 4 + 256 * i;
            const float4 gg = *(const float4*)(g + c), sc = *(const float4*)(md + 4096 + c), sh = *(const float4*)(md + 3072 + c);
            const float hv[4] = {v[i].x * rstd * gg.x * (1.f + sc.x) + sh.x, v[i].y * rstd * gg.y * (1.f + sc.y) + sh.y,
                                 v[i].z * rstd * gg.z * (1.f + sc.z) + sh.z, v[i].w * rstd * gg.w * (1.f + sc.w) + sh.w};
            f32x4 h4 = {hv[0], hv[1], hv[2], hv[3]};
            store_bf16x4(H + (size_t)row * 1024 + c, h4);
#pragma unroll
            for (int j = 0; j < 4; ++j) {
                const float* wr_ = rw + (size_t)(c + j) * 16;
                const float4 w0 = *(const float4*)wr_, w1 = *(const float4*)(wr_ + 4), w2 = *(const float4*)(wr_ + 8), w3 = *(const float4*)(wr_ + 12);
                lg[0] += hv[j] * w0.x; lg[1] += hv[j] * w0.y; lg[2] += hv[j] * w0.z; lg[3] += hv[j] * w0.w;
                lg[4] += hv[j] * w1.x; lg[5] += hv[j] * w1.y; lg[6] += hv[j] * w1.z; lg[7] += hv[j] * w1.w;
                lg[8] += hv[j] * w2.x; lg[9] += hv[j] * w2.y; lg[10] += hv[j] * w2.z; lg[11] += hv[j] * w2.w;
                lg[12] += hv[j] * w3.x; lg[13] += hv[j] * w3.y; lg[14] += hv[j] * w3.z; lg[15] += hv[j] * w3.w;
            }
        }
        float sc_[16], sel[16];
#pragma unroll
        for (int e = 0; e < 16; ++e) { lg[e] = wsum(lg[e]); sc_[e] = 1.f / (1.f + expf(-lg[e])); sel[e] = sc_[e] + rb[e]; }
        int best = 0; float bestv = -1e30f;
#pragma unroll
        for (int gi = 0; gi < 4; ++gi) {
            float m1 = -1e30f, m2 = -1e30f;
#pragma unroll
            for (int j = 0; j < 4; ++j) { const float s = sel[gi * 4 + j]; if (s > m1) { m2 = m1; m1 = s; } else if (s > m2) m2 = s; }
            const float gs = m1 + m2;
            if (gs > bestv) { bestv = gs; best = gi; }
        }
        float s4[4] = {0.f, 0.f, 0.f, 0.f}, c4[4] = {0.f, 0.f, 0.f, 0.f};
#pragma unroll
        for (int gi = 0; gi < 4; ++gi)
#pragma unroll
            for (int j = 0; j < 4; ++j) if (gi == best) { s4[j] = sel[gi * 4 + j]; c4[j] = sc_[gi * 4 + j]; }
        int i1 = 0; float v1 = s4[0], w1 = c4[0];
#pragma unroll
        for (int j = 1; j < 4; ++j) if (s4[j] > v1) { v1 = s4[j]; i1 = j; w1 = c4[j]; }
        int i2 = -1; float v2 = -1e30f, w2 = 0.f;
#pragma unroll
        for (int j = 0; j < 4; ++j) if (j != i1 && s4[j] > v2) { v2 = s4[j]; i2 = j; w2 = c4[j]; }
        if (lane == 0) {
            const float inv = 1.f / (w1 + w2);
            const int e1 = best * 4 + i1, e2 = best * 4 + i2;
            const unsigned p1 = atomicAdd(&cnt[e1], 1u), p2 = atomicAdd(&cnt[e2], 1u);
            LTOK[(size_t)e1 * RT + p1] = row; LW[(size_t)e1 * RT + p1] = w1 * inv;
            LTOK[(size_t)e2 * RT + p2] = row; LW[(size_t)e2 * RT + p2] = w2 * inv;
            SLOT[row * 2] = (e1 << 20) | (int)p1; SLOT[row * 2 + 1] = (e2 << 20) | (int)p2;
        }
    }
}

struct MoeTiles { int tb[17]; int sm; };
__device__ __forceinline__ void moe_tiles(const Params& p, int l, int* s_tb) {
    if (tidx() == 0) {
        const unsigned* cnt = (const unsigned*)(p.ws + O_CNT);
        int a = 0;
        for (int e = 0; e < 16; ++e) { s_tb[e] = a; a += ((int)cnt[e] + 127) >> 7; }
        s_tb[16] = a;
    }
    __syncthreads();
}
struct ALGather {
    const bf16_t* p[2]; bool ok[2];
    __device__ __forceinline__ uint4 load(int i, int k) const { return ok[i] ? *(const uint4*)(p[i] + k) : make_uint4(0u, 0u, 0u, 0u); }
};
struct ALSwiglu {
    const bf16_t* p[2]; float w[2];
    __device__ __forceinline__ uint4 load(int i, int k) const {
        float g[8], u[8], o[8]; unpack8(*(const uint4*)(p[i] + k), g); unpack8(*(const uint4*)(p[i] + 512 + k), u);
#pragma unroll
        for (int j = 0; j < 8; ++j) o[j] = siluf_(g[j]) * u[j] * w[i];
        return pack8(o);
    }
};
__device__ __forceinline__ void ph_e1(const Params& p, int l, char* smem) {
    int* s_tb = (int*)(smem + 48 * 1024);
    moe_tiles(p, l, s_tb);
    const bf16_t* H = (const bf16_t*)(p.ws + O_H); bf16_t* GU = (bf16_t*)(p.ws + O_P);
    const unsigned* cnt = (const unsigned*)(p.ws + O_CNT); const int* LTOK = (const int*)(p.ws + O_LTOK);
    const int sm = (l < NLAYER - 1) ? RT / 128 : RL / 128;
    const int total = (sm + s_tb[16]) * 8;
    for (int it = blockIdx.x; it < total; it += gridDim.x) {
        const int mt = it >> 3, nt = it & 7;
        int e = 16, erow0 = mt * 128, lt = 0;
        if (mt >= sm) { const int q = mt - sm; e = 0; while (q >= s_tb[e + 1]) ++e; lt = q - s_tb[e]; erow0 = RT + q * 128; }
        ALGather al;
#pragma unroll
        for (int i = 0; i < 2; ++i) {
            const int r = (tidx() >> 2) + 64 * i;
            if (e == 16) { al.ok[i] = true; al.p[i] = H + (size_t)(mt * 128 + r) * 1024; }
            else { const int idx = lt * 128 + r; al.ok[i] = idx < (int)cnt[e]; const int tok = al.ok[i] ? LTOK[(size_t)e * RT + idx] : 0; al.p[i] = H + (size_t)tok * 1024; }
        }
        f32x4 acc[4][4];
        gemm_core<4>(al, (const bf16_t*)(p.ws + O_WB + W_GU) + (size_t)e * 1024 * 1024 + (size_t)nt * 128 * 1024, 1024, 1024, acc, smem);
        acc_foreach<4>(acc, [&](int m, int n, const f32x4& v) { store_bf16x4(GU + (size_t)(erow0 + m) * 1024 + nt * 128 + n, v); });
    }
}
__device__ __forceinline__ void ph_e2(const Params& p, int l, char* smem) {
    int* s_tb = (int*)(smem + 48 * 1024);
    moe_tiles(p, l, s_tb);
    const bf16_t* GU = (const bf16_t*)(p.ws + O_P); bf16_t* YE = (bf16_t*)(p.ws + O_X + X_YE);
    const unsigned* cnt = (const unsigned*)(p.ws + O_CNT); const float* LW = (const float*)(p.ws + O_LW);
    const int sm = (l < NLAYER - 1) ? RT / 128 : RL / 128;
    const int total = (sm + s_tb[16]) * 8;
    for (int it = blockIdx.x; it < total; it += gridDim.x) {
        const int mt = it >> 3, nt = it & 7;
        int e = 16, erow0 = mt * 128, lt = 0;
        if (mt >= sm) { const int q = mt - sm; e = 0; while (q >= s_tb[e + 1]) ++e; lt = q - s_tb[e]; erow0 = RT + q * 128; }
        ALSwiglu al;
#pragma unroll
        for (int i = 0; i < 2; ++i) {
            const int r = (tidx() >> 2) + 64 * i;
            al.p[i] = GU + (size_t)(erow0 + r) * 1024;
            if (e == 16) al.w[i] = 1.f;
            else { const int idx = lt * 128 + r; al.w[i] = idx < (int)cnt[e] ? LW[(size_t)e * RT + idx] : 0.f; }
        }
        f32x4 acc[4][4];
        gemm_core<4>(al, (const bf16_t*)(p.ws + O_WB + W_D) + (size_t)e * 1024 * 512 + (size_t)nt * 128 * 512, 512, 512, acc, smem);
        acc_foreach<4>(acc, [&](int m, int n, const f32x4& v) { store_bf16x4(YE + (size_t)(erow0 + m) * 1024 + nt * 128 + n, v); });
    }
}
__device__ __forceinline__ void ph_e3(const Params& p, int l, char* smem) {
    int* s_tb = (int*)(smem + 48 * 1024);
    moe_tiles(p, l, s_tb);
    const int lane = tidx() & 63, wave = tidx() >> 6;
    const bf16_t* YE = (const bf16_t*)(p.ws + O_X + X_YE); const int* SLOT = (const int*)(p.ws + O_SLOT);
    float* xcur = (float*)(p.ws + O_XCUR); const float* mod = (const float*)(p.ws + O_MOD);
    const int nrows = (l < NLAYER - 1) ? RT : RL;
    for (int row = blockIdx.x * 4 + wave; row < nrows; row += gridDim.x * 4) {
        const int s1 = SLOT[row * 2], s2 = SLOT[row * 2 + 1];
        const size_t r0 = row, r1 = (size_t)RT + s_tb[s1 >> 20] * 128 + (s1 & 0xfffff), r2 = (size_t)RT + s_tb[s2 >> 20] * 128 + (s2 & 0xfffff);
        const float* g2 = mod + (size_t)(l * 5 + modidx(row)) * 6144 + 5120;
#pragma unroll
        for (int i = 0; i < 2; ++i) {
            const int c = lane * 8 + 512 * i;
            float a[8], b[8], d[8];
            unpack8(*(const uint4*)(YE + r0 * 1024 + c), a); unpack8(*(const uint4*)(YE + r1 * 1024 + c), b); unpack8(*(const uint4*)(YE + r2 * 1024 + c), d);
            float4* xp = (float4*)(xcur + (size_t)row * 1024 + c);
            float4 x0 = xp[0], x1 = xp[1];
            const float4 ga = *(const float4*)(g2 + c), gb = *(const float4*)(g2 + c + 4);
            x0.x += ga.x * (a[0] + b[0] + d[0]); x0.y += ga.y * (a[1] + b[1] + d[1]); x0.z += ga.z * (a[2] + b[2] + d[2]); x0.w += ga.w * (a[3] + b[3] + d[3]);
            x1.x += gb.x * (a[4] + b[4] + d[4]); x1.y += gb.y * (a[5] + b[5] + d[5]); x1.z += gb.z * (a[6] + b[6] + d[6]); x1.w += gb.w * (a[7] + b[7] + d[7]);
            xp[0] = x0; xp[1] = x1;
        }
    }
}
__device__ __forceinline__ void ph_final(const Params& p) {
    const int lane = tidx() & 63, wave = tidx() >> 6;
    const float* xcur = (const float*)(p.ws + O_XCUR); const float* g = p.in[I_FNG];
    for (int row = blockIdx.x * 4 + wave; row < RL; row += gridDim.x * 4) {
        const float* x = xcur + (size_t)row * 1024;
        float4 v[4]; float ss = 0.f;
#pragma unroll
        for (int i = 0; i < 4; ++i) { v[i] = *(const float4*)(x + lane * 4 + 256 * i); ss += v[i].x * v[i].x + v[i].y * v[i].y + v[i].z * v[i].z + v[i].w * v[i].w; }
        ss = wsum(ss);
        const float rstd = rsqrtf(ss * (1.f / 1024.f) + 1e-6f);
#pragma unroll
        for (int i = 0; i < 4; ++i) {
            const int c = lane * 4 + 256 * i; const float4 gg = *(const float4*)(g + c);
            *(float4*)(p.out + (size_t)row * 1024 + c) = make_float4(v[i].x * rstd * gg.x, v[i].y * rstd * gg.y, v[i].z * rstd * gg.z, v[i].w * rstd * gg.w);
        }
    }
}

constexpr int LDS_BYTES = 51200;
constexpr int NIV = 17;
extern __shared__ __attribute__((aligned(16))) char dynsmem[];
template <int ID> __device__ __forceinline__ void run_iv(const Params& pin, int l, char* smem) {
    Params p = pin; p.ws = launder(pin.ws);
    if constexpr (ID == 0) { ph_pre(p, smem); __syncthreads(); ph_w(p, 0, smem); }
    else if constexpr (ID == 1) ph_n1(p, l);
    else if constexpr (ID == 2) ph_g1(p, smem);
    else if constexpr (ID == 3) ph_qu(p, smem);
    else if constexpr (ID == 4) ph_m2(p);
    else if constexpr (ID == 5) ph_at(p, l, smem);
    else if constexpr (ID == 6) { ph_rp1(p, l, smem); ph_rp2(p, l); }
    else if constexpr (ID == 7) ph_sc(p, l, smem);
    else if constexpr (ID == 8) { ph_rpost(p, l); ph_f1(p, l, smem); }
    else if constexpr (ID == 9) ph_f2(p, l, smem);
    else if constexpr (ID == 10) ph_mg(p, l, smem);
    else if constexpr (ID == 11) ph_out(p, l, smem);
    else if constexpr (ID == 12) ph_n2(p, l);
    else if constexpr (ID == 13) ph_e1(p, l, smem);
    else if constexpr (ID == 14) ph_e2(p, l, smem);
    else if constexpr (ID == 15) { ph_e3(p, l, smem); __syncthreads(); if (l + 1 < NLAYER) ph_w(p, l + 1, smem); }
    else ph_final(p);
}
#if MEGA
#define IV(ID) run_iv<ID>(p, l, smem); xcd_barrier(bar);
__global__ void __launch_bounds__(256, 2) k_mega(Params p) {
    char* smem = dynsmem;
    volatile LAS unsigned* st = (volatile LAS unsigned*)(smem + LDS_BYTES - 16);
    if (tidx() == 0) { st[0] = 0u; st[1] = 0u; }
    __syncthreads();
    XcdBarrier bar = xcd_barrier_post((unsigned*)(p.ws + O_BAR), st);
    { const int l = 0; IV(0) }
    for (int l = 0; l < NLAYER; ++l) {
        IV(1) IV(2) IV(3) IV(4) IV(5) IV(6) IV(7) IV(8) IV(9) IV(10) IV(11) IV(12) IV(13) IV(14) IV(15)
    }
    run_iv<16>(p, 0, smem);
}
#else
template <int ID> __global__ void __launch_bounds__(256, 2) k_iv(Params p, int l) { run_iv<ID>(p, l, dynsmem); }
template <int ID> static void launch_iv(const Params& p, int l, int grid, hipStream_t s) { hipLaunchKernelGGL(k_iv<ID>, dim3(grid), dim3(256), LDS_BYTES, s, p, l); }
#endif

extern "C" void kernel_launch(void* const* d_in, const int* in_sizes, int n_in, void* d_out, int out_size, void* d_ws, size_t ws_size, hipStream_t stream) {
    (void)in_sizes; (void)out_size;
    if (n_in < N_IN || ws_size < WS_NEED) return;
    Params p{};
    for (int i = 0; i < N_IN; ++i) p.in[i] = (const float*)d_in[i];
    p.out = (float*)d_out; p.ws = (char*)d_ws;
    static int grid = 0;
    if (!grid) {
        int dev = 0, cus = 0; hipGetDevice(&dev); hipDeviceGetAttribute(&cus, hipDeviceAttributeMultiprocessorCount, dev);
        int per_cu = 2;
#if MEGA
        int occ = 0; hipOccupancyMaxActiveBlocksPerMultiprocessor(&occ, k_mega, 256, LDS_BYTES);
        if (occ < per_cu) per_cu = occ;
        if (per_cu < 1) per_cu = 1;
#endif
        grid = cus * per_cu;
    }
#if MEGA
    hipMemsetAsync(p.ws + O_BAR, 0, 16384, stream);
    hipLaunchKernelGGL(k_mega, dim3(grid), dim3(256), LDS_BYTES, stream, p);
#else
    launch_iv<0>(p, 0, grid, stream);
    for (int l = 0; l < NLAYER; ++l) {
        launch_iv<1>(p, l, grid, stream); launch_iv<2>(p, l, grid, stream); launch_iv<3>(p, l, grid, stream); launch_iv<4>(p, l, grid, stream);
        launch_iv<5>(p, l, grid, stream); launch_iv<6>(p, l, grid, stream); launch_iv<7>(p, l, grid, stream); launch_iv<8>(p, l, grid, stream);
        launch_iv<9>(p, l, grid, stream); launch_iv<10>(p, l, grid, stream); launch_iv<11>(p, l, grid, stream); launch_iv<12>(p, l, grid, stream);
        launch_iv<13>(p, l, grid, stream); launch_iv<14>(p, l, grid, stream); launch_iv<15>(p, l, grid, stream);
    }
    launch_iv<16>(p, 0, grid, stream);
#endif
}
```

```cpp
#include <hip/hip_runtime.h>
#include <stdint.h>

#ifndef MEGA
#define MEGA 1
#endif

typedef unsigned short bf16_t;
typedef short bf16x8 __attribute__((ext_vector_type(8)));
typedef float f32x4 __attribute__((ext_vector_type(4)));
typedef float f32x2 __attribute__((ext_vector_type(2)));
typedef __bf16 bf16v2 __attribute__((ext_vector_type(2)));

constexpr int NLAYER = 4;
constexpr int DM = 1024;
constexpr int RL = 16384, RC = 1024, RT = RL + RC;
constexpr int SEQ = 4096, CTX = 256, KEYS = SEQ + CTX;
constexpr int LDP = 6144;
constexpr int PQ0 = 512, PKV0 = 896, PKR0 = 1152, PR0 = 1184, PG0 = 2976, PEND = 6048;
constexpr int NEXP = 16;
constexpr int EROWS = 54272;

enum { I_X = 0, I_C, I_CTX, I_CCTX, I_WADA, I_BADA, I_N1G, I_N2G, I_WIN, I_QNG, I_KVNG, I_WUQ, I_WUKV, I_MU, I_W0, I_WUP, I_A0, I_AUP, I_GUP,
       I_KK, I_KA, I_RK, I_GNG, I_GNB, I_WPA, I_WPB, I_WPC, I_WOUT, I_RW, I_RB, I_EG, I_EU, I_ED, I_SG, I_SU, I_SD, I_FNG, N_IN };

struct Params { const float* in[N_IN]; float* out; char* ws; };

constexpr size_t al256(size_t x) { return (x + 255) & ~(size_t)255; }
constexpr size_t O_BAR   = 0;
constexpr size_t O_CNT   = O_BAR + 16384;
constexpr size_t O_MOD   = O_CNT + 4096;
constexpr size_t O_ROPEC = O_MOD + (size_t)NLAYER * 5 * 6144 * 4;
constexpr size_t O_ROPES = O_ROPEC + (size_t)SEQ * 16 * 4;
constexpr size_t O_CSC   = O_ROPES + (size_t)SEQ * 16 * 4;
constexpr size_t O_CST256= O_CSC + 256 * 128 * 2;
constexpr size_t O_CST   = O_CST256 + 256 * 512 * 2;
constexpr size_t O_XCUR  = O_CST + (size_t)4096 * 8192 * 2;
constexpr size_t O_WB    = O_XCUR + (size_t)RT * DM * 4;
constexpr size_t W_IN   = 0;
constexpr size_t W_UQ   = W_IN + (size_t)6144 * 1024 * 2;
constexpr size_t W_UKV  = W_UQ + (size_t)768 * 384 * 2;
constexpr size_t W_WUP  = W_UKV + (size_t)1024 * 256 * 2;
constexpr size_t W_AUP  = W_WUP + (size_t)2 * 512 * 64 * 2;
constexpr size_t W_GUP  = W_AUP + (size_t)2 * 512 * 64 * 2;
constexpr size_t W_PA   = W_GUP + (size_t)512 * 128 * 2;
constexpr size_t W_PB   = W_PA + (size_t)1024 * 512 * 2;
constexpr size_t W_PC   = W_PB + (size_t)1024 * 512 * 2;
constexpr size_t W_OUT  = W_PC + (size_t)1024 * 512 * 2;
constexpr size_t W_GU   = W_OUT + (size_t)1024 * 1024 * 2;
constexpr size_t W_D    = W_GU + (size_t)17 * 1024 * 1024 * 2;
constexpr size_t W_END  = W_D + (size_t)17 * 1024 * 512 * 2;
constexpr size_t O_H    = O_WB + W_END;
constexpr size_t O_P    = O_H + (size_t)RT * DM * 2;
constexpr size_t O_ATT  = O_P + (size_t)RT * LDP * 2;
constexpr size_t O_RG   = O_ATT + (size_t)RT * 512 * 2;
constexpr size_t O_RWO  = O_RG + (size_t)RT * 512 * 2;
constexpr size_t O_FA   = O_RWO + (size_t)RT * 512 * 2;
constexpr size_t O_LTOK = O_FA + (size_t)RT * 512 * 2;
constexpr size_t O_LW   = O_LTOK + (size_t)NEXP * RT * 4;
constexpr size_t O_SLOT = O_LW + (size_t)NEXP * RT * 4;
constexpr size_t O_X    = al256(O_SLOT + (size_t)RT * 2 * 4);
constexpr size_t X_QRAW = 0;
constexpr size_t X_KVRAW= X_QRAW + (size_t)RT * 768 * 2;
constexpr size_t X_QA   = X_KVRAW + (size_t)RT * 1024 * 2;
constexpr size_t X_KA   = X_QA + (size_t)RT * 768 * 2;
constexpr size_t X_VA   = X_KA + (size_t)4 * KEYS * 768 * 2;
constexpr int NCP = 4 * 8 * 2 * 68;
constexpr size_t X_MT   = 0;
constexpr size_t X_NL   = X_MT + (size_t)NCP * 8192;
constexpr size_t X_GT   = X_NL + (size_t)NCP * 8192;
constexpr size_t X_YL   = X_GT + (size_t)NCP * 8192;
constexpr size_t X_S0   = X_YL + (size_t)NCP * 8192;
constexpr size_t X_KKN  = X_S0 + (size_t)NCP * 8192;
constexpr size_t X_BON  = X_KKN + (size_t)RT * 8 * 4;
constexpr size_t X_END  = X_BON + (size_t)2 * RT * 8 * 4;
constexpr size_t X_YT   = 0;
constexpr size_t X_YTC  = X_YT + (size_t)4 * 512 * 8192 * 2;
constexpr size_t X_YE   = 0;
constexpr size_t WS_NEED = O_X + X_END;

__device__ __forceinline__ float bf2f(bf16_t u) { return __builtin_bit_cast(float, (unsigned)u << 16); }
__device__ __forceinline__ float bflo(unsigned u) { return __builtin_bit_cast(float, u << 16); }
__device__ __forceinline__ float bfhi(unsigned u) { return __builtin_bit_cast(float, u & 0xffff0000u); }
__device__ __forceinline__ unsigned pack2(float lo, float hi) { f32x2 v = {lo, hi}; bf16v2 b = __builtin_convertvector(v, bf16v2); return __builtin_bit_cast(unsigned, b); }
__device__ __forceinline__ bf16_t f2bf(float f) { return (bf16_t)(pack2(f, 0.f) & 0xffffu); }
__device__ __forceinline__ float wsum(float v) {
#pragma unroll
    for (int o = 32; o > 0; o >>= 1) v += __shfl_xor(v, o);
    return v;
}
__device__ __forceinline__ float sigmoidf_(float x) { return 1.f / (1.f + __expf(-x)); }
__device__ __forceinline__ float siluf_(float x) { return x / (1.f + __expf(-x)); }
__device__ __forceinline__ int modidx(int row) { return row < RL ? (row >> 12) : 4; }
__device__ __forceinline__ void unpack8(const uint4& u, float (&f)[8]) {
    f[0] = bflo(u.x); f[1] = bfhi(u.x); f[2] = bflo(u.y); f[3] = bfhi(u.y); f[4] = bflo(u.z); f[5] = bfhi(u.z); f[6] = bflo(u.w); f[7] = bfhi(u.w);
}
__device__ __forceinline__ uint4 pack8(const float (&f)[8]) { return make_uint4(pack2(f[0], f[1]), pack2(f[2], f[3]), pack2(f[4], f[5]), pack2(f[6], f[7])); }

#define XB_TMO      128
#define XB_XCNT(j)  (256  + 64 * (j))
#define XB_XSUB(j)  (1280 + 64 * (j))
#define XB_XGEN(j)  (2304 + 64 * (j))
#define XB_TOP      3328
#define XB_TOPGEN   3392
#define XCD_BAR_WORDS 3456
#define XB_SPIN_CAP (1u << 22)
#define LAS __attribute__((address_space(3)))
__device__ __forceinline__ unsigned xb_ld(unsigned* p)              { return __hip_atomic_load(p, __ATOMIC_RELAXED, __HIP_MEMORY_SCOPE_AGENT); }
__device__ __forceinline__ unsigned xb_add(unsigned* p, unsigned v) { return __hip_atomic_fetch_add(p, v, __ATOMIC_RELAXED, __HIP_MEMORY_SCOPE_AGENT); }
__device__ __forceinline__ unsigned xb_xcc_id() { return (unsigned)__builtin_amdgcn_s_getreg((3 << 11) | 20) & 0xFu; }
#define XB_SPIN(cond, bar) do { unsigned _sp = 0; while (cond) { __builtin_amdgcn_s_sleep(1); \
    if ((++_sp & 255u) == 0u) { if (xb_ld(&(bar)[XB_TMO])) break; if (_sp > XB_SPIN_CAP) { atomicAdd(&(bar)[XB_TMO], 1u); break; } } } } while (0)
struct XcdBarrier { unsigned* bar; unsigned x; volatile LAS unsigned* st; };
__device__ __forceinline__ XcdBarrier xcd_barrier_post(unsigned* bar, volatile LAS unsigned* st) {
    XcdBarrier b; b.bar = bar; b.x = xb_xcc_id(); b.st = st;
    if (threadIdx.x == 0) (void)xb_add(&bar[XB_XCNT(b.x)], 1u);
    return b;
}
__device__ __forceinline__ void xcd_barrier_complete(unsigned* bar, unsigned x, unsigned& nloc, unsigned& nx) {
    const unsigned G = gridDim.x * gridDim.y * gridDim.z;
    unsigned sum, cnt, mine, sp = 0u;
    for (;;) {
        sum = 0u; cnt = 0u; mine = 0u;
#pragma unroll
        for (unsigned j = 0; j < 16; ++j) { const unsigned c = xb_ld(&bar[XB_XCNT(j)]); sum += c; cnt += (c > 0u) ? 1u : 0u; mine = (j == x) ? c : mine; }
        if (sum == G) break;
        __builtin_amdgcn_s_sleep(1);
        if ((++sp & 255u) == 0u) { if (xb_ld(&bar[XB_TMO])) break; if (sp > XB_SPIN_CAP) { atomicAdd(&bar[XB_TMO], 1u); break; } }
    }
    nloc = mine > 0u ? mine : 1u; nx = cnt > 0u ? cnt : 1u;
}
__device__ __forceinline__ void xcd_barrier(const XcdBarrier& b) {
    asm volatile("s_waitcnt vmcnt(0)" ::: "memory");
    __syncthreads();
    if (threadIdx.x == 0) {
        unsigned* bar = b.bar;
        __builtin_amdgcn_s_waitcnt(0);
        unsigned nloc = b.st[0], nx = b.st[1];
        if (nloc == 0u) { xcd_barrier_complete(bar, b.x, nloc, nx); b.st[0] = nloc; b.st[1] = nx; }
        const unsigned old = xb_add(&bar[XB_XSUB(b.x)], 1u);
        const unsigned gen = old / nloc;
        if (old + 1u == (gen + 1u) * nloc) {
            __builtin_amdgcn_fence(__ATOMIC_RELEASE, "agent");
            asm volatile("s_waitcnt vmcnt(0)" ::: "memory");
            const unsigned og = xb_add(&bar[XB_TOP], 1u);
            const unsigned tg = og / nx;
            if (og + 1u == (tg + 1u) * nx) xb_add(&bar[XB_TOPGEN], 1u);
            else XB_SPIN(xb_ld(&bar[XB_TOPGEN]) == tg, bar);
            __builtin_amdgcn_fence(__ATOMIC_ACQUIRE, "agent");
            xb_add(&bar[XB_XGEN(b.x)], 1u);
            asm volatile("s_waitcnt vmcnt(0)" ::: "memory");
        } else {
            XB_SPIN(xb_ld(&bar[XB_XGEN(b.x)]) == gen, bar);
            __builtin_amdgcn_fence(__ATOMIC_ACQUIRE, "agent");
            asm volatile("s_waitcnt vmcnt(0)" ::: "memory");
        }
    }
    __syncthreads();
}

__device__ __forceinline__ int tidx() { int t = threadIdx.x; asm volatile("" : "+v"(t)); return t; }
__device__ __forceinline__ int lv(int x) { asm volatile("" : "+v"(x)); return x; }
__device__ __forceinline__ char* launder(char* p) { size_t z = 0; asm volatile("" : "+s"(z)); return p + z; }

constexpr int LDSROW = 40;
template <int MI, class AL>
__device__ __forceinline__ void gemm_core(const AL& al, const bf16_t* __restrict__ Bt, int ldb, int K, f32x4 (&acc)[MI][4], char* smem) {
    constexpr int TM = MI * 32;
    constexpr int NA = TM / 64;
    bf16_t* As = (bf16_t*)smem;
    bf16_t* Bs = As + 2 * TM * LDSROW;
    const int tid = tidx(), lane = tid & 63, wave = tid >> 6;
    const int wr = wave >> 1, wc = wave & 1, fr = lane & 15, fq = lane >> 4;
    const int kc = (tid & 3) * 8;
#pragma unroll
    for (int i = 0; i < MI; ++i)
#pragma unroll
        for (int j = 0; j < 4; ++j) acc[i][j] = (f32x4){0.f, 0.f, 0.f, 0.f};
    uint4 ra[NA], rb[2];
    const bf16_t* bp0 = Bt + (size_t)(tid >> 2) * ldb + kc;
    const bf16_t* bp1 = Bt + (size_t)((tid >> 2) + 64) * ldb + kc;
    const int nk = K >> 5;
#pragma unroll
    for (int i = 0; i < NA; ++i) ra[i] = al.load(i, kc);
    rb[0] = *(const uint4*)(bp0); rb[1] = *(const uint4*)(bp1);
#pragma unroll
    for (int i = 0; i < NA; ++i) *(uint4*)(As + ((tid >> 2) + 64 * i) * LDSROW + kc) = ra[i];
    *(uint4*)(Bs + (tid >> 2) * LDSROW + kc) = rb[0];
    *(uint4*)(Bs + ((tid >> 2) + 64) * LDSROW + kc) = rb[1];
    __syncthreads();
    for (int kt = 0; kt < nk; ++kt) {
        const int cur = kt & 1;
        if (kt + 1 < nk) {
            const int k0 = (kt + 1) << 5;
#pragma unroll
            for (int i = 0; i < NA; ++i) ra[i] = al.load(i, k0 + kc);
            rb[0] = *(const uint4*)(bp0 + k0); rb[1] = *(const uint4*)(bp1 + k0);
        }
        const bf16_t* Ac = As + cur * TM * LDSROW + (wr * MI * 16 + fr) * LDSROW + fq * 8;
        const bf16_t* Bc = Bs + cur * 128 * LDSROW + (wc * 64 + fr) * LDSROW + fq * 8;
        bf16x8 af[MI], bfv[4];
#pragma unroll
        for (int i = 0; i < MI; ++i) af[i] = *(const bf16x8*)(Ac + i * 16 * LDSROW);
#pragma unroll
        for (int j = 0; j < 4; ++j) bfv[j] = *(const bf16x8*)(Bc + j * 16 * LDSROW);
#pragma unroll
        for (int i = 0; i < MI; ++i)
#pragma unroll
            for (int j = 0; j < 4; ++j) acc[i][j] = __builtin_amdgcn_mfma_f32_16x16x32_bf16(bfv[j], af[i], acc[i][j], 0, 0, 0);
        if (kt + 1 < nk) {
            const int nxt = cur ^ 1;
#pragma unroll
            for (int i = 0; i < NA; ++i) *(uint4*)(As + nxt * TM * LDSROW + ((tid >> 2) + 64 * i) * LDSROW + kc) = ra[i];
            *(uint4*)(Bs + nxt * 128 * LDSROW + (tid >> 2) * LDSROW + kc) = rb[0];
            *(uint4*)(Bs + nxt * 128 * LDSROW + ((tid >> 2) + 64) * LDSROW + kc) = rb[1];
        }
        __syncthreads();
    }
}
template <int MI, class F>
__device__ __forceinline__ void acc_foreach(const f32x4 (&acc)[MI][4], F f) {
    const int lane = tidx() & 63, wave = tidx() >> 6;
    const int wr = wave >> 1, wc = wave & 1, fr = lane & 15, fq = lane >> 4;
#pragma unroll
    for (int i = 0; i < MI; ++i)
#pragma unroll
        for (int j = 0; j < 4; ++j) f(wr * MI * 16 + i * 16 + fr, wc * 64 + j * 16 + fq * 4, acc[i][j]);
}
struct ALPlain {
    const bf16_t* p[2];
    __device__ __forceinline__ ALPlain(const bf16_t* A, int lda, int row0) {
        const int r = tidx() >> 2;
        p[0] = A + (size_t)(row0 + r) * lda; p[1] = A + (size_t)(row0 + r + 64) * lda;
    }
    __device__ __forceinline__ uint4 load(int i, int k) const { return *(const uint4*)(p[i] + k); }
};
__device__ __forceinline__ void store_bf16x4(bf16_t* dst, const f32x4& v) { *(uint2*)dst = make_uint2(pack2(v[0], v[1]), pack2(v[2], v[3])); }

__device__ __forceinline__ void ph_pre(const Params& p, char* smem) {
    const int tid = tidx(), nb = gridDim.x, bid = blockIdx.x;
    float* mod = (float*)(p.ws + O_MOD);
    {
        float* sv = (float*)smem;
        float* part = sv + 5 * 1024;
        for (int i = tid; i < 5 * 1024; i += 256) { const float v = (i < 4096) ? p.in[I_C][i] : p.in[I_CCTX][i - 4096]; sv[i] = siluf_(v); }
        __syncthreads();
        for (int it = bid; it < NLAYER * 96; it += nb) {
            const int l = it / 96, jb = it % 96;
            const int jj = tid & 63, kq = tid >> 6, j = jb * 64 + jj;
            const float* w = p.in[I_WADA] + (size_t)l * 1024 * 6144 + (size_t)(kq * 256) * 6144 + j;
            float a0 = 0.f, a1 = 0.f, a2 = 0.f, a3 = 0.f, a4 = 0.f;
#pragma unroll 8
            for (int k = 0; k < 256; ++k) {
                const float wv = w[(size_t)k * 6144]; const int kk = kq * 256 + k;
                a0 += sv[kk] * wv; a1 += sv[1024 + kk] * wv; a2 += sv[2048 + kk] * wv; a3 += sv[3072 + kk] * wv; a4 += sv[4096 + kk] * wv;
            }
            part[(kq * 5 + 0) * 64 + jj] = a0; part[(kq * 5 + 1) * 64 + jj] = a1; part[(kq * 5 + 2) * 64 + jj] = a2;
            part[(kq * 5 + 3) * 64 + jj] = a3; part[(kq * 5 + 4) * 64 + jj] = a4;
            __syncthreads();
            for (int o = tid; o < 320; o += 256) {
                const int i = o >> 6, c = o & 63;
                const float s = part[(0 * 5 + i) * 64 + c] + part[(1 * 5 + i) * 64 + c] + part[(2 * 5 + i) * 64 + c] + part[(3 * 5 + i) * 64 + c];
                mod[(size_t)(l * 5 + i) * 6144 + jb * 64 + c] = s + p.in[I_BADA][l * 6144 + jb * 64 + c];
            }
            __syncthreads();
        }
    }
    {
        float4* xc = (float4*)(p.ws + O_XCUR);
        const float4* x4 = (const float4*)p.in[I_X]; const float4* c4 = (const float4*)p.in[I_CTX];
        for (size_t i = (size_t)bid * 256 + tid; i < (size_t)RT * 256; i += (size_t)nb * 256) xc[i] = (i < (size_t)RL * 256) ? x4[i] : c4[i - (size_t)RL * 256];
    }
    {
        float* ct = (float*)smem;
        __syncthreads();
        for (int m = tid; m < 4096; m += 256) ct[m] = cospif((float)m * (1.f / 2048.f));
        __syncthreads();
        bf16_t* cst = (bf16_t*)(p.ws + O_CST);
        for (size_t ch = (size_t)bid * 256 + tid; ch < (size_t)4096 * 8192 / 8; ch += (size_t)nb * 256) {
            const int kt = (int)(ch >> 10), c0 = (int)(ch & 1023) * 8, part = c0 >> 12, t0 = c0 & 4095;
            float f[8];
#pragma unroll
            for (int e = 0; e < 8; ++e) { const int m = (kt * (t0 + e)) & 4095; f[e] = part == 0 ? ct[m] : -ct[(m - 1024) & 4095]; }
            *(uint4*)(cst + ch * 8) = pack8(f);
        }
        bf16_t* cst2 = (bf16_t*)(p.ws + O_CST256);
        for (int ch = bid * 256 + tid; ch < 256 * 512 / 8; ch += nb * 256) {
            const int ks = ch >> 6, c0 = (ch & 63) * 8, part = c0 >> 8, s0 = c0 & 255;
            float f[8];
#pragma unroll
            for (int e = 0; e < 8; ++e) { const int m = (16 * ks * (s0 + e)) & 4095; f[e] = part == 0 ? ct[m] : -ct[(m - 1024) & 4095]; }
            *(uint4*)(cst2 + ch * 8) = pack8(f);
        }
        bf16_t* csc = (bf16_t*)(p.ws + O_CSC);
        for (int ch = bid * 256 + tid; ch < 256 * 128 / 8; ch += nb * 256) {
            const int n = ch >> 4, c0 = (ch & 15) * 8, part = n >> 7, kc = n & 127;
            float f[8];
#pragma unroll
            for (int e = 0; e < 8; ++e) { const int m = (32 * kc * (c0 + e)) & 4095; f[e] = part == 0 ? ct[m] : ct[(m - 1024) & 4095]; }
            *(uint4*)(csc + ch * 8) = pack8(f);
        }
        float* rc = (float*)(p.ws + O_ROPEC); float* rs = (float*)(p.ws + O_ROPES);
        for (int i = bid * 256 + tid; i < SEQ * 16; i += nb * 256) {
            const int t = i >> 4, ax = (i >> 3) & 1, f = i & 7;
            const float inv = powf(10000.f, -(float)f / 8.f);
            const float pos = (float)(ax == 0 ? (t >> 6) : (t & 63));
            const float ang = pos * inv;
            rc[i] = cosf(ang); rs[i] = sinf(ang);
        }
    }
}

struct ConvTask { const float* src; const float* scale; bf16_t* dst; int K, Nsrc, Ndst; size_t sbs, dbs; };
__constant__ int c_conv_cum[17] = {0, 1536, 1608, 1672, 1688, 1704, 1720, 1848, 1976, 2104, 2360, 4408, 6456, 8504, 8632, 8760, 8888};
__device__ __forceinline__ ConvTask conv_task(const Params& p, int l, int t) {
    bf16_t* wb = (bf16_t*)(p.ws + O_WB);
    ConvTask c; c.scale = nullptr; c.sbs = 0; c.dbs = 0;
    switch (t) {
    case 0:  c.src = p.in[I_WIN] + (size_t)l * 1024 * 6048; c.K = 1024; c.Nsrc = 6048; c.Ndst = 6144; c.dst = wb + W_IN / 2; break;
    case 1:  c.src = p.in[I_WUQ] + (size_t)l * 384 * 768; c.K = 384; c.Nsrc = 768; c.Ndst = 768; c.dst = wb + W_UQ / 2; c.scale = p.in[I_QNG] + l * 384; break;
    case 2:  c.src = p.in[I_WUKV] + (size_t)l * 256 * 1024; c.K = 256; c.Nsrc = 1024; c.Ndst = 1024; c.dst = wb + W_UKV / 2; c.scale = p.in[I_KVNG] + l * 256; break;
    case 3:  c.src = p.in[I_WUP] + (size_t)l * 2 * 64 * 512; c.K = 64; c.Nsrc = 512; c.Ndst = 512; c.dst = wb + W_WUP / 2; c.sbs = 64 * 512; c.dbs = 512 * 64; break;
    case 4:  c.src = p.in[I_AUP] + (size_t)l * 2 * 64 * 512; c.K = 64; c.Nsrc = 512; c.Ndst = 512; c.dst = wb + W_AUP / 2; c.sbs = 64 * 512; c.dbs = 512 * 64; break;
    case 5:  c.src = p.in[I_GUP] + (size_t)l * 128 * 512; c.K = 128; c.Nsrc = 512; c.Ndst = 512; c.dst = wb + W_GUP / 2; break;
    case 6:  c.src = p.in[I_WPA] + (size_t)l * 512 * 1024; c.K = 512; c.Nsrc = 1024; c.Ndst = 1024; c.dst = wb + W_PA / 2; break;
    case 7:  c.src = p.in[I_WPB] + (size_t)l * 512 * 1024; c.K = 512; c.Nsrc = 1024; c.Ndst = 1024; c.dst = wb + W_PB / 2; break;
    case 8:  c.src = p.in[I_WPC] + (size_t)l * 512 * 1024; c.K = 512; c.Nsrc = 1024; c.Ndst = 1024; c.dst = wb + W_PC / 2; break;
    case 9:  c.src = p.in[I_WOUT] + (size_t)l * 1024 * 1024; c.K = 1024; c.Nsrc = 1024; c.Ndst = 1024; c.dst = wb + W_OUT / 2; break;
    case 10: c.src = p.in[I_EG] + (size_t)l * 16 * 1024 * 512; c.K = 1024; c.Nsrc = 512; c.Ndst = 512; c.dst = wb + W_GU / 2; c.sbs = 1024 * 512; c.dbs = 1024 * 1024; break;
    case 11: c.src = p.in[I_EU] + (size_t)l * 16 * 1024 * 512; c.K = 1024; c.Nsrc = 512; c.Ndst = 512; c.dst = wb + W_GU / 2 + 512 * 1024; c.sbs = 1024 * 512; c.dbs = 1024 * 1024; break;
    case 12: c.src = p.in[I_ED] + (size_t)l * 16 * 512 * 1024; c.K = 512; c.Nsrc = 1024; c.Ndst = 1024; c.dst = wb + W_D / 2; c.sbs = 512 * 1024; c.dbs = 1024 * 512; break;
    case 13: c.src = p.in[I_SG] + (size_t)l * 1024 * 512; c.K = 1024; c.Nsrc = 512; c.Ndst = 512; c.dst = wb + W_GU / 2 + (size_t)16 * 1024 * 1024; break;
    case 14: c.src = p.in[I_SU] + (size_t)l * 1024 * 512; c.K = 1024; c.Nsrc = 512; c.Ndst = 512; c.dst = wb + W_GU / 2 + (size_t)16 * 1024 * 1024 + 512 * 1024; break;
    default: c.src = p.in[I_SD] + (size_t)l * 512 * 1024; c.K = 512; c.Nsrc = 1024; c.Ndst = 1024; c.dst = wb + W_D / 2 + (size_t)16 * 1024 * 512; break;
    }
    return c;
}
__device__ __forceinline__ void ph_w(const Params& p, int l, char* smem) {
    const int tid = tidx();
    float* tl = (float*)smem;
    for (int g = blockIdx.x; g < 8888; g += gridDim.x) {
        int t = 0;
        while (g >= c_conv_cum[t + 1]) ++t;
        const ConvTask c = conv_task(p, l, t);
        int r = g - c_conv_cum[t];
        const int nkt = c.K >> 6, nnt = c.Ndst >> 6;
        const int bi = r / (nkt * nnt); r -= bi * nkt * nnt;
        const int k0 = (r / nnt) * 64, n0 = (r % nnt) * 64;
        const float* src = c.src + bi * c.sbs; bf16_t* dst = c.dst + bi * c.dbs;
#pragma unroll
        for (int i = 0; i < 4; ++i) {
            const int k = (tid >> 4) + 16 * i, n = n0 + (tid & 15) * 4;
            float4 v = make_float4(0.f, 0.f, 0.f, 0.f);
            if (n < c.Nsrc) v = *(const float4*)(src + (size_t)(k0 + k) * c.Nsrc + n);
            if (c.scale) { const float s = c.scale[k0 + k]; v.x *= s; v.y *= s; v.z *= s; v.w *= s; }
            float* d = tl + k * 65 + (tid & 15) * 4;
            d[0] = v.x; d[1] = v.y; d[2] = v.z; d[3] = v.w;
        }
        __syncthreads();
        {
            const int n = tid >> 2, kk0 = (tid & 3) * 16;
            float f[8], g2[8];
#pragma unroll
            for (int j = 0; j < 8; ++j) { f[j] = tl[(kk0 + j) * 65 + n]; g2[j] = tl[(kk0 + 8 + j) * 65 + n]; }
            bf16_t* d = dst + (size_t)(n0 + n) * c.K + k0 + kk0;
            *(uint4*)d = pack8(f); *(uint4*)(d + 8) = pack8(g2);
        }
        __syncthreads();
    }
}

__device__ __forceinline__ void ph_n1(const Params& p, int l) {
    const int lane = tidx() & 63, wave = tidx() >> 6;
    const float* xcur = (const float*)(p.ws + O_XCUR); const float* mod = (const float*)(p.ws + O_MOD);
    bf16_t* H = (bf16_t*)(p.ws + O_H);
    if (blockIdx.x == 0 && tidx() < 64) ((unsigned*)(p.ws + O_CNT))[tidx()] = 0u;
    const float* g = p.in[I_N1G] + l * 1024;
    for (int row = blockIdx.x * 4 + wave; row < RT; row += gridDim.x * 4) {
        const float* x = xcur + (size_t)row * 1024; const float* md = mod + (size_t)(l * 5 + modidx(row)) * 6144;
        float4 v[4]; float ss = 0.f;
#pragma unroll
        for (int i = 0; i < 4; ++i) { v[i] = *(const float4*)(x + lane * 4 + 256 * i); ss += v[i].x * v[i].x + v[i].y * v[i].y + v[i].z * v[i].z + v[i].w * v[i].w; }
        ss = wsum(ss);
        const float rstd = rsqrtf(ss * (1.f / 1024.f) + 1e-6f);
#pragma unroll
        for (int i = 0; i < 4; ++i) {
            const int c = lane * 4 + 256 * i;
            const float4 gg = *(const float4*)(g + c), sc = *(const float4*)(md + 1024 + c), sh = *(const float4*)(md + c);
            f32x4 h = {v[i].x * rstd * gg.x * (1.f + sc.x) + sh.x, v[i].y * rstd * gg.y * (1.f + sc.y) + sh.y,
                       v[i].z * rstd * gg.z * (1.f + sc.z) + sh.z, v[i].w * rstd * gg.w * (1.f + sc.w) + sh.w};
            store_bf16x4(H + (size_t)row * 1024 + c, h);
        }
    }
}

__device__ __forceinline__ void ph_g1(const Params& p, char* smem) {
    const bf16_t* H = (const bf16_t*)(p.ws + O_H); const bf16_t* W = (const bf16_t*)(p.ws + O_WB + W_IN);
    bf16_t* P = (bf16_t*)(p.ws + O_P);
    for (int it = blockIdx.x; it < 136 * 48; it += gridDim.x) {
        const int mt = it / 48, nt = it % 48;
        f32x4 acc[4][4];
        ALPlain al(H, 1024, mt * 128);
        gemm_core<4>(al, W + (size_t)nt * 128 * 1024, 1024, 1024, acc, smem);
        acc_foreach<4>(acc, [&](int m, int n, const f32x4& v) {
            const int col = nt * 128 + n; f32x4 o = v;
            if (col >= PG0 && col < PEND) { o[0] = sigmoidf_(v[0]); o[1] = sigmoidf_(v[1]); o[2] = sigmoidf_(v[2]); o[3] = sigmoidf_(v[3]); }
            store_bf16x4(P + (size_t)(mt * 128 + m) * LDP + col, o);
        });
    }
}

__device__ __forceinline__ void ph_qu(const Params& p, char* smem) {
    const bf16_t* P = (const bf16_t*)(p.ws + O_P);
    bf16_t* QR = (bf16_t*)(p.ws + O_X + X_QRAW); bf16_t* KVR = (bf16_t*)(p.ws + O_X + X_KVRAW);
    for (int it = blockIdx.x; it < 136 * 14; it += gridDim.x) {
        const int mt = it / 14, nn = it % 14;
        f32x4 acc[4][4];
        if (nn < 6) {
            ALPlain al(P + PQ0, LDP, mt * 128);
            gemm_core<4>(al, (const bf16_t*)(p.ws + O_WB + W_UQ) + (size_t)nn * 128 * 384, 384, 384, acc, smem);
            acc_foreach<4>(acc, [&](int m, int n, const f32x4& v) { store_bf16x4(QR + (size_t)(mt * 128 + m) * 768 + nn * 128 + n, v); });
        } else {
            const int nt = nn - 6;
            ALPlain al(P + PKV0, LDP, mt * 128);
            gemm_core<4>(al, (const bf16_t*)(p.ws + O_WB + W_UKV) + (size_t)nt * 128 * 256, 256, 256, acc, smem);
            acc_foreach<4>(acc, [&](int m, int n, const f32x4& v) { store_bf16x4(KVR + (size_t)(mt * 128 + m) * 1024 + nt * 128 + n, v); });
        }
    }
}

constexpr float QSCALE = 0.10206207261596575f * 1.4426950408889634f;
__device__ __forceinline__ void ph_m2(const Params& p) {
    const int lane = tidx() & 63, wave = tidx() >> 6;
    const bf16_t* P = (const bf16_t*)(p.ws + O_P);
    const bf16_t* QR = (const bf16_t*)(p.ws + O_X + X_QRAW); const bf16_t* KVR = (const bf16_t*)(p.ws + O_X + X_KVRAW);
    bf16_t* QA = (bf16_t*)(p.ws + O_X + X_QA); bf16_t* KA = (bf16_t*)(p.ws + O_X + X_KA); bf16_t* VA = (bf16_t*)(p.ws + O_X + X_VA);
    const float* rc = (const float*)(p.ws + O_ROPEC); const float* rs = (const float*)(p.ws + O_ROPES);
    for (int row = blockIdx.x * 4 + wave; row < RT; row += gridDim.x * 4) {
        const bool lat = row < RL;
        const int b = lat ? (row >> 12) : ((row - RL) >> 8), t = lat ? (row & 4095) : ((row - RL) & 255);
        const size_t keyrow = (size_t)b * KEYS + (lat ? t : SEQ + t);
        const bf16_t* pr = P + (size_t)row * LDP;
        float sq = 0.f, sk = 0.f;
#pragma unroll
        for (int i = 0; i < 6; ++i) { const float v = bf2f(pr[PQ0 + lane + 64 * i]); sq += v * v; }
#pragma unroll
        for (int i = 0; i < 4; ++i) { const float v = bf2f(pr[PKV0 + lane + 64 * i]); sk += v * v; }
        sq = wsum(sq); sk = wsum(sk);
        const float rq = rsqrtf(sq * (1.f / 384.f) + 1e-6f), rkv = rsqrtf(sk * (1.f / 256.f) + 1e-6f);
        const bf16_t* qr = QR + (size_t)row * 768; const bf16_t* kvr = KVR + (size_t)row * 1024;
        const float* rct = rc + t * 16; const float* rst = rs + t * 16;
#pragma unroll
        for (int i = 0; i < 12; ++i) {
            const int e = lane + 64 * i, h = e / 96, dd = e - h * 96;
            float xq = bf2f(qr[e]) * rq, xk;
            if (dd < 64) xk = bf2f(kvr[h * 128 + dd]) * rkv;
            else {
                const int ii = dd - 64;
                xk = bf2f(pr[PKR0 + ii]);
                if (lat) {
                    const int ax = ii >> 4, half = (ii >> 3) & 1, f = ii & 7;
                    const float c = rct[ax * 8 + f], s = rst[ax * 8 + f];
                    const float xqp = bf2f(qr[half ? e - 8 : e + 8]) * rq, xkp = bf2f(pr[PKR0 + (ii ^ 8)]);
                    xq = half ? (xq * c + xqp * s) : (xq * c - xqp * s);
                    xk = half ? (xk * c + xkp * s) : (xk * c - xkp * s);
                }
            }
            QA[(size_t)row * 768 + e] = f2bf(xq * QSCALE);
            KA[keyrow * 768 + e] = f2bf(xk);
        }
#pragma unroll
        for (int i = 0; i < 8; ++i) {
            const int e = lane + 64 * i, h = e >> 6, dd = e & 63;
            VA[keyrow * 512 + e] = f2bf(bf2f(kvr[h * 128 + 64 + dd]) * rkv);
        }
    }
}

constexpr int KS_LD = 104, VT_LD = 72;
constexpr int AT_BUF = 64 * KS_LD * 2 + 64 * VT_LD * 2;
__device__ __forceinline__ void ph_at(const Params& p, int l, char* smem) {
    const int tid = tidx(), lane = tid & 63, wave = tid >> 6, fr = lane & 15, fq = lane >> 4;
    const bf16_t* QA = (const bf16_t*)(p.ws + O_X + X_QA); const bf16_t* KA = (const bf16_t*)(p.ws + O_X + X_KA); const bf16_t* VA = (const bf16_t*)(p.ws + O_X + X_VA);
    bf16_t* ATT = (bf16_t*)(p.ws + O_ATT);
    const int nitems = 2048 + (l < NLAYER - 1 ? 128 : 0);
    for (int it = blockIdx.x; it < nitems; it += gridDim.x) {
        int b, h, row0, ntile; size_t krow0;
        if (it < 2048) { b = it >> 9; h = (it >> 6) & 7; row0 = b * SEQ + (it & 63) * 64; krow0 = (size_t)b * KEYS; ntile = KEYS / 64; }
        else { const int j = it - 2048; b = j >> 5; h = (j >> 2) & 7; row0 = RL + b * CTX + (j & 3) * 64; krow0 = (size_t)b * KEYS + SEQ; ntile = CTX / 64; }
        const int qrow = row0 + wave * 16 + fr;
        bf16x8 qf[3];
#pragma unroll
        for (int ks = 0; ks < 3; ++ks) qf[ks] = *(const bf16x8*)(QA + (size_t)qrow * 768 + h * 96 + ks * 32 + fq * 8);
        f32x4 ot[4];
#pragma unroll
        for (int i = 0; i < 4; ++i) ot[i] = (f32x4){0.f, 0.f, 0.f, 0.f};
        float m_run = -1e30f, l_run = 0.f;
        uint4 rk0, rk1, rk2, rv0, rv1;
#define AT_GLOAD(KT) do { const size_t kr_ = krow0 + (size_t)(KT) * 64; \
            { const int c = tid, key = c / 12, part = c % 12; rk0 = *(const uint4*)(KA + (kr_ + key) * 768 + h * 96 + part * 8); } \
            { const int c = tid + 256, key = c / 12, part = c % 12; rk1 = *(const uint4*)(KA + (kr_ + key) * 768 + h * 96 + part * 8); } \
            { const int c = tid + 512, key = c / 12, part = c % 12; rk2 = *(const uint4*)(KA + (kr_ + key) * 768 + h * 96 + part * 8); } \
            { const int c = tid, key = c >> 3, part = c & 7; rv0 = *(const uint4*)(VA + (kr_ + key) * 512 + h * 64 + part * 8); } \
            { const int c = tid + 256, key = c >> 3, part = c & 7; rv1 = *(const uint4*)(VA + (kr_ + key) * 512 + h * 64 + part * 8); } } while (0)
#define AT_VSTORE(RV, C) do { const int key = (C) >> 3, part = (C) & 7; bf16_t* vd_ = Vt_ + (part * 8) * VT_LD + key; \
            vd_[0 * VT_LD] = (bf16_t)(RV.x & 0xffffu); vd_[1 * VT_LD] = (bf16_t)(RV.x >> 16); vd_[2 * VT_LD] = (bf16_t)(RV.y & 0xffffu); vd_[3 * VT_LD] = (bf16_t)(RV.y >> 16); \
            vd_[4 * VT_LD] = (bf16_t)(RV.z & 0xffffu); vd_[5 * VT_LD] = (bf16_t)(RV.z >> 16); vd_[6 * VT_LD] = (bf16_t)(RV.w & 0xffffu); vd_[7 * VT_LD] = (bf16_t)(RV.w >> 16); } while (0)
#define AT_SSTORE(BUF) do { bf16_t* Ks_ = (bf16_t*)(smem + (BUF) * AT_BUF); bf16_t* Vt_ = Ks_ + 64 * KS_LD; \
            { const int c = tid, key = c / 12, part = c % 12; *(uint4*)(Ks_ + key * KS_LD + part * 8) = rk0; } \
            { const int c = tid + 256, key = c / 12, part = c % 12; *(uint4*)(Ks_ + key * KS_LD + part * 8) = rk1; } \
            { const int c = tid + 512, key = c / 12, part = c % 12; *(uint4*)(Ks_ + key * KS_LD + part * 8) = rk2; } \
            AT_VSTORE(rv0, tid); AT_VSTORE(rv1, tid + 256); } while (0)
        AT_GLOAD(0); AT_SSTORE(0);
        __syncthreads();
        for (int kt = 0; kt < ntile; ++kt) {
            const int cur = kt & 1;
            if (kt + 1 < ntile) AT_GLOAD(kt + 1);
            const bf16_t* Ks = (const bf16_t*)(smem + cur * AT_BUF); const bf16_t* Vt = Ks + 64 * KS_LD;
            f32x4 st[4];
#pragma unroll
            for (int j = 0; j < 4; ++j) {
                st[j] = (f32x4){0.f, 0.f, 0.f, 0.f};
#pragma unroll
                for (int ks = 0; ks < 3; ++ks) {
                    const bf16x8 kf = *(const bf16x8*)(Ks + (j * 16 + fr) * KS_LD + ks * 32 + fq * 8);
                    st[j] = __builtin_amdgcn_mfma_f32_16x16x32_bf16(kf, qf[ks], st[j], 0, 0, 0);
                }
            }
            float mx = st[0][0];
#pragma unroll
            for (int j = 0; j < 4; ++j)
#pragma unroll
                for (int r = 0; r < 4; ++r) mx = fmaxf(mx, st[j][r]);
            mx = fmaxf(mx, __shfl_xor(mx, 16)); mx = fmaxf(mx, __shfl_xor(mx, 32));
            const float m_new = fmaxf(m_run, mx);
            const float alpha = exp2f(m_run - m_new);
            m_run = m_new;
            float ps = 0.f;
#pragma unroll
            for (int j = 0; j < 4; ++j)
#pragma unroll
                for (int r = 0; r < 4; ++r) { st[j][r] = exp2f(st[j][r] - m_new); ps += st[j][r]; }
            l_run = l_run * alpha + ps;
#pragma unroll
            for (int i = 0; i < 4; ++i) ot[i] *= alpha;
#pragma unroll
            for (int k2 = 0; k2 < 2; ++k2) {
                const uint4 pu = make_uint4(pack2(st[2 * k2][0], st[2 * k2][1]), pack2(st[2 * k2][2], st[2 * k2][3]),
                                            pack2(st[2 * k2 + 1][0], st[2 * k2 + 1][1]), pack2(st[2 * k2 + 1][2], st[2 * k2 + 1][3]));
                const bf16x8 pb = __builtin_bit_cast(bf16x8, pu);
#pragma unroll
                for (int dt = 0; dt < 4; ++dt) {
                    const bf16_t* vp = Vt + (dt * 16 + fr) * VT_LD + k2 * 32 + fq * 4;
                    const uint2 v0 = *(const uint2*)vp, v1 = *(const uint2*)(vp + 16);
                    const bf16x8 vf = __builtin_bit_cast(bf16x8, make_uint4(v0.x, v0.y, v1.x, v1.y));
                    ot[dt] = __builtin_amdgcn_mfma_f32_16x16x32_bf16(vf, pb, ot[dt], 0, 0, 0);
                }
            }
            if (kt + 1 < ntile) AT_SSTORE(cur ^ 1);
            __syncthreads();
        }
        float lt = l_run; lt += __shfl_xor(lt, 16); lt += __shfl_xor(lt, 32);
        const float inv = 1.f / lt;
#pragma unroll
        for (int dt = 0; dt < 4; ++dt) { f32x4 o = ot[dt] * inv; store_bf16x4(ATT + (size_t)qrow * 512 + h * 64 + dt * 16 + fq * 4, o); }
    }
}

__device__ __forceinline__ void row_edges(int row, bool& first, bool& last) {
    if (row < RL) { const int t = row & 4095; first = t == 0; last = t == 4095; }
    else { const int s = (row - RL) & 255; first = s == 0; last = s == 255; }
}
__device__ __forceinline__ float xs1(const bf16_t* P, const float* mu, int row, int col) {
    bool first, last; row_edges(row, first, last);
    const bf16_t* pc = P + (size_t)row * LDP + PR0 + col;
    const float c = bf2f(*pc), pv = first ? 0.f : bf2f(*(pc - LDP)), nx = last ? 0.f : bf2f(*(pc + LDP));
    return c + (0.5f * (pv + nx) - c) * mu[col];
}
__device__ __forceinline__ void xs8(const bf16_t* P, const float* mu, int row, int col, float (&o)[8]) {
    bool first, last; row_edges(row, first, last);
    const bf16_t* pc = P + (size_t)row * LDP + PR0 + col;
    const uint4 z = make_uint4(0u, 0u, 0u, 0u);
    const uint4 uc = *(const uint4*)pc, up = first ? z : *(const uint4*)(pc - LDP), un = last ? z : *(const uint4*)(pc + LDP);
    float c[8], pv[8], nx[8]; unpack8(uc, c); unpack8(up, pv); unpack8(un, nx);
    const float4 m0 = *(const float4*)(mu + col), m1 = *(const float4*)(mu + col + 4);
    const float m[8] = {m0.x, m0.y, m0.z, m0.w, m1.x, m1.y, m1.z, m1.w};
#pragma unroll
    for (int j = 0; j < 8; ++j) o[j] = c[j] + (0.5f * (pv[j] + nx[j]) - c[j]) * m[j];
}
struct ALRw {
    const bf16_t* P; const float* mu; int row[2]; int colbase, mode;
    __device__ __forceinline__ ALRw(const bf16_t* P_, const float* mu_, int row0, int colbase_, int mode_) : P(P_), mu(mu_), colbase(colbase_), mode(mode_) {
        row[0] = row0 + (tidx() >> 2); row[1] = row[0] + 64;
    }
    __device__ __forceinline__ uint4 load(int i, int k) const {
        float o[8]; xs8(P, mu, row[i], colbase + k, o);
        if (mode == 0) {
#pragma unroll
            for (int j = 0; j < 8; ++j) o[j] = tanhf(o[j]);
        } else if (mode == 2) {
#pragma unroll
            for (int j = 0; j < 8; ++j) o[j] = sigmoidf_(o[j]);
        }
        return pack8(o);
    }
};
__device__ __forceinline__ void ph_rp1(const Params& p, int l, char* smem) {
    const bf16_t* P = (const bf16_t*)(p.ws + O_P); const float* mu = p.in[I_MU] + l * 1792;
    bf16_t* RG = (bf16_t*)(p.ws + O_RG);
    for (int it = blockIdx.x; it < 544; it += gridDim.x) {
        const int mt = it >> 2, nt = it & 3;
        f32x4 acc[4][4];
        ALRw al(P, mu, mt * 128, 1664, 2);
        gemm_core<4>(al, (const bf16_t*)(p.ws + O_WB + W_GUP) + (size_t)nt * 128 * 128, 128, 128, acc, smem);
        acc_foreach<4>(acc, [&](int m, int n, const f32x4& v) { store_bf16x4(RG + (size_t)(mt * 128 + m) * 512 + nt * 128 + n, v); });
    }
}
__device__ __forceinline__ void ph_rp2(const Params& p, int l) {
    const int lane = tidx() & 63, wave = tidx() >> 6;
    const bf16_t* P = (const bf16_t*)(p.ws + O_P); const float* mu = p.in[I_MU] + l * 1792; const float* kkw = p.in[I_KK] + l * 512;
    float* KKN = (float*)(p.ws + O_X + X_KKN);
    for (int row = blockIdx.x * 4 + wave; row < RT; row += gridDim.x * 4) {
        float k8[8]; xs8(P, mu, row, 512 + lane * 8, k8);
        float s = 0.f;
#pragma unroll
        for (int j = 0; j < 8; ++j) { const float v = k8[j] * kkw[lane * 8 + j]; s += v * v; }
        s += __shfl_xor(s, 1); s += __shfl_xor(s, 2); s += __shfl_xor(s, 4);
        if ((lane & 7) == 0) KKN[(size_t)row * 8 + (lane >> 3)] = rsqrtf(s + 1e-12f);
    }
}

__device__ __forceinline__ int scan_row(int b, int d, int n) {
    if (n < CTX) return RL + b * CTX + (d == 0 ? n : CTX - 1 - n);
    const int t = n - CTX; return b * SEQ + (d == 0 ? t : SEQ - 1 - t);
}
constexpr int SL = 72;
constexpr int SLOT_E = 64 * SL;
template <int LDA, int LDB>
__device__ __forceinline__ void mm64(const bf16_t* A, const bf16_t* B, f32x4 (&acc)[4], int wave, int fr, int fq) {
#pragma unroll
    for (int ks = 0; ks < 2; ++ks) {
        const bf16x8 af = *(const bf16x8*)(A + (wave * 16 + fr) * LDA + ks * 32 + fq * 8);
#pragma unroll
        for (int nt = 0; nt < 4; ++nt) {
            const bf16x8 bfv = *(const bf16x8*)(B + (nt * 16 + fr) * LDB + ks * 32 + fq * 8);
            acc[nt] = __builtin_amdgcn_mfma_f32_16x16x32_bf16(bfv, af, acc[nt], 0, 0, 0);
        }
    }
}
__device__ __forceinline__ void acc_zero(f32x4 (&acc)[4]) {
#pragma unroll
    for (int nt = 0; nt < 4; ++nt) acc[nt] = (f32x4){0.f, 0.f, 0.f, 0.f};
}
template <bool STRICT>
__device__ __forceinline__ void acc_mask(f32x4 (&acc)[4], int m, int fq) {
#pragma unroll
    for (int nt = 0; nt < 4; ++nt)
#pragma unroll
        for (int r = 0; r < 4; ++r) { const int n = nt * 16 + fq * 4 + r; const bool keep = STRICT ? (m < n) : (m <= n); if (!keep) acc[nt][r] = 0.f; }
}
__device__ __forceinline__ void st_rm(bf16_t* dst, const f32x4 (&acc)[4], int m, int fq) {
#pragma unroll
    for (int nt = 0; nt < 4; ++nt) store_bf16x4(dst + m * SL + nt * 16 + fq * 4, acc[nt]);
}
__device__ __forceinline__ void st_tr(bf16_t* dst, const f32x4 (&acc)[4], int m, int fq) {
#pragma unroll
    for (int nt = 0; nt < 4; ++nt)
#pragma unroll
        for (int r = 0; r < 4; ++r) dst[(nt * 16 + fq * 4 + r) * SL + m] = f2bf(acc[nt][r]);
}
__device__ __forceinline__ void ph_r1(const Params& p, int l, char* smem) {
    const int tid0 = tidx();
#define R1_IDX const int tid = lv(tid0), lane = tid & 63, wave = tid >> 6, fr = lane & 15, fq = lane >> 4, bi = tid >> 2, bq = (tid & 3) * 16, m = wave * 16 + fr; (void)bi; (void)bq; (void)m; (void)fq;
    const bf16_t* P = (const bf16_t*)(p.ws + O_P); const float* mu = p.in[I_MU] + l * 1792;
    const float* kkw = p.in[I_KK] + l * 512; const float* kaw = p.in[I_KA] + l * 512; const float* rkw = p.in[I_RK] + l * 512;
    const float* KKN = (const float*)(p.ws + O_X + X_KKN); float* BON = (float*)(p.ws + O_X + X_BON);
    bf16_t* gMT = (bf16_t*)(p.ws + O_X + X_MT); bf16_t* gNL = (bf16_t*)(p.ws + O_X + X_NL);
    bf16_t* gGT = (bf16_t*)(p.ws + O_X + X_GT); bf16_t* gYL = (bf16_t*)(p.ws + O_X + X_YL);
    bf16_t* slot = (bf16_t*)smem;
    bf16_t* s0 = slot, *s1 = slot + SLOT_E, *s2 = slot + 2 * SLOT_E, *s3 = slot + 3 * SLOT_E;
    bf16_t* sa = slot + 4 * SLOT_E, *sb = slot + 5 * SLOT_E, *sc = slot + 6 * SLOT_E, *sT = slot + 7 * SLOT_E;
    float* misc = (float*)(smem + 8 * SLOT_E * 2);
    float* GAM = misc; float* SEG = misc + 64;
    float* ASIG = (float*)s0;
    float* LWS = (float*)s2;
    for (int it = blockIdx.x; it < NCP; it += gridDim.x) {
        const int c = it % 68, d = (it / 68) & 1, h = (it / 136) & 7, b = it / 1088;
        {
            R1_IDX const int rowb = scan_row(b, d, c * 64 + bi); (void)rowb;
            float o[8];
#pragma unroll
            for (int hh = 0; hh < 2; ++hh) {
                xs8(P, mu, rowb, 1536 + bq + hh * 8, o);
#pragma unroll
                for (int j = 0; j < 8; ++j) o[j] = tanhf(o[j]);
                *(uint4*)(sa + bi * SL + bq + hh * 8) = pack8(o);
                xs8(P, mu, rowb, 1600 + bq + hh * 8, o);
                *(uint4*)(sb + bi * SL + bq + hh * 8) = pack8(o);
            }
        }
        __syncthreads();
        {
            R1_IDX const int rowb = scan_row(b, d, c * 64 + bi); (void)rowb;
            f32x4 acc[4];
            acc_zero(acc);
            mm64<SL, 64>(sa, (const bf16_t*)(p.ws + O_WB + W_WUP) + ((size_t)d * 512 + h * 64) * 64, acc, wave, fr, fq);
            const float* w0 = p.in[I_W0] + (l * 2 + d) * 512 + h * 64;
#pragma unroll
            for (int nt = 0; nt < 4; ++nt) {
                const int n = nt * 16 + fq * 4; float4 o; float* op = (float*)&o;
#pragma unroll
                for (int r = 0; r < 4; ++r) { const float z = w0[n + r] + acc[nt][r]; const float sp = fmaxf(-z, 0.f) + log1pf(expf(-fabsf(z))); op[r] = -expf(-sp - 0.5f); }
                *(float4*)(LWS + m * 64 + n) = o;
            }
            acc_zero(acc);
            mm64<SL, 64>(sb, (const bf16_t*)(p.ws + O_WB + W_AUP) + ((size_t)d * 512 + h * 64) * 64, acc, wave, fr, fq);
            const float* a0 = p.in[I_A0] + (l * 2 + d) * 512 + h * 64;
#pragma unroll
            for (int nt = 0; nt < 4; ++nt) {
                const int n = nt * 16 + fq * 4;
                *(float4*)(ASIG + m * 64 + n) = make_float4(sigmoidf_(a0[n] + acc[nt][0]), sigmoidf_(a0[n + 1] + acc[nt][1]), sigmoidf_(a0[n + 2] + acc[nt][2]), sigmoidf_(a0[n + 3] + acc[nt][3]));
            }
        }
        __syncthreads();
        {
            R1_IDX const int rowb = scan_row(b, d, c * 64 + bi); (void)rowb;
            const int k = tid & 63, seg = tid >> 6;
            float run = 0.f;
#pragma unroll
            for (int ii = 0; ii < 16; ++ii) { run += LWS[(seg * 16 + ii) * 64 + k]; LWS[(seg * 16 + ii) * 64 + k] = run; }
            SEG[seg * 64 + k] = run;
            __syncthreads();
            float off = 0.f;
#pragma unroll
            for (int sgi = 0; sgi < 3; ++sgi) if (sgi < seg) off += SEG[sgi * 64 + k];
#pragma unroll
            for (int ii = 0; ii < 16; ++ii) LWS[(seg * 16 + ii) * 64 + k] += off;
        }
        __syncthreads();
        {
            R1_IDX const int rowb = scan_row(b, d, c * 64 + bi); (void)rowb;
            float cs[16], cm[16], cc[16], ag[16];
#pragma unroll
            for (int q = 0; q < 4; ++q) {
                const float4 v0 = *(const float4*)(LWS + bi * 64 + bq + q * 4);
                const float4 v1 = bi > 0 ? *(const float4*)(LWS + (bi - 1) * 64 + bq + q * 4) : make_float4(0.f, 0.f, 0.f, 0.f);
                const float4 v2 = *(const float4*)(LWS + 63 * 64 + bq + q * 4);
                const float4 v3 = *(const float4*)(ASIG + bi * 64 + bq + q * 4);
                cs[q * 4] = v0.x; cs[q * 4 + 1] = v0.y; cs[q * 4 + 2] = v0.z; cs[q * 4 + 3] = v0.w;
                cm[q * 4] = v1.x; cm[q * 4 + 1] = v1.y; cm[q * 4 + 2] = v1.z; cm[q * 4 + 3] = v1.w;
                cc[q * 4] = v2.x; cc[q * 4 + 1] = v2.y; cc[q * 4 + 2] = v2.z; cc[q * 4 + 3] = v2.w;
                ag[q * 4] = v3.x; ag[q * 4 + 1] = v3.y; ag[q * 4 + 2] = v3.z; ag[q * 4 + 3] = v3.w;
            }
            __syncthreads();
            const float kkn = KKN[(size_t)rowb * 8 + h];
            float bon = 0.f;
#pragma unroll
            for (int hh = 0; hh < 2; ++hh) {
                float r8[8], k8[8], oa[8], ob[8], ok[8], orr[8];
                const int col = h * 64 + bq + hh * 8;
                xs8(P, mu, rowb, col, r8); xs8(P, mu, rowb, 512 + col, k8);
#pragma unroll
                for (int j = 0; j < 8; ++j) {
                    const int e = hh * 8 + j;
                    const float kk = k8[j] * kkw[col + j] * kkn;
                    const float kd = k8[j] * (1.f + (ag[e] - 1.f) * kaw[col + j]);
                    const float eneg = __expf(-cs[e]);
                    oa[j] = -kk * __expf(cm[e]); ob[j] = kk * ag[e] * eneg; ok[j] = kd * eneg; orr[j] = r8[j] * __expf(cs[e]);
                    bon += r8[j] * kd * rkw[col + j];
                }
                *(uint4*)(s0 + bi * SL + bq + hh * 8) = pack8(oa); *(uint4*)(s1 + bi * SL + bq + hh * 8) = pack8(ob);
                *(uint4*)(s2 + bi * SL + bq + hh * 8) = pack8(ok); *(uint4*)(s3 + bi * SL + bq + hh * 8) = pack8(orr);
            }
            bon += __shfl_xor(bon, 1); bon += __shfl_xor(bon, 2);
            if ((tid & 3) == 0) BON[((size_t)d * RT + rowb) * 8 + h] = bon;
            if (bi == 0) {
#pragma unroll
                for (int e = 0; e < 16; ++e) GAM[bq + e] = __expf(cc[e]);
            }
        }
        __syncthreads();
        {
            R1_IDX const int rowb = scan_row(b, d, c * 64 + bi); (void)rowb;
            f32x4 acc[4]; acc_zero(acc);
            mm64<SL, SL>(s1, s0, acc, wave, fr, fq);
            acc_mask<true>(acc, m, fq);
            st_rm(sa, acc, m, fq); st_tr(sb, acc, m, fq);
#pragma unroll
            for (int nt = 0; nt < 4; ++nt)
#pragma unroll
                for (int r = 0; r < 4; ++r) if (nt * 16 + fq * 4 + r == m) acc[nt][r] += 1.f;
            st_rm(sc, acc, m, fq);
        }
        __syncthreads();
#pragma unroll
        for (int itr = 0; itr < 5; ++itr) {
            R1_IDX
            bf16_t* ptr = (itr & 1) ? sT : sb;
            bf16_t* ptw = (itr & 1) ? sb : sT;
            f32x4 acc[4]; acc_zero(acc);
            mm64<SL, SL>(sa, ptr, acc, wave, fr, fq);
            st_rm(sa, acc, m, fq); st_tr(ptw, acc, m, fq);
            __syncthreads();
            f32x4 tacc[4];
#pragma unroll
            for (int nt = 0; nt < 4; ++nt) { const uint2 u = *(const uint2*)(sc + m * SL + nt * 16 + fq * 4); tacc[nt] = (f32x4){bflo(u.x), bfhi(u.x), bflo(u.y), bfhi(u.y)}; }
            mm64<SL, SL>(sc, ptw, tacc, wave, fr, fq);
            if (itr < 4) st_rm(sc, tacc, m, fq); else st_tr(sb, tacc, m, fq);
        }
        __syncthreads();
        {
            R1_IDX const int rowb = scan_row(b, d, c * 64 + bi); (void)rowb;
            f32x4 acc[4]; acc_zero(acc);
            mm64<SL, SL>(s2, s0, acc, wave, fr, fq);
            acc_mask<true>(acc, m, fq);
            st_rm(sa, acc, m, fq);
            float f0[8], f1[8];
            unpack8(*(const uint4*)(s0 + bi * SL + bq), f0); unpack8(*(const uint4*)(s0 + bi * SL + bq + 8), f1);
#pragma unroll
            for (int e = 0; e < 8; ++e) { sc[(bq + e) * SL + bi] = f2bf(f0[e]); sc[(bq + 8 + e) * SL + bi] = f2bf(f1[e]); }
        }
        __syncthreads();
        {
            R1_IDX const int rowb = scan_row(b, d, c * 64 + bi); (void)rowb;
            f32x4 acc[4]; acc_zero(acc);
            mm64<SL, SL>(sc, sb, acc, wave, fr, fq);
            st_rm(sT, acc, m, fq);
            acc_zero(acc);
            mm64<SL, SL>(sa, sb, acc, wave, fr, fq);
            st_rm(s0, acc, m, fq);
        }
        __syncthreads();
        f32x4 qacc[4];
        {
            R1_IDX const int rowb = scan_row(b, d, c * 64 + bi); (void)rowb;
            f32x4 acc[4]; acc_zero(acc);
            mm64<SL, SL>(s1, s3, acc, wave, fr, fq);
            acc_mask<false>(acc, m, fq);
            st_tr(sa, acc, m, fq);
            acc_zero(qacc);
            mm64<SL, SL>(s2, s3, qacc, wave, fr, fq);
            acc_mask<false>(qacc, m, fq);
            float f0[8], f1[8];
            unpack8(*(const uint4*)(s3 + bi * SL + bq), f0); unpack8(*(const uint4*)(s3 + bi * SL + bq + 8), f1);
#pragma unroll
            for (int e = 0; e < 8; ++e) { sc[(bq + e) * SL + bi] = f2bf(f0[e]); sc[(bq + 8 + e) * SL + bi] = f2bf(f1[e]); }
        }
        __syncthreads();
        {
            R1_IDX const int rowb = scan_row(b, d, c * 64 + bi); (void)rowb;
            f32x4 acc[4];
#pragma unroll
            for (int nt = 0; nt < 4; ++nt) { const uint2 u = *(const uint2*)(sc + m * SL + nt * 16 + fq * 4); acc[nt] = (f32x4){bflo(u.x), bfhi(u.x), bflo(u.y), bfhi(u.y)}; }
            mm64<SL, SL>(sT, sa, acc, wave, fr, fq);
            bf16_t* gt = gGT + (size_t)it * 4096;
#pragma unroll
            for (int nt = 0; nt < 4; ++nt)
#pragma unroll
                for (int r = 0; r < 4; ++r) gt[(nt * 16 + fq * 4 + r) * 64 + m] = f2bf(acc[nt][r]);
            mm64<SL, SL>(s0, sa, qacc, wave, fr, fq);
            st_tr(sb, qacc, m, fq);
            float f0[8], f1[8];
            unpack8(*(const uint4*)(s1 + bi * SL + bq), f0); unpack8(*(const uint4*)(s1 + bi * SL + bq + 8), f1);
#pragma unroll
            for (int e = 0; e < 8; ++e) { s3[(bq + e) * SL + bi] = f2bf(f0[e] * GAM[bq + e]); s3[(bq + 8 + e) * SL + bi] = f2bf(f1[e] * GAM[bq + 8 + e]); }
        }
        __syncthreads();
        {
            R1_IDX const int rowb = scan_row(b, d, c * 64 + bi); (void)rowb;
            f32x4 acc[4]; acc_zero(acc);
            mm64<SL, SL>(sT, s3, acc, wave, fr, fq);
            bf16_t* mt = gMT + (size_t)it * 4096;
#pragma unroll
            for (int nt = 0; nt < 4; ++nt)
#pragma unroll
                for (int r = 0; r < 4; ++r) { const int n = nt * 16 + fq * 4 + r; mt[n * 64 + m] = f2bf(acc[nt][r] + (n == m ? GAM[m] : 0.f)); }
#pragma unroll
            for (int nt = 0; nt < 4; ++nt) {
                const int n = nt * 16 + fq * 4; const uint2 u = *(const uint2*)(s2 + m * SL + n);
                acc[nt] = (f32x4){bflo(u.x) * GAM[n], bfhi(u.x) * GAM[n + 1], bflo(u.y) * GAM[n + 2], bfhi(u.y) * GAM[n + 3]};
            }
            mm64<SL, SL>(s0, s3, acc, wave, fr, fq);
            st_tr(s1, acc, m, fq);
            float v8[8];
#pragma unroll
            for (int hh = 0; hh < 2; ++hh) {
                xs8(P, mu, rowb, 1024 + h * 64 + bq + hh * 8, v8);
#pragma unroll
                for (int e = 0; e < 8; ++e) sc[(bq + hh * 8 + e) * SL + bi] = f2bf(v8[e]);
            }
        }
        __syncthreads();
        {
            R1_IDX const int rowb = scan_row(b, d, c * 64 + bi); (void)rowb;
            f32x4 acc[4]; acc_zero(acc);
            mm64<SL, SL>(sc, sb, acc, wave, fr, fq);
            bf16_t* yl = gYL + (size_t)it * 4096;
#pragma unroll
            for (int nt = 0; nt < 4; ++nt) store_bf16x4(yl + m * 64 + nt * 16 + fq * 4, acc[nt]);
            acc_zero(acc);
            mm64<SL, SL>(sc, s1, acc, wave, fr, fq);
            bf16_t* nl = gNL + (size_t)it * 4096;
#pragma unroll
            for (int nt = 0; nt < 4; ++nt) store_bf16x4(nl + m * 64 + nt * 16 + fq * 4, acc[nt]);
        }
        __syncthreads();
    }
}
__device__ __forceinline__ void ph_r2(const Params& p) {
    const int tid = tidx(), lane = tid & 63, wave = tid >> 6, fr = lane & 15, fq = lane >> 4;
    const bf16_t* gMT = (const bf16_t*)(p.ws + O_X + X_MT); const bf16_t* gNL = (const bf16_t*)(p.ws + O_X + X_NL);
    uint4* gS0 = (uint4*)(p.ws + O_X + X_S0);
    for (int it = blockIdx.x; it < 64; it += gridDim.x) {
        f32x4 st[4];
#pragma unroll
        for (int tt = 0; tt < 4; ++tt) st[tt] = (f32x4){0.f, 0.f, 0.f, 0.f};
        for (int c = 0; c < 68; ++c) {
            const size_t cp = (size_t)it * 68 + c;
            const bf16_t* mt = gMT + cp * 4096; const bf16_t* nl = gNL + cp * 4096;
            uint2 ma[4][2][2], nv[4];
#pragma unroll
            for (int tt = 0; tt < 4; ++tt) {
#pragma unroll
                for (int s = 0; s < 2; ++s) { const bf16_t* q = mt + (tt * 16 + fr) * 64 + s * 32 + fq * 4; ma[tt][s][0] = *(const uint2*)q; ma[tt][s][1] = *(const uint2*)(q + 16); }
                nv[tt] = *(const uint2*)(nl + (wave * 16 + fr) * 64 + tt * 16 + fq * 4);
            }
            uint4 sbv[2];
#pragma unroll
            for (int s = 0; s < 2; ++s) sbv[s] = make_uint4(pack2(st[2 * s][0], st[2 * s][1]), pack2(st[2 * s][2], st[2 * s][3]), pack2(st[2 * s + 1][0], st[2 * s + 1][1]), pack2(st[2 * s + 1][2], st[2 * s + 1][3]));
            gS0[(cp * 4 + wave) * 128 + lane] = sbv[0]; gS0[(cp * 4 + wave) * 128 + 64 + lane] = sbv[1];
#pragma unroll
            for (int tt = 0; tt < 4; ++tt) {
                f32x4 acc = {bflo(nv[tt].x), bfhi(nv[tt].x), bflo(nv[tt].y), bfhi(nv[tt].y)};
#pragma unroll
                for (int s = 0; s < 2; ++s) {
                    const bf16x8 af = __builtin_bit_cast(bf16x8, make_uint4(ma[tt][s][0].x, ma[tt][s][0].y, ma[tt][s][1].x, ma[tt][s][1].y));
                    acc = __builtin_amdgcn_mfma_f32_16x16x32_bf16(af, __builtin_bit_cast(bf16x8, sbv[s]), acc, 0, 0, 0);
                }
                st[tt] = acc;
            }
        }
    }
}
__device__ __forceinline__ void ph_r3(const Params& p) {
    const int tid = tidx(), lane = tid & 63, wave = tid >> 6, fr = lane & 15, fq = lane >> 4;
    const bf16_t* gGT = (const bf16_t*)(p.ws + O_X + X_GT); const bf16_t* gYL = (const bf16_t*)(p.ws + O_X + X_YL);
    const uint4* gS0 = (const uint4*)(p.ws + O_X + X_S0);
    bf16_t* YS = (bf16_t*)(p.ws + O_H);
    for (int it = blockIdx.x; it < NCP; it += gridDim.x) {
        const int c = it % 68, d = (it / 68) & 1, h = (it / 136) & 7, b = it / 1088;
        const bf16_t* gt = gGT + (size_t)it * 4096; const bf16_t* yl = gYL + (size_t)it * 4096;
        const uint4 sb0 = gS0[((size_t)it * 4 + wave) * 128 + lane], sb1 = gS0[((size_t)it * 4 + wave) * 128 + 64 + lane];
#pragma unroll
        for (int tt = 0; tt < 4; ++tt) {
            const uint2 yv = *(const uint2*)(yl + (wave * 16 + fr) * 64 + tt * 16 + fq * 4);
            f32x4 acc = {bflo(yv.x), bfhi(yv.x), bflo(yv.y), bfhi(yv.y)};
#pragma unroll
            for (int s = 0; s < 2; ++s) {
                const bf16_t* q = gt + (tt * 16 + fr) * 64 + s * 32 + fq * 4;
                const uint2 a0 = *(const uint2*)q, a1 = *(const uint2*)(q + 16);
                const bf16x8 af = __builtin_bit_cast(bf16x8, make_uint4(a0.x, a0.y, a1.x, a1.y));
                acc = __builtin_amdgcn_mfma_f32_16x16x32_bf16(af, __builtin_bit_cast(bf16x8, s ? sb1 : sb0), acc, 0, 0, 0);
            }
#pragma unroll
            for (int r = 0; r < 4; ++r) {
                const int row = scan_row(b, d, c * 64 + tt * 16 + fq * 4 + r);
                YS[((size_t)d * RT + row) * 512 + h * 64 + wave * 16 + fr] = f2bf(acc[r]);
            }
        }
    }
}

__device__ __forceinline__ void ph_rpost(const Params& p, int l) {
    const int lane = tidx() & 63, wave = tidx() >> 6;
    const bf16_t* P = (const bf16_t*)(p.ws + O_P); const float* mu = p.in[I_MU] + l * 1792;
    const float* gng = p.in[I_GNG] + l * 512; const float* gnb = p.in[I_GNB] + l * 512;
    const float* BON = (const float*)(p.ws + O_X + X_BON); const bf16_t* YS = (const bf16_t*)(p.ws + O_H);
    const bf16_t* RG = (const bf16_t*)(p.ws + O_RG); bf16_t* RWO = (bf16_t*)(p.ws + O_RWO);
    for (int row = blockIdx.x * 4 + wave; row < RT; row += gridDim.x * 4) {
        const int col = lane * 8, h = lane >> 3;
        float v8[8], g8[8], y0[8], y1[8];
        xs8(P, mu, row, 1024 + col, v8);
        unpack8(*(const uint4*)(RG + (size_t)row * 512 + col), g8);
        unpack8(*(const uint4*)(YS + ((size_t)0 * RT + row) * 512 + col), y0);
        unpack8(*(const uint4*)(YS + ((size_t)1 * RT + row) * 512 + col), y1);
        const float bs = BON[((size_t)0 * RT + row) * 8 + h] + BON[((size_t)1 * RT + row) * 8 + h];
        float y[8]; float sm = 0.f;
#pragma unroll
        for (int j = 0; j < 8; ++j) { y[j] = y0[j] + y1[j]; sm += y[j]; }
        sm += __shfl_xor(sm, 1); sm += __shfl_xor(sm, 2); sm += __shfl_xor(sm, 4);
        const float mean = sm * (1.f / 64.f);
        float vs = 0.f;
#pragma unroll
        for (int j = 0; j < 8; ++j) { const float dlt = y[j] - mean; vs += dlt * dlt; }
        vs += __shfl_xor(vs, 1); vs += __shfl_xor(vs, 2); vs += __shfl_xor(vs, 4);
        const float rstd = rsqrtf(vs * (1.f / 64.f) + 64e-5f);
        float o[8];
#pragma unroll
        for (int j = 0; j < 8; ++j) o[j] = ((y[j] - mean) * rstd * gng[col + j] + gnb[col + j] + bs * v8[j]) * g8[j];
        *(uint4*)(RWO + (size_t)row * 512 + col) = pack8(o);
    }
}

__device__ __forceinline__ void ph_f1(const Params& p, int l, char* smem) {
    const bf16_t* P = (const bf16_t*)(p.ws + O_P); const bf16_t* CSC = (const bf16_t*)(p.ws + O_CSC);
    bf16_t* YT = (bf16_t*)(p.ws + O_X + X_YT); bf16_t* YTC = (bf16_t*)(p.ws + O_X + X_YTC);
    const int nitems = 1024 + (l < NLAYER - 1 ? 64 : 0);
    for (int it = blockIdx.x; it < nitems; it += gridDim.x) {
        f32x4 acc[4][4];
        if (it < 1024) {
            const int b = it >> 8, g = (it >> 6) & 3, mt = (it >> 5) & 1, nt = it & 31;
            ALPlain al(CSC, 128, mt * 128);
            gemm_core<4>(al, P + (size_t)(b * SEQ + nt * 128) * LDP + g * 128, LDP, 128, acc, smem);
            acc_foreach<4>(acc, [&](int m, int n, const f32x4& v) {
                store_bf16x4(YT + ((size_t)(b * 512 + g * 128 + m)) * 8192 + mt * 4096 + nt * 128 + n, v);
            });
        } else {
            const int j = it - 1024, b = j >> 4, g = (j >> 2) & 3, mt = (j >> 1) & 1, nt = j & 1;
            ALPlain al(CSC, 128, mt * 128);
            gemm_core<4>(al, P + (size_t)(RL + b * CTX + nt * 128) * LDP + g * 128, LDP, 128, acc, smem);
            acc_foreach<4>(acc, [&](int m, int n, const f32x4& v) {
                store_bf16x4(YTC + ((size_t)(b * 512 + g * 128 + m)) * 512 + mt * 256 + nt * 128 + n, v);
            });
        }
    }
}
__device__ __forceinline__ void ph_f2(const Params& p, int l, char* smem) {
    const bf16_t* CST = (const bf16_t*)(p.ws + O_CST); const bf16_t* CST2 = (const bf16_t*)(p.ws + O_CST256);
    const bf16_t* YT = (const bf16_t*)(p.ws + O_X + X_YT); const bf16_t* YTC = (const bf16_t*)(p.ws + O_X + X_YTC);
    bf16_t* FA = (bf16_t*)(p.ws + O_FA);
    const int nitems = 512 + (l < NLAYER - 1 ? 32 : 0);
    for (int it = blockIdx.x; it < nitems; it += gridDim.x) {
        f32x4 acc[4][4];
        if (it < 512) {
            const int b = it >> 7, mt = (it >> 2) & 31, nt = it & 3;
            ALPlain al(CST, 8192, mt * 128);
            gemm_core<4>(al, YT + ((size_t)b * 512 + nt * 128) * 8192, 8192, 8192, acc, smem);
            const float sc = 0.001381067932004975f;
            acc_foreach<4>(acc, [&](int m, int n, const f32x4& v) { f32x4 o = v * sc; store_bf16x4(FA + (size_t)(b * SEQ + mt * 128 + m) * 512 + nt * 128 + n, o); });
        } else {
            const int j = it - 512, b = j >> 3, mt = (j >> 2) & 1, nt = j & 3;
            ALPlain al(CST2, 512, mt * 128);
            gemm_core<4>(al, YTC + ((size_t)b * 512 + nt * 128) * 512, 512, 512, acc, smem);
            const float sc = 0.005524271728019903f;
            acc_foreach<4>(acc, [&](int m, int n, const f32x4& v) { f32x4 o = v * sc; store_bf16x4(FA + (size_t)(RL + b * CTX + mt * 128 + m) * 512 + nt * 128 + n, o); });
        }
    }
}

__device__ __forceinline__ void ph_mg(const Params& p, int l, char* smem) {
    const bf16_t* P = (const bf16_t*)(p.ws + O_P);
    const bf16_t* A[3] = {(const bf16_t*)(p.ws + O_FA), (const bf16_t*)(p.ws + O_ATT), (const bf16_t*)(p.ws + O_RWO)};
    const bf16_t* W[3] = {(const bf16_t*)(p.ws + O_WB + W_PA), (const bf16_t*)(p.ws + O_WB + W_PB), (const bf16_t*)(p.ws + O_WB + W_PC)};
    bf16_t* MG = (bf16_t*)(p.ws + O_H);
    const int nmt = (l < NLAYER - 1) ? RT / 64 : RL / 64;
    for (int it = blockIdx.x; it < nmt * 8; it += gridDim.x) {
        const int mt = it >> 3, nt = it & 7;
        f32x4 tot[2][4];
#pragma unroll
        for (int i = 0; i < 2; ++i)
#pragma unroll
            for (int j = 0; j < 4; ++j) tot[i][j] = (f32x4){0.f, 0.f, 0.f, 0.f};
#pragma unroll
        for (int br = 0; br < 3; ++br) {
            f32x4 acc[2][4];
            ALPlain al(A[br], 512, mt * 64);
            gemm_core<2>(al, W[br] + (size_t)nt * 128 * 512, 512, 512, acc, smem);
            const int lane = tidx() & 63, wave = tidx() >> 6, wr = wave >> 1, wc = wave & 1, fr = lane & 15, fq = lane >> 4;
#pragma unroll
            for (int i = 0; i < 2; ++i)
#pragma unroll
                for (int j = 0; j < 4; ++j) {
                    const int m = wr * 32 + i * 16 + fr, n = wc * 64 + j * 16 + fq * 4;
                    const uint2 gu = *(const uint2*)(P + (size_t)(mt * 64 + m) * LDP + PG0 + br * 1024 + nt * 128 + n);
                    tot[i][j][0] += bflo(gu.x) * acc[i][j][0]; tot[i][j][1] += bfhi(gu.x) * acc[i][j][1];
                    tot[i][j][2] += bflo(gu.y) * acc[i][j][2]; tot[i][j][3] += bfhi(gu.y) * acc[i][j][3];
                }
        }
        acc_foreach<2>(tot, [&](int m, int n, const f32x4& v) { store_bf16x4(MG + (size_t)(mt * 64 + m) * 1024 + nt * 128 + n, v); });
    }
}
__device__ __forceinline__ void ph_out(const Params& p, int l, char* smem) {
    const bf16_t* MG = (const bf16_t*)(p.ws + O_H); const bf16_t* W = (const bf16_t*)(p.ws + O_WB + W_OUT);
    float* xcur = (float*)(p.ws + O_XCUR); const float* mod = (const float*)(p.ws + O_MOD);
    const int nmt = (l < NLAYER - 1) ? RT / 128 : RL / 128;
    for (int it = blockIdx.x; it < nmt * 8; it += gridDim.x) {
        const int mt = it >> 3, nt = it & 7;
        f32x4 acc[4][4];
        ALPlain al(MG, 1024, mt * 128);
        gemm_core<4>(al, W + (size_t)nt * 128 * 1024, 1024, 1024, acc, smem);
        acc_foreach<4>(acc, [&](int m, int n, const f32x4& v) {
            const int row = mt * 128 + m, col = nt * 128 + n;
            const float4 g = *(const float4*)(mod + (size_t)(l * 5 + modidx(row)) * 6144 + 2048 + col);
            float4* xp = (float4*)(xcur + (size_t)row * 1024 + col);
            float4 x = *xp; x.x += g.x * v[0]; x.y += g.y * v[1]; x.z += g.z * v[2]; x.w += g.w * v[3]; *xp = x;
        });
    }
}

__device__ __forceinline__ void ph_n2(const Params& p, int l) {
    const int lane = tidx() & 63, wave = tidx() >> 6;
    const float* xcur = (const float*)(p.ws + O_XCUR); const float* mod = (const float*)(p.ws + O_MOD);
    bf16_t* H = (bf16_t*)(p.ws + O_H);
    unsigned* cnt = (unsigned*)(p.ws + O_CNT); int* LTOK = (int*)(p.ws + O_LTOK); float* LW = (float*)(p.ws + O_LW); int* SLOT = (int*)(p.ws + O_SLOT);
    const float* g = p.in[I_N2G] + l * 1024; const float* rw = p.in[I_RW]; const float* rb = p.in[I_RB];
    const int nrows = (l < NLAYER - 1) ? RT : RL;
    for (int row = blockIdx.x * 4 + wave; row < nrows; row += gridDim.x * 4) {
        const float* x = xcur + (size_t)row * 1024; const float* md = mod + (size_t)(l * 5 + modidx(row)) * 6144;
        float4 v[4]; float ss = 0.f;
#pragma unroll
        for (int i = 0; i < 4; ++i) { v[i] = *(const float4*)(x + lane * 4 + 256 * i); ss += v[i].x * v[i].x + v[i].y * v[i].y + v[i].z * v[i].z + v[i].w * v[i].w; }
        ss = wsum(ss);
        const float rstd = rsqrtf(ss * (1.f / 1024.f) + 1e-6f);
        float lg[16];
#pragma unroll
        for (int e = 0; e < 16; ++e) lg[e] = 0.f;
#pragma unroll
        for (int i = 0; i < 4; ++i) {
            const int c = lane * 4 + 256 * i;
            const float4 gg = *(const float4*)(g + c), sc = *(const float4*)(md + 4096 + c), sh = *(const float4*)(md + 3072 + c);
            const float hv[4] = {v[i].x * rstd * gg.x * (1.f + sc.x) + sh.x, v[i].y * rstd * gg.y * (1.f + sc.y) + sh.y,
                                 v[i].z * rstd * gg.z * (1.f + sc.z) + sh.z, v[i].w * rstd * gg.w * (1.f + sc.w) + sh.w};
            f32x4 h4 = {hv[0], hv[1], hv[2], hv[3]};
            store_bf16x4(H + (size_t)row * 1024 + c, h4);
#pragma unroll
            for (int j = 0; j < 4; ++j) {
                const float* wr_ = rw + (size_t)(c + j) * 16;
                const float4 w0 = *(const float4*)wr_, w1 = *(const float4*)(wr_ + 4), w2 = *(const float4*)(wr_ + 8), w3 = *(const float4*)(wr_ + 12);
                lg[0] += hv[j] * w0.x; lg[1] += hv[j] * w0.y; lg[2] += hv[j] * w0.z; lg[3] += hv[j] * w0.w;
                lg[4] += hv[j] * w1.x; lg[5] += hv[j] * w1.y; lg[6] += hv[j] * w1.z; lg[7] += hv[j] * w1.w;
                lg[8] += hv[j] * w2.x; lg[9] += hv[j] * w2.y; lg[10] += hv[j] * w2.z; lg[11] += hv[j] * w2.w;
                lg[12] += hv[j] * w3.x; lg[13] += hv[j] * w3.y; lg[14] += hv[j] * w3.z; lg[15] += hv[j] * w3.w;
            }
        }
        float sc_[16], sel[16];
#pragma unroll
        for (int e = 0; e < 16; ++e) { lg[e] = wsum(lg[e]); sc_[e] = 1.f / (1.f + expf(-lg[e])); sel[e] = sc_[e] + rb[e]; }
        int best = 0; float bestv = -1e30f;
#pragma unroll
        for (int gi = 0; gi < 4; ++gi) {
            float m1 = -1e30f, m2 = -1e30f;
#pragma unroll
            for (int j = 0; j < 4; ++j) { const float s = sel[gi * 4 + j]; if (s > m1) { m2 = m1; m1 = s; } else if (s > m2) m2 = s; }
            const float gs = m1 + m2;
            if (gs > bestv) { bestv = gs; best = gi; }
        }
        float s4[4] = {0.f, 0.f, 0.f, 0.f}, c4[4] = {0.f, 0.f, 0.f, 0.f};
#pragma unroll
        for (int gi = 0; gi < 4; ++gi)
#pragma unroll
            for (int j = 0; j < 4; ++j) if (gi == best) { s4[j] = sel[gi * 4 + j]; c4[j] = sc_[gi * 4 + j]; }
        int i1 = 0; float v1 = s4[0], w1 = c4[0];
#pragma unroll
        for (int j = 1; j < 4; ++j) if (s4[j] > v1) { v1 = s4[j]; i1 = j; w1 = c4[j]; }
        int i2 = -1; float v2 = -1e30f, w2 = 0.f;
#pragma unroll
        for (int j = 0; j < 4; ++j) if (j != i1 && s4[j] > v2) { v2 = s4[j]; i2 = j; w2 = c4[j]; }
        if (lane == 0) {
            const float inv = 1.f / (w1 + w2);
            const int e1 = best * 4 + i1, e2 = best * 4 + i2;
            const unsigned p1 = atomicAdd(&cnt[e1], 1u), p2 = atomicAdd(&cnt[e2], 1u);
            LTOK[(size_t)e1 * RT + p1] = row; LW[(size_t)e1 * RT + p1] = w1 * inv;
            LTOK[(size_t)e2 * RT + p2] = row; LW[(size_t)e2 * RT + p2] = w2 * inv;
            SLOT[row * 2] = (e1 << 20) | (int)p1; SLOT[row * 2 + 1] = (e2 << 20) | (int)p2;
        }
    }
}

struct MoeTiles { int tb[17]; int sm; };
__device__ __forceinline__ void moe_tiles(const Params& p, int l, int* s_tb) {
    if (tidx() == 0) {
        const unsigned* cnt = (const unsigned*)(p.ws + O_CNT);
        int a = 0;
        for (int e = 0; e < 16; ++e) { s_tb[e] = a; a += ((int)cnt[e] + 127) >> 7; }
        s_tb[16] = a;
    }
    __syncthreads();
}
struct ALGather {
    const bf16_t* p[2]; bool ok[2];
    __device__ __forceinline__ uint4 load(int i, int k) const { return ok[i] ? *(const uint4*)(p[i] + k) : make_uint4(0u, 0u, 0u, 0u); }
};
struct ALSwiglu {
    const bf16_t* p[2]; float w[2];
    __device__ __forceinline__ uint4 load(int i, int k) const {
        float g[8], u[8], o[8]; unpack8(*(const uint4*)(p[i] + k), g); unpack8(*(const uint4*)(p[i] + 512 + k), u);
#pragma unroll
        for (int j = 0; j < 8; ++j) o[j] = siluf_(g[j]) * u[j] * w[i];
        return pack8(o);
    }
};
__device__ __forceinline__ void ph_e1(const Params& p, int l, char* smem) {
    int* s_tb = (int*)(smem + 48 * 1024);
    moe_tiles(p, l, s_tb);
    const bf16_t* H = (const bf16_t*)(p.ws + O_H); bf16_t* GU = (bf16_t*)(p.ws + O_P);
    const unsigned* cnt = (const unsigned*)(p.ws + O_CNT); const int* LTOK = (const int*)(p.ws + O_LTOK);
    const int sm = (l < NLAYER - 1) ? RT / 128 : RL / 128;
    const int total = (sm + s_tb[16]) * 8;
    for (int it = blockIdx.x; it < total; it += gridDim.x) {
        const int mt = it >> 3, nt = it & 7;
        int e = 16, erow0 = mt * 128, lt = 0;
        if (mt >= sm) { const int q = mt - sm; e = 0; while (q >= s_tb[e + 1]) ++e; lt = q - s_tb[e]; erow0 = RT + q * 128; }
        ALGather al;
#pragma unroll
        for (int i = 0; i < 2; ++i) {
            const int r = (tidx() >> 2) + 64 * i;
            if (e == 16) { al.ok[i] = true; al.p[i] = H + (size_t)(mt * 128 + r) * 1024; }
            else { const int idx = lt * 128 + r; al.ok[i] = idx < (int)cnt[e]; const int tok = al.ok[i] ? LTOK[(size_t)e * RT + idx] : 0; al.p[i] = H + (size_t)tok * 1024; }
        }
        f32x4 acc[4][4];
        gemm_core<4>(al, (const bf16_t*)(p.ws + O_WB + W_GU) + (size_t)e * 1024 * 1024 + (size_t)nt * 128 * 1024, 1024, 1024, acc, smem);
        acc_foreach<4>(acc, [&](int m, int n, const f32x4& v) { store_bf16x4(GU + (size_t)(erow0 + m) * 1024 + nt * 128 + n, v); });
    }
}
__device__ __forceinline__ void ph_e2(const Params& p, int l, char* smem) {
    int* s_tb = (int*)(smem + 48 * 1024);
    moe_tiles(p, l, s_tb);
    const bf16_t* GU = (const bf16_t*)(p.ws + O_P); bf16_t* YE = (bf16_t*)(p.ws + O_X + X_YE);
    const unsigned* cnt = (const unsigned*)(p.ws + O_CNT); const float* LW = (const float*)(p.ws + O_LW);
    const int sm = (l < NLAYER - 1) ? RT / 128 : RL / 128;
    const int total = (sm + s_tb[16]) * 8;
    for (int it = blockIdx.x; it < total; it += gridDim.x) {
        const int mt = it >> 3, nt = it & 7;
        int e = 16, erow0 = mt * 128, lt = 0;
        if (mt >= sm) { const int q = mt - sm; e = 0; while (q >= s_tb[e + 1]) ++e; lt = q - s_tb[e]; erow0 = RT + q * 128; }
        ALSwiglu al;
#pragma unroll
        for (int i = 0; i < 2; ++i) {
            const int r = (tidx() >> 2) + 64 * i;
            al.p[i] = GU + (size_t)(erow0 + r) * 1024;
            if (e == 16) al.w[i] = 1.f;
            else { const int idx = lt * 128 + r; al.w[i] = idx < (int)cnt[e] ? LW[(size_t)e * RT + idx] : 0.f; }
        }
        f32x4 acc[4][4];
        gemm_core<4>(al, (const bf16_t*)(p.ws + O_WB + W_D) + (size_t)e * 1024 * 512 + (size_t)nt * 128 * 512, 512, 512, acc, smem);
        acc_foreach<4>(acc, [&](int m, int n, const f32x4& v) { store_bf16x4(YE + (size_t)(erow0 + m) * 1024 + nt * 128 + n, v); });
    }
}
__device__ __forceinline__ void ph_e3(const Params& p, int l, char* smem) {
    int* s_tb = (int*)(smem + 48 * 1024);
    moe_tiles(p, l, s_tb);
    const int lane = tidx() & 63, wave = tidx() >> 6;
    const bf16_t* YE = (const bf16_t*)(p.ws + O_X + X_YE); const int* SLOT = (const int*)(p.ws + O_SLOT);
    float* xcur = (float*)(p.ws + O_XCUR); const float* mod = (const float*)(p.ws + O_MOD);
    const int nrows = (l < NLAYER - 1) ? RT : RL;
    for (int row = blockIdx.x * 4 + wave; row < nrows; row += gridDim.x * 4) {
        const int s1 = SLOT[row * 2], s2 = SLOT[row * 2 + 1];
        const size_t r0 = row, r1 = (size_t)RT + s_tb[s1 >> 20] * 128 + (s1 & 0xfffff), r2 = (size_t)RT + s_tb[s2 >> 20] * 128 + (s2 & 0xfffff);
        const float* g2 = mod + (size_t)(l * 5 + modidx(row)) * 6144 + 5120;
#pragma unroll
        for (int i = 0; i < 2; ++i) {
            const int c = lane * 8 + 512 * i;
            float a[8], b[8], d[8];
            unpack8(*(const uint4*)(YE + r0 * 1024 + c), a); unpack8(*(const uint4*)(YE + r1 * 1024 + c), b); unpack8(*(const uint4*)(YE + r2 * 1024 + c), d);
            float4* xp = (float4*)(xcur + (size_t)row * 1024 + c);
            float4 x0 = xp[0], x1 = xp[1];
            const float4 ga = *(const float4*)(g2 + c), gb = *(const float4*)(g2 + c + 4);
            x0.x += ga.x * (a[0] + b[0] + d[0]); x0.y += ga.y * (a[1] + b[1] + d[1]); x0.z += ga.z * (a[2] + b[2] + d[2]); x0.w += ga.w * (a[3] + b[3] + d[3]);
            x1.x += gb.x * (a[4] + b[4] + d[4]); x1.y += gb.y * (a[5] + b[5] + d[5]); x1.z += gb.z * (a[6] + b[6] + d[6]); x1.w += gb.w * (a[7] + b[7] + d[7]);
            xp[0] = x0; xp[1] = x1;
        }
    }
}
__device__ __forceinline__ void ph_final(const Params& p) {
    const int lane = tidx() & 63, wave = tidx() >> 6;
    const float* xcur = (const float*)(p.ws + O_XCUR); const float* g = p.in[I_FNG];
    for (int row = blockIdx.x * 4 + wave; row < RL; row += gridDim.x * 4) {
        const float* x = xcur + (size_t)row * 1024;
        float4 v[4]; float ss = 0.f;
#pragma unroll
        for (int i = 0; i < 4; ++i) { v[i] = *(const float4*)(x + lane * 4 + 256 * i); ss += v[i].x * v[i].x + v[i].y * v[i].y + v[i].z * v[i].z + v[i].w * v[i].w; }
        ss = wsum(ss);
        const float rstd = rsqrtf(ss * (1.f / 1024.f) + 1e-6f);
#pragma unroll
        for (int i = 0; i < 4; ++i) {
            const int c = lane * 4 + 256 * i; const float4 gg = *(const float4*)(g + c);
            *(float4*)(p.out + (size_t)row * 1024 + c) = make_float4(v[i].x * rstd * gg.x, v[i].y * rstd * gg.y, v[i].z * rstd * gg.z, v[i].w * rstd * gg.w);
        }
    }
}

constexpr int LDS_BYTES = 76800;
constexpr int NIV = 19;
extern __shared__ __attribute__((aligned(16))) char dynsmem[];
template <int ID> __device__ __forceinline__ void run_iv(const Params& pin, int l, char* smem) {
    Params p = pin; p.ws = launder(pin.ws);
    if constexpr (ID == 0) { ph_pre(p, smem); __syncthreads(); ph_w(p, 0, smem); }
    else if constexpr (ID == 1) ph_n1(p, l);
    else if constexpr (ID == 2) ph_g1(p, smem);
    else if constexpr (ID == 3) ph_qu(p, smem);
    else if constexpr (ID == 4) ph_m2(p);
    else if constexpr (ID == 5) ph_at(p, l, smem);
    else if constexpr (ID == 6) { ph_rp1(p, l, smem); ph_rp2(p, l); }
    else if constexpr (ID == 7) ph_r1(p, l, smem);
    else if constexpr (ID == 8) ph_r2(p);
    else if constexpr (ID == 9) ph_r3(p);
    else if constexpr (ID == 10) { ph_rpost(p, l); ph_f1(p, l, smem); }
    else if constexpr (ID == 11) ph_f2(p, l, smem);
    else if constexpr (ID == 12) ph_mg(p, l, smem);
    else if constexpr (ID == 13) ph_out(p, l, smem);
    else if constexpr (ID == 14) ph_n2(p, l);
    else if constexpr (ID == 15) ph_e1(p, l, smem);
    else if constexpr (ID == 16) ph_e2(p, l, smem);
    else if constexpr (ID == 17) { ph_e3(p, l, smem); __syncthreads(); if (l + 1 < NLAYER) ph_w(p, l + 1, smem); }
    else ph_final(p);
}
#if MEGA
#ifndef PROBE_ID
#define PROBE_ID -1
#define PROBE_REP 1
#endif
#define IV(ID) for (int r_ = 0; r_ < ((ID) == PROBE_ID ? PROBE_REP : 1); ++r_) { run_iv<ID>(p, l, smem); xcd_barrier(bar); }
__global__ void __launch_bounds__(256, 2) k_mega(Params p) {
    char* smem = dynsmem;
    volatile LAS unsigned* st = (volatile LAS unsigned*)(smem + LDS_BYTES - 16);
    if (tidx() == 0) { st[0] = 0u; st[1] = 0u; }
    __syncthreads();
    XcdBarrier bar = xcd_barrier_post((unsigned*)(p.ws + O_BAR), st);
    { const int l = 0; IV(0) }
    for (int l = 0; l < NLAYER; ++l) {
        IV(1) IV(2) IV(3) IV(4) IV(5) IV(6) IV(7) IV(8) IV(9) IV(10) IV(11) IV(12) IV(13) IV(14) IV(15) IV(16) IV(17)
    }
    run_iv<18>(p, 0, smem);
}
#else
template <int ID> __global__ void __launch_bounds__(256, 2) k_iv(Params p, int l) { run_iv<ID>(p, l, dynsmem); }
template <int ID> static void launch_iv(const Params& p, int l, int grid, hipStream_t s) {
    static bool once = false; if (!once) { once = true; (void)hipFuncSetAttribute((const void*)k_iv<ID>, hipFuncAttributeMaxDynamicSharedMemorySize, LDS_BYTES); }
    hipLaunchKernelGGL(k_iv<ID>, dim3(grid), dim3(256), LDS_BYTES, s, p, l);
}
#endif

extern "C" void kernel_launch(void* const* d_in, const int* in_sizes, int n_in, void* d_out, int out_size, void* d_ws, size_t ws_size, hipStream_t stream) {
    (void)in_sizes; (void)out_size;
    if (n_in < N_IN || ws_size < WS_NEED) return;
    Params p{};
    for (int i = 0; i < N_IN; ++i) p.in[i] = (const float*)d_in[i];
    p.out = (float*)d_out; p.ws = (char*)d_ws;
    static int grid = 0;
    if (!grid) {
        int dev = 0, cus = 0; (void)hipGetDevice(&dev); (void)hipDeviceGetAttribute(&cus, hipDeviceAttributeMultiprocessorCount, dev);
        int per_cu = 2;
#if MEGA
        (void)hipFuncSetAttribute((const void*)k_mega, hipFuncAttributeMaxDynamicSharedMemorySize, LDS_BYTES);
        int occ = 0; (void)hipOccupancyMaxActiveBlocksPerMultiprocessor(&occ, k_mega, 256, LDS_BYTES);
        if (occ < per_cu) per_cu = occ;
        if (per_cu < 1) per_cu = 1;
#endif
        grid = cus * per_cu;
    }
#if MEGA
    (void)hipMemsetAsync(p.ws + O_BAR, 0, 16384, stream);
    hipLaunchKernelGGL(k_mega, dim3(grid), dim3(256), LDS_BYTES, stream, p);
#else
    launch_iv<0>(p, 0, grid, stream);
    for (int l = 0; l < NLAYER; ++l) {
        launch_iv<1>(p, l, grid, stream); launch_iv<2>(p, l, grid, stream); launch_iv<3>(p, l, grid, stream); launch_iv<4>(p, l, grid, stream);
        launch_iv<5>(p, l, grid, stream); launch_iv<6>(p, l, grid, stream); launch_iv<7>(p, l, grid, stream); launch_iv<8>(p, l, grid, stream);
        launch_iv<9>(p, l, grid, stream); launch_iv<10>(p, l, grid, stream); launch_iv<11>(p, l, grid, stream); launch_iv<12>(p, l, grid, stream);
        launch_iv<13>(p, l, grid, stream); launch_iv<14>(p, l, grid, stream); launch_iv<15>(p, l, grid, stream); launch_iv<16>(p, l, grid, stream); launch_iv<17>(p, l, grid, stream);
    }
    launch_iv<18>(p, 0, grid, stream);
#endif
}
```

```cpp
#include <hip/hip_runtime.h>
#include <stdint.h>

#ifndef MEGA
#define MEGA 1
#endif

typedef unsigned short bf16_t;
typedef short bf16x8 __attribute__((ext_vector_type(8)));
typedef float f32x4 __attribute__((ext_vector_type(4)));
typedef float f32x2 __attribute__((ext_vector_type(2)));
typedef unsigned u32x4 __attribute__((ext_vector_type(4)));
typedef __bf16 bf16v2 __attribute__((ext_vector_type(2)));

constexpr int NLAYER = 4;
constexpr int DM = 1024;
constexpr int RL = 16384, RC = 1024, RT = RL + RC;
constexpr int SEQ = 4096, CTX = 256, KEYS = SEQ + CTX;
constexpr int LDP = 6144;
constexpr int PQ0 = 512, PKV0 = 896, PKR0 = 1152, PR0 = 1184, PG0 = 2976, PEND = 6048;
constexpr int NEXP = 16;
constexpr int EROWS = 54272;

enum { I_X = 0, I_C, I_CTX, I_CCTX, I_WADA, I_BADA, I_N1G, I_N2G, I_WIN, I_QNG, I_KVNG, I_WUQ, I_WUKV, I_MU, I_W0, I_WUP, I_A0, I_AUP, I_GUP,
       I_KK, I_KA, I_RK, I_GNG, I_GNB, I_WPA, I_WPB, I_WPC, I_WOUT, I_RW, I_RB, I_EG, I_EU, I_ED, I_SG, I_SU, I_SD, I_FNG, N_IN };

struct Params { const float* in[N_IN]; float* out; char* ws; };

constexpr size_t al256(size_t x) { return (x + 255) & ~(size_t)255; }
constexpr size_t O_BAR   = 0;
constexpr size_t O_CNT   = O_BAR + 16384;
constexpr size_t O_MOD   = O_CNT + 4096;
constexpr size_t O_ROPEC = O_MOD + (size_t)NLAYER * 5 * 6144 * 4;
constexpr size_t O_ROPES = O_ROPEC + (size_t)SEQ * 16 * 4;
constexpr size_t O_CSC   = O_ROPES + (size_t)SEQ * 16 * 4;
constexpr size_t O_CST256= O_CSC + 256 * 128 * 2;
constexpr size_t O_CST   = O_CST256 + 256 * 512 * 2;
constexpr size_t O_XCUR  = O_CST + (size_t)4096 * 8192 * 2;
constexpr size_t O_WB    = O_XCUR + (size_t)RT * DM * 4;
constexpr size_t W_IN   = 0;
constexpr size_t W_UQ   = W_IN + (size_t)6144 * 1024 * 2;
constexpr size_t W_UKV  = W_UQ + (size_t)768 * 384 * 2;
constexpr size_t W_WUP  = W_UKV + (size_t)1024 * 256 * 2;
constexpr size_t W_AUP  = W_WUP + (size_t)2 * 512 * 64 * 2;
constexpr size_t W_GUP  = W_AUP + (size_t)2 * 512 * 64 * 2;
constexpr size_t W_PA   = W_GUP + (size_t)512 * 128 * 2;
constexpr size_t W_PB   = W_PA + (size_t)1024 * 512 * 2;
constexpr size_t W_PC   = W_PB + (size_t)1024 * 512 * 2;
constexpr size_t W_OUT  = W_PC + (size_t)1024 * 512 * 2;
constexpr size_t W_GU   = W_OUT + (size_t)1024 * 1024 * 2;
constexpr size_t W_D    = W_GU + (size_t)17 * 1024 * 1024 * 2;
constexpr size_t W_END  = W_D + (size_t)17 * 1024 * 512 * 2;
constexpr size_t O_H    = O_WB + W_END;
constexpr size_t O_P    = O_H + (size_t)RT * DM * 2;
constexpr size_t O_ATT  = O_P + (size_t)RT * LDP * 2;
constexpr size_t O_RG   = O_ATT + (size_t)RT * 512 * 2;
constexpr size_t O_RWO  = O_RG + (size_t)RT * 512 * 2;
constexpr size_t O_FA   = O_RWO + (size_t)RT * 512 * 2;
constexpr size_t O_LTOK = O_FA + (size_t)RT * 512 * 2;
constexpr size_t O_LW   = O_LTOK + (size_t)NEXP * RT * 4;
constexpr size_t O_SLOT = O_LW + (size_t)NEXP * RT * 4;
constexpr size_t O_X    = al256(O_SLOT + (size_t)RT * 2 * 4);
constexpr size_t X_QRAW = 0;
constexpr size_t X_KVRAW= X_QRAW + (size_t)RT * 768 * 2;
constexpr size_t X_QA   = X_KVRAW + (size_t)RT * 1024 * 2;
constexpr size_t X_KA   = X_QA + (size_t)RT * 768 * 2;
constexpr size_t X_VA   = X_KA + (size_t)4 * KEYS * 768 * 2;
constexpr int NCP = 4 * 8 * 2 * 68;
constexpr size_t X_MT   = 0;
constexpr size_t X_NL   = X_MT + (size_t)NCP * 8192;
constexpr size_t X_GT   = X_NL + (size_t)NCP * 8192;
constexpr size_t X_YL   = X_GT + (size_t)NCP * 8192;
constexpr size_t X_S0   = X_YL + (size_t)NCP * 8192;
constexpr size_t X_KKN  = X_S0 + (size_t)NCP * 8192;
constexpr size_t X_BON  = X_KKN + (size_t)RT * 8 * 4;
constexpr size_t X_END  = X_BON + (size_t)2 * RT * 8 * 4;
constexpr size_t X_YT   = 0;
constexpr size_t X_YTC  = X_YT + (size_t)4 * 512 * 8192 * 2;
constexpr size_t X_YE   = 0;
constexpr size_t WS_NEED = O_X + X_END;

__device__ __forceinline__ float bf2f(bf16_t u) { return __builtin_bit_cast(float, (unsigned)u << 16); }
__device__ __forceinline__ float bflo(unsigned u) { return __builtin_bit_cast(float, u << 16); }
__device__ __forceinline__ float bfhi(unsigned u) { return __builtin_bit_cast(float, u & 0xffff0000u); }
__device__ __forceinline__ unsigned pack2(float lo, float hi) { f32x2 v = {lo, hi}; bf16v2 b = __builtin_convertvector(v, bf16v2); return __builtin_bit_cast(unsigned, b); }
__device__ __forceinline__ bf16_t f2bf(float f) { return (bf16_t)(pack2(f, 0.f) & 0xffffu); }
__device__ __forceinline__ float wsum(float v) {
#pragma unroll
    for (int o = 32; o > 0; o >>= 1) v += __shfl_xor(v, o);
    return v;
}
__device__ __forceinline__ float sigmoidf_(float x) { return 1.f / (1.f + __expf(-x)); }
__device__ __forceinline__ float siluf_(float x) { return x / (1.f + __expf(-x)); }
__device__ __forceinline__ int modidx(int row) { return row < RL ? (row >> 12) : 4; }
__device__ __forceinline__ void unpack8(const uint4& u, float (&f)[8]) {
    f[0] = bflo(u.x); f[1] = bfhi(u.x); f[2] = bflo(u.y); f[3] = bfhi(u.y); f[4] = bflo(u.z); f[5] = bfhi(u.z); f[6] = bflo(u.w); f[7] = bfhi(u.w);
}
__device__ __forceinline__ uint4 pack8(const float (&f)[8]) { return make_uint4(pack2(f[0], f[1]), pack2(f[2], f[3]), pack2(f[4], f[5]), pack2(f[6], f[7])); }

#define XB_TMO      128
#define XB_XCNT(j)  (256  + 64 * (j))
#define XB_XSUB(j)  (1280 + 64 * (j))
#define XB_XGEN(j)  (2304 + 64 * (j))
#define XB_TOP      3328
#define XB_TOPGEN   3392
#define XCD_BAR_WORDS 3456
#define XB_SPIN_CAP (1u << 22)
#define LAS __attribute__((address_space(3)))
__device__ __forceinline__ unsigned xb_ld(unsigned* p)              { return __hip_atomic_load(p, __ATOMIC_RELAXED, __HIP_MEMORY_SCOPE_AGENT); }
__device__ __forceinline__ unsigned xb_add(unsigned* p, unsigned v) { return __hip_atomic_fetch_add(p, v, __ATOMIC_RELAXED, __HIP_MEMORY_SCOPE_AGENT); }
__device__ __forceinline__ unsigned xb_xcc_id() { return (unsigned)__builtin_amdgcn_s_getreg((3 << 11) | 20) & 0xFu; }
#define XB_SPIN(cond, bar) do { unsigned _sp = 0; while (cond) { __builtin_amdgcn_s_sleep(1); \
    if ((++_sp & 255u) == 0u) { if (xb_ld(&(bar)[XB_TMO])) break; if (_sp > XB_SPIN_CAP) { atomicAdd(&(bar)[XB_TMO], 1u); break; } } } } while (0)
struct XcdBarrier { unsigned* bar; unsigned x; volatile LAS unsigned* st; };
__device__ __forceinline__ XcdBarrier xcd_barrier_post(unsigned* bar, volatile LAS unsigned* st) {
    XcdBarrier b; b.bar = bar; b.x = xb_xcc_id(); b.st = st;
    if (threadIdx.x == 0) (void)xb_add(&bar[XB_XCNT(b.x)], 1u);
    return b;
}
__device__ __forceinline__ void xcd_barrier_complete(unsigned* bar, unsigned x, unsigned& nloc, unsigned& nx) {
    const unsigned G = gridDim.x * gridDim.y * gridDim.z;
    unsigned sum, cnt, mine, sp = 0u;
    for (;;) {
        sum = 0u; cnt = 0u; mine = 0u;
#pragma unroll
        for (unsigned j = 0; j < 16; ++j) { const unsigned c = xb_ld(&bar[XB_XCNT(j)]); sum += c; cnt += (c > 0u) ? 1u : 0u; mine = (j == x) ? c : mine; }
        if (sum == G) break;
        __builtin_amdgcn_s_sleep(1);
        if ((++sp & 255u) == 0u) { if (xb_ld(&bar[XB_TMO])) break; if (sp > XB_SPIN_CAP) { atomicAdd(&bar[XB_TMO], 1u); break; } }
    }
    nloc = mine > 0u ? mine : 1u; nx = cnt > 0u ? cnt : 1u;
}
__device__ __forceinline__ void xcd_barrier(const XcdBarrier& b) {
    asm volatile("s_waitcnt vmcnt(0)" ::: "memory");
    __syncthreads();
    if (threadIdx.x == 0) {
        unsigned* bar = b.bar;
        __builtin_amdgcn_s_waitcnt(0);
        unsigned nloc = b.st[0], nx = b.st[1];
        if (nloc == 0u) { xcd_barrier_complete(bar, b.x, nloc, nx); b.st[0] = nloc; b.st[1] = nx; }
        const unsigned old = xb_add(&bar[XB_XSUB(b.x)], 1u);
        const unsigned gen = old / nloc;
        if (old + 1u == (gen + 1u) * nloc) {
            __builtin_amdgcn_fence(__ATOMIC_RELEASE, "agent");
            asm volatile("s_waitcnt vmcnt(0)" ::: "memory");
            const unsigned og = xb_add(&bar[XB_TOP], 1u);
            const unsigned tg = og / nx;
            if (og + 1u == (tg + 1u) * nx) xb_add(&bar[XB_TOPGEN], 1u);
            else XB_SPIN(xb_ld(&bar[XB_TOPGEN]) == tg, bar);
            __builtin_amdgcn_fence(__ATOMIC_ACQUIRE, "agent");
            xb_add(&bar[XB_XGEN(b.x)], 1u);
            asm volatile("s_waitcnt vmcnt(0)" ::: "memory");
        } else {
            XB_SPIN(xb_ld(&bar[XB_XGEN(b.x)]) == gen, bar);
            __builtin_amdgcn_fence(__ATOMIC_ACQUIRE, "agent");
            asm volatile("s_waitcnt vmcnt(0)" ::: "memory");
        }
    }
    __syncthreads();
}

__device__ __forceinline__ int tidx() { int t = threadIdx.x; asm volatile("" : "+v"(t)); return t; }
__device__ __forceinline__ int lv(int x) { asm volatile("" : "+v"(x)); return x; }
__device__ __forceinline__ char* launder(char* p) { size_t z = 0; asm volatile("" : "+s"(z)); return p + z; }

constexpr int LDSROW = 72;
template <int NA, class AL>
__device__ __forceinline__ void gc_load(const AL& al, const bf16_t* bp, size_t bstep, int k0, int kc, u32x4 (&ra)[NA], u32x4 (&rb)[4]) {
#pragma unroll
    for (int i = 0; i < NA; ++i) ra[i] = __builtin_bit_cast(u32x4, al.load(i, k0 + kc));
#pragma unroll
    for (int j = 0; j < 4; ++j) rb[j] = *(const u32x4*)(bp + j * bstep + k0);
}
template <int NA>
__device__ __forceinline__ void gc_store(bf16_t* Ab, bf16_t* Bb, int lr, int kc, const u32x4 (&ra)[NA], const u32x4 (&rb)[4]) {
#pragma unroll
    for (int i = 0; i < NA; ++i) *(u32x4*)(Ab + (lr + 32 * i) * LDSROW + kc) = ra[i];
#pragma unroll
    for (int j = 0; j < 4; ++j) *(u32x4*)(Bb + (lr + 32 * j) * LDSROW + kc) = rb[j];
}
template <int MI>
__device__ __forceinline__ void gc_compute(const bf16_t* Ac, const bf16_t* Bc, f32x4 (&acc)[MI][4]) {
#pragma unroll
    for (int kh = 0; kh < 2; ++kh) {
        bf16x8 af[MI], bfv[4];
#pragma unroll
        for (int i = 0; i < MI; ++i) af[i] = *(const bf16x8*)(Ac + i * 16 * LDSROW + kh * 32);
#pragma unroll
        for (int j = 0; j < 4; ++j) bfv[j] = *(const bf16x8*)(Bc + j * 16 * LDSROW + kh * 32);
#pragma unroll
        for (int i = 0; i < MI; ++i)
#pragma unroll
            for (int j = 0; j < 4; ++j) acc[i][j] = __builtin_amdgcn_mfma_f32_16x16x32_bf16(bfv[j], af[i], acc[i][j], 0, 0, 0);
    }
}
template <int MI, class AL>
__device__ __forceinline__ void gemm_core(const AL& al, const bf16_t* __restrict__ Bt, int ldb, int K, f32x4 (&acc)[MI][4], char* smem) {
    constexpr int TM = MI * 32;
    constexpr int NA = TM / 32;
    bf16_t* As = (bf16_t*)smem;
    bf16_t* Bs = As + 2 * TM * LDSROW;
    const int tid = tidx(), lane = tid & 63, wave = tid >> 6;
    const int wr = wave >> 1, wc = wave & 1, fr = lane & 15, fq = lane >> 4;
    const int kc = (tid & 7) * 8, lr = tid >> 3;
#pragma unroll
    for (int i = 0; i < MI; ++i)
#pragma unroll
        for (int j = 0; j < 4; ++j) acc[i][j] = (f32x4){0.f, 0.f, 0.f, 0.f};
    u32x4 a0[NA], b0[4], a1[NA], b1[4];
    const bf16_t* bp = Bt + (size_t)lr * ldb + kc;
    const size_t bstep = (size_t)32 * ldb;
    const int nk = K >> 6;
    bf16_t* As1 = As + TM * LDSROW; bf16_t* Bs1 = Bs + 128 * LDSROW;
    const int aoff = (wr * MI * 16 + fr) * LDSROW + fq * 8, boff = (wc * 64 + fr) * LDSROW + fq * 8;
    gc_load<NA>(al, bp, bstep, 0, kc, a0, b0);
    gc_store<NA>(As, Bs, lr, kc, a0, b0);
    if (nk > 1) gc_load<NA>(al, bp, bstep, 64, kc, a0, b0);
    __syncthreads();
    for (int kt = 0; kt < nk; kt += 2) {
        if (kt + 2 < nk) gc_load<NA>(al, bp, bstep, (kt + 2) << 6, kc, a1, b1);
        gc_compute<MI>(As + aoff, Bs + boff, acc);
        if (kt + 1 < nk) gc_store<NA>(As1, Bs1, lr, kc, a0, b0);
        __syncthreads();
        if (kt + 1 >= nk) break;
        if (kt + 3 < nk) gc_load<NA>(al, bp, bstep, (kt + 3) << 6, kc, a0, b0);
        gc_compute<MI>(As1 + aoff, Bs1 + boff, acc);
        if (kt + 2 < nk) gc_store<NA>(As, Bs, lr, kc, a1, b1);
        __syncthreads();
    }
}
template <int MI, class RP>
__device__ __forceinline__ void gemm_core_g(const RP& rp, const bf16_t* __restrict__ Bt, int ldb, int K, f32x4 (&acc)[MI][4], char* smem) {
    constexpr int ABYTES = MI * 32 * 128;
    constexpr int SBYTES = ABYTES + 16384;
    const int tid = tidx(), lane = tid & 63, wave = tid >> 6;
    const int wr = wave >> 1, wc = wave & 1, fr = lane & 15, fq = lane >> 4;
    const int rr = lane >> 3, cs = ((lane & 7) ^ ((wave * 4 + (lane >> 4)) & 7)) * 8;
#pragma unroll
    for (int i = 0; i < MI; ++i)
#pragma unroll
        for (int j = 0; j < 4; ++j) acc[i][j] = (f32x4){0.f, 0.f, 0.f, 0.f};
    const bf16_t* ap[MI]; const bf16_t* bp[4];
#pragma unroll
    for (int i = 0; i < MI; ++i) { const int r = (i * 4 + wave) * 8 + rr; ap[i] = rp(r) + cs; }
#pragma unroll
    for (int i = 0; i < 4; ++i) { const int r = (i * 4 + wave) * 8 + rr; bp[i] = Bt + (size_t)r * ldb + cs; }
    const int wbase = __builtin_amdgcn_readfirstlane(wave) * 1024;
    const int nk = K >> 6;
    auto stage = [&](int buf, int kt) {
        char* Ab = smem + buf * SBYTES + wbase; char* Bb = Ab + ABYTES;
#pragma unroll
        for (int i = 0; i < MI; ++i) __builtin_amdgcn_global_load_lds((const unsigned*)(ap[i] + kt * 64), (unsigned*)(Ab + i * 4096), 16, 0, 0);
#pragma unroll
        for (int i = 0; i < 4; ++i) __builtin_amdgcn_global_load_lds((const unsigned*)(bp[i] + kt * 64), (unsigned*)(Bb + i * 4096), 16, 0, 0);
    };
    const int aoff = (wr * MI * 16 + fr) * 128, boff = ABYTES + (wc * 64 + fr) * 128, sw = fr >> 1;
    stage(0, 0);
    asm volatile("s_waitcnt vmcnt(0)" ::: "memory");
    __syncthreads();
    for (int kt = 0; kt < nk; ++kt) {
        const int cur = kt & 1;
        if (kt + 1 < nk) stage(cur ^ 1, kt + 1);
        const char* base = smem + cur * SBYTES;
#pragma unroll
        for (int kh = 0; kh < 2; ++kh) {
            const int xo = ((kh * 4 + fq) ^ sw) * 16;
            bf16x8 af[MI], bfv[4];
#pragma unroll
            for (int i = 0; i < MI; ++i) af[i] = *(const bf16x8*)(base + aoff + i * 2048 + xo);
#pragma unroll
            for (int j = 0; j < 4; ++j) bfv[j] = *(const bf16x8*)(base + boff + j * 2048 + xo);
#pragma unroll
            for (int i = 0; i < MI; ++i)
#pragma unroll
                for (int j = 0; j < 4; ++j) acc[i][j] = __builtin_amdgcn_mfma_f32_16x16x32_bf16(bfv[j], af[i], acc[i][j], 0, 0, 0);
        }
        asm volatile("s_waitcnt vmcnt(0)" ::: "memory");
        __syncthreads();
    }
}
struct RPPlain {
    const bf16_t* A; size_t lda;
    __device__ __forceinline__ const bf16_t* operator()(int r) const { return A + (size_t)r * lda; }
};
template <int MI, class F>
__device__ __forceinline__ void acc_foreach(const f32x4 (&acc)[MI][4], F f) {
    const int lane = tidx() & 63, wave = tidx() >> 6;
    const int wr = wave >> 1, wc = wave & 1, fr = lane & 15, fq = lane >> 4;
#pragma unroll
    for (int i = 0; i < MI; ++i)
#pragma unroll
        for (int j = 0; j < 4; ++j) f(wr * MI * 16 + i * 16 + fr, wc * 64 + j * 16 + fq * 4, acc[i][j]);
}
struct ALPlain {
    const bf16_t* p0; size_t step;
    __device__ __forceinline__ ALPlain(const bf16_t* A, int lda, int row0) { p0 = A + (size_t)(row0 + (tidx() >> 3)) * lda; step = (size_t)32 * lda; }
    __device__ __forceinline__ uint4 load(int i, int k) const { return *(const uint4*)(p0 + i * step + k); }
};
__device__ __forceinline__ void store_bf16x4(bf16_t* dst, const f32x4& v) { *(uint2*)dst = make_uint2(pack2(v[0], v[1]), pack2(v[2], v[3])); }

__device__ __forceinline__ void ph_pre(const Params& p, char* smem) {
    const int tid = tidx(), nb = gridDim.x, bid = blockIdx.x;
    float* mod = (float*)(p.ws + O_MOD);
    {
        float* sv = (float*)smem;
        float* part = sv + 5 * 1024;
        for (int i = tid; i < 5 * 1024; i += 256) { const float v = (i < 4096) ? p.in[I_C][i] : p.in[I_CCTX][i - 4096]; sv[i] = siluf_(v); }
        __syncthreads();
        for (int it = bid; it < NLAYER * 96; it += nb) {
            const int l = it / 96, jb = it % 96;
            const int jj = tid & 63, kq = tid >> 6, j = jb * 64 + jj;
            const float* w = p.in[I_WADA] + (size_t)l * 1024 * 6144 + (size_t)(kq * 256) * 6144 + j;
            float a0 = 0.f, a1 = 0.f, a2 = 0.f, a3 = 0.f, a4 = 0.f;
#pragma unroll 8
            for (int k = 0; k < 256; ++k) {
                const float wv = w[(size_t)k * 6144]; const int kk = kq * 256 + k;
                a0 += sv[kk] * wv; a1 += sv[1024 + kk] * wv; a2 += sv[2048 + kk] * wv; a3 += sv[3072 + kk] * wv; a4 += sv[4096 + kk] * wv;
            }
            part[(kq * 5 + 0) * 64 + jj] = a0; part[(kq * 5 + 1) * 64 + jj] = a1; part[(kq * 5 + 2) * 64 + jj] = a2;
            part[(kq * 5 + 3) * 64 + jj] = a3; part[(kq * 5 + 4) * 64 + jj] = a4;
            __syncthreads();
            for (int o = tid; o < 320; o += 256) {
                const int i = o >> 6, c = o & 63;
                const float s = part[(0 * 5 + i) * 64 + c] + part[(1 * 5 + i) * 64 + c] + part[(2 * 5 + i) * 64 + c] + part[(3 * 5 + i) * 64 + c];
                mod[(size_t)(l * 5 + i) * 6144 + jb * 64 + c] = s + p.in[I_BADA][l * 6144 + jb * 64 + c];
            }
            __syncthreads();
        }
    }
    {
        float4* xc = (float4*)(p.ws + O_XCUR);
        const float4* x4 = (const float4*)p.in[I_X]; const float4* c4 = (const float4*)p.in[I_CTX];
        for (size_t i = (size_t)bid * 256 + tid; i < (size_t)RT * 256; i += (size_t)nb * 256) xc[i] = (i < (size_t)RL * 256) ? x4[i] : c4[i - (size_t)RL * 256];
    }
    {
        float* ct = (float*)smem;
        __syncthreads();
        for (int m = tid; m < 4096; m += 256) ct[m] = cospif((float)m * (1.f / 2048.f));
        __syncthreads();
        bf16_t* cst = (bf16_t*)(p.ws + O_CST);
        for (size_t ch = (size_t)bid * 256 + tid; ch < (size_t)4096 * 8192 / 8; ch += (size_t)nb * 256) {
            const int kt = (int)(ch >> 10), c0 = (int)(ch & 1023) * 8, part = c0 >> 12, t0 = c0 & 4095;
            float f[8];
#pragma unroll
            for (int e = 0; e < 8; ++e) { const int m = (kt * (t0 + e)) & 4095; f[e] = part == 0 ? ct[m] : -ct[(m - 1024) & 4095]; }
            *(uint4*)(cst + ch * 8) = pack8(f);
        }
        bf16_t* cst2 = (bf16_t*)(p.ws + O_CST256);
        for (int ch = bid * 256 + tid; ch < 256 * 512 / 8; ch += nb * 256) {
            const int ks = ch >> 6, c0 = (ch & 63) * 8, part = c0 >> 8, s0 = c0 & 255;
            float f[8];
#pragma unroll
            for (int e = 0; e < 8; ++e) { const int m = (16 * ks * (s0 + e)) & 4095; f[e] = part == 0 ? ct[m] : -ct[(m - 1024) & 4095]; }
            *(uint4*)(cst2 + ch * 8) = pack8(f);
        }
        bf16_t* csc = (bf16_t*)(p.ws + O_CSC);
        for (int ch = bid * 256 + tid; ch < 256 * 128 / 8; ch += nb * 256) {
            const int n = ch >> 4, c0 = (ch & 15) * 8, part = n >> 7, kc = n & 127;
            float f[8];
#pragma unroll
            for (int e = 0; e < 8; ++e) { const int m = (32 * kc * (c0 + e)) & 4095; f[e] = part == 0 ? ct[m] : ct[(m - 1024) & 4095]; }
            *(uint4*)(csc + ch * 8) = pack8(f);
        }
        float* rc = (float*)(p.ws + O_ROPEC); float* rs = (float*)(p.ws + O_ROPES);
        for (int i = bid * 256 + tid; i < SEQ * 16; i += nb * 256) {
            const int t = i >> 4, ax = (i >> 3) & 1, f = i & 7;
            const float inv = powf(10000.f, -(float)f / 8.f);
            const float pos = (float)(ax == 0 ? (t >> 6) : (t & 63));
            const float ang = pos * inv;
            rc[i] = cosf(ang); rs[i] = sinf(ang);
        }
    }
}

struct ConvTask { const float* src; const float* scale; bf16_t* dst; int K, Nsrc, Ndst; size_t sbs, dbs; };
__constant__ int c_conv_cum[17] = {0, 1536, 1608, 1672, 1688, 1704, 1720, 1848, 1976, 2104, 2360, 4408, 6456, 8504, 8632, 8760, 8888};
__device__ __forceinline__ ConvTask conv_task(const Params& p, int l, int t) {
    bf16_t* wb = (bf16_t*)(p.ws + O_WB);
    ConvTask c; c.scale = nullptr; c.sbs = 0; c.dbs = 0;
    switch (t) {
    case 0:  c.src = p.in[I_WIN] + (size_t)l * 1024 * 6048; c.K = 1024; c.Nsrc = 6048; c.Ndst = 6144; c.dst = wb + W_IN / 2; break;
    case 1:  c.src = p.in[I_WUQ] + (size_t)l * 384 * 768; c.K = 384; c.Nsrc = 768; c.Ndst = 768; c.dst = wb + W_UQ / 2; c.scale = p.in[I_QNG] + l * 384; break;
    case 2:  c.src = p.in[I_WUKV] + (size_t)l * 256 * 1024; c.K = 256; c.Nsrc = 1024; c.Ndst = 1024; c.dst = wb + W_UKV / 2; c.scale = p.in[I_KVNG] + l * 256; break;
    case 3:  c.src = p.in[I_WUP] + (size_t)l * 2 * 64 * 512; c.K = 64; c.Nsrc = 512; c.Ndst = 512; c.dst = wb + W_WUP / 2; c.sbs = 64 * 512; c.dbs = 512 * 64; break;
    case 4:  c.src = p.in[I_AUP] + (size_t)l * 2 * 64 * 512; c.K = 64; c.Nsrc = 512; c.Ndst = 512; c.dst = wb + W_AUP / 2; c.sbs = 64 * 512; c.dbs = 512 * 64; break;
    case 5:  c.src = p.in[I_GUP] + (size_t)l * 128 * 512; c.K = 128; c.Nsrc = 512; c.Ndst = 512; c.dst = wb + W_GUP / 2; break;
    case 6:  c.src = p.in[I_WPA] + (size_t)l * 512 * 1024; c.K = 512; c.Nsrc = 1024; c.Ndst = 1024; c.dst = wb + W_PA / 2; break;
    case 7:  c.src = p.in[I_WPB] + (size_t)l * 512 * 1024; c.K = 512; c.Nsrc = 1024; c.Ndst = 1024; c.dst = wb + W_PB / 2; break;
    case 8:  c.src = p.in[I_WPC] + (size_t)l * 512 * 1024; c.K = 512; c.Nsrc = 1024; c.Ndst = 1024; c.dst = wb + W_PC / 2; break;
    case 9:  c.src = p.in[I_WOUT] + (size_t)l * 1024 * 1024; c.K = 1024; c.Nsrc = 1024; c.Ndst = 1024; c.dst = wb + W_OUT / 2; break;
    case 10: c.src = p.in[I_EG] + (size_t)l * 16 * 1024 * 512; c.K = 1024; c.Nsrc = 512; c.Ndst = 512; c.dst = wb + W_GU / 2; c.sbs = 1024 * 512; c.dbs = 1024 * 1024; break;
    case 11: c.src = p.in[I_EU] + (size_t)l * 16 * 1024 * 512; c.K = 1024; c.Nsrc = 512; c.Ndst = 512; c.dst = wb + W_GU / 2 + 512 * 1024; c.sbs = 1024 * 512; c.dbs = 1024 * 1024; break;
    case 12: c.src = p.in[I_ED] + (size_t)l * 16 * 512 * 1024; c.K = 512; c.Nsrc = 1024; c.Ndst = 1024; c.dst = wb + W_D / 2; c.sbs = 512 * 1024; c.dbs = 1024 * 512; break;
    case 13: c.src = p.in[I_SG] + (size_t)l * 1024 * 512; c.K = 1024; c.Nsrc = 512; c.Ndst = 512; c.dst = wb + W_GU / 2 + (size_t)16 * 1024 * 1024; break;
    case 14: c.src = p.in[I_SU] + (size_t)l * 1024 * 512; c.K = 1024; c.Nsrc = 512; c.Ndst = 512; c.dst = wb + W_GU / 2 + (size_t)16 * 1024 * 1024 + 512 * 1024; break;
    default: c.src = p.in[I_SD] + (size_t)l * 512 * 1024; c.K = 512; c.Nsrc = 1024; c.Ndst = 1024; c.dst = wb + W_D / 2 + (size_t)16 * 1024 * 512; break;
    }
    return c;
}
__device__ __forceinline__ void ph_w(const Params& p, int l, char* smem) {
    const int tid = tidx();
    float* tl = (float*)smem;
    for (int g = blockIdx.x; g < 8888; g += gridDim.x) {
        int t = 0;
        while (g >= c_conv_cum[t + 1]) ++t;
        const ConvTask c = conv_task(p, l, t);
        int r = g - c_conv_cum[t];
        const int nkt = c.K >> 6, nnt = c.Ndst >> 6;
        const int bi = r / (nkt * nnt); r -= bi * nkt * nnt;
        const int k0 = (r / nnt) * 64, n0 = (r % nnt) * 64;
        const float* src = c.src + bi * c.sbs; bf16_t* dst = c.dst + bi * c.dbs;
#pragma unroll
        for (int i = 0; i < 4; ++i) {
            const int k = (tid >> 4) + 16 * i, n = n0 + (tid & 15) * 4;
            float4 v = make_float4(0.f, 0.f, 0.f, 0.f);
            if (n < c.Nsrc) v = *(const float4*)(src + (size_t)(k0 + k) * c.Nsrc + n);
            if (c.scale) { const float s = c.scale[k0 + k]; v.x *= s; v.y *= s; v.z *= s; v.w *= s; }
            float* d = tl + k * 65 + (tid & 15) * 4;
            d[0] = v.x; d[1] = v.y; d[2] = v.z; d[3] = v.w;
        }
        __syncthreads();
        {
            const int n = tid >> 2, kk0 = (tid & 3) * 16;
            float f[8], g2[8];
#pragma unroll
            for (int j = 0; j < 8; ++j) { f[j] = tl[(kk0 + j) * 65 + n]; g2[j] = tl[(kk0 + 8 + j) * 65 + n]; }
            bf16_t* d = dst + (size_t)(n0 + n) * c.K + k0 + kk0;
            *(uint4*)d = pack8(f); *(uint4*)(d + 8) = pack8(g2);
        }
        __syncthreads();
    }
}

__device__ __forceinline__ void ph_n1(const Params& p, int l) {
    const int lane = tidx() & 63, wave = tidx() >> 6;
    const float* xcur = (const float*)(p.ws + O_XCUR); const float* mod = (const float*)(p.ws + O_MOD);
    bf16_t* H = (bf16_t*)(p.ws + O_H);
    if (blockIdx.x == 0 && tidx() < 64) ((unsigned*)(p.ws + O_CNT))[tidx()] = 0u;
    const float* g = p.in[I_N1G] + l * 1024;
    for (int row = blockIdx.x * 4 + wave; row < RT; row += gridDim.x * 4) {
        const float* x = xcur + (size_t)row * 1024; const float* md = mod + (size_t)(l * 5 + modidx(row)) * 6144;
        float4 v[4]; float ss = 0.f;
#pragma unroll
        for (int i = 0; i < 4; ++i) { v[i] = *(const float4*)(x + lane * 4 + 256 * i); ss += v[i].x * v[i].x + v[i].y * v[i].y + v[i].z * v[i].z + v[i].w * v[i].w; }
        ss = wsum(ss);
        const float rstd = rsqrtf(ss * (1.f / 1024.f) + 1e-6f);
#pragma unroll
        for (int i = 0; i < 4; ++i) {
            const int c = lane * 4 + 256 * i;
            const float4 gg = *(const float4*)(g + c), sc = *(const float4*)(md + 1024 + c), sh = *(const float4*)(md + c);
            f32x4 h = {v[i].x * rstd * gg.x * (1.f + sc.x) + sh.x, v[i].y * rstd * gg.y * (1.f + sc.y) + sh.y,
                       v[i].z * rstd * gg.z * (1.f + sc.z) + sh.z, v[i].w * rstd * gg.w * (1.f + sc.w) + sh.w};
            store_bf16x4(H + (size_t)row * 1024 + c, h);
        }
    }
}

__device__ __forceinline__ void ph_g1(const Params& p, char* smem) {
    const bf16_t* H = (const bf16_t*)(p.ws + O_H); const bf16_t* W = (const bf16_t*)(p.ws + O_WB + W_IN);
    bf16_t* P = (bf16_t*)(p.ws + O_P);
    for (int it = blockIdx.x; it < 136 * 48; it += gridDim.x) {
        const int mt = it / 48, nt = it % 48;
        f32x4 acc[4][4];
        RPPlain rp{H + (size_t)mt * 128 * 1024, 1024};
        gemm_core_g<4>(rp, W + (size_t)nt * 128 * 1024, 1024, 1024, acc, smem);
        acc_foreach<4>(acc, [&](int m, int n, const f32x4& v) {
            const int col = nt * 128 + n; f32x4 o = v;
            if (col >= PG0 && col < PEND) { o[0] = sigmoidf_(v[0]); o[1] = sigmoidf_(v[1]); o[2] = sigmoidf_(v[2]); o[3] = sigmoidf_(v[3]); }
            store_bf16x4(P + (size_t)(mt * 128 + m) * LDP + col, o);
        });
    }
}

__device__ __forceinline__ void ph_qu(const Params& p, char* smem) {
    const bf16_t* P = (const bf16_t*)(p.ws + O_P);
    bf16_t* QR = (bf16_t*)(p.ws + O_X + X_QRAW); bf16_t* KVR = (bf16_t*)(p.ws + O_X + X_KVRAW);
    for (int it = blockIdx.x; it < 136 * 14; it += gridDim.x) {
        const int mt = it / 14, nn = it % 14;
        f32x4 acc[4][4];
        if (nn < 6) {
            RPPlain rp{P + (size_t)mt * 128 * LDP + PQ0, LDP};
            gemm_core_g<4>(rp, (const bf16_t*)(p.ws + O_WB + W_UQ) + (size_t)nn * 128 * 384, 384, 384, acc, smem);
            acc_foreach<4>(acc, [&](int m, int n, const f32x4& v) { store_bf16x4(QR + (size_t)(mt * 128 + m) * 768 + nn * 128 + n, v); });
        } else {
            const int nt = nn - 6;
            RPPlain rp{P + (size_t)mt * 128 * LDP + PKV0, LDP};
            gemm_core_g<4>(rp, (const bf16_t*)(p.ws + O_WB + W_UKV) + (size_t)nt * 128 * 256, 256, 256, acc, smem);
            acc_foreach<4>(acc, [&](int m, int n, const f32x4& v) { store_bf16x4(KVR + (size_t)(mt * 128 + m) * 1024 + nt * 128 + n, v); });
        }
    }
}

constexpr float QSCALE = 0.10206207261596575f * 1.4426950408889634f;
__device__ __forceinline__ void ph_m2(const Params& p) {
    const int lane = tidx() & 63, wave = tidx() >> 6;
    const bf16_t* P = (const bf16_t*)(p.ws + O_P);
    const bf16_t* QR = (const bf16_t*)(p.ws + O_X + X_QRAW); const bf16_t* KVR = (const bf16_t*)(p.ws + O_X + X_KVRAW);
    bf16_t* QA = (bf16_t*)(p.ws + O_X + X_QA); bf16_t* KA = (bf16_t*)(p.ws + O_X + X_KA); bf16_t* VA = (bf16_t*)(p.ws + O_X + X_VA);
    const float* rc = (const float*)(p.ws + O_ROPEC); const float* rs = (const float*)(p.ws + O_ROPES);
    for (int row = blockIdx.x * 4 + wave; row < RT; row += gridDim.x * 4) {
        const bool lat = row < RL;
        const int b = lat ? (row >> 12) : ((row - RL) >> 8), t = lat ? (row & 4095) : ((row - RL) & 255);
        const size_t keyrow = (size_t)b * KEYS + (lat ? t : SEQ + t);
        const bf16_t* pr = P + (size_t)row * LDP;
        float sq = 0.f, sk = 0.f;
#pragma unroll
        for (int i = 0; i < 6; ++i) { const float v = bf2f(pr[PQ0 + lane + 64 * i]); sq += v * v; }
#pragma unroll
        for (int i = 0; i < 4; ++i) { const float v = bf2f(pr[PKV0 + lane + 64 * i]); sk += v * v; }
        sq = wsum(sq); sk = wsum(sk);
        const float rq = rsqrtf(sq * (1.f / 384.f) + 1e-6f), rkv = rsqrtf(sk * (1.f / 256.f) + 1e-6f);
        const bf16_t* qr = QR + (size_t)row * 768; const bf16_t* kvr = KVR + (size_t)row * 1024;
        const float* rct = rc + t * 16; const float* rst = rs + t * 16;
#pragma unroll
        for (int i = 0; i < 12; ++i) {
            const int e = lane + 64 * i, h = e / 96, dd = e - h * 96;
            float xq = bf2f(qr[e]) * rq, xk;
            if (dd < 64) xk = bf2f(kvr[h * 128 + dd]) * rkv;
            else {
                const int ii = dd - 64;
                xk = bf2f(pr[PKR0 + ii]);
                if (lat) {
                    const int ax = ii >> 4, half = (ii >> 3) & 1, f = ii & 7;
                    const float c = rct[ax * 8 + f], s = rst[ax * 8 + f];
                    const float xqp = bf2f(qr[half ? e - 8 : e + 8]) * rq, xkp = bf2f(pr[PKR0 + (ii ^ 8)]);
                    xq = half ? (xq * c + xqp * s) : (xq * c - xqp * s);
                    xk = half ? (xk * c + xkp * s) : (xk * c - xkp * s);
                }
            }
            QA[(size_t)row * 768 + e] = f2bf(xq * QSCALE);
            KA[keyrow * 768 + e] = f2bf(xk);
        }
#pragma unroll
        for (int i = 0; i < 8; ++i) {
            const int e = lane + 64 * i, h = e >> 6, dd = e & 63;
            VA[keyrow * 512 + e] = f2bf(bf2f(kvr[h * 128 + 64 + dd]) * rkv);
        }
    }
}

constexpr int KS_LD = 104, VT_LD = 72;
constexpr int AT_BUF = 64 * KS_LD * 2 + 64 * VT_LD * 2;
__device__ __forceinline__ void ph_at(const Params& p, int l, char* smem) {
    const int tid = tidx(), lane = tid & 63, wave = tid >> 6, fr = lane & 15, fq = lane >> 4;
    const bf16_t* QA = (const bf16_t*)(p.ws + O_X + X_QA); const bf16_t* KA = (const bf16_t*)(p.ws + O_X + X_KA); const bf16_t* VA = (const bf16_t*)(p.ws + O_X + X_VA);
    bf16_t* ATT = (bf16_t*)(p.ws + O_ATT);
    const int nitems = 2048 + (l < NLAYER - 1 ? 128 : 0);
    for (int it = blockIdx.x; it < nitems; it += gridDim.x) {
        int b, h, row0, ntile; size_t krow0;
        if (it < 2048) { b = it >> 9; h = (it >> 6) & 7; row0 = b * SEQ + (it & 63) * 64; krow0 = (size_t)b * KEYS; ntile = KEYS / 64; }
        else { const int j = it - 2048; b = j >> 5; h = (j >> 2) & 7; row0 = RL + b * CTX + (j & 3) * 64; krow0 = (size_t)b * KEYS + SEQ; ntile = CTX / 64; }
        const int qrow = row0 + wave * 16 + fr;
        bf16x8 qf[3];
#pragma unroll
        for (int ks = 0; ks < 3; ++ks) qf[ks] = *(const bf16x8*)(QA + (size_t)qrow * 768 + h * 96 + ks * 32 + fq * 8);
        f32x4 ot[4];
#pragma unroll
        for (int i = 0; i < 4; ++i) ot[i] = (f32x4){0.f, 0.f, 0.f, 0.f};
        float m_run = -1e30f, l_run = 0.f;
        uint4 rk0, rk1, rk2, rv0, rv1;
#define AT_GLOAD(KT) do { const size_t kr_ = krow0 + (size_t)(KT) * 64; \
            { const int c = tid, key = c / 12, part = c % 12; rk0 = *(const uint4*)(KA + (kr_ + key) * 768 + h * 96 + part * 8); } \
            { const int c = tid + 256, key = c / 12, part = c % 12; rk1 = *(const uint4*)(KA + (kr_ + key) * 768 + h * 96 + part * 8); } \
            { const int c = tid + 512, key = c / 12, part = c % 12; rk2 = *(const uint4*)(KA + (kr_ + key) * 768 + h * 96 + part * 8); } \
            { const int c = tid, key = c >> 3, part = c & 7; rv0 = *(const uint4*)(VA + (kr_ + key) * 512 + h * 64 + part * 8); } \
            { const int c = tid + 256, key = c >> 3, part = c & 7; rv1 = *(const uint4*)(VA + (kr_ + key) * 512 + h * 64 + part * 8); } } while (0)
#define AT_VSTORE(RV, C) do { const int key = (C) >> 3, part = (C) & 7; bf16_t* vd_ = Vt_ + (part * 8) * VT_LD + key; \
            vd_[0 * VT_LD] = (bf16_t)(RV.x & 0xffffu); vd_[1 * VT_LD] = (bf16_t)(RV.x >> 16); vd_[2 * VT_LD] = (bf16_t)(RV.y & 0xffffu); vd_[3 * VT_LD] = (bf16_t)(RV.y >> 16); \
            vd_[4 * VT_LD] = (bf16_t)(RV.z & 0xffffu); vd_[5 * VT_LD] = (bf16_t)(RV.z >> 16); vd_[6 * VT_LD] = (bf16_t)(RV.w & 0xffffu); vd_[7 * VT_LD] = (bf16_t)(RV.w >> 16); } while (0)
#define AT_SSTORE(BUF) do { bf16_t* Ks_ = (bf16_t*)(smem + (BUF) * AT_BUF); bf16_t* Vt_ = Ks_ + 64 * KS_LD; \
            { const int c = tid, key = c / 12, part = c % 12; *(uint4*)(Ks_ + key * KS_LD + part * 8) = rk0; } \
            { const int c = tid + 256, key = c / 12, part = c % 12; *(uint4*)(Ks_ + key * KS_LD + part * 8) = rk1; } \
            { const int c = tid + 512, key = c / 12, part = c % 12; *(uint4*)(Ks_ + key * KS_LD + part * 8) = rk2; } \
            AT_VSTORE(rv0, tid); AT_VSTORE(rv1, tid + 256); } while (0)
        AT_GLOAD(0); AT_SSTORE(0);
        __syncthreads();
        for (int kt = 0; kt < ntile; ++kt) {
            const int cur = kt & 1;
            if (kt + 1 < ntile) AT_GLOAD(kt + 1);
            const bf16_t* Ks = (const bf16_t*)(smem + cur * AT_BUF); const bf16_t* Vt = Ks + 64 * KS_LD;
            f32x4 st[4];
#pragma unroll
            for (int j = 0; j < 4; ++j) {
                st[j] = (f32x4){0.f, 0.f, 0.f, 0.f};
#pragma unroll
                for (int ks = 0; ks < 3; ++ks) {
                    const bf16x8 kf = *(const bf16x8*)(Ks + (j * 16 + fr) * KS_LD + ks * 32 + fq * 8);
                    st[j] = __builtin_amdgcn_mfma_f32_16x16x32_bf16(kf, qf[ks], st[j], 0, 0, 0);
                }
            }
            float mx = st[0][0];
#pragma unroll
            for (int j = 0; j < 4; ++j)
#pragma unroll
                for (int r = 0; r < 4; ++r) mx = fmaxf(mx, st[j][r]);
            mx = fmaxf(mx, __shfl_xor(mx, 16)); mx = fmaxf(mx, __shfl_xor(mx, 32));
            const float m_new = fmaxf(m_run, mx);
            const float alpha = exp2f(m_run - m_new);
            m_run = m_new;
            float ps = 0.f;
#pragma unroll
            for (int j = 0; j < 4; ++j)
#pragma unroll
                for (int r = 0; r < 4; ++r) { st[j][r] = exp2f(st[j][r] - m_new); ps += st[j][r]; }
            l_run = l_run * alpha + ps;
#pragma unroll
            for (int i = 0; i < 4; ++i) ot[i] *= alpha;
#pragma unroll
            for (int k2 = 0; k2 < 2; ++k2) {
                const uint4 pu = make_uint4(pack2(st[2 * k2][0], st[2 * k2][1]), pack2(st[2 * k2][2], st[2 * k2][3]),
                                            pack2(st[2 * k2 + 1][0], st[2 * k2 + 1][1]), pack2(st[2 * k2 + 1][2], st[2 * k2 + 1][3]));
                const bf16x8 pb = __builtin_bit_cast(bf16x8, pu);
#pragma unroll
                for (int dt = 0; dt < 4; ++dt) {
                    const bf16_t* vp = Vt + (dt * 16 + fr) * VT_LD + k2 * 32 + fq * 4;
                    const uint2 v0 = *(const uint2*)vp, v1 = *(const uint2*)(vp + 16);
                    const bf16x8 vf = __builtin_bit_cast(bf16x8, make_uint4(v0.x, v0.y, v1.x, v1.y));
                    ot[dt] = __builtin_amdgcn_mfma_f32_16x16x32_bf16(vf, pb, ot[dt], 0, 0, 0);
                }
            }
            if (kt + 1 < ntile) AT_SSTORE(cur ^ 1);
            __syncthreads();
        }
        float lt = l_run; lt += __shfl_xor(lt, 16); lt += __shfl_xor(lt, 32);
        const float inv = 1.f / lt;
#pragma unroll
        for (int dt = 0; dt < 4; ++dt) { f32x4 o = ot[dt] * inv; store_bf16x4(ATT + (size_t)qrow * 512 + h * 64 + dt * 16 + fq * 4, o); }
    }
}

__device__ __forceinline__ void row_edges(int row, bool& first, bool& last) {
    if (row < RL) { const int t = row & 4095; first = t == 0; last = t == 4095; }
    else { const int s = (row - RL) & 255; first = s == 0; last = s == 255; }
}
__device__ __forceinline__ float xs1(const bf16_t* P, const float* mu, int row, int col) {
    bool first, last; row_edges(row, first, last);
    const bf16_t* pc = P + (size_t)row * LDP + PR0 + col;
    const float c = bf2f(*pc), pv = first ? 0.f : bf2f(*(pc - LDP)), nx = last ? 0.f : bf2f(*(pc + LDP));
    return c + (0.5f * (pv + nx) - c) * mu[col];
}
__device__ __forceinline__ void xs8(const bf16_t* P, const float* mu, int row, int col, float (&o)[8]) {
    bool first, last; row_edges(row, first, last);
    const bf16_t* pc = P + (size_t)row * LDP + PR0 + col;
    const uint4 z = make_uint4(0u, 0u, 0u, 0u);
    const uint4 uc = *(const uint4*)pc, up = first ? z : *(const uint4*)(pc - LDP), un = last ? z : *(const uint4*)(pc + LDP);
    float c[8], pv[8], nx[8]; unpack8(uc, c); unpack8(up, pv); unpack8(un, nx);
    const float4 m0 = *(const float4*)(mu + col), m1 = *(const float4*)(mu + col + 4);
    const float m[8] = {m0.x, m0.y, m0.z, m0.w, m1.x, m1.y, m1.z, m1.w};
#pragma unroll
    for (int j = 0; j < 8; ++j) o[j] = c[j] + (0.5f * (pv[j] + nx[j]) - c[j]) * m[j];
}
struct ALRw {
    const bf16_t* P; const float* mu; int row0; int colbase, mode;
    __device__ __forceinline__ ALRw(const bf16_t* P_, const float* mu_, int row0_, int colbase_, int mode_) : P(P_), mu(mu_), colbase(colbase_), mode(mode_) {
        row0 = row0_ + (tidx() >> 3);
    }
    __device__ __forceinline__ uint4 load(int i, int k) const {
        float o[8]; xs8(P, mu, row0 + 32 * i, colbase + k, o);
        if (mode == 0) {
#pragma unroll
            for (int j = 0; j < 8; ++j) o[j] = tanhf(o[j]);
        } else if (mode == 2) {
#pragma unroll
            for (int j = 0; j < 8; ++j) o[j] = sigmoidf_(o[j]);
        }
        return pack8(o);
    }
};
__device__ __forceinline__ void ph_rp1(const Params& p, int l, char* smem) {
    const bf16_t* P = (const bf16_t*)(p.ws + O_P); const float* mu = p.in[I_MU] + l * 1792;
    bf16_t* RG = (bf16_t*)(p.ws + O_RG);
    for (int it = blockIdx.x; it < 544; it += gridDim.x) {
        const int mt = it >> 2, nt = it & 3;
        f32x4 acc[4][4];
        ALRw al(P, mu, mt * 128, 1664, 2);
        gemm_core<4>(al, (const bf16_t*)(p.ws + O_WB + W_GUP) + (size_t)nt * 128 * 128, 128, 128, acc, smem);
        acc_foreach<4>(acc, [&](int m, int n, const f32x4& v) { store_bf16x4(RG + (size_t)(mt * 128 + m) * 512 + nt * 128 + n, v); });
    }
}
__device__ __forceinline__ void ph_rp2(const Params& p, int l) {
    const int lane = tidx() & 63, wave = tidx() >> 6;
    const bf16_t* P = (const bf16_t*)(p.ws + O_P); const float* mu = p.in[I_MU] + l * 1792; const float* kkw = p.in[I_KK] + l * 512;
    float* KKN = (float*)(p.ws + O_X + X_KKN);
    for (int row = blockIdx.x * 4 + wave; row < RT; row += gridDim.x * 4) {
        float k8[8]; xs8(P, mu, row, 512 + lane * 8, k8);
        float s = 0.f;
#pragma unroll
        for (int j = 0; j < 8; ++j) { const float v = k8[j] * kkw[lane * 8 + j]; s += v * v; }
        s += __shfl_xor(s, 1); s += __shfl_xor(s, 2); s += __shfl_xor(s, 4);
        if ((lane & 7) == 0) KKN[(size_t)row * 8 + (lane >> 3)] = rsqrtf(s + 1e-12f);
    }
}

__device__ __forceinline__ int scan_row(int b, int d, int n) {
    if (n < CTX) return RL + b * CTX + (d == 0 ? n : CTX - 1 - n);
    const int t = n - CTX; return b * SEQ + (d == 0 ? t : SEQ - 1 - t);
}
constexpr int SL = 72;
constexpr int SLOT_E = 64 * SL;
template <int LDA, int LDB>
__device__ __forceinline__ void mm64(const bf16_t* A, const bf16_t* B, f32x4 (&acc)[4], int wave, int fr, int fq) {
#pragma unroll
    for (int ks = 0; ks < 2; ++ks) {
        const bf16x8 af = *(const bf16x8*)(A + (wave * 16 + fr) * LDA + ks * 32 + fq * 8);
#pragma unroll
        for (int nt = 0; nt < 4; ++nt) {
            const bf16x8 bfv = *(const bf16x8*)(B + (nt * 16 + fr) * LDB + ks * 32 + fq * 8);
            acc[nt] = __builtin_amdgcn_mfma_f32_16x16x32_bf16(bfv, af, acc[nt], 0, 0, 0);
        }
    }
}
__device__ __forceinline__ void acc_zero(f32x4 (&acc)[4]) {
#pragma unroll
    for (int nt = 0; nt < 4; ++nt) acc[nt] = (f32x4){0.f, 0.f, 0.f, 0.f};
}
template <bool STRICT>
__device__ __forceinline__ void acc_mask(f32x4 (&acc)[4], int m, int fq) {
#pragma unroll
    for (int nt = 0; nt < 4; ++nt)
#pragma unroll
        for (int r = 0; r < 4; ++r) { const int n = nt * 16 + fq * 4 + r; const bool keep = STRICT ? (m < n) : (m <= n); if (!keep) acc[nt][r] = 0.f; }
}
__device__ __forceinline__ void st_rm(bf16_t* dst, const f32x4 (&acc)[4], int m, int fq) {
#pragma unroll
    for (int nt = 0; nt < 4; ++nt) store_bf16x4(dst + m * SL + nt * 16 + fq * 4, acc[nt]);
}
__device__ __forceinline__ void st_tr(bf16_t* dst, const f32x4 (&acc)[4], int m, int fq) {
#pragma unroll
    for (int nt = 0; nt < 4; ++nt)
#pragma unroll
        for (int r = 0; r < 4; ++r) dst[(nt * 16 + fq * 4 + r) * SL + m] = f2bf(acc[nt][r]);
}
__device__ __forceinline__ void ph_r1(const Params& p, int l, char* smem) {
    const int tid0 = tidx();
#define R1_IDX const int tid = lv(tid0), lane = tid & 63, wave = tid >> 6, fr = lane & 15, fq = lane >> 4, bi = tid >> 2, bq = (tid & 3) * 16, m = wave * 16 + fr; (void)bi; (void)bq; (void)m; (void)fq;
    const bf16_t* P = (const bf16_t*)(p.ws + O_P); const float* mu = p.in[I_MU] + l * 1792;
    const float* kkw = p.in[I_KK] + l * 512; const float* kaw = p.in[I_KA] + l * 512; const float* rkw = p.in[I_RK] + l * 512;
    const float* KKN = (const float*)(p.ws + O_X + X_KKN); float* BON = (float*)(p.ws + O_X + X_BON);
    bf16_t* gMT = (bf16_t*)(p.ws + O_X + X_MT); bf16_t* gNL = (bf16_t*)(p.ws + O_X + X_NL);
    bf16_t* gGT = (bf16_t*)(p.ws + O_X + X_GT); bf16_t* gYL = (bf16_t*)(p.ws + O_X + X_YL);
    bf16_t* slot = (bf16_t*)smem;
    bf16_t* s0 = slot, *s1 = slot + SLOT_E, *s2 = slot + 2 * SLOT_E, *s3 = slot + 3 * SLOT_E;
    bf16_t* sa = slot + 4 * SLOT_E, *sb = slot + 5 * SLOT_E, *sc = slot + 6 * SLOT_E, *sT = slot + 7 * SLOT_E;
    float* misc = (float*)(smem + 8 * SLOT_E * 2);
    float* GAM = misc; float* SEG = misc + 64;
    float* ASIG = (float*)s0;
    float* LWS = (float*)s2;
    for (int it = blockIdx.x; it < NCP; it += gridDim.x) {
        const int c = it % 68, d = (it / 68) & 1, h = (it / 136) & 7, b = it / 1088;
        {
            R1_IDX const int rowb = scan_row(b, d, c * 64 + bi); (void)rowb;
            float o[8];
#pragma unroll
            for (int hh = 0; hh < 2; ++hh) {
                xs8(P, mu, rowb, 1536 + bq + hh * 8, o);
#pragma unroll
                for (int j = 0; j < 8; ++j) o[j] = tanhf(o[j]);
                *(uint4*)(sa + bi * SL + bq + hh * 8) = pack8(o);
                xs8(P, mu, rowb, 1600 + bq + hh * 8, o);
                *(uint4*)(sb + bi * SL + bq + hh * 8) = pack8(o);
            }
        }
        __syncthreads();
        {
            R1_IDX const int rowb = scan_row(b, d, c * 64 + bi); (void)rowb;
            f32x4 acc[4];
            acc_zero(acc);
            mm64<SL, 64>(sa, (const bf16_t*)(p.ws + O_WB + W_WUP) + ((size_t)d * 512 + h * 64) * 64, acc, wave, fr, fq);
            const float* w0 = p.in[I_W0] + (l * 2 + d) * 512 + h * 64;
#pragma unroll
            for (int nt = 0; nt < 4; ++nt) {
                const int n = nt * 16 + fq * 4; float4 o; float* op = (float*)&o;
#pragma unroll
                for (int r = 0; r < 4; ++r) { const float z = w0[n + r] + acc[nt][r]; const float sp = fmaxf(-z, 0.f) + log1pf(expf(-fabsf(z))); op[r] = -expf(-sp - 0.5f); }
                *(float4*)(LWS + m * 64 + n) = o;
            }
            acc_zero(acc);
            mm64<SL, 64>(sb, (const bf16_t*)(p.ws + O_WB + W_AUP) + ((size_t)d * 512 + h * 64) * 64, acc, wave, fr, fq);
            const float* a0 = p.in[I_A0] + (l * 2 + d) * 512 + h * 64;
#pragma unroll
            for (int nt = 0; nt < 4; ++nt) {
                const int n = nt * 16 + fq * 4;
                *(float4*)(ASIG + m * 64 + n) = make_float4(sigmoidf_(a0[n] + acc[nt][0]), sigmoidf_(a0[n + 1] + acc[nt][1]), sigmoidf_(a0[n + 2] + acc[nt][2]), sigmoidf_(a0[n + 3] + acc[nt][3]));
            }
        }
        __syncthreads();
        {
            R1_IDX const int rowb = scan_row(b, d, c * 64 + bi); (void)rowb;
            const int k = tid & 63, seg = tid >> 6;
            float run = 0.f;
#pragma unroll
            for (int ii = 0; ii < 16; ++ii) { run += LWS[(seg * 16 + ii) * 64 + k]; LWS[(seg * 16 + ii) * 64 + k] = run; }
            SEG[seg * 64 + k] = run;
            __syncthreads();
            float off = 0.f;
#pragma unroll
            for (int sgi = 0; sgi < 3; ++sgi) if (sgi < seg) off += SEG[sgi * 64 + k];
#pragma unroll
            for (int ii = 0; ii < 16; ++ii) LWS[(seg * 16 + ii) * 64 + k] += off;
        }
        __syncthreads();
        {
            R1_IDX const int rowb = scan_row(b, d, c * 64 + bi); (void)rowb;
            float cs[16], cm[16], cc[16], ag[16];
#pragma unroll
            for (int q = 0; q < 4; ++q) {
                const float4 v0 = *(const float4*)(LWS + bi * 64 + bq + q * 4);
                const float4 v1 = bi > 0 ? *(const float4*)(LWS + (bi - 1) * 64 + bq + q * 4) : make_float4(0.f, 0.f, 0.f, 0.f);
                const float4 v2 = *(const float4*)(LWS + 63 * 64 + bq + q * 4);
                const float4 v3 = *(const float4*)(ASIG + bi * 64 + bq + q * 4);
                cs[q * 4] = v0.x; cs[q * 4 + 1] = v0.y; cs[q * 4 + 2] = v0.z; cs[q * 4 + 3] = v0.w;
                cm[q * 4] = v1.x; cm[q * 4 + 1] = v1.y; cm[q * 4 + 2] = v1.z; cm[q * 4 + 3] = v1.w;
                cc[q * 4] = v2.x; cc[q * 4 + 1] = v2.y; cc[q * 4 + 2] = v2.z; cc[q * 4 + 3] = v2.w;
                ag[q * 4] = v3.x; ag[q * 4 + 1] = v3.y; ag[q * 4 + 2] = v3.z; ag[q * 4 + 3] = v3.w;
            }
            __syncthreads();
            const float kkn = KKN[(size_t)rowb * 8 + h];
            float bon = 0.f;
#pragma unroll
            for (int hh = 0; hh < 2; ++hh) {
                float r8[8], k8[8], oa[8], ob[8], ok[8], orr[8];
                const int col = h * 64 + bq + hh * 8;
                xs8(P, mu, rowb, col, r8); xs8(P, mu, rowb, 512 + col, k8);
#pragma unroll
                for (int j = 0; j < 8; ++j) {
                    const int e = hh * 8 + j;
                    const float kk = k8[j] * kkw[col + j] * kkn;
                    const float kd = k8[j] * (1.f + (ag[e] - 1.f) * kaw[col + j]);
                    const float eneg = __expf(-cs[e]);
                    oa[j] = -kk * __expf(cm[e]); ob[j] = kk * ag[e] * eneg; ok[j] = kd * eneg; orr[j] = r8[j] * __expf(cs[e]);
                    bon += r8[j] * kd * rkw[col + j];
                }
                *(uint4*)(s0 + bi * SL + bq + hh * 8) = pack8(oa); *(uint4*)(s1 + bi * SL + bq + hh * 8) = pack8(ob);
                *(uint4*)(s2 + bi * SL + bq + hh * 8) = pack8(ok); *(uint4*)(s3 + bi * SL + bq + hh * 8) = pack8(orr);
            }
            bon += __shfl_xor(bon, 1); bon += __shfl_xor(bon, 2);
            if ((tid & 3) == 0) BON[((size_t)d * RT + rowb) * 8 + h] = bon;
            if (bi == 0) {
#pragma unroll
                for (int e = 0; e < 16; ++e) GAM[bq + e] = __expf(cc[e]);
            }
        }
        __syncthreads();
        {
            R1_IDX const int rowb = scan_row(b, d, c * 64 + bi); (void)rowb;
            f32x4 acc[4]; acc_zero(acc);
            mm64<SL, SL>(s1, s0, acc, wave, fr, fq);
            acc_mask<true>(acc, m, fq);
            st_rm(sa, acc, m, fq); st_tr(sb, acc, m, fq);
#pragma unroll
            for (int nt = 0; nt < 4; ++nt)
#pragma unroll
                for (int r = 0; r < 4; ++r) if (nt * 16 + fq * 4 + r == m) acc[nt][r] += 1.f;
            st_rm(sc, acc, m, fq);
        }
        __syncthreads();
#pragma unroll
        for (int itr = 0; itr < 5; ++itr) {
            R1_IDX
            bf16_t* ptr = (itr & 1) ? sT : sb;
            bf16_t* ptw = (itr & 1) ? sb : sT;
            f32x4 acc[4]; acc_zero(acc);
            mm64<SL, SL>(sa, ptr, acc, wave, fr, fq);
            st_rm(sa, acc, m, fq); st_tr(ptw, acc, m, fq);
            __syncthreads();
            f32x4 tacc[4];
#pragma unroll
            for (int nt = 0; nt < 4; ++nt) { const uint2 u = *(const uint2*)(sc + m * SL + nt * 16 + fq * 4); tacc[nt] = (f32x4){bflo(u.x), bfhi(u.x), bflo(u.y), bfhi(u.y)}; }
            mm64<SL, SL>(sc, ptw, tacc, wave, fr, fq);
            if (itr < 4) st_rm(sc, tacc, m, fq); else st_tr(sb, tacc, m, fq);
        }
        __syncthreads();
        {
            R1_IDX const int rowb = scan_row(b, d, c * 64 + bi); (void)rowb;
            f32x4 acc[4]; acc_zero(acc);
            mm64<SL, SL>(s2, s0, acc, wave, fr, fq);
            acc_mask<true>(acc, m, fq);
            st_rm(sa, acc, m, fq);
            float f0[8], f1[8];
            unpack8(*(const uint4*)(s0 + bi * SL + bq), f0); unpack8(*(const uint4*)(s0 + bi * SL + bq + 8), f1);
#pragma unroll
            for (int e = 0; e < 8; ++e) { sc[(bq + e) * SL + bi] = f2bf(f0[e]); sc[(bq + 8 + e) * SL + bi] = f2bf(f1[e]); }
        }
        __syncthreads();
        {
            R1_IDX const int rowb = scan_row(b, d, c * 64 + bi); (void)rowb;
            f32x4 acc[4]; acc_zero(acc);
            mm64<SL, SL>(sc, sb, acc, wave, fr, fq);
            st_rm(sT, acc, m, fq);
            acc_zero(acc);
            mm64<SL, SL>(sa, sb, acc, wave, fr, fq);
            st_rm(s0, acc, m, fq);
        }
        __syncthreads();
        f32x4 qacc[4];
        {
            R1_IDX const int rowb = scan_row(b, d, c * 64 + bi); (void)rowb;
            f32x4 acc[4]; acc_zero(acc);
            mm64<SL, SL>(s1, s3, acc, wave, fr, fq);
            acc_mask<false>(acc, m, fq);
            st_tr(sa, acc, m, fq);
            acc_zero(qacc);
            mm64<SL, SL>(s2, s3, qacc, wave, fr, fq);
            acc_mask<false>(qacc, m, fq);
            float f0[8], f1[8];
            unpack8(*(const uint4*)(s3 + bi * SL + bq), f0); unpack8(*(const uint4*)(s3 + bi * SL + bq + 8), f1);
#pragma unroll
            for (int e = 0; e < 8; ++e) { sc[(bq + e) * SL + bi] = f2bf(f0[e]); sc[(bq + 8 + e) * SL + bi] = f2bf(f1[e]); }
        }
        __syncthreads();
        {
            R1_IDX const int rowb = scan_row(b, d, c * 64 + bi); (void)rowb;
            f32x4 acc[4];
#pragma unroll
            for (int nt = 0; nt < 4; ++nt) { const uint2 u = *(const uint2*)(sc + m * SL + nt * 16 + fq * 4); acc[nt] = (f32x4){bflo(u.x), bfhi(u.x), bflo(u.y), bfhi(u.y)}; }
            mm64<SL, SL>(sT, sa, acc, wave, fr, fq);
            bf16_t* gt = gGT + (size_t)it * 4096;
#pragma unroll
            for (int nt = 0; nt < 4; ++nt)
#pragma unroll
                for (int r = 0; r < 4; ++r) gt[(nt * 16 + fq * 4 + r) * 64 + m] = f2bf(acc[nt][r]);
            mm64<SL, SL>(s0, sa, qacc, wave, fr, fq);
            st_tr(sb, qacc, m, fq);
            float f0[8], f1[8];
            unpack8(*(const uint4*)(s1 + bi * SL + bq), f0); unpack8(*(const uint4*)(s1 + bi * SL + bq + 8), f1);
#pragma unroll
            for (int e = 0; e < 8; ++e) { s3[(bq + e) * SL + bi] = f2bf(f0[e] * GAM[bq + e]); s3[(bq + 8 + e) * SL + bi] = f2bf(f1[e] * GAM[bq + 8 + e]); }
        }
        __syncthreads();
        {
            R1_IDX const int rowb = scan_row(b, d, c * 64 + bi); (void)rowb;
            f32x4 acc[4]; acc_zero(acc);
            mm64<SL, SL>(sT, s3, acc, wave, fr, fq);
            bf16_t* mt = gMT + (size_t)it * 4096;
#pragma unroll
            for (int nt = 0; nt < 4; ++nt)
#pragma unroll
                for (int r = 0; r < 4; ++r) { const int n = nt * 16 + fq * 4 + r; mt[n * 64 + m] = f2bf(acc[nt][r] + (n == m ? GAM[m] : 0.f)); }
#pragma unroll
            for (int nt = 0; nt < 4; ++nt) {
                const int n = nt * 16 + fq * 4; const uint2 u = *(const uint2*)(s2 + m * SL + n);
                acc[nt] = (f32x4){bflo(u.x) * GAM[n], bfhi(u.x) * GAM[n + 1], bflo(u.y) * GAM[n + 2], bfhi(u.y) * GAM[n + 3]};
            }
            mm64<SL, SL>(s0, s3, acc, wave, fr, fq);
            st_tr(s1, acc, m, fq);
            float v8[8];
#pragma unroll
            for (int hh = 0; hh < 2; ++hh) {
                xs8(P, mu, rowb, 1024 + h * 64 + bq + hh * 8, v8);
#pragma unroll
                for (int e = 0; e < 8; ++e) sc[(bq + hh * 8 + e) * SL + bi] = f2bf(v8[e]);
            }
        }
        __syncthreads();
        {
            R1_IDX const int rowb = scan_row(b, d, c * 64 + bi); (void)rowb;
            f32x4 acc[4]; acc_zero(acc);
            mm64<SL, SL>(sc, sb, acc, wave, fr, fq);
            bf16_t* yl = gYL + (size_t)it * 4096;
#pragma unroll
            for (int nt = 0; nt < 4; ++nt) store_bf16x4(yl + m * 64 + nt * 16 + fq * 4, acc[nt]);
            acc_zero(acc);
            mm64<SL, SL>(sc, s1, acc, wave, fr, fq);
            bf16_t* nl = gNL + (size_t)it * 4096;
#pragma unroll
            for (int nt = 0; nt < 4; ++nt) store_bf16x4(nl + m * 64 + nt * 16 + fq * 4, acc[nt]);
        }
        __syncthreads();
    }
}
__device__ __forceinline__ void ph_r2(const Params& p) {
    const int tid = tidx(), lane = tid & 63, wave = tid >> 6, fr = lane & 15, fq = lane >> 4;
    const bf16_t* gMT = (const bf16_t*)(p.ws + O_X + X_MT); const bf16_t* gNL = (const bf16_t*)(p.ws + O_X + X_NL);
    uint4* gS0 = (uint4*)(p.ws + O_X + X_S0);
    for (int it = blockIdx.x; it < 64; it += gridDim.x) {
        f32x4 st[4];
#pragma unroll
        for (int tt = 0; tt < 4; ++tt) st[tt] = (f32x4){0.f, 0.f, 0.f, 0.f};
        for (int c = 0; c < 68; ++c) {
            const size_t cp = (size_t)it * 68 + c;
            const bf16_t* mt = gMT + cp * 4096; const bf16_t* nl = gNL + cp * 4096;
            uint2 ma[4][2][2], nv[4];
#pragma unroll
            for (int tt = 0; tt < 4; ++tt) {
#pragma unroll
                for (int s = 0; s < 2; ++s) { const bf16_t* q = mt + (tt * 16 + fr) * 64 + s * 32 + fq * 4; ma[tt][s][0] = *(const uint2*)q; ma[tt][s][1] = *(const uint2*)(q + 16); }
                nv[tt] = *(const uint2*)(nl + (wave * 16 + fr) * 64 + tt * 16 + fq * 4);
            }
            uint4 sbv[2];
#pragma unroll
            for (int s = 0; s < 2; ++s) sbv[s] = make_uint4(pack2(st[2 * s][0], st[2 * s][1]), pack2(st[2 * s][2], st[2 * s][3]), pack2(st[2 * s + 1][0], st[2 * s + 1][1]), pack2(st[2 * s + 1][2], st[2 * s + 1][3]));
            gS0[(cp * 4 + wave) * 128 + lane] = sbv[0]; gS0[(cp * 4 + wave) * 128 + 64 + lane] = sbv[1];
#pragma unroll
            for (int tt = 0; tt < 4; ++tt) {
                f32x4 acc = {bflo(nv[tt].x), bfhi(nv[tt].x), bflo(nv[tt].y), bfhi(nv[tt].y)};
#pragma unroll
                for (int s = 0; s < 2; ++s) {
                    const bf16x8 af = __builtin_bit_cast(bf16x8, make_uint4(ma[tt][s][0].x, ma[tt][s][0].y, ma[tt][s][1].x, ma[tt][s][1].y));
                    acc = __builtin_amdgcn_mfma_f32_16x16x32_bf16(af, __builtin_bit_cast(bf16x8, sbv[s]), acc, 0, 0, 0);
                }
                st[tt] = acc;
            }
        }
    }
}
__device__ __forceinline__ void ph_r3(const Params& p) {
    const int tid = tidx(), lane = tid & 63, wave = tid >> 6, fr = lane & 15, fq = lane >> 4;
    const bf16_t* gGT = (const bf16_t*)(p.ws + O_X + X_GT); const bf16_t* gYL = (const bf16_t*)(p.ws + O_X + X_YL);
    const uint4* gS0 = (const uint4*)(p.ws + O_X + X_S0);
    bf16_t* YS = (bf16_t*)(p.ws + O_H);
    for (int it = blockIdx.x; it < NCP; it += gridDim.x) {
        const int c = it % 68, d = (it / 68) & 1, h = (it / 136) & 7, b = it / 1088;
        const bf16_t* gt = gGT + (size_t)it * 4096; const bf16_t* yl = gYL + (size_t)it * 4096;
        const uint4 sb0 = gS0[((size_t)it * 4 + wave) * 128 + lane], sb1 = gS0[((size_t)it * 4 + wave) * 128 + 64 + lane];
#pragma unroll
        for (int tt = 0; tt < 4; ++tt) {
            const uint2 yv = *(const uint2*)(yl + (wave * 16 + fr) * 64 + tt * 16 + fq * 4);
            f32x4 acc = {bflo(yv.x), bfhi(yv.x), bflo(yv.y), bfhi(yv.y)};
#pragma unroll
            for (int s = 0; s < 2; ++s) {
                const bf16_t* q = gt + (tt * 16 + fr) * 64 + s * 32 + fq * 4;
                const uint2 a0 = *(const uint2*)q, a1 = *(const uint2*)(q + 16);
                const bf16x8 af = __builtin_bit_cast(bf16x8, make_uint4(a0.x, a0.y, a1.x, a1.y));
                acc = __builtin_amdgcn_mfma_f32_16x16x32_bf16(af, __builtin_bit_cast(bf16x8, s ? sb1 : sb0), acc, 0, 0, 0);
            }
#pragma unroll
            for (int r = 0; r < 4; ++r) {
                const int row = scan_row(b, d, c * 64 + tt * 16 + fq * 4 + r);
                YS[((size_t)d * RT + row) * 512 + h * 64 + wave * 16 + fr] = f2bf(acc[r]);
            }
        }
    }
}

__device__ __forceinline__ void ph_rpost(const Params& p, int l) {
    const int lane = tidx() & 63, wave = tidx() >> 6;
    const bf16_t* P = (const bf16_t*)(p.ws + O_P); const float* mu = p.in[I_MU] + l * 1792;
    const float* gng = p.in[I_GNG] + l * 512; const float* gnb = p.in[I_GNB] + l * 512;
    const float* BON = (const float*)(p.ws + O_X + X_BON); const bf16_t* YS = (const bf16_t*)(p.ws + O_H);
    const bf16_t* RG = (const bf16_t*)(p.ws + O_RG); bf16_t* RWO = (bf16_t*)(p.ws + O_RWO);
    for (int row = blockIdx.x * 4 + wave; row < RT; row += gridDim.x * 4) {
        const int col = lane * 8, h = lane >> 3;
        float v8[8], g8[8], y0[8], y1[8];
        xs8(P, mu, row, 1024 + col, v8);
        unpack8(*(const uint4*)(RG + (size_t)row * 512 + col), g8);
        unpack8(*(const uint4*)(YS + ((size_t)0 * RT + row) * 512 + col), y0);
        unpack8(*(const uint4*)(YS + ((size_t)1 * RT + row) * 512 + col), y1);
        const float bs = BON[((size_t)0 * RT + row) * 8 + h] + BON[((size_t)1 * RT + row) * 8 + h];
        float y[8]; float sm = 0.f;
#pragma unroll
        for (int j = 0; j < 8; ++j) { y[j] = y0[j] + y1[j]; sm += y[j]; }
        sm += __shfl_xor(sm, 1); sm += __shfl_xor(sm, 2); sm += __shfl_xor(sm, 4);
        const float mean = sm * (1.f / 64.f);
        float vs = 0.f;
#pragma unroll
        for (int j = 0; j < 8; ++j) { const float dlt = y[j] - mean; vs += dlt * dlt; }
        vs += __shfl_xor(vs, 1); vs += __shfl_xor(vs, 2); vs += __shfl_xor(vs, 4);
        const float rstd = rsqrtf(vs * (1.f / 64.f) + 64e-5f);
        float o[8];
#pragma unroll
        for (int j = 0; j < 8; ++j) o[j] = ((y[j] - mean) * rstd * gng[col + j] + gnb[col + j] + bs * v8[j]) * g8[j];
        *(uint4*)(RWO + (size_t)row * 512 + col) = pack8(o);
    }
}

__device__ __forceinline__ void ph_f1(const Params& p, int l, char* smem) {
    const bf16_t* P = (const bf16_t*)(p.ws + O_P); const bf16_t* CSC = (const bf16_t*)(p.ws + O_CSC);
    bf16_t* YT = (bf16_t*)(p.ws + O_X + X_YT); bf16_t* YTC = (bf16_t*)(p.ws + O_X + X_YTC);
    const int nitems = 1024 + (l < NLAYER - 1 ? 64 : 0);
    for (int it = blockIdx.x; it < nitems; it += gridDim.x) {
        f32x4 acc[4][4];
        if (it < 1024) {
            const int b = it >> 8, g = (it >> 6) & 3, mt = (it >> 5) & 1, nt = it & 31;
            RPPlain rp{CSC + (size_t)mt * 128 * 128, 128};
            gemm_core_g<4>(rp, P + (size_t)(b * SEQ + nt * 128) * LDP + g * 128, LDP, 128, acc, smem);
            acc_foreach<4>(acc, [&](int m, int n, const f32x4& v) {
                store_bf16x4(YT + ((size_t)(b * 512 + g * 128 + m)) * 8192 + mt * 4096 + nt * 128 + n, v);
            });
        } else {
            const int j = it - 1024, b = j >> 4, g = (j >> 2) & 3, mt = (j >> 1) & 1, nt = j & 1;
            RPPlain rp{CSC + (size_t)mt * 128 * 128, 128};
            gemm_core_g<4>(rp, P + (size_t)(RL + b * CTX + nt * 128) * LDP + g * 128, LDP, 128, acc, smem);
            acc_foreach<4>(acc, [&](int m, int n, const f32x4& v) {
                store_bf16x4(YTC + ((size_t)(b * 512 + g * 128 + m)) * 512 + mt * 256 + nt * 128 + n, v);
            });
        }
    }
}
__device__ __forceinline__ void ph_f2(const Params& p, int l, char* smem) {
    const bf16_t* CST = (const bf16_t*)(p.ws + O_CST); const bf16_t* CST2 = (const bf16_t*)(p.ws + O_CST256);
    const bf16_t* YT = (const bf16_t*)(p.ws + O_X + X_YT); const bf16_t* YTC = (const bf16_t*)(p.ws + O_X + X_YTC);
    bf16_t* FA = (bf16_t*)(p.ws + O_FA);
    const int nitems = 512 + (l < NLAYER - 1 ? 32 : 0);
    for (int it = blockIdx.x; it < nitems; it += gridDim.x) {
        f32x4 acc[4][4];
        if (it < 512) {
            const int b = it >> 7, mt = (it >> 2) & 31, nt = it & 3;
            RPPlain rp{CST + (size_t)mt * 128 * 8192, 8192};
            gemm_core_g<4>(rp, YT + ((size_t)b * 512 + nt * 128) * 8192, 8192, 8192, acc, smem);
            const float sc = 0.001381067932004975f;
            acc_foreach<4>(acc, [&](int m, int n, const f32x4& v) { f32x4 o = v * sc; store_bf16x4(FA + (size_t)(b * SEQ + mt * 128 + m) * 512 + nt * 128 + n, o); });
        } else {
            const int j = it - 512, b = j >> 3, mt = (j >> 2) & 1, nt = j & 3;
            RPPlain rp{CST2 + (size_t)mt * 128 * 512, 512};
            gemm_core_g<4>(rp, YTC + ((size_t)b * 512 + nt * 128) * 512, 512, 512, acc, smem);
            const float sc = 0.005524271728019903f;
            acc_foreach<4>(acc, [&](int m, int n, const f32x4& v) { f32x4 o = v * sc; store_bf16x4(FA + (size_t)(RL + b * CTX + mt * 128 + m) * 512 + nt * 128 + n, o); });
        }
    }
}

__device__ __forceinline__ void ph_mg(const Params& p, int l, char* smem) {
    const bf16_t* P = (const bf16_t*)(p.ws + O_P);
    const bf16_t* A[3] = {(const bf16_t*)(p.ws + O_FA), (const bf16_t*)(p.ws + O_ATT), (const bf16_t*)(p.ws + O_RWO)};
    const bf16_t* W[3] = {(const bf16_t*)(p.ws + O_WB + W_PA), (const bf16_t*)(p.ws + O_WB + W_PB), (const bf16_t*)(p.ws + O_WB + W_PC)};
    bf16_t* MG = (bf16_t*)(p.ws + O_H);
    const int nmt = (l < NLAYER - 1) ? RT / 64 : RL / 64;
    for (int it = blockIdx.x; it < nmt * 8; it += gridDim.x) {
        const int mt = it >> 3, nt = it & 7;
        f32x4 tot[2][4];
#pragma unroll
        for (int i = 0; i < 2; ++i)
#pragma unroll
            for (int j = 0; j < 4; ++j) tot[i][j] = (f32x4){0.f, 0.f, 0.f, 0.f};
#pragma unroll
        for (int br = 0; br < 3; ++br) {
            f32x4 acc[2][4];
            RPPlain rp{A[br] + (size_t)mt * 64 * 512, 512};
            gemm_core_g<2>(rp, W[br] + (size_t)nt * 128 * 512, 512, 512, acc, smem);
            const int lane = tidx() & 63, wave = tidx() >> 6, wr = wave >> 1, wc = wave & 1, fr = lane & 15, fq = lane >> 4;
#pragma unroll
            for (int i = 0; i < 2; ++i)
#pragma unroll
                for (int j = 0; j < 4; ++j) {
                    const int m = wr * 32 + i * 16 + fr, n = wc * 64 + j * 16 + fq * 4;
                    const uint2 gu = *(const uint2*)(P + (size_t)(mt * 64 + m) * LDP + PG0 + br * 1024 + nt * 128 + n);
                    tot[i][j][0] += bflo(gu.x) * acc[i][j][0]; tot[i][j][1] += bfhi(gu.x) * acc[i][j][1];
                    tot[i][j][2] += bflo(gu.y) * acc[i][j][2]; tot[i][j][3] += bfhi(gu.y) * acc[i][j][3];
                }
        }
        acc_foreach<2>(tot, [&](int m, int n, const f32x4& v) { store_bf16x4(MG + (size_t)(mt * 64 + m) * 1024 + nt * 128 + n, v); });
    }
}
__device__ __forceinline__ void ph_out(const Params& p, int l, char* smem) {
    const bf16_t* MG = (const bf16_t*)(p.ws + O_H); const bf16_t* W = (const bf16_t*)(p.ws + O_WB + W_OUT);
    float* xcur = (float*)(p.ws + O_XCUR); const float* mod = (const float*)(p.ws + O_MOD);
    const int nmt = (l < NLAYER - 1) ? RT / 128 : RL / 128;
    for (int it = blockIdx.x; it < nmt * 8; it += gridDim.x) {
        const int mt = it >> 3, nt = it & 7;
        f32x4 acc[4][4];
        RPPlain rp{MG + (size_t)mt * 128 * 1024, 1024};
        gemm_core_g<4>(rp, W + (size_t)nt * 128 * 1024, 1024, 1024, acc, smem);
        acc_foreach<4>(acc, [&](int m, int n, const f32x4& v) {
            const int row = mt * 128 + m, col = nt * 128 + n;
            const float4 g = *(const float4*)(mod + (size_t)(l * 5 + modidx(row)) * 6144 + 2048 + col);
            float4* xp = (float4*)(xcur + (size_t)row * 1024 + col);
            float4 x = *xp; x.x += g.x * v[0]; x.y += g.y * v[1]; x.z += g.z * v[2]; x.w += g.w * v[3]; *xp = x;
        });
    }
}

__device__ __forceinline__ void ph_n2(const Params& p, int l) {
    const int lane = tidx() & 63, wave = tidx() >> 6;
    const float* xcur = (const float*)(p.ws + O_XCUR); const float* mod = (const float*)(p.ws + O_MOD);
    bf16_t* H = (bf16_t*)(p.ws + O_H);
    unsigned* cnt = (unsigned*)(p.ws + O_CNT); int* LTOK = (int*)(p.ws + O_LTOK); float* LW = (float*)(p.ws + O_LW); int* SLOT = (int*)(p.ws + O_SLOT);
    const float* g = p.in[I_N2G] + l * 1024; const float* rw = p.in[I_RW]; const float* rb = p.in[I_RB];
    const int nrows = (l < NLAYER - 1) ? RT : RL;
    for (int row = blockIdx.x * 4 + wave; row < nrows; row += gridDim.x * 4) {
        const float* x = xcur + (size_t)row * 1024; const float* md = mod + (size_t)(l * 5 + modidx(row)) * 6144;
        float4 v[4]; float ss = 0.f;
#pragma unroll
        for (int i = 0; i < 4; ++i) { v[i] = *(const float4*)(x + lane * 4 + 256 * i); ss += v[i].x * v[i].x + v[i].y * v[i].y + v[i].z * v[i].z + v[i].w * v[i].w; }
        ss = wsum(ss);
        const float rstd = rsqrtf(ss * (1.f / 1024.f) + 1e-6f);
        float lg[16];
#pragma unroll
        for (int e = 0; e < 16; ++e) lg[e] = 0.f;
#pragma unroll
        for (int i = 0; i < 4; ++i) {
            const int c = lane * 4 + 256 * i;
            const float4 gg = *(const float4*)(g + c), sc = *(const float4*)(md + 4096 + c), sh = *(const float4*)(md + 3072 + c);
            const float hv[4] = {v[i].x * rstd * gg.x * (1.f + sc.x) + sh.x, v[i].y * rstd * gg.y * (1.f + sc.y) + sh.y,
                                 v[i].z * rstd * gg.z * (1.f + sc.z) + sh.z, v[i].w * rstd * gg.w * (1.f + sc.w) + sh.w};
            f32x4 h4 = {hv[0], hv[1], hv[2], hv[3]};
            store_bf16x4(H + (size_t)row * 1024 + c, h4);
#pragma unroll
            for (int j = 0; j < 4; ++j) {
                const float* wr_ = rw + (size_t)(c + j) * 16;
                const float4 w0 = *(const float4*)wr_, w1 = *(const float4*)(wr_ + 4), w2 = *(const float4*)(wr_ + 8), w3 = *(const float4*)(wr_ + 12);
                lg[0] += hv[j] * w0.x; lg[1] += hv[j] * w0.y; lg[2] += hv[j] * w0.z; lg[3] += hv[j] * w0.w;
                lg[4] += hv[j] * w1.x; lg[5] += hv[j] * w1.y; lg[6] += hv[j] * w1.z; lg[7] += hv[j] * w1.w;
                lg[8] += hv[j] * w2.x; lg[9] += hv[j] * w2.y; lg[10] += hv[j] * w2.z; lg[11] += hv[j] * w2.w;
                lg[12] += hv[j] * w3.x; lg[13] += hv[j] * w3.y; lg[14] += hv[j] * w3.z; lg[15] += hv[j] * w3.w;
            }
        }
        float sc_[16], sel[16];
#pragma unroll
        for (int e = 0; e < 16; ++e) { lg[e] = wsum(lg[e]); sc_[e] = 1.f / (1.f + expf(-lg[e])); sel[e] = sc_[e] + rb[e]; }
        int best = 0; float bestv = -1e30f;
#pragma unroll
        for (int gi = 0; gi < 4; ++gi) {
            float m1 = -1e30f, m2 = -1e30f;
#pragma unroll
            for (int j = 0; j < 4; ++j) { const float s = sel[gi * 4 + j]; if (s > m1) { m2 = m1; m1 = s; } else if (s > m2) m2 = s; }
            const float gs = m1 + m2;
            if (gs > bestv) { bestv = gs; best = gi; }
        }
        float s4[4] = {0.f, 0.f, 0.f, 0.f}, c4[4] = {0.f, 0.f, 0.f, 0.f};
#pragma unroll
        for (int gi = 0; gi < 4; ++gi)
#pragma unroll
            for (int j = 0; j < 4; ++j) if (gi == best) { s4[j] = sel[gi * 4 + j]; c4[j] = sc_[gi * 4 + j]; }
        int i1 = 0; float v1 = s4[0], w1 = c4[0];
#pragma unroll
        for (int j = 1; j < 4; ++j) if (s4[j] > v1) { v1 = s4[j]; i1 = j; w1 = c4[j]; }
        int i2 = -1; float v2 = -1e30f, w2 = 0.f;
#pragma unroll
        for (int j = 0; j < 4; ++j) if (j != i1 && s4[j] > v2) { v2 = s4[j]; i2 = j; w2 = c4[j]; }
        if (lane == 0) {
            const float inv = 1.f / (w1 + w2);
            const int e1 = best * 4 + i1, e2 = best * 4 + i2;
            const unsigned p1 = atomicAdd(&cnt[e1], 1u), p2 = atomicAdd(&cnt[e2], 1u);
            LTOK[(size_t)e1 * RT + p1] = row; LW[(size_t)e1 * RT + p1] = w1 * inv;
            LTOK[(size_t)e2 * RT + p2] = row; LW[(size_t)e2 * RT + p2] = w2 * inv;
            SLOT[row * 2] = (e1 << 20) | (int)p1; SLOT[row * 2 + 1] = (e2 << 20) | (int)p2;
        }
    }
}

struct MoeTiles { int tb[17]; int sm; };
__device__ __forceinline__ void moe_tiles(const Params& p, int l, int* s_tb) {
    if (tidx() == 0) {
        const unsigned* cnt = (const unsigned*)(p.ws + O_CNT);
        int a = 0;
        for (int e = 0; e < 16; ++e) { s_tb[e] = a; a += ((int)cnt[e] + 127) >> 7; }
        s_tb[16] = a;
    }
    __syncthreads();
}
struct ALGather {
    const bf16_t* p[4]; bool ok[4];
    __device__ __forceinline__ uint4 load(int i, int k) const { return ok[i] ? *(const uint4*)(p[i] + k) : make_uint4(0u, 0u, 0u, 0u); }
};
struct ALSwiglu {
    const bf16_t* p[4]; float w[4];
    __device__ __forceinline__ uint4 load(int i, int k) const {
        float g[8], u[8], o[8]; unpack8(*(const uint4*)(p[i] + k), g); unpack8(*(const uint4*)(p[i] + 512 + k), u);
#pragma unroll
        for (int j = 0; j < 8; ++j) o[j] = siluf_(g[j]) * u[j] * w[i];
        return pack8(o);
    }
};
__device__ __forceinline__ void ph_e1(const Params& p, int l, char* smem) {
    int* s_tb = (int*)(smem + 73728);
    moe_tiles(p, l, s_tb);
    const bf16_t* H = (const bf16_t*)(p.ws + O_H); bf16_t* GU = (bf16_t*)(p.ws + O_P);
    const unsigned* cnt = (const unsigned*)(p.ws + O_CNT); const int* LTOK = (const int*)(p.ws + O_LTOK);
    const int sm = (l < NLAYER - 1) ? RT / 128 : RL / 128;
    const int total = (sm + s_tb[16]) * 8;
    for (int it = blockIdx.x; it < total; it += gridDim.x) {
        const int mt = it >> 3, nt = it & 7;
        int e = 16, erow0 = mt * 128, lt = 0;
        if (mt >= sm) { const int q = mt - sm; e = 0; while (q >= s_tb[e + 1]) ++e; lt = q - s_tb[e]; erow0 = RT + q * 128; }
        const int cnte = (e == 16) ? 0 : (int)cnt[e];
        auto rp = [&](int r) -> const bf16_t* {
            if (e == 16) return H + (size_t)(mt * 128 + r) * 1024;
            const int idx = lt * 128 + r;
            const int tok = idx < cnte ? LTOK[(size_t)e * RT + idx] : 0;
            return H + (size_t)tok * 1024;
        };
        f32x4 acc[4][4];
        gemm_core_g<4>(rp, (const bf16_t*)(p.ws + O_WB + W_GU) + (size_t)e * 1024 * 1024 + (size_t)nt * 128 * 1024, 1024, 1024, acc, smem);
        acc_foreach<4>(acc, [&](int m, int n, const f32x4& v) { store_bf16x4(GU + (size_t)(erow0 + m) * 1024 + nt * 128 + n, v); });
    }
}
__device__ __forceinline__ void ph_e2(const Params& p, int l, char* smem) {
    int* s_tb = (int*)(smem + 73728);
    moe_tiles(p, l, s_tb);
    const bf16_t* GU = (const bf16_t*)(p.ws + O_P); bf16_t* YE = (bf16_t*)(p.ws + O_X + X_YE);
    const unsigned* cnt = (const unsigned*)(p.ws + O_CNT); const float* LW = (const float*)(p.ws + O_LW);
    const int sm = (l < NLAYER - 1) ? RT / 128 : RL / 128;
    const int total = (sm + s_tb[16]) * 8;
    for (int it = blockIdx.x; it < total; it += gridDim.x) {
        const int mt = it >> 3, nt = it & 7;
        int e = 16, erow0 = mt * 128, lt = 0;
        if (mt >= sm) { const int q = mt - sm; e = 0; while (q >= s_tb[e + 1]) ++e; lt = q - s_tb[e]; erow0 = RT + q * 128; }
        ALSwiglu al;
#pragma unroll
        for (int i = 0; i < 4; ++i) {
            const int r = (tidx() >> 3) + 32 * i;
            al.p[i] = GU + (size_t)(erow0 + r) * 1024;
            if (e == 16) al.w[i] = 1.f;
            else { const int idx = lt * 128 + r; al.w[i] = idx < (int)cnt[e] ? LW[(size_t)e * RT + idx] : 0.f; }
        }
        f32x4 acc[4][4];
        gemm_core<4>(al, (const bf16_t*)(p.ws + O_WB + W_D) + (size_t)e * 1024 * 512 + (size_t)nt * 128 * 512, 512, 512, acc, smem);
        acc_foreach<4>(acc, [&](int m, int n, const f32x4& v) { store_bf16x4(YE + (size_t)(erow0 + m) * 1024 + nt * 128 + n, v); });
    }
}
__device__ __forceinline__ void ph_e3(const Params& p, int l, char* smem) {
    int* s_tb = (int*)(smem + 73728);
    moe_tiles(p, l, s_tb);
    const int lane = tidx() & 63, wave = tidx() >> 6;
    const bf16_t* YE = (const bf16_t*)(p.ws + O_X + X_YE); const int* SLOT = (const int*)(p.ws + O_SLOT);
    float* xcur = (float*)(p.ws + O_XCUR); const float* mod = (const float*)(p.ws + O_MOD);
    const int nrows = (l < NLAYER - 1) ? RT : RL;
    for (int row = blockIdx.x * 4 + wave; row < nrows; row += gridDim.x * 4) {
        const int s1 = SLOT[row * 2], s2 = SLOT[row * 2 + 1];
        const size_t r0 = row, r1 = (size_t)RT + s_tb[s1 >> 20] * 128 + (s1 & 0xfffff), r2 = (size_t)RT + s_tb[s2 >> 20] * 128 + (s2 & 0xfffff);
        const float* g2 = mod + (size_t)(l * 5 + modidx(row)) * 6144 + 5120;
#pragma unroll
        for (int i = 0; i < 2; ++i) {
            const int c = lane * 8 + 512 * i;
            float a[8], b[8], d[8];
            unpack8(*(const uint4*)(YE + r0 * 1024 + c), a); unpack8(*(const uint4*)(YE + r1 * 1024 + c), b); unpack8(*(const uint4*)(YE + r2 * 1024 + c), d);
            float4* xp = (float4*)(xcur + (size_t)row * 1024 + c);
            float4 x0 = xp[0], x1 = xp[1];
            const float4 ga = *(const float4*)(g2 + c), gb = *(const float4*)(g2 + c + 4);
            x0.x += ga.x * (a[0] + b[0] + d[0]); x0.y += ga.y * (a[1] + b[1] + d[1]); x0.z += ga.z * (a[2] + b[2] + d[2]); x0.w += ga.w * (a[3] + b[3] + d[3]);
            x1.x += gb.x * (a[4] + b[4] + d[4]); x1.y += gb.y * (a[5] + b[5] + d[5]); x1.z += gb.z * (a[6] + b[6] + d[6]); x1.w += gb.w * (a[7] + b[7] + d[7]);
            xp[0] = x0; xp[1] = x1;
        }
    }
}
__device__ __forceinline__ void ph_final(const Params& p) {
    const int lane = tidx() & 63, wave = tidx() >> 6;
    const float* xcur = (const float*)(p.ws + O_XCUR); const float* g = p.in[I_FNG];
    for (int row = blockIdx.x * 4 + wave; row < RL; row += gridDim.x * 4) {
        const float* x = xcur + (size_t)row * 1024;
        float4 v[4]; float ss = 0.f;
#pragma unroll
        for (int i = 0; i < 4; ++i) { v[i] = *(const float4*)(x + lane * 4 + 256 * i); ss += v[i].x * v[i].x + v[i].y * v[i].y + v[i].z * v[i].z + v[i].w * v[i].w; }
        ss = wsum(ss);
        const float rstd = rsqrtf(ss * (1.f / 1024.f) + 1e-6f);
#pragma unroll
        for (int i = 0; i < 4; ++i) {
            const int c = lane * 4 + 256 * i; const float4 gg = *(const float4*)(g + c);
            *(float4*)(p.out + (size_t)row * 1024 + c) = make_float4(v[i].x * rstd * gg.x, v[i].y * rstd * gg.y, v[i].z * rstd * gg.z, v[i].w * rstd * gg.w);
        }
    }
}

constexpr int LDS_BYTES = 76800;
constexpr int NIV = 19;
extern __shared__ __attribute__((aligned(16))) char dynsmem[];
template <int ID> __device__ __forceinline__ void run_iv(const Params& pin, int l, char* smem) {
    Params p = pin; p.ws = launder(pin.ws);
    if constexpr (ID == 0) { ph_pre(p, smem); __syncthreads(); ph_w(p, 0, smem); }
    else if constexpr (ID == 1) ph_n1(p, l);
    else if constexpr (ID == 2) ph_g1(p, smem);
    else if constexpr (ID == 3) ph_qu(p, smem);
    else if constexpr (ID == 4) ph_m2(p);
    else if constexpr (ID == 5) ph_at(p, l, smem);
    else if constexpr (ID == 6) { ph_rp1(p, l, smem); ph_rp2(p, l); }
    else if constexpr (ID == 7) ph_r1(p, l, smem);
    else if constexpr (ID == 8) ph_r2(p);
    else if constexpr (ID == 9) ph_r3(p);
    else if constexpr (ID == 10) { ph_rpost(p, l); ph_f1(p, l, smem); }
    else if constexpr (ID == 11) ph_f2(p, l, smem);
    else if constexpr (ID == 12) ph_mg(p, l, smem);
    else if constexpr (ID == 13) ph_out(p, l, smem);
    else if constexpr (ID == 14) ph_n2(p, l);
    else if constexpr (ID == 15) ph_e1(p, l, smem);
    else if constexpr (ID == 16) ph_e2(p, l, smem);
    else if constexpr (ID == 17) { ph_e3(p, l, smem); __syncthreads(); if (l + 1 < NLAYER) ph_w(p, l + 1, smem); }
    else ph_final(p);
}
#if MEGA
#ifndef PROBE_MASK
#define PROBE_MASK 0
#define PROBE_REP 1
#endif
#define IV(ID) for (int r_ = 0; r_ < (((PROBE_MASK >> (ID)) & 1) ? PROBE_REP : 1); ++r_) { run_iv<ID>(p, l, smem); xcd_barrier(bar); }
__global__ void __launch_bounds__(256, 2) k_mega(Params p) {
    char* smem = dynsmem;
    volatile LAS unsigned* st = (volatile LAS unsigned*)(smem + LDS_BYTES - 16);
    if (tidx() == 0) { st[0] = 0u; st[1] = 0u; }
    __syncthreads();
    XcdBarrier bar = xcd_barrier_post((unsigned*)(p.ws + O_BAR), st);
    { const int l = 0; IV(0) }
    for (int l = 0; l < NLAYER; ++l) {
        IV(1) IV(2) IV(3) IV(4) IV(5) IV(6) IV(7) IV(8) IV(9) IV(10) IV(11) IV(12) IV(13) IV(14) IV(15) IV(16) IV(17)
    }
    run_iv<18>(p, 0, smem);
}
#else
template <int ID> __global__ void __launch_bounds__(256, 2) k_iv(Params p, int l) { run_iv<ID>(p, l, dynsmem); }
template <int ID> static void launch_iv(const Params& p, int l, int grid, hipStream_t s) {
    static bool once = false; if (!once) { once = true; (void)hipFuncSetAttribute((const void*)k_iv<ID>, hipFuncAttributeMaxDynamicSharedMemorySize, LDS_BYTES); }
    hipLaunchKernelGGL(k_iv<ID>, dim3(grid), dim3(256), LDS_BYTES, s, p, l);
}
#endif

extern "C" void kernel_launch(void* const* d_in, const int* in_sizes, int n_in, void* d_out, int out_size, void* d_ws, size_t ws_size, hipStream_t stream) {
    (void)in_sizes; (void)out_size;
    if (n_in < N_IN || ws_size < WS_NEED) return;
    Params p{};
    for (int i = 0; i < N_IN; ++i) p.in[i] = (const float*)d_in[i];
    p.out = (float*)d_out; p.ws = (char*)d_ws;
    static int grid = 0;
    if (!grid) {
        int dev = 0, cus = 0; (void)hipGetDevice(&dev); (void)hipDeviceGetAttribute(&cus, hipDeviceAttributeMultiprocessorCount, dev);
        int per_cu = 2;
#if MEGA
        (void)hipFuncSetAttribute((const void*)k_mega, hipFuncAttributeMaxDynamicSharedMemorySize, LDS_BYTES);
        int occ = 0; (void)hipOccupancyMaxActiveBlocksPerMultiprocessor(&occ, k_mega, 256, LDS_BYTES);
        if (occ < per_cu) per_cu = occ;
        if (per_cu < 1) per_cu = 1;
#endif
        grid = cus * per_cu;
    }
#if MEGA
    (void)hipMemsetAsync(p.ws + O_BAR, 0, 16384, stream);
    hipLaunchKernelGGL(k_mega, dim3(grid), dim3(256), LDS_BYTES, stream, p);
#else
    launch_iv<0>(p, 0, grid, stream);
    for (int l = 0; l < NLAYER; ++l) {
        launch_iv<1>(p, l, grid, stream); launch_iv<2>(p, l, grid, stream); launch_iv<3>(p, l, grid, stream); launch_iv<4>(p, l, grid, stream);
        launch_iv<5>(p, l, grid, stream); launch_iv<6>(p, l, grid, stream); launch_iv<7>(p, l, grid, stream); launch_iv<8>(p, l, grid, stream);
        launch_iv<9>(p, l, grid, stream); launch_iv<10>(p, l, grid, stream); launch_iv<11>(p, l, grid, stream); launch_iv<12>(p, l, grid, stream);
        launch_iv<13>(p, l, grid, stream); launch_iv<14>(p, l, grid, stream); launch_iv<15>(p, l, grid, stream); launch_iv<16>(p, l, grid, stream); launch_iv<17>(p, l, grid, stream);
    }
    launch_iv<18>(p, 0, grid, stream);
#endif
}
```

```cpp
#include <hip/hip_runtime.h>
#include <stdint.h>

#ifndef MEGA
#define MEGA 1
#endif

typedef unsigned short bf16_t;
typedef short bf16x8 __attribute__((ext_vector_type(8)));
typedef float f32x4 __attribute__((ext_vector_type(4)));
typedef float f32x2 __attribute__((ext_vector_type(2)));
typedef unsigned u32x4 __attribute__((ext_vector_type(4)));
typedef __bf16 bf16v2 __attribute__((ext_vector_type(2)));

constexpr int NLAYER = 4;
constexpr int DM = 1024;
constexpr int RL = 16384, RC = 1024, RT = RL + RC;
constexpr int SEQ = 4096, CTX = 256, KEYS = SEQ + CTX;
constexpr int LDP = 6144;
constexpr int PQ0 = 512, PKV0 = 896, PKR0 = 1152, PR0 = 1184, PG0 = 2976, PEND = 6048;
constexpr int NEXP = 16;
constexpr int EROWS = 54272;

enum { I_X = 0, I_C, I_CTX, I_CCTX, I_WADA, I_BADA, I_N1G, I_N2G, I_WIN, I_QNG, I_KVNG, I_WUQ, I_WUKV, I_MU, I_W0, I_WUP, I_A0, I_AUP, I_GUP,
       I_KK, I_KA, I_RK, I_GNG, I_GNB, I_WPA, I_WPB, I_WPC, I_WOUT, I_RW, I_RB, I_EG, I_EU, I_ED, I_SG, I_SU, I_SD, I_FNG, N_IN };

struct Params { const float* in[N_IN]; float* out; char* ws; };

constexpr size_t al256(size_t x) { return (x + 255) & ~(size_t)255; }
constexpr size_t O_BAR   = 0;
constexpr size_t O_CNT   = O_BAR + 16384;
constexpr size_t O_MOD   = O_CNT + 4096;
constexpr size_t O_ROPEC = O_MOD + (size_t)NLAYER * 5 * 6144 * 4;
constexpr size_t O_ROPES = O_ROPEC + (size_t)SEQ * 16 * 4;
constexpr size_t O_CSC   = O_ROPES + (size_t)SEQ * 16 * 4;
constexpr size_t O_CST256= O_CSC + 256 * 128 * 2;
constexpr size_t O_CST   = O_CST256 + 256 * 512 * 2;
constexpr size_t O_XCUR  = O_CST + (size_t)4096 * 8192 * 2;
constexpr size_t O_WB    = O_XCUR + (size_t)RT * DM * 4;
constexpr size_t W_IN   = 0;
constexpr size_t W_UQ   = W_IN + (size_t)6144 * 1024 * 2;
constexpr size_t W_UKV  = W_UQ + (size_t)768 * 384 * 2;
constexpr size_t W_WUP  = W_UKV + (size_t)1024 * 256 * 2;
constexpr size_t W_AUP  = W_WUP + (size_t)2 * 512 * 64 * 2;
constexpr size_t W_GUP  = W_AUP + (size_t)2 * 512 * 64 * 2;
constexpr size_t W_PA   = W_GUP + (size_t)512 * 128 * 2;
constexpr size_t W_PB   = W_PA + (size_t)1024 * 512 * 2;
constexpr size_t W_PC   = W_PB + (size_t)1024 * 512 * 2;
constexpr size_t W_OUT  = W_PC + (size_t)1024 * 512 * 2;
constexpr size_t W_GU   = W_OUT + (size_t)1024 * 1024 * 2;
constexpr size_t W_D    = W_GU + (size_t)17 * 1024 * 1024 * 2;
constexpr size_t W_END  = W_D + (size_t)17 * 1024 * 512 * 2;
constexpr size_t O_H    = O_WB + W_END;
constexpr size_t O_P    = O_H + (size_t)RT * DM * 2;
constexpr size_t O_ATT  = O_P + (size_t)RT * LDP * 2;
constexpr size_t O_RG   = O_ATT + (size_t)RT * 512 * 2;
constexpr size_t O_RWO  = O_RG + (size_t)RT * 512 * 2;
constexpr size_t O_FA   = O_RWO + (size_t)RT * 512 * 2;
constexpr size_t O_LTOK = O_FA + (size_t)RT * 512 * 2;
constexpr size_t O_LW   = O_LTOK + (size_t)NEXP * RT * 4;
constexpr size_t O_SLOT = O_LW + (size_t)NEXP * RT * 4;
constexpr size_t O_X    = al256(O_SLOT + (size_t)RT * 2 * 4);
constexpr size_t X_QRAW = 0;
constexpr size_t X_KVRAW= X_QRAW + (size_t)RT * 768 * 2;
constexpr size_t X_QA   = X_KVRAW + (size_t)RT * 1024 * 2;
constexpr size_t X_KA   = X_QA + (size_t)RT * 768 * 2;
constexpr size_t X_VA   = X_KA + (size_t)4 * KEYS * 768 * 2;
constexpr int NCP = 4 * 8 * 2 * 68;
constexpr size_t X_MT   = 0;
constexpr size_t X_NL   = X_MT + (size_t)NCP * 8192;
constexpr size_t X_GT   = X_NL + (size_t)NCP * 8192;
constexpr size_t X_YL   = X_GT + (size_t)NCP * 8192;
constexpr size_t X_S0   = X_YL + (size_t)NCP * 8192;
constexpr size_t X_KKN  = X_S0 + (size_t)NCP * 8192;
constexpr size_t X_BON  = X_KKN + (size_t)RT * 8 * 4;
constexpr size_t X_END  = X_BON + (size_t)2 * RT * 8 * 4;
constexpr size_t X_YT   = 0;
constexpr size_t X_YTC  = X_YT + (size_t)4 * 512 * 8192 * 2;
constexpr size_t X_YE   = 0;
constexpr size_t WS_NEED = O_X + X_END;

__device__ __forceinline__ float bf2f(bf16_t u) { return __builtin_bit_cast(float, (unsigned)u << 16); }
__device__ __forceinline__ float bflo(unsigned u) { return __builtin_bit_cast(float, u << 16); }
__device__ __forceinline__ float bfhi(unsigned u) { return __builtin_bit_cast(float, u & 0xffff0000u); }
__device__ __forceinline__ unsigned pack2(float lo, float hi) { f32x2 v = {lo, hi}; bf16v2 b = __builtin_convertvector(v, bf16v2); return __builtin_bit_cast(unsigned, b); }
__device__ __forceinline__ bf16_t f2bf(float f) { return (bf16_t)(pack2(f, 0.f) & 0xffffu); }
__device__ __forceinline__ float wsum(float v) {
#pragma unroll
    for (int o = 32; o > 0; o >>= 1) v += __shfl_xor(v, o);
    return v;
}
__device__ __forceinline__ float sigmoidf_(float x) { return 1.f / (1.f + __expf(-x)); }
__device__ __forceinline__ float siluf_(float x) { return x / (1.f + __expf(-x)); }
__device__ __forceinline__ int modidx(int row) { return row < RL ? (row >> 12) : 4; }
__device__ __forceinline__ void unpack8(const uint4& u, float (&f)[8]) {
    f[0] = bflo(u.x); f[1] = bfhi(u.x); f[2] = bflo(u.y); f[3] = bfhi(u.y); f[4] = bflo(u.z); f[5] = bfhi(u.z); f[6] = bflo(u.w); f[7] = bfhi(u.w);
}
__device__ __forceinline__ uint4 pack8(const float (&f)[8]) { return make_uint4(pack2(f[0], f[1]), pack2(f[2], f[3]), pack2(f[4], f[5]), pack2(f[6], f[7])); }

#define XB_TMO      128
#define XB_XCNT(j)  (256  + 64 * (j))
#define XB_XSUB(j)  (1280 + 64 * (j))
#define XB_XGEN(j)  (2304 + 64 * (j))
#define XB_TOP      3328
#define XB_TOPGEN   3392
#define XCD_BAR_WORDS 3456
#define XB_SPIN_CAP (1u << 22)
#define LAS __attribute__((address_space(3)))
__device__ __forceinline__ unsigned xb_ld(unsigned* p)              { return __hip_atomic_load(p, __ATOMIC_RELAXED, __HIP_MEMORY_SCOPE_AGENT); }
__device__ __forceinline__ unsigned xb_add(unsigned* p, unsigned v) { return __hip_atomic_fetch_add(p, v, __ATOMIC_RELAXED, __HIP_MEMORY_SCOPE_AGENT); }
__device__ __forceinline__ unsigned xb_xcc_id() { return (unsigned)__builtin_amdgcn_s_getreg((3 << 11) | 20) & 0xFu; }
#define XB_SPIN(cond, bar) do { unsigned _sp = 0; while (cond) { __builtin_amdgcn_s_sleep(1); \
    if ((++_sp & 255u) == 0u) { if (xb_ld(&(bar)[XB_TMO])) break; if (_sp > XB_SPIN_CAP) { atomicAdd(&(bar)[XB_TMO], 1u); break; } } } } while (0)
struct XcdBarrier { unsigned* bar; unsigned x; volatile LAS unsigned* st; };
__device__ __forceinline__ XcdBarrier xcd_barrier_post(unsigned* bar, volatile LAS unsigned* st) {
    XcdBarrier b; b.bar = bar; b.x = xb_xcc_id(); b.st = st;
    if (threadIdx.x == 0) (void)xb_add(&bar[XB_XCNT(b.x)], 1u);
    return b;
}
__device__ __forceinline__ void xcd_barrier_complete(unsigned* bar, unsigned x, unsigned& nloc, unsigned& nx) {
    const unsigned G = gridDim.x * gridDim.y * gridDim.z;
    unsigned sum, cnt, mine, sp = 0u;
    for (;;) {
        sum = 0u; cnt = 0u; mine = 0u;
#pragma unroll
        for (unsigned j = 0; j < 16; ++j) { const unsigned c = xb_ld(&bar[XB_XCNT(j)]); sum += c; cnt += (c > 0u) ? 1u : 0u; mine = (j == x) ? c : mine; }
        if (sum == G) break;
        __builtin_amdgcn_s_sleep(1);
        if ((++sp & 255u) == 0u) { if (xb_ld(&bar[XB_TMO])) break; if (sp > XB_SPIN_CAP) { atomicAdd(&bar[XB_TMO], 1u); break; } }
    }
    nloc = mine > 0u ? mine : 1u; nx = cnt > 0u ? cnt : 1u;
}
__device__ __forceinline__ void xcd_barrier(const XcdBarrier& b) {
    asm volatile("s_waitcnt vmcnt(0)" ::: "memory");
    __syncthreads();
    if (threadIdx.x == 0) {
        unsigned* bar = b.bar;
        __builtin_amdgcn_s_waitcnt(0);
        unsigned nloc = b.st[0], nx = b.st[1];
        if (nloc == 0u) { xcd_barrier_complete(bar, b.x, nloc, nx); b.st[0] = nloc; b.st[1] = nx; }
        const unsigned old = xb_add(&bar[XB_XSUB(b.x)], 1u);
        const unsigned gen = old / nloc;
        if (old + 1u == (gen + 1u) * nloc) {
            __builtin_amdgcn_fence(__ATOMIC_RELEASE, "agent");
            asm volatile("s_waitcnt vmcnt(0)" ::: "memory");
            const unsigned og = xb_add(&bar[XB_TOP], 1u);
            const unsigned tg = og / nx;
            if (og + 1u == (tg + 1u) * nx) xb_add(&bar[XB_TOPGEN], 1u);
            else XB_SPIN(xb_ld(&bar[XB_TOPGEN]) == tg, bar);
            __builtin_amdgcn_fence(__ATOMIC_ACQUIRE, "agent");
            xb_add(&bar[XB_XGEN(b.x)], 1u);
            asm volatile("s_waitcnt vmcnt(0)" ::: "memory");
        } else {
            XB_SPIN(xb_ld(&bar[XB_XGEN(b.x)]) == gen, bar);
            __builtin_amdgcn_fence(__ATOMIC_ACQUIRE, "agent");
            asm volatile("s_waitcnt vmcnt(0)" ::: "memory");
        }
    }
    __syncthreads();
}

__device__ __forceinline__ int tidx() { int t = threadIdx.x; asm volatile("" : "+v"(t)); return t; }
__device__ __forceinline__ int lv(int x) { asm volatile("" : "+v"(x)); return x; }
__device__ __forceinline__ char* launder(char* p) { size_t z = 0; asm volatile("" : "+s"(z)); return p + z; }

constexpr int LDSROW = 72;
template <int NA, class AL>
__device__ __forceinline__ void gc_load(const AL& al, const bf16_t* bp, size_t bstep, int k0, int kc, u32x4 (&ra)[NA], u32x4 (&rb)[4]) {
#pragma unroll
    for (int i = 0; i < NA; ++i) ra[i] = __builtin_bit_cast(u32x4, al.load(i, k0 + kc));
#pragma unroll
    for (int j = 0; j < 4; ++j) rb[j] = *(const u32x4*)(bp + j * bstep + k0);
}
template <int NA>
__device__ __forceinline__ void gc_store(bf16_t* Ab, bf16_t* Bb, int lr, int kc, const u32x4 (&ra)[NA], const u32x4 (&rb)[4]) {
#pragma unroll
    for (int i = 0; i < NA; ++i) *(u32x4*)(Ab + (lr + 32 * i) * LDSROW + kc) = ra[i];
#pragma unroll
    for (int j = 0; j < 4; ++j) *(u32x4*)(Bb + (lr + 32 * j) * LDSROW + kc) = rb[j];
}
template <int MI>
__device__ __forceinline__ void gc_compute(const bf16_t* Ac, const bf16_t* Bc, f32x4 (&acc)[MI][4]) {
#pragma unroll
    for (int kh = 0; kh < 2; ++kh) {
        bf16x8 af[MI], bfv[4];
#pragma unroll
        for (int i = 0; i < MI; ++i) af[i] = *(const bf16x8*)(Ac + i * 16 * LDSROW + kh * 32);
#pragma unroll
        for (int j = 0; j < 4; ++j) bfv[j] = *(const bf16x8*)(Bc + j * 16 * LDSROW + kh * 32);
#pragma unroll
        for (int i = 0; i < MI; ++i)
#pragma unroll
            for (int j = 0; j < 4; ++j) acc[i][j] = __builtin_amdgcn_mfma_f32_16x16x32_bf16(bfv[j], af[i], acc[i][j], 0, 0, 0);
    }
}
template <int MI, class AL>
__device__ __forceinline__ void gemm_core(const AL& al, const bf16_t* __restrict__ Bt, int ldb, int K, f32x4 (&acc)[MI][4], char* smem) {
    constexpr int TM = MI * 32;
    constexpr int NA = TM / 32;
    bf16_t* As = (bf16_t*)smem;
    bf16_t* Bs = As + 2 * TM * LDSROW;
    const int tid = tidx(), lane = tid & 63, wave = tid >> 6;
    const int wr = wave >> 1, wc = wave & 1, fr = lane & 15, fq = lane >> 4;
    const int kc = (tid & 7) * 8, lr = tid >> 3;
#pragma unroll
    for (int i = 0; i < MI; ++i)
#pragma unroll
        for (int j = 0; j < 4; ++j) acc[i][j] = (f32x4){0.f, 0.f, 0.f, 0.f};
    u32x4 a0[NA], b0[4], a1[NA], b1[4];
    const bf16_t* bp = Bt + (size_t)lr * ldb + kc;
    const size_t bstep = (size_t)32 * ldb;
    const int nk = K >> 6;
    bf16_t* As1 = As + TM * LDSROW; bf16_t* Bs1 = Bs + 128 * LDSROW;
    const int aoff = (wr * MI * 16 + fr) * LDSROW + fq * 8, boff = (wc * 64 + fr) * LDSROW + fq * 8;
    gc_load<NA>(al, bp, bstep, 0, kc, a0, b0);
    gc_store<NA>(As, Bs, lr, kc, a0, b0);
    if (nk > 1) gc_load<NA>(al, bp, bstep, 64, kc, a0, b0);
    __syncthreads();
    for (int kt = 0; kt < nk; kt += 2) {
        if (kt + 2 < nk) gc_load<NA>(al, bp, bstep, (kt + 2) << 6, kc, a1, b1);
        gc_compute<MI>(As + aoff, Bs + boff, acc);
        if (kt + 1 < nk) gc_store<NA>(As1, Bs1, lr, kc, a0, b0);
        __syncthreads();
        if (kt + 1 >= nk) break;
        if (kt + 3 < nk) gc_load<NA>(al, bp, bstep, (kt + 3) << 6, kc, a0, b0);
        gc_compute<MI>(As1 + aoff, Bs1 + boff, acc);
        if (kt + 2 < nk) gc_store<NA>(As, Bs, lr, kc, a1, b1);
        __syncthreads();
    }
}
template <int MI, class RP>
__device__ __forceinline__ void gemm_core_g(const RP& rp, const bf16_t* __restrict__ Bt, int ldb, int K, f32x4 (&acc)[MI][4], char* smem) {
    constexpr int ABYTES = MI * 32 * 128;
    constexpr int SBYTES = ABYTES + 16384;
    const int tid = tidx(), lane = tid & 63, wave = tid >> 6;
    const int wr = wave >> 1, wc = wave & 1, fr = lane & 15, fq = lane >> 4;
    const int rr = lane >> 3, cs = ((lane & 7) ^ ((wave * 4 + (lane >> 4)) & 7)) * 8;
#pragma unroll
    for (int i = 0; i < MI; ++i)
#pragma unroll
        for (int j = 0; j < 4; ++j) acc[i][j] = (f32x4){0.f, 0.f, 0.f, 0.f};
    const bf16_t* ap[MI]; const bf16_t* bp[4];
#pragma unroll
    for (int i = 0; i < MI; ++i) { const int r = (i * 4 + wave) * 8 + rr; ap[i] = rp(r) + cs; }
#pragma unroll
    for (int i = 0; i < 4; ++i) { const int r = (i * 4 + wave) * 8 + rr; bp[i] = Bt + (size_t)r * ldb + cs; }
    const int wbase = __builtin_amdgcn_readfirstlane(wave) * 1024;
    const int nk = K >> 6;
    auto stage = [&](int buf, int kt) {
        char* Ab = smem + buf * SBYTES + wbase; char* Bb = Ab + ABYTES;
#pragma unroll
        for (int i = 0; i < MI; ++i) __builtin_amdgcn_global_load_lds((const unsigned*)(ap[i] + kt * 64), (unsigned*)(Ab + i * 4096), 16, 0, 0);
#pragma unroll
        for (int i = 0; i < 4; ++i) __builtin_amdgcn_global_load_lds((const unsigned*)(bp[i] + kt * 64), (unsigned*)(Bb + i * 4096), 16, 0, 0);
    };
    const int aoff = (wr * MI * 16 + fr) * 128, boff = ABYTES + (wc * 64 + fr) * 128, sw = fr >> 1;
    stage(0, 0);
    asm volatile("s_waitcnt vmcnt(0)" ::: "memory");
    __syncthreads();
    for (int kt = 0; kt < nk; ++kt) {
        const int cur = kt & 1;
        if (kt + 1 < nk) stage(cur ^ 1, kt + 1);
        const char* base = smem + cur * SBYTES;
#pragma unroll
        for (int kh = 0; kh < 2; ++kh) {
            const int xo = ((kh * 4 + fq) ^ sw) * 16;
            bf16x8 af[MI], bfv[4];
#pragma unroll
            for (int i = 0; i < MI; ++i) af[i] = *(const bf16x8*)(base + aoff + i * 2048 + xo);
#pragma unroll
            for (int j = 0; j < 4; ++j) bfv[j] = *(const bf16x8*)(base + boff + j * 2048 + xo);
#pragma unroll
            for (int i = 0; i < MI; ++i)
#pragma unroll
                for (int j = 0; j < 4; ++j) acc[i][j] = __builtin_amdgcn_mfma_f32_16x16x32_bf16(bfv[j], af[i], acc[i][j], 0, 0, 0);
        }
        asm volatile("s_waitcnt vmcnt(0)" ::: "memory");
        __syncthreads();
    }
}
struct RPPlain {
    const bf16_t* A; size_t lda;
    __device__ __forceinline__ const bf16_t* operator()(int r) const { return A + (size_t)r * lda; }
};
template <int MI, class F>
__device__ __forceinline__ void acc_foreach(const f32x4 (&acc)[MI][4], F f) {
    const int lane = tidx() & 63, wave = tidx() >> 6;
    const int wr = wave >> 1, wc = wave & 1, fr = lane & 15, fq = lane >> 4;
#pragma unroll
    for (int i = 0; i < MI; ++i)
#pragma unroll
        for (int j = 0; j < 4; ++j) f(wr * MI * 16 + i * 16 + fr, wc * 64 + j * 16 + fq * 4, acc[i][j]);
}
struct ALPlain {
    const bf16_t* p0; size_t step;
    __device__ __forceinline__ ALPlain(const bf16_t* A, int lda, int row0) { p0 = A + (size_t)(row0 + (tidx() >> 3)) * lda; step = (size_t)32 * lda; }
    __device__ __forceinline__ uint4 load(int i, int k) const { return *(const uint4*)(p0 + i * step + k); }
};
__device__ __forceinline__ void store_bf16x4(bf16_t* dst, const f32x4& v) { *(uint2*)dst = make_uint2(pack2(v[0], v[1]), pack2(v[2], v[3])); }

__device__ __forceinline__ void ph_pre(const Params& p, char* smem) {
    const int tid = tidx(), nb = gridDim.x, bid = blockIdx.x;
    float* mod = (float*)(p.ws + O_MOD);
    {
        float* sv = (float*)smem;
        float* part = sv + 5 * 1024;
        for (int i = tid; i < 5 * 1024; i += 256) { const float v = (i < 4096) ? p.in[I_C][i] : p.in[I_CCTX][i - 4096]; sv[i] = siluf_(v); }
        __syncthreads();
        for (int it = bid; it < NLAYER * 96; it += nb) {
            const int l = it / 96, jb = it % 96;
            const int jj = tid & 63, kq = tid >> 6, j = jb * 64 + jj;
            const float* w = p.in[I_WADA] + (size_t)l * 1024 * 6144 + (size_t)(kq * 256) * 6144 + j;
            float a0 = 0.f, a1 = 0.f, a2 = 0.f, a3 = 0.f, a4 = 0.f;
#pragma unroll 8
            for (int k = 0; k < 256; ++k) {
                const float wv = w[(size_t)k * 6144]; const int kk = kq * 256 + k;
                a0 += sv[kk] * wv; a1 += sv[1024 + kk] * wv; a2 += sv[2048 + kk] * wv; a3 += sv[3072 + kk] * wv; a4 += sv[4096 + kk] * wv;
            }
            part[(kq * 5 + 0) * 64 + jj] = a0; part[(kq * 5 + 1) * 64 + jj] = a1; part[(kq * 5 + 2) * 64 + jj] = a2;
            part[(kq * 5 + 3) * 64 + jj] = a3; part[(kq * 5 + 4) * 64 + jj] = a4;
            __syncthreads();
            for (int o = tid; o < 320; o += 256) {
                const int i = o >> 6, c = o & 63;
                const float s = part[(0 * 5 + i) * 64 + c] + part[(1 * 5 + i) * 64 + c] + part[(2 * 5 + i) * 64 + c] + part[(3 * 5 + i) * 64 + c];
                mod[(size_t)(l * 5 + i) * 6144 + jb * 64 + c] = s + p.in[I_BADA][l * 6144 + jb * 64 + c];
            }
            __syncthreads();
        }
    }
    {
        float4* xc = (float4*)(p.ws + O_XCUR);
        const float4* x4 = (const float4*)p.in[I_X]; const float4* c4 = (const float4*)p.in[I_CTX];
        for (size_t i = (size_t)bid * 256 + tid; i < (size_t)RT * 256; i += (size_t)nb * 256) xc[i] = (i < (size_t)RL * 256) ? x4[i] : c4[i - (size_t)RL * 256];
    }
    {
        float* ct = (float*)smem;
        __syncthreads();
        for (int m = tid; m < 4096; m += 256) ct[m] = cospif((float)m * (1.f / 2048.f));
        __syncthreads();
        bf16_t* cst = (bf16_t*)(p.ws + O_CST);
        for (size_t ch = (size_t)bid * 256 + tid; ch < (size_t)4096 * 8192 / 8; ch += (size_t)nb * 256) {
            const int kt = (int)(ch >> 10), c0 = (int)(ch & 1023) * 8, part = c0 >> 12, t0 = c0 & 4095;
            float f[8];
#pragma unroll
            for (int e = 0; e < 8; ++e) { const int m = (kt * (t0 + e)) & 4095; f[e] = part == 0 ? ct[m] : -ct[(m - 1024) & 4095]; }
            *(uint4*)(cst + ch * 8) = pack8(f);
        }
        bf16_t* cst2 = (bf16_t*)(p.ws + O_CST256);
        for (int ch = bid * 256 + tid; ch < 256 * 512 / 8; ch += nb * 256) {
            const int ks = ch >> 6, c0 = (ch & 63) * 8, part = c0 >> 8, s0 = c0 & 255;
            float f[8];
#pragma unroll
            for (int e = 0; e < 8; ++e) { const int m = (16 * ks * (s0 + e)) & 4095; f[e] = part == 0 ? ct[m] : -ct[(m - 1024) & 4095]; }
            *(uint4*)(cst2 + ch * 8) = pack8(f);
        }
        bf16_t* csc = (bf16_t*)(p.ws + O_CSC);
        for (int ch = bid * 256 + tid; ch < 256 * 128 / 8; ch += nb * 256) {
            const int n = ch >> 4, c0 = (ch & 15) * 8, part = n >> 7, kc = n & 127;
            float f[8];
#pragma unroll
            for (int e = 0; e < 8; ++e) { const int m = (32 * kc * (c0 + e)) & 4095; f[e] = part == 0 ? ct[m] : ct[(m - 1024) & 4095]; }
            *(uint4*)(csc + ch * 8) = pack8(f);
        }
        float* rc = (float*)(p.ws + O_ROPEC); float* rs = (float*)(p.ws + O_ROPES);
        for (int i = bid * 256 + tid; i < SEQ * 16; i += nb * 256) {
            const int t = i >> 4, ax = (i >> 3) & 1, f = i & 7;
            const float inv = powf(10000.f, -(float)f / 8.f);
            const float pos = (float)(ax == 0 ? (t >> 6) : (t & 63));
            const float ang = pos * inv;
            rc[i] = cosf(ang); rs[i] = sinf(ang);
        }
    }
}

struct ConvTask { const float* src; const float* scale; bf16_t* dst; int K, Nsrc, Ndst; size_t sbs, dbs; };
__constant__ int c_conv_cum[17] = {0, 1536, 1608, 1672, 1688, 1704, 1720, 1848, 1976, 2104, 2360, 4408, 6456, 8504, 8632, 8760, 8888};
__device__ __forceinline__ ConvTask conv_task(const Params& p, int l, int t) {
    bf16_t* wb = (bf16_t*)(p.ws + O_WB);
    ConvTask c; c.scale = nullptr; c.sbs = 0; c.dbs = 0;
    switch (t) {
    case 0:  c.src = p.in[I_WIN] + (size_t)l * 1024 * 6048; c.K = 1024; c.Nsrc = 6048; c.Ndst = 6144; c.dst = wb + W_IN / 2; break;
    case 1:  c.src = p.in[I_WUQ] + (size_t)l * 384 * 768; c.K = 384; c.Nsrc = 768; c.Ndst = 768; c.dst = wb + W_UQ / 2; c.scale = p.in[I_QNG] + l * 384; break;
    case 2:  c.src = p.in[I_WUKV] + (size_t)l * 256 * 1024; c.K = 256; c.Nsrc = 1024; c.Ndst = 1024; c.dst = wb + W_UKV / 2; c.scale = p.in[I_KVNG] + l * 256; break;
    case 3:  c.src = p.in[I_WUP] + (size_t)l * 2 * 64 * 512; c.K = 64; c.Nsrc = 512; c.Ndst = 512; c.dst = wb + W_WUP / 2; c.sbs = 64 * 512; c.dbs = 512 * 64; break;
    case 4:  c.src = p.in[I_AUP] + (size_t)l * 2 * 64 * 512; c.K = 64; c.Nsrc = 512; c.Ndst = 512; c.dst = wb + W_AUP / 2; c.sbs = 64 * 512; c.dbs = 512 * 64; break;
    case 5:  c.src = p.in[I_GUP] + (size_t)l * 128 * 512; c.K = 128; c.Nsrc = 512; c.Ndst = 512; c.dst = wb + W_GUP / 2; break;
    case 6:  c.src = p.in[I_WPA] + (size_t)l * 512 * 1024; c.K = 512; c.Nsrc = 1024; c.Ndst = 1024; c.dst = wb + W_PA / 2; break;
    case 7:  c.src = p.in[I_WPB] + (size_t)l * 512 * 1024; c.K = 512; c.Nsrc = 1024; c.Ndst = 1024; c.dst = wb + W_PB / 2; break;
    case 8:  c.src = p.in[I_WPC] + (size_t)l * 512 * 1024; c.K = 512; c.Nsrc = 1024; c.Ndst = 1024; c.dst = wb + W_PC / 2; break;
    case 9:  c.src = p.in[I_WOUT] + (size_t)l * 1024 * 1024; c.K = 1024; c.Nsrc = 1024; c.Ndst = 1024; c.dst = wb + W_OUT / 2; break;
    case 10: c.src = p.in[I_EG] + (size_t)l * 16 * 1024 * 512; c.K = 1024; c.Nsrc = 512; c.Ndst = 512; c.dst = wb + W_GU / 2; c.sbs = 1024 * 512; c.dbs = 1024 * 1024; break;
    case 11: c.src = p.in[I_EU] + (size_t)l * 16 * 1024 * 512; c.K = 1024; c.Nsrc = 512; c.Ndst = 512; c.dst = wb + W_GU / 2 + 512 * 1024; c.sbs = 1024 * 512; c.dbs = 1024 * 1024; break;
    case 12: c.src = p.in[I_ED] + (size_t)l * 16 * 512 * 1024; c.K = 512; c.Nsrc = 1024; c.Ndst = 1024; c.dst = wb + W_D / 2; c.sbs = 512 * 1024; c.dbs = 1024 * 512; break;
    case 13: c.src = p.in[I_SG] + (size_t)l * 1024 * 512; c.K = 1024; c.Nsrc = 512; c.Ndst = 512; c.dst = wb + W_GU / 2 + (size_t)16 * 1024 * 1024; break;
    case 14: c.src = p.in[I_SU] + (size_t)l * 1024 * 512; c.K = 1024; c.Nsrc = 512; c.Ndst = 512; c.dst = wb + W_GU / 2 + (size_t)16 * 1024 * 1024 + 512 * 1024; break;
    default: c.src = p.in[I_SD] + (size_t)l * 512 * 1024; c.K = 512; c.Nsrc = 1024; c.Ndst = 1024; c.dst = wb + W_D / 2 + (size_t)16 * 1024 * 512; break;
    }
    return c;
}
__device__ __forceinline__ void ph_w(const Params& p, int l, char* smem) {
    const int tid = tidx();
    float* tl = (float*)smem;
    for (int g = blockIdx.x; g < 8888; g += gridDim.x) {
        int t = 0;
        while (g >= c_conv_cum[t + 1]) ++t;
        const ConvTask c = conv_task(p, l, t);
        int r = g - c_conv_cum[t];
        const int nkt = c.K >> 6, nnt = c.Ndst >> 6;
        const int bi = r / (nkt * nnt); r -= bi * nkt * nnt;
        const int k0 = (r / nnt) * 64, n0 = (r % nnt) * 64;
        const float* src = c.src + bi * c.sbs; bf16_t* dst = c.dst + bi * c.dbs;
#pragma unroll
        for (int i = 0; i < 4; ++i) {
            const int k = (tid >> 4) + 16 * i, n = n0 + (tid & 15) * 4;
            float4 v = make_float4(0.f, 0.f, 0.f, 0.f);
            if (n < c.Nsrc) v = *(const float4*)(src + (size_t)(k0 + k) * c.Nsrc + n);
            if (c.scale) { const float s = c.scale[k0 + k]; v.x *= s; v.y *= s; v.z *= s; v.w *= s; }
            float* d = tl + k * 65 + (tid & 15) * 4;
            d[0] = v.x; d[1] = v.y; d[2] = v.z; d[3] = v.w;
        }
        __syncthreads();
        {
            const int n = tid >> 2, kk0 = (tid & 3) * 16;
            float f[8], g2[8];
#pragma unroll
            for (int j = 0; j < 8; ++j) { f[j] = tl[(kk0 + j) * 65 + n]; g2[j] = tl[(kk0 + 8 + j) * 65 + n]; }
            bf16_t* d = dst + (size_t)(n0 + n) * c.K + k0 + kk0;
            *(uint4*)d = pack8(f); *(uint4*)(d + 8) = pack8(g2);
        }
        __syncthreads();
    }
}

__device__ __forceinline__ void ph_n1(const Params& p, int l) {
    const int lane = tidx() & 63, wave = tidx() >> 6;
    const float* xcur = (const float*)(p.ws + O_XCUR); const float* mod = (const float*)(p.ws + O_MOD);
    bf16_t* H = (bf16_t*)(p.ws + O_H);
    if (blockIdx.x == 0 && tidx() < 64) ((unsigned*)(p.ws + O_CNT))[tidx()] = 0u;
    const float* g = p.in[I_N1G] + l * 1024;
    for (int row = blockIdx.x * 4 + wave; row < RT; row += gridDim.x * 4) {
        const float* x = xcur + (size_t)row * 1024; const float* md = mod + (size_t)(l * 5 + modidx(row)) * 6144;
        float4 v[4]; float ss = 0.f;
#pragma unroll
        for (int i = 0; i < 4; ++i) { v[i] = *(const float4*)(x + lane * 4 + 256 * i); ss += v[i].x * v[i].x + v[i].y * v[i].y + v[i].z * v[i].z + v[i].w * v[i].w; }
        ss = wsum(ss);
        const float rstd = rsqrtf(ss * (1.f / 1024.f) + 1e-6f);
#pragma unroll
        for (int i = 0; i < 4; ++i) {
            const int c = lane * 4 + 256 * i;
            const float4 gg = *(const float4*)(g + c), sc = *(const float4*)(md + 1024 + c), sh = *(const float4*)(md + c);
            f32x4 h = {v[i].x * rstd * gg.x * (1.f + sc.x) + sh.x, v[i].y * rstd * gg.y * (1.f + sc.y) + sh.y,
                       v[i].z * rstd * gg.z * (1.f + sc.z) + sh.z, v[i].w * rstd * gg.w * (1.f + sc.w) + sh.w};
            store_bf16x4(H + (size_t)row * 1024 + c, h);
        }
    }
}

__device__ __forceinline__ void ph_g1(const Params& p, char* smem) {
    const bf16_t* H = (const bf16_t*)(p.ws + O_H); const bf16_t* W = (const bf16_t*)(p.ws + O_WB + W_IN);
    bf16_t* P = (bf16_t*)(p.ws + O_P);
    for (int it = blockIdx.x; it < 136 * 48; it += gridDim.x) {
        const int mt = it / 48, nt = it % 48;
        f32x4 acc[4][4];
        RPPlain rp{H + (size_t)mt * 128 * 1024, 1024};
        gemm_core_g<4>(rp, W + (size_t)nt * 128 * 1024, 1024, 1024, acc, smem);
        acc_foreach<4>(acc, [&](int m, int n, const f32x4& v) {
            const int col = nt * 128 + n; f32x4 o = v;
            if (col >= PG0 && col < PEND) { o[0] = sigmoidf_(v[0]); o[1] = sigmoidf_(v[1]); o[2] = sigmoidf_(v[2]); o[3] = sigmoidf_(v[3]); }
            store_bf16x4(P + (size_t)(mt * 128 + m) * LDP + col, o);
        });
    }
}

__device__ __forceinline__ void ph_qu(const Params& p, char* smem) {
    const bf16_t* P = (const bf16_t*)(p.ws + O_P);
    bf16_t* QR = (bf16_t*)(p.ws + O_X + X_QRAW); bf16_t* KVR = (bf16_t*)(p.ws + O_X + X_KVRAW);
    for (int it = blockIdx.x; it < 136 * 14; it += gridDim.x) {
        const int mt = it / 14, nn = it % 14;
        f32x4 acc[4][4];
        if (nn < 6) {
            RPPlain rp{P + (size_t)mt * 128 * LDP + PQ0, LDP};
            gemm_core_g<4>(rp, (const bf16_t*)(p.ws + O_WB + W_UQ) + (size_t)nn * 128 * 384, 384, 384, acc, smem);
            acc_foreach<4>(acc, [&](int m, int n, const f32x4& v) { store_bf16x4(QR + (size_t)(mt * 128 + m) * 768 + nn * 128 + n, v); });
        } else {
            const int nt = nn - 6;
            RPPlain rp{P + (size_t)mt * 128 * LDP + PKV0, LDP};
            gemm_core_g<4>(rp, (const bf16_t*)(p.ws + O_WB + W_UKV) + (size_t)nt * 128 * 256, 256, 256, acc, smem);
            acc_foreach<4>(acc, [&](int m, int n, const f32x4& v) { store_bf16x4(KVR + (size_t)(mt * 128 + m) * 1024 + nt * 128 + n, v); });
        }
    }
}

constexpr float QSCALE = 0.10206207261596575f * 1.4426950408889634f;
__device__ __forceinline__ void ph_m2(const Params& p, char* smem) {
    const int tid = tidx(), lane = tid & 63, wave = tid >> 6;
    const bf16_t* P = (const bf16_t*)(p.ws + O_P);
    const bf16_t* QR = (const bf16_t*)(p.ws + O_X + X_QRAW); const bf16_t* KVR = (const bf16_t*)(p.ws + O_X + X_KVRAW);
    bf16_t* QA = (bf16_t*)(p.ws + O_X + X_QA); bf16_t* KA = (bf16_t*)(p.ws + O_X + X_KA); bf16_t* VA = (bf16_t*)(p.ws + O_X + X_VA);
    const float* rc = (const float*)(p.ws + O_ROPEC); const float* rs = (const float*)(p.ws + O_ROPES);
    for (int row = blockIdx.x * 4 + wave; row < RT; row += gridDim.x * 4) {
        const bool lat = row < RL;
        const int b = lat ? (row >> 12) : ((row - RL) >> 8), t = lat ? (row & 4095) : ((row - RL) & 255);
        const size_t keyrow = (size_t)b * KEYS + (lat ? t : SEQ + t);
        const bf16_t* pr = P + (size_t)row * LDP;
        float sq = 0.f, sk = 0.f;
#pragma unroll
        for (int i = 0; i < 6; ++i) { const float v = bf2f(pr[PQ0 + lane + 64 * i]); sq += v * v; }
#pragma unroll
        for (int i = 0; i < 4; ++i) { const float v = bf2f(pr[PKV0 + lane + 64 * i]); sk += v * v; }
        sq = wsum(sq); sk = wsum(sk);
        const float rq = rsqrtf(sq * (1.f / 384.f) + 1e-6f), rkv = rsqrtf(sk * (1.f / 256.f) + 1e-6f);
        const bf16_t* qr = QR + (size_t)row * 768; const bf16_t* kvr = KVR + (size_t)row * 1024;
        const float* rct = rc + t * 16; const float* rst = rs + t * 16;
#pragma unroll
        for (int i = 0; i < 12; ++i) {
            const int e = lane + 64 * i, h = e / 96, dd = e - h * 96;
            float xq = bf2f(qr[e]) * rq, xk;
            if (dd < 64) xk = bf2f(kvr[h * 128 + dd]) * rkv;
            else {
                const int ii = dd - 64;
                xk = bf2f(pr[PKR0 + ii]);
                if (lat) {
                    const int ax = ii >> 4, half = (ii >> 3) & 1, f = ii & 7;
                    const float c = rct[ax * 8 + f], sn = rst[ax * 8 + f];
                    const float xqp = bf2f(qr[half ? e - 8 : e + 8]) * rq, xkp = bf2f(pr[PKR0 + (ii ^ 8)]);
                    xq = half ? (xq * c + xqp * sn) : (xq * c - xqp * sn);
                    xk = half ? (xk * c + xkp * sn) : (xk * c - xkp * sn);
                }
            }
            QA[(size_t)row * 768 + e] = f2bf(xq * QSCALE);
            KA[keyrow * 768 + e] = f2bf(xk);
        }
    }
    bf16_t* vt = (bf16_t*)smem;
    float* rk = (float*)(smem + 64 * 72 * 2);
    for (int it = blockIdx.x; it < (RT / 64) * 8; it += gridDim.x) {
        const int g = it >> 3, h = it & 7, rowg = g * 64;
        const bool lat = rowg < RL;
        const int b = lat ? (rowg >> 12) : ((rowg - RL) >> 8), t0 = lat ? (rowg & 4095) : ((rowg - RL) & 255);
        const size_t key0 = lat ? t0 : SEQ + t0;
#pragma unroll 4
        for (int rr = 0; rr < 16; ++rr) {
            const int lr = wave * 16 + rr;
            const bf16_t* pr = P + (size_t)(rowg + lr) * LDP + PKV0;
            const uint2 u = *(const uint2*)(pr + lane * 4);
            float sk = bflo(u.x) * bflo(u.x) + bfhi(u.x) * bfhi(u.x) + bflo(u.y) * bflo(u.y) + bfhi(u.y) * bfhi(u.y);
            sk = wsum(sk);
            if (lane == 0) rk[lr] = rsqrtf(sk * (1.f / 256.f) + 1e-6f);
        }
        __syncthreads();
#pragma unroll
        for (int i = 0; i < 2; ++i) {
            const int c = tid + 256 * i, lr = c >> 3, part = c & 7;
            float f[8]; unpack8(*(const uint4*)(KVR + (size_t)(rowg + lr) * 1024 + h * 128 + 64 + part * 8), f);
            const float sc = rk[lr];
#pragma unroll
            for (int e = 0; e < 8; ++e) f[e] *= sc;
            *(uint4*)(vt + lr * 72 + part * 8) = pack8(f);
        }
        __syncthreads();
#pragma unroll
        for (int i = 0; i < 2; ++i) {
            const int c = tid + 256 * i, dd = c >> 3, kc = c & 7;
            float f[8];
#pragma unroll
            for (int e = 0; e < 8; ++e) f[e] = bf2f(vt[(kc * 8 + e) * 72 + dd]);
            *(uint4*)(VA + ((size_t)(b * 8 + h) * 64 + dd) * KEYS + key0 + kc * 8) = pack8(f);
        }
        __syncthreads();
    }
}
__device__ __forceinline__ float xmax_16_32(float v) {
    unsigned u = __builtin_bit_cast(unsigned, v);
    auto r = __builtin_amdgcn_permlane32_swap(u, u, false, false);
    float m = fmaxf(__builtin_bit_cast(float, r[0]), __builtin_bit_cast(float, r[1]));
    u = __builtin_bit_cast(unsigned, m);
    auto r2 = __builtin_amdgcn_permlane16_swap(u, u, false, false);
    return fmaxf(__builtin_bit_cast(float, r2[0]), __builtin_bit_cast(float, r2[1]));
}
__device__ __forceinline__ float xsum_16_32(float v) {
    unsigned u = __builtin_bit_cast(unsigned, v);
    auto r = __builtin_amdgcn_permlane32_swap(u, u, false, false);
    float m = __builtin_bit_cast(float, r[0]) + __builtin_bit_cast(float, r[1]);
    u = __builtin_bit_cast(unsigned, m);
    auto r2 = __builtin_amdgcn_permlane16_swap(u, u, false, false);
    return __builtin_bit_cast(float, r2[0]) + __builtin_bit_cast(float, r2[1]);
}
constexpr int KS_LD = 104, VT_LD = 72;
constexpr int AT_BUF = 64 * KS_LD * 2 + 64 * VT_LD * 2;
__device__ __forceinline__ void ph_at(const Params& p, int l, char* smem) {
    const int tid = tidx(), lane = tid & 63, wave = tid >> 6, fr = lane & 15, fq = lane >> 4;
    const bf16_t* QA = (const bf16_t*)(p.ws + O_X + X_QA); const bf16_t* KA = (const bf16_t*)(p.ws + O_X + X_KA); const bf16_t* VA = (const bf16_t*)(p.ws + O_X + X_VA);
    bf16_t* ATT = (bf16_t*)(p.ws + O_ATT);
    const int nitems = 1024 + (l < NLAYER - 1 ? 64 : 0);
    for (int it0 = blockIdx.x; it0 < nitems; it0 += gridDim.x) {
        int it = it0;
        if (gridDim.x == 512 && it0 < 1024) {
            const int x = it0 & 7, j = (it0 >> 3) & 63, rd = it0 >> 9;
            it = ((x * 4 + rd * 2 + (j >> 5)) << 5) | (j & 31);
        }
        int b, h, row0, ntile; size_t krow0;
        if (it < 1024) { b = it >> 8; h = (it >> 5) & 7; row0 = b * SEQ + (it & 31) * 128; krow0 = (size_t)b * KEYS; ntile = KEYS / 64; }
        else { const int j = it - 1024; b = j >> 4; h = (j >> 1) & 7; row0 = RL + b * CTX + (j & 1) * 128; krow0 = (size_t)b * KEYS + SEQ; ntile = CTX / 64; }
        const int qrow = row0 + wave * 32 + fr;
        const size_t vrow0 = (size_t)(b * 8 + h) * 64; const int koff0 = (int)(krow0 - (size_t)b * KEYS);
        bf16x8 qf[2][3];
#pragma unroll
        for (int t = 0; t < 2; ++t)
#pragma unroll
            for (int ks = 0; ks < 3; ++ks) qf[t][ks] = *(const bf16x8*)(QA + (size_t)(qrow + 16 * t) * 768 + h * 96 + ks * 32 + fq * 8);
        f32x4 ot[2][4];
#pragma unroll
        for (int t = 0; t < 2; ++t)
#pragma unroll
            for (int i = 0; i < 4; ++i) ot[t][i] = (f32x4){0.f, 0.f, 0.f, 0.f};
        float m_run[2] = {-1e30f, -1e30f}, l_run[2] = {0.f, 0.f};
        uint4 rk0, rk1, rk2, rv0, rv1;
#define AT_GLOAD(KT) do { const size_t kr_ = krow0 + (size_t)(KT) * 64; \
            { const int c = tid, key = c / 12, part = c % 12; rk0 = *(const uint4*)(KA + (kr_ + key) * 768 + h * 96 + part * 8); } \
            { const int c = tid + 256, key = c / 12, part = c % 12; rk1 = *(const uint4*)(KA + (kr_ + key) * 768 + h * 96 + part * 8); } \
            { const int c = tid + 512, key = c / 12, part = c % 12; rk2 = *(const uint4*)(KA + (kr_ + key) * 768 + h * 96 + part * 8); } \
            { const int c = tid, dd_ = c >> 3, part = c & 7; rv0 = *(const uint4*)(VA + (vrow0 + dd_) * KEYS + koff0 + (KT) * 64 + part * 8); } \
            { const int c = tid + 256, dd_ = c >> 3, part = c & 7; rv1 = *(const uint4*)(VA + (vrow0 + dd_) * KEYS + koff0 + (KT) * 64 + part * 8); } } while (0)
#define AT_VSTORE(RV, C) do { const int dd_ = (C) >> 3, part = (C) & 7; *(uint4*)(Vt_ + dd_ * VT_LD + part * 8) = RV; } while (0)
#define AT_SSTORE(BUF) do { bf16_t* Ks_ = (bf16_t*)(smem + (BUF) * AT_BUF); bf16_t* Vt_ = Ks_ + 64 * KS_LD; \
            { const int c = tid, key = c / 12, part = c % 12; *(uint4*)(Ks_ + key * KS_LD + part * 8) = rk0; } \
            { const int c = tid + 256, key = c / 12, part = c % 12; *(uint4*)(Ks_ + key * KS_LD + part * 8) = rk1; } \
            { const int c = tid + 512, key = c / 12, part = c % 12; *(uint4*)(Ks_ + key * KS_LD + part * 8) = rk2; } \
            AT_VSTORE(rv0, tid); AT_VSTORE(rv1, tid + 256); } while (0)
        AT_GLOAD(0); AT_SSTORE(0);
        __syncthreads();
        for (int kt = 0; kt < ntile; ++kt) {
            const int cur = kt & 1;
            if (kt + 1 < ntile) AT_GLOAD(kt + 1);
            const bf16_t* Ks = (const bf16_t*)(smem + cur * AT_BUF); const bf16_t* Vt = Ks + 64 * KS_LD;
            bf16x8 kf[4][3];
#pragma unroll
            for (int j = 0; j < 4; ++j)
#pragma unroll
                for (int ks = 0; ks < 3; ++ks) kf[j][ks] = *(const bf16x8*)(Ks + (j * 16 + fr) * KS_LD + ks * 32 + fq * 8);
            f32x4 st[2][4];
#pragma unroll
            for (int j = 0; j < 4; ++j) {
                st[0][j] = (f32x4){0.f, 0.f, 0.f, 0.f}; st[1][j] = (f32x4){0.f, 0.f, 0.f, 0.f};
#pragma unroll
                for (int ks = 0; ks < 3; ++ks) {
                    st[0][j] = __builtin_amdgcn_mfma_f32_16x16x32_bf16(kf[j][ks], qf[0][ks], st[0][j], 0, 0, 0);
                    st[1][j] = __builtin_amdgcn_mfma_f32_16x16x32_bf16(kf[j][ks], qf[1][ks], st[1][j], 0, 0, 0);
                }
            }
            bf16x8 vf[2][4];
#pragma unroll
            for (int k2 = 0; k2 < 2; ++k2)
#pragma unroll
                for (int dt = 0; dt < 4; ++dt) {
                    const bf16_t* vp = Vt + (dt * 16 + fr) * VT_LD + k2 * 32 + fq * 4;
                    const uint2 v0 = *(const uint2*)vp, v1 = *(const uint2*)(vp + 16);
                    vf[k2][dt] = __builtin_bit_cast(bf16x8, make_uint4(v0.x, v0.y, v1.x, v1.y));
                }
            uint4 pu[2][2];
#pragma unroll
            for (int t = 0; t < 2; ++t) {
                float mx = st[t][0][0];
#pragma unroll
                for (int j = 0; j < 4; ++j)
#pragma unroll
                    for (int r = 0; r < 4; ++r) mx = fmaxf(mx, st[t][j][r]);
                if (__any(mx > m_run[t] + 6.f)) {
                    mx = xmax_16_32(mx);
                    const float m_new = fmaxf(m_run[t], mx);
                    const float alpha = __builtin_amdgcn_exp2f(m_run[t] - m_new);
                    m_run[t] = m_new;
                    l_run[t] *= alpha;
#pragma unroll
                    for (int i = 0; i < 4; ++i) ot[t][i] *= alpha;
                }
                const float mr = m_run[t];
                float ps = 0.f;
#pragma unroll
                for (int j = 0; j < 4; ++j)
#pragma unroll
                    for (int r = 0; r < 4; ++r) { st[t][j][r] = __builtin_amdgcn_exp2f(st[t][j][r] - mr); ps += st[t][j][r]; }
                l_run[t] += ps;
#pragma unroll
                for (int k2 = 0; k2 < 2; ++k2)
                    pu[t][k2] = make_uint4(pack2(st[t][2 * k2][0], st[t][2 * k2][1]), pack2(st[t][2 * k2][2], st[t][2 * k2][3]),
                                           pack2(st[t][2 * k2 + 1][0], st[t][2 * k2 + 1][1]), pack2(st[t][2 * k2 + 1][2], st[t][2 * k2 + 1][3]));
            }
#pragma unroll
            for (int k2 = 0; k2 < 2; ++k2) {
                const bf16x8 pb0 = __builtin_bit_cast(bf16x8, pu[0][k2]), pb1 = __builtin_bit_cast(bf16x8, pu[1][k2]);
#pragma unroll
                for (int dt = 0; dt < 4; ++dt) {
                    ot[0][dt] = __builtin_amdgcn_mfma_f32_16x16x32_bf16(vf[k2][dt], pb0, ot[0][dt], 0, 0, 0);
                    ot[1][dt] = __builtin_amdgcn_mfma_f32_16x16x32_bf16(vf[k2][dt], pb1, ot[1][dt], 0, 0, 0);
                }
            }
            if (kt + 1 < ntile) AT_SSTORE(cur ^ 1);
            __syncthreads();
        }
#pragma unroll
        for (int t = 0; t < 2; ++t) {
            const float inv = 1.f / xsum_16_32(l_run[t]);
#pragma unroll
            for (int dt = 0; dt < 4; ++dt) { f32x4 o = ot[t][dt] * inv; store_bf16x4(ATT + (size_t)(qrow + 16 * t) * 512 + h * 64 + dt * 16 + fq * 4, o); }
        }
    }
}

__device__ __forceinline__ void row_edges(int row, bool& first, bool& last) {
    if (row < RL) { const int t = row & 4095; first = t == 0; last = t == 4095; }
    else { const int s = (row - RL) & 255; first = s == 0; last = s == 255; }
}
__device__ __forceinline__ float xs1(const bf16_t* P, const float* mu, int row, int col) {
    bool first, last; row_edges(row, first, last);
    const bf16_t* pc = P + (size_t)row * LDP + PR0 + col;
    const float c = bf2f(*pc), pv = first ? 0.f : bf2f(*(pc - LDP)), nx = last ? 0.f : bf2f(*(pc + LDP));
    return c + (0.5f * (pv + nx) - c) * mu[col];
}
__device__ __forceinline__ void xs8(const bf16_t* P, const float* mu, int row, int col, float (&o)[8]) {
    bool first, last; row_edges(row, first, last);
    const bf16_t* pc = P + (size_t)row * LDP + PR0 + col;
    const uint4 z = make_uint4(0u, 0u, 0u, 0u);
    const uint4 uc = *(const uint4*)pc, up = first ? z : *(const uint4*)(pc - LDP), un = last ? z : *(const uint4*)(pc + LDP);
    float c[8], pv[8], nx[8]; unpack8(uc, c); unpack8(up, pv); unpack8(un, nx);
    const float4 m0 = *(const float4*)(mu + col), m1 = *(const float4*)(mu + col + 4);
    const float m[8] = {m0.x, m0.y, m0.z, m0.w, m1.x, m1.y, m1.z, m1.w};
#pragma unroll
    for (int j = 0; j < 8; ++j) o[j] = c[j] + (0.5f * (pv[j] + nx[j]) - c[j]) * m[j];
}
struct ALRw {
    const bf16_t* P; const float* mu; int row0; int colbase, mode;
    __device__ __forceinline__ ALRw(const bf16_t* P_, const float* mu_, int row0_, int colbase_, int mode_) : P(P_), mu(mu_), colbase(colbase_), mode(mode_) {
        row0 = row0_ + (tidx() >> 3);
    }
    __device__ __forceinline__ uint4 load(int i, int k) const {
        float o[8]; xs8(P, mu, row0 + 32 * i, colbase + k, o);
        if (mode == 0) {
#pragma unroll
            for (int j = 0; j < 8; ++j) o[j] = tanhf(o[j]);
        } else if (mode == 2) {
#pragma unroll
            for (int j = 0; j < 8; ++j) o[j] = sigmoidf_(o[j]);
        }
        return pack8(o);
    }
};
__device__ __forceinline__ void ph_rp1(const Params& p, int l, char* smem) {
    const bf16_t* P = (const bf16_t*)(p.ws + O_P); const float* mu = p.in[I_MU] + l * 1792;
    bf16_t* RG = (bf16_t*)(p.ws + O_RG);
    for (int it = blockIdx.x; it < 544; it += gridDim.x) {
        const int mt = it >> 2, nt = it & 3;
        f32x4 acc[4][4];
        ALRw al(P, mu, mt * 128, 1664, 2);
        gemm_core<4>(al, (const bf16_t*)(p.ws + O_WB + W_GUP) + (size_t)nt * 128 * 128, 128, 128, acc, smem);
        acc_foreach<4>(acc, [&](int m, int n, const f32x4& v) { store_bf16x4(RG + (size_t)(mt * 128 + m) * 512 + nt * 128 + n, v); });
    }
}
__device__ __forceinline__ void ph_rp2(const Params& p, int l) {
    const int lane = tidx() & 63, wave = tidx() >> 6;
    const bf16_t* P = (const bf16_t*)(p.ws + O_P); const float* mu = p.in[I_MU] + l * 1792; const float* kkw = p.in[I_KK] + l * 512;
    float* KKN = (float*)(p.ws + O_X + X_KKN);
    for (int row = blockIdx.x * 4 + wave; row < RT; row += gridDim.x * 4) {
        float k8[8]; xs8(P, mu, row, 512 + lane * 8, k8);
        float s = 0.f;
#pragma unroll
        for (int j = 0; j < 8; ++j) { const float v = k8[j] * kkw[lane * 8 + j]; s += v * v; }
        s += __shfl_xor(s, 1); s += __shfl_xor(s, 2); s += __shfl_xor(s, 4);
        if ((lane & 7) == 0) KKN[(size_t)row * 8 + (lane >> 3)] = rsqrtf(s + 1e-12f);
    }
}

__device__ __forceinline__ int scan_row(int b, int d, int n) {
    if (n < CTX) return RL + b * CTX + (d == 0 ? n : CTX - 1 - n);
    const int t = n - CTX; return b * SEQ + (d == 0 ? t : SEQ - 1 - t);
}
constexpr int SL = 72;
constexpr int SLOT_E = 64 * SL;
template <int LDA, int LDB>
__device__ __forceinline__ void mm64(const bf16_t* A, const bf16_t* B, f32x4 (&acc)[4], int wave, int fr, int fq) {
#pragma unroll
    for (int ks = 0; ks < 2; ++ks) {
        const bf16x8 af = *(const bf16x8*)(A + (wave * 16 + fr) * LDA + ks * 32 + fq * 8);
#pragma unroll
        for (int nt = 0; nt < 4; ++nt) {
            const bf16x8 bfv = *(const bf16x8*)(B + (nt * 16 + fr) * LDB + ks * 32 + fq * 8);
            acc[nt] = __builtin_amdgcn_mfma_f32_16x16x32_bf16(bfv, af, acc[nt], 0, 0, 0);
        }
    }
}
__device__ __forceinline__ void acc_zero(f32x4 (&acc)[4]) {
#pragma unroll
    for (int nt = 0; nt < 4; ++nt) acc[nt] = (f32x4){0.f, 0.f, 0.f, 0.f};
}
template <bool STRICT>
__device__ __forceinline__ void acc_mask(f32x4 (&acc)[4], int m, int fq) {
#pragma unroll
    for (int nt = 0; nt < 4; ++nt)
#pragma unroll
        for (int r = 0; r < 4; ++r) { const int n = nt * 16 + fq * 4 + r; const bool keep = STRICT ? (m < n) : (m <= n); if (!keep) acc[nt][r] = 0.f; }
}
__device__ __forceinline__ void st_rm(bf16_t* dst, const f32x4 (&acc)[4], int m, int fq) {
#pragma unroll
    for (int nt = 0; nt < 4; ++nt) store_bf16x4(dst + m * SL + nt * 16 + fq * 4, acc[nt]);
}
__device__ __forceinline__ void st_tr(bf16_t* dst, const f32x4 (&acc)[4], int m, int fq) {
#pragma unroll
    for (int nt = 0; nt < 4; ++nt)
#pragma unroll
        for (int r = 0; r < 4; ++r) dst[(nt * 16 + fq * 4 + r) * SL + m] = f2bf(acc[nt][r]);
}
__device__ __forceinline__ void ph_r1(const Params& p, int l, char* smem) {
    const int tid0 = tidx();
#define R1_IDX const int tid = lv(tid0), lane = tid & 63, wave = tid >> 6, fr = lane & 15, fq = lane >> 4, bi = tid >> 2, bq = (tid & 3) * 16, m = wave * 16 + fr; (void)bi; (void)bq; (void)m; (void)fq;
    const bf16_t* P = (const bf16_t*)(p.ws + O_P); const float* mu = p.in[I_MU] + l * 1792;
    const float* kkw = p.in[I_KK] + l * 512; const float* kaw = p.in[I_KA] + l * 512; const float* rkw = p.in[I_RK] + l * 512;
    const float* KKN = (const float*)(p.ws + O_X + X_KKN); float* BON = (float*)(p.ws + O_X + X_BON);
    bf16_t* gMT = (bf16_t*)(p.ws + O_X + X_MT); bf16_t* gNL = (bf16_t*)(p.ws + O_X + X_NL);
    bf16_t* gGT = (bf16_t*)(p.ws + O_X + X_GT); bf16_t* gYL = (bf16_t*)(p.ws + O_X + X_YL);
    bf16_t* slot = (bf16_t*)smem;
    bf16_t* s0 = slot, *s1 = slot + SLOT_E, *s2 = slot + 2 * SLOT_E, *s3 = slot + 3 * SLOT_E;
    bf16_t* sa = slot + 4 * SLOT_E, *sb = slot + 5 * SLOT_E, *sc = slot + 6 * SLOT_E, *sT = slot + 7 * SLOT_E;
    float* misc = (float*)(smem + 8 * SLOT_E * 2);
    float* GAM = misc; float* SEG = misc + 64;
    float* ASIG = (float*)s0;
    float* LWS = (float*)s2;
    for (int it = blockIdx.x; it < NCP; it += gridDim.x) {
        const int c = it % 68, d = (it / 68) & 1, h = (it / 136) & 7, b = it / 1088;
        {
            R1_IDX const int rowb = scan_row(b, d, c * 64 + bi); (void)rowb;
            float o[8];
#pragma unroll
            for (int hh = 0; hh < 2; ++hh) {
                xs8(P, mu, rowb, 1536 + bq + hh * 8, o);
#pragma unroll
                for (int j = 0; j < 8; ++j) o[j] = tanhf(o[j]);
                *(uint4*)(sa + bi * SL + bq + hh * 8) = pack8(o);
                xs8(P, mu, rowb, 1600 + bq + hh * 8, o);
                *(uint4*)(sb + bi * SL + bq + hh * 8) = pack8(o);
            }
        }
        __syncthreads();
        {
            R1_IDX const int rowb = scan_row(b, d, c * 64 + bi); (void)rowb;
            f32x4 acc[4];
            acc_zero(acc);
            mm64<SL, 64>(sa, (const bf16_t*)(p.ws + O_WB + W_WUP) + ((size_t)d * 512 + h * 64) * 64, acc, wave, fr, fq);
            const float* w0 = p.in[I_W0] + (l * 2 + d) * 512 + h * 64;
#pragma unroll
            for (int nt = 0; nt < 4; ++nt) {
                const int n = nt * 16 + fq * 4; float4 o; float* op = (float*)&o;
#pragma unroll
                for (int r = 0; r < 4; ++r) { const float z = w0[n + r] + acc[nt][r]; const float sp = fmaxf(-z, 0.f) + log1pf(expf(-fabsf(z))); op[r] = -expf(-sp - 0.5f); }
                *(float4*)(LWS + m * 64 + n) = o;
            }
            acc_zero(acc);
            mm64<SL, 64>(sb, (const bf16_t*)(p.ws + O_WB + W_AUP) + ((size_t)d * 512 + h * 64) * 64, acc, wave, fr, fq);
            const float* a0 = p.in[I_A0] + (l * 2 + d) * 512 + h * 64;
#pragma unroll
            for (int nt = 0; nt < 4; ++nt) {
                const int n = nt * 16 + fq * 4;
                *(float4*)(ASIG + m * 64 + n) = make_float4(sigmoidf_(a0[n] + acc[nt][0]), sigmoidf_(a0[n + 1] + acc[nt][1]), sigmoidf_(a0[n + 2] + acc[nt][2]), sigmoidf_(a0[n + 3] + acc[nt][3]));
            }
        }
        __syncthreads();
        {
            R1_IDX const int rowb = scan_row(b, d, c * 64 + bi); (void)rowb;
            const int k = tid & 63, seg = tid >> 6;
            float run = 0.f;
#pragma unroll
            for (int ii = 0; ii < 16; ++ii) { run += LWS[(seg * 16 + ii) * 64 + k]; LWS[(seg * 16 + ii) * 64 + k] = run; }
            SEG[seg * 64 + k] = run;
            __syncthreads();
            float off = 0.f;
#pragma unroll
            for (int sgi = 0; sgi < 3; ++sgi) if (sgi < seg) off += SEG[sgi * 64 + k];
#pragma unroll
            for (int ii = 0; ii < 16; ++ii) LWS[(seg * 16 + ii) * 64 + k] += off;
        }
        __syncthreads();
        {
            R1_IDX const int rowb = scan_row(b, d, c * 64 + bi); (void)rowb;
            float cs[16], cm[16], cc[16], ag[16];
#pragma unroll
            for (int q = 0; q < 4; ++q) {
                const float4 v0 = *(const float4*)(LWS + bi * 64 + bq + q * 4);
                const float4 v1 = bi > 0 ? *(const float4*)(LWS + (bi - 1) * 64 + bq + q * 4) : make_float4(0.f, 0.f, 0.f, 0.f);
                const float4 v2 = *(const float4*)(LWS + 63 * 64 + bq + q * 4);
                const float4 v3 = *(const float4*)(ASIG + bi * 64 + bq + q * 4);
                cs[q * 4] = v0.x; cs[q * 4 + 1] = v0.y; cs[q * 4 + 2] = v0.z; cs[q * 4 + 3] = v0.w;
                cm[q * 4] = v1.x; cm[q * 4 + 1] = v1.y; cm[q * 4 + 2] = v1.z; cm[q * 4 + 3] = v1.w;
                cc[q * 4] = v2.x; cc[q * 4 + 1] = v2.y; cc[q * 4 + 2] = v2.z; cc[q * 4 + 3] = v2.w;
                ag[q * 4] = v3.x; ag[q * 4 + 1] = v3.y; ag[q * 4 + 2] = v3.z; ag[q * 4 + 3] = v3.w;
            }
            __syncthreads();
            const float kkn = KKN[(size_t)rowb * 8 + h];
            float bon = 0.f;
#pragma unroll
            for (int hh = 0; hh < 2; ++hh) {
                float r8[8], k8[8], oa[8], ob[8], ok[8], orr[8];
                const int col = h * 64 + bq + hh * 8;
                xs8(P, mu, rowb, col, r8); xs8(P, mu, rowb, 512 + col, k8);
#pragma unroll
                for (int j = 0; j < 8; ++j) {
                    const int e = hh * 8 + j;
                    const float kk = k8[j] * kkw[col + j] * kkn;
                    const float kd = k8[j] * (1.f + (ag[e] - 1.f) * kaw[col + j]);
                    const float eneg = __expf(-cs[e]);
                    oa[j] = -kk * __expf(cm[e]); ob[j] = kk * ag[e] * eneg; ok[j] = kd * eneg; orr[j] = r8[j] * __expf(cs[e]);
                    bon += r8[j] * kd * rkw[col + j];
                }
                *(uint4*)(s0 + bi * SL + bq + hh * 8) = pack8(oa); *(uint4*)(s1 + bi * SL + bq + hh * 8) = pack8(ob);
                *(uint4*)(s2 + bi * SL + bq + hh * 8) = pack8(ok); *(uint4*)(s3 + bi * SL + bq + hh * 8) = pack8(orr);
            }
            bon += __shfl_xor(bon, 1); bon += __shfl_xor(bon, 2);
            if ((tid & 3) == 0) BON[((size_t)d * RT + rowb) * 8 + h] = bon;
            if (bi == 0) {
#pragma unroll
                for (int e = 0; e < 16; ++e) GAM[bq + e] = __expf(cc[e]);
            }
        }
        __syncthreads();
        {
            R1_IDX const int rowb = scan_row(b, d, c * 64 + bi); (void)rowb;
            f32x4 acc[4]; acc_zero(acc);
            mm64<SL, SL>(s1, s0, acc, wave, fr, fq);
            acc_mask<true>(acc, m, fq);
            st_rm(sa, acc, m, fq); st_tr(sb, acc, m, fq);
#pragma unroll
            for (int nt = 0; nt < 4; ++nt)
#pragma unroll
                for (int r = 0; r < 4; ++r) if (nt * 16 + fq * 4 + r == m) acc[nt][r] += 1.f;
            st_rm(sc, acc, m, fq);
        }
        __syncthreads();
#pragma unroll
        for (int itr = 0; itr < 5; ++itr) {
            R1_IDX
            bf16_t* ptr = (itr & 1) ? sT : sb;
            bf16_t* ptw = (itr & 1) ? sb : sT;
            f32x4 acc[4]; acc_zero(acc);
            mm64<SL, SL>(sa, ptr, acc, wave, fr, fq);
            st_rm(sa, acc, m, fq); st_tr(ptw, acc, m, fq);
            __syncthreads();
            f32x4 tacc[4];
#pragma unroll
            for (int nt = 0; nt < 4; ++nt) { const uint2 u = *(const uint2*)(sc + m * SL + nt * 16 + fq * 4); tacc[nt] = (f32x4){bflo(u.x), bfhi(u.x), bflo(u.y), bfhi(u.y)}; }
            mm64<SL, SL>(sc, ptw, tacc, wave, fr, fq);
            if (itr < 4) st_rm(sc, tacc, m, fq); else st_tr(sb, tacc, m, fq);
        }
        __syncthreads();
        {
            R1_IDX const int rowb = scan_row(b, d, c * 64 + bi); (void)rowb;
            f32x4 acc[4]; acc_zero(acc);
            mm64<SL, SL>(s2, s0, acc, wave, fr, fq);
            acc_mask<true>(acc, m, fq);
            st_rm(sa, acc, m, fq);
            float f0[8], f1[8];
            unpack8(*(const uint4*)(s0 + bi * SL + bq), f0); unpack8(*(const uint4*)(s0 + bi * SL + bq + 8), f1);
#pragma unroll
            for (int e = 0; e < 8; ++e) { sc[(bq + e) * SL + bi] = f2bf(f0[e]); sc[(bq + 8 + e) * SL + bi] = f2bf(f1[e]); }
        }
        __syncthreads();
        {
            R1_IDX const int rowb = scan_row(b, d, c * 64 + bi); (void)rowb;
            f32x4 acc[4]; acc_zero(acc);
            mm64<SL, SL>(sc, sb, acc, wave, fr, fq);
            st_rm(sT, acc, m, fq);
            acc_zero(acc);
            mm64<SL, SL>(sa, sb, acc, wave, fr, fq);
            st_rm(s0, acc, m, fq);
        }
        __syncthreads();
        f32x4 qacc[4];
        {
            R1_IDX const int rowb = scan_row(b, d, c * 64 + bi); (void)rowb;
            f32x4 acc[4]; acc_zero(acc);
            mm64<SL, SL>(s1, s3, acc, wave, fr, fq);
            acc_mask<false>(acc, m, fq);
            st_tr(sa, acc, m, fq);
            acc_zero(qacc);
            mm64<SL, SL>(s2, s3, qacc, wave, fr, fq);
            acc_mask<false>(qacc, m, fq);
            float f0[8], f1[8];
            unpack8(*(const uint4*)(s3 + bi * SL + bq), f0); unpack8(*(const uint4*)(s3 + bi * SL + bq + 8), f1);
#pragma unroll
            for (int e = 0; e < 8; ++e) { sc[(bq + e) * SL + bi] = f2bf(f0[e]); sc[(bq + 8 + e) * SL + bi] = f2bf(f1[e]); }
        }
        __syncthreads();
        {
            R1_IDX const int rowb = scan_row(b, d, c * 64 + bi); (void)rowb;
            f32x4 acc[4];
#pragma unroll
            for (int nt = 0; nt < 4; ++nt) { const uint2 u = *(const uint2*)(sc + m * SL + nt * 16 + fq * 4); acc[nt] = (f32x4){bflo(u.x), bfhi(u.x), bflo(u.y), bfhi(u.y)}; }
            mm64<SL, SL>(sT, sa, acc, wave, fr, fq);
            bf16_t* gt = gGT + (size_t)it * 4096;
#pragma unroll
            for (int nt = 0; nt < 4; ++nt)
#pragma unroll
                for (int r = 0; r < 4; ++r) gt[(nt * 16 + fq * 4 + r) * 64 + m] = f2bf(acc[nt][r]);
            mm64<SL, SL>(s0, sa, qacc, wave, fr, fq);
            st_tr(sb, qacc, m, fq);
            float f0[8], f1[8];
            unpack8(*(const uint4*)(s1 + bi * SL + bq), f0); unpack8(*(const uint4*)(s1 + bi * SL + bq + 8), f1);
#pragma unroll
            for (int e = 0; e < 8; ++e) { s3[(bq + e) * SL + bi] = f2bf(f0[e] * GAM[bq + e]); s3[(bq + 8 + e) * SL + bi] = f2bf(f1[e] * GAM[bq + 8 + e]); }
        }
        __syncthreads();
        {
            R1_IDX const int rowb = scan_row(b, d, c * 64 + bi); (void)rowb;
            f32x4 acc[4]; acc_zero(acc);
            mm64<SL, SL>(sT, s3, acc, wave, fr, fq);
            bf16_t* mt = gMT + (size_t)it * 4096;
#pragma unroll
            for (int nt = 0; nt < 4; ++nt)
#pragma unroll
                for (int r = 0; r < 4; ++r) { const int n = nt * 16 + fq * 4 + r; mt[n * 64 + m] = f2bf(acc[nt][r] + (n == m ? GAM[m] : 0.f)); }
#pragma unroll
            for (int nt = 0; nt < 4; ++nt) {
                const int n = nt * 16 + fq * 4; const uint2 u = *(const uint2*)(s2 + m * SL + n);
                acc[nt] = (f32x4){bflo(u.x) * GAM[n], bfhi(u.x) * GAM[n + 1], bflo(u.y) * GAM[n + 2], bfhi(u.y) * GAM[n + 3]};
            }
            mm64<SL, SL>(s0, s3, acc, wave, fr, fq);
            st_tr(s1, acc, m, fq);
            float v8[8];
#pragma unroll
            for (int hh = 0; hh < 2; ++hh) {
                xs8(P, mu, rowb, 1024 + h * 64 + bq + hh * 8, v8);
#pragma unroll
                for (int e = 0; e < 8; ++e) sc[(bq + hh * 8 + e) * SL + bi] = f2bf(v8[e]);
            }
        }
        __syncthreads();
        {
            R1_IDX const int rowb = scan_row(b, d, c * 64 + bi); (void)rowb;
            f32x4 acc[4]; acc_zero(acc);
            mm64<SL, SL>(sc, sb, acc, wave, fr, fq);
            bf16_t* yl = gYL + (size_t)it * 4096;
#pragma unroll
            for (int nt = 0; nt < 4; ++nt) store_bf16x4(yl + m * 64 + nt * 16 + fq * 4, acc[nt]);
            acc_zero(acc);
            mm64<SL, SL>(sc, s1, acc, wave, fr, fq);
            bf16_t* nl = gNL + (size_t)it * 4096;
#pragma unroll
            for (int nt = 0; nt < 4; ++nt) store_bf16x4(nl + m * 64 + nt * 16 + fq * 4, acc[nt]);
        }
        __syncthreads();
    }
}
__device__ __forceinline__ void ph_r2(const Params& p) {
    const int tid = tidx(), lane = tid & 63, wave = tid >> 6, fr = lane & 15, fq = lane >> 4;
    const bf16_t* gMT = (const bf16_t*)(p.ws + O_X + X_MT); const bf16_t* gNL = (const bf16_t*)(p.ws + O_X + X_NL);
    uint4* gS0 = (uint4*)(p.ws + O_X + X_S0);
    for (int it = blockIdx.x; it < 64; it += gridDim.x) {
        f32x4 st[4];
#pragma unroll
        for (int tt = 0; tt < 4; ++tt) st[tt] = (f32x4){0.f, 0.f, 0.f, 0.f};
        for (int c = 0; c < 68; ++c) {
            const size_t cp = (size_t)it * 68 + c;
            const bf16_t* mt = gMT + cp * 4096; const bf16_t* nl = gNL + cp * 4096;
            uint2 ma[4][2][2], nv[4];
#pragma unroll
            for (int tt = 0; tt < 4; ++tt) {
#pragma unroll
                for (int s = 0; s < 2; ++s) { const bf16_t* q = mt + (tt * 16 + fr) * 64 + s * 32 + fq * 4; ma[tt][s][0] = *(const uint2*)q; ma[tt][s][1] = *(const uint2*)(q + 16); }
                nv[tt] = *(const uint2*)(nl + (wave * 16 + fr) * 64 + tt * 16 + fq * 4);
            }
            uint4 sbv[2];
#pragma unroll
            for (int s = 0; s < 2; ++s) sbv[s] = make_uint4(pack2(st[2 * s][0], st[2 * s][1]), pack2(st[2 * s][2], st[2 * s][3]), pack2(st[2 * s + 1][0], st[2 * s + 1][1]), pack2(st[2 * s + 1][2], st[2 * s + 1][3]));
            gS0[(cp * 4 + wave) * 128 + lane] = sbv[0]; gS0[(cp * 4 + wave) * 128 + 64 + lane] = sbv[1];
#pragma unroll
            for (int tt = 0; tt < 4; ++tt) {
                f32x4 acc = {bflo(nv[tt].x), bfhi(nv[tt].x), bflo(nv[tt].y), bfhi(nv[tt].y)};
#pragma unroll
                for (int s = 0; s < 2; ++s) {
                    const bf16x8 af = __builtin_bit_cast(bf16x8, make_uint4(ma[tt][s][0].x, ma[tt][s][0].y, ma[tt][s][1].x, ma[tt][s][1].y));
                    acc = __builtin_amdgcn_mfma_f32_16x16x32_bf16(af, __builtin_bit_cast(bf16x8, sbv[s]), acc, 0, 0, 0);
                }
                st[tt] = acc;
            }
        }
    }
}
__device__ __forceinline__ void ph_r3(const Params& p) {
    const int tid = tidx(), lane = tid & 63, wave = tid >> 6, fr = lane & 15, fq = lane >> 4;
    const bf16_t* gGT = (const bf16_t*)(p.ws + O_X + X_GT); const bf16_t* gYL = (const bf16_t*)(p.ws + O_X + X_YL);
    const uint4* gS0 = (const uint4*)(p.ws + O_X + X_S0);
    bf16_t* YS = (bf16_t*)(p.ws + O_H);
    for (int it = blockIdx.x; it < NCP; it += gridDim.x) {
        const int c = it % 68, d = (it / 68) & 1, h = (it / 136) & 7, b = it / 1088;
        const bf16_t* gt = gGT + (size_t)it * 4096; const bf16_t* yl = gYL + (size_t)it * 4096;
        const uint4 sb0 = gS0[((size_t)it * 4 + wave) * 128 + lane], sb1 = gS0[((size_t)it * 4 + wave) * 128 + 64 + lane];
#pragma unroll
        for (int tt = 0; tt < 4; ++tt) {
            const uint2 yv = *(const uint2*)(yl + (wave * 16 + fr) * 64 + tt * 16 + fq * 4);
            f32x4 acc = {bflo(yv.x), bfhi(yv.x), bflo(yv.y), bfhi(yv.y)};
#pragma unroll
            for (int s = 0; s < 2; ++s) {
                const bf16_t* q = gt + (tt * 16 + fr) * 64 + s * 32 + fq * 4;
                const uint2 a0 = *(const uint2*)q, a1 = *(const uint2*)(q + 16);
                const bf16x8 af = __builtin_bit_cast(bf16x8, make_uint4(a0.x, a0.y, a1.x, a1.y));
                acc = __builtin_amdgcn_mfma_f32_16x16x32_bf16(af, __builtin_bit_cast(bf16x8, s ? sb1 : sb0), acc, 0, 0, 0);
            }
#pragma unroll
            for (int r = 0; r < 4; ++r) {
                const int row = scan_row(b, d, c * 64 + tt * 16 + fq * 4 + r);
                YS[((size_t)d * RT + row) * 512 + h * 64 + wave * 16 + fr] = f2bf(acc[r]);
            }
        }
    }
}

__device__ __forceinline__ void ph_rpost(const Params& p, int l) {
    const int lane = tidx() & 63, wave = tidx() >> 6;
    const bf16_t* P = (const bf16_t*)(p.ws + O_P); const float* mu = p.in[I_MU] + l * 1792;
    const float* gng = p.in[I_GNG] + l * 512; const float* gnb = p.in[I_GNB] + l * 512;
    const float* BON = (const float*)(p.ws + O_X + X_BON); const bf16_t* YS = (const bf16_t*)(p.ws + O_H);
    const bf16_t* RG = (const bf16_t*)(p.ws + O_RG); bf16_t* RWO = (bf16_t*)(p.ws + O_RWO);
    for (int row = blockIdx.x * 4 + wave; row < RT; row += gridDim.x * 4) {
        const int col = lane * 8, h = lane >> 3;
        float v8[8], g8[8], y0[8], y1[8];
        xs8(P, mu, row, 1024 + col, v8);
        unpack8(*(const uint4*)(RG + (size_t)row * 512 + col), g8);
        unpack8(*(const uint4*)(YS + ((size_t)0 * RT + row) * 512 + col), y0);
        unpack8(*(const uint4*)(YS + ((size_t)1 * RT + row) * 512 + col), y1);
        const float bs = BON[((size_t)0 * RT + row) * 8 + h] + BON[((size_t)1 * RT + row) * 8 + h];
        float y[8]; float sm = 0.f;
#pragma unroll
        for (int j = 0; j < 8; ++j) { y[j] = y0[j] + y1[j]; sm += y[j]; }
        sm += __shfl_xor(sm, 1); sm += __shfl_xor(sm, 2); sm += __shfl_xor(sm, 4);
        const float mean = sm * (1.f / 64.f);
        float vs = 0.f;
#pragma unroll
        for (int j = 0; j < 8; ++j) { const float dlt = y[j] - mean; vs += dlt * dlt; }
        vs += __shfl_xor(vs, 1); vs += __shfl_xor(vs, 2); vs += __shfl_xor(vs, 4);
        const float rstd = rsqrtf(vs * (1.f / 64.f) + 64e-5f);
        float o[8];
#pragma unroll
        for (int j = 0; j < 8; ++j) o[j] = ((y[j] - mean) * rstd * gng[col + j] + gnb[col + j] + bs * v8[j]) * g8[j];
        *(uint4*)(RWO + (size_t)row * 512 + col) = pack8(o);
    }
}

__device__ __forceinline__ void ph_f1(const Params& p, int l, char* smem) {
    const bf16_t* P = (const bf16_t*)(p.ws + O_P); const bf16_t* CSC = (const bf16_t*)(p.ws + O_CSC);
    bf16_t* YT = (bf16_t*)(p.ws + O_X + X_YT); bf16_t* YTC = (bf16_t*)(p.ws + O_X + X_YTC);
    const int nitems = 1024 + (l < NLAYER - 1 ? 64 : 0);
    for (int it = blockIdx.x; it < nitems; it += gridDim.x) {
        f32x4 acc[4][4];
        if (it < 1024) {
            const int b = it >> 8, g = (it >> 6) & 3, mt = (it >> 5) & 1, nt = it & 31;
            RPPlain rp{CSC + (size_t)mt * 128 * 128, 128};
            gemm_core_g<4>(rp, P + (size_t)(b * SEQ + nt * 128) * LDP + g * 128, LDP, 128, acc, smem);
            acc_foreach<4>(acc, [&](int m, int n, const f32x4& v) {
                store_bf16x4(YT + ((size_t)(b * 512 + g * 128 + m)) * 8192 + mt * 4096 + nt * 128 + n, v);
            });
        } else {
            const int j = it - 1024, b = j >> 4, g = (j >> 2) & 3, mt = (j >> 1) & 1, nt = j & 1;
            RPPlain rp{CSC + (size_t)mt * 128 * 128, 128};
            gemm_core_g<4>(rp, P + (size_t)(RL + b * CTX + nt * 128) * LDP + g * 128, LDP, 128, acc, smem);
            acc_foreach<4>(acc, [&](int m, int n, const f32x4& v) {
                store_bf16x4(YTC + ((size_t)(b * 512 + g * 128 + m)) * 512 + mt * 256 + nt * 128 + n, v);
            });
        }
    }
}
__device__ __forceinline__ void ph_f2(const Params& p, int l, char* smem) {
    const bf16_t* CST = (const bf16_t*)(p.ws + O_CST); const bf16_t* CST2 = (const bf16_t*)(p.ws + O_CST256);
    const bf16_t* YT = (const bf16_t*)(p.ws + O_X + X_YT); const bf16_t* YTC = (const bf16_t*)(p.ws + O_X + X_YTC);
    bf16_t* FA = (bf16_t*)(p.ws + O_FA);
    const int nitems = 512 + (l < NLAYER - 1 ? 32 : 0);
    for (int it = blockIdx.x; it < nitems; it += gridDim.x) {
        f32x4 acc[4][4];
        if (it < 512) {
            const int b = it >> 7, mt = (it >> 2) & 31, nt = it & 3;
            RPPlain rp{CST + (size_t)mt * 128 * 8192, 8192};
            gemm_core_g<4>(rp, YT + ((size_t)b * 512 + nt * 128) * 8192, 8192, 8192, acc, smem);
            const float sc = 0.001381067932004975f;
            acc_foreach<4>(acc, [&](int m, int n, const f32x4& v) { f32x4 o = v * sc; store_bf16x4(FA + (size_t)(b * SEQ + mt * 128 + m) * 512 + nt * 128 + n, o); });
        } else {
            const int j = it - 512, b = j >> 3, mt = (j >> 2) & 1, nt = j & 3;
            RPPlain rp{CST2 + (size_t)mt * 128 * 512, 512};
            gemm_core_g<4>(rp, YTC + ((size_t)b * 512 + nt * 128) * 512, 512, 512, acc, smem);
            const float sc = 0.005524271728019903f;
            acc_foreach<4>(acc, [&](int m, int n, const f32x4& v) { f32x4 o = v * sc; store_bf16x4(FA + (size_t)(RL + b * CTX + mt * 128 + m) * 512 + nt * 128 + n, o); });
        }
    }
}

__device__ __forceinline__ void ph_mg(const Params& p, int l, char* smem) {
    const bf16_t* P = (const bf16_t*)(p.ws + O_P);
    const bf16_t* A[3] = {(const bf16_t*)(p.ws + O_FA), (const bf16_t*)(p.ws + O_ATT), (const bf16_t*)(p.ws + O_RWO)};
    const bf16_t* W[3] = {(const bf16_t*)(p.ws + O_WB + W_PA), (const bf16_t*)(p.ws + O_WB + W_PB), (const bf16_t*)(p.ws + O_WB + W_PC)};
    bf16_t* MG = (bf16_t*)(p.ws + O_H);
    const int nmt = (l < NLAYER - 1) ? RT / 64 : RL / 64;
    for (int it = blockIdx.x; it < nmt * 8; it += gridDim.x) {
        const int mt = it >> 3, nt = it & 7;
        f32x4 tot[2][4];
#pragma unroll
        for (int i = 0; i < 2; ++i)
#pragma unroll
            for (int j = 0; j < 4; ++j) tot[i][j] = (f32x4){0.f, 0.f, 0.f, 0.f};
#pragma unroll
        for (int br = 0; br < 3; ++br) {
            f32x4 acc[2][4];
            RPPlain rp{A[br] + (size_t)mt * 64 * 512, 512};
            gemm_core_g<2>(rp, W[br] + (size_t)nt * 128 * 512, 512, 512, acc, smem);
            const int lane = tidx() & 63, wave = tidx() >> 6, wr = wave >> 1, wc = wave & 1, fr = lane & 15, fq = lane >> 4;
#pragma unroll
            for (int i = 0; i < 2; ++i)
#pragma unroll
                for (int j = 0; j < 4; ++j) {
                    const int m = wr * 32 + i * 16 + fr, n = wc * 64 + j * 16 + fq * 4;
                    const uint2 gu = *(const uint2*)(P + (size_t)(mt * 64 + m) * LDP + PG0 + br * 1024 + nt * 128 + n);
                    tot[i][j][0] += bflo(gu.x) * acc[i][j][0]; tot[i][j][1] += bfhi(gu.x) * acc[i][j][1];
                    tot[i][j][2] += bflo(gu.y) * acc[i][j][2]; tot[i][j][3] += bfhi(gu.y) * acc[i][j][3];
                }
        }
        acc_foreach<2>(tot, [&](int m, int n, const f32x4& v) { store_bf16x4(MG + (size_t)(mt * 64 + m) * 1024 + nt * 128 + n, v); });
    }
}
__device__ __forceinline__ void ph_out(const Params& p, int l, char* smem) {
    const bf16_t* MG = (const bf16_t*)(p.ws + O_H); const bf16_t* W = (const bf16_t*)(p.ws + O_WB + W_OUT);
    float* xcur = (float*)(p.ws + O_XCUR); const float* mod = (const float*)(p.ws + O_MOD);
    const int nmt = (l < NLAYER - 1) ? RT / 128 : RL / 128;
    for (int it = blockIdx.x; it < nmt * 8; it += gridDim.x) {
        const int mt = it >> 3, nt = it & 7;
        f32x4 acc[4][4];
        RPPlain rp{MG + (size_t)mt * 128 * 1024, 1024};
        gemm_core_g<4>(rp, W + (size_t)nt * 128 * 1024, 1024, 1024, acc, smem);
        acc_foreach<4>(acc, [&](int m, int n, const f32x4& v) {
            const int row = mt * 128 + m, col = nt * 128 + n;
            const float4 g = *(const float4*)(mod + (size_t)(l * 5 + modidx(row)) * 6144 + 2048 + col);
            float4* xp = (float4*)(xcur + (size_t)row * 1024 + col);
            float4 x = *xp; x.x += g.x * v[0]; x.y += g.y * v[1]; x.z += g.z * v[2]; x.w += g.w * v[3]; *xp = x;
        });
    }
}

__device__ __forceinline__ void ph_n2(const Params& p, int l, char* smem) {
    const int tid = tidx(), lane = tid & 63, wave = tid >> 6;
    unsigned* lcnt = (unsigned*)smem;
    unsigned* gbase = lcnt + 16;
    int* rec = (int*)(smem + 256);
    if (tid < 16) lcnt[tid] = 0u;
    __syncthreads();
    int nrec = 0;
    const float* xcur = (const float*)(p.ws + O_XCUR); const float* mod = (const float*)(p.ws + O_MOD);
    bf16_t* H = (bf16_t*)(p.ws + O_H);
    unsigned* cnt = (unsigned*)(p.ws + O_CNT); int* LTOK = (int*)(p.ws + O_LTOK); float* LW = (float*)(p.ws + O_LW); int* SLOT = (int*)(p.ws + O_SLOT);
    const float* g = p.in[I_N2G] + l * 1024; const float* rw = p.in[I_RW]; const float* rb = p.in[I_RB];
    const int nrows = (l < NLAYER - 1) ? RT : RL;
    for (int row = blockIdx.x * 4 + wave; row < nrows; row += gridDim.x * 4) {
        const float* x = xcur + (size_t)row * 1024; const float* md = mod + (size_t)(l * 5 + modidx(row)) * 6144;
        float4 v[4]; float ss = 0.f;
#pragma unroll
        for (int i = 0; i < 4; ++i) { v[i] = *(const float4*)(x + lane * 4 + 256 * i); ss += v[i].x * v[i].x + v[i].y * v[i].y + v[i].z * v[i].z + v[i].w * v[i].w; }
        ss = wsum(ss);
        const float rstd = rsqrtf(ss * (1.f / 1024.f) + 1e-6f);
        float lg[16];
#pragma unroll
        for (int e = 0; e < 16; ++e) lg[e] = 0.f;
#pragma unroll
        for (int i = 0; i < 4; ++i) {
            const int c = lane * 4 + 256 * i;
            const float4 gg = *(const float4*)(g + c), sc = *(const float4*)(md + 4096 + c), sh = *(const float4*)(md + 3072 + c);
            const float hv[4] = {v[i].x * rstd * gg.x * (1.f + sc.x) + sh.x, v[i].y * rstd * gg.y * (1.f + sc.y) + sh.y,
                                 v[i].z * rstd * gg.z * (1.f + sc.z) + sh.z, v[i].w * rstd * gg.w * (1.f + sc.w) + sh.w};
            f32x4 h4 = {hv[0], hv[1], hv[2], hv[3]};
            store_bf16x4(H + (size_t)row * 1024 + c, h4);
#pragma unroll
            for (int j = 0; j < 4; ++j) {
                const float* wr_ = rw + (size_t)(c + j) * 16;
                const float4 w0 = *(const float4*)wr_, w1 = *(const float4*)(wr_ + 4), w2 = *(const float4*)(wr_ + 8), w3 = *(const float4*)(wr_ + 12);
                lg[0] += hv[j] * w0.x; lg[1] += hv[j] * w0.y; lg[2] += hv[j] * w0.z; lg[3] += hv[j] * w0.w;
                lg[4] += hv[j] * w1.x; lg[5] += hv[j] * w1.y; lg[6] += hv[j] * w1.z; lg[7] += hv[j] * w1.w;
                lg[8] += hv[j] * w2.x; lg[9] += hv[j] * w2.y; lg[10] += hv[j] * w2.z; lg[11] += hv[j] * w2.w;
                lg[12] += hv[j] * w3.x; lg[13] += hv[j] * w3.y; lg[14] += hv[j] * w3.z; lg[15] += hv[j] * w3.w;
            }
        }
        float sc_[16], sel[16];
#pragma unroll
        for (int e = 0; e < 16; ++e) { lg[e] = wsum(lg[e]); sc_[e] = 1.f / (1.f + expf(-lg[e])); sel[e] = sc_[e] + rb[e]; }
        int best = 0; float bestv = -1e30f;
#pragma unroll
        for (int gi = 0; gi < 4; ++gi) {
            float m1 = -1e30f, m2 = -1e30f;
#pragma unroll
            for (int j = 0; j < 4; ++j) { const float s = sel[gi * 4 + j]; if (s > m1) { m2 = m1; m1 = s; } else if (s > m2) m2 = s; }
            const float gs = m1 + m2;
            if (gs > bestv) { bestv = gs; best = gi; }
        }
        float s4[4] = {0.f, 0.f, 0.f, 0.f}, c4[4] = {0.f, 0.f, 0.f, 0.f};
#pragma unroll
        for (int gi = 0; gi < 4; ++gi)
#pragma unroll
            for (int j = 0; j < 4; ++j) if (gi == best) { s4[j] = sel[gi * 4 + j]; c4[j] = sc_[gi * 4 + j]; }
        int i1 = 0; float v1 = s4[0], w1 = c4[0];
#pragma unroll
        for (int j = 1; j < 4; ++j) if (s4[j] > v1) { v1 = s4[j]; i1 = j; w1 = c4[j]; }
        int i2 = -1; float v2 = -1e30f, w2 = 0.f;
#pragma unroll
        for (int j = 0; j < 4; ++j) if (j != i1 && s4[j] > v2) { v2 = s4[j]; i2 = j; w2 = c4[j]; }
        if (lane == 0) {
            const float inv = 1.f / (w1 + w2);
            const int e1 = best * 4 + i1, e2 = best * 4 + i2;
            const unsigned r1 = atomicAdd(&lcnt[e1], 1u), r2 = atomicAdd(&lcnt[e2], 1u);
            int* rc = rec + (wave * 32 + nrec) * 8;
            rc[0] = row; rc[1] = e1; rc[2] = e2; rc[3] = (int)r1; rc[4] = (int)r2; rc[5] = __float_as_int(w1 * inv); rc[6] = __float_as_int(w2 * inv);
        }
        ++nrec;
    }
    __syncthreads();
    if (tid < 16) gbase[tid] = lcnt[tid] ? atomicAdd(&cnt[tid], lcnt[tid]) : 0u;
    __syncthreads();
    for (int i = lane; i < nrec; i += 64) {
        const int* rc = rec + (wave * 32 + i) * 8;
        const int row = rc[0], e1 = rc[1], e2 = rc[2];
        const unsigned p1 = gbase[e1] + (unsigned)rc[3], p2 = gbase[e2] + (unsigned)rc[4];
        LTOK[(size_t)e1 * RT + p1] = row; LW[(size_t)e1 * RT + p1] = __int_as_float(rc[5]);
        LTOK[(size_t)e2 * RT + p2] = row; LW[(size_t)e2 * RT + p2] = __int_as_float(rc[6]);
        SLOT[row * 2] = (e1 << 20) | (int)p1; SLOT[row * 2 + 1] = (e2 << 20) | (int)p2;
    }
}

struct MoeTiles { int tb[17]; int sm; };
__device__ __forceinline__ void moe_tiles(const Params& p, int l, int* s_tb) {
    if (tidx() == 0) {
        const unsigned* cnt = (const unsigned*)(p.ws + O_CNT);
        int a = 0;
        for (int e = 0; e < 16; ++e) { s_tb[e] = a; a += ((int)cnt[e] + 127) >> 7; }
        s_tb[16] = a;
    }
    __syncthreads();
}
struct ALGather {
    const bf16_t* p[4]; bool ok[4];
    __device__ __forceinline__ uint4 load(int i, int k) const { return ok[i] ? *(const uint4*)(p[i] + k) : make_uint4(0u, 0u, 0u, 0u); }
};
struct ALSwiglu {
    const bf16_t* p[4]; float w[4];
    __device__ __forceinline__ uint4 load(int i, int k) const {
        float g[8], u[8], o[8]; unpack8(*(const uint4*)(p[i] + k), g); unpack8(*(const uint4*)(p[i] + 512 + k), u);
#pragma unroll
        for (int j = 0; j < 8; ++j) o[j] = siluf_(g[j]) * u[j] * w[i];
        return pack8(o);
    }
};
__device__ __forceinline__ void ph_e1(const Params& p, int l, char* smem) {
    int* s_tb = (int*)(smem + 73728);
    moe_tiles(p, l, s_tb);
    const bf16_t* H = (const bf16_t*)(p.ws + O_H); bf16_t* GU = (bf16_t*)(p.ws + O_P);
    const unsigned* cnt = (const unsigned*)(p.ws + O_CNT); const int* LTOK = (const int*)(p.ws + O_LTOK);
    const int sm = (l < NLAYER - 1) ? RT / 128 : RL / 128;
    const int total = (sm + s_tb[16]) * 8;
    for (int it = blockIdx.x; it < total; it += gridDim.x) {
        const int mt = it >> 3, nt = it & 7;
        int e = 16, erow0 = mt * 128, lt = 0;
        if (mt >= sm) { const int q = mt - sm; e = 0; while (q >= s_tb[e + 1]) ++e; lt = q - s_tb[e]; erow0 = RT + q * 128; }
        const int cnte = (e == 16) ? 0 : (int)cnt[e];
        auto rp = [&](int r) -> const bf16_t* {
            if (e == 16) return H + (size_t)(mt * 128 + r) * 1024;
            const int idx = lt * 128 + r;
            const int tok = idx < cnte ? LTOK[(size_t)e * RT + idx] : 0;
            return H + (size_t)tok * 1024;
        };
        f32x4 acc[4][4];
        gemm_core_g<4>(rp, (const bf16_t*)(p.ws + O_WB + W_GU) + (size_t)e * 1024 * 1024 + (size_t)nt * 128 * 1024, 1024, 1024, acc, smem);
        acc_foreach<4>(acc, [&](int m, int n, const f32x4& v) { store_bf16x4(GU + (size_t)(erow0 + m) * 1024 + nt * 128 + n, v); });
    }
}
__device__ __forceinline__ void ph_e2(const Params& p, int l, char* smem) {
    int* s_tb = (int*)(smem + 73728);
    moe_tiles(p, l, s_tb);
    const bf16_t* GU = (const bf16_t*)(p.ws + O_P); bf16_t* YE = (bf16_t*)(p.ws + O_X + X_YE);
    const unsigned* cnt = (const unsigned*)(p.ws + O_CNT); const float* LW = (const float*)(p.ws + O_LW);
    const int sm = (l < NLAYER - 1) ? RT / 128 : RL / 128;
    const int total = (sm + s_tb[16]) * 8;
    for (int it = blockIdx.x; it < total; it += gridDim.x) {
        const int mt = it >> 3, nt = it & 7;
        int e = 16, erow0 = mt * 128, lt = 0;
        if (mt >= sm) { const int q = mt - sm; e = 0; while (q >= s_tb[e + 1]) ++e; lt = q - s_tb[e]; erow0 = RT + q * 128; }
        ALSwiglu al;
#pragma unroll
        for (int i = 0; i < 4; ++i) {
            const int r = (tidx() >> 3) + 32 * i;
            al.p[i] = GU + (size_t)(erow0 + r) * 1024;
            if (e == 16) al.w[i] = 1.f;
            else { const int idx = lt * 128 + r; al.w[i] = idx < (int)cnt[e] ? LW[(size_t)e * RT + idx] : 0.f; }
        }
        f32x4 acc[4][4];
        gemm_core<4>(al, (const bf16_t*)(p.ws + O_WB + W_D) + (size_t)e * 1024 * 512 + (size_t)nt * 128 * 512, 512, 512, acc, smem);
        acc_foreach<4>(acc, [&](int m, int n, const f32x4& v) { store_bf16x4(YE + (size_t)(erow0 + m) * 1024 + nt * 128 + n, v); });
    }
}
__device__ __forceinline__ void ph_e3(const Params& p, int l, char* smem) {
    int* s_tb = (int*)(smem + 73728);
    moe_tiles(p, l, s_tb);
    const int lane = tidx() & 63, wave = tidx() >> 6;
    const bf16_t* YE = (const bf16_t*)(p.ws + O_X + X_YE); const int* SLOT = (const int*)(p.ws + O_SLOT);
    float* xcur = (float*)(p.ws + O_XCUR); const float* mod = (const float*)(p.ws + O_MOD);
    const int nrows = (l < NLAYER - 1) ? RT : RL;
    for (int row = blockIdx.x * 4 + wave; row < nrows; row += gridDim.x * 4) {
        const int s1 = SLOT[row * 2], s2 = SLOT[row * 2 + 1];
        const size_t r0 = row, r1 = (size_t)RT + s_tb[s1 >> 20] * 128 + (s1 & 0xfffff), r2 = (size_t)RT + s_tb[s2 >> 20] * 128 + (s2 & 0xfffff);
        const float* g2 = mod + (size_t)(l * 5 + modidx(row)) * 6144 + 5120;
#pragma unroll
        for (int i = 0; i < 2; ++i) {
            const int c = lane * 8 + 512 * i;
            float a[8], b[8], d[8];
            unpack8(*(const uint4*)(YE + r0 * 1024 + c), a); unpack8(*(const uint4*)(YE + r1 * 1024 + c), b); unpack8(*(const uint4*)(YE + r2 * 1024 + c), d);
            float4* xp = (float4*)(xcur + (size_t)row * 1024 + c);
            float4 x0 = xp[0], x1 = xp[1];
            const float4 ga = *(const float4*)(g2 + c), gb = *(const float4*)(g2 + c + 4);
            x0.x += ga.x * (a[0] + b[0] + d[0]); x0.y += ga.y * (a[1] + b[1] + d[1]); x0.z += ga.z * (a[2] + b[2] + d[2]); x0.w += ga.w * (a[3] + b[3] + d[3]);
            x1.x += gb.x * (a[4] + b[4] + d[4]); x1.y += gb.y * (a[5] + b[5] + d[5]); x1.z += gb.z * (a[6] + b[6] + d[6]); x1.w += gb.w * (a[7] + b[7] + d[7]);
            xp[0] = x0; xp[1] = x1;
        }
    }
}
__device__ __forceinline__ void ph_final(const Params& p) {
    const int lane = tidx() & 63, wave = tidx() >> 6;
    const float* xcur = (const float*)(p.ws + O_XCUR); const float* g = p.in[I_FNG];
    for (int row = blockIdx.x * 4 + wave; row < RL; row += gridDim.x * 4) {
        const float* x = xcur + (size_t)row * 1024;
        float4 v[4]; float ss = 0.f;
#pragma unroll
        for (int i = 0; i < 4; ++i) { v[i] = *(const float4*)(x + lane * 4 + 256 * i); ss += v[i].x * v[i].x + v[i].y * v[i].y + v[i].z * v[i].z + v[i].w * v[i].w; }
        ss = wsum(ss);
        const float rstd = rsqrtf(ss * (1.f / 1024.f) + 1e-6f);
#pragma unroll
        for (int i = 0; i < 4; ++i) {
            const int c = lane * 4 + 256 * i; const float4 gg = *(const float4*)(g + c);
            *(float4*)(p.out + (size_t)row * 1024 + c) = make_float4(v[i].x * rstd * gg.x, v[i].y * rstd * gg.y, v[i].z * rstd * gg.z, v[i].w * rstd * gg.w);
        }
    }
}

constexpr int LDS_BYTES = 76800;
constexpr int NIV = 19;
extern __shared__ __attribute__((aligned(16))) char dynsmem[];
template <int ID> __device__ __forceinline__ void run_iv(const Params& pin, int l, char* smem) {
    Params p = pin; p.ws = launder(pin.ws);
    if constexpr (ID == 0) { ph_pre(p, smem); __syncthreads(); ph_w(p, 0, smem); }
    else if constexpr (ID == 1) ph_n1(p, l);
    else if constexpr (ID == 2) ph_g1(p, smem);
    else if constexpr (ID == 3) ph_qu(p, smem);
    else if constexpr (ID == 4) ph_m2(p, smem);
    else if constexpr (ID == 5) ph_at(p, l, smem);
    else if constexpr (ID == 6) { ph_rp1(p, l, smem); ph_rp2(p, l); }
    else if constexpr (ID == 7) ph_r1(p, l, smem);
    else if constexpr (ID == 8) ph_r2(p);
    else if constexpr (ID == 9) ph_r3(p);
    else if constexpr (ID == 10) { ph_rpost(p, l); ph_f1(p, l, smem); }
    else if constexpr (ID == 11) ph_f2(p, l, smem);
    else if constexpr (ID == 12) ph_mg(p, l, smem);
    else if constexpr (ID == 13) ph_out(p, l, smem);
    else if constexpr (ID == 14) ph_n2(p, l, smem);
    else if constexpr (ID == 15) ph_e1(p, l, smem);
    else if constexpr (ID == 16) ph_e2(p, l, smem);
    else if constexpr (ID == 17) { ph_e3(p, l, smem); __syncthreads(); if (l + 1 < NLAYER) ph_w(p, l + 1, smem); }
    else ph_final(p);
}
#if MEGA
#ifndef PROBE_MASK
#define PROBE_MASK 0
#define PROBE_REP 1
#endif
#define IV(ID) for (int r_ = 0; r_ < (((PROBE_MASK >> (ID)) & 1) ? PROBE_REP : 1); ++r_) { run_iv<ID>(p, l, smem); xcd_barrier(bar); }
__global__ void __launch_bounds__(256, 2) k_mega(Params p) {
    char* smem = dynsmem;
    volatile LAS unsigned* st = (volatile LAS unsigned*)(smem + LDS_BYTES - 16);
    if (tidx() == 0) { st[0] = 0u; st[1] = 0u; }
    __syncthreads();
    XcdBarrier bar = xcd_barrier_post((unsigned*)(p.ws + O_BAR), st);
    { const int l = 0; IV(0) }
    for (int l = 0; l < NLAYER; ++l) {
        IV(1) IV(2) IV(3) IV(4) IV(5) IV(6) IV(7) IV(8) IV(9) IV(10) IV(11) IV(12) IV(13) IV(14) IV(15) IV(16) IV(17)
    }
    run_iv<18>(p, 0, smem);
}
#else
template <int ID> __global__ void __launch_bounds__(256, 2) k_iv(Params p, int l) { run_iv<ID>(p, l, dynsmem); }
template <int ID> static void launch_iv(const Params& p, int l, int grid, hipStream_t s) {
    static bool once = false; if (!once) { once = true; (void)hipFuncSetAttribute((const void*)k_iv<ID>, hipFuncAttributeMaxDynamicSharedMemorySize, LDS_BYTES); }
    hipLaunchKernelGGL(k_iv<ID>, dim3(grid), dim3(256), LDS_BYTES, s, p, l);
}
#endif

extern "C" void kernel_launch(void* const* d_in, const int* in_sizes, int n_in, void* d_out, int out_size, void* d_ws, size_t ws_size, hipStream_t stream) {
    (void)in_sizes; (void)out_size;
    if (n_in < N_IN || ws_size < WS_NEED) return;
    Params p{};
    for (int i = 0; i < N_IN; ++i) p.in[i] = (const float*)d_in[i];
    p.out = (float*)d_out; p.ws = (char*)d_ws;
    static int grid = 0;
    if (!grid) {
        int dev = 0, cus = 0; (void)hipGetDevice(&dev); (void)hipDeviceGetAttribute(&cus, hipDeviceAttributeMultiprocessorCount, dev);
        int per_cu = 2;
#if MEGA
        (void)hipFuncSetAttribute((const void*)k_mega, hipFuncAttributeMaxDynamicSharedMemorySize, LDS_BYTES);
        int occ = 0; (void)hipOccupancyMaxActiveBlocksPerMultiprocessor(&occ, k_mega, 256, LDS_BYTES);
        if (occ < per_cu) per_cu = occ;
        if (per_cu < 1) per_cu = 1;
#endif
        grid = cus * per_cu;
    }
#if MEGA
    (void)hipMemsetAsync(p.ws + O_BAR, 0, 16384, stream);
    hipLaunchKernelGGL(k_mega, dim3(grid), dim3(256), LDS_BYTES, stream, p);
#else
    launch_iv<0>(p, 0, grid, stream);
    for (int l = 0; l < NLAYER; ++l) {
        launch_iv<1>(p, l, grid, stream); launch_iv<2>(p, l, grid, stream); launch_iv<3>(p, l, grid, stream); launch_iv<4>(p, l, grid, stream);
        launch_iv<5>(p, l, grid, stream); launch_iv<6>(p, l, grid, stream); launch_iv<7>(p, l, grid, stream); launch_iv<8>(p, l, grid, stream);
        launch_iv<9>(p, l, grid, stream); launch_iv<10>(p, l, grid, stream); launch_iv<11>(p, l, grid, stream); launch_iv<12>(p, l, grid, stream);
        launch_iv<13>(p, l, grid, stream); launch_iv<14>(p, l, grid, stream); launch_iv<15>(p, l, grid, stream); launch_iv<16>(p, l, grid, stream); launch_iv<17>(p, l, grid, stream);
    }
    launch_iv<18>(p, 0, grid, stream);
#endif
}
```

```cpp
#include <hip/hip_runtime.h>
#include <stdint.h>

#ifndef MEGA
#define MEGA 1
#endif

typedef unsigned short bf16_t;
typedef short bf16x8 __attribute__((ext_vector_type(8)));
typedef float f32x4 __attribute__((ext_vector_type(4)));
typedef float f32x2 __attribute__((ext_vector_type(2)));
typedef unsigned u32x4 __attribute__((ext_vector_type(4)));
typedef __bf16 bf16v2 __attribute__((ext_vector_type(2)));

constexpr int NLAYER = 4;
constexpr int DM = 1024;
constexpr int RL = 16384, RC = 1024, RT = RL + RC;
constexpr int SEQ = 4096, CTX = 256, KEYS = SEQ + CTX;
constexpr int LDP = 6144;
constexpr int PQ0 = 512, PKV0 = 896, PKR0 = 1152, PR0 = 1184, PG0 = 2976, PEND = 6048;
constexpr int NEXP = 16;
constexpr int EROWS = 54272;

enum { I_X = 0, I_C, I_CTX, I_CCTX, I_WADA, I_BADA, I_N1G, I_N2G, I_WIN, I_QNG, I_KVNG, I_WUQ, I_WUKV, I_MU, I_W0, I_WUP, I_A0, I_AUP, I_GUP,
       I_KK, I_KA, I_RK, I_GNG, I_GNB, I_WPA, I_WPB, I_WPC, I_WOUT, I_RW, I_RB, I_EG, I_EU, I_ED, I_SG, I_SU, I_SD, I_FNG, N_IN };

struct Params { const float* in[N_IN]; float* out; char* ws; };

constexpr size_t al256(size_t x) { return (x + 255) & ~(size_t)255; }
constexpr size_t O_BAR   = 0;
constexpr size_t O_CNT   = O_BAR + 16384;
constexpr size_t O_MOD   = O_CNT + 4096;
constexpr size_t O_ROPEC = O_MOD + (size_t)NLAYER * 5 * 6144 * 4;
constexpr size_t O_ROPES = O_ROPEC + (size_t)SEQ * 16 * 4;
constexpr size_t O_CSC   = O_ROPES + (size_t)SEQ * 16 * 4;
constexpr size_t O_CST256= O_CSC + 256 * 128 * 2;
constexpr size_t O_CST   = O_CST256 + 256 * 512 * 2;
constexpr size_t O_XCUR  = O_CST + (size_t)4096 * 8192 * 2;
constexpr size_t O_WB    = O_XCUR + (size_t)RT * DM * 4;
constexpr size_t W_IN   = 0;
constexpr size_t W_UQ   = W_IN + (size_t)6144 * 1024 * 2;
constexpr size_t W_UKV  = W_UQ + (size_t)768 * 384 * 2;
constexpr size_t W_WUP  = W_UKV + (size_t)1024 * 256 * 2;
constexpr size_t W_AUP  = W_WUP + (size_t)2 * 512 * 64 * 2;
constexpr size_t W_GUP  = W_AUP + (size_t)2 * 512 * 64 * 2;
constexpr size_t W_PA   = W_GUP + (size_t)512 * 128 * 2;
constexpr size_t W_PB   = W_PA + (size_t)1024 * 512 * 2;
constexpr size_t W_PC   = W_PB + (size_t)1024 * 512 * 2;
constexpr size_t W_OUT  = W_PC + (size_t)1024 * 512 * 2;
constexpr size_t W_GU   = W_OUT + (size_t)1024 * 1024 * 2;
constexpr size_t W_D    = W_GU + (size_t)17 * 1024 * 1024 * 2;
constexpr size_t W_END  = W_D + (size_t)17 * 1024 * 512 * 2;
constexpr size_t O_H    = O_WB + W_END;
constexpr size_t O_P    = O_H + (size_t)RT * DM * 2;
constexpr size_t O_ATT  = O_P + (size_t)RT * LDP * 2;
constexpr size_t O_RG   = O_ATT + (size_t)RT * 512 * 2;
constexpr size_t O_RWO  = O_RG + (size_t)RT * 512 * 2;
constexpr size_t O_FA   = O_RWO + (size_t)RT * 512 * 2;
constexpr size_t O_LTOK = O_FA + (size_t)RT * 512 * 2;
constexpr size_t O_LW   = O_LTOK + (size_t)NEXP * RT * 4;
constexpr size_t O_SLOT = O_LW + (size_t)NEXP * RT * 4;
constexpr size_t O_X    = al256(O_SLOT + (size_t)RT * 2 * 4);
constexpr size_t X_QRAW = 0;
constexpr size_t X_KVRAW= X_QRAW + (size_t)RT * 768 * 2;
constexpr size_t X_QA   = X_KVRAW + (size_t)RT * 1024 * 2;
constexpr size_t X_KA   = X_QA + (size_t)RT * 768 * 2;
constexpr size_t X_VA   = X_KA + (size_t)4 * KEYS * 768 * 2;
constexpr int NCP = 4 * 8 * 2 * 68;
constexpr size_t X_MT   = 0;
constexpr size_t X_NL   = X_MT + (size_t)NCP * 8192;
constexpr size_t X_GT   = X_NL + (size_t)NCP * 8192;
constexpr size_t X_YL   = X_GT + (size_t)NCP * 8192;
constexpr size_t X_S0   = X_YL + (size_t)NCP * 8192;
constexpr size_t X_KKN  = X_S0 + (size_t)NCP * 8192;
constexpr size_t X_BON  = X_KKN + (size_t)RT * 8 * 4;
constexpr size_t X_END  = X_BON + (size_t)2 * RT * 8 * 4;
constexpr size_t X_YT   = 0;
constexpr size_t X_YTC  = X_YT + (size_t)4 * 512 * 8192 * 2;
constexpr size_t X_YE   = 0;
constexpr size_t WS_NEED = O_X + X_END;

__device__ __forceinline__ float bf2f(bf16_t u) { return __builtin_bit_cast(float, (unsigned)u << 16); }
__device__ __forceinline__ float bflo(unsigned u) { return __builtin_bit_cast(float, u << 16); }
__device__ __forceinline__ float bfhi(unsigned u) { return __builtin_bit_cast(float, u & 0xffff0000u); }
__device__ __forceinline__ unsigned pack2(float lo, float hi) { f32x2 v = {lo, hi}; bf16v2 b = __builtin_convertvector(v, bf16v2); return __builtin_bit_cast(unsigned, b); }
__device__ __forceinline__ bf16_t f2bf(float f) { return (bf16_t)(pack2(f, 0.f) & 0xffffu); }
__device__ __forceinline__ float wsum(float v) {
#pragma unroll
    for (int o = 32; o > 0; o >>= 1) v += __shfl_xor(v, o);
    return v;
}
__device__ __forceinline__ float sigmoidf_(float x) { return 1.f / (1.f + __expf(-x)); }
__device__ __forceinline__ float siluf_(float x) { return x / (1.f + __expf(-x)); }
__device__ __forceinline__ int modidx(int row) { return row < RL ? (row >> 12) : 4; }
__device__ __forceinline__ void unpack8(const uint4& u, float (&f)[8]) {
    f[0] = bflo(u.x); f[1] = bfhi(u.x); f[2] = bflo(u.y); f[3] = bfhi(u.y); f[4] = bflo(u.z); f[5] = bfhi(u.z); f[6] = bflo(u.w); f[7] = bfhi(u.w);
}
__device__ __forceinline__ uint4 pack8(const float (&f)[8]) { return make_uint4(pack2(f[0], f[1]), pack2(f[2], f[3]), pack2(f[4], f[5]), pack2(f[6], f[7])); }

#define XB_TMO      128
#define XB_XCNT(j)  (256  + 64 * (j))
#define XB_XSUB(j)  (1280 + 64 * (j))
#define XB_XGEN(j)  (2304 + 64 * (j))
#define XB_TOP      3328
#define XB_TOPGEN   3392
#define XCD_BAR_WORDS 3456
#define XB_SPIN_CAP (1u << 22)
#define LAS __attribute__((address_space(3)))
__device__ __forceinline__ unsigned xb_ld(unsigned* p)              { return __hip_atomic_load(p, __ATOMIC_RELAXED, __HIP_MEMORY_SCOPE_AGENT); }
__device__ __forceinline__ unsigned xb_add(unsigned* p, unsigned v) { return __hip_atomic_fetch_add(p, v, __ATOMIC_RELAXED, __HIP_MEMORY_SCOPE_AGENT); }
__device__ __forceinline__ unsigned xb_xcc_id() { return (unsigned)__builtin_amdgcn_s_getreg((3 << 11) | 20) & 0xFu; }
#define XB_SPIN(cond, bar) do { unsigned _sp = 0; while (cond) { __builtin_amdgcn_s_sleep(1); \
    if ((++_sp & 255u) == 0u) { if (xb_ld(&(bar)[XB_TMO])) break; if (_sp > XB_SPIN_CAP) { atomicAdd(&(bar)[XB_TMO], 1u); break; } } } } while (0)
struct XcdBarrier { unsigned* bar; unsigned x; volatile LAS unsigned* st; };
__device__ __forceinline__ XcdBarrier xcd_barrier_post(unsigned* bar, volatile LAS unsigned* st) {
    XcdBarrier b; b.bar = bar; b.x = xb_xcc_id(); b.st = st;
    if (threadIdx.x == 0) (void)xb_add(&bar[XB_XCNT(b.x)], 1u);
    return b;
}
__device__ __forceinline__ void xcd_barrier_complete(unsigned* bar, unsigned x, unsigned& nloc, unsigned& nx) {
    const unsigned G = gridDim.x * gridDim.y * gridDim.z;
    unsigned sum, cnt, mine, sp = 0u;
    for (;;) {
        sum = 0u; cnt = 0u; mine = 0u;
#pragma unroll
        for (unsigned j = 0; j < 16; ++j) { const unsigned c = xb_ld(&bar[XB_XCNT(j)]); sum += c; cnt += (c > 0u) ? 1u : 0u; mine = (j == x) ? c : mine; }
        if (sum == G) break;
        __builtin_amdgcn_s_sleep(1);
        if ((++sp & 255u) == 0u) { if (xb_ld(&bar[XB_TMO])) break; if (sp > XB_SPIN_CAP) { atomicAdd(&bar[XB_TMO], 1u); break; } }
    }
    nloc = mine > 0u ? mine : 1u; nx = cnt > 0u ? cnt : 1u;
}
__device__ __forceinline__ void xcd_barrier(const XcdBarrier& b) {
    asm volatile("s_waitcnt vmcnt(0)" ::: "memory");
    __syncthreads();
    if (threadIdx.x == 0) {
        unsigned* bar = b.bar;
        __builtin_amdgcn_s_waitcnt(0);
        unsigned nloc = b.st[0], nx = b.st[1];
        if (nloc == 0u) { xcd_barrier_complete(bar, b.x, nloc, nx); b.st[0] = nloc; b.st[1] = nx; }
        const unsigned old = xb_add(&bar[XB_XSUB(b.x)], 1u);
        const unsigned gen = old / nloc;
        if (old + 1u == (gen + 1u) * nloc) {
            __builtin_amdgcn_fence(__ATOMIC_RELEASE, "agent");
            asm volatile("s_waitcnt vmcnt(0)" ::: "memory");
            const unsigned og = xb_add(&bar[XB_TOP], 1u);
            const unsigned tg = og / nx;
            if (og + 1u == (tg + 1u) * nx) xb_add(&bar[XB_TOPGEN], 1u);
            else XB_SPIN(xb_ld(&bar[XB_TOPGEN]) == tg, bar);
            __builtin_amdgcn_fence(__ATOMIC_ACQUIRE, "agent");
            xb_add(&bar[XB_XGEN(b.x)], 1u);
            asm volatile("s_waitcnt vmcnt(0)" ::: "memory");
        } else {
            XB_SPIN(xb_ld(&bar[XB_XGEN(b.x)]) == gen, bar);
            __builtin_amdgcn_fence(__ATOMIC_ACQUIRE, "agent");
            asm volatile("s_waitcnt vmcnt(0)" ::: "memory");
        }
    }
    __syncthreads();
}

__device__ __forceinline__ int tidx() { int t = threadIdx.x; asm volatile("" : "+v"(t)); return t; }
__device__ __forceinline__ int lv(int x) { asm volatile("" : "+v"(x)); return x; }
__device__ __forceinline__ char* launder(char* p) { size_t z = 0; asm volatile("" : "+s"(z)); return p + z; }

constexpr int LDSROW = 72;
template <int NA, class AL>
__device__ __forceinline__ void gc_load(const AL& al, const bf16_t* bp, size_t bstep, int k0, int kc, u32x4 (&ra)[NA], u32x4 (&rb)[4]) {
#pragma unroll
    for (int i = 0; i < NA; ++i) ra[i] = __builtin_bit_cast(u32x4, al.load(i, k0 + kc));
#pragma unroll
    for (int j = 0; j < 4; ++j) rb[j] = *(const u32x4*)(bp + j * bstep + k0);
}
template <int NA>
__device__ __forceinline__ void gc_store(bf16_t* Ab, bf16_t* Bb, int lr, int kc, const u32x4 (&ra)[NA], const u32x4 (&rb)[4]) {
#pragma unroll
    for (int i = 0; i < NA; ++i) *(u32x4*)(Ab + (lr + 32 * i) * LDSROW + kc) = ra[i];
#pragma unroll
    for (int j = 0; j < 4; ++j) *(u32x4*)(Bb + (lr + 32 * j) * LDSROW + kc) = rb[j];
}
template <int MI>
__device__ __forceinline__ void gc_compute(const bf16_t* Ac, const bf16_t* Bc, f32x4 (&acc)[MI][4]) {
#pragma unroll
    for (int kh = 0; kh < 2; ++kh) {
        bf16x8 af[MI], bfv[4];
#pragma unroll
        for (int i = 0; i < MI; ++i) af[i] = *(const bf16x8*)(Ac + i * 16 * LDSROW + kh * 32);
#pragma unroll
        for (int j = 0; j < 4; ++j) bfv[j] = *(const bf16x8*)(Bc + j * 16 * LDSROW + kh * 32);
#pragma unroll
        for (int i = 0; i < MI; ++i)
#pragma unroll
            for (int j = 0; j < 4; ++j) acc[i][j] = __builtin_amdgcn_mfma_f32_16x16x32_bf16(bfv[j], af[i], acc[i][j], 0, 0, 0);
    }
}
template <int MI, class AL>
__device__ __forceinline__ void gemm_core(const AL& al, const bf16_t* __restrict__ Bt, int ldb, int K, f32x4 (&acc)[MI][4], char* smem) {
    constexpr int TM = MI * 32;
    constexpr int NA = TM / 32;
    bf16_t* As = (bf16_t*)smem;
    bf16_t* Bs = As + 2 * TM * LDSROW;
    const int tid = tidx(), lane = tid & 63, wave = tid >> 6;
    const int wr = wave >> 1, wc = wave & 1, fr = lane & 15, fq = lane >> 4;
    const int kc = (tid & 7) * 8, lr = tid >> 3;
#pragma unroll
    for (int i = 0; i < MI; ++i)
#pragma unroll
        for (int j = 0; j < 4; ++j) acc[i][j] = (f32x4){0.f, 0.f, 0.f, 0.f};
    u32x4 a0[NA], b0[4], a1[NA], b1[4];
    const bf16_t* bp = Bt + (size_t)lr * ldb + kc;
    const size_t bstep = (size_t)32 * ldb;
    const int nk = K >> 6;
    bf16_t* As1 = As + TM * LDSROW; bf16_t* Bs1 = Bs + 128 * LDSROW;
    const int aoff = (wr * MI * 16 + fr) * LDSROW + fq * 8, boff = (wc * 64 + fr) * LDSROW + fq * 8;
    gc_load<NA>(al, bp, bstep, 0, kc, a0, b0);
    gc_store<NA>(As, Bs, lr, kc, a0, b0);
    if (nk > 1) gc_load<NA>(al, bp, bstep, 64, kc, a0, b0);
    __syncthreads();
    for (int kt = 0; kt < nk; kt += 2) {
        if (kt + 2 < nk) gc_load<NA>(al, bp, bstep, (kt + 2) << 6, kc, a1, b1);
        gc_compute<MI>(As + aoff, Bs + boff, acc);
        if (kt + 1 < nk) gc_store<NA>(As1, Bs1, lr, kc, a0, b0);
        __syncthreads();
        if (kt + 1 >= nk) break;
        if (kt + 3 < nk) gc_load<NA>(al, bp, bstep, (kt + 3) << 6, kc, a0, b0);
        gc_compute<MI>(As1 + aoff, Bs1 + boff, acc);
        if (kt + 2 < nk) gc_store<NA>(As, Bs, lr, kc, a1, b1);
        __syncthreads();
    }
}
template <int MI, class RP>
__device__ __forceinline__ void gemm_core_g(const RP& rp, const bf16_t* __restrict__ Bt, int ldb, int K, f32x4 (&acc)[MI][4], char* smem) {
    constexpr int ABYTES = MI * 32 * 128;
    constexpr int SBYTES = ABYTES + 16384;
    const int tid = tidx(), lane = tid & 63, wave = tid >> 6;
    const int wr = wave >> 1, wc = wave & 1, fr = lane & 15, fq = lane >> 4;
    const int rr = lane >> 3, cs = ((lane & 7) ^ ((wave * 4 + (lane >> 4)) & 7)) * 8;
#pragma unroll
    for (int i = 0; i < MI; ++i)
#pragma unroll
        for (int j = 0; j < 4; ++j) acc[i][j] = (f32x4){0.f, 0.f, 0.f, 0.f};
    const bf16_t* ap[MI]; const bf16_t* bp[4];
#pragma unroll
    for (int i = 0; i < MI; ++i) { const int r = (i * 4 + wave) * 8 + rr; ap[i] = rp(r) + cs; }
#pragma unroll
    for (int i = 0; i < 4; ++i) { const int r = (i * 4 + wave) * 8 + rr; bp[i] = Bt + (size_t)r * ldb + cs; }
    const int wbase = __builtin_amdgcn_readfirstlane(wave) * 1024;
    const int nk = K >> 6;
    auto stage = [&](int buf, int kt) {
        char* Ab = smem + buf * SBYTES + wbase; char* Bb = Ab + ABYTES;
#pragma unroll
        for (int i = 0; i < MI; ++i) __builtin_amdgcn_global_load_lds((const unsigned*)(ap[i] + kt * 64), (unsigned*)(Ab + i * 4096), 16, 0, 0);
#pragma unroll
        for (int i = 0; i < 4; ++i) __builtin_amdgcn_global_load_lds((const unsigned*)(bp[i] + kt * 64), (unsigned*)(Bb + i * 4096), 16, 0, 0);
    };
    const int aoff = (wr * MI * 16 + fr) * 128, boff = ABYTES + (wc * 64 + fr) * 128, sw = fr >> 1;
    stage(0, 0);
    asm volatile("s_waitcnt vmcnt(0)" ::: "memory");
    __syncthreads();
    for (int kt = 0; kt < nk; ++kt) {
        const int cur = kt & 1;
        if (kt + 1 < nk) stage(cur ^ 1, kt + 1);
        const char* base = smem + cur * SBYTES;
#pragma unroll
        for (int kh = 0; kh < 2; ++kh) {
            const int xo = ((kh * 4 + fq) ^ sw) * 16;
            bf16x8 af[MI], bfv[4];
#pragma unroll
            for (int i = 0; i < MI; ++i) af[i] = *(const bf16x8*)(base + aoff + i * 2048 + xo);
#pragma unroll
            for (int j = 0; j < 4; ++j) bfv[j] = *(const bf16x8*)(base + boff + j * 2048 + xo);
#pragma unroll
            for (int i = 0; i < MI; ++i)
#pragma unroll
                for (int j = 0; j < 4; ++j) acc[i][j] = __builtin_amdgcn_mfma_f32_16x16x32_bf16(bfv[j], af[i], acc[i][j], 0, 0, 0);
        }
        asm volatile("s_waitcnt vmcnt(0)" ::: "memory");
        __syncthreads();
    }
}
struct RPPlain {
    const bf16_t* A; size_t lda;
    __device__ __forceinline__ const bf16_t* operator()(int r) const { return A + (size_t)r * lda; }
};
template <int MI, class F>
__device__ __forceinline__ void acc_foreach(const f32x4 (&acc)[MI][4], F f) {
    const int lane = tidx() & 63, wave = tidx() >> 6;
    const int wr = wave >> 1, wc = wave & 1, fr = lane & 15, fq = lane >> 4;
#pragma unroll
    for (int i = 0; i < MI; ++i)
#pragma unroll
        for (int j = 0; j < 4; ++j) f(wr * MI * 16 + i * 16 + fr, wc * 64 + j * 16 + fq * 4, acc[i][j]);
}
struct ALPlain {
    const bf16_t* p0; size_t step;
    __device__ __forceinline__ ALPlain(const bf16_t* A, int lda, int row0) { p0 = A + (size_t)(row0 + (tidx() >> 3)) * lda; step = (size_t)32 * lda; }
    __device__ __forceinline__ uint4 load(int i, int k) const { return *(const uint4*)(p0 + i * step + k); }
};
__device__ __forceinline__ void store_bf16x4(bf16_t* dst, const f32x4& v) { *(uint2*)dst = make_uint2(pack2(v[0], v[1]), pack2(v[2], v[3])); }

__device__ __forceinline__ void ph_pre(const Params& p, char* smem) {
    const int tid = tidx(), nb = gridDim.x, bid = blockIdx.x;
    float* mod = (float*)(p.ws + O_MOD);
    {
        float* sv = (float*)smem;
        float* part = sv + 5 * 1024;
        for (int i = tid; i < 5 * 1024; i += 256) { const float v = (i < 4096) ? p.in[I_C][i] : p.in[I_CCTX][i - 4096]; sv[i] = siluf_(v); }
        __syncthreads();
        for (int it = bid; it < NLAYER * 96; it += nb) {
            const int l = it / 96, jb = it % 96;
            const int jj = tid & 63, kq = tid >> 6, j = jb * 64 + jj;
            const float* w = p.in[I_WADA] + (size_t)l * 1024 * 6144 + (size_t)(kq * 256) * 6144 + j;
            float a0 = 0.f, a1 = 0.f, a2 = 0.f, a3 = 0.f, a4 = 0.f;
#pragma unroll 8
            for (int k = 0; k < 256; ++k) {
                const float wv = w[(size_t)k * 6144]; const int kk = kq * 256 + k;
                a0 += sv[kk] * wv; a1 += sv[1024 + kk] * wv; a2 += sv[2048 + kk] * wv; a3 += sv[3072 + kk] * wv; a4 += sv[4096 + kk] * wv;
            }
            part[(kq * 5 + 0) * 64 + jj] = a0; part[(kq * 5 + 1) * 64 + jj] = a1; part[(kq * 5 + 2) * 64 + jj] = a2;
            part[(kq * 5 + 3) * 64 + jj] = a3; part[(kq * 5 + 4) * 64 + jj] = a4;
            __syncthreads();
            for (int o = tid; o < 320; o += 256) {
                const int i = o >> 6, c = o & 63;
                const float s = part[(0 * 5 + i) * 64 + c] + part[(1 * 5 + i) * 64 + c] + part[(2 * 5 + i) * 64 + c] + part[(3 * 5 + i) * 64 + c];
                mod[(size_t)(l * 5 + i) * 6144 + jb * 64 + c] = s + p.in[I_BADA][l * 6144 + jb * 64 + c];
            }
            __syncthreads();
        }
    }
    {
        float4* xc = (float4*)(p.ws + O_XCUR);
        const float4* x4 = (const float4*)p.in[I_X]; const float4* c4 = (const float4*)p.in[I_CTX];
        for (size_t i = (size_t)bid * 256 + tid; i < (size_t)RT * 256; i += (size_t)nb * 256) xc[i] = (i < (size_t)RL * 256) ? x4[i] : c4[i - (size_t)RL * 256];
    }
    {
        float* ct = (float*)smem;
        __syncthreads();
        for (int m = tid; m < 4096; m += 256) ct[m] = cospif((float)m * (1.f / 2048.f));
        __syncthreads();
        bf16_t* cst = (bf16_t*)(p.ws + O_CST);
        for (size_t ch = (size_t)bid * 256 + tid; ch < (size_t)4096 * 8192 / 8; ch += (size_t)nb * 256) {
            const int kt = (int)(ch >> 10), c0 = (int)(ch & 1023) * 8, part = c0 >> 12, t0 = c0 & 4095;
            float f[8];
#pragma unroll
            for (int e = 0; e < 8; ++e) { const int m = (kt * (t0 + e)) & 4095; f[e] = part == 0 ? ct[m] : -ct[(m - 1024) & 4095]; }
            *(uint4*)(cst + ch * 8) = pack8(f);
        }
        bf16_t* cst2 = (bf16_t*)(p.ws + O_CST256);
        for (int ch = bid * 256 + tid; ch < 256 * 512 / 8; ch += nb * 256) {
            const int ks = ch >> 6, c0 = (ch & 63) * 8, part = c0 >> 8, s0 = c0 & 255;
            float f[8];
#pragma unroll
            for (int e = 0; e < 8; ++e) { const int m = (16 * ks * (s0 + e)) & 4095; f[e] = part == 0 ? ct[m] : -ct[(m - 1024) & 4095]; }
            *(uint4*)(cst2 + ch * 8) = pack8(f);
        }
        bf16_t* csc = (bf16_t*)(p.ws + O_CSC);
        for (int ch = bid * 256 + tid; ch < 256 * 128 / 8; ch += nb * 256) {
            const int n = ch >> 4, c0 = (ch & 15) * 8, part = n >> 7, kc = n & 127;
            float f[8];
#pragma unroll
            for (int e = 0; e < 8; ++e) { const int m = (32 * kc * (c0 + e)) & 4095; f[e] = part == 0 ? ct[m] : ct[(m - 1024) & 4095]; }
            *(uint4*)(csc + ch * 8) = pack8(f);
        }
        float* rc = (float*)(p.ws + O_ROPEC); float* rs = (float*)(p.ws + O_ROPES);
        for (int i = bid * 256 + tid; i < SEQ * 16; i += nb * 256) {
            const int t = i >> 4, ax = (i >> 3) & 1, f = i & 7;
            const float inv = powf(10000.f, -(float)f / 8.f);
            const float pos = (float)(ax == 0 ? (t >> 6) : (t & 63));
            const float ang = pos * inv;
            rc[i] = cosf(ang); rs[i] = sinf(ang);
        }
    }
}

struct ConvTask { const float* src; const float* scale; bf16_t* dst; int K, Nsrc, Ndst, rmul; size_t sbs, dbs; };
__constant__ int c_conv_cum[17] = {0, 1536, 1608, 1672, 1688, 1704, 1720, 1848, 1976, 2104, 2360, 4408, 6456, 8504, 8632, 8760, 8888};
__device__ __forceinline__ ConvTask conv_task(const Params& p, int l, int t) {
    bf16_t* wb = (bf16_t*)(p.ws + O_WB);
    ConvTask c; c.scale = nullptr; c.sbs = 0; c.dbs = 0; c.rmul = 64;
    switch (t) {
    case 0:  c.src = p.in[I_WIN] + (size_t)l * 1024 * 6048; c.K = 1024; c.Nsrc = 6048; c.Ndst = 6144; c.dst = wb + W_IN / 2; break;
    case 1:  c.src = p.in[I_WUQ] + (size_t)l * 384 * 768; c.K = 384; c.Nsrc = 768; c.Ndst = 768; c.dst = wb + W_UQ / 2; c.scale = p.in[I_QNG] + l * 384; break;
    case 2:  c.src = p.in[I_WUKV] + (size_t)l * 256 * 1024; c.K = 256; c.Nsrc = 1024; c.Ndst = 1024; c.dst = wb + W_UKV / 2; c.scale = p.in[I_KVNG] + l * 256; break;
    case 3:  c.src = p.in[I_WUP] + (size_t)l * 2 * 64 * 512; c.K = 64; c.Nsrc = 512; c.Ndst = 512; c.dst = wb + W_WUP / 2; c.sbs = 64 * 512; c.dbs = 512 * 64; break;
    case 4:  c.src = p.in[I_AUP] + (size_t)l * 2 * 64 * 512; c.K = 64; c.Nsrc = 512; c.Ndst = 512; c.dst = wb + W_AUP / 2; c.sbs = 64 * 512; c.dbs = 512 * 64; break;
    case 5:  c.src = p.in[I_GUP] + (size_t)l * 128 * 512; c.K = 128; c.Nsrc = 512; c.Ndst = 512; c.dst = wb + W_GUP / 2; break;
    case 6:  c.src = p.in[I_WPA] + (size_t)l * 512 * 1024; c.K = 512; c.Nsrc = 1024; c.Ndst = 1024; c.dst = wb + W_PA / 2; break;
    case 7:  c.src = p.in[I_WPB] + (size_t)l * 512 * 1024; c.K = 512; c.Nsrc = 1024; c.Ndst = 1024; c.dst = wb + W_PB / 2; break;
    case 8:  c.src = p.in[I_WPC] + (size_t)l * 512 * 1024; c.K = 512; c.Nsrc = 1024; c.Ndst = 1024; c.dst = wb + W_PC / 2; break;
    case 9:  c.src = p.in[I_WOUT] + (size_t)l * 1024 * 1024; c.K = 1024; c.Nsrc = 1024; c.Ndst = 1024; c.dst = wb + W_OUT / 2; break;
    case 10: c.src = p.in[I_EG] + (size_t)l * 16 * 1024 * 512; c.K = 1024; c.Nsrc = 512; c.Ndst = 512; c.dst = wb + W_GU / 2; c.sbs = 1024 * 512; c.dbs = 1024 * 1024; c.rmul = 128; break;
    case 11: c.src = p.in[I_EU] + (size_t)l * 16 * 1024 * 512; c.K = 1024; c.Nsrc = 512; c.Ndst = 512; c.dst = wb + W_GU / 2 + 64 * 1024; c.sbs = 1024 * 512; c.dbs = 1024 * 1024; c.rmul = 128; break;
    case 12: c.src = p.in[I_ED] + (size_t)l * 16 * 512 * 1024; c.K = 512; c.Nsrc = 1024; c.Ndst = 1024; c.dst = wb + W_D / 2; c.sbs = 512 * 1024; c.dbs = 1024 * 512; break;
    case 13: c.src = p.in[I_SG] + (size_t)l * 1024 * 512; c.K = 1024; c.Nsrc = 512; c.Ndst = 512; c.dst = wb + W_GU / 2 + (size_t)16 * 1024 * 1024; c.rmul = 128; break;
    case 14: c.src = p.in[I_SU] + (size_t)l * 1024 * 512; c.K = 1024; c.Nsrc = 512; c.Ndst = 512; c.dst = wb + W_GU / 2 + (size_t)16 * 1024 * 1024 + 64 * 1024; c.rmul = 128; break;
    default: c.src = p.in[I_SD] + (size_t)l * 512 * 1024; c.K = 512; c.Nsrc = 1024; c.Ndst = 1024; c.dst = wb + W_D / 2 + (size_t)16 * 1024 * 512; break;
    }
    return c;
}
__device__ __forceinline__ void ph_w(const Params& p, int l, char* smem) {
    const int tid = tidx();
    float* tl = (float*)smem;
    for (int g = blockIdx.x; g < 8888; g += gridDim.x) {
        int t = 0;
        while (g >= c_conv_cum[t + 1]) ++t;
        const ConvTask c = conv_task(p, l, t);
        int r = g - c_conv_cum[t];
        const int nkt = c.K >> 6, nnt = c.Ndst >> 6;
        const int bi = r / (nkt * nnt); r -= bi * nkt * nnt;
        const int k0 = (r / nnt) * 64, n0 = (r % nnt) * 64;
        const float* src = c.src + bi * c.sbs; bf16_t* dst = c.dst + bi * c.dbs;
#pragma unroll
        for (int i = 0; i < 4; ++i) {
            const int k = (tid >> 4) + 16 * i, n = n0 + (tid & 15) * 4;
            float4 v = make_float4(0.f, 0.f, 0.f, 0.f);
            if (n < c.Nsrc) v = *(const float4*)(src + (size_t)(k0 + k) * c.Nsrc + n);
            if (c.scale) { const float s = c.scale[k0 + k]; v.x *= s; v.y *= s; v.z *= s; v.w *= s; }
            float* d = tl + k * 65 + (tid & 15) * 4;
            d[0] = v.x; d[1] = v.y; d[2] = v.z; d[3] = v.w;
        }
        __syncthreads();
        {
            const int n = tid >> 2, kk0 = (tid & 3) * 16;
            float f[8], g2[8];
#pragma unroll
            for (int j = 0; j < 8; ++j) { f[j] = tl[(kk0 + j) * 65 + n]; g2[j] = tl[(kk0 + 8 + j) * 65 + n]; }
            bf16_t* d = dst + (size_t)((n0 >> 6) * c.rmul + n) * c.K + k0 + kk0;
            *(uint4*)d = pack8(f); *(uint4*)(d + 8) = pack8(g2);
        }
        __syncthreads();
    }
}

__device__ __forceinline__ void ph_n1(const Params& p, int l) {
    const int lane = tidx() & 63, wave = tidx() >> 6;
    const float* xcur = (const float*)(p.ws + O_XCUR); const float* mod = (const float*)(p.ws + O_MOD);
    bf16_t* H = (bf16_t*)(p.ws + O_H);
    if (blockIdx.x == 0 && tidx() < 64) ((unsigned*)(p.ws + O_CNT))[tidx()] = 0u;
    const float* g = p.in[I_N1G] + l * 1024;
    for (int row = blockIdx.x * 4 + wave; row < RT; row += gridDim.x * 4) {
        const float* x = xcur + (size_t)row * 1024; const float* md = mod + (size_t)(l * 5 + modidx(row)) * 6144;
        float4 v[4]; float ss = 0.f;
#pragma unroll
        for (int i = 0; i < 4; ++i) { v[i] = *(const float4*)(x + lane * 4 + 256 * i); ss += v[i].x * v[i].x + v[i].y * v[i].y + v[i].z * v[i].z + v[i].w * v[i].w; }
        ss = wsum(ss);
        const float rstd = rsqrtf(ss * (1.f / 1024.f) + 1e-6f);
#pragma unroll
        for (int i = 0; i < 4; ++i) {
            const int c = lane * 4 + 256 * i;
            const float4 gg = *(const float4*)(g + c), sc = *(const float4*)(md + 1024 + c), sh = *(const float4*)(md + c);
            f32x4 h = {v[i].x * rstd * gg.x * (1.f + sc.x) + sh.x, v[i].y * rstd * gg.y * (1.f + sc.y) + sh.y,
                       v[i].z * rstd * gg.z * (1.f + sc.z) + sh.z, v[i].w * rstd * gg.w * (1.f + sc.w) + sh.w};
            store_bf16x4(H + (size_t)row * 1024 + c, h);
        }
    }
}

__device__ __forceinline__ void ph_g1(const Params& p, char* smem) {
    const bf16_t* H = (const bf16_t*)(p.ws + O_H); const bf16_t* W = (const bf16_t*)(p.ws + O_WB + W_IN);
    bf16_t* P = (bf16_t*)(p.ws + O_P);
    for (int it = blockIdx.x; it < 136 * 48; it += gridDim.x) {
        const int mt = it / 48, nt = it % 48;
        f32x4 acc[4][4];
        RPPlain rp{H + (size_t)mt * 128 * 1024, 1024};
        gemm_core_g<4>(rp, W + (size_t)nt * 128 * 1024, 1024, 1024, acc, smem);
        acc_foreach<4>(acc, [&](int m, int n, const f32x4& v) {
            const int col = nt * 128 + n; f32x4 o = v;
            if (col >= PG0 && col < PEND) { o[0] = sigmoidf_(v[0]); o[1] = sigmoidf_(v[1]); o[2] = sigmoidf_(v[2]); o[3] = sigmoidf_(v[3]); }
            store_bf16x4(P + (size_t)(mt * 128 + m) * LDP + col, o);
        });
    }
}

__device__ __forceinline__ void ph_qu(const Params& p, char* smem) {
    const bf16_t* P = (const bf16_t*)(p.ws + O_P);
    bf16_t* QR = (bf16_t*)(p.ws + O_X + X_QRAW); bf16_t* KVR = (bf16_t*)(p.ws + O_X + X_KVRAW);
    for (int it = blockIdx.x; it < 136 * 14; it += gridDim.x) {
        const int mt = it / 14, nn = it % 14;
        f32x4 acc[4][4];
        if (nn < 6) {
            RPPlain rp{P + (size_t)mt * 128 * LDP + PQ0, LDP};
            gemm_core_g<4>(rp, (const bf16_t*)(p.ws + O_WB + W_UQ) + (size_t)nn * 128 * 384, 384, 384, acc, smem);
            acc_foreach<4>(acc, [&](int m, int n, const f32x4& v) { store_bf16x4(QR + (size_t)(mt * 128 + m) * 768 + nn * 128 + n, v); });
        } else {
            const int nt = nn - 6;
            RPPlain rp{P + (size_t)mt * 128 * LDP + PKV0, LDP};
            gemm_core_g<4>(rp, (const bf16_t*)(p.ws + O_WB + W_UKV) + (size_t)nt * 128 * 256, 256, 256, acc, smem);
            acc_foreach<4>(acc, [&](int m, int n, const f32x4& v) { store_bf16x4(KVR + (size_t)(mt * 128 + m) * 1024 + nt * 128 + n, v); });
        }
    }
}

constexpr float QSCALE = 0.10206207261596575f * 1.4426950408889634f;
__device__ __forceinline__ void ph_m2(const Params& p, char* smem) {
    const int tid = tidx(), lane = tid & 63, wave = tid >> 6;
    const bf16_t* P = (const bf16_t*)(p.ws + O_P);
    const bf16_t* QR = (const bf16_t*)(p.ws + O_X + X_QRAW); const bf16_t* KVR = (const bf16_t*)(p.ws + O_X + X_KVRAW);
    bf16_t* QA = (bf16_t*)(p.ws + O_X + X_QA); bf16_t* KA = (bf16_t*)(p.ws + O_X + X_KA); bf16_t* VA = (bf16_t*)(p.ws + O_X + X_VA);
    const float* rc = (const float*)(p.ws + O_ROPEC); const float* rs = (const float*)(p.ws + O_ROPES);
    for (int row = blockIdx.x * 4 + wave; row < RT; row += gridDim.x * 4) {
        const bool lat = row < RL;
        const int b = lat ? (row >> 12) : ((row - RL) >> 8), t = lat ? (row & 4095) : ((row - RL) & 255);
        const size_t keyrow = (size_t)b * KEYS + (lat ? t : SEQ + t);
        const bf16_t* pr = P + (size_t)row * LDP;
        float sq = 0.f, sk = 0.f;
#pragma unroll
        for (int i = 0; i < 6; ++i) { const float v = bf2f(pr[PQ0 + lane + 64 * i]); sq += v * v; }
#pragma unroll
        for (int i = 0; i < 4; ++i) { const float v = bf2f(pr[PKV0 + lane + 64 * i]); sk += v * v; }
        sq = wsum(sq); sk = wsum(sk);
        const float rq = rsqrtf(sq * (1.f / 384.f) + 1e-6f), rkv = rsqrtf(sk * (1.f / 256.f) + 1e-6f);
        const bf16_t* qr = QR + (size_t)row * 768; const bf16_t* kvr = KVR + (size_t)row * 1024;
        const float* rct = rc + t * 16; const float* rst = rs + t * 16;
#pragma unroll
        for (int i = 0; i < 12; ++i) {
            const int e = lane + 64 * i, h = e / 96, dd = e - h * 96;
            float xq = bf2f(qr[e]) * rq, xk;
            if (dd < 64) xk = bf2f(kvr[h * 128 + dd]) * rkv;
            else {
                const int ii = dd - 64;
                xk = bf2f(pr[PKR0 + ii]);
                if (lat) {
                    const int ax = ii >> 4, half = (ii >> 3) & 1, f = ii & 7;
                    const float c = rct[ax * 8 + f], sn = rst[ax * 8 + f];
                    const float xqp = bf2f(qr[half ? e - 8 : e + 8]) * rq, xkp = bf2f(pr[PKR0 + (ii ^ 8)]);
                    xq = half ? (xq * c + xqp * sn) : (xq * c - xqp * sn);
                    xk = half ? (xk * c + xkp * sn) : (xk * c - xkp * sn);
                }
            }
            QA[(size_t)row * 768 + e] = f2bf(xq * QSCALE);
            KA[keyrow * 768 + e] = f2bf(xk);
        }
    }
    bf16_t* vt = (bf16_t*)smem;
    float* rk = (float*)(smem + 64 * 72 * 2);
    for (int it = blockIdx.x; it < (RT / 64) * 8; it += gridDim.x) {
        const int g = it >> 3, h = it & 7, rowg = g * 64;
        const bool lat = rowg < RL;
        const int b = lat ? (rowg >> 12) : ((rowg - RL) >> 8), t0 = lat ? (rowg & 4095) : ((rowg - RL) & 255);
        const size_t key0 = lat ? t0 : SEQ + t0;
#pragma unroll 4
        for (int rr = 0; rr < 16; ++rr) {
            const int lr = wave * 16 + rr;
            const bf16_t* pr = P + (size_t)(rowg + lr) * LDP + PKV0;
            const uint2 u = *(const uint2*)(pr + lane * 4);
            float sk = bflo(u.x) * bflo(u.x) + bfhi(u.x) * bfhi(u.x) + bflo(u.y) * bflo(u.y) + bfhi(u.y) * bfhi(u.y);
            sk = wsum(sk);
            if (lane == 0) rk[lr] = rsqrtf(sk * (1.f / 256.f) + 1e-6f);
        }
        __syncthreads();
#pragma unroll
        for (int i = 0; i < 2; ++i) {
            const int c = tid + 256 * i, lr = c >> 3, part = c & 7;
            float f[8]; unpack8(*(const uint4*)(KVR + (size_t)(rowg + lr) * 1024 + h * 128 + 64 + part * 8), f);
            const float sc = rk[lr];
#pragma unroll
            for (int e = 0; e < 8; ++e) f[e] *= sc;
            *(uint4*)(vt + lr * 72 + part * 8) = pack8(f);
        }
        __syncthreads();
#pragma unroll
        for (int i = 0; i < 2; ++i) {
            const int c = tid + 256 * i, dd = c >> 3, kc = c & 7;
            float f[8];
#pragma unroll
            for (int e = 0; e < 8; ++e) f[e] = bf2f(vt[(kc * 8 + e) * 72 + dd]);
            *(uint4*)(VA + ((size_t)(b * 8 + h) * 64 + dd) * KEYS + key0 + kc * 8) = pack8(f);
        }
        __syncthreads();
    }
}
__device__ __forceinline__ float xmax_16_32(float v) {
    unsigned u = __builtin_bit_cast(unsigned, v);
    auto r = __builtin_amdgcn_permlane32_swap(u, u, false, false);
    float m = fmaxf(__builtin_bit_cast(float, r[0]), __builtin_bit_cast(float, r[1]));
    u = __builtin_bit_cast(unsigned, m);
    auto r2 = __builtin_amdgcn_permlane16_swap(u, u, false, false);
    return fmaxf(__builtin_bit_cast(float, r2[0]), __builtin_bit_cast(float, r2[1]));
}
__device__ __forceinline__ float xsum_16_32(float v) {
    unsigned u = __builtin_bit_cast(unsigned, v);
    auto r = __builtin_amdgcn_permlane32_swap(u, u, false, false);
    float m = __builtin_bit_cast(float, r[0]) + __builtin_bit_cast(float, r[1]);
    u = __builtin_bit_cast(unsigned, m);
    auto r2 = __builtin_amdgcn_permlane16_swap(u, u, false, false);
    return __builtin_bit_cast(float, r2[0]) + __builtin_bit_cast(float, r2[1]);
}
constexpr int KS_LD = 104, VT_LD = 72;
constexpr int AT_BUF = 64 * KS_LD * 2 + 64 * VT_LD * 2;
__device__ __forceinline__ void ph_at(const Params& p, int l, char* smem) {
    const int tid = tidx(), lane = tid & 63, wave = tid >> 6, fr = lane & 15, fq = lane >> 4;
    const bf16_t* QA = (const bf16_t*)(p.ws + O_X + X_QA); const bf16_t* KA = (const bf16_t*)(p.ws + O_X + X_KA); const bf16_t* VA = (const bf16_t*)(p.ws + O_X + X_VA);
    bf16_t* ATT = (bf16_t*)(p.ws + O_ATT);
    const int nitems = 1024 + (l < NLAYER - 1 ? 64 : 0);
    for (int it0 = blockIdx.x; it0 < nitems; it0 += gridDim.x) {
        int it = it0;
        if (gridDim.x == 512 && it0 < 1024) {
            const int x = it0 & 7, j = (it0 >> 3) & 63, rd = it0 >> 9;
            it = ((x * 4 + rd * 2 + (j >> 5)) << 5) | (j & 31);
        }
        int b, h, row0, ntile; size_t krow0;
        if (it < 1024) { b = it >> 8; h = (it >> 5) & 7; row0 = b * SEQ + (it & 31) * 128; krow0 = (size_t)b * KEYS; ntile = KEYS / 64; }
        else { const int j = it - 1024; b = j >> 4; h = (j >> 1) & 7; row0 = RL + b * CTX + (j & 1) * 128; krow0 = (size_t)b * KEYS + SEQ; ntile = CTX / 64; }
        const int qrow = row0 + wave * 32 + fr;
        const size_t vrow0 = (size_t)(b * 8 + h) * 64; const int koff0 = (int)(krow0 - (size_t)b * KEYS);
        bf16x8 qf[2][3];
#pragma unroll
        for (int t = 0; t < 2; ++t)
#pragma unroll
            for (int ks = 0; ks < 3; ++ks) qf[t][ks] = *(const bf16x8*)(QA + (size_t)(qrow + 16 * t) * 768 + h * 96 + ks * 32 + fq * 8);
        f32x4 ot[2][4];
#pragma unroll
        for (int t = 0; t < 2; ++t)
#pragma unroll
            for (int i = 0; i < 4; ++i) ot[t][i] = (f32x4){0.f, 0.f, 0.f, 0.f};
        float m_run[2] = {-1e30f, -1e30f}, l_run[2] = {0.f, 0.f};
        uint4 rk0, rk1, rk2, rv0, rv1;
#define AT_GLOAD(KT) do { const size_t kr_ = krow0 + (size_t)(KT) * 64; \
            { const int c = tid, key = c / 12, part = c % 12; rk0 = *(const uint4*)(KA + (kr_ + key) * 768 + h * 96 + part * 8); } \
            { const int c = tid + 256, key = c / 12, part = c % 12; rk1 = *(const uint4*)(KA + (kr_ + key) * 768 + h * 96 + part * 8); } \
            { const int c = tid + 512, key = c / 12, part = c % 12; rk2 = *(const uint4*)(KA + (kr_ + key) * 768 + h * 96 + part * 8); } \
            { const int c = tid, dd_ = c >> 3, part = c & 7; rv0 = *(const uint4*)(VA + (vrow0 + dd_) * KEYS + koff0 + (KT) * 64 + part * 8); } \
            { const int c = tid + 256, dd_ = c >> 3, part = c & 7; rv1 = *(const uint4*)(VA + (vrow0 + dd_) * KEYS + koff0 + (KT) * 64 + part * 8); } } while (0)
#define AT_VSTORE(RV, C) do { const int dd_ = (C) >> 3, part = (C) & 7; *(uint4*)(Vt_ + dd_ * VT_LD + part * 8) = RV; } while (0)
#define AT_SSTORE(BUF) do { bf16_t* Ks_ = (bf16_t*)(smem + (BUF) * AT_BUF); bf16_t* Vt_ = Ks_ + 64 * KS_LD; \
            { const int c = tid, key = c / 12, part = c % 12; *(uint4*)(Ks_ + key * KS_LD + part * 8) = rk0; } \
            { const int c = tid + 256, key = c / 12, part = c % 12; *(uint4*)(Ks_ + key * KS_LD + part * 8) = rk1; } \
            { const int c = tid + 512, key = c / 12, part = c % 12; *(uint4*)(Ks_ + key * KS_LD + part * 8) = rk2; } \
            AT_VSTORE(rv0, tid); AT_VSTORE(rv1, tid + 256); } while (0)
        AT_GLOAD(0); AT_SSTORE(0);
        __syncthreads();
        for (int kt = 0; kt < ntile; ++kt) {
            const int cur = kt & 1;
            if (kt + 1 < ntile) AT_GLOAD(kt + 1);
            const bf16_t* Ks = (const bf16_t*)(smem + cur * AT_BUF); const bf16_t* Vt = Ks + 64 * KS_LD;
            bf16x8 kf[4][3];
#pragma unroll
            for (int j = 0; j < 4; ++j)
#pragma unroll
                for (int ks = 0; ks < 3; ++ks) kf[j][ks] = *(const bf16x8*)(Ks + (j * 16 + fr) * KS_LD + ks * 32 + fq * 8);
            f32x4 st[2][4];
#pragma unroll
            for (int j = 0; j < 4; ++j) {
                st[0][j] = (f32x4){0.f, 0.f, 0.f, 0.f}; st[1][j] = (f32x4){0.f, 0.f, 0.f, 0.f};
#pragma unroll
                for (int ks = 0; ks < 3; ++ks) {
                    st[0][j] = __builtin_amdgcn_mfma_f32_16x16x32_bf16(kf[j][ks], qf[0][ks], st[0][j], 0, 0, 0);
                    st[1][j] = __builtin_amdgcn_mfma_f32_16x16x32_bf16(kf[j][ks], qf[1][ks], st[1][j], 0, 0, 0);
                }
            }
            bf16x8 vf[2][4];
#pragma unroll
            for (int k2 = 0; k2 < 2; ++k2)
#pragma unroll
                for (int dt = 0; dt < 4; ++dt) {
                    const bf16_t* vp = Vt + (dt * 16 + fr) * VT_LD + k2 * 32 + fq * 4;
                    const uint2 v0 = *(const uint2*)vp, v1 = *(const uint2*)(vp + 16);
                    vf[k2][dt] = __builtin_bit_cast(bf16x8, make_uint4(v0.x, v0.y, v1.x, v1.y));
                }
            uint4 pu[2][2];
#pragma unroll
            for (int t = 0; t < 2; ++t) {
                float mx = st[t][0][0];
#pragma unroll
                for (int j = 0; j < 4; ++j)
#pragma unroll
                    for (int r = 0; r < 4; ++r) mx = fmaxf(mx, st[t][j][r]);
                if (__any(mx > m_run[t] + 6.f)) {
                    mx = xmax_16_32(mx);
                    const float m_new = fmaxf(m_run[t], mx);
                    const float alpha = __builtin_amdgcn_exp2f(m_run[t] - m_new);
                    m_run[t] = m_new;
                    l_run[t] *= alpha;
#pragma unroll
                    for (int i = 0; i < 4; ++i) ot[t][i] *= alpha;
                }
                const float mr = m_run[t];
                float ps = 0.f;
#pragma unroll
                for (int j = 0; j < 4; ++j)
#pragma unroll
                    for (int r = 0; r < 4; ++r) { st[t][j][r] = __builtin_amdgcn_exp2f(st[t][j][r] - mr); ps += st[t][j][r]; }
                l_run[t] += ps;
#pragma unroll
                for (int k2 = 0; k2 < 2; ++k2)
                    pu[t][k2] = make_uint4(pack2(st[t][2 * k2][0], st[t][2 * k2][1]), pack2(st[t][2 * k2][2], st[t][2 * k2][3]),
                                           pack2(st[t][2 * k2 + 1][0], st[t][2 * k2 + 1][1]), pack2(st[t][2 * k2 + 1][2], st[t][2 * k2 + 1][3]));
            }
#pragma unroll
            for (int k2 = 0; k2 < 2; ++k2) {
                const bf16x8 pb0 = __builtin_bit_cast(bf16x8, pu[0][k2]), pb1 = __builtin_bit_cast(bf16x8, pu[1][k2]);
#pragma unroll
                for (int dt = 0; dt < 4; ++dt) {
                    ot[0][dt] = __builtin_amdgcn_mfma_f32_16x16x32_bf16(vf[k2][dt], pb0, ot[0][dt], 0, 0, 0);
                    ot[1][dt] = __builtin_amdgcn_mfma_f32_16x16x32_bf16(vf[k2][dt], pb1, ot[1][dt], 0, 0, 0);
                }
            }
            if (kt + 1 < ntile) AT_SSTORE(cur ^ 1);
            __syncthreads();
        }
#pragma unroll
        for (int t = 0; t < 2; ++t) {
            const float inv = 1.f / xsum_16_32(l_run[t]);
#pragma unroll
            for (int dt = 0; dt < 4; ++dt) { f32x4 o = ot[t][dt] * inv; store_bf16x4(ATT + (size_t)(qrow + 16 * t) * 512 + h * 64 + dt * 16 + fq * 4, o); }
        }
    }
}

__device__ __forceinline__ void row_edges(int row, bool& first, bool& last) {
    if (row < RL) { const int t = row & 4095; first = t == 0; last = t == 4095; }
    else { const int s = (row - RL) & 255; first = s == 0; last = s == 255; }
}
__device__ __forceinline__ float xs1(const bf16_t* P, const float* mu, int row, int col) {
    bool first, last; row_edges(row, first, last);
    const bf16_t* pc = P + (size_t)row * LDP + PR0 + col;
    const float c = bf2f(*pc), pv0 = bf2f(*(first ? pc : pc - LDP)), nx0 = bf2f(*(last ? pc : pc + LDP));
    const float pv = first ? 0.f : pv0, nx = last ? 0.f : nx0;
    return c + (0.5f * (pv + nx) - c) * mu[col];
}
__device__ __forceinline__ void xs8(const bf16_t* P, const float* mu, int row, int col, float (&o)[8]) {
    bool first, last; row_edges(row, first, last);
    const bf16_t* pc = P + (size_t)row * LDP + PR0 + col;
    const uint4 uc = *(const uint4*)pc, up = *(const uint4*)(first ? pc : pc - LDP), un = *(const uint4*)(last ? pc : pc + LDP);
    float c[8], pv[8], nx[8]; unpack8(uc, c); unpack8(up, pv); unpack8(un, nx);
    const float fp = first ? 0.f : 0.5f, fn = last ? 0.f : 0.5f;
    const float4 m0 = *(const float4*)(mu + col), m1 = *(const float4*)(mu + col + 4);
    const float m[8] = {m0.x, m0.y, m0.z, m0.w, m1.x, m1.y, m1.z, m1.w};
#pragma unroll
    for (int j = 0; j < 8; ++j) o[j] = c[j] + ((fp * pv[j] + fn * nx[j]) - c[j]) * m[j];
}
struct ALRw {
    const bf16_t* P; const float* mu; int row0; int colbase, mode;
    __device__ __forceinline__ ALRw(const bf16_t* P_, const float* mu_, int row0_, int colbase_, int mode_) : P(P_), mu(mu_), colbase(colbase_), mode(mode_) {
        row0 = row0_ + (tidx() >> 3);
    }
    __device__ __forceinline__ uint4 load(int i, int k) const {
        float o[8]; xs8(P, mu, row0 + 32 * i, colbase + k, o);
        if (mode == 0) {
#pragma unroll
            for (int j = 0; j < 8; ++j) o[j] = tanhf(o[j]);
        } else if (mode == 2) {
#pragma unroll
            for (int j = 0; j < 8; ++j) o[j] = sigmoidf_(o[j]);
        }
        return pack8(o);
    }
};
__device__ __forceinline__ void ph_rp1(const Params& p, int l, char* smem) {
    const bf16_t* P = (const bf16_t*)(p.ws + O_P); const float* mu = p.in[I_MU] + l * 1792;
    bf16_t* RG = (bf16_t*)(p.ws + O_RG);
    for (int it = blockIdx.x; it < 544; it += gridDim.x) {
        const int mt = it >> 2, nt = it & 3;
        f32x4 acc[4][4];
        ALRw al(P, mu, mt * 128, 1664, 2);
        gemm_core<4>(al, (const bf16_t*)(p.ws + O_WB + W_GUP) + (size_t)nt * 128 * 128, 128, 128, acc, smem);
        acc_foreach<4>(acc, [&](int m, int n, const f32x4& v) { store_bf16x4(RG + (size_t)(mt * 128 + m) * 512 + nt * 128 + n, v); });
    }
}
__device__ __forceinline__ void ph_rp2(const Params& p, int l) {
    const int lane = tidx() & 63, wave = tidx() >> 6;
    const bf16_t* P = (const bf16_t*)(p.ws + O_P); const float* mu = p.in[I_MU] + l * 1792; const float* kkw = p.in[I_KK] + l * 512;
    float* KKN = (float*)(p.ws + O_X + X_KKN);
    for (int row = blockIdx.x * 4 + wave; row < RT; row += gridDim.x * 4) {
        float k8[8]; xs8(P, mu, row, 512 + lane * 8, k8);
        float s = 0.f;
#pragma unroll
        for (int j = 0; j < 8; ++j) { const float v = k8[j] * kkw[lane * 8 + j]; s += v * v; }
        s += __shfl_xor(s, 1); s += __shfl_xor(s, 2); s += __shfl_xor(s, 4);
        if ((lane & 7) == 0) KKN[(size_t)row * 8 + (lane >> 3)] = rsqrtf(s + 1e-12f);
    }
}

__device__ __forceinline__ int scan_row(int b, int d, int n) {
    if (n < CTX) return RL + b * CTX + (d == 0 ? n : CTX - 1 - n);
    const int t = n - CTX; return b * SEQ + (d == 0 ? t : SEQ - 1 - t);
}
constexpr int SL = 72;
constexpr int SLOT_E = 64 * SL;
template <int LDA, int LDB>
__device__ __forceinline__ void mm64(const bf16_t* A, const bf16_t* B, f32x4 (&acc)[4], int wave, int fr, int fq) {
#pragma unroll
    for (int ks = 0; ks < 2; ++ks) {
        const bf16x8 af = *(const bf16x8*)(A + (wave * 16 + fr) * LDA + ks * 32 + fq * 8);
#pragma unroll
        for (int nt = 0; nt < 4; ++nt) {
            const bf16x8 bfv = *(const bf16x8*)(B + (nt * 16 + fr) * LDB + ks * 32 + fq * 8);
            acc[nt] = __builtin_amdgcn_mfma_f32_16x16x32_bf16(bfv, af, acc[nt], 0, 0, 0);
        }
    }
}
__device__ __forceinline__ void acc_zero(f32x4 (&acc)[4]) {
#pragma unroll
    for (int nt = 0; nt < 4; ++nt) acc[nt] = (f32x4){0.f, 0.f, 0.f, 0.f};
}
template <bool STRICT>
__device__ __forceinline__ void acc_mask(f32x4 (&acc)[4], int m, int fq) {
#pragma unroll
    for (int nt = 0; nt < 4; ++nt)
#pragma unroll
        for (int r = 0; r < 4; ++r) { const int n = nt * 16 + fq * 4 + r; const bool keep = STRICT ? (m < n) : (m <= n); if (!keep) acc[nt][r] = 0.f; }
}
__device__ __forceinline__ void st_rm(bf16_t* dst, const f32x4 (&acc)[4], int m, int fq) {
#pragma unroll
    for (int nt = 0; nt < 4; ++nt) store_bf16x4(dst + m * SL + nt * 16 + fq * 4, acc[nt]);
}
__device__ __forceinline__ void st_tr(bf16_t* dst, const f32x4 (&acc)[4], int m, int fq) {
#pragma unroll
    for (int nt = 0; nt < 4; ++nt)
#pragma unroll
        for (int r = 0; r < 4; ++r) dst[(nt * 16 + fq * 4 + r) * SL + m] = f2bf(acc[nt][r]);
}
__device__ __forceinline__ void ph_r1(const Params& p, int l, char* smem) {
    const int tid0 = tidx();
#define R1_IDX const int tid = lv(tid0), lane = tid & 63, wave = tid >> 6, fr = lane & 15, fq = lane >> 4, bi = tid >> 2, bq = (tid & 3) * 16, m = wave * 16 + fr; (void)bi; (void)bq; (void)m; (void)fq;
    const bf16_t* P = (const bf16_t*)(p.ws + O_P); const float* mu = p.in[I_MU] + l * 1792;
    const float* kkw = p.in[I_KK] + l * 512; const float* kaw = p.in[I_KA] + l * 512; const float* rkw = p.in[I_RK] + l * 512;
    const float* KKN = (const float*)(p.ws + O_X + X_KKN); float* BON = (float*)(p.ws + O_X + X_BON);
    bf16_t* gMT = (bf16_t*)(p.ws + O_X + X_MT); bf16_t* gNL = (bf16_t*)(p.ws + O_X + X_NL);
    bf16_t* gGT = (bf16_t*)(p.ws + O_X + X_GT); bf16_t* gYL = (bf16_t*)(p.ws + O_X + X_YL);
    bf16_t* slot = (bf16_t*)smem;
    bf16_t* s0 = slot, *s1 = slot + SLOT_E, *s2 = slot + 2 * SLOT_E, *s3 = slot + 3 * SLOT_E;
    bf16_t* sa = slot + 4 * SLOT_E, *sb = slot + 5 * SLOT_E, *sc = slot + 6 * SLOT_E, *sT = slot + 7 * SLOT_E;
    float* misc = (float*)(smem + 8 * SLOT_E * 2);
    float* GAM = misc; float* SEG = misc + 64;
    float* ASIG = (float*)s0;
    float* LWS = (float*)s2;
    for (int it = blockIdx.x; it < NCP; it += gridDim.x) {
        const int c = it % 68, d = (it / 68) & 1, h = (it / 136) & 7, b = it / 1088;
        {
            R1_IDX const int rowb = scan_row(b, d, c * 64 + bi); (void)rowb;
            float o[8];
#pragma unroll
            for (int hh = 0; hh < 2; ++hh) {
                xs8(P, mu, rowb, 1536 + bq + hh * 8, o);
#pragma unroll
                for (int j = 0; j < 8; ++j) o[j] = 1.f - 2.f * __builtin_amdgcn_rcpf(1.f + __expf(2.f * o[j]));
                *(uint4*)(sa + bi * SL + bq + hh * 8) = pack8(o);
                xs8(P, mu, rowb, 1600 + bq + hh * 8, o);
                *(uint4*)(sb + bi * SL + bq + hh * 8) = pack8(o);
            }
        }
        __syncthreads();
        {
            R1_IDX const int rowb = scan_row(b, d, c * 64 + bi); (void)rowb;
            f32x4 acc[4];
            acc_zero(acc);
            mm64<SL, 64>(sa, (const bf16_t*)(p.ws + O_WB + W_WUP) + ((size_t)d * 512 + h * 64) * 64, acc, wave, fr, fq);
            const float* w0 = p.in[I_W0] + (l * 2 + d) * 512 + h * 64;
#pragma unroll
            for (int nt = 0; nt < 4; ++nt) {
                const int n = nt * 16 + fq * 4; float4 o; float* op = (float*)&o;
#pragma unroll
                for (int r = 0; r < 4; ++r) { const float z = w0[n + r] + acc[nt][r]; op[r] = -0.6065306597126334f * __builtin_amdgcn_rcpf(1.f + __expf(-z)); }
                *(float4*)(LWS + m * 68 + n) = o;
            }
            acc_zero(acc);
            mm64<SL, 64>(sb, (const bf16_t*)(p.ws + O_WB + W_AUP) + ((size_t)d * 512 + h * 64) * 64, acc, wave, fr, fq);
            const float* a0 = p.in[I_A0] + (l * 2 + d) * 512 + h * 64;
#pragma unroll
            for (int nt = 0; nt < 4; ++nt) {
                const int n = nt * 16 + fq * 4;
                *(float4*)(ASIG + m * 68 + n) = make_float4(__builtin_amdgcn_rcpf(1.f + __expf(-(a0[n] + acc[nt][0]))), __builtin_amdgcn_rcpf(1.f + __expf(-(a0[n + 1] + acc[nt][1]))), __builtin_amdgcn_rcpf(1.f + __expf(-(a0[n + 2] + acc[nt][2]))), __builtin_amdgcn_rcpf(1.f + __expf(-(a0[n + 3] + acc[nt][3]))));
            }
        }
        __syncthreads();
        {
            R1_IDX const int rowb = scan_row(b, d, c * 64 + bi); (void)rowb;
            const int k = tid & 63, seg = tid >> 6;
            float run = 0.f;
#pragma unroll
            for (int ii = 0; ii < 16; ++ii) { run += LWS[(seg * 16 + ii) * 68 + k]; LWS[(seg * 16 + ii) * 68 + k] = run; }
            SEG[seg * 64 + k] = run;
            __syncthreads();
            float off = 0.f;
#pragma unroll
            for (int sgi = 0; sgi < 3; ++sgi) if (sgi < seg) off += SEG[sgi * 64 + k];
#pragma unroll
            for (int ii = 0; ii < 16; ++ii) LWS[(seg * 16 + ii) * 68 + k] += off;
        }
        __syncthreads();
        {
            R1_IDX const int rowb = scan_row(b, d, c * 64 + bi); (void)rowb;
            float cs[16], cm[16], cc[16], ag[16];
#pragma unroll
            for (int q = 0; q < 4; ++q) {
                const float4 v0 = *(const float4*)(LWS + bi * 68 + bq + q * 4);
                const float4 v1 = bi > 0 ? *(const float4*)(LWS + (bi - 1) * 68 + bq + q * 4) : make_float4(0.f, 0.f, 0.f, 0.f);
                const float4 v2 = *(const float4*)(LWS + 63 * 68 + bq + q * 4);
                const float4 v3 = *(const float4*)(ASIG + bi * 68 + bq + q * 4);
                cs[q * 4] = v0.x; cs[q * 4 + 1] = v0.y; cs[q * 4 + 2] = v0.z; cs[q * 4 + 3] = v0.w;
                cm[q * 4] = v1.x; cm[q * 4 + 1] = v1.y; cm[q * 4 + 2] = v1.z; cm[q * 4 + 3] = v1.w;
                cc[q * 4] = v2.x; cc[q * 4 + 1] = v2.y; cc[q * 4 + 2] = v2.z; cc[q * 4 + 3] = v2.w;
                ag[q * 4] = v3.x; ag[q * 4 + 1] = v3.y; ag[q * 4 + 2] = v3.z; ag[q * 4 + 3] = v3.w;
            }
            __syncthreads();
            const float kkn = KKN[(size_t)rowb * 8 + h];
            float bon = 0.f;
#pragma unroll
            for (int hh = 0; hh < 2; ++hh) {
                float r8[8], k8[8], oa[8], ob[8], ok[8], orr[8];
                const int col = h * 64 + bq + hh * 8;
                xs8(P, mu, rowb, col, r8); xs8(P, mu, rowb, 512 + col, k8);
#pragma unroll
                for (int j = 0; j < 8; ++j) {
                    const int e = hh * 8 + j;
                    const float kk = k8[j] * kkw[col + j] * kkn;
                    const float kd = k8[j] * (1.f + (ag[e] - 1.f) * kaw[col + j]);
                    const float eneg = __expf(-cs[e]);
                    oa[j] = -kk * __expf(cm[e]); ob[j] = kk * ag[e] * eneg; ok[j] = kd * eneg; orr[j] = r8[j] * __builtin_amdgcn_rcpf(eneg);
                    bon += r8[j] * kd * rkw[col + j];
                }
                *(uint4*)(s0 + bi * SL + bq + hh * 8) = pack8(oa); *(uint4*)(s1 + bi * SL + bq + hh * 8) = pack8(ob);
                *(uint4*)(s2 + bi * SL + bq + hh * 8) = pack8(ok); *(uint4*)(s3 + bi * SL + bq + hh * 8) = pack8(orr);
            }
            bon += __shfl_xor(bon, 1); bon += __shfl_xor(bon, 2);
            if ((tid & 3) == 0) BON[((size_t)d * RT + rowb) * 8 + h] = bon;
            if (bi == 0) {
#pragma unroll
                for (int e = 0; e < 16; ++e) GAM[bq + e] = __expf(cc[e]);
            }
        }
        __syncthreads();
        {
            R1_IDX const int rowb = scan_row(b, d, c * 64 + bi); (void)rowb;
            f32x4 acc[4]; acc_zero(acc);
            mm64<SL, SL>(s1, s0, acc, wave, fr, fq);
            acc_mask<true>(acc, m, fq);
            st_rm(sa, acc, m, fq); st_tr(sb, acc, m, fq);
#pragma unroll
            for (int nt = 0; nt < 4; ++nt)
#pragma unroll
                for (int r = 0; r < 4; ++r) if (nt * 16 + fq * 4 + r == m) acc[nt][r] += 1.f;
            st_rm(sc, acc, m, fq);
        }
        __syncthreads();
#pragma unroll
        for (int itr = 0; itr < 5; ++itr) {
            R1_IDX
            bf16_t* ptr = (itr & 1) ? sT : sb;
            bf16_t* ptw = (itr & 1) ? sb : sT;
            f32x4 acc[4]; acc_zero(acc);
            mm64<SL, SL>(sa, ptr, acc, wave, fr, fq);
            st_rm(sa, acc, m, fq); st_tr(ptw, acc, m, fq);
            __syncthreads();
            f32x4 tacc[4];
#pragma unroll
            for (int nt = 0; nt < 4; ++nt) { const uint2 u = *(const uint2*)(sc + m * SL + nt * 16 + fq * 4); tacc[nt] = (f32x4){bflo(u.x), bfhi(u.x), bflo(u.y), bfhi(u.y)}; }
            mm64<SL, SL>(sc, ptw, tacc, wave, fr, fq);
            if (itr < 4) st_rm(sc, tacc, m, fq); else st_tr(sb, tacc, m, fq);
        }
        __syncthreads();
        {
            R1_IDX const int rowb = scan_row(b, d, c * 64 + bi); (void)rowb;
            f32x4 acc[4]; acc_zero(acc);
            mm64<SL, SL>(s2, s0, acc, wave, fr, fq);
            acc_mask<true>(acc, m, fq);
            st_rm(sa, acc, m, fq);
            float f0[8], f1[8];
            unpack8(*(const uint4*)(s0 + bi * SL + bq), f0); unpack8(*(const uint4*)(s0 + bi * SL + bq + 8), f1);
#pragma unroll
            for (int e = 0; e < 8; ++e) { sc[(bq + e) * SL + bi] = f2bf(f0[e]); sc[(bq + 8 + e) * SL + bi] = f2bf(f1[e]); }
        }
        __syncthreads();
        {
            R1_IDX const int rowb = scan_row(b, d, c * 64 + bi); (void)rowb;
            f32x4 acc[4]; acc_zero(acc);
            mm64<SL, SL>(sc, sb, acc, wave, fr, fq);
            st_rm(sT, acc, m, fq);
            acc_zero(acc);
            mm64<SL, SL>(sa, sb, acc, wave, fr, fq);
            st_rm(s0, acc, m, fq);
        }
        __syncthreads();
        f32x4 qacc[4];
        {
            R1_IDX const int rowb = scan_row(b, d, c * 64 + bi); (void)rowb;
            f32x4 acc[4]; acc_zero(acc);
            mm64<SL, SL>(s1, s3, acc, wave, fr, fq);
            acc_mask<false>(acc, m, fq);
            st_tr(sa, acc, m, fq);
            acc_zero(qacc);
            mm64<SL, SL>(s2, s3, qacc, wave, fr, fq);
            acc_mask<false>(qacc, m, fq);
            float f0[8], f1[8];
            unpack8(*(const uint4*)(s3 + bi * SL + bq), f0); unpack8(*(const uint4*)(s3 + bi * SL + bq + 8), f1);
#pragma unroll
            for (int e = 0; e < 8; ++e) { sc[(bq + e) * SL + bi] = f2bf(f0[e]); sc[(bq + 8 + e) * SL + bi] = f2bf(f1[e]); }
        }
        __syncthreads();
        {
            R1_IDX const int rowb = scan_row(b, d, c * 64 + bi); (void)rowb;
            f32x4 acc[4];
#pragma unroll
            for (int nt = 0; nt < 4; ++nt) { const uint2 u = *(const uint2*)(sc + m * SL + nt * 16 + fq * 4); acc[nt] = (f32x4){bflo(u.x), bfhi(u.x), bflo(u.y), bfhi(u.y)}; }
            mm64<SL, SL>(sT, sa, acc, wave, fr, fq);
            bf16_t* gt = gGT + (size_t)it * 4096;
#pragma unroll
            for (int nt = 0; nt < 4; ++nt)
#pragma unroll
                for (int r = 0; r < 4; ++r) gt[(nt * 16 + fq * 4 + r) * 64 + m] = f2bf(acc[nt][r]);
            mm64<SL, SL>(s0, sa, qacc, wave, fr, fq);
            st_tr(sb, qacc, m, fq);
            float f0[8], f1[8];
            unpack8(*(const uint4*)(s1 + bi * SL + bq), f0); unpack8(*(const uint4*)(s1 + bi * SL + bq + 8), f1);
#pragma unroll
            for (int e = 0; e < 8; ++e) { s3[(bq + e) * SL + bi] = f2bf(f0[e] * GAM[bq + e]); s3[(bq + 8 + e) * SL + bi] = f2bf(f1[e] * GAM[bq + 8 + e]); }
        }
        __syncthreads();
        {
            R1_IDX const int rowb = scan_row(b, d, c * 64 + bi); (void)rowb;
            f32x4 acc[4]; acc_zero(acc);
            mm64<SL, SL>(sT, s3, acc, wave, fr, fq);
            bf16_t* mt = gMT + (size_t)it * 4096;
#pragma unroll
            for (int nt = 0; nt < 4; ++nt)
#pragma unroll
                for (int r = 0; r < 4; ++r) { const int n = nt * 16 + fq * 4 + r; mt[n * 64 + m] = f2bf(acc[nt][r] + (n == m ? GAM[m] : 0.f)); }
#pragma unroll
            for (int nt = 0; nt < 4; ++nt) {
                const int n = nt * 16 + fq * 4; const uint2 u = *(const uint2*)(s2 + m * SL + n);
                acc[nt] = (f32x4){bflo(u.x) * GAM[n], bfhi(u.x) * GAM[n + 1], bflo(u.y) * GAM[n + 2], bfhi(u.y) * GAM[n + 3]};
            }
            mm64<SL, SL>(s0, s3, acc, wave, fr, fq);
            st_tr(s1, acc, m, fq);
            float v8[8];
#pragma unroll
            for (int hh = 0; hh < 2; ++hh) {
                xs8(P, mu, rowb, 1024 + h * 64 + bq + hh * 8, v8);
#pragma unroll
                for (int e = 0; e < 8; ++e) sc[(bq + hh * 8 + e) * SL + bi] = f2bf(v8[e]);
            }
        }
        __syncthreads();
        {
            R1_IDX const int rowb = scan_row(b, d, c * 64 + bi); (void)rowb;
            f32x4 acc[4]; acc_zero(acc);
            mm64<SL, SL>(sc, sb, acc, wave, fr, fq);
            bf16_t* yl = gYL + (size_t)it * 4096;
#pragma unroll
            for (int nt = 0; nt < 4; ++nt) store_bf16x4(yl + m * 64 + nt * 16 + fq * 4, acc[nt]);
            acc_zero(acc);
            mm64<SL, SL>(sc, s1, acc, wave, fr, fq);
            bf16_t* nl = gNL + (size_t)it * 4096;
#pragma unroll
            for (int nt = 0; nt < 4; ++nt) store_bf16x4(nl + m * 64 + nt * 16 + fq * 4, acc[nt]);
        }
        __syncthreads();
    }
}
__device__ __forceinline__ void ph_r2(const Params& p) {
    const int tid = tidx(), lane = tid & 63, wave = tid >> 6, fr = lane & 15, fq = lane >> 4;
    const bf16_t* gMT = (const bf16_t*)(p.ws + O_X + X_MT); const bf16_t* gNL = (const bf16_t*)(p.ws + O_X + X_NL);
    uint4* gS0 = (uint4*)(p.ws + O_X + X_S0);
    for (int it = blockIdx.x; it < 64; it += gridDim.x) {
        f32x4 st[4];
#pragma unroll
        for (int tt = 0; tt < 4; ++tt) st[tt] = (f32x4){0.f, 0.f, 0.f, 0.f};
        u32x4 maA[4][2], maB[4][2]; uint2 nvA[4], nvB[4];
#define R2_LOAD(MA, NV, C) do { const size_t cp_ = (size_t)it * 68 + (C); const bf16_t* mt_ = gMT + cp_ * 4096; const bf16_t* nl_ = gNL + cp_ * 4096; \
            _Pragma("unroll") for (int tt = 0; tt < 4; ++tt) { \
                _Pragma("unroll") for (int s_ = 0; s_ < 2; ++s_) { const bf16_t* q_ = mt_ + (tt * 16 + fr) * 64 + s_ * 32 + fq * 4; const uint2 x_ = *(const uint2*)q_, y_ = *(const uint2*)(q_ + 16); MA[tt][s_] = (u32x4){x_.x, x_.y, y_.x, y_.y}; } \
                NV[tt] = *(const uint2*)(nl_ + (wave * 16 + fr) * 64 + tt * 16 + fq * 4); } } while (0)
#define R2_STEP(MA, NV, C) do { const size_t cp_ = (size_t)it * 68 + (C); \
            u32x4 sb_[2]; \
            _Pragma("unroll") for (int s_ = 0; s_ < 2; ++s_) sb_[s_] = (u32x4){pack2(st[2 * s_][0], st[2 * s_][1]), pack2(st[2 * s_][2], st[2 * s_][3]), pack2(st[2 * s_ + 1][0], st[2 * s_ + 1][1]), pack2(st[2 * s_ + 1][2], st[2 * s_ + 1][3])}; \
            *(u32x4*)(gS0 + (cp_ * 4 + wave) * 128 + lane) = sb_[0]; *(u32x4*)(gS0 + (cp_ * 4 + wave) * 128 + 64 + lane) = sb_[1]; \
            _Pragma("unroll") for (int tt = 0; tt < 4; ++tt) { \
                f32x4 acc_ = {bflo(NV[tt].x), bfhi(NV[tt].x), bflo(NV[tt].y), bfhi(NV[tt].y)}; \
                _Pragma("unroll") for (int s_ = 0; s_ < 2; ++s_) acc_ = __builtin_amdgcn_mfma_f32_16x16x32_bf16(__builtin_bit_cast(bf16x8, MA[tt][s_]), __builtin_bit_cast(bf16x8, sb_[s_]), acc_, 0, 0, 0); \
                st[tt] = acc_; } } while (0)
        R2_LOAD(maA, nvA, 0);
        for (int c = 0; c < 68; c += 2) {
            R2_LOAD(maB, nvB, c + 1);
            R2_STEP(maA, nvA, c);
            if (c + 2 < 68) R2_LOAD(maA, nvA, c + 2);
            R2_STEP(maB, nvB, c + 1);
        }
#undef R2_LOAD
#undef R2_STEP
    }
}
__device__ __forceinline__ void ph_r3(const Params& p) {
    const int tid = tidx(), lane = tid & 63, wave = tid >> 6, fr = lane & 15, fq = lane >> 4;
    const bf16_t* gGT = (const bf16_t*)(p.ws + O_X + X_GT); const bf16_t* gYL = (const bf16_t*)(p.ws + O_X + X_YL);
    const uint4* gS0 = (const uint4*)(p.ws + O_X + X_S0);
    bf16_t* YS = (bf16_t*)(p.ws + O_H);
    for (int it = blockIdx.x; it < NCP; it += gridDim.x) {
        const int c = it % 68, d = (it / 68) & 1, h = (it / 136) & 7, b = it / 1088;
        const bf16_t* gt = gGT + (size_t)it * 4096; const bf16_t* yl = gYL + (size_t)it * 4096;
        const uint4 sb0 = gS0[((size_t)it * 4 + wave) * 128 + lane], sb1 = gS0[((size_t)it * 4 + wave) * 128 + 64 + lane];
#pragma unroll
        for (int tt = 0; tt < 4; ++tt) {
            const uint2 yv = *(const uint2*)(yl + (wave * 16 + fr) * 64 + tt * 16 + fq * 4);
            f32x4 acc = {bflo(yv.x), bfhi(yv.x), bflo(yv.y), bfhi(yv.y)};
#pragma unroll
            for (int s = 0; s < 2; ++s) {
                const bf16_t* q = gt + (tt * 16 + fr) * 64 + s * 32 + fq * 4;
                const uint2 a0 = *(const uint2*)q, a1 = *(const uint2*)(q + 16);
                const bf16x8 af = __builtin_bit_cast(bf16x8, make_uint4(a0.x, a0.y, a1.x, a1.y));
                acc = __builtin_amdgcn_mfma_f32_16x16x32_bf16(af, __builtin_bit_cast(bf16x8, s ? sb1 : sb0), acc, 0, 0, 0);
            }
#pragma unroll
            for (int r = 0; r < 4; ++r) {
                const int row = scan_row(b, d, c * 64 + tt * 16 + fq * 4 + r);
                YS[((size_t)d * RT + row) * 512 + h * 64 + wave * 16 + fr] = f2bf(acc[r]);
            }
        }
    }
}

__device__ __forceinline__ void ph_rpost(const Params& p, int l) {
    const int lane = tidx() & 63, wave = tidx() >> 6;
    const bf16_t* P = (const bf16_t*)(p.ws + O_P); const float* mu = p.in[I_MU] + l * 1792;
    const float* gng = p.in[I_GNG] + l * 512; const float* gnb = p.in[I_GNB] + l * 512;
    const float* BON = (const float*)(p.ws + O_X + X_BON); const bf16_t* YS = (const bf16_t*)(p.ws + O_H);
    const bf16_t* RG = (const bf16_t*)(p.ws + O_RG); bf16_t* RWO = (bf16_t*)(p.ws + O_RWO);
    for (int row = blockIdx.x * 4 + wave; row < RT; row += gridDim.x * 4) {
        const int col = lane * 8, h = lane >> 3;
        float v8[8], g8[8], y0[8], y1[8];
        xs8(P, mu, row, 1024 + col, v8);
        unpack8(*(const uint4*)(RG + (size_t)row * 512 + col), g8);
        unpack8(*(const uint4*)(YS + ((size_t)0 * RT + row) * 512 + col), y0);
        unpack8(*(const uint4*)(YS + ((size_t)1 * RT + row) * 512 + col), y1);
        const float bs = BON[((size_t)0 * RT + row) * 8 + h] + BON[((size_t)1 * RT + row) * 8 + h];
        float y[8]; float sm = 0.f;
#pragma unroll
        for (int j = 0; j < 8; ++j) { y[j] = y0[j] + y1[j]; sm += y[j]; }
        sm += __shfl_xor(sm, 1); sm += __shfl_xor(sm, 2); sm += __shfl_xor(sm, 4);
        const float mean = sm * (1.f / 64.f);
        float vs = 0.f;
#pragma unroll
        for (int j = 0; j < 8; ++j) { const float dlt = y[j] - mean; vs += dlt * dlt; }
        vs += __shfl_xor(vs, 1); vs += __shfl_xor(vs, 2); vs += __shfl_xor(vs, 4);
        const float rstd = rsqrtf(vs * (1.f / 64.f) + 64e-5f);
        float o[8];
#pragma unroll
        for (int j = 0; j < 8; ++j) o[j] = ((y[j] - mean) * rstd * gng[col + j] + gnb[col + j] + bs * v8[j]) * g8[j];
        *(uint4*)(RWO + (size_t)row * 512 + col) = pack8(o);
    }
}

__device__ __forceinline__ void ph_f1(const Params& p, int l, char* smem) {
    const bf16_t* P = (const bf16_t*)(p.ws + O_P); const bf16_t* CSC = (const bf16_t*)(p.ws + O_CSC);
    bf16_t* YT = (bf16_t*)(p.ws + O_X + X_YT); bf16_t* YTC = (bf16_t*)(p.ws + O_X + X_YTC);
    const int nitems = 1024 + (l < NLAYER - 1 ? 64 : 0);
    for (int it = blockIdx.x; it < nitems; it += gridDim.x) {
        f32x4 acc[4][4];
        if (it < 1024) {
            const int b = it >> 8, g = (it >> 6) & 3, mt = (it >> 5) & 1, nt = it & 31;
            RPPlain rp{CSC + (size_t)mt * 128 * 128, 128};
            gemm_core_g<4>(rp, P + (size_t)(b * SEQ + nt * 128) * LDP + g * 128, LDP, 128, acc, smem);
            acc_foreach<4>(acc, [&](int m, int n, const f32x4& v) {
                store_bf16x4(YT + ((size_t)(b * 512 + g * 128 + m)) * 8192 + mt * 4096 + nt * 128 + n, v);
            });
        } else {
            const int j = it - 1024, b = j >> 4, g = (j >> 2) & 3, mt = (j >> 1) & 1, nt = j & 1;
            RPPlain rp{CSC + (size_t)mt * 128 * 128, 128};
            gemm_core_g<4>(rp, P + (size_t)(RL + b * CTX + nt * 128) * LDP + g * 128, LDP, 128, acc, smem);
            acc_foreach<4>(acc, [&](int m, int n, const f32x4& v) {
                store_bf16x4(YTC + ((size_t)(b * 512 + g * 128 + m)) * 512 + mt * 256 + nt * 128 + n, v);
            });
        }
    }
}
__device__ __forceinline__ void ph_f2(const Params& p, int l, char* smem) {
    const bf16_t* CST = (const bf16_t*)(p.ws + O_CST); const bf16_t* CST2 = (const bf16_t*)(p.ws + O_CST256);
    const bf16_t* YT = (const bf16_t*)(p.ws + O_X + X_YT); const bf16_t* YTC = (const bf16_t*)(p.ws + O_X + X_YTC);
    bf16_t* FA = (bf16_t*)(p.ws + O_FA);
    const int nitems = 512 + (l < NLAYER - 1 ? 32 : 0);
    for (int it = blockIdx.x; it < nitems; it += gridDim.x) {
        f32x4 acc[4][4];
        if (it < 512) {
            const int b = it >> 7, mt = (it >> 2) & 31, nt = it & 3;
            RPPlain rp{CST + (size_t)mt * 128 * 8192, 8192};
            gemm_core_g<4>(rp, YT + ((size_t)b * 512 + nt * 128) * 8192, 8192, 8192, acc, smem);
            const float sc = 0.001381067932004975f;
            acc_foreach<4>(acc, [&](int m, int n, const f32x4& v) { f32x4 o = v * sc; store_bf16x4(FA + (size_t)(b * SEQ + mt * 128 + m) * 512 + nt * 128 + n, o); });
        } else {
            const int j = it - 512, b = j >> 3, mt = (j >> 2) & 1, nt = j & 3;
            RPPlain rp{CST2 + (size_t)mt * 128 * 512, 512};
            gemm_core_g<4>(rp, YTC + ((size_t)b * 512 + nt * 128) * 512, 512, 512, acc, smem);
            const float sc = 0.005524271728019903f;
            acc_foreach<4>(acc, [&](int m, int n, const f32x4& v) { f32x4 o = v * sc; store_bf16x4(FA + (size_t)(RL + b * CTX + mt * 128 + m) * 512 + nt * 128 + n, o); });
        }
    }
}

__device__ __forceinline__ void ph_mg(const Params& p, int l, char* smem) {
    const bf16_t* P = (const bf16_t*)(p.ws + O_P);
    const bf16_t* A[3] = {(const bf16_t*)(p.ws + O_FA), (const bf16_t*)(p.ws + O_ATT), (const bf16_t*)(p.ws + O_RWO)};
    const bf16_t* W[3] = {(const bf16_t*)(p.ws + O_WB + W_PA), (const bf16_t*)(p.ws + O_WB + W_PB), (const bf16_t*)(p.ws + O_WB + W_PC)};
    bf16_t* MG = (bf16_t*)(p.ws + O_H);
    const int nmt = (l < NLAYER - 1) ? RT / 64 : RL / 64;
    for (int it = blockIdx.x; it < nmt * 8; it += gridDim.x) {
        const int mt = it >> 3, nt = it & 7;
        f32x4 tot[2][4];
#pragma unroll
        for (int i = 0; i < 2; ++i)
#pragma unroll
            for (int j = 0; j < 4; ++j) tot[i][j] = (f32x4){0.f, 0.f, 0.f, 0.f};
#pragma unroll
        for (int br = 0; br < 3; ++br) {
            f32x4 acc[2][4];
            RPPlain rp{A[br] + (size_t)mt * 64 * 512, 512};
            gemm_core_g<2>(rp, W[br] + (size_t)nt * 128 * 512, 512, 512, acc, smem);
            const int lane = tidx() & 63, wave = tidx() >> 6, wr = wave >> 1, wc = wave & 1, fr = lane & 15, fq = lane >> 4;
#pragma unroll
            for (int i = 0; i < 2; ++i)
#pragma unroll
                for (int j = 0; j < 4; ++j) {
                    const int m = wr * 32 + i * 16 + fr, n = wc * 64 + j * 16 + fq * 4;
                    const uint2 gu = *(const uint2*)(P + (size_t)(mt * 64 + m) * LDP + PG0 + br * 1024 + nt * 128 + n);
                    tot[i][j][0] += bflo(gu.x) * acc[i][j][0]; tot[i][j][1] += bfhi(gu.x) * acc[i][j][1];
                    tot[i][j][2] += bflo(gu.y) * acc[i][j][2]; tot[i][j][3] += bfhi(gu.y) * acc[i][j][3];
                }
        }
        acc_foreach<2>(tot, [&](int m, int n, const f32x4& v) { store_bf16x4(MG + (size_t)(mt * 64 + m) * 1024 + nt * 128 + n, v); });
    }
}
__device__ __forceinline__ void ph_out(const Params& p, int l, char* smem) {
    const bf16_t* MG = (const bf16_t*)(p.ws + O_H); const bf16_t* W = (const bf16_t*)(p.ws + O_WB + W_OUT);
    float* xcur = (float*)(p.ws + O_XCUR); const float* mod = (const float*)(p.ws + O_MOD);
    const int nmt = (l < NLAYER - 1) ? RT / 128 : RL / 128;
    for (int it = blockIdx.x; it < nmt * 8; it += gridDim.x) {
        const int mt = it >> 3, nt = it & 7;
        f32x4 acc[4][4];
        RPPlain rp{MG + (size_t)mt * 128 * 1024, 1024};
        gemm_core_g<4>(rp, W + (size_t)nt * 128 * 1024, 1024, 1024, acc, smem);
        acc_foreach<4>(acc, [&](int m, int n, const f32x4& v) {
            const int row = mt * 128 + m, col = nt * 128 + n;
            const float4 g = *(const float4*)(mod + (size_t)(l * 5 + modidx(row)) * 6144 + 2048 + col);
            float4* xp = (float4*)(xcur + (size_t)row * 1024 + col);
            float4 x = *xp; x.x += g.x * v[0]; x.y += g.y * v[1]; x.z += g.z * v[2]; x.w += g.w * v[3]; *xp = x;
        });
    }
}

__device__ __forceinline__ void ph_n2(const Params& p, int l, char* smem) {
    const int tid = tidx(), lane = tid & 63, wave = tid >> 6;
    unsigned* lcnt = (unsigned*)smem;
    unsigned* gbase = lcnt + 16;
    int* rec = (int*)(smem + 256);
    if (tid < 16) lcnt[tid] = 0u;
    __syncthreads();
    int nrec = 0;
    const float* xcur = (const float*)(p.ws + O_XCUR); const float* mod = (const float*)(p.ws + O_MOD);
    bf16_t* H = (bf16_t*)(p.ws + O_H);
    unsigned* cnt = (unsigned*)(p.ws + O_CNT); int* LTOK = (int*)(p.ws + O_LTOK); float* LW = (float*)(p.ws + O_LW); int* SLOT = (int*)(p.ws + O_SLOT);
    const float* g = p.in[I_N2G] + l * 1024; const float* rw = p.in[I_RW]; const float* rb = p.in[I_RB];
    const int nrows = (l < NLAYER - 1) ? RT : RL;
    for (int row = blockIdx.x * 4 + wave; row < nrows; row += gridDim.x * 4) {
        const float* x = xcur + (size_t)row * 1024; const float* md = mod + (size_t)(l * 5 + modidx(row)) * 6144;
        float4 v[4]; float ss = 0.f;
#pragma unroll
        for (int i = 0; i < 4; ++i) { v[i] = *(const float4*)(x + lane * 4 + 256 * i); ss += v[i].x * v[i].x + v[i].y * v[i].y + v[i].z * v[i].z + v[i].w * v[i].w; }
        ss = wsum(ss);
        const float rstd = rsqrtf(ss * (1.f / 1024.f) + 1e-6f);
        float lg[16];
#pragma unroll
        for (int e = 0; e < 16; ++e) lg[e] = 0.f;
#pragma unroll
        for (int i = 0; i < 4; ++i) {
            const int c = lane * 4 + 256 * i;
            const float4 gg = *(const float4*)(g + c), sc = *(const float4*)(md + 4096 + c), sh = *(const float4*)(md + 3072 + c);
            const float hv[4] = {v[i].x * rstd * gg.x * (1.f + sc.x) + sh.x, v[i].y * rstd * gg.y * (1.f + sc.y) + sh.y,
                                 v[i].z * rstd * gg.z * (1.f + sc.z) + sh.z, v[i].w * rstd * gg.w * (1.f + sc.w) + sh.w};
            f32x4 h4 = {hv[0], hv[1], hv[2], hv[3]};
            store_bf16x4(H + (size_t)row * 1024 + c, h4);
#pragma unroll
            for (int j = 0; j < 4; ++j) {
                const float* wr_ = rw + (size_t)(c + j) * 16;
                const float4 w0 = *(const float4*)wr_, w1 = *(const float4*)(wr_ + 4), w2 = *(const float4*)(wr_ + 8), w3 = *(const float4*)(wr_ + 12);
                lg[0] += hv[j] * w0.x; lg[1] += hv[j] * w0.y; lg[2] += hv[j] * w0.z; lg[3] += hv[j] * w0.w;
                lg[4] += hv[j] * w1.x; lg[5] += hv[j] * w1.y; lg[6] += hv[j] * w1.z; lg[7] += hv[j] * w1.w;
                lg[8] += hv[j] * w2.x; lg[9] += hv[j] * w2.y; lg[10] += hv[j] * w2.z; lg[11] += hv[j] * w2.w;
                lg[12] += hv[j] * w3.x; lg[13] += hv[j] * w3.y; lg[14] += hv[j] * w3.z; lg[15] += hv[j] * w3.w;
            }
        }
        float sc_[16], sel[16];
#pragma unroll
        for (int e = 0; e < 16; ++e) { lg[e] = wsum(lg[e]); sc_[e] = 1.f / (1.f + expf(-lg[e])); sel[e] = sc_[e] + rb[e]; }
        int best = 0; float bestv = -1e30f;
#pragma unroll
        for (int gi = 0; gi < 4; ++gi) {
            float m1 = -1e30f, m2 = -1e30f;
#pragma unroll
            for (int j = 0; j < 4; ++j) { const float s = sel[gi * 4 + j]; if (s > m1) { m2 = m1; m1 = s; } else if (s > m2) m2 = s; }
            const float gs = m1 + m2;
            if (gs > bestv) { bestv = gs; best = gi; }
        }
        float s4[4] = {0.f, 0.f, 0.f, 0.f}, c4[4] = {0.f, 0.f, 0.f, 0.f};
#pragma unroll
        for (int gi = 0; gi < 4; ++gi)
#pragma unroll
            for (int j = 0; j < 4; ++j) if (gi == best) { s4[j] = sel[gi * 4 + j]; c4[j] = sc_[gi * 4 + j]; }
        int i1 = 0; float v1 = s4[0], w1 = c4[0];
#pragma unroll
        for (int j = 1; j < 4; ++j) if (s4[j] > v1) { v1 = s4[j]; i1 = j; w1 = c4[j]; }
        int i2 = -1; float v2 = -1e30f, w2 = 0.f;
#pragma unroll
        for (int j = 0; j < 4; ++j) if (j != i1 && s4[j] > v2) { v2 = s4[j]; i2 = j; w2 = c4[j]; }
        if (lane == 0) {
            const float inv = 1.f / (w1 + w2);
            const int e1 = best * 4 + i1, e2 = best * 4 + i2;
            const unsigned r1 = atomicAdd(&lcnt[e1], 1u), r2 = atomicAdd(&lcnt[e2], 1u);
            int* rc = rec + (wave * 32 + nrec) * 8;
            rc[0] = row; rc[1] = e1; rc[2] = e2; rc[3] = (int)r1; rc[4] = (int)r2; rc[5] = __float_as_int(w1 * inv); rc[6] = __float_as_int(w2 * inv);
        }
        ++nrec;
    }
    __syncthreads();
    if (tid < 16) gbase[tid] = lcnt[tid] ? atomicAdd(&cnt[tid], lcnt[tid]) : 0u;
    __syncthreads();
    for (int i = lane; i < nrec; i += 64) {
        const int* rc = rec + (wave * 32 + i) * 8;
        const int row = rc[0], e1 = rc[1], e2 = rc[2];
        const unsigned p1 = gbase[e1] + (unsigned)rc[3], p2 = gbase[e2] + (unsigned)rc[4];
        LTOK[(size_t)e1 * RT + p1] = row; LW[(size_t)e1 * RT + p1] = __int_as_float(rc[5]);
        LTOK[(size_t)e2 * RT + p2] = row; LW[(size_t)e2 * RT + p2] = __int_as_float(rc[6]);
        SLOT[row * 2] = (e1 << 20) | (int)p1; SLOT[row * 2 + 1] = (e2 << 20) | (int)p2;
    }
}

struct MoeTiles { int tb[17]; int sm; };
__device__ __forceinline__ void moe_tiles(const Params& p, int l, int* s_tb) {
    if (tidx() == 0) {
        const unsigned* cnt = (const unsigned*)(p.ws + O_CNT);
        int a = 0;
        for (int e = 0; e < 16; ++e) { s_tb[e] = a; a += ((int)cnt[e] + 127) >> 7; }
        s_tb[16] = a;
    }
    __syncthreads();
}
struct ALGather {
    const bf16_t* p[4]; bool ok[4];
    __device__ __forceinline__ uint4 load(int i, int k) const { return ok[i] ? *(const uint4*)(p[i] + k) : make_uint4(0u, 0u, 0u, 0u); }
};
struct ALSwiglu {
    const bf16_t* p[4]; float w[4];
    __device__ __forceinline__ uint4 load(int i, int k) const {
        float g[8], u[8], o[8]; unpack8(*(const uint4*)(p[i] + k), g); unpack8(*(const uint4*)(p[i] + 512 + k), u);
#pragma unroll
        for (int j = 0; j < 8; ++j) o[j] = siluf_(g[j]) * u[j] * w[i];
        return pack8(o);
    }
};
__device__ __forceinline__ void ph_e1(const Params& p, int l, char* smem) {
    int* s_tb = (int*)(smem + 73728);
    moe_tiles(p, l, s_tb);
    const bf16_t* H = (const bf16_t*)(p.ws + O_H); bf16_t* ACT = (bf16_t*)(p.ws + O_P);
    const unsigned* cnt = (const unsigned*)(p.ws + O_CNT); const int* LTOK = (const int*)(p.ws + O_LTOK); const float* LW = (const float*)(p.ws + O_LW);
    const int sm = (l < NLAYER - 1) ? RT / 128 : RL / 128;
    const int total = (sm + s_tb[16]) * 8;
    for (int it = blockIdx.x; it < total; it += gridDim.x) {
        const int mt = it >> 3, nt = it & 7;
        int e = 16, erow0 = mt * 128, lt = 0;
        if (mt >= sm) { const int q = mt - sm; e = 0; while (q >= s_tb[e + 1]) ++e; lt = q - s_tb[e]; erow0 = RT + q * 128; }
        const int cnte = (e == 16) ? 0 : (int)cnt[e];
        auto rp = [&](int r) -> const bf16_t* {
            if (e == 16) return H + (size_t)(mt * 128 + r) * 1024;
            const int idx = lt * 128 + r;
            const int tok = idx < cnte ? LTOK[(size_t)e * RT + idx] : 0;
            return H + (size_t)tok * 1024;
        };
        f32x4 acc[4][4];
        gemm_core_g<4>(rp, (const bf16_t*)(p.ws + O_WB + W_GU) + (size_t)e * 1024 * 1024 + (size_t)nt * 128 * 1024, 1024, 1024, acc, smem);
        {
            const int lane = tidx() & 63, wave = tidx() >> 6, wr = wave >> 1, wc = wave & 1, fr = lane & 15, fq = lane >> 4;
            float* U = (float*)smem;
            if (wc == 1) {
#pragma unroll
                for (int i = 0; i < 4; ++i)
#pragma unroll
                    for (int j = 0; j < 4; ++j) *(f32x4*)(U + (wr * 64 + i * 16 + fr) * 68 + j * 16 + fq * 4) = acc[i][j];
            }
            __syncthreads();
            if (wc == 0) {
#pragma unroll
                for (int i = 0; i < 4; ++i) {
                    const int m = wr * 64 + i * 16 + fr;
                    float wgt = 1.f;
                    if (e != 16) { const int idx = lt * 128 + m; wgt = idx < cnte ? LW[(size_t)e * RT + idx] : 0.f; }
#pragma unroll
                    for (int j = 0; j < 4; ++j) {
                        const f32x4 u = *(const f32x4*)(U + m * 68 + j * 16 + fq * 4);
                        f32x4 o;
#pragma unroll
                        for (int r = 0; r < 4; ++r) o[r] = siluf_(acc[i][j][r]) * u[r] * wgt;
                        store_bf16x4(ACT + (size_t)(erow0 + m) * 512 + nt * 64 + j * 16 + fq * 4, o);
                    }
                }
            }
            __syncthreads();
        }
    }
}
__device__ __forceinline__ void ph_e2(const Params& p, int l, char* smem) {
    int* s_tb = (int*)(smem + 73728);
    moe_tiles(p, l, s_tb);
    const bf16_t* ACT = (const bf16_t*)(p.ws + O_P); bf16_t* YE = (bf16_t*)(p.ws + O_X + X_YE);
    const int sm = (l < NLAYER - 1) ? RT / 128 : RL / 128;
    const int total = (sm + s_tb[16]) * 8;
    for (int it = blockIdx.x; it < total; it += gridDim.x) {
        const int mt = it >> 3, nt = it & 7;
        int e = 16, erow0 = mt * 128;
        if (mt >= sm) { const int q = mt - sm; e = 0; while (q >= s_tb[e + 1]) ++e; erow0 = RT + q * 128; }
        RPPlain rp{ACT + (size_t)erow0 * 512, 512};
        f32x4 acc[4][4];
        gemm_core_g<4>(rp, (const bf16_t*)(p.ws + O_WB + W_D) + (size_t)e * 1024 * 512 + (size_t)nt * 128 * 512, 512, 512, acc, smem);
        acc_foreach<4>(acc, [&](int m, int n, const f32x4& v) { store_bf16x4(YE + (size_t)(erow0 + m) * 1024 + nt * 128 + n, v); });
    }
}
__device__ __forceinline__ void ph_e3(const Params& p, int l, char* smem) {
    int* s_tb = (int*)(smem + 73728);
    moe_tiles(p, l, s_tb);
    const int lane = tidx() & 63, wave = tidx() >> 6;
    const bf16_t* YE = (const bf16_t*)(p.ws + O_X + X_YE); const int* SLOT = (const int*)(p.ws + O_SLOT);
    float* xcur = (float*)(p.ws + O_XCUR); const float* mod = (const float*)(p.ws + O_MOD);
    const int nrows = (l < NLAYER - 1) ? RT : RL;
    for (int row = blockIdx.x * 4 + wave; row < nrows; row += gridDim.x * 4) {
        const int s1 = SLOT[row * 2], s2 = SLOT[row * 2 + 1];
        const size_t r0 = row, r1 = (size_t)RT + s_tb[s1 >> 20] * 128 + (s1 & 0xfffff), r2 = (size_t)RT + s_tb[s2 >> 20] * 128 + (s2 & 0xfffff);
        const float* g2 = mod + (size_t)(l * 5 + modidx(row)) * 6144 + 5120;
#pragma unroll
        for (int i = 0; i < 2; ++i) {
            const int c = lane * 8 + 512 * i;
            float a[8], b[8], d[8];
            unpack8(*(const uint4*)(YE + r0 * 1024 + c), a); unpack8(*(const uint4*)(YE + r1 * 1024 + c), b); unpack8(*(const uint4*)(YE + r2 * 1024 + c), d);
            float4* xp = (float4*)(xcur + (size_t)row * 1024 + c);
            float4 x0 = xp[0], x1 = xp[1];
            const float4 ga = *(const float4*)(g2 + c), gb = *(const float4*)(g2 + c + 4);
            x0.x += ga.x * (a[0] + b[0] + d[0]); x0.y += ga.y * (a[1] + b[1] + d[1]); x0.z += ga.z * (a[2] + b[2] + d[2]); x0.w += ga.w * (a[3] + b[3] + d[3]);
            x1.x += gb.x * (a[4] + b[4] + d[4]); x1.y += gb.y * (a[5] + b[5] + d[5]); x1.z += gb.z * (a[6] + b[6] + d[6]); x1.w += gb.w * (a[7] + b[7] + d[7]);
            xp[0] = x0; xp[1] = x1;
        }
    }
}
__device__ __forceinline__ void ph_final(const Params& p) {
    const int lane = tidx() & 63, wave = tidx() >> 6;
    const float* xcur = (const float*)(p.ws + O_XCUR); const float* g = p.in[I_FNG];
    for (int row = blockIdx.x * 4 + wave; row < RL; row += gridDim.x * 4) {
        const float* x = xcur + (size_t)row * 1024;
        float4 v[4]; float ss = 0.f;
#pragma unroll
        for (int i = 0; i < 4; ++i) { v[i] = *(const float4*)(x + lane * 4 + 256 * i); ss += v[i].x * v[i].x + v[i].y * v[i].y + v[i].z * v[i].z + v[i].w * v[i].w; }
        ss = wsum(ss);
        const float rstd = rsqrtf(ss * (1.f / 1024.f) + 1e-6f);
#pragma unroll
        for (int i = 0; i < 4; ++i) {
            const int c = lane * 4 + 256 * i; const float4 gg = *(const float4*)(g + c);
            *(float4*)(p.out + (size_t)row * 1024 + c) = make_float4(v[i].x * rstd * gg.x, v[i].y * rstd * gg.y, v[i].z * rstd * gg.z, v[i].w * rstd * gg.w);
        }
    }
}

constexpr int LDS_BYTES = 76800;
constexpr int NIV = 19;
extern __shared__ __attribute__((aligned(16))) char dynsmem[];
template <int ID> __device__ __forceinline__ void run_iv(const Params& pin, int l, char* smem) {
    Params p = pin; p.ws = launder(pin.ws);
    if constexpr (ID == 0) { ph_pre(p, smem); __syncthreads(); ph_w(p, 0, smem); }
    else if constexpr (ID == 1) ph_n1(p, l);
    else if constexpr (ID == 2) ph_g1(p, smem);
    else if constexpr (ID == 3) ph_qu(p, smem);
    else if constexpr (ID == 4) ph_m2(p, smem);
    else if constexpr (ID == 5) ph_at(p, l, smem);
    else if constexpr (ID == 6) { ph_rp1(p, l, smem); ph_rp2(p, l); }
    else if constexpr (ID == 7) ph_r1(p, l, smem);
    else if constexpr (ID == 8) ph_r2(p);
    else if constexpr (ID == 9) ph_r3(p);
    else if constexpr (ID == 10) { ph_rpost(p, l); ph_f1(p, l, smem); }
    else if constexpr (ID == 11) ph_f2(p, l, smem);
    else if constexpr (ID == 12) ph_mg(p, l, smem);
    else if constexpr (ID == 13) ph_out(p, l, smem);
    else if constexpr (ID == 14) ph_n2(p, l, smem);
    else if constexpr (ID == 15) ph_e1(p, l, smem);
    else if constexpr (ID == 16) ph_e2(p, l, smem);
    else if constexpr (ID == 17) { ph_e3(p, l, smem); __syncthreads(); if (l + 1 < NLAYER) ph_w(p, l + 1, smem); }
    else ph_final(p);
}
#if MEGA
#ifndef PROBE_MASK
#define PROBE_MASK 0
#define PROBE_REP 1
#endif
#define IV(ID) for (int r_ = 0; r_ < (((PROBE_MASK >> (ID)) & 1) ? PROBE_REP : 1); ++r_) { run_iv<ID>(p, l, smem); xcd_barrier(bar); }
__global__ void __launch_bounds__(256, 2) k_mega(Params p) {
    char* smem = dynsmem;
    volatile LAS unsigned* st = (volatile LAS unsigned*)(smem + LDS_BYTES - 16);
    if (tidx() == 0) { st[0] = 0u; st[1] = 0u; }
    __syncthreads();
    XcdBarrier bar = xcd_barrier_post((unsigned*)(p.ws + O_BAR), st);
    { const int l = 0; IV(0) }
    for (int l = 0; l < NLAYER; ++l) {
        IV(1) IV(2) IV(3) IV(4) IV(5) IV(6) IV(7) IV(8) IV(9) IV(10) IV(11) IV(12) IV(13) IV(14) IV(15) IV(16) IV(17)
    }
    run_iv<18>(p, 0, smem);
}
#else
template <int ID> __global__ void __launch_bounds__(256, 2) k_iv(Params p, int l) { run_iv<ID>(p, l, dynsmem); }
template <int ID> static void launch_iv(const Params& p, int l, int grid, hipStream_t s) {
    static bool once = false; if (!once) { once = true; (void)hipFuncSetAttribute((const void*)k_iv<ID>, hipFuncAttributeMaxDynamicSharedMemorySize, LDS_BYTES); }
    hipLaunchKernelGGL(k_iv<ID>, dim3(grid), dim3(256), LDS_BYTES, s, p, l);
}
#endif

extern "C" void kernel_launch(void* const* d_in, const int* in_sizes, int n_in, void* d_out, int out_size, void* d_ws, size_t ws_size, hipStream_t stream) {
    (void)in_sizes; (void)out_size;
    if (n_in < N_IN || ws_size < WS_NEED) return;
    Params p{};
    for (int i = 0; i < N_IN; ++i) p.in[i] = (const float*)d_in[i];
    p.out = (float*)d_out; p.ws = (char*)d_ws;
    static int grid = 0;
    if (!grid) {
        int dev = 0, cus = 0; (void)hipGetDevice(&dev); (void)hipDeviceGetAttribute(&cus, hipDeviceAttributeMultiprocessorCount, dev);
        int per_cu = 2;
#if MEGA
        (void)hipFuncSetAttribute((const void*)k_mega, hipFuncAttributeMaxDynamicSharedMemorySize, LDS_BYTES);
        int occ = 0; (void)hipOccupancyMaxActiveBlocksPerMultiprocessor(&occ, k_mega, 256, LDS_BYTES);
        if (occ < per_cu) per_cu = occ;
        if (per_cu < 1) per_cu = 1;
#endif
        grid = cus * per_cu;
    }
#if MEGA
    (void)hipMemsetAsync(p.ws + O_BAR, 0, 16384, stream);
    hipLaunchKernelGGL(k_mega, dim3(grid), dim3(256), LDS_BYTES, stream, p);
#else
    launch_iv<0>(p, 0, grid, stream);
    for (int l = 0; l < NLAYER; ++l) {
        launch_iv<1>(p, l, grid, stream); launch_iv<2>(p, l, grid, stream); launch_iv<3>(p, l, grid, stream); launch_iv<4>(p, l, grid, stream);
        launch_iv<5>(p, l, grid, stream); launch_iv<6>(p, l, grid, stream); launch_iv<7>(p, l, grid, stream); launch_iv<8>(p, l, grid, stream);
        launch_iv<9>(p, l, grid, stream); launch_iv<10>(p, l, grid, stream); launch_iv<11>(p, l, grid, stream); launch_iv<12>(p, l, grid, stream);
        launch_iv<13>(p, l, grid, stream); launch_iv<14>(p, l, grid, stream); launch_iv<15>(p, l, grid, stream); launch_iv<16>(p, l, grid, stream); launch_iv<17>(p, l, grid, stream);
    }
    launch_iv<18>(p, 0, grid, stream);
#endif
}
```

```cpp
#include <hip/hip_runtime.h>
#include <stdint.h>

#ifndef MEGA
#define MEGA 1
#endif

typedef unsigned short bf16_t;
typedef short bf16x8 __attribute__((ext_vector_type(8)));
typedef float f32x4 __attribute__((ext_vector_type(4)));
typedef float f32x2 __attribute__((ext_vector_type(2)));
typedef unsigned u32x4 __attribute__((ext_vector_type(4)));
typedef __bf16 bf16v2 __attribute__((ext_vector_type(2)));

constexpr int NLAYER = 4;
constexpr int DM = 1024;
constexpr int RL = 16384, RC = 1024, RT = RL + RC;
constexpr int SEQ = 4096, CTX = 256, KEYS = SEQ + CTX;
constexpr int LDP = 6144;
constexpr int PQ0 = 512, PKV0 = 896, PKR0 = 1152, PR0 = 1184, PG0 = 2976, PEND = 6048;
constexpr int NEXP = 16;
constexpr int EROWS = 54272;

enum { I_X = 0, I_C, I_CTX, I_CCTX, I_WADA, I_BADA, I_N1G, I_N2G, I_WIN, I_QNG, I_KVNG, I_WUQ, I_WUKV, I_MU, I_W0, I_WUP, I_A0, I_AUP, I_GUP,
       I_KK, I_KA, I_RK, I_GNG, I_GNB, I_WPA, I_WPB, I_WPC, I_WOUT, I_RW, I_RB, I_EG, I_EU, I_ED, I_SG, I_SU, I_SD, I_FNG, N_IN };

struct Params { const float* in[N_IN]; float* out; char* ws; };

constexpr size_t al256(size_t x) { return (x + 255) & ~(size_t)255; }
constexpr size_t O_BAR   = 0;
constexpr size_t O_CNT   = O_BAR + 16384;
constexpr size_t O_MOD   = O_CNT + 4096;
constexpr size_t O_ROPEC = O_MOD + (size_t)NLAYER * 5 * 6144 * 4;
constexpr size_t O_ROPES = O_ROPEC + (size_t)SEQ * 16 * 4;
constexpr size_t O_CSC   = O_ROPES + (size_t)SEQ * 16 * 4;
constexpr size_t O_CST256= O_CSC + 256 * 128 * 2;
constexpr size_t O_D128  = O_CST256 + 256 * 512 * 2;
constexpr size_t O_E64   = O_D128 + 128 * 128 * 2;
constexpr size_t O_TWC   = O_E64 + 64 * 128 * 2;
constexpr size_t O_TWS   = O_TWC + 64 * 64 * 4;
constexpr size_t O_YT2   = O_TWS + 64 * 64 * 4;
constexpr size_t O_A2    = O_YT2 + (size_t)4 * 512 * 64 * 128 * 2;
constexpr size_t O_YTC   = O_A2 + (size_t)4 * 512 * 64 * 128 * 2;
constexpr size_t O_XCUR  = O_YTC + (size_t)4 * 512 * 512 * 2;
constexpr size_t O_WB    = O_XCUR + (size_t)RT * DM * 4;
constexpr size_t W_IN   = 0;
constexpr size_t W_UQ   = W_IN + (size_t)6144 * 1024 * 2;
constexpr size_t W_UKV  = W_UQ + (size_t)768 * 384 * 2;
constexpr size_t W_WUP  = W_UKV + (size_t)1024 * 256 * 2;
constexpr size_t W_AUP  = W_WUP + (size_t)2 * 512 * 64 * 2;
constexpr size_t W_GUP  = W_AUP + (size_t)2 * 512 * 64 * 2;
constexpr size_t W_PA   = W_GUP + (size_t)512 * 128 * 2;
constexpr size_t W_PB   = W_PA + (size_t)1024 * 512 * 2;
constexpr size_t W_PC   = W_PB + (size_t)1024 * 512 * 2;
constexpr size_t W_OUT  = W_PC + (size_t)1024 * 512 * 2;
constexpr size_t W_GU   = W_OUT + (size_t)1024 * 1024 * 2;
constexpr size_t W_D    = W_GU + (size_t)17 * 1024 * 1024 * 2;
constexpr size_t W_END  = W_D + (size_t)17 * 1024 * 512 * 2;
constexpr size_t O_H    = O_WB + W_END;
constexpr size_t O_P    = O_H + (size_t)RT * DM * 2;
constexpr size_t O_ATT  = O_P + (size_t)RT * LDP * 2;
constexpr size_t O_RG   = O_ATT + (size_t)RT * 512 * 2;
constexpr size_t O_RWO  = O_RG + (size_t)RT * 512 * 2;
constexpr size_t O_FA   = O_RWO + (size_t)RT * 512 * 2;
constexpr size_t O_LTOK = O_FA + (size_t)RT * 512 * 2;
constexpr size_t O_LW   = O_LTOK + (size_t)NEXP * RT * 4;
constexpr size_t O_SLOT = O_LW + (size_t)NEXP * RT * 4;
constexpr size_t O_X    = al256(O_SLOT + (size_t)RT * 2 * 4);
constexpr size_t X_QRAW = 0;
constexpr size_t X_KVRAW= X_QRAW + (size_t)RT * 768 * 2;
constexpr size_t X_QA   = X_KVRAW + (size_t)RT * 1024 * 2;
constexpr size_t X_KA   = X_QA + (size_t)RT * 768 * 2;
constexpr size_t X_VA   = X_KA + (size_t)4 * KEYS * 768 * 2;
constexpr int NCP = 4 * 8 * 2 * 68;
constexpr size_t X_MT   = 0;
constexpr size_t X_NL   = X_MT + (size_t)NCP * 8192;
constexpr size_t X_GT   = X_NL + (size_t)NCP * 8192;
constexpr size_t X_YL   = X_GT + (size_t)NCP * 8192;
constexpr size_t X_S0   = X_YL + (size_t)NCP * 8192;
constexpr size_t X_KKN  = X_S0 + (size_t)NCP * 8192;
constexpr size_t X_BON  = X_KKN + (size_t)RT * 8 * 4;
constexpr size_t X_END  = X_BON + (size_t)2 * RT * 8 * 4;
constexpr size_t X_YE   = 0;
constexpr size_t WS_NEED = O_X + X_END;

__device__ __forceinline__ float bf2f(bf16_t u) { return __builtin_bit_cast(float, (unsigned)u << 16); }
__device__ __forceinline__ float bflo(unsigned u) { return __builtin_bit_cast(float, u << 16); }
__device__ __forceinline__ float bfhi(unsigned u) { return __builtin_bit_cast(float, u & 0xffff0000u); }
__device__ __forceinline__ unsigned pack2(float lo, float hi) { f32x2 v = {lo, hi}; bf16v2 b = __builtin_convertvector(v, bf16v2); return __builtin_bit_cast(unsigned, b); }
__device__ __forceinline__ bf16_t f2bf(float f) { return (bf16_t)(pack2(f, 0.f) & 0xffffu); }
__device__ __forceinline__ float wsum(float v) {
#pragma unroll
    for (int o = 32; o > 0; o >>= 1) v += __shfl_xor(v, o);
    return v;
}
__device__ __forceinline__ float sigmoidf_(float x) { return 1.f / (1.f + __expf(-x)); }
__device__ __forceinline__ float siluf_(float x) { return x / (1.f + __expf(-x)); }
__device__ __forceinline__ int modidx(int row) { return row < RL ? (row >> 12) : 4; }
__device__ __forceinline__ void unpack8(const uint4& u, float (&f)[8]) {
    f[0] = bflo(u.x); f[1] = bfhi(u.x); f[2] = bflo(u.y); f[3] = bfhi(u.y); f[4] = bflo(u.z); f[5] = bfhi(u.z); f[6] = bflo(u.w); f[7] = bfhi(u.w);
}
__device__ __forceinline__ uint4 pack8(const float (&f)[8]) { return make_uint4(pack2(f[0], f[1]), pack2(f[2], f[3]), pack2(f[4], f[5]), pack2(f[6], f[7])); }

#define XB_TMO      128
#define XB_XCNT(j)  (256  + 64 * (j))
#define XB_XSUB(j)  (1280 + 64 * (j))
#define XB_XGEN(j)  (2304 + 64 * (j))
#define XB_TOP      3328
#define XB_TOPGEN   3392
#define XCD_BAR_WORDS 3456
#define XB_SPIN_CAP (1u << 22)
#define LAS __attribute__((address_space(3)))
__device__ __forceinline__ unsigned xb_ld(unsigned* p)              { return __hip_atomic_load(p, __ATOMIC_RELAXED, __HIP_MEMORY_SCOPE_AGENT); }
__device__ __forceinline__ unsigned xb_add(unsigned* p, unsigned v) { return __hip_atomic_fetch_add(p, v, __ATOMIC_RELAXED, __HIP_MEMORY_SCOPE_AGENT); }
__device__ __forceinline__ unsigned xb_xcc_id() { return (unsigned)__builtin_amdgcn_s_getreg((3 << 11) | 20) & 0xFu; }
#define XB_SPIN(cond, bar) do { unsigned _sp = 0; while (cond) { __builtin_amdgcn_s_sleep(1); \
    if ((++_sp & 255u) == 0u) { if (xb_ld(&(bar)[XB_TMO])) break; if (_sp > XB_SPIN_CAP) { atomicAdd(&(bar)[XB_TMO], 1u); break; } } } } while (0)
struct XcdBarrier { unsigned* bar; unsigned x; volatile LAS unsigned* st; };
__device__ __forceinline__ XcdBarrier xcd_barrier_post(unsigned* bar, volatile LAS unsigned* st) {
    XcdBarrier b; b.bar = bar; b.x = xb_xcc_id(); b.st = st;
    if (threadIdx.x == 0) (void)xb_add(&bar[XB_XCNT(b.x)], 1u);
    return b;
}
__device__ __forceinline__ void xcd_barrier_complete(unsigned* bar, unsigned x, unsigned& nloc, unsigned& nx) {
    const unsigned G = gridDim.x * gridDim.y * gridDim.z;
    unsigned sum, cnt, mine, sp = 0u;
    for (;;) {
        sum = 0u; cnt = 0u; mine = 0u;
#pragma unroll
        for (unsigned j = 0; j < 16; ++j) { const unsigned c = xb_ld(&bar[XB_XCNT(j)]); sum += c; cnt += (c > 0u) ? 1u : 0u; mine = (j == x) ? c : mine; }
        if (sum == G) break;
        __builtin_amdgcn_s_sleep(1);
        if ((++sp & 255u) == 0u) { if (xb_ld(&bar[XB_TMO])) break; if (sp > XB_SPIN_CAP) { atomicAdd(&bar[XB_TMO], 1u); break; } }
    }
    nloc = mine > 0u ? mine : 1u; nx = cnt > 0u ? cnt : 1u;
}
__device__ __forceinline__ void xcd_barrier(const XcdBarrier& b) {
    asm volatile("s_waitcnt vmcnt(0)" ::: "memory");
    __syncthreads();
    if (threadIdx.x == 0) {
        unsigned* bar = b.bar;
        __builtin_amdgcn_s_waitcnt(0);
        unsigned nloc = b.st[0], nx = b.st[1];
        if (nloc == 0u) { xcd_barrier_complete(bar, b.x, nloc, nx); b.st[0] = nloc; b.st[1] = nx; }
        const unsigned old = xb_add(&bar[XB_XSUB(b.x)], 1u);
        const unsigned gen = old / nloc;
        if (old + 1u == (gen + 1u) * nloc) {
            __builtin_amdgcn_fence(__ATOMIC_RELEASE, "agent");
            asm volatile("s_waitcnt vmcnt(0)" ::: "memory");
            const unsigned og = xb_add(&bar[XB_TOP], 1u);
            const unsigned tg = og / nx;
            if (og + 1u == (tg + 1u) * nx) xb_add(&bar[XB_TOPGEN], 1u);
            else XB_SPIN(xb_ld(&bar[XB_TOPGEN]) == tg, bar);
            __builtin_amdgcn_fence(__ATOMIC_ACQUIRE, "agent");
            xb_add(&bar[XB_XGEN(b.x)], 1u);
            asm volatile("s_waitcnt vmcnt(0)" ::: "memory");
        } else {
            XB_SPIN(xb_ld(&bar[XB_XGEN(b.x)]) == gen, bar);
            __builtin_amdgcn_fence(__ATOMIC_ACQUIRE, "agent");
            asm volatile("s_waitcnt vmcnt(0)" ::: "memory");
        }
    }
    __syncthreads();
}

__device__ __forceinline__ int tidx() { int t = threadIdx.x; asm volatile("" : "+v"(t)); return t; }
__device__ __forceinline__ int lv(int x) { asm volatile("" : "+v"(x)); return x; }
__device__ __forceinline__ char* launder(char* p) { size_t z = 0; asm volatile("" : "+s"(z)); return p + z; }

constexpr int LDSROW = 72;
template <int NA, class AL>
__device__ __forceinline__ void gc_load(const AL& al, const bf16_t* bp, size_t bstep, int k0, int kc, u32x4 (&ra)[NA], u32x4 (&rb)[4]) {
#pragma unroll
    for (int i = 0; i < NA; ++i) ra[i] = __builtin_bit_cast(u32x4, al.load(i, k0 + kc));
#pragma unroll
    for (int j = 0; j < 4; ++j) rb[j] = *(const u32x4*)(bp + j * bstep + k0);
}
template <int NA>
__device__ __forceinline__ void gc_store(bf16_t* Ab, bf16_t* Bb, int lr, int kc, const u32x4 (&ra)[NA], const u32x4 (&rb)[4]) {
#pragma unroll
    for (int i = 0; i < NA; ++i) *(u32x4*)(Ab + (lr + 32 * i) * LDSROW + kc) = ra[i];
#pragma unroll
    for (int j = 0; j < 4; ++j) *(u32x4*)(Bb + (lr + 32 * j) * LDSROW + kc) = rb[j];
}
template <int MI>
__device__ __forceinline__ void gc_compute(const bf16_t* Ac, const bf16_t* Bc, f32x4 (&acc)[MI][4]) {
#pragma unroll
    for (int kh = 0; kh < 2; ++kh) {
        bf16x8 af[MI], bfv[4];
#pragma unroll
        for (int i = 0; i < MI; ++i) af[i] = *(const bf16x8*)(Ac + i * 16 * LDSROW + kh * 32);
#pragma unroll
        for (int j = 0; j < 4; ++j) bfv[j] = *(const bf16x8*)(Bc + j * 16 * LDSROW + kh * 32);
#pragma unroll
        for (int i = 0; i < MI; ++i)
#pragma unroll
            for (int j = 0; j < 4; ++j) acc[i][j] = __builtin_amdgcn_mfma_f32_16x16x32_bf16(bfv[j], af[i], acc[i][j], 0, 0, 0);
    }
}
template <int MI, class AL>
__device__ __forceinline__ void gemm_core(const AL& al, const bf16_t* __restrict__ Bt, int ldb, int K, f32x4 (&acc)[MI][4], char* smem) {
    constexpr int TM = MI * 32;
    constexpr int NA = TM / 32;
    bf16_t* As = (bf16_t*)smem;
    bf16_t* Bs = As + 2 * TM * LDSROW;
    const int tid = tidx(), lane = tid & 63, wave = tid >> 6;
    const int wr = wave >> 1, wc = wave & 1, fr = lane & 15, fq = lane >> 4;
    const int kc = (tid & 7) * 8, lr = tid >> 3;
#pragma unroll
    for (int i = 0; i < MI; ++i)
#pragma unroll
        for (int j = 0; j < 4; ++j) acc[i][j] = (f32x4){0.f, 0.f, 0.f, 0.f};
    u32x4 a0[NA], b0[4], a1[NA], b1[4];
    const bf16_t* bp = Bt + (size_t)lr * ldb + kc;
    const size_t bstep = (size_t)32 * ldb;
    const int nk = K >> 6;
    bf16_t* As1 = As + TM * LDSROW; bf16_t* Bs1 = Bs + 128 * LDSROW;
    const int aoff = (wr * MI * 16 + fr) * LDSROW + fq * 8, boff = (wc * 64 + fr) * LDSROW + fq * 8;
    gc_load<NA>(al, bp, bstep, 0, kc, a0, b0);
    gc_store<NA>(As, Bs, lr, kc, a0, b0);
    if (nk > 1) gc_load<NA>(al, bp, bstep, 64, kc, a0, b0);
    __syncthreads();
    for (int kt = 0; kt < nk; kt += 2) {
        if (kt + 2 < nk) gc_load<NA>(al, bp, bstep, (kt + 2) << 6, kc, a1, b1);
        gc_compute<MI>(As + aoff, Bs + boff, acc);
        if (kt + 1 < nk) gc_store<NA>(As1, Bs1, lr, kc, a0, b0);
        __syncthreads();
        if (kt + 1 >= nk) break;
        if (kt + 3 < nk) gc_load<NA>(al, bp, bstep, (kt + 3) << 6, kc, a0, b0);
        gc_compute<MI>(As1 + aoff, Bs1 + boff, acc);
        if (kt + 2 < nk) gc_store<NA>(As, Bs, lr, kc, a1, b1);
        __syncthreads();
    }
}
template <int MI, class RP, class RPB>
__device__ __forceinline__ void gemm_core_gb(const RP& rp, const RPB& rpb, int K, f32x4 (&acc)[MI][4], char* smem) {
    constexpr int ABYTES = MI * 32 * 128;
    constexpr int SBYTES = ABYTES + 16384;
    const int tid = tidx(), lane = tid & 63, wave = tid >> 6;
    const int wr = wave >> 1, wc = wave & 1, fr = lane & 15, fq = lane >> 4;
    const int rr = lane >> 3, cs = ((lane & 7) ^ ((wave * 4 + (lane >> 4)) & 7)) * 8;
#pragma unroll
    for (int i = 0; i < MI; ++i)
#pragma unroll
        for (int j = 0; j < 4; ++j) acc[i][j] = (f32x4){0.f, 0.f, 0.f, 0.f};
    const bf16_t* ap[MI]; const bf16_t* bp[4];
#pragma unroll
    for (int i = 0; i < MI; ++i) { const int r = (i * 4 + wave) * 8 + rr; ap[i] = rp(r) + cs; }
#pragma unroll
    for (int i = 0; i < 4; ++i) { const int r = (i * 4 + wave) * 8 + rr; bp[i] = rpb(r) + cs; }
    const int wbase = __builtin_amdgcn_readfirstlane(wave) * 1024;
    const int nk = K >> 6;
    auto stage = [&](int buf, int kt) {
        char* Ab = smem + buf * SBYTES + wbase; char* Bb = Ab + ABYTES;
#pragma unroll
        for (int i = 0; i < MI; ++i) __builtin_amdgcn_global_load_lds((const unsigned*)(ap[i] + kt * 64), (unsigned*)(Ab + i * 4096), 16, 0, 0);
#pragma unroll
        for (int i = 0; i < 4; ++i) __builtin_amdgcn_global_load_lds((const unsigned*)(bp[i] + kt * 64), (unsigned*)(Bb + i * 4096), 16, 0, 0);
    };
    const int aoff = (wr * MI * 16 + fr) * 128, boff = ABYTES + (wc * 64 + fr) * 128, sw = fr >> 1;
    stage(0, 0);
    asm volatile("s_waitcnt vmcnt(0)" ::: "memory");
    __syncthreads();
    for (int kt = 0; kt < nk; ++kt) {
        const int cur = kt & 1;
        if (kt + 1 < nk) stage(cur ^ 1, kt + 1);
        const char* base = smem + cur * SBYTES;
#pragma unroll
        for (int kh = 0; kh < 2; ++kh) {
            const int xo = ((kh * 4 + fq) ^ sw) * 16;
            bf16x8 af[MI], bfv[4];
#pragma unroll
            for (int i = 0; i < MI; ++i) af[i] = *(const bf16x8*)(base + aoff + i * 2048 + xo);
#pragma unroll
            for (int j = 0; j < 4; ++j) bfv[j] = *(const bf16x8*)(base + boff + j * 2048 + xo);
#pragma unroll
            for (int i = 0; i < MI; ++i)
#pragma unroll
                for (int j = 0; j < 4; ++j) acc[i][j] = __builtin_amdgcn_mfma_f32_16x16x32_bf16(bfv[j], af[i], acc[i][j], 0, 0, 0);
        }
        asm volatile("s_waitcnt vmcnt(0)" ::: "memory");
        __syncthreads();
    }
}
struct RPPlain;
template <int MI, class RP>
__device__ __forceinline__ void gemm_core_g(const RP& rp, const bf16_t* __restrict__ Bt, int ldb, int K, f32x4 (&acc)[MI][4], char* smem);
struct RPPlain {
    const bf16_t* A; size_t lda;
    __device__ __forceinline__ const bf16_t* operator()(int r) const { return A + (size_t)r * lda; }
};
template <int MI, class RP>
__device__ __forceinline__ void gemm_core_g(const RP& rp, const bf16_t* __restrict__ Bt, int ldb, int K, f32x4 (&acc)[MI][4], char* smem) {
    RPPlain rpb{Bt, (size_t)ldb};
    gemm_core_gb<MI>(rp, rpb, K, acc, smem);
}
template <int MI, class F>
__device__ __forceinline__ void acc_foreach(const f32x4 (&acc)[MI][4], F f) {
    const int lane = tidx() & 63, wave = tidx() >> 6;
    const int wr = wave >> 1, wc = wave & 1, fr = lane & 15, fq = lane >> 4;
#pragma unroll
    for (int i = 0; i < MI; ++i)
#pragma unroll
        for (int j = 0; j < 4; ++j) f(wr * MI * 16 + i * 16 + fr, wc * 64 + j * 16 + fq * 4, acc[i][j]);
}
struct ALPlain {
    const bf16_t* p0; size_t step;
    __device__ __forceinline__ ALPlain(const bf16_t* A, int lda, int row0) { p0 = A + (size_t)(row0 + (tidx() >> 3)) * lda; step = (size_t)32 * lda; }
    __device__ __forceinline__ uint4 load(int i, int k) const { return *(const uint4*)(p0 + i * step + k); }
};
__device__ __forceinline__ void store_bf16x4(bf16_t* dst, const f32x4& v) { *(uint2*)dst = make_uint2(pack2(v[0], v[1]), pack2(v[2], v[3])); }

__device__ __forceinline__ void ph_pre(const Params& p, char* smem) {
    const int tid = tidx(), nb = gridDim.x, bid = blockIdx.x;
    float* mod = (float*)(p.ws + O_MOD);
    {
        float* sv = (float*)smem;
        float* part = sv + 5 * 1024;
        for (int i = tid; i < 5 * 1024; i += 256) { const float v = (i < 4096) ? p.in[I_C][i] : p.in[I_CCTX][i - 4096]; sv[i] = siluf_(v); }
        __syncthreads();
        for (int it = bid; it < NLAYER * 96; it += nb) {
            const int l = it / 96, jb = it % 96;
            const int jj = tid & 63, kq = tid >> 6, j = jb * 64 + jj;
            const float* w = p.in[I_WADA] + (size_t)l * 1024 * 6144 + (size_t)(kq * 256) * 6144 + j;
            float a0 = 0.f, a1 = 0.f, a2 = 0.f, a3 = 0.f, a4 = 0.f;
#pragma unroll 8
            for (int k = 0; k < 256; ++k) {
                const float wv = w[(size_t)k * 6144]; const int kk = kq * 256 + k;
                a0 += sv[kk] * wv; a1 += sv[1024 + kk] * wv; a2 += sv[2048 + kk] * wv; a3 += sv[3072 + kk] * wv; a4 += sv[4096 + kk] * wv;
            }
            part[(kq * 5 + 0) * 64 + jj] = a0; part[(kq * 5 + 1) * 64 + jj] = a1; part[(kq * 5 + 2) * 64 + jj] = a2;
            part[(kq * 5 + 3) * 64 + jj] = a3; part[(kq * 5 + 4) * 64 + jj] = a4;
            __syncthreads();
            for (int o = tid; o < 320; o += 256) {
                const int i = o >> 6, c = o & 63;
                const float s = part[(0 * 5 + i) * 64 + c] + part[(1 * 5 + i) * 64 + c] + part[(2 * 5 + i) * 64 + c] + part[(3 * 5 + i) * 64 + c];
                mod[(size_t)(l * 5 + i) * 6144 + jb * 64 + c] = s + p.in[I_BADA][l * 6144 + jb * 64 + c];
            }
            __syncthreads();
        }
    }
    {
        float4* xc = (float4*)(p.ws + O_XCUR);
        const float4* x4 = (const float4*)p.in[I_X]; const float4* c4 = (const float4*)p.in[I_CTX];
        for (size_t i = (size_t)bid * 256 + tid; i < (size_t)RT * 256; i += (size_t)nb * 256) xc[i] = (i < (size_t)RL * 256) ? x4[i] : c4[i - (size_t)RL * 256];
    }
    {
        float* ct = (float*)smem;
        __syncthreads();
        for (int m = tid; m < 4096; m += 256) ct[m] = cospif((float)m * (1.f / 2048.f));
        __syncthreads();
        bf16_t* cst2 = (bf16_t*)(p.ws + O_CST256);
        for (int ch = bid * 256 + tid; ch < 256 * 512 / 8; ch += nb * 256) {
            const int ks = ch >> 6, c0 = (ch & 63) * 8, part = c0 >> 8, s0 = c0 & 255;
            float f[8];
#pragma unroll
            for (int e = 0; e < 8; ++e) { const int m = (16 * ks * (s0 + e)) & 4095; f[e] = part == 0 ? ct[m] : ct[(m - 1024) & 4095]; }
            *(uint4*)(cst2 + ch * 8) = pack8(f);
        }
        bf16_t* d128 = (bf16_t*)(p.ws + O_D128);
        for (int ch = bid * 256 + tid; ch < 128 * 128 / 8; ch += nb * 256) {
            const int mrow = ch >> 4, c0 = (ch & 15) * 8, po = mrow >> 6, k1 = mrow & 63, pi = c0 >> 6, t10 = c0 & 63;
            float f[8];
#pragma unroll
            for (int e = 0; e < 8; ++e) {
                const int m = (64 * k1 * (t10 + e)) & 4095; const float cv = ct[m], sv = ct[(m - 1024) & 4095];
                f[e] = (po == pi) ? cv : (po == 0 ? sv : -sv);
            }
            *(uint4*)(d128 + ch * 8) = pack8(f);
        }
        bf16_t* e64 = (bf16_t*)(p.ws + O_E64);
        for (int ch = bid * 256 + tid; ch < 64 * 128 / 8; ch += nb * 256) {
            const int k2 = ch >> 4, c0 = (ch & 15) * 8, po = c0 >> 6, t20 = c0 & 63;
            float f[8];
#pragma unroll
            for (int e = 0; e < 8; ++e) { const int m = (64 * k2 * (t20 + e)) & 4095; f[e] = po == 0 ? ct[m] : ct[(m - 1024) & 4095]; }
            *(uint4*)(e64 + ch * 8) = pack8(f);
        }
        float* twc = (float*)(p.ws + O_TWC); float* tws = (float*)(p.ws + O_TWS);
        for (int i = bid * 256 + tid; i < 64 * 64; i += nb * 256) {
            const int k1 = i >> 6, t2 = i & 63, m = (k1 * t2) & 4095;
            twc[i] = ct[m]; tws[i] = -ct[(m - 1024) & 4095];
        }
        bf16_t* csc = (bf16_t*)(p.ws + O_CSC);
        for (int ch = bid * 256 + tid; ch < 256 * 128 / 8; ch += nb * 256) {
            const int n = ch >> 4, c0 = (ch & 15) * 8, part = n >> 7, kc = n & 127;
            float f[8];
#pragma unroll
            for (int e = 0; e < 8; ++e) { const int m = (32 * kc * (c0 + e)) & 4095; f[e] = part == 0 ? ct[m] : -ct[(m - 1024) & 4095]; }
            *(uint4*)(csc + ch * 8) = pack8(f);
        }
        float* rc = (float*)(p.ws + O_ROPEC); float* rs = (float*)(p.ws + O_ROPES);
        for (int i = bid * 256 + tid; i < SEQ * 16; i += nb * 256) {
            const int t = i >> 4, ax = (i >> 3) & 1, f = i & 7;
            const float inv = powf(10000.f, -(float)f / 8.f);
            const float pos = (float)(ax == 0 ? (t >> 6) : (t & 63));
            const float ang = pos * inv;
            rc[i] = cosf(ang); rs[i] = sinf(ang);
        }
    }
}

struct ConvTask { const float* src; const float* scale; bf16_t* dst; int K, Nsrc, Ndst, rmul; size_t sbs, dbs; };
__constant__ int c_conv_cum[17] = {0, 1536, 1608, 1672, 1688, 1704, 1720, 1848, 1976, 2104, 2360, 4408, 6456, 8504, 8632, 8760, 8888};
__device__ __forceinline__ ConvTask conv_task(const Params& p, int l, int t) {
    bf16_t* wb = (bf16_t*)(p.ws + O_WB);
    ConvTask c; c.scale = nullptr; c.sbs = 0; c.dbs = 0; c.rmul = 64;
    switch (t) {
    case 0:  c.src = p.in[I_WIN] + (size_t)l * 1024 * 6048; c.K = 1024; c.Nsrc = 6048; c.Ndst = 6144; c.dst = wb + W_IN / 2; break;
    case 1:  c.src = p.in[I_WUQ] + (size_t)l * 384 * 768; c.K = 384; c.Nsrc = 768; c.Ndst = 768; c.dst = wb + W_UQ / 2; c.scale = p.in[I_QNG] + l * 384; break;
    case 2:  c.src = p.in[I_WUKV] + (size_t)l * 256 * 1024; c.K = 256; c.Nsrc = 1024; c.Ndst = 1024; c.dst = wb + W_UKV / 2; c.scale = p.in[I_KVNG] + l * 256; break;
    case 3:  c.src = p.in[I_WUP] + (size_t)l * 2 * 64 * 512; c.K = 64; c.Nsrc = 512; c.Ndst = 512; c.dst = wb + W_WUP / 2; c.sbs = 64 * 512; c.dbs = 512 * 64; break;
    case 4:  c.src = p.in[I_AUP] + (size_t)l * 2 * 64 * 512; c.K = 64; c.Nsrc = 512; c.Ndst = 512; c.dst = wb + W_AUP / 2; c.sbs = 64 * 512; c.dbs = 512 * 64; break;
    case 5:  c.src = p.in[I_GUP] + (size_t)l * 128 * 512; c.K = 128; c.Nsrc = 512; c.Ndst = 512; c.dst = wb + W_GUP / 2; break;
    case 6:  c.src = p.in[I_WPA] + (size_t)l * 512 * 1024; c.K = 512; c.Nsrc = 1024; c.Ndst = 1024; c.dst = wb + W_PA / 2; break;
    case 7:  c.src = p.in[I_WPB] + (size_t)l * 512 * 1024; c.K = 512; c.Nsrc = 1024; c.Ndst = 1024; c.dst = wb + W_PB / 2; break;
    case 8:  c.src = p.in[I_WPC] + (size_t)l * 512 * 1024; c.K = 512; c.Nsrc = 1024; c.Ndst = 1024; c.dst = wb + W_PC / 2; break;
    case 9:  c.src = p.in[I_WOUT] + (size_t)l * 1024 * 1024; c.K = 1024; c.Nsrc = 1024; c.Ndst = 1024; c.dst = wb + W_OUT / 2; break;
    case 10: c.src = p.in[I_EG] + (size_t)l * 16 * 1024 * 512; c.K = 1024; c.Nsrc = 512; c.Ndst = 512; c.dst = wb + W_GU / 2; c.sbs = 1024 * 512; c.dbs = 1024 * 1024; c.rmul = 128; break;
    case 11: c.src = p.in[I_EU] + (size_t)l * 16 * 1024 * 512; c.K = 1024; c.Nsrc = 512; c.Ndst = 512; c.dst = wb + W_GU / 2 + 64 * 1024; c.sbs = 1024 * 512; c.dbs = 1024 * 1024; c.rmul = 128; break;
    case 12: c.src = p.in[I_ED] + (size_t)l * 16 * 512 * 1024; c.K = 512; c.Nsrc = 1024; c.Ndst = 1024; c.dst = wb + W_D / 2; c.sbs = 512 * 1024; c.dbs = 1024 * 512; break;
    case 13: c.src = p.in[I_SG] + (size_t)l * 1024 * 512; c.K = 1024; c.Nsrc = 512; c.Ndst = 512; c.dst = wb + W_GU / 2 + (size_t)16 * 1024 * 1024; c.rmul = 128; break;
    case 14: c.src = p.in[I_SU] + (size_t)l * 1024 * 512; c.K = 1024; c.Nsrc = 512; c.Ndst = 512; c.dst = wb + W_GU / 2 + (size_t)16 * 1024 * 1024 + 64 * 1024; c.rmul = 128; break;
    default: c.src = p.in[I_SD] + (size_t)l * 512 * 1024; c.K = 512; c.Nsrc = 1024; c.Ndst = 1024; c.dst = wb + W_D / 2 + (size_t)16 * 1024 * 512; break;
    }
    return c;
}
__device__ __forceinline__ void ph_w(const Params& p, int l, char* smem) {
    const int tid = tidx();
    float* tl = (float*)smem;
    for (int g = blockIdx.x; g < 8888; g += gridDim.x) {
        int t = 0;
        while (g >= c_conv_cum[t + 1]) ++t;
        const ConvTask c = conv_task(p, l, t);
        int r = g - c_conv_cum[t];
        const int nkt = c.K >> 6, nnt = c.Ndst >> 6;
        const int bi = r / (nkt * nnt); r -= bi * nkt * nnt;
        const int k0 = (r / nnt) * 64, n0 = (r % nnt) * 64;
        const float* src = c.src + bi * c.sbs; bf16_t* dst = c.dst + bi * c.dbs;
#pragma unroll
        for (int i = 0; i < 4; ++i) {
            const int k = (tid >> 4) + 16 * i, n = n0 + (tid & 15) * 4;
            float4 v = make_float4(0.f, 0.f, 0.f, 0.f);
            if (n < c.Nsrc) v = *(const float4*)(src + (size_t)(k0 + k) * c.Nsrc + n);
            if (c.scale) { const float s = c.scale[k0 + k]; v.x *= s; v.y *= s; v.z *= s; v.w *= s; }
            float* d = tl + k * 65 + (tid & 15) * 4;
            d[0] = v.x; d[1] = v.y; d[2] = v.z; d[3] = v.w;
        }
        __syncthreads();
        {
            const int n = tid >> 2, kk0 = (tid & 3) * 16;
            float f[8], g2[8];
#pragma unroll
            for (int j = 0; j < 8; ++j) { f[j] = tl[(kk0 + j) * 65 + n]; g2[j] = tl[(kk0 + 8 + j) * 65 + n]; }
            bf16_t* d = dst + (size_t)((n0 >> 6) * c.rmul + n) * c.K + k0 + kk0;
            *(uint4*)d = pack8(f); *(uint4*)(d + 8) = pack8(g2);
        }
        __syncthreads();
    }
}

__device__ __forceinline__ void ph_n1(const Params& p, int l) {
    const int lane = tidx() & 63, wave = tidx() >> 6;
    const float* xcur = (const float*)(p.ws + O_XCUR); const float* mod = (const float*)(p.ws + O_MOD);
    bf16_t* H = (bf16_t*)(p.ws + O_H);
    if (blockIdx.x == 0 && tidx() < 64) ((unsigned*)(p.ws + O_CNT))[tidx()] = 0u;
    const float* g = p.in[I_N1G] + l * 1024;
    for (int row = blockIdx.x * 4 + wave; row < RT; row += gridDim.x * 4) {
        const float* x = xcur + (size_t)row * 1024; const float* md = mod + (size_t)(l * 5 + modidx(row)) * 6144;
        float4 v[4]; float ss = 0.f;
#pragma unroll
        for (int i = 0; i < 4; ++i) { v[i] = *(const float4*)(x + lane * 4 + 256 * i); ss += v[i].x * v[i].x + v[i].y * v[i].y + v[i].z * v[i].z + v[i].w * v[i].w; }
        ss = wsum(ss);
        const float rstd = rsqrtf(ss * (1.f / 1024.f) + 1e-6f);
#pragma unroll
        for (int i = 0; i < 4; ++i) {
            const int c = lane * 4 + 256 * i;
            const float4 gg = *(const float4*)(g + c), sc = *(const float4*)(md + 1024 + c), sh = *(const float4*)(md + c);
            f32x4 h = {v[i].x * rstd * gg.x * (1.f + sc.x) + sh.x, v[i].y * rstd * gg.y * (1.f + sc.y) + sh.y,
                       v[i].z * rstd * gg.z * (1.f + sc.z) + sh.z, v[i].w * rstd * gg.w * (1.f + sc.w) + sh.w};
            store_bf16x4(H + (size_t)row * 1024 + c, h);
        }
    }
}

__device__ __forceinline__ void ph_g1(const Params& p, char* smem) {
    const bf16_t* H = (const bf16_t*)(p.ws + O_H); const bf16_t* W = (const bf16_t*)(p.ws + O_WB + W_IN);
    bf16_t* P = (bf16_t*)(p.ws + O_P);
    for (int it = blockIdx.x; it < 136 * 48; it += gridDim.x) {
        const int mt = it / 48, nt = it % 48;
        f32x4 acc[4][4];
        RPPlain rp{H + (size_t)mt * 128 * 1024, 1024};
        gemm_core_g<4>(rp, W + (size_t)nt * 128 * 1024, 1024, 1024, acc, smem);
        acc_foreach<4>(acc, [&](int m, int n, const f32x4& v) {
            const int col = nt * 128 + n; f32x4 o = v;
            if (col >= PG0 && col < PEND) { o[0] = sigmoidf_(v[0]); o[1] = sigmoidf_(v[1]); o[2] = sigmoidf_(v[2]); o[3] = sigmoidf_(v[3]); }
            store_bf16x4(P + (size_t)(mt * 128 + m) * LDP + col, o);
        });
    }
}

__device__ __forceinline__ void ph_qu(const Params& p, char* smem) {
    const bf16_t* P = (const bf16_t*)(p.ws + O_P);
    bf16_t* QR = (bf16_t*)(p.ws + O_X + X_QRAW); bf16_t* KVR = (bf16_t*)(p.ws + O_X + X_KVRAW);
    for (int it = blockIdx.x; it < 136 * 14; it += gridDim.x) {
        const int mt = it / 14, nn = it % 14;
        f32x4 acc[4][4];
        if (nn < 6) {
            RPPlain rp{P + (size_t)mt * 128 * LDP + PQ0, LDP};
            gemm_core_g<4>(rp, (const bf16_t*)(p.ws + O_WB + W_UQ) + (size_t)nn * 128 * 384, 384, 384, acc, smem);
            acc_foreach<4>(acc, [&](int m, int n, const f32x4& v) { store_bf16x4(QR + (size_t)(mt * 128 + m) * 768 + nn * 128 + n, v); });
        } else {
            const int nt = nn - 6;
            RPPlain rp{P + (size_t)mt * 128 * LDP + PKV0, LDP};
            gemm_core_g<4>(rp, (const bf16_t*)(p.ws + O_WB + W_UKV) + (size_t)nt * 128 * 256, 256, 256, acc, smem);
            acc_foreach<4>(acc, [&](int m, int n, const f32x4& v) { store_bf16x4(KVR + (size_t)(mt * 128 + m) * 1024 + nt * 128 + n, v); });
        }
    }
}

constexpr float QSCALE = 0.10206207261596575f * 1.4426950408889634f;
__device__ __forceinline__ void ph_m2(const Params& p, char* smem) {
    const int tid = tidx(), lane = tid & 63, wave = tid >> 6;
    const bf16_t* P = (const bf16_t*)(p.ws + O_P);
    const bf16_t* QR = (const bf16_t*)(p.ws + O_X + X_QRAW); const bf16_t* KVR = (const bf16_t*)(p.ws + O_X + X_KVRAW);
    bf16_t* QA = (bf16_t*)(p.ws + O_X + X_QA); bf16_t* KA = (bf16_t*)(p.ws + O_X + X_KA); bf16_t* VA = (bf16_t*)(p.ws + O_X + X_VA);
    const float* rc = (const float*)(p.ws + O_ROPEC); const float* rs = (const float*)(p.ws + O_ROPES);
    for (int row = blockIdx.x * 4 + wave; row < RT; row += gridDim.x * 4) {
        const bool lat = row < RL;
        const int b = lat ? (row >> 12) : ((row - RL) >> 8), t = lat ? (row & 4095) : ((row - RL) & 255);
        const size_t keyrow = (size_t)b * KEYS + (lat ? t : SEQ + t);
        const bf16_t* pr = P + (size_t)row * LDP;
        float sq = 0.f, sk = 0.f;
#pragma unroll
        for (int i = 0; i < 6; ++i) { const float v = bf2f(pr[PQ0 + lane + 64 * i]); sq += v * v; }
#pragma unroll
        for (int i = 0; i < 4; ++i) { const float v = bf2f(pr[PKV0 + lane + 64 * i]); sk += v * v; }
        sq = wsum(sq); sk = wsum(sk);
        const float rq = rsqrtf(sq * (1.f / 384.f) + 1e-6f), rkv = rsqrtf(sk * (1.f / 256.f) + 1e-6f);
        const bf16_t* qr = QR + (size_t)row * 768; const bf16_t* kvr = KVR + (size_t)row * 1024;
        const float* rct = rc + t * 16; const float* rst = rs + t * 16;
#pragma unroll
        for (int i = 0; i < 12; ++i) {
            const int e = lane + 64 * i, h = e / 96, dd = e - h * 96;
            float xq = bf2f(qr[e]) * rq, xk;
            if (dd < 64) xk = bf2f(kvr[h * 128 + dd]) * rkv;
            else {
                const int ii = dd - 64;
                xk = bf2f(pr[PKR0 + ii]);
                if (lat) {
                    const int ax = ii >> 4, half = (ii >> 3) & 1, f = ii & 7;
                    const float c = rct[ax * 8 + f], sn = rst[ax * 8 + f];
                    const float xqp = bf2f(qr[half ? e - 8 : e + 8]) * rq, xkp = bf2f(pr[PKR0 + (ii ^ 8)]);
                    xq = half ? (xq * c + xqp * sn) : (xq * c - xqp * sn);
                    xk = half ? (xk * c + xkp * sn) : (xk * c - xkp * sn);
                }
            }
            QA[(size_t)row * 768 + e] = f2bf(xq * QSCALE);
            KA[keyrow * 768 + e] = f2bf(xk);
        }
    }
    bf16_t* vt = (bf16_t*)smem;
    float* rk = (float*)(smem + 64 * 72 * 2);
    for (int it = blockIdx.x; it < (RT / 64) * 8; it += gridDim.x) {
        const int g = it >> 3, h = it & 7, rowg = g * 64;
        const bool lat = rowg < RL;
        const int b = lat ? (rowg >> 12) : ((rowg - RL) >> 8), t0 = lat ? (rowg & 4095) : ((rowg - RL) & 255);
        const size_t key0 = lat ? t0 : SEQ + t0;
#pragma unroll 4
        for (int rr = 0; rr < 16; ++rr) {
            const int lr = wave * 16 + rr;
            const bf16_t* pr = P + (size_t)(rowg + lr) * LDP + PKV0;
            const uint2 u = *(const uint2*)(pr + lane * 4);
            float sk = bflo(u.x) * bflo(u.x) + bfhi(u.x) * bfhi(u.x) + bflo(u.y) * bflo(u.y) + bfhi(u.y) * bfhi(u.y);
            sk = wsum(sk);
            if (lane == 0) rk[lr] = rsqrtf(sk * (1.f / 256.f) + 1e-6f);
        }
        __syncthreads();
#pragma unroll
        for (int i = 0; i < 2; ++i) {
            const int c = tid + 256 * i, lr = c >> 3, part = c & 7;
            float f[8]; unpack8(*(const uint4*)(KVR + (size_t)(rowg + lr) * 1024 + h * 128 + 64 + part * 8), f);
            const float sc = rk[lr];
#pragma unroll
            for (int e = 0; e < 8; ++e) f[e] *= sc;
            *(uint4*)(vt + lr * 72 + part * 8) = pack8(f);
        }
        __syncthreads();
#pragma unroll
        for (int i = 0; i < 2; ++i) {
            const int c = tid + 256 * i, dd = c >> 3, kc = c & 7;
            float f[8];
#pragma unroll
            for (int e = 0; e < 8; ++e) f[e] = bf2f(vt[(kc * 8 + e) * 72 + dd]);
            *(uint4*)(VA + ((size_t)(b * 8 + h) * 64 + dd) * KEYS + key0 + kc * 8) = pack8(f);
        }
        __syncthreads();
    }
}
__device__ __forceinline__ float xmax_16_32(float v) {
    unsigned u = __builtin_bit_cast(unsigned, v);
    auto r = __builtin_amdgcn_permlane32_swap(u, u, false, false);
    float m = fmaxf(__builtin_bit_cast(float, r[0]), __builtin_bit_cast(float, r[1]));
    u = __builtin_bit_cast(unsigned, m);
    auto r2 = __builtin_amdgcn_permlane16_swap(u, u, false, false);
    return fmaxf(__builtin_bit_cast(float, r2[0]), __builtin_bit_cast(float, r2[1]));
}
__device__ __forceinline__ float xsum_16_32(float v) {
    unsigned u = __builtin_bit_cast(unsigned, v);
    auto r = __builtin_amdgcn_permlane32_swap(u, u, false, false);
    float m = __builtin_bit_cast(float, r[0]) + __builtin_bit_cast(float, r[1]);
    u = __builtin_bit_cast(unsigned, m);
    auto r2 = __builtin_amdgcn_permlane16_swap(u, u, false, false);
    return __builtin_bit_cast(float, r2[0]) + __builtin_bit_cast(float, r2[1]);
}
constexpr int KS_LD = 104, VT_LD = 72;
constexpr int AT_BUF = 64 * KS_LD * 2 + 64 * VT_LD * 2;
__device__ __forceinline__ void ph_at(const Params& p, int l, char* smem) {
    const int tid = tidx(), lane = tid & 63, wave = tid >> 6, fr = lane & 15, fq = lane >> 4;
    const bf16_t* QA = (const bf16_t*)(p.ws + O_X + X_QA); const bf16_t* KA = (const bf16_t*)(p.ws + O_X + X_KA); const bf16_t* VA = (const bf16_t*)(p.ws + O_X + X_VA);
    bf16_t* ATT = (bf16_t*)(p.ws + O_ATT);
    const int nitems = 1024 + (l < NLAYER - 1 ? 64 : 0);
    for (int it0 = blockIdx.x; it0 < nitems; it0 += gridDim.x) {
        int it = it0;
        if (gridDim.x == 512 && it0 < 1024) {
            const int x = it0 & 7, j = (it0 >> 3) & 63, rd = it0 >> 9;
            it = ((x * 4 + rd * 2 + (j >> 5)) << 5) | (j & 31);
        }
        int b, h, row0, ntile; size_t krow0;
        if (it < 1024) { b = it >> 8; h = (it >> 5) & 7; row0 = b * SEQ + (it & 31) * 128; krow0 = (size_t)b * KEYS; ntile = KEYS / 64; }
        else { const int j = it - 1024; b = j >> 4; h = (j >> 1) & 7; row0 = RL + b * CTX + (j & 1) * 128; krow0 = (size_t)b * KEYS + SEQ; ntile = CTX / 64; }
        const int qrow = row0 + wave * 32 + fr;
        const size_t vrow0 = (size_t)(b * 8 + h) * 64; const int koff0 = (int)(krow0 - (size_t)b * KEYS);
        bf16x8 qf[2][3];
#pragma unroll
        for (int t = 0; t < 2; ++t)
#pragma unroll
            for (int ks = 0; ks < 3; ++ks) qf[t][ks] = *(const bf16x8*)(QA + (size_t)(qrow + 16 * t) * 768 + h * 96 + ks * 32 + fq * 8);
        f32x4 ot[2][4];
#pragma unroll
        for (int t = 0; t < 2; ++t)
#pragma unroll
            for (int i = 0; i < 4; ++i) ot[t][i] = (f32x4){0.f, 0.f, 0.f, 0.f};
        float m_run[2] = {-1e30f, -1e30f}, l_run[2] = {0.f, 0.f};
        uint4 rk0, rk1, rk2, rv0, rv1;
#define AT_GLOAD(KT) do { const size_t kr_ = krow0 + (size_t)(KT) * 64; \
            { const int c = tid, key = c / 12, part = c % 12; rk0 = *(const uint4*)(KA + (kr_ + key) * 768 + h * 96 + part * 8); } \
            { const int c = tid + 256, key = c / 12, part = c % 12; rk1 = *(const uint4*)(KA + (kr_ + key) * 768 + h * 96 + part * 8); } \
            { const int c = tid + 512, key = c / 12, part = c % 12; rk2 = *(const uint4*)(KA + (kr_ + key) * 768 + h * 96 + part * 8); } \
            { const int c = tid, dd_ = c >> 3, part = c & 7; rv0 = *(const uint4*)(VA + (vrow0 + dd_) * KEYS + koff0 + (KT) * 64 + part * 8); } \
            { const int c = tid + 256, dd_ = c >> 3, part = c & 7; rv1 = *(const uint4*)(VA + (vrow0 + dd_) * KEYS + koff0 + (KT) * 64 + part * 8); } } while (0)
#define AT_VSTORE(RV, C) do { const int dd_ = (C) >> 3, part = (C) & 7; *(uint4*)(Vt_ + dd_ * VT_LD + part * 8) = RV; } while (0)
#define AT_SSTORE(BUF) do { bf16_t* Ks_ = (bf16_t*)(smem + (BUF) * AT_BUF); bf16_t* Vt_ = Ks_ + 64 * KS_LD; \
            { const int c = tid, key = c / 12, part = c % 12; *(uint4*)(Ks_ + key * KS_LD + part * 8) = rk0; } \
            { const int c = tid + 256, key = c / 12, part = c % 12; *(uint4*)(Ks_ + key * KS_LD + part * 8) = rk1; } \
            { const int c = tid + 512, key = c / 12, part = c % 12; *(uint4*)(Ks_ + key * KS_LD + part * 8) = rk2; } \
            AT_VSTORE(rv0, tid); AT_VSTORE(rv1, tid + 256); } while (0)
        AT_GLOAD(0); AT_SSTORE(0);
        __syncthreads();
        for (int kt = 0; kt < ntile; ++kt) {
            const int cur = kt & 1;
            if (kt + 1 < ntile) AT_GLOAD(kt + 1);
            const bf16_t* Ks = (const bf16_t*)(smem + cur * AT_BUF); const bf16_t* Vt = Ks + 64 * KS_LD;
            bf16x8 kf[4][3];
#pragma unroll
            for (int j = 0; j < 4; ++j)
#pragma unroll
                for (int ks = 0; ks < 3; ++ks) kf[j][ks] = *(const bf16x8*)(Ks + (j * 16 + fr) * KS_LD + ks * 32 + fq * 8);
            f32x4 st[2][4];
#pragma unroll
            for (int j = 0; j < 4; ++j) {
                st[0][j] = (f32x4){0.f, 0.f, 0.f, 0.f}; st[1][j] = (f32x4){0.f, 0.f, 0.f, 0.f};
#pragma unroll
                for (int ks = 0; ks < 3; ++ks) {
                    st[0][j] = __builtin_amdgcn_mfma_f32_16x16x32_bf16(kf[j][ks], qf[0][ks], st[0][j], 0, 0, 0);
                    st[1][j] = __builtin_amdgcn_mfma_f32_16x16x32_bf16(kf[j][ks], qf[1][ks], st[1][j], 0, 0, 0);
                }
            }
            bf16x8 vf[2][4];
#pragma unroll
            for (int k2 = 0; k2 < 2; ++k2)
#pragma unroll
                for (int dt = 0; dt < 4; ++dt) {
                    const bf16_t* vp = Vt + (dt * 16 + fr) * VT_LD + k2 * 32 + fq * 4;
                    const uint2 v0 = *(const uint2*)vp, v1 = *(const uint2*)(vp + 16);
                    vf[k2][dt] = __builtin_bit_cast(bf16x8, make_uint4(v0.x, v0.y, v1.x, v1.y));
                }
            uint4 pu[2][2];
#pragma unroll
            for (int t = 0; t < 2; ++t) {
                float mx = st[t][0][0];
#pragma unroll
                for (int j = 0; j < 4; ++j)
#pragma unroll
                    for (int r = 0; r < 4; ++r) mx = fmaxf(mx, st[t][j][r]);
                if (__any(mx > m_run[t] + 6.f)) {
                    mx = xmax_16_32(mx);
                    const float m_new = fmaxf(m_run[t], mx);
                    const float alpha = __builtin_amdgcn_exp2f(m_run[t] - m_new);
                    m_run[t] = m_new;
                    l_run[t] *= alpha;
#pragma unroll
                    for (int i = 0; i < 4; ++i) ot[t][i] *= alpha;
                }
                const float mr = m_run[t];
                float ps = 0.f;
#pragma unroll
                for (int j = 0; j < 4; ++j)
#pragma unroll
                    for (int r = 0; r < 4; ++r) { st[t][j][r] = __builtin_amdgcn_exp2f(st[t][j][r] - mr); ps += st[t][j][r]; }
                l_run[t] += ps;
#pragma unroll
                for (int k2 = 0; k2 < 2; ++k2)
                    pu[t][k2] = make_uint4(pack2(st[t][2 * k2][0], st[t][2 * k2][1]), pack2(st[t][2 * k2][2], st[t][2 * k2][3]),
                                           pack2(st[t][2 * k2 + 1][0], st[t][2 * k2 + 1][1]), pack2(st[t][2 * k2 + 1][2], st[t][2 * k2 + 1][3]));
            }
#pragma unroll
            for (int k2 = 0; k2 < 2; ++k2) {
                const bf16x8 pb0 = __builtin_bit_cast(bf16x8, pu[0][k2]), pb1 = __builtin_bit_cast(bf16x8, pu[1][k2]);
#pragma unroll
                for (int dt = 0; dt < 4; ++dt) {
                    ot[0][dt] = __builtin_amdgcn_mfma_f32_16x16x32_bf16(vf[k2][dt], pb0, ot[0][dt], 0, 0, 0);
                    ot[1][dt] = __builtin_amdgcn_mfma_f32_16x16x32_bf16(vf[k2][dt], pb1, ot[1][dt], 0, 0, 0);
                }
            }
            if (kt + 1 < ntile) AT_SSTORE(cur ^ 1);
            __syncthreads();
        }
#pragma unroll
        for (int t = 0; t < 2; ++t) {
            const float inv = 1.f / xsum_16_32(l_run[t]);
#pragma unroll
            for (int dt = 0; dt < 4; ++dt) { f32x4 o = ot[t][dt] * inv; store_bf16x4(ATT + (size_t)(qrow + 16 * t) * 512 + h * 64 + dt * 16 + fq * 4, o); }
        }
    }
}

__device__ __forceinline__ void row_edges(int row, bool& first, bool& last) {
    if (row < RL) { const int t = row & 4095; first = t == 0; last = t == 4095; }
    else { const int s = (row - RL) & 255; first = s == 0; last = s == 255; }
}
__device__ __forceinline__ float xs1(const bf16_t* P, const float* mu, int row, int col) {
    bool first, last; row_edges(row, first, last);
    const bf16_t* pc = P + (size_t)row * LDP + PR0 + col;
    const float c = bf2f(*pc), pv0 = bf2f(*(first ? pc : pc - LDP)), nx0 = bf2f(*(last ? pc : pc + LDP));
    const float pv = first ? 0.f : pv0, nx = last ? 0.f : nx0;
    return c + (0.5f * (pv + nx) - c) * mu[col];
}
__device__ __forceinline__ void xs8(const bf16_t* P, const float* mu, int row, int col, float (&o)[8]) {
    bool first, last; row_edges(row, first, last);
    const bf16_t* pc = P + (size_t)row * LDP + PR0 + col;
    const uint4 uc = *(const uint4*)pc, up = *(const uint4*)(first ? pc : pc - LDP), un = *(const uint4*)(last ? pc : pc + LDP);
    float c[8], pv[8], nx[8]; unpack8(uc, c); unpack8(up, pv); unpack8(un, nx);
    const float fp = first ? 0.f : 0.5f, fn = last ? 0.f : 0.5f;
    const float4 m0 = *(const float4*)(mu + col), m1 = *(const float4*)(mu + col + 4);
    const float m[8] = {m0.x, m0.y, m0.z, m0.w, m1.x, m1.y, m1.z, m1.w};
#pragma unroll
    for (int j = 0; j < 8; ++j) o[j] = c[j] + ((fp * pv[j] + fn * nx[j]) - c[j]) * m[j];
}
struct ALRw {
    const bf16_t* P; const float* mu; int row0; int colbase, mode;
    __device__ __forceinline__ ALRw(const bf16_t* P_, const float* mu_, int row0_, int colbase_, int mode_) : P(P_), mu(mu_), colbase(colbase_), mode(mode_) {
        row0 = row0_ + (tidx() >> 3);
    }
    __device__ __forceinline__ uint4 load(int i, int k) const {
        float o[8]; xs8(P, mu, row0 + 32 * i, colbase + k, o);
        if (mode == 0) {
#pragma unroll
            for (int j = 0; j < 8; ++j) o[j] = tanhf(o[j]);
        } else if (mode == 2) {
#pragma unroll
            for (int j = 0; j < 8; ++j) o[j] = sigmoidf_(o[j]);
        }
        return pack8(o);
    }
};
__device__ __forceinline__ void ph_rp1(const Params& p, int l, char* smem) {
    const bf16_t* P = (const bf16_t*)(p.ws + O_P); const float* mu = p.in[I_MU] + l * 1792;
    bf16_t* RG = (bf16_t*)(p.ws + O_RG);
    for (int it = blockIdx.x; it < 1088; it += gridDim.x) {
        const int mt = it >> 2, nt = it & 3;
        f32x4 acc[2][4];
        ALRw al(P, mu, mt * 64, 1664, 2);
        gemm_core<2>(al, (const bf16_t*)(p.ws + O_WB + W_GUP) + (size_t)nt * 128 * 128, 128, 128, acc, smem);
        acc_foreach<2>(acc, [&](int m, int n, const f32x4& v) { store_bf16x4(RG + (size_t)(mt * 64 + m) * 512 + nt * 128 + n, v); });
    }
}
__device__ __forceinline__ void ph_rp2(const Params& p, int l) {
    const int lane = tidx() & 63, wave = tidx() >> 6;
    const bf16_t* P = (const bf16_t*)(p.ws + O_P); const float* mu = p.in[I_MU] + l * 1792; const float* kkw = p.in[I_KK] + l * 512;
    float* KKN = (float*)(p.ws + O_X + X_KKN);
    for (int row = blockIdx.x * 4 + wave; row < RT; row += gridDim.x * 4) {
        float k8[8]; xs8(P, mu, row, 512 + lane * 8, k8);
        float s = 0.f;
#pragma unroll
        for (int j = 0; j < 8; ++j) { const float v = k8[j] * kkw[lane * 8 + j]; s += v * v; }
        s += __shfl_xor(s, 1); s += __shfl_xor(s, 2); s += __shfl_xor(s, 4);
        if ((lane & 7) == 0) KKN[(size_t)row * 8 + (lane >> 3)] = rsqrtf(s + 1e-12f);
    }
}

__device__ __forceinline__ int scan_row(int b, int d, int n) {
    if (n < CTX) return RL + b * CTX + (d == 0 ? n : CTX - 1 - n);
    const int t = n - CTX; return b * SEQ + (d == 0 ? t : SEQ - 1 - t);
}
constexpr int SL = 72;
constexpr int SLOT_E = 64 * SL;
template <int LDA, int LDB>
__device__ __forceinline__ void mm64(const bf16_t* A, const bf16_t* B, f32x4 (&acc)[4], int wave, int fr, int fq) {
#pragma unroll
    for (int ks = 0; ks < 2; ++ks) {
        const bf16x8 af = *(const bf16x8*)(A + (wave * 16 + fr) * LDA + ks * 32 + fq * 8);
#pragma unroll
        for (int nt = 0; nt < 4; ++nt) {
            const bf16x8 bfv = *(const bf16x8*)(B + (nt * 16 + fr) * LDB + ks * 32 + fq * 8);
            acc[nt] = __builtin_amdgcn_mfma_f32_16x16x32_bf16(bfv, af, acc[nt], 0, 0, 0);
        }
    }
}
__device__ __forceinline__ void acc_zero(f32x4 (&acc)[4]) {
#pragma unroll
    for (int nt = 0; nt < 4; ++nt) acc[nt] = (f32x4){0.f, 0.f, 0.f, 0.f};
}
template <bool STRICT>
__device__ __forceinline__ void acc_mask(f32x4 (&acc)[4], int m, int fq) {
#pragma unroll
    for (int nt = 0; nt < 4; ++nt)
#pragma unroll
        for (int r = 0; r < 4; ++r) { const int n = nt * 16 + fq * 4 + r; const bool keep = STRICT ? (m < n) : (m <= n); if (!keep) acc[nt][r] = 0.f; }
}
__device__ __forceinline__ void st_rm(bf16_t* dst, const f32x4 (&acc)[4], int m, int fq) {
#pragma unroll
    for (int nt = 0; nt < 4; ++nt) store_bf16x4(dst + m * SL + nt * 16 + fq * 4, acc[nt]);
}
__device__ __forceinline__ void st_tr(bf16_t* dst, const f32x4 (&acc)[4], int m, int fq) {
#pragma unroll
    for (int nt = 0; nt < 4; ++nt)
#pragma unroll
        for (int r = 0; r < 4; ++r) dst[(nt * 16 + fq * 4 + r) * SL + m] = f2bf(acc[nt][r]);
}
__device__ __forceinline__ void ph_r1(const Params& p, int l, char* smem) {
    const int tid0 = tidx();
#define R1_IDX const int tid = lv(tid0), lane = tid & 63, wave = tid >> 6, fr = lane & 15, fq = lane >> 4, bi = tid >> 2, bq = (tid & 3) * 16, m = wave * 16 + fr; (void)bi; (void)bq; (void)m; (void)fq;
    const bf16_t* P = (const bf16_t*)(p.ws + O_P); const float* mu = p.in[I_MU] + l * 1792;
    const float* kkw = p.in[I_KK] + l * 512; const float* kaw = p.in[I_KA] + l * 512; const float* rkw = p.in[I_RK] + l * 512;
    const float* KKN = (const float*)(p.ws + O_X + X_KKN); float* BON = (float*)(p.ws + O_X + X_BON);
    bf16_t* gMT = (bf16_t*)(p.ws + O_X + X_MT); bf16_t* gNL = (bf16_t*)(p.ws + O_X + X_NL);
    bf16_t* gGT = (bf16_t*)(p.ws + O_X + X_GT); bf16_t* gYL = (bf16_t*)(p.ws + O_X + X_YL);
    bf16_t* slot = (bf16_t*)smem;
    bf16_t* s0 = slot, *s1 = slot + SLOT_E, *s2 = slot + 2 * SLOT_E, *s3 = slot + 3 * SLOT_E;
    bf16_t* sa = slot + 4 * SLOT_E, *sb = slot + 5 * SLOT_E, *sc = slot + 6 * SLOT_E, *sT = slot + 7 * SLOT_E;
    float* misc = (float*)(smem + 8 * SLOT_E * 2);
    float* GAM = misc; float* SEG = misc + 64;
    float* ASIG = (float*)s0;
    float* LWS = (float*)s2;
    for (int it = blockIdx.x; it < NCP; it += gridDim.x) {
        const int c = it % 68, d = (it / 68) & 1, h = (it / 136) & 7, b = it / 1088;
        {
            R1_IDX const int rowb = scan_row(b, d, c * 64 + bi); (void)rowb;
            float o[8];
#pragma unroll
            for (int hh = 0; hh < 2; ++hh) {
                xs8(P, mu, rowb, 1536 + bq + hh * 8, o);
#pragma unroll
                for (int j = 0; j < 8; ++j) o[j] = 1.f - 2.f * __builtin_amdgcn_rcpf(1.f + __expf(2.f * o[j]));
                *(uint4*)(sa + bi * SL + bq + hh * 8) = pack8(o);
                xs8(P, mu, rowb, 1600 + bq + hh * 8, o);
                *(uint4*)(sb + bi * SL + bq + hh * 8) = pack8(o);
            }
        }
        __syncthreads();
        {
            R1_IDX const int rowb = scan_row(b, d, c * 64 + bi); (void)rowb;
            f32x4 acc[4];
            acc_zero(acc);
            mm64<SL, 64>(sa, (const bf16_t*)(p.ws + O_WB + W_WUP) + ((size_t)d * 512 + h * 64) * 64, acc, wave, fr, fq);
            const float* w0 = p.in[I_W0] + (l * 2 + d) * 512 + h * 64;
#pragma unroll
            for (int nt = 0; nt < 4; ++nt) {
                const int n = nt * 16 + fq * 4; float4 o; float* op = (float*)&o;
#pragma unroll
                for (int r = 0; r < 4; ++r) { const float z = w0[n + r] + acc[nt][r]; op[r] = -0.6065306597126334f * __builtin_amdgcn_rcpf(1.f + __expf(-z)); }
                *(float4*)(LWS + m * 68 + n) = o;
            }
            acc_zero(acc);
            mm64<SL, 64>(sb, (const bf16_t*)(p.ws + O_WB + W_AUP) + ((size_t)d * 512 + h * 64) * 64, acc, wave, fr, fq);
            const float* a0 = p.in[I_A0] + (l * 2 + d) * 512 + h * 64;
#pragma unroll
            for (int nt = 0; nt < 4; ++nt) {
                const int n = nt * 16 + fq * 4;
                *(float4*)(ASIG + m * 68 + n) = make_float4(__builtin_amdgcn_rcpf(1.f + __expf(-(a0[n] + acc[nt][0]))), __builtin_amdgcn_rcpf(1.f + __expf(-(a0[n + 1] + acc[nt][1]))), __builtin_amdgcn_rcpf(1.f + __expf(-(a0[n + 2] + acc[nt][2]))), __builtin_amdgcn_rcpf(1.f + __expf(-(a0[n + 3] + acc[nt][3]))));
            }
        }
        __syncthreads();
        {
            R1_IDX const int rowb = scan_row(b, d, c * 64 + bi); (void)rowb;
            const int k = tid & 63, seg = tid >> 6;
            float run = 0.f;
#pragma unroll
            for (int ii = 0; ii < 16; ++ii) { run += LWS[(seg * 16 + ii) * 68 + k]; LWS[(seg * 16 + ii) * 68 + k] = run; }
            SEG[seg * 64 + k] = run;
            __syncthreads();
            float off = 0.f;
#pragma unroll
            for (int sgi = 0; sgi < 3; ++sgi) if (sgi < seg) off += SEG[sgi * 64 + k];
#pragma unroll
            for (int ii = 0; ii < 16; ++ii) LWS[(seg * 16 + ii) * 68 + k] += off;
        }
        __syncthreads();
        {
            R1_IDX const int rowb = scan_row(b, d, c * 64 + bi); (void)rowb;
            float cs[16], cm[16], cc[16], ag[16];
#pragma unroll
            for (int q = 0; q < 4; ++q) {
                const float4 v0 = *(const float4*)(LWS + bi * 68 + bq + q * 4);
                const float4 v1 = bi > 0 ? *(const float4*)(LWS + (bi - 1) * 68 + bq + q * 4) : make_float4(0.f, 0.f, 0.f, 0.f);
                const float4 v2 = *(const float4*)(LWS + 63 * 68 + bq + q * 4);
                const float4 v3 = *(const float4*)(ASIG + bi * 68 + bq + q * 4);
                cs[q * 4] = v0.x; cs[q * 4 + 1] = v0.y; cs[q * 4 + 2] = v0.z; cs[q * 4 + 3] = v0.w;
                cm[q * 4] = v1.x; cm[q * 4 + 1] = v1.y; cm[q * 4 + 2] = v1.z; cm[q * 4 + 3] = v1.w;
                cc[q * 4] = v2.x; cc[q * 4 + 1] = v2.y; cc[q * 4 + 2] = v2.z; cc[q * 4 + 3] = v2.w;
                ag[q * 4] = v3.x; ag[q * 4 + 1] = v3.y; ag[q * 4 + 2] = v3.z; ag[q * 4 + 3] = v3.w;
            }
            __syncthreads();
            const float kkn = KKN[(size_t)rowb * 8 + h];
            float bon = 0.f;
#pragma unroll
            for (int hh = 0; hh < 2; ++hh) {
                float r8[8], k8[8], oa[8], ob[8], ok[8], orr[8];
                const int col = h * 64 + bq + hh * 8;
                xs8(P, mu, rowb, col, r8); xs8(P, mu, rowb, 512 + col, k8);
#pragma unroll
                for (int j = 0; j < 8; ++j) {
                    const int e = hh * 8 + j;
                    const float kk = k8[j] * kkw[col + j] * kkn;
                    const float kd = k8[j] * (1.f + (ag[e] - 1.f) * kaw[col + j]);
                    const float eneg = __expf(-cs[e]);
                    oa[j] = -kk * __expf(cm[e]); ob[j] = kk * ag[e] * eneg; ok[j] = kd * eneg; orr[j] = r8[j] * __builtin_amdgcn_rcpf(eneg);
                    bon += r8[j] * kd * rkw[col + j];
                }
                *(uint4*)(s0 + bi * SL + bq + hh * 8) = pack8(oa); *(uint4*)(s1 + bi * SL + bq + hh * 8) = pack8(ob);
                *(uint4*)(s2 + bi * SL + bq + hh * 8) = pack8(ok); *(uint4*)(s3 + bi * SL + bq + hh * 8) = pack8(orr);
            }
            bon += __shfl_xor(bon, 1); bon += __shfl_xor(bon, 2);
            if ((tid & 3) == 0) BON[((size_t)d * RT + rowb) * 8 + h] = bon;
            if (bi == 0) {
#pragma unroll
                for (int e = 0; e < 16; ++e) GAM[bq + e] = __expf(cc[e]);
            }
        }
        __syncthreads();
        {
            R1_IDX const int rowb = scan_row(b, d, c * 64 + bi); (void)rowb;
            f32x4 acc[4]; acc_zero(acc);
            mm64<SL, SL>(s1, s0, acc, wave, fr, fq);
            acc_mask<true>(acc, m, fq);
            st_rm(sa, acc, m, fq); st_tr(sb, acc, m, fq);
#pragma unroll
            for (int nt = 0; nt < 4; ++nt)
#pragma unroll
                for (int r = 0; r < 4; ++r) if (nt * 16 + fq * 4 + r == m) acc[nt][r] += 1.f;
            st_rm(sc, acc, m, fq);
        }
        __syncthreads();
#pragma unroll
        for (int itr = 0; itr < 5; ++itr) {
            R1_IDX
            bf16_t* ptr = (itr & 1) ? sT : sb;
            bf16_t* ptw = (itr & 1) ? sb : sT;
            f32x4 acc[4]; acc_zero(acc);
            mm64<SL, SL>(sa, ptr, acc, wave, fr, fq);
            st_rm(sa, acc, m, fq); st_tr(ptw, acc, m, fq);
            __syncthreads();
            f32x4 tacc[4];
#pragma unroll
            for (int nt = 0; nt < 4; ++nt) { const uint2 u = *(const uint2*)(sc + m * SL + nt * 16 + fq * 4); tacc[nt] = (f32x4){bflo(u.x), bfhi(u.x), bflo(u.y), bfhi(u.y)}; }
            mm64<SL, SL>(sc, ptw, tacc, wave, fr, fq);
            if (itr < 4) st_rm(sc, tacc, m, fq); else st_tr(sb, tacc, m, fq);
        }
        __syncthreads();
        {
            R1_IDX const int rowb = scan_row(b, d, c * 64 + bi); (void)rowb;
            f32x4 acc[4]; acc_zero(acc);
            mm64<SL, SL>(s2, s0, acc, wave, fr, fq);
            acc_mask<true>(acc, m, fq);
            st_rm(sa, acc, m, fq);
            float f0[8], f1[8];
            unpack8(*(const uint4*)(s0 + bi * SL + bq), f0); unpack8(*(const uint4*)(s0 + bi * SL + bq + 8), f1);
#pragma unroll
            for (int e = 0; e < 8; ++e) { sc[(bq + e) * SL + bi] = f2bf(f0[e]); sc[(bq + 8 + e) * SL + bi] = f2bf(f1[e]); }
        }
        __syncthreads();
        {
            R1_IDX const int rowb = scan_row(b, d, c * 64 + bi); (void)rowb;
            f32x4 acc[4]; acc_zero(acc);
            mm64<SL, SL>(sc, sb, acc, wave, fr, fq);
            st_rm(sT, acc, m, fq);
            acc_zero(acc);
            mm64<SL, SL>(sa, sb, acc, wave, fr, fq);
            st_rm(s0, acc, m, fq);
        }
        __syncthreads();
        f32x4 qacc[4];
        {
            R1_IDX const int rowb = scan_row(b, d, c * 64 + bi); (void)rowb;
            f32x4 acc[4]; acc_zero(acc);
            mm64<SL, SL>(s1, s3, acc, wave, fr, fq);
            acc_mask<false>(acc, m, fq);
            st_tr(sa, acc, m, fq);
            acc_zero(qacc);
            mm64<SL, SL>(s2, s3, qacc, wave, fr, fq);
            acc_mask<false>(qacc, m, fq);
            float f0[8], f1[8];
            unpack8(*(const uint4*)(s3 + bi * SL + bq), f0); unpack8(*(const uint4*)(s3 + bi * SL + bq + 8), f1);
#pragma unroll
            for (int e = 0; e < 8; ++e) { sc[(bq + e) * SL + bi] = f2bf(f0[e]); sc[(bq + 8 + e) * SL + bi] = f2bf(f1[e]); }
        }
        __syncthreads();
        {
            R1_IDX const int rowb = scan_row(b, d, c * 64 + bi); (void)rowb;
            f32x4 acc[4];
#pragma unroll
            for (int nt = 0; nt < 4; ++nt) { const uint2 u = *(const uint2*)(sc + m * SL + nt * 16 + fq * 4); acc[nt] = (f32x4){bflo(u.x), bfhi(u.x), bflo(u.y), bfhi(u.y)}; }
            mm64<SL, SL>(sT, sa, acc, wave, fr, fq);
            bf16_t* gt = gGT + (size_t)it * 4096;
#pragma unroll
            for (int nt = 0; nt < 4; ++nt)
#pragma unroll
                for (int r = 0; r < 4; ++r) gt[(nt * 16 + fq * 4 + r) * 64 + m] = f2bf(acc[nt][r]);
            mm64<SL, SL>(s0, sa, qacc, wave, fr, fq);
            st_tr(sb, qacc, m, fq);
            float f0[8], f1[8];
            unpack8(*(const uint4*)(s1 + bi * SL + bq), f0); unpack8(*(const uint4*)(s1 + bi * SL + bq + 8), f1);
#pragma unroll
            for (int e = 0; e < 8; ++e) { s3[(bq + e) * SL + bi] = f2bf(f0[e] * GAM[bq + e]); s3[(bq + 8 + e) * SL + bi] = f2bf(f1[e] * GAM[bq + 8 + e]); }
        }
        __syncthreads();
        {
            R1_IDX const int rowb = scan_row(b, d, c * 64 + bi); (void)rowb;
            f32x4 acc[4]; acc_zero(acc);
            mm64<SL, SL>(sT, s3, acc, wave, fr, fq);
            bf16_t* mt = gMT + (size_t)it * 4096;
#pragma unroll
            for (int nt = 0; nt < 4; ++nt)
#pragma unroll
                for (int r = 0; r < 4; ++r) { const int n = nt * 16 + fq * 4 + r; mt[n * 64 + m] = f2bf(acc[nt][r] + (n == m ? GAM[m] : 0.f)); }
#pragma unroll
            for (int nt = 0; nt < 4; ++nt) {
                const int n = nt * 16 + fq * 4; const uint2 u = *(const uint2*)(s2 + m * SL + n);
                acc[nt] = (f32x4){bflo(u.x) * GAM[n], bfhi(u.x) * GAM[n + 1], bflo(u.y) * GAM[n + 2], bfhi(u.y) * GAM[n + 3]};
            }
            mm64<SL, SL>(s0, s3, acc, wave, fr, fq);
            st_tr(s1, acc, m, fq);
            float v8[8];
#pragma unroll
            for (int hh = 0; hh < 2; ++hh) {
                xs8(P, mu, rowb, 1024 + h * 64 + bq + hh * 8, v8);
#pragma unroll
                for (int e = 0; e < 8; ++e) sc[(bq + hh * 8 + e) * SL + bi] = f2bf(v8[e]);
            }
        }
        __syncthreads();
        {
            R1_IDX const int rowb = scan_row(b, d, c * 64 + bi); (void)rowb;
            f32x4 acc[4]; acc_zero(acc);
            mm64<SL, SL>(sc, sb, acc, wave, fr, fq);
            bf16_t* yl = gYL + (size_t)it * 4096;
#pragma unroll
            for (int nt = 0; nt < 4; ++nt) store_bf16x4(yl + m * 64 + nt * 16 + fq * 4, acc[nt]);
            acc_zero(acc);
            mm64<SL, SL>(sc, s1, acc, wave, fr, fq);
            bf16_t* nl = gNL + (size_t)it * 4096;
#pragma unroll
            for (int nt = 0; nt < 4; ++nt) store_bf16x4(nl + m * 64 + nt * 16 + fq * 4, acc[nt]);
        }
        __syncthreads();
    }
}
__device__ __forceinline__ void ph_r2(const Params& p, char* smem) {
    const int tid = tidx(), lane = tid & 63, wave = tid >> 6, fr = lane & 15, fq = lane >> 4;
    const char* gMT = (const char*)(p.ws + O_X + X_MT); const char* gNL = (const char*)(p.ws + O_X + X_NL);
    uint4* gS0 = (uint4*)(p.ws + O_X + X_S0);
    const int wofs = __builtin_amdgcn_readfirstlane(wave) * 1024;
    const unsigned lds0 = (unsigned)(uintptr_t)smem;
    const unsigned mtaddr = lds0 + fr * 128 + fq * 8, nladdr = lds0 + (wave * 16 + fr) * 128 + fq * 8;
    auto issue = [&](size_t cp, int slot) {
        char* dst = smem + slot * 16384 + wofs;
        const char* s0 = gMT + cp * 8192 + wofs + lane * 16; const char* s1 = gNL + cp * 8192 + wofs + lane * 16;
        __builtin_amdgcn_global_load_lds((const unsigned*)s0, (unsigned*)dst, 16, 0, 0);
        __builtin_amdgcn_global_load_lds((const unsigned*)(s0 + 4096), (unsigned*)(dst + 4096), 16, 0, 0);
        __builtin_amdgcn_global_load_lds((const unsigned*)s1, (unsigned*)(dst + 8192), 16, 0, 0);
        __builtin_amdgcn_global_load_lds((const unsigned*)(s1 + 4096), (unsigned*)(dst + 12288), 16, 0, 0);
    };
    for (int it = blockIdx.x; it < 64; it += gridDim.x) {
        f32x4 st[4];
#pragma unroll
        for (int tt = 0; tt < 4; ++tt) st[tt] = (f32x4){0.f, 0.f, 0.f, 0.f};
        const size_t cp0 = (size_t)it * 68;
        issue(cp0, 0); issue(cp0 + 1, 1); issue(cp0 + 2, 2);
        for (int c4 = 0; c4 < 68; c4 += 4) {
#pragma unroll
            for (int j = 0; j < 4; ++j) {
                const int c = c4 + j;
                if (c < 65) asm volatile("s_waitcnt vmcnt(8)" ::: "memory"); else asm volatile("s_waitcnt vmcnt(0)" ::: "memory");
                __builtin_amdgcn_s_barrier();
                asm volatile("" ::: "memory");
                uint2 mx[4][2][2], nvv[4];
                asm volatile("ds_read_b64 %0, %1 offset:0" : "=v"(mx[0][0][0]) : "v"(mtaddr + j * 16384));
                asm volatile("ds_read_b64 %0, %1 offset:32" : "=v"(mx[0][0][1]) : "v"(mtaddr + j * 16384));
                asm volatile("ds_read_b64 %0, %1 offset:64" : "=v"(mx[0][1][0]) : "v"(mtaddr + j * 16384));
                asm volatile("ds_read_b64 %0, %1 offset:96" : "=v"(mx[0][1][1]) : "v"(mtaddr + j * 16384));
                asm volatile("ds_read_b64 %0, %1 offset:8192" : "=v"(nvv[0]) : "v"(nladdr + j * 16384));
                asm volatile("ds_read_b64 %0, %1 offset:2048" : "=v"(mx[1][0][0]) : "v"(mtaddr + j * 16384));
                asm volatile("ds_read_b64 %0, %1 offset:2080" : "=v"(mx[1][0][1]) : "v"(mtaddr + j * 16384));
                asm volatile("ds_read_b64 %0, %1 offset:2112" : "=v"(mx[1][1][0]) : "v"(mtaddr + j * 16384));
                asm volatile("ds_read_b64 %0, %1 offset:2144" : "=v"(mx[1][1][1]) : "v"(mtaddr + j * 16384));
                asm volatile("ds_read_b64 %0, %1 offset:8224" : "=v"(nvv[1]) : "v"(nladdr + j * 16384));
                asm volatile("ds_read_b64 %0, %1 offset:4096" : "=v"(mx[2][0][0]) : "v"(mtaddr + j * 16384));
                asm volatile("ds_read_b64 %0, %1 offset:4128" : "=v"(mx[2][0][1]) : "v"(mtaddr + j * 16384));
                asm volatile("ds_read_b64 %0, %1 offset:4160" : "=v"(mx[2][1][0]) : "v"(mtaddr + j * 16384));
                asm volatile("ds_read_b64 %0, %1 offset:4192" : "=v"(mx[2][1][1]) : "v"(mtaddr + j * 16384));
                asm volatile("ds_read_b64 %0, %1 offset:8256" : "=v"(nvv[2]) : "v"(nladdr + j * 16384));
                asm volatile("ds_read_b64 %0, %1 offset:6144" : "=v"(mx[3][0][0]) : "v"(mtaddr + j * 16384));
                asm volatile("ds_read_b64 %0, %1 offset:6176" : "=v"(mx[3][0][1]) : "v"(mtaddr + j * 16384));
                asm volatile("ds_read_b64 %0, %1 offset:6208" : "=v"(mx[3][1][0]) : "v"(mtaddr + j * 16384));
                asm volatile("ds_read_b64 %0, %1 offset:6240" : "=v"(mx[3][1][1]) : "v"(mtaddr + j * 16384));
                asm volatile("ds_read_b64 %0, %1 offset:8288" : "=v"(nvv[3]) : "v"(nladdr + j * 16384));
                u32x4 sb[2];
#pragma unroll
                for (int s_ = 0; s_ < 2; ++s_) sb[s_] = (u32x4){pack2(st[2 * s_][0], st[2 * s_][1]), pack2(st[2 * s_][2], st[2 * s_][3]), pack2(st[2 * s_ + 1][0], st[2 * s_ + 1][1]), pack2(st[2 * s_ + 1][2], st[2 * s_ + 1][3])};
                asm volatile("s_waitcnt lgkmcnt(0)" ::: "memory");
                __builtin_amdgcn_sched_barrier(0);
#pragma unroll
                for (int tt = 0; tt < 4; ++tt) {
                    f32x4 acc = {bflo(nvv[tt].x), bfhi(nvv[tt].x), bflo(nvv[tt].y), bfhi(nvv[tt].y)};
#pragma unroll
                    for (int s_ = 0; s_ < 2; ++s_)
                        acc = __builtin_amdgcn_mfma_f32_16x16x32_bf16(__builtin_bit_cast(bf16x8, (u32x4){mx[tt][s_][0].x, mx[tt][s_][0].y, mx[tt][s_][1].x, mx[tt][s_][1].y}), __builtin_bit_cast(bf16x8, sb[s_]), acc, 0, 0, 0);
                    st[tt] = acc;
                }
                *(u32x4*)(gS0 + ((cp0 + c) * 4 + wave) * 128 + lane) = sb[0]; *(u32x4*)(gS0 + ((cp0 + c) * 4 + wave) * 128 + 64 + lane) = sb[1];
                if (c + 3 < 68) issue(cp0 + c + 3, (j + 3) & 3);
            }
        }
        asm volatile("s_waitcnt vmcnt(0)" ::: "memory");
        __syncthreads();
    }
}
__device__ __forceinline__ void ph_r3(const Params& p) {
    const int tid = tidx(), lane = tid & 63, wave = tid >> 6, fr = lane & 15, fq = lane >> 4;
    const bf16_t* gGT = (const bf16_t*)(p.ws + O_X + X_GT); const bf16_t* gYL = (const bf16_t*)(p.ws + O_X + X_YL);
    const uint4* gS0 = (const uint4*)(p.ws + O_X + X_S0);
    bf16_t* YS = (bf16_t*)(p.ws + O_H);
    for (int it = blockIdx.x; it < NCP; it += gridDim.x) {
        const int c = it % 68, d = (it / 68) & 1, h = (it / 136) & 7, b = it / 1088;
        const bf16_t* gt = gGT + (size_t)it * 4096; const bf16_t* yl = gYL + (size_t)it * 4096;
        const uint4 sb0 = gS0[((size_t)it * 4 + wave) * 128 + lane], sb1 = gS0[((size_t)it * 4 + wave) * 128 + 64 + lane];
#pragma unroll
        for (int tt = 0; tt < 4; ++tt) {
            const uint2 yv = *(const uint2*)(yl + (wave * 16 + fr) * 64 + tt * 16 + fq * 4);
            f32x4 acc = {bflo(yv.x), bfhi(yv.x), bflo(yv.y), bfhi(yv.y)};
#pragma unroll
            for (int s = 0; s < 2; ++s) {
                const bf16_t* q = gt + (tt * 16 + fr) * 64 + s * 32 + fq * 4;
                const uint2 a0 = *(const uint2*)q, a1 = *(const uint2*)(q + 16);
                const bf16x8 af = __builtin_bit_cast(bf16x8, make_uint4(a0.x, a0.y, a1.x, a1.y));
                acc = __builtin_amdgcn_mfma_f32_16x16x32_bf16(af, __builtin_bit_cast(bf16x8, s ? sb1 : sb0), acc, 0, 0, 0);
            }
#pragma unroll
            for (int r = 0; r < 4; ++r) {
                const int row = scan_row(b, d, c * 64 + tt * 16 + fq * 4 + r);
                YS[((size_t)d * RT + row) * 512 + h * 64 + wave * 16 + fr] = f2bf(acc[r]);
            }
        }
    }
}

__device__ __forceinline__ void ph_rpost(const Params& p, int l) {
    const int lane = tidx() & 63, wave = tidx() >> 6;
    const bf16_t* P = (const bf16_t*)(p.ws + O_P); const float* mu = p.in[I_MU] + l * 1792;
    const float* gng = p.in[I_GNG] + l * 512; const float* gnb = p.in[I_GNB] + l * 512;
    const float* BON = (const float*)(p.ws + O_X + X_BON); const bf16_t* YS = (const bf16_t*)(p.ws + O_H);
    const bf16_t* RG = (const bf16_t*)(p.ws + O_RG); bf16_t* RWO = (bf16_t*)(p.ws + O_RWO);
    for (int row = blockIdx.x * 4 + wave; row < RT; row += gridDim.x * 4) {
        const int col = lane * 8, h = lane >> 3;
        float v8[8], g8[8], y0[8], y1[8];
        xs8(P, mu, row, 1024 + col, v8);
        unpack8(*(const uint4*)(RG + (size_t)row * 512 + col), g8);
        unpack8(*(const uint4*)(YS + ((size_t)0 * RT + row) * 512 + col), y0);
        unpack8(*(const uint4*)(YS + ((size_t)1 * RT + row) * 512 + col), y1);
        const float bs = BON[((size_t)0 * RT + row) * 8 + h] + BON[((size_t)1 * RT + row) * 8 + h];
        float y[8]; float sm = 0.f;
#pragma unroll
        for (int j = 0; j < 8; ++j) { y[j] = y0[j] + y1[j]; sm += y[j]; }
        sm += __shfl_xor(sm, 1); sm += __shfl_xor(sm, 2); sm += __shfl_xor(sm, 4);
        const float mean = sm * (1.f / 64.f);
        float vs = 0.f;
#pragma unroll
        for (int j = 0; j < 8; ++j) { const float dlt = y[j] - mean; vs += dlt * dlt; }
        vs += __shfl_xor(vs, 1); vs += __shfl_xor(vs, 2); vs += __shfl_xor(vs, 4);
        const float rstd = rsqrtf(vs * (1.f / 64.f) + 64e-5f);
        float o[8];
#pragma unroll
        for (int j = 0; j < 8; ++j) o[j] = ((y[j] - mean) * rstd * gng[col + j] + gnb[col + j] + bs * v8[j]) * g8[j];
        *(uint4*)(RWO + (size_t)row * 512 + col) = pack8(o);
    }
}

__device__ __forceinline__ void ph_f1(const Params& p, int l, char* smem) {
    const bf16_t* P = (const bf16_t*)(p.ws + O_P); const bf16_t* CSC = (const bf16_t*)(p.ws + O_CSC);
    bf16_t* YT2 = (bf16_t*)(p.ws + O_YT2); bf16_t* YTC = (bf16_t*)(p.ws + O_YTC);
    const int nitems = 1024 + (l < NLAYER - 1 ? 64 : 0);
    for (int it = blockIdx.x; it < nitems; it += gridDim.x) {
        f32x4 acc[4][4];
        if (it < 1024) {
            const int b = it >> 8, g = (it >> 6) & 3, part = (it >> 5) & 1, j = it & 31;
            RPPlain rpa{CSC + (size_t)part * 128 * 128, 128};
            const bf16_t* pb = P + (size_t)b * SEQ * LDP + g * 128;
            auto rpb = [&](int r) -> const bf16_t* { return pb + (size_t)(64 * (r & 63) + 2 * j + (r >> 6)) * LDP; };
            gemm_core_gb<4>(rpa, rpb, 128, acc, smem);
            acc_foreach<4>(acc, [&](int m, int n, const f32x4& v) {
                const int t1 = n & 63, t2 = 2 * j + (n >> 6);
                store_bf16x4(YT2 + ((size_t)(b * 512 + g * 128 + m) * 64 + t2) * 128 + part * 64 + t1, v);
            });
        } else {
            const int jj = it - 1024, b = jj >> 4, g = (jj >> 2) & 3, part = (jj >> 1) & 1, nt = jj & 1;
            RPPlain rpa{CSC + (size_t)part * 128 * 128, 128};
            gemm_core_g<4>(rpa, P + (size_t)(RL + b * CTX + nt * 128) * LDP + g * 128, LDP, 128, acc, smem);
            acc_foreach<4>(acc, [&](int m, int n, const f32x4& v) {
                store_bf16x4(YTC + ((size_t)(b * 512 + g * 128 + m)) * 512 + part * 256 + nt * 128 + n, v);
            });
        }
    }
}
__device__ __forceinline__ void ph_fa(const Params& p, char* smem) {
    const bf16_t* YT2 = (const bf16_t*)(p.ws + O_YT2); const bf16_t* D128 = (const bf16_t*)(p.ws + O_D128);
    const float* TWC = (const float*)(p.ws + O_TWC); const float* TWS = (const float*)(p.ws + O_TWS);
    bf16_t* A2 = (bf16_t*)(p.ws + O_A2);
    for (int it = blockIdx.x; it < 1024; it += gridDim.x) {
        f32x4 acc[4][4];
        RPPlain rpa{D128, 128};
        gemm_core_g<4>(rpa, YT2 + (size_t)it * 128 * 128, 128, 128, acc, smem);
        const int lane = tidx() & 63, wave = tidx() >> 6, wr = wave >> 1, wc = wave & 1, fr = lane & 15, fq = lane >> 4;
        float* U = (float*)smem;
        if (wr == 1) {
#pragma unroll
            for (int i = 0; i < 4; ++i)
#pragma unroll
                for (int j = 0; j < 4; ++j) *(f32x4*)(U + (i * 16 + fr) * 132 + wc * 64 + j * 16 + fq * 4) = acc[i][j];
        }
        __syncthreads();
        if (wr == 0) {
#pragma unroll
            for (int i = 0; i < 4; ++i) {
                const int k1 = i * 16 + fr;
#pragma unroll
                for (int j = 0; j < 4; ++j) {
                    const int r = wc * 64 + j * 16 + fq * 4;
                    const int R = it * 128 + r, bn = R >> 6, t2 = R & 63, b = bn >> 9, n = bn & 511;
                    const f32x4 ai = *(const f32x4*)(U + k1 * 132 + r);
                    const f32x4 c = *(const f32x4*)(TWC + k1 * 64 + t2), sn = *(const f32x4*)(TWS + k1 * 64 + t2);
                    const f32x4 ar = acc[i][j];
                    const f32x4 pr = ar * c - ai * sn, pi = ar * sn + ai * c;
                    bf16_t* dst = A2 + ((size_t)(b * 64 + k1) * 512 + n) * 128 + t2;
                    store_bf16x4(dst, pr); store_bf16x4(dst + 64, pi);
                }
            }
        }
        __syncthreads();
    }
}
__device__ __forceinline__ void ph_fb(const Params& p, int l, char* smem) {
    const bf16_t* A2 = (const bf16_t*)(p.ws + O_A2); const bf16_t* E64 = (const bf16_t*)(p.ws + O_E64);
    const bf16_t* CST2 = (const bf16_t*)(p.ws + O_CST256); const bf16_t* YTC = (const bf16_t*)(p.ws + O_YTC);
    bf16_t* FA = (bf16_t*)(p.ws + O_FA);
    const int nitems = 1024 + (l < NLAYER - 1 ? 32 : 0);
    for (int it = blockIdx.x; it < nitems; it += gridDim.x) {
        if (it < 1024) {
            const int b = it >> 8, k1 = (it >> 2) & 63, nt = it & 3;
            f32x4 acc[2][4];
            RPPlain rpa{E64, 128};
            gemm_core_g<2>(rpa, A2 + ((size_t)(b * 64 + k1) * 512 + nt * 128) * 128, 128, 128, acc, smem);
            const float sc = 0.001381067932004975f;
            acc_foreach<2>(acc, [&](int m, int n, const f32x4& v) { f32x4 o = v * sc; store_bf16x4(FA + (size_t)(b * SEQ + k1 + 64 * m) * 512 + nt * 128 + n, o); });
        } else {
            const int j = it - 1024, b = j >> 3, mt = (j >> 2) & 1, nt = j & 3;
            f32x4 acc[4][4];
            RPPlain rp{CST2 + (size_t)mt * 128 * 512, 512};
            gemm_core_g<4>(rp, YTC + ((size_t)b * 512 + nt * 128) * 512, 512, 512, acc, smem);
            const float sc = 0.005524271728019903f;
            acc_foreach<4>(acc, [&](int m, int n, const f32x4& v) { f32x4 o = v * sc; store_bf16x4(FA + (size_t)(RL + b * CTX + mt * 128 + m) * 512 + nt * 128 + n, o); });
        }
    }
}

__device__ __forceinline__ void ph_mg(const Params& p, int l, char* smem) {
    const bf16_t* P = (const bf16_t*)(p.ws + O_P);
    const bf16_t* A0 = (const bf16_t*)(p.ws + O_FA); const bf16_t* A1 = (const bf16_t*)(p.ws + O_ATT); const bf16_t* A2 = (const bf16_t*)(p.ws + O_RWO);
    const bf16_t* W0 = (const bf16_t*)(p.ws + O_WB + W_PA); const bf16_t* W1 = (const bf16_t*)(p.ws + O_WB + W_PB); const bf16_t* W2 = (const bf16_t*)(p.ws + O_WB + W_PC);
    bf16_t* MG = (bf16_t*)(p.ws + O_H);
    const int nmt = (l < NLAYER - 1) ? RT / 64 : RL / 64;
    for (int it = blockIdx.x; it < nmt * 8; it += gridDim.x) {
        const int mt = it >> 3, nt = it & 7;
        f32x4 tot[2][4];
#pragma unroll
        for (int i = 0; i < 2; ++i)
#pragma unroll
            for (int j = 0; j < 4; ++j) tot[i][j] = (f32x4){0.f, 0.f, 0.f, 0.f};
#pragma unroll 1
        for (int br = 0; br < 3; ++br) {
            const bf16_t* Ab = br == 0 ? A0 : (br == 1 ? A1 : A2);
            const bf16_t* Wb = br == 0 ? W0 : (br == 1 ? W1 : W2);
            f32x4 acc[2][4];
            RPPlain rp{Ab + (size_t)mt * 64 * 512, 512};
            gemm_core_g<2>(rp, Wb + (size_t)nt * 128 * 512, 512, 512, acc, smem);
            const int lane = tidx() & 63, wave = tidx() >> 6, wr = wave >> 1, wc = wave & 1, fr = lane & 15, fq = lane >> 4;
#pragma unroll
            for (int i = 0; i < 2; ++i)
#pragma unroll
                for (int j = 0; j < 4; ++j) {
                    const int m = wr * 32 + i * 16 + fr, n = wc * 64 + j * 16 + fq * 4;
                    const uint2 gu = *(const uint2*)(P + (size_t)(mt * 64 + m) * LDP + PG0 + br * 1024 + nt * 128 + n);
                    tot[i][j][0] += bflo(gu.x) * acc[i][j][0]; tot[i][j][1] += bfhi(gu.x) * acc[i][j][1];
                    tot[i][j][2] += bflo(gu.y) * acc[i][j][2]; tot[i][j][3] += bfhi(gu.y) * acc[i][j][3];
                }
        }
        acc_foreach<2>(tot, [&](int m, int n, const f32x4& v) { store_bf16x4(MG + (size_t)(mt * 64 + m) * 1024 + nt * 128 + n, v); });
    }
}
__device__ __forceinline__ void ph_out(const Params& p, int l, char* smem) {
    const bf16_t* MG = (const bf16_t*)(p.ws + O_H); const bf16_t* W = (const bf16_t*)(p.ws + O_WB + W_OUT);
    float* xcur = (float*)(p.ws + O_XCUR); const float* mod = (const float*)(p.ws + O_MOD);
    const int nmt = (l < NLAYER - 1) ? RT / 128 : RL / 128;
    for (int it = blockIdx.x; it < nmt * 8; it += gridDim.x) {
        const int mt = it >> 3, nt = it & 7;
        f32x4 acc[4][4];
        RPPlain rp{MG + (size_t)mt * 128 * 1024, 1024};
        gemm_core_g<4>(rp, W + (size_t)nt * 128 * 1024, 1024, 1024, acc, smem);
        acc_foreach<4>(acc, [&](int m, int n, const f32x4& v) {
            const int row = mt * 128 + m, col = nt * 128 + n;
            const float4 g = *(const float4*)(mod + (size_t)(l * 5 + modidx(row)) * 6144 + 2048 + col);
            float4* xp = (float4*)(xcur + (size_t)row * 1024 + col);
            float4 x = *xp; x.x += g.x * v[0]; x.y += g.y * v[1]; x.z += g.z * v[2]; x.w += g.w * v[3]; *xp = x;
        });
    }
}

__device__ __forceinline__ void ph_n2(const Params& p, int l, char* smem) {
    const int tid = tidx(), lane = tid & 63, wave = tid >> 6;
    unsigned* lcnt = (unsigned*)smem;
    unsigned* gbase = lcnt + 16;
    int* rec = (int*)(smem + 256);
    if (tid < 16) lcnt[tid] = 0u;
    __syncthreads();
    int nrec = 0;
    const float* xcur = (const float*)(p.ws + O_XCUR); const float* mod = (const float*)(p.ws + O_MOD);
    bf16_t* H = (bf16_t*)(p.ws + O_H);
    unsigned* cnt = (unsigned*)(p.ws + O_CNT); int* LTOK = (int*)(p.ws + O_LTOK); float* LW = (float*)(p.ws + O_LW); int* SLOT = (int*)(p.ws + O_SLOT);
    const float* g = p.in[I_N2G] + l * 1024; const float* rw = p.in[I_RW]; const float* rb = p.in[I_RB];
    const int nrows = (l < NLAYER - 1) ? RT : RL;
    for (int row = blockIdx.x * 4 + wave; row < nrows; row += gridDim.x * 4) {
        const float* x = xcur + (size_t)row * 1024; const float* md = mod + (size_t)(l * 5 + modidx(row)) * 6144;
        float4 v[4]; float ss = 0.f;
#pragma unroll
        for (int i = 0; i < 4; ++i) { v[i] = *(const float4*)(x + lane * 4 + 256 * i); ss += v[i].x * v[i].x + v[i].y * v[i].y + v[i].z * v[i].z + v[i].w * v[i].w; }
        ss = wsum(ss);
        const float rstd = rsqrtf(ss * (1.f / 1024.f) + 1e-6f);
        float lg[16];
#pragma unroll
        for (int e = 0; e < 16; ++e) lg[e] = 0.f;
#pragma unroll
        for (int i = 0; i < 4; ++i) {
            const int c = lane * 4 + 256 * i;
            const float4 gg = *(const float4*)(g + c), sc = *(const float4*)(md + 4096 + c), sh = *(const float4*)(md + 3072 + c);
            const float hv[4] = {v[i].x * rstd * gg.x * (1.f + sc.x) + sh.x, v[i].y * rstd * gg.y * (1.f + sc.y) + sh.y,
                                 v[i].z * rstd * gg.z * (1.f + sc.z) + sh.z, v[i].w * rstd * gg.w * (1.f + sc.w) + sh.w};
            f32x4 h4 = {hv[0], hv[1], hv[2], hv[3]};
            store_bf16x4(H + (size_t)row * 1024 + c, h4);
#pragma unroll
            for (int j = 0; j < 4; ++j) {
                const float* wr_ = rw + (size_t)(c + j) * 16;
                const float4 w0 = *(const float4*)wr_, w1 = *(const float4*)(wr_ + 4), w2 = *(const float4*)(wr_ + 8), w3 = *(const float4*)(wr_ + 12);
                lg[0] += hv[j] * w0.x; lg[1] += hv[j] * w0.y; lg[2] += hv[j] * w0.z; lg[3] += hv[j] * w0.w;
                lg[4] += hv[j] * w1.x; lg[5] += hv[j] * w1.y; lg[6] += hv[j] * w1.z; lg[7] += hv[j] * w1.w;
                lg[8] += hv[j] * w2.x; lg[9] += hv[j] * w2.y; lg[10] += hv[j] * w2.z; lg[11] += hv[j] * w2.w;
                lg[12] += hv[j] * w3.x; lg[13] += hv[j] * w3.y; lg[14] += hv[j] * w3.z; lg[15] += hv[j] * w3.w;
            }
        }
        float sc_[16], sel[16];
#pragma unroll
        for (int e = 0; e < 16; ++e) { lg[e] = wsum(lg[e]); sc_[e] = 1.f / (1.f + expf(-lg[e])); sel[e] = sc_[e] + rb[e]; }
        int best = 0; float bestv = -1e30f;
#pragma unroll
        for (int gi = 0; gi < 4; ++gi) {
            float m1 = -1e30f, m2 = -1e30f;
#pragma unroll
            for (int j = 0; j < 4; ++j) { const float s = sel[gi * 4 + j]; if (s > m1) { m2 = m1; m1 = s; } else if (s > m2) m2 = s; }
            const float gs = m1 + m2;
            if (gs > bestv) { bestv = gs; best = gi; }
        }
        float s4[4] = {0.f, 0.f, 0.f, 0.f}, c4[4] = {0.f, 0.f, 0.f, 0.f};
#pragma unroll
        for (int gi = 0; gi < 4; ++gi)
#pragma unroll
            for (int j = 0; j < 4; ++j) if (gi == best) { s4[j] = sel[gi * 4 + j]; c4[j] = sc_[gi * 4 + j]; }
        int i1 = 0; float v1 = s4[0], w1 = c4[0];
#pragma unroll
        for (int j = 1; j < 4; ++j) if (s4[j] > v1) { v1 = s4[j]; i1 = j; w1 = c4[j]; }
        int i2 = -1; float v2 = -1e30f, w2 = 0.f;
#pragma unroll
        for (int j = 0; j < 4; ++j) if (j != i1 && s4[j] > v2) { v2 = s4[j]; i2 = j; w2 = c4[j]; }
        if (lane == 0) {
            const float inv = 1.f / (w1 + w2);
            const int e1 = best * 4 + i1, e2 = best * 4 + i2;
            const unsigned r1 = atomicAdd(&lcnt[e1], 1u), r2 = atomicAdd(&lcnt[e2], 1u);
            int* rc = rec + (wave * 32 + nrec) * 8;
            rc[0] = row; rc[1] = e1; rc[2] = e2; rc[3] = (int)r1; rc[4] = (int)r2; rc[5] = __float_as_int(w1 * inv); rc[6] = __float_as_int(w2 * inv);
        }
        ++nrec;
    }
    __syncthreads();
    if (tid < 16) gbase[tid] = lcnt[tid] ? atomicAdd(&cnt[tid], lcnt[tid]) : 0u;
    __syncthreads();
    for (int i = lane; i < nrec; i += 64) {
        const int* rc = rec + (wave * 32 + i) * 8;
        const int row = rc[0], e1 = rc[1], e2 = rc[2];
        const unsigned p1 = gbase[e1] + (unsigned)rc[3], p2 = gbase[e2] + (unsigned)rc[4];
        LTOK[(size_t)e1 * RT + p1] = row; LW[(size_t)e1 * RT + p1] = __int_as_float(rc[5]);
        LTOK[(size_t)e2 * RT + p2] = row; LW[(size_t)e2 * RT + p2] = __int_as_float(rc[6]);
        SLOT[row * 2] = (e1 << 20) | (int)p1; SLOT[row * 2 + 1] = (e2 << 20) | (int)p2;
    }
}

struct MoeTiles { int tb[17]; int sm; };
__device__ __forceinline__ void moe_tiles(const Params& p, int l, int* s_tb) {
    if (tidx() == 0) {
        const unsigned* cnt = (const unsigned*)(p.ws + O_CNT);
        int a = 0;
        for (int e = 0; e < 16; ++e) { s_tb[e] = a; a += ((int)cnt[e] + 127) >> 7; }
        s_tb[16] = a;
    }
    __syncthreads();
}
struct ALGather {
    const bf16_t* p[4]; bool ok[4];
    __device__ __forceinline__ uint4 load(int i, int k) const { return ok[i] ? *(const uint4*)(p[i] + k) : make_uint4(0u, 0u, 0u, 0u); }
};
struct ALSwiglu {
    const bf16_t* p[4]; float w[4];
    __device__ __forceinline__ uint4 load(int i, int k) const {
        float g[8], u[8], o[8]; unpack8(*(const uint4*)(p[i] + k), g); unpack8(*(const uint4*)(p[i] + 512 + k), u);
#pragma unroll
        for (int j = 0; j < 8; ++j) o[j] = siluf_(g[j]) * u[j] * w[i];
        return pack8(o);
    }
};
__device__ __forceinline__ void ph_e1(const Params& p, int l, char* smem) {
    int* s_tb = (int*)(smem + 73728);
    moe_tiles(p, l, s_tb);
    const bf16_t* H = (const bf16_t*)(p.ws + O_H); bf16_t* ACT = (bf16_t*)(p.ws + O_P);
    const unsigned* cnt = (const unsigned*)(p.ws + O_CNT); const int* LTOK = (const int*)(p.ws + O_LTOK); const float* LW = (const float*)(p.ws + O_LW);
    const int sm = (l < NLAYER - 1) ? RT / 128 : RL / 128;
    const int total = (sm + s_tb[16]) * 8;
    for (int it = blockIdx.x; it < total; it += gridDim.x) {
        const int mt = it >> 3, nt = it & 7;
        int e = 16, erow0 = mt * 128, lt = 0;
        if (mt >= sm) { const int q = mt - sm; e = 0; while (q >= s_tb[e + 1]) ++e; lt = q - s_tb[e]; erow0 = RT + q * 128; }
        const int cnte = (e == 16) ? 0 : (int)cnt[e];
        auto rp = [&](int r) -> const bf16_t* {
            if (e == 16) return H + (size_t)(mt * 128 + r) * 1024;
            const int idx = lt * 128 + r;
            const int tok = idx < cnte ? LTOK[(size_t)e * RT + idx] : 0;
            return H + (size_t)tok * 1024;
        };
        f32x4 acc[4][4];
        gemm_core_g<4>(rp, (const bf16_t*)(p.ws + O_WB + W_GU) + (size_t)e * 1024 * 1024 + (size_t)nt * 128 * 1024, 1024, 1024, acc, smem);
        {
            const int lane = tidx() & 63, wave = tidx() >> 6, wr = wave >> 1, wc = wave & 1, fr = lane & 15, fq = lane >> 4;
            float* U = (float*)smem;
            if (wc == 1) {
#pragma unroll
                for (int i = 0; i < 4; ++i)
#pragma unroll
                    for (int j = 0; j < 4; ++j) *(f32x4*)(U + (wr * 64 + i * 16 + fr) * 68 + j * 16 + fq * 4) = acc[i][j];
            }
            __syncthreads();
            if (wc == 0) {
#pragma unroll
                for (int i = 0; i < 4; ++i) {
                    const int m = wr * 64 + i * 16 + fr;
                    float wgt = 1.f;
                    if (e != 16) { const int idx = lt * 128 + m; wgt = idx < cnte ? LW[(size_t)e * RT + idx] : 0.f; }
#pragma unroll
                    for (int j = 0; j < 4; ++j) {
                        const f32x4 u = *(const f32x4*)(U + m * 68 + j * 16 + fq * 4);
                        f32x4 o;
#pragma unroll
                        for (int r = 0; r < 4; ++r) o[r] = siluf_(acc[i][j][r]) * u[r] * wgt;
                        store_bf16x4(ACT + (size_t)(erow0 + m) * 512 + nt * 64 + j * 16 + fq * 4, o);
                    }
                }
            }
            __syncthreads();
        }
    }
}
__device__ __forceinline__ void ph_e2(const Params& p, int l, char* smem) {
    int* s_tb = (int*)(smem + 73728);
    moe_tiles(p, l, s_tb);
    const bf16_t* ACT = (const bf16_t*)(p.ws + O_P); bf16_t* YE = (bf16_t*)(p.ws + O_X + X_YE);
    const int sm = (l < NLAYER - 1) ? RT / 128 : RL / 128;
    const int total = (sm + s_tb[16]) * 8;
    for (int it = blockIdx.x; it < total; it += gridDim.x) {
        const int mt = it >> 3, nt = it & 7;
        int e = 16, erow0 = mt * 128;
        if (mt >= sm) { const int q = mt - sm; e = 0; while (q >= s_tb[e + 1]) ++e; erow0 = RT + q * 128; }
        RPPlain rp{ACT + (size_t)erow0 * 512, 512};
        f32x4 acc[4][4];
        gemm_core_g<4>(rp, (const bf16_t*)(p.ws + O_WB + W_D) + (size_t)e * 1024 * 512 + (size_t)nt * 128 * 512, 512, 512, acc, smem);
        acc_foreach<4>(acc, [&](int m, int n, const f32x4& v) { store_bf16x4(YE + (size_t)(erow0 + m) * 1024 + nt * 128 + n, v); });
    }
}
__device__ __forceinline__ void ph_e3(const Params& p, int l, char* smem) {
    int* s_tb = (int*)(smem + 73728);
    moe_tiles(p, l, s_tb);
    const int lane = tidx() & 63, wave = tidx() >> 6;
    const bf16_t* YE = (const bf16_t*)(p.ws + O_X + X_YE); const int* SLOT = (const int*)(p.ws + O_SLOT);
    float* xcur = (float*)(p.ws + O_XCUR); const float* mod = (const float*)(p.ws + O_MOD);
    const int nrows = (l < NLAYER - 1) ? RT : RL;
    for (int row = blockIdx.x * 4 + wave; row < nrows; row += gridDim.x * 4) {
        const int s1 = SLOT[row * 2], s2 = SLOT[row * 2 + 1];
        const size_t r0 = row, r1 = (size_t)RT + s_tb[s1 >> 20] * 128 + (s1 & 0xfffff), r2 = (size_t)RT + s_tb[s2 >> 20] * 128 + (s2 & 0xfffff);
        const float* g2 = mod + (size_t)(l * 5 + modidx(row)) * 6144 + 5120;
#pragma unroll
        for (int i = 0; i < 2; ++i) {
            const int c = lane * 8 + 512 * i;
            float a[8], b[8], d[8];
            unpack8(*(const uint4*)(YE + r0 * 1024 + c), a); unpack8(*(const uint4*)(YE + r1 * 1024 + c), b); unpack8(*(const uint4*)(YE + r2 * 1024 + c), d);
            float4* xp = (float4*)(xcur + (size_t)row * 1024 + c);
            float4 x0 = xp[0], x1 = xp[1];
            const float4 ga = *(const float4*)(g2 + c), gb = *(const float4*)(g2 + c + 4);
            x0.x += ga.x * (a[0] + b[0] + d[0]); x0.y += ga.y * (a[1] + b[1] + d[1]); x0.z += ga.z * (a[2] + b[2] + d[2]); x0.w += ga.w * (a[3] + b[3] + d[3]);
            x1.x += gb.x * (a[4] + b[4] + d[4]); x1.y += gb.y * (a[5] + b[5] + d[5]); x1.z += gb.z * (a[6] + b[6] + d[6]); x1.w += gb.w * (a[7] + b[7] + d[7]);
            xp[0] = x0; xp[1] = x1;
        }
    }
}
__device__ __forceinline__ void ph_final(const Params& p) {
    const int lane = tidx() & 63, wave = tidx() >> 6;
    const float* xcur = (const float*)(p.ws + O_XCUR); const float* g = p.in[I_FNG];
    for (int row = blockIdx.x * 4 + wave; row < RL; row += gridDim.x * 4) {
        const float* x = xcur + (size_t)row * 1024;
        float4 v[4]; float ss = 0.f;
#pragma unroll
        for (int i = 0; i < 4; ++i) { v[i] = *(const float4*)(x + lane * 4 + 256 * i); ss += v[i].x * v[i].x + v[i].y * v[i].y + v[i].z * v[i].z + v[i].w * v[i].w; }
        ss = wsum(ss);
        const float rstd = rsqrtf(ss * (1.f / 1024.f) + 1e-6f);
#pragma unroll
        for (int i = 0; i < 4; ++i) {
            const int c = lane * 4 + 256 * i; const float4 gg = *(const float4*)(g + c);
            *(float4*)(p.out + (size_t)row * 1024 + c) = make_float4(v[i].x * rstd * gg.x, v[i].y * rstd * gg.y, v[i].z * rstd * gg.z, v[i].w * rstd * gg.w);
        }
    }
}

constexpr int LDS_BYTES = 76800;
constexpr int NIV = 19;
extern __shared__ __attribute__((aligned(16))) char dynsmem[];
template <int ID> __device__ __forceinline__ void run_iv(const Params& pin, int l, char* smem) {
    Params p = pin; p.ws = launder(pin.ws);
    if constexpr (ID == 0) { ph_pre(p, smem); __syncthreads(); ph_w(p, 0, smem); }
    else if constexpr (ID == 1) ph_n1(p, l);
    else if constexpr (ID == 2) ph_g1(p, smem);
    else if constexpr (ID == 3) ph_qu(p, smem);
    else if constexpr (ID == 4) ph_m2(p, smem);
    else if constexpr (ID == 5) ph_at(p, l, smem);
    else if constexpr (ID == 6) { ph_rp1(p, l, smem); ph_rp2(p, l); ph_f1(p, l, smem); }
    else if constexpr (ID == 7) { ph_r1(p, l, smem); ph_fa(p, smem); }
    else if constexpr (ID == 8) { ph_r2(p, smem); __syncthreads(); ph_fb(p, l, smem); }
    else if constexpr (ID == 9) ph_r3(p);
    else if constexpr (ID == 10) ph_rpost(p, l);
    else if constexpr (ID == 11) { }
    else if constexpr (ID == 12) ph_mg(p, l, smem);
    else if constexpr (ID == 13) ph_out(p, l, smem);
    else if constexpr (ID == 14) ph_n2(p, l, smem);
    else if constexpr (ID == 15) ph_e1(p, l, smem);
    else if constexpr (ID == 16) ph_e2(p, l, smem);
    else if constexpr (ID == 17) { ph_e3(p, l, smem); __syncthreads(); if (l + 1 < NLAYER) ph_w(p, l + 1, smem); }
    else ph_final(p);
}
#if MEGA
#ifndef PROBE_MASK
#define PROBE_MASK 0
#define PROBE_REP 1
#endif
#define IV(ID) for (int r_ = 0; r_ < (((PROBE_MASK >> (ID)) & 1) ? PROBE_REP : 1); ++r_) { run_iv<ID>(p, l, smem); xcd_barrier(bar); }
__global__ void __launch_bounds__(256, 2) k_mega(Params p) {
    char* smem = dynsmem;
    volatile LAS unsigned* st = (volatile LAS unsigned*)(smem + LDS_BYTES - 16);
    if (tidx() == 0) { st[0] = 0u; st[1] = 0u; }
    __syncthreads();
    XcdBarrier bar = xcd_barrier_post((unsigned*)(p.ws + O_BAR), st);
    { const int l = 0; IV(0) }
    for (int l = 0; l < NLAYER; ++l) {
        IV(1) IV(2) IV(3) IV(4) IV(5) IV(6) IV(7) IV(8) IV(9) IV(10) IV(12) IV(13) IV(14) IV(15) IV(16) IV(17)
    }
    run_iv<18>(p, 0, smem);
}
#else
template <int ID> __global__ void __launch_bounds__(256, 2) k_iv(Params p, int l) { run_iv<ID>(p, l, dynsmem); }
template <int ID> static void launch_iv(const Params& p, int l, int grid, hipStream_t s) {
    static bool once = false; if (!once) { once = true; (void)hipFuncSetAttribute((const void*)k_iv<ID>, hipFuncAttributeMaxDynamicSharedMemorySize, LDS_BYTES); }
    hipLaunchKernelGGL(k_iv<ID>, dim3(grid), dim3(256), LDS_BYTES, s, p, l);
}
#endif

extern "C" void kernel_launch(void* const* d_in, const int* in_sizes, int n_in, void* d_out, int out_size, void* d_ws, size_t ws_size, hipStream_t stream) {
    (void)in_sizes; (void)out_size;
    if (n_in < N_IN || ws_size < WS_NEED) return;
    Params p{};
    for (int i = 0; i < N_IN; ++i) p.in[i] = (const float*)d_in[i];
    p.out = (float*)d_out; p.ws = (char*)d_ws;
    static int grid = 0;
    if (!grid) {
        int dev = 0, cus = 0; (void)hipGetDevice(&dev); (void)hipDeviceGetAttribute(&cus, hipDeviceAttributeMultiprocessorCount, dev);
        int per_cu = 2;
#if MEGA
        (void)hipFuncSetAttribute((const void*)k_mega, hipFuncAttributeMaxDynamicSharedMemorySize, LDS_BYTES);
        int occ = 0; (void)hipOccupancyMaxActiveBlocksPerMultiprocessor(&occ, k_mega, 256, LDS_BYTES);
        if (occ < per_cu) per_cu = occ;
        if (per_cu < 1) per_cu = 1;
#endif
        grid = cus * per_cu;
    }
#if MEGA
    (void)hipMemsetAsync(p.ws + O_BAR, 0, 16384, stream);
    hipLaunchKernelGGL(k_mega, dim3(grid), dim3(256), LDS_BYTES, stream, p);
#else
    launch_iv<0>(p, 0, grid, stream);
    for (int l = 0; l < NLAYER; ++l) {
        launch_iv<1>(p, l, grid, stream); launch_iv<2>(p, l, grid, stream); launch_iv<3>(p, l, grid, stream); launch_iv<4>(p, l, grid, stream);
        launch_iv<5>(p, l, grid, stream); launch_iv<6>(p, l, grid, stream); launch_iv<7>(p, l, grid, stream); launch_iv<8>(p, l, grid, stream);
        launch_iv<9>(p, l, grid, stream); launch_iv<10>(p, l, grid, stream); launch_iv<12>(p, l, grid, stream);
        launch_iv<13>(p, l, grid, stream); launch_iv<14>(p, l, grid, stream); launch_iv<15>(p, l, grid, stream); launch_iv<16>(p, l, grid, stream); launch_iv<17>(p, l, grid, stream);
    }
    launch_iv<18>(p, 0, grid, stream);
#endif
}
```

```cpp
#include <hip/hip_runtime.h>
#include <stdint.h>

#ifndef MEGA
#define MEGA 1
#endif

typedef unsigned short bf16_t;
typedef short bf16x8 __attribute__((ext_vector_type(8)));
typedef float f32x4 __attribute__((ext_vector_type(4)));
typedef float f32x2 __attribute__((ext_vector_type(2)));
typedef unsigned u32x4 __attribute__((ext_vector_type(4)));
typedef __bf16 bf16v2 __attribute__((ext_vector_type(2)));

constexpr int NLAYER = 4;
constexpr int DM = 1024;
constexpr int RL = 16384, RC = 1024, RT = RL + RC;
constexpr int SEQ = 4096, CTX = 256, KEYS = SEQ + CTX;
constexpr int LDP = 6144;
constexpr int PQ0 = 512, PKV0 = 896, PKR0 = 1152, PR0 = 1184, PG0 = 2976, PEND = 6048;
constexpr int NEXP = 16;
constexpr int EROWS = 54272;

enum { I_X = 0, I_C, I_CTX, I_CCTX, I_WADA, I_BADA, I_N1G, I_N2G, I_WIN, I_QNG, I_KVNG, I_WUQ, I_WUKV, I_MU, I_W0, I_WUP, I_A0, I_AUP, I_GUP,
       I_KK, I_KA, I_RK, I_GNG, I_GNB, I_WPA, I_WPB, I_WPC, I_WOUT, I_RW, I_RB, I_EG, I_EU, I_ED, I_SG, I_SU, I_SD, I_FNG, N_IN };

struct Params { const float* in[N_IN]; float* out; char* ws; };

constexpr size_t al256(size_t x) { return (x + 255) & ~(size_t)255; }
constexpr size_t O_BAR   = 0;
constexpr size_t O_CNT   = O_BAR + 16384;
constexpr size_t O_MOD   = O_CNT + 4096;
constexpr size_t O_ROPEC = O_MOD + (size_t)NLAYER * 5 * 6144 * 4;
constexpr size_t O_ROPES = O_ROPEC + (size_t)SEQ * 16 * 4;
constexpr size_t O_CSC   = O_ROPES + (size_t)SEQ * 16 * 4;
constexpr size_t O_CST256= O_CSC + 256 * 128 * 2;
constexpr size_t O_D128  = O_CST256 + 256 * 512 * 2;
constexpr size_t O_E64   = O_D128 + 128 * 128 * 2;
constexpr size_t O_TWC   = O_E64 + 64 * 128 * 2;
constexpr size_t O_TWS   = O_TWC + 64 * 64 * 4;
constexpr size_t O_YT2   = O_TWS + 64 * 64 * 4;
constexpr size_t O_A2    = O_YT2 + (size_t)4 * 512 * 64 * 128 * 2;
constexpr size_t O_YTC   = O_A2 + (size_t)4 * 512 * 64 * 128 * 2;
constexpr size_t O_XCUR  = O_YTC + (size_t)4 * 512 * 512 * 2;
constexpr size_t O_WB    = O_XCUR + (size_t)RT * DM * 4;
constexpr size_t W_IN   = 0;
constexpr size_t W_UQ   = W_IN + (size_t)6144 * 1024 * 2;
constexpr size_t W_UKV  = W_UQ + (size_t)768 * 384 * 2;
constexpr size_t W_WUP  = W_UKV + (size_t)1024 * 256 * 2;
constexpr size_t W_AUP  = W_WUP + (size_t)2 * 512 * 64 * 2;
constexpr size_t W_GUP  = W_AUP + (size_t)2 * 512 * 64 * 2;
constexpr size_t W_PA   = W_GUP + (size_t)512 * 128 * 2;
constexpr size_t W_PB   = W_PA + (size_t)1024 * 512 * 2;
constexpr size_t W_PC   = W_PB + (size_t)1024 * 512 * 2;
constexpr size_t W_OUT  = W_PC + (size_t)1024 * 512 * 2;
constexpr size_t W_GU   = W_OUT + (size_t)1024 * 1024 * 2;
constexpr size_t W_D    = W_GU + (size_t)17 * 1024 * 1024 * 2;
constexpr size_t W_END  = W_D + (size_t)17 * 1024 * 512 * 2;
constexpr size_t O_H    = O_WB + W_END;
constexpr size_t O_P    = O_H + (size_t)RT * DM * 2;
constexpr size_t O_ATT  = O_P + (size_t)RT * LDP * 2;
constexpr size_t O_RG   = O_ATT + (size_t)RT * 512 * 2;
constexpr size_t O_RWO  = O_RG + (size_t)RT * 512 * 2;
constexpr size_t O_FA   = O_RWO + (size_t)RT * 512 * 2;
constexpr size_t O_LTOK = O_FA + (size_t)RT * 512 * 2;
constexpr size_t O_LW   = O_LTOK + (size_t)NEXP * RT * 4;
constexpr size_t O_SLOT = O_LW + (size_t)NEXP * RT * 4;
constexpr size_t O_X    = al256(O_SLOT + (size_t)RT * 2 * 4);
constexpr size_t X_QA   = 0;
constexpr size_t X_KA   = X_QA + (size_t)RT * 768 * 2;
constexpr size_t X_VA   = X_KA + (size_t)4 * KEYS * 768 * 2;
constexpr int NCP = 4 * 8 * 2 * 68;
constexpr size_t X_S0   = 0;
constexpr size_t X_MT   = X_VA + (size_t)4 * 8 * 64 * KEYS * 2;
constexpr size_t X_GT   = X_MT + (size_t)NCP * 8192;
constexpr size_t X_YL   = X_GT + (size_t)NCP * 8192;
constexpr size_t X_QRAW = X_MT;
constexpr size_t X_KVRAW= X_QRAW + (size_t)RT * 768 * 2;
constexpr size_t X_KKN  = X_YL + (size_t)NCP * 8192;
constexpr size_t X_BON  = X_KKN + (size_t)RT * 8 * 4;
constexpr size_t X_END  = X_BON + (size_t)2 * RT * 8 * 4;
static_assert(X_KVRAW + (size_t)RT * 1024 * 2 <= X_YL + (size_t)NCP * 8192, "raw q/kv must fit under the chunk data");
static_assert(X_S0 + (size_t)NCP * 8192 <= X_VA, "S0 must fit in the q/k area");
constexpr size_t X_YE   = 0;
constexpr size_t WS_NEED = O_X + X_END;

__device__ __forceinline__ float bf2f(bf16_t u) { return __builtin_bit_cast(float, (unsigned)u << 16); }
__device__ __forceinline__ float bflo(unsigned u) { return __builtin_bit_cast(float, u << 16); }
__device__ __forceinline__ float bfhi(unsigned u) { return __builtin_bit_cast(float, u & 0xffff0000u); }
__device__ __forceinline__ unsigned pack2(float lo, float hi) { f32x2 v = {lo, hi}; bf16v2 b = __builtin_convertvector(v, bf16v2); return __builtin_bit_cast(unsigned, b); }
__device__ __forceinline__ bf16_t f2bf(float f) { return (bf16_t)(pack2(f, 0.f) & 0xffffu); }
__device__ __forceinline__ float wsum(float v) {
#pragma unroll
    for (int o = 32; o > 0; o >>= 1) v += __shfl_xor(v, o);
    return v;
}
__device__ __forceinline__ float sigmoidf_(float x) { return 1.f / (1.f + __expf(-x)); }
__device__ __forceinline__ float siluf_(float x) { return x / (1.f + __expf(-x)); }
__device__ __forceinline__ int modidx(int row) { return row < RL ? (row >> 12) : 4; }
__device__ __forceinline__ void unpack8(const uint4& u, float (&f)[8]) {
    f[0] = bflo(u.x); f[1] = bfhi(u.x); f[2] = bflo(u.y); f[3] = bfhi(u.y); f[4] = bflo(u.z); f[5] = bfhi(u.z); f[6] = bflo(u.w); f[7] = bfhi(u.w);
}
__device__ __forceinline__ uint4 pack8(const float (&f)[8]) { return make_uint4(pack2(f[0], f[1]), pack2(f[2], f[3]), pack2(f[4], f[5]), pack2(f[6], f[7])); }

#define XB_TMO      128
#define XB_XCNT(j)  (256  + 64 * (j))
#define XB_XSUB(j)  (1280 + 64 * (j))
#define XB_XGEN(j)  (2304 + 64 * (j))
#define XB_TOP      3328
#define XB_TOPGEN   3392
#define XCD_BAR_WORDS 3456
#define XB_SPIN_CAP (1u << 22)
#define LAS __attribute__((address_space(3)))
__device__ __forceinline__ unsigned xb_ld(unsigned* p)              { return __hip_atomic_load(p, __ATOMIC_RELAXED, __HIP_MEMORY_SCOPE_AGENT); }
__device__ __forceinline__ unsigned xb_add(unsigned* p, unsigned v) { return __hip_atomic_fetch_add(p, v, __ATOMIC_RELAXED, __HIP_MEMORY_SCOPE_AGENT); }
__device__ __forceinline__ unsigned xb_xcc_id() { return (unsigned)__builtin_amdgcn_s_getreg((3 << 11) | 20) & 0xFu; }
#define XB_SPIN(cond, bar) do { unsigned _sp = 0; while (cond) { __builtin_amdgcn_s_sleep(1); \
    if ((++_sp & 255u) == 0u) { if (xb_ld(&(bar)[XB_TMO])) break; if (_sp > XB_SPIN_CAP) { atomicAdd(&(bar)[XB_TMO], 1u); break; } } } } while (0)
struct XcdBarrier { unsigned* bar; unsigned x; volatile LAS unsigned* st; };
__device__ __forceinline__ XcdBarrier xcd_barrier_post(unsigned* bar, volatile LAS unsigned* st) {
    XcdBarrier b; b.bar = bar; b.x = xb_xcc_id(); b.st = st;
    if (threadIdx.x == 0) (void)xb_add(&bar[XB_XCNT(b.x)], 1u);
    return b;
}
__device__ __forceinline__ void xcd_barrier_complete(unsigned* bar, unsigned x, unsigned& nloc, unsigned& nx) {
    const unsigned G = gridDim.x * gridDim.y * gridDim.z;
    unsigned sum, cnt, mine, sp = 0u;
    for (;;) {
        sum = 0u; cnt = 0u; mine = 0u;
#pragma unroll
        for (unsigned j = 0; j < 16; ++j) { const unsigned c = xb_ld(&bar[XB_XCNT(j)]); sum += c; cnt += (c > 0u) ? 1u : 0u; mine = (j == x) ? c : mine; }
        if (sum == G) break;
        __builtin_amdgcn_s_sleep(1);
        if ((++sp & 255u) == 0u) { if (xb_ld(&bar[XB_TMO])) break; if (sp > XB_SPIN_CAP) { atomicAdd(&bar[XB_TMO], 1u); break; } }
    }
    nloc = mine > 0u ? mine : 1u; nx = cnt > 0u ? cnt : 1u;
}
__device__ __forceinline__ void xcd_barrier(const XcdBarrier& b) {
    asm volatile("s_waitcnt vmcnt(0)" ::: "memory");
    __syncthreads();
    if (threadIdx.x == 0) {
        unsigned* bar = b.bar;
        __builtin_amdgcn_s_waitcnt(0);
        unsigned nloc = b.st[0], nx = b.st[1];
        if (nloc == 0u) { xcd_barrier_complete(bar, b.x, nloc, nx); b.st[0] = nloc; b.st[1] = nx; }
        const unsigned old = xb_add(&bar[XB_XSUB(b.x)], 1u);
        const unsigned gen = old / nloc;
        if (old + 1u == (gen + 1u) * nloc) {
            __builtin_amdgcn_fence(__ATOMIC_RELEASE, "agent");
            asm volatile("s_waitcnt vmcnt(0)" ::: "memory");
            const unsigned og = xb_add(&bar[XB_TOP], 1u);
            const unsigned tg = og / nx;
            if (og + 1u == (tg + 1u) * nx) xb_add(&bar[XB_TOPGEN], 1u);
            else XB_SPIN(xb_ld(&bar[XB_TOPGEN]) == tg, bar);
            __builtin_amdgcn_fence(__ATOMIC_ACQUIRE, "agent");
            xb_add(&bar[XB_XGEN(b.x)], 1u);
            asm volatile("s_waitcnt vmcnt(0)" ::: "memory");
        } else {
            XB_SPIN(xb_ld(&bar[XB_XGEN(b.x)]) == gen, bar);
            __builtin_amdgcn_fence(__ATOMIC_ACQUIRE, "agent");
            asm volatile("s_waitcnt vmcnt(0)" ::: "memory");
        }
    }
    __syncthreads();
}

__device__ __forceinline__ int tidx() { int t = threadIdx.x; asm volatile("" : "+v"(t)); return t; }
__device__ __forceinline__ int lv(int x) { asm volatile("" : "+v"(x)); return x; }
__device__ __forceinline__ char* launder(char* p) { size_t z = 0; asm volatile("" : "+s"(z)); return p + z; }

constexpr int LDSROW = 72;
template <int NA, class AL>
__device__ __forceinline__ void gc_load(const AL& al, const bf16_t* bp, size_t bstep, int k0, int kc, u32x4 (&ra)[NA], u32x4 (&rb)[4]) {
#pragma unroll
    for (int i = 0; i < NA; ++i) ra[i] = __builtin_bit_cast(u32x4, al.load(i, k0 + kc));
#pragma unroll
    for (int j = 0; j < 4; ++j) rb[j] = *(const u32x4*)(bp + j * bstep + k0);
}
template <int NA>
__device__ __forceinline__ void gc_store(bf16_t* Ab, bf16_t* Bb, int lr, int kc, const u32x4 (&ra)[NA], const u32x4 (&rb)[4]) {
#pragma unroll
    for (int i = 0; i < NA; ++i) *(u32x4*)(Ab + (lr + 32 * i) * LDSROW + kc) = ra[i];
#pragma unroll
    for (int j = 0; j < 4; ++j) *(u32x4*)(Bb + (lr + 32 * j) * LDSROW + kc) = rb[j];
}
template <int MI>
__device__ __forceinline__ void gc_compute(const bf16_t* Ac, const bf16_t* Bc, f32x4 (&acc)[MI][4]) {
#pragma unroll
    for (int kh = 0; kh < 2; ++kh) {
        bf16x8 af[MI], bfv[4];
#pragma unroll
        for (int i = 0; i < MI; ++i) af[i] = *(const bf16x8*)(Ac + i * 16 * LDSROW + kh * 32);
#pragma unroll
        for (int j = 0; j < 4; ++j) bfv[j] = *(const bf16x8*)(Bc + j * 16 * LDSROW + kh * 32);
#pragma unroll
        for (int i = 0; i < MI; ++i)
#pragma unroll
            for (int j = 0; j < 4; ++j) acc[i][j] = __builtin_amdgcn_mfma_f32_16x16x32_bf16(bfv[j], af[i], acc[i][j], 0, 0, 0);
    }
}
template <int MI, class AL>
__device__ __forceinline__ void gemm_core(const AL& al, const bf16_t* __restrict__ Bt, int ldb, int K, f32x4 (&acc)[MI][4], char* smem) {
    constexpr int TM = MI * 32;
    constexpr int NA = TM / 32;
    bf16_t* As = (bf16_t*)smem;
    bf16_t* Bs = As + 2 * TM * LDSROW;
    const int tid = tidx(), lane = tid & 63, wave = tid >> 6;
    const int wr = wave >> 1, wc = wave & 1, fr = lane & 15, fq = lane >> 4;
    const int kc = (tid & 7) * 8, lr = tid >> 3;
#pragma unroll
    for (int i = 0; i < MI; ++i)
#pragma unroll
        for (int j = 0; j < 4; ++j) acc[i][j] = (f32x4){0.f, 0.f, 0.f, 0.f};
    u32x4 a0[NA], b0[4], a1[NA], b1[4];
    const bf16_t* bp = Bt + (size_t)lr * ldb + kc;
    const size_t bstep = (size_t)32 * ldb;
    const int nk = K >> 6;
    bf16_t* As1 = As + TM * LDSROW; bf16_t* Bs1 = Bs + 128 * LDSROW;
    const int aoff = (wr * MI * 16 + fr) * LDSROW + fq * 8, boff = (wc * 64 + fr) * LDSROW + fq * 8;
    gc_load<NA>(al, bp, bstep, 0, kc, a0, b0);
    gc_store<NA>(As, Bs, lr, kc, a0, b0);
    if (nk > 1) gc_load<NA>(al, bp, bstep, 64, kc, a0, b0);
    __syncthreads();
    for (int kt = 0; kt < nk; kt += 2) {
        if (kt + 2 < nk) gc_load<NA>(al, bp, bstep, (kt + 2) << 6, kc, a1, b1);
        gc_compute<MI>(As + aoff, Bs + boff, acc);
        if (kt + 1 < nk) gc_store<NA>(As1, Bs1, lr, kc, a0, b0);
        __syncthreads();
        if (kt + 1 >= nk) break;
        if (kt + 3 < nk) gc_load<NA>(al, bp, bstep, (kt + 3) << 6, kc, a0, b0);
        gc_compute<MI>(As1 + aoff, Bs1 + boff, acc);
        if (kt + 2 < nk) gc_store<NA>(As, Bs, lr, kc, a1, b1);
        __syncthreads();
    }
}
template <int MI, class RP, class RPB>
__device__ __forceinline__ void gemm_core_gb(const RP& rp, const RPB& rpb, int K, f32x4 (&acc)[MI][4], char* smem) {
    constexpr int ABYTES = MI * 32 * 128;
    constexpr int SBYTES = ABYTES + 16384;
    const int tid = tidx(), lane = tid & 63, wave = tid >> 6;
    const int wr = wave >> 1, wc = wave & 1, fr = lane & 15, fq = lane >> 4;
    const int rr = lane >> 3, cs = ((lane & 7) ^ ((wave * 4 + (lane >> 4)) & 7)) * 8;
#pragma unroll
    for (int i = 0; i < MI; ++i)
#pragma unroll
        for (int j = 0; j < 4; ++j) acc[i][j] = (f32x4){0.f, 0.f, 0.f, 0.f};
    const bf16_t* ap[MI]; const bf16_t* bp[4];
#pragma unroll
    for (int i = 0; i < MI; ++i) { const int r = (i * 4 + wave) * 8 + rr; ap[i] = rp(r) + cs; }
#pragma unroll
    for (int i = 0; i < 4; ++i) { const int r = (i * 4 + wave) * 8 + rr; bp[i] = rpb(r) + cs; }
    const int wbase = __builtin_amdgcn_readfirstlane(wave) * 1024;
    const int nk = K >> 6;
    auto stage = [&](int buf, int kt) {
        char* Ab = smem + buf * SBYTES + wbase; char* Bb = Ab + ABYTES;
#pragma unroll
        for (int i = 0; i < MI; ++i) __builtin_amdgcn_global_load_lds((const unsigned*)(ap[i] + kt * 64), (unsigned*)(Ab + i * 4096), 16, 0, 0);
#pragma unroll
        for (int i = 0; i < 4; ++i) __builtin_amdgcn_global_load_lds((const unsigned*)(bp[i] + kt * 64), (unsigned*)(Bb + i * 4096), 16, 0, 0);
    };
    const int aoff = (wr * MI * 16 + fr) * 128, boff = ABYTES + (wc * 64 + fr) * 128, sw = fr >> 1;
    stage(0, 0);
    asm volatile("s_waitcnt vmcnt(0)" ::: "memory");
    __syncthreads();
    for (int kt = 0; kt < nk; ++kt) {
        const int cur = kt & 1;
        if (kt + 1 < nk) stage(cur ^ 1, kt + 1);
        const char* base = smem + cur * SBYTES;
#pragma unroll
        for (int kh = 0; kh < 2; ++kh) {
            const int xo = ((kh * 4 + fq) ^ sw) * 16;
            bf16x8 af[MI], bfv[4];
#pragma unroll
            for (int i = 0; i < MI; ++i) af[i] = *(const bf16x8*)(base + aoff + i * 2048 + xo);
#pragma unroll
            for (int j = 0; j < 4; ++j) bfv[j] = *(const bf16x8*)(base + boff + j * 2048 + xo);
#pragma unroll
            for (int i = 0; i < MI; ++i)
#pragma unroll
                for (int j = 0; j < 4; ++j) acc[i][j] = __builtin_amdgcn_mfma_f32_16x16x32_bf16(bfv[j], af[i], acc[i][j], 0, 0, 0);
        }
        asm volatile("s_waitcnt vmcnt(0)" ::: "memory");
        __syncthreads();
    }
}
template <int MI, class RP, class RPB>
__device__ __forceinline__ void gemm_core_p(const RP& rp, const RPB& rpb, int K, f32x4 (&acc)[MI][4], char* smem) {
    constexpr int NAI = MI / 2;
    constexpr int BOFF = 8192;
    const int tid = tidx(), lane = tid & 63, wave = tid >> 6;
    const int wr = wave >> 1, wc = wave & 1, fr = lane & 15, fq = lane >> 4;
    const int cs = ((lane & 3) ^ ((lane >> 4) & 3)) * 8;
#pragma unroll
    for (int i = 0; i < MI; ++i)
#pragma unroll
        for (int j = 0; j < 4; ++j) acc[i][j] = (f32x4){0.f, 0.f, 0.f, 0.f};
    const bf16_t* ap[NAI]; const bf16_t* bp[2];
#pragma unroll
    for (int i = 0; i < NAI; ++i) ap[i] = rp((wave * NAI + i) * 16 + (lane >> 2)) + cs;
#pragma unroll
    for (int i = 0; i < 2; ++i) bp[i] = rpb((wave * 2 + i) * 16 + (lane >> 2)) + cs;
    const int wA = __builtin_amdgcn_readfirstlane(wave) * (NAI * 1024), wB = BOFF + __builtin_amdgcn_readfirstlane(wave) * 2048;
    const unsigned lds0 = (unsigned)(uintptr_t)smem;
    const unsigned sw = (unsigned)((fq ^ ((fr >> 2) & 3)) * 16);
    const unsigned abase = lds0 + (unsigned)((wr * MI * 16 + fr) * 64) + sw, bbase = lds0 + BOFF + (unsigned)((wc * 64 + fr) * 64) + sw;
    const int nk = K >> 5;
#define GP_ISSUE(KT, SLOT) do { char* d_ = smem + (SLOT) * 16384; \
        _Pragma("unroll") for (int i = 0; i < NAI; ++i) __builtin_amdgcn_global_load_lds((const unsigned*)(ap[i] + (KT) * 32), (unsigned*)(d_ + wA + i * 1024), 16, 0, 0); \
        _Pragma("unroll") for (int i = 0; i < 2; ++i) __builtin_amdgcn_global_load_lds((const unsigned*)(bp[i] + (KT) * 32), (unsigned*)(d_ + wB + i * 1024), 16, 0, 0); } while (0)
#define GP_RD(DST, ADDR, OFF) asm volatile("ds_read_b128 %0, %1 offset:%2" : "=v"(DST) : "v"(ADDR), "n"(OFF))
#define GP_READ(FA_, FB_, SLOT) do { \
        GP_RD(FA_[0], abase, (SLOT) * 16384 + 0 * 1024); GP_RD(FA_[1], abase, (SLOT) * 16384 + 1 * 1024); \
        if (MI == 4) { GP_RD(FA_[MI - 2], abase, (SLOT) * 16384 + 2 * 1024); GP_RD(FA_[MI - 1], abase, (SLOT) * 16384 + 3 * 1024); } \
        GP_RD(FB_[0], bbase, (SLOT) * 16384 + 0 * 1024); GP_RD(FB_[1], bbase, (SLOT) * 16384 + 1 * 1024); \
        GP_RD(FB_[2], bbase, (SLOT) * 16384 + 2 * 1024); GP_RD(FB_[3], bbase, (SLOT) * 16384 + 3 * 1024); } while (0)
#define GP_MMA(FA_, FB_) do { \
        _Pragma("unroll") for (int i = 0; i < MI; ++i) \
            _Pragma("unroll") for (int j = 0; j < 4; ++j) acc[i][j] = __builtin_amdgcn_mfma_f32_16x16x32_bf16(__builtin_bit_cast(bf16x8, FB_[j]), __builtin_bit_cast(bf16x8, FA_[i]), acc[i][j], 0, 0, 0); } while (0)
#define GP_STEP(KT, FA_, FB_, FAN, FBN, SLOTN, SLOTI) do { \
        if ((KT) + 1 < nk) { \
            if ((KT) + 2 < nk) asm volatile("s_waitcnt vmcnt(%0)" :: "n"(NAI + 2) : "memory"); else asm volatile("s_waitcnt vmcnt(0)" ::: "memory"); \
            __builtin_amdgcn_s_barrier(); \
            asm volatile("" ::: "memory"); \
            if ((KT) + 3 < nk) GP_ISSUE((KT) + 3, SLOTI); \
            GP_READ(FAN, FBN, SLOTN); \
            asm volatile("s_waitcnt lgkmcnt(%0)" :: "n"(MI + 4) : "memory"); \
        } else asm volatile("s_waitcnt lgkmcnt(0)" ::: "memory"); \
        __builtin_amdgcn_sched_barrier(0); \
        GP_MMA(FA_, FB_); \
        __builtin_amdgcn_sched_barrier(0); } while (0)
    u32x4 fa0[MI], fb0[4], fa1[MI], fb1[4];
    GP_ISSUE(0, 0); GP_ISSUE(1, 1); GP_ISSUE(2, 2);
    asm volatile("s_waitcnt vmcnt(%0)" :: "n"(2 * (NAI + 2)) : "memory");
    __builtin_amdgcn_s_barrier();
    asm volatile("" ::: "memory");
    GP_READ(fa0, fb0, 0);
    for (int kt = 0; kt < nk; kt += 4) {
        GP_STEP(kt,     fa0, fb0, fa1, fb1, 1, 3);
        GP_STEP(kt + 1, fa1, fb1, fa0, fb0, 2, 0);
        GP_STEP(kt + 2, fa0, fb0, fa1, fb1, 3, 1);
        GP_STEP(kt + 3, fa1, fb1, fa0, fb0, 0, 2);
    }
#undef GP_ISSUE
#undef GP_RD
#undef GP_READ
#undef GP_MMA
#undef GP_STEP
    __syncthreads();
}
template <class RP, class RPB>
__device__ __forceinline__ void gemm_core_w(const RP& rp, const RPB& rpb, int K, f32x4 (&acc)[8][4], char* smem) {
    constexpr int SLOTB = 24576, BOFF = 16384;
    const int tid = tidx(), lane = tid & 63, wave = tid >> 6;
    const int wr = wave >> 1, wc = wave & 1, fr = lane & 15, fq = lane >> 4;
    const int cs = ((lane & 3) ^ ((lane >> 4) & 3)) * 8;
#pragma unroll
    for (int i = 0; i < 8; ++i)
#pragma unroll
        for (int j = 0; j < 4; ++j) acc[i][j] = (f32x4){0.f, 0.f, 0.f, 0.f};
    const bf16_t* ap[4]; const bf16_t* bp[2];
#pragma unroll
    for (int i = 0; i < 4; ++i) ap[i] = rp((wave * 4 + i) * 16 + (lane >> 2)) + cs;
#pragma unroll
    for (int i = 0; i < 2; ++i) bp[i] = rpb((wave * 2 + i) * 16 + (lane >> 2)) + cs;
    const int wA = __builtin_amdgcn_readfirstlane(wave) * 4096, wB = BOFF + __builtin_amdgcn_readfirstlane(wave) * 2048;
    const unsigned lds0 = (unsigned)(uintptr_t)smem;
    const unsigned sw = (unsigned)((fq ^ ((fr >> 2) & 3)) * 16);
    const unsigned abase = lds0 + (unsigned)((wr * 128 + fr) * 64) + sw, bbase = lds0 + BOFF + (unsigned)((wc * 64 + fr) * 64) + sw;
    const int nk = K >> 5;
    auto issue = [&](int kt, int slot) {
        char* d = smem + slot * SLOTB;
#pragma unroll
        for (int i = 0; i < 4; ++i) __builtin_amdgcn_global_load_lds((const unsigned*)(ap[i] + kt * 32), (unsigned*)(d + wA + i * 1024), 16, 0, 0);
#pragma unroll
        for (int i = 0; i < 2; ++i) __builtin_amdgcn_global_load_lds((const unsigned*)(bp[i] + kt * 32), (unsigned*)(d + wB + i * 1024), 16, 0, 0);
    };
    issue(0, 0);
    if (nk > 1) issue(1, 1);
    int slot = 0;
    for (int kt = 0; kt < nk; ++kt) {
        if (kt + 1 < nk) asm volatile("s_waitcnt vmcnt(6)" ::: "memory"); else asm volatile("s_waitcnt vmcnt(0)" ::: "memory");
        __builtin_amdgcn_s_barrier();
        asm volatile("" ::: "memory");
        if (kt + 2 < nk) issue(kt + 2, slot >= 1 ? slot - 1 : 2);
        const unsigned aa = abase + (unsigned)(slot * SLOTB), bb = bbase + (unsigned)(slot * SLOTB);
        u32x4 fa[8], fb[4];
#define GW_RD(DST, ADDR, OFF) asm volatile("ds_read_b128 %0, %1 offset:%2" : "=v"(DST) : "v"(ADDR), "n"(OFF))
        GW_RD(fa[0], aa, 0); GW_RD(fa[1], aa, 1024); GW_RD(fa[2], aa, 2048); GW_RD(fa[3], aa, 3072);
        GW_RD(fa[4], aa, 4096); GW_RD(fa[5], aa, 5120); GW_RD(fa[6], aa, 6144); GW_RD(fa[7], aa, 7168);
        GW_RD(fb[0], bb, 0); GW_RD(fb[1], bb, 1024); GW_RD(fb[2], bb, 2048); GW_RD(fb[3], bb, 3072);
#undef GW_RD
        asm volatile("s_waitcnt lgkmcnt(0)" ::: "memory");
        __builtin_amdgcn_sched_barrier(0);
#pragma unroll
        for (int i = 0; i < 8; ++i)
#pragma unroll
            for (int j = 0; j < 4; ++j) acc[i][j] = __builtin_amdgcn_mfma_f32_16x16x32_bf16(__builtin_bit_cast(bf16x8, fb[j]), __builtin_bit_cast(bf16x8, fa[i]), acc[i][j], 0, 0, 0);
        __builtin_amdgcn_sched_barrier(0);
        slot = slot == 2 ? 0 : slot + 1;
    }
    __syncthreads();
}
struct RPPlain;
template <int MI, class RP>
__device__ __forceinline__ void gemm_core_g(const RP& rp, const bf16_t* __restrict__ Bt, int ldb, int K, f32x4 (&acc)[MI][4], char* smem);
struct RPPlain {
    const bf16_t* A; size_t lda;
    __device__ __forceinline__ const bf16_t* operator()(int r) const { return A + (size_t)r * lda; }
};
template <int MI, class RP>
__device__ __forceinline__ void gemm_core_g(const RP& rp, const bf16_t* __restrict__ Bt, int ldb, int K, f32x4 (&acc)[MI][4], char* smem) {
    RPPlain rpb{Bt, (size_t)ldb};
    gemm_core_gb<MI>(rp, rpb, K, acc, smem);
}
template <int MI, class F>
__device__ __forceinline__ void acc_foreach(const f32x4 (&acc)[MI][4], F f) {
    const int lane = tidx() & 63, wave = tidx() >> 6;
    const int wr = wave >> 1, wc = wave & 1, fr = lane & 15, fq = lane >> 4;
#pragma unroll
    for (int i = 0; i < MI; ++i)
#pragma unroll
        for (int j = 0; j < 4; ++j) f(wr * MI * 16 + i * 16 + fr, wc * 64 + j * 16 + fq * 4, acc[i][j]);
}
struct ALPlain {
    const bf16_t* p0; size_t step;
    __device__ __forceinline__ ALPlain(const bf16_t* A, int lda, int row0) { p0 = A + (size_t)(row0 + (tidx() >> 3)) * lda; step = (size_t)32 * lda; }
    __device__ __forceinline__ uint4 load(int i, int k) const { return *(const uint4*)(p0 + i * step + k); }
};
__device__ __forceinline__ void store_bf16x4(bf16_t* dst, const f32x4& v) { *(uint2*)dst = make_uint2(pack2(v[0], v[1]), pack2(v[2], v[3])); }

__device__ __forceinline__ void ph_pre(const Params& p, char* smem) {
    const int tid = tidx(), nb = gridDim.x, bid = blockIdx.x;
    float* mod = (float*)(p.ws + O_MOD);
    {
        float* sv = (float*)smem;
        float* part = sv + 5 * 1024;
        for (int i = tid; i < 5 * 1024; i += 256) { const float v = (i < 4096) ? p.in[I_C][i] : p.in[I_CCTX][i - 4096]; sv[i] = siluf_(v); }
        __syncthreads();
        for (int it = bid; it < NLAYER * 96; it += nb) {
            const int l = it / 96, jb = it % 96;
            const int jj = tid & 63, kq = tid >> 6, j = jb * 64 + jj;
            const float* w = p.in[I_WADA] + (size_t)l * 1024 * 6144 + (size_t)(kq * 256) * 6144 + j;
            float a0 = 0.f, a1 = 0.f, a2 = 0.f, a3 = 0.f, a4 = 0.f;
#pragma unroll 8
            for (int k = 0; k < 256; ++k) {
                const float wv = w[(size_t)k * 6144]; const int kk = kq * 256 + k;
                a0 += sv[kk] * wv; a1 += sv[1024 + kk] * wv; a2 += sv[2048 + kk] * wv; a3 += sv[3072 + kk] * wv; a4 += sv[4096 + kk] * wv;
            }
            part[(kq * 5 + 0) * 64 + jj] = a0; part[(kq * 5 + 1) * 64 + jj] = a1; part[(kq * 5 + 2) * 64 + jj] = a2;
            part[(kq * 5 + 3) * 64 + jj] = a3; part[(kq * 5 + 4) * 64 + jj] = a4;
            __syncthreads();
            for (int o = tid; o < 320; o += 256) {
                const int i = o >> 6, c = o & 63;
                const float s = part[(0 * 5 + i) * 64 + c] + part[(1 * 5 + i) * 64 + c] + part[(2 * 5 + i) * 64 + c] + part[(3 * 5 + i) * 64 + c];
                mod[(size_t)(l * 5 + i) * 6144 + jb * 64 + c] = s + p.in[I_BADA][l * 6144 + jb * 64 + c];
            }
            __syncthreads();
        }
    }
    {
        float4* xc = (float4*)(p.ws + O_XCUR);
        const float4* x4 = (const float4*)p.in[I_X]; const float4* c4 = (const float4*)p.in[I_CTX];
        for (size_t i = (size_t)bid * 256 + tid; i < (size_t)RT * 256; i += (size_t)nb * 256) xc[i] = (i < (size_t)RL * 256) ? x4[i] : c4[i - (size_t)RL * 256];
    }
    {
        float* ct = (float*)smem;
        __syncthreads();
        for (int m = tid; m < 4096; m += 256) ct[m] = cospif((float)m * (1.f / 2048.f));
        __syncthreads();
        bf16_t* cst2 = (bf16_t*)(p.ws + O_CST256);
        for (int ch = bid * 256 + tid; ch < 256 * 512 / 8; ch += nb * 256) {
            const int ks = ch >> 6, c0 = (ch & 63) * 8, part = c0 >> 8, s0 = c0 & 255;
            float f[8];
#pragma unroll
            for (int e = 0; e < 8; ++e) { const int m = (16 * ks * (s0 + e)) & 4095; f[e] = part == 0 ? ct[m] : ct[(m - 1024) & 4095]; }
            *(uint4*)(cst2 + ch * 8) = pack8(f);
        }
        bf16_t* d128 = (bf16_t*)(p.ws + O_D128);
        for (int ch = bid * 256 + tid; ch < 128 * 128 / 8; ch += nb * 256) {
            const int mrow = ch >> 4, c0 = (ch & 15) * 8, po = mrow >> 6, k1 = mrow & 63, pi = c0 >> 6, t10 = c0 & 63;
            float f[8];
#pragma unroll
            for (int e = 0; e < 8; ++e) {
                const int m = (64 * k1 * (t10 + e)) & 4095; const float cv = ct[m], sv = ct[(m - 1024) & 4095];
                f[e] = (po == pi) ? cv : (po == 0 ? sv : -sv);
            }
            *(uint4*)(d128 + ch * 8) = pack8(f);
        }
        bf16_t* e64 = (bf16_t*)(p.ws + O_E64);
        for (int ch = bid * 256 + tid; ch < 64 * 128 / 8; ch += nb * 256) {
            const int k2 = ch >> 4, c0 = (ch & 15) * 8, po = c0 >> 6, t20 = c0 & 63;
            float f[8];
#pragma unroll
            for (int e = 0; e < 8; ++e) { const int m = (64 * k2 * (t20 + e)) & 4095; f[e] = po == 0 ? ct[m] : ct[(m - 1024) & 4095]; }
            *(uint4*)(e64 + ch * 8) = pack8(f);
        }
        float* twc = (float*)(p.ws + O_TWC); float* tws = (float*)(p.ws + O_TWS);
        for (int i = bid * 256 + tid; i < 64 * 64; i += nb * 256) {
            const int k1 = i >> 6, t2 = i & 63, m = (k1 * t2) & 4095;
            twc[i] = ct[m]; tws[i] = -ct[(m - 1024) & 4095];
        }
        bf16_t* csc = (bf16_t*)(p.ws + O_CSC);
        for (int ch = bid * 256 + tid; ch < 256 * 128 / 8; ch += nb * 256) {
            const int n = ch >> 4, c0 = (ch & 15) * 8, part = n >> 7, kc = n & 127;
            float f[8];
#pragma unroll
            for (int e = 0; e < 8; ++e) { const int m = (32 * kc * (c0 + e)) & 4095; f[e] = part == 0 ? ct[m] : -ct[(m - 1024) & 4095]; }
            *(uint4*)(csc + ch * 8) = pack8(f);
        }
        float* rc = (float*)(p.ws + O_ROPEC); float* rs = (float*)(p.ws + O_ROPES);
        for (int i = bid * 256 + tid; i < SEQ * 16; i += nb * 256) {
            const int t = i >> 4, ax = (i >> 3) & 1, f = i & 7;
            const float inv = powf(10000.f, -(float)f / 8.f);
            const float pos = (float)(ax == 0 ? (t >> 6) : (t & 63));
            const float ang = pos * inv;
            rc[i] = cosf(ang); rs[i] = sinf(ang);
        }
    }
}

struct ConvTask { const float* src; const float* scale; bf16_t* dst; int K, Nsrc, Ndst, rmul; size_t sbs, dbs; };
__constant__ int c_conv_cum[17] = {0, 1536, 1608, 1672, 1688, 1704, 1720, 1848, 1976, 2104, 2360, 4408, 6456, 8504, 8632, 8760, 8888};
__device__ __forceinline__ ConvTask conv_task(const Params& p, int l, int t) {
    bf16_t* wb = (bf16_t*)(p.ws + O_WB);
    ConvTask c; c.scale = nullptr; c.sbs = 0; c.dbs = 0; c.rmul = 64;
    switch (t) {
    case 0:  c.src = p.in[I_WIN] + (size_t)l * 1024 * 6048; c.K = 1024; c.Nsrc = 6048; c.Ndst = 6144; c.dst = wb + W_IN / 2; break;
    case 1:  c.src = p.in[I_WUQ] + (size_t)l * 384 * 768; c.K = 384; c.Nsrc = 768; c.Ndst = 768; c.dst = wb + W_UQ / 2; c.scale = p.in[I_QNG] + l * 384; break;
    case 2:  c.src = p.in[I_WUKV] + (size_t)l * 256 * 1024; c.K = 256; c.Nsrc = 1024; c.Ndst = 1024; c.dst = wb + W_UKV / 2; c.scale = p.in[I_KVNG] + l * 256; break;
    case 3:  c.src = p.in[I_WUP] + (size_t)l * 2 * 64 * 512; c.K = 64; c.Nsrc = 512; c.Ndst = 512; c.dst = wb + W_WUP / 2; c.sbs = 64 * 512; c.dbs = 512 * 64; break;
    case 4:  c.src = p.in[I_AUP] + (size_t)l * 2 * 64 * 512; c.K = 64; c.Nsrc = 512; c.Ndst = 512; c.dst = wb + W_AUP / 2; c.sbs = 64 * 512; c.dbs = 512 * 64; break;
    case 5:  c.src = p.in[I_GUP] + (size_t)l * 128 * 512; c.K = 128; c.Nsrc = 512; c.Ndst = 512; c.dst = wb + W_GUP / 2; break;
    case 6:  c.src = p.in[I_WPA] + (size_t)l * 512 * 1024; c.K = 512; c.Nsrc = 1024; c.Ndst = 1024; c.dst = wb + W_PA / 2; break;
    case 7:  c.src = p.in[I_WPB] + (size_t)l * 512 * 1024; c.K = 512; c.Nsrc = 1024; c.Ndst = 1024; c.dst = wb + W_PB / 2; break;
    case 8:  c.src = p.in[I_WPC] + (size_t)l * 512 * 1024; c.K = 512; c.Nsrc = 1024; c.Ndst = 1024; c.dst = wb + W_PC / 2; break;
    case 9:  c.src = p.in[I_WOUT] + (size_t)l * 1024 * 1024; c.K = 1024; c.Nsrc = 1024; c.Ndst = 1024; c.dst = wb + W_OUT / 2; break;
    case 10: c.src = p.in[I_EG] + (size_t)l * 16 * 1024 * 512; c.K = 1024; c.Nsrc = 512; c.Ndst = 512; c.dst = wb + W_GU / 2; c.sbs = 1024 * 512; c.dbs = 1024 * 1024; c.rmul = 128; break;
    case 11: c.src = p.in[I_EU] + (size_t)l * 16 * 1024 * 512; c.K = 1024; c.Nsrc = 512; c.Ndst = 512; c.dst = wb + W_GU / 2 + 64 * 1024; c.sbs = 1024 * 512; c.dbs = 1024 * 1024; c.rmul = 128; break;
    case 12: c.src = p.in[I_ED] + (size_t)l * 16 * 512 * 1024; c.K = 512; c.Nsrc = 1024; c.Ndst = 1024; c.dst = wb + W_D / 2; c.sbs = 512 * 1024; c.dbs = 1024 * 512; break;
    case 13: c.src = p.in[I_SG] + (size_t)l * 1024 * 512; c.K = 1024; c.Nsrc = 512; c.Ndst = 512; c.dst = wb + W_GU / 2 + (size_t)16 * 1024 * 1024; c.rmul = 128; break;
    case 14: c.src = p.in[I_SU] + (size_t)l * 1024 * 512; c.K = 1024; c.Nsrc = 512; c.Ndst = 512; c.dst = wb + W_GU / 2 + (size_t)16 * 1024 * 1024 + 64 * 1024; c.rmul = 128; break;
    default: c.src = p.in[I_SD] + (size_t)l * 512 * 1024; c.K = 512; c.Nsrc = 1024; c.Ndst = 1024; c.dst = wb + W_D / 2 + (size_t)16 * 1024 * 512; break;
    }
    return c;
}
__device__ __forceinline__ void ph_w(const Params& p, int l, char* smem) {
    const int tid = tidx();
    float* tl = (float*)smem;
    for (int g = blockIdx.x; g < 8888; g += gridDim.x) {
        int t = 0;
        while (g >= c_conv_cum[t + 1]) ++t;
        const ConvTask c = conv_task(p, l, t);
        int r = g - c_conv_cum[t];
        const int nkt = c.K >> 6, nnt = c.Ndst >> 6;
        const int bi = r / (nkt * nnt); r -= bi * nkt * nnt;
        const int k0 = (r / nnt) * 64, n0 = (r % nnt) * 64;
        const float* src = c.src + bi * c.sbs; bf16_t* dst = c.dst + bi * c.dbs;
#pragma unroll
        for (int i = 0; i < 4; ++i) {
            const int k = (tid >> 4) + 16 * i, n = n0 + (tid & 15) * 4;
            float4 v = make_float4(0.f, 0.f, 0.f, 0.f);
            if (n < c.Nsrc) v = *(const float4*)(src + (size_t)(k0 + k) * c.Nsrc + n);
            if (c.scale) { const float s = c.scale[k0 + k]; v.x *= s; v.y *= s; v.z *= s; v.w *= s; }
            float* d = tl + k * 65 + (tid & 15) * 4;
            d[0] = v.x; d[1] = v.y; d[2] = v.z; d[3] = v.w;
        }
        __syncthreads();
        {
            const int n = tid >> 2, kk0 = (tid & 3) * 16;
            float f[8], g2[8];
#pragma unroll
            for (int j = 0; j < 8; ++j) { f[j] = tl[(kk0 + j) * 65 + n]; g2[j] = tl[(kk0 + 8 + j) * 65 + n]; }
            bf16_t* d = dst + (size_t)((n0 >> 6) * c.rmul + n) * c.K + k0 + kk0;
            *(uint4*)d = pack8(f); *(uint4*)(d + 8) = pack8(g2);
        }
        __syncthreads();
    }
}

__device__ __forceinline__ void ph_n1(const Params& p, int l) {
    const int lane = tidx() & 63, wave = tidx() >> 6;
    const float* xcur = (const float*)(p.ws + O_XCUR); const float* mod = (const float*)(p.ws + O_MOD);
    bf16_t* H = (bf16_t*)(p.ws + O_H);
    const float* g = p.in[I_N1G] + l * 1024;
    for (int row = blockIdx.x * 4 + wave; row < RT; row += gridDim.x * 4) {
        const float* x = xcur + (size_t)row * 1024; const float* md = mod + (size_t)(l * 5 + modidx(row)) * 6144;
        float4 v[4]; float ss = 0.f;
#pragma unroll
        for (int i = 0; i < 4; ++i) { v[i] = *(const float4*)(x + lane * 4 + 256 * i); ss += v[i].x * v[i].x + v[i].y * v[i].y + v[i].z * v[i].z + v[i].w * v[i].w; }
        ss = wsum(ss);
        const float rstd = rsqrtf(ss * (1.f / 1024.f) + 1e-6f);
#pragma unroll
        for (int i = 0; i < 4; ++i) {
            const int c = lane * 4 + 256 * i;
            const float4 gg = *(const float4*)(g + c), sc = *(const float4*)(md + 1024 + c), sh = *(const float4*)(md + c);
            f32x4 h = {v[i].x * rstd * gg.x * (1.f + sc.x) + sh.x, v[i].y * rstd * gg.y * (1.f + sc.y) + sh.y,
                       v[i].z * rstd * gg.z * (1.f + sc.z) + sh.z, v[i].w * rstd * gg.w * (1.f + sc.w) + sh.w};
            store_bf16x4(H + (size_t)row * 1024 + c, h);
        }
    }
}

__device__ __forceinline__ void ph_g1(const Params& p, char* smem) {
    if (blockIdx.x == 0 && tidx() < 64) ((unsigned*)(p.ws + O_CNT))[tidx()] = 0u;
    const bf16_t* H = (const bf16_t*)(p.ws + O_H); const bf16_t* W = (const bf16_t*)(p.ws + O_WB + W_IN);
    bf16_t* P = (bf16_t*)(p.ws + O_P);
    for (int it = blockIdx.x; it < 136 * 48; it += gridDim.x) {
        const int mt = it / 48, nt = it % 48;
        f32x4 acc[4][4];
        RPPlain rp{H + (size_t)mt * 128 * 1024, 1024};
        gemm_core_g<4>(rp, W + (size_t)nt * 128 * 1024, 1024, 1024, acc, smem);
        acc_foreach<4>(acc, [&](int m, int n, const f32x4& v) {
            const int col = nt * 128 + n; f32x4 o = v;
            if (col >= PG0 && col < PEND) { o[0] = sigmoidf_(v[0]); o[1] = sigmoidf_(v[1]); o[2] = sigmoidf_(v[2]); o[3] = sigmoidf_(v[3]); }
            store_bf16x4(P + (size_t)(mt * 128 + m) * LDP + col, o);
        });
    }
}

__device__ __forceinline__ void ph_qu(const Params& p, char* smem) {
    const bf16_t* P = (const bf16_t*)(p.ws + O_P);
    bf16_t* QR = (bf16_t*)(p.ws + O_X + X_QRAW); bf16_t* KVR = (bf16_t*)(p.ws + O_X + X_KVRAW);
    for (int it = blockIdx.x; it < 136 * 14; it += gridDim.x) {
        const int mt = it / 14, nn = it % 14;
        f32x4 acc[4][4];
        if (nn < 6) {
            RPPlain rp{P + (size_t)mt * 128 * LDP + PQ0, LDP};
            gemm_core_g<4>(rp, (const bf16_t*)(p.ws + O_WB + W_UQ) + (size_t)nn * 128 * 384, 384, 384, acc, smem);
            acc_foreach<4>(acc, [&](int m, int n, const f32x4& v) { store_bf16x4(QR + (size_t)(mt * 128 + m) * 768 + nn * 128 + n, v); });
        } else {
            const int nt = nn - 6;
            RPPlain rp{P + (size_t)mt * 128 * LDP + PKV0, LDP};
            gemm_core_g<4>(rp, (const bf16_t*)(p.ws + O_WB + W_UKV) + (size_t)nt * 128 * 256, 256, 256, acc, smem);
            acc_foreach<4>(acc, [&](int m, int n, const f32x4& v) { store_bf16x4(KVR + (size_t)(mt * 128 + m) * 1024 + nt * 128 + n, v); });
        }
    }
}

constexpr float QSCALE = 0.10206207261596575f * 1.4426950408889634f;
__device__ __forceinline__ void ph_m2(const Params& p, char* smem) {
    const int tid = tidx(), lane = tid & 63, wave = tid >> 6;
    const bf16_t* P = (const bf16_t*)(p.ws + O_P);
    const bf16_t* QR = (const bf16_t*)(p.ws + O_X + X_QRAW); const bf16_t* KVR = (const bf16_t*)(p.ws + O_X + X_KVRAW);
    bf16_t* QA = (bf16_t*)(p.ws + O_X + X_QA); bf16_t* KA = (bf16_t*)(p.ws + O_X + X_KA); bf16_t* VA = (bf16_t*)(p.ws + O_X + X_VA);
    const float* rc = (const float*)(p.ws + O_ROPEC); const float* rs = (const float*)(p.ws + O_ROPES);
    for (int row = blockIdx.x * 4 + wave; row < RT; row += gridDim.x * 4) {
        const bool lat = row < RL;
        const int b = lat ? (row >> 12) : ((row - RL) >> 8), t = lat ? (row & 4095) : ((row - RL) & 255);
        const size_t keyrow = (size_t)b * KEYS + (lat ? t : SEQ + t);
        const bf16_t* pr = P + (size_t)row * LDP;
        float sq = 0.f, sk = 0.f;
        if (lane < 48) { float f[8]; unpack8(*(const uint4*)(pr + PQ0 + lane * 8), f);
#pragma unroll
            for (int e = 0; e < 8; ++e) sq += f[e] * f[e]; }
        if (lane < 32) { float f[8]; unpack8(*(const uint4*)(pr + PKV0 + lane * 8), f);
#pragma unroll
            for (int e = 0; e < 8; ++e) sk += f[e] * f[e]; }
        sq = wsum(sq); sk = wsum(sk);
        const float rq = rsqrtf(sq * (1.f / 384.f) + 1e-6f), rkv = rsqrtf(sk * (1.f / 256.f) + 1e-6f);
        const bf16_t* qr = QR + (size_t)row * 768; const bf16_t* kvr = KVR + (size_t)row * 1024;
        const float* rct = rc + t * 16; const float* rst = rs + t * 16;
#pragma unroll
        for (int pass = 0; pass < 2; ++pass) {
            const int ch = lane + 64 * pass;
            if (ch < 96) {
                const int h = ch / 12, cc = ch - h * 12;
                float q[8], k[8];
                unpack8(*(const uint4*)(qr + ch * 8), q);
                if (cc < 8) unpack8(*(const uint4*)(kvr + h * 128 + cc * 8), k);
                else unpack8(*(const uint4*)(pr + PKR0 + (cc - 8) * 8), k);
                const float ksc = cc < 8 ? rkv : 1.f;
#pragma unroll
                for (int e = 0; e < 8; ++e) { q[e] *= rq; k[e] *= ksc; }
                if (cc >= 8 && lat) {
                    const int sub = cc - 8, ax = sub >> 1, half = sub & 1;
                    float qp[8], kp[8];
                    unpack8(*(const uint4*)(qr + (ch ^ 1) * 8), qp); unpack8(*(const uint4*)(pr + PKR0 + (sub ^ 1) * 8), kp);
                    const float4 c0 = *(const float4*)(rct + ax * 8), c1 = *(const float4*)(rct + ax * 8 + 4), s0 = *(const float4*)(rst + ax * 8), s1 = *(const float4*)(rst + ax * 8 + 4);
                    const float cs_[8] = {c0.x, c0.y, c0.z, c0.w, c1.x, c1.y, c1.z, c1.w}, sn_[8] = {s0.x, s0.y, s0.z, s0.w, s1.x, s1.y, s1.z, s1.w};
#pragma unroll
                    for (int e = 0; e < 8; ++e) {
                        const float sg = half ? sn_[e] : -sn_[e];
                        q[e] = q[e] * cs_[e] + qp[e] * rq * sg;
                        k[e] = k[e] * cs_[e] + kp[e] * sg;
                    }
                }
#pragma unroll
                for (int e = 0; e < 8; ++e) q[e] *= QSCALE;
                *(uint4*)(QA + (size_t)row * 768 + ch * 8) = pack8(q);
                *(uint4*)(KA + keyrow * 768 + ch * 8) = pack8(k);
            }
        }
    }
    bf16_t* vt = (bf16_t*)smem;
    float* rk = (float*)(smem + 64 * 72 * 2);
    for (int it = blockIdx.x; it < (RT / 64) * 8; it += gridDim.x) {
        const int g = it >> 3, h = it & 7, rowg = g * 64;
        const bool lat = rowg < RL;
        const int b = lat ? (rowg >> 12) : ((rowg - RL) >> 8), t0 = lat ? (rowg & 4095) : ((rowg - RL) & 255);
        const size_t key0 = lat ? t0 : SEQ + t0;
#pragma unroll 4
        for (int rr = 0; rr < 16; ++rr) {
            const int lr = wave * 16 + rr;
            const bf16_t* pr = P + (size_t)(rowg + lr) * LDP + PKV0;
            const uint2 u = *(const uint2*)(pr + lane * 4);
            float sk = bflo(u.x) * bflo(u.x) + bfhi(u.x) * bfhi(u.x) + bflo(u.y) * bflo(u.y) + bfhi(u.y) * bfhi(u.y);
            sk = wsum(sk);
            if (lane == 0) rk[lr] = rsqrtf(sk * (1.f / 256.f) + 1e-6f);
        }
        __syncthreads();
#pragma unroll
        for (int i = 0; i < 2; ++i) {
            const int c = tid + 256 * i, lr = c >> 3, part = c & 7;
            float f[8]; unpack8(*(const uint4*)(KVR + (size_t)(rowg + lr) * 1024 + h * 128 + 64 + part * 8), f);
            const float sc = rk[lr];
#pragma unroll
            for (int e = 0; e < 8; ++e) f[e] *= sc;
            *(uint4*)(vt + lr * 72 + part * 8) = pack8(f);
        }
        __syncthreads();
#pragma unroll
        for (int i = 0; i < 2; ++i) {
            const int c = tid + 256 * i, dd = c >> 3, kc = c & 7;
            float f[8];
#pragma unroll
            for (int e = 0; e < 8; ++e) f[e] = bf2f(vt[(kc * 8 + e) * 72 + dd]);
            *(uint4*)(VA + ((size_t)(b * 8 + h) * 64 + dd) * KEYS + key0 + kc * 8) = pack8(f);
        }
        __syncthreads();
    }
}
__device__ __forceinline__ float xmax_16_32(float v) {
    unsigned u = __builtin_bit_cast(unsigned, v);
    auto r = __builtin_amdgcn_permlane32_swap(u, u, false, false);
    float m = fmaxf(__builtin_bit_cast(float, r[0]), __builtin_bit_cast(float, r[1]));
    u = __builtin_bit_cast(unsigned, m);
    auto r2 = __builtin_amdgcn_permlane16_swap(u, u, false, false);
    return fmaxf(__builtin_bit_cast(float, r2[0]), __builtin_bit_cast(float, r2[1]));
}
__device__ __forceinline__ float xsum_16_32(float v) {
    unsigned u = __builtin_bit_cast(unsigned, v);
    auto r = __builtin_amdgcn_permlane32_swap(u, u, false, false);
    float m = __builtin_bit_cast(float, r[0]) + __builtin_bit_cast(float, r[1]);
    u = __builtin_bit_cast(unsigned, m);
    auto r2 = __builtin_amdgcn_permlane16_swap(u, u, false, false);
    return __builtin_bit_cast(float, r2[0]) + __builtin_bit_cast(float, r2[1]);
}
constexpr int KS_LD = 104, VT_LD = 72;
constexpr int AT_BUF = 64 * KS_LD * 2 + 64 * VT_LD * 2;
__device__ __forceinline__ void ph_at(const Params& p, int l, char* smem) {
    const int tid = tidx(), lane = tid & 63, wave = tid >> 6, fr = lane & 15, fq = lane >> 4;
    const bf16_t* QA = (const bf16_t*)(p.ws + O_X + X_QA); const bf16_t* KA = (const bf16_t*)(p.ws + O_X + X_KA); const bf16_t* VA = (const bf16_t*)(p.ws + O_X + X_VA);
    bf16_t* ATT = (bf16_t*)(p.ws + O_ATT);
    const int nitems = 1024 + (l < NLAYER - 1 ? 64 : 0);
    for (int it0 = blockIdx.x; it0 < nitems; it0 += gridDim.x) {
        int it = it0;
        if (gridDim.x == 512 && it0 < 1024) {
            const int x = it0 & 7, j = (it0 >> 3) & 63, rd = it0 >> 9;
            it = ((x * 4 + rd * 2 + (j >> 5)) << 5) | (j & 31);
        }
        int b, h, row0, ntile; size_t krow0;
        if (it < 1024) { b = it >> 8; h = (it >> 5) & 7; row0 = b * SEQ + (it & 31) * 128; krow0 = (size_t)b * KEYS; ntile = KEYS / 64; }
        else { const int j = it - 1024; b = j >> 4; h = (j >> 1) & 7; row0 = RL + b * CTX + (j & 1) * 128; krow0 = (size_t)b * KEYS + SEQ; ntile = CTX / 64; }
        const int qrow = row0 + wave * 32 + fr;
        const size_t vrow0 = (size_t)(b * 8 + h) * 64; const int koff0 = (int)(krow0 - (size_t)b * KEYS);
        bf16x8 qf[2][3];
#pragma unroll
        for (int t = 0; t < 2; ++t)
#pragma unroll
            for (int ks = 0; ks < 3; ++ks) qf[t][ks] = *(const bf16x8*)(QA + (size_t)(qrow + 16 * t) * 768 + h * 96 + ks * 32 + fq * 8);
        f32x4 ot[2][4];
#pragma unroll
        for (int t = 0; t < 2; ++t)
#pragma unroll
            for (int i = 0; i < 4; ++i) ot[t][i] = (f32x4){0.f, 0.f, 0.f, 0.f};
        float m_run[2] = {-1e30f, -1e30f}, l_run[2] = {0.f, 0.f};
        uint4 rk0, rk1, rk2, rv0, rv1;
#define AT_GLOAD(KT) do { const size_t kr_ = krow0 + (size_t)(KT) * 64; \
            { const int c = tid, key = c / 12, part = c % 12; rk0 = *(const uint4*)(KA + (kr_ + key) * 768 + h * 96 + part * 8); } \
            { const int c = tid + 256, key = c / 12, part = c % 12; rk1 = *(const uint4*)(KA + (kr_ + key) * 768 + h * 96 + part * 8); } \
            { const int c = tid + 512, key = c / 12, part = c % 12; rk2 = *(const uint4*)(KA + (kr_ + key) * 768 + h * 96 + part * 8); } \
            { const int c = tid, dd_ = c >> 3, part = c & 7; rv0 = *(const uint4*)(VA + (vrow0 + dd_) * KEYS + koff0 + (KT) * 64 + part * 8); } \
            { const int c = tid + 256, dd_ = c >> 3, part = c & 7; rv1 = *(const uint4*)(VA + (vrow0 + dd_) * KEYS + koff0 + (KT) * 64 + part * 8); } } while (0)
#define AT_VSTORE(RV, C) do { const int dd_ = (C) >> 3, part = (C) & 7; *(uint4*)(Vt_ + dd_ * VT_LD + part * 8) = RV; } while (0)
#define AT_SSTORE(BUF) do { bf16_t* Ks_ = (bf16_t*)(smem + (BUF) * AT_BUF); bf16_t* Vt_ = Ks_ + 64 * KS_LD; \
            { const int c = tid, key = c / 12, part = c % 12; *(uint4*)(Ks_ + key * KS_LD + part * 8) = rk0; } \
            { const int c = tid + 256, key = c / 12, part = c % 12; *(uint4*)(Ks_ + key * KS_LD + part * 8) = rk1; } \
            { const int c = tid + 512, key = c / 12, part = c % 12; *(uint4*)(Ks_ + key * KS_LD + part * 8) = rk2; } \
            AT_VSTORE(rv0, tid); AT_VSTORE(rv1, tid + 256); } while (0)
        AT_GLOAD(0); AT_SSTORE(0);
        __syncthreads();
        for (int kt = 0; kt < ntile; ++kt) {
            const int cur = kt & 1;
            if (kt + 1 < ntile) AT_GLOAD(kt + 1);
            const bf16_t* Ks = (const bf16_t*)(smem + cur * AT_BUF); const bf16_t* Vt = Ks + 64 * KS_LD;
            f32x4 st[2][4];
#pragma unroll
            for (int jh = 0; jh < 2; ++jh) {
                bf16x8 kf[2][3];
#pragma unroll
                for (int jj = 0; jj < 2; ++jj)
#pragma unroll
                    for (int ks = 0; ks < 3; ++ks) kf[jj][ks] = *(const bf16x8*)(Ks + ((jh * 2 + jj) * 16 + fr) * KS_LD + ks * 32 + fq * 8);
#pragma unroll
                for (int jj = 0; jj < 2; ++jj) {
                    const int j = jh * 2 + jj;
                    st[0][j] = (f32x4){0.f, 0.f, 0.f, 0.f}; st[1][j] = (f32x4){0.f, 0.f, 0.f, 0.f};
#pragma unroll
                    for (int ks = 0; ks < 3; ++ks) {
                        st[0][j] = __builtin_amdgcn_mfma_f32_16x16x32_bf16(kf[jj][ks], qf[0][ks], st[0][j], 0, 0, 0);
                        st[1][j] = __builtin_amdgcn_mfma_f32_16x16x32_bf16(kf[jj][ks], qf[1][ks], st[1][j], 0, 0, 0);
                    }
                }
            }
            bf16x8 vf[2][4];
#pragma unroll
            for (int k2 = 0; k2 < 2; ++k2)
#pragma unroll
                for (int dt = 0; dt < 4; ++dt) {
                    const bf16_t* vp = Vt + (dt * 16 + fr) * VT_LD + k2 * 32 + fq * 4;
                    const uint2 v0 = *(const uint2*)vp, v1 = *(const uint2*)(vp + 16);
                    vf[k2][dt] = __builtin_bit_cast(bf16x8, make_uint4(v0.x, v0.y, v1.x, v1.y));
                }
            uint4 pu[2][2];
#pragma unroll
            for (int t = 0; t < 2; ++t) {
                float mx = st[t][0][0];
#pragma unroll
                for (int j = 0; j < 4; ++j)
#pragma unroll
                    for (int r = 0; r < 4; ++r) mx = fmaxf(mx, st[t][j][r]);
                if (__any(mx > m_run[t] + 6.f)) {
                    mx = xmax_16_32(mx);
                    const float m_new = fmaxf(m_run[t], mx);
                    const float alpha = __builtin_amdgcn_exp2f(m_run[t] - m_new);
                    m_run[t] = m_new;
                    l_run[t] *= alpha;
#pragma unroll
                    for (int i = 0; i < 4; ++i) ot[t][i] *= alpha;
                }
                const float mr = m_run[t];
                float ps = 0.f;
#pragma unroll
                for (int j = 0; j < 4; ++j)
#pragma unroll
                    for (int r = 0; r < 4; ++r) { st[t][j][r] = __builtin_amdgcn_exp2f(st[t][j][r] - mr); ps += st[t][j][r]; }
                l_run[t] += ps;
#pragma unroll
                for (int k2 = 0; k2 < 2; ++k2)
                    pu[t][k2] = make_uint4(pack2(st[t][2 * k2][0], st[t][2 * k2][1]), pack2(st[t][2 * k2][2], st[t][2 * k2][3]),
                                           pack2(st[t][2 * k2 + 1][0], st[t][2 * k2 + 1][1]), pack2(st[t][2 * k2 + 1][2], st[t][2 * k2 + 1][3]));
            }
#pragma unroll
            for (int k2 = 0; k2 < 2; ++k2) {
                const bf16x8 pb0 = __builtin_bit_cast(bf16x8, pu[0][k2]), pb1 = __builtin_bit_cast(bf16x8, pu[1][k2]);
#pragma unroll
                for (int dt = 0; dt < 4; ++dt) {
                    ot[0][dt] = __builtin_amdgcn_mfma_f32_16x16x32_bf16(vf[k2][dt], pb0, ot[0][dt], 0, 0, 0);
                    ot[1][dt] = __builtin_amdgcn_mfma_f32_16x16x32_bf16(vf[k2][dt], pb1, ot[1][dt], 0, 0, 0);
                }
            }
            if (kt + 1 < ntile) AT_SSTORE(cur ^ 1);
            __syncthreads();
        }
#pragma unroll
        for (int t = 0; t < 2; ++t) {
            const float inv = 1.f / xsum_16_32(l_run[t]);
#pragma unroll
            for (int dt = 0; dt < 4; ++dt) { f32x4 o = ot[t][dt] * inv; store_bf16x4(ATT + (size_t)(qrow + 16 * t) * 512 + h * 64 + dt * 16 + fq * 4, o); }
        }
    }
}

__device__ __forceinline__ void row_edges(int row, bool& first, bool& last) {
    if (row < RL) { const int t = row & 4095; first = t == 0; last = t == 4095; }
    else { const int s = (row - RL) & 255; first = s == 0; last = s == 255; }
}
__device__ __forceinline__ float xs1(const bf16_t* P, const float* mu, int row, int col) {
    bool first, last; row_edges(row, first, last);
    const bf16_t* pc = P + (size_t)row * LDP + PR0 + col;
    const float c = bf2f(*pc), pv0 = bf2f(*(first ? pc : pc - LDP)), nx0 = bf2f(*(last ? pc : pc + LDP));
    const float pv = first ? 0.f : pv0, nx = last ? 0.f : nx0;
    return c + (0.5f * (pv + nx) - c) * mu[col];
}
__device__ __forceinline__ void xs8(const bf16_t* P, const float* mu, int row, int col, float (&o)[8]) {
    bool first, last; row_edges(row, first, last);
    const bf16_t* pc = P + (size_t)row * LDP + PR0 + col;
    const uint4 uc = *(const uint4*)pc, up = *(const uint4*)(first ? pc : pc - LDP), un = *(const uint4*)(last ? pc : pc + LDP);
    float c[8], pv[8], nx[8]; unpack8(uc, c); unpack8(up, pv); unpack8(un, nx);
    const float fp = first ? 0.f : 0.5f, fn = last ? 0.f : 0.5f;
    const float4 m0 = *(const float4*)(mu + col), m1 = *(const float4*)(mu + col + 4);
    const float m[8] = {m0.x, m0.y, m0.z, m0.w, m1.x, m1.y, m1.z, m1.w};
#pragma unroll
    for (int j = 0; j < 8; ++j) o[j] = c[j] + ((fp * pv[j] + fn * nx[j]) - c[j]) * m[j];
}
struct ALRw {
    const bf16_t* P; const float* mu; int row0; int colbase, mode;
    __device__ __forceinline__ ALRw(const bf16_t* P_, const float* mu_, int row0_, int colbase_, int mode_) : P(P_), mu(mu_), colbase(colbase_), mode(mode_) {
        row0 = row0_ + (tidx() >> 3);
    }
    __device__ __forceinline__ uint4 load(int i, int k) const {
        float o[8]; xs8(P, mu, row0 + 32 * i, colbase + k, o);
        if (mode == 0) {
#pragma unroll
            for (int j = 0; j < 8; ++j) o[j] = tanhf(o[j]);
        } else if (mode == 2) {
#pragma unroll
            for (int j = 0; j < 8; ++j) o[j] = sigmoidf_(o[j]);
        }
        return pack8(o);
    }
};
__device__ __forceinline__ void ph_rp1(const Params& p, int l, char* smem) {
    const bf16_t* P = (const bf16_t*)(p.ws + O_P); const float* mu = p.in[I_MU] + l * 1792;
    bf16_t* RG = (bf16_t*)(p.ws + O_RG);
    for (int it = blockIdx.x; it < 1088; it += gridDim.x) {
        const int mt = it >> 2, nt = it & 3;
        f32x4 acc[2][4];
        ALRw al(P, mu, mt * 64, 1664, 2);
        gemm_core<2>(al, (const bf16_t*)(p.ws + O_WB + W_GUP) + (size_t)nt * 128 * 128, 128, 128, acc, smem);
        acc_foreach<2>(acc, [&](int m, int n, const f32x4& v) { store_bf16x4(RG + (size_t)(mt * 64 + m) * 512 + nt * 128 + n, v); });
    }
}
__device__ __forceinline__ void ph_rp2(const Params& p, int l) {
    const int lane = tidx() & 63, wave = tidx() >> 6;
    const bf16_t* P = (const bf16_t*)(p.ws + O_P); const float* mu = p.in[I_MU] + l * 1792; const float* kkw = p.in[I_KK] + l * 512;
    float* KKN = (float*)(p.ws + O_X + X_KKN);
    for (int row = blockIdx.x * 4 + wave; row < RT; row += gridDim.x * 4) {
        float k8[8]; xs8(P, mu, row, 512 + lane * 8, k8);
        float s = 0.f;
#pragma unroll
        for (int j = 0; j < 8; ++j) { const float v = k8[j] * kkw[lane * 8 + j]; s += v * v; }
        s += __shfl_xor(s, 1); s += __shfl_xor(s, 2); s += __shfl_xor(s, 4);
        if ((lane & 7) == 0) KKN[(size_t)row * 8 + (lane >> 3)] = rsqrtf(s + 1e-12f);
    }
}

__device__ __forceinline__ int scan_row(int b, int d, int n) {
    if (n < CTX) return RL + b * CTX + (d == 0 ? n : CTX - 1 - n);
    const int t = n - CTX; return b * SEQ + (d == 0 ? t : SEQ - 1 - t);
}
constexpr int SL = 72;
constexpr int SLOT_E = 64 * SL;
template <int LDA, int LDB>
__device__ __forceinline__ void mm64(const bf16_t* A, const bf16_t* B, f32x4 (&acc)[4], int wave, int fr, int fq) {
#pragma unroll
    for (int ks = 0; ks < 2; ++ks) {
        const bf16x8 af = *(const bf16x8*)(A + (wave * 16 + fr) * LDA + ks * 32 + fq * 8);
#pragma unroll
        for (int nt = 0; nt < 4; ++nt) {
            const bf16x8 bfv = *(const bf16x8*)(B + (nt * 16 + fr) * LDB + ks * 32 + fq * 8);
            acc[nt] = __builtin_amdgcn_mfma_f32_16x16x32_bf16(bfv, af, acc[nt], 0, 0, 0);
        }
    }
}
__device__ __forceinline__ void acc_zero(f32x4 (&acc)[4]) {
#pragma unroll
    for (int nt = 0; nt < 4; ++nt) acc[nt] = (f32x4){0.f, 0.f, 0.f, 0.f};
}
template <bool STRICT>
__device__ __forceinline__ void acc_mask(f32x4 (&acc)[4], int m, int fq) {
#pragma unroll
    for (int nt = 0; nt < 4; ++nt)
#pragma unroll
        for (int r = 0; r < 4; ++r) { const int n = nt * 16 + fq * 4 + r; const bool keep = STRICT ? (m < n) : (m <= n); if (!keep) acc[nt][r] = 0.f; }
}
__device__ __forceinline__ void st_rm(bf16_t* dst, const f32x4 (&acc)[4], int m, int fq) {
#pragma unroll
    for (int nt = 0; nt < 4; ++nt) store_bf16x4(dst + m * SL + nt * 16 + fq * 4, acc[nt]);
}
__device__ __forceinline__ void st_tr(bf16_t* dst, const f32x4 (&acc)[4], int m, int fq) {
#pragma unroll
    for (int nt = 0; nt < 4; ++nt)
#pragma unroll
        for (int r = 0; r < 4; ++r) dst[(nt * 16 + fq * 4 + r) * SL + m] = f2bf(acc[nt][r]);
}
__device__ __forceinline__ void ph_r1(const Params& p, int l, char* smem) {
    const int tid0 = tidx();
#define R1_IDX const int tid = lv(tid0), lane = tid & 63, wave = tid >> 6, fr = lane & 15, fq = lane >> 4, bi = tid >> 2, bq = (tid & 3) * 16, m = wave * 16 + fr; (void)bi; (void)bq; (void)m; (void)fq;
    const bf16_t* P = (const bf16_t*)(p.ws + O_P); const float* mu = p.in[I_MU] + l * 1792;
    const float* kkw = p.in[I_KK] + l * 512; const float* kaw = p.in[I_KA] + l * 512; const float* rkw = p.in[I_RK] + l * 512;
    const float* KKN = (const float*)(p.ws + O_X + X_KKN); float* BON = (float*)(p.ws + O_X + X_BON);
    bf16_t* gMT = (bf16_t*)(p.ws + O_X + X_MT); bf16_t* gNL = (bf16_t*)(p.ws + O_H);
    bf16_t* gGT = (bf16_t*)(p.ws + O_X + X_GT); bf16_t* gYL = (bf16_t*)(p.ws + O_X + X_YL);
    bf16_t* slot = (bf16_t*)smem;
    bf16_t* s0 = slot, *s1 = slot + SLOT_E, *s2 = slot + 2 * SLOT_E, *s3 = slot + 3 * SLOT_E;
    bf16_t* sa = slot + 4 * SLOT_E, *sb = slot + 5 * SLOT_E, *sc = slot + 6 * SLOT_E, *sT = slot + 7 * SLOT_E;
    float* misc = (float*)(smem + 8 * SLOT_E * 2);
    float* GAM = misc; float* SEG = misc + 64;
    float* ASIG = (float*)s0;
    float* LWS = (float*)s2;
    for (int it = blockIdx.x; it < NCP; it += gridDim.x) {
        const int c = it % 68, d = (it / 68) & 1, h = (it / 136) & 7, b = it / 1088;
        {
            R1_IDX const int rowb = scan_row(b, d, c * 64 + bi); (void)rowb;
            float o[8];
#pragma unroll
            for (int hh = 0; hh < 2; ++hh) {
                xs8(P, mu, rowb, 1536 + bq + hh * 8, o);
#pragma unroll
                for (int j = 0; j < 8; ++j) o[j] = 1.f - 2.f * __builtin_amdgcn_rcpf(1.f + __expf(2.f * o[j]));
                *(uint4*)(sa + bi * SL + bq + hh * 8) = pack8(o);
                xs8(P, mu, rowb, 1600 + bq + hh * 8, o);
                *(uint4*)(sb + bi * SL + bq + hh * 8) = pack8(o);
            }
        }
        __syncthreads();
        {
            R1_IDX const int rowb = scan_row(b, d, c * 64 + bi); (void)rowb;
            f32x4 acc[4];
            acc_zero(acc);
            mm64<SL, 64>(sa, (const bf16_t*)(p.ws + O_WB + W_WUP) + ((size_t)d * 512 + h * 64) * 64, acc, wave, fr, fq);
            const float* w0 = p.in[I_W0] + (l * 2 + d) * 512 + h * 64;
#pragma unroll
            for (int nt = 0; nt < 4; ++nt) {
                const int n = nt * 16 + fq * 4; float4 o; float* op = (float*)&o;
#pragma unroll
                for (int r = 0; r < 4; ++r) { const float z = w0[n + r] + acc[nt][r]; op[r] = -0.6065306597126334f * __builtin_amdgcn_rcpf(1.f + __expf(-z)); }
                *(float4*)(LWS + m * 68 + n) = o;
            }
            acc_zero(acc);
            mm64<SL, 64>(sb, (const bf16_t*)(p.ws + O_WB + W_AUP) + ((size_t)d * 512 + h * 64) * 64, acc, wave, fr, fq);
            const float* a0 = p.in[I_A0] + (l * 2 + d) * 512 + h * 64;
#pragma unroll
            for (int nt = 0; nt < 4; ++nt) {
                const int n = nt * 16 + fq * 4;
                *(float4*)(ASIG + m * 68 + n) = make_float4(__builtin_amdgcn_rcpf(1.f + __expf(-(a0[n] + acc[nt][0]))), __builtin_amdgcn_rcpf(1.f + __expf(-(a0[n + 1] + acc[nt][1]))), __builtin_amdgcn_rcpf(1.f + __expf(-(a0[n + 2] + acc[nt][2]))), __builtin_amdgcn_rcpf(1.f + __expf(-(a0[n + 3] + acc[nt][3]))));
            }
        }
        __syncthreads();
        {
            R1_IDX const int rowb = scan_row(b, d, c * 64 + bi); (void)rowb;
            const int k = tid & 63, seg = tid >> 6;
            float run = 0.f;
#pragma unroll
            for (int ii = 0; ii < 16; ++ii) { run += LWS[(seg * 16 + ii) * 68 + k]; LWS[(seg * 16 + ii) * 68 + k] = run; }
            SEG[seg * 64 + k] = run;
            __syncthreads();
            float off = 0.f;
#pragma unroll
            for (int sgi = 0; sgi < 3; ++sgi) if (sgi < seg) off += SEG[sgi * 64 + k];
#pragma unroll
            for (int ii = 0; ii < 16; ++ii) LWS[(seg * 16 + ii) * 68 + k] += off;
        }
        __syncthreads();
        {
            R1_IDX const int rowb = scan_row(b, d, c * 64 + bi); (void)rowb;
            float cs[16], cm[16], cc[16], ag[16];
#pragma unroll
            for (int q = 0; q < 4; ++q) {
                const float4 v0 = *(const float4*)(LWS + bi * 68 + bq + q * 4);
                const float4 v1 = bi > 0 ? *(const float4*)(LWS + (bi - 1) * 68 + bq + q * 4) : make_float4(0.f, 0.f, 0.f, 0.f);
                const float4 v2 = *(const float4*)(LWS + 63 * 68 + bq + q * 4);
                const float4 v3 = *(const float4*)(ASIG + bi * 68 + bq + q * 4);
                cs[q * 4] = v0.x; cs[q * 4 + 1] = v0.y; cs[q * 4 + 2] = v0.z; cs[q * 4 + 3] = v0.w;
                cm[q * 4] = v1.x; cm[q * 4 + 1] = v1.y; cm[q * 4 + 2] = v1.z; cm[q * 4 + 3] = v1.w;
                cc[q * 4] = v2.x; cc[q * 4 + 1] = v2.y; cc[q * 4 + 2] = v2.z; cc[q * 4 + 3] = v2.w;
                ag[q * 4] = v3.x; ag[q * 4 + 1] = v3.y; ag[q * 4 + 2] = v3.z; ag[q * 4 + 3] = v3.w;
            }
            __syncthreads();
            const float kkn = KKN[(size_t)rowb * 8 + h];
            float bon = 0.f;
#pragma unroll
            for (int hh = 0; hh < 2; ++hh) {
                float r8[8], k8[8], oa[8], ob[8], ok[8], orr[8];
                const int col = h * 64 + bq + hh * 8;
                xs8(P, mu, rowb, col, r8); xs8(P, mu, rowb, 512 + col, k8);
#pragma unroll
                for (int j = 0; j < 8; ++j) {
                    const int e = hh * 8 + j;
                    const float kk = k8[j] * kkw[col + j] * kkn;
                    const float kd = k8[j] * (1.f + (ag[e] - 1.f) * kaw[col + j]);
                    const float eneg = __expf(-cs[e]);
                    oa[j] = -kk * __expf(cm[e]); ob[j] = kk * ag[e] * eneg; ok[j] = kd * eneg; orr[j] = r8[j] * __builtin_amdgcn_rcpf(eneg);
                    bon += r8[j] * kd * rkw[col + j];
                }
                *(uint4*)(s0 + bi * SL + bq + hh * 8) = pack8(oa); *(uint4*)(s1 + bi * SL + bq + hh * 8) = pack8(ob);
                *(uint4*)(s2 + bi * SL + bq + hh * 8) = pack8(ok); *(uint4*)(s3 + bi * SL + bq + hh * 8) = pack8(orr);
            }
            bon += __shfl_xor(bon, 1); bon += __shfl_xor(bon, 2);
            if ((tid & 3) == 0) BON[((size_t)d * RT + rowb) * 8 + h] = bon;
            if (bi == 0) {
#pragma unroll
                for (int e = 0; e < 16; ++e) GAM[bq + e] = __expf(cc[e]);
            }
        }
        __syncthreads();
        {
            R1_IDX const int rowb = scan_row(b, d, c * 64 + bi); (void)rowb;
            f32x4 acc[4]; acc_zero(acc);
            mm64<SL, SL>(s1, s0, acc, wave, fr, fq);
            acc_mask<true>(acc, m, fq);
            st_rm(sa, acc, m, fq); st_tr(sb, acc, m, fq);
#pragma unroll
            for (int nt = 0; nt < 4; ++nt)
#pragma unroll
                for (int r = 0; r < 4; ++r) if (nt * 16 + fq * 4 + r == m) acc[nt][r] += 1.f;
            st_rm(sc, acc, m, fq);
        }
        __syncthreads();
#pragma unroll
        for (int itr = 0; itr < 5; ++itr) {
            R1_IDX
            bf16_t* ptr = (itr & 1) ? sT : sb;
            bf16_t* ptw = (itr & 1) ? sb : sT;
            f32x4 acc[4]; acc_zero(acc);
            mm64<SL, SL>(sa, ptr, acc, wave, fr, fq);
            st_rm(sa, acc, m, fq); st_tr(ptw, acc, m, fq);
            __syncthreads();
            f32x4 tacc[4];
#pragma unroll
            for (int nt = 0; nt < 4; ++nt) { const uint2 u = *(const uint2*)(sc + m * SL + nt * 16 + fq * 4); tacc[nt] = (f32x4){bflo(u.x), bfhi(u.x), bflo(u.y), bfhi(u.y)}; }
            mm64<SL, SL>(sc, ptw, tacc, wave, fr, fq);
            if (itr < 4) st_rm(sc, tacc, m, fq); else st_tr(sb, tacc, m, fq);
        }
        __syncthreads();
        {
            R1_IDX const int rowb = scan_row(b, d, c * 64 + bi); (void)rowb;
            f32x4 acc[4]; acc_zero(acc);
            mm64<SL, SL>(s2, s0, acc, wave, fr, fq);
            acc_mask<true>(acc, m, fq);
            st_rm(sa, acc, m, fq);
            float f0[8], f1[8];
            unpack8(*(const uint4*)(s0 + bi * SL + bq), f0); unpack8(*(const uint4*)(s0 + bi * SL + bq + 8), f1);
#pragma unroll
            for (int e = 0; e < 8; ++e) { sc[(bq + e) * SL + bi] = f2bf(f0[e]); sc[(bq + 8 + e) * SL + bi] = f2bf(f1[e]); }
        }
        __syncthreads();
        {
            R1_IDX const int rowb = scan_row(b, d, c * 64 + bi); (void)rowb;
            f32x4 acc[4]; acc_zero(acc);
            mm64<SL, SL>(sc, sb, acc, wave, fr, fq);
            st_rm(sT, acc, m, fq);
            acc_zero(acc);
            mm64<SL, SL>(sa, sb, acc, wave, fr, fq);
            st_rm(s0, acc, m, fq);
        }
        __syncthreads();
        f32x4 qacc[4];
        {
            R1_IDX const int rowb = scan_row(b, d, c * 64 + bi); (void)rowb;
            f32x4 acc[4]; acc_zero(acc);
            mm64<SL, SL>(s1, s3, acc, wave, fr, fq);
            acc_mask<false>(acc, m, fq);
            st_tr(sa, acc, m, fq);
            acc_zero(qacc);
            mm64<SL, SL>(s2, s3, qacc, wave, fr, fq);
            acc_mask<false>(qacc, m, fq);
            float f0[8], f1[8];
            unpack8(*(const uint4*)(s3 + bi * SL + bq), f0); unpack8(*(const uint4*)(s3 + bi * SL + bq + 8), f1);
#pragma unroll
            for (int e = 0; e < 8; ++e) { sc[(bq + e) * SL + bi] = f2bf(f0[e]); sc[(bq + 8 + e) * SL + bi] = f2bf(f1[e]); }
        }
        __syncthreads();
        {
            R1_IDX const int rowb = scan_row(b, d, c * 64 + bi); (void)rowb;
            f32x4 acc[4];
#pragma unroll
            for (int nt = 0; nt < 4; ++nt) { const uint2 u = *(const uint2*)(sc + m * SL + nt * 16 + fq * 4); acc[nt] = (f32x4){bflo(u.x), bfhi(u.x), bflo(u.y), bfhi(u.y)}; }
            mm64<SL, SL>(sT, sa, acc, wave, fr, fq);
            bf16_t* gt = gGT + (size_t)it * 4096;
#pragma unroll
            for (int nt = 0; nt < 4; ++nt)
#pragma unroll
                for (int r = 0; r < 4; ++r) gt[(nt * 16 + fq * 4 + r) * 64 + m] = f2bf(acc[nt][r]);
            mm64<SL, SL>(s0, sa, qacc, wave, fr, fq);
            st_tr(sb, qacc, m, fq);
            float f0[8], f1[8];
            unpack8(*(const uint4*)(s1 + bi * SL + bq), f0); unpack8(*(const uint4*)(s1 + bi * SL + bq + 8), f1);
#pragma unroll
            for (int e = 0; e < 8; ++e) { s3[(bq + e) * SL + bi] = f2bf(f0[e] * GAM[bq + e]); s3[(bq + 8 + e) * SL + bi] = f2bf(f1[e] * GAM[bq + 8 + e]); }
        }
        __syncthreads();
        {
            R1_IDX const int rowb = scan_row(b, d, c * 64 + bi); (void)rowb;
            f32x4 acc[4]; acc_zero(acc);
            mm64<SL, SL>(sT, s3, acc, wave, fr, fq);
            bf16_t* mt = gMT + (size_t)it * 4096;
#pragma unroll
            for (int nt = 0; nt < 4; ++nt)
#pragma unroll
                for (int r = 0; r < 4; ++r) { const int n = nt * 16 + fq * 4 + r; mt[n * 64 + m] = f2bf(acc[nt][r] + (n == m ? GAM[m] : 0.f)); }
#pragma unroll
            for (int nt = 0; nt < 4; ++nt) {
                const int n = nt * 16 + fq * 4; const uint2 u = *(const uint2*)(s2 + m * SL + n);
                acc[nt] = (f32x4){bflo(u.x) * GAM[n], bfhi(u.x) * GAM[n + 1], bflo(u.y) * GAM[n + 2], bfhi(u.y) * GAM[n + 3]};
            }
            mm64<SL, SL>(s0, s3, acc, wave, fr, fq);
            st_tr(s1, acc, m, fq);
            float v8[8];
#pragma unroll
            for (int hh = 0; hh < 2; ++hh) {
                xs8(P, mu, rowb, 1024 + h * 64 + bq + hh * 8, v8);
#pragma unroll
                for (int e = 0; e < 8; ++e) sc[(bq + hh * 8 + e) * SL + bi] = f2bf(v8[e]);
            }
        }
        __syncthreads();
        {
            R1_IDX const int rowb = scan_row(b, d, c * 64 + bi); (void)rowb;
            f32x4 acc[4]; acc_zero(acc);
            mm64<SL, SL>(sc, sb, acc, wave, fr, fq);
            bf16_t* yl = gYL + (size_t)it * 4096;
#pragma unroll
            for (int nt = 0; nt < 4; ++nt) store_bf16x4(yl + m * 64 + nt * 16 + fq * 4, acc[nt]);
            acc_zero(acc);
            mm64<SL, SL>(sc, s1, acc, wave, fr, fq);
            bf16_t* nl = gNL + (size_t)it * 4096;
#pragma unroll
            for (int nt = 0; nt < 4; ++nt) store_bf16x4(nl + m * 64 + nt * 16 + fq * 4, acc[nt]);
        }
        __syncthreads();
    }
}
__device__ __forceinline__ void ph_r2(const Params& p, char* smem) {
    const int tid = tidx(), lane = tid & 63, wave = tid >> 6, fr = lane & 15, fq = lane >> 4;
    const char* gMT = (const char*)(p.ws + O_X + X_MT); const char* gNL = (const char*)(p.ws + O_H);
    uint4* gS0 = (uint4*)(p.ws + O_X + X_S0);
    const int wofs = __builtin_amdgcn_readfirstlane(wave) * 1024;
    const unsigned lds0 = (unsigned)(uintptr_t)smem;
    const unsigned mtaddr = lds0 + fr * 128 + fq * 8, nladdr = lds0 + (wave * 16 + fr) * 128 + fq * 8;
    auto issue = [&](size_t cp, int slot) {
        char* dst = smem + slot * 16384 + wofs;
        const char* s0 = gMT + cp * 8192 + wofs + lane * 16; const char* s1 = gNL + cp * 8192 + wofs + lane * 16;
        __builtin_amdgcn_global_load_lds((const unsigned*)s0, (unsigned*)dst, 16, 0, 0);
        __builtin_amdgcn_global_load_lds((const unsigned*)(s0 + 4096), (unsigned*)(dst + 4096), 16, 0, 0);
        __builtin_amdgcn_global_load_lds((const unsigned*)s1, (unsigned*)(dst + 8192), 16, 0, 0);
        __builtin_amdgcn_global_load_lds((const unsigned*)(s1 + 4096), (unsigned*)(dst + 12288), 16, 0, 0);
    };
    for (int it = blockIdx.x; it < 64; it += gridDim.x) {
        f32x4 st[4];
#pragma unroll
        for (int tt = 0; tt < 4; ++tt) st[tt] = (f32x4){0.f, 0.f, 0.f, 0.f};
        const size_t cp0 = (size_t)it * 68;
        issue(cp0, 0); issue(cp0 + 1, 1); issue(cp0 + 2, 2);
        for (int c4 = 0; c4 < 68; c4 += 4) {
#pragma unroll
            for (int j = 0; j < 4; ++j) {
                const int c = c4 + j;
                if (c < 65) asm volatile("s_waitcnt vmcnt(8)" ::: "memory"); else asm volatile("s_waitcnt vmcnt(0)" ::: "memory");
                __builtin_amdgcn_s_barrier();
                asm volatile("" ::: "memory");
                uint2 mx[4][2][2], nvv[4];
                asm volatile("ds_read_b64 %0, %1 offset:0" : "=v"(mx[0][0][0]) : "v"(mtaddr + j * 16384));
                asm volatile("ds_read_b64 %0, %1 offset:32" : "=v"(mx[0][0][1]) : "v"(mtaddr + j * 16384));
                asm volatile("ds_read_b64 %0, %1 offset:64" : "=v"(mx[0][1][0]) : "v"(mtaddr + j * 16384));
                asm volatile("ds_read_b64 %0, %1 offset:96" : "=v"(mx[0][1][1]) : "v"(mtaddr + j * 16384));
                asm volatile("ds_read_b64 %0, %1 offset:8192" : "=v"(nvv[0]) : "v"(nladdr + j * 16384));
                asm volatile("ds_read_b64 %0, %1 offset:2048" : "=v"(mx[1][0][0]) : "v"(mtaddr + j * 16384));
                asm volatile("ds_read_b64 %0, %1 offset:2080" : "=v"(mx[1][0][1]) : "v"(mtaddr + j * 16384));
                asm volatile("ds_read_b64 %0, %1 offset:2112" : "=v"(mx[1][1][0]) : "v"(mtaddr + j * 16384));
                asm volatile("ds_read_b64 %0, %1 offset:2144" : "=v"(mx[1][1][1]) : "v"(mtaddr + j * 16384));
                asm volatile("ds_read_b64 %0, %1 offset:8224" : "=v"(nvv[1]) : "v"(nladdr + j * 16384));
                asm volatile("ds_read_b64 %0, %1 offset:4096" : "=v"(mx[2][0][0]) : "v"(mtaddr + j * 16384));
                asm volatile("ds_read_b64 %0, %1 offset:4128" : "=v"(mx[2][0][1]) : "v"(mtaddr + j * 16384));
                asm volatile("ds_read_b64 %0, %1 offset:4160" : "=v"(mx[2][1][0]) : "v"(mtaddr + j * 16384));
                asm volatile("ds_read_b64 %0, %1 offset:4192" : "=v"(mx[2][1][1]) : "v"(mtaddr + j * 16384));
                asm volatile("ds_read_b64 %0, %1 offset:8256" : "=v"(nvv[2]) : "v"(nladdr + j * 16384));
                asm volatile("ds_read_b64 %0, %1 offset:6144" : "=v"(mx[3][0][0]) : "v"(mtaddr + j * 16384));
                asm volatile("ds_read_b64 %0, %1 offset:6176" : "=v"(mx[3][0][1]) : "v"(mtaddr + j * 16384));
                asm volatile("ds_read_b64 %0, %1 offset:6208" : "=v"(mx[3][1][0]) : "v"(mtaddr + j * 16384));
                asm volatile("ds_read_b64 %0, %1 offset:6240" : "=v"(mx[3][1][1]) : "v"(mtaddr + j * 16384));
                asm volatile("ds_read_b64 %0, %1 offset:8288" : "=v"(nvv[3]) : "v"(nladdr + j * 16384));
                u32x4 sb[2];
#pragma unroll
                for (int s_ = 0; s_ < 2; ++s_) sb[s_] = (u32x4){pack2(st[2 * s_][0], st[2 * s_][1]), pack2(st[2 * s_][2], st[2 * s_][3]), pack2(st[2 * s_ + 1][0], st[2 * s_ + 1][1]), pack2(st[2 * s_ + 1][2], st[2 * s_ + 1][3])};
                asm volatile("s_waitcnt lgkmcnt(0)" ::: "memory");
                __builtin_amdgcn_sched_barrier(0);
#pragma unroll
                for (int tt = 0; tt < 4; ++tt) {
                    f32x4 acc = {bflo(nvv[tt].x), bfhi(nvv[tt].x), bflo(nvv[tt].y), bfhi(nvv[tt].y)};
#pragma unroll
                    for (int s_ = 0; s_ < 2; ++s_)
                        acc = __builtin_amdgcn_mfma_f32_16x16x32_bf16(__builtin_bit_cast(bf16x8, (u32x4){mx[tt][s_][0].x, mx[tt][s_][0].y, mx[tt][s_][1].x, mx[tt][s_][1].y}), __builtin_bit_cast(bf16x8, sb[s_]), acc, 0, 0, 0);
                    st[tt] = acc;
                }
                *(u32x4*)(gS0 + ((cp0 + c) * 4 + wave) * 128 + lane) = sb[0]; *(u32x4*)(gS0 + ((cp0 + c) * 4 + wave) * 128 + 64 + lane) = sb[1];
                if (c + 3 < 68) issue(cp0 + c + 3, (j + 3) & 3);
            }
        }
        asm volatile("s_waitcnt vmcnt(0)" ::: "memory");
        __syncthreads();
    }
}
__device__ __forceinline__ void ph_r3(const Params& p) {
    const int tid = tidx(), lane = tid & 63, wave = tid >> 6, fr = lane & 15, fq = lane >> 4;
    const bf16_t* gGT = (const bf16_t*)(p.ws + O_X + X_GT); const bf16_t* gYL = (const bf16_t*)(p.ws + O_X + X_YL);
    const u32x4* gS0 = (const u32x4*)(p.ws + O_X + X_S0);
    bf16_t* YS = (bf16_t*)(p.ws + O_H);
    for (int it = blockIdx.x * 4 + wave; it < NCP; it += gridDim.x * 4) {
        const int c = it % 68, d = (it / 68) & 1, h = (it / 136) & 7, b = it / 1088;
        const bf16_t* gt = gGT + (size_t)it * 4096; const bf16_t* yl = gYL + (size_t)it * 4096;
        u32x4 gf[4][2];
#pragma unroll
        for (int tt = 0; tt < 4; ++tt)
#pragma unroll
            for (int s_ = 0; s_ < 2; ++s_) {
                const bf16_t* q = gt + (tt * 16 + fr) * 64 + s_ * 32 + fq * 4;
                const uint2 a0 = *(const uint2*)q, a1 = *(const uint2*)(q + 16);
                gf[tt][s_] = (u32x4){a0.x, a0.y, a1.x, a1.y};
            }
#pragma unroll
        for (int vg = 0; vg < 4; ++vg) {
            const u32x4 sb0 = gS0[((size_t)it * 4 + vg) * 128 + lane], sb1 = gS0[((size_t)it * 4 + vg) * 128 + 64 + lane];
#pragma unroll
            for (int tt = 0; tt < 4; ++tt) {
                const uint2 yv = *(const uint2*)(yl + (vg * 16 + fr) * 64 + tt * 16 + fq * 4);
                f32x4 acc = {bflo(yv.x), bfhi(yv.x), bflo(yv.y), bfhi(yv.y)};
                acc = __builtin_amdgcn_mfma_f32_16x16x32_bf16(__builtin_bit_cast(bf16x8, gf[tt][0]), __builtin_bit_cast(bf16x8, sb0), acc, 0, 0, 0);
                acc = __builtin_amdgcn_mfma_f32_16x16x32_bf16(__builtin_bit_cast(bf16x8, gf[tt][1]), __builtin_bit_cast(bf16x8, sb1), acc, 0, 0, 0);
#pragma unroll
                for (int r = 0; r < 4; ++r) {
                    const int row = scan_row(b, d, c * 64 + tt * 16 + fq * 4 + r);
                    YS[((size_t)d * RT + row) * 512 + h * 64 + vg * 16 + fr] = f2bf(acc[r]);
                }
            }
        }
    }
}

__device__ __forceinline__ void ph_rpost(const Params& p, int l) {
    const int lane = tidx() & 63, wave = tidx() >> 6;
    const bf16_t* P = (const bf16_t*)(p.ws + O_P); const float* mu = p.in[I_MU] + l * 1792;
    const float* gng = p.in[I_GNG] + l * 512; const float* gnb = p.in[I_GNB] + l * 512;
    const float* BON = (const float*)(p.ws + O_X + X_BON); const bf16_t* YS = (const bf16_t*)(p.ws + O_H);
    const bf16_t* RG = (const bf16_t*)(p.ws + O_RG); bf16_t* RWO = (bf16_t*)(p.ws + O_RWO);
    for (int row = blockIdx.x * 4 + wave; row < RT; row += gridDim.x * 4) {
        const int col = lane * 8, h = lane >> 3;
        float v8[8], g8[8], y0[8], y1[8];
        xs8(P, mu, row, 1024 + col, v8);
        unpack8(*(const uint4*)(RG + (size_t)row * 512 + col), g8);
        unpack8(*(const uint4*)(YS + ((size_t)0 * RT + row) * 512 + col), y0);
        unpack8(*(const uint4*)(YS + ((size_t)1 * RT + row) * 512 + col), y1);
        const float bs = BON[((size_t)0 * RT + row) * 8 + h] + BON[((size_t)1 * RT + row) * 8 + h];
        float y[8]; float sm = 0.f;
#pragma unroll
        for (int j = 0; j < 8; ++j) { y[j] = y0[j] + y1[j]; sm += y[j]; }
        sm += __shfl_xor(sm, 1); sm += __shfl_xor(sm, 2); sm += __shfl_xor(sm, 4);
        const float mean = sm * (1.f / 64.f);
        float vs = 0.f;
#pragma unroll
        for (int j = 0; j < 8; ++j) { const float dlt = y[j] - mean; vs += dlt * dlt; }
        vs += __shfl_xor(vs, 1); vs += __shfl_xor(vs, 2); vs += __shfl_xor(vs, 4);
        const float rstd = rsqrtf(vs * (1.f / 64.f) + 64e-5f);
        float o[8];
#pragma unroll
        for (int j = 0; j < 8; ++j) o[j] = ((y[j] - mean) * rstd * gng[col + j] + gnb[col + j] + bs * v8[j]) * g8[j];
        *(uint4*)(RWO + (size_t)row * 512 + col) = pack8(o);
    }
}

__device__ __forceinline__ void ph_f1(const Params& p, int l, char* smem) {
    const bf16_t* P = (const bf16_t*)(p.ws + O_P); const bf16_t* CSC = (const bf16_t*)(p.ws + O_CSC);
    bf16_t* YT2 = (bf16_t*)(p.ws + O_YT2); bf16_t* YTC = (bf16_t*)(p.ws + O_YTC);
    const int nitems = 1024 + (l < NLAYER - 1 ? 64 : 0);
    for (int it = blockIdx.x; it < nitems; it += gridDim.x) {
        f32x4 acc[4][4];
        if (it < 1024) {
            const int b = it >> 8, g = (it >> 6) & 3, part = (it >> 5) & 1, j = it & 31;
            RPPlain rpa{CSC + (size_t)part * 128 * 128, 128};
            const bf16_t* pb = P + (size_t)b * SEQ * LDP + g * 128;
            auto rpb = [&](int r) -> const bf16_t* { return pb + (size_t)(64 * (r & 63) + 2 * j + (r >> 6)) * LDP; };
            gemm_core_gb<4>(rpa, rpb, 128, acc, smem);
            acc_foreach<4>(acc, [&](int m, int n, const f32x4& v) {
                const int t1 = n & 63, t2 = 2 * j + (n >> 6);
                store_bf16x4(YT2 + ((size_t)(b * 512 + g * 128 + m) * 64 + t2) * 128 + part * 64 + t1, v);
            });
        } else {
            const int jj = it - 1024, b = jj >> 4, g = (jj >> 2) & 3, part = (jj >> 1) & 1, nt = jj & 1;
            RPPlain rpa{CSC + (size_t)part * 128 * 128, 128};
            gemm_core_g<4>(rpa, P + (size_t)(RL + b * CTX + nt * 128) * LDP + g * 128, LDP, 128, acc, smem);
            acc_foreach<4>(acc, [&](int m, int n, const f32x4& v) {
                store_bf16x4(YTC + ((size_t)(b * 512 + g * 128 + m)) * 512 + part * 256 + nt * 128 + n, v);
            });
        }
    }
}
__device__ __forceinline__ void ph_fa(const Params& p, char* smem) {
    const bf16_t* YT2 = (const bf16_t*)(p.ws + O_YT2); const bf16_t* D128 = (const bf16_t*)(p.ws + O_D128);
    const float* TWC = (const float*)(p.ws + O_TWC); const float* TWS = (const float*)(p.ws + O_TWS);
    bf16_t* A2 = (bf16_t*)(p.ws + O_A2);
    for (int it = blockIdx.x; it < 1024; it += gridDim.x) {
        f32x4 acc[4][4];
        RPPlain rpa{D128, 128};
        gemm_core_g<4>(rpa, YT2 + (size_t)it * 128 * 128, 128, 128, acc, smem);
        const int lane = tidx() & 63, wave = tidx() >> 6, wr = wave >> 1, wc = wave & 1, fr = lane & 15, fq = lane >> 4;
        float* U = (float*)smem;
        if (wr == 1) {
#pragma unroll
            for (int i = 0; i < 4; ++i)
#pragma unroll
                for (int j = 0; j < 4; ++j) *(f32x4*)(U + (i * 16 + fr) * 132 + wc * 64 + j * 16 + fq * 4) = acc[i][j];
        }
        __syncthreads();
        if (wr == 0) {
#pragma unroll
            for (int i = 0; i < 4; ++i) {
                const int k1 = i * 16 + fr;
#pragma unroll
                for (int j = 0; j < 4; ++j) {
                    const int r = wc * 64 + j * 16 + fq * 4;
                    const int R = it * 128 + r, bn = R >> 6, t2 = R & 63, b = bn >> 9, n = bn & 511;
                    const f32x4 ai = *(const f32x4*)(U + k1 * 132 + r);
                    const f32x4 c = *(const f32x4*)(TWC + k1 * 64 + t2), sn = *(const f32x4*)(TWS + k1 * 64 + t2);
                    const f32x4 ar = acc[i][j];
                    const f32x4 pr = ar * c - ai * sn, pi = ar * sn + ai * c;
                    bf16_t* dst = A2 + ((size_t)(b * 64 + k1) * 512 + n) * 128 + t2;
                    store_bf16x4(dst, pr); store_bf16x4(dst + 64, pi);
                }
            }
        }
        __syncthreads();
    }
}
__device__ __forceinline__ void ph_fb(const Params& p, int l, char* smem) {
    const bf16_t* A2 = (const bf16_t*)(p.ws + O_A2); const bf16_t* E64 = (const bf16_t*)(p.ws + O_E64);
    const bf16_t* CST2 = (const bf16_t*)(p.ws + O_CST256); const bf16_t* YTC = (const bf16_t*)(p.ws + O_YTC);
    bf16_t* FA = (bf16_t*)(p.ws + O_FA);
    const int nitems = 1024 + (l < NLAYER - 1 ? 32 : 0);
    for (int it = blockIdx.x; it < nitems; it += gridDim.x) {
        if (it < 1024) {
            const int b = it >> 8, k1 = (it >> 2) & 63, nt = it & 3;
            f32x4 acc[2][4];
            RPPlain rpa{E64, 128};
            gemm_core_g<2>(rpa, A2 + ((size_t)(b * 64 + k1) * 512 + nt * 128) * 128, 128, 128, acc, smem);
            const float sc = 0.001381067932004975f;
            acc_foreach<2>(acc, [&](int m, int n, const f32x4& v) { f32x4 o = v * sc; store_bf16x4(FA + (size_t)(b * SEQ + k1 + 64 * m) * 512 + nt * 128 + n, o); });
        } else {
            const int j = it - 1024, b = j >> 3, mt = (j >> 2) & 1, nt = j & 3;
            f32x4 acc[4][4];
            RPPlain rp{CST2 + (size_t)mt * 128 * 512, 512};
            gemm_core_g<4>(rp, YTC + ((size_t)b * 512 + nt * 128) * 512, 512, 512, acc, smem);
            const float sc = 0.005524271728019903f;
            acc_foreach<4>(acc, [&](int m, int n, const f32x4& v) { f32x4 o = v * sc; store_bf16x4(FA + (size_t)(RL + b * CTX + mt * 128 + m) * 512 + nt * 128 + n, o); });
        }
    }
}

__device__ __forceinline__ void ph_mg(const Params& p, int l, char* smem) {
    const bf16_t* P = (const bf16_t*)(p.ws + O_P);
    const bf16_t* A0 = (const bf16_t*)(p.ws + O_FA); const bf16_t* A1 = (const bf16_t*)(p.ws + O_ATT); const bf16_t* A2 = (const bf16_t*)(p.ws + O_RWO);
    const bf16_t* W0 = (const bf16_t*)(p.ws + O_WB + W_PA); const bf16_t* W1 = (const bf16_t*)(p.ws + O_WB + W_PB); const bf16_t* W2 = (const bf16_t*)(p.ws + O_WB + W_PC);
    bf16_t* MG = (bf16_t*)(p.ws + O_H);
    const int nmt = (l < NLAYER - 1) ? RT / 64 : RL / 64;
    for (int it = blockIdx.x; it < nmt * 8; it += gridDim.x) {
        const int mt = it >> 3, nt = it & 7;
        f32x4 tot[2][4];
#pragma unroll
        for (int i = 0; i < 2; ++i)
#pragma unroll
            for (int j = 0; j < 4; ++j) tot[i][j] = (f32x4){0.f, 0.f, 0.f, 0.f};
#pragma unroll 1
        for (int br = 0; br < 3; ++br) {
            const bf16_t* Ab = br == 0 ? A0 : (br == 1 ? A1 : A2);
            const bf16_t* Wb = br == 0 ? W0 : (br == 1 ? W1 : W2);
            f32x4 acc[2][4];
            RPPlain rp{Ab + (size_t)mt * 64 * 512, 512};
            gemm_core_g<2>(rp, Wb + (size_t)nt * 128 * 512, 512, 512, acc, smem);
            const int lane = tidx() & 63, wave = tidx() >> 6, wr = wave >> 1, wc = wave & 1, fr = lane & 15, fq = lane >> 4;
#pragma unroll
            for (int i = 0; i < 2; ++i)
#pragma unroll
                for (int j = 0; j < 4; ++j) {
                    const int m = wr * 32 + i * 16 + fr, n = wc * 64 + j * 16 + fq * 4;
                    const uint2 gu = *(const uint2*)(P + (size_t)(mt * 64 + m) * LDP + PG0 + br * 1024 + nt * 128 + n);
                    tot[i][j][0] += bflo(gu.x) * acc[i][j][0]; tot[i][j][1] += bfhi(gu.x) * acc[i][j][1];
                    tot[i][j][2] += bflo(gu.y) * acc[i][j][2]; tot[i][j][3] += bfhi(gu.y) * acc[i][j][3];
                }
        }
        acc_foreach<2>(tot, [&](int m, int n, const f32x4& v) { store_bf16x4(MG + (size_t)(mt * 64 + m) * 1024 + nt * 128 + n, v); });
    }
}
__device__ __forceinline__ void ph_out(const Params& p, int l, char* smem) {
    const bf16_t* MG = (const bf16_t*)(p.ws + O_H); const bf16_t* W = (const bf16_t*)(p.ws + O_WB + W_OUT);
    float* xcur = (float*)(p.ws + O_XCUR); const float* mod = (const float*)(p.ws + O_MOD);
    const int nmt = (l < NLAYER - 1) ? RT / 64 : RL / 64;
    for (int it = blockIdx.x; it < nmt * 8; it += gridDim.x) {
        const int mt = it >> 3, nt = it & 7;
        f32x4 acc[2][4];
        RPPlain rp{MG + (size_t)mt * 64 * 1024, 1024};
        gemm_core_g<2>(rp, W + (size_t)nt * 128 * 1024, 1024, 1024, acc, smem);
        acc_foreach<2>(acc, [&](int m, int n, const f32x4& v) {
            const int row = mt * 64 + m, col = nt * 128 + n;
            const float4 g = *(const float4*)(mod + (size_t)(l * 5 + modidx(row)) * 6144 + 2048 + col);
            float4* xp = (float4*)(xcur + (size_t)row * 1024 + col);
            float4 x = *xp; x.x += g.x * v[0]; x.y += g.y * v[1]; x.z += g.z * v[2]; x.w += g.w * v[3]; *xp = x;
        });
    }
}

__device__ __forceinline__ void ph_n2(const Params& p, int l, char* smem) {
    const int tid = tidx(), lane = tid & 63, wave = tid >> 6;
    unsigned* lcnt = (unsigned*)smem;
    unsigned* gbase = lcnt + 16;
    int* rec = (int*)(smem + 256);
    if (tid < 16) lcnt[tid] = 0u;
    __syncthreads();
    int nrec = 0;
    const float* xcur = (const float*)(p.ws + O_XCUR); const float* mod = (const float*)(p.ws + O_MOD);
    bf16_t* H = (bf16_t*)(p.ws + O_H);
    unsigned* cnt = (unsigned*)(p.ws + O_CNT); int* LTOK = (int*)(p.ws + O_LTOK); float* LW = (float*)(p.ws + O_LW); int* SLOT = (int*)(p.ws + O_SLOT);
    const float* g = p.in[I_N2G] + l * 1024; const float* rw = p.in[I_RW]; const float* rb = p.in[I_RB];
    const int nrows = (l < NLAYER - 1) ? RT : RL;
    for (int row = blockIdx.x * 4 + wave; row < nrows; row += gridDim.x * 4) {
        const float* x = xcur + (size_t)row * 1024; const float* md = mod + (size_t)(l * 5 + modidx(row)) * 6144;
        float4 v[4]; float ss = 0.f;
#pragma unroll
        for (int i = 0; i < 4; ++i) { v[i] = *(const float4*)(x + lane * 4 + 256 * i); ss += v[i].x * v[i].x + v[i].y * v[i].y + v[i].z * v[i].z + v[i].w * v[i].w; }
        ss = wsum(ss);
        const float rstd = rsqrtf(ss * (1.f / 1024.f) + 1e-6f);
        float lg[16];
#pragma unroll
        for (int e = 0; e < 16; ++e) lg[e] = 0.f;
#pragma unroll
        for (int i = 0; i < 4; ++i) {
            const int c = lane * 4 + 256 * i;
            const float4 gg = *(const float4*)(g + c), sc = *(const float4*)(md + 4096 + c), sh = *(const float4*)(md + 3072 + c);
            const float hv[4] = {v[i].x * rstd * gg.x * (1.f + sc.x) + sh.x, v[i].y * rstd * gg.y * (1.f + sc.y) + sh.y,
                                 v[i].z * rstd * gg.z * (1.f + sc.z) + sh.z, v[i].w * rstd * gg.w * (1.f + sc.w) + sh.w};
            f32x4 h4 = {hv[0], hv[1], hv[2], hv[3]};
            store_bf16x4(H + (size_t)row * 1024 + c, h4);
#pragma unroll
            for (int j = 0; j < 4; ++j) {
                const float* wr_ = rw + (size_t)(c + j) * 16;
                const float4 w0 = *(const float4*)wr_, w1 = *(const float4*)(wr_ + 4), w2 = *(const float4*)(wr_ + 8), w3 = *(const float4*)(wr_ + 12);
                lg[0] += hv[j] * w0.x; lg[1] += hv[j] * w0.y; lg[2] += hv[j] * w0.z; lg[3] += hv[j] * w0.w;
                lg[4] += hv[j] * w1.x; lg[5] += hv[j] * w1.y; lg[6] += hv[j] * w1.z; lg[7] += hv[j] * w1.w;
                lg[8] += hv[j] * w2.x; lg[9] += hv[j] * w2.y; lg[10] += hv[j] * w2.z; lg[11] += hv[j] * w2.w;
                lg[12] += hv[j] * w3.x; lg[13] += hv[j] * w3.y; lg[14] += hv[j] * w3.z; lg[15] += hv[j] * w3.w;
            }
        }
        float sc_[16], sel[16];
#pragma unroll
        for (int e = 0; e < 16; ++e) { lg[e] = wsum(lg[e]); sc_[e] = 1.f / (1.f + expf(-lg[e])); sel[e] = sc_[e] + rb[e]; }
        int best = 0; float bestv = -1e30f;
#pragma unroll
        for (int gi = 0; gi < 4; ++gi) {
            float m1 = -1e30f, m2 = -1e30f;
#pragma unroll
            for (int j = 0; j < 4; ++j) { const float s = sel[gi * 4 + j]; if (s > m1) { m2 = m1; m1 = s; } else if (s > m2) m2 = s; }
            const float gs = m1 + m2;
            if (gs > bestv) { bestv = gs; best = gi; }
        }
        float s4[4] = {0.f, 0.f, 0.f, 0.f}, c4[4] = {0.f, 0.f, 0.f, 0.f};
#pragma unroll
        for (int gi = 0; gi < 4; ++gi)
#pragma unroll
            for (int j = 0; j < 4; ++j) if (gi == best) { s4[j] = sel[gi * 4 + j]; c4[j] = sc_[gi * 4 + j]; }
        int i1 = 0; float v1 = s4[0], w1 = c4[0];
#pragma unroll
        for (int j = 1; j < 4; ++j) if (s4[j] > v1) { v1 = s4[j]; i1 = j; w1 = c4[j]; }
        int i2 = -1; float v2 = -1e30f, w2 = 0.f;
#pragma unroll
        for (int j = 0; j < 4; ++j) if (j != i1 && s4[j] > v2) { v2 = s4[j]; i2 = j; w2 = c4[j]; }
        if (lane == 0) {
            const float inv = 1.f / (w1 + w2);
            const int e1 = best * 4 + i1, e2 = best * 4 + i2;
            const unsigned r1 = atomicAdd(&lcnt[e1], 1u), r2 = atomicAdd(&lcnt[e2], 1u);
            int* rc = rec + (wave * 32 + nrec) * 8;
            rc[0] = row; rc[1] = e1; rc[2] = e2; rc[3] = (int)r1; rc[4] = (int)r2; rc[5] = __float_as_int(w1 * inv); rc[6] = __float_as_int(w2 * inv);
        }
        ++nrec;
    }
    __syncthreads();
    if (tid < 16) gbase[tid] = lcnt[tid] ? atomicAdd(&cnt[tid], lcnt[tid]) : 0u;
    __syncthreads();
    for (int i = lane; i < nrec; i += 64) {
        const int* rc = rec + (wave * 32 + i) * 8;
        const int row = rc[0], e1 = rc[1], e2 = rc[2];
        const unsigned p1 = gbase[e1] + (unsigned)rc[3], p2 = gbase[e2] + (unsigned)rc[4];
        LTOK[(size_t)e1 * RT + p1] = row; LW[(size_t)e1 * RT + p1] = __int_as_float(rc[5]);
        LTOK[(size_t)e2 * RT + p2] = row; LW[(size_t)e2 * RT + p2] = __int_as_float(rc[6]);
        SLOT[row * 2] = (e1 << 20) | (int)p1; SLOT[row * 2 + 1] = (e2 << 20) | (int)p2;
    }
}

struct MoeTiles { int tb[17]; int sm; };
__device__ __forceinline__ void moe_tiles(const Params& p, int l, int* s_tb) {
    if (tidx() == 0) {
        const unsigned* cnt = (const unsigned*)(p.ws + O_CNT);
        int a = 0;
        for (int e = 0; e < 16; ++e) { s_tb[e] = a; a += ((int)cnt[e] + 127) >> 7; }
        s_tb[16] = a;
    }
    __syncthreads();
}
struct ALGather {
    const bf16_t* p[4]; bool ok[4];
    __device__ __forceinline__ uint4 load(int i, int k) const { return ok[i] ? *(const uint4*)(p[i] + k) : make_uint4(0u, 0u, 0u, 0u); }
};
struct ALSwiglu {
    const bf16_t* p[4]; float w[4];
    __device__ __forceinline__ uint4 load(int i, int k) const {
        float g[8], u[8], o[8]; unpack8(*(const uint4*)(p[i] + k), g); unpack8(*(const uint4*)(p[i] + 512 + k), u);
#pragma unroll
        for (int j = 0; j < 8; ++j) o[j] = siluf_(g[j]) * u[j] * w[i];
        return pack8(o);
    }
};
__device__ __forceinline__ void ph_e1(const Params& p, int l, char* smem) {
    int* s_tb = (int*)(smem + 73728);
    moe_tiles(p, l, s_tb);
    const bf16_t* H = (const bf16_t*)(p.ws + O_H); bf16_t* ACT = (bf16_t*)(p.ws + O_P);
    const unsigned* cnt = (const unsigned*)(p.ws + O_CNT); const int* LTOK = (const int*)(p.ws + O_LTOK); const float* LW = (const float*)(p.ws + O_LW);
    const int sm = (l < NLAYER - 1) ? RT / 128 : RL / 128;
    const int total = (sm + s_tb[16]) * 8;
    for (int it = blockIdx.x; it < total; it += gridDim.x) {
        const int mt = it >> 3, nt = it & 7;
        int e = 16, erow0 = mt * 128, lt = 0;
        if (mt >= sm) { const int q = mt - sm; e = 0; while (q >= s_tb[e + 1]) ++e; lt = q - s_tb[e]; erow0 = RT + q * 128; }
        const int cnte = (e == 16) ? 0 : (int)cnt[e];
        auto rp = [&](int r) -> const bf16_t* {
            if (e == 16) return H + (size_t)(mt * 128 + r) * 1024;
            const int idx = lt * 128 + r;
            const int tok = idx < cnte ? LTOK[(size_t)e * RT + idx] : 0;
            return H + (size_t)tok * 1024;
        };
        f32x4 acc[4][4];
        gemm_core_g<4>(rp, (const bf16_t*)(p.ws + O_WB + W_GU) + (size_t)e * 1024 * 1024 + (size_t)nt * 128 * 1024, 1024, 1024, acc, smem);
        {
            const int lane = tidx() & 63, wave = tidx() >> 6, wr = wave >> 1, wc = wave & 1, fr = lane & 15, fq = lane >> 4;
            float* U = (float*)smem;
            if (wc == 1) {
#pragma unroll
                for (int i = 0; i < 4; ++i)
#pragma unroll
                    for (int j = 0; j < 4; ++j) *(f32x4*)(U + (wr * 64 + i * 16 + fr) * 68 + j * 16 + fq * 4) = acc[i][j];
            }
            __syncthreads();
            if (wc == 0) {
#pragma unroll
                for (int i = 0; i < 4; ++i) {
                    const int m = wr * 64 + i * 16 + fr;
                    float wgt = 1.f;
                    if (e != 16) { const int idx = lt * 128 + m; wgt = idx < cnte ? LW[(size_t)e * RT + idx] : 0.f; }
#pragma unroll
                    for (int j = 0; j < 4; ++j) {
                        const f32x4 u = *(const f32x4*)(U + m * 68 + j * 16 + fq * 4);
                        f32x4 o;
#pragma unroll
                        for (int r = 0; r < 4; ++r) o[r] = siluf_(acc[i][j][r]) * u[r] * wgt;
                        store_bf16x4(ACT + (size_t)(erow0 + m) * 512 + nt * 64 + j * 16 + fq * 4, o);
                    }
                }
            }
            __syncthreads();
        }
    }
}
__device__ __forceinline__ void ph_e2(const Params& p, int l, char* smem) {
    int* s_tb = (int*)(smem + 73728);
    moe_tiles(p, l, s_tb);
    const bf16_t* ACT = (const bf16_t*)(p.ws + O_P); bf16_t* YE = (bf16_t*)(p.ws + O_X + X_YE);
    const int sm = (l < NLAYER - 1) ? RT / 128 : RL / 128;
    const int total = (sm + s_tb[16]) * 8;
    for (int it = blockIdx.x; it < total; it += gridDim.x) {
        const int mt = it >> 3, nt = it & 7;
        int e = 16, erow0 = mt * 128;
        if (mt >= sm) { const int q = mt - sm; e = 0; while (q >= s_tb[e + 1]) ++e; erow0 = RT + q * 128; }
        RPPlain rp{ACT + (size_t)erow0 * 512, 512};
        f32x4 acc[4][4];
        gemm_core_g<4>(rp, (const bf16_t*)(p.ws + O_WB + W_D) + (size_t)e * 1024 * 512 + (size_t)nt * 128 * 512, 512, 512, acc, smem);
        acc_foreach<4>(acc, [&](int m, int n, const f32x4& v) { store_bf16x4(YE + (size_t)(erow0 + m) * 1024 + nt * 128 + n, v); });
    }
}
__device__ __forceinline__ void ph_e3(const Params& p, int l, char* smem) {
    int* s_tb = (int*)(smem + 73728);
    moe_tiles(p, l, s_tb);
    const int lane = tidx() & 63, wave = tidx() >> 6;
    const bf16_t* YE = (const bf16_t*)(p.ws + O_X + X_YE); const int* SLOT = (const int*)(p.ws + O_SLOT);
    float* xcur = (float*)(p.ws + O_XCUR); const float* mod = (const float*)(p.ws + O_MOD);
    bf16_t* H = (bf16_t*)(p.ws + O_H);
    const bool last = l == NLAYER - 1;
    const int nrows = last ? RL : RT;
    const float* gn = last ? p.in[I_FNG] : p.in[I_N1G] + (l + 1) * 1024;
    for (int row = blockIdx.x * 4 + wave; row < nrows; row += gridDim.x * 4) {
        const int s1 = SLOT[row * 2], s2 = SLOT[row * 2 + 1];
        const size_t r0 = row, r1 = (size_t)RT + s_tb[s1 >> 20] * 128 + (s1 & 0xfffff), r2 = (size_t)RT + s_tb[s2 >> 20] * 128 + (s2 & 0xfffff);
        const float* g2 = mod + (size_t)(l * 5 + modidx(row)) * 6144 + 5120;
        float xv[2][8]; float ss = 0.f;
#pragma unroll
        for (int i = 0; i < 2; ++i) {
            const int c = lane * 8 + 512 * i;
            float a[8], b[8], d[8];
            unpack8(*(const uint4*)(YE + r0 * 1024 + c), a); unpack8(*(const uint4*)(YE + r1 * 1024 + c), b); unpack8(*(const uint4*)(YE + r2 * 1024 + c), d);
            float4* xp = (float4*)(xcur + (size_t)row * 1024 + c);
            const float4 x0 = xp[0], x1 = xp[1];
            const float4 ga = *(const float4*)(g2 + c), gb = *(const float4*)(g2 + c + 4);
            const float xo[8] = {x0.x, x0.y, x0.z, x0.w, x1.x, x1.y, x1.z, x1.w}, gg[8] = {ga.x, ga.y, ga.z, ga.w, gb.x, gb.y, gb.z, gb.w};
#pragma unroll
            for (int e = 0; e < 8; ++e) { xv[i][e] = xo[e] + gg[e] * (a[e] + b[e] + d[e]); ss += xv[i][e] * xv[i][e]; }
            if (!last) { xp[0] = make_float4(xv[i][0], xv[i][1], xv[i][2], xv[i][3]); xp[1] = make_float4(xv[i][4], xv[i][5], xv[i][6], xv[i][7]); }
        }
        ss = wsum(ss);
        const float rstd = rsqrtf(ss * (1.f / 1024.f) + 1e-6f);
        const float* md = mod + (size_t)((l + 1) * 5 + modidx(row)) * 6144;
#pragma unroll
        for (int i = 0; i < 2; ++i) {
            const int c = lane * 8 + 512 * i;
            const float4 n0 = *(const float4*)(gn + c), n1 = *(const float4*)(gn + c + 4);
            const float nn[8] = {n0.x, n0.y, n0.z, n0.w, n1.x, n1.y, n1.z, n1.w};
            if (last) {
                float* op = p.out + (size_t)row * 1024 + c;
                *(float4*)op = make_float4(xv[i][0] * rstd * nn[0], xv[i][1] * rstd * nn[1], xv[i][2] * rstd * nn[2], xv[i][3] * rstd * nn[3]);
                *(float4*)(op + 4) = make_float4(xv[i][4] * rstd * nn[4], xv[i][5] * rstd * nn[5], xv[i][6] * rstd * nn[6], xv[i][7] * rstd * nn[7]);
            } else {
                const float4 c0 = *(const float4*)(md + 1024 + c), c1 = *(const float4*)(md + 1024 + c + 4), h0 = *(const float4*)(md + c), h1 = *(const float4*)(md + c + 4);
                const float sc[8] = {c0.x, c0.y, c0.z, c0.w, c1.x, c1.y, c1.z, c1.w}, sh[8] = {h0.x, h0.y, h0.z, h0.w, h1.x, h1.y, h1.z, h1.w};
                float o[8];
#pragma unroll
                for (int e = 0; e < 8; ++e) o[e] = xv[i][e] * rstd * nn[e] * (1.f + sc[e]) + sh[e];
                *(uint4*)(H + (size_t)row * 1024 + c) = pack8(o);
            }
        }
    }
}
__device__ __forceinline__ void ph_final(const Params& p) {
    const int lane = tidx() & 63, wave = tidx() >> 6;
    const float* xcur = (const float*)(p.ws + O_XCUR); const float* g = p.in[I_FNG];
    for (int row = blockIdx.x * 4 + wave; row < RL; row += gridDim.x * 4) {
        const float* x = xcur + (size_t)row * 1024;
        float4 v[4]; float ss = 0.f;
#pragma unroll
        for (int i = 0; i < 4; ++i) { v[i] = *(const float4*)(x + lane * 4 + 256 * i); ss += v[i].x * v[i].x + v[i].y * v[i].y + v[i].z * v[i].z + v[i].w * v[i].w; }
        ss = wsum(ss);
        const float rstd = rsqrtf(ss * (1.f / 1024.f) + 1e-6f);
#pragma unroll
        for (int i = 0; i < 4; ++i) {
            const int c = lane * 4 + 256 * i; const float4 gg = *(const float4*)(g + c);
            *(float4*)(p.out + (size_t)row * 1024 + c) = make_float4(v[i].x * rstd * gg.x, v[i].y * rstd * gg.y, v[i].z * rstd * gg.z, v[i].w * rstd * gg.w);
        }
    }
}

constexpr int LDS_BYTES = 76800;
constexpr int NIV = 19;
extern __shared__ __attribute__((aligned(16))) char dynsmem[];
template <int ID> __device__ __forceinline__ void run_iv(const Params& pin, int l, char* smem) {
    Params p = pin; p.ws = launder(pin.ws);
    if constexpr (ID == 0) { ph_pre(p, smem); __syncthreads(); ph_w(p, 0, smem); }
    else if constexpr (ID == 1) ph_n1(p, l);
    else if constexpr (ID == 2) ph_g1(p, smem);
    else if constexpr (ID == 3) { ph_qu(p, smem); ph_rp1(p, l, smem); ph_rp2(p, l); ph_f1(p, l, smem); }
    else if constexpr (ID == 4) ph_m2(p, smem);
    else if constexpr (ID == 5) {
        const bool r1first = (blockIdx.x >> 8) & 1;
#pragma unroll 1
        for (int pass = 0; pass < 2; ++pass) {
            if ((pass == 0) == r1first) { ph_r1(p, l, smem); ph_fa(p, smem); } else ph_at(p, l, smem);
            __syncthreads();
        }
    }
    else if constexpr (ID == 6) { }
    else if constexpr (ID == 7) { }
    else if constexpr (ID == 8) { ph_r2(p, smem); __syncthreads(); ph_fb(p, l, smem); }
    else if constexpr (ID == 9) ph_r3(p);
    else if constexpr (ID == 10) ph_rpost(p, l);
    else if constexpr (ID == 11) { }
    else if constexpr (ID == 12) ph_mg(p, l, smem);
    else if constexpr (ID == 13) ph_out(p, l, smem);
    else if constexpr (ID == 14) ph_n2(p, l, smem);
    else if constexpr (ID == 15) ph_e1(p, l, smem);
    else if constexpr (ID == 16) ph_e2(p, l, smem);
    else if constexpr (ID == 17) { ph_e3(p, l, smem); __syncthreads(); if (l + 1 < NLAYER) ph_w(p, l + 1, smem); }
    else ph_final(p);
}
#if MEGA
#ifndef PROBE_MASK
#define PROBE_MASK 0
#define PROBE_REP 1
#endif
#define IV(ID) for (int r_ = 0; r_ < (((PROBE_MASK >> (ID)) & 1) ? PROBE_REP : 1); ++r_) { run_iv<ID>(p, l, smem); xcd_barrier(bar); }
__global__ void __launch_bounds__(256, 2) k_mega(Params p) {
    char* smem = dynsmem;
    volatile LAS unsigned* st = (volatile LAS unsigned*)(smem + LDS_BYTES - 16);
    if (tidx() == 0) { st[0] = 0u; st[1] = 0u; }
    __syncthreads();
    XcdBarrier bar = xcd_barrier_post((unsigned*)(p.ws + O_BAR), st);
    { const int l = 0; IV(0) }
    for (int l = 0; l < NLAYER; ++l) {
        if (l == 0) { IV(1) } IV(2) IV(3) IV(4) IV(5) IV(8) IV(9) IV(10) IV(12) IV(13) IV(14) IV(15) IV(16) IV(17)
    }
}
#else
template <int ID> __global__ void __launch_bounds__(256, 2) k_iv(Params p, int l) { run_iv<ID>(p, l, dynsmem); }
template <int ID> static void launch_iv(const Params& p, int l, int grid, hipStream_t s) {
    static bool once = false; if (!once) { once = true; (void)hipFuncSetAttribute((const void*)k_iv<ID>, hipFuncAttributeMaxDynamicSharedMemorySize, LDS_BYTES); }
    hipLaunchKernelGGL(k_iv<ID>, dim3(grid), dim3(256), LDS_BYTES, s, p, l);
}
#endif

extern "C" void kernel_launch(void* const* d_in, const int* in_sizes, int n_in, void* d_out, int out_size, void* d_ws, size_t ws_size, hipStream_t stream) {
    (void)in_sizes; (void)out_size;
    if (n_in < N_IN || ws_size < WS_NEED) return;
    Params p{};
    for (int i = 0; i < N_IN; ++i) p.in[i] = (const float*)d_in[i];
    p.out = (float*)d_out; p.ws = (char*)d_ws;
    static int grid = 0;
    if (!grid) {
        int dev = 0, cus = 0; (void)hipGetDevice(&dev); (void)hipDeviceGetAttribute(&cus, hipDeviceAttributeMultiprocessorCount, dev);
        int per_cu = 2;
#if MEGA
        (void)hipFuncSetAttribute((const void*)k_mega, hipFuncAttributeMaxDynamicSharedMemorySize, LDS_BYTES);
        int occ = 0; (void)hipOccupancyMaxActiveBlocksPerMultiprocessor(&occ, k_mega, 256, LDS_BYTES);
        if (occ < per_cu) per_cu = occ;
        if (per_cu < 1) per_cu = 1;
#endif
        grid = cus * per_cu;
    }
#if MEGA
    (void)hipMemsetAsync(p.ws + O_BAR, 0, 16384, stream);
    hipLaunchKernelGGL(k_mega, dim3(grid), dim3(256), LDS_BYTES, stream, p);
#else
    launch_iv<0>(p, 0, grid, stream);
    for (int l = 0; l < NLAYER; ++l) {
        if (l == 0) launch_iv<1>(p, l, grid, stream); launch_iv<2>(p, l, grid, stream); launch_iv<3>(p, l, grid, stream); launch_iv<4>(p, l, grid, stream);
        launch_iv<5>(p, l, grid, stream); launch_iv<8>(p, l, grid, stream);
        launch_iv<9>(p, l, grid, stream); launch_iv<10>(p, l, grid, stream); launch_iv<12>(p, l, grid, stream);
        launch_iv<13>(p, l, grid, stream); launch_iv<14>(p, l, grid, stream); launch_iv<15>(p, l, grid, stream); launch_iv<16>(p, l, grid, stream); launch_iv<17>(p, l, grid, stream);
    }
#endif
}
```

```cpp
#include <hip/hip_runtime.h>
#include <stdint.h>

#ifndef MEGA
#define MEGA 1
#endif

typedef unsigned short bf16_t;
typedef short bf16x8 __attribute__((ext_vector_type(8)));
typedef float f32x4 __attribute__((ext_vector_type(4)));
typedef float f32x2 __attribute__((ext_vector_type(2)));
typedef unsigned u32x4 __attribute__((ext_vector_type(4)));
typedef __bf16 bf16v2 __attribute__((ext_vector_type(2)));

constexpr int NLAYER = 4;
constexpr int DM = 1024;
constexpr int RL = 16384, RC = 1024, RT = RL + RC;
constexpr int SEQ = 4096, CTX = 256, KEYS = SEQ + CTX;
constexpr int LDP = 6144;
constexpr int PQ0 = 512, PKV0 = 896, PKR0 = 1152, PR0 = 1184, PG0 = 2976, PEND = 6048;
constexpr int NEXP = 16;
constexpr int EROWS = 54272;

enum { I_X = 0, I_C, I_CTX, I_CCTX, I_WADA, I_BADA, I_N1G, I_N2G, I_WIN, I_QNG, I_KVNG, I_WUQ, I_WUKV, I_MU, I_W0, I_WUP, I_A0, I_AUP, I_GUP,
       I_KK, I_KA, I_RK, I_GNG, I_GNB, I_WPA, I_WPB, I_WPC, I_WOUT, I_RW, I_RB, I_EG, I_EU, I_ED, I_SG, I_SU, I_SD, I_FNG, N_IN };

struct Params { const float* in[N_IN]; float* out; char* ws; };

constexpr size_t al256(size_t x) { return (x + 255) & ~(size_t)255; }
constexpr size_t O_BAR   = 0;
constexpr size_t O_CNT   = O_BAR + 16384;
constexpr size_t O_MOD   = O_CNT + 4096;
constexpr size_t O_ROPEC = O_MOD + (size_t)NLAYER * 5 * 6144 * 4;
constexpr size_t O_ROPES = O_ROPEC + (size_t)SEQ * 16 * 4;
constexpr size_t O_CSC   = O_ROPES + (size_t)SEQ * 16 * 4;
constexpr size_t O_CST256= O_CSC + 256 * 128 * 2;
constexpr size_t O_D128  = O_CST256 + 256 * 512 * 2;
constexpr size_t O_E64   = O_D128 + 128 * 128 * 2;
constexpr size_t O_TWC   = O_E64 + 64 * 128 * 2;
constexpr size_t O_TWS   = O_TWC + 64 * 64 * 4;
constexpr size_t O_YT2   = O_TWS + 64 * 64 * 4;
constexpr size_t O_A2    = O_YT2 + (size_t)4 * 512 * 64 * 128 * 2;
constexpr size_t O_YTC   = O_A2 + (size_t)4 * 512 * 64 * 128 * 2;
constexpr size_t O_XCUR  = O_YTC + (size_t)4 * 512 * 512 * 2;
constexpr size_t O_WB    = O_XCUR + (size_t)RT * DM * 4;
constexpr size_t W_IN   = 0;
constexpr size_t W_UQ   = W_IN + (size_t)6144 * 1024 * 2;
constexpr size_t W_UKV  = W_UQ + (size_t)768 * 384 * 2;
constexpr size_t W_WUP  = W_UKV + (size_t)1024 * 256 * 2;
constexpr size_t W_AUP  = W_WUP + (size_t)2 * 512 * 64 * 2;
constexpr size_t W_GUP  = W_AUP + (size_t)2 * 512 * 64 * 2;
constexpr size_t W_PA   = W_GUP + (size_t)512 * 128 * 2;
constexpr size_t W_PB   = W_PA + (size_t)1024 * 512 * 2;
constexpr size_t W_PC   = W_PB + (size_t)1024 * 512 * 2;
constexpr size_t W_OUT  = W_PC + (size_t)1024 * 512 * 2;
constexpr size_t W_GU   = W_OUT + (size_t)1024 * 1024 * 2;
constexpr size_t W_D    = W_GU + (size_t)17 * 1024 * 1024 * 2;
constexpr size_t W_END  = W_D + (size_t)17 * 1024 * 512 * 2;
constexpr size_t O_H    = O_WB + W_END;
constexpr size_t O_P    = O_H + (size_t)RT * DM * 2;
constexpr size_t O_ATT  = O_P + (size_t)RT * LDP * 2;
constexpr size_t O_RG   = O_ATT + (size_t)RT * 512 * 2;
constexpr size_t O_RWO  = O_RG + (size_t)RT * 512 * 2;
constexpr size_t O_FA   = O_RWO + (size_t)RT * 512 * 2;
constexpr size_t O_LTOK = O_FA + (size_t)RT * 512 * 2;
constexpr size_t O_LW   = O_LTOK + (size_t)NEXP * RT * 4;
constexpr size_t O_SLOT = O_LW + (size_t)NEXP * RT * 4;
constexpr size_t O_X    = al256(O_SLOT + (size_t)RT * 2 * 4);
constexpr size_t X_QA   = 0;
constexpr size_t X_KA   = X_QA + (size_t)RT * 768 * 2;
constexpr size_t X_VA   = X_KA + (size_t)4 * KEYS * 768 * 2;
constexpr int NCP = 4 * 8 * 2 * 68;
constexpr size_t X_S0   = 0;
constexpr size_t X_MT   = X_VA + (size_t)4 * 8 * 64 * KEYS * 2;
constexpr size_t X_GT   = X_MT + (size_t)NCP * 8192;
constexpr size_t X_YL   = X_GT + (size_t)NCP * 8192;
constexpr size_t X_QRAW = X_MT;
constexpr size_t X_KVRAW= X_QRAW + (size_t)RT * 768 * 2;
constexpr size_t X_KKN  = X_YL + (size_t)NCP * 8192;
constexpr size_t X_BON  = X_KKN + (size_t)RT * 8 * 4;
constexpr size_t X_END  = X_BON + (size_t)2 * RT * 8 * 4;
static_assert(X_KVRAW + (size_t)RT * 1024 * 2 <= X_YL + (size_t)NCP * 8192, "raw q/kv must fit under the chunk data");
static_assert(X_S0 + (size_t)NCP * 8192 <= X_VA, "S0 must fit in the q/k area");
constexpr size_t X_YE   = 0;
constexpr size_t WS_NEED = O_X + X_END;

__device__ __forceinline__ float bf2f(bf16_t u) { return __builtin_bit_cast(float, (unsigned)u << 16); }
__device__ __forceinline__ float bflo(unsigned u) { return __builtin_bit_cast(float, u << 16); }
__device__ __forceinline__ float bfhi(unsigned u) { return __builtin_bit_cast(float, u & 0xffff0000u); }
__device__ __forceinline__ unsigned pack2(float lo, float hi) { f32x2 v = {lo, hi}; bf16v2 b = __builtin_convertvector(v, bf16v2); return __builtin_bit_cast(unsigned, b); }
__device__ __forceinline__ bf16_t f2bf(float f) { return (bf16_t)(pack2(f, 0.f) & 0xffffu); }
__device__ __forceinline__ float wsum(float v) {
#pragma unroll
    for (int o = 32; o > 0; o >>= 1) v += __shfl_xor(v, o);
    return v;
}
__device__ __forceinline__ float sigmoidf_(float x) { return 1.f / (1.f + __expf(-x)); }
__device__ __forceinline__ float siluf_(float x) { return x / (1.f + __expf(-x)); }
__device__ __forceinline__ int modidx(int row) { return row < RL ? (row >> 12) : 4; }
__device__ __forceinline__ void unpack8(const uint4& u, float (&f)[8]) {
    f[0] = bflo(u.x); f[1] = bfhi(u.x); f[2] = bflo(u.y); f[3] = bfhi(u.y); f[4] = bflo(u.z); f[5] = bfhi(u.z); f[6] = bflo(u.w); f[7] = bfhi(u.w);
}
__device__ __forceinline__ uint4 pack8(const float (&f)[8]) { return make_uint4(pack2(f[0], f[1]), pack2(f[2], f[3]), pack2(f[4], f[5]), pack2(f[6], f[7])); }

#define XB_TMO      128
#define XB_XCNT(j)  (256  + 64 * (j))
#define XB_XSUB(j)  (1280 + 64 * (j))
#define XB_XGEN(j)  (2304 + 64 * (j))
#define XB_TOP      3328
#define XB_TOPGEN   3392
#define XCD_BAR_WORDS 3456
#define XB_SPIN_CAP (1u << 22)
#define LAS __attribute__((address_space(3)))
__device__ __forceinline__ unsigned xb_ld(unsigned* p)              { return __hip_atomic_load(p, __ATOMIC_RELAXED, __HIP_MEMORY_SCOPE_AGENT); }
__device__ __forceinline__ unsigned xb_add(unsigned* p, unsigned v) { return __hip_atomic_fetch_add(p, v, __ATOMIC_RELAXED, __HIP_MEMORY_SCOPE_AGENT); }
__device__ __forceinline__ unsigned xb_xcc_id() { return (unsigned)__builtin_amdgcn_s_getreg((3 << 11) | 20) & 0xFu; }
#define XB_SPIN(cond, bar) do { unsigned _sp = 0; while (cond) { __builtin_amdgcn_s_sleep(1); \
    if ((++_sp & 255u) == 0u) { if (xb_ld(&(bar)[XB_TMO])) break; if (_sp > XB_SPIN_CAP) { atomicAdd(&(bar)[XB_TMO], 1u); break; } } } } while (0)
struct XcdBarrier { unsigned* bar; unsigned x; volatile LAS unsigned* st; };
__device__ __forceinline__ XcdBarrier xcd_barrier_post(unsigned* bar, volatile LAS unsigned* st) {
    XcdBarrier b; b.bar = bar; b.x = xb_xcc_id(); b.st = st;
    if (threadIdx.x == 0) (void)xb_add(&bar[XB_XCNT(b.x)], 1u);
    return b;
}
__device__ __forceinline__ void xcd_barrier_complete(unsigned* bar, unsigned x, unsigned& nloc, unsigned& nx) {
    const unsigned G = gridDim.x * gridDim.y * gridDim.z;
    unsigned sum, cnt, mine, sp = 0u;
    for (;;) {
        sum = 0u; cnt = 0u; mine = 0u;
#pragma unroll
        for (unsigned j = 0; j < 16; ++j) { const unsigned c = xb_ld(&bar[XB_XCNT(j)]); sum += c; cnt += (c > 0u) ? 1u : 0u; mine = (j == x) ? c : mine; }
        if (sum == G) break;
        __builtin_amdgcn_s_sleep(1);
        if ((++sp & 255u) == 0u) { if (xb_ld(&bar[XB_TMO])) break; if (sp > XB_SPIN_CAP) { atomicAdd(&bar[XB_TMO], 1u); break; } }
    }
    nloc = mine > 0u ? mine : 1u; nx = cnt > 0u ? cnt : 1u;
}
__device__ __forceinline__ void xcd_barrier(const XcdBarrier& b) {
    asm volatile("s_waitcnt vmcnt(0)" ::: "memory");
    __syncthreads();
    if (threadIdx.x == 0) {
        unsigned* bar = b.bar;
        __builtin_amdgcn_s_waitcnt(0);
        unsigned nloc = b.st[0], nx = b.st[1];
        if (nloc == 0u) { xcd_barrier_complete(bar, b.x, nloc, nx); b.st[0] = nloc; b.st[1] = nx; }
        const unsigned old = xb_add(&bar[XB_XSUB(b.x)], 1u);
        const unsigned gen = old / nloc;
        if (old + 1u == (gen + 1u) * nloc) {
            __builtin_amdgcn_fence(__ATOMIC_RELEASE, "agent");
            asm volatile("s_waitcnt vmcnt(0)" ::: "memory");
            const unsigned og = xb_add(&bar[XB_TOP], 1u);
            const unsigned tg = og / nx;
            if (og + 1u == (tg + 1u) * nx) xb_add(&bar[XB_TOPGEN], 1u);
            else XB_SPIN(xb_ld(&bar[XB_TOPGEN]) == tg, bar);
            __builtin_amdgcn_fence(__ATOMIC_ACQUIRE, "agent");
            xb_add(&bar[XB_XGEN(b.x)], 1u);
            asm volatile("s_waitcnt vmcnt(0)" ::: "memory");
        } else {
            XB_SPIN(xb_ld(&bar[XB_XGEN(b.x)]) == gen, bar);
            __builtin_amdgcn_fence(__ATOMIC_ACQUIRE, "agent");
            asm volatile("s_waitcnt vmcnt(0)" ::: "memory");
        }
    }
    __syncthreads();
}

__device__ __forceinline__ int tidx() { int t = threadIdx.x; asm volatile("" : "+v"(t)); return t; }
__device__ __forceinline__ int lv(int x) { asm volatile("" : "+v"(x)); return x; }
__device__ __forceinline__ char* launder(char* p) { size_t z = 0; asm volatile("" : "+s"(z)); return p + z; }

constexpr int LDSROW = 72;
template <int NA, class AL>
__device__ __forceinline__ void gc_load(const AL& al, const bf16_t* bp, size_t bstep, int k0, int kc, u32x4 (&ra)[NA], u32x4 (&rb)[4]) {
#pragma unroll
    for (int i = 0; i < NA; ++i) ra[i] = __builtin_bit_cast(u32x4, al.load(i, k0 + kc));
#pragma unroll
    for (int j = 0; j < 4; ++j) rb[j] = *(const u32x4*)(bp + j * bstep + k0);
}
template <int NA>
__device__ __forceinline__ void gc_store(bf16_t* Ab, bf16_t* Bb, int lr, int kc, const u32x4 (&ra)[NA], const u32x4 (&rb)[4]) {
#pragma unroll
    for (int i = 0; i < NA; ++i) *(u32x4*)(Ab + (lr + 32 * i) * LDSROW + kc) = ra[i];
#pragma unroll
    for (int j = 0; j < 4; ++j) *(u32x4*)(Bb + (lr + 32 * j) * LDSROW + kc) = rb[j];
}
template <int MI>
__device__ __forceinline__ void gc_compute(const bf16_t* Ac, const bf16_t* Bc, f32x4 (&acc)[MI][4]) {
#pragma unroll
    for (int kh = 0; kh < 2; ++kh) {
        bf16x8 af[MI], bfv[4];
#pragma unroll
        for (int i = 0; i < MI; ++i) af[i] = *(const bf16x8*)(Ac + i * 16 * LDSROW + kh * 32);
#pragma unroll
        for (int j = 0; j < 4; ++j) bfv[j] = *(const bf16x8*)(Bc + j * 16 * LDSROW + kh * 32);
#pragma unroll
        for (int i = 0; i < MI; ++i)
#pragma unroll
            for (int j = 0; j < 4; ++j) acc[i][j] = __builtin_amdgcn_mfma_f32_16x16x32_bf16(bfv[j], af[i], acc[i][j], 0, 0, 0);
    }
}
template <int MI, class AL>
__device__ __forceinline__ void gemm_core(const AL& al, const bf16_t* __restrict__ Bt, int ldb, int K, f32x4 (&acc)[MI][4], char* smem) {
    constexpr int TM = MI * 32;
    constexpr int NA = TM / 32;
    bf16_t* As = (bf16_t*)smem;
    bf16_t* Bs = As + 2 * TM * LDSROW;
    const int tid = tidx(), lane = tid & 63, wave = tid >> 6;
    const int wr = wave >> 1, wc = wave & 1, fr = lane & 15, fq = lane >> 4;
    const int kc = (tid & 7) * 8, lr = tid >> 3;
#pragma unroll
    for (int i = 0; i < MI; ++i)
#pragma unroll
        for (int j = 0; j < 4; ++j) acc[i][j] = (f32x4){0.f, 0.f, 0.f, 0.f};
    u32x4 a0[NA], b0[4], a1[NA], b1[4];
    const bf16_t* bp = Bt + (size_t)lr * ldb + kc;
    const size_t bstep = (size_t)32 * ldb;
    const int nk = K >> 6;
    bf16_t* As1 = As + TM * LDSROW; bf16_t* Bs1 = Bs + 128 * LDSROW;
    const int aoff = (wr * MI * 16 + fr) * LDSROW + fq * 8, boff = (wc * 64 + fr) * LDSROW + fq * 8;
    gc_load<NA>(al, bp, bstep, 0, kc, a0, b0);
    gc_store<NA>(As, Bs, lr, kc, a0, b0);
    if (nk > 1) gc_load<NA>(al, bp, bstep, 64, kc, a0, b0);
    __syncthreads();
    for (int kt = 0; kt < nk; kt += 2) {
        if (kt + 2 < nk) gc_load<NA>(al, bp, bstep, (kt + 2) << 6, kc, a1, b1);
        gc_compute<MI>(As + aoff, Bs + boff, acc);
        if (kt + 1 < nk) gc_store<NA>(As1, Bs1, lr, kc, a0, b0);
        __syncthreads();
        if (kt + 1 >= nk) break;
        if (kt + 3 < nk) gc_load<NA>(al, bp, bstep, (kt + 3) << 6, kc, a0, b0);
        gc_compute<MI>(As1 + aoff, Bs1 + boff, acc);
        if (kt + 2 < nk) gc_store<NA>(As, Bs, lr, kc, a1, b1);
        __syncthreads();
    }
}
template <int MI, class RP, class RPB>
__device__ __forceinline__ void gemm_core_gb(const RP& rp, const RPB& rpb, int K, f32x4 (&acc)[MI][4], char* smem) {
    constexpr int ABYTES = MI * 32 * 128;
    constexpr int SBYTES = ABYTES + 16384;
    const int tid = tidx(), lane = tid & 63, wave = tid >> 6;
    const int wr = wave >> 1, wc = wave & 1, fr = lane & 15, fq = lane >> 4;
    const int rr = lane >> 3, cs = ((lane & 7) ^ ((wave * 4 + (lane >> 4)) & 7)) * 8;
#pragma unroll
    for (int i = 0; i < MI; ++i)
#pragma unroll
        for (int j = 0; j < 4; ++j) acc[i][j] = (f32x4){0.f, 0.f, 0.f, 0.f};
    const bf16_t* ap[MI]; const bf16_t* bp[4];
#pragma unroll
    for (int i = 0; i < MI; ++i) { const int r = (i * 4 + wave) * 8 + rr; ap[i] = rp(r) + cs; }
#pragma unroll
    for (int i = 0; i < 4; ++i) { const int r = (i * 4 + wave) * 8 + rr; bp[i] = rpb(r) + cs; }
    const int wbase = __builtin_amdgcn_readfirstlane(wave) * 1024;
    const int nk = K >> 6;
    auto stage = [&](int buf, int kt) {
        char* Ab = smem + buf * SBYTES + wbase; char* Bb = Ab + ABYTES;
#pragma unroll
        for (int i = 0; i < MI; ++i) __builtin_amdgcn_global_load_lds((const unsigned*)(ap[i] + kt * 64), (unsigned*)(Ab + i * 4096), 16, 0, 0);
#pragma unroll
        for (int i = 0; i < 4; ++i) __builtin_amdgcn_global_load_lds((const unsigned*)(bp[i] + kt * 64), (unsigned*)(Bb + i * 4096), 16, 0, 0);
    };
    const int aoff = (wr * MI * 16 + fr) * 128, boff = ABYTES + (wc * 64 + fr) * 128, sw = fr >> 1;
    stage(0, 0);
    asm volatile("s_waitcnt vmcnt(0)" ::: "memory");
    __syncthreads();
    for (int kt = 0; kt < nk; ++kt) {
        const int cur = kt & 1;
        if (kt + 1 < nk) stage(cur ^ 1, kt + 1);
        const char* base = smem + cur * SBYTES;
#pragma unroll
        for (int kh = 0; kh < 2; ++kh) {
            const int xo = ((kh * 4 + fq) ^ sw) * 16;
            bf16x8 af[MI], bfv[4];
#pragma unroll
            for (int i = 0; i < MI; ++i) af[i] = *(const bf16x8*)(base + aoff + i * 2048 + xo);
#pragma unroll
            for (int j = 0; j < 4; ++j) bfv[j] = *(const bf16x8*)(base + boff + j * 2048 + xo);
#pragma unroll
            for (int i = 0; i < MI; ++i)
#pragma unroll
                for (int j = 0; j < 4; ++j) acc[i][j] = __builtin_amdgcn_mfma_f32_16x16x32_bf16(bfv[j], af[i], acc[i][j], 0, 0, 0);
        }
        asm volatile("s_waitcnt vmcnt(0)" ::: "memory");
        __syncthreads();
    }
}
template <int MI, class RP, class RPB>
__device__ __forceinline__ void gemm_core_p(const RP& rp, const RPB& rpb, int K, f32x4 (&acc)[MI][4], char* smem) {
    constexpr int NAI = MI / 2;
    constexpr int BOFF = 8192;
    const int tid = tidx(), lane = tid & 63, wave = tid >> 6;
    const int wr = wave >> 1, wc = wave & 1, fr = lane & 15, fq = lane >> 4;
    const int cs = ((lane & 3) ^ ((lane >> 4) & 3)) * 8;
#pragma unroll
    for (int i = 0; i < MI; ++i)
#pragma unroll
        for (int j = 0; j < 4; ++j) acc[i][j] = (f32x4){0.f, 0.f, 0.f, 0.f};
    const bf16_t* ap[NAI]; const bf16_t* bp[2];
#pragma unroll
    for (int i = 0; i < NAI; ++i) ap[i] = rp((wave * NAI + i) * 16 + (lane >> 2)) + cs;
#pragma unroll
    for (int i = 0; i < 2; ++i) bp[i] = rpb((wave * 2 + i) * 16 + (lane >> 2)) + cs;
    const int wA = __builtin_amdgcn_readfirstlane(wave) * (NAI * 1024), wB = BOFF + __builtin_amdgcn_readfirstlane(wave) * 2048;
    const unsigned lds0 = (unsigned)(uintptr_t)smem;
    const unsigned sw = (unsigned)((fq ^ ((fr >> 2) & 3)) * 16);
    const unsigned abase = lds0 + (unsigned)((wr * MI * 16 + fr) * 64) + sw, bbase = lds0 + BOFF + (unsigned)((wc * 64 + fr) * 64) + sw;
    const int nk = K >> 5;
#define GP_ISSUE(KT, SLOT) do { char* d_ = smem + (SLOT) * 16384; \
        _Pragma("unroll") for (int i = 0; i < NAI; ++i) __builtin_amdgcn_global_load_lds((const unsigned*)(ap[i] + (KT) * 32), (unsigned*)(d_ + wA + i * 1024), 16, 0, 0); \
        _Pragma("unroll") for (int i = 0; i < 2; ++i) __builtin_amdgcn_global_load_lds((const unsigned*)(bp[i] + (KT) * 32), (unsigned*)(d_ + wB + i * 1024), 16, 0, 0); } while (0)
#define GP_RD(DST, ADDR, OFF) asm volatile("ds_read_b128 %0, %1 offset:%2" : "=v"(DST) : "v"(ADDR), "n"(OFF))
#define GP_READ(FA_, FB_, SLOT) do { \
        GP_RD(FA_[0], abase, (SLOT) * 16384 + 0 * 1024); GP_RD(FA_[1], abase, (SLOT) * 16384 + 1 * 1024); \
        if (MI == 4) { GP_RD(FA_[MI - 2], abase, (SLOT) * 16384 + 2 * 1024); GP_RD(FA_[MI - 1], abase, (SLOT) * 16384 + 3 * 1024); } \
        GP_RD(FB_[0], bbase, (SLOT) * 16384 + 0 * 1024); GP_RD(FB_[1], bbase, (SLOT) * 16384 + 1 * 1024); \
        GP_RD(FB_[2], bbase, (SLOT) * 16384 + 2 * 1024); GP_RD(FB_[3], bbase, (SLOT) * 16384 + 3 * 1024); } while (0)
#define GP_MMA(FA_, FB_) do { \
        _Pragma("unroll") for (int i = 0; i < MI; ++i) \
            _Pragma("unroll") for (int j = 0; j < 4; ++j) acc[i][j] = __builtin_amdgcn_mfma_f32_16x16x32_bf16(__builtin_bit_cast(bf16x8, FB_[j]), __builtin_bit_cast(bf16x8, FA_[i]), acc[i][j], 0, 0, 0); } while (0)
#define GP_STEP(KT, FA_, FB_, FAN, FBN, SLOTN, SLOTI) do { \
        if ((KT) + 1 < nk) { \
            if ((KT) + 2 < nk) asm volatile("s_waitcnt vmcnt(%0)" :: "n"(NAI + 2) : "memory"); else asm volatile("s_waitcnt vmcnt(0)" ::: "memory"); \
            __builtin_amdgcn_s_barrier(); \
            asm volatile("" ::: "memory"); \
            if ((KT) + 3 < nk) GP_ISSUE((KT) + 3, SLOTI); \
            GP_READ(FAN, FBN, SLOTN); \
            asm volatile("s_waitcnt lgkmcnt(%0)" :: "n"(MI + 4) : "memory"); \
        } else asm volatile("s_waitcnt lgkmcnt(0)" ::: "memory"); \
        __builtin_amdgcn_sched_barrier(0); \
        GP_MMA(FA_, FB_); \
        __builtin_amdgcn_sched_barrier(0); } while (0)
    u32x4 fa0[MI], fb0[4], fa1[MI], fb1[4];
    GP_ISSUE(0, 0); GP_ISSUE(1, 1); GP_ISSUE(2, 2);
    asm volatile("s_waitcnt vmcnt(%0)" :: "n"(2 * (NAI + 2)) : "memory");
    __builtin_amdgcn_s_barrier();
    asm volatile("" ::: "memory");
    GP_READ(fa0, fb0, 0);
    for (int kt = 0; kt < nk; kt += 4) {
        GP_STEP(kt,     fa0, fb0, fa1, fb1, 1, 3);
        GP_STEP(kt + 1, fa1, fb1, fa0, fb0, 2, 0);
        GP_STEP(kt + 2, fa0, fb0, fa1, fb1, 3, 1);
        GP_STEP(kt + 3, fa1, fb1, fa0, fb0, 0, 2);
    }
#undef GP_ISSUE
#undef GP_RD
#undef GP_READ
#undef GP_MMA
#undef GP_STEP
    __syncthreads();
}
template <class RP, class RPB>
__device__ __forceinline__ void gemm_core_w(const RP& rp, const RPB& rpb, int K, f32x4 (&acc)[8][4], char* smem) {
    constexpr int SLOTB = 24576, BOFF = 16384;
    const int tid = tidx(), lane = tid & 63, wave = tid >> 6;
    const int wr = wave >> 1, wc = wave & 1, fr = lane & 15, fq = lane >> 4;
    const int cs = ((lane & 3) ^ ((lane >> 4) & 3)) * 8;
#pragma unroll
    for (int i = 0; i < 8; ++i)
#pragma unroll
        for (int j = 0; j < 4; ++j) acc[i][j] = (f32x4){0.f, 0.f, 0.f, 0.f};
    const bf16_t* ap[4]; const bf16_t* bp[2];
#pragma unroll
    for (int i = 0; i < 4; ++i) ap[i] = rp((wave * 4 + i) * 16 + (lane >> 2)) + cs;
#pragma unroll
    for (int i = 0; i < 2; ++i) bp[i] = rpb((wave * 2 + i) * 16 + (lane >> 2)) + cs;
    const int wA = __builtin_amdgcn_readfirstlane(wave) * 4096, wB = BOFF + __builtin_amdgcn_readfirstlane(wave) * 2048;
    const unsigned lds0 = (unsigned)(uintptr_t)smem;
    const unsigned sw = (unsigned)((fq ^ ((fr >> 2) & 3)) * 16);
    const unsigned abase = lds0 + (unsigned)((wr * 128 + fr) * 64) + sw, bbase = lds0 + BOFF + (unsigned)((wc * 64 + fr) * 64) + sw;
    const int nk = K >> 5;
    auto issue = [&](int kt, int slot) {
        char* d = smem + slot * SLOTB;
#pragma unroll
        for (int i = 0; i < 4; ++i) __builtin_amdgcn_global_load_lds((const unsigned*)(ap[i] + kt * 32), (unsigned*)(d + wA + i * 1024), 16, 0, 0);
#pragma unroll
        for (int i = 0; i < 2; ++i) __builtin_amdgcn_global_load_lds((const unsigned*)(bp[i] + kt * 32), (unsigned*)(d + wB + i * 1024), 16, 0, 0);
    };
    issue(0, 0);
    if (nk > 1) issue(1, 1);
    int slot = 0;
    for (int kt = 0; kt < nk; ++kt) {
        if (kt + 1 < nk) asm volatile("s_waitcnt vmcnt(6)" ::: "memory"); else asm volatile("s_waitcnt vmcnt(0)" ::: "memory");
        __builtin_amdgcn_s_barrier();
        asm volatile("" ::: "memory");
        if (kt + 2 < nk) issue(kt + 2, slot >= 1 ? slot - 1 : 2);
        const unsigned aa = abase + (unsigned)(slot * SLOTB), bb = bbase + (unsigned)(slot * SLOTB);
        u32x4 fa[8], fb[4];
#define GW_RD(DST, ADDR, OFF) asm volatile("ds_read_b128 %0, %1 offset:%2" : "=v"(DST) : "v"(ADDR), "n"(OFF))
        GW_RD(fa[0], aa, 0); GW_RD(fa[1], aa, 1024); GW_RD(fa[2], aa, 2048); GW_RD(fa[3], aa, 3072);
        GW_RD(fa[4], aa, 4096); GW_RD(fa[5], aa, 5120); GW_RD(fa[6], aa, 6144); GW_RD(fa[7], aa, 7168);
        GW_RD(fb[0], bb, 0); GW_RD(fb[1], bb, 1024); GW_RD(fb[2], bb, 2048); GW_RD(fb[3], bb, 3072);
#undef GW_RD
        asm volatile("s_waitcnt lgkmcnt(0)" ::: "memory");
        __builtin_amdgcn_sched_barrier(0);
#pragma unroll
        for (int i = 0; i < 8; ++i)
#pragma unroll
            for (int j = 0; j < 4; ++j) acc[i][j] = __builtin_amdgcn_mfma_f32_16x16x32_bf16(__builtin_bit_cast(bf16x8, fb[j]), __builtin_bit_cast(bf16x8, fa[i]), acc[i][j], 0, 0, 0);
        __builtin_amdgcn_sched_barrier(0);
        slot = slot == 2 ? 0 : slot + 1;
    }
    __syncthreads();
}
struct RPPlain;
template <int MI, class RP>
__device__ __forceinline__ void gemm_core_g(const RP& rp, const bf16_t* __restrict__ Bt, int ldb, int K, f32x4 (&acc)[MI][4], char* smem);
struct RPPlain {
    const bf16_t* A; size_t lda;
    __device__ __forceinline__ const bf16_t* operator()(int r) const { return A + (size_t)r * lda; }
};
template <int MI, class RP>
__device__ __forceinline__ void gemm_core_g(const RP& rp, const bf16_t* __restrict__ Bt, int ldb, int K, f32x4 (&acc)[MI][4], char* smem) {
    RPPlain rpb{Bt, (size_t)ldb};
    gemm_core_gb<MI>(rp, rpb, K, acc, smem);
}
template <int MI, class F>
__device__ __forceinline__ void acc_foreach(const f32x4 (&acc)[MI][4], F f) {
    const int lane = tidx() & 63, wave = tidx() >> 6;
    const int wr = wave >> 1, wc = wave & 1, fr = lane & 15, fq = lane >> 4;
#pragma unroll
    for (int i = 0; i < MI; ++i)
#pragma unroll
        for (int j = 0; j < 4; ++j) f(wr * MI * 16 + i * 16 + fr, wc * 64 + j * 16 + fq * 4, acc[i][j]);
}
struct ALPlain {
    const bf16_t* p0; size_t step;
    __device__ __forceinline__ ALPlain(const bf16_t* A, int lda, int row0) { p0 = A + (size_t)(row0 + (tidx() >> 3)) * lda; step = (size_t)32 * lda; }
    __device__ __forceinline__ uint4 load(int i, int k) const { return *(const uint4*)(p0 + i * step + k); }
};
__device__ __forceinline__ void store_bf16x4(bf16_t* dst, const f32x4& v) { *(uint2*)dst = make_uint2(pack2(v[0], v[1]), pack2(v[2], v[3])); }

__device__ __forceinline__ void ph_pre(const Params& p, char* smem) {
    const int tid = tidx(), nb = gridDim.x, bid = blockIdx.x;
    float* mod = (float*)(p.ws + O_MOD);
    {
        float* sv = (float*)smem;
        float* part = sv + 5 * 1024;
        for (int i = tid; i < 5 * 1024; i += 256) { const float v = (i < 4096) ? p.in[I_C][i] : p.in[I_CCTX][i - 4096]; sv[i] = siluf_(v); }
        __syncthreads();
        for (int it = bid; it < NLAYER * 96; it += nb) {
            const int l = it / 96, jb = it % 96;
            const int jj = tid & 63, kq = tid >> 6, j = jb * 64 + jj;
            const float* w = p.in[I_WADA] + (size_t)l * 1024 * 6144 + (size_t)(kq * 256) * 6144 + j;
            float a0 = 0.f, a1 = 0.f, a2 = 0.f, a3 = 0.f, a4 = 0.f;
#pragma unroll 8
            for (int k = 0; k < 256; ++k) {
                const float wv = w[(size_t)k * 6144]; const int kk = kq * 256 + k;
                a0 += sv[kk] * wv; a1 += sv[1024 + kk] * wv; a2 += sv[2048 + kk] * wv; a3 += sv[3072 + kk] * wv; a4 += sv[4096 + kk] * wv;
            }
            part[(kq * 5 + 0) * 64 + jj] = a0; part[(kq * 5 + 1) * 64 + jj] = a1; part[(kq * 5 + 2) * 64 + jj] = a2;
            part[(kq * 5 + 3) * 64 + jj] = a3; part[(kq * 5 + 4) * 64 + jj] = a4;
            __syncthreads();
            for (int o = tid; o < 320; o += 256) {
                const int i = o >> 6, c = o & 63;
                const float s = part[(0 * 5 + i) * 64 + c] + part[(1 * 5 + i) * 64 + c] + part[(2 * 5 + i) * 64 + c] + part[(3 * 5 + i) * 64 + c];
                mod[(size_t)(l * 5 + i) * 6144 + jb * 64 + c] = s + p.in[I_BADA][l * 6144 + jb * 64 + c];
            }
            __syncthreads();
        }
    }
    {
        float4* xc = (float4*)(p.ws + O_XCUR);
        const float4* x4 = (const float4*)p.in[I_X]; const float4* c4 = (const float4*)p.in[I_CTX];
        for (size_t i = (size_t)bid * 256 + tid; i < (size_t)RT * 256; i += (size_t)nb * 256) xc[i] = (i < (size_t)RL * 256) ? x4[i] : c4[i - (size_t)RL * 256];
    }
    {
        float* ct = (float*)smem;
        __syncthreads();
        for (int m = tid; m < 4096; m += 256) ct[m] = cospif((float)m * (1.f / 2048.f));
        __syncthreads();
        bf16_t* cst2 = (bf16_t*)(p.ws + O_CST256);
        for (int ch = bid * 256 + tid; ch < 256 * 512 / 8; ch += nb * 256) {
            const int ks = ch >> 6, c0 = (ch & 63) * 8, part = c0 >> 8, s0 = c0 & 255;
            float f[8];
#pragma unroll
            for (int e = 0; e < 8; ++e) { const int m = (16 * ks * (s0 + e)) & 4095; f[e] = part == 0 ? ct[m] : ct[(m - 1024) & 4095]; }
            *(uint4*)(cst2 + ch * 8) = pack8(f);
        }
        bf16_t* d128 = (bf16_t*)(p.ws + O_D128);
        for (int ch = bid * 256 + tid; ch < 128 * 128 / 8; ch += nb * 256) {
            const int mrow = ch >> 4, c0 = (ch & 15) * 8, po = mrow >> 6, k1 = mrow & 63, pi = c0 >> 6, t10 = c0 & 63;
            float f[8];
#pragma unroll
            for (int e = 0; e < 8; ++e) {
                const int m = (64 * k1 * (t10 + e)) & 4095; const float cv = ct[m], sv = ct[(m - 1024) & 4095];
                f[e] = (po == pi) ? cv : (po == 0 ? sv : -sv);
            }
            *(uint4*)(d128 + ch * 8) = pack8(f);
        }
        bf16_t* e64 = (bf16_t*)(p.ws + O_E64);
        for (int ch = bid * 256 + tid; ch < 64 * 128 / 8; ch += nb * 256) {
            const int k2 = ch >> 4, c0 = (ch & 15) * 8, po = c0 >> 6, t20 = c0 & 63;
            float f[8];
#pragma unroll
            for (int e = 0; e < 8; ++e) { const int m = (64 * k2 * (t20 + e)) & 4095; f[e] = po == 0 ? ct[m] : ct[(m - 1024) & 4095]; }
            *(uint4*)(e64 + ch * 8) = pack8(f);
        }
        float* twc = (float*)(p.ws + O_TWC); float* tws = (float*)(p.ws + O_TWS);
        for (int i = bid * 256 + tid; i < 64 * 64; i += nb * 256) {
            const int k1 = i >> 6, t2 = i & 63, m = (k1 * t2) & 4095;
            twc[i] = ct[m]; tws[i] = -ct[(m - 1024) & 4095];
        }
        bf16_t* csc = (bf16_t*)(p.ws + O_CSC);
        for (int ch = bid * 256 + tid; ch < 256 * 128 / 8; ch += nb * 256) {
            const int n = ch >> 4, c0 = (ch & 15) * 8, part = n >> 7, kc = n & 127;
            float f[8];
#pragma unroll
            for (int e = 0; e < 8; ++e) { const int m = (32 * kc * (c0 + e)) & 4095; f[e] = part == 0 ? ct[m] : -ct[(m - 1024) & 4095]; }
            *(uint4*)(csc + ch * 8) = pack8(f);
        }
        float* rc = (float*)(p.ws + O_ROPEC); float* rs = (float*)(p.ws + O_ROPES);
        for (int i = bid * 256 + tid; i < SEQ * 16; i += nb * 256) {
            const int t = i >> 4, ax = (i >> 3) & 1, f = i & 7;
            const float inv = powf(10000.f, -(float)f / 8.f);
            const float pos = (float)(ax == 0 ? (t >> 6) : (t & 63));
            const float ang = pos * inv;
            rc[i] = cosf(ang); rs[i] = sinf(ang);
        }
    }
}

struct ConvTask { const float* src; const float* scale; bf16_t* dst; int K, Nsrc, Ndst, rmul; size_t sbs, dbs; };
__constant__ int c_conv_cum[17] = {0, 1536, 1608, 1672, 1688, 1704, 1720, 1848, 1976, 2104, 2360, 4408, 6456, 8504, 8632, 8760, 8888};
__device__ __forceinline__ ConvTask conv_task(const Params& p, int l, int t) {
    bf16_t* wb = (bf16_t*)(p.ws + O_WB);
    ConvTask c; c.scale = nullptr; c.sbs = 0; c.dbs = 0; c.rmul = 64;
    switch (t) {
    case 0:  c.src = p.in[I_WIN] + (size_t)l * 1024 * 6048; c.K = 1024; c.Nsrc = 6048; c.Ndst = 6144; c.dst = wb + W_IN / 2; break;
    case 1:  c.src = p.in[I_WUQ] + (size_t)l * 384 * 768; c.K = 384; c.Nsrc = 768; c.Ndst = 768; c.dst = wb + W_UQ / 2; c.scale = p.in[I_QNG] + l * 384; break;
    case 2:  c.src = p.in[I_WUKV] + (size_t)l * 256 * 1024; c.K = 256; c.Nsrc = 1024; c.Ndst = 1024; c.dst = wb + W_UKV / 2; c.scale = p.in[I_KVNG] + l * 256; break;
    case 3:  c.src = p.in[I_WUP] + (size_t)l * 2 * 64 * 512; c.K = 64; c.Nsrc = 512; c.Ndst = 512; c.dst = wb + W_WUP / 2; c.sbs = 64 * 512; c.dbs = 512 * 64; break;
    case 4:  c.src = p.in[I_AUP] + (size_t)l * 2 * 64 * 512; c.K = 64; c.Nsrc = 512; c.Ndst = 512; c.dst = wb + W_AUP / 2; c.sbs = 64 * 512; c.dbs = 512 * 64; break;
    case 5:  c.src = p.in[I_GUP] + (size_t)l * 128 * 512; c.K = 128; c.Nsrc = 512; c.Ndst = 512; c.dst = wb + W_GUP / 2; break;
    case 6:  c.src = p.in[I_WPA] + (size_t)l * 512 * 1024; c.K = 512; c.Nsrc = 1024; c.Ndst = 1024; c.dst = wb + W_PA / 2; break;
    case 7:  c.src = p.in[I_WPB] + (size_t)l * 512 * 1024; c.K = 512; c.Nsrc = 1024; c.Ndst = 1024; c.dst = wb + W_PB / 2; break;
    case 8:  c.src = p.in[I_WPC] + (size_t)l * 512 * 1024; c.K = 512; c.Nsrc = 1024; c.Ndst = 1024; c.dst = wb + W_PC / 2; break;
    case 9:  c.src = p.in[I_WOUT] + (size_t)l * 1024 * 1024; c.K = 1024; c.Nsrc = 1024; c.Ndst = 1024; c.dst = wb + W_OUT / 2; break;
    case 10: c.src = p.in[I_EG] + (size_t)l * 16 * 1024 * 512; c.K = 1024; c.Nsrc = 512; c.Ndst = 512; c.dst = wb + W_GU / 2; c.sbs = 1024 * 512; c.dbs = 1024 * 1024; c.rmul = 128; break;
    case 11: c.src = p.in[I_EU] + (size_t)l * 16 * 1024 * 512; c.K = 1024; c.Nsrc = 512; c.Ndst = 512; c.dst = wb + W_GU / 2 + 64 * 1024; c.sbs = 1024 * 512; c.dbs = 1024 * 1024; c.rmul = 128; break;
    case 12: c.src = p.in[I_ED] + (size_t)l * 16 * 512 * 1024; c.K = 512; c.Nsrc = 1024; c.Ndst = 1024; c.dst = wb + W_D / 2; c.sbs = 512 * 1024; c.dbs = 1024 * 512; break;
    case 13: c.src = p.in[I_SG] + (size_t)l * 1024 * 512; c.K = 1024; c.Nsrc = 512; c.Ndst = 512; c.dst = wb + W_GU / 2 + (size_t)16 * 1024 * 1024; c.rmul = 128; break;
    case 14: c.src = p.in[I_SU] + (size_t)l * 1024 * 512; c.K = 1024; c.Nsrc = 512; c.Ndst = 512; c.dst = wb + W_GU / 2 + (size_t)16 * 1024 * 1024 + 64 * 1024; c.rmul = 128; break;
    default: c.src = p.in[I_SD] + (size_t)l * 512 * 1024; c.K = 512; c.Nsrc = 1024; c.Ndst = 1024; c.dst = wb + W_D / 2 + (size_t)16 * 1024 * 512; break;
    }
    return c;
}
__device__ __forceinline__ void ph_w(const Params& p, int l, char* smem) {
    const int tid = tidx();
    float* tl = (float*)smem;
    for (int g = blockIdx.x; g < 8888; g += gridDim.x) {
        int t = 0;
        while (g >= c_conv_cum[t + 1]) ++t;
        const ConvTask c = conv_task(p, l, t);
        int r = g - c_conv_cum[t];
        const int nkt = c.K >> 6, nnt = c.Ndst >> 6;
        const int bi = r / (nkt * nnt); r -= bi * nkt * nnt;
        const int k0 = (r / nnt) * 64, n0 = (r % nnt) * 64;
        const float* src = c.src + bi * c.sbs; bf16_t* dst = c.dst + bi * c.dbs;
#pragma unroll
        for (int i = 0; i < 4; ++i) {
            const int k = (tid >> 4) + 16 * i, n = n0 + (tid & 15) * 4;
            float4 v = make_float4(0.f, 0.f, 0.f, 0.f);
            if (n < c.Nsrc) v = *(const float4*)(src + (size_t)(k0 + k) * c.Nsrc + n);
            if (c.scale) { const float s = c.scale[k0 + k]; v.x *= s; v.y *= s; v.z *= s; v.w *= s; }
            float* d = tl + k * 65 + (tid & 15) * 4;
            d[0] = v.x; d[1] = v.y; d[2] = v.z; d[3] = v.w;
        }
        __syncthreads();
        {
            const int n = tid >> 2, kk0 = (tid & 3) * 16;
            float f[8], g2[8];
#pragma unroll
            for (int j = 0; j < 8; ++j) { f[j] = tl[(kk0 + j) * 65 + n]; g2[j] = tl[(kk0 + 8 + j) * 65 + n]; }
            bf16_t* d = dst + (size_t)((n0 >> 6) * c.rmul + n) * c.K + k0 + kk0;
            *(uint4*)d = pack8(f); *(uint4*)(d + 8) = pack8(g2);
        }
        __syncthreads();
    }
}

__device__ __forceinline__ void ph_n1(const Params& p, int l) {
    const int lane = tidx() & 63, wave = tidx() >> 6;
    const float* xcur = (const float*)(p.ws + O_XCUR); const float* mod = (const float*)(p.ws + O_MOD);
    bf16_t* H = (bf16_t*)(p.ws + O_H);
    const float* g = p.in[I_N1G] + l * 1024;
    for (int row = blockIdx.x * 4 + wave; row < RT; row += gridDim.x * 4) {
        const float* x = xcur + (size_t)row * 1024; const float* md = mod + (size_t)(l * 5 + modidx(row)) * 6144;
        float4 v[4]; float ss = 0.f;
#pragma unroll
        for (int i = 0; i < 4; ++i) { v[i] = *(const float4*)(x + lane * 4 + 256 * i); ss += v[i].x * v[i].x + v[i].y * v[i].y + v[i].z * v[i].z + v[i].w * v[i].w; }
        ss = wsum(ss);
        const float rstd = rsqrtf(ss * (1.f / 1024.f) + 1e-6f);
#pragma unroll
        for (int i = 0; i < 4; ++i) {
            const int c = lane * 4 + 256 * i;
            const float4 gg = *(const float4*)(g + c), sc = *(const float4*)(md + 1024 + c), sh = *(const float4*)(md + c);
            f32x4 h = {v[i].x * rstd * gg.x * (1.f + sc.x) + sh.x, v[i].y * rstd * gg.y * (1.f + sc.y) + sh.y,
                       v[i].z * rstd * gg.z * (1.f + sc.z) + sh.z, v[i].w * rstd * gg.w * (1.f + sc.w) + sh.w};
            store_bf16x4(H + (size_t)row * 1024 + c, h);
        }
    }
}

__device__ __forceinline__ void ph_g1(const Params& p, char* smem) {
    if (blockIdx.x == 0 && tidx() < 64) ((unsigned*)(p.ws + O_CNT))[tidx()] = 0u;
    const bf16_t* H = (const bf16_t*)(p.ws + O_H); const bf16_t* W = (const bf16_t*)(p.ws + O_WB + W_IN);
    bf16_t* P = (bf16_t*)(p.ws + O_P);
    for (int it = blockIdx.x; it < 136 * 48; it += gridDim.x) {
        const int mt = it / 48, nt = it % 48;
        f32x4 acc[4][4];
        RPPlain rp{H + (size_t)mt * 128 * 1024, 1024};
        gemm_core_g<4>(rp, W + (size_t)nt * 128 * 1024, 1024, 1024, acc, smem);
        acc_foreach<4>(acc, [&](int m, int n, const f32x4& v) {
            const int col = nt * 128 + n; f32x4 o = v;
            if (col >= PG0 && col < PEND) { o[0] = sigmoidf_(v[0]); o[1] = sigmoidf_(v[1]); o[2] = sigmoidf_(v[2]); o[3] = sigmoidf_(v[3]); }
            store_bf16x4(P + (size_t)(mt * 128 + m) * LDP + col, o);
        });
    }
}

__device__ __forceinline__ void ph_qu(const Params& p, char* smem) {
    const bf16_t* P = (const bf16_t*)(p.ws + O_P);
    bf16_t* QR = (bf16_t*)(p.ws + O_X + X_QRAW); bf16_t* KVR = (bf16_t*)(p.ws + O_X + X_KVRAW);
    for (int it = blockIdx.x; it < 136 * 14; it += gridDim.x) {
        const int mt = it / 14, nn = it % 14;
        f32x4 acc[4][4];
        if (nn < 6) {
            RPPlain rp{P + (size_t)mt * 128 * LDP + PQ0, LDP};
            gemm_core_g<4>(rp, (const bf16_t*)(p.ws + O_WB + W_UQ) + (size_t)nn * 128 * 384, 384, 384, acc, smem);
            acc_foreach<4>(acc, [&](int m, int n, const f32x4& v) { store_bf16x4(QR + (size_t)(mt * 128 + m) * 768 + nn * 128 + n, v); });
        } else {
            const int nt = nn - 6;
            RPPlain rp{P + (size_t)mt * 128 * LDP + PKV0, LDP};
            gemm_core_g<4>(rp, (const bf16_t*)(p.ws + O_WB + W_UKV) + (size_t)nt * 128 * 256, 256, 256, acc, smem);
            acc_foreach<4>(acc, [&](int m, int n, const f32x4& v) { store_bf16x4(KVR + (size_t)(mt * 128 + m) * 1024 + nt * 128 + n, v); });
        }
    }
}

constexpr float QSCALE = 0.10206207261596575f * 1.4426950408889634f;
__device__ __forceinline__ void ph_m2(const Params& p, char* smem) {
    const int tid = tidx(), lane = tid & 63, wave = tid >> 6;
    const bf16_t* P = (const bf16_t*)(p.ws + O_P);
    const bf16_t* QR = (const bf16_t*)(p.ws + O_X + X_QRAW); const bf16_t* KVR = (const bf16_t*)(p.ws + O_X + X_KVRAW);
    bf16_t* QA = (bf16_t*)(p.ws + O_X + X_QA); bf16_t* KA = (bf16_t*)(p.ws + O_X + X_KA); bf16_t* VA = (bf16_t*)(p.ws + O_X + X_VA);
    const float* rc = (const float*)(p.ws + O_ROPEC); const float* rs = (const float*)(p.ws + O_ROPES);
    for (int row = blockIdx.x * 4 + wave; row < RT; row += gridDim.x * 4) {
        const bool lat = row < RL;
        const int b = lat ? (row >> 12) : ((row - RL) >> 8), t = lat ? (row & 4095) : ((row - RL) & 255);
        const size_t keyrow = (size_t)b * KEYS + (lat ? t : SEQ + t);
        const bf16_t* pr = P + (size_t)row * LDP;
        float sq = 0.f, sk = 0.f;
        if (lane < 48) { float f[8]; unpack8(*(const uint4*)(pr + PQ0 + lane * 8), f);
#pragma unroll
            for (int e = 0; e < 8; ++e) sq += f[e] * f[e]; }
        if (lane < 32) { float f[8]; unpack8(*(const uint4*)(pr + PKV0 + lane * 8), f);
#pragma unroll
            for (int e = 0; e < 8; ++e) sk += f[e] * f[e]; }
        sq = wsum(sq); sk = wsum(sk);
        const float rq = rsqrtf(sq * (1.f / 384.f) + 1e-6f), rkv = rsqrtf(sk * (1.f / 256.f) + 1e-6f);
        const bf16_t* qr = QR + (size_t)row * 768; const bf16_t* kvr = KVR + (size_t)row * 1024;
        const float* rct = rc + t * 16; const float* rst = rs + t * 16;
#pragma unroll
        for (int pass = 0; pass < 2; ++pass) {
            const int ch = lane + 64 * pass;
            if (ch < 96) {
                const int h = ch / 12, cc = ch - h * 12;
                float q[8], k[8];
                unpack8(*(const uint4*)(qr + ch * 8), q);
                if (cc < 8) unpack8(*(const uint4*)(kvr + h * 128 + cc * 8), k);
                else unpack8(*(const uint4*)(pr + PKR0 + (cc - 8) * 8), k);
                const float ksc = cc < 8 ? rkv : 1.f;
#pragma unroll
                for (int e = 0; e < 8; ++e) { q[e] *= rq; k[e] *= ksc; }
                if (cc >= 8 && lat) {
                    const int sub = cc - 8, ax = sub >> 1, half = sub & 1;
                    float qp[8], kp[8];
                    unpack8(*(const uint4*)(qr + (ch ^ 1) * 8), qp); unpack8(*(const uint4*)(pr + PKR0 + (sub ^ 1) * 8), kp);
                    const float4 c0 = *(const float4*)(rct + ax * 8), c1 = *(const float4*)(rct + ax * 8 + 4), s0 = *(const float4*)(rst + ax * 8), s1 = *(const float4*)(rst + ax * 8 + 4);
                    const float cs_[8] = {c0.x, c0.y, c0.z, c0.w, c1.x, c1.y, c1.z, c1.w}, sn_[8] = {s0.x, s0.y, s0.z, s0.w, s1.x, s1.y, s1.z, s1.w};
#pragma unroll
                    for (int e = 0; e < 8; ++e) {
                        const float sg = half ? sn_[e] : -sn_[e];
                        q[e] = q[e] * cs_[e] + qp[e] * rq * sg;
                        k[e] = k[e] * cs_[e] + kp[e] * sg;
                    }
                }
#pragma unroll
                for (int e = 0; e < 8; ++e) q[e] *= QSCALE;
                *(uint4*)(QA + (size_t)row * 768 + ch * 8) = pack8(q);
                *(uint4*)(KA + keyrow * 768 + ch * 8) = pack8(k);
            }
        }
    }
    bf16_t* vt = (bf16_t*)smem;
    float* rk = (float*)(smem + 64 * 72 * 2);
    for (int it = blockIdx.x; it < (RT / 64) * 8; it += gridDim.x) {
        const int g = it >> 3, h = it & 7, rowg = g * 64;
        const bool lat = rowg < RL;
        const int b = lat ? (rowg >> 12) : ((rowg - RL) >> 8), t0 = lat ? (rowg & 4095) : ((rowg - RL) & 255);
        const size_t key0 = lat ? t0 : SEQ + t0;
#pragma unroll 4
        for (int rr = 0; rr < 16; ++rr) {
            const int lr = wave * 16 + rr;
            const bf16_t* pr = P + (size_t)(rowg + lr) * LDP + PKV0;
            const uint2 u = *(const uint2*)(pr + lane * 4);
            float sk = bflo(u.x) * bflo(u.x) + bfhi(u.x) * bfhi(u.x) + bflo(u.y) * bflo(u.y) + bfhi(u.y) * bfhi(u.y);
            sk = wsum(sk);
            if (lane == 0) rk[lr] = rsqrtf(sk * (1.f / 256.f) + 1e-6f);
        }
        __syncthreads();
#pragma unroll
        for (int i = 0; i < 2; ++i) {
            const int c = tid + 256 * i, lr = c >> 3, part = c & 7;
            float f[8]; unpack8(*(const uint4*)(KVR + (size_t)(rowg + lr) * 1024 + h * 128 + 64 + part * 8), f);
            const float sc = rk[lr];
#pragma unroll
            for (int e = 0; e < 8; ++e) f[e] *= sc;
            *(uint4*)(vt + lr * 72 + part * 8) = pack8(f);
        }
        __syncthreads();
#pragma unroll
        for (int i = 0; i < 2; ++i) {
            const int c = tid + 256 * i, dd = c >> 3, kc = c & 7;
            float f[8];
#pragma unroll
            for (int e = 0; e < 8; ++e) f[e] = bf2f(vt[(kc * 8 + e) * 72 + dd]);
            const uint4 u = pack8(f);
            bf16_t* dst = VA + ((size_t)(b * 8 + h) * 64 + dd) * KEYS + key0 + (kc >> 2) * 32 + (kc & 1) * 16 + ((kc & 3) >> 1) * 4;
            *(uint2*)dst = make_uint2(u.x, u.y); *(uint2*)(dst + 8) = make_uint2(u.z, u.w);
        }
        __syncthreads();
    }
}
__device__ __forceinline__ float xmax_16_32(float v) {
    unsigned u = __builtin_bit_cast(unsigned, v);
    auto r = __builtin_amdgcn_permlane32_swap(u, u, false, false);
    float m = fmaxf(__builtin_bit_cast(float, r[0]), __builtin_bit_cast(float, r[1]));
    u = __builtin_bit_cast(unsigned, m);
    auto r2 = __builtin_amdgcn_permlane16_swap(u, u, false, false);
    return fmaxf(__builtin_bit_cast(float, r2[0]), __builtin_bit_cast(float, r2[1]));
}
__device__ __forceinline__ float xsum_16_32(float v) {
    unsigned u = __builtin_bit_cast(unsigned, v);
    auto r = __builtin_amdgcn_permlane32_swap(u, u, false, false);
    float m = __builtin_bit_cast(float, r[0]) + __builtin_bit_cast(float, r[1]);
    u = __builtin_bit_cast(unsigned, m);
    auto r2 = __builtin_amdgcn_permlane16_swap(u, u, false, false);
    return __builtin_bit_cast(float, r2[0]) + __builtin_bit_cast(float, r2[1]);
}
constexpr int KS_LD = 104, VT_LD = 72;
constexpr int AT_BUF = 64 * KS_LD * 2 + 64 * VT_LD * 2;
__device__ __forceinline__ void ph_at(const Params& p, int l, char* smem) {
    const int tid = tidx(), lane = tid & 63, wave = tid >> 6, fr = lane & 15, fq = lane >> 4;
    const bf16_t* QA = (const bf16_t*)(p.ws + O_X + X_QA); const bf16_t* KA = (const bf16_t*)(p.ws + O_X + X_KA); const bf16_t* VA = (const bf16_t*)(p.ws + O_X + X_VA);
    bf16_t* ATT = (bf16_t*)(p.ws + O_ATT);
    const int nitems = 1024 + (l < NLAYER - 1 ? 64 : 0);
    for (int it0 = blockIdx.x; it0 < nitems; it0 += gridDim.x) {
        int it = it0;
        if (gridDim.x == 512 && it0 < 1024) {
            const int x = it0 & 7, j = (it0 >> 3) & 63, rd = it0 >> 9;
            it = ((x * 4 + rd * 2 + (j >> 5)) << 5) | (j & 31);
        }
        int b, h, row0, ntile; size_t krow0;
        if (it < 1024) { b = it >> 8; h = (it >> 5) & 7; row0 = b * SEQ + (it & 31) * 128; krow0 = (size_t)b * KEYS; ntile = KEYS / 64; }
        else { const int j = it - 1024; b = j >> 4; h = (j >> 1) & 7; row0 = RL + b * CTX + (j & 1) * 128; krow0 = (size_t)b * KEYS + SEQ; ntile = CTX / 64; }
        const int qrow = row0 + wave * 32 + fr;
        const size_t vrow0 = (size_t)(b * 8 + h) * 64; const int koff0 = (int)(krow0 - (size_t)b * KEYS);
        bf16x8 qf[2][3];
#pragma unroll
        for (int t = 0; t < 2; ++t)
#pragma unroll
            for (int ks = 0; ks < 3; ++ks) qf[t][ks] = *(const bf16x8*)(QA + (size_t)(qrow + 16 * t) * 768 + h * 96 + ks * 32 + fq * 8);
        f32x4 ot[2][4];
#pragma unroll
        for (int t = 0; t < 2; ++t)
#pragma unroll
            for (int i = 0; i < 4; ++i) ot[t][i] = (f32x4){0.f, 0.f, 0.f, 0.f};
        float m_run[2] = {-1e30f, -1e30f}, l_run[2] = {0.f, 0.f};
        uint4 rk0, rk1, rk2, rv0, rv1;
#define AT_GLOAD(KT) do { const size_t kr_ = krow0 + (size_t)(KT) * 64; \
            { const int c = tid, key = c / 12, part = c % 12; rk0 = *(const uint4*)(KA + (kr_ + key) * 768 + h * 96 + part * 8); } \
            { const int c = tid + 256, key = c / 12, part = c % 12; rk1 = *(const uint4*)(KA + (kr_ + key) * 768 + h * 96 + part * 8); } \
            { const int c = tid + 512, key = c / 12, part = c % 12; rk2 = *(const uint4*)(KA + (kr_ + key) * 768 + h * 96 + part * 8); } \
            { const int c = tid, dd_ = c >> 3, part = c & 7; rv0 = *(const uint4*)(VA + (vrow0 + dd_) * KEYS + koff0 + (KT) * 64 + part * 8); } \
            { const int c = tid + 256, dd_ = c >> 3, part = c & 7; rv1 = *(const uint4*)(VA + (vrow0 + dd_) * KEYS + koff0 + (KT) * 64 + part * 8); } } while (0)
#define AT_VSTORE(RV, C) do { const int dd_ = (C) >> 3, part = (C) & 7; *(uint4*)(Vt_ + dd_ * VT_LD + part * 8) = RV; } while (0)
#define AT_SSTORE(BUF) do { bf16_t* Ks_ = (bf16_t*)(smem + (BUF) * AT_BUF); bf16_t* Vt_ = Ks_ + 64 * KS_LD; \
            { const int c = tid, key = c / 12, part = c % 12; *(uint4*)(Ks_ + key * KS_LD + part * 8) = rk0; } \
            { const int c = tid + 256, key = c / 12, part = c % 12; *(uint4*)(Ks_ + key * KS_LD + part * 8) = rk1; } \
            { const int c = tid + 512, key = c / 12, part = c % 12; *(uint4*)(Ks_ + key * KS_LD + part * 8) = rk2; } \
            AT_VSTORE(rv0, tid); AT_VSTORE(rv1, tid + 256); } while (0)
        AT_GLOAD(0); AT_SSTORE(0);
        __syncthreads();
        for (int kt = 0; kt < ntile; ++kt) {
            const int cur = kt & 1;
            if (kt + 1 < ntile) AT_GLOAD(kt + 1);
            const bf16_t* Ks = (const bf16_t*)(smem + cur * AT_BUF); const bf16_t* Vt = Ks + 64 * KS_LD;
            f32x4 st[2][4];
#pragma unroll
            for (int jh = 0; jh < 2; ++jh) {
                bf16x8 kf[2][3];
#pragma unroll
                for (int jj = 0; jj < 2; ++jj)
#pragma unroll
                    for (int ks = 0; ks < 3; ++ks) kf[jj][ks] = *(const bf16x8*)(Ks + ((jh * 2 + jj) * 16 + fr) * KS_LD + ks * 32 + fq * 8);
#pragma unroll
                for (int jj = 0; jj < 2; ++jj) {
                    const int j = jh * 2 + jj;
                    st[0][j] = (f32x4){0.f, 0.f, 0.f, 0.f}; st[1][j] = (f32x4){0.f, 0.f, 0.f, 0.f};
#pragma unroll
                    for (int ks = 0; ks < 3; ++ks) {
                        st[0][j] = __builtin_amdgcn_mfma_f32_16x16x32_bf16(kf[jj][ks], qf[0][ks], st[0][j], 0, 0, 0);
                        st[1][j] = __builtin_amdgcn_mfma_f32_16x16x32_bf16(kf[jj][ks], qf[1][ks], st[1][j], 0, 0, 0);
                    }
                }
            }
            bf16x8 vf[2][4];
#pragma unroll
            for (int k2 = 0; k2 < 2; ++k2)
#pragma unroll
                for (int dt = 0; dt < 4; ++dt) {
                    vf[k2][dt] = *(const bf16x8*)(Vt + (dt * 16 + fr) * VT_LD + k2 * 32 + fq * 8);
                }
            uint4 pu[2][2];
#pragma unroll
            for (int t = 0; t < 2; ++t) {
                float mx = st[t][0][0];
#pragma unroll
                for (int j = 0; j < 4; ++j)
#pragma unroll
                    for (int r = 0; r < 4; ++r) mx = fmaxf(mx, st[t][j][r]);
                if (__any(mx > m_run[t] + 6.f)) {
                    mx = xmax_16_32(mx);
                    const float m_new = fmaxf(m_run[t], mx);
                    const float alpha = __builtin_amdgcn_exp2f(m_run[t] - m_new);
                    m_run[t] = m_new;
                    l_run[t] *= alpha;
#pragma unroll
                    for (int i = 0; i < 4; ++i) ot[t][i] *= alpha;
                }
                const float mr = m_run[t];
                float ps = 0.f;
#pragma unroll
                for (int j = 0; j < 4; ++j)
#pragma unroll
                    for (int r = 0; r < 4; ++r) { st[t][j][r] = __builtin_amdgcn_exp2f(st[t][j][r] - mr); ps += st[t][j][r]; }
                l_run[t] += ps;
#pragma unroll
                for (int k2 = 0; k2 < 2; ++k2)
                    pu[t][k2] = make_uint4(pack2(st[t][2 * k2][0], st[t][2 * k2][1]), pack2(st[t][2 * k2][2], st[t][2 * k2][3]),
                                           pack2(st[t][2 * k2 + 1][0], st[t][2 * k2 + 1][1]), pack2(st[t][2 * k2 + 1][2], st[t][2 * k2 + 1][3]));
            }
#pragma unroll
            for (int k2 = 0; k2 < 2; ++k2) {
                const bf16x8 pb0 = __builtin_bit_cast(bf16x8, pu[0][k2]), pb1 = __builtin_bit_cast(bf16x8, pu[1][k2]);
#pragma unroll
                for (int dt = 0; dt < 4; ++dt) {
                    ot[0][dt] = __builtin_amdgcn_mfma_f32_16x16x32_bf16(vf[k2][dt], pb0, ot[0][dt], 0, 0, 0);
                    ot[1][dt] = __builtin_amdgcn_mfma_f32_16x16x32_bf16(vf[k2][dt], pb1, ot[1][dt], 0, 0, 0);
                }
            }
            if (kt + 1 < ntile) AT_SSTORE(cur ^ 1);
            __syncthreads();
        }
#pragma unroll
        for (int t = 0; t < 2; ++t) {
            const float inv = 1.f / xsum_16_32(l_run[t]);
#pragma unroll
            for (int dt = 0; dt < 4; ++dt) { f32x4 o = ot[t][dt] * inv; store_bf16x4(ATT + (size_t)(qrow + 16 * t) * 512 + h * 64 + dt * 16 + fq * 4, o); }
        }
    }
}

__device__ __forceinline__ void row_edges(int row, bool& first, bool& last) {
    if (row < RL) { const int t = row & 4095; first = t == 0; last = t == 4095; }
    else { const int s = (row - RL) & 255; first = s == 0; last = s == 255; }
}
__device__ __forceinline__ float xs1(const bf16_t* P, const float* mu, int row, int col) {
    bool first, last; row_edges(row, first, last);
    const bf16_t* pc = P + (size_t)row * LDP + PR0 + col;
    const float c = bf2f(*pc), pv0 = bf2f(*(first ? pc : pc - LDP)), nx0 = bf2f(*(last ? pc : pc + LDP));
    const float pv = first ? 0.f : pv0, nx = last ? 0.f : nx0;
    return c + (0.5f * (pv + nx) - c) * mu[col];
}
__device__ __forceinline__ void xs8(const bf16_t* P, const float* mu, int row, int col, float (&o)[8]) {
    bool first, last; row_edges(row, first, last);
    const bf16_t* pc = P + (size_t)row * LDP + PR0 + col;
    const uint4 uc = *(const uint4*)pc, up = *(const uint4*)(first ? pc : pc - LDP), un = *(const uint4*)(last ? pc : pc + LDP);
    float c[8], pv[8], nx[8]; unpack8(uc, c); unpack8(up, pv); unpack8(un, nx);
    const float fp = first ? 0.f : 0.5f, fn = last ? 0.f : 0.5f;
    const float4 m0 = *(const float4*)(mu + col), m1 = *(const float4*)(mu + col + 4);
    const float m[8] = {m0.x, m0.y, m0.z, m0.w, m1.x, m1.y, m1.z, m1.w};
#pragma unroll
    for (int j = 0; j < 8; ++j) o[j] = c[j] + ((fp * pv[j] + fn * nx[j]) - c[j]) * m[j];
}
struct ALRw {
    const bf16_t* P; const float* mu; int row0; int colbase, mode;
    __device__ __forceinline__ ALRw(const bf16_t* P_, const float* mu_, int row0_, int colbase_, int mode_) : P(P_), mu(mu_), colbase(colbase_), mode(mode_) {
        row0 = row0_ + (tidx() >> 3);
    }
    __device__ __forceinline__ uint4 load(int i, int k) const {
        float o[8]; xs8(P, mu, row0 + 32 * i, colbase + k, o);
        if (mode == 0) {
#pragma unroll
            for (int j = 0; j < 8; ++j) o[j] = tanhf(o[j]);
        } else if (mode == 2) {
#pragma unroll
            for (int j = 0; j < 8; ++j) o[j] = sigmoidf_(o[j]);
        }
        return pack8(o);
    }
};
__device__ __forceinline__ void ph_rp1(const Params& p, int l, char* smem) {
    const bf16_t* P = (const bf16_t*)(p.ws + O_P); const float* mu = p.in[I_MU] + l * 1792;
    bf16_t* RG = (bf16_t*)(p.ws + O_RG);
    for (int it = blockIdx.x; it < 1088; it += gridDim.x) {
        const int mt = it >> 2, nt = it & 3;
        f32x4 acc[2][4];
        ALRw al(P, mu, mt * 64, 1664, 2);
        gemm_core<2>(al, (const bf16_t*)(p.ws + O_WB + W_GUP) + (size_t)nt * 128 * 128, 128, 128, acc, smem);
        acc_foreach<2>(acc, [&](int m, int n, const f32x4& v) { store_bf16x4(RG + (size_t)(mt * 64 + m) * 512 + nt * 128 + n, v); });
    }
}
__device__ __forceinline__ void ph_rp2(const Params& p, int l) {
    const int lane = tidx() & 63, wave = tidx() >> 6;
    const bf16_t* P = (const bf16_t*)(p.ws + O_P); const float* mu = p.in[I_MU] + l * 1792; const float* kkw = p.in[I_KK] + l * 512;
    float* KKN = (float*)(p.ws + O_X + X_KKN);
    for (int row = blockIdx.x * 4 + wave; row < RT; row += gridDim.x * 4) {
        float k8[8]; xs8(P, mu, row, 512 + lane * 8, k8);
        float s = 0.f;
#pragma unroll
        for (int j = 0; j < 8; ++j) { const float v = k8[j] * kkw[lane * 8 + j]; s += v * v; }
        s += __shfl_xor(s, 1); s += __shfl_xor(s, 2); s += __shfl_xor(s, 4);
        if ((lane & 7) == 0) KKN[(size_t)row * 8 + (lane >> 3)] = rsqrtf(s + 1e-12f);
    }
}

__device__ __forceinline__ int scan_row(int b, int d, int n) {
    if (n < CTX) return RL + b * CTX + (d == 0 ? n : CTX - 1 - n);
    const int t = n - CTX; return b * SEQ + (d == 0 ? t : SEQ - 1 - t);
}
constexpr int SL = 72;
constexpr int SLOT_E = 64 * SL;
template <int LDA, int LDB>
__device__ __forceinline__ void mm64(const bf16_t* A, const bf16_t* B, f32x4 (&acc)[4], int wave, int fr, int fq) {
#pragma unroll
    for (int ks = 0; ks < 2; ++ks) {
        const bf16x8 af = *(const bf16x8*)(A + (wave * 16 + fr) * LDA + ks * 32 + fq * 8);
#pragma unroll
        for (int nt = 0; nt < 4; ++nt) {
            const bf16x8 bfv = *(const bf16x8*)(B + (nt * 16 + fr) * LDB + ks * 32 + fq * 8);
            acc[nt] = __builtin_amdgcn_mfma_f32_16x16x32_bf16(bfv, af, acc[nt], 0, 0, 0);
        }
    }
}
__device__ __forceinline__ void acc_zero(f32x4 (&acc)[4]) {
#pragma unroll
    for (int nt = 0; nt < 4; ++nt) acc[nt] = (f32x4){0.f, 0.f, 0.f, 0.f};
}
template <bool STRICT>
__device__ __forceinline__ void acc_mask(f32x4 (&acc)[4], int m, int fq) {
#pragma unroll
    for (int nt = 0; nt < 4; ++nt)
#pragma unroll
        for (int r = 0; r < 4; ++r) { const int n = nt * 16 + fq * 4 + r; const bool keep = STRICT ? (m < n) : (m <= n); if (!keep) acc[nt][r] = 0.f; }
}
__device__ __forceinline__ void st_rm(bf16_t* dst, const f32x4 (&acc)[4], int m, int fq) {
#pragma unroll
    for (int nt = 0; nt < 4; ++nt) store_bf16x4(dst + m * SL + nt * 16 + fq * 4, acc[nt]);
}
__device__ __forceinline__ void st_tr(bf16_t* dst, const f32x4 (&acc)[4], int m, int fq) {
#pragma unroll
    for (int nt = 0; nt < 4; ++nt)
#pragma unroll
        for (int r = 0; r < 4; ++r) dst[(nt * 16 + fq * 4 + r) * SL + m] = f2bf(acc[nt][r]);
}
__device__ __forceinline__ void ph_r1(const Params& p, int l, char* smem) {
    const int tid0 = tidx();
#define R1_IDX const int tid = lv(tid0), lane = tid & 63, wave = tid >> 6, fr = lane & 15, fq = lane >> 4, bi = tid >> 2, bq = (tid & 3) * 16, m = wave * 16 + fr; (void)bi; (void)bq; (void)m; (void)fq;
    const bf16_t* P = (const bf16_t*)(p.ws + O_P); const float* mu = p.in[I_MU] + l * 1792;
    const float* kkw = p.in[I_KK] + l * 512; const float* kaw = p.in[I_KA] + l * 512; const float* rkw = p.in[I_RK] + l * 512;
    const float* KKN = (const float*)(p.ws + O_X + X_KKN); float* BON = (float*)(p.ws + O_X + X_BON);
    bf16_t* gMT = (bf16_t*)(p.ws + O_X + X_MT); bf16_t* gNL = (bf16_t*)(p.ws + O_H);
    bf16_t* gGT = (bf16_t*)(p.ws + O_X + X_GT); bf16_t* gYL = (bf16_t*)(p.ws + O_X + X_YL);
    bf16_t* slot = (bf16_t*)smem;
    bf16_t* s0 = slot, *s1 = slot + SLOT_E, *s2 = slot + 2 * SLOT_E, *s3 = slot + 3 * SLOT_E;
    bf16_t* sa = slot + 4 * SLOT_E, *sb = slot + 5 * SLOT_E, *sc = slot + 6 * SLOT_E, *sT = slot + 7 * SLOT_E;
    float* misc = (float*)(smem + 8 * SLOT_E * 2);
    float* GAM = misc; float* SEG = misc + 64;
    float* ASIG = (float*)s0;
    float* LWS = (float*)s2;
    for (int it = blockIdx.x; it < NCP; it += gridDim.x) {
        const int c = it % 68, d = (it / 68) & 1, h = (it / 136) & 7, b = it / 1088;
        {
            R1_IDX const int rowb = scan_row(b, d, c * 64 + bi); (void)rowb;
            float o[8];
#pragma unroll
            for (int hh = 0; hh < 2; ++hh) {
                xs8(P, mu, rowb, 1536 + bq + hh * 8, o);
#pragma unroll
                for (int j = 0; j < 8; ++j) o[j] = 1.f - 2.f * __builtin_amdgcn_rcpf(1.f + __expf(2.f * o[j]));
                *(uint4*)(sa + bi * SL + bq + hh * 8) = pack8(o);
                xs8(P, mu, rowb, 1600 + bq + hh * 8, o);
                *(uint4*)(sb + bi * SL + bq + hh * 8) = pack8(o);
            }
        }
        __syncthreads();
        {
            R1_IDX const int rowb = scan_row(b, d, c * 64 + bi); (void)rowb;
            f32x4 acc[4];
            acc_zero(acc);
            mm64<SL, 64>(sa, (const bf16_t*)(p.ws + O_WB + W_WUP) + ((size_t)d * 512 + h * 64) * 64, acc, wave, fr, fq);
            const float* w0 = p.in[I_W0] + (l * 2 + d) * 512 + h * 64;
#pragma unroll
            for (int nt = 0; nt < 4; ++nt) {
                const int n = nt * 16 + fq * 4; float4 o; float* op = (float*)&o;
#pragma unroll
                for (int r = 0; r < 4; ++r) { const float z = w0[n + r] + acc[nt][r]; op[r] = -0.6065306597126334f * __builtin_amdgcn_rcpf(1.f + __expf(-z)); }
                *(float4*)(LWS + m * 68 + n) = o;
            }
            acc_zero(acc);
            mm64<SL, 64>(sb, (const bf16_t*)(p.ws + O_WB + W_AUP) + ((size_t)d * 512 + h * 64) * 64, acc, wave, fr, fq);
            const float* a0 = p.in[I_A0] + (l * 2 + d) * 512 + h * 64;
#pragma unroll
            for (int nt = 0; nt < 4; ++nt) {
                const int n = nt * 16 + fq * 4;
                *(float4*)(ASIG + m * 68 + n) = make_float4(__builtin_amdgcn_rcpf(1.f + __expf(-(a0[n] + acc[nt][0]))), __builtin_amdgcn_rcpf(1.f + __expf(-(a0[n + 1] + acc[nt][1]))), __builtin_amdgcn_rcpf(1.f + __expf(-(a0[n + 2] + acc[nt][2]))), __builtin_amdgcn_rcpf(1.f + __expf(-(a0[n + 3] + acc[nt][3]))));
            }
        }
        __syncthreads();
        {
            R1_IDX const int rowb = scan_row(b, d, c * 64 + bi); (void)rowb;
            const int k = tid & 63, seg = tid >> 6;
            float run = 0.f;
#pragma unroll
            for (int ii = 0; ii < 16; ++ii) { run += LWS[(seg * 16 + ii) * 68 + k]; LWS[(seg * 16 + ii) * 68 + k] = run; }
            SEG[seg * 64 + k] = run;
            __syncthreads();
            float off = 0.f;
#pragma unroll
            for (int sgi = 0; sgi < 3; ++sgi) if (sgi < seg) off += SEG[sgi * 64 + k];
#pragma unroll
            for (int ii = 0; ii < 16; ++ii) LWS[(seg * 16 + ii) * 68 + k] += off;
        }
        __syncthreads();
        {
            R1_IDX const int rowb = scan_row(b, d, c * 64 + bi); (void)rowb;
            float cs[16], cm[16], cc[16], ag[16];
#pragma unroll
            for (int q = 0; q < 4; ++q) {
                const float4 v0 = *(const float4*)(LWS + bi * 68 + bq + q * 4);
                const float4 v1 = bi > 0 ? *(const float4*)(LWS + (bi - 1) * 68 + bq + q * 4) : make_float4(0.f, 0.f, 0.f, 0.f);
                const float4 v2 = *(const float4*)(LWS + 63 * 68 + bq + q * 4);
                const float4 v3 = *(const float4*)(ASIG + bi * 68 + bq + q * 4);
                cs[q * 4] = v0.x; cs[q * 4 + 1] = v0.y; cs[q * 4 + 2] = v0.z; cs[q * 4 + 3] = v0.w;
                cm[q * 4] = v1.x; cm[q * 4 + 1] = v1.y; cm[q * 4 + 2] = v1.z; cm[q * 4 + 3] = v1.w;
                cc[q * 4] = v2.x; cc[q * 4 + 1] = v2.y; cc[q * 4 + 2] = v2.z; cc[q * 4 + 3] = v2.w;
                ag[q * 4] = v3.x; ag[q * 4 + 1] = v3.y; ag[q * 4 + 2] = v3.z; ag[q * 4 + 3] = v3.w;
            }
            __syncthreads();
            const float kkn = KKN[(size_t)rowb * 8 + h];
            float bon = 0.f;
#pragma unroll
            for (int hh = 0; hh < 2; ++hh) {
                float r8[8], k8[8], oa[8], ob[8], ok[8], orr[8];
                const int col = h * 64 + bq + hh * 8;
                xs8(P, mu, rowb, col, r8); xs8(P, mu, rowb, 512 + col, k8);
#pragma unroll
                for (int j = 0; j < 8; ++j) {
                    const int e = hh * 8 + j;
                    const float kk = k8[j] * kkw[col + j] * kkn;
                    const float kd = k8[j] * (1.f + (ag[e] - 1.f) * kaw[col + j]);
                    const float eneg = __expf(-cs[e]);
                    oa[j] = -kk * __expf(cm[e]); ob[j] = kk * ag[e] * eneg; ok[j] = kd * eneg; orr[j] = r8[j] * __builtin_amdgcn_rcpf(eneg);
                    bon += r8[j] * kd * rkw[col + j];
                }
                *(uint4*)(s0 + bi * SL + bq + hh * 8) = pack8(oa); *(uint4*)(s1 + bi * SL + bq + hh * 8) = pack8(ob);
                *(uint4*)(s2 + bi * SL + bq + hh * 8) = pack8(ok); *(uint4*)(s3 + bi * SL + bq + hh * 8) = pack8(orr);
            }
            bon += __shfl_xor(bon, 1); bon += __shfl_xor(bon, 2);
            if ((tid & 3) == 0) BON[((size_t)d * RT + rowb) * 8 + h] = bon;
            if (bi == 0) {
#pragma unroll
                for (int e = 0; e < 16; ++e) GAM[bq + e] = __expf(cc[e]);
            }
        }
        __syncthreads();
        {
            R1_IDX const int rowb = scan_row(b, d, c * 64 + bi); (void)rowb;
            f32x4 acc[4]; acc_zero(acc);
            mm64<SL, SL>(s1, s0, acc, wave, fr, fq);
            acc_mask<true>(acc, m, fq);
            st_rm(sa, acc, m, fq); st_tr(sb, acc, m, fq);
#pragma unroll
            for (int nt = 0; nt < 4; ++nt)
#pragma unroll
                for (int r = 0; r < 4; ++r) if (nt * 16 + fq * 4 + r == m) acc[nt][r] += 1.f;
            st_rm(sc, acc, m, fq);
        }
        __syncthreads();
#pragma unroll
        for (int itr = 0; itr < 5; ++itr) {
            R1_IDX
            bf16_t* ptr = (itr & 1) ? sT : sb;
            bf16_t* ptw = (itr & 1) ? sb : sT;
            f32x4 acc[4]; acc_zero(acc);
            mm64<SL, SL>(sa, ptr, acc, wave, fr, fq);
            st_rm(sa, acc, m, fq); st_tr(ptw, acc, m, fq);
            __syncthreads();
            f32x4 tacc[4];
#pragma unroll
            for (int nt = 0; nt < 4; ++nt) { const uint2 u = *(const uint2*)(sc + m * SL + nt * 16 + fq * 4); tacc[nt] = (f32x4){bflo(u.x), bfhi(u.x), bflo(u.y), bfhi(u.y)}; }
            mm64<SL, SL>(sc, ptw, tacc, wave, fr, fq);
            if (itr < 4) st_rm(sc, tacc, m, fq); else st_tr(sb, tacc, m, fq);
        }
        __syncthreads();
        {
            R1_IDX const int rowb = scan_row(b, d, c * 64 + bi); (void)rowb;
            f32x4 acc[4]; acc_zero(acc);
            mm64<SL, SL>(s2, s0, acc, wave, fr, fq);
            acc_mask<true>(acc, m, fq);
            st_rm(sa, acc, m, fq);
            float f0[8], f1[8];
            unpack8(*(const uint4*)(s0 + bi * SL + bq), f0); unpack8(*(const uint4*)(s0 + bi * SL + bq + 8), f1);
#pragma unroll
            for (int e = 0; e < 8; ++e) { sc[(bq + e) * SL + bi] = f2bf(f0[e]); sc[(bq + 8 + e) * SL + bi] = f2bf(f1[e]); }
        }
        __syncthreads();
        {
            R1_IDX const int rowb = scan_row(b, d, c * 64 + bi); (void)rowb;
            f32x4 acc[4]; acc_zero(acc);
            mm64<SL, SL>(sc, sb, acc, wave, fr, fq);
            st_rm(sT, acc, m, fq);
            acc_zero(acc);
            mm64<SL, SL>(sa, sb, acc, wave, fr, fq);
            st_rm(s0, acc, m, fq);
        }
        __syncthreads();
        f32x4 qacc[4];
        {
            R1_IDX const int rowb = scan_row(b, d, c * 64 + bi); (void)rowb;
            f32x4 acc[4]; acc_zero(acc);
            mm64<SL, SL>(s1, s3, acc, wave, fr, fq);
            acc_mask<false>(acc, m, fq);
            st_tr(sa, acc, m, fq);
            acc_zero(qacc);
            mm64<SL, SL>(s2, s3, qacc, wave, fr, fq);
            acc_mask<false>(qacc, m, fq);
            float f0[8], f1[8];
            unpack8(*(const uint4*)(s3 + bi * SL + bq), f0); unpack8(*(const uint4*)(s3 + bi * SL + bq + 8), f1);
#pragma unroll
            for (int e = 0; e < 8; ++e) { sc[(bq + e) * SL + bi] = f2bf(f0[e]); sc[(bq + 8 + e) * SL + bi] = f2bf(f1[e]); }
        }
        __syncthreads();
        {
            R1_IDX const int rowb = scan_row(b, d, c * 64 + bi); (void)rowb;
            f32x4 acc[4];
#pragma unroll
            for (int nt = 0; nt < 4; ++nt) { const uint2 u = *(const uint2*)(sc + m * SL + nt * 16 + fq * 4); acc[nt] = (f32x4){bflo(u.x), bfhi(u.x), bflo(u.y), bfhi(u.y)}; }
            mm64<SL, SL>(sT, sa, acc, wave, fr, fq);
            bf16_t* gt = gGT + (size_t)it * 4096;
#pragma unroll
            for (int nt = 0; nt < 4; ++nt)
#pragma unroll
                for (int r = 0; r < 4; ++r) gt[(nt * 16 + fq * 4 + r) * 64 + m] = f2bf(acc[nt][r]);
            mm64<SL, SL>(s0, sa, qacc, wave, fr, fq);
            st_tr(sb, qacc, m, fq);
            float f0[8], f1[8];
            unpack8(*(const uint4*)(s1 + bi * SL + bq), f0); unpack8(*(const uint4*)(s1 + bi * SL + bq + 8), f1);
#pragma unroll
            for (int e = 0; e < 8; ++e) { s3[(bq + e) * SL + bi] = f2bf(f0[e] * GAM[bq + e]); s3[(bq + 8 + e) * SL + bi] = f2bf(f1[e] * GAM[bq + 8 + e]); }
        }
        __syncthreads();
        {
            R1_IDX const int rowb = scan_row(b, d, c * 64 + bi); (void)rowb;
            f32x4 acc[4]; acc_zero(acc);
            mm64<SL, SL>(sT, s3, acc, wave, fr, fq);
            bf16_t* mt = gMT + (size_t)it * 4096;
#pragma unroll
            for (int nt = 0; nt < 4; ++nt)
#pragma unroll
                for (int r = 0; r < 4; ++r) { const int n = nt * 16 + fq * 4 + r; mt[n * 64 + m] = f2bf(acc[nt][r] + (n == m ? GAM[m] : 0.f)); }
#pragma unroll
            for (int nt = 0; nt < 4; ++nt) {
                const int n = nt * 16 + fq * 4; const uint2 u = *(const uint2*)(s2 + m * SL + n);
                acc[nt] = (f32x4){bflo(u.x) * GAM[n], bfhi(u.x) * GAM[n + 1], bflo(u.y) * GAM[n + 2], bfhi(u.y) * GAM[n + 3]};
            }
            mm64<SL, SL>(s0, s3, acc, wave, fr, fq);
            st_tr(s1, acc, m, fq);
            float v8[8];
#pragma unroll
            for (int hh = 0; hh < 2; ++hh) {
                xs8(P, mu, rowb, 1024 + h * 64 + bq + hh * 8, v8);
#pragma unroll
                for (int e = 0; e < 8; ++e) sc[(bq + hh * 8 + e) * SL + bi] = f2bf(v8[e]);
            }
        }
        __syncthreads();
        {
            R1_IDX const int rowb = scan_row(b, d, c * 64 + bi); (void)rowb;
            f32x4 acc[4]; acc_zero(acc);
            mm64<SL, SL>(sc, sb, acc, wave, fr, fq);
            bf16_t* yl = gYL + (size_t)it * 4096;
#pragma unroll
            for (int nt = 0; nt < 4; ++nt) store_bf16x4(yl + m * 64 + nt * 16 + fq * 4, acc[nt]);
            acc_zero(acc);
            mm64<SL, SL>(sc, s1, acc, wave, fr, fq);
            bf16_t* nl = gNL + (size_t)it * 4096;
#pragma unroll
            for (int nt = 0; nt < 4; ++nt) store_bf16x4(nl + m * 64 + nt * 16 + fq * 4, acc[nt]);
        }
        __syncthreads();
    }
}
__device__ __forceinline__ void ph_r2(const Params& p, char* smem) {
    const int tid = tidx(), lane = tid & 63, wave = tid >> 6, fr = lane & 15, fq = lane >> 4;
    const char* gMT = (const char*)(p.ws + O_X + X_MT); const char* gNL = (const char*)(p.ws + O_H);
    uint4* gS0 = (uint4*)(p.ws + O_X + X_S0);
    const int wofs = __builtin_amdgcn_readfirstlane(wave) * 1024;
    const unsigned lds0 = (unsigned)(uintptr_t)smem;
    const unsigned mtaddr = lds0 + fr * 128 + fq * 8, nladdr = lds0 + (wave * 16 + fr) * 128 + fq * 8;
    auto issue = [&](size_t cp, int slot) {
        char* dst = smem + slot * 16384 + wofs;
        const char* s0 = gMT + cp * 8192 + wofs + lane * 16; const char* s1 = gNL + cp * 8192 + wofs + lane * 16;
        __builtin_amdgcn_global_load_lds((const unsigned*)s0, (unsigned*)dst, 16, 0, 0);
        __builtin_amdgcn_global_load_lds((const unsigned*)(s0 + 4096), (unsigned*)(dst + 4096), 16, 0, 0);
        __builtin_amdgcn_global_load_lds((const unsigned*)s1, (unsigned*)(dst + 8192), 16, 0, 0);
        __builtin_amdgcn_global_load_lds((const unsigned*)(s1 + 4096), (unsigned*)(dst + 12288), 16, 0, 0);
    };
    for (int it = blockIdx.x; it < 64; it += gridDim.x) {
        f32x4 st[4];
#pragma unroll
        for (int tt = 0; tt < 4; ++tt) st[tt] = (f32x4){0.f, 0.f, 0.f, 0.f};
        const size_t cp0 = (size_t)it * 68;
        issue(cp0, 0); issue(cp0 + 1, 1); issue(cp0 + 2, 2);
        for (int c4 = 0; c4 < 68; c4 += 4) {
#pragma unroll
            for (int j = 0; j < 4; ++j) {
                const int c = c4 + j;
                if (c < 65) asm volatile("s_waitcnt vmcnt(8)" ::: "memory"); else asm volatile("s_waitcnt vmcnt(0)" ::: "memory");
                __builtin_amdgcn_s_barrier();
                asm volatile("" ::: "memory");
                uint2 mx[4][2][2], nvv[4];
                asm volatile("ds_read_b64 %0, %1 offset:0" : "=v"(mx[0][0][0]) : "v"(mtaddr + j * 16384));
                asm volatile("ds_read_b64 %0, %1 offset:32" : "=v"(mx[0][0][1]) : "v"(mtaddr + j * 16384));
                asm volatile("ds_read_b64 %0, %1 offset:64" : "=v"(mx[0][1][0]) : "v"(mtaddr + j * 16384));
                asm volatile("ds_read_b64 %0, %1 offset:96" : "=v"(mx[0][1][1]) : "v"(mtaddr + j * 16384));
                asm volatile("ds_read_b64 %0, %1 offset:8192" : "=v"(nvv[0]) : "v"(nladdr + j * 16384));
                asm volatile("ds_read_b64 %0, %1 offset:2048" : "=v"(mx[1][0][0]) : "v"(mtaddr + j * 16384));
                asm volatile("ds_read_b64 %0, %1 offset:2080" : "=v"(mx[1][0][1]) : "v"(mtaddr + j * 16384));
                asm volatile("ds_read_b64 %0, %1 offset:2112" : "=v"(mx[1][1][0]) : "v"(mtaddr + j * 16384));
                asm volatile("ds_read_b64 %0, %1 offset:2144" : "=v"(mx[1][1][1]) : "v"(mtaddr + j * 16384));
                asm volatile("ds_read_b64 %0, %1 offset:8224" : "=v"(nvv[1]) : "v"(nladdr + j * 16384));
                asm volatile("ds_read_b64 %0, %1 offset:4096" : "=v"(mx[2][0][0]) : "v"(mtaddr + j * 16384));
                asm volatile("ds_read_b64 %0, %1 offset:4128" : "=v"(mx[2][0][1]) : "v"(mtaddr + j * 16384));
                asm volatile("ds_read_b64 %0, %1 offset:4160" : "=v"(mx[2][1][0]) : "v"(mtaddr + j * 16384));
                asm volatile("ds_read_b64 %0, %1 offset:4192" : "=v"(mx[2][1][1]) : "v"(mtaddr + j * 16384));
                asm volatile("ds_read_b64 %0, %1 offset:8256" : "=v"(nvv[2]) : "v"(nladdr + j * 16384));
                asm volatile("ds_read_b64 %0, %1 offset:6144" : "=v"(mx[3][0][0]) : "v"(mtaddr + j * 16384));
                asm volatile("ds_read_b64 %0, %1 offset:6176" : "=v"(mx[3][0][1]) : "v"(mtaddr + j * 16384));
                asm volatile("ds_read_b64 %0, %1 offset:6208" : "=v"(mx[3][1][0]) : "v"(mtaddr + j * 16384));
                asm volatile("ds_read_b64 %0, %1 offset:6240" : "=v"(mx[3][1][1]) : "v"(mtaddr + j * 16384));
                asm volatile("ds_read_b64 %0, %1 offset:8288" : "=v"(nvv[3]) : "v"(nladdr + j * 16384));
                u32x4 sb[2];
#pragma unroll
                for (int s_ = 0; s_ < 2; ++s_) sb[s_] = (u32x4){pack2(st[2 * s_][0], st[2 * s_][1]), pack2(st[2 * s_][2], st[2 * s_][3]), pack2(st[2 * s_ + 1][0], st[2 * s_ + 1][1]), pack2(st[2 * s_ + 1][2], st[2 * s_ + 1][3])};
                asm volatile("s_waitcnt lgkmcnt(0)" ::: "memory");
                __builtin_amdgcn_sched_barrier(0);
#pragma unroll
                for (int tt = 0; tt < 4; ++tt) {
                    f32x4 acc = {bflo(nvv[tt].x), bfhi(nvv[tt].x), bflo(nvv[tt].y), bfhi(nvv[tt].y)};
#pragma unroll
                    for (int s_ = 0; s_ < 2; ++s_)
                        acc = __builtin_amdgcn_mfma_f32_16x16x32_bf16(__builtin_bit_cast(bf16x8, (u32x4){mx[tt][s_][0].x, mx[tt][s_][0].y, mx[tt][s_][1].x, mx[tt][s_][1].y}), __builtin_bit_cast(bf16x8, sb[s_]), acc, 0, 0, 0);
                    st[tt] = acc;
                }
                *(u32x4*)(gS0 + ((cp0 + c) * 4 + wave) * 128 + lane) = sb[0]; *(u32x4*)(gS0 + ((cp0 + c) * 4 + wave) * 128 + 64 + lane) = sb[1];
                if (c + 3 < 68) issue(cp0 + c + 3, (j + 3) & 3);
            }
        }
        asm volatile("s_waitcnt vmcnt(0)" ::: "memory");
        __syncthreads();
    }
}
__device__ __forceinline__ void ph_r3(const Params& p) {
    const int tid = tidx(), lane = tid & 63, wave = tid >> 6, fr = lane & 15, fq = lane >> 4;
    const bf16_t* gGT = (const bf16_t*)(p.ws + O_X + X_GT); const bf16_t* gYL = (const bf16_t*)(p.ws + O_X + X_YL);
    const u32x4* gS0 = (const u32x4*)(p.ws + O_X + X_S0);
    bf16_t* YS = (bf16_t*)(p.ws + O_H);
    for (int it = blockIdx.x * 4 + wave; it < NCP; it += gridDim.x * 4) {
        const int c = it % 68, d = (it / 68) & 1, h = (it / 136) & 7, b = it / 1088;
        const bf16_t* gt = gGT + (size_t)it * 4096; const bf16_t* yl = gYL + (size_t)it * 4096;
        u32x4 gf[4][2];
#pragma unroll
        for (int tt = 0; tt < 4; ++tt)
#pragma unroll
            for (int s_ = 0; s_ < 2; ++s_) {
                const bf16_t* q = gt + (tt * 16 + fr) * 64 + s_ * 32 + fq * 4;
                const uint2 a0 = *(const uint2*)q, a1 = *(const uint2*)(q + 16);
                gf[tt][s_] = (u32x4){a0.x, a0.y, a1.x, a1.y};
            }
#pragma unroll
        for (int vg = 0; vg < 4; ++vg) {
            const u32x4 sb0 = gS0[((size_t)it * 4 + vg) * 128 + lane], sb1 = gS0[((size_t)it * 4 + vg) * 128 + 64 + lane];
#pragma unroll
            for (int tt = 0; tt < 4; ++tt) {
                const uint2 yv = *(const uint2*)(yl + (vg * 16 + fr) * 64 + tt * 16 + fq * 4);
                f32x4 acc = {bflo(yv.x), bfhi(yv.x), bflo(yv.y), bfhi(yv.y)};
                acc = __builtin_amdgcn_mfma_f32_16x16x32_bf16(__builtin_bit_cast(bf16x8, gf[tt][0]), __builtin_bit_cast(bf16x8, sb0), acc, 0, 0, 0);
                acc = __builtin_amdgcn_mfma_f32_16x16x32_bf16(__builtin_bit_cast(bf16x8, gf[tt][1]), __builtin_bit_cast(bf16x8, sb1), acc, 0, 0, 0);
#pragma unroll
                for (int r = 0; r < 4; ++r) {
                    const int row = scan_row(b, d, c * 64 + tt * 16 + fq * 4 + r);
                    YS[((size_t)d * RT + row) * 512 + h * 64 + vg * 16 + fr] = f2bf(acc[r]);
                }
            }
        }
    }
}

__device__ __forceinline__ void ph_rpost(const Params& p, int l) {
    const int lane = tidx() & 63, wave = tidx() >> 6;
    const bf16_t* P = (const bf16_t*)(p.ws + O_P); const float* mu = p.in[I_MU] + l * 1792;
    const float* gng = p.in[I_GNG] + l * 512; const float* gnb = p.in[I_GNB] + l * 512;
    const float* BON = (const float*)(p.ws + O_X + X_BON); const bf16_t* YS = (const bf16_t*)(p.ws + O_H);
    const bf16_t* RG = (const bf16_t*)(p.ws + O_RG); bf16_t* RWO = (bf16_t*)(p.ws + O_RWO);
    for (int row = blockIdx.x * 4 + wave; row < RT; row += gridDim.x * 4) {
        const int col = lane * 8, h = lane >> 3;
        float v8[8], g8[8], y0[8], y1[8];
        xs8(P, mu, row, 1024 + col, v8);
        unpack8(*(const uint4*)(RG + (size_t)row * 512 + col), g8);
        unpack8(*(const uint4*)(YS + ((size_t)0 * RT + row) * 512 + col), y0);
        unpack8(*(const uint4*)(YS + ((size_t)1 * RT + row) * 512 + col), y1);
        const float bs = BON[((size_t)0 * RT + row) * 8 + h] + BON[((size_t)1 * RT + row) * 8 + h];
        float y[8]; float sm = 0.f;
#pragma unroll
        for (int j = 0; j < 8; ++j) { y[j] = y0[j] + y1[j]; sm += y[j]; }
        sm += __shfl_xor(sm, 1); sm += __shfl_xor(sm, 2); sm += __shfl_xor(sm, 4);
        const float mean = sm * (1.f / 64.f);
        float vs = 0.f;
#pragma unroll
        for (int j = 0; j < 8; ++j) { const float dlt = y[j] - mean; vs += dlt * dlt; }
        vs += __shfl_xor(vs, 1); vs += __shfl_xor(vs, 2); vs += __shfl_xor(vs, 4);
        const float rstd = rsqrtf(vs * (1.f / 64.f) + 64e-5f);
        float o[8];
#pragma unroll
        for (int j = 0; j < 8; ++j) o[j] = ((y[j] - mean) * rstd * gng[col + j] + gnb[col + j] + bs * v8[j]) * g8[j];
        *(uint4*)(RWO + (size_t)row * 512 + col) = pack8(o);
    }
}

__device__ __forceinline__ void ph_f1(const Params& p, int l, char* smem) {
    const bf16_t* P = (const bf16_t*)(p.ws + O_P); const bf16_t* CSC = (const bf16_t*)(p.ws + O_CSC);
    bf16_t* YT2 = (bf16_t*)(p.ws + O_YT2); bf16_t* YTC = (bf16_t*)(p.ws + O_YTC);
    const int nitems = 1024 + (l < NLAYER - 1 ? 64 : 0);
    for (int it = blockIdx.x; it < nitems; it += gridDim.x) {
        f32x4 acc[4][4];
        if (it < 1024) {
            const int b = it >> 8, g = (it >> 6) & 3, part = (it >> 5) & 1, j = it & 31;
            RPPlain rpa{CSC + (size_t)part * 128 * 128, 128};
            const bf16_t* pb = P + (size_t)b * SEQ * LDP + g * 128;
            auto rpb = [&](int r) -> const bf16_t* { return pb + (size_t)(64 * (r & 63) + 2 * j + (r >> 6)) * LDP; };
            gemm_core_gb<4>(rpa, rpb, 128, acc, smem);
            acc_foreach<4>(acc, [&](int m, int n, const f32x4& v) {
                const int t1 = n & 63, t2 = 2 * j + (n >> 6);
                store_bf16x4(YT2 + ((size_t)(b * 512 + g * 128 + m) * 64 + t2) * 128 + part * 64 + t1, v);
            });
        } else {
            const int jj = it - 1024, b = jj >> 4, g = (jj >> 2) & 3, part = (jj >> 1) & 1, nt = jj & 1;
            RPPlain rpa{CSC + (size_t)part * 128 * 128, 128};
            gemm_core_g<4>(rpa, P + (size_t)(RL + b * CTX + nt * 128) * LDP + g * 128, LDP, 128, acc, smem);
            acc_foreach<4>(acc, [&](int m, int n, const f32x4& v) {
                store_bf16x4(YTC + ((size_t)(b * 512 + g * 128 + m)) * 512 + part * 256 + nt * 128 + n, v);
            });
        }
    }
}
__device__ __forceinline__ void ph_fa(const Params& p, char* smem) {
    const bf16_t* YT2 = (const bf16_t*)(p.ws + O_YT2); const bf16_t* D128 = (const bf16_t*)(p.ws + O_D128);
    const float* TWC = (const float*)(p.ws + O_TWC); const float* TWS = (const float*)(p.ws + O_TWS);
    bf16_t* A2 = (bf16_t*)(p.ws + O_A2);
    for (int it = blockIdx.x; it < 1024; it += gridDim.x) {
        f32x4 acc[4][4];
        RPPlain rpa{D128, 128};
        gemm_core_g<4>(rpa, YT2 + (size_t)it * 128 * 128, 128, 128, acc, smem);
        const int lane = tidx() & 63, wave = tidx() >> 6, wr = wave >> 1, wc = wave & 1, fr = lane & 15, fq = lane >> 4;
        float* U = (float*)smem;
        if (wr == 1) {
#pragma unroll
            for (int i = 0; i < 4; ++i)
#pragma unroll
                for (int j = 0; j < 4; ++j) *(f32x4*)(U + (i * 16 + fr) * 132 + wc * 64 + j * 16 + fq * 4) = acc[i][j];
        }
        __syncthreads();
        if (wr == 0) {
#pragma unroll
            for (int i = 0; i < 4; ++i) {
                const int k1 = i * 16 + fr;
#pragma unroll
                for (int j = 0; j < 4; ++j) {
                    const int r = wc * 64 + j * 16 + fq * 4;
                    const int R = it * 128 + r, bn = R >> 6, t2 = R & 63, b = bn >> 9, n = bn & 511;
                    const f32x4 ai = *(const f32x4*)(U + k1 * 132 + r);
                    const f32x4 c = *(const f32x4*)(TWC + k1 * 64 + t2), sn = *(const f32x4*)(TWS + k1 * 64 + t2);
                    const f32x4 ar = acc[i][j];
                    const f32x4 pr = ar * c - ai * sn, pi = ar * sn + ai * c;
                    bf16_t* dst = A2 + ((size_t)(b * 64 + k1) * 512 + n) * 128 + t2;
                    store_bf16x4(dst, pr); store_bf16x4(dst + 64, pi);
                }
            }
        }
        __syncthreads();
    }
}
__device__ __forceinline__ void ph_fb(const Params& p, int l, char* smem) {
    const bf16_t* A2 = (const bf16_t*)(p.ws + O_A2); const bf16_t* E64 = (const bf16_t*)(p.ws + O_E64);
    const bf16_t* CST2 = (const bf16_t*)(p.ws + O_CST256); const bf16_t* YTC = (const bf16_t*)(p.ws + O_YTC);
    bf16_t* FA = (bf16_t*)(p.ws + O_FA);
    const int nitems = 1024 + (l < NLAYER - 1 ? 32 : 0);
    for (int it = blockIdx.x; it < nitems; it += gridDim.x) {
        if (it < 1024) {
            const int b = it >> 8, k1 = (it >> 2) & 63, nt = it & 3;
            f32x4 acc[2][4];
            RPPlain rpa{E64, 128};
            gemm_core_g<2>(rpa, A2 + ((size_t)(b * 64 + k1) * 512 + nt * 128) * 128, 128, 128, acc, smem);
            const float sc = 0.001381067932004975f;
            acc_foreach<2>(acc, [&](int m, int n, const f32x4& v) { f32x4 o = v * sc; store_bf16x4(FA + (size_t)(b * SEQ + k1 + 64 * m) * 512 + nt * 128 + n, o); });
        } else {
            const int j = it - 1024, b = j >> 3, mt = (j >> 2) & 1, nt = j & 3;
            f32x4 acc[4][4];
            RPPlain rp{CST2 + (size_t)mt * 128 * 512, 512};
            gemm_core_g<4>(rp, YTC + ((size_t)b * 512 + nt * 128) * 512, 512, 512, acc, smem);
            const float sc = 0.005524271728019903f;
            acc_foreach<4>(acc, [&](int m, int n, const f32x4& v) { f32x4 o = v * sc; store_bf16x4(FA + (size_t)(RL + b * CTX + mt * 128 + m) * 512 + nt * 128 + n, o); });
        }
    }
}

__device__ __forceinline__ void ph_mg(const Params& p, int l, char* smem) {
    const bf16_t* P = (const bf16_t*)(p.ws + O_P);
    const bf16_t* A0 = (const bf16_t*)(p.ws + O_FA); const bf16_t* A1 = (const bf16_t*)(p.ws + O_ATT); const bf16_t* A2 = (const bf16_t*)(p.ws + O_RWO);
    const bf16_t* W0 = (const bf16_t*)(p.ws + O_WB + W_PA); const bf16_t* W1 = (const bf16_t*)(p.ws + O_WB + W_PB); const bf16_t* W2 = (const bf16_t*)(p.ws + O_WB + W_PC);
    bf16_t* MG = (bf16_t*)(p.ws + O_H);
    const int nmt = (l < NLAYER - 1) ? RT / 64 : RL / 64;
    for (int it = blockIdx.x; it < nmt * 8; it += gridDim.x) {
        const int mt = it >> 3, nt = it & 7;
        f32x4 tot[2][4];
#pragma unroll
        for (int i = 0; i < 2; ++i)
#pragma unroll
            for (int j = 0; j < 4; ++j) tot[i][j] = (f32x4){0.f, 0.f, 0.f, 0.f};
#pragma unroll 1
        for (int br = 0; br < 3; ++br) {
            const bf16_t* Ab = br == 0 ? A0 : (br == 1 ? A1 : A2);
            const bf16_t* Wb = br == 0 ? W0 : (br == 1 ? W1 : W2);
            f32x4 acc[2][4];
            RPPlain rp{Ab + (size_t)mt * 64 * 512, 512};
            gemm_core_g<2>(rp, Wb + (size_t)nt * 128 * 512, 512, 512, acc, smem);
            const int lane = tidx() & 63, wave = tidx() >> 6, wr = wave >> 1, wc = wave & 1, fr = lane & 15, fq = lane >> 4;
#pragma unroll
            for (int i = 0; i < 2; ++i)
#pragma unroll
                for (int j = 0; j < 4; ++j) {
                    const int m = wr * 32 + i * 16 + fr, n = wc * 64 + j * 16 + fq * 4;
                    const uint2 gu = *(const uint2*)(P + (size_t)(mt * 64 + m) * LDP + PG0 + br * 1024 + nt * 128 + n);
                    tot[i][j][0] += bflo(gu.x) * acc[i][j][0]; tot[i][j][1] += bfhi(gu.x) * acc[i][j][1];
                    tot[i][j][2] += bflo(gu.y) * acc[i][j][2]; tot[i][j][3] += bfhi(gu.y) * acc[i][j][3];
                }
        }
        acc_foreach<2>(tot, [&](int m, int n, const f32x4& v) { store_bf16x4(MG + (size_t)(mt * 64 + m) * 1024 + nt * 128 + n, v); });
    }
}
__device__ __forceinline__ void ph_out(const Params& p, int l, char* smem) {
    const bf16_t* MG = (const bf16_t*)(p.ws + O_H); const bf16_t* W = (const bf16_t*)(p.ws + O_WB + W_OUT);
    float* xcur = (float*)(p.ws + O_XCUR); const float* mod = (const float*)(p.ws + O_MOD);
    const int nmt = (l < NLAYER - 1) ? RT / 64 : RL / 64;
    for (int it = blockIdx.x; it < nmt * 8; it += gridDim.x) {
        const int mt = it >> 3, nt = it & 7;
        f32x4 acc[2][4];
        RPPlain rp{MG + (size_t)mt * 64 * 1024, 1024};
        gemm_core_g<2>(rp, W + (size_t)nt * 128 * 1024, 1024, 1024, acc, smem);
        acc_foreach<2>(acc, [&](int m, int n, const f32x4& v) {
            const int row = mt * 64 + m, col = nt * 128 + n;
            const float4 g = *(const float4*)(mod + (size_t)(l * 5 + modidx(row)) * 6144 + 2048 + col);
            float4* xp = (float4*)(xcur + (size_t)row * 1024 + col);
            float4 x = *xp; x.x += g.x * v[0]; x.y += g.y * v[1]; x.z += g.z * v[2]; x.w += g.w * v[3]; *xp = x;
        });
    }
}

__device__ __forceinline__ void ph_n2(const Params& p, int l, char* smem) {
    const int tid = tidx(), lane = tid & 63, wave = tid >> 6;
    unsigned* lcnt = (unsigned*)smem;
    unsigned* gbase = lcnt + 16;
    int* rec = (int*)(smem + 256);
    float4* rwl = (float4*)(smem + 8192);
    for (int idx = tid; idx < 4096; idx += 256) {
        const int k = idx >> 2, pp = idx & 3;
        rwl[(((k >> 8) * 16 + (k & 3) * 4 + pp) << 6) + ((k & 255) >> 2)] = *(const float4*)(p.in[I_RW] + (size_t)k * 16 + pp * 4);
    }
    if (tid < 16) lcnt[tid] = 0u;
    __syncthreads();
    int nrec = 0;
    const float* xcur = (const float*)(p.ws + O_XCUR); const float* mod = (const float*)(p.ws + O_MOD);
    bf16_t* H = (bf16_t*)(p.ws + O_H);
    unsigned* cnt = (unsigned*)(p.ws + O_CNT); int* LTOK = (int*)(p.ws + O_LTOK); float* LW = (float*)(p.ws + O_LW); int* SLOT = (int*)(p.ws + O_SLOT);
    const float* g = p.in[I_N2G] + l * 1024; const float* rw = p.in[I_RW]; const float* rb = p.in[I_RB];
    const int nrows = (l < NLAYER - 1) ? RT : RL;
    for (int row = blockIdx.x * 4 + wave; row < nrows; row += gridDim.x * 4) {
        const float* x = xcur + (size_t)row * 1024; const float* md = mod + (size_t)(l * 5 + modidx(row)) * 6144;
        float4 v[4]; float ss = 0.f;
#pragma unroll
        for (int i = 0; i < 4; ++i) { v[i] = *(const float4*)(x + lane * 4 + 256 * i); ss += v[i].x * v[i].x + v[i].y * v[i].y + v[i].z * v[i].z + v[i].w * v[i].w; }
        ss = wsum(ss);
        const float rstd = rsqrtf(ss * (1.f / 1024.f) + 1e-6f);
        float lg[16];
#pragma unroll
        for (int e = 0; e < 16; ++e) lg[e] = 0.f;
#pragma unroll
        for (int i = 0; i < 4; ++i) {
            const int c = lane * 4 + 256 * i;
            const float4 gg = *(const float4*)(g + c), sc = *(const float4*)(md + 4096 + c), sh = *(const float4*)(md + 3072 + c);
            const float hv[4] = {v[i].x * rstd * gg.x * (1.f + sc.x) + sh.x, v[i].y * rstd * gg.y * (1.f + sc.y) + sh.y,
                                 v[i].z * rstd * gg.z * (1.f + sc.z) + sh.z, v[i].w * rstd * gg.w * (1.f + sc.w) + sh.w};
            f32x4 h4 = {hv[0], hv[1], hv[2], hv[3]};
            store_bf16x4(H + (size_t)row * 1024 + c, h4);
#pragma unroll
            for (int j = 0; j < 4; ++j) {
                const float4* wr_ = rwl + ((i * 16 + j * 4) << 6) + lane;
                const float4 w0 = wr_[0], w1 = wr_[64], w2 = wr_[128], w3 = wr_[192];
                lg[0] += hv[j] * w0.x; lg[1] += hv[j] * w0.y; lg[2] += hv[j] * w0.z; lg[3] += hv[j] * w0.w;
                lg[4] += hv[j] * w1.x; lg[5] += hv[j] * w1.y; lg[6] += hv[j] * w1.z; lg[7] += hv[j] * w1.w;
                lg[8] += hv[j] * w2.x; lg[9] += hv[j] * w2.y; lg[10] += hv[j] * w2.z; lg[11] += hv[j] * w2.w;
                lg[12] += hv[j] * w3.x; lg[13] += hv[j] * w3.y; lg[14] += hv[j] * w3.z; lg[15] += hv[j] * w3.w;
            }
        }
        float sc_[16], sel[16];
#pragma unroll
        for (int e = 0; e < 16; ++e) { lg[e] = wsum(lg[e]); sc_[e] = 1.f / (1.f + expf(-lg[e])); sel[e] = sc_[e] + rb[e]; }
        int best = 0; float bestv = -1e30f;
#pragma unroll
        for (int gi = 0; gi < 4; ++gi) {
            float m1 = -1e30f, m2 = -1e30f;
#pragma unroll
            for (int j = 0; j < 4; ++j) { const float s = sel[gi * 4 + j]; if (s > m1) { m2 = m1; m1 = s; } else if (s > m2) m2 = s; }
            const float gs = m1 + m2;
            if (gs > bestv) { bestv = gs; best = gi; }
        }
        float s4[4] = {0.f, 0.f, 0.f, 0.f}, c4[4] = {0.f, 0.f, 0.f, 0.f};
#pragma unroll
        for (int gi = 0; gi < 4; ++gi)
#pragma unroll
            for (int j = 0; j < 4; ++j) if (gi == best) { s4[j] = sel[gi * 4 + j]; c4[j] = sc_[gi * 4 + j]; }
        int i1 = 0; float v1 = s4[0], w1 = c4[0];
#pragma unroll
        for (int j = 1; j < 4; ++j) if (s4[j] > v1) { v1 = s4[j]; i1 = j; w1 = c4[j]; }
        int i2 = -1; float v2 = -1e30f, w2 = 0.f;
#pragma unroll
        for (int j = 0; j < 4; ++j) if (j != i1 && s4[j] > v2) { v2 = s4[j]; i2 = j; w2 = c4[j]; }
        if (lane == 0) {
            const float inv = 1.f / (w1 + w2);
            const int e1 = best * 4 + i1, e2 = best * 4 + i2;
            const unsigned r1 = atomicAdd(&lcnt[e1], 1u), r2 = atomicAdd(&lcnt[e2], 1u);
            int* rc = rec + (wave * 32 + nrec) * 8;
            rc[0] = row; rc[1] = e1; rc[2] = e2; rc[3] = (int)r1; rc[4] = (int)r2; rc[5] = __float_as_int(w1 * inv); rc[6] = __float_as_int(w2 * inv);
        }
        ++nrec;
    }
    __syncthreads();
    if (tid < 16) gbase[tid] = lcnt[tid] ? atomicAdd(&cnt[tid], lcnt[tid]) : 0u;
    __syncthreads();
    for (int i = lane; i < nrec; i += 64) {
        const int* rc = rec + (wave * 32 + i) * 8;
        const int row = rc[0], e1 = rc[1], e2 = rc[2];
        const unsigned p1 = gbase[e1] + (unsigned)rc[3], p2 = gbase[e2] + (unsigned)rc[4];
        LTOK[(size_t)e1 * RT + p1] = row; LW[(size_t)e1 * RT + p1] = __int_as_float(rc[5]);
        LTOK[(size_t)e2 * RT + p2] = row; LW[(size_t)e2 * RT + p2] = __int_as_float(rc[6]);
        SLOT[row * 2] = (e1 << 20) | (int)p1; SLOT[row * 2 + 1] = (e2 << 20) | (int)p2;
    }
}

struct MoeTiles { int tb[17]; int sm; };
__device__ __forceinline__ void moe_tiles(const Params& p, int l, int* s_tb) {
    if (tidx() == 0) {
        const unsigned* cnt = (const unsigned*)(p.ws + O_CNT);
        int a = 0;
        for (int e = 0; e < 16; ++e) { s_tb[e] = a; a += ((int)cnt[e] + 127) >> 7; }
        s_tb[16] = a;
    }
    __syncthreads();
}
struct ALGather {
    const bf16_t* p[4]; bool ok[4];
    __device__ __forceinline__ uint4 load(int i, int k) const { return ok[i] ? *(const uint4*)(p[i] + k) : make_uint4(0u, 0u, 0u, 0u); }
};
struct ALSwiglu {
    const bf16_t* p[4]; float w[4];
    __device__ __forceinline__ uint4 load(int i, int k) const {
        float g[8], u[8], o[8]; unpack8(*(const uint4*)(p[i] + k), g); unpack8(*(const uint4*)(p[i] + 512 + k), u);
#pragma unroll
        for (int j = 0; j < 8; ++j) o[j] = siluf_(g[j]) * u[j] * w[i];
        return pack8(o);
    }
};
__device__ __forceinline__ void ph_e1(const Params& p, int l, char* smem) {
    int* s_tb = (int*)(smem + 73728);
    moe_tiles(p, l, s_tb);
    const bf16_t* H = (const bf16_t*)(p.ws + O_H); bf16_t* ACT = (bf16_t*)(p.ws + O_P);
    const unsigned* cnt = (const unsigned*)(p.ws + O_CNT); const int* LTOK = (const int*)(p.ws + O_LTOK); const float* LW = (const float*)(p.ws + O_LW);
    const int sm = (l < NLAYER - 1) ? RT / 128 : RL / 128;
    const int total = (sm + s_tb[16]) * 8;
    for (int it = blockIdx.x; it < total; it += gridDim.x) {
        const int mt = it >> 3, nt = it & 7;
        int e = 16, erow0 = mt * 128, lt = 0;
        if (mt >= sm) { const int q = mt - sm; e = 0; while (q >= s_tb[e + 1]) ++e; lt = q - s_tb[e]; erow0 = RT + q * 128; }
        const int cnte = (e == 16) ? 0 : (int)cnt[e];
        auto rp = [&](int r) -> const bf16_t* {
            if (e == 16) return H + (size_t)(mt * 128 + r) * 1024;
            const int idx = lt * 128 + r;
            const int tok = idx < cnte ? LTOK[(size_t)e * RT + idx] : 0;
            return H + (size_t)tok * 1024;
        };
        f32x4 acc[4][4];
        gemm_core_g<4>(rp, (const bf16_t*)(p.ws + O_WB + W_GU) + (size_t)e * 1024 * 1024 + (size_t)nt * 128 * 1024, 1024, 1024, acc, smem);
        {
            const int lane = tidx() & 63, wave = tidx() >> 6, wr = wave >> 1, wc = wave & 1, fr = lane & 15, fq = lane >> 4;
            float* U = (float*)smem;
            if (wc == 1) {
#pragma unroll
                for (int i = 0; i < 4; ++i)
#pragma unroll
                    for (int j = 0; j < 4; ++j) *(f32x4*)(U + (wr * 64 + i * 16 + fr) * 68 + j * 16 + fq * 4) = acc[i][j];
            }
            __syncthreads();
            if (wc == 0) {
#pragma unroll
                for (int i = 0; i < 4; ++i) {
                    const int m = wr * 64 + i * 16 + fr;
                    float wgt = 1.f;
                    if (e != 16) { const int idx = lt * 128 + m; wgt = idx < cnte ? LW[(size_t)e * RT + idx] : 0.f; }
#pragma unroll
                    for (int j = 0; j < 4; ++j) {
                        const f32x4 u = *(const f32x4*)(U + m * 68 + j * 16 + fq * 4);
                        f32x4 o;
#pragma unroll
                        for (int r = 0; r < 4; ++r) o[r] = siluf_(acc[i][j][r]) * u[r] * wgt;
                        store_bf16x4(ACT + (size_t)(erow0 + m) * 512 + nt * 64 + j * 16 + fq * 4, o);
                    }
                }
            }
            __syncthreads();
        }
    }
}
__device__ __forceinline__ void ph_e2(const Params& p, int l, char* smem) {
    int* s_tb = (int*)(smem + 73728);
    moe_tiles(p, l, s_tb);
    const bf16_t* ACT = (const bf16_t*)(p.ws + O_P); bf16_t* YE = (bf16_t*)(p.ws + O_X + X_YE);
    const int sm = (l < NLAYER - 1) ? RT / 128 : RL / 128;
    const int total = (sm + s_tb[16]) * 8;
    for (int it = blockIdx.x; it < total; it += gridDim.x) {
        const int mt = it >> 3, nt = it & 7;
        int e = 16, erow0 = mt * 128;
        if (mt >= sm) { const int q = mt - sm; e = 0; while (q >= s_tb[e + 1]) ++e; erow0 = RT + q * 128; }
        RPPlain rp{ACT + (size_t)erow0 * 512, 512};
        f32x4 acc[4][4];
        gemm_core_g<4>(rp, (const bf16_t*)(p.ws + O_WB + W_D) + (size_t)e * 1024 * 512 + (size_t)nt * 128 * 512, 512, 512, acc, smem);
        acc_foreach<4>(acc, [&](int m, int n, const f32x4& v) { store_bf16x4(YE + (size_t)(erow0 + m) * 1024 + nt * 128 + n, v); });
    }
}
__device__ __forceinline__ void ph_e3(const Params& p, int l, char* smem) {
    int* s_tb = (int*)(smem + 73728);
    moe_tiles(p, l, s_tb);
    const int lane = tidx() & 63, wave = tidx() >> 6;
    const bf16_t* YE = (const bf16_t*)(p.ws + O_X + X_YE); const int* SLOT = (const int*)(p.ws + O_SLOT);
    float* xcur = (float*)(p.ws + O_XCUR); const float* mod = (const float*)(p.ws + O_MOD);
    bf16_t* H = (bf16_t*)(p.ws + O_H);
    const bool last = l == NLAYER - 1;
    const int nrows = last ? RL : RT;
    const float* gn = last ? p.in[I_FNG] : p.in[I_N1G] + (l + 1) * 1024;
    for (int row = blockIdx.x * 4 + wave; row < nrows; row += gridDim.x * 4) {
        const int s1 = SLOT[row * 2], s2 = SLOT[row * 2 + 1];
        const size_t r0 = row, r1 = (size_t)RT + s_tb[s1 >> 20] * 128 + (s1 & 0xfffff), r2 = (size_t)RT + s_tb[s2 >> 20] * 128 + (s2 & 0xfffff);
        const float* g2 = mod + (size_t)(l * 5 + modidx(row)) * 6144 + 5120;
        float xv[2][8]; float ss = 0.f;
#pragma unroll
        for (int i = 0; i < 2; ++i) {
            const int c = lane * 8 + 512 * i;
            float a[8], b[8], d[8];
            unpack8(*(const uint4*)(YE + r0 * 1024 + c), a); unpack8(*(const uint4*)(YE + r1 * 1024 + c), b); unpack8(*(const uint4*)(YE + r2 * 1024 + c), d);
            float4* xp = (float4*)(xcur + (size_t)row * 1024 + c);
            const float4 x0 = xp[0], x1 = xp[1];
            const float4 ga = *(const float4*)(g2 + c), gb = *(const float4*)(g2 + c + 4);
            const float xo[8] = {x0.x, x0.y, x0.z, x0.w, x1.x, x1.y, x1.z, x1.w}, gg[8] = {ga.x, ga.y, ga.z, ga.w, gb.x, gb.y, gb.z, gb.w};
#pragma unroll
            for (int e = 0; e < 8; ++e) { xv[i][e] = xo[e] + gg[e] * (a[e] + b[e] + d[e]); ss += xv[i][e] * xv[i][e]; }
            if (!last) { xp[0] = make_float4(xv[i][0], xv[i][1], xv[i][2], xv[i][3]); xp[1] = make_float4(xv[i][4], xv[i][5], xv[i][6], xv[i][7]); }
        }
        ss = wsum(ss);
        const float rstd = rsqrtf(ss * (1.f / 1024.f) + 1e-6f);
        const float* md = mod + (size_t)((l + 1) * 5 + modidx(row)) * 6144;
#pragma unroll
        for (int i = 0; i < 2; ++i) {
            const int c = lane * 8 + 512 * i;
            const float4 n0 = *(const float4*)(gn + c), n1 = *(const float4*)(gn + c + 4);
            const float nn[8] = {n0.x, n0.y, n0.z, n0.w, n1.x, n1.y, n1.z, n1.w};
            if (last) {
                float* op = p.out + (size_t)row * 1024 + c;
                *(float4*)op = make_float4(xv[i][0] * rstd * nn[0], xv[i][1] * rstd * nn[1], xv[i][2] * rstd * nn[2], xv[i][3] * rstd * nn[3]);
                *(float4*)(op + 4) = make_float4(xv[i][4] * rstd * nn[4], xv[i][5] * rstd * nn[5], xv[i][6] * rstd * nn[6], xv[i][7] * rstd * nn[7]);
            } else {
                const float4 c0 = *(const float4*)(md + 1024 + c), c1 = *(const float4*)(md + 1024 + c + 4), h0 = *(const float4*)(md + c), h1 = *(const float4*)(md + c + 4);
                const float sc[8] = {c0.x, c0.y, c0.z, c0.w, c1.x, c1.y, c1.z, c1.w}, sh[8] = {h0.x, h0.y, h0.z, h0.w, h1.x, h1.y, h1.z, h1.w};
                float o[8];
#pragma unroll
                for (int e = 0; e < 8; ++e) o[e] = xv[i][e] * rstd * nn[e] * (1.f + sc[e]) + sh[e];
                *(uint4*)(H + (size_t)row * 1024 + c) = pack8(o);
            }
        }
    }
}
__device__ __forceinline__ void ph_final(const Params& p) {
    const int lane = tidx() & 63, wave = tidx() >> 6;
    const float* xcur = (const float*)(p.ws + O_XCUR); const float* g = p.in[I_FNG];
    for (int row = blockIdx.x * 4 + wave; row < RL; row += gridDim.x * 4) {
        const float* x = xcur + (size_t)row * 1024;
        float4 v[4]; float ss = 0.f;
#pragma unroll
        for (int i = 0; i < 4; ++i) { v[i] = *(const float4*)(x + lane * 4 + 256 * i); ss += v[i].x * v[i].x + v[i].y * v[i].y + v[i].z * v[i].z + v[i].w * v[i].w; }
        ss = wsum(ss);
        const float rstd = rsqrtf(ss * (1.f / 1024.f) + 1e-6f);
#pragma unroll
        for (int i = 0; i < 4; ++i) {
            const int c = lane * 4 + 256 * i; const float4 gg = *(const float4*)(g + c);
            *(float4*)(p.out + (size_t)row * 1024 + c) = make_float4(v[i].x * rstd * gg.x, v[i].y * rstd * gg.y, v[i].z * rstd * gg.z, v[i].w * rstd * gg.w);
        }
    }
}

constexpr int LDS_BYTES = 76800;
constexpr int NIV = 19;
extern __shared__ __attribute__((aligned(16))) char dynsmem[];
template <int ID> __device__ __forceinline__ void run_iv(const Params& pin, int l, char* smem) {
    Params p = pin; p.ws = launder(pin.ws);
    if constexpr (ID == 0) { ph_pre(p, smem); __syncthreads(); ph_w(p, 0, smem); }
    else if constexpr (ID == 1) ph_n1(p, l);
    else if constexpr (ID == 2) ph_g1(p, smem);
    else if constexpr (ID == 3) { ph_qu(p, smem); ph_rp1(p, l, smem); ph_rp2(p, l); ph_f1(p, l, smem); }
    else if constexpr (ID == 4) ph_m2(p, smem);
    else if constexpr (ID == 5) {
        const bool r1first = (blockIdx.x >> 8) & 1;
#pragma unroll 1
        for (int pass = 0; pass < 2; ++pass) {
            if ((pass == 0) == r1first) { ph_r1(p, l, smem); ph_fa(p, smem); } else ph_at(p, l, smem);
            __syncthreads();
        }
    }
    else if constexpr (ID == 6) { }
    else if constexpr (ID == 7) { }
    else if constexpr (ID == 8) { ph_r2(p, smem); __syncthreads(); ph_fb(p, l, smem); }
    else if constexpr (ID == 9) ph_r3(p);
    else if constexpr (ID == 10) ph_rpost(p, l);
    else if constexpr (ID == 11) { }
    else if constexpr (ID == 12) ph_mg(p, l, smem);
    else if constexpr (ID == 13) ph_out(p, l, smem);
    else if constexpr (ID == 14) ph_n2(p, l, smem);
    else if constexpr (ID == 15) ph_e1(p, l, smem);
    else if constexpr (ID == 16) ph_e2(p, l, smem);
    else if constexpr (ID == 17) { ph_e3(p, l, smem); __syncthreads(); if (l + 1 < NLAYER) ph_w(p, l + 1, smem); }
    else ph_final(p);
}
#if MEGA
#ifndef PROBE_MASK
#define PROBE_MASK 0
#define PROBE_REP 1
#endif
#define IV(ID) for (int r_ = 0; r_ < (((PROBE_MASK >> (ID)) & 1) ? PROBE_REP : 1); ++r_) { run_iv<ID>(p, l, smem); xcd_barrier(bar); }
__global__ void __launch_bounds__(256, 2) k_mega(Params p) {
    char* smem = dynsmem;
    volatile LAS unsigned* st = (volatile LAS unsigned*)(smem + LDS_BYTES - 16);
    if (tidx() == 0) { st[0] = 0u; st[1] = 0u; }
    __syncthreads();
    XcdBarrier bar = xcd_barrier_post((unsigned*)(p.ws + O_BAR), st);
    { const int l = 0; IV(0) }
    for (int l = 0; l < NLAYER; ++l) {
        if (l == 0) { IV(1) } IV(2) IV(3) IV(4) IV(5) IV(8) IV(9) IV(10) IV(12) IV(13) IV(14) IV(15) IV(16) IV(17)
    }
}
#else
template <int ID> __global__ void __launch_bounds__(256, 2) k_iv(Params p, int l) { run_iv<ID>(p, l, dynsmem); }
template <int ID> static void launch_iv(const Params& p, int l, int grid, hipStream_t s) {
    static bool once = false; if (!once) { once = true; (void)hipFuncSetAttribute((const void*)k_iv<ID>, hipFuncAttributeMaxDynamicSharedMemorySize, LDS_BYTES); }
    hipLaunchKernelGGL(k_iv<ID>, dim3(grid), dim3(256), LDS_BYTES, s, p, l);
}
#endif

extern "C" void kernel_launch(void* const* d_in, const int* in_sizes, int n_in, void* d_out, int out_size, void* d_ws, size_t ws_size, hipStream_t stream) {
    (void)in_sizes; (void)out_size;
    if (n_in < N_IN || ws_size < WS_NEED) return;
    Params p{};
    for (int i = 0; i < N_IN; ++i) p.in[i] = (const float*)d_in[i];
    p.out = (float*)d_out; p.ws = (char*)d_ws;
    static int grid = 0;
    if (!grid) {
        int dev = 0, cus = 0; (void)hipGetDevice(&dev); (void)hipDeviceGetAttribute(&cus, hipDeviceAttributeMultiprocessorCount, dev);
        int per_cu = 2;
#if MEGA
        (void)hipFuncSetAttribute((const void*)k_mega, hipFuncAttributeMaxDynamicSharedMemorySize, LDS_BYTES);
        int occ = 0; (void)hipOccupancyMaxActiveBlocksPerMultiprocessor(&occ, k_mega, 256, LDS_BYTES);
        if (occ < per_cu) per_cu = occ;
        if (per_cu < 1) per_cu = 1;
#endif
        grid = cus * per_cu;
    }
#if MEGA
    (void)hipMemsetAsync(p.ws + O_BAR, 0, 16384, stream);
    hipLaunchKernelGGL(k_mega, dim3(grid), dim3(256), LDS_BYTES, stream, p);
#else
    launch_iv<0>(p, 0, grid, stream);
    for (int l = 0; l < NLAYER; ++l) {
        if (l == 0) launch_iv<1>(p, l, grid, stream); launch_iv<2>(p, l, grid, stream); launch_iv<3>(p, l, grid, stream); launch_iv<4>(p, l, grid, stream);
        launch_iv<5>(p, l, grid, stream); launch_iv<8>(p, l, grid, stream);
        launch_iv<9>(p, l, grid, stream); launch_iv<10>(p, l, grid, stream); launch_iv<12>(p, l, grid, stream);
        launch_iv<13>(p, l, grid, stream); launch_iv<14>(p, l, grid, stream); launch_iv<15>(p, l, grid, stream); launch_iv<16>(p, l, grid, stream); launch_iv<17>(p, l, grid, stream);
    }
#endif
}
```

```cpp
#include <hip/hip_runtime.h>
#include <stdint.h>

#ifndef MEGA
#define MEGA 1
#endif

typedef unsigned short bf16_t;
typedef short bf16x8 __attribute__((ext_vector_type(8)));
typedef float f32x4 __attribute__((ext_vector_type(4)));
typedef float f32x2 __attribute__((ext_vector_type(2)));
typedef unsigned u32x4 __attribute__((ext_vector_type(4)));
typedef __bf16 bf16v2 __attribute__((ext_vector_type(2)));

constexpr int NLAYER = 4;
constexpr int DM = 1024;
constexpr int RL = 16384, RC = 1024, RT = RL + RC;
constexpr int SEQ = 4096, CTX = 256, KEYS = SEQ + CTX;
constexpr int LDP = 6144;
constexpr int PQ0 = 512, PKV0 = 896, PKR0 = 1152, PR0 = 1184, PG0 = 2976, PEND = 6048;
constexpr int NEXP = 16;
constexpr int EROWS = 54272;

enum { I_X = 0, I_C, I_CTX, I_CCTX, I_WADA, I_BADA, I_N1G, I_N2G, I_WIN, I_QNG, I_KVNG, I_WUQ, I_WUKV, I_MU, I_W0, I_WUP, I_A0, I_AUP, I_GUP,
       I_KK, I_KA, I_RK, I_GNG, I_GNB, I_WPA, I_WPB, I_WPC, I_WOUT, I_RW, I_RB, I_EG, I_EU, I_ED, I_SG, I_SU, I_SD, I_FNG, N_IN };

struct Params { const float* in[N_IN]; float* out; char* ws; };

constexpr size_t al256(size_t x) { return (x + 255) & ~(size_t)255; }
constexpr size_t O_BAR   = 0;
constexpr size_t O_CNT   = O_BAR + 16384;
constexpr size_t O_MOD   = O_CNT + 4096;
constexpr size_t O_ROPEC = O_MOD + (size_t)NLAYER * 5 * 6144 * 4;
constexpr size_t O_ROPES = O_ROPEC + (size_t)SEQ * 16 * 4;
constexpr size_t O_CSC   = O_ROPES + (size_t)SEQ * 16 * 4;
constexpr size_t O_CST256= O_CSC + 256 * 128 * 2;
constexpr size_t O_D128  = O_CST256 + 256 * 512 * 2;
constexpr size_t O_E64   = O_D128 + 128 * 128 * 2;
constexpr size_t O_TWC   = O_E64 + 64 * 128 * 2;
constexpr size_t O_TWS   = O_TWC + 64 * 64 * 4;
constexpr size_t O_YT2   = O_TWS + 64 * 64 * 4;
constexpr size_t O_A2    = O_YT2 + (size_t)4 * 512 * 64 * 128 * 2;
constexpr size_t O_YTC   = O_A2 + (size_t)4 * 512 * 64 * 128 * 2;
constexpr size_t O_XCUR  = O_YTC + (size_t)4 * 512 * 512 * 2;
constexpr size_t O_WB    = O_XCUR + (size_t)RT * DM * 4;
constexpr size_t W_IN   = 0;
constexpr size_t W_UQ   = W_IN + (size_t)6144 * 1024 * 2;
constexpr size_t W_UKV  = W_UQ + (size_t)768 * 384 * 2;
constexpr size_t W_WUP  = W_UKV + (size_t)1024 * 256 * 2;
constexpr size_t W_AUP  = W_WUP + (size_t)2 * 512 * 64 * 2;
constexpr size_t W_GUP  = W_AUP + (size_t)2 * 512 * 64 * 2;
constexpr size_t W_PA   = W_GUP + (size_t)512 * 128 * 2;
constexpr size_t W_PB   = W_PA + (size_t)1024 * 512 * 2;
constexpr size_t W_PC   = W_PB + (size_t)1024 * 512 * 2;
constexpr size_t W_OUT  = W_PC + (size_t)1024 * 512 * 2;
constexpr size_t W_GU   = W_OUT + (size_t)1024 * 1024 * 2;
constexpr size_t W_D    = W_GU + (size_t)17 * 1024 * 1024 * 2;
constexpr size_t W_END  = W_D + (size_t)17 * 1024 * 512 * 2;
constexpr size_t O_H    = O_WB + W_END;
constexpr size_t O_P    = O_H + (size_t)RT * DM * 2;
constexpr size_t O_ATT  = O_P + (size_t)RT * LDP * 2;
constexpr size_t O_RG   = O_ATT + (size_t)RT * 512 * 2;
constexpr size_t O_RWO  = O_RG + (size_t)RT * 512 * 2;
constexpr size_t O_FA   = O_RWO + (size_t)RT * 512 * 2;
constexpr size_t O_LTOK = O_FA + (size_t)RT * 512 * 2;
constexpr size_t O_LW   = O_LTOK + (size_t)NEXP * RT * 4;
constexpr size_t O_SLOT = O_LW + (size_t)NEXP * RT * 4;
constexpr size_t O_X    = al256(O_SLOT + (size_t)RT * 2 * 4);
constexpr size_t X_QA   = 0;
constexpr size_t X_KA   = X_QA + (size_t)RT * 768 * 2;
constexpr size_t X_VA   = X_KA + (size_t)4 * KEYS * 768 * 2;
constexpr int NCP = 4 * 8 * 2 * 68;
constexpr size_t X_S0   = 0;
constexpr size_t X_MT   = X_VA + (size_t)4 * 8 * 64 * KEYS * 2;
constexpr size_t X_GT   = X_MT + (size_t)NCP * 8192;
constexpr size_t X_YL   = X_GT + (size_t)NCP * 8192;
constexpr size_t X_QRAW = X_MT;
constexpr size_t X_KVRAW= X_QRAW + (size_t)RT * 768 * 2;
constexpr size_t X_KKN  = X_YL + (size_t)NCP * 8192;
constexpr size_t X_BON  = X_KKN + (size_t)RT * 8 * 4;
constexpr size_t X_END  = X_BON + (size_t)2 * RT * 8 * 4;
static_assert(X_KVRAW + (size_t)RT * 1024 * 2 <= X_YL + (size_t)NCP * 8192, "raw q/kv must fit under the chunk data");
static_assert(X_S0 + (size_t)NCP * 8192 <= X_VA, "S0 must fit in the q/k area");
constexpr size_t X_YE   = 0;
constexpr size_t WS_NEED = O_X + X_END;

__device__ __forceinline__ float bf2f(bf16_t u) { return __builtin_bit_cast(float, (unsigned)u << 16); }
__device__ __forceinline__ float bflo(unsigned u) { return __builtin_bit_cast(float, u << 16); }
__device__ __forceinline__ float bfhi(unsigned u) { return __builtin_bit_cast(float, u & 0xffff0000u); }
__device__ __forceinline__ unsigned pack2(float lo, float hi) { f32x2 v = {lo, hi}; bf16v2 b = __builtin_convertvector(v, bf16v2); return __builtin_bit_cast(unsigned, b); }
__device__ __forceinline__ bf16_t f2bf(float f) { return (bf16_t)(pack2(f, 0.f) & 0xffffu); }
__device__ __forceinline__ float wsum(float v) {
#pragma unroll
    for (int o = 32; o > 0; o >>= 1) v += __shfl_xor(v, o);
    return v;
}
__device__ __forceinline__ float sigmoidf_(float x) { return 1.f / (1.f + __expf(-x)); }
__device__ __forceinline__ float siluf_(float x) { return x / (1.f + __expf(-x)); }
__device__ __forceinline__ int modidx(int row) { return row < RL ? (row >> 12) : 4; }
__device__ __forceinline__ void unpack8(const uint4& u, float (&f)[8]) {
    f[0] = bflo(u.x); f[1] = bfhi(u.x); f[2] = bflo(u.y); f[3] = bfhi(u.y); f[4] = bflo(u.z); f[5] = bfhi(u.z); f[6] = bflo(u.w); f[7] = bfhi(u.w);
}
__device__ __forceinline__ uint4 pack8(const float (&f)[8]) { return make_uint4(pack2(f[0], f[1]), pack2(f[2], f[3]), pack2(f[4], f[5]), pack2(f[6], f[7])); }

#define XB_TMO      128
#define XB_XCNT(j)  (256  + 64 * (j))
#define XB_XSUB(j)  (1280 + 64 * (j))
#define XB_XGEN(j)  (2304 + 64 * (j))
#define XB_TOP      3328
#define XB_TOPGEN   3392
#define XCD_BAR_WORDS 3456
#define XB_SPIN_CAP (1u << 22)
#define LAS __attribute__((address_space(3)))
__device__ __forceinline__ unsigned xb_ld(unsigned* p)              { return __hip_atomic_load(p, __ATOMIC_RELAXED, __HIP_MEMORY_SCOPE_AGENT); }
__device__ __forceinline__ unsigned xb_add(unsigned* p, unsigned v) { return __hip_atomic_fetch_add(p, v, __ATOMIC_RELAXED, __HIP_MEMORY_SCOPE_AGENT); }
__device__ __forceinline__ unsigned xb_xcc_id() { return (unsigned)__builtin_amdgcn_s_getreg((3 << 11) | 20) & 0xFu; }
#define XB_SPIN(cond, bar) do { unsigned _sp = 0; while (cond) { __builtin_amdgcn_s_sleep(1); \
    if ((++_sp & 255u) == 0u) { if (xb_ld(&(bar)[XB_TMO])) break; if (_sp > XB_SPIN_CAP) { atomicAdd(&(bar)[XB_TMO], 1u); break; } } } } while (0)
struct XcdBarrier { unsigned* bar; unsigned x; volatile LAS unsigned* st; };
__device__ __forceinline__ XcdBarrier xcd_barrier_post(unsigned* bar, volatile LAS unsigned* st) {
    XcdBarrier b; b.bar = bar; b.x = xb_xcc_id(); b.st = st;
    if (threadIdx.x == 0) (void)xb_add(&bar[XB_XCNT(b.x)], 1u);
    return b;
}
__device__ __forceinline__ void xcd_barrier_complete(unsigned* bar, unsigned x, unsigned& nloc, unsigned& nx) {
    const unsigned G = gridDim.x * gridDim.y * gridDim.z;
    unsigned sum, cnt, mine, sp = 0u;
    for (;;) {
        sum = 0u; cnt = 0u; mine = 0u;
#pragma unroll
        for (unsigned j = 0; j < 16; ++j) { const unsigned c = xb_ld(&bar[XB_XCNT(j)]); sum += c; cnt += (c > 0u) ? 1u : 0u; mine = (j == x) ? c : mine; }
        if (sum == G) break;
        __builtin_amdgcn_s_sleep(1);
        if ((++sp & 255u) == 0u) { if (xb_ld(&bar[XB_TMO])) break; if (sp > XB_SPIN_CAP) { atomicAdd(&bar[XB_TMO], 1u); break; } }
    }
    nloc = mine > 0u ? mine : 1u; nx = cnt > 0u ? cnt : 1u;
}
__device__ __forceinline__ void xcd_barrier(const XcdBarrier& b) {
    asm volatile("s_waitcnt vmcnt(0)" ::: "memory");
    __syncthreads();
    if (threadIdx.x == 0) {
        unsigned* bar = b.bar;
        __builtin_amdgcn_s_waitcnt(0);
        unsigned nloc = b.st[0], nx = b.st[1];
        if (nloc == 0u) { xcd_barrier_complete(bar, b.x, nloc, nx); b.st[0] = nloc; b.st[1] = nx; }
        const unsigned old = xb_add(&bar[XB_XSUB(b.x)], 1u);
        const unsigned gen = old / nloc;
        if (old + 1u == (gen + 1u) * nloc) {
            __builtin_amdgcn_fence(__ATOMIC_RELEASE, "agent");
            asm volatile("s_waitcnt vmcnt(0)" ::: "memory");
            const unsigned og = xb_add(&bar[XB_TOP], 1u);
            const unsigned tg = og / nx;
            if (og + 1u == (tg + 1u) * nx) xb_add(&bar[XB_TOPGEN], 1u);
            else XB_SPIN(xb_ld(&bar[XB_TOPGEN]) == tg, bar);
            __builtin_amdgcn_fence(__ATOMIC_ACQUIRE, "agent");
            xb_add(&bar[XB_XGEN(b.x)], 1u);
            asm volatile("s_waitcnt vmcnt(0)" ::: "memory");
        } else {
            XB_SPIN(xb_ld(&bar[XB_XGEN(b.x)]) == gen, bar);
            __builtin_amdgcn_fence(__ATOMIC_ACQUIRE, "agent");
            asm volatile("s_waitcnt vmcnt(0)" ::: "memory");
        }
    }
    __syncthreads();
}

__device__ __forceinline__ int tidx() { int t = threadIdx.x; asm volatile("" : "+v"(t)); return t; }
__device__ __forceinline__ int lv(int x) { asm volatile("" : "+v"(x)); return x; }
__device__ __forceinline__ char* launder(char* p) { size_t z = 0; asm volatile("" : "+s"(z)); return p + z; }

constexpr int LDSROW = 72;
template <int NA, class AL>
__device__ __forceinline__ void gc_load(const AL& al, const bf16_t* bp, size_t bstep, int k0, int kc, u32x4 (&ra)[NA], u32x4 (&rb)[4]) {
#pragma unroll
    for (int i = 0; i < NA; ++i) ra[i] = __builtin_bit_cast(u32x4, al.load(i, k0 + kc));
#pragma unroll
    for (int j = 0; j < 4; ++j) rb[j] = *(const u32x4*)(bp + j * bstep + k0);
}
template <int NA>
__device__ __forceinline__ void gc_store(bf16_t* Ab, bf16_t* Bb, int lr, int kc, const u32x4 (&ra)[NA], const u32x4 (&rb)[4]) {
#pragma unroll
    for (int i = 0; i < NA; ++i) *(u32x4*)(Ab + (lr + 32 * i) * LDSROW + kc) = ra[i];
#pragma unroll
    for (int j = 0; j < 4; ++j) *(u32x4*)(Bb + (lr + 32 * j) * LDSROW + kc) = rb[j];
}
template <int MI>
__device__ __forceinline__ void gc_compute(const bf16_t* Ac, const bf16_t* Bc, f32x4 (&acc)[MI][4]) {
#pragma unroll
    for (int kh = 0; kh < 2; ++kh) {
        bf16x8 af[MI], bfv[4];
#pragma unroll
        for (int i = 0; i < MI; ++i) af[i] = *(const bf16x8*)(Ac + i * 16 * LDSROW + kh * 32);
#pragma unroll
        for (int j = 0; j < 4; ++j) bfv[j] = *(const bf16x8*)(Bc + j * 16 * LDSROW + kh * 32);
#pragma unroll
        for (int i = 0; i < MI; ++i)
#pragma unroll
            for (int j = 0; j < 4; ++j) acc[i][j] = __builtin_amdgcn_mfma_f32_16x16x32_bf16(bfv[j], af[i], acc[i][j], 0, 0, 0);
    }
}
template <int MI, class AL>
__device__ __forceinline__ void gemm_core(const AL& al, const bf16_t* __restrict__ Bt, int ldb, int K, f32x4 (&acc)[MI][4], char* smem) {
    constexpr int TM = MI * 32;
    constexpr int NA = TM / 32;
    bf16_t* As = (bf16_t*)smem;
    bf16_t* Bs = As + 2 * TM * LDSROW;
    const int tid = tidx(), lane = tid & 63, wave = tid >> 6;
    const int wr = wave >> 1, wc = wave & 1, fr = lane & 15, fq = lane >> 4;
    const int kc = (tid & 7) * 8, lr = tid >> 3;
#pragma unroll
    for (int i = 0; i < MI; ++i)
#pragma unroll
        for (int j = 0; j < 4; ++j) acc[i][j] = (f32x4){0.f, 0.f, 0.f, 0.f};
    u32x4 a0[NA], b0[4], a1[NA], b1[4];
    const bf16_t* bp = Bt + (size_t)lr * ldb + kc;
    const size_t bstep = (size_t)32 * ldb;
    const int nk = K >> 6;
    bf16_t* As1 = As + TM * LDSROW; bf16_t* Bs1 = Bs + 128 * LDSROW;
    const int aoff = (wr * MI * 16 + fr) * LDSROW + fq * 8, boff = (wc * 64 + fr) * LDSROW + fq * 8;
    gc_load<NA>(al, bp, bstep, 0, kc, a0, b0);
    gc_store<NA>(As, Bs, lr, kc, a0, b0);
    if (nk > 1) gc_load<NA>(al, bp, bstep, 64, kc, a0, b0);
    __syncthreads();
    for (int kt = 0; kt < nk; kt += 2) {
        if (kt + 2 < nk) gc_load<NA>(al, bp, bstep, (kt + 2) << 6, kc, a1, b1);
        gc_compute<MI>(As + aoff, Bs + boff, acc);
        if (kt + 1 < nk) gc_store<NA>(As1, Bs1, lr, kc, a0, b0);
        __syncthreads();
        if (kt + 1 >= nk) break;
        if (kt + 3 < nk) gc_load<NA>(al, bp, bstep, (kt + 3) << 6, kc, a0, b0);
        gc_compute<MI>(As1 + aoff, Bs1 + boff, acc);
        if (kt + 2 < nk) gc_store<NA>(As, Bs, lr, kc, a1, b1);
        __syncthreads();
    }
}
template <int MI, class RP, class RPB>
__device__ __forceinline__ void gemm_core_gb(const RP& rp, const RPB& rpb, int K, f32x4 (&acc)[MI][4], char* smem) {
    constexpr int ABYTES = MI * 32 * 128;
    constexpr int SBYTES = ABYTES + 16384;
    const int tid = tidx(), lane = tid & 63, wave = tid >> 6;
    const int wr = wave >> 1, wc = wave & 1, fr = lane & 15, fq = lane >> 4;
    const int rr = lane >> 3, cs = ((lane & 7) ^ ((wave * 4 + (lane >> 4)) & 7)) * 8;
#pragma unroll
    for (int i = 0; i < MI; ++i)
#pragma unroll
        for (int j = 0; j < 4; ++j) acc[i][j] = (f32x4){0.f, 0.f, 0.f, 0.f};
    const bf16_t* ap[MI]; const bf16_t* bp[4];
#pragma unroll
    for (int i = 0; i < MI; ++i) { const int r = (i * 4 + wave) * 8 + rr; ap[i] = rp(r) + cs; }
#pragma unroll
    for (int i = 0; i < 4; ++i) { const int r = (i * 4 + wave) * 8 + rr; bp[i] = rpb(r) + cs; }
    const int wbase = __builtin_amdgcn_readfirstlane(wave) * 1024;
    const int nk = K >> 6;
    auto stage = [&](int buf, int kt) {
        char* Ab = smem + buf * SBYTES + wbase; char* Bb = Ab + ABYTES;
#pragma unroll
        for (int i = 0; i < MI; ++i) __builtin_amdgcn_global_load_lds((const unsigned*)(ap[i] + kt * 64), (unsigned*)(Ab + i * 4096), 16, 0, 0);
#pragma unroll
        for (int i = 0; i < 4; ++i) __builtin_amdgcn_global_load_lds((const unsigned*)(bp[i] + kt * 64), (unsigned*)(Bb + i * 4096), 16, 0, 0);
    };
    const int aoff = (wr * MI * 16 + fr) * 128, boff = ABYTES + (wc * 64 + fr) * 128, sw = fr >> 1;
    stage(0, 0);
    asm volatile("s_waitcnt vmcnt(0)" ::: "memory");
    __syncthreads();
    for (int kt = 0; kt < nk; ++kt) {
        const int cur = kt & 1;
        if (kt + 1 < nk) stage(cur ^ 1, kt + 1);
        const char* base = smem + cur * SBYTES;
#pragma unroll
        for (int kh = 0; kh < 2; ++kh) {
            const int xo = ((kh * 4 + fq) ^ sw) * 16;
            bf16x8 af[MI], bfv[4];
#pragma unroll
            for (int i = 0; i < MI; ++i) af[i] = *(const bf16x8*)(base + aoff + i * 2048 + xo);
#pragma unroll
            for (int j = 0; j < 4; ++j) bfv[j] = *(const bf16x8*)(base + boff + j * 2048 + xo);
#pragma unroll
            for (int i = 0; i < MI; ++i)
#pragma unroll
                for (int j = 0; j < 4; ++j) acc[i][j] = __builtin_amdgcn_mfma_f32_16x16x32_bf16(bfv[j], af[i], acc[i][j], 0, 0, 0);
        }
        asm volatile("s_waitcnt vmcnt(0)" ::: "memory");
        __syncthreads();
    }
}
struct RPPlain;
template <int MI, class RP>
__device__ __forceinline__ void gemm_core_g(const RP& rp, const bf16_t* __restrict__ Bt, int ldb, int K, f32x4 (&acc)[MI][4], char* smem);
struct RPPlain {
    const bf16_t* A; size_t lda;
    __device__ __forceinline__ const bf16_t* operator()(int r) const { return A + (size_t)r * lda; }
};
template <int MI, class RP>
__device__ __forceinline__ void gemm_core_g(const RP& rp, const bf16_t* __restrict__ Bt, int ldb, int K, f32x4 (&acc)[MI][4], char* smem) {
    RPPlain rpb{Bt, (size_t)ldb};
    gemm_core_gb<MI>(rp, rpb, K, acc, smem);
}
template <int MI, class F>
__device__ __forceinline__ void acc_foreach(const f32x4 (&acc)[MI][4], F f) {
    const int lane = tidx() & 63, wave = tidx() >> 6;
    const int wr = wave >> 1, wc = wave & 1, fr = lane & 15, fq = lane >> 4;
#pragma unroll
    for (int i = 0; i < MI; ++i)
#pragma unroll
        for (int j = 0; j < 4; ++j) f(wr * MI * 16 + i * 16 + fr, wc * 64 + j * 16 + fq * 4, acc[i][j]);
}
struct ALPlain {
    const bf16_t* p0; size_t step;
    __device__ __forceinline__ ALPlain(const bf16_t* A, int lda, int row0) { p0 = A + (size_t)(row0 + (tidx() >> 3)) * lda; step = (size_t)32 * lda; }
    __device__ __forceinline__ uint4 load(int i, int k) const { return *(const uint4*)(p0 + i * step + k); }
};
__device__ __forceinline__ void store_bf16x4(bf16_t* dst, const f32x4& v) { *(uint2*)dst = make_uint2(pack2(v[0], v[1]), pack2(v[2], v[3])); }

__device__ __forceinline__ void ph_pre(const Params& p, char* smem) {
    const int tid = tidx(), nb = gridDim.x, bid = blockIdx.x;
    float* mod = (float*)(p.ws + O_MOD);
    {
        float* sv = (float*)smem;
        float* part = sv + 5 * 1024;
        for (int i = tid; i < 5 * 1024; i += 256) { const float v = (i < 4096) ? p.in[I_C][i] : p.in[I_CCTX][i - 4096]; sv[i] = siluf_(v); }
        __syncthreads();
        for (int it = bid; it < NLAYER * 96; it += nb) {
            const int l = it / 96, jb = it % 96;
            const int jj = tid & 63, kq = tid >> 6, j = jb * 64 + jj;
            const float* w = p.in[I_WADA] + (size_t)l * 1024 * 6144 + (size_t)(kq * 256) * 6144 + j;
            float a0 = 0.f, a1 = 0.f, a2 = 0.f, a3 = 0.f, a4 = 0.f;
#pragma unroll 8
            for (int k = 0; k < 256; ++k) {
                const float wv = w[(size_t)k * 6144]; const int kk = kq * 256 + k;
                a0 += sv[kk] * wv; a1 += sv[1024 + kk] * wv; a2 += sv[2048 + kk] * wv; a3 += sv[3072 + kk] * wv; a4 += sv[4096 + kk] * wv;
            }
            part[(kq * 5 + 0) * 64 + jj] = a0; part[(kq * 5 + 1) * 64 + jj] = a1; part[(kq * 5 + 2) * 64 + jj] = a2;
            part[(kq * 5 + 3) * 64 + jj] = a3; part[(kq * 5 + 4) * 64 + jj] = a4;
            __syncthreads();
            for (int o = tid; o < 320; o += 256) {
                const int i = o >> 6, c = o & 63;
                const float s = part[(0 * 5 + i) * 64 + c] + part[(1 * 5 + i) * 64 + c] + part[(2 * 5 + i) * 64 + c] + part[(3 * 5 + i) * 64 + c];
                mod[(size_t)(l * 5 + i) * 6144 + jb * 64 + c] = s + p.in[I_BADA][l * 6144 + jb * 64 + c];
            }
            __syncthreads();
        }
    }
    {
        float4* xc = (float4*)(p.ws + O_XCUR);
        const float4* x4 = (const float4*)p.in[I_X]; const float4* c4 = (const float4*)p.in[I_CTX];
        for (size_t i = (size_t)bid * 256 + tid; i < (size_t)RT * 256; i += (size_t)nb * 256) xc[i] = (i < (size_t)RL * 256) ? x4[i] : c4[i - (size_t)RL * 256];
    }
    {
        float* ct = (float*)smem;
        __syncthreads();
        for (int m = tid; m < 4096; m += 256) ct[m] = cospif((float)m * (1.f / 2048.f));
        __syncthreads();
        bf16_t* cst2 = (bf16_t*)(p.ws + O_CST256);
        for (int ch = bid * 256 + tid; ch < 256 * 512 / 8; ch += nb * 256) {
            const int ks = ch >> 6, c0 = (ch & 63) * 8, part = c0 >> 8, s0 = c0 & 255;
            float f[8];
#pragma unroll
            for (int e = 0; e < 8; ++e) { const int m = (16 * ks * (s0 + e)) & 4095; f[e] = part == 0 ? ct[m] : ct[(m - 1024) & 4095]; }
            *(uint4*)(cst2 + ch * 8) = pack8(f);
        }
        bf16_t* d128 = (bf16_t*)(p.ws + O_D128);
        for (int ch = bid * 256 + tid; ch < 128 * 128 / 8; ch += nb * 256) {
            const int mrow = ch >> 4, c0 = (ch & 15) * 8, po = mrow >> 6, k1 = mrow & 63, pi = c0 >> 6, t10 = c0 & 63;
            float f[8];
#pragma unroll
            for (int e = 0; e < 8; ++e) {
                const int m = (64 * k1 * (t10 + e)) & 4095; const float cv = ct[m], sv = ct[(m - 1024) & 4095];
                f[e] = (po == pi) ? cv : (po == 0 ? sv : -sv);
            }
            *(uint4*)(d128 + ch * 8) = pack8(f);
        }
        bf16_t* e64 = (bf16_t*)(p.ws + O_E64);
        for (int ch = bid * 256 + tid; ch < 64 * 128 / 8; ch += nb * 256) {
            const int k2 = ch >> 4, c0 = (ch & 15) * 8, po = c0 >> 6, t20 = c0 & 63;
            float f[8];
#pragma unroll
            for (int e = 0; e < 8; ++e) { const int m = (64 * k2 * (t20 + e)) & 4095; f[e] = po == 0 ? ct[m] : ct[(m - 1024) & 4095]; }
            *(uint4*)(e64 + ch * 8) = pack8(f);
        }
        float* twc = (float*)(p.ws + O_TWC); float* tws = (float*)(p.ws + O_TWS);
        for (int i = bid * 256 + tid; i < 64 * 64; i += nb * 256) {
            const int k1 = i >> 6, t2 = i & 63, m = (k1 * t2) & 4095;
            twc[i] = ct[m]; tws[i] = -ct[(m - 1024) & 4095];
        }
        bf16_t* csc = (bf16_t*)(p.ws + O_CSC);
        for (int ch = bid * 256 + tid; ch < 256 * 128 / 8; ch += nb * 256) {
            const int n = ch >> 4, c0 = (ch & 15) * 8, part = n >> 7, kc = n & 127;
            float f[8];
#pragma unroll
            for (int e = 0; e < 8; ++e) { const int m = (32 * kc * (c0 + e)) & 4095; f[e] = part == 0 ? ct[m] : -ct[(m - 1024) & 4095]; }
            *(uint4*)(csc + ch * 8) = pack8(f);
        }
        float* rc = (float*)(p.ws + O_ROPEC); float* rs = (float*)(p.ws + O_ROPES);
        for (int i = bid * 256 + tid; i < SEQ * 16; i += nb * 256) {
            const int t = i >> 4, ax = (i >> 3) & 1, f = i & 7;
            const float inv = powf(10000.f, -(float)f / 8.f);
            const float pos = (float)(ax == 0 ? (t >> 6) : (t & 63));
            const float ang = pos * inv;
            rc[i] = cosf(ang); rs[i] = sinf(ang);
        }
    }
}

struct ConvTask { const float* src; const float* scale; bf16_t* dst; int K, Nsrc, Ndst, rmul; size_t sbs, dbs; };
__constant__ int c_conv_cum[17] = {0, 1536, 1608, 1672, 1688, 1704, 1720, 1848, 1976, 2104, 2360, 4408, 6456, 8504, 8632, 8760, 8888};
__device__ __forceinline__ ConvTask conv_task(const Params& p, int l, int t) {
    bf16_t* wb = (bf16_t*)(p.ws + O_WB);
    ConvTask c; c.scale = nullptr; c.sbs = 0; c.dbs = 0; c.rmul = 64;
    switch (t) {
    case 0:  c.src = p.in[I_WIN] + (size_t)l * 1024 * 6048; c.K = 1024; c.Nsrc = 6048; c.Ndst = 6144; c.dst = wb + W_IN / 2; break;
    case 1:  c.src = p.in[I_WUQ] + (size_t)l * 384 * 768; c.K = 384; c.Nsrc = 768; c.Ndst = 768; c.dst = wb + W_UQ / 2; c.scale = p.in[I_QNG] + l * 384; break;
    case 2:  c.src = p.in[I_WUKV] + (size_t)l * 256 * 1024; c.K = 256; c.Nsrc = 1024; c.Ndst = 1024; c.dst = wb + W_UKV / 2; c.scale = p.in[I_KVNG] + l * 256; break;
    case 3:  c.src = p.in[I_WUP] + (size_t)l * 2 * 64 * 512; c.K = 64; c.Nsrc = 512; c.Ndst = 512; c.dst = wb + W_WUP / 2; c.sbs = 64 * 512; c.dbs = 512 * 64; break;
    case 4:  c.src = p.in[I_AUP] + (size_t)l * 2 * 64 * 512; c.K = 64; c.Nsrc = 512; c.Ndst = 512; c.dst = wb + W_AUP / 2; c.sbs = 64 * 512; c.dbs = 512 * 64; break;
    case 5:  c.src = p.in[I_GUP] + (size_t)l * 128 * 512; c.K = 128; c.Nsrc = 512; c.Ndst = 512; c.dst = wb + W_GUP / 2; break;
    case 6:  c.src = p.in[I_WPA] + (size_t)l * 512 * 1024; c.K = 512; c.Nsrc = 1024; c.Ndst = 1024; c.dst = wb + W_PA / 2; break;
    case 7:  c.src = p.in[I_WPB] + (size_t)l * 512 * 1024; c.K = 512; c.Nsrc = 1024; c.Ndst = 1024; c.dst = wb + W_PB / 2; break;
    case 8:  c.src = p.in[I_WPC] + (size_t)l * 512 * 1024; c.K = 512; c.Nsrc = 1024; c.Ndst = 1024; c.dst = wb + W_PC / 2; break;
    case 9:  c.src = p.in[I_WOUT] + (size_t)l * 1024 * 1024; c.K = 1024; c.Nsrc = 1024; c.Ndst = 1024; c.dst = wb + W_OUT / 2; break;
    case 10: c.src = p.in[I_EG] + (size_t)l * 16 * 1024 * 512; c.K = 1024; c.Nsrc = 512; c.Ndst = 512; c.dst = wb + W_GU / 2; c.sbs = 1024 * 512; c.dbs = 1024 * 1024; c.rmul = 128; break;
    case 11: c.src = p.in[I_EU] + (size_t)l * 16 * 1024 * 512; c.K = 1024; c.Nsrc = 512; c.Ndst = 512; c.dst = wb + W_GU / 2 + 64 * 1024; c.sbs = 1024 * 512; c.dbs = 1024 * 1024; c.rmul = 128; break;
    case 12: c.src = p.in[I_ED] + (size_t)l * 16 * 512 * 1024; c.K = 512; c.Nsrc = 1024; c.Ndst = 1024; c.dst = wb + W_D / 2; c.sbs = 512 * 1024; c.dbs = 1024 * 512; break;
    case 13: c.src = p.in[I_SG] + (size_t)l * 1024 * 512; c.K = 1024; c.Nsrc = 512; c.Ndst = 512; c.dst = wb + W_GU / 2 + (size_t)16 * 1024 * 1024; c.rmul = 128; break;
    case 14: c.src = p.in[I_SU] + (size_t)l * 1024 * 512; c.K = 1024; c.Nsrc = 512; c.Ndst = 512; c.dst = wb + W_GU / 2 + (size_t)16 * 1024 * 1024 + 64 * 1024; c.rmul = 128; break;
    default: c.src = p.in[I_SD] + (size_t)l * 512 * 1024; c.K = 512; c.Nsrc = 1024; c.Ndst = 1024; c.dst = wb + W_D / 2 + (size_t)16 * 1024 * 512; break;
    }
    return c;
}
__device__ __forceinline__ void ph_w(const Params& p, int l, char* smem) {
    const int tid = tidx();
    float* tl = (float*)smem;
    for (int g = blockIdx.x; g < 8888; g += gridDim.x) {
        int t = 0;
        while (g >= c_conv_cum[t + 1]) ++t;
        const ConvTask c = conv_task(p, l, t);
        int r = g - c_conv_cum[t];
        const int nkt = c.K >> 6, nnt = c.Ndst >> 6;
        const int bi = r / (nkt * nnt); r -= bi * nkt * nnt;
        const int k0 = (r / nnt) * 64, n0 = (r % nnt) * 64;
        const float* src = c.src + bi * c.sbs; bf16_t* dst = c.dst + bi * c.dbs;
#pragma unroll
        for (int i = 0; i < 4; ++i) {
            const int k = (tid >> 4) + 16 * i, n = n0 + (tid & 15) * 4;
            float4 v = make_float4(0.f, 0.f, 0.f, 0.f);
            if (n < c.Nsrc) v = *(const float4*)(src + (size_t)(k0 + k) * c.Nsrc + n);
            if (c.scale) { const float s = c.scale[k0 + k]; v.x *= s; v.y *= s; v.z *= s; v.w *= s; }
            float* d = tl + k * 65 + (tid & 15) * 4;
            d[0] = v.x; d[1] = v.y; d[2] = v.z; d[3] = v.w;
        }
        __syncthreads();
        {
            const int n = tid >> 2, kk0 = (tid & 3) * 16;
            float f[8], g2[8];
#pragma unroll
            for (int j = 0; j < 8; ++j) { f[j] = tl[(kk0 + j) * 65 + n]; g2[j] = tl[(kk0 + 8 + j) * 65 + n]; }
            bf16_t* d = dst + (size_t)((n0 >> 6) * c.rmul + n) * c.K + k0 + kk0;
            *(uint4*)d = pack8(f); *(uint4*)(d + 8) = pack8(g2);
        }
        __syncthreads();
    }
}

__device__ __forceinline__ void ph_n1(const Params& p, int l) {
    const int lane = tidx() & 63, wave = tidx() >> 6;
    const float* xcur = (const float*)(p.ws + O_XCUR); const float* mod = (const float*)(p.ws + O_MOD);
    bf16_t* H = (bf16_t*)(p.ws + O_H);
    const float* g = p.in[I_N1G] + l * 1024;
    for (int row = blockIdx.x * 4 + wave; row < RT; row += gridDim.x * 4) {
        const float* x = xcur + (size_t)row * 1024; const float* md = mod + (size_t)(l * 5 + modidx(row)) * 6144;
        float4 v[4]; float ss = 0.f;
#pragma unroll
        for (int i = 0; i < 4; ++i) { v[i] = *(const float4*)(x + lane * 4 + 256 * i); ss += v[i].x * v[i].x + v[i].y * v[i].y + v[i].z * v[i].z + v[i].w * v[i].w; }
        ss = wsum(ss);
        const float rstd = rsqrtf(ss * (1.f / 1024.f) + 1e-6f);
#pragma unroll
        for (int i = 0; i < 4; ++i) {
            const int c = lane * 4 + 256 * i;
            const float4 gg = *(const float4*)(g + c), sc = *(const float4*)(md + 1024 + c), sh = *(const float4*)(md + c);
            f32x4 h = {v[i].x * rstd * gg.x * (1.f + sc.x) + sh.x, v[i].y * rstd * gg.y * (1.f + sc.y) + sh.y,
                       v[i].z * rstd * gg.z * (1.f + sc.z) + sh.z, v[i].w * rstd * gg.w * (1.f + sc.w) + sh.w};
            store_bf16x4(H + (size_t)row * 1024 + c, h);
        }
    }
}

__device__ __forceinline__ void ph_g1(const Params& p, char* smem) {
    if (blockIdx.x == 0 && tidx() < 64) ((unsigned*)(p.ws + O_CNT))[tidx()] = 0u;
    const bf16_t* H = (const bf16_t*)(p.ws + O_H); const bf16_t* W = (const bf16_t*)(p.ws + O_WB + W_IN);
    bf16_t* P = (bf16_t*)(p.ws + O_P);
    for (int it = blockIdx.x; it < 136 * 48; it += gridDim.x) {
        const int mt = it / 48, nt = it % 48;
        f32x4 acc[4][4];
        RPPlain rp{H + (size_t)mt * 128 * 1024, 1024};
        gemm_core_g<4>(rp, W + (size_t)nt * 128 * 1024, 1024, 1024, acc, smem);
        acc_foreach<4>(acc, [&](int m, int n, const f32x4& v) {
            const int col = nt * 128 + n; f32x4 o = v;
            if (col >= PG0 && col < PEND) { o[0] = sigmoidf_(v[0]); o[1] = sigmoidf_(v[1]); o[2] = sigmoidf_(v[2]); o[3] = sigmoidf_(v[3]); }
            store_bf16x4(P + (size_t)(mt * 128 + m) * LDP + col, o);
        });
    }
}

__device__ __forceinline__ void ph_qu(const Params& p, char* smem) {
    const bf16_t* P = (const bf16_t*)(p.ws + O_P);
    bf16_t* QR = (bf16_t*)(p.ws + O_X + X_QRAW); bf16_t* KVR = (bf16_t*)(p.ws + O_X + X_KVRAW);
    for (int it = blockIdx.x; it < 136 * 14; it += gridDim.x) {
        const int mt = it / 14, nn = it % 14;
        f32x4 acc[4][4];
        if (nn < 6) {
            RPPlain rp{P + (size_t)mt * 128 * LDP + PQ0, LDP};
            gemm_core_g<4>(rp, (const bf16_t*)(p.ws + O_WB + W_UQ) + (size_t)nn * 128 * 384, 384, 384, acc, smem);
            acc_foreach<4>(acc, [&](int m, int n, const f32x4& v) { store_bf16x4(QR + (size_t)(mt * 128 + m) * 768 + nn * 128 + n, v); });
        } else {
            const int nt = nn - 6;
            RPPlain rp{P + (size_t)mt * 128 * LDP + PKV0, LDP};
            gemm_core_g<4>(rp, (const bf16_t*)(p.ws + O_WB + W_UKV) + (size_t)nt * 128 * 256, 256, 256, acc, smem);
            acc_foreach<4>(acc, [&](int m, int n, const f32x4& v) { store_bf16x4(KVR + (size_t)(mt * 128 + m) * 1024 + nt * 128 + n, v); });
        }
    }
}

constexpr float QSCALE = 0.10206207261596575f * 1.4426950408889634f;
__device__ __forceinline__ void ph_m2(const Params& p, char* smem) {
    const int tid = tidx(), lane = tid & 63, wave = tid >> 6;
    const bf16_t* P = (const bf16_t*)(p.ws + O_P);
    const bf16_t* QR = (const bf16_t*)(p.ws + O_X + X_QRAW); const bf16_t* KVR = (const bf16_t*)(p.ws + O_X + X_KVRAW);
    bf16_t* QA = (bf16_t*)(p.ws + O_X + X_QA); bf16_t* KA = (bf16_t*)(p.ws + O_X + X_KA); bf16_t* VA = (bf16_t*)(p.ws + O_X + X_VA);
    const float* rc = (const float*)(p.ws + O_ROPEC); const float* rs = (const float*)(p.ws + O_ROPES);
    for (int row = blockIdx.x * 4 + wave; row < RT; row += gridDim.x * 4) {
        const bool lat = row < RL;
        const int b = lat ? (row >> 12) : ((row - RL) >> 8), t = lat ? (row & 4095) : ((row - RL) & 255);
        const size_t keyrow = (size_t)b * KEYS + (lat ? t : SEQ + t);
        const bf16_t* pr = P + (size_t)row * LDP;
        float sq = 0.f, sk = 0.f;
        if (lane < 48) { float f[8]; unpack8(*(const uint4*)(pr + PQ0 + lane * 8), f);
#pragma unroll
            for (int e = 0; e < 8; ++e) sq += f[e] * f[e]; }
        if (lane < 32) { float f[8]; unpack8(*(const uint4*)(pr + PKV0 + lane * 8), f);
#pragma unroll
            for (int e = 0; e < 8; ++e) sk += f[e] * f[e]; }
        sq = wsum(sq); sk = wsum(sk);
        const float rq = rsqrtf(sq * (1.f / 384.f) + 1e-6f), rkv = rsqrtf(sk * (1.f / 256.f) + 1e-6f);
        const bf16_t* qr = QR + (size_t)row * 768; const bf16_t* kvr = KVR + (size_t)row * 1024;
        const float* rct = rc + t * 16; const float* rst = rs + t * 16;
#pragma unroll
        for (int pass = 0; pass < 2; ++pass) {
            const int ch = lane + 64 * pass;
            if (ch < 96) {
                const int h = ch / 12, cc = ch - h * 12;
                float q[8], k[8];
                unpack8(*(const uint4*)(qr + ch * 8), q);
                if (cc < 8) unpack8(*(const uint4*)(kvr + h * 128 + cc * 8), k);
                else unpack8(*(const uint4*)(pr + PKR0 + (cc - 8) * 8), k);
                const float ksc = cc < 8 ? rkv : 1.f;
#pragma unroll
                for (int e = 0; e < 8; ++e) { q[e] *= rq; k[e] *= ksc; }
                if (cc >= 8 && lat) {
                    const int sub = cc - 8, ax = sub >> 1, half = sub & 1;
                    float qp[8], kp[8];
                    unpack8(*(const uint4*)(qr + (ch ^ 1) * 8), qp); unpack8(*(const uint4*)(pr + PKR0 + (sub ^ 1) * 8), kp);
                    const float4 c0 = *(const float4*)(rct + ax * 8), c1 = *(const float4*)(rct + ax * 8 + 4), s0 = *(const float4*)(rst + ax * 8), s1 = *(const float4*)(rst + ax * 8 + 4);
                    const float cs_[8] = {c0.x, c0.y, c0.z, c0.w, c1.x, c1.y, c1.z, c1.w}, sn_[8] = {s0.x, s0.y, s0.z, s0.w, s1.x, s1.y, s1.z, s1.w};
#pragma unroll
                    for (int e = 0; e < 8; ++e) {
                        const float sg = half ? sn_[e] : -sn_[e];
                        q[e] = q[e] * cs_[e] + qp[e] * rq * sg;
                        k[e] = k[e] * cs_[e] + kp[e] * sg;
                    }
                }
#pragma unroll
                for (int e = 0; e < 8; ++e) q[e] *= QSCALE;
                *(uint4*)(QA + (size_t)row * 768 + ch * 8) = pack8(q);
                *(uint4*)(KA + keyrow * 768 + ch * 8) = pack8(k);
            }
        }
    }
    bf16_t* vt = (bf16_t*)smem;
    float* rk = (float*)(smem + 64 * 72 * 2);
    for (int it = blockIdx.x; it < (RT / 64) * 8; it += gridDim.x) {
        const int g = it >> 3, h = it & 7, rowg = g * 64;
        const bool lat = rowg < RL;
        const int b = lat ? (rowg >> 12) : ((rowg - RL) >> 8), t0 = lat ? (rowg & 4095) : ((rowg - RL) & 255);
        const size_t key0 = lat ? t0 : SEQ + t0;
#pragma unroll 4
        for (int rr = 0; rr < 16; ++rr) {
            const int lr = wave * 16 + rr;
            const bf16_t* pr = P + (size_t)(rowg + lr) * LDP + PKV0;
            const uint2 u = *(const uint2*)(pr + lane * 4);
            float sk = bflo(u.x) * bflo(u.x) + bfhi(u.x) * bfhi(u.x) + bflo(u.y) * bflo(u.y) + bfhi(u.y) * bfhi(u.y);
            sk = wsum(sk);
            if (lane == 0) rk[lr] = rsqrtf(sk * (1.f / 256.f) + 1e-6f);
        }
        __syncthreads();
#pragma unroll
        for (int i = 0; i < 2; ++i) {
            const int c = tid + 256 * i, lr = c >> 3, part = c & 7;
            float f[8]; unpack8(*(const uint4*)(KVR + (size_t)(rowg + lr) * 1024 + h * 128 + 64 + part * 8), f);
            const float sc = rk[lr];
#pragma unroll
            for (int e = 0; e < 8; ++e) f[e] *= sc;
            *(uint4*)(vt + lr * 72 + part * 8) = pack8(f);
        }
        __syncthreads();
#pragma unroll
        for (int i = 0; i < 2; ++i) {
            const int c = tid + 256 * i, dd = c >> 3, kc = c & 7;
            float f[8];
#pragma unroll
            for (int e = 0; e < 8; ++e) f[e] = bf2f(vt[(kc * 8 + e) * 72 + dd]);
            const uint4 u = pack8(f);
            bf16_t* dst = VA + ((size_t)(b * 8 + h) * 64 + dd) * KEYS + key0 + (kc >> 2) * 32 + (kc & 1) * 16 + ((kc & 3) >> 1) * 4;
            *(uint2*)dst = make_uint2(u.x, u.y); *(uint2*)(dst + 8) = make_uint2(u.z, u.w);
        }
        __syncthreads();
    }
}
__device__ __forceinline__ float xmax_16_32(float v) {
    unsigned u = __builtin_bit_cast(unsigned, v);
    auto r = __builtin_amdgcn_permlane32_swap(u, u, false, false);
    float m = fmaxf(__builtin_bit_cast(float, r[0]), __builtin_bit_cast(float, r[1]));
    u = __builtin_bit_cast(unsigned, m);
    auto r2 = __builtin_amdgcn_permlane16_swap(u, u, false, false);
    return fmaxf(__builtin_bit_cast(float, r2[0]), __builtin_bit_cast(float, r2[1]));
}
__device__ __forceinline__ float xsum_16_32(float v) {
    unsigned u = __builtin_bit_cast(unsigned, v);
    auto r = __builtin_amdgcn_permlane32_swap(u, u, false, false);
    float m = __builtin_bit_cast(float, r[0]) + __builtin_bit_cast(float, r[1]);
    u = __builtin_bit_cast(unsigned, m);
    auto r2 = __builtin_amdgcn_permlane16_swap(u, u, false, false);
    return __builtin_bit_cast(float, r2[0]) + __builtin_bit_cast(float, r2[1]);
}
constexpr int KS_LD = 104, VT_LD = 72;
constexpr int AT_BUF = 64 * KS_LD * 2 + 64 * VT_LD * 2;
__device__ __forceinline__ void ph_at(const Params& p, int l, char* smem) {
    const int tid = tidx(), lane = tid & 63, wave = tid >> 6, fr = lane & 15, fq = lane >> 4;
    const bf16_t* QA = (const bf16_t*)(p.ws + O_X + X_QA); const bf16_t* KA = (const bf16_t*)(p.ws + O_X + X_KA); const bf16_t* VA = (const bf16_t*)(p.ws + O_X + X_VA);
    bf16_t* ATT = (bf16_t*)(p.ws + O_ATT);
    const int nitems = 1024 + (l < NLAYER - 1 ? 64 : 0);
    for (int it0 = blockIdx.x; it0 < nitems; it0 += gridDim.x) {
        int it = it0;
        if (gridDim.x == 512 && it0 < 1024) {
            const int x = it0 & 7, j = (it0 >> 3) & 63, rd = it0 >> 9;
            it = ((x * 4 + rd * 2 + (j >> 5)) << 5) | (j & 31);
        }
        int b, h, row0, ntile; size_t krow0;
        if (it < 1024) { b = it >> 8; h = (it >> 5) & 7; row0 = b * SEQ + (it & 31) * 128; krow0 = (size_t)b * KEYS; ntile = KEYS / 64; }
        else { const int j = it - 1024; b = j >> 4; h = (j >> 1) & 7; row0 = RL + b * CTX + (j & 1) * 128; krow0 = (size_t)b * KEYS + SEQ; ntile = CTX / 64; }
        const int qrow = row0 + wave * 32 + fr;
        const size_t vrow0 = (size_t)(b * 8 + h) * 64; const int koff0 = (int)(krow0 - (size_t)b * KEYS);
        bf16x8 qf[2][3];
#pragma unroll
        for (int t = 0; t < 2; ++t)
#pragma unroll
            for (int ks = 0; ks < 3; ++ks) qf[t][ks] = *(const bf16x8*)(QA + (size_t)(qrow + 16 * t) * 768 + h * 96 + ks * 32 + fq * 8);
        f32x4 ot[2][4];
#pragma unroll
        for (int t = 0; t < 2; ++t)
#pragma unroll
            for (int i = 0; i < 4; ++i) ot[t][i] = (f32x4){0.f, 0.f, 0.f, 0.f};
        float m_run[2] = {-1e30f, -1e30f}, l_run[2] = {0.f, 0.f};
        uint4 rk0, rk1, rk2, rv0, rv1;
#define AT_GLOAD(KT) do { const size_t kr_ = krow0 + (size_t)(KT) * 64; \
            { const int c = tid, key = c / 12, part = c % 12; rk0 = *(const uint4*)(KA + (kr_ + key) * 768 + h * 96 + part * 8); } \
            { const int c = tid + 256, key = c / 12, part = c % 12; rk1 = *(const uint4*)(KA + (kr_ + key) * 768 + h * 96 + part * 8); } \
            { const int c = tid + 512, key = c / 12, part = c % 12; rk2 = *(const uint4*)(KA + (kr_ + key) * 768 + h * 96 + part * 8); } \
            { const int c = tid, dd_ = c >> 3, part = c & 7; rv0 = *(const uint4*)(VA + (vrow0 + dd_) * KEYS + koff0 + (KT) * 64 + part * 8); } \
            { const int c = tid + 256, dd_ = c >> 3, part = c & 7; rv1 = *(const uint4*)(VA + (vrow0 + dd_) * KEYS + koff0 + (KT) * 64 + part * 8); } } while (0)
#define AT_VSTORE(RV, C) do { const int dd_ = (C) >> 3, part = (C) & 7; *(uint4*)(Vt_ + dd_ * VT_LD + part * 8) = RV; } while (0)
#define AT_SSTORE(BUF) do { bf16_t* Ks_ = (bf16_t*)(smem + (BUF) * AT_BUF); bf16_t* Vt_ = Ks_ + 64 * KS_LD; \
            { const int c = tid, key = c / 12, part = c % 12; *(uint4*)(Ks_ + key * KS_LD + part * 8) = rk0; } \
            { const int c = tid + 256, key = c / 12, part = c % 12; *(uint4*)(Ks_ + key * KS_LD + part * 8) = rk1; } \
            { const int c = tid + 512, key = c / 12, part = c % 12; *(uint4*)(Ks_ + key * KS_LD + part * 8) = rk2; } \
            AT_VSTORE(rv0, tid); AT_VSTORE(rv1, tid + 256); } while (0)
        AT_GLOAD(0); AT_SSTORE(0);
        __syncthreads();
        for (int kt = 0; kt < ntile; ++kt) {
            const int cur = kt & 1;
            if (kt + 1 < ntile) AT_GLOAD(kt + 1);
            const bf16_t* Ks = (const bf16_t*)(smem + cur * AT_BUF); const bf16_t* Vt = Ks + 64 * KS_LD;
            f32x4 st[2][4];
#pragma unroll
            for (int jh = 0; jh < 2; ++jh) {
                bf16x8 kf[2][3];
#pragma unroll
                for (int jj = 0; jj < 2; ++jj)
#pragma unroll
                    for (int ks = 0; ks < 3; ++ks) kf[jj][ks] = *(const bf16x8*)(Ks + ((jh * 2 + jj) * 16 + fr) * KS_LD + ks * 32 + fq * 8);
#pragma unroll
                for (int jj = 0; jj < 2; ++jj) {
                    const int j = jh * 2 + jj;
                    st[0][j] = (f32x4){0.f, 0.f, 0.f, 0.f}; st[1][j] = (f32x4){0.f, 0.f, 0.f, 0.f};
#pragma unroll
                    for (int ks = 0; ks < 3; ++ks) {
                        st[0][j] = __builtin_amdgcn_mfma_f32_16x16x32_bf16(kf[jj][ks], qf[0][ks], st[0][j], 0, 0, 0);
                        st[1][j] = __builtin_amdgcn_mfma_f32_16x16x32_bf16(kf[jj][ks], qf[1][ks], st[1][j], 0, 0, 0);
                    }
                }
            }
            bf16x8 vf[2][4];
#pragma unroll
            for (int k2 = 0; k2 < 2; ++k2)
#pragma unroll
                for (int dt = 0; dt < 4; ++dt) {
                    vf[k2][dt] = *(const bf16x8*)(Vt + (dt * 16 + fr) * VT_LD + k2 * 32 + fq * 8);
                }
            uint4 pu[2][2];
#pragma unroll
            for (int t = 0; t < 2; ++t) {
                float mx = st[t][0][0];
#pragma unroll
                for (int j = 0; j < 4; ++j)
#pragma unroll
                    for (int r = 0; r < 4; ++r) mx = fmaxf(mx, st[t][j][r]);
                if (__any(mx > m_run[t] + 6.f)) {
                    mx = xmax_16_32(mx);
                    const float m_new = fmaxf(m_run[t], mx);
                    const float alpha = __builtin_amdgcn_exp2f(m_run[t] - m_new);
                    m_run[t] = m_new;
                    l_run[t] *= alpha;
#pragma unroll
                    for (int i = 0; i < 4; ++i) ot[t][i] *= alpha;
                }
                const float mr = m_run[t];
                float ps = 0.f;
#pragma unroll
                for (int j = 0; j < 4; ++j)
#pragma unroll
                    for (int r = 0; r < 4; ++r) { st[t][j][r] = __builtin_amdgcn_exp2f(st[t][j][r] - mr); ps += st[t][j][r]; }
                l_run[t] += ps;
#pragma unroll
                for (int k2 = 0; k2 < 2; ++k2)
                    pu[t][k2] = make_uint4(pack2(st[t][2 * k2][0], st[t][2 * k2][1]), pack2(st[t][2 * k2][2], st[t][2 * k2][3]),
                                           pack2(st[t][2 * k2 + 1][0], st[t][2 * k2 + 1][1]), pack2(st[t][2 * k2 + 1][2], st[t][2 * k2 + 1][3]));
            }
#pragma unroll
            for (int k2 = 0; k2 < 2; ++k2) {
                const bf16x8 pb0 = __builtin_bit_cast(bf16x8, pu[0][k2]), pb1 = __builtin_bit_cast(bf16x8, pu[1][k2]);
#pragma unroll
                for (int dt = 0; dt < 4; ++dt) {
                    ot[0][dt] = __builtin_amdgcn_mfma_f32_16x16x32_bf16(vf[k2][dt], pb0, ot[0][dt], 0, 0, 0);
                    ot[1][dt] = __builtin_amdgcn_mfma_f32_16x16x32_bf16(vf[k2][dt], pb1, ot[1][dt], 0, 0, 0);
                }
            }
            if (kt + 1 < ntile) AT_SSTORE(cur ^ 1);
            __syncthreads();
        }
#pragma unroll
        for (int t = 0; t < 2; ++t) {
            const float inv = 1.f / xsum_16_32(l_run[t]);
#pragma unroll
            for (int dt = 0; dt < 4; ++dt) { f32x4 o = ot[t][dt] * inv; store_bf16x4(ATT + (size_t)(qrow + 16 * t) * 512 + h * 64 + dt * 16 + fq * 4, o); }
        }
    }
}

__device__ __forceinline__ void row_edges(int row, bool& first, bool& last) {
    if (row < RL) { const int t = row & 4095; first = t == 0; last = t == 4095; }
    else { const int s = (row - RL) & 255; first = s == 0; last = s == 255; }
}
__device__ __forceinline__ float xs1(const bf16_t* P, const float* mu, int row, int col) {
    bool first, last; row_edges(row, first, last);
    const bf16_t* pc = P + (size_t)row * LDP + PR0 + col;
    const float c = bf2f(*pc), pv0 = bf2f(*(first ? pc : pc - LDP)), nx0 = bf2f(*(last ? pc : pc + LDP));
    const float pv = first ? 0.f : pv0, nx = last ? 0.f : nx0;
    return c + (0.5f * (pv + nx) - c) * mu[col];
}
__device__ __forceinline__ void xs8(const bf16_t* P, const float* mu, int row, int col, float (&o)[8]) {
    bool first, last; row_edges(row, first, last);
    const bf16_t* pc = P + (size_t)row * LDP + PR0 + col;
    const uint4 uc = *(const uint4*)pc, up = *(const uint4*)(first ? pc : pc - LDP), un = *(const uint4*)(last ? pc : pc + LDP);
    float c[8], pv[8], nx[8]; unpack8(uc, c); unpack8(up, pv); unpack8(un, nx);
    const float fp = first ? 0.f : 0.5f, fn = last ? 0.f : 0.5f;
    const float4 m0 = *(const float4*)(mu + col), m1 = *(const float4*)(mu + col + 4);
    const float m[8] = {m0.x, m0.y, m0.z, m0.w, m1.x, m1.y, m1.z, m1.w};
#pragma unroll
    for (int j = 0; j < 8; ++j) o[j] = c[j] + ((fp * pv[j] + fn * nx[j]) - c[j]) * m[j];
}
struct ALRw {
    const bf16_t* P; const float* mu; int row0; int colbase, mode;
    __device__ __forceinline__ ALRw(const bf16_t* P_, const float* mu_, int row0_, int colbase_, int mode_) : P(P_), mu(mu_), colbase(colbase_), mode(mode_) {
        row0 = row0_ + (tidx() >> 3);
    }
    __device__ __forceinline__ uint4 load(int i, int k) const {
        float o[8]; xs8(P, mu, row0 + 32 * i, colbase + k, o);
        if (mode == 0) {
#pragma unroll
            for (int j = 0; j < 8; ++j) o[j] = tanhf(o[j]);
        } else if (mode == 2) {
#pragma unroll
            for (int j = 0; j < 8; ++j) o[j] = sigmoidf_(o[j]);
        }
        return pack8(o);
    }
};
__device__ __forceinline__ void ph_rp1(const Params& p, int l, char* smem) {
    const bf16_t* P = (const bf16_t*)(p.ws + O_P); const float* mu = p.in[I_MU] + l * 1792;
    bf16_t* RG = (bf16_t*)(p.ws + O_RG);
    for (int it = blockIdx.x; it < 1088; it += gridDim.x) {
        const int mt = it >> 2, nt = it & 3;
        f32x4 acc[2][4];
        ALRw al(P, mu, mt * 64, 1664, 2);
        gemm_core<2>(al, (const bf16_t*)(p.ws + O_WB + W_GUP) + (size_t)nt * 128 * 128, 128, 128, acc, smem);
        acc_foreach<2>(acc, [&](int m, int n, const f32x4& v) { store_bf16x4(RG + (size_t)(mt * 64 + m) * 512 + nt * 128 + n, v); });
    }
}
__device__ __forceinline__ void ph_rp2(const Params& p, int l) {
    const int lane = tidx() & 63, wave = tidx() >> 6;
    const bf16_t* P = (const bf16_t*)(p.ws + O_P); const float* mu = p.in[I_MU] + l * 1792; const float* kkw = p.in[I_KK] + l * 512;
    float* KKN = (float*)(p.ws + O_X + X_KKN);
    for (int row = blockIdx.x * 4 + wave; row < RT; row += gridDim.x * 4) {
        float k8[8]; xs8(P, mu, row, 512 + lane * 8, k8);
        float s = 0.f;
#pragma unroll
        for (int j = 0; j < 8; ++j) { const float v = k8[j] * kkw[lane * 8 + j]; s += v * v; }
        s += __shfl_xor(s, 1); s += __shfl_xor(s, 2); s += __shfl_xor(s, 4);
        if ((lane & 7) == 0) KKN[(size_t)row * 8 + (lane >> 3)] = rsqrtf(s + 1e-12f);
    }
}

__device__ __forceinline__ int scan_row(int b, int d, int n) {
    if (n < CTX) return RL + b * CTX + (d == 0 ? n : CTX - 1 - n);
    const int t = n - CTX; return b * SEQ + (d == 0 ? t : SEQ - 1 - t);
}
constexpr int SL = 72;
constexpr int SLOT_E = 64 * SL;
template <int LDA, int LDB>
__device__ __forceinline__ void mm64(const bf16_t* A, const bf16_t* B, f32x4 (&acc)[4], int wave, int fr, int fq) {
#pragma unroll
    for (int ks = 0; ks < 2; ++ks) {
        const bf16x8 af = *(const bf16x8*)(A + (wave * 16 + fr) * LDA + ks * 32 + fq * 8);
#pragma unroll
        for (int nt = 0; nt < 4; ++nt) {
            const bf16x8 bfv = *(const bf16x8*)(B + (nt * 16 + fr) * LDB + ks * 32 + fq * 8);
            acc[nt] = __builtin_amdgcn_mfma_f32_16x16x32_bf16(bfv, af, acc[nt], 0, 0, 0);
        }
    }
}
__device__ __forceinline__ void acc_zero(f32x4 (&acc)[4]) {
#pragma unroll
    for (int nt = 0; nt < 4; ++nt) acc[nt] = (f32x4){0.f, 0.f, 0.f, 0.f};
}
template <bool STRICT>
__device__ __forceinline__ void acc_mask(f32x4 (&acc)[4], int m, int fq) {
#pragma unroll
    for (int nt = 0; nt < 4; ++nt)
#pragma unroll
        for (int r = 0; r < 4; ++r) { const int n = nt * 16 + fq * 4 + r; const bool keep = STRICT ? (m < n) : (m <= n); if (!keep) acc[nt][r] = 0.f; }
}
__device__ __forceinline__ void st_rm(bf16_t* dst, const f32x4 (&acc)[4], int m, int fq) {
#pragma unroll
    for (int nt = 0; nt < 4; ++nt) store_bf16x4(dst + m * SL + nt * 16 + fq * 4, acc[nt]);
}
__device__ __forceinline__ void st_tr(bf16_t* dst, const f32x4 (&acc)[4], int m, int fq) {
#pragma unroll
    for (int nt = 0; nt < 4; ++nt)
#pragma unroll
        for (int r = 0; r < 4; ++r) dst[(nt * 16 + fq * 4 + r) * SL + m] = f2bf(acc[nt][r]);
}
__device__ __forceinline__ void ph_r1(const Params& p, int l, char* smem) {
    const int tid0 = tidx();
#define R1_IDX const int tid = lv(tid0), lane = tid & 63, wave = tid >> 6, fr = lane & 15, fq = lane >> 4, bi = tid >> 2, bq = (tid & 3) * 16, m = wave * 16 + fr; (void)bi; (void)bq; (void)m; (void)fq;
    const bf16_t* P = (const bf16_t*)(p.ws + O_P); const float* mu = p.in[I_MU] + l * 1792;
    const float* kkw = p.in[I_KK] + l * 512; const float* kaw = p.in[I_KA] + l * 512; const float* rkw = p.in[I_RK] + l * 512;
    const float* KKN = (const float*)(p.ws + O_X + X_KKN); float* BON = (float*)(p.ws + O_X + X_BON);
    bf16_t* gMT = (bf16_t*)(p.ws + O_X + X_MT); bf16_t* gNL = (bf16_t*)(p.ws + O_H);
    bf16_t* gGT = (bf16_t*)(p.ws + O_X + X_GT); bf16_t* gYL = (bf16_t*)(p.ws + O_X + X_YL);
    bf16_t* slot = (bf16_t*)smem;
    bf16_t* s0 = slot, *s1 = slot + SLOT_E, *s2 = slot + 2 * SLOT_E, *s3 = slot + 3 * SLOT_E;
    bf16_t* sa = slot + 4 * SLOT_E, *sb = slot + 5 * SLOT_E, *sc = slot + 6 * SLOT_E, *sT = slot + 7 * SLOT_E;
    float* misc = (float*)(smem + 8 * SLOT_E * 2);
    float* GAM = misc; float* SEG = misc + 64;
    float* ASIG = (float*)s0;
    float* LWS = (float*)s2;
    for (int it = blockIdx.x; it < NCP; it += gridDim.x) {
        const int c = it % 68, d = (it / 68) & 1, h = (it / 136) & 7, b = it / 1088;
        {
            R1_IDX const int rowb = scan_row(b, d, c * 64 + bi); (void)rowb;
            float o[8];
#pragma unroll
            for (int hh = 0; hh < 2; ++hh) {
                xs8(P, mu, rowb, 1536 + bq + hh * 8, o);
#pragma unroll
                for (int j = 0; j < 8; ++j) o[j] = 1.f - 2.f * __builtin_amdgcn_rcpf(1.f + __expf(2.f * o[j]));
                *(uint4*)(sa + bi * SL + bq + hh * 8) = pack8(o);
                xs8(P, mu, rowb, 1600 + bq + hh * 8, o);
                *(uint4*)(sb + bi * SL + bq + hh * 8) = pack8(o);
            }
        }
        __syncthreads();
        {
            R1_IDX const int rowb = scan_row(b, d, c * 64 + bi); (void)rowb;
            f32x4 acc[4];
            acc_zero(acc);
            mm64<SL, 64>(sa, (const bf16_t*)(p.ws + O_WB + W_WUP) + ((size_t)d * 512 + h * 64) * 64, acc, wave, fr, fq);
            const float* w0 = p.in[I_W0] + (l * 2 + d) * 512 + h * 64;
#pragma unroll
            for (int nt = 0; nt < 4; ++nt) {
                const int n = nt * 16 + fq * 4; float4 o; float* op = (float*)&o;
#pragma unroll
                for (int r = 0; r < 4; ++r) { const float z = w0[n + r] + acc[nt][r]; op[r] = -0.6065306597126334f * __builtin_amdgcn_rcpf(1.f + __expf(-z)); }
                *(float4*)(LWS + m * 68 + n) = o;
            }
            acc_zero(acc);
            mm64<SL, 64>(sb, (const bf16_t*)(p.ws + O_WB + W_AUP) + ((size_t)d * 512 + h * 64) * 64, acc, wave, fr, fq);
            const float* a0 = p.in[I_A0] + (l * 2 + d) * 512 + h * 64;
#pragma unroll
            for (int nt = 0; nt < 4; ++nt) {
                const int n = nt * 16 + fq * 4;
                *(float4*)(ASIG + m * 68 + n) = make_float4(__builtin_amdgcn_rcpf(1.f + __expf(-(a0[n] + acc[nt][0]))), __builtin_amdgcn_rcpf(1.f + __expf(-(a0[n + 1] + acc[nt][1]))), __builtin_amdgcn_rcpf(1.f + __expf(-(a0[n + 2] + acc[nt][2]))), __builtin_amdgcn_rcpf(1.f + __expf(-(a0[n + 3] + acc[nt][3]))));
            }
        }
        __syncthreads();
        {
            R1_IDX const int rowb = scan_row(b, d, c * 64 + bi); (void)rowb;
            const int k = tid & 63, seg = tid >> 6;
            float run = 0.f;
#pragma unroll
            for (int ii = 0; ii < 16; ++ii) { run += LWS[(seg * 16 + ii) * 68 + k]; LWS[(seg * 16 + ii) * 68 + k] = run; }
            SEG[seg * 64 + k] = run;
            __syncthreads();
            float off = 0.f;
#pragma unroll
            for (int sgi = 0; sgi < 3; ++sgi) if (sgi < seg) off += SEG[sgi * 64 + k];
#pragma unroll
            for (int ii = 0; ii < 16; ++ii) LWS[(seg * 16 + ii) * 68 + k] += off;
        }
        __syncthreads();
        {
            R1_IDX const int rowb = scan_row(b, d, c * 64 + bi); (void)rowb;
            float cs[16], cm[16], cc[16], ag[16];
#pragma unroll
            for (int q = 0; q < 4; ++q) {
                const float4 v0 = *(const float4*)(LWS + bi * 68 + bq + q * 4);
                const float4 v1 = bi > 0 ? *(const float4*)(LWS + (bi - 1) * 68 + bq + q * 4) : make_float4(0.f, 0.f, 0.f, 0.f);
                const float4 v2 = *(const float4*)(LWS + 63 * 68 + bq + q * 4);
                const float4 v3 = *(const float4*)(ASIG + bi * 68 + bq + q * 4);
                cs[q * 4] = v0.x; cs[q * 4 + 1] = v0.y; cs[q * 4 + 2] = v0.z; cs[q * 4 + 3] = v0.w;
                cm[q * 4] = v1.x; cm[q * 4 + 1] = v1.y; cm[q * 4 + 2] = v1.z; cm[q * 4 + 3] = v1.w;
                cc[q * 4] = v2.x; cc[q * 4 + 1] = v2.y; cc[q * 4 + 2] = v2.z; cc[q * 4 + 3] = v2.w;
                ag[q * 4] = v3.x; ag[q * 4 + 1] = v3.y; ag[q * 4 + 2] = v3.z; ag[q * 4 + 3] = v3.w;
            }
            __syncthreads();
            const float kkn = KKN[(size_t)rowb * 8 + h];
            float bon = 0.f;
#pragma unroll
            for (int hh = 0; hh < 2; ++hh) {
                float r8[8], k8[8], oa[8], ob[8], ok[8], orr[8];
                const int col = h * 64 + bq + hh * 8;
                xs8(P, mu, rowb, col, r8); xs8(P, mu, rowb, 512 + col, k8);
#pragma unroll
                for (int j = 0; j < 8; ++j) {
                    const int e = hh * 8 + j;
                    const float kk = k8[j] * kkw[col + j] * kkn;
                    const float kd = k8[j] * (1.f + (ag[e] - 1.f) * kaw[col + j]);
                    const float eneg = __expf(-cs[e]);
                    oa[j] = -kk * __expf(cm[e]); ob[j] = kk * ag[e] * eneg; ok[j] = kd * eneg; orr[j] = r8[j] * __builtin_amdgcn_rcpf(eneg);
                    bon += r8[j] * kd * rkw[col + j];
                }
                *(uint4*)(s0 + bi * SL + bq + hh * 8) = pack8(oa); *(uint4*)(s1 + bi * SL + bq + hh * 8) = pack8(ob);
                *(uint4*)(s2 + bi * SL + bq + hh * 8) = pack8(ok); *(uint4*)(s3 + bi * SL + bq + hh * 8) = pack8(orr);
            }
            bon += __shfl_xor(bon, 1); bon += __shfl_xor(bon, 2);
            if ((tid & 3) == 0) BON[((size_t)d * RT + rowb) * 8 + h] = bon;
            if (bi == 0) {
#pragma unroll
                for (int e = 0; e < 16; ++e) GAM[bq + e] = __expf(cc[e]);
            }
        }
        __syncthreads();
        {
            R1_IDX const int rowb = scan_row(b, d, c * 64 + bi); (void)rowb;
            f32x4 acc[4]; acc_zero(acc);
            mm64<SL, SL>(s1, s0, acc, wave, fr, fq);
            acc_mask<true>(acc, m, fq);
            st_rm(sa, acc, m, fq); st_tr(sb, acc, m, fq);
#pragma unroll
            for (int nt = 0; nt < 4; ++nt)
#pragma unroll
                for (int r = 0; r < 4; ++r) if (nt * 16 + fq * 4 + r == m) acc[nt][r] += 1.f;
            st_rm(sc, acc, m, fq);
        }
        __syncthreads();
#pragma unroll
        for (int itr = 0; itr < 5; ++itr) {
            R1_IDX
            bf16_t* ptr = (itr & 1) ? sT : sb;
            bf16_t* ptw = (itr & 1) ? sb : sT;
            f32x4 acc[4]; acc_zero(acc);
            mm64<SL, SL>(sa, ptr, acc, wave, fr, fq);
            st_rm(sa, acc, m, fq); st_tr(ptw, acc, m, fq);
            __syncthreads();
            f32x4 tacc[4];
#pragma unroll
            for (int nt = 0; nt < 4; ++nt) { const uint2 u = *(const uint2*)(sc + m * SL + nt * 16 + fq * 4); tacc[nt] = (f32x4){bflo(u.x), bfhi(u.x), bflo(u.y), bfhi(u.y)}; }
            mm64<SL, SL>(sc, ptw, tacc, wave, fr, fq);
            if (itr < 4) st_rm(sc, tacc, m, fq); else st_tr(sb, tacc, m, fq);
        }
        __syncthreads();
        {
            R1_IDX const int rowb = scan_row(b, d, c * 64 + bi); (void)rowb;
            f32x4 acc[4]; acc_zero(acc);
            mm64<SL, SL>(s2, s0, acc, wave, fr, fq);
            acc_mask<true>(acc, m, fq);
            st_rm(sa, acc, m, fq);
            float f0[8], f1[8];
            unpack8(*(const uint4*)(s0 + bi * SL + bq), f0); unpack8(*(const uint4*)(s0 + bi * SL + bq + 8), f1);
#pragma unroll
            for (int e = 0; e < 8; ++e) { sc[(bq + e) * SL + bi] = f2bf(f0[e]); sc[(bq + 8 + e) * SL + bi] = f2bf(f1[e]); }
        }
        __syncthreads();
        {
            R1_IDX const int rowb = scan_row(b, d, c * 64 + bi); (void)rowb;
            f32x4 acc[4]; acc_zero(acc);
            mm64<SL, SL>(sc, sb, acc, wave, fr, fq);
            st_rm(sT, acc, m, fq);
            acc_zero(acc);
            mm64<SL, SL>(sa, sb, acc, wave, fr, fq);
            st_rm(s0, acc, m, fq);
        }
        __syncthreads();
        f32x4 qacc[4];
        {
            R1_IDX const int rowb = scan_row(b, d, c * 64 + bi); (void)rowb;
            f32x4 acc[4]; acc_zero(acc);
            mm64<SL, SL>(s1, s3, acc, wave, fr, fq);
            acc_mask<false>(acc, m, fq);
            st_tr(sa, acc, m, fq);
            acc_zero(qacc);
            mm64<SL, SL>(s2, s3, qacc, wave, fr, fq);
            acc_mask<false>(qacc, m, fq);
            float f0[8], f1[8];
            unpack8(*(const uint4*)(s3 + bi * SL + bq), f0); unpack8(*(const uint4*)(s3 + bi * SL + bq + 8), f1);
#pragma unroll
            for (int e = 0; e < 8; ++e) { sc[(bq + e) * SL + bi] = f2bf(f0[e]); sc[(bq + 8 + e) * SL + bi] = f2bf(f1[e]); }
        }
        __syncthreads();
        {
            R1_IDX const int rowb = scan_row(b, d, c * 64 + bi); (void)rowb;
            f32x4 acc[4];
#pragma unroll
            for (int nt = 0; nt < 4; ++nt) { const uint2 u = *(const uint2*)(sc + m * SL + nt * 16 + fq * 4); acc[nt] = (f32x4){bflo(u.x), bfhi(u.x), bflo(u.y), bfhi(u.y)}; }
            mm64<SL, SL>(sT, sa, acc, wave, fr, fq);
            bf16_t* gt = gGT + (size_t)it * 4096;
#pragma unroll
            for (int nt = 0; nt < 4; ++nt)
#pragma unroll
                for (int r = 0; r < 4; ++r) gt[(nt * 16 + fq * 4 + r) * 64 + m] = f2bf(acc[nt][r]);
            mm64<SL, SL>(s0, sa, qacc, wave, fr, fq);
            st_tr(sb, qacc, m, fq);
            float f0[8], f1[8];
            unpack8(*(const uint4*)(s1 + bi * SL + bq), f0); unpack8(*(const uint4*)(s1 + bi * SL + bq + 8), f1);
#pragma unroll
            for (int e = 0; e < 8; ++e) { s3[(bq + e) * SL + bi] = f2bf(f0[e] * GAM[bq + e]); s3[(bq + 8 + e) * SL + bi] = f2bf(f1[e] * GAM[bq + 8 + e]); }
        }
        __syncthreads();
        {
            R1_IDX const int rowb = scan_row(b, d, c * 64 + bi); (void)rowb;
            f32x4 acc[4]; acc_zero(acc);
            mm64<SL, SL>(sT, s3, acc, wave, fr, fq);
            bf16_t* mt = gMT + (size_t)it * 4096;
#pragma unroll
            for (int nt = 0; nt < 4; ++nt)
#pragma unroll
                for (int r = 0; r < 4; ++r) { const int n = nt * 16 + fq * 4 + r; mt[n * 64 + m] = f2bf(acc[nt][r] + (n == m ? GAM[m] : 0.f)); }
#pragma unroll
            for (int nt = 0; nt < 4; ++nt) {
                const int n = nt * 16 + fq * 4; const uint2 u = *(const uint2*)(s2 + m * SL + n);
                acc[nt] = (f32x4){bflo(u.x) * GAM[n], bfhi(u.x) * GAM[n + 1], bflo(u.y) * GAM[n + 2], bfhi(u.y) * GAM[n + 3]};
            }
            mm64<SL, SL>(s0, s3, acc, wave, fr, fq);
            st_tr(s1, acc, m, fq);
            float v8[8];
#pragma unroll
            for (int hh = 0; hh < 2; ++hh) {
                xs8(P, mu, rowb, 1024 + h * 64 + bq + hh * 8, v8);
#pragma unroll
                for (int e = 0; e < 8; ++e) sc[(bq + hh * 8 + e) * SL + bi] = f2bf(v8[e]);
            }
        }
        __syncthreads();
        {
            R1_IDX const int rowb = scan_row(b, d, c * 64 + bi); (void)rowb;
            f32x4 acc[4]; acc_zero(acc);
            mm64<SL, SL>(sc, sb, acc, wave, fr, fq);
            bf16_t* yl = gYL + (size_t)it * 4096;
#pragma unroll
            for (int nt = 0; nt < 4; ++nt) store_bf16x4(yl + m * 64 + nt * 16 + fq * 4, acc[nt]);
            acc_zero(acc);
            mm64<SL, SL>(sc, s1, acc, wave, fr, fq);
            bf16_t* nl = gNL + (size_t)it * 4096;
#pragma unroll
            for (int nt = 0; nt < 4; ++nt) store_bf16x4(nl + m * 64 + nt * 16 + fq * 4, acc[nt]);
        }
        __syncthreads();
    }
}
__device__ __forceinline__ void ph_r2(const Params& p, char* smem) {
    const int tid = tidx(), lane = tid & 63, wave = tid >> 6, fr = lane & 15, fq = lane >> 4;
    const char* gMT = (const char*)(p.ws + O_X + X_MT); const char* gNL = (const char*)(p.ws + O_H);
    uint4* gS0 = (uint4*)(p.ws + O_X + X_S0);
    const int wofs = __builtin_amdgcn_readfirstlane(wave) * 1024;
    const unsigned lds0 = (unsigned)(uintptr_t)smem;
    const unsigned mtaddr = lds0 + fr * 128 + fq * 8, nladdr = lds0 + (wave * 16 + fr) * 128 + fq * 8;
    auto issue = [&](size_t cp, int slot) {
        char* dst = smem + slot * 16384 + wofs;
        const char* s0 = gMT + cp * 8192 + wofs + lane * 16; const char* s1 = gNL + cp * 8192 + wofs + lane * 16;
        __builtin_amdgcn_global_load_lds((const unsigned*)s0, (unsigned*)dst, 16, 0, 0);
        __builtin_amdgcn_global_load_lds((const unsigned*)(s0 + 4096), (unsigned*)(dst + 4096), 16, 0, 0);
        __builtin_amdgcn_global_load_lds((const unsigned*)s1, (unsigned*)(dst + 8192), 16, 0, 0);
        __builtin_amdgcn_global_load_lds((const unsigned*)(s1 + 4096), (unsigned*)(dst + 12288), 16, 0, 0);
    };
    for (int it = blockIdx.x; it < 64; it += gridDim.x) {
        f32x4 st[4];
#pragma unroll
        for (int tt = 0; tt < 4; ++tt) st[tt] = (f32x4){0.f, 0.f, 0.f, 0.f};
        const size_t cp0 = (size_t)it * 68;
        issue(cp0, 0); issue(cp0 + 1, 1); issue(cp0 + 2, 2);
        for (int c4 = 0; c4 < 68; c4 += 4) {
#pragma unroll
            for (int j = 0; j < 4; ++j) {
                const int c = c4 + j;
                if (c < 65) asm volatile("s_waitcnt vmcnt(8)" ::: "memory"); else asm volatile("s_waitcnt vmcnt(0)" ::: "memory");
                __builtin_amdgcn_s_barrier();
                asm volatile("" ::: "memory");
                uint2 mx[4][2][2], nvv[4];
                asm volatile("ds_read_b64 %0, %1 offset:0" : "=v"(mx[0][0][0]) : "v"(mtaddr + j * 16384));
                asm volatile("ds_read_b64 %0, %1 offset:32" : "=v"(mx[0][0][1]) : "v"(mtaddr + j * 16384));
                asm volatile("ds_read_b64 %0, %1 offset:64" : "=v"(mx[0][1][0]) : "v"(mtaddr + j * 16384));
                asm volatile("ds_read_b64 %0, %1 offset:96" : "=v"(mx[0][1][1]) : "v"(mtaddr + j * 16384));
                asm volatile("ds_read_b64 %0, %1 offset:8192" : "=v"(nvv[0]) : "v"(nladdr + j * 16384));
                asm volatile("ds_read_b64 %0, %1 offset:2048" : "=v"(mx[1][0][0]) : "v"(mtaddr + j * 16384));
                asm volatile("ds_read_b64 %0, %1 offset:2080" : "=v"(mx[1][0][1]) : "v"(mtaddr + j * 16384));
                asm volatile("ds_read_b64 %0, %1 offset:2112" : "=v"(mx[1][1][0]) : "v"(mtaddr + j * 16384));
                asm volatile("ds_read_b64 %0, %1 offset:2144" : "=v"(mx[1][1][1]) : "v"(mtaddr + j * 16384));
                asm volatile("ds_read_b64 %0, %1 offset:8224" : "=v"(nvv[1]) : "v"(nladdr + j * 16384));
                asm volatile("ds_read_b64 %0, %1 offset:4096" : "=v"(mx[2][0][0]) : "v"(mtaddr + j * 16384));
                asm volatile("ds_read_b64 %0, %1 offset:4128" : "=v"(mx[2][0][1]) : "v"(mtaddr + j * 16384));
                asm volatile("ds_read_b64 %0, %1 offset:4160" : "=v"(mx[2][1][0]) : "v"(mtaddr + j * 16384));
                asm volatile("ds_read_b64 %0, %1 offset:4192" : "=v"(mx[2][1][1]) : "v"(mtaddr + j * 16384));
                asm volatile("ds_read_b64 %0, %1 offset:8256" : "=v"(nvv[2]) : "v"(nladdr + j * 16384));
                asm volatile("ds_read_b64 %0, %1 offset:6144" : "=v"(mx[3][0][0]) : "v"(mtaddr + j * 16384));
                asm volatile("ds_read_b64 %0, %1 offset:6176" : "=v"(mx[3][0][1]) : "v"(mtaddr + j * 16384));
                asm volatile("ds_read_b64 %0, %1 offset:6208" : "=v"(mx[3][1][0]) : "v"(mtaddr + j * 16384));
                asm volatile("ds_read_b64 %0, %1 offset:6240" : "=v"(mx[3][1][1]) : "v"(mtaddr + j * 16384));
                asm volatile("ds_read_b64 %0, %1 offset:8288" : "=v"(nvv[3]) : "v"(nladdr + j * 16384));
                u32x4 sb[2];
#pragma unroll
                for (int s_ = 0; s_ < 2; ++s_) sb[s_] = (u32x4){pack2(st[2 * s_][0], st[2 * s_][1]), pack2(st[2 * s_][2], st[2 * s_][3]), pack2(st[2 * s_ + 1][0], st[2 * s_ + 1][1]), pack2(st[2 * s_ + 1][2], st[2 * s_ + 1][3])};
                asm volatile("s_waitcnt lgkmcnt(0)" ::: "memory");
                __builtin_amdgcn_sched_barrier(0);
#pragma unroll
                for (int tt = 0; tt < 4; ++tt) {
                    f32x4 acc = {bflo(nvv[tt].x), bfhi(nvv[tt].x), bflo(nvv[tt].y), bfhi(nvv[tt].y)};
#pragma unroll
                    for (int s_ = 0; s_ < 2; ++s_)
                        acc = __builtin_amdgcn_mfma_f32_16x16x32_bf16(__builtin_bit_cast(bf16x8, (u32x4){mx[tt][s_][0].x, mx[tt][s_][0].y, mx[tt][s_][1].x, mx[tt][s_][1].y}), __builtin_bit_cast(bf16x8, sb[s_]), acc, 0, 0, 0);
                    st[tt] = acc;
                }
                *(u32x4*)(gS0 + ((cp0 + c) * 4 + wave) * 128 + lane) = sb[0]; *(u32x4*)(gS0 + ((cp0 + c) * 4 + wave) * 128 + 64 + lane) = sb[1];
                if (c + 3 < 68) issue(cp0 + c + 3, (j + 3) & 3);
            }
        }
        asm volatile("s_waitcnt vmcnt(0)" ::: "memory");
        __syncthreads();
    }
}
__device__ __forceinline__ void ph_r3(const Params& p) {
    const int tid = tidx(), lane = tid & 63, wave = tid >> 6, fr = lane & 15, fq = lane >> 4;
    const bf16_t* gGT = (const bf16_t*)(p.ws + O_X + X_GT); const bf16_t* gYL = (const bf16_t*)(p.ws + O_X + X_YL);
    const u32x4* gS0 = (const u32x4*)(p.ws + O_X + X_S0);
    bf16_t* YS = (bf16_t*)(p.ws + O_H);
    for (int it = blockIdx.x * 4 + wave; it < NCP; it += gridDim.x * 4) {
        const int c = it % 68, d = (it / 68) & 1, h = (it / 136) & 7, b = it / 1088;
        const bf16_t* gt = gGT + (size_t)it * 4096; const bf16_t* yl = gYL + (size_t)it * 4096;
        u32x4 gf[4][2];
#pragma unroll
        for (int tt = 0; tt < 4; ++tt)
#pragma unroll
            for (int s_ = 0; s_ < 2; ++s_) {
                const bf16_t* q = gt + (tt * 16 + fr) * 64 + s_ * 32 + fq * 4;
                const uint2 a0 = *(const uint2*)q, a1 = *(const uint2*)(q + 16);
                gf[tt][s_] = (u32x4){a0.x, a0.y, a1.x, a1.y};
            }
#pragma unroll
        for (int vg = 0; vg < 4; ++vg) {
            const u32x4 sb0 = gS0[((size_t)it * 4 + vg) * 128 + lane], sb1 = gS0[((size_t)it * 4 + vg) * 128 + 64 + lane];
#pragma unroll
            for (int tt = 0; tt < 4; ++tt) {
                const uint2 yv = *(const uint2*)(yl + (vg * 16 + fr) * 64 + tt * 16 + fq * 4);
                f32x4 acc = {bflo(yv.x), bfhi(yv.x), bflo(yv.y), bfhi(yv.y)};
                acc = __builtin_amdgcn_mfma_f32_16x16x32_bf16(__builtin_bit_cast(bf16x8, gf[tt][0]), __builtin_bit_cast(bf16x8, sb0), acc, 0, 0, 0);
                acc = __builtin_amdgcn_mfma_f32_16x16x32_bf16(__builtin_bit_cast(bf16x8, gf[tt][1]), __builtin_bit_cast(bf16x8, sb1), acc, 0, 0, 0);
#pragma unroll
                for (int r = 0; r < 4; ++r) {
                    const int row = scan_row(b, d, c * 64 + tt * 16 + fq * 4 + r);
                    YS[((size_t)d * RT + row) * 512 + h * 64 + vg * 16 + fr] = f2bf(acc[r]);
                }
            }
        }
    }
}

__device__ __forceinline__ void ph_rpost(const Params& p, int l) {
    const int lane = tidx() & 63, wave = tidx() >> 6;
    const bf16_t* P = (const bf16_t*)(p.ws + O_P); const float* mu = p.in[I_MU] + l * 1792;
    const float* gng = p.in[I_GNG] + l * 512; const float* gnb = p.in[I_GNB] + l * 512;
    const float* BON = (const float*)(p.ws + O_X + X_BON); const bf16_t* YS = (const bf16_t*)(p.ws + O_H);
    const bf16_t* RG = (const bf16_t*)(p.ws + O_RG); bf16_t* RWO = (bf16_t*)(p.ws + O_RWO);
    for (int row = blockIdx.x * 4 + wave; row < RT; row += gridDim.x * 4) {
        const int col = lane * 8, h = lane >> 3;
        float v8[8], g8[8], y0[8], y1[8];
        xs8(P, mu, row, 1024 + col, v8);
        unpack8(*(const uint4*)(RG + (size_t)row * 512 + col), g8);
        unpack8(*(const uint4*)(YS + ((size_t)0 * RT + row) * 512 + col), y0);
        unpack8(*(const uint4*)(YS + ((size_t)1 * RT + row) * 512 + col), y1);
        const float bs = BON[((size_t)0 * RT + row) * 8 + h] + BON[((size_t)1 * RT + row) * 8 + h];
        float y[8]; float sm = 0.f;
#pragma unroll
        for (int j = 0; j < 8; ++j) { y[j] = y0[j] + y1[j]; sm += y[j]; }
        sm += __shfl_xor(sm, 1); sm += __shfl_xor(sm, 2); sm += __shfl_xor(sm, 4);
        const float mean = sm * (1.f / 64.f);
        float vs = 0.f;
#pragma unroll
        for (int j = 0; j < 8; ++j) { const float dlt = y[j] - mean; vs += dlt * dlt; }
        vs += __shfl_xor(vs, 1); vs += __shfl_xor(vs, 2); vs += __shfl_xor(vs, 4);
        const float rstd = rsqrtf(vs * (1.f / 64.f) + 64e-5f);
        float o[8];
#pragma unroll
        for (int j = 0; j < 8; ++j) o[j] = ((y[j] - mean) * rstd * gng[col + j] + gnb[col + j] + bs * v8[j]) * g8[j];
        *(uint4*)(RWO + (size_t)row * 512 + col) = pack8(o);
    }
}

__device__ __forceinline__ void ph_f1(const Params& p, int l, char* smem) {
    const bf16_t* P = (const bf16_t*)(p.ws + O_P); const bf16_t* CSC = (const bf16_t*)(p.ws + O_CSC);
    bf16_t* YT2 = (bf16_t*)(p.ws + O_YT2); bf16_t* YTC = (bf16_t*)(p.ws + O_YTC);
    const int nitems = 1024 + (l < NLAYER - 1 ? 64 : 0);
    for (int it = blockIdx.x; it < nitems; it += gridDim.x) {
        f32x4 acc[4][4];
        if (it < 1024) {
            const int b = it >> 8, g = (it >> 6) & 3, part = (it >> 5) & 1, j = it & 31;
            RPPlain rpa{CSC + (size_t)part * 128 * 128, 128};
            const bf16_t* pb = P + (size_t)b * SEQ * LDP + g * 128;
            auto rpb = [&](int r) -> const bf16_t* { return pb + (size_t)(64 * (r & 63) + 2 * j + (r >> 6)) * LDP; };
            gemm_core_gb<4>(rpa, rpb, 128, acc, smem);
            acc_foreach<4>(acc, [&](int m, int n, const f32x4& v) {
                const int t1 = n & 63, t2 = 2 * j + (n >> 6);
                store_bf16x4(YT2 + ((size_t)(b * 512 + g * 128 + m) * 64 + t2) * 128 + part * 64 + t1, v);
            });
        } else {
            const int jj = it - 1024, b = jj >> 4, g = (jj >> 2) & 3, part = (jj >> 1) & 1, nt = jj & 1;
            RPPlain rpa{CSC + (size_t)part * 128 * 128, 128};
            gemm_core_g<4>(rpa, P + (size_t)(RL + b * CTX + nt * 128) * LDP + g * 128, LDP, 128, acc, smem);
            acc_foreach<4>(acc, [&](int m, int n, const f32x4& v) {
                store_bf16x4(YTC + ((size_t)(b * 512 + g * 128 + m)) * 512 + part * 256 + nt * 128 + n, v);
            });
        }
    }
}
__device__ __forceinline__ void ph_fa(const Params& p, char* smem) {
    const bf16_t* YT2 = (const bf16_t*)(p.ws + O_YT2); const bf16_t* D128 = (const bf16_t*)(p.ws + O_D128);
    const float* TWC = (const float*)(p.ws + O_TWC); const float* TWS = (const float*)(p.ws + O_TWS);
    bf16_t* A2 = (bf16_t*)(p.ws + O_A2);
    for (int it = blockIdx.x; it < 1024; it += gridDim.x) {
        f32x4 acc[4][4];
        RPPlain rpa{D128, 128};
        gemm_core_g<4>(rpa, YT2 + (size_t)it * 128 * 128, 128, 128, acc, smem);
        const int lane = tidx() & 63, wave = tidx() >> 6, wr = wave >> 1, wc = wave & 1, fr = lane & 15, fq = lane >> 4;
        float* U = (float*)smem;
        if (wr == 1) {
#pragma unroll
            for (int i = 0; i < 4; ++i)
#pragma unroll
                for (int j = 0; j < 4; ++j) *(f32x4*)(U + (i * 16 + fr) * 132 + wc * 64 + j * 16 + fq * 4) = acc[i][j];
        }
        __syncthreads();
        if (wr == 0) {
#pragma unroll
            for (int i = 0; i < 4; ++i) {
                const int k1 = i * 16 + fr;
#pragma unroll
                for (int j = 0; j < 4; ++j) {
                    const int r = wc * 64 + j * 16 + fq * 4;
                    const int R = it * 128 + r, bn = R >> 6, t2 = R & 63, b = bn >> 9, n = bn & 511;
                    const f32x4 ai = *(const f32x4*)(U + k1 * 132 + r);
                    const f32x4 c = *(const f32x4*)(TWC + k1 * 64 + t2), sn = *(const f32x4*)(TWS + k1 * 64 + t2);
                    const f32x4 ar = acc[i][j];
                    const f32x4 pr = ar * c - ai * sn, pi = ar * sn + ai * c;
                    bf16_t* dst = A2 + ((size_t)(b * 64 + k1) * 512 + n) * 128 + t2;
                    store_bf16x4(dst, pr); store_bf16x4(dst + 64, pi);
                }
            }
        }
        __syncthreads();
    }
}
__device__ __forceinline__ void ph_fb(const Params& p, int l, char* smem) {
    const bf16_t* A2 = (const bf16_t*)(p.ws + O_A2); const bf16_t* E64 = (const bf16_t*)(p.ws + O_E64);
    const bf16_t* CST2 = (const bf16_t*)(p.ws + O_CST256); const bf16_t* YTC = (const bf16_t*)(p.ws + O_YTC);
    bf16_t* FA = (bf16_t*)(p.ws + O_FA);
    const int nitems = 1024 + (l < NLAYER - 1 ? 32 : 0);
    for (int it = blockIdx.x; it < nitems; it += gridDim.x) {
        if (it < 1024) {
            const int b = it >> 8, k1 = (it >> 2) & 63, nt = it & 3;
            f32x4 acc[2][4];
            RPPlain rpa{E64, 128};
            gemm_core_g<2>(rpa, A2 + ((size_t)(b * 64 + k1) * 512 + nt * 128) * 128, 128, 128, acc, smem);
            const float sc = 0.001381067932004975f;
            acc_foreach<2>(acc, [&](int m, int n, const f32x4& v) { f32x4 o = v * sc; store_bf16x4(FA + (size_t)(b * SEQ + k1 + 64 * m) * 512 + nt * 128 + n, o); });
        } else {
            const int j = it - 1024, b = j >> 3, mt = (j >> 2) & 1, nt = j & 3;
            f32x4 acc[4][4];
            RPPlain rp{CST2 + (size_t)mt * 128 * 512, 512};
            gemm_core_g<4>(rp, YTC + ((size_t)b * 512 + nt * 128) * 512, 512, 512, acc, smem);
            const float sc = 0.005524271728019903f;
            acc_foreach<4>(acc, [&](int m, int n, const f32x4& v) { f32x4 o = v * sc; store_bf16x4(FA + (size_t)(RL + b * CTX + mt * 128 + m) * 512 + nt * 128 + n, o); });
        }
    }
}

__device__ __forceinline__ void ph_mg(const Params& p, int l, char* smem) {
    const bf16_t* P = (const bf16_t*)(p.ws + O_P);
    const bf16_t* A0 = (const bf16_t*)(p.ws + O_FA); const bf16_t* A1 = (const bf16_t*)(p.ws + O_ATT); const bf16_t* A2 = (const bf16_t*)(p.ws + O_RWO);
    const bf16_t* W0 = (const bf16_t*)(p.ws + O_WB + W_PA); const bf16_t* W1 = (const bf16_t*)(p.ws + O_WB + W_PB); const bf16_t* W2 = (const bf16_t*)(p.ws + O_WB + W_PC);
    bf16_t* MG = (bf16_t*)(p.ws + O_H);
    const int nmt = (l < NLAYER - 1) ? RT / 64 : RL / 64;
    for (int it = blockIdx.x; it < nmt * 8; it += gridDim.x) {
        const int mt = it >> 3, nt = it & 7;
        f32x4 tot[2][4];
#pragma unroll
        for (int i = 0; i < 2; ++i)
#pragma unroll
            for (int j = 0; j < 4; ++j) tot[i][j] = (f32x4){0.f, 0.f, 0.f, 0.f};
#pragma unroll 1
        for (int br = 0; br < 3; ++br) {
            const bf16_t* Ab = br == 0 ? A0 : (br == 1 ? A1 : A2);
            const bf16_t* Wb = br == 0 ? W0 : (br == 1 ? W1 : W2);
            f32x4 acc[2][4];
            RPPlain rp{Ab + (size_t)mt * 64 * 512, 512};
            gemm_core_g<2>(rp, Wb + (size_t)nt * 128 * 512, 512, 512, acc, smem);
            const int lane = tidx() & 63, wave = tidx() >> 6, wr = wave >> 1, wc = wave & 1, fr = lane & 15, fq = lane >> 4;
#pragma unroll
            for (int i = 0; i < 2; ++i)
#pragma unroll
                for (int j = 0; j < 4; ++j) {
                    const int m = wr * 32 + i * 16 + fr, n = wc * 64 + j * 16 + fq * 4;
                    const uint2 gu = *(const uint2*)(P + (size_t)(mt * 64 + m) * LDP + PG0 + br * 1024 + nt * 128 + n);
                    tot[i][j][0] += bflo(gu.x) * acc[i][j][0]; tot[i][j][1] += bfhi(gu.x) * acc[i][j][1];
                    tot[i][j][2] += bflo(gu.y) * acc[i][j][2]; tot[i][j][3] += bfhi(gu.y) * acc[i][j][3];
                }
        }
        acc_foreach<2>(tot, [&](int m, int n, const f32x4& v) { store_bf16x4(MG + (size_t)(mt * 64 + m) * 1024 + nt * 128 + n, v); });
    }
}
__device__ __forceinline__ void ph_out(const Params& p, int l, char* smem) {
    const bf16_t* MG = (const bf16_t*)(p.ws + O_H); const bf16_t* W = (const bf16_t*)(p.ws + O_WB + W_OUT);
    float* xcur = (float*)(p.ws + O_XCUR); const float* mod = (const float*)(p.ws + O_MOD);
    const int nmt = (l < NLAYER - 1) ? RT / 64 : RL / 64;
    for (int it = blockIdx.x; it < nmt * 8; it += gridDim.x) {
        const int mt = it >> 3, nt = it & 7;
        f32x4 acc[2][4];
        RPPlain rp{MG + (size_t)mt * 64 * 1024, 1024};
        gemm_core_g<2>(rp, W + (size_t)nt * 128 * 1024, 1024, 1024, acc, smem);
        acc_foreach<2>(acc, [&](int m, int n, const f32x4& v) {
            const int row = mt * 64 + m, col = nt * 128 + n;
            const float4 g = *(const float4*)(mod + (size_t)(l * 5 + modidx(row)) * 6144 + 2048 + col);
            float4* xp = (float4*)(xcur + (size_t)row * 1024 + col);
            float4 x = *xp; x.x += g.x * v[0]; x.y += g.y * v[1]; x.z += g.z * v[2]; x.w += g.w * v[3]; *xp = x;
        });
    }
}

__device__ __forceinline__ void ph_n2(const Params& p, int l, char* smem) {
    const int tid = tidx(), lane = tid & 63, wave = tid >> 6;
    unsigned* lcnt = (unsigned*)smem;
    unsigned* gbase = lcnt + 16;
    int* rec = (int*)(smem + 256);
    float4* rwl = (float4*)(smem + 8192);
    for (int idx = tid; idx < 4096; idx += 256) {
        const int k = idx >> 2, pp = idx & 3;
        rwl[(((k >> 8) * 16 + (k & 3) * 4 + pp) << 6) + ((k & 255) >> 2)] = *(const float4*)(p.in[I_RW] + (size_t)k * 16 + pp * 4);
    }
    if (tid < 16) lcnt[tid] = 0u;
    __syncthreads();
    int nrec = 0;
    const float* xcur = (const float*)(p.ws + O_XCUR); const float* mod = (const float*)(p.ws + O_MOD);
    bf16_t* H = (bf16_t*)(p.ws + O_H);
    unsigned* cnt = (unsigned*)(p.ws + O_CNT); int* LTOK = (int*)(p.ws + O_LTOK); float* LW = (float*)(p.ws + O_LW); int* SLOT = (int*)(p.ws + O_SLOT);
    const float* g = p.in[I_N2G] + l * 1024; const float* rw = p.in[I_RW]; const float* rb = p.in[I_RB];
    const int nrows = (l < NLAYER - 1) ? RT : RL;
    for (int row = blockIdx.x * 4 + wave; row < nrows; row += gridDim.x * 4) {
        const float* x = xcur + (size_t)row * 1024; const float* md = mod + (size_t)(l * 5 + modidx(row)) * 6144;
        float4 v[4]; float ss = 0.f;
#pragma unroll
        for (int i = 0; i < 4; ++i) { v[i] = *(const float4*)(x + lane * 4 + 256 * i); ss += v[i].x * v[i].x + v[i].y * v[i].y + v[i].z * v[i].z + v[i].w * v[i].w; }
        ss = wsum(ss);
        const float rstd = rsqrtf(ss * (1.f / 1024.f) + 1e-6f);
        float lg[16];
#pragma unroll
        for (int e = 0; e < 16; ++e) lg[e] = 0.f;
#pragma unroll
        for (int i = 0; i < 4; ++i) {
            const int c = lane * 4 + 256 * i;
            const float4 gg = *(const float4*)(g + c), sc = *(const float4*)(md + 4096 + c), sh = *(const float4*)(md + 3072 + c);
            const float hv[4] = {v[i].x * rstd * gg.x * (1.f + sc.x) + sh.x, v[i].y * rstd * gg.y * (1.f + sc.y) + sh.y,
                                 v[i].z * rstd * gg.z * (1.f + sc.z) + sh.z, v[i].w * rstd * gg.w * (1.f + sc.w) + sh.w};
            f32x4 h4 = {hv[0], hv[1], hv[2], hv[3]};
            store_bf16x4(H + (size_t)row * 1024 + c, h4);
#pragma unroll
            for (int j = 0; j < 4; ++j) {
                const float4* wr_ = rwl + ((i * 16 + j * 4) << 6) + lane;
                const float4 w0 = wr_[0], w1 = wr_[64], w2 = wr_[128], w3 = wr_[192];
                lg[0] += hv[j] * w0.x; lg[1] += hv[j] * w0.y; lg[2] += hv[j] * w0.z; lg[3] += hv[j] * w0.w;
                lg[4] += hv[j] * w1.x; lg[5] += hv[j] * w1.y; lg[6] += hv[j] * w1.z; lg[7] += hv[j] * w1.w;
                lg[8] += hv[j] * w2.x; lg[9] += hv[j] * w2.y; lg[10] += hv[j] * w2.z; lg[11] += hv[j] * w2.w;
                lg[12] += hv[j] * w3.x; lg[13] += hv[j] * w3.y; lg[14] += hv[j] * w3.z; lg[15] += hv[j] * w3.w;
            }
        }
        float sc_[16], sel[16];
#pragma unroll
        for (int e = 0; e < 16; ++e) { lg[e] = wsum(lg[e]); sc_[e] = 1.f / (1.f + expf(-lg[e])); sel[e] = sc_[e] + rb[e]; }
        int best = 0; float bestv = -1e30f;
#pragma unroll
        for (int gi = 0; gi < 4; ++gi) {
            float m1 = -1e30f, m2 = -1e30f;
#pragma unroll
            for (int j = 0; j < 4; ++j) { const float s = sel[gi * 4 + j]; if (s > m1) { m2 = m1; m1 = s; } else if (s > m2) m2 = s; }
            const float gs = m1 + m2;
            if (gs > bestv) { bestv = gs; best = gi; }
        }
        float s4[4] = {0.f, 0.f, 0.f, 0.f}, c4[4] = {0.f, 0.f, 0.f, 0.f};
#pragma unroll
        for (int gi = 0; gi < 4; ++gi)
#pragma unroll
            for (int j = 0; j < 4; ++j) if (gi == best) { s4[j] = sel[gi * 4 + j]; c4[j] = sc_[gi * 4 + j]; }
        int i1 = 0; float v1 = s4[0], w1 = c4[0];
#pragma unroll
        for (int j = 1; j < 4; ++j) if (s4[j] > v1) { v1 = s4[j]; i1 = j; w1 = c4[j]; }
        int i2 = -1; float v2 = -1e30f, w2 = 0.f;
#pragma unroll
        for (int j = 0; j < 4; ++j) if (j != i1 && s4[j] > v2) { v2 = s4[j]; i2 = j; w2 = c4[j]; }
        if (lane == 0) {
            const float inv = 1.f / (w1 + w2);
            const int e1 = best * 4 + i1, e2 = best * 4 + i2;
            const unsigned r1 = atomicAdd(&lcnt[e1], 1u), r2 = atomicAdd(&lcnt[e2], 1u);
            int* rc = rec + (wave * 32 + nrec) * 8;
            rc[0] = row; rc[1] = e1; rc[2] = e2; rc[3] = (int)r1; rc[4] = (int)r2; rc[5] = __float_as_int(w1 * inv); rc[6] = __float_as_int(w2 * inv);
        }
        ++nrec;
    }
    __syncthreads();
    if (tid < 16) gbase[tid] = lcnt[tid] ? atomicAdd(&cnt[tid], lcnt[tid]) : 0u;
    __syncthreads();
    for (int i = lane; i < nrec; i += 64) {
        const int* rc = rec + (wave * 32 + i) * 8;
        const int row = rc[0], e1 = rc[1], e2 = rc[2];
        const unsigned p1 = gbase[e1] + (unsigned)rc[3], p2 = gbase[e2] + (unsigned)rc[4];
        LTOK[(size_t)e1 * RT + p1] = row; LW[(size_t)e1 * RT + p1] = __int_as_float(rc[5]);
        LTOK[(size_t)e2 * RT + p2] = row; LW[(size_t)e2 * RT + p2] = __int_as_float(rc[6]);
        SLOT[row * 2] = (e1 << 20) | (int)p1; SLOT[row * 2 + 1] = (e2 << 20) | (int)p2;
    }
}

struct MoeTiles { int tb[17]; int sm; };
__device__ __forceinline__ void moe_tiles(const Params& p, int l, int* s_tb) {
    if (tidx() == 0) {
        const unsigned* cnt = (const unsigned*)(p.ws + O_CNT);
        int a = 0;
        for (int e = 0; e < 16; ++e) { s_tb[e] = a; a += ((int)cnt[e] + 127) >> 7; }
        s_tb[16] = a;
    }
    __syncthreads();
}
__device__ __forceinline__ void ph_e1(const Params& p, int l, char* smem) {
    int* s_tb = (int*)(smem + 73728);
    moe_tiles(p, l, s_tb);
    const bf16_t* H = (const bf16_t*)(p.ws + O_H); bf16_t* ACT = (bf16_t*)(p.ws + O_P);
    const unsigned* cnt = (const unsigned*)(p.ws + O_CNT); const int* LTOK = (const int*)(p.ws + O_LTOK); const float* LW = (const float*)(p.ws + O_LW);
    const int sm = (l < NLAYER - 1) ? RT / 128 : RL / 128;
    const int total = (sm + s_tb[16]) * 8;
    for (int it = blockIdx.x; it < total; it += gridDim.x) {
        const int mt = it >> 3, nt = it & 7;
        int e = 16, erow0 = mt * 128, lt = 0;
        if (mt >= sm) { const int q = mt - sm; e = 0; while (q >= s_tb[e + 1]) ++e; lt = q - s_tb[e]; erow0 = RT + q * 128; }
        const int cnte = (e == 16) ? 0 : (int)cnt[e];
        auto rp = [&](int r) -> const bf16_t* {
            if (e == 16) return H + (size_t)(mt * 128 + r) * 1024;
            const int idx = lt * 128 + r;
            const int tok = idx < cnte ? LTOK[(size_t)e * RT + idx] : 0;
            return H + (size_t)tok * 1024;
        };
        f32x4 acc[4][4];
        gemm_core_g<4>(rp, (const bf16_t*)(p.ws + O_WB + W_GU) + (size_t)e * 1024 * 1024 + (size_t)nt * 128 * 1024, 1024, 1024, acc, smem);
        {
            const int lane = tidx() & 63, wave = tidx() >> 6, wr = wave >> 1, wc = wave & 1, fr = lane & 15, fq = lane >> 4;
            float* U = (float*)smem;
            if (wc == 1) {
#pragma unroll
                for (int i = 0; i < 4; ++i)
#pragma unroll
                    for (int j = 0; j < 4; ++j) *(f32x4*)(U + (wr * 64 + i * 16 + fr) * 68 + j * 16 + fq * 4) = acc[i][j];
            }
            __syncthreads();
            if (wc == 0) {
#pragma unroll
                for (int i = 0; i < 4; ++i) {
                    const int m = wr * 64 + i * 16 + fr;
                    float wgt = 1.f;
                    if (e != 16) { const int idx = lt * 128 + m; wgt = idx < cnte ? LW[(size_t)e * RT + idx] : 0.f; }
#pragma unroll
                    for (int j = 0; j < 4; ++j) {
                        const f32x4 u = *(const f32x4*)(U + m * 68 + j * 16 + fq * 4);
                        f32x4 o;
#pragma unroll
                        for (int r = 0; r < 4; ++r) o[r] = siluf_(acc[i][j][r]) * u[r] * wgt;
                        store_bf16x4(ACT + (size_t)(erow0 + m) * 512 + nt * 64 + j * 16 + fq * 4, o);
                    }
                }
            }
            __syncthreads();
        }
    }
}
__device__ __forceinline__ void ph_e2(const Params& p, int l, char* smem) {
    int* s_tb = (int*)(smem + 73728);
    moe_tiles(p, l, s_tb);
    const bf16_t* ACT = (const bf16_t*)(p.ws + O_P); bf16_t* YE = (bf16_t*)(p.ws + O_X + X_YE);
    const int sm = (l < NLAYER - 1) ? RT / 128 : RL / 128;
    const int total = (sm + s_tb[16]) * 8;
    for (int it = blockIdx.x; it < total; it += gridDim.x) {
        const int mt = it >> 3, nt = it & 7;
        int e = 16, erow0 = mt * 128;
        if (mt >= sm) { const int q = mt - sm; e = 0; while (q >= s_tb[e + 1]) ++e; erow0 = RT + q * 128; }
        RPPlain rp{ACT + (size_t)erow0 * 512, 512};
        f32x4 acc[4][4];
        gemm_core_g<4>(rp, (const bf16_t*)(p.ws + O_WB + W_D) + (size_t)e * 1024 * 512 + (size_t)nt * 128 * 512, 512, 512, acc, smem);
        acc_foreach<4>(acc, [&](int m, int n, const f32x4& v) { store_bf16x4(YE + (size_t)(erow0 + m) * 1024 + nt * 128 + n, v); });
    }
}
__device__ __forceinline__ void ph_e3(const Params& p, int l, char* smem) {
    int* s_tb = (int*)(smem + 73728);
    moe_tiles(p, l, s_tb);
    const int lane = tidx() & 63, wave = tidx() >> 6;
    const bf16_t* YE = (const bf16_t*)(p.ws + O_X + X_YE); const int* SLOT = (const int*)(p.ws + O_SLOT);
    float* xcur = (float*)(p.ws + O_XCUR); const float* mod = (const float*)(p.ws + O_MOD);
    bf16_t* H = (bf16_t*)(p.ws + O_H);
    const bool last = l == NLAYER - 1;
    const int nrows = last ? RL : RT;
    const float* gn = last ? p.in[I_FNG] : p.in[I_N1G] + (l + 1) * 1024;
    for (int row = blockIdx.x * 4 + wave; row < nrows; row += gridDim.x * 4) {
        const int s1 = SLOT[row * 2], s2 = SLOT[row * 2 + 1];
        const size_t r0 = row, r1 = (size_t)RT + s_tb[s1 >> 20] * 128 + (s1 & 0xfffff), r2 = (size_t)RT + s_tb[s2 >> 20] * 128 + (s2 & 0xfffff);
        const float* g2 = mod + (size_t)(l * 5 + modidx(row)) * 6144 + 5120;
        float xv[2][8]; float ss = 0.f;
#pragma unroll
        for (int i = 0; i < 2; ++i) {
            const int c = lane * 8 + 512 * i;
            float a[8], b[8], d[8];
            unpack8(*(const uint4*)(YE + r0 * 1024 + c), a); unpack8(*(const uint4*)(YE + r1 * 1024 + c), b); unpack8(*(const uint4*)(YE + r2 * 1024 + c), d);
            float4* xp = (float4*)(xcur + (size_t)row * 1024 + c);
            const float4 x0 = xp[0], x1 = xp[1];
            const float4 ga = *(const float4*)(g2 + c), gb = *(const float4*)(g2 + c + 4);
            const float xo[8] = {x0.x, x0.y, x0.z, x0.w, x1.x, x1.y, x1.z, x1.w}, gg[8] = {ga.x, ga.y, ga.z, ga.w, gb.x, gb.y, gb.z, gb.w};
#pragma unroll
            for (int e = 0; e < 8; ++e) { xv[i][e] = xo[e] + gg[e] * (a[e] + b[e] + d[e]); ss += xv[i][e] * xv[i][e]; }
            if (!last) { xp[0] = make_float4(xv[i][0], xv[i][1], xv[i][2], xv[i][3]); xp[1] = make_float4(xv[i][4], xv[i][5], xv[i][6], xv[i][7]); }
        }
        ss = wsum(ss);
        const float rstd = rsqrtf(ss * (1.f / 1024.f) + 1e-6f);
        const float* md = mod + (size_t)((l + 1) * 5 + modidx(row)) * 6144;
#pragma unroll
        for (int i = 0; i < 2; ++i) {
            const int c = lane * 8 + 512 * i;
            const float4 n0 = *(const float4*)(gn + c), n1 = *(const float4*)(gn + c + 4);
            const float nn[8] = {n0.x, n0.y, n0.z, n0.w, n1.x, n1.y, n1.z, n1.w};
            if (last) {
                float* op = p.out + (size_t)row * 1024 + c;
                *(float4*)op = make_float4(xv[i][0] * rstd * nn[0], xv[i][1] * rstd * nn[1], xv[i][2] * rstd * nn[2], xv[i][3] * rstd * nn[3]);
                *(float4*)(op + 4) = make_float4(xv[i][4] * rstd * nn[4], xv[i][5] * rstd * nn[5], xv[i][6] * rstd * nn[6], xv[i][7] * rstd * nn[7]);
            } else {
                const float4 c0 = *(const float4*)(md + 1024 + c), c1 = *(const float4*)(md + 1024 + c + 4), h0 = *(const float4*)(md + c), h1 = *(const float4*)(md + c + 4);
                const float sc[8] = {c0.x, c0.y, c0.z, c0.w, c1.x, c1.y, c1.z, c1.w}, sh[8] = {h0.x, h0.y, h0.z, h0.w, h1.x, h1.y, h1.z, h1.w};
                float o[8];
#pragma unroll
                for (int e = 0; e < 8; ++e) o[e] = xv[i][e] * rstd * nn[e] * (1.f + sc[e]) + sh[e];
                *(uint4*)(H + (size_t)row * 1024 + c) = pack8(o);
            }
        }
    }
}
constexpr int LDS_BYTES = 76800;
constexpr int NIV = 19;
extern __shared__ __attribute__((aligned(16))) char dynsmem[];
template <int ID> __device__ __forceinline__ void run_iv(const Params& pin, int l, char* smem) {
    Params p = pin; p.ws = launder(pin.ws);
    if constexpr (ID == 0) { ph_pre(p, smem); __syncthreads(); ph_w(p, 0, smem); }
    else if constexpr (ID == 1) ph_n1(p, l);
    else if constexpr (ID == 2) ph_g1(p, smem);
    else if constexpr (ID == 3) { ph_qu(p, smem); ph_rp1(p, l, smem); ph_rp2(p, l); ph_f1(p, l, smem); }
    else if constexpr (ID == 4) ph_m2(p, smem);
    else if constexpr (ID == 5) {
        const bool r1first = (blockIdx.x >> 8) & 1;
#pragma unroll 1
        for (int pass = 0; pass < 2; ++pass) {
            if ((pass == 0) == r1first) { ph_r1(p, l, smem); ph_fa(p, smem); } else ph_at(p, l, smem);
            __syncthreads();
        }
    }
    else if constexpr (ID == 8) { ph_r2(p, smem); __syncthreads(); ph_fb(p, l, smem); }
    else if constexpr (ID == 9) ph_r3(p);
    else if constexpr (ID == 10) ph_rpost(p, l);
    else if constexpr (ID == 12) ph_mg(p, l, smem);
    else if constexpr (ID == 13) ph_out(p, l, smem);
    else if constexpr (ID == 14) ph_n2(p, l, smem);
    else if constexpr (ID == 15) ph_e1(p, l, smem);
    else if constexpr (ID == 16) ph_e2(p, l, smem);
    else if constexpr (ID == 17) { ph_e3(p, l, smem); __syncthreads(); if (l + 1 < NLAYER) ph_w(p, l + 1, smem); }
}
#if MEGA
#ifndef PROBE_MASK
#define PROBE_MASK 0
#define PROBE_REP 1
#endif
#define IV(ID) for (int r_ = 0; r_ < (((PROBE_MASK >> (ID)) & 1) ? PROBE_REP : 1); ++r_) { run_iv<ID>(p, l, smem); xcd_barrier(bar); }
__global__ void __launch_bounds__(256, 2) k_mega(Params p) {
    char* smem = dynsmem;
    volatile LAS unsigned* st = (volatile LAS unsigned*)(smem + LDS_BYTES - 16);
    if (tidx() == 0) { st[0] = 0u; st[1] = 0u; }
    __syncthreads();
    XcdBarrier bar = xcd_barrier_post((unsigned*)(p.ws + O_BAR), st);
    { const int l = 0; IV(0) }
    for (int l = 0; l < NLAYER; ++l) {
        if (l == 0) { IV(1) } IV(2) IV(3) IV(4) IV(5) IV(8) IV(9) IV(10) IV(12) IV(13) IV(14) IV(15) IV(16) IV(17)
    }
}
#else
template <int ID> __global__ void __launch_bounds__(256, 2) k_iv(Params p, int l) { run_iv<ID>(p, l, dynsmem); }
template <int ID> static void launch_iv(const Params& p, int l, int grid, hipStream_t s) {
    static bool once = false; if (!once) { once = true; (void)hipFuncSetAttribute((const void*)k_iv<ID>, hipFuncAttributeMaxDynamicSharedMemorySize, LDS_BYTES); }
    hipLaunchKernelGGL(k_iv<ID>, dim3(grid), dim3(256), LDS_BYTES, s, p, l);
}
#endif

extern "C" void kernel_launch(void* const* d_in, const int* in_sizes, int n_in, void* d_out, int out_size, void* d_ws, size_t ws_size, hipStream_t stream) {
    (void)in_sizes; (void)out_size;
    if (n_in < N_IN || ws_size < WS_NEED) return;
    Params p{};
    for (int i = 0; i < N_IN; ++i) p.in[i] = (const float*)d_in[i];
    p.out = (float*)d_out; p.ws = (char*)d_ws;
    static int grid = 0;
    if (!grid) {
        int dev = 0, cus = 0; (void)hipGetDevice(&dev); (void)hipDeviceGetAttribute(&cus, hipDeviceAttributeMultiprocessorCount, dev);
        int per_cu = 2;
#if MEGA
        (void)hipFuncSetAttribute((const void*)k_mega, hipFuncAttributeMaxDynamicSharedMemorySize, LDS_BYTES);
        int occ = 0; (void)hipOccupancyMaxActiveBlocksPerMultiprocessor(&occ, k_mega, 256, LDS_BYTES);
        if (occ < per_cu) per_cu = occ;
        if (per_cu < 1) per_cu = 1;
#endif
        grid = cus * per_cu;
    }
#if MEGA
    (void)hipMemsetAsync(p.ws + O_BAR, 0, 16384, stream);
    hipLaunchKernelGGL(k_mega, dim3(grid), dim3(256), LDS_BYTES, stream, p);
#else
    launch_iv<0>(p, 0, grid, stream);
    for (int l = 0; l < NLAYER; ++l) {
        if (l == 0) launch_iv<1>(p, l, grid, stream); launch_iv<2>(p, l, grid, stream); launch_iv<3>(p, l, grid, stream); launch_iv<4>(p, l, grid, stream);
        launch_iv<5>(p, l, grid, stream); launch_iv<8>(p, l, grid, stream);
        launch_iv<9>(p, l, grid, stream); launch_iv<10>(p, l, grid, stream); launch_iv<12>(p, l, grid, stream);
        launch_iv<13>(p, l, grid, stream); launch_iv<14>(p, l, grid, stream); launch_iv<15>(p, l, grid, stream); launch_iv<16>(p, l, grid, stream); launch_iv<17>(p, l, grid, stream);
    }
#endif
}
```

```cpp
#include <hip/hip_runtime.h>
#include <stdint.h>

#ifndef MEGA
#define MEGA 1
#endif

typedef unsigned short bf16_t;
typedef short bf16x8 __attribute__((ext_vector_type(8)));
typedef float f32x4 __attribute__((ext_vector_type(4)));
typedef float f32x2 __attribute__((ext_vector_type(2)));
typedef unsigned u32x4 __attribute__((ext_vector_type(4)));
typedef __bf16 bf16v2 __attribute__((ext_vector_type(2)));

constexpr int NLAYER = 4;
constexpr int DM = 1024;
constexpr int RL = 16384, RC = 1024, RT = RL + RC;
constexpr int SEQ = 4096, CTX = 256, KEYS = SEQ + CTX;
constexpr int LDP = 6144;
constexpr int PQ0 = 512, PKV0 = 896, PKR0 = 1152, PR0 = 1184, PG0 = 2976, PEND = 6048;
constexpr int NEXP = 16;
constexpr int EROWS = 54272;

enum { I_X = 0, I_C, I_CTX, I_CCTX, I_WADA, I_BADA, I_N1G, I_N2G, I_WIN, I_QNG, I_KVNG, I_WUQ, I_WUKV, I_MU, I_W0, I_WUP, I_A0, I_AUP, I_GUP,
       I_KK, I_KA, I_RK, I_GNG, I_GNB, I_WPA, I_WPB, I_WPC, I_WOUT, I_RW, I_RB, I_EG, I_EU, I_ED, I_SG, I_SU, I_SD, I_FNG, N_IN };

struct Params { const float* in[N_IN]; float* out; char* ws; };

constexpr size_t al256(size_t x) { return (x + 255) & ~(size_t)255; }
constexpr size_t O_BAR   = 0;
constexpr size_t O_CNT   = O_BAR + 16384;
constexpr size_t O_MOD   = O_CNT + 4096;
constexpr size_t O_ROPEC = O_MOD + (size_t)NLAYER * 5 * 6144 * 4;
constexpr size_t O_ROPES = O_ROPEC + (size_t)SEQ * 16 * 4;
constexpr size_t O_CSC   = O_ROPES + (size_t)SEQ * 16 * 4;
constexpr size_t O_CST256= O_CSC + 256 * 128 * 2;
constexpr size_t O_D128  = O_CST256 + 256 * 512 * 2;
constexpr size_t O_E64   = O_D128 + 128 * 128 * 2;
constexpr size_t O_TWC   = O_E64 + 64 * 128 * 2;
constexpr size_t O_TWS   = O_TWC + 64 * 64 * 4;
constexpr size_t O_YT2   = O_TWS + 64 * 64 * 4;
constexpr size_t O_A2    = O_YT2 + (size_t)4 * 512 * 64 * 128 * 2;
constexpr size_t O_YTC   = O_A2 + (size_t)4 * 512 * 64 * 128 * 2;
constexpr size_t O_XCUR  = O_YTC + (size_t)4 * 512 * 512 * 2;
constexpr size_t O_WB    = O_XCUR + (size_t)RT * DM * 4;
constexpr size_t W_IN   = 0;
constexpr size_t W_UQ   = W_IN + (size_t)6144 * 1024 * 2;
constexpr size_t W_UKV  = W_UQ + (size_t)768 * 384 * 2;
constexpr size_t W_WUP  = W_UKV + (size_t)1024 * 256 * 2;
constexpr size_t W_AUP  = W_WUP + (size_t)2 * 512 * 64 * 2;
constexpr size_t W_GUP  = W_AUP + (size_t)2 * 512 * 64 * 2;
constexpr size_t W_PA   = W_GUP + (size_t)512 * 128 * 2;
constexpr size_t W_PB   = W_PA + (size_t)1024 * 512 * 2;
constexpr size_t W_PC   = W_PB + (size_t)1024 * 512 * 2;
constexpr size_t W_OUT  = W_PC + (size_t)1024 * 512 * 2;
constexpr size_t W_GU   = W_OUT + (size_t)1024 * 1024 * 2;
constexpr size_t W_D    = W_GU + (size_t)17 * 1024 * 1024 * 2;
constexpr size_t W_END  = W_D + (size_t)17 * 1024 * 512 * 2;
constexpr size_t O_H    = O_WB + W_END;
constexpr size_t O_P    = O_H + (size_t)RT * DM * 2;
constexpr size_t O_ATT  = O_P + (size_t)RT * LDP * 2;
constexpr size_t O_RG   = O_ATT + (size_t)RT * 512 * 2;
constexpr size_t O_RWO  = O_RG + (size_t)RT * 512 * 2;
constexpr size_t O_FA   = O_RWO + (size_t)RT * 512 * 2;
constexpr size_t O_LTOK = O_FA + (size_t)RT * 512 * 2;
constexpr size_t O_LW   = O_LTOK + (size_t)NEXP * RT * 4;
constexpr size_t O_SLOT = O_LW + (size_t)NEXP * RT * 4;
constexpr size_t O_X    = al256(O_SLOT + (size_t)RT * 2 * 4);
constexpr size_t X_QA   = 0;
constexpr size_t X_KA   = X_QA + (size_t)RT * 768 * 2;
constexpr size_t X_VA   = X_KA + (size_t)4 * KEYS * 768 * 2;
constexpr int NCP = 4 * 8 * 2 * 68;
constexpr size_t X_S0   = 0;
constexpr size_t X_MT   = X_VA + (size_t)4 * 8 * 64 * KEYS * 2;
constexpr size_t X_GT   = X_MT + (size_t)NCP * 8192;
constexpr size_t X_YL   = X_GT + (size_t)NCP * 8192;
constexpr size_t X_QRAW = X_MT;
constexpr size_t X_KVRAW= X_QRAW + (size_t)RT * 768 * 2;
constexpr size_t X_KKN  = X_YL + (size_t)NCP * 8192;
constexpr size_t X_BON  = X_KKN + (size_t)RT * 8 * 4;
constexpr size_t X_END  = X_BON + (size_t)2 * RT * 8 * 4;
static_assert(X_KVRAW + (size_t)RT * 1024 * 2 <= X_YL + (size_t)NCP * 8192, "raw q/kv must fit under the chunk data");
static_assert(X_S0 + (size_t)NCP * 8192 <= X_VA, "S0 must fit in the q/k area");
constexpr size_t X_YE   = 0;
constexpr size_t WS_NEED = O_X + X_END;

__device__ __forceinline__ float bf2f(bf16_t u) { return __builtin_bit_cast(float, (unsigned)u << 16); }
__device__ __forceinline__ float bflo(unsigned u) { return __builtin_bit_cast(float, u << 16); }
__device__ __forceinline__ float bfhi(unsigned u) { return __builtin_bit_cast(float, u & 0xffff0000u); }
__device__ __forceinline__ unsigned pack2(float lo, float hi) { f32x2 v = {lo, hi}; bf16v2 b = __builtin_convertvector(v, bf16v2); return __builtin_bit_cast(unsigned, b); }
__device__ __forceinline__ bf16_t f2bf(float f) { return (bf16_t)(pack2(f, 0.f) & 0xffffu); }
__device__ __forceinline__ float wsum(float v) {
#pragma unroll
    for (int o = 32; o > 0; o >>= 1) v += __shfl_xor(v, o);
    return v;
}
__device__ __forceinline__ float sigmoidf_(float x) { return 1.f / (1.f + __expf(-x)); }
__device__ __forceinline__ float siluf_(float x) { return x / (1.f + __expf(-x)); }
__device__ __forceinline__ int modidx(int row) { return row < RL ? (row >> 12) : 4; }
__device__ __forceinline__ void unpack8(const uint4& u, float (&f)[8]) {
    f[0] = bflo(u.x); f[1] = bfhi(u.x); f[2] = bflo(u.y); f[3] = bfhi(u.y); f[4] = bflo(u.z); f[5] = bfhi(u.z); f[6] = bflo(u.w); f[7] = bfhi(u.w);
}
__device__ __forceinline__ uint4 pack8(const float (&f)[8]) { return make_uint4(pack2(f[0], f[1]), pack2(f[2], f[3]), pack2(f[4], f[5]), pack2(f[6], f[7])); }

#define XB_TMO      128
#define XB_XCNT(j)  (256  + 64 * (j))
#define XB_XSUB(j)  (1280 + 64 * (j))
#define XB_XGEN(j)  (2304 + 64 * (j))
#define XB_TOP      3328
#define XB_TOPGEN   3392
#define XCD_BAR_WORDS 3456
#define XB_SPIN_CAP (1u << 22)
#define LAS __attribute__((address_space(3)))
__device__ __forceinline__ unsigned xb_ld(unsigned* p)              { return __hip_atomic_load(p, __ATOMIC_RELAXED, __HIP_MEMORY_SCOPE_AGENT); }
__device__ __forceinline__ unsigned xb_add(unsigned* p, unsigned v) { return __hip_atomic_fetch_add(p, v, __ATOMIC_RELAXED, __HIP_MEMORY_SCOPE_AGENT); }
__device__ __forceinline__ unsigned xb_xcc_id() { return (unsigned)__builtin_amdgcn_s_getreg((3 << 11) | 20) & 0xFu; }
#define XB_SPIN(cond, bar) do { unsigned _sp = 0; while (cond) { __builtin_amdgcn_s_sleep(1); \
    if ((++_sp & 255u) == 0u) { if (xb_ld(&(bar)[XB_TMO])) break; if (_sp > XB_SPIN_CAP) { atomicAdd(&(bar)[XB_TMO], 1u); break; } } } } while (0)
struct XcdBarrier { unsigned* bar; unsigned x; volatile LAS unsigned* st; };
__device__ __forceinline__ XcdBarrier xcd_barrier_post(unsigned* bar, volatile LAS unsigned* st) {
    XcdBarrier b; b.bar = bar; b.x = xb_xcc_id(); b.st = st;
    if (threadIdx.x == 0) (void)xb_add(&bar[XB_XCNT(b.x)], 1u);
    return b;
}
__device__ __forceinline__ void xcd_barrier_complete(unsigned* bar, unsigned x, unsigned& nloc, unsigned& nx) {
    const unsigned G = gridDim.x * gridDim.y * gridDim.z;
    unsigned sum, cnt, mine, sp = 0u;
    for (;;) {
        sum = 0u; cnt = 0u; mine = 0u;
#pragma unroll
        for (unsigned j = 0; j < 16; ++j) { const unsigned c = xb_ld(&bar[XB_XCNT(j)]); sum += c; cnt += (c > 0u) ? 1u : 0u; mine = (j == x) ? c : mine; }
        if (sum == G) break;
        __builtin_amdgcn_s_sleep(1);
        if ((++sp & 255u) == 0u) { if (xb_ld(&bar[XB_TMO])) break; if (sp > XB_SPIN_CAP) { atomicAdd(&bar[XB_TMO], 1u); break; } }
    }
    nloc = mine > 0u ? mine : 1u; nx = cnt > 0u ? cnt : 1u;
}
__device__ __forceinline__ void xcd_barrier(const XcdBarrier& b) {
    asm volatile("s_waitcnt vmcnt(0)" ::: "memory");
    __syncthreads();
    if (threadIdx.x == 0) {
        unsigned* bar = b.bar;
        __builtin_amdgcn_s_waitcnt(0);
        unsigned nloc = b.st[0], nx = b.st[1];
        if (nloc == 0u) { xcd_barrier_complete(bar, b.x, nloc, nx); b.st[0] = nloc; b.st[1] = nx; }
        const unsigned old = xb_add(&bar[XB_XSUB(b.x)], 1u);
        const unsigned gen = old / nloc;
        if (old + 1u == (gen + 1u) * nloc) {
            __builtin_amdgcn_fence(__ATOMIC_RELEASE, "agent");
            asm volatile("s_waitcnt vmcnt(0)" ::: "memory");
            const unsigned og = xb_add(&bar[XB_TOP], 1u);
            const unsigned tg = og / nx;
            if (og + 1u == (tg + 1u) * nx) xb_add(&bar[XB_TOPGEN], 1u);
            else XB_SPIN(xb_ld(&bar[XB_TOPGEN]) == tg, bar);
            __builtin_amdgcn_fence(__ATOMIC_ACQUIRE, "agent");
            xb_add(&bar[XB_XGEN(b.x)], 1u);
            asm volatile("s_waitcnt vmcnt(0)" ::: "memory");
        } else {
            XB_SPIN(xb_ld(&bar[XB_XGEN(b.x)]) == gen, bar);
            __builtin_amdgcn_fence(__ATOMIC_ACQUIRE, "agent");
            asm volatile("s_waitcnt vmcnt(0)" ::: "memory");
        }
    }
    __syncthreads();
}

__device__ __forceinline__ int tidx() { int t = threadIdx.x; asm volatile("" : "+v"(t)); return t; }
__device__ __forceinline__ int lv(int x) { asm volatile("" : "+v"(x)); return x; }
__device__ __forceinline__ char* launder(char* p) { size_t z = 0; asm volatile("" : "+s"(z)); return p + z; }

constexpr int LDSROW = 72;
template <int NA, class AL>
__device__ __forceinline__ void gc_load(const AL& al, const bf16_t* bp, size_t bstep, int k0, int kc, u32x4 (&ra)[NA], u32x4 (&rb)[4]) {
#pragma unroll
    for (int i = 0; i < NA; ++i) ra[i] = __builtin_bit_cast(u32x4, al.load(i, k0 + kc));
#pragma unroll
    for (int j = 0; j < 4; ++j) rb[j] = *(const u32x4*)(bp + j * bstep + k0);
}
template <int NA>
__device__ __forceinline__ void gc_store(bf16_t* Ab, bf16_t* Bb, int lr, int kc, const u32x4 (&ra)[NA], const u32x4 (&rb)[4]) {
#pragma unroll
    for (int i = 0; i < NA; ++i) *(u32x4*)(Ab + (lr + 32 * i) * LDSROW + kc) = ra[i];
#pragma unroll
    for (int j = 0; j < 4; ++j) *(u32x4*)(Bb + (lr + 32 * j) * LDSROW + kc) = rb[j];
}
template <int MI>
__device__ __forceinline__ void gc_compute(const bf16_t* Ac, const bf16_t* Bc, f32x4 (&acc)[MI][4]) {
#pragma unroll
    for (int kh = 0; kh < 2; ++kh) {
        bf16x8 af[MI], bfv[4];
#pragma unroll
        for (int i = 0; i < MI; ++i) af[i] = *(const bf16x8*)(Ac + i * 16 * LDSROW + kh * 32);
#pragma unroll
        for (int j = 0; j < 4; ++j) bfv[j] = *(const bf16x8*)(Bc + j * 16 * LDSROW + kh * 32);
#pragma unroll
        for (int i = 0; i < MI; ++i)
#pragma unroll
            for (int j = 0; j < 4; ++j) acc[i][j] = __builtin_amdgcn_mfma_f32_16x16x32_bf16(bfv[j], af[i], acc[i][j], 0, 0, 0);
    }
}
template <int MI, class AL>
__device__ __forceinline__ void gemm_core(const AL& al, const bf16_t* __restrict__ Bt, int ldb, int K, f32x4 (&acc)[MI][4], char* smem) {
    constexpr int TM = MI * 32;
    constexpr int NA = TM / 32;
    bf16_t* As = (bf16_t*)smem;
    bf16_t* Bs = As + 2 * TM * LDSROW;
    const int tid = tidx(), lane = tid & 63, wave = tid >> 6;
    const int wr = wave >> 1, wc = wave & 1, fr = lane & 15, fq = lane >> 4;
    const int kc = (tid & 7) * 8, lr = tid >> 3;
#pragma unroll
    for (int i = 0; i < MI; ++i)
#pragma unroll
        for (int j = 0; j < 4; ++j) acc[i][j] = (f32x4){0.f, 0.f, 0.f, 0.f};
    u32x4 a0[NA], b0[4], a1[NA], b1[4];
    const bf16_t* bp = Bt + (size_t)lr * ldb + kc;
    const size_t bstep = (size_t)32 * ldb;
    const int nk = K >> 6;
    bf16_t* As1 = As + TM * LDSROW; bf16_t* Bs1 = Bs + 128 * LDSROW;
    const int aoff = (wr * MI * 16 + fr) * LDSROW + fq * 8, boff = (wc * 64 + fr) * LDSROW + fq * 8;
    gc_load<NA>(al, bp, bstep, 0, kc, a0, b0);
    gc_store<NA>(As, Bs, lr, kc, a0, b0);
    if (nk > 1) gc_load<NA>(al, bp, bstep, 64, kc, a0, b0);
    __syncthreads();
    for (int kt = 0; kt < nk; kt += 2) {
        if (kt + 2 < nk) gc_load<NA>(al, bp, bstep, (kt + 2) << 6, kc, a1, b1);
        gc_compute<MI>(As + aoff, Bs + boff, acc);
        if (kt + 1 < nk) gc_store<NA>(As1, Bs1, lr, kc, a0, b0);
        __syncthreads();
        if (kt + 1 >= nk) break;
        if (kt + 3 < nk) gc_load<NA>(al, bp, bstep, (kt + 3) << 6, kc, a0, b0);
        gc_compute<MI>(As1 + aoff, Bs1 + boff, acc);
        if (kt + 2 < nk) gc_store<NA>(As, Bs, lr, kc, a1, b1);
        __syncthreads();
    }
}
template <int MI, class RP, class RPB>
__device__ __forceinline__ void gemm_core_gb(const RP& rp, const RPB& rpb, int K, f32x4 (&acc)[MI][4], char* smem) {
    constexpr int ABYTES = MI * 32 * 128;
    constexpr int SBYTES = ABYTES + 16384;
    const int tid = tidx(), lane = tid & 63, wave = tid >> 6;
    const int wr = wave >> 1, wc = wave & 1, fr = lane & 15, fq = lane >> 4;
    const int rr = lane >> 3, cs = ((lane & 7) ^ ((wave * 4 + (lane >> 4)) & 7)) * 8;
#pragma unroll
    for (int i = 0; i < MI; ++i)
#pragma unroll
        for (int j = 0; j < 4; ++j) acc[i][j] = (f32x4){0.f, 0.f, 0.f, 0.f};
    const bf16_t* ap[MI]; const bf16_t* bp[4];
#pragma unroll
    for (int i = 0; i < MI; ++i) { const int r = (i * 4 + wave) * 8 + rr; ap[i] = rp(r) + cs; }
#pragma unroll
    for (int i = 0; i < 4; ++i) { const int r = (i * 4 + wave) * 8 + rr; bp[i] = rpb(r) + cs; }
    const int wbase = __builtin_amdgcn_readfirstlane(wave) * 1024;
    const int nk = K >> 6;
    auto stage = [&](int buf, int kt) {
        char* Ab = smem + buf * SBYTES + wbase; char* Bb = Ab + ABYTES;
#pragma unroll
        for (int i = 0; i < MI; ++i) __builtin_amdgcn_global_load_lds((const unsigned*)(ap[i] + kt * 64), (unsigned*)(Ab + i * 4096), 16, 0, 0);
#pragma unroll
        for (int i = 0; i < 4; ++i) __builtin_amdgcn_global_load_lds((const unsigned*)(bp[i] + kt * 64), (unsigned*)(Bb + i * 4096), 16, 0, 0);
    };
    const int aoff = (wr * MI * 16 + fr) * 128, boff = ABYTES + (wc * 64 + fr) * 128, sw = fr >> 1;
    stage(0, 0);
    asm volatile("s_waitcnt vmcnt(0)" ::: "memory");
    __syncthreads();
    for (int kt = 0; kt < nk; ++kt) {
        const int cur = kt & 1;
        if (kt + 1 < nk) stage(cur ^ 1, kt + 1);
        const char* base = smem + cur * SBYTES;
#pragma unroll
        for (int kh = 0; kh < 2; ++kh) {
            const int xo = ((kh * 4 + fq) ^ sw) * 16;
            bf16x8 af[MI], bfv[4];
#pragma unroll
            for (int i = 0; i < MI; ++i) af[i] = *(const bf16x8*)(base + aoff + i * 2048 + xo);
#pragma unroll
            for (int j = 0; j < 4; ++j) bfv[j] = *(const bf16x8*)(base + boff + j * 2048 + xo);
#pragma unroll
            for (int i = 0; i < MI; ++i)
#pragma unroll
                for (int j = 0; j < 4; ++j) acc[i][j] = __builtin_amdgcn_mfma_f32_16x16x32_bf16(bfv[j], af[i], acc[i][j], 0, 0, 0);
        }
        asm volatile("s_waitcnt vmcnt(0)" ::: "memory");
        __syncthreads();
    }
}
struct RPPlain;
template <int MI, class RP>
__device__ __forceinline__ void gemm_core_g(const RP& rp, const bf16_t* __restrict__ Bt, int ldb, int K, f32x4 (&acc)[MI][4], char* smem);
struct RPPlain {
    const bf16_t* A; size_t lda;
    __device__ __forceinline__ const bf16_t* operator()(int r) const { return A + (size_t)r * lda; }
};
template <int MI, class RP>
__device__ __forceinline__ void gemm_core_g(const RP& rp, const bf16_t* __restrict__ Bt, int ldb, int K, f32x4 (&acc)[MI][4], char* smem) {
    RPPlain rpb{Bt, (size_t)ldb};
    gemm_core_gb<MI>(rp, rpb, K, acc, smem);
}
template <int MI, class F>
__device__ __forceinline__ void acc_foreach(const f32x4 (&acc)[MI][4], F f) {
    const int lane = tidx() & 63, wave = tidx() >> 6;
    const int wr = wave >> 1, wc = wave & 1, fr = lane & 15, fq = lane >> 4;
#pragma unroll
    for (int i = 0; i < MI; ++i)
#pragma unroll
        for (int j = 0; j < 4; ++j) f(wr * MI * 16 + i * 16 + fr, wc * 64 + j * 16 + fq * 4, acc[i][j]);
}
struct ALPlain {
    const bf16_t* p0; size_t step;
    __device__ __forceinline__ ALPlain(const bf16_t* A, int lda, int row0) { p0 = A + (size_t)(row0 + (tidx() >> 3)) * lda; step = (size_t)32 * lda; }
    __device__ __forceinline__ uint4 load(int i, int k) const { return *(const uint4*)(p0 + i * step + k); }
};
__device__ __forceinline__ void store_bf16x4(bf16_t* dst, const f32x4& v) { *(uint2*)dst = make_uint2(pack2(v[0], v[1]), pack2(v[2], v[3])); }

__device__ __forceinline__ void ph_pre(const Params& p, char* smem) {
    const int tid = tidx(), nb = gridDim.x, bid = blockIdx.x;
    float* mod = (float*)(p.ws + O_MOD);
    {
        float* sv = (float*)smem;
        float* part = sv + 5 * 1024;
        for (int i = tid; i < 5 * 1024; i += 256) { const float v = (i < 4096) ? p.in[I_C][i] : p.in[I_CCTX][i - 4096]; sv[i] = siluf_(v); }
        __syncthreads();
        for (int it = bid; it < NLAYER * 96; it += nb) {
            const int l = it / 96, jb = it % 96;
            const int jj = tid & 63, kq = tid >> 6, j = jb * 64 + jj;
            const float* w = p.in[I_WADA] + (size_t)l * 1024 * 6144 + (size_t)(kq * 256) * 6144 + j;
            float a0 = 0.f, a1 = 0.f, a2 = 0.f, a3 = 0.f, a4 = 0.f;
#pragma unroll 8
            for (int k = 0; k < 256; ++k) {
                const float wv = w[(size_t)k * 6144]; const int kk = kq * 256 + k;
                a0 += sv[kk] * wv; a1 += sv[1024 + kk] * wv; a2 += sv[2048 + kk] * wv; a3 += sv[3072 + kk] * wv; a4 += sv[4096 + kk] * wv;
            }
            part[(kq * 5 + 0) * 64 + jj] = a0; part[(kq * 5 + 1) * 64 + jj] = a1; part[(kq * 5 + 2) * 64 + jj] = a2;
            part[(kq * 5 + 3) * 64 + jj] = a3; part[(kq * 5 + 4) * 64 + jj] = a4;
            __syncthreads();
            for (int o = tid; o < 320; o += 256) {
                const int i = o >> 6, c = o & 63;
                const float s = part[(0 * 5 + i) * 64 + c] + part[(1 * 5 + i) * 64 + c] + part[(2 * 5 + i) * 64 + c] + part[(3 * 5 + i) * 64 + c];
                mod[(size_t)(l * 5 + i) * 6144 + jb * 64 + c] = s + p.in[I_BADA][l * 6144 + jb * 64 + c];
            }
            __syncthreads();
        }
    }
    {
        float4* xc = (float4*)(p.ws + O_XCUR);
        const float4* x4 = (const float4*)p.in[I_X]; const float4* c4 = (const float4*)p.in[I_CTX];
        for (size_t i = (size_t)bid * 256 + tid; i < (size_t)RT * 256; i += (size_t)nb * 256) xc[i] = (i < (size_t)RL * 256) ? x4[i] : c4[i - (size_t)RL * 256];
    }
    {
        float* ct = (float*)smem;
        __syncthreads();
        for (int m = tid; m < 4096; m += 256) ct[m] = cospif((float)m * (1.f / 2048.f));
        __syncthreads();
        bf16_t* cst2 = (bf16_t*)(p.ws + O_CST256);
        for (int ch = bid * 256 + tid; ch < 256 * 512 / 8; ch += nb * 256) {
            const int ks = ch >> 6, c0 = (ch & 63) * 8, part = c0 >> 8, s0 = c0 & 255;
            float f[8];
#pragma unroll
            for (int e = 0; e < 8; ++e) { const int m = (16 * ks * (s0 + e)) & 4095; f[e] = part == 0 ? ct[m] : ct[(m - 1024) & 4095]; }
            *(uint4*)(cst2 + ch * 8) = pack8(f);
        }
        bf16_t* d128 = (bf16_t*)(p.ws + O_D128);
        for (int ch = bid * 256 + tid; ch < 128 * 128 / 8; ch += nb * 256) {
            const int mrow = ch >> 4, c0 = (ch & 15) * 8, po = mrow >> 6, k1 = mrow & 63, pi = c0 >> 6, t10 = c0 & 63;
            float f[8];
#pragma unroll
            for (int e = 0; e < 8; ++e) {
                const int m = (64 * k1 * (t10 + e)) & 4095; const float cv = ct[m], sv = ct[(m - 1024) & 4095];
                f[e] = (po == pi) ? cv : (po == 0 ? sv : -sv);
            }
            *(uint4*)(d128 + ch * 8) = pack8(f);
        }
        bf16_t* e64 = (bf16_t*)(p.ws + O_E64);
        for (int ch = bid * 256 + tid; ch < 64 * 128 / 8; ch += nb * 256) {
            const int k2 = ch >> 4, c0 = (ch & 15) * 8, po = c0 >> 6, t20 = c0 & 63;
            float f[8];
#pragma unroll
            for (int e = 0; e < 8; ++e) { const int m = (64 * k2 * (t20 + e)) & 4095; f[e] = po == 0 ? ct[m] : ct[(m - 1024) & 4095]; }
            *(uint4*)(e64 + ch * 8) = pack8(f);
        }
        float* twc = (float*)(p.ws + O_TWC); float* tws = (float*)(p.ws + O_TWS);
        for (int i = bid * 256 + tid; i < 64 * 64; i += nb * 256) {
            const int k1 = i >> 6, t2 = i & 63, m = (k1 * t2) & 4095;
            twc[i] = ct[m]; tws[i] = -ct[(m - 1024) & 4095];
        }
        bf16_t* csc = (bf16_t*)(p.ws + O_CSC);
        for (int ch = bid * 256 + tid; ch < 256 * 128 / 8; ch += nb * 256) {
            const int n = ch >> 4, c0 = (ch & 15) * 8, part = n >> 7, kc = n & 127;
            float f[8];
#pragma unroll
            for (int e = 0; e < 8; ++e) { const int m = (32 * kc * (c0 + e)) & 4095; f[e] = part == 0 ? ct[m] : -ct[(m - 1024) & 4095]; }
            *(uint4*)(csc + ch * 8) = pack8(f);
        }
        float* rc = (float*)(p.ws + O_ROPEC); float* rs = (float*)(p.ws + O_ROPES);
        for (int i = bid * 256 + tid; i < SEQ * 16; i += nb * 256) {
            const int t = i >> 4, ax = (i >> 3) & 1, f = i & 7;
            const float inv = powf(10000.f, -(float)f / 8.f);
            const float pos = (float)(ax == 0 ? (t >> 6) : (t & 63));
            const float ang = pos * inv;
            rc[i] = cosf(ang); rs[i] = sinf(ang);
        }
    }
}

struct ConvTask { const float* src; const float* scale; bf16_t* dst; int K, Nsrc, Ndst, rmul; size_t sbs, dbs; };
__constant__ int c_conv_cum[17] = {0, 1536, 1608, 1672, 1688, 1704, 1720, 1848, 1976, 2104, 2360, 4408, 6456, 8504, 8632, 8760, 8888};
__device__ __forceinline__ ConvTask conv_task(const Params& p, int l, int t) {
    bf16_t* wb = (bf16_t*)(p.ws + O_WB);
    ConvTask c; c.scale = nullptr; c.sbs = 0; c.dbs = 0; c.rmul = 64;
    switch (t) {
    case 0:  c.src = p.in[I_WIN] + (size_t)l * 1024 * 6048; c.K = 1024; c.Nsrc = 6048; c.Ndst = 6144; c.dst = wb + W_IN / 2; break;
    case 1:  c.src = p.in[I_WUQ] + (size_t)l * 384 * 768; c.K = 384; c.Nsrc = 768; c.Ndst = 768; c.dst = wb + W_UQ / 2; c.scale = p.in[I_QNG] + l * 384; break;
    case 2:  c.src = p.in[I_WUKV] + (size_t)l * 256 * 1024; c.K = 256; c.Nsrc = 1024; c.Ndst = 1024; c.dst = wb + W_UKV / 2; c.scale = p.in[I_KVNG] + l * 256; break;
    case 3:  c.src = p.in[I_WUP] + (size_t)l * 2 * 64 * 512; c.K = 64; c.Nsrc = 512; c.Ndst = 512; c.dst = wb + W_WUP / 2; c.sbs = 64 * 512; c.dbs = 512 * 64; break;
    case 4:  c.src = p.in[I_AUP] + (size_t)l * 2 * 64 * 512; c.K = 64; c.Nsrc = 512; c.Ndst = 512; c.dst = wb + W_AUP / 2; c.sbs = 64 * 512; c.dbs = 512 * 64; break;
    case 5:  c.src = p.in[I_GUP] + (size_t)l * 128 * 512; c.K = 128; c.Nsrc = 512; c.Ndst = 512; c.dst = wb + W_GUP / 2; break;
    case 6:  c.src = p.in[I_WPA] + (size_t)l * 512 * 1024; c.K = 512; c.Nsrc = 1024; c.Ndst = 1024; c.dst = wb + W_PA / 2; break;
    case 7:  c.src = p.in[I_WPB] + (size_t)l * 512 * 1024; c.K = 512; c.Nsrc = 1024; c.Ndst = 1024; c.dst = wb + W_PB / 2; break;
    case 8:  c.src = p.in[I_WPC] + (size_t)l * 512 * 1024; c.K = 512; c.Nsrc = 1024; c.Ndst = 1024; c.dst = wb + W_PC / 2; break;
    case 9:  c.src = p.in[I_WOUT] + (size_t)l * 1024 * 1024; c.K = 1024; c.Nsrc = 1024; c.Ndst = 1024; c.dst = wb + W_OUT / 2; break;
    case 10: c.src = p.in[I_EG] + (size_t)l * 16 * 1024 * 512; c.K = 1024; c.Nsrc = 512; c.Ndst = 512; c.dst = wb + W_GU / 2; c.sbs = 1024 * 512; c.dbs = 1024 * 1024; c.rmul = 128; break;
    case 11: c.src = p.in[I_EU] + (size_t)l * 16 * 1024 * 512; c.K = 1024; c.Nsrc = 512; c.Ndst = 512; c.dst = wb + W_GU / 2 + 64 * 1024; c.sbs = 1024 * 512; c.dbs = 1024 * 1024; c.rmul = 128; break;
    case 12: c.src = p.in[I_ED] + (size_t)l * 16 * 512 * 1024; c.K = 512; c.Nsrc = 1024; c.Ndst = 1024; c.dst = wb + W_D / 2; c.sbs = 512 * 1024; c.dbs = 1024 * 512; break;
    case 13: c.src = p.in[I_SG] + (size_t)l * 1024 * 512; c.K = 1024; c.Nsrc = 512; c.Ndst = 512; c.dst = wb + W_GU / 2 + (size_t)16 * 1024 * 1024; c.rmul = 128; break;
    case 14: c.src = p.in[I_SU] + (size_t)l * 1024 * 512; c.K = 1024; c.Nsrc = 512; c.Ndst = 512; c.dst = wb + W_GU / 2 + (size_t)16 * 1024 * 1024 + 64 * 1024; c.rmul = 128; break;
    default: c.src = p.in[I_SD] + (size_t)l * 512 * 1024; c.K = 512; c.Nsrc = 1024; c.Ndst = 1024; c.dst = wb + W_D / 2 + (size_t)16 * 1024 * 512; break;
    }
    return c;
}
__device__ __forceinline__ void ph_w(const Params& p, int l, char* smem) {
    const int tid = tidx();
    float* tl = (float*)smem;
    for (int g = blockIdx.x; g < 8888; g += gridDim.x) {
        int t = 0;
        while (g >= c_conv_cum[t + 1]) ++t;
        const ConvTask c = conv_task(p, l, t);
        int r = g - c_conv_cum[t];
        const int nkt = c.K >> 6, nnt = c.Ndst >> 6;
        const int bi = r / (nkt * nnt); r -= bi * nkt * nnt;
        const int k0 = (r / nnt) * 64, n0 = (r % nnt) * 64;
        const float* src = c.src + bi * c.sbs; bf16_t* dst = c.dst + bi * c.dbs;
#pragma unroll
        for (int i = 0; i < 4; ++i) {
            const int k = (tid >> 4) + 16 * i, n = n0 + (tid & 15) * 4;
            float4 v = make_float4(0.f, 0.f, 0.f, 0.f);
            if (n < c.Nsrc) v = *(const float4*)(src + (size_t)(k0 + k) * c.Nsrc + n);
            if (c.scale) { const float s = c.scale[k0 + k]; v.x *= s; v.y *= s; v.z *= s; v.w *= s; }
            float* d = tl + k * 65 + (tid & 15) * 4;
            d[0] = v.x; d[1] = v.y; d[2] = v.z; d[3] = v.w;
        }
        __syncthreads();
        {
            const int n = tid >> 2, kk0 = (tid & 3) * 16;
            float f[8], g2[8];
#pragma unroll
            for (int j = 0; j < 8; ++j) { f[j] = tl[(kk0 + j) * 65 + n]; g2[j] = tl[(kk0 + 8 + j) * 65 + n]; }
            bf16_t* d = dst + (size_t)((n0 >> 6) * c.rmul + n) * c.K + k0 + kk0;
            *(uint4*)d = pack8(f); *(uint4*)(d + 8) = pack8(g2);
        }
        __syncthreads();
    }
}

__device__ __forceinline__ void ph_n1(const Params& p, int l) {
    const int lane = tidx() & 63, wave = tidx() >> 6;
    const float* xcur = (const float*)(p.ws + O_XCUR); const float* mod = (const float*)(p.ws + O_MOD);
    bf16_t* H = (bf16_t*)(p.ws + O_H);
    const float* g = p.in[I_N1G] + l * 1024;
    for (int row = blockIdx.x * 4 + wave; row < RT; row += gridDim.x * 4) {
        const float* x = xcur + (size_t)row * 1024; const float* md = mod + (size_t)(l * 5 + modidx(row)) * 6144;
        float4 v[4]; float ss = 0.f;
#pragma unroll
        for (int i = 0; i < 4; ++i) { v[i] = *(const float4*)(x + lane * 4 + 256 * i); ss += v[i].x * v[i].x + v[i].y * v[i].y + v[i].z * v[i].z + v[i].w * v[i].w; }
        ss = wsum(ss);
        const float rstd = rsqrtf(ss * (1.f / 1024.f) + 1e-6f);
#pragma unroll
        for (int i = 0; i < 4; ++i) {
            const int c = lane * 4 + 256 * i;
            const float4 gg = *(const float4*)(g + c), sc = *(const float4*)(md + 1024 + c), sh = *(const float4*)(md + c);
            f32x4 h = {v[i].x * rstd * gg.x * (1.f + sc.x) + sh.x, v[i].y * rstd * gg.y * (1.f + sc.y) + sh.y,
                       v[i].z * rstd * gg.z * (1.f + sc.z) + sh.z, v[i].w * rstd * gg.w * (1.f + sc.w) + sh.w};
            store_bf16x4(H + (size_t)row * 1024 + c, h);
        }
    }
}

__device__ __forceinline__ void ph_g1(const Params& p, char* smem) {
    if (blockIdx.x == 0 && tidx() < 64) ((unsigned*)(p.ws + O_CNT))[tidx()] = 0u;
    const bf16_t* H = (const bf16_t*)(p.ws + O_H); const bf16_t* W = (const bf16_t*)(p.ws + O_WB + W_IN);
    bf16_t* P = (bf16_t*)(p.ws + O_P);
    for (int it = blockIdx.x; it < 136 * 48; it += gridDim.x) {
        const int mt = it / 48, nt = it % 48;
        f32x4 acc[4][4];
        RPPlain rp{H + (size_t)mt * 128 * 1024, 1024};
        gemm_core_g<4>(rp, W + (size_t)nt * 128 * 1024, 1024, 1024, acc, smem);
        acc_foreach<4>(acc, [&](int m, int n, const f32x4& v) {
            const int col = nt * 128 + n; f32x4 o = v;
            if (col >= PG0 && col < PEND) { o[0] = sigmoidf_(v[0]); o[1] = sigmoidf_(v[1]); o[2] = sigmoidf_(v[2]); o[3] = sigmoidf_(v[3]); }
            store_bf16x4(P + (size_t)(mt * 128 + m) * LDP + col, o);
        });
    }
}

__device__ __forceinline__ void ph_qu(const Params& p, char* smem) {
    const bf16_t* P = (const bf16_t*)(p.ws + O_P);
    bf16_t* QR = (bf16_t*)(p.ws + O_X + X_QRAW); bf16_t* KVR = (bf16_t*)(p.ws + O_X + X_KVRAW);
    for (int it = blockIdx.x; it < 136 * 14; it += gridDim.x) {
        const int mt = it / 14, nn = it % 14;
        f32x4 acc[4][4];
        if (nn < 6) {
            RPPlain rp{P + (size_t)mt * 128 * LDP + PQ0, LDP};
            gemm_core_g<4>(rp, (const bf16_t*)(p.ws + O_WB + W_UQ) + (size_t)nn * 128 * 384, 384, 384, acc, smem);
            acc_foreach<4>(acc, [&](int m, int n, const f32x4& v) { store_bf16x4(QR + (size_t)(mt * 128 + m) * 768 + nn * 128 + n, v); });
        } else {
            const int nt = nn - 6;
            RPPlain rp{P + (size_t)mt * 128 * LDP + PKV0, LDP};
            gemm_core_g<4>(rp, (const bf16_t*)(p.ws + O_WB + W_UKV) + (size_t)nt * 128 * 256, 256, 256, acc, smem);
            acc_foreach<4>(acc, [&](int m, int n, const f32x4& v) { store_bf16x4(KVR + (size_t)(mt * 128 + m) * 1024 + nt * 128 + n, v); });
        }
    }
}

constexpr float QSCALE = 0.10206207261596575f * 1.4426950408889634f;
__device__ __forceinline__ void ph_m2(const Params& p, char* smem) {
    const int tid = tidx(), lane = tid & 63, wave = tid >> 6;
    const bf16_t* P = (const bf16_t*)(p.ws + O_P);
    const bf16_t* QR = (const bf16_t*)(p.ws + O_X + X_QRAW); const bf16_t* KVR = (const bf16_t*)(p.ws + O_X + X_KVRAW);
    bf16_t* QA = (bf16_t*)(p.ws + O_X + X_QA); bf16_t* KA = (bf16_t*)(p.ws + O_X + X_KA); bf16_t* VA = (bf16_t*)(p.ws + O_X + X_VA);
    const float* rc = (const float*)(p.ws + O_ROPEC); const float* rs = (const float*)(p.ws + O_ROPES);
    for (int row = blockIdx.x * 4 + wave; row < RT; row += gridDim.x * 4) {
        const bool lat = row < RL;
        const int b = lat ? (row >> 12) : ((row - RL) >> 8), t = lat ? (row & 4095) : ((row - RL) & 255);
        const size_t keyrow = (size_t)b * KEYS + (lat ? t : SEQ + t);
        const bf16_t* pr = P + (size_t)row * LDP;
        float sq = 0.f, sk = 0.f;
        if (lane < 48) { float f[8]; unpack8(*(const uint4*)(pr + PQ0 + lane * 8), f);
#pragma unroll
            for (int e = 0; e < 8; ++e) sq += f[e] * f[e]; }
        if (lane < 32) { float f[8]; unpack8(*(const uint4*)(pr + PKV0 + lane * 8), f);
#pragma unroll
            for (int e = 0; e < 8; ++e) sk += f[e] * f[e]; }
        sq = wsum(sq); sk = wsum(sk);
        const float rq = rsqrtf(sq * (1.f / 384.f) + 1e-6f), rkv = rsqrtf(sk * (1.f / 256.f) + 1e-6f);
        const bf16_t* qr = QR + (size_t)row * 768; const bf16_t* kvr = KVR + (size_t)row * 1024;
        const float* rct = rc + t * 16; const float* rst = rs + t * 16;
#pragma unroll
        for (int pass = 0; pass < 2; ++pass) {
            const int ch = lane + 64 * pass;
            if (ch < 96) {
                const int h = ch / 12, cc = ch - h * 12;
                float q[8], k[8];
                unpack8(*(const uint4*)(qr + ch * 8), q);
                if (cc < 8) unpack8(*(const uint4*)(kvr + h * 128 + cc * 8), k);
                else unpack8(*(const uint4*)(pr + PKR0 + (cc - 8) * 8), k);
                const float ksc = cc < 8 ? rkv : 1.f;
#pragma unroll
                for (int e = 0; e < 8; ++e) { q[e] *= rq; k[e] *= ksc; }
                if (cc >= 8 && lat) {
                    const int sub = cc - 8, ax = sub >> 1, half = sub & 1;
                    float qp[8], kp[8];
                    unpack8(*(const uint4*)(qr + (ch ^ 1) * 8), qp); unpack8(*(const uint4*)(pr + PKR0 + (sub ^ 1) * 8), kp);
                    const float4 c0 = *(const float4*)(rct + ax * 8), c1 = *(const float4*)(rct + ax * 8 + 4), s0 = *(const float4*)(rst + ax * 8), s1 = *(const float4*)(rst + ax * 8 + 4);
                    const float cs_[8] = {c0.x, c0.y, c0.z, c0.w, c1.x, c1.y, c1.z, c1.w}, sn_[8] = {s0.x, s0.y, s0.z, s0.w, s1.x, s1.y, s1.z, s1.w};
#pragma unroll
                    for (int e = 0; e < 8; ++e) {
                        const float sg = half ? sn_[e] : -sn_[e];
                        q[e] = q[e] * cs_[e] + qp[e] * rq * sg;
                        k[e] = k[e] * cs_[e] + kp[e] * sg;
                    }
                }
#pragma unroll
                for (int e = 0; e < 8; ++e) q[e] *= QSCALE;
                *(uint4*)(QA + (size_t)row * 768 + ch * 8) = pack8(q);
                *(uint4*)(KA + keyrow * 768 + ch * 8) = pack8(k);
            }
        }
    }
    bf16_t* vt = (bf16_t*)smem;
    float* rk = (float*)(smem + 64 * 72 * 2);
    for (int it = blockIdx.x; it < (RT / 64) * 8; it += gridDim.x) {
        const int g = it >> 3, h = it & 7, rowg = g * 64;
        const bool lat = rowg < RL;
        const int b = lat ? (rowg >> 12) : ((rowg - RL) >> 8), t0 = lat ? (rowg & 4095) : ((rowg - RL) & 255);
        const size_t key0 = lat ? t0 : SEQ + t0;
#pragma unroll 4
        for (int rr = 0; rr < 16; ++rr) {
            const int lr = wave * 16 + rr;
            const bf16_t* pr = P + (size_t)(rowg + lr) * LDP + PKV0;
            const uint2 u = *(const uint2*)(pr + lane * 4);
            float sk = bflo(u.x) * bflo(u.x) + bfhi(u.x) * bfhi(u.x) + bflo(u.y) * bflo(u.y) + bfhi(u.y) * bfhi(u.y);
            sk = wsum(sk);
            if (lane == 0) rk[lr] = rsqrtf(sk * (1.f / 256.f) + 1e-6f);
        }
        __syncthreads();
#pragma unroll
        for (int i = 0; i < 2; ++i) {
            const int c = tid + 256 * i, lr = c >> 3, part = c & 7;
            float f[8]; unpack8(*(const uint4*)(KVR + (size_t)(rowg + lr) * 1024 + h * 128 + 64 + part * 8), f);
            const float sc = rk[lr];
#pragma unroll
            for (int e = 0; e < 8; ++e) f[e] *= sc;
            *(uint4*)(vt + lr * 72 + part * 8) = pack8(f);
        }
        __syncthreads();
#pragma unroll
        for (int i = 0; i < 2; ++i) {
            const int c = tid + 256 * i, dd = c >> 3, kc = c & 7;
            float f[8];
#pragma unroll
            for (int e = 0; e < 8; ++e) f[e] = bf2f(vt[(kc * 8 + e) * 72 + dd]);
            const uint4 u = pack8(f);
            bf16_t* dst = VA + ((size_t)(b * 8 + h) * 64 + dd) * KEYS + key0 + (kc >> 2) * 32 + (kc & 1) * 16 + ((kc & 3) >> 1) * 4;
            *(uint2*)dst = make_uint2(u.x, u.y); *(uint2*)(dst + 8) = make_uint2(u.z, u.w);
        }
        __syncthreads();
    }
}
__device__ __forceinline__ float xmax_16_32(float v) {
    unsigned u = __builtin_bit_cast(unsigned, v);
    auto r = __builtin_amdgcn_permlane32_swap(u, u, false, false);
    float m = fmaxf(__builtin_bit_cast(float, r[0]), __builtin_bit_cast(float, r[1]));
    u = __builtin_bit_cast(unsigned, m);
    auto r2 = __builtin_amdgcn_permlane16_swap(u, u, false, false);
    return fmaxf(__builtin_bit_cast(float, r2[0]), __builtin_bit_cast(float, r2[1]));
}
__device__ __forceinline__ float xsum_16_32(float v) {
    unsigned u = __builtin_bit_cast(unsigned, v);
    auto r = __builtin_amdgcn_permlane32_swap(u, u, false, false);
    float m = __builtin_bit_cast(float, r[0]) + __builtin_bit_cast(float, r[1]);
    u = __builtin_bit_cast(unsigned, m);
    auto r2 = __builtin_amdgcn_permlane16_swap(u, u, false, false);
    return __builtin_bit_cast(float, r2[0]) + __builtin_bit_cast(float, r2[1]);
}
constexpr int KS_LD = 104, VT_LD = 72;
constexpr int AT_BUF = 64 * KS_LD * 2 + 64 * VT_LD * 2;
__device__ __forceinline__ void ph_at(const Params& p, int l, char* smem) {
    const int tid = tidx(), lane = tid & 63, wave = tid >> 6, fr = lane & 15, fq = lane >> 4;
    const bf16_t* QA = (const bf16_t*)(p.ws + O_X + X_QA); const bf16_t* KA = (const bf16_t*)(p.ws + O_X + X_KA); const bf16_t* VA = (const bf16_t*)(p.ws + O_X + X_VA);
    bf16_t* ATT = (bf16_t*)(p.ws + O_ATT);
    const int nitems = 1024 + (l < NLAYER - 1 ? 64 : 0);
    for (int it0 = blockIdx.x; it0 < nitems; it0 += gridDim.x) {
        int it = it0;
        if (gridDim.x == 512 && it0 < 1024) {
            const int x = it0 & 7, j = (it0 >> 3) & 63, rd = it0 >> 9;
            it = ((x * 4 + rd * 2 + (j >> 5)) << 5) | (j & 31);
        }
        int b, h, row0, ntile; size_t krow0;
        if (it < 1024) { b = it >> 8; h = (it >> 5) & 7; row0 = b * SEQ + (it & 31) * 128; krow0 = (size_t)b * KEYS; ntile = KEYS / 64; }
        else { const int j = it - 1024; b = j >> 4; h = (j >> 1) & 7; row0 = RL + b * CTX + (j & 1) * 128; krow0 = (size_t)b * KEYS + SEQ; ntile = CTX / 64; }
        const int qrow = row0 + wave * 32 + fr;
        const size_t vrow0 = (size_t)(b * 8 + h) * 64; const int koff0 = (int)(krow0 - (size_t)b * KEYS);
        bf16x8 qf[2][3];
#pragma unroll
        for (int t = 0; t < 2; ++t)
#pragma unroll
            for (int ks = 0; ks < 3; ++ks) qf[t][ks] = *(const bf16x8*)(QA + (size_t)(qrow + 16 * t) * 768 + h * 96 + ks * 32 + fq * 8);
        f32x4 ot[2][4];
#pragma unroll
        for (int t = 0; t < 2; ++t)
#pragma unroll
            for (int i = 0; i < 4; ++i) ot[t][i] = (f32x4){0.f, 0.f, 0.f, 0.f};
        float m_run[2] = {-1e30f, -1e30f}, l_run[2] = {0.f, 0.f};
        uint4 rk0, rk1, rk2, rv0, rv1;
#define AT_GLOAD(KT) do { const size_t kr_ = krow0 + (size_t)(KT) * 64; \
            { const int c = tid, key = c / 12, part = c % 12; rk0 = *(const uint4*)(KA + (kr_ + key) * 768 + h * 96 + part * 8); } \
            { const int c = tid + 256, key = c / 12, part = c % 12; rk1 = *(const uint4*)(KA + (kr_ + key) * 768 + h * 96 + part * 8); } \
            { const int c = tid + 512, key = c / 12, part = c % 12; rk2 = *(const uint4*)(KA + (kr_ + key) * 768 + h * 96 + part * 8); } \
            { const int c = tid, dd_ = c >> 3, part = c & 7; rv0 = *(const uint4*)(VA + (vrow0 + dd_) * KEYS + koff0 + (KT) * 64 + part * 8); } \
            { const int c = tid + 256, dd_ = c >> 3, part = c & 7; rv1 = *(const uint4*)(VA + (vrow0 + dd_) * KEYS + koff0 + (KT) * 64 + part * 8); } } while (0)
#define AT_VSTORE(RV, C) do { const int dd_ = (C) >> 3, part = (C) & 7; *(uint4*)(Vt_ + dd_ * VT_LD + part * 8) = RV; } while (0)
#define AT_SSTORE(BUF) do { bf16_t* Ks_ = (bf16_t*)(smem + (BUF) * AT_BUF); bf16_t* Vt_ = Ks_ + 64 * KS_LD; \
            { const int c = tid, key = c / 12, part = c % 12; *(uint4*)(Ks_ + key * KS_LD + part * 8) = rk0; } \
            { const int c = tid + 256, key = c / 12, part = c % 12; *(uint4*)(Ks_ + key * KS_LD + part * 8) = rk1; } \
            { const int c = tid + 512, key = c / 12, part = c % 12; *(uint4*)(Ks_ + key * KS_LD + part * 8) = rk2; } \
            AT_VSTORE(rv0, tid); AT_VSTORE(rv1, tid + 256); } while (0)
        AT_GLOAD(0); AT_SSTORE(0);
        __syncthreads();
        for (int kt = 0; kt < ntile; ++kt) {
            const int cur = kt & 1;
            if (kt + 1 < ntile) AT_GLOAD(kt + 1);
            const bf16_t* Ks = (const bf16_t*)(smem + cur * AT_BUF); const bf16_t* Vt = Ks + 64 * KS_LD;
            f32x4 st[2][4];
#pragma unroll
            for (int jh = 0; jh < 2; ++jh) {
                bf16x8 kf[2][3];
#pragma unroll
                for (int jj = 0; jj < 2; ++jj)
#pragma unroll
                    for (int ks = 0; ks < 3; ++ks) kf[jj][ks] = *(const bf16x8*)(Ks + ((jh * 2 + jj) * 16 + fr) * KS_LD + ks * 32 + fq * 8);
#pragma unroll
                for (int jj = 0; jj < 2; ++jj) {
                    const int j = jh * 2 + jj;
                    st[0][j] = (f32x4){0.f, 0.f, 0.f, 0.f}; st[1][j] = (f32x4){0.f, 0.f, 0.f, 0.f};
#pragma unroll
                    for (int ks = 0; ks < 3; ++ks) {
                        st[0][j] = __builtin_amdgcn_mfma_f32_16x16x32_bf16(kf[jj][ks], qf[0][ks], st[0][j], 0, 0, 0);
                        st[1][j] = __builtin_amdgcn_mfma_f32_16x16x32_bf16(kf[jj][ks], qf[1][ks], st[1][j], 0, 0, 0);
                    }
                }
            }
            bf16x8 vf[2][4];
#pragma unroll
            for (int k2 = 0; k2 < 2; ++k2)
#pragma unroll
                for (int dt = 0; dt < 4; ++dt) {
                    vf[k2][dt] = *(const bf16x8*)(Vt + (dt * 16 + fr) * VT_LD + k2 * 32 + fq * 8);
                }
            uint4 pu[2][2];
#pragma unroll
            for (int t = 0; t < 2; ++t) {
                float mx = st[t][0][0];
#pragma unroll
                for (int j = 0; j < 4; ++j)
#pragma unroll
                    for (int r = 0; r < 4; ++r) mx = fmaxf(mx, st[t][j][r]);
                if (__any(mx > m_run[t] + 6.f)) {
                    mx = xmax_16_32(mx);
                    const float m_new = fmaxf(m_run[t], mx);
                    const float alpha = __builtin_amdgcn_exp2f(m_run[t] - m_new);
                    m_run[t] = m_new;
                    l_run[t] *= alpha;
#pragma unroll
                    for (int i = 0; i < 4; ++i) ot[t][i] *= alpha;
                }
                const float mr = m_run[t];
                float ps = 0.f;
#pragma unroll
                for (int j = 0; j < 4; ++j)
#pragma unroll
                    for (int r = 0; r < 4; ++r) { st[t][j][r] = __builtin_amdgcn_exp2f(st[t][j][r] - mr); ps += st[t][j][r]; }
                l_run[t] += ps;
#pragma unroll
                for (int k2 = 0; k2 < 2; ++k2)
                    pu[t][k2] = make_uint4(pack2(st[t][2 * k2][0], st[t][2 * k2][1]), pack2(st[t][2 * k2][2], st[t][2 * k2][3]),
                                           pack2(st[t][2 * k2 + 1][0], st[t][2 * k2 + 1][1]), pack2(st[t][2 * k2 + 1][2], st[t][2 * k2 + 1][3]));
            }
#pragma unroll
            for (int k2 = 0; k2 < 2; ++k2) {
                const bf16x8 pb0 = __builtin_bit_cast(bf16x8, pu[0][k2]), pb1 = __builtin_bit_cast(bf16x8, pu[1][k2]);
#pragma unroll
                for (int dt = 0; dt < 4; ++dt) {
                    ot[0][dt] = __builtin_amdgcn_mfma_f32_16x16x32_bf16(vf[k2][dt], pb0, ot[0][dt], 0, 0, 0);
                    ot[1][dt] = __builtin_amdgcn_mfma_f32_16x16x32_bf16(vf[k2][dt], pb1, ot[1][dt], 0, 0, 0);
                }
            }
            if (kt + 1 < ntile) AT_SSTORE(cur ^ 1);
            __syncthreads();
        }
#pragma unroll
        for (int t = 0; t < 2; ++t) {
            const float inv = 1.f / xsum_16_32(l_run[t]);
#pragma unroll
            for (int dt = 0; dt < 4; ++dt) { f32x4 o = ot[t][dt] * inv; store_bf16x4(ATT + (size_t)(qrow + 16 * t) * 512 + h * 64 + dt * 16 + fq * 4, o); }
        }
    }
}

__device__ __forceinline__ void row_edges(int row, bool& first, bool& last) {
    if (row < RL) { const int t = row & 4095; first = t == 0; last = t == 4095; }
    else { const int s = (row - RL) & 255; first = s == 0; last = s == 255; }
}
__device__ __forceinline__ float xs1(const bf16_t* P, const float* mu, int row, int col) {
    bool first, last; row_edges(row, first, last);
    const bf16_t* pc = P + (size_t)row * LDP + PR0 + col;
    const float c = bf2f(*pc), pv0 = bf2f(*(first ? pc : pc - LDP)), nx0 = bf2f(*(last ? pc : pc + LDP));
    const float pv = first ? 0.f : pv0, nx = last ? 0.f : nx0;
    return c + (0.5f * (pv + nx) - c) * mu[col];
}
__device__ __forceinline__ void xs8(const bf16_t* P, const float* mu, int row, int col, float (&o)[8]) {
    bool first, last; row_edges(row, first, last);
    const bf16_t* pc = P + (size_t)row * LDP + PR0 + col;
    const uint4 uc = *(const uint4*)pc, up = *(const uint4*)(first ? pc : pc - LDP), un = *(const uint4*)(last ? pc : pc + LDP);
    float c[8], pv[8], nx[8]; unpack8(uc, c); unpack8(up, pv); unpack8(un, nx);
    const float fp = first ? 0.f : 0.5f, fn = last ? 0.f : 0.5f;
    const float4 m0 = *(const float4*)(mu + col), m1 = *(const float4*)(mu + col + 4);
    const float m[8] = {m0.x, m0.y, m0.z, m0.w, m1.x, m1.y, m1.z, m1.w};
#pragma unroll
    for (int j = 0; j < 8; ++j) o[j] = c[j] + ((fp * pv[j] + fn * nx[j]) - c[j]) * m[j];
}
struct ALRw {
    const bf16_t* P; const float* mu; int row0; int colbase, mode;
    __device__ __forceinline__ ALRw(const bf16_t* P_, const float* mu_, int row0_, int colbase_, int mode_) : P(P_), mu(mu_), colbase(colbase_), mode(mode_) {
        row0 = row0_ + (tidx() >> 3);
    }
    __device__ __forceinline__ uint4 load(int i, int k) const {
        float o[8]; xs8(P, mu, row0 + 32 * i, colbase + k, o);
        if (mode == 0) {
#pragma unroll
            for (int j = 0; j < 8; ++j) o[j] = tanhf(o[j]);
        } else if (mode == 2) {
#pragma unroll
            for (int j = 0; j < 8; ++j) o[j] = sigmoidf_(o[j]);
        }
        return pack8(o);
    }
};
__device__ __forceinline__ void ph_rp1(const Params& p, int l, char* smem) {
    const bf16_t* P = (const bf16_t*)(p.ws + O_P); const float* mu = p.in[I_MU] + l * 1792;
    bf16_t* RG = (bf16_t*)(p.ws + O_RG);
    for (int it = blockIdx.x; it < 1088; it += gridDim.x) {
        const int mt = it >> 2, nt = it & 3;
        f32x4 acc[2][4];
        ALRw al(P, mu, mt * 64, 1664, 2);
        gemm_core<2>(al, (const bf16_t*)(p.ws + O_WB + W_GUP) + (size_t)nt * 128 * 128, 128, 128, acc, smem);
        acc_foreach<2>(acc, [&](int m, int n, const f32x4& v) { store_bf16x4(RG + (size_t)(mt * 64 + m) * 512 + nt * 128 + n, v); });
    }
}
__device__ __forceinline__ void ph_rp2(const Params& p, int l) {
    const int lane = tidx() & 63, wave = tidx() >> 6;
    const bf16_t* P = (const bf16_t*)(p.ws + O_P); const float* mu = p.in[I_MU] + l * 1792; const float* kkw = p.in[I_KK] + l * 512;
    float* KKN = (float*)(p.ws + O_X + X_KKN);
    for (int row = blockIdx.x * 4 + wave; row < RT; row += gridDim.x * 4) {
        float k8[8]; xs8(P, mu, row, 512 + lane * 8, k8);
        float s = 0.f;
#pragma unroll
        for (int j = 0; j < 8; ++j) { const float v = k8[j] * kkw[lane * 8 + j]; s += v * v; }
        s += __shfl_xor(s, 1); s += __shfl_xor(s, 2); s += __shfl_xor(s, 4);
        if ((lane & 7) == 0) KKN[(size_t)row * 8 + (lane >> 3)] = rsqrtf(s + 1e-12f);
    }
}

__device__ __forceinline__ int scan_row(int b, int d, int n) {
    if (n < CTX) return RL + b * CTX + (d == 0 ? n : CTX - 1 - n);
    const int t = n - CTX; return b * SEQ + (d == 0 ? t : SEQ - 1 - t);
}
constexpr int SL = 72;
constexpr int SLOT_E = 64 * SL;
template <int LDA, int LDB>
__device__ __forceinline__ void mm64(const bf16_t* A, const bf16_t* B, f32x4 (&acc)[4], int wave, int fr, int fq) {
#pragma unroll
    for (int ks = 0; ks < 2; ++ks) {
        const bf16x8 af = *(const bf16x8*)(A + (wave * 16 + fr) * LDA + ks * 32 + fq * 8);
#pragma unroll
        for (int nt = 0; nt < 4; ++nt) {
            const bf16x8 bfv = *(const bf16x8*)(B + (nt * 16 + fr) * LDB + ks * 32 + fq * 8);
            acc[nt] = __builtin_amdgcn_mfma_f32_16x16x32_bf16(bfv, af, acc[nt], 0, 0, 0);
        }
    }
}
__device__ __forceinline__ void acc_zero(f32x4 (&acc)[4]) {
#pragma unroll
    for (int nt = 0; nt < 4; ++nt) acc[nt] = (f32x4){0.f, 0.f, 0.f, 0.f};
}
template <bool STRICT>
__device__ __forceinline__ void acc_mask(f32x4 (&acc)[4], int m, int fq) {
#pragma unroll
    for (int nt = 0; nt < 4; ++nt)
#pragma unroll
        for (int r = 0; r < 4; ++r) { const int n = nt * 16 + fq * 4 + r; const bool keep = STRICT ? (m < n) : (m <= n); if (!keep) acc[nt][r] = 0.f; }
}
__device__ __forceinline__ void st_rm(bf16_t* dst, const f32x4 (&acc)[4], int m, int fq) {
#pragma unroll
    for (int nt = 0; nt < 4; ++nt) store_bf16x4(dst + m * SL + nt * 16 + fq * 4, acc[nt]);
}
__device__ __forceinline__ void st_tr(bf16_t* dst, const f32x4 (&acc)[4], int m, int fq) {
#pragma unroll
    for (int nt = 0; nt < 4; ++nt)
#pragma unroll
        for (int r = 0; r < 4; ++r) dst[(nt * 16 + fq * 4 + r) * SL + m] = f2bf(acc[nt][r]);
}
__device__ __forceinline__ void ph_r1(const Params& p, int l, char* smem) {
    const int tid0 = tidx();
#define R1_IDX const int tid = lv(tid0), lane = tid & 63, wave = tid >> 6, fr = lane & 15, fq = lane >> 4, bi = tid >> 2, bq = (tid & 3) * 16, m = wave * 16 + fr; (void)bi; (void)bq; (void)m; (void)fq;
    const bf16_t* P = (const bf16_t*)(p.ws + O_P); const float* mu = p.in[I_MU] + l * 1792;
    const float* kkw = p.in[I_KK] + l * 512; const float* kaw = p.in[I_KA] + l * 512; const float* rkw = p.in[I_RK] + l * 512;
    const float* KKN = (const float*)(p.ws + O_X + X_KKN); float* BON = (float*)(p.ws + O_X + X_BON);
    bf16_t* gMT = (bf16_t*)(p.ws + O_X + X_MT); bf16_t* gNL = (bf16_t*)(p.ws + O_H);
    bf16_t* gGT = (bf16_t*)(p.ws + O_X + X_GT); bf16_t* gYL = (bf16_t*)(p.ws + O_X + X_YL);
    bf16_t* slot = (bf16_t*)smem;
    bf16_t* s0 = slot, *s1 = slot + SLOT_E, *s2 = slot + 2 * SLOT_E, *s3 = slot + 3 * SLOT_E;
    bf16_t* sa = slot + 4 * SLOT_E, *sb = slot + 5 * SLOT_E, *sc = slot + 6 * SLOT_E, *sT = slot + 7 * SLOT_E;
    float* misc = (float*)(smem + 8 * SLOT_E * 2);
    float* GAM = misc; float* SEG = misc + 64;
    float* ASIG = (float*)s0;
    float* LWS = (float*)s2;
    for (int it = blockIdx.x; it < NCP; it += gridDim.x) {
        const int c = it % 68, d = (it / 68) & 1, h = (it / 136) & 7, b = it / 1088;
        {
            R1_IDX const int rowb = scan_row(b, d, c * 64 + bi); (void)rowb;
            float o[8];
#pragma unroll
            for (int hh = 0; hh < 2; ++hh) {
                xs8(P, mu, rowb, 1536 + bq + hh * 8, o);
#pragma unroll
                for (int j = 0; j < 8; ++j) o[j] = 1.f - 2.f * __builtin_amdgcn_rcpf(1.f + __expf(2.f * o[j]));
                *(uint4*)(sa + bi * SL + bq + hh * 8) = pack8(o);
                xs8(P, mu, rowb, 1600 + bq + hh * 8, o);
                *(uint4*)(sb + bi * SL + bq + hh * 8) = pack8(o);
            }
        }
        __syncthreads();
        {
            R1_IDX const int rowb = scan_row(b, d, c * 64 + bi); (void)rowb;
            f32x4 acc[4];
            acc_zero(acc);
            mm64<SL, 64>(sa, (const bf16_t*)(p.ws + O_WB + W_WUP) + ((size_t)d * 512 + h * 64) * 64, acc, wave, fr, fq);
            const float* w0 = p.in[I_W0] + (l * 2 + d) * 512 + h * 64;
#pragma unroll
            for (int nt = 0; nt < 4; ++nt) {
                const int n = nt * 16 + fq * 4; float4 o; float* op = (float*)&o;
#pragma unroll
                for (int r = 0; r < 4; ++r) { const float z = w0[n + r] + acc[nt][r]; op[r] = -0.6065306597126334f * __builtin_amdgcn_rcpf(1.f + __expf(-z)); }
                *(float4*)(LWS + m * 68 + n) = o;
            }
            acc_zero(acc);
            mm64<SL, 64>(sb, (const bf16_t*)(p.ws + O_WB + W_AUP) + ((size_t)d * 512 + h * 64) * 64, acc, wave, fr, fq);
            const float* a0 = p.in[I_A0] + (l * 2 + d) * 512 + h * 64;
#pragma unroll
            for (int nt = 0; nt < 4; ++nt) {
                const int n = nt * 16 + fq * 4;
                *(float4*)(ASIG + m * 68 + n) = make_float4(__builtin_amdgcn_rcpf(1.f + __expf(-(a0[n] + acc[nt][0]))), __builtin_amdgcn_rcpf(1.f + __expf(-(a0[n + 1] + acc[nt][1]))), __builtin_amdgcn_rcpf(1.f + __expf(-(a0[n + 2] + acc[nt][2]))), __builtin_amdgcn_rcpf(1.f + __expf(-(a0[n + 3] + acc[nt][3]))));
            }
        }
        __syncthreads();
        {
            R1_IDX const int rowb = scan_row(b, d, c * 64 + bi); (void)rowb;
            const int k = tid & 63, seg = tid >> 6;
            float run = 0.f;
#pragma unroll
            for (int ii = 0; ii < 16; ++ii) { run += LWS[(seg * 16 + ii) * 68 + k]; LWS[(seg * 16 + ii) * 68 + k] = run; }
            SEG[seg * 64 + k] = run;
            __syncthreads();
            float off = 0.f;
#pragma unroll
            for (int sgi = 0; sgi < 3; ++sgi) if (sgi < seg) off += SEG[sgi * 64 + k];
#pragma unroll
            for (int ii = 0; ii < 16; ++ii) LWS[(seg * 16 + ii) * 68 + k] += off;
        }
        __syncthreads();
        {
            R1_IDX const int rowb = scan_row(b, d, c * 64 + bi); (void)rowb;
            float cs[16], cm[16], cc[16], ag[16];
#pragma unroll
            for (int q = 0; q < 4; ++q) {
                const float4 v0 = *(const float4*)(LWS + bi * 68 + bq + q * 4);
                const float4 v1 = bi > 0 ? *(const float4*)(LWS + (bi - 1) * 68 + bq + q * 4) : make_float4(0.f, 0.f, 0.f, 0.f);
                const float4 v2 = *(const float4*)(LWS + 63 * 68 + bq + q * 4);
                const float4 v3 = *(const float4*)(ASIG + bi * 68 + bq + q * 4);
                cs[q * 4] = v0.x; cs[q * 4 + 1] = v0.y; cs[q * 4 + 2] = v0.z; cs[q * 4 + 3] = v0.w;
                cm[q * 4] = v1.x; cm[q * 4 + 1] = v1.y; cm[q * 4 + 2] = v1.z; cm[q * 4 + 3] = v1.w;
                cc[q * 4] = v2.x; cc[q * 4 + 1] = v2.y; cc[q * 4 + 2] = v2.z; cc[q * 4 + 3] = v2.w;
                ag[q * 4] = v3.x; ag[q * 4 + 1] = v3.y; ag[q * 4 + 2] = v3.z; ag[q * 4 + 3] = v3.w;
            }
            __syncthreads();
            const float kkn = KKN[(size_t)rowb * 8 + h];
            float bon = 0.f;
#pragma unroll
            for (int hh = 0; hh < 2; ++hh) {
                float r8[8], k8[8], oa[8], ob[8], ok[8], orr[8];
                const int col = h * 64 + bq + hh * 8;
                xs8(P, mu, rowb, col, r8); xs8(P, mu, rowb, 512 + col, k8);
#pragma unroll
                for (int j = 0; j < 8; ++j) {
                    const int e = hh * 8 + j;
                    const float kk = k8[j] * kkw[col + j] * kkn;
                    const float kd = k8[j] * (1.f + (ag[e] - 1.f) * kaw[col + j]);
                    const float eneg = __expf(-cs[e]);
                    oa[j] = -kk * __expf(cm[e]); ob[j] = kk * ag[e] * eneg; ok[j] = kd * eneg; orr[j] = r8[j] * __builtin_amdgcn_rcpf(eneg);
                    bon += r8[j] * kd * rkw[col + j];
                }
                *(uint4*)(s0 + bi * SL + bq + hh * 8) = pack8(oa); *(uint4*)(s1 + bi * SL + bq + hh * 8) = pack8(ob);
                *(uint4*)(s2 + bi * SL + bq + hh * 8) = pack8(ok); *(uint4*)(s3 + bi * SL + bq + hh * 8) = pack8(orr);
            }
            bon += __shfl_xor(bon, 1); bon += __shfl_xor(bon, 2);
            if ((tid & 3) == 0) BON[((size_t)d * RT + rowb) * 8 + h] = bon;
            if (bi == 0) {
#pragma unroll
                for (int e = 0; e < 16; ++e) GAM[bq + e] = __expf(cc[e]);
            }
        }
        __syncthreads();
        {
            R1_IDX const int rowb = scan_row(b, d, c * 64 + bi); (void)rowb;
            f32x4 acc[4]; acc_zero(acc);
            mm64<SL, SL>(s1, s0, acc, wave, fr, fq);
            acc_mask<true>(acc, m, fq);
            st_rm(sa, acc, m, fq); st_tr(sb, acc, m, fq);
#pragma unroll
            for (int nt = 0; nt < 4; ++nt)
#pragma unroll
                for (int r = 0; r < 4; ++r) if (nt * 16 + fq * 4 + r == m) acc[nt][r] += 1.f;
            st_rm(sc, acc, m, fq);
        }
        __syncthreads();
#pragma unroll
        for (int itr = 0; itr < 5; ++itr) {
            R1_IDX
            bf16_t* ptr = (itr & 1) ? sT : sb;
            bf16_t* ptw = (itr & 1) ? sb : sT;
            f32x4 acc[4]; acc_zero(acc);
            mm64<SL, SL>(sa, ptr, acc, wave, fr, fq);
            st_rm(sa, acc, m, fq); st_tr(ptw, acc, m, fq);
            __syncthreads();
            f32x4 tacc[4];
#pragma unroll
            for (int nt = 0; nt < 4; ++nt) { const uint2 u = *(const uint2*)(sc + m * SL + nt * 16 + fq * 4); tacc[nt] = (f32x4){bflo(u.x), bfhi(u.x), bflo(u.y), bfhi(u.y)}; }
            mm64<SL, SL>(sc, ptw, tacc, wave, fr, fq);
            if (itr < 4) st_rm(sc, tacc, m, fq); else st_tr(sb, tacc, m, fq);
        }
        __syncthreads();
        {
            R1_IDX const int rowb = scan_row(b, d, c * 64 + bi); (void)rowb;
            f32x4 acc[4]; acc_zero(acc);
            mm64<SL, SL>(s2, s0, acc, wave, fr, fq);
            acc_mask<true>(acc, m, fq);
            st_rm(sa, acc, m, fq);
            float f0[8], f1[8];
            unpack8(*(const uint4*)(s0 + bi * SL + bq), f0); unpack8(*(const uint4*)(s0 + bi * SL + bq + 8), f1);
#pragma unroll
            for (int e = 0; e < 8; ++e) { sc[(bq + e) * SL + bi] = f2bf(f0[e]); sc[(bq + 8 + e) * SL + bi] = f2bf(f1[e]); }
        }
        __syncthreads();
        {
            R1_IDX const int rowb = scan_row(b, d, c * 64 + bi); (void)rowb;
            f32x4 acc[4]; acc_zero(acc);
            mm64<SL, SL>(sc, sb, acc, wave, fr, fq);
            st_rm(sT, acc, m, fq);
            acc_zero(acc);
            mm64<SL, SL>(sa, sb, acc, wave, fr, fq);
            st_rm(s0, acc, m, fq);
        }
        __syncthreads();
        f32x4 qacc[4];
        {
            R1_IDX const int rowb = scan_row(b, d, c * 64 + bi); (void)rowb;
            f32x4 acc[4]; acc_zero(acc);
            mm64<SL, SL>(s1, s3, acc, wave, fr, fq);
            acc_mask<false>(acc, m, fq);
            st_tr(sa, acc, m, fq);
            acc_zero(qacc);
            mm64<SL, SL>(s2, s3, qacc, wave, fr, fq);
            acc_mask<false>(qacc, m, fq);
            float f0[8], f1[8];
            unpack8(*(const uint4*)(s3 + bi * SL + bq), f0); unpack8(*(const uint4*)(s3 + bi * SL + bq + 8), f1);
#pragma unroll
            for (int e = 0; e < 8; ++e) { sc[(bq + e) * SL + bi] = f2bf(f0[e]); sc[(bq + 8 + e) * SL + bi] = f2bf(f1[e]); }
        }
        __syncthreads();
        {
            R1_IDX const int rowb = scan_row(b, d, c * 64 + bi); (void)rowb;
            f32x4 acc[4];
#pragma unroll
            for (int nt = 0; nt < 4; ++nt) { const uint2 u = *(const uint2*)(sc + m * SL + nt * 16 + fq * 4); acc[nt] = (f32x4){bflo(u.x), bfhi(u.x), bflo(u.y), bfhi(u.y)}; }
            mm64<SL, SL>(sT, sa, acc, wave, fr, fq);
            bf16_t* gt = gGT + (size_t)it * 4096;
#pragma unroll
            for (int nt = 0; nt < 4; ++nt)
#pragma unroll
                for (int r = 0; r < 4; ++r) gt[(nt * 16 + fq * 4 + r) * 64 + m] = f2bf(acc[nt][r]);
            mm64<SL, SL>(s0, sa, qacc, wave, fr, fq);
            st_tr(sb, qacc, m, fq);
            float f0[8], f1[8];
            unpack8(*(const uint4*)(s1 + bi * SL + bq), f0); unpack8(*(const uint4*)(s1 + bi * SL + bq + 8), f1);
#pragma unroll
            for (int e = 0; e < 8; ++e) { s3[(bq + e) * SL + bi] = f2bf(f0[e] * GAM[bq + e]); s3[(bq + 8 + e) * SL + bi] = f2bf(f1[e] * GAM[bq + 8 + e]); }
        }
        __syncthreads();
        {
            R1_IDX const int rowb = scan_row(b, d, c * 64 + bi); (void)rowb;
            f32x4 acc[4]; acc_zero(acc);
            mm64<SL, SL>(sT, s3, acc, wave, fr, fq);
            bf16_t* mt = gMT + (size_t)it * 4096;
#pragma unroll
            for (int nt = 0; nt < 4; ++nt)
#pragma unroll
                for (int r = 0; r < 4; ++r) { const int n = nt * 16 + fq * 4 + r; mt[n * 64 + m] = f2bf(acc[nt][r] + (n == m ? GAM[m] : 0.f)); }
#pragma unroll
            for (int nt = 0; nt < 4; ++nt) {
                const int n = nt * 16 + fq * 4; const uint2 u = *(const uint2*)(s2 + m * SL + n);
                acc[nt] = (f32x4){bflo(u.x) * GAM[n], bfhi(u.x) * GAM[n + 1], bflo(u.y) * GAM[n + 2], bfhi(u.y) * GAM[n + 3]};
            }
            mm64<SL, SL>(s0, s3, acc, wave, fr, fq);
            st_tr(s1, acc, m, fq);
            float v8[8];
#pragma unroll
            for (int hh = 0; hh < 2; ++hh) {
                xs8(P, mu, rowb, 1024 + h * 64 + bq + hh * 8, v8);
#pragma unroll
                for (int e = 0; e < 8; ++e) sc[(bq + hh * 8 + e) * SL + bi] = f2bf(v8[e]);
            }
        }
        __syncthreads();
        {
            R1_IDX const int rowb = scan_row(b, d, c * 64 + bi); (void)rowb;
            f32x4 acc[4]; acc_zero(acc);
            mm64<SL, SL>(sc, sb, acc, wave, fr, fq);
            bf16_t* yl = gYL + (size_t)it * 4096;
#pragma unroll
            for (int nt = 0; nt < 4; ++nt) store_bf16x4(yl + m * 64 + nt * 16 + fq * 4, acc[nt]);
            acc_zero(acc);
            mm64<SL, SL>(sc, s1, acc, wave, fr, fq);
            bf16_t* nl = gNL + (size_t)it * 4096;
#pragma unroll
            for (int nt = 0; nt < 4; ++nt) store_bf16x4(nl + m * 64 + nt * 16 + fq * 4, acc[nt]);
        }
        __syncthreads();
    }
}
__device__ __forceinline__ void ph_r2(const Params& p, char* smem) {
    const int tid = tidx(), lane = tid & 63, wave = tid >> 6, fr = lane & 15, fq = lane >> 4;
    const char* gMT = (const char*)(p.ws + O_X + X_MT); const char* gNL = (const char*)(p.ws + O_H);
    uint4* gS0 = (uint4*)(p.ws + O_X + X_S0);
    const int wofs = __builtin_amdgcn_readfirstlane(wave) * 1024;
    const unsigned lds0 = (unsigned)(uintptr_t)smem;
    const unsigned mtaddr = lds0 + fr * 128 + fq * 8, nladdr = lds0 + (wave * 16 + fr) * 128 + fq * 8;
    auto issue = [&](size_t cp, int slot) {
        char* dst = smem + slot * 16384 + wofs;
        const char* s0 = gMT + cp * 8192 + wofs + lane * 16; const char* s1 = gNL + cp * 8192 + wofs + lane * 16;
        __builtin_amdgcn_global_load_lds((const unsigned*)s0, (unsigned*)dst, 16, 0, 0);
        __builtin_amdgcn_global_load_lds((const unsigned*)(s0 + 4096), (unsigned*)(dst + 4096), 16, 0, 0);
        __builtin_amdgcn_global_load_lds((const unsigned*)s1, (unsigned*)(dst + 8192), 16, 0, 0);
        __builtin_amdgcn_global_load_lds((const unsigned*)(s1 + 4096), (unsigned*)(dst + 12288), 16, 0, 0);
    };
    for (int it = blockIdx.x; it < 64; it += gridDim.x) {
        f32x4 st[4];
#pragma unroll
        for (int tt = 0; tt < 4; ++tt) st[tt] = (f32x4){0.f, 0.f, 0.f, 0.f};
        const size_t cp0 = (size_t)it * 68;
        issue(cp0, 0); issue(cp0 + 1, 1); issue(cp0 + 2, 2);
        for (int c4 = 0; c4 < 68; c4 += 4) {
#pragma unroll
            for (int j = 0; j < 4; ++j) {
                const int c = c4 + j;
                if (c < 65) asm volatile("s_waitcnt vmcnt(8)" ::: "memory"); else asm volatile("s_waitcnt vmcnt(0)" ::: "memory");
                __builtin_amdgcn_s_barrier();
                asm volatile("" ::: "memory");
                uint2 mx[4][2][2], nvv[4];
                asm volatile("ds_read_b64 %0, %1 offset:0" : "=v"(mx[0][0][0]) : "v"(mtaddr + j * 16384));
                asm volatile("ds_read_b64 %0, %1 offset:32" : "=v"(mx[0][0][1]) : "v"(mtaddr + j * 16384));
                asm volatile("ds_read_b64 %0, %1 offset:64" : "=v"(mx[0][1][0]) : "v"(mtaddr + j * 16384));
                asm volatile("ds_read_b64 %0, %1 offset:96" : "=v"(mx[0][1][1]) : "v"(mtaddr + j * 16384));
                asm volatile("ds_read_b64 %0, %1 offset:8192" : "=v"(nvv[0]) : "v"(nladdr + j * 16384));
                asm volatile("ds_read_b64 %0, %1 offset:2048" : "=v"(mx[1][0][0]) : "v"(mtaddr + j * 16384));
                asm volatile("ds_read_b64 %0, %1 offset:2080" : "=v"(mx[1][0][1]) : "v"(mtaddr + j * 16384));
                asm volatile("ds_read_b64 %0, %1 offset:2112" : "=v"(mx[1][1][0]) : "v"(mtaddr + j * 16384));
                asm volatile("ds_read_b64 %0, %1 offset:2144" : "=v"(mx[1][1][1]) : "v"(mtaddr + j * 16384));
                asm volatile("ds_read_b64 %0, %1 offset:8224" : "=v"(nvv[1]) : "v"(nladdr + j * 16384));
                asm volatile("ds_read_b64 %0, %1 offset:4096" : "=v"(mx[2][0][0]) : "v"(mtaddr + j * 16384));
                asm volatile("ds_read_b64 %0, %1 offset:4128" : "=v"(mx[2][0][1]) : "v"(mtaddr + j * 16384));
                asm volatile("ds_read_b64 %0, %1 offset:4160" : "=v"(mx[2][1][0]) : "v"(mtaddr + j * 16384));
                asm volatile("ds_read_b64 %0, %1 offset:4192" : "=v"(mx[2][1][1]) : "v"(mtaddr + j * 16384));
                asm volatile("ds_read_b64 %0, %1 offset:8256" : "=v"(nvv[2]) : "v"(nladdr + j * 16384));
                asm volatile("ds_read_b64 %0, %1 offset:6144" : "=v"(mx[3][0][0]) : "v"(mtaddr + j * 16384));
                asm volatile("ds_read_b64 %0, %1 offset:6176" : "=v"(mx[3][0][1]) : "v"(mtaddr + j * 16384));
                asm volatile("ds_read_b64 %0, %1 offset:6208" : "=v"(mx[3][1][0]) : "v"(mtaddr + j * 16384));
                asm volatile("ds_read_b64 %0, %1 offset:6240" : "=v"(mx[3][1][1]) : "v"(mtaddr + j * 16384));
                asm volatile("ds_read_b64 %0, %1 offset:8288" : "=v"(nvv[3]) : "v"(nladdr + j * 16384));
                u32x4 sb[2];
#pragma unroll
                for (int s_ = 0; s_ < 2; ++s_) sb[s_] = (u32x4){pack2(st[2 * s_][0], st[2 * s_][1]), pack2(st[2 * s_][2], st[2 * s_][3]), pack2(st[2 * s_ + 1][0], st[2 * s_ + 1][1]), pack2(st[2 * s_ + 1][2], st[2 * s_ + 1][3])};
                asm volatile("s_waitcnt lgkmcnt(0)" ::: "memory");
                __builtin_amdgcn_sched_barrier(0);
#pragma unroll
                for (int tt = 0; tt < 4; ++tt) {
                    f32x4 acc = {bflo(nvv[tt].x), bfhi(nvv[tt].x), bflo(nvv[tt].y), bfhi(nvv[tt].y)};
#pragma unroll
                    for (int s_ = 0; s_ < 2; ++s_)
                        acc = __builtin_amdgcn_mfma_f32_16x16x32_bf16(__builtin_bit_cast(bf16x8, (u32x4){mx[tt][s_][0].x, mx[tt][s_][0].y, mx[tt][s_][1].x, mx[tt][s_][1].y}), __builtin_bit_cast(bf16x8, sb[s_]), acc, 0, 0, 0);
                    st[tt] = acc;
                }
                *(u32x4*)(gS0 + ((cp0 + c) * 4 + wave) * 128 + lane) = sb[0]; *(u32x4*)(gS0 + ((cp0 + c) * 4 + wave) * 128 + 64 + lane) = sb[1];
                if (c + 3 < 68) issue(cp0 + c + 3, (j + 3) & 3);
            }
        }
        asm volatile("s_waitcnt vmcnt(0)" ::: "memory");
        __syncthreads();
    }
}
__device__ __forceinline__ void ph_r3(const Params& p) {
    const int tid = tidx(), lane = tid & 63, wave = tid >> 6, fr = lane & 15, fq = lane >> 4;
    const bf16_t* gGT = (const bf16_t*)(p.ws + O_X + X_GT); const bf16_t* gYL = (const bf16_t*)(p.ws + O_X + X_YL);
    const u32x4* gS0 = (const u32x4*)(p.ws + O_X + X_S0);
    bf16_t* YS = (bf16_t*)(p.ws + O_H);
    for (int it = blockIdx.x * 4 + wave; it < NCP; it += gridDim.x * 4) {
        const int c = it % 68, d = (it / 68) & 1, h = (it / 136) & 7, b = it / 1088;
        const bf16_t* gt = gGT + (size_t)it * 4096; const bf16_t* yl = gYL + (size_t)it * 4096;
        u32x4 gf[4][2];
#pragma unroll
        for (int tt = 0; tt < 4; ++tt)
#pragma unroll
            for (int s_ = 0; s_ < 2; ++s_) {
                const bf16_t* q = gt + (tt * 16 + fr) * 64 + s_ * 32 + fq * 4;
                const uint2 a0 = *(const uint2*)q, a1 = *(const uint2*)(q + 16);
                gf[tt][s_] = (u32x4){a0.x, a0.y, a1.x, a1.y};
            }
#pragma unroll
        for (int vg = 0; vg < 4; ++vg) {
            const u32x4 sb0 = gS0[((size_t)it * 4 + vg) * 128 + lane], sb1 = gS0[((size_t)it * 4 + vg) * 128 + 64 + lane];
#pragma unroll
            for (int tt = 0; tt < 4; ++tt) {
                const uint2 yv = *(const uint2*)(yl + (vg * 16 + fr) * 64 + tt * 16 + fq * 4);
                f32x4 acc = {bflo(yv.x), bfhi(yv.x), bflo(yv.y), bfhi(yv.y)};
                acc = __builtin_amdgcn_mfma_f32_16x16x32_bf16(__builtin_bit_cast(bf16x8, gf[tt][0]), __builtin_bit_cast(bf16x8, sb0), acc, 0, 0, 0);
                acc = __builtin_amdgcn_mfma_f32_16x16x32_bf16(__builtin_bit_cast(bf16x8, gf[tt][1]), __builtin_bit_cast(bf16x8, sb1), acc, 0, 0, 0);
#pragma unroll
                for (int r = 0; r < 4; ++r) {
                    const int row = scan_row(b, d, c * 64 + tt * 16 + fq * 4 + r);
                    YS[((size_t)d * RT + row) * 512 + h * 64 + vg * 16 + fr] = f2bf(acc[r]);
                }
            }
        }
    }
}

__device__ __forceinline__ void ph_rpost(const Params& p, int l) {
    const int lane = tidx() & 63, wave = tidx() >> 6;
    const bf16_t* P = (const bf16_t*)(p.ws + O_P); const float* mu = p.in[I_MU] + l * 1792;
    const float* gng = p.in[I_GNG] + l * 512; const float* gnb = p.in[I_GNB] + l * 512;
    const float* BON = (const float*)(p.ws + O_X + X_BON); const bf16_t* YS = (const bf16_t*)(p.ws + O_H);
    const bf16_t* RG = (const bf16_t*)(p.ws + O_RG); bf16_t* RWO = (bf16_t*)(p.ws + O_RWO);
    for (int row = blockIdx.x * 4 + wave; row < RT; row += gridDim.x * 4) {
        const int col = lane * 8, h = lane >> 3;
        float v8[8], g8[8], y0[8], y1[8];
        xs8(P, mu, row, 1024 + col, v8);
        unpack8(*(const uint4*)(RG + (size_t)row * 512 + col), g8);
        unpack8(*(const uint4*)(YS + ((size_t)0 * RT + row) * 512 + col), y0);
        unpack8(*(const uint4*)(YS + ((size_t)1 * RT + row) * 512 + col), y1);
        const float bs = BON[((size_t)0 * RT + row) * 8 + h] + BON[((size_t)1 * RT + row) * 8 + h];
        float y[8]; float sm = 0.f;
#pragma unroll
        for (int j = 0; j < 8; ++j) { y[j] = y0[j] + y1[j]; sm += y[j]; }
        sm += __shfl_xor(sm, 1); sm += __shfl_xor(sm, 2); sm += __shfl_xor(sm, 4);
        const float mean = sm * (1.f / 64.f);
        float vs = 0.f;
#pragma unroll
        for (int j = 0; j < 8; ++j) { const float dlt = y[j] - mean; vs += dlt * dlt; }
        vs += __shfl_xor(vs, 1); vs += __shfl_xor(vs, 2); vs += __shfl_xor(vs, 4);
        const float rstd = rsqrtf(vs * (1.f / 64.f) + 64e-5f);
        float o[8];
#pragma unroll
        for (int j = 0; j < 8; ++j) o[j] = ((y[j] - mean) * rstd * gng[col + j] + gnb[col + j] + bs * v8[j]) * g8[j];
        *(uint4*)(RWO + (size_t)row * 512 + col) = pack8(o);
    }
}

__device__ __forceinline__ void ph_f1(const Params& p, int l, char* smem) {
    const bf16_t* P = (const bf16_t*)(p.ws + O_P); const bf16_t* CSC = (const bf16_t*)(p.ws + O_CSC);
    bf16_t* YT2 = (bf16_t*)(p.ws + O_YT2); bf16_t* YTC = (bf16_t*)(p.ws + O_YTC);
    const int nitems = 1024 + (l < NLAYER - 1 ? 64 : 0);
    for (int it = blockIdx.x; it < nitems; it += gridDim.x) {
        f32x4 acc[4][4];
        if (it < 1024) {
            const int b = it >> 8, g = (it >> 6) & 3, part = (it >> 5) & 1, j = it & 31;
            RPPlain rpa{CSC + (size_t)part * 128 * 128, 128};
            const bf16_t* pb = P + (size_t)b * SEQ * LDP + g * 128;
            auto rpb = [&](int r) -> const bf16_t* { return pb + (size_t)(64 * (r & 63) + 2 * j + (r >> 6)) * LDP; };
            gemm_core_gb<4>(rpa, rpb, 128, acc, smem);
            acc_foreach<4>(acc, [&](int m, int n, const f32x4& v) {
                const int t1 = n & 63, t2 = 2 * j + (n >> 6);
                store_bf16x4(YT2 + ((size_t)(b * 512 + g * 128 + m) * 64 + t2) * 128 + part * 64 + t1, v);
            });
        } else {
            const int jj = it - 1024, b = jj >> 4, g = (jj >> 2) & 3, part = (jj >> 1) & 1, nt = jj & 1;
            RPPlain rpa{CSC + (size_t)part * 128 * 128, 128};
            gemm_core_g<4>(rpa, P + (size_t)(RL + b * CTX + nt * 128) * LDP + g * 128, LDP, 128, acc, smem);
            acc_foreach<4>(acc, [&](int m, int n, const f32x4& v) {
                store_bf16x4(YTC + ((size_t)(b * 512 + g * 128 + m)) * 512 + part * 256 + nt * 128 + n, v);
            });
        }
    }
}
__device__ __forceinline__ void ph_fa(const Params& p, char* smem) {
    const bf16_t* YT2 = (const bf16_t*)(p.ws + O_YT2); const bf16_t* D128 = (const bf16_t*)(p.ws + O_D128);
    const float* TWC = (const float*)(p.ws + O_TWC); const float* TWS = (const float*)(p.ws + O_TWS);
    bf16_t* A2 = (bf16_t*)(p.ws + O_A2);
    for (int it = blockIdx.x; it < 1024; it += gridDim.x) {
        f32x4 acc[4][4];
        RPPlain rpa{D128, 128};
        gemm_core_g<4>(rpa, YT2 + (size_t)it * 128 * 128, 128, 128, acc, smem);
        const int lane = tidx() & 63, wave = tidx() >> 6, wr = wave >> 1, wc = wave & 1, fr = lane & 15, fq = lane >> 4;
        float* U = (float*)smem;
        if (wr == 1) {
#pragma unroll
            for (int i = 0; i < 4; ++i)
#pragma unroll
                for (int j = 0; j < 4; ++j) *(f32x4*)(U + (i * 16 + fr) * 132 + wc * 64 + j * 16 + fq * 4) = acc[i][j];
        }
        __syncthreads();
        if (wr == 0) {
#pragma unroll
            for (int i = 0; i < 4; ++i) {
                const int k1 = i * 16 + fr;
#pragma unroll
                for (int j = 0; j < 4; ++j) {
                    const int r = wc * 64 + j * 16 + fq * 4;
                    const int R = it * 128 + r, bn = R >> 6, t2 = R & 63, b = bn >> 9, n = bn & 511;
                    const f32x4 ai = *(const f32x4*)(U + k1 * 132 + r);
                    const f32x4 c = *(const f32x4*)(TWC + k1 * 64 + t2), sn = *(const f32x4*)(TWS + k1 * 64 + t2);
                    const f32x4 ar = acc[i][j];
                    const f32x4 pr = ar * c - ai * sn, pi = ar * sn + ai * c;
                    bf16_t* dst = A2 + ((size_t)(b * 64 + k1) * 512 + n) * 128 + t2;
                    store_bf16x4(dst, pr); store_bf16x4(dst + 64, pi);
                }
            }
        }
        __syncthreads();
    }
}
__device__ __forceinline__ void ph_fb(const Params& p, int l, char* smem) {
    const bf16_t* A2 = (const bf16_t*)(p.ws + O_A2); const bf16_t* E64 = (const bf16_t*)(p.ws + O_E64);
    const bf16_t* CST2 = (const bf16_t*)(p.ws + O_CST256); const bf16_t* YTC = (const bf16_t*)(p.ws + O_YTC);
    bf16_t* FA = (bf16_t*)(p.ws + O_FA);
    const int nitems = 1024 + (l < NLAYER - 1 ? 32 : 0);
    for (int it = blockIdx.x; it < nitems; it += gridDim.x) {
        if (it < 1024) {
            const int b = it >> 8, k1 = (it >> 2) & 63, nt = it & 3;
            f32x4 acc[2][4];
            RPPlain rpa{E64, 128};
            gemm_core_g<2>(rpa, A2 + ((size_t)(b * 64 + k1) * 512 + nt * 128) * 128, 128, 128, acc, smem);
            const float sc = 0.001381067932004975f;
            acc_foreach<2>(acc, [&](int m, int n, const f32x4& v) { f32x4 o = v * sc; store_bf16x4(FA + (size_t)(b * SEQ + k1 + 64 * m) * 512 + nt * 128 + n, o); });
        } else {
            const int j = it - 1024, b = j >> 3, mt = (j >> 2) & 1, nt = j & 3;
            f32x4 acc[4][4];
            RPPlain rp{CST2 + (size_t)mt * 128 * 512, 512};
            gemm_core_g<4>(rp, YTC + ((size_t)b * 512 + nt * 128) * 512, 512, 512, acc, smem);
            const float sc = 0.005524271728019903f;
            acc_foreach<4>(acc, [&](int m, int n, const f32x4& v) { f32x4 o = v * sc; store_bf16x4(FA + (size_t)(RL + b * CTX + mt * 128 + m) * 512 + nt * 128 + n, o); });
        }
    }
}

__device__ __forceinline__ void ph_mg(const Params& p, int l, char* smem) {
    const bf16_t* P = (const bf16_t*)(p.ws + O_P);
    const bf16_t* A0 = (const bf16_t*)(p.ws + O_FA); const bf16_t* A1 = (const bf16_t*)(p.ws + O_ATT); const bf16_t* A2 = (const bf16_t*)(p.ws + O_RWO);
    const bf16_t* W0 = (const bf16_t*)(p.ws + O_WB + W_PA); const bf16_t* W1 = (const bf16_t*)(p.ws + O_WB + W_PB); const bf16_t* W2 = (const bf16_t*)(p.ws + O_WB + W_PC);
    bf16_t* MG = (bf16_t*)(p.ws + O_H);
    const int nmt = (l < NLAYER - 1) ? RT / 64 : RL / 64;
    for (int it = blockIdx.x; it < nmt * 8; it += gridDim.x) {
        const int mt = it >> 3, nt = it & 7;
        f32x4 tot[2][4];
#pragma unroll
        for (int i = 0; i < 2; ++i)
#pragma unroll
            for (int j = 0; j < 4; ++j) tot[i][j] = (f32x4){0.f, 0.f, 0.f, 0.f};
#pragma unroll 1
        for (int br = 0; br < 3; ++br) {
            const bf16_t* Ab = br == 0 ? A0 : (br == 1 ? A1 : A2);
            const bf16_t* Wb = br == 0 ? W0 : (br == 1 ? W1 : W2);
            f32x4 acc[2][4];
            RPPlain rp{Ab + (size_t)mt * 64 * 512, 512};
            gemm_core_g<2>(rp, Wb + (size_t)nt * 128 * 512, 512, 512, acc, smem);
            const int lane = tidx() & 63, wave = tidx() >> 6, wr = wave >> 1, wc = wave & 1, fr = lane & 15, fq = lane >> 4;
#pragma unroll
            for (int i = 0; i < 2; ++i)
#pragma unroll
                for (int j = 0; j < 4; ++j) {
                    const int m = wr * 32 + i * 16 + fr, n = wc * 64 + j * 16 + fq * 4;
                    const uint2 gu = *(const uint2*)(P + (size_t)(mt * 64 + m) * LDP + PG0 + br * 1024 + nt * 128 + n);
                    tot[i][j][0] += bflo(gu.x) * acc[i][j][0]; tot[i][j][1] += bfhi(gu.x) * acc[i][j][1];
                    tot[i][j][2] += bflo(gu.y) * acc[i][j][2]; tot[i][j][3] += bfhi(gu.y) * acc[i][j][3];
                }
        }
        acc_foreach<2>(tot, [&](int m, int n, const f32x4& v) { store_bf16x4(MG + (size_t)(mt * 64 + m) * 1024 + nt * 128 + n, v); });
    }
}
__device__ __forceinline__ void ph_out(const Params& p, int l, char* smem) {
    const bf16_t* MG = (const bf16_t*)(p.ws + O_H); const bf16_t* W = (const bf16_t*)(p.ws + O_WB + W_OUT);
    float* xcur = (float*)(p.ws + O_XCUR); const float* mod = (const float*)(p.ws + O_MOD);
    const int nmt = (l < NLAYER - 1) ? RT / 64 : RL / 64;
    for (int it = blockIdx.x; it < nmt * 8; it += gridDim.x) {
        const int mt = it >> 3, nt = it & 7;
        f32x4 acc[2][4];
        RPPlain rp{MG + (size_t)mt * 64 * 1024, 1024};
        gemm_core_g<2>(rp, W + (size_t)nt * 128 * 1024, 1024, 1024, acc, smem);
        acc_foreach<2>(acc, [&](int m, int n, const f32x4& v) {
            const int row = mt * 64 + m, col = nt * 128 + n;
            const float4 g = *(const float4*)(mod + (size_t)(l * 5 + modidx(row)) * 6144 + 2048 + col);
            float4* xp = (float4*)(xcur + (size_t)row * 1024 + col);
            float4 x = *xp; x.x += g.x * v[0]; x.y += g.y * v[1]; x.z += g.z * v[2]; x.w += g.w * v[3]; *xp = x;
        });
    }
}

__device__ __forceinline__ void ph_n2(const Params& p, int l, char* smem) {
    const int tid = tidx(), lane = tid & 63, wave = tid >> 6;
    unsigned* lcnt = (unsigned*)smem;
    unsigned* gbase = lcnt + 16;
    int* rec = (int*)(smem + 256);
    float4* rwl = (float4*)(smem + 8192);
    for (int idx = tid; idx < 4096; idx += 256) {
        const int k = idx >> 2, pp = idx & 3;
        rwl[(((k >> 8) * 16 + (k & 3) * 4 + pp) << 6) + ((k & 255) >> 2)] = *(const float4*)(p.in[I_RW] + (size_t)k * 16 + pp * 4);
    }
    if (tid < 16) lcnt[tid] = 0u;
    __syncthreads();
    int nrec = 0;
    const float* xcur = (const float*)(p.ws + O_XCUR); const float* mod = (const float*)(p.ws + O_MOD);
    bf16_t* H = (bf16_t*)(p.ws + O_H);
    unsigned* cnt = (unsigned*)(p.ws + O_CNT); int* LTOK = (int*)(p.ws + O_LTOK); float* LW = (float*)(p.ws + O_LW); int* SLOT = (int*)(p.ws + O_SLOT);
    const float* g = p.in[I_N2G] + l * 1024; const float* rw = p.in[I_RW]; const float* rb = p.in[I_RB];
    const int nrows = (l < NLAYER - 1) ? RT : RL;
    float4 vn[4];
    {
        const int r0 = blockIdx.x * 4 + wave;
        const float* x0 = xcur + (size_t)(r0 < nrows ? r0 : 0) * 1024;
#pragma unroll
        for (int i = 0; i < 4; ++i) vn[i] = *(const float4*)(x0 + lane * 4 + 256 * i);
    }
    for (int row = blockIdx.x * 4 + wave; row < nrows; row += gridDim.x * 4) {
        const float* md = mod + (size_t)(l * 5 + modidx(row)) * 6144;
        float4 v[4]; float ss = 0.f;
#pragma unroll
        for (int i = 0; i < 4; ++i) { v[i] = vn[i]; ss += v[i].x * v[i].x + v[i].y * v[i].y + v[i].z * v[i].z + v[i].w * v[i].w; }
        {
            const int rn = row + gridDim.x * 4;
            const float* xn = xcur + (size_t)(rn < nrows ? rn : row) * 1024;
#pragma unroll
            for (int i = 0; i < 4; ++i) vn[i] = *(const float4*)(xn + lane * 4 + 256 * i);
        }
        ss = wsum(ss);
        const float rstd = rsqrtf(ss * (1.f / 1024.f) + 1e-6f);
        float lg[16];
#pragma unroll
        for (int e = 0; e < 16; ++e) lg[e] = 0.f;
#pragma unroll
        for (int i = 0; i < 4; ++i) {
            const int c = lane * 4 + 256 * i;
            const float4 gg = *(const float4*)(g + c), sc = *(const float4*)(md + 4096 + c), sh = *(const float4*)(md + 3072 + c);
            const float hv[4] = {v[i].x * rstd * gg.x * (1.f + sc.x) + sh.x, v[i].y * rstd * gg.y * (1.f + sc.y) + sh.y,
                                 v[i].z * rstd * gg.z * (1.f + sc.z) + sh.z, v[i].w * rstd * gg.w * (1.f + sc.w) + sh.w};
            f32x4 h4 = {hv[0], hv[1], hv[2], hv[3]};
            store_bf16x4(H + (size_t)row * 1024 + c, h4);
#pragma unroll
            for (int j = 0; j < 4; ++j) {
                const float4* wr_ = rwl + ((i * 16 + j * 4) << 6) + lane;
                const float4 w0 = wr_[0], w1 = wr_[64], w2 = wr_[128], w3 = wr_[192];
                lg[0] += hv[j] * w0.x; lg[1] += hv[j] * w0.y; lg[2] += hv[j] * w0.z; lg[3] += hv[j] * w0.w;
                lg[4] += hv[j] * w1.x; lg[5] += hv[j] * w1.y; lg[6] += hv[j] * w1.z; lg[7] += hv[j] * w1.w;
                lg[8] += hv[j] * w2.x; lg[9] += hv[j] * w2.y; lg[10] += hv[j] * w2.z; lg[11] += hv[j] * w2.w;
                lg[12] += hv[j] * w3.x; lg[13] += hv[j] * w3.y; lg[14] += hv[j] * w3.z; lg[15] += hv[j] * w3.w;
            }
        }
        float sc_[16], sel[16];
#pragma unroll
        for (int e = 0; e < 16; ++e) { lg[e] = wsum(lg[e]); sc_[e] = 1.f / (1.f + expf(-lg[e])); sel[e] = sc_[e] + rb[e]; }
        int best = 0; float bestv = -1e30f;
#pragma unroll
        for (int gi = 0; gi < 4; ++gi) {
            float m1 = -1e30f, m2 = -1e30f;
#pragma unroll
            for (int j = 0; j < 4; ++j) { const float s = sel[gi * 4 + j]; if (s > m1) { m2 = m1; m1 = s; } else if (s > m2) m2 = s; }
            const float gs = m1 + m2;
            if (gs > bestv) { bestv = gs; best = gi; }
        }
        float s4[4] = {0.f, 0.f, 0.f, 0.f}, c4[4] = {0.f, 0.f, 0.f, 0.f};
#pragma unroll
        for (int gi = 0; gi < 4; ++gi)
#pragma unroll
            for (int j = 0; j < 4; ++j) if (gi == best) { s4[j] = sel[gi * 4 + j]; c4[j] = sc_[gi * 4 + j]; }
        int i1 = 0; float v1 = s4[0], w1 = c4[0];
#pragma unroll
        for (int j = 1; j < 4; ++j) if (s4[j] > v1) { v1 = s4[j]; i1 = j; w1 = c4[j]; }
        int i2 = -1; float v2 = -1e30f, w2 = 0.f;
#pragma unroll
        for (int j = 0; j < 4; ++j) if (j != i1 && s4[j] > v2) { v2 = s4[j]; i2 = j; w2 = c4[j]; }
        if (lane == 0) {
            const float inv = 1.f / (w1 + w2);
            const int e1 = best * 4 + i1, e2 = best * 4 + i2;
            const unsigned r1 = atomicAdd(&lcnt[e1], 1u), r2 = atomicAdd(&lcnt[e2], 1u);
            int* rc = rec + (wave * 32 + nrec) * 8;
            rc[0] = row; rc[1] = e1; rc[2] = e2; rc[3] = (int)r1; rc[4] = (int)r2; rc[5] = __float_as_int(w1 * inv); rc[6] = __float_as_int(w2 * inv);
        }
        ++nrec;
    }
    __syncthreads();
    if (tid < 16) gbase[tid] = lcnt[tid] ? atomicAdd(&cnt[tid], lcnt[tid]) : 0u;
    __syncthreads();
    for (int i = lane; i < nrec; i += 64) {
        const int* rc = rec + (wave * 32 + i) * 8;
        const int row = rc[0], e1 = rc[1], e2 = rc[2];
        const unsigned p1 = gbase[e1] + (unsigned)rc[3], p2 = gbase[e2] + (unsigned)rc[4];
        LTOK[(size_t)e1 * RT + p1] = row; LW[(size_t)e1 * RT + p1] = __int_as_float(rc[5]);
        LTOK[(size_t)e2 * RT + p2] = row; LW[(size_t)e2 * RT + p2] = __int_as_float(rc[6]);
        SLOT[row * 2] = (e1 << 20) | (int)p1; SLOT[row * 2 + 1] = (e2 << 20) | (int)p2;
    }
}

struct MoeTiles { int tb[17]; int sm; };
__device__ __forceinline__ void moe_tiles(const Params& p, int l, int* s_tb) {
    if (tidx() == 0) {
        const unsigned* cnt = (const unsigned*)(p.ws + O_CNT);
        int a = 0;
        for (int e = 0; e < 16; ++e) { s_tb[e] = a; a += ((int)cnt[e] + 127) >> 7; }
        s_tb[16] = a;
    }
    __syncthreads();
}
__device__ __forceinline__ void ph_e1(const Params& p, int l, char* smem) {
    int* s_tb = (int*)(smem + 73728);
    moe_tiles(p, l, s_tb);
    const bf16_t* H = (const bf16_t*)(p.ws + O_H); bf16_t* ACT = (bf16_t*)(p.ws + O_P);
    const unsigned* cnt = (const unsigned*)(p.ws + O_CNT); const int* LTOK = (const int*)(p.ws + O_LTOK); const float* LW = (const float*)(p.ws + O_LW);
    const int sm = (l < NLAYER - 1) ? RT / 128 : RL / 128;
    const int total = (sm + s_tb[16]) * 8;
    for (int it = blockIdx.x; it < total; it += gridDim.x) {
        const int mt = it >> 3, nt = it & 7;
        int e = 16, erow0 = mt * 128, lt = 0;
        if (mt >= sm) { const int q = mt - sm; e = 0; while (q >= s_tb[e + 1]) ++e; lt = q - s_tb[e]; erow0 = RT + q * 128; }
        const int cnte = (e == 16) ? 0 : (int)cnt[e];
        auto rp = [&](int r) -> const bf16_t* {
            if (e == 16) return H + (size_t)(mt * 128 + r) * 1024;
            const int idx = lt * 128 + r;
            const int tok = idx < cnte ? LTOK[(size_t)e * RT + idx] : 0;
            return H + (size_t)tok * 1024;
        };
        f32x4 acc[4][4];
        gemm_core_g<4>(rp, (const bf16_t*)(p.ws + O_WB + W_GU) + (size_t)e * 1024 * 1024 + (size_t)nt * 128 * 1024, 1024, 1024, acc, smem);
        {
            const int lane = tidx() & 63, wave = tidx() >> 6, wr = wave >> 1, wc = wave & 1, fr = lane & 15, fq = lane >> 4;
            float* U = (float*)smem;
            if (wc == 1) {
#pragma unroll
                for (int i = 0; i < 4; ++i)
#pragma unroll
                    for (int j = 0; j < 4; ++j) *(f32x4*)(U + (wr * 64 + i * 16 + fr) * 68 + j * 16 + fq * 4) = acc[i][j];
            }
            __syncthreads();
            if (wc == 0) {
#pragma unroll
                for (int i = 0; i < 4; ++i) {
                    const int m = wr * 64 + i * 16 + fr;
                    float wgt = 1.f;
                    if (e != 16) { const int idx = lt * 128 + m; wgt = idx < cnte ? LW[(size_t)e * RT + idx] : 0.f; }
#pragma unroll
                    for (int j = 0; j < 4; ++j) {
                        const f32x4 u = *(const f32x4*)(U + m * 68 + j * 16 + fq * 4);
                        f32x4 o;
#pragma unroll
                        for (int r = 0; r < 4; ++r) o[r] = siluf_(acc[i][j][r]) * u[r] * wgt;
                        store_bf16x4(ACT + (size_t)(erow0 + m) * 512 + nt * 64 + j * 16 + fq * 4, o);
                    }
                }
            }
            __syncthreads();
        }
    }
}
__device__ __forceinline__ void ph_e2(const Params& p, int l, char* smem) {
    int* s_tb = (int*)(smem + 73728);
    moe_tiles(p, l, s_tb);
    const bf16_t* ACT = (const bf16_t*)(p.ws + O_P); bf16_t* YE = (bf16_t*)(p.ws + O_X + X_YE);
    const int sm = (l < NLAYER - 1) ? RT / 128 : RL / 128;
    const int total = (sm + s_tb[16]) * 8;
    for (int it = blockIdx.x; it < total; it += gridDim.x) {
        const int mt = it >> 3, nt = it & 7;
        int e = 16, erow0 = mt * 128;
        if (mt >= sm) { const int q = mt - sm; e = 0; while (q >= s_tb[e + 1]) ++e; erow0 = RT + q * 128; }
        RPPlain rp{ACT + (size_t)erow0 * 512, 512};
        f32x4 acc[4][4];
        gemm_core_g<4>(rp, (const bf16_t*)(p.ws + O_WB + W_D) + (size_t)e * 1024 * 512 + (size_t)nt * 128 * 512, 512, 512, acc, smem);
        acc_foreach<4>(acc, [&](int m, int n, const f32x4& v) { store_bf16x4(YE + (size_t)(erow0 + m) * 1024 + nt * 128 + n, v); });
    }
}
__device__ __forceinline__ void ph_e3(const Params& p, int l, char* smem) {
    int* s_tb = (int*)(smem + 73728);
    moe_tiles(p, l, s_tb);
    const int lane = tidx() & 63, wave = tidx() >> 6;
    const bf16_t* YE = (const bf16_t*)(p.ws + O_X + X_YE); const int* SLOT = (const int*)(p.ws + O_SLOT);
    float* xcur = (float*)(p.ws + O_XCUR); const float* mod = (const float*)(p.ws + O_MOD);
    bf16_t* H = (bf16_t*)(p.ws + O_H);
    const bool last = l == NLAYER - 1;
    const int nrows = last ? RL : RT;
    const float* gn = last ? p.in[I_FNG] : p.in[I_N1G] + (l + 1) * 1024;
    for (int row = blockIdx.x * 4 + wave; row < nrows; row += gridDim.x * 4) {
        const int s1 = SLOT[row * 2], s2 = SLOT[row * 2 + 1];
        const size_t r0 = row, r1 = (size_t)RT + s_tb[s1 >> 20] * 128 + (s1 & 0xfffff), r2 = (size_t)RT + s_tb[s2 >> 20] * 128 + (s2 & 0xfffff);
        const float* g2 = mod + (size_t)(l * 5 + modidx(row)) * 6144 + 5120;
        float xv[2][8]; float ss = 0.f;
#pragma unroll
        for (int i = 0; i < 2; ++i) {
            const int c = lane * 8 + 512 * i;
            float a[8], b[8], d[8];
            unpack8(*(const uint4*)(YE + r0 * 1024 + c), a); unpack8(*(const uint4*)(YE + r1 * 1024 + c), b); unpack8(*(const uint4*)(YE + r2 * 1024 + c), d);
            float4* xp = (float4*)(xcur + (size_t)row * 1024 + c);
            const float4 x0 = xp[0], x1 = xp[1];
            const float4 ga = *(const float4*)(g2 + c), gb = *(const float4*)(g2 + c + 4);
            const float xo[8] = {x0.x, x0.y, x0.z, x0.w, x1.x, x1.y, x1.z, x1.w}, gg[8] = {ga.x, ga.y, ga.z, ga.w, gb.x, gb.y, gb.z, gb.w};
#pragma unroll
            for (int e = 0; e < 8; ++e) { xv[i][e] = xo[e] + gg[e] * (a[e] + b[e] + d[e]); ss += xv[i][e] * xv[i][e]; }
            if (!last) { xp[0] = make_float4(xv[i][0], xv[i][1], xv[i][2], xv[i][3]); xp[1] = make_float4(xv[i][4], xv[i][5], xv[i][6], xv[i][7]); }
        }
        ss = wsum(ss);
        const float rstd = rsqrtf(ss * (1.f / 1024.f) + 1e-6f);
        const float* md = mod + (size_t)((l + 1) * 5 + modidx(row)) * 6144;
#pragma unroll
        for (int i = 0; i < 2; ++i) {
            const int c = lane * 8 + 512 * i;
            const float4 n0 = *(const float4*)(gn + c), n1 = *(const float4*)(gn + c + 4);
            const float nn[8] = {n0.x, n0.y, n0.z, n0.w, n1.x, n1.y, n1.z, n1.w};
            if (last) {
                float* op = p.out + (size_t)row * 1024 + c;
                *(float4*)op = make_float4(xv[i][0] * rstd * nn[0], xv[i][1] * rstd * nn[1], xv[i][2] * rstd * nn[2], xv[i][3] * rstd * nn[3]);
                *(float4*)(op + 4) = make_float4(xv[i][4] * rstd * nn[4], xv[i][5] * rstd * nn[5], xv[i][6] * rstd * nn[6], xv[i][7] * rstd * nn[7]);
            } else {
                const float4 c0 = *(const float4*)(md + 1024 + c), c1 = *(const float4*)(md + 1024 + c + 4), h0 = *(const float4*)(md + c), h1 = *(const float4*)(md + c + 4);
                const float sc[8] = {c0.x, c0.y, c0.z, c0.w, c1.x, c1.y, c1.z, c1.w}, sh[8] = {h0.x, h0.y, h0.z, h0.w, h1.x, h1.y, h1.z, h1.w};
                float o[8];
#pragma unroll
                for (int e = 0; e < 8; ++e) o[e] = xv[i][e] * rstd * nn[e] * (1.f + sc[e]) + sh[e];
                *(uint4*)(H + (size_t)row * 1024 + c) = pack8(o);
            }
        }
    }
}
constexpr int LDS_BYTES = 76800;
constexpr int NIV = 19;
extern __shared__ __attribute__((aligned(16))) char dynsmem[];
template <int ID> __device__ __forceinline__ void run_iv(const Params& pin, int l, char* smem) {
    Params p = pin; p.ws = launder(pin.ws);
    if constexpr (ID == 0) { ph_pre(p, smem); __syncthreads(); ph_w(p, 0, smem); }
    else if constexpr (ID == 1) ph_n1(p, l);
    else if constexpr (ID == 2) ph_g1(p, smem);
    else if constexpr (ID == 3) { ph_qu(p, smem); ph_rp1(p, l, smem); ph_rp2(p, l); ph_f1(p, l, smem); }
    else if constexpr (ID == 4) ph_m2(p, smem);
    else if constexpr (ID == 5) {
        const bool r1first = (blockIdx.x >> 8) & 1;
#pragma unroll 1
        for (int pass = 0; pass < 2; ++pass) {
            if ((pass == 0) == r1first) { ph_r1(p, l, smem); ph_fa(p, smem); } else ph_at(p, l, smem);
            __syncthreads();
        }
    }
    else if constexpr (ID == 8) { ph_r2(p, smem); __syncthreads(); ph_fb(p, l, smem); }
    else if constexpr (ID == 9) ph_r3(p);
    else if constexpr (ID == 10) ph_rpost(p, l);
    else if constexpr (ID == 12) ph_mg(p, l, smem);
    else if constexpr (ID == 13) ph_out(p, l, smem);
    else if constexpr (ID == 14) ph_n2(p, l, smem);
    else if constexpr (ID == 15) ph_e1(p, l, smem);
    else if constexpr (ID == 16) ph_e2(p, l, smem);
    else if constexpr (ID == 17) { ph_e3(p, l, smem); __syncthreads(); if (l + 1 < NLAYER) ph_w(p, l + 1, smem); }
}
#if MEGA
#ifndef PROBE_MASK
#define PROBE_MASK 0
#define PROBE_REP 1
#endif
#define IV(ID) for (int r_ = 0; r_ < (((PROBE_MASK >> (ID)) & 1) ? PROBE_REP : 1); ++r_) { run_iv<ID>(p, l, smem); xcd_barrier(bar); }
__global__ void __launch_bounds__(256, 2) k_mega(Params p) {
    char* smem = dynsmem;
    volatile LAS unsigned* st = (volatile LAS unsigned*)(smem + LDS_BYTES - 16);
    if (tidx() == 0) { st[0] = 0u; st[1] = 0u; }
    __syncthreads();
    XcdBarrier bar = xcd_barrier_post((unsigned*)(p.ws + O_BAR), st);
    { const int l = 0; IV(0) }
    for (int l = 0; l < NLAYER; ++l) {
        if (l == 0) { IV(1) } IV(2) IV(3) IV(4) IV(5) IV(8) IV(9) IV(10) IV(12) IV(13) IV(14) IV(15) IV(16) IV(17)
    }
}
#else
template <int ID> __global__ void __launch_bounds__(256, 2) k_iv(Params p, int l) { run_iv<ID>(p, l, dynsmem); }
template <int ID> static void launch_iv(const Params& p, int l, int grid, hipStream_t s) {
    static bool once = false; if (!once) { once = true; (void)hipFuncSetAttribute((const void*)k_iv<ID>, hipFuncAttributeMaxDynamicSharedMemorySize, LDS_BYTES); }
    hipLaunchKernelGGL(k_iv<ID>, dim3(grid), dim3(256), LDS_BYTES, s, p, l);
}
#endif

extern "C" void kernel_launch(void* const* d_in, const int* in_sizes, int n_in, void* d_out, int out_size, void* d_ws, size_t ws_size, hipStream_t stream) {
    (void)in_sizes; (void)out_size;
    if (n_in < N_IN || ws_size < WS_NEED) return;
    Params p{};
    for (int i = 0; i < N_IN; ++i) p.in[i] = (const float*)d_in[i];
    p.out = (float*)d_out; p.ws = (char*)d_ws;
    static int grid = 0;
    if (!grid) {
        int dev = 0, cus = 0; (void)hipGetDevice(&dev); (void)hipDeviceGetAttribute(&cus, hipDeviceAttributeMultiprocessorCount, dev);
        int per_cu = 2;
#if MEGA
        (void)hipFuncSetAttribute((const void*)k_mega, hipFuncAttributeMaxDynamicSharedMemorySize, LDS_BYTES);
        int occ = 0; (void)hipOccupancyMaxActiveBlocksPerMultiprocessor(&occ, k_mega, 256, LDS_BYTES);
        if (occ < per_cu) per_cu = occ;
        if (per_cu < 1) per_cu = 1;
#endif
        grid = cus * per_cu;
    }
#if MEGA
    (void)hipMemsetAsync(p.ws + O_BAR, 0, 16384, stream);
    hipLaunchKernelGGL(k_mega, dim3(grid), dim3(256), LDS_BYTES, stream, p);
#else
    launch_iv<0>(p, 0, grid, stream);
    for (int l = 0; l < NLAYER; ++l) {
        if (l == 0) launch_iv<1>(p, l, grid, stream); launch_iv<2>(p, l, grid, stream); launch_iv<3>(p, l, grid, stream); launch_iv<4>(p, l, grid, stream);
        launch_iv<5>(p, l, grid, stream); launch_iv<8>(p, l, grid, stream);
        launch_iv<9>(p, l, grid, stream); launch_iv<10>(p, l, grid, stream); launch_iv<12>(p, l, grid, stream);
        launch_iv<13>(p, l, grid, stream); launch_iv<14>(p, l, grid, stream); launch_iv<15>(p, l, grid, stream); launch_iv<16>(p, l, grid, stream); launch_iv<17>(p, l, grid, stream);
    }
#endif
}
```

```cpp
#include <hip/hip_runtime.h>
#include <stdint.h>

#ifndef MEGA
#define MEGA 1
#endif

typedef unsigned short bf16_t;
typedef short bf16x8 __attribute__((ext_vector_type(8)));
typedef float f32x4 __attribute__((ext_vector_type(4)));
typedef float f32x2 __attribute__((ext_vector_type(2)));
typedef unsigned u32x4 __attribute__((ext_vector_type(4)));
typedef __bf16 bf16v2 __attribute__((ext_vector_type(2)));

constexpr int NLAYER = 4;
constexpr int DM = 1024;
constexpr int RL = 16384, RC = 1024, RT = RL + RC;
constexpr int SEQ = 4096, CTX = 256, KEYS = SEQ + CTX;
constexpr int LDP = 6144;
constexpr int PQ0 = 512, PKV0 = 896, PKR0 = 1152, PR0 = 1184, PG0 = 2976, PEND = 6048;
constexpr int NEXP = 16;
constexpr int EROWS = 54272;

enum { I_X = 0, I_C, I_CTX, I_CCTX, I_WADA, I_BADA, I_N1G, I_N2G, I_WIN, I_QNG, I_KVNG, I_WUQ, I_WUKV, I_MU, I_W0, I_WUP, I_A0, I_AUP, I_GUP,
       I_KK, I_KA, I_RK, I_GNG, I_GNB, I_WPA, I_WPB, I_WPC, I_WOUT, I_RW, I_RB, I_EG, I_EU, I_ED, I_SG, I_SU, I_SD, I_FNG, N_IN };

struct Params { const float* in[N_IN]; float* out; char* ws; };

constexpr size_t al256(size_t x) { return (x + 255) & ~(size_t)255; }
constexpr size_t O_BAR   = 0;
constexpr size_t O_CNT   = O_BAR + 16384;
constexpr size_t O_MOD   = O_CNT + 4096;
constexpr size_t O_ROPEC = O_MOD + (size_t)NLAYER * 5 * 6144 * 4;
constexpr size_t O_ROPES = O_ROPEC + (size_t)SEQ * 16 * 4;
constexpr size_t O_CSC   = O_ROPES + (size_t)SEQ * 16 * 4;
constexpr size_t O_CST256= O_CSC + 256 * 128 * 2;
constexpr size_t O_D128  = O_CST256 + 256 * 512 * 2;
constexpr size_t O_E64   = O_D128 + 128 * 128 * 2;
constexpr size_t O_TWC   = O_E64 + 64 * 128 * 2;
constexpr size_t O_TWS   = O_TWC + 64 * 64 * 4;
constexpr size_t O_YT2   = O_TWS + 64 * 64 * 4;
constexpr size_t O_A2    = O_YT2 + (size_t)4 * 512 * 64 * 128 * 2;
constexpr size_t O_YTC   = O_A2 + (size_t)4 * 512 * 64 * 128 * 2;
constexpr size_t O_XCUR  = O_YTC + (size_t)4 * 512 * 512 * 2;
constexpr size_t O_WB    = O_XCUR + (size_t)RT * DM * 4;
constexpr size_t W_IN   = 0;
constexpr size_t W_UQ   = W_IN + (size_t)6144 * 1024 * 2;
constexpr size_t W_UKV  = W_UQ + (size_t)768 * 384 * 2;
constexpr size_t W_WUP  = W_UKV + (size_t)1024 * 256 * 2;
constexpr size_t W_AUP  = W_WUP + (size_t)2 * 512 * 64 * 2;
constexpr size_t W_GUP  = W_AUP + (size_t)2 * 512 * 64 * 2;
constexpr size_t W_PA   = W_GUP + (size_t)512 * 128 * 2;
constexpr size_t W_PB   = W_PA + (size_t)1024 * 512 * 2;
constexpr size_t W_PC   = W_PB + (size_t)1024 * 512 * 2;
constexpr size_t W_OUT  = W_PC + (size_t)1024 * 512 * 2;
constexpr size_t W_GU   = W_OUT + (size_t)1024 * 1024 * 2;
constexpr size_t W_D    = W_GU + (size_t)17 * 1024 * 1024 * 2;
constexpr size_t W_END  = W_D + (size_t)17 * 1024 * 512 * 2;
constexpr size_t O_H    = O_WB + W_END;
constexpr size_t O_P    = O_H + (size_t)RT * DM * 2;
constexpr size_t O_ATT  = O_P + (size_t)RT * LDP * 2;
constexpr size_t O_RG   = O_ATT + (size_t)RT * 512 * 2;
constexpr size_t O_RWO  = O_RG + (size_t)RT * 512 * 2;
constexpr size_t O_FA   = O_RWO + (size_t)RT * 512 * 2;
constexpr size_t O_LTOK = O_FA + (size_t)RT * 512 * 2;
constexpr size_t O_LW   = O_LTOK + (size_t)NEXP * RT * 4;
constexpr size_t O_SLOT = O_LW + (size_t)NEXP * RT * 4;
constexpr size_t O_X    = al256(O_SLOT + (size_t)RT * 2 * 4);
constexpr size_t X_QA   = 0;
constexpr size_t X_KA   = X_QA + (size_t)RT * 768 * 2;
constexpr size_t X_VA   = X_KA + (size_t)4 * KEYS * 768 * 2;
constexpr int NCP = 4 * 8 * 2 * 68;
constexpr size_t X_S0   = 0;
constexpr size_t X_MT   = X_VA + (size_t)4 * 8 * 64 * KEYS * 2;
constexpr size_t X_GT   = X_MT + (size_t)NCP * 8192;
constexpr size_t X_YL   = X_GT + (size_t)NCP * 8192;
constexpr size_t X_QRAW = X_MT;
constexpr size_t X_KVRAW= X_QRAW + (size_t)RT * 768 * 2;
constexpr size_t X_KKN  = X_YL + (size_t)NCP * 8192;
constexpr size_t X_BON  = X_KKN + (size_t)RT * 8 * 4;
constexpr size_t X_END  = X_BON + (size_t)2 * RT * 8 * 4;
static_assert(X_KVRAW + (size_t)RT * 1024 * 2 <= X_YL + (size_t)NCP * 8192, "raw q/kv must fit under the chunk data");
static_assert(X_S0 + (size_t)NCP * 8192 <= X_VA, "S0 must fit in the q/k area");
constexpr size_t X_YE   = 0;
constexpr size_t WS_NEED = O_X + X_END;

__device__ __forceinline__ float bf2f(bf16_t u) { return __builtin_bit_cast(float, (unsigned)u << 16); }
__device__ __forceinline__ float bflo(unsigned u) { return __builtin_bit_cast(float, u << 16); }
__device__ __forceinline__ float bfhi(unsigned u) { return __builtin_bit_cast(float, u & 0xffff0000u); }
__device__ __forceinline__ unsigned pack2(float lo, float hi) { f32x2 v = {lo, hi}; bf16v2 b = __builtin_convertvector(v, bf16v2); return __builtin_bit_cast(unsigned, b); }
__device__ __forceinline__ bf16_t f2bf(float f) { return (bf16_t)(pack2(f, 0.f) & 0xffffu); }
__device__ __forceinline__ float wsum(float v) {
#pragma unroll
    for (int o = 32; o > 0; o >>= 1) v += __shfl_xor(v, o);
    return v;
}
__device__ __forceinline__ float sigmoidf_(float x) { return 1.f / (1.f + __expf(-x)); }
__device__ __forceinline__ float siluf_(float x) { return x / (1.f + __expf(-x)); }
__device__ __forceinline__ int modidx(int row) { return row < RL ? (row >> 12) : 4; }
__device__ __forceinline__ void unpack8(const uint4& u, float (&f)[8]) {
    f[0] = bflo(u.x); f[1] = bfhi(u.x); f[2] = bflo(u.y); f[3] = bfhi(u.y); f[4] = bflo(u.z); f[5] = bfhi(u.z); f[6] = bflo(u.w); f[7] = bfhi(u.w);
}
__device__ __forceinline__ uint4 pack8(const float (&f)[8]) { return make_uint4(pack2(f[0], f[1]), pack2(f[2], f[3]), pack2(f[4], f[5]), pack2(f[6], f[7])); }

#define XB_TMO      128
#define XB_XCNT(j)  (256  + 64 * (j))
#define XB_XSUB(j)  (1280 + 64 * (j))
#define XB_XGEN(j)  (2304 + 64 * (j))
#define XB_TOP      3328
#define XB_TOPGEN   3392
#define XCD_BAR_WORDS 3456
#define XB_SPIN_CAP (1u << 22)
#define LAS __attribute__((address_space(3)))
__device__ __forceinline__ unsigned xb_ld(unsigned* p)              { return __hip_atomic_load(p, __ATOMIC_RELAXED, __HIP_MEMORY_SCOPE_AGENT); }
__device__ __forceinline__ unsigned xb_add(unsigned* p, unsigned v) { return __hip_atomic_fetch_add(p, v, __ATOMIC_RELAXED, __HIP_MEMORY_SCOPE_AGENT); }
__device__ __forceinline__ unsigned xb_xcc_id() { return (unsigned)__builtin_amdgcn_s_getreg((3 << 11) | 20) & 0xFu; }
#define XB_SPIN(cond, bar) do { unsigned _sp = 0; while (cond) { __builtin_amdgcn_s_sleep(1); \
    if ((++_sp & 255u) == 0u) { if (xb_ld(&(bar)[XB_TMO])) break; if (_sp > XB_SPIN_CAP) { atomicAdd(&(bar)[XB_TMO], 1u); break; } } } } while (0)
struct XcdBarrier { unsigned* bar; unsigned x; volatile LAS unsigned* st; };
__device__ __forceinline__ XcdBarrier xcd_barrier_post(unsigned* bar, volatile LAS unsigned* st) {
    XcdBarrier b; b.bar = bar; b.x = xb_xcc_id(); b.st = st;
    if (threadIdx.x == 0) (void)xb_add(&bar[XB_XCNT(b.x)], 1u);
    return b;
}
__device__ __forceinline__ void xcd_barrier_complete(unsigned* bar, unsigned x, unsigned& nloc, unsigned& nx) {
    const unsigned G = gridDim.x * gridDim.y * gridDim.z;
    unsigned sum, cnt, mine, sp = 0u;
    for (;;) {
        sum = 0u; cnt = 0u; mine = 0u;
#pragma unroll
        for (unsigned j = 0; j < 16; ++j) { const unsigned c = xb_ld(&bar[XB_XCNT(j)]); sum += c; cnt += (c > 0u) ? 1u : 0u; mine = (j == x) ? c : mine; }
        if (sum == G) break;
        __builtin_amdgcn_s_sleep(1);
        if ((++sp & 255u) == 0u) { if (xb_ld(&bar[XB_TMO])) break; if (sp > XB_SPIN_CAP) { atomicAdd(&bar[XB_TMO], 1u); break; } }
    }
    nloc = mine > 0u ? mine : 1u; nx = cnt > 0u ? cnt : 1u;
}
__device__ __forceinline__ void xcd_barrier(const XcdBarrier& b) {
    asm volatile("s_waitcnt vmcnt(0)" ::: "memory");
    __syncthreads();
    if (threadIdx.x == 0) {
        unsigned* bar = b.bar;
        __builtin_amdgcn_s_waitcnt(0);
        unsigned nloc = b.st[0], nx = b.st[1];
        if (nloc == 0u) { xcd_barrier_complete(bar, b.x, nloc, nx); b.st[0] = nloc; b.st[1] = nx; }
        const unsigned old = xb_add(&bar[XB_XSUB(b.x)], 1u);
        const unsigned gen = old / nloc;
        if (old + 1u == (gen + 1u) * nloc) {
            __builtin_amdgcn_fence(__ATOMIC_RELEASE, "agent");
            asm volatile("s_waitcnt vmcnt(0)" ::: "memory");
            const unsigned og = xb_add(&bar[XB_TOP], 1u);
            const unsigned tg = og / nx;
            if (og + 1u == (tg + 1u) * nx) xb_add(&bar[XB_TOPGEN], 1u);
            else XB_SPIN(xb_ld(&bar[XB_TOPGEN]) == tg, bar);
            __builtin_amdgcn_fence(__ATOMIC_ACQUIRE, "agent");
            xb_add(&bar[XB_XGEN(b.x)], 1u);
            asm volatile("s_waitcnt vmcnt(0)" ::: "memory");
        } else {
            XB_SPIN(xb_ld(&bar[XB_XGEN(b.x)]) == gen, bar);
            __builtin_amdgcn_fence(__ATOMIC_ACQUIRE, "agent");
            asm volatile("s_waitcnt vmcnt(0)" ::: "memory");
        }
    }
    __syncthreads();
}

__device__ __forceinline__ int tidx() { int t = threadIdx.x; asm volatile("" : "+v"(t)); return t; }
__device__ __forceinline__ int lv(int x) { asm volatile("" : "+v"(x)); return x; }
__device__ __forceinline__ char* launder(char* p) { size_t z = 0; asm volatile("" : "+s"(z)); return p + z; }

constexpr int LDSROW = 72;
template <int NA, class AL>
__device__ __forceinline__ void gc_load(const AL& al, const bf16_t* bp, size_t bstep, int k0, int kc, u32x4 (&ra)[NA], u32x4 (&rb)[4]) {
#pragma unroll
    for (int i = 0; i < NA; ++i) ra[i] = __builtin_bit_cast(u32x4, al.load(i, k0 + kc));
#pragma unroll
    for (int j = 0; j < 4; ++j) rb[j] = *(const u32x4*)(bp + j * bstep + k0);
}
template <int NA>
__device__ __forceinline__ void gc_store(bf16_t* Ab, bf16_t* Bb, int lr, int kc, const u32x4 (&ra)[NA], const u32x4 (&rb)[4]) {
#pragma unroll
    for (int i = 0; i < NA; ++i) *(u32x4*)(Ab + (lr + 32 * i) * LDSROW + kc) = ra[i];
#pragma unroll
    for (int j = 0; j < 4; ++j) *(u32x4*)(Bb + (lr + 32 * j) * LDSROW + kc) = rb[j];
}
template <int MI>
__device__ __forceinline__ void gc_compute(const bf16_t* Ac, const bf16_t* Bc, f32x4 (&acc)[MI][4]) {
#pragma unroll
    for (int kh = 0; kh < 2; ++kh) {
        bf16x8 af[MI], bfv[4];
#pragma unroll
        for (int i = 0; i < MI; ++i) af[i] = *(const bf16x8*)(Ac + i * 16 * LDSROW + kh * 32);
#pragma unroll
        for (int j = 0; j < 4; ++j) bfv[j] = *(const bf16x8*)(Bc + j * 16 * LDSROW + kh * 32);
#pragma unroll
        for (int i = 0; i < MI; ++i)
#pragma unroll
            for (int j = 0; j < 4; ++j) acc[i][j] = __builtin_amdgcn_mfma_f32_16x16x32_bf16(bfv[j], af[i], acc[i][j], 0, 0, 0);
    }
}
template <int MI, class AL>
__device__ __forceinline__ void gemm_core(const AL& al, const bf16_t* __restrict__ Bt, int ldb, int K, f32x4 (&acc)[MI][4], char* smem) {
    constexpr int TM = MI * 32;
    constexpr int NA = TM / 32;
    bf16_t* As = (bf16_t*)smem;
    bf16_t* Bs = As + 2 * TM * LDSROW;
    const int tid = tidx(), lane = tid & 63, wave = tid >> 6;
    const int wr = wave >> 1, wc = wave & 1, fr = lane & 15, fq = lane >> 4;
    const int kc = (tid & 7) * 8, lr = tid >> 3;
#pragma unroll
    for (int i = 0; i < MI; ++i)
#pragma unroll
        for (int j = 0; j < 4; ++j) acc[i][j] = (f32x4){0.f, 0.f, 0.f, 0.f};
    u32x4 a0[NA], b0[4], a1[NA], b1[4];
    const bf16_t* bp = Bt + (size_t)lr * ldb + kc;
    const size_t bstep = (size_t)32 * ldb;
    const int nk = K >> 6;
    bf16_t* As1 = As + TM * LDSROW; bf16_t* Bs1 = Bs + 128 * LDSROW;
    const int aoff = (wr * MI * 16 + fr) * LDSROW + fq * 8, boff = (wc * 64 + fr) * LDSROW + fq * 8;
    gc_load<NA>(al, bp, bstep, 0, kc, a0, b0);
    gc_store<NA>(As, Bs, lr, kc, a0, b0);
    if (nk > 1) gc_load<NA>(al, bp, bstep, 64, kc, a0, b0);
    __syncthreads();
    for (int kt = 0; kt < nk; kt += 2) {
        if (kt + 2 < nk) gc_load<NA>(al, bp, bstep, (kt + 2) << 6, kc, a1, b1);
        gc_compute<MI>(As + aoff, Bs + boff, acc);
        if (kt + 1 < nk) gc_store<NA>(As1, Bs1, lr, kc, a0, b0);
        __syncthreads();
        if (kt + 1 >= nk) break;
        if (kt + 3 < nk) gc_load<NA>(al, bp, bstep, (kt + 3) << 6, kc, a0, b0);
        gc_compute<MI>(As1 + aoff, Bs1 + boff, acc);
        if (kt + 2 < nk) gc_store<NA>(As, Bs, lr, kc, a1, b1);
        __syncthreads();
    }
}
template <int MI, class RP, class RPB>
__device__ __forceinline__ void gemm_core_gb(const RP& rp, const RPB& rpb, int K, f32x4 (&acc)[MI][4], char* smem) {
    constexpr int ABYTES = MI * 32 * 128;
    constexpr int SBYTES = ABYTES + 16384;
    const int tid = tidx(), lane = tid & 63, wave = tid >> 6;
    const int wr = wave >> 1, wc = wave & 1, fr = lane & 15, fq = lane >> 4;
    const int rr = lane >> 3, cs = ((lane & 7) ^ ((wave * 4 + (lane >> 4)) & 7)) * 8;
#pragma unroll
    for (int i = 0; i < MI; ++i)
#pragma unroll
        for (int j = 0; j < 4; ++j) acc[i][j] = (f32x4){0.f, 0.f, 0.f, 0.f};
    const bf16_t* ap[MI]; const bf16_t* bp[4];
#pragma unroll
    for (int i = 0; i < MI; ++i) { const int r = (i * 4 + wave) * 8 + rr; ap[i] = rp(r) + cs; }
#pragma unroll
    for (int i = 0; i < 4; ++i) { const int r = (i * 4 + wave) * 8 + rr; bp[i] = rpb(r) + cs; }
    const int wbase = __builtin_amdgcn_readfirstlane(wave) * 1024;
    const int nk = K >> 6;
    auto stage = [&](int buf, int kt) {
        char* Ab = smem + buf * SBYTES + wbase; char* Bb = Ab + ABYTES;
#pragma unroll
        for (int i = 0; i < MI; ++i) __builtin_amdgcn_global_load_lds((const unsigned*)(ap[i] + kt * 64), (unsigned*)(Ab + i * 4096), 16, 0, 0);
#pragma unroll
        for (int i = 0; i < 4; ++i) __builtin_amdgcn_global_load_lds((const unsigned*)(bp[i] + kt * 64), (unsigned*)(Bb + i * 4096), 16, 0, 0);
    };
    const int aoff = (wr * MI * 16 + fr) * 128, boff = ABYTES + (wc * 64 + fr) * 128, sw = fr >> 1;
    stage(0, 0);
    asm volatile("s_waitcnt vmcnt(0)" ::: "memory");
    __syncthreads();
    for (int kt = 0; kt < nk; ++kt) {
        const int cur = kt & 1;
        if (kt + 1 < nk) stage(cur ^ 1, kt + 1);
        const char* base = smem + cur * SBYTES;
#pragma unroll
        for (int kh = 0; kh < 2; ++kh) {
            const int xo = ((kh * 4 + fq) ^ sw) * 16;
            bf16x8 af[MI], bfv[4];
#pragma unroll
            for (int i = 0; i < MI; ++i) af[i] = *(const bf16x8*)(base + aoff + i * 2048 + xo);
#pragma unroll
            for (int j = 0; j < 4; ++j) bfv[j] = *(const bf16x8*)(base + boff + j * 2048 + xo);
#pragma unroll
            for (int i = 0; i < MI; ++i)
#pragma unroll
                for (int j = 0; j < 4; ++j) acc[i][j] = __builtin_amdgcn_mfma_f32_16x16x32_bf16(bfv[j], af[i], acc[i][j], 0, 0, 0);
        }
        asm volatile("s_waitcnt vmcnt(0)" ::: "memory");
        __syncthreads();
    }
}
struct RPPlain;
template <int MI, class RP>
__device__ __forceinline__ void gemm_core_g(const RP& rp, const bf16_t* __restrict__ Bt, int ldb, int K, f32x4 (&acc)[MI][4], char* smem);
struct RPPlain {
    const bf16_t* A; size_t lda;
    __device__ __forceinline__ const bf16_t* operator()(int r) const { return A + (size_t)r * lda; }
};
template <int MI, class RP>
__device__ __forceinline__ void gemm_core_g(const RP& rp, const bf16_t* __restrict__ Bt, int ldb, int K, f32x4 (&acc)[MI][4], char* smem) {
    RPPlain rpb{Bt, (size_t)ldb};
    gemm_core_gb<MI>(rp, rpb, K, acc, smem);
}
template <int MI, class F>
__device__ __forceinline__ void acc_foreach(const f32x4 (&acc)[MI][4], F f) {
    const int lane = tidx() & 63, wave = tidx() >> 6;
    const int wr = wave >> 1, wc = wave & 1, fr = lane & 15, fq = lane >> 4;
#pragma unroll
    for (int i = 0; i < MI; ++i)
#pragma unroll
        for (int j = 0; j < 4; ++j) f(wr * MI * 16 + i * 16 + fr, wc * 64 + j * 16 + fq * 4, acc[i][j]);
}
struct ALPlain {
    const bf16_t* p0; size_t step;
    __device__ __forceinline__ ALPlain(const bf16_t* A, int lda, int row0) { p0 = A + (size_t)(row0 + (tidx() >> 3)) * lda; step = (size_t)32 * lda; }
    __device__ __forceinline__ uint4 load(int i, int k) const { return *(const uint4*)(p0 + i * step + k); }
};
__device__ __forceinline__ void store_bf16x4(bf16_t* dst, const f32x4& v) { *(uint2*)dst = make_uint2(pack2(v[0], v[1]), pack2(v[2], v[3])); }

__device__ __forceinline__ void ph_pre(const Params& p, char* smem) {
    const int tid = tidx(), nb = gridDim.x, bid = blockIdx.x;
    float* mod = (float*)(p.ws + O_MOD);
    {
        float* sv = (float*)smem;
        float* part = sv + 5 * 1024;
        for (int i = tid; i < 5 * 1024; i += 256) { const float v = (i < 4096) ? p.in[I_C][i] : p.in[I_CCTX][i - 4096]; sv[i] = siluf_(v); }
        __syncthreads();
        for (int it = bid; it < NLAYER * 96; it += nb) {
            const int l = it / 96, jb = it % 96;
            const int jj = tid & 63, kq = tid >> 6, j = jb * 64 + jj;
            const float* w = p.in[I_WADA] + (size_t)l * 1024 * 6144 + (size_t)(kq * 256) * 6144 + j;
            float a0 = 0.f, a1 = 0.f, a2 = 0.f, a3 = 0.f, a4 = 0.f;
#pragma unroll 8
            for (int k = 0; k < 256; ++k) {
                const float wv = w[(size_t)k * 6144]; const int kk = kq * 256 + k;
                a0 += sv[kk] * wv; a1 += sv[1024 + kk] * wv; a2 += sv[2048 + kk] * wv; a3 += sv[3072 + kk] * wv; a4 += sv[4096 + kk] * wv;
            }
            part[(kq * 5 + 0) * 64 + jj] = a0; part[(kq * 5 + 1) * 64 + jj] = a1; part[(kq * 5 + 2) * 64 + jj] = a2;
            part[(kq * 5 + 3) * 64 + jj] = a3; part[(kq * 5 + 4) * 64 + jj] = a4;
            __syncthreads();
            for (int o = tid; o < 320; o += 256) {
                const int i = o >> 6, c = o & 63;
                const float s = part[(0 * 5 + i) * 64 + c] + part[(1 * 5 + i) * 64 + c] + part[(2 * 5 + i) * 64 + c] + part[(3 * 5 + i) * 64 + c];
                mod[(size_t)(l * 5 + i) * 6144 + jb * 64 + c] = s + p.in[I_BADA][l * 6144 + jb * 64 + c];
            }
            __syncthreads();
        }
    }
    {
        float4* xc = (float4*)(p.ws + O_XCUR);
        const float4* x4 = (const float4*)p.in[I_X]; const float4* c4 = (const float4*)p.in[I_CTX];
        for (size_t i = (size_t)bid * 256 + tid; i < (size_t)RT * 256; i += (size_t)nb * 256) xc[i] = (i < (size_t)RL * 256) ? x4[i] : c4[i - (size_t)RL * 256];
    }
    {
        float* ct = (float*)smem;
        __syncthreads();
        for (int m = tid; m < 4096; m += 256) ct[m] = cospif((float)m * (1.f / 2048.f));
        __syncthreads();
        bf16_t* cst2 = (bf16_t*)(p.ws + O_CST256);
        for (int ch = bid * 256 + tid; ch < 256 * 512 / 8; ch += nb * 256) {
            const int ks = ch >> 6, c0 = (ch & 63) * 8, part = c0 >> 8, s0 = c0 & 255;
            float f[8];
#pragma unroll
            for (int e = 0; e < 8; ++e) { const int m = (16 * ks * (s0 + e)) & 4095; f[e] = part == 0 ? ct[m] : ct[(m - 1024) & 4095]; }
            *(uint4*)(cst2 + ch * 8) = pack8(f);
        }
        bf16_t* d128 = (bf16_t*)(p.ws + O_D128);
        for (int ch = bid * 256 + tid; ch < 128 * 128 / 8; ch += nb * 256) {
            const int mrow = ch >> 4, c0 = (ch & 15) * 8, po = mrow >> 6, k1 = mrow & 63, pi = c0 >> 6, t10 = c0 & 63;
            float f[8];
#pragma unroll
            for (int e = 0; e < 8; ++e) {
                const int m = (64 * k1 * (t10 + e)) & 4095; const float cv = ct[m], sv = ct[(m - 1024) & 4095];
                f[e] = (po == pi) ? cv : (po == 0 ? sv : -sv);
            }
            *(uint4*)(d128 + ch * 8) = pack8(f);
        }
        bf16_t* e64 = (bf16_t*)(p.ws + O_E64);
        for (int ch = bid * 256 + tid; ch < 64 * 128 / 8; ch += nb * 256) {
            const int k2 = ch >> 4, c0 = (ch & 15) * 8, po = c0 >> 6, t20 = c0 & 63;
            float f[8];
#pragma unroll
            for (int e = 0; e < 8; ++e) { const int m = (64 * k2 * (t20 + e)) & 4095; f[e] = po == 0 ? ct[m] : ct[(m - 1024) & 4095]; }
            *(uint4*)(e64 + ch * 8) = pack8(f);
        }
        float* twc = (float*)(p.ws + O_TWC); float* tws = (float*)(p.ws + O_TWS);
        for (int i = bid * 256 + tid; i < 64 * 64; i += nb * 256) {
            const int k1 = i >> 6, t2 = i & 63, m = (k1 * t2) & 4095;
            twc[i] = ct[m]; tws[i] = -ct[(m - 1024) & 4095];
        }
        bf16_t* csc = (bf16_t*)(p.ws + O_CSC);
        for (int ch = bid * 256 + tid; ch < 256 * 128 / 8; ch += nb * 256) {
            const int n = ch >> 4, c0 = (ch & 15) * 8, part = n >> 7, kc = n & 127;
            float f[8];
#pragma unroll
            for (int e = 0; e < 8; ++e) { const int m = (32 * kc * (c0 + e)) & 4095; f[e] = part == 0 ? ct[m] : -ct[(m - 1024) & 4095]; }
            *(uint4*)(csc + ch * 8) = pack8(f);
        }
        float* rc = (float*)(p.ws + O_ROPEC); float* rs = (float*)(p.ws + O_ROPES);
        for (int i = bid * 256 + tid; i < SEQ * 16; i += nb * 256) {
            const int t = i >> 4, ax = (i >> 3) & 1, f = i & 7;
            const float inv = powf(10000.f, -(float)f / 8.f);
            const float pos = (float)(ax == 0 ? (t >> 6) : (t & 63));
            const float ang = pos * inv;
            rc[i] = cosf(ang); rs[i] = sinf(ang);
        }
    }
}

struct ConvTask { const float* src; const float* scale; bf16_t* dst; int K, Nsrc, Ndst, rmul; size_t sbs, dbs; };
__constant__ int c_conv_cum[17] = {0, 1536, 1608, 1672, 1688, 1704, 1720, 1848, 1976, 2104, 2360, 4408, 6456, 8504, 8632, 8760, 8888};
__device__ __forceinline__ ConvTask conv_task(const Params& p, int l, int t) {
    bf16_t* wb = (bf16_t*)(p.ws + O_WB);
    ConvTask c; c.scale = nullptr; c.sbs = 0; c.dbs = 0; c.rmul = 64;
    switch (t) {
    case 0:  c.src = p.in[I_WIN] + (size_t)l * 1024 * 6048; c.K = 1024; c.Nsrc = 6048; c.Ndst = 6144; c.dst = wb + W_IN / 2; break;
    case 1:  c.src = p.in[I_WUQ] + (size_t)l * 384 * 768; c.K = 384; c.Nsrc = 768; c.Ndst = 768; c.dst = wb + W_UQ / 2; c.scale = p.in[I_QNG] + l * 384; break;
    case 2:  c.src = p.in[I_WUKV] + (size_t)l * 256 * 1024; c.K = 256; c.Nsrc = 1024; c.Ndst = 1024; c.dst = wb + W_UKV / 2; c.scale = p.in[I_KVNG] + l * 256; break;
    case 3:  c.src = p.in[I_WUP] + (size_t)l * 2 * 64 * 512; c.K = 64; c.Nsrc = 512; c.Ndst = 512; c.dst = wb + W_WUP / 2; c.sbs = 64 * 512; c.dbs = 512 * 64; break;
    case 4:  c.src = p.in[I_AUP] + (size_t)l * 2 * 64 * 512; c.K = 64; c.Nsrc = 512; c.Ndst = 512; c.dst = wb + W_AUP / 2; c.sbs = 64 * 512; c.dbs = 512 * 64; break;
    case 5:  c.src = p.in[I_GUP] + (size_t)l * 128 * 512; c.K = 128; c.Nsrc = 512; c.Ndst = 512; c.dst = wb + W_GUP / 2; break;
    case 6:  c.src = p.in[I_WPA] + (size_t)l * 512 * 1024; c.K = 512; c.Nsrc = 1024; c.Ndst = 1024; c.dst = wb + W_PA / 2; break;
    case 7:  c.src = p.in[I_WPB] + (size_t)l * 512 * 1024; c.K = 512; c.Nsrc = 1024; c.Ndst = 1024; c.dst = wb + W_PB / 2; break;
    case 8:  c.src = p.in[I_WPC] + (size_t)l * 512 * 1024; c.K = 512; c.Nsrc = 1024; c.Ndst = 1024; c.dst = wb + W_PC / 2; break;
    case 9:  c.src = p.in[I_WOUT] + (size_t)l * 1024 * 1024; c.K = 1024; c.Nsrc = 1024; c.Ndst = 1024; c.dst = wb + W_OUT / 2; break;
    case 10: c.src = p.in[I_EG] + (size_t)l * 16 * 1024 * 512; c.K = 1024; c.Nsrc = 512; c.Ndst = 512; c.dst = wb + W_GU / 2; c.sbs = 1024 * 512; c.dbs = 1024 * 1024; c.rmul = 128; break;
    case 11: c.src = p.in[I_EU] + (size_t)l * 16 * 1024 * 512; c.K = 1024; c.Nsrc = 512; c.Ndst = 512; c.dst = wb + W_GU / 2 + 64 * 1024; c.sbs = 1024 * 512; c.dbs = 1024 * 1024; c.rmul = 128; break;
    case 12: c.src = p.in[I_ED] + (size_t)l * 16 * 512 * 1024; c.K = 512; c.Nsrc = 1024; c.Ndst = 1024; c.dst = wb + W_D / 2; c.sbs = 512 * 1024; c.dbs = 1024 * 512; break;
    case 13: c.src = p.in[I_SG] + (size_t)l * 1024 * 512; c.K = 1024; c.Nsrc = 512; c.Ndst = 512; c.dst = wb + W_GU / 2 + (size_t)16 * 1024 * 1024; c.rmul = 128; break;
    case 14: c.src = p.in[I_SU] + (size_t)l * 1024 * 512; c.K = 1024; c.Nsrc = 512; c.Ndst = 512; c.dst = wb + W_GU / 2 + (size_t)16 * 1024 * 1024 + 64 * 1024; c.rmul = 128; break;
    default: c.src = p.in[I_SD] + (size_t)l * 512 * 1024; c.K = 512; c.Nsrc = 1024; c.Ndst = 1024; c.dst = wb + W_D / 2 + (size_t)16 * 1024 * 512; break;
    }
    return c;
}
__device__ __forceinline__ void ph_w(const Params& p, int l, char* smem) {
    const int tid = tidx();
    float* tl = (float*)smem;
    for (int g = blockIdx.x; g < 8888; g += gridDim.x) {
        int t = 0;
        while (g >= c_conv_cum[t + 1]) ++t;
        const ConvTask c = conv_task(p, l, t);
        int r = g - c_conv_cum[t];
        const int nkt = c.K >> 6, nnt = c.Ndst >> 6;
        const int bi = r / (nkt * nnt); r -= bi * nkt * nnt;
        const int k0 = (r / nnt) * 64, n0 = (r % nnt) * 64;
        const float* src = c.src + bi * c.sbs; bf16_t* dst = c.dst + bi * c.dbs;
#pragma unroll
        for (int i = 0; i < 4; ++i) {
            const int k = (tid >> 4) + 16 * i, n = n0 + (tid & 15) * 4;
            float4 v = make_float4(0.f, 0.f, 0.f, 0.f);
            if (n < c.Nsrc) v = *(const float4*)(src + (size_t)(k0 + k) * c.Nsrc + n);
            if (c.scale) { const float s = c.scale[k0 + k]; v.x *= s; v.y *= s; v.z *= s; v.w *= s; }
            float* d = tl + k * 65 + (tid & 15) * 4;
            d[0] = v.x; d[1] = v.y; d[2] = v.z; d[3] = v.w;
        }
        __syncthreads();
        {
            const int n = tid >> 2, kk0 = (tid & 3) * 16;
            float f[8], g2[8];
#pragma unroll
            for (int j = 0; j < 8; ++j) { f[j] = tl[(kk0 + j) * 65 + n]; g2[j] = tl[(kk0 + 8 + j) * 65 + n]; }
            bf16_t* d = dst + (size_t)((n0 >> 6) * c.rmul + n) * c.K + k0 + kk0;
            *(uint4*)d = pack8(f); *(uint4*)(d + 8) = pack8(g2);
        }
        __syncthreads();
    }
}

__device__ __forceinline__ void ph_n1(const Params& p, int l) {
    const int lane = tidx() & 63, wave = tidx() >> 6;
    const float* xcur = (const float*)(p.ws + O_XCUR); const float* mod = (const float*)(p.ws + O_MOD);
    bf16_t* H = (bf16_t*)(p.ws + O_H);
    const float* g = p.in[I_N1G] + l * 1024;
    for (int row = blockIdx.x * 4 + wave; row < RT; row += gridDim.x * 4) {
        const float* x = xcur + (size_t)row * 1024; const float* md = mod + (size_t)(l * 5 + modidx(row)) * 6144;
        float4 v[4]; float ss = 0.f;
#pragma unroll
        for (int i = 0; i < 4; ++i) { v[i] = *(const float4*)(x + lane * 4 + 256 * i); ss += v[i].x * v[i].x + v[i].y * v[i].y + v[i].z * v[i].z + v[i].w * v[i].w; }
        ss = wsum(ss);
        const float rstd = rsqrtf(ss * (1.f / 1024.f) + 1e-6f);
#pragma unroll
        for (int i = 0; i < 4; ++i) {
            const int c = lane * 4 + 256 * i;
            const float4 gg = *(const float4*)(g + c), sc = *(const float4*)(md + 1024 + c), sh = *(const float4*)(md + c);
            f32x4 h = {v[i].x * rstd * gg.x * (1.f + sc.x) + sh.x, v[i].y * rstd * gg.y * (1.f + sc.y) + sh.y,
                       v[i].z * rstd * gg.z * (1.f + sc.z) + sh.z, v[i].w * rstd * gg.w * (1.f + sc.w) + sh.w};
            store_bf16x4(H + (size_t)row * 1024 + c, h);
        }
    }
}

__device__ __forceinline__ void ph_g1(const Params& p, char* smem) {
    if (blockIdx.x == 0 && tidx() < 64) ((unsigned*)(p.ws + O_CNT))[tidx()] = 0u;
    const bf16_t* H = (const bf16_t*)(p.ws + O_H); const bf16_t* W = (const bf16_t*)(p.ws + O_WB + W_IN);
    bf16_t* P = (bf16_t*)(p.ws + O_P);
    for (int it = blockIdx.x; it < 136 * 48; it += gridDim.x) {
        const int mt = it / 48, nt = it % 48;
        f32x4 acc[4][4];
        RPPlain rp{H + (size_t)mt * 128 * 1024, 1024};
        gemm_core_g<4>(rp, W + (size_t)nt * 128 * 1024, 1024, 1024, acc, smem);
        acc_foreach<4>(acc, [&](int m, int n, const f32x4& v) {
            const int col = nt * 128 + n; f32x4 o = v;
            if (col >= PG0 && col < PEND) { o[0] = sigmoidf_(v[0]); o[1] = sigmoidf_(v[1]); o[2] = sigmoidf_(v[2]); o[3] = sigmoidf_(v[3]); }
            store_bf16x4(P + (size_t)(mt * 128 + m) * LDP + col, o);
        });
    }
}

__device__ __forceinline__ void ph_qu(const Params& p, char* smem) {
    const bf16_t* P = (const bf16_t*)(p.ws + O_P);
    bf16_t* QR = (bf16_t*)(p.ws + O_X + X_QRAW); bf16_t* KVR = (bf16_t*)(p.ws + O_X + X_KVRAW);
    for (int it = blockIdx.x; it < 136 * 14; it += gridDim.x) {
        const int mt = it / 14, nn = it % 14;
        f32x4 acc[4][4];
        if (nn < 6) {
            RPPlain rp{P + (size_t)mt * 128 * LDP + PQ0, LDP};
            gemm_core_g<4>(rp, (const bf16_t*)(p.ws + O_WB + W_UQ) + (size_t)nn * 128 * 384, 384, 384, acc, smem);
            acc_foreach<4>(acc, [&](int m, int n, const f32x4& v) { store_bf16x4(QR + (size_t)(mt * 128 + m) * 768 + nn * 128 + n, v); });
        } else {
            const int nt = nn - 6;
            RPPlain rp{P + (size_t)mt * 128 * LDP + PKV0, LDP};
            gemm_core_g<4>(rp, (const bf16_t*)(p.ws + O_WB + W_UKV) + (size_t)nt * 128 * 256, 256, 256, acc, smem);
            acc_foreach<4>(acc, [&](int m, int n, const f32x4& v) { store_bf16x4(KVR + (size_t)(mt * 128 + m) * 1024 + nt * 128 + n, v); });
        }
    }
}

constexpr float QSCALE = 0.10206207261596575f * 1.4426950408889634f;
__device__ __forceinline__ void ph_m2(const Params& p, char* smem) {
    const int tid = tidx(), lane = tid & 63, wave = tid >> 6;
    const bf16_t* P = (const bf16_t*)(p.ws + O_P);
    const bf16_t* QR = (const bf16_t*)(p.ws + O_X + X_QRAW); const bf16_t* KVR = (const bf16_t*)(p.ws + O_X + X_KVRAW);
    bf16_t* QA = (bf16_t*)(p.ws + O_X + X_QA); bf16_t* KA = (bf16_t*)(p.ws + O_X + X_KA); bf16_t* VA = (bf16_t*)(p.ws + O_X + X_VA);
    const float* rc = (const float*)(p.ws + O_ROPEC); const float* rs = (const float*)(p.ws + O_ROPES);
    for (int row = blockIdx.x * 4 + wave; row < RT; row += gridDim.x * 4) {
        const bool lat = row < RL;
        const int b = lat ? (row >> 12) : ((row - RL) >> 8), t = lat ? (row & 4095) : ((row - RL) & 255);
        const size_t keyrow = (size_t)b * KEYS + (lat ? t : SEQ + t);
        const bf16_t* pr = P + (size_t)row * LDP;
        float sq = 0.f, sk = 0.f;
        if (lane < 48) { float f[8]; unpack8(*(const uint4*)(pr + PQ0 + lane * 8), f);
#pragma unroll
            for (int e = 0; e < 8; ++e) sq += f[e] * f[e]; }
        if (lane < 32) { float f[8]; unpack8(*(const uint4*)(pr + PKV0 + lane * 8), f);
#pragma unroll
            for (int e = 0; e < 8; ++e) sk += f[e] * f[e]; }
        sq = wsum(sq); sk = wsum(sk);
        const float rq = rsqrtf(sq * (1.f / 384.f) + 1e-6f), rkv = rsqrtf(sk * (1.f / 256.f) + 1e-6f);
        const bf16_t* qr = QR + (size_t)row * 768; const bf16_t* kvr = KVR + (size_t)row * 1024;
        const float* rct = rc + t * 16; const float* rst = rs + t * 16;
#pragma unroll
        for (int pass = 0; pass < 2; ++pass) {
            const int ch = lane + 64 * pass;
            if (ch < 96) {
                const int h = ch / 12, cc = ch - h * 12;
                float q[8], k[8];
                unpack8(*(const uint4*)(qr + ch * 8), q);
                if (cc < 8) unpack8(*(const uint4*)(kvr + h * 128 + cc * 8), k);
                else unpack8(*(const uint4*)(pr + PKR0 + (cc - 8) * 8), k);
                const float ksc = cc < 8 ? rkv : 1.f;
#pragma unroll
                for (int e = 0; e < 8; ++e) { q[e] *= rq; k[e] *= ksc; }
                if (cc >= 8 && lat) {
                    const int sub = cc - 8, ax = sub >> 1, half = sub & 1;
                    float qp[8], kp[8];
                    unpack8(*(const uint4*)(qr + (ch ^ 1) * 8), qp); unpack8(*(const uint4*)(pr + PKR0 + (sub ^ 1) * 8), kp);
                    const float4 c0 = *(const float4*)(rct + ax * 8), c1 = *(const float4*)(rct + ax * 8 + 4), s0 = *(const float4*)(rst + ax * 8), s1 = *(const float4*)(rst + ax * 8 + 4);
                    const float cs_[8] = {c0.x, c0.y, c0.z, c0.w, c1.x, c1.y, c1.z, c1.w}, sn_[8] = {s0.x, s0.y, s0.z, s0.w, s1.x, s1.y, s1.z, s1.w};
#pragma unroll
                    for (int e = 0; e < 8; ++e) {
                        const float sg = half ? sn_[e] : -sn_[e];
                        q[e] = q[e] * cs_[e] + qp[e] * rq * sg;
                        k[e] = k[e] * cs_[e] + kp[e] * sg;
                    }
                }
#pragma unroll
                for (int e = 0; e < 8; ++e) q[e] *= QSCALE;
                *(uint4*)(QA + (size_t)row * 768 + ch * 8) = pack8(q);
                *(uint4*)(KA + keyrow * 768 + ch * 8) = pack8(k);
            }
        }
    }
    bf16_t* vt = (bf16_t*)smem;
    float* rk = (float*)(smem + 64 * 72 * 2);
    for (int it = blockIdx.x; it < (RT / 64) * 8; it += gridDim.x) {
        const int g = it >> 3, h = it & 7, rowg = g * 64;
        const bool lat = rowg < RL;
        const int b = lat ? (rowg >> 12) : ((rowg - RL) >> 8), t0 = lat ? (rowg & 4095) : ((rowg - RL) & 255);
        const size_t key0 = lat ? t0 : SEQ + t0;
        {
            const int lr = tid >> 2, q4 = tid & 3;
            const bf16_t* pr = P + (size_t)(rowg + lr) * LDP + PKV0 + q4 * 64;
            float sk = 0.f;
#pragma unroll
            for (int i = 0; i < 8; ++i) {
                float f[8]; unpack8(*(const uint4*)(pr + i * 8), f);
#pragma unroll
                for (int e = 0; e < 8; ++e) sk += f[e] * f[e];
            }
            sk += __shfl_xor(sk, 1); sk += __shfl_xor(sk, 2);
            if (q4 == 0) rk[lr] = rsqrtf(sk * (1.f / 256.f) + 1e-6f);
        }
        __syncthreads();
#pragma unroll
        for (int i = 0; i < 2; ++i) {
            const int c = tid + 256 * i, lr = c >> 3, part = c & 7;
            float f[8]; unpack8(*(const uint4*)(KVR + (size_t)(rowg + lr) * 1024 + h * 128 + 64 + part * 8), f);
            const float sc = rk[lr];
#pragma unroll
            for (int e = 0; e < 8; ++e) f[e] *= sc;
            *(uint4*)(vt + lr * 72 + part * 8) = pack8(f);
        }
        __syncthreads();
#pragma unroll
        for (int i = 0; i < 2; ++i) {
            const int c = tid + 256 * i, dd = c >> 3, kc = c & 7;
            float f[8];
#pragma unroll
            for (int e = 0; e < 8; ++e) f[e] = bf2f(vt[(kc * 8 + e) * 72 + dd]);
            const uint4 u = pack8(f);
            bf16_t* dst = VA + ((size_t)(b * 8 + h) * 64 + dd) * KEYS + key0 + (kc >> 2) * 32 + (kc & 1) * 16 + ((kc & 3) >> 1) * 4;
            *(uint2*)dst = make_uint2(u.x, u.y); *(uint2*)(dst + 8) = make_uint2(u.z, u.w);
        }
        __syncthreads();
    }
}
__device__ __forceinline__ float xmax_16_32(float v) {
    unsigned u = __builtin_bit_cast(unsigned, v);
    auto r = __builtin_amdgcn_permlane32_swap(u, u, false, false);
    float m = fmaxf(__builtin_bit_cast(float, r[0]), __builtin_bit_cast(float, r[1]));
    u = __builtin_bit_cast(unsigned, m);
    auto r2 = __builtin_amdgcn_permlane16_swap(u, u, false, false);
    return fmaxf(__builtin_bit_cast(float, r2[0]), __builtin_bit_cast(float, r2[1]));
}
__device__ __forceinline__ float xsum_16_32(float v) {
    unsigned u = __builtin_bit_cast(unsigned, v);
    auto r = __builtin_amdgcn_permlane32_swap(u, u, false, false);
    float m = __builtin_bit_cast(float, r[0]) + __builtin_bit_cast(float, r[1]);
    u = __builtin_bit_cast(unsigned, m);
    auto r2 = __builtin_amdgcn_permlane16_swap(u, u, false, false);
    return __builtin_bit_cast(float, r2[0]) + __builtin_bit_cast(float, r2[1]);
}
constexpr int KS_LD = 104, VT_LD = 72;
constexpr int AT_BUF = 64 * KS_LD * 2 + 64 * VT_LD * 2;
__device__ __forceinline__ void ph_at(const Params& p, int l, char* smem) {
    const int tid = tidx(), lane = tid & 63, wave = tid >> 6, fr = lane & 15, fq = lane >> 4;
    const bf16_t* QA = (const bf16_t*)(p.ws + O_X + X_QA); const bf16_t* KA = (const bf16_t*)(p.ws + O_X + X_KA); const bf16_t* VA = (const bf16_t*)(p.ws + O_X + X_VA);
    bf16_t* ATT = (bf16_t*)(p.ws + O_ATT);
    const int nitems = 1024 + (l < NLAYER - 1 ? 64 : 0);
    for (int it0 = blockIdx.x; it0 < nitems; it0 += gridDim.x) {
        int it = it0;
        if (gridDim.x == 512 && it0 < 1024) {
            const int x = it0 & 7, j = (it0 >> 3) & 63, rd = it0 >> 9;
            it = ((x * 4 + rd * 2 + (j >> 5)) << 5) | (j & 31);
        }
        int b, h, row0, ntile; size_t krow0;
        if (it < 1024) { b = it >> 8; h = (it >> 5) & 7; row0 = b * SEQ + (it & 31) * 128; krow0 = (size_t)b * KEYS; ntile = KEYS / 64; }
        else { const int j = it - 1024; b = j >> 4; h = (j >> 1) & 7; row0 = RL + b * CTX + (j & 1) * 128; krow0 = (size_t)b * KEYS + SEQ; ntile = CTX / 64; }
        const int qrow = row0 + wave * 32 + fr;
        const size_t vrow0 = (size_t)(b * 8 + h) * 64; const int koff0 = (int)(krow0 - (size_t)b * KEYS);
        bf16x8 qf[2][3];
#pragma unroll
        for (int t = 0; t < 2; ++t)
#pragma unroll
            for (int ks = 0; ks < 3; ++ks) qf[t][ks] = *(const bf16x8*)(QA + (size_t)(qrow + 16 * t) * 768 + h * 96 + ks * 32 + fq * 8);
        f32x4 ot[2][4];
#pragma unroll
        for (int t = 0; t < 2; ++t)
#pragma unroll
            for (int i = 0; i < 4; ++i) ot[t][i] = (f32x4){0.f, 0.f, 0.f, 0.f};
        float m_run[2] = {-1e30f, -1e30f}, l_run[2] = {0.f, 0.f};
        uint4 rk0, rk1, rk2, rv0, rv1;
#define AT_GLOAD(KT) do { const size_t kr_ = krow0 + (size_t)(KT) * 64; \
            { const int c = tid, key = c / 12, part = c % 12; rk0 = *(const uint4*)(KA + (kr_ + key) * 768 + h * 96 + part * 8); } \
            { const int c = tid + 256, key = c / 12, part = c % 12; rk1 = *(const uint4*)(KA + (kr_ + key) * 768 + h * 96 + part * 8); } \
            { const int c = tid + 512, key = c / 12, part = c % 12; rk2 = *(const uint4*)(KA + (kr_ + key) * 768 + h * 96 + part * 8); } \
            { const int c = tid, dd_ = c >> 3, part = c & 7; rv0 = *(const uint4*)(VA + (vrow0 + dd_) * KEYS + koff0 + (KT) * 64 + part * 8); } \
            { const int c = tid + 256, dd_ = c >> 3, part = c & 7; rv1 = *(const uint4*)(VA + (vrow0 + dd_) * KEYS + koff0 + (KT) * 64 + part * 8); } } while (0)
#define AT_VSTORE(RV, C) do { const int dd_ = (C) >> 3, part = (C) & 7; *(uint4*)(Vt_ + dd_ * VT_LD + part * 8) = RV; } while (0)
#define AT_SSTORE(BUF) do { bf16_t* Ks_ = (bf16_t*)(smem + (BUF) * AT_BUF); bf16_t* Vt_ = Ks_ + 64 * KS_LD; \
            { const int c = tid, key = c / 12, part = c % 12; *(uint4*)(Ks_ + key * KS_LD + part * 8) = rk0; } \
            { const int c = tid + 256, key = c / 12, part = c % 12; *(uint4*)(Ks_ + key * KS_LD + part * 8) = rk1; } \
            { const int c = tid + 512, key = c / 12, part = c % 12; *(uint4*)(Ks_ + key * KS_LD + part * 8) = rk2; } \
            AT_VSTORE(rv0, tid); AT_VSTORE(rv1, tid + 256); } while (0)
        AT_GLOAD(0); AT_SSTORE(0);
        __syncthreads();
        for (int kt = 0; kt < ntile; ++kt) {
            const int cur = kt & 1;
            if (kt + 1 < ntile) AT_GLOAD(kt + 1);
            const bf16_t* Ks = (const bf16_t*)(smem + cur * AT_BUF); const bf16_t* Vt = Ks + 64 * KS_LD;
            f32x4 st[2][4];
#pragma unroll
            for (int jh = 0; jh < 2; ++jh) {
                bf16x8 kf[2][3];
#pragma unroll
                for (int jj = 0; jj < 2; ++jj)
#pragma unroll
                    for (int ks = 0; ks < 3; ++ks) kf[jj][ks] = *(const bf16x8*)(Ks + ((jh * 2 + jj) * 16 + fr) * KS_LD + ks * 32 + fq * 8);
#pragma unroll
                for (int jj = 0; jj < 2; ++jj) {
                    const int j = jh * 2 + jj;
                    st[0][j] = (f32x4){0.f, 0.f, 0.f, 0.f}; st[1][j] = (f32x4){0.f, 0.f, 0.f, 0.f};
#pragma unroll
                    for (int ks = 0; ks < 3; ++ks) {
                        st[0][j] = __builtin_amdgcn_mfma_f32_16x16x32_bf16(kf[jj][ks], qf[0][ks], st[0][j], 0, 0, 0);
                        st[1][j] = __builtin_amdgcn_mfma_f32_16x16x32_bf16(kf[jj][ks], qf[1][ks], st[1][j], 0, 0, 0);
                    }
                }
            }
            bf16x8 vf[2][4];
#pragma unroll
            for (int k2 = 0; k2 < 2; ++k2)
#pragma unroll
                for (int dt = 0; dt < 4; ++dt) {
                    vf[k2][dt] = *(const bf16x8*)(Vt + (dt * 16 + fr) * VT_LD + k2 * 32 + fq * 8);
                }
            uint4 pu[2][2];
#pragma unroll
            for (int t = 0; t < 2; ++t) {
                float mx = st[t][0][0];
#pragma unroll
                for (int j = 0; j < 4; ++j)
#pragma unroll
                    for (int r = 0; r < 4; ++r) mx = fmaxf(mx, st[t][j][r]);
                if (__any(mx > m_run[t] + 6.f)) {
                    mx = xmax_16_32(mx);
                    const float m_new = fmaxf(m_run[t], mx);
                    const float alpha = __builtin_amdgcn_exp2f(m_run[t] - m_new);
                    m_run[t] = m_new;
                    l_run[t] *= alpha;
#pragma unroll
                    for (int i = 0; i < 4; ++i) ot[t][i] *= alpha;
                }
                const float mr = m_run[t];
                float ps = 0.f;
#pragma unroll
                for (int j = 0; j < 4; ++j)
#pragma unroll
                    for (int r = 0; r < 4; ++r) { st[t][j][r] = __builtin_amdgcn_exp2f(st[t][j][r] - mr); ps += st[t][j][r]; }
                l_run[t] += ps;
#pragma unroll
                for (int k2 = 0; k2 < 2; ++k2)
                    pu[t][k2] = make_uint4(pack2(st[t][2 * k2][0], st[t][2 * k2][1]), pack2(st[t][2 * k2][2], st[t][2 * k2][3]),
                                           pack2(st[t][2 * k2 + 1][0], st[t][2 * k2 + 1][1]), pack2(st[t][2 * k2 + 1][2], st[t][2 * k2 + 1][3]));
            }
#pragma unroll
            for (int k2 = 0; k2 < 2; ++k2) {
                const bf16x8 pb0 = __builtin_bit_cast(bf16x8, pu[0][k2]), pb1 = __builtin_bit_cast(bf16x8, pu[1][k2]);
#pragma unroll
                for (int dt = 0; dt < 4; ++dt) {
                    ot[0][dt] = __builtin_amdgcn_mfma_f32_16x16x32_bf16(vf[k2][dt], pb0, ot[0][dt], 0, 0, 0);
                    ot[1][dt] = __builtin_amdgcn_mfma_f32_16x16x32_bf16(vf[k2][dt], pb1, ot[1][dt], 0, 0, 0);
                }
            }
            if (kt + 1 < ntile) AT_SSTORE(cur ^ 1);
            __syncthreads();
        }
#pragma unroll
        for (int t = 0; t < 2; ++t) {
            const float inv = 1.f / xsum_16_32(l_run[t]);
#pragma unroll
            for (int dt = 0; dt < 4; ++dt) { f32x4 o = ot[t][dt] * inv; store_bf16x4(ATT + (size_t)(qrow + 16 * t) * 512 + h * 64 + dt * 16 + fq * 4, o); }
        }
    }
}

__device__ __forceinline__ void row_edges(int row, bool& first, bool& last) {
    if (row < RL) { const int t = row & 4095; first = t == 0; last = t == 4095; }
    else { const int s = (row - RL) & 255; first = s == 0; last = s == 255; }
}
__device__ __forceinline__ float xs1(const bf16_t* P, const float* mu, int row, int col) {
    bool first, last; row_edges(row, first, last);
    const bf16_t* pc = P + (size_t)row * LDP + PR0 + col;
    const float c = bf2f(*pc), pv0 = bf2f(*(first ? pc : pc - LDP)), nx0 = bf2f(*(last ? pc : pc + LDP));
    const float pv = first ? 0.f : pv0, nx = last ? 0.f : nx0;
    return c + (0.5f * (pv + nx) - c) * mu[col];
}
__device__ __forceinline__ void xs8(const bf16_t* P, const float* mu, int row, int col, float (&o)[8]) {
    bool first, last; row_edges(row, first, last);
    const bf16_t* pc = P + (size_t)row * LDP + PR0 + col;
    const uint4 uc = *(const uint4*)pc, up = *(const uint4*)(first ? pc : pc - LDP), un = *(const uint4*)(last ? pc : pc + LDP);
    float c[8], pv[8], nx[8]; unpack8(uc, c); unpack8(up, pv); unpack8(un, nx);
    const float fp = first ? 0.f : 0.5f, fn = last ? 0.f : 0.5f;
    const float4 m0 = *(const float4*)(mu + col), m1 = *(const float4*)(mu + col + 4);
    const float m[8] = {m0.x, m0.y, m0.z, m0.w, m1.x, m1.y, m1.z, m1.w};
#pragma unroll
    for (int j = 0; j < 8; ++j) o[j] = c[j] + ((fp * pv[j] + fn * nx[j]) - c[j]) * m[j];
}
struct ALRw {
    const bf16_t* P; const float* mu; int row0; int colbase, mode;
    __device__ __forceinline__ ALRw(const bf16_t* P_, const float* mu_, int row0_, int colbase_, int mode_) : P(P_), mu(mu_), colbase(colbase_), mode(mode_) {
        row0 = row0_ + (tidx() >> 3);
    }
    __device__ __forceinline__ uint4 load(int i, int k) const {
        float o[8]; xs8(P, mu, row0 + 32 * i, colbase + k, o);
        if (mode == 0) {
#pragma unroll
            for (int j = 0; j < 8; ++j) o[j] = tanhf(o[j]);
        } else if (mode == 2) {
#pragma unroll
            for (int j = 0; j < 8; ++j) o[j] = sigmoidf_(o[j]);
        }
        return pack8(o);
    }
};
__device__ __forceinline__ void ph_rp1(const Params& p, int l, char* smem) {
    const bf16_t* P = (const bf16_t*)(p.ws + O_P); const float* mu = p.in[I_MU] + l * 1792;
    bf16_t* RG = (bf16_t*)(p.ws + O_RG);
    for (int it = blockIdx.x; it < 1088; it += gridDim.x) {
        const int mt = it >> 2, nt = it & 3;
        f32x4 acc[2][4];
        ALRw al(P, mu, mt * 64, 1664, 2);
        gemm_core<2>(al, (const bf16_t*)(p.ws + O_WB + W_GUP) + (size_t)nt * 128 * 128, 128, 128, acc, smem);
        acc_foreach<2>(acc, [&](int m, int n, const f32x4& v) { store_bf16x4(RG + (size_t)(mt * 64 + m) * 512 + nt * 128 + n, v); });
    }
}
__device__ __forceinline__ void ph_rp2(const Params& p, int l) {
    const int lane = tidx() & 63, wave = tidx() >> 6;
    const bf16_t* P = (const bf16_t*)(p.ws + O_P); const float* mu = p.in[I_MU] + l * 1792; const float* kkw = p.in[I_KK] + l * 512;
    float* KKN = (float*)(p.ws + O_X + X_KKN);
    for (int row = blockIdx.x * 4 + wave; row < RT; row += gridDim.x * 4) {
        float k8[8]; xs8(P, mu, row, 512 + lane * 8, k8);
        float s = 0.f;
#pragma unroll
        for (int j = 0; j < 8; ++j) { const float v = k8[j] * kkw[lane * 8 + j]; s += v * v; }
        s += __shfl_xor(s, 1); s += __shfl_xor(s, 2); s += __shfl_xor(s, 4);
        if ((lane & 7) == 0) KKN[(size_t)row * 8 + (lane >> 3)] = rsqrtf(s + 1e-12f);
    }
}

__device__ __forceinline__ int scan_row(int b, int d, int n) {
    if (n < CTX) return RL + b * CTX + (d == 0 ? n : CTX - 1 - n);
    const int t = n - CTX; return b * SEQ + (d == 0 ? t : SEQ - 1 - t);
}
constexpr int SL = 72;
constexpr int SLOT_E = 64 * SL;
template <int LDA, int LDB>
__device__ __forceinline__ void mm64(const bf16_t* A, const bf16_t* B, f32x4 (&acc)[4], int wave, int fr, int fq) {
#pragma unroll
    for (int ks = 0; ks < 2; ++ks) {
        const bf16x8 af = *(const bf16x8*)(A + (wave * 16 + fr) * LDA + ks * 32 + fq * 8);
#pragma unroll
        for (int nt = 0; nt < 4; ++nt) {
            const bf16x8 bfv = *(const bf16x8*)(B + (nt * 16 + fr) * LDB + ks * 32 + fq * 8);
            acc[nt] = __builtin_amdgcn_mfma_f32_16x16x32_bf16(bfv, af, acc[nt], 0, 0, 0);
        }
    }
}
__device__ __forceinline__ void acc_zero(f32x4 (&acc)[4]) {
#pragma unroll
    for (int nt = 0; nt < 4; ++nt) acc[nt] = (f32x4){0.f, 0.f, 0.f, 0.f};
}
template <bool STRICT>
__device__ __forceinline__ void acc_mask(f32x4 (&acc)[4], int m, int fq) {
#pragma unroll
    for (int nt = 0; nt < 4; ++nt)
#pragma unroll
        for (int r = 0; r < 4; ++r) { const int n = nt * 16 + fq * 4 + r; const bool keep = STRICT ? (m < n) : (m <= n); if (!keep) acc[nt][r] = 0.f; }
}
__device__ __forceinline__ void st_rm(bf16_t* dst, const f32x4 (&acc)[4], int m, int fq) {
#pragma unroll
    for (int nt = 0; nt < 4; ++nt) store_bf16x4(dst + m * SL + nt * 16 + fq * 4, acc[nt]);
}
__device__ __forceinline__ void st_tr(bf16_t* dst, const f32x4 (&acc)[4], int m, int fq) {
#pragma unroll
    for (int nt = 0; nt < 4; ++nt)
#pragma unroll
        for (int r = 0; r < 4; ++r) dst[(nt * 16 + fq * 4 + r) * SL + m] = f2bf(acc[nt][r]);
}
__device__ __forceinline__ void ph_r1(const Params& p, int l, char* smem) {
    const int tid0 = tidx();
#define R1_IDX const int tid = lv(tid0), lane = tid & 63, wave = tid >> 6, fr = lane & 15, fq = lane >> 4, bi = tid >> 2, bq = (tid & 3) * 16, m = wave * 16 + fr; (void)bi; (void)bq; (void)m; (void)fq;
    const bf16_t* P = (const bf16_t*)(p.ws + O_P); const float* mu = p.in[I_MU] + l * 1792;
    const float* kkw = p.in[I_KK] + l * 512; const float* kaw = p.in[I_KA] + l * 512; const float* rkw = p.in[I_RK] + l * 512;
    const float* KKN = (const float*)(p.ws + O_X + X_KKN); float* BON = (float*)(p.ws + O_X + X_BON);
    bf16_t* gMT = (bf16_t*)(p.ws + O_X + X_MT); bf16_t* gNL = (bf16_t*)(p.ws + O_H);
    bf16_t* gGT = (bf16_t*)(p.ws + O_X + X_GT); bf16_t* gYL = (bf16_t*)(p.ws + O_X + X_YL);
    bf16_t* slot = (bf16_t*)smem;
    bf16_t* s0 = slot, *s1 = slot + SLOT_E, *s2 = slot + 2 * SLOT_E, *s3 = slot + 3 * SLOT_E;
    bf16_t* sa = slot + 4 * SLOT_E, *sb = slot + 5 * SLOT_E, *sc = slot + 6 * SLOT_E, *sT = slot + 7 * SLOT_E;
    float* misc = (float*)(smem + 8 * SLOT_E * 2);
    float* GAM = misc; float* SEG = misc + 64;
    float* ASIG = (float*)s0;
    float* LWS = (float*)s2;
    for (int it = blockIdx.x; it < NCP; it += gridDim.x) {
        const int c = it % 68, d = (it / 68) & 1, h = (it / 136) & 7, b = it / 1088;
        {
            R1_IDX const int rowb = scan_row(b, d, c * 64 + bi); (void)rowb;
            float o[8];
#pragma unroll
            for (int hh = 0; hh < 2; ++hh) {
                xs8(P, mu, rowb, 1536 + bq + hh * 8, o);
#pragma unroll
                for (int j = 0; j < 8; ++j) o[j] = 1.f - 2.f * __builtin_amdgcn_rcpf(1.f + __expf(2.f * o[j]));
                *(uint4*)(sa + bi * SL + bq + hh * 8) = pack8(o);
                xs8(P, mu, rowb, 1600 + bq + hh * 8, o);
                *(uint4*)(sb + bi * SL + bq + hh * 8) = pack8(o);
            }
        }
        __syncthreads();
        {
            R1_IDX const int rowb = scan_row(b, d, c * 64 + bi); (void)rowb;
            f32x4 acc[4];
            acc_zero(acc);
            mm64<SL, 64>(sa, (const bf16_t*)(p.ws + O_WB + W_WUP) + ((size_t)d * 512 + h * 64) * 64, acc, wave, fr, fq);
            const float* w0 = p.in[I_W0] + (l * 2 + d) * 512 + h * 64;
#pragma unroll
            for (int nt = 0; nt < 4; ++nt) {
                const int n = nt * 16 + fq * 4; float4 o; float* op = (float*)&o;
#pragma unroll
                for (int r = 0; r < 4; ++r) { const float z = w0[n + r] + acc[nt][r]; op[r] = -0.6065306597126334f * __builtin_amdgcn_rcpf(1.f + __expf(-z)); }
                *(float4*)(LWS + m * 68 + n) = o;
            }
            acc_zero(acc);
            mm64<SL, 64>(sb, (const bf16_t*)(p.ws + O_WB + W_AUP) + ((size_t)d * 512 + h * 64) * 64, acc, wave, fr, fq);
            const float* a0 = p.in[I_A0] + (l * 2 + d) * 512 + h * 64;
#pragma unroll
            for (int nt = 0; nt < 4; ++nt) {
                const int n = nt * 16 + fq * 4;
                *(float4*)(ASIG + m * 68 + n) = make_float4(__builtin_amdgcn_rcpf(1.f + __expf(-(a0[n] + acc[nt][0]))), __builtin_amdgcn_rcpf(1.f + __expf(-(a0[n + 1] + acc[nt][1]))), __builtin_amdgcn_rcpf(1.f + __expf(-(a0[n + 2] + acc[nt][2]))), __builtin_amdgcn_rcpf(1.f + __expf(-(a0[n + 3] + acc[nt][3]))));
            }
        }
        __syncthreads();
        {
            R1_IDX const int rowb = scan_row(b, d, c * 64 + bi); (void)rowb;
            const int k = tid & 63, seg = tid >> 6;
            float run = 0.f;
#pragma unroll
            for (int ii = 0; ii < 16; ++ii) { run += LWS[(seg * 16 + ii) * 68 + k]; LWS[(seg * 16 + ii) * 68 + k] = run; }
            SEG[seg * 64 + k] = run;
            __syncthreads();
            float off = 0.f;
#pragma unroll
            for (int sgi = 0; sgi < 3; ++sgi) if (sgi < seg) off += SEG[sgi * 64 + k];
#pragma unroll
            for (int ii = 0; ii < 16; ++ii) LWS[(seg * 16 + ii) * 68 + k] += off;
        }
        __syncthreads();
        {
            R1_IDX const int rowb = scan_row(b, d, c * 64 + bi); (void)rowb;
            float cs[16], cm[16], cc[16], ag[16];
#pragma unroll
            for (int q = 0; q < 4; ++q) {
                const float4 v0 = *(const float4*)(LWS + bi * 68 + bq + q * 4);
                const float4 v1 = bi > 0 ? *(const float4*)(LWS + (bi - 1) * 68 + bq + q * 4) : make_float4(0.f, 0.f, 0.f, 0.f);
                const float4 v2 = *(const float4*)(LWS + 63 * 68 + bq + q * 4);
                const float4 v3 = *(const float4*)(ASIG + bi * 68 + bq + q * 4);
                cs[q * 4] = v0.x; cs[q * 4 + 1] = v0.y; cs[q * 4 + 2] = v0.z; cs[q * 4 + 3] = v0.w;
                cm[q * 4] = v1.x; cm[q * 4 + 1] = v1.y; cm[q * 4 + 2] = v1.z; cm[q * 4 + 3] = v1.w;
                cc[q * 4] = v2.x; cc[q * 4 + 1] = v2.y; cc[q * 4 + 2] = v2.z; cc[q * 4 + 3] = v2.w;
                ag[q * 4] = v3.x; ag[q * 4 + 1] = v3.y; ag[q * 4 + 2] = v3.z; ag[q * 4 + 3] = v3.w;
            }
            __syncthreads();
            const float kkn = KKN[(size_t)rowb * 8 + h];
            float bon = 0.f;
#pragma unroll
            for (int hh = 0; hh < 2; ++hh) {
                float r8[8], k8[8], oa[8], ob[8], ok[8], orr[8];
                const int col = h * 64 + bq + hh * 8;
                xs8(P, mu, rowb, col, r8); xs8(P, mu, rowb, 512 + col, k8);
#pragma unroll
                for (int j = 0; j < 8; ++j) {
                    const int e = hh * 8 + j;
                    const float kk = k8[j] * kkw[col + j] * kkn;
                    const float kd = k8[j] * (1.f + (ag[e] - 1.f) * kaw[col + j]);
                    const float eneg = __expf(-cs[e]);
                    oa[j] = -kk * __expf(cm[e]); ob[j] = kk * ag[e] * eneg; ok[j] = kd * eneg; orr[j] = r8[j] * __builtin_amdgcn_rcpf(eneg);
                    bon += r8[j] * kd * rkw[col + j];
                }
                *(uint4*)(s0 + bi * SL + bq + hh * 8) = pack8(oa); *(uint4*)(s1 + bi * SL + bq + hh * 8) = pack8(ob);
                *(uint4*)(s2 + bi * SL + bq + hh * 8) = pack8(ok); *(uint4*)(s3 + bi * SL + bq + hh * 8) = pack8(orr);
            }
            bon += __shfl_xor(bon, 1); bon += __shfl_xor(bon, 2);
            if ((tid & 3) == 0) BON[((size_t)d * RT + rowb) * 8 + h] = bon;
            if (bi == 0) {
#pragma unroll
                for (int e = 0; e < 16; ++e) GAM[bq + e] = __expf(cc[e]);
            }
        }
        __syncthreads();
        {
            R1_IDX const int rowb = scan_row(b, d, c * 64 + bi); (void)rowb;
            f32x4 acc[4]; acc_zero(acc);
            mm64<SL, SL>(s1, s0, acc, wave, fr, fq);
            acc_mask<true>(acc, m, fq);
            st_rm(sa, acc, m, fq); st_tr(sb, acc, m, fq);
#pragma unroll
            for (int nt = 0; nt < 4; ++nt)
#pragma unroll
                for (int r = 0; r < 4; ++r) if (nt * 16 + fq * 4 + r == m) acc[nt][r] += 1.f;
            st_rm(sc, acc, m, fq);
        }
        __syncthreads();
#pragma unroll
        for (int itr = 0; itr < 5; ++itr) {
            R1_IDX
            bf16_t* ptr = (itr & 1) ? sT : sb;
            bf16_t* ptw = (itr & 1) ? sb : sT;
            f32x4 acc[4]; acc_zero(acc);
            mm64<SL, SL>(sa, ptr, acc, wave, fr, fq);
            st_rm(sa, acc, m, fq); st_tr(ptw, acc, m, fq);
            __syncthreads();
            f32x4 tacc[4];
#pragma unroll
            for (int nt = 0; nt < 4; ++nt) { const uint2 u = *(const uint2*)(sc + m * SL + nt * 16 + fq * 4); tacc[nt] = (f32x4){bflo(u.x), bfhi(u.x), bflo(u.y), bfhi(u.y)}; }
            mm64<SL, SL>(sc, ptw, tacc, wave, fr, fq);
            if (itr < 4) st_rm(sc, tacc, m, fq); else st_tr(sb, tacc, m, fq);
        }
        __syncthreads();
        {
            R1_IDX const int rowb = scan_row(b, d, c * 64 + bi); (void)rowb;
            f32x4 acc[4]; acc_zero(acc);
            mm64<SL, SL>(s2, s0, acc, wave, fr, fq);
            acc_mask<true>(acc, m, fq);
            st_rm(sa, acc, m, fq);
            float f0[8], f1[8];
            unpack8(*(const uint4*)(s0 + bi * SL + bq), f0); unpack8(*(const uint4*)(s0 + bi * SL + bq + 8), f1);
#pragma unroll
            for (int e = 0; e < 8; ++e) { sc[(bq + e) * SL + bi] = f2bf(f0[e]); sc[(bq + 8 + e) * SL + bi] = f2bf(f1[e]); }
        }
        __syncthreads();
        {
            R1_IDX const int rowb = scan_row(b, d, c * 64 + bi); (void)rowb;
            f32x4 acc[4]; acc_zero(acc);
            mm64<SL, SL>(sc, sb, acc, wave, fr, fq);
            st_rm(sT, acc, m, fq);
            acc_zero(acc);
            mm64<SL, SL>(sa, sb, acc, wave, fr, fq);
            st_rm(s0, acc, m, fq);
        }
        __syncthreads();
        f32x4 qacc[4];
        {
            R1_IDX const int rowb = scan_row(b, d, c * 64 + bi); (void)rowb;
            f32x4 acc[4]; acc_zero(acc);
            mm64<SL, SL>(s1, s3, acc, wave, fr, fq);
            acc_mask<false>(acc, m, fq);
            st_tr(sa, acc, m, fq);
            acc_zero(qacc);
            mm64<SL, SL>(s2, s3, qacc, wave, fr, fq);
            acc_mask<false>(qacc, m, fq);
            float f0[8], f1[8];
            unpack8(*(const uint4*)(s3 + bi * SL + bq), f0); unpack8(*(const uint4*)(s3 + bi * SL + bq + 8), f1);
#pragma unroll
            for (int e = 0; e < 8; ++e) { sc[(bq + e) * SL + bi] = f2bf(f0[e]); sc[(bq + 8 + e) * SL + bi] = f2bf(f1[e]); }
        }
        __syncthreads();
        {
            R1_IDX const int rowb = scan_row(b, d, c * 64 + bi); (void)rowb;
            f32x4 acc[4];
#pragma unroll
            for (int nt = 0; nt < 4; ++nt) { const uint2 u = *(const uint2*)(sc + m * SL + nt * 16 + fq * 4); acc[nt] = (f32x4){bflo(u.x), bfhi(u.x), bflo(u.y), bfhi(u.y)}; }
            mm64<SL, SL>(sT, sa, acc, wave, fr, fq);
            bf16_t* gt = gGT + (size_t)it * 4096;
#pragma unroll
            for (int nt = 0; nt < 4; ++nt)
#pragma unroll
                for (int r = 0; r < 4; ++r) gt[(nt * 16 + fq * 4 + r) * 64 + m] = f2bf(acc[nt][r]);
            mm64<SL, SL>(s0, sa, qacc, wave, fr, fq);
            st_tr(sb, qacc, m, fq);
            float f0[8], f1[8];
            unpack8(*(const uint4*)(s1 + bi * SL + bq), f0); unpack8(*(const uint4*)(s1 + bi * SL + bq + 8), f1);
#pragma unroll
            for (int e = 0; e < 8; ++e) { s3[(bq + e) * SL + bi] = f2bf(f0[e] * GAM[bq + e]); s3[(bq + 8 + e) * SL + bi] = f2bf(f1[e] * GAM[bq + 8 + e]); }
        }
        __syncthreads();
        {
            R1_IDX const int rowb = scan_row(b, d, c * 64 + bi); (void)rowb;
            f32x4 acc[4]; acc_zero(acc);
            mm64<SL, SL>(sT, s3, acc, wave, fr, fq);
            bf16_t* mt = gMT + (size_t)it * 4096;
#pragma unroll
            for (int nt = 0; nt < 4; ++nt)
#pragma unroll
                for (int r = 0; r < 4; ++r) { const int n = nt * 16 + fq * 4 + r; mt[n * 64 + m] = f2bf(acc[nt][r] + (n == m ? GAM[m] : 0.f)); }
#pragma unroll
            for (int nt = 0; nt < 4; ++nt) {
                const int n = nt * 16 + fq * 4; const uint2 u = *(const uint2*)(s2 + m * SL + n);
                acc[nt] = (f32x4){bflo(u.x) * GAM[n], bfhi(u.x) * GAM[n + 1], bflo(u.y) * GAM[n + 2], bfhi(u.y) * GAM[n + 3]};
            }
            mm64<SL, SL>(s0, s3, acc, wave, fr, fq);
            st_tr(s1, acc, m, fq);
            float v8[8];
#pragma unroll
            for (int hh = 0; hh < 2; ++hh) {
                xs8(P, mu, rowb, 1024 + h * 64 + bq + hh * 8, v8);
#pragma unroll
                for (int e = 0; e < 8; ++e) sc[(bq + hh * 8 + e) * SL + bi] = f2bf(v8[e]);
            }
        }
        __syncthreads();
        {
            R1_IDX const int rowb = scan_row(b, d, c * 64 + bi); (void)rowb;
            f32x4 acc[4]; acc_zero(acc);
            mm64<SL, SL>(sc, sb, acc, wave, fr, fq);
            bf16_t* yl = gYL + (size_t)it * 4096;
#pragma unroll
            for (int nt = 0; nt < 4; ++nt) store_bf16x4(yl + m * 64 + nt * 16 + fq * 4, acc[nt]);
            acc_zero(acc);
            mm64<SL, SL>(sc, s1, acc, wave, fr, fq);
            bf16_t* nl = gNL + (size_t)it * 4096;
#pragma unroll
            for (int nt = 0; nt < 4; ++nt) store_bf16x4(nl + m * 64 + nt * 16 + fq * 4, acc[nt]);
        }
        __syncthreads();
    }
}
__device__ __forceinline__ void ph_r2(const Params& p, char* smem) {
    const int tid = tidx(), lane = tid & 63, wave = tid >> 6, fr = lane & 15, fq = lane >> 4;
    const char* gMT = (const char*)(p.ws + O_X + X_MT); const char* gNL = (const char*)(p.ws + O_H);
    uint4* gS0 = (uint4*)(p.ws + O_X + X_S0);
    const int wofs = __builtin_amdgcn_readfirstlane(wave) * 1024;
    const unsigned lds0 = (unsigned)(uintptr_t)smem;
    const unsigned mtaddr = lds0 + fr * 128 + fq * 8, nladdr = lds0 + (wave * 16 + fr) * 128 + fq * 8;
    auto issue = [&](size_t cp, int slot) {
        char* dst = smem + slot * 16384 + wofs;
        const char* s0 = gMT + cp * 8192 + wofs + lane * 16; const char* s1 = gNL + cp * 8192 + wofs + lane * 16;
        __builtin_amdgcn_global_load_lds((const unsigned*)s0, (unsigned*)dst, 16, 0, 0);
        __builtin_amdgcn_global_load_lds((const unsigned*)(s0 + 4096), (unsigned*)(dst + 4096), 16, 0, 0);
        __builtin_amdgcn_global_load_lds((const unsigned*)s1, (unsigned*)(dst + 8192), 16, 0, 0);
        __builtin_amdgcn_global_load_lds((const unsigned*)(s1 + 4096), (unsigned*)(dst + 12288), 16, 0, 0);
    };
    for (int it = blockIdx.x; it < 64; it += gridDim.x) {
        f32x4 st[4];
#pragma unroll
        for (int tt = 0; tt < 4; ++tt) st[tt] = (f32x4){0.f, 0.f, 0.f, 0.f};
        const size_t cp0 = (size_t)it * 68;
        issue(cp0, 0); issue(cp0 + 1, 1); issue(cp0 + 2, 2);
        for (int c4 = 0; c4 < 68; c4 += 4) {
#pragma unroll
            for (int j = 0; j < 4; ++j) {
                const int c = c4 + j;
                if (c < 65) asm volatile("s_waitcnt vmcnt(8)" ::: "memory"); else asm volatile("s_waitcnt vmcnt(0)" ::: "memory");
                __builtin_amdgcn_s_barrier();
                asm volatile("" ::: "memory");
                uint2 mx[4][2][2], nvv[4];
                asm volatile("ds_read_b64 %0, %1 offset:0" : "=v"(mx[0][0][0]) : "v"(mtaddr + j * 16384));
                asm volatile("ds_read_b64 %0, %1 offset:32" : "=v"(mx[0][0][1]) : "v"(mtaddr + j * 16384));
                asm volatile("ds_read_b64 %0, %1 offset:64" : "=v"(mx[0][1][0]) : "v"(mtaddr + j * 16384));
                asm volatile("ds_read_b64 %0, %1 offset:96" : "=v"(mx[0][1][1]) : "v"(mtaddr + j * 16384));
                asm volatile("ds_read_b64 %0, %1 offset:8192" : "=v"(nvv[0]) : "v"(nladdr + j * 16384));
                asm volatile("ds_read_b64 %0, %1 offset:2048" : "=v"(mx[1][0][0]) : "v"(mtaddr + j * 16384));
                asm volatile("ds_read_b64 %0, %1 offset:2080" : "=v"(mx[1][0][1]) : "v"(mtaddr + j * 16384));
                asm volatile("ds_read_b64 %0, %1 offset:2112" : "=v"(mx[1][1][0]) : "v"(mtaddr + j * 16384));
                asm volatile("ds_read_b64 %0, %1 offset:2144" : "=v"(mx[1][1][1]) : "v"(mtaddr + j * 16384));
                asm volatile("ds_read_b64 %0, %1 offset:8224" : "=v"(nvv[1]) : "v"(nladdr + j * 16384));
                asm volatile("ds_read_b64 %0, %1 offset:4096" : "=v"(mx[2][0][0]) : "v"(mtaddr + j * 16384));
                asm volatile("ds_read_b64 %0, %1 offset:4128" : "=v"(mx[2][0][1]) : "v"(mtaddr + j * 16384));
                asm volatile("ds_read_b64 %0, %1 offset:4160" : "=v"(mx[2][1][0]) : "v"(mtaddr + j * 16384));
                asm volatile("ds_read_b64 %0, %1 offset:4192" : "=v"(mx[2][1][1]) : "v"(mtaddr + j * 16384));
                asm volatile("ds_read_b64 %0, %1 offset:8256" : "=v"(nvv[2]) : "v"(nladdr + j * 16384));
                asm volatile("ds_read_b64 %0, %1 offset:6144" : "=v"(mx[3][0][0]) : "v"(mtaddr + j * 16384));
                asm volatile("ds_read_b64 %0, %1 offset:6176" : "=v"(mx[3][0][1]) : "v"(mtaddr + j * 16384));
                asm volatile("ds_read_b64 %0, %1 offset:6208" : "=v"(mx[3][1][0]) : "v"(mtaddr + j * 16384));
                asm volatile("ds_read_b64 %0, %1 offset:6240" : "=v"(mx[3][1][1]) : "v"(mtaddr + j * 16384));
                asm volatile("ds_read_b64 %0, %1 offset:8288" : "=v"(nvv[3]) : "v"(nladdr + j * 16384));
                u32x4 sb[2];
#pragma unroll
                for (int s_ = 0; s_ < 2; ++s_) sb[s_] = (u32x4){pack2(st[2 * s_][0], st[2 * s_][1]), pack2(st[2 * s_][2], st[2 * s_][3]), pack2(st[2 * s_ + 1][0], st[2 * s_ + 1][1]), pack2(st[2 * s_ + 1][2], st[2 * s_ + 1][3])};
                asm volatile("s_waitcnt lgkmcnt(0)" ::: "memory");
                __builtin_amdgcn_sched_barrier(0);
#pragma unroll
                for (int tt = 0; tt < 4; ++tt) {
                    f32x4 acc = {bflo(nvv[tt].x), bfhi(nvv[tt].x), bflo(nvv[tt].y), bfhi(nvv[tt].y)};
#pragma unroll
                    for (int s_ = 0; s_ < 2; ++s_)
                        acc = __builtin_amdgcn_mfma_f32_16x16x32_bf16(__builtin_bit_cast(bf16x8, (u32x4){mx[tt][s_][0].x, mx[tt][s_][0].y, mx[tt][s_][1].x, mx[tt][s_][1].y}), __builtin_bit_cast(bf16x8, sb[s_]), acc, 0, 0, 0);
                    st[tt] = acc;
                }
                *(u32x4*)(gS0 + ((cp0 + c) * 4 + wave) * 128 + lane) = sb[0]; *(u32x4*)(gS0 + ((cp0 + c) * 4 + wave) * 128 + 64 + lane) = sb[1];
                if (c + 3 < 68) issue(cp0 + c + 3, (j + 3) & 3);
            }
        }
        asm volatile("s_waitcnt vmcnt(0)" ::: "memory");
        __syncthreads();
    }
}
__device__ __forceinline__ void ph_r3(const Params& p) {
    const int tid = tidx(), lane = tid & 63, wave = tid >> 6, fr = lane & 15, fq = lane >> 4;
    const bf16_t* gGT = (const bf16_t*)(p.ws + O_X + X_GT); const bf16_t* gYL = (const bf16_t*)(p.ws + O_X + X_YL);
    const u32x4* gS0 = (const u32x4*)(p.ws + O_X + X_S0);
    bf16_t* YS = (bf16_t*)(p.ws + O_H);
    for (int it = blockIdx.x * 4 + wave; it < NCP; it += gridDim.x * 4) {
        const int c = it % 68, d = (it / 68) & 1, h = (it / 136) & 7, b = it / 1088;
        const bf16_t* gt = gGT + (size_t)it * 4096; const bf16_t* yl = gYL + (size_t)it * 4096;
        u32x4 gf[4][2];
#pragma unroll
        for (int tt = 0; tt < 4; ++tt)
#pragma unroll
            for (int s_ = 0; s_ < 2; ++s_) {
                const bf16_t* q = gt + (tt * 16 + fr) * 64 + s_ * 32 + fq * 4;
                const uint2 a0 = *(const uint2*)q, a1 = *(const uint2*)(q + 16);
                gf[tt][s_] = (u32x4){a0.x, a0.y, a1.x, a1.y};
            }
#pragma unroll
        for (int vg = 0; vg < 4; ++vg) {
            const u32x4 sb0 = gS0[((size_t)it * 4 + vg) * 128 + lane], sb1 = gS0[((size_t)it * 4 + vg) * 128 + 64 + lane];
#pragma unroll
            for (int tt = 0; tt < 4; ++tt) {
                const uint2 yv = *(const uint2*)(yl + (vg * 16 + fr) * 64 + tt * 16 + fq * 4);
                f32x4 acc = {bflo(yv.x), bfhi(yv.x), bflo(yv.y), bfhi(yv.y)};
                acc = __builtin_amdgcn_mfma_f32_16x16x32_bf16(__builtin_bit_cast(bf16x8, gf[tt][0]), __builtin_bit_cast(bf16x8, sb0), acc, 0, 0, 0);
                acc = __builtin_amdgcn_mfma_f32_16x16x32_bf16(__builtin_bit_cast(bf16x8, gf[tt][1]), __builtin_bit_cast(bf16x8, sb1), acc, 0, 0, 0);
#pragma unroll
                for (int r = 0; r < 4; ++r) {
                    const int row = scan_row(b, d, c * 64 + tt * 16 + fq * 4 + r);
                    YS[((size_t)d * RT + row) * 512 + h * 64 + vg * 16 + fr] = f2bf(acc[r]);
                }
            }
        }
    }
}

__device__ __forceinline__ void ph_rpost(const Params& p, int l) {
    const int lane = tidx() & 63, wave = tidx() >> 6;
    const bf16_t* P = (const bf16_t*)(p.ws + O_P); const float* mu = p.in[I_MU] + l * 1792;
    const float* gng = p.in[I_GNG] + l * 512; const float* gnb = p.in[I_GNB] + l * 512;
    const float* BON = (const float*)(p.ws + O_X + X_BON); const bf16_t* YS = (const bf16_t*)(p.ws + O_H);
    const bf16_t* RG = (const bf16_t*)(p.ws + O_RG); bf16_t* RWO = (bf16_t*)(p.ws + O_RWO);
    for (int row = blockIdx.x * 4 + wave; row < RT; row += gridDim.x * 4) {
        const int col = lane * 8, h = lane >> 3;
        float v8[8], g8[8], y0[8], y1[8];
        xs8(P, mu, row, 1024 + col, v8);
        unpack8(*(const uint4*)(RG + (size_t)row * 512 + col), g8);
        unpack8(*(const uint4*)(YS + ((size_t)0 * RT + row) * 512 + col), y0);
        unpack8(*(const uint4*)(YS + ((size_t)1 * RT + row) * 512 + col), y1);
        const float bs = BON[((size_t)0 * RT + row) * 8 + h] + BON[((size_t)1 * RT + row) * 8 + h];
        float y[8]; float sm = 0.f;
#pragma unroll
        for (int j = 0; j < 8; ++j) { y[j] = y0[j] + y1[j]; sm += y[j]; }
        sm += __shfl_xor(sm, 1); sm += __shfl_xor(sm, 2); sm += __shfl_xor(sm, 4);
        const float mean = sm * (1.f / 64.f);
        float vs = 0.f;
#pragma unroll
        for (int j = 0; j < 8; ++j) { const float dlt = y[j] - mean; vs += dlt * dlt; }
        vs += __shfl_xor(vs, 1); vs += __shfl_xor(vs, 2); vs += __shfl_xor(vs, 4);
        const float rstd = rsqrtf(vs * (1.f / 64.f) + 64e-5f);
        float o[8];
#pragma unroll
        for (int j = 0; j < 8; ++j) o[j] = ((y[j] - mean) * rstd * gng[col + j] + gnb[col + j] + bs * v8[j]) * g8[j];
        *(uint4*)(RWO + (size_t)row * 512 + col) = pack8(o);
    }
}

__device__ __forceinline__ void ph_f1(const Params& p, int l, char* smem) {
    const bf16_t* P = (const bf16_t*)(p.ws + O_P); const bf16_t* CSC = (const bf16_t*)(p.ws + O_CSC);
    bf16_t* YT2 = (bf16_t*)(p.ws + O_YT2); bf16_t* YTC = (bf16_t*)(p.ws + O_YTC);
    const int nitems = 1024 + (l < NLAYER - 1 ? 64 : 0);
    for (int it = blockIdx.x; it < nitems; it += gridDim.x) {
        f32x4 acc[4][4];
        if (it < 1024) {
            const int b = it >> 8, g = (it >> 6) & 3, part = (it >> 5) & 1, j = it & 31;
            RPPlain rpa{CSC + (size_t)part * 128 * 128, 128};
            const bf16_t* pb = P + (size_t)b * SEQ * LDP + g * 128;
            auto rpb = [&](int r) -> const bf16_t* { return pb + (size_t)(64 * (r & 63) + 2 * j + (r >> 6)) * LDP; };
            gemm_core_gb<4>(rpa, rpb, 128, acc, smem);
            acc_foreach<4>(acc, [&](int m, int n, const f32x4& v) {
                const int t1 = n & 63, t2 = 2 * j + (n >> 6);
                store_bf16x4(YT2 + ((size_t)(b * 512 + g * 128 + m) * 64 + t2) * 128 + part * 64 + t1, v);
            });
        } else {
            const int jj = it - 1024, b = jj >> 4, g = (jj >> 2) & 3, part = (jj >> 1) & 1, nt = jj & 1;
            RPPlain rpa{CSC + (size_t)part * 128 * 128, 128};
            gemm_core_g<4>(rpa, P + (size_t)(RL + b * CTX + nt * 128) * LDP + g * 128, LDP, 128, acc, smem);
            acc_foreach<4>(acc, [&](int m, int n, const f32x4& v) {
                store_bf16x4(YTC + ((size_t)(b * 512 + g * 128 + m)) * 512 + part * 256 + nt * 128 + n, v);
            });
        }
    }
}
__device__ __forceinline__ void ph_fa(const Params& p, char* smem) {
    const bf16_t* YT2 = (const bf16_t*)(p.ws + O_YT2); const bf16_t* D128 = (const bf16_t*)(p.ws + O_D128);
    const float* TWC = (const float*)(p.ws + O_TWC); const float* TWS = (const float*)(p.ws + O_TWS);
    bf16_t* A2 = (bf16_t*)(p.ws + O_A2);
    for (int it = blockIdx.x; it < 1024; it += gridDim.x) {
        f32x4 acc[4][4];
        RPPlain rpa{D128, 128};
        gemm_core_g<4>(rpa, YT2 + (size_t)it * 128 * 128, 128, 128, acc, smem);
        const int lane = tidx() & 63, wave = tidx() >> 6, wr = wave >> 1, wc = wave & 1, fr = lane & 15, fq = lane >> 4;
        float* U = (float*)smem;
        if (wr == 1) {
#pragma unroll
            for (int i = 0; i < 4; ++i)
#pragma unroll
                for (int j = 0; j < 4; ++j) *(f32x4*)(U + (i * 16 + fr) * 132 + wc * 64 + j * 16 + fq * 4) = acc[i][j];
        }
        __syncthreads();
        if (wr == 0) {
#pragma unroll
            for (int i = 0; i < 4; ++i) {
                const int k1 = i * 16 + fr;
#pragma unroll
                for (int j = 0; j < 4; ++j) {
                    const int r = wc * 64 + j * 16 + fq * 4;
                    const int R = it * 128 + r, bn = R >> 6, t2 = R & 63, b = bn >> 9, n = bn & 511;
                    const f32x4 ai = *(const f32x4*)(U + k1 * 132 + r);
                    const f32x4 c = *(const f32x4*)(TWC + k1 * 64 + t2), sn = *(const f32x4*)(TWS + k1 * 64 + t2);
                    const f32x4 ar = acc[i][j];
                    const f32x4 pr = ar * c - ai * sn, pi = ar * sn + ai * c;
                    bf16_t* dst = A2 + ((size_t)(b * 64 + k1) * 512 + n) * 128 + t2;
                    store_bf16x4(dst, pr); store_bf16x4(dst + 64, pi);
                }
            }
        }
        __syncthreads();
    }
}
__device__ __forceinline__ void ph_fb(const Params& p, int l, char* smem) {
    const bf16_t* A2 = (const bf16_t*)(p.ws + O_A2); const bf16_t* E64 = (const bf16_t*)(p.ws + O_E64);
    const bf16_t* CST2 = (const bf16_t*)(p.ws + O_CST256); const bf16_t* YTC = (const bf16_t*)(p.ws + O_YTC);
    bf16_t* FA = (bf16_t*)(p.ws + O_FA);
    const int nitems = 1024 + (l < NLAYER - 1 ? 32 : 0);
    for (int it = blockIdx.x; it < nitems; it += gridDim.x) {
        if (it < 1024) {
            const int b = it >> 8, k1 = (it >> 2) & 63, nt = it & 3;
            f32x4 acc[2][4];
            RPPlain rpa{E64, 128};
            gemm_core_g<2>(rpa, A2 + ((size_t)(b * 64 + k1) * 512 + nt * 128) * 128, 128, 128, acc, smem);
            const float sc = 0.001381067932004975f;
            acc_foreach<2>(acc, [&](int m, int n, const f32x4& v) { f32x4 o = v * sc; store_bf16x4(FA + (size_t)(b * SEQ + k1 + 64 * m) * 512 + nt * 128 + n, o); });
        } else {
            const int j = it - 1024, b = j >> 3, mt = (j >> 2) & 1, nt = j & 3;
            f32x4 acc[4][4];
            RPPlain rp{CST2 + (size_t)mt * 128 * 512, 512};
            gemm_core_g<4>(rp, YTC + ((size_t)b * 512 + nt * 128) * 512, 512, 512, acc, smem);
            const float sc = 0.005524271728019903f;
            acc_foreach<4>(acc, [&](int m, int n, const f32x4& v) { f32x4 o = v * sc; store_bf16x4(FA + (size_t)(RL + b * CTX + mt * 128 + m) * 512 + nt * 128 + n, o); });
        }
    }
}

__device__ __forceinline__ void ph_mg(const Params& p, int l, char* smem) {
    const bf16_t* P = (const bf16_t*)(p.ws + O_P);
    const bf16_t* A0 = (const bf16_t*)(p.ws + O_FA); const bf16_t* A1 = (const bf16_t*)(p.ws + O_ATT); const bf16_t* A2 = (const bf16_t*)(p.ws + O_RWO);
    const bf16_t* W0 = (const bf16_t*)(p.ws + O_WB + W_PA); const bf16_t* W1 = (const bf16_t*)(p.ws + O_WB + W_PB); const bf16_t* W2 = (const bf16_t*)(p.ws + O_WB + W_PC);
    bf16_t* MG = (bf16_t*)(p.ws + O_H);
    const int nmt = (l < NLAYER - 1) ? RT / 64 : RL / 64;
    for (int it = blockIdx.x; it < nmt * 8; it += gridDim.x) {
        const int mt = it >> 3, nt = it & 7;
        f32x4 tot[2][4];
#pragma unroll
        for (int i = 0; i < 2; ++i)
#pragma unroll
            for (int j = 0; j < 4; ++j) tot[i][j] = (f32x4){0.f, 0.f, 0.f, 0.f};
#pragma unroll 1
        for (int br = 0; br < 3; ++br) {
            const bf16_t* Ab = br == 0 ? A0 : (br == 1 ? A1 : A2);
            const bf16_t* Wb = br == 0 ? W0 : (br == 1 ? W1 : W2);
            f32x4 acc[2][4];
            RPPlain rp{Ab + (size_t)mt * 64 * 512, 512};
            gemm_core_g<2>(rp, Wb + (size_t)nt * 128 * 512, 512, 512, acc, smem);
            const int lane = tidx() & 63, wave = tidx() >> 6, wr = wave >> 1, wc = wave & 1, fr = lane & 15, fq = lane >> 4;
#pragma unroll
            for (int i = 0; i < 2; ++i)
#pragma unroll
                for (int j = 0; j < 4; ++j) {
                    const int m = wr * 32 + i * 16 + fr, n = wc * 64 + j * 16 + fq * 4;
                    const uint2 gu = *(const uint2*)(P + (size_t)(mt * 64 + m) * LDP + PG0 + br * 1024 + nt * 128 + n);
                    tot[i][j][0] += bflo(gu.x) * acc[i][j][0]; tot[i][j][1] += bfhi(gu.x) * acc[i][j][1];
                    tot[i][j][2] += bflo(gu.y) * acc[i][j][2]; tot[i][j][3] += bfhi(gu.y) * acc[i][j][3];
                }
        }
        acc_foreach<2>(tot, [&](int m, int n, const f32x4& v) { store_bf16x4(MG + (size_t)(mt * 64 + m) * 1024 + nt * 128 + n, v); });
    }
}
__device__ __forceinline__ void ph_out(const Params& p, int l, char* smem) {
    const bf16_t* MG = (const bf16_t*)(p.ws + O_H); const bf16_t* W = (const bf16_t*)(p.ws + O_WB + W_OUT);
    float* xcur = (float*)(p.ws + O_XCUR); const float* mod = (const float*)(p.ws + O_MOD);
    const int nmt = (l < NLAYER - 1) ? RT / 64 : RL / 64;
    for (int it = blockIdx.x; it < nmt * 8; it += gridDim.x) {
        const int mt = it >> 3, nt = it & 7;
        f32x4 acc[2][4];
        RPPlain rp{MG + (size_t)mt * 64 * 1024, 1024};
        gemm_core_g<2>(rp, W + (size_t)nt * 128 * 1024, 1024, 1024, acc, smem);
        acc_foreach<2>(acc, [&](int m, int n, const f32x4& v) {
            const int row = mt * 64 + m, col = nt * 128 + n;
            const float4 g = *(const float4*)(mod + (size_t)(l * 5 + modidx(row)) * 6144 + 2048 + col);
            float4* xp = (float4*)(xcur + (size_t)row * 1024 + col);
            float4 x = *xp; x.x += g.x * v[0]; x.y += g.y * v[1]; x.z += g.z * v[2]; x.w += g.w * v[3]; *xp = x;
        });
    }
}

__device__ __forceinline__ void ph_n2(const Params& p, int l, char* smem) {
    const int tid = tidx(), lane = tid & 63, wave = tid >> 6;
    unsigned* lcnt = (unsigned*)smem;
    unsigned* gbase = lcnt + 16;
    int* rec = (int*)(smem + 256);
    float4* rwl = (float4*)(smem + 8192);
    for (int idx = tid; idx < 4096; idx += 256) {
        const int k = idx >> 2, pp = idx & 3;
        rwl[(((k >> 8) * 16 + (k & 3) * 4 + pp) << 6) + ((k & 255) >> 2)] = *(const float4*)(p.in[I_RW] + (size_t)k * 16 + pp * 4);
    }
    if (tid < 16) lcnt[tid] = 0u;
    __syncthreads();
    int nrec = 0;
    const float* xcur = (const float*)(p.ws + O_XCUR); const float* mod = (const float*)(p.ws + O_MOD);
    bf16_t* H = (bf16_t*)(p.ws + O_H);
    unsigned* cnt = (unsigned*)(p.ws + O_CNT); int* LTOK = (int*)(p.ws + O_LTOK); float* LW = (float*)(p.ws + O_LW); int* SLOT = (int*)(p.ws + O_SLOT);
    const float* g = p.in[I_N2G] + l * 1024; const float* rw = p.in[I_RW]; const float* rb = p.in[I_RB];
    const int nrows = (l < NLAYER - 1) ? RT : RL;
    float4 vn[4];
    {
        const int r0 = blockIdx.x * 4 + wave;
        const float* x0 = xcur + (size_t)(r0 < nrows ? r0 : 0) * 1024;
#pragma unroll
        for (int i = 0; i < 4; ++i) vn[i] = *(const float4*)(x0 + lane * 4 + 256 * i);
    }
    for (int row = blockIdx.x * 4 + wave; row < nrows; row += gridDim.x * 4) {
        const float* md = mod + (size_t)(l * 5 + modidx(row)) * 6144;
        float4 v[4]; float ss = 0.f;
#pragma unroll
        for (int i = 0; i < 4; ++i) { v[i] = vn[i]; ss += v[i].x * v[i].x + v[i].y * v[i].y + v[i].z * v[i].z + v[i].w * v[i].w; }
        {
            const int rn = row + gridDim.x * 4;
            const float* xn = xcur + (size_t)(rn < nrows ? rn : row) * 1024;
#pragma unroll
            for (int i = 0; i < 4; ++i) vn[i] = *(const float4*)(xn + lane * 4 + 256 * i);
        }
        ss = wsum(ss);
        const float rstd = rsqrtf(ss * (1.f / 1024.f) + 1e-6f);
        float lg[16];
#pragma unroll
        for (int e = 0; e < 16; ++e) lg[e] = 0.f;
#pragma unroll
        for (int i = 0; i < 4; ++i) {
            const int c = lane * 4 + 256 * i;
            const float4 gg = *(const float4*)(g + c), sc = *(const float4*)(md + 4096 + c), sh = *(const float4*)(md + 3072 + c);
            const float hv[4] = {v[i].x * rstd * gg.x * (1.f + sc.x) + sh.x, v[i].y * rstd * gg.y * (1.f + sc.y) + sh.y,
                                 v[i].z * rstd * gg.z * (1.f + sc.z) + sh.z, v[i].w * rstd * gg.w * (1.f + sc.w) + sh.w};
            f32x4 h4 = {hv[0], hv[1], hv[2], hv[3]};
            store_bf16x4(H + (size_t)row * 1024 + c, h4);
#pragma unroll
            for (int j = 0; j < 4; ++j) {
                const float4* wr_ = rwl + ((i * 16 + j * 4) << 6) + lane;
                const float4 w0 = wr_[0], w1 = wr_[64], w2 = wr_[128], w3 = wr_[192];
                lg[0] += hv[j] * w0.x; lg[1] += hv[j] * w0.y; lg[2] += hv[j] * w0.z; lg[3] += hv[j] * w0.w;
                lg[4] += hv[j] * w1.x; lg[5] += hv[j] * w1.y; lg[6] += hv[j] * w1.z; lg[7] += hv[j] * w1.w;
                lg[8] += hv[j] * w2.x; lg[9] += hv[j] * w2.y; lg[10] += hv[j] * w2.z; lg[11] += hv[j] * w2.w;
                lg[12] += hv[j] * w3.x; lg[13] += hv[j] * w3.y; lg[14] += hv[j] * w3.z; lg[15] += hv[j] * w3.w;
            }
        }
        float sc_[16], sel[16];
#pragma unroll
        for (int e = 0; e < 16; ++e) { lg[e] = wsum(lg[e]); sc_[e] = 1.f / (1.f + expf(-lg[e])); sel[e] = sc_[e] + rb[e]; }
        int best = 0; float bestv = -1e30f;
#pragma unroll
        for (int gi = 0; gi < 4; ++gi) {
            float m1 = -1e30f, m2 = -1e30f;
#pragma unroll
            for (int j = 0; j < 4; ++j) { const float s = sel[gi * 4 + j]; if (s > m1) { m2 = m1; m1 = s; } else if (s > m2) m2 = s; }
            const float gs = m1 + m2;
            if (gs > bestv) { bestv = gs; best = gi; }
        }
        float s4[4] = {0.f, 0.f, 0.f, 0.f}, c4[4] = {0.f, 0.f, 0.f, 0.f};
#pragma unroll
        for (int gi = 0; gi < 4; ++gi)
#pragma unroll
            for (int j = 0; j < 4; ++j) if (gi == best) { s4[j] = sel[gi * 4 + j]; c4[j] = sc_[gi * 4 + j]; }
        int i1 = 0; float v1 = s4[0], w1 = c4[0];
#pragma unroll
        for (int j = 1; j < 4; ++j) if (s4[j] > v1) { v1 = s4[j]; i1 = j; w1 = c4[j]; }
        int i2 = -1; float v2 = -1e30f, w2 = 0.f;
#pragma unroll
        for (int j = 0; j < 4; ++j) if (j != i1 && s4[j] > v2) { v2 = s4[j]; i2 = j; w2 = c4[j]; }
        if (lane == 0) {
            const float inv = 1.f / (w1 + w2);
            const int e1 = best * 4 + i1, e2 = best * 4 + i2;
            const unsigned r1 = atomicAdd(&lcnt[e1], 1u), r2 = atomicAdd(&lcnt[e2], 1u);
            int* rc = rec + (wave * 32 + nrec) * 8;
            rc[0] = row; rc[1] = e1; rc[2] = e2; rc[3] = (int)r1; rc[4] = (int)r2; rc[5] = __float_as_int(w1 * inv); rc[6] = __float_as_int(w2 * inv);
        }
        ++nrec;
    }
    __syncthreads();
    if (tid < 16) gbase[tid] = lcnt[tid] ? atomicAdd(&cnt[tid], lcnt[tid]) : 0u;
    __syncthreads();
    for (int i = lane; i < nrec; i += 64) {
        const int* rc = rec + (wave * 32 + i) * 8;
        const int row = rc[0], e1 = rc[1], e2 = rc[2];
        const unsigned p1 = gbase[e1] + (unsigned)rc[3], p2 = gbase[e2] + (unsigned)rc[4];
        LTOK[(size_t)e1 * RT + p1] = row; LW[(size_t)e1 * RT + p1] = __int_as_float(rc[5]);
        LTOK[(size_t)e2 * RT + p2] = row; LW[(size_t)e2 * RT + p2] = __int_as_float(rc[6]);
        SLOT[row * 2] = (e1 << 20) | (int)p1; SLOT[row * 2 + 1] = (e2 << 20) | (int)p2;
    }
}

struct MoeTiles { int tb[17]; int sm; };
__device__ __forceinline__ void moe_tiles(const Params& p, int l, int* s_tb) {
    if (tidx() == 0) {
        const unsigned* cnt = (const unsigned*)(p.ws + O_CNT);
        int a = 0;
        for (int e = 0; e < 16; ++e) { s_tb[e] = a; a += ((int)cnt[e] + 127) >> 7; }
        s_tb[16] = a;
    }
    __syncthreads();
}
__device__ __forceinline__ void ph_e1(const Params& p, int l, char* smem) {
    int* s_tb = (int*)(smem + 73728);
    moe_tiles(p, l, s_tb);
    const bf16_t* H = (const bf16_t*)(p.ws + O_H); bf16_t* ACT = (bf16_t*)(p.ws + O_P);
    const unsigned* cnt = (const unsigned*)(p.ws + O_CNT); const int* LTOK = (const int*)(p.ws + O_LTOK); const float* LW = (const float*)(p.ws + O_LW);
    const int sm = (l < NLAYER - 1) ? RT / 128 : RL / 128;
    const int total = (sm + s_tb[16]) * 8;
    for (int it = blockIdx.x; it < total; it += gridDim.x) {
        const int mt = it >> 3, nt = it & 7;
        int e = 16, erow0 = mt * 128, lt = 0;
        if (mt >= sm) { const int q = mt - sm; e = 0; while (q >= s_tb[e + 1]) ++e; lt = q - s_tb[e]; erow0 = RT + q * 128; }
        const int cnte = (e == 16) ? 0 : (int)cnt[e];
        auto rp = [&](int r) -> const bf16_t* {
            if (e == 16) return H + (size_t)(mt * 128 + r) * 1024;
            const int idx = lt * 128 + r;
            const int tok = idx < cnte ? LTOK[(size_t)e * RT + idx] : 0;
            return H + (size_t)tok * 1024;
        };
        f32x4 acc[4][4];
        gemm_core_g<4>(rp, (const bf16_t*)(p.ws + O_WB + W_GU) + (size_t)e * 1024 * 1024 + (size_t)nt * 128 * 1024, 1024, 1024, acc, smem);
        {
            const int lane = tidx() & 63, wave = tidx() >> 6, wr = wave >> 1, wc = wave & 1, fr = lane & 15, fq = lane >> 4;
            float* U = (float*)smem;
            if (wc == 1) {
#pragma unroll
                for (int i = 0; i < 4; ++i)
#pragma unroll
                    for (int j = 0; j < 4; ++j) *(f32x4*)(U + (wr * 64 + i * 16 + fr) * 68 + j * 16 + fq * 4) = acc[i][j];
            }
            __syncthreads();
            if (wc == 0) {
#pragma unroll
                for (int i = 0; i < 4; ++i) {
                    const int m = wr * 64 + i * 16 + fr;
                    float wgt = 1.f;
                    if (e != 16) { const int idx = lt * 128 + m; wgt = idx < cnte ? LW[(size_t)e * RT + idx] : 0.f; }
#pragma unroll
                    for (int j = 0; j < 4; ++j) {
                        const f32x4 u = *(const f32x4*)(U + m * 68 + j * 16 + fq * 4);
                        f32x4 o;
#pragma unroll
                        for (int r = 0; r < 4; ++r) o[r] = siluf_(acc[i][j][r]) * u[r] * wgt;
                        store_bf16x4(ACT + (size_t)(erow0 + m) * 512 + nt * 64 + j * 16 + fq * 4, o);
                    }
                }
            }
            __syncthreads();
        }
    }
}
__device__ __forceinline__ void ph_e2(const Params& p, int l, char* smem) {
    int* s_tb = (int*)(smem + 73728);
    moe_tiles(p, l, s_tb);
    const bf16_t* ACT = (const bf16_t*)(p.ws + O_P); bf16_t* YE = (bf16_t*)(p.ws + O_X + X_YE);
    const int sm = (l < NLAYER - 1) ? RT / 128 : RL / 128;
    const int total = (sm + s_tb[16]) * 8;
    for (int it = blockIdx.x; it < total; it += gridDim.x) {
        const int mt = it >> 3, nt = it & 7;
        int e = 16, erow0 = mt * 128;
        if (mt >= sm) { const int q = mt - sm; e = 0; while (q >= s_tb[e + 1]) ++e; erow0 = RT + q * 128; }
        RPPlain rp{ACT + (size_t)erow0 * 512, 512};
        f32x4 acc[4][4];
        gemm_core_g<4>(rp, (const bf16_t*)(p.ws + O_WB + W_D) + (size_t)e * 1024 * 512 + (size_t)nt * 128 * 512, 512, 512, acc, smem);
        acc_foreach<4>(acc, [&](int m, int n, const f32x4& v) { store_bf16x4(YE + (size_t)(erow0 + m) * 1024 + nt * 128 + n, v); });
    }
}
__device__ __forceinline__ void ph_e3(const Params& p, int l, char* smem) {
    int* s_tb = (int*)(smem + 73728);
    moe_tiles(p, l, s_tb);
    const int lane = tidx() & 63, wave = tidx() >> 6;
    const bf16_t* YE = (const bf16_t*)(p.ws + O_X + X_YE); const int* SLOT = (const int*)(p.ws + O_SLOT);
    float* xcur = (float*)(p.ws + O_XCUR); const float* mod = (const float*)(p.ws + O_MOD);
    bf16_t* H = (bf16_t*)(p.ws + O_H);
    const bool last = l == NLAYER - 1;
    const int nrows = last ? RL : RT;
    const float* gn = last ? p.in[I_FNG] : p.in[I_N1G] + (l + 1) * 1024;
    const int stride = gridDim.x * 4, row0 = blockIdx.x * 4 + wave;
    auto slot_rows = [&](int row, size_t& r1, size_t& r2) {
        const int rr = row < nrows ? row : 0;
        const int s1 = SLOT[rr * 2], s2 = SLOT[rr * 2 + 1];
        r1 = (size_t)RT + s_tb[s1 >> 20] * 128 + (s1 & 0xfffff); r2 = (size_t)RT + s_tb[s2 >> 20] * 128 + (s2 & 0xfffff);
    };
    uint4 ya[2], yb[2], yd[2]; float4 xa[2][2];
    size_t r1n, r2n;
    auto load_row = [&](int row, size_t r1, size_t r2) {
        const size_t rr = row < nrows ? row : 0;
#pragma unroll
        for (int i = 0; i < 2; ++i) {
            const int c = lane * 8 + 512 * i;
            ya[i] = *(const uint4*)(YE + rr * 1024 + c); yb[i] = *(const uint4*)(YE + r1 * 1024 + c); yd[i] = *(const uint4*)(YE + r2 * 1024 + c);
            const float4* xp = (const float4*)(xcur + rr * 1024 + c);
            xa[i][0] = xp[0]; xa[i][1] = xp[1];
        }
    };
    { size_t r1, r2; slot_rows(row0, r1, r2); load_row(row0, r1, r2); slot_rows(row0 + stride, r1n, r2n); }
    for (int row = row0; row < nrows; row += stride) {
        const float* g2 = mod + (size_t)(l * 5 + modidx(row)) * 6144 + 5120;
        float xv[2][8]; float ss = 0.f;
#pragma unroll
        for (int i = 0; i < 2; ++i) {
            const int c = lane * 8 + 512 * i;
            float a[8], b[8], d[8];
            unpack8(ya[i], a); unpack8(yb[i], b); unpack8(yd[i], d);
            const float4 x0 = xa[i][0], x1 = xa[i][1];
            const float4 ga = *(const float4*)(g2 + c), gb = *(const float4*)(g2 + c + 4);
            const float xo[8] = {x0.x, x0.y, x0.z, x0.w, x1.x, x1.y, x1.z, x1.w}, gg[8] = {ga.x, ga.y, ga.z, ga.w, gb.x, gb.y, gb.z, gb.w};
#pragma unroll
            for (int e = 0; e < 8; ++e) { xv[i][e] = xo[e] + gg[e] * (a[e] + b[e] + d[e]); ss += xv[i][e] * xv[i][e]; }
            if (!last) { float4* xp = (float4*)(xcur + (size_t)row * 1024 + c); xp[0] = make_float4(xv[i][0], xv[i][1], xv[i][2], xv[i][3]); xp[1] = make_float4(xv[i][4], xv[i][5], xv[i][6], xv[i][7]); }
        }
        { const size_t r1 = r1n, r2 = r2n; load_row(row + stride, r1, r2); slot_rows(row + 2 * stride, r1n, r2n); }
        ss = wsum(ss);
        const float rstd = rsqrtf(ss * (1.f / 1024.f) + 1e-6f);
        const float* md = mod + (size_t)((l + 1) * 5 + modidx(row)) * 6144;
#pragma unroll
        for (int i = 0; i < 2; ++i) {
            const int c = lane * 8 + 512 * i;
            const float4 n0 = *(const float4*)(gn + c), n1 = *(const float4*)(gn + c + 4);
            const float nn[8] = {n0.x, n0.y, n0.z, n0.w, n1.x, n1.y, n1.z, n1.w};
            if (last) {
                float* op = p.out + (size_t)row * 1024 + c;
                *(float4*)op = make_float4(xv[i][0] * rstd * nn[0], xv[i][1] * rstd * nn[1], xv[i][2] * rstd * nn[2], xv[i][3] * rstd * nn[3]);
                *(float4*)(op + 4) = make_float4(xv[i][4] * rstd * nn[4], xv[i][5] * rstd * nn[5], xv[i][6] * rstd * nn[6], xv[i][7] * rstd * nn[7]);
            } else {
                const float4 c0 = *(const float4*)(md + 1024 + c), c1 = *(const float4*)(md + 1024 + c + 4), h0 = *(const float4*)(md + c), h1 = *(const float4*)(md + c + 4);
                const float sc[8] = {c0.x, c0.y, c0.z, c0.w, c1.x, c1.y, c1.z, c1.w}, sh[8] = {h0.x, h0.y, h0.z, h0.w, h1.x, h1.y, h1.z, h1.w};
                float o[8];
#pragma unroll
                for (int e = 0; e < 8; ++e) o[e] = xv[i][e] * rstd * nn[e] * (1.f + sc[e]) + sh[e];
                *(uint4*)(H + (size_t)row * 1024 + c) = pack8(o);
            }
        }
    }
}
constexpr int LDS_BYTES = 76800;
constexpr int NIV = 19;
extern __shared__ __attribute__((aligned(16))) char dynsmem[];
template <int ID> __device__ __forceinline__ void run_iv(const Params& pin, int l, char* smem) {
    Params p = pin; p.ws = launder(pin.ws);
    if constexpr (ID == 0) { ph_pre(p, smem); __syncthreads(); ph_w(p, 0, smem); }
    else if constexpr (ID == 1) ph_n1(p, l);
    else if constexpr (ID == 2) ph_g1(p, smem);
    else if constexpr (ID == 3) { ph_qu(p, smem); ph_rp1(p, l, smem); ph_rp2(p, l); ph_f1(p, l, smem); }
    else if constexpr (ID == 4) ph_m2(p, smem);
    else if constexpr (ID == 5) {
        const bool r1first = (blockIdx.x >> 8) & 1;
#pragma unroll 1
        for (int pass = 0; pass < 2; ++pass) {
            if ((pass == 0) == r1first) { ph_r1(p, l, smem); ph_fa(p, smem); } else ph_at(p, l, smem);
            __syncthreads();
        }
    }
    else if constexpr (ID == 8) { ph_r2(p, smem); __syncthreads(); ph_fb(p, l, smem); }
    else if constexpr (ID == 9) ph_r3(p);
    else if constexpr (ID == 10) ph_rpost(p, l);
    else if constexpr (ID == 12) ph_mg(p, l, smem);
    else if constexpr (ID == 13) ph_out(p, l, smem);
    else if constexpr (ID == 14) ph_n2(p, l, smem);
    else if constexpr (ID == 15) ph_e1(p, l, smem);
    else if constexpr (ID == 16) ph_e2(p, l, smem);
    else if constexpr (ID == 17) { ph_e3(p, l, smem); __syncthreads(); if (l + 1 < NLAYER) ph_w(p, l + 1, smem); }
}
#if MEGA
#ifndef PROBE_MASK
#define PROBE_MASK 0
#define PROBE_REP 1
#endif
#define IV(ID) for (int r_ = 0; r_ < (((PROBE_MASK >> (ID)) & 1) ? PROBE_REP : 1); ++r_) { run_iv<ID>(p, l, smem); xcd_barrier(bar); }
__global__ void __launch_bounds__(256, 2) k_mega(Params p) {
    char* smem = dynsmem;
    volatile LAS unsigned* st = (volatile LAS unsigned*)(smem + LDS_BYTES - 16);
    if (tidx() == 0) { st[0] = 0u; st[1] = 0u; }
    __syncthreads();
    XcdBarrier bar = xcd_barrier_post((unsigned*)(p.ws + O_BAR), st);
    { const int l = 0; IV(0) }
    for (int l = 0; l < NLAYER; ++l) {
        if (l == 0) { IV(1) } IV(2) IV(3) IV(4) IV(5) IV(8) IV(9) IV(10) IV(12) IV(13) IV(14) IV(15) IV(16) IV(17)
    }
}
#else
template <int ID> __global__ void __launch_bounds__(256, 2) k_iv(Params p, int l) { run_iv<ID>(p, l, dynsmem); }
template <int ID> static void launch_iv(const Params& p, int l, int grid, hipStream_t s) {
    static bool once = false; if (!once) { once = true; (void)hipFuncSetAttribute((const void*)k_iv<ID>, hipFuncAttributeMaxDynamicSharedMemorySize, LDS_BYTES); }
    hipLaunchKernelGGL(k_iv<ID>, dim3(grid), dim3(256), LDS_BYTES, s, p, l);
}
#endif

extern "C" void kernel_launch(void* const* d_in, const int* in_sizes, int n_in, void* d_out, int out_size, void* d_ws, size_t ws_size, hipStream_t stream) {
    (void)in_sizes; (void)out_size;
    if (n_in < N_IN || ws_size < WS_NEED) return;
    Params p{};
    for (int i = 0; i < N_IN; ++i) p.in[i] = (const float*)d_in[i];
    p.out = (float*)d_out; p.ws = (char*)d_ws;
    static int grid = 0;
    if (!grid) {
        int dev = 0, cus = 0; (void)hipGetDevice(&dev); (void)hipDeviceGetAttribute(&cus, hipDeviceAttributeMultiprocessorCount, dev);
        int per_cu = 2;
#if MEGA
        (void)hipFuncSetAttribute((const void*)k_mega, hipFuncAttributeMaxDynamicSharedMemorySize, LDS_BYTES);
        int occ = 0; (void)hipOccupancyMaxActiveBlocksPerMultiprocessor(&occ, k_mega, 256, LDS_BYTES);
        if (occ < per_cu) per_cu = occ;
        if (per_cu < 1) per_cu = 1;
#endif
        grid = cus * per_cu;
    }
#if MEGA
    (void)hipMemsetAsync(p.ws + O_BAR, 0, 16384, stream);
    hipLaunchKernelGGL(k_mega, dim3(grid), dim3(256), LDS_BYTES, stream, p);
#else
    launch_iv<0>(p, 0, grid, stream);
    for (int l = 0; l < NLAYER; ++l) {
        if (l == 0) launch_iv<1>(p, l, grid, stream); launch_iv<2>(p, l, grid, stream); launch_iv<3>(p, l, grid, stream); launch_iv<4>(p, l, grid, stream);
        launch_iv<5>(p, l, grid, stream); launch_iv<8>(p, l, grid, stream);
        launch_iv<9>(p, l, grid, stream); launch_iv<10>(p, l, grid, stream); launch_iv<12>(p, l, grid, stream);
        launch_iv<13>(p, l, grid, stream); launch_iv<14>(p, l, grid, stream); launch_iv<15>(p, l, grid, stream); launch_iv<16>(p, l, grid, stream); launch_iv<17>(p, l, grid, stream);
    }
#endif
}
```

```cpp
#include <hip/hip_runtime.h>
#include <stdint.h>

#ifndef MEGA
#define MEGA 1
#endif

typedef unsigned short bf16_t;
typedef short bf16x8 __attribute__((ext_vector_type(8)));
typedef float f32x4 __attribute__((ext_vector_type(4)));
typedef float f32x2 __attribute__((ext_vector_type(2)));
typedef unsigned u32x4 __attribute__((ext_vector_type(4)));
typedef __bf16 bf16v2 __attribute__((ext_vector_type(2)));

constexpr int NLAYER = 4;
constexpr int DM = 1024;
constexpr int RL = 16384, RC = 1024, RT = RL + RC;
constexpr int SEQ = 4096, CTX = 256, KEYS = SEQ + CTX;
constexpr int LDP = 6144;
constexpr int PQ0 = 512, PKV0 = 896, PKR0 = 1152, PR0 = 1184, PG0 = 2976, PEND = 6048;
constexpr int NEXP = 16;
constexpr int EROWS = 54272;

enum { I_X = 0, I_C, I_CTX, I_CCTX, I_WADA, I_BADA, I_N1G, I_N2G, I_WIN, I_QNG, I_KVNG, I_WUQ, I_WUKV, I_MU, I_W0, I_WUP, I_A0, I_AUP, I_GUP,
       I_KK, I_KA, I_RK, I_GNG, I_GNB, I_WPA, I_WPB, I_WPC, I_WOUT, I_RW, I_RB, I_EG, I_EU, I_ED, I_SG, I_SU, I_SD, I_FNG, N_IN };

struct Params { const float* in[N_IN]; float* out; char* ws; };

constexpr size_t al256(size_t x) { return (x + 255) & ~(size_t)255; }
constexpr size_t O_BAR   = 0;
constexpr size_t O_CNT   = O_BAR + 16384;
constexpr size_t O_MOD   = O_CNT + 4096;
constexpr size_t O_ROPEC = O_MOD + (size_t)NLAYER * 5 * 6144 * 4;
constexpr size_t O_ROPES = O_ROPEC + (size_t)SEQ * 16 * 4;
constexpr size_t O_CSC   = O_ROPES + (size_t)SEQ * 16 * 4;
constexpr size_t O_CST256= O_CSC + 256 * 128 * 2;
constexpr size_t O_D128  = O_CST256 + 256 * 512 * 2;
constexpr size_t O_E64   = O_D128 + 128 * 128 * 2;
constexpr size_t O_TWC   = O_E64 + 64 * 128 * 2;
constexpr size_t O_TWS   = O_TWC + 64 * 64 * 4;
constexpr size_t O_YT2   = O_TWS + 64 * 64 * 4;
constexpr size_t O_A2    = O_YT2 + (size_t)4 * 512 * 64 * 128 * 2;
constexpr size_t O_YTC   = O_A2 + (size_t)4 * 512 * 64 * 128 * 2;
constexpr size_t O_XCUR  = O_YTC + (size_t)4 * 512 * 512 * 2;
constexpr size_t O_WB    = O_XCUR + (size_t)RT * DM * 4;
constexpr size_t W_IN   = 0;
constexpr size_t W_UQ   = W_IN + (size_t)6144 * 1024 * 2;
constexpr size_t W_UKV  = W_UQ + (size_t)768 * 384 * 2;
constexpr size_t W_WUP  = W_UKV + (size_t)1024 * 256 * 2;
constexpr size_t W_AUP  = W_WUP + (size_t)2 * 512 * 64 * 2;
constexpr size_t W_GUP  = W_AUP + (size_t)2 * 512 * 64 * 2;
constexpr size_t W_PA   = W_GUP + (size_t)512 * 128 * 2;
constexpr size_t W_PB   = W_PA + (size_t)1024 * 512 * 2;
constexpr size_t W_PC   = W_PB + (size_t)1024 * 512 * 2;
constexpr size_t W_OUT  = W_PC + (size_t)1024 * 512 * 2;
constexpr size_t W_GU   = W_OUT + (size_t)1024 * 1024 * 2;
constexpr size_t W_D    = W_GU + (size_t)17 * 1024 * 1024 * 2;
constexpr size_t W_END  = W_D + (size_t)17 * 1024 * 512 * 2;
constexpr size_t O_H    = O_WB + W_END;
constexpr size_t O_P    = O_H + (size_t)RT * DM * 2;
constexpr size_t O_ATT  = O_P + (size_t)RT * LDP * 2;
constexpr size_t O_RG   = O_ATT + (size_t)RT * 512 * 2;
constexpr size_t O_RWO  = O_RG + (size_t)RT * 512 * 2;
constexpr size_t O_FA   = O_RWO + (size_t)RT * 512 * 2;
constexpr size_t O_LTOK = O_FA + (size_t)RT * 512 * 2;
constexpr size_t O_LW   = O_LTOK + (size_t)NEXP * RT * 4;
constexpr size_t O_SLOT = O_LW + (size_t)NEXP * RT * 4;
constexpr size_t O_X    = al256(O_SLOT + (size_t)RT * 2 * 4);
constexpr size_t X_QA   = 0;
constexpr size_t X_KA   = X_QA + (size_t)RT * 768 * 2;
constexpr size_t X_VA   = X_KA + (size_t)4 * KEYS * 768 * 2;
constexpr int NCP = 4 * 8 * 2 * 68;
constexpr size_t X_S0   = 0;
constexpr size_t X_MT   = X_VA + (size_t)4 * 8 * 64 * KEYS * 2;
constexpr size_t X_GT   = X_MT + (size_t)NCP * 8192;
constexpr size_t X_YL   = X_GT + (size_t)NCP * 8192;
constexpr size_t X_QRAW = X_MT;
constexpr size_t X_KVRAW= X_QRAW + (size_t)RT * 768 * 2;
constexpr size_t X_KKN  = X_YL + (size_t)NCP * 8192;
constexpr size_t X_BON  = X_KKN + (size_t)RT * 8 * 4;
constexpr size_t X_END  = X_BON + (size_t)2 * RT * 8 * 4;
static_assert(X_KVRAW + (size_t)RT * 1024 * 2 <= X_YL + (size_t)NCP * 8192, "raw q/kv must fit under the chunk data");
static_assert(X_S0 + (size_t)NCP * 8192 <= X_VA, "S0 must fit in the q/k area");
constexpr size_t X_YE   = 0;
constexpr size_t WS_NEED = O_X + X_END;

__device__ __forceinline__ float bf2f(bf16_t u) { return __builtin_bit_cast(float, (unsigned)u << 16); }
__device__ __forceinline__ float bflo(unsigned u) { return __builtin_bit_cast(float, u << 16); }
__device__ __forceinline__ float bfhi(unsigned u) { return __builtin_bit_cast(float, u & 0xffff0000u); }
__device__ __forceinline__ unsigned pack2(float lo, float hi) { f32x2 v = {lo, hi}; bf16v2 b = __builtin_convertvector(v, bf16v2); return __builtin_bit_cast(unsigned, b); }
__device__ __forceinline__ bf16_t f2bf(float f) { return (bf16_t)(pack2(f, 0.f) & 0xffffu); }
__device__ __forceinline__ float wsum(float v) {
#pragma unroll
    for (int o = 32; o > 0; o >>= 1) v += __shfl_xor(v, o);
    return v;
}
__device__ __forceinline__ float sigmoidf_(float x) { return 1.f / (1.f + __expf(-x)); }
__device__ __forceinline__ float siluf_(float x) { return x / (1.f + __expf(-x)); }
__device__ __forceinline__ int modidx(int row) { return row < RL ? (row >> 12) : 4; }
__device__ __forceinline__ void unpack8(const uint4& u, float (&f)[8]) {
    f[0] = bflo(u.x); f[1] = bfhi(u.x); f[2] = bflo(u.y); f[3] = bfhi(u.y); f[4] = bflo(u.z); f[5] = bfhi(u.z); f[6] = bflo(u.w); f[7] = bfhi(u.w);
}
__device__ __forceinline__ uint4 pack8(const float (&f)[8]) { return make_uint4(pack2(f[0], f[1]), pack2(f[2], f[3]), pack2(f[4], f[5]), pack2(f[6], f[7])); }

#define XB_TMO      128
#define XB_XCNT(j)  (256  + 64 * (j))
#define XB_XSUB(j)  (1280 + 64 * (j))
#define XB_XGEN(j)  (2304 + 64 * (j))
#define XB_TOP      3328
#define XB_TOPGEN   3392
#define XCD_BAR_WORDS 3456
#define XB_SPIN_CAP (1u << 22)
#define LAS __attribute__((address_space(3)))
__device__ __forceinline__ unsigned xb_ld(unsigned* p)              { return __hip_atomic_load(p, __ATOMIC_RELAXED, __HIP_MEMORY_SCOPE_AGENT); }
__device__ __forceinline__ unsigned xb_add(unsigned* p, unsigned v) { return __hip_atomic_fetch_add(p, v, __ATOMIC_RELAXED, __HIP_MEMORY_SCOPE_AGENT); }
__device__ __forceinline__ unsigned xb_xcc_id() { return (unsigned)__builtin_amdgcn_s_getreg((3 << 11) | 20) & 0xFu; }
#define XB_SPIN(cond, bar) do { unsigned _sp = 0; while (cond) { __builtin_amdgcn_s_sleep(1); \
    if ((++_sp & 255u) == 0u) { if (xb_ld(&(bar)[XB_TMO])) break; if (_sp > XB_SPIN_CAP) { atomicAdd(&(bar)[XB_TMO], 1u); break; } } } } while (0)
struct XcdBarrier { unsigned* bar; unsigned x; volatile LAS unsigned* st; };
__device__ __forceinline__ XcdBarrier xcd_barrier_post(unsigned* bar, volatile LAS unsigned* st) {
    XcdBarrier b; b.bar = bar; b.x = xb_xcc_id(); b.st = st;
    if (threadIdx.x == 0) (void)xb_add(&bar[XB_XCNT(b.x)], 1u);
    return b;
}
__device__ __forceinline__ void xcd_barrier_complete(unsigned* bar, unsigned x, unsigned& nloc, unsigned& nx) {
    const unsigned G = gridDim.x * gridDim.y * gridDim.z;
    unsigned sum, cnt, mine, sp = 0u;
    for (;;) {
        sum = 0u; cnt = 0u; mine = 0u;
#pragma unroll
        for (unsigned j = 0; j < 16; ++j) { const unsigned c = xb_ld(&bar[XB_XCNT(j)]); sum += c; cnt += (c > 0u) ? 1u : 0u; mine = (j == x) ? c : mine; }
        if (sum == G) break;
        __builtin_amdgcn_s_sleep(1);
        if ((++sp & 255u) == 0u) { if (xb_ld(&bar[XB_TMO])) break; if (sp > XB_SPIN_CAP) { atomicAdd(&bar[XB_TMO], 1u); break; } }
    }
    nloc = mine > 0u ? mine : 1u; nx = cnt > 0u ? cnt : 1u;
}
__device__ __forceinline__ void xcd_barrier(const XcdBarrier& b) {
    asm volatile("s_waitcnt vmcnt(0)" ::: "memory");
    __syncthreads();
    if (threadIdx.x == 0) {
        unsigned* bar = b.bar;
        __builtin_amdgcn_s_waitcnt(0);
        unsigned nloc = b.st[0], nx = b.st[1];
        if (nloc == 0u) { xcd_barrier_complete(bar, b.x, nloc, nx); b.st[0] = nloc; b.st[1] = nx; }
        const unsigned old = xb_add(&bar[XB_XSUB(b.x)], 1u);
        const unsigned gen = old / nloc;
        if (old + 1u == (gen + 1u) * nloc) {
            __builtin_amdgcn_fence(__ATOMIC_RELEASE, "agent");
            asm volatile("s_waitcnt vmcnt(0)" ::: "memory");
            const unsigned og = xb_add(&bar[XB_TOP], 1u);
            const unsigned tg = og / nx;
            if (og + 1u == (tg + 1u) * nx) xb_add(&bar[XB_TOPGEN], 1u);
            else XB_SPIN(xb_ld(&bar[XB_TOPGEN]) == tg, bar);
            __builtin_amdgcn_fence(__ATOMIC_ACQUIRE, "agent");
            xb_add(&bar[XB_XGEN(b.x)], 1u);
            asm volatile("s_waitcnt vmcnt(0)" ::: "memory");
        } else {
            XB_SPIN(xb_ld(&bar[XB_XGEN(b.x)]) == gen, bar);
            __builtin_amdgcn_fence(__ATOMIC_ACQUIRE, "agent");
            asm volatile("s_waitcnt vmcnt(0)" ::: "memory");
        }
    }
    __syncthreads();
}

__device__ __forceinline__ int tidx() { int t = threadIdx.x; asm volatile("" : "+v"(t)); return t; }
__device__ __forceinline__ int lv(int x) { asm volatile("" : "+v"(x)); return x; }
__device__ __forceinline__ char* launder(char* p) { size_t z = 0; asm volatile("" : "+s"(z)); return p + z; }

constexpr int LDSROW = 72;
template <int NA, class AL>
__device__ __forceinline__ void gc_load(const AL& al, const bf16_t* bp, size_t bstep, int k0, int kc, u32x4 (&ra)[NA], u32x4 (&rb)[4]) {
#pragma unroll
    for (int i = 0; i < NA; ++i) ra[i] = __builtin_bit_cast(u32x4, al.load(i, k0 + kc));
#pragma unroll
    for (int j = 0; j < 4; ++j) rb[j] = *(const u32x4*)(bp + j * bstep + k0);
}
template <int NA>
__device__ __forceinline__ void gc_store(bf16_t* Ab, bf16_t* Bb, int lr, int kc, const u32x4 (&ra)[NA], const u32x4 (&rb)[4]) {
#pragma unroll
    for (int i = 0; i < NA; ++i) *(u32x4*)(Ab + (lr + 32 * i) * LDSROW + kc) = ra[i];
#pragma unroll
    for (int j = 0; j < 4; ++j) *(u32x4*)(Bb + (lr + 32 * j) * LDSROW + kc) = rb[j];
}
template <int MI>
__device__ __forceinline__ void gc_compute(const bf16_t* Ac, const bf16_t* Bc, f32x4 (&acc)[MI][4]) {
#pragma unroll
    for (int kh = 0; kh < 2; ++kh) {
        bf16x8 af[MI], bfv[4];
#pragma unroll
        for (int i = 0; i < MI; ++i) af[i] = *(const bf16x8*)(Ac + i * 16 * LDSROW + kh * 32);
#pragma unroll
        for (int j = 0; j < 4; ++j) bfv[j] = *(const bf16x8*)(Bc + j * 16 * LDSROW + kh * 32);
#pragma unroll
        for (int i = 0; i < MI; ++i)
#pragma unroll
            for (int j = 0; j < 4; ++j) acc[i][j] = __builtin_amdgcn_mfma_f32_16x16x32_bf16(bfv[j], af[i], acc[i][j], 0, 0, 0);
    }
}
template <int MI, class AL>
__device__ __forceinline__ void gemm_core(const AL& al, const bf16_t* __restrict__ Bt, int ldb, int K, f32x4 (&acc)[MI][4], char* smem) {
    constexpr int TM = MI * 32;
    constexpr int NA = TM / 32;
    bf16_t* As = (bf16_t*)smem;
    bf16_t* Bs = As + 2 * TM * LDSROW;
    const int tid = tidx(), lane = tid & 63, wave = tid >> 6;
    const int wr = wave >> 1, wc = wave & 1, fr = lane & 15, fq = lane >> 4;
    const int kc = (tid & 7) * 8, lr = tid >> 3;
#pragma unroll
    for (int i = 0; i < MI; ++i)
#pragma unroll
        for (int j = 0; j < 4; ++j) acc[i][j] = (f32x4){0.f, 0.f, 0.f, 0.f};
    u32x4 a0[NA], b0[4], a1[NA], b1[4];
    const bf16_t* bp = Bt + (size_t)lr * ldb + kc;
    const size_t bstep = (size_t)32 * ldb;
    const int nk = K >> 6;
    bf16_t* As1 = As + TM * LDSROW; bf16_t* Bs1 = Bs + 128 * LDSROW;
    const int aoff = (wr * MI * 16 + fr) * LDSROW + fq * 8, boff = (wc * 64 + fr) * LDSROW + fq * 8;
    gc_load<NA>(al, bp, bstep, 0, kc, a0, b0);
    gc_store<NA>(As, Bs, lr, kc, a0, b0);
    if (nk > 1) gc_load<NA>(al, bp, bstep, 64, kc, a0, b0);
    __syncthreads();
    for (int kt = 0; kt < nk; kt += 2) {
        if (kt + 2 < nk) gc_load<NA>(al, bp, bstep, (kt + 2) << 6, kc, a1, b1);
        gc_compute<MI>(As + aoff, Bs + boff, acc);
        if (kt + 1 < nk) gc_store<NA>(As1, Bs1, lr, kc, a0, b0);
        __syncthreads();
        if (kt + 1 >= nk) break;
        if (kt + 3 < nk) gc_load<NA>(al, bp, bstep, (kt + 3) << 6, kc, a0, b0);
        gc_compute<MI>(As1 + aoff, Bs1 + boff, acc);
        if (kt + 2 < nk) gc_store<NA>(As, Bs, lr, kc, a1, b1);
        __syncthreads();
    }
}
template <int MI, class RP, class RPB>
__device__ __forceinline__ void gemm_core_gb(const RP& rp, const RPB& rpb, int K, f32x4 (&acc)[MI][4], char* smem) {
    constexpr int ABYTES = MI * 32 * 128;
    constexpr int SBYTES = ABYTES + 16384;
    const int tid = tidx(), lane = tid & 63, wave = tid >> 6;
    const int wr = wave >> 1, wc = wave & 1, fr = lane & 15, fq = lane >> 4;
    const int rr = lane >> 3, cs = ((lane & 7) ^ ((wave * 4 + (lane >> 4)) & 7)) * 8;
#pragma unroll
    for (int i = 0; i < MI; ++i)
#pragma unroll
        for (int j = 0; j < 4; ++j) acc[i][j] = (f32x4){0.f, 0.f, 0.f, 0.f};
    const bf16_t* ap[MI]; const bf16_t* bp[4];
#pragma unroll
    for (int i = 0; i < MI; ++i) { const int r = (i * 4 + wave) * 8 + rr; ap[i] = rp(r) + cs; }
#pragma unroll
    for (int i = 0; i < 4; ++i) { const int r = (i * 4 + wave) * 8 + rr; bp[i] = rpb(r) + cs; }
    const int wbase = __builtin_amdgcn_readfirstlane(wave) * 1024;
    const int nk = K >> 6;
    auto stage = [&](int buf, int kt) {
        char* Ab = smem + buf * SBYTES + wbase; char* Bb = Ab + ABYTES;
#pragma unroll
        for (int i = 0; i < MI; ++i) __builtin_amdgcn_global_load_lds((const unsigned*)(ap[i] + kt * 64), (unsigned*)(Ab + i * 4096), 16, 0, 0);
#pragma unroll
        for (int i = 0; i < 4; ++i) __builtin_amdgcn_global_load_lds((const unsigned*)(bp[i] + kt * 64), (unsigned*)(Bb + i * 4096), 16, 0, 0);
    };
    const int aoff = (wr * MI * 16 + fr) * 128, boff = ABYTES + (wc * 64 + fr) * 128, sw = fr >> 1;
    stage(0, 0);
    asm volatile("s_waitcnt vmcnt(0)" ::: "memory");
    __syncthreads();
    for (int kt = 0; kt < nk; ++kt) {
        const int cur = kt & 1;
        if (kt + 1 < nk) stage(cur ^ 1, kt + 1);
        const char* base = smem + cur * SBYTES;
#pragma unroll
        for (int kh = 0; kh < 2; ++kh) {
            const int xo = ((kh * 4 + fq) ^ sw) * 16;
            bf16x8 af[MI], bfv[4];
#pragma unroll
            for (int i = 0; i < MI; ++i) af[i] = *(const bf16x8*)(base + aoff + i * 2048 + xo);
#pragma unroll
            for (int j = 0; j < 4; ++j) bfv[j] = *(const bf16x8*)(base + boff + j * 2048 + xo);
#pragma unroll
            for (int i = 0; i < MI; ++i)
#pragma unroll
                for (int j = 0; j < 4; ++j) acc[i][j] = __builtin_amdgcn_mfma_f32_16x16x32_bf16(bfv[j], af[i], acc[i][j], 0, 0, 0);
        }
        asm volatile("s_waitcnt vmcnt(0)" ::: "memory");
        __syncthreads();
    }
}
struct RPPlain;
template <int MI, class RP>
__device__ __forceinline__ void gemm_core_g(const RP& rp, const bf16_t* __restrict__ Bt, int ldb, int K, f32x4 (&acc)[MI][4], char* smem);
struct RPPlain {
    const bf16_t* A; size_t lda;
    __device__ __forceinline__ const bf16_t* operator()(int r) const { return A + (size_t)r * lda; }
};
template <int MI, class RP>
__device__ __forceinline__ void gemm_core_g(const RP& rp, const bf16_t* __restrict__ Bt, int ldb, int K, f32x4 (&acc)[MI][4], char* smem) {
    RPPlain rpb{Bt, (size_t)ldb};
    gemm_core_gb<MI>(rp, rpb, K, acc, smem);
}
template <int MI, class F>
__device__ __forceinline__ void acc_foreach(const f32x4 (&acc)[MI][4], F f) {
    const int lane = tidx() & 63, wave = tidx() >> 6;
    const int wr = wave >> 1, wc = wave & 1, fr = lane & 15, fq = lane >> 4;
#pragma unroll
    for (int i = 0; i < MI; ++i)
#pragma unroll
        for (int j = 0; j < 4; ++j) f(wr * MI * 16 + i * 16 + fr, wc * 64 + j * 16 + fq * 4, acc[i][j]);
}
struct ALPlain {
    const bf16_t* p0; size_t step;
    __device__ __forceinline__ ALPlain(const bf16_t* A, int lda, int row0) { p0 = A + (size_t)(row0 + (tidx() >> 3)) * lda; step = (size_t)32 * lda; }
    __device__ __forceinline__ uint4 load(int i, int k) const { return *(const uint4*)(p0 + i * step + k); }
};
__device__ __forceinline__ void store_bf16x4(bf16_t* dst, const f32x4& v) { *(uint2*)dst = make_uint2(pack2(v[0], v[1]), pack2(v[2], v[3])); }

__device__ __forceinline__ void ph_pre(const Params& p, char* smem) {
    const int tid = tidx(), nb = gridDim.x, bid = blockIdx.x;
    float* mod = (float*)(p.ws + O_MOD);
    {
        float* sv = (float*)smem;
        float* part = sv + 5 * 1024;
        for (int i = tid; i < 5 * 1024; i += 256) { const float v = (i < 4096) ? p.in[I_C][i] : p.in[I_CCTX][i - 4096]; sv[i] = siluf_(v); }
        __syncthreads();
        for (int it = bid; it < NLAYER * 96; it += nb) {
            const int l = it / 96, jb = it % 96;
            const int jj = tid & 63, kq = tid >> 6, j = jb * 64 + jj;
            const float* w = p.in[I_WADA] + (size_t)l * 1024 * 6144 + (size_t)(kq * 256) * 6144 + j;
            float a0 = 0.f, a1 = 0.f, a2 = 0.f, a3 = 0.f, a4 = 0.f;
#pragma unroll 8
            for (int k = 0; k < 256; ++k) {
                const float wv = w[(size_t)k * 6144]; const int kk = kq * 256 + k;
                a0 += sv[kk] * wv; a1 += sv[1024 + kk] * wv; a2 += sv[2048 + kk] * wv; a3 += sv[3072 + kk] * wv; a4 += sv[4096 + kk] * wv;
            }
            part[(kq * 5 + 0) * 64 + jj] = a0; part[(kq * 5 + 1) * 64 + jj] = a1; part[(kq * 5 + 2) * 64 + jj] = a2;
            part[(kq * 5 + 3) * 64 + jj] = a3; part[(kq * 5 + 4) * 64 + jj] = a4;
            __syncthreads();
            for (int o = tid; o < 320; o += 256) {
                const int i = o >> 6, c = o & 63;
                const float s = part[(0 * 5 + i) * 64 + c] + part[(1 * 5 + i) * 64 + c] + part[(2 * 5 + i) * 64 + c] + part[(3 * 5 + i) * 64 + c];
                mod[(size_t)(l * 5 + i) * 6144 + jb * 64 + c] = s + p.in[I_BADA][l * 6144 + jb * 64 + c];
            }
            __syncthreads();
        }
    }
    {
        float4* xc = (float4*)(p.ws + O_XCUR);
        const float4* x4 = (const float4*)p.in[I_X]; const float4* c4 = (const float4*)p.in[I_CTX];
        for (size_t i = (size_t)bid * 256 + tid; i < (size_t)RT * 256; i += (size_t)nb * 256) xc[i] = (i < (size_t)RL * 256) ? x4[i] : c4[i - (size_t)RL * 256];
    }
    {
        float* ct = (float*)smem;
        __syncthreads();
        for (int m = tid; m < 4096; m += 256) ct[m] = cospif((float)m * (1.f / 2048.f));
        __syncthreads();
        bf16_t* cst2 = (bf16_t*)(p.ws + O_CST256);
        for (int ch = bid * 256 + tid; ch < 256 * 512 / 8; ch += nb * 256) {
            const int ks = ch >> 6, c0 = (ch & 63) * 8, part = c0 >> 8, s0 = c0 & 255;
            float f[8];
#pragma unroll
            for (int e = 0; e < 8; ++e) { const int m = (16 * ks * (s0 + e)) & 4095; f[e] = part == 0 ? ct[m] : ct[(m - 1024) & 4095]; }
            *(uint4*)(cst2 + ch * 8) = pack8(f);
        }
        bf16_t* d128 = (bf16_t*)(p.ws + O_D128);
        for (int ch = bid * 256 + tid; ch < 128 * 128 / 8; ch += nb * 256) {
            const int mrow = ch >> 4, c0 = (ch & 15) * 8, po = mrow >> 6, k1 = mrow & 63, pi = c0 >> 6, t10 = c0 & 63;
            float f[8];
#pragma unroll
            for (int e = 0; e < 8; ++e) {
                const int m = (64 * k1 * (t10 + e)) & 4095; const float cv = ct[m], sv = ct[(m - 1024) & 4095];
                f[e] = (po == pi) ? cv : (po == 0 ? sv : -sv);
            }
            *(uint4*)(d128 + ch * 8) = pack8(f);
        }
        bf16_t* e64 = (bf16_t*)(p.ws + O_E64);
        for (int ch = bid * 256 + tid; ch < 64 * 128 / 8; ch += nb * 256) {
            const int k2 = ch >> 4, c0 = (ch & 15) * 8, po = c0 >> 6, t20 = c0 & 63;
            float f[8];
#pragma unroll
            for (int e = 0; e < 8; ++e) { const int m = (64 * k2 * (t20 + e)) & 4095; f[e] = po == 0 ? ct[m] : ct[(m - 1024) & 4095]; }
            *(uint4*)(e64 + ch * 8) = pack8(f);
        }
        float* twc = (float*)(p.ws + O_TWC); float* tws = (float*)(p.ws + O_TWS);
        for (int i = bid * 256 + tid; i < 64 * 64; i += nb * 256) {
            const int k1 = i >> 6, t2 = i & 63, m = (k1 * t2) & 4095;
            twc[i] = ct[m]; tws[i] = -ct[(m - 1024) & 4095];
        }
        bf16_t* csc = (bf16_t*)(p.ws + O_CSC);
        for (int ch = bid * 256 + tid; ch < 256 * 128 / 8; ch += nb * 256) {
            const int n = ch >> 4, c0 = (ch & 15) * 8, part = n >> 7, kc = n & 127;
            float f[8];
#pragma unroll
            for (int e = 0; e < 8; ++e) { const int m = (32 * kc * (c0 + e)) & 4095; f[e] = part == 0 ? ct[m] : -ct[(m - 1024) & 4095]; }
            *(uint4*)(csc + ch * 8) = pack8(f);
        }
        float* rc = (float*)(p.ws + O_ROPEC); float* rs = (float*)(p.ws + O_ROPES);
        for (int i = bid * 256 + tid; i < SEQ * 16; i += nb * 256) {
            const int t = i >> 4, ax = (i >> 3) & 1, f = i & 7;
            const float inv = powf(10000.f, -(float)f / 8.f);
            const float pos = (float)(ax == 0 ? (t >> 6) : (t & 63));
            const float ang = pos * inv;
            rc[i] = cosf(ang); rs[i] = sinf(ang);
        }
    }
}

struct ConvTask { const float* src; const float* scale; bf16_t* dst; int K, Nsrc, Ndst, rmul; size_t sbs, dbs; };
__constant__ int c_conv_cum[17] = {0, 1536, 1608, 1672, 1688, 1704, 1720, 1848, 1976, 2104, 2360, 4408, 6456, 8504, 8632, 8760, 8888};
__device__ __forceinline__ ConvTask conv_task(const Params& p, int l, int t) {
    bf16_t* wb = (bf16_t*)(p.ws + O_WB);
    ConvTask c; c.scale = nullptr; c.sbs = 0; c.dbs = 0; c.rmul = 64;
    switch (t) {
    case 0:  c.src = p.in[I_WIN] + (size_t)l * 1024 * 6048; c.K = 1024; c.Nsrc = 6048; c.Ndst = 6144; c.dst = wb + W_IN / 2; break;
    case 1:  c.src = p.in[I_WUQ] + (size_t)l * 384 * 768; c.K = 384; c.Nsrc = 768; c.Ndst = 768; c.dst = wb + W_UQ / 2; c.scale = p.in[I_QNG] + l * 384; break;
    case 2:  c.src = p.in[I_WUKV] + (size_t)l * 256 * 1024; c.K = 256; c.Nsrc = 1024; c.Ndst = 1024; c.dst = wb + W_UKV / 2; c.scale = p.in[I_KVNG] + l * 256; break;
    case 3:  c.src = p.in[I_WUP] + (size_t)l * 2 * 64 * 512; c.K = 64; c.Nsrc = 512; c.Ndst = 512; c.dst = wb + W_WUP / 2; c.sbs = 64 * 512; c.dbs = 512 * 64; break;
    case 4:  c.src = p.in[I_AUP] + (size_t)l * 2 * 64 * 512; c.K = 64; c.Nsrc = 512; c.Ndst = 512; c.dst = wb + W_AUP / 2; c.sbs = 64 * 512; c.dbs = 512 * 64; break;
    case 5:  c.src = p.in[I_GUP] + (size_t)l * 128 * 512; c.K = 128; c.Nsrc = 512; c.Ndst = 512; c.dst = wb + W_GUP / 2; break;
    case 6:  c.src = p.in[I_WPA] + (size_t)l * 512 * 1024; c.K = 512; c.Nsrc = 1024; c.Ndst = 1024; c.dst = wb + W_PA / 2; break;
    case 7:  c.src = p.in[I_WPB] + (size_t)l * 512 * 1024; c.K = 512; c.Nsrc = 1024; c.Ndst = 1024; c.dst = wb + W_PB / 2; break;
    case 8:  c.src = p.in[I_WPC] + (size_t)l * 512 * 1024; c.K = 512; c.Nsrc = 1024; c.Ndst = 1024; c.dst = wb + W_PC / 2; break;
    case 9:  c.src = p.in[I_WOUT] + (size_t)l * 1024 * 1024; c.K = 1024; c.Nsrc = 1024; c.Ndst = 1024; c.dst = wb + W_OUT / 2; break;
    case 10: c.src = p.in[I_EG] + (size_t)l * 16 * 1024 * 512; c.K = 1024; c.Nsrc = 512; c.Ndst = 512; c.dst = wb + W_GU / 2; c.sbs = 1024 * 512; c.dbs = 1024 * 1024; c.rmul = 128; break;
    case 11: c.src = p.in[I_EU] + (size_t)l * 16 * 1024 * 512; c.K = 1024; c.Nsrc = 512; c.Ndst = 512; c.dst = wb + W_GU / 2 + 64 * 1024; c.sbs = 1024 * 512; c.dbs = 1024 * 1024; c.rmul = 128; break;
    case 12: c.src = p.in[I_ED] + (size_t)l * 16 * 512 * 1024; c.K = 512; c.Nsrc = 1024; c.Ndst = 1024; c.dst = wb + W_D / 2; c.sbs = 512 * 1024; c.dbs = 1024 * 512; break;
    case 13: c.src = p.in[I_SG] + (size_t)l * 1024 * 512; c.K = 1024; c.Nsrc = 512; c.Ndst = 512; c.dst = wb + W_GU / 2 + (size_t)16 * 1024 * 1024; c.rmul = 128; break;
    case 14: c.src = p.in[I_SU] + (size_t)l * 1024 * 512; c.K = 1024; c.Nsrc = 512; c.Ndst = 512; c.dst = wb + W_GU / 2 + (size_t)16 * 1024 * 1024 + 64 * 1024; c.rmul = 128; break;
    default: c.src = p.in[I_SD] + (size_t)l * 512 * 1024; c.K = 512; c.Nsrc = 1024; c.Ndst = 1024; c.dst = wb + W_D / 2 + (size_t)16 * 1024 * 512; break;
    }
    return c;
}
__device__ __forceinline__ void ph_w(const Params& p, int l, char* smem) {
    const int tid = tidx();
    float* tl = (float*)smem;
    for (int g = blockIdx.x; g < 8888; g += gridDim.x) {
        int t = 0;
        while (g >= c_conv_cum[t + 1]) ++t;
        const ConvTask c = conv_task(p, l, t);
        int r = g - c_conv_cum[t];
        const int nkt = c.K >> 6, nnt = c.Ndst >> 6;
        const int bi = r / (nkt * nnt); r -= bi * nkt * nnt;
        const int k0 = (r / nnt) * 64, n0 = (r % nnt) * 64;
        const float* src = c.src + bi * c.sbs; bf16_t* dst = c.dst + bi * c.dbs;
#pragma unroll
        for (int i = 0; i < 4; ++i) {
            const int k = (tid >> 4) + 16 * i, n = n0 + (tid & 15) * 4;
            float4 v = make_float4(0.f, 0.f, 0.f, 0.f);
            if (n < c.Nsrc) v = *(const float4*)(src + (size_t)(k0 + k) * c.Nsrc + n);
            if (c.scale) { const float s = c.scale[k0 + k]; v.x *= s; v.y *= s; v.z *= s; v.w *= s; }
            float* d = tl + k * 65 + (tid & 15) * 4;
            d[0] = v.x; d[1] = v.y; d[2] = v.z; d[3] = v.w;
        }
        __syncthreads();
        {
            const int n = tid >> 2, kk0 = (tid & 3) * 16;
            float f[8], g2[8];
#pragma unroll
            for (int j = 0; j < 8; ++j) { f[j] = tl[(kk0 + j) * 65 + n]; g2[j] = tl[(kk0 + 8 + j) * 65 + n]; }
            bf16_t* d = dst + (size_t)((n0 >> 6) * c.rmul + n) * c.K + k0 + kk0;
            *(uint4*)d = pack8(f); *(uint4*)(d + 8) = pack8(g2);
        }
        __syncthreads();
    }
}

__device__ __forceinline__ void ph_n1(const Params& p, int l) {
    const int lane = tidx() & 63, wave = tidx() >> 6;
    const float* xcur = (const float*)(p.ws + O_XCUR); const float* mod = (const float*)(p.ws + O_MOD);
    bf16_t* H = (bf16_t*)(p.ws + O_H);
    const float* g = p.in[I_N1G] + l * 1024;
    for (int row = blockIdx.x * 4 + wave; row < RT; row += gridDim.x * 4) {
        const float* x = xcur + (size_t)row * 1024; const float* md = mod + (size_t)(l * 5 + modidx(row)) * 6144;
        float4 v[4]; float ss = 0.f;
#pragma unroll
        for (int i = 0; i < 4; ++i) { v[i] = *(const float4*)(x + lane * 4 + 256 * i); ss += v[i].x * v[i].x + v[i].y * v[i].y + v[i].z * v[i].z + v[i].w * v[i].w; }
        ss = wsum(ss);
        const float rstd = rsqrtf(ss * (1.f / 1024.f) + 1e-6f);
#pragma unroll
        for (int i = 0; i < 4; ++i) {
            const int c = lane * 4 + 256 * i;
            const float4 gg = *(const float4*)(g + c), sc = *(const float4*)(md + 1024 + c), sh = *(const float4*)(md + c);
            f32x4 h = {v[i].x * rstd * gg.x * (1.f + sc.x) + sh.x, v[i].y * rstd * gg.y * (1.f + sc.y) + sh.y,
                       v[i].z * rstd * gg.z * (1.f + sc.z) + sh.z, v[i].w * rstd * gg.w * (1.f + sc.w) + sh.w};
            store_bf16x4(H + (size_t)row * 1024 + c, h);
        }
    }
}

__device__ __forceinline__ void ph_g1(const Params& p, char* smem) {
    if (blockIdx.x == 0 && tidx() < 64) ((unsigned*)(p.ws + O_CNT))[tidx()] = 0u;
    const bf16_t* H = (const bf16_t*)(p.ws + O_H); const bf16_t* W = (const bf16_t*)(p.ws + O_WB + W_IN);
    bf16_t* P = (bf16_t*)(p.ws + O_P);
    for (int it = blockIdx.x; it < 136 * 48; it += gridDim.x) {
        const int mt = it / 48, nt = it % 48;
        f32x4 acc[4][4];
        RPPlain rp{H + (size_t)mt * 128 * 1024, 1024};
        gemm_core_g<4>(rp, W + (size_t)nt * 128 * 1024, 1024, 1024, acc, smem);
        acc_foreach<4>(acc, [&](int m, int n, const f32x4& v) {
            const int col = nt * 128 + n; f32x4 o = v;
            if (col >= PG0 && col < PEND) { o[0] = sigmoidf_(v[0]); o[1] = sigmoidf_(v[1]); o[2] = sigmoidf_(v[2]); o[3] = sigmoidf_(v[3]); }
            store_bf16x4(P + (size_t)(mt * 128 + m) * LDP + col, o);
        });
    }
}

__device__ __forceinline__ void ph_qu(const Params& p, char* smem) {
    const bf16_t* P = (const bf16_t*)(p.ws + O_P);
    bf16_t* QR = (bf16_t*)(p.ws + O_X + X_QRAW); bf16_t* KVR = (bf16_t*)(p.ws + O_X + X_KVRAW);
    for (int it = blockIdx.x; it < 136 * 14; it += gridDim.x) {
        const int mt = it / 14, nn = it % 14;
        f32x4 acc[4][4];
        if (nn < 6) {
            RPPlain rp{P + (size_t)mt * 128 * LDP + PQ0, LDP};
            gemm_core_g<4>(rp, (const bf16_t*)(p.ws + O_WB + W_UQ) + (size_t)nn * 128 * 384, 384, 384, acc, smem);
            acc_foreach<4>(acc, [&](int m, int n, const f32x4& v) { store_bf16x4(QR + (size_t)(mt * 128 + m) * 768 + nn * 128 + n, v); });
        } else {
            const int nt = nn - 6;
            RPPlain rp{P + (size_t)mt * 128 * LDP + PKV0, LDP};
            gemm_core_g<4>(rp, (const bf16_t*)(p.ws + O_WB + W_UKV) + (size_t)nt * 128 * 256, 256, 256, acc, smem);
            acc_foreach<4>(acc, [&](int m, int n, const f32x4& v) { store_bf16x4(KVR + (size_t)(mt * 128 + m) * 1024 + nt * 128 + n, v); });
        }
    }
}

constexpr float QSCALE = 0.10206207261596575f * 1.4426950408889634f;
__device__ __forceinline__ void ph_m2(const Params& p, char* smem) {
    const int tid = tidx(), lane = tid & 63, wave = tid >> 6;
    const bf16_t* P = (const bf16_t*)(p.ws + O_P);
    const bf16_t* QR = (const bf16_t*)(p.ws + O_X + X_QRAW); const bf16_t* KVR = (const bf16_t*)(p.ws + O_X + X_KVRAW);
    bf16_t* QA = (bf16_t*)(p.ws + O_X + X_QA); bf16_t* KA = (bf16_t*)(p.ws + O_X + X_KA); bf16_t* VA = (bf16_t*)(p.ws + O_X + X_VA);
    const float* rc = (const float*)(p.ws + O_ROPEC); const float* rs = (const float*)(p.ws + O_ROPES);
    for (int row = blockIdx.x * 4 + wave; row < RT; row += gridDim.x * 4) {
        const bool lat = row < RL;
        const int b = lat ? (row >> 12) : ((row - RL) >> 8), t = lat ? (row & 4095) : ((row - RL) & 255);
        const size_t keyrow = (size_t)b * KEYS + (lat ? t : SEQ + t);
        const bf16_t* pr = P + (size_t)row * LDP;
        float sq = 0.f, sk = 0.f;
        if (lane < 48) { float f[8]; unpack8(*(const uint4*)(pr + PQ0 + lane * 8), f);
#pragma unroll
            for (int e = 0; e < 8; ++e) sq += f[e] * f[e]; }
        if (lane < 32) { float f[8]; unpack8(*(const uint4*)(pr + PKV0 + lane * 8), f);
#pragma unroll
            for (int e = 0; e < 8; ++e) sk += f[e] * f[e]; }
        sq = wsum(sq); sk = wsum(sk);
        const float rq = rsqrtf(sq * (1.f / 384.f) + 1e-6f), rkv = rsqrtf(sk * (1.f / 256.f) + 1e-6f);
        const bf16_t* qr = QR + (size_t)row * 768; const bf16_t* kvr = KVR + (size_t)row * 1024;
        const float* rct = rc + t * 16; const float* rst = rs + t * 16;
#pragma unroll
        for (int pass = 0; pass < 2; ++pass) {
            const int ch = lane + 64 * pass;
            if (ch < 96) {
                const int h = ch / 12, cc = ch - h * 12;
                float q[8], k[8];
                unpack8(*(const uint4*)(qr + ch * 8), q);
                if (cc < 8) unpack8(*(const uint4*)(kvr + h * 128 + cc * 8), k);
                else unpack8(*(const uint4*)(pr + PKR0 + (cc - 8) * 8), k);
                const float ksc = cc < 8 ? rkv : 1.f;
#pragma unroll
                for (int e = 0; e < 8; ++e) { q[e] *= rq; k[e] *= ksc; }
                if (cc >= 8 && lat) {
                    const int sub = cc - 8, ax = sub >> 1, half = sub & 1;
                    float qp[8], kp[8];
                    unpack8(*(const uint4*)(qr + (ch ^ 1) * 8), qp); unpack8(*(const uint4*)(pr + PKR0 + (sub ^ 1) * 8), kp);
                    const float4 c0 = *(const float4*)(rct + ax * 8), c1 = *(const float4*)(rct + ax * 8 + 4), s0 = *(const float4*)(rst + ax * 8), s1 = *(const float4*)(rst + ax * 8 + 4);
                    const float cs_[8] = {c0.x, c0.y, c0.z, c0.w, c1.x, c1.y, c1.z, c1.w}, sn_[8] = {s0.x, s0.y, s0.z, s0.w, s1.x, s1.y, s1.z, s1.w};
#pragma unroll
                    for (int e = 0; e < 8; ++e) {
                        const float sg = half ? sn_[e] : -sn_[e];
                        q[e] = q[e] * cs_[e] + qp[e] * rq * sg;
                        k[e] = k[e] * cs_[e] + kp[e] * sg;
                    }
                }
#pragma unroll
                for (int e = 0; e < 8; ++e) q[e] *= QSCALE;
                *(uint4*)(QA + (size_t)row * 768 + ch * 8) = pack8(q);
                *(uint4*)(KA + keyrow * 768 + ch * 8) = pack8(k);
            }
        }
    }
    bf16_t* vt = (bf16_t*)smem;
    float* rk = (float*)(smem + 64 * 72 * 2);
    for (int it = blockIdx.x; it < (RT / 64) * 8; it += gridDim.x) {
        const int g = it >> 3, h = it & 7, rowg = g * 64;
        const bool lat = rowg < RL;
        const int b = lat ? (rowg >> 12) : ((rowg - RL) >> 8), t0 = lat ? (rowg & 4095) : ((rowg - RL) & 255);
        const size_t key0 = lat ? t0 : SEQ + t0;
        {
            const int lr = tid >> 2, q4 = tid & 3;
            const bf16_t* pr = P + (size_t)(rowg + lr) * LDP + PKV0 + q4 * 64;
            float sk = 0.f;
#pragma unroll
            for (int i = 0; i < 8; ++i) {
                float f[8]; unpack8(*(const uint4*)(pr + i * 8), f);
#pragma unroll
                for (int e = 0; e < 8; ++e) sk += f[e] * f[e];
            }
            sk += __shfl_xor(sk, 1); sk += __shfl_xor(sk, 2);
            if (q4 == 0) rk[lr] = rsqrtf(sk * (1.f / 256.f) + 1e-6f);
        }
        __syncthreads();
#pragma unroll
        for (int i = 0; i < 2; ++i) {
            const int c = tid + 256 * i, lr = c >> 3, part = c & 7;
            float f[8]; unpack8(*(const uint4*)(KVR + (size_t)(rowg + lr) * 1024 + h * 128 + 64 + part * 8), f);
            const float sc = rk[lr];
#pragma unroll
            for (int e = 0; e < 8; ++e) f[e] *= sc;
            *(uint4*)(vt + lr * 72 + part * 8) = pack8(f);
        }
        __syncthreads();
#pragma unroll
        for (int i = 0; i < 2; ++i) {
            const int c = tid + 256 * i, dd = c >> 3, kc = c & 7;
            float f[8];
#pragma unroll
            for (int e = 0; e < 8; ++e) f[e] = bf2f(vt[(kc * 8 + e) * 72 + dd]);
            const uint4 u = pack8(f);
            bf16_t* dst = VA + ((size_t)(b * 8 + h) * 64 + dd) * KEYS + key0 + (kc >> 2) * 32 + (kc & 1) * 16 + ((kc & 3) >> 1) * 4;
            *(uint2*)dst = make_uint2(u.x, u.y); *(uint2*)(dst + 8) = make_uint2(u.z, u.w);
        }
        __syncthreads();
    }
}
__device__ __forceinline__ float xmax_16_32(float v) {
    unsigned u = __builtin_bit_cast(unsigned, v);
    auto r = __builtin_amdgcn_permlane32_swap(u, u, false, false);
    float m = fmaxf(__builtin_bit_cast(float, r[0]), __builtin_bit_cast(float, r[1]));
    u = __builtin_bit_cast(unsigned, m);
    auto r2 = __builtin_amdgcn_permlane16_swap(u, u, false, false);
    return fmaxf(__builtin_bit_cast(float, r2[0]), __builtin_bit_cast(float, r2[1]));
}
__device__ __forceinline__ float xsum_16_32(float v) {
    unsigned u = __builtin_bit_cast(unsigned, v);
    auto r = __builtin_amdgcn_permlane32_swap(u, u, false, false);
    float m = __builtin_bit_cast(float, r[0]) + __builtin_bit_cast(float, r[1]);
    u = __builtin_bit_cast(unsigned, m);
    auto r2 = __builtin_amdgcn_permlane16_swap(u, u, false, false);
    return __builtin_bit_cast(float, r2[0]) + __builtin_bit_cast(float, r2[1]);
}
constexpr int KS_LD = 104, VT_LD = 72;
constexpr int AT_BUF = 64 * KS_LD * 2 + 64 * VT_LD * 2;
__device__ __forceinline__ void ph_at(const Params& p, int l, char* smem) {
    const int tid = tidx(), lane = tid & 63, wave = tid >> 6, fr = lane & 15, fq = lane >> 4;
    const bf16_t* QA = (const bf16_t*)(p.ws + O_X + X_QA); const bf16_t* KA = (const bf16_t*)(p.ws + O_X + X_KA); const bf16_t* VA = (const bf16_t*)(p.ws + O_X + X_VA);
    bf16_t* ATT = (bf16_t*)(p.ws + O_ATT);
    const int nitems = 1024 + (l < NLAYER - 1 ? 64 : 0);
    for (int it0 = blockIdx.x; it0 < nitems; it0 += gridDim.x) {
        int it = it0;
        if (gridDim.x == 512 && it0 < 1024) {
            const int x = it0 & 7, j = (it0 >> 3) & 63, rd = it0 >> 9;
            it = ((x * 4 + rd * 2 + (j >> 5)) << 5) | (j & 31);
        }
        int b, h, row0, ntile; size_t krow0;
        if (it < 1024) { b = it >> 8; h = (it >> 5) & 7; row0 = b * SEQ + (it & 31) * 128; krow0 = (size_t)b * KEYS; ntile = KEYS / 64; }
        else { const int j = it - 1024; b = j >> 4; h = (j >> 1) & 7; row0 = RL + b * CTX + (j & 1) * 128; krow0 = (size_t)b * KEYS + SEQ; ntile = CTX / 64; }
        const int qrow = row0 + wave * 32 + fr;
        const size_t vrow0 = (size_t)(b * 8 + h) * 64; const int koff0 = (int)(krow0 - (size_t)b * KEYS);
        bf16x8 qf[2][3];
#pragma unroll
        for (int t = 0; t < 2; ++t)
#pragma unroll
            for (int ks = 0; ks < 3; ++ks) qf[t][ks] = *(const bf16x8*)(QA + (size_t)(qrow + 16 * t) * 768 + h * 96 + ks * 32 + fq * 8);
        f32x4 ot[2][4];
#pragma unroll
        for (int t = 0; t < 2; ++t)
#pragma unroll
            for (int i = 0; i < 4; ++i) ot[t][i] = (f32x4){0.f, 0.f, 0.f, 0.f};
        float m_run[2] = {-1e30f, -1e30f}, l_run[2] = {0.f, 0.f};
        uint4 rk0, rk1, rk2, rv0, rv1;
#define AT_GLOAD(KT) do { const size_t kr_ = krow0 + (size_t)(KT) * 64; \
            { const int c = tid, key = c / 12, part = c % 12; rk0 = *(const uint4*)(KA + (kr_ + key) * 768 + h * 96 + part * 8); } \
            { const int c = tid + 256, key = c / 12, part = c % 12; rk1 = *(const uint4*)(KA + (kr_ + key) * 768 + h * 96 + part * 8); } \
            { const int c = tid + 512, key = c / 12, part = c % 12; rk2 = *(const uint4*)(KA + (kr_ + key) * 768 + h * 96 + part * 8); } \
            { const int c = tid, dd_ = c >> 3, part = c & 7; rv0 = *(const uint4*)(VA + (vrow0 + dd_) * KEYS + koff0 + (KT) * 64 + part * 8); } \
            { const int c = tid + 256, dd_ = c >> 3, part = c & 7; rv1 = *(const uint4*)(VA + (vrow0 + dd_) * KEYS + koff0 + (KT) * 64 + part * 8); } } while (0)
#define AT_VSTORE(RV, C) do { const int dd_ = (C) >> 3, part = (C) & 7; *(uint4*)(Vt_ + dd_ * VT_LD + part * 8) = RV; } while (0)
#define AT_SSTORE(BUF) do { bf16_t* Ks_ = (bf16_t*)(smem + (BUF) * AT_BUF); bf16_t* Vt_ = Ks_ + 64 * KS_LD; \
            { const int c = tid, key = c / 12, part = c % 12; *(uint4*)(Ks_ + key * KS_LD + part * 8) = rk0; } \
            { const int c = tid + 256, key = c / 12, part = c % 12; *(uint4*)(Ks_ + key * KS_LD + part * 8) = rk1; } \
            { const int c = tid + 512, key = c / 12, part = c % 12; *(uint4*)(Ks_ + key * KS_LD + part * 8) = rk2; } \
            AT_VSTORE(rv0, tid); AT_VSTORE(rv1, tid + 256); } while (0)
        AT_GLOAD(0); AT_SSTORE(0);
        __syncthreads();
        for (int kt = 0; kt < ntile; ++kt) {
            const int cur = kt & 1;
            if (kt + 1 < ntile) AT_GLOAD(kt + 1);
            const bf16_t* Ks = (const bf16_t*)(smem + cur * AT_BUF); const bf16_t* Vt = Ks + 64 * KS_LD;
            f32x4 st[2][4];
#pragma unroll
            for (int jh = 0; jh < 2; ++jh) {
                bf16x8 kf[2][3];
#pragma unroll
                for (int jj = 0; jj < 2; ++jj)
#pragma unroll
                    for (int ks = 0; ks < 3; ++ks) kf[jj][ks] = *(const bf16x8*)(Ks + ((jh * 2 + jj) * 16 + fr) * KS_LD + ks * 32 + fq * 8);
#pragma unroll
                for (int jj = 0; jj < 2; ++jj) {
                    const int j = jh * 2 + jj;
                    st[0][j] = (f32x4){0.f, 0.f, 0.f, 0.f}; st[1][j] = (f32x4){0.f, 0.f, 0.f, 0.f};
#pragma unroll
                    for (int ks = 0; ks < 3; ++ks) {
                        st[0][j] = __builtin_amdgcn_mfma_f32_16x16x32_bf16(kf[jj][ks], qf[0][ks], st[0][j], 0, 0, 0);
                        st[1][j] = __builtin_amdgcn_mfma_f32_16x16x32_bf16(kf[jj][ks], qf[1][ks], st[1][j], 0, 0, 0);
                    }
                }
            }
            bf16x8 vf[2][4];
#pragma unroll
            for (int k2 = 0; k2 < 2; ++k2)
#pragma unroll
                for (int dt = 0; dt < 4; ++dt) {
                    vf[k2][dt] = *(const bf16x8*)(Vt + (dt * 16 + fr) * VT_LD + k2 * 32 + fq * 8);
                }
            uint4 pu[2][2];
#pragma unroll
            for (int t = 0; t < 2; ++t) {
                float mx = st[t][0][0];
#pragma unroll
                for (int j = 0; j < 4; ++j)
#pragma unroll
                    for (int r = 0; r < 4; ++r) mx = fmaxf(mx, st[t][j][r]);
                if (__any(mx > m_run[t] + 6.f)) {
                    mx = xmax_16_32(mx);
                    const float m_new = fmaxf(m_run[t], mx);
                    const float alpha = __builtin_amdgcn_exp2f(m_run[t] - m_new);
                    m_run[t] = m_new;
                    l_run[t] *= alpha;
#pragma unroll
                    for (int i = 0; i < 4; ++i) ot[t][i] *= alpha;
                }
                const float mr = m_run[t];
                float ps = 0.f;
#pragma unroll
                for (int j = 0; j < 4; ++j)
#pragma unroll
                    for (int r = 0; r < 4; ++r) { st[t][j][r] = __builtin_amdgcn_exp2f(st[t][j][r] - mr); ps += st[t][j][r]; }
                l_run[t] += ps;
#pragma unroll
                for (int k2 = 0; k2 < 2; ++k2)
                    pu[t][k2] = make_uint4(pack2(st[t][2 * k2][0], st[t][2 * k2][1]), pack2(st[t][2 * k2][2], st[t][2 * k2][3]),
                                           pack2(st[t][2 * k2 + 1][0], st[t][2 * k2 + 1][1]), pack2(st[t][2 * k2 + 1][2], st[t][2 * k2 + 1][3]));
            }
#pragma unroll
            for (int k2 = 0; k2 < 2; ++k2) {
                const bf16x8 pb0 = __builtin_bit_cast(bf16x8, pu[0][k2]), pb1 = __builtin_bit_cast(bf16x8, pu[1][k2]);
#pragma unroll
                for (int dt = 0; dt < 4; ++dt) {
                    ot[0][dt] = __builtin_amdgcn_mfma_f32_16x16x32_bf16(vf[k2][dt], pb0, ot[0][dt], 0, 0, 0);
                    ot[1][dt] = __builtin_amdgcn_mfma_f32_16x16x32_bf16(vf[k2][dt], pb1, ot[1][dt], 0, 0, 0);
                }
            }
            if (kt + 1 < ntile) AT_SSTORE(cur ^ 1);
            __syncthreads();
        }
#pragma unroll
        for (int t = 0; t < 2; ++t) {
            const float inv = 1.f / xsum_16_32(l_run[t]);
#pragma unroll
            for (int dt = 0; dt < 4; ++dt) { f32x4 o = ot[t][dt] * inv; store_bf16x4(ATT + (size_t)(qrow + 16 * t) * 512 + h * 64 + dt * 16 + fq * 4, o); }
        }
    }
}

__device__ __forceinline__ void row_edges(int row, bool& first, bool& last) {
    if (row < RL) { const int t = row & 4095; first = t == 0; last = t == 4095; }
    else { const int s = (row - RL) & 255; first = s == 0; last = s == 255; }
}
__device__ __forceinline__ float xs1(const bf16_t* P, const float* mu, int row, int col) {
    bool first, last; row_edges(row, first, last);
    const bf16_t* pc = P + (size_t)row * LDP + PR0 + col;
    const float c = bf2f(*pc), pv0 = bf2f(*(first ? pc : pc - LDP)), nx0 = bf2f(*(last ? pc : pc + LDP));
    const float pv = first ? 0.f : pv0, nx = last ? 0.f : nx0;
    return c + (0.5f * (pv + nx) - c) * mu[col];
}
__device__ __forceinline__ void xs8(const bf16_t* P, const float* mu, int row, int col, float (&o)[8]) {
    bool first, last; row_edges(row, first, last);
    const bf16_t* pc = P + (size_t)row * LDP + PR0 + col;
    const uint4 uc = *(const uint4*)pc, up = *(const uint4*)(first ? pc : pc - LDP), un = *(const uint4*)(last ? pc : pc + LDP);
    float c[8], pv[8], nx[8]; unpack8(uc, c); unpack8(up, pv); unpack8(un, nx);
    const float fp = first ? 0.f : 0.5f, fn = last ? 0.f : 0.5f;
    const float4 m0 = *(const float4*)(mu + col), m1 = *(const float4*)(mu + col + 4);
    const float m[8] = {m0.x, m0.y, m0.z, m0.w, m1.x, m1.y, m1.z, m1.w};
#pragma unroll
    for (int j = 0; j < 8; ++j) o[j] = c[j] + ((fp * pv[j] + fn * nx[j]) - c[j]) * m[j];
}
struct ALRw {
    const bf16_t* P; const float* mu; int row0; int colbase, mode;
    __device__ __forceinline__ ALRw(const bf16_t* P_, const float* mu_, int row0_, int colbase_, int mode_) : P(P_), mu(mu_), colbase(colbase_), mode(mode_) {
        row0 = row0_ + (tidx() >> 3);
    }
    __device__ __forceinline__ uint4 load(int i, int k) const {
        float o[8]; xs8(P, mu, row0 + 32 * i, colbase + k, o);
        if (mode == 0) {
#pragma unroll
            for (int j = 0; j < 8; ++j) o[j] = tanhf(o[j]);
        } else if (mode == 2) {
#pragma unroll
            for (int j = 0; j < 8; ++j) o[j] = sigmoidf_(o[j]);
        }
        return pack8(o);
    }
};
__device__ __forceinline__ void ph_rp1(const Params& p, int l, char* smem) {
    const bf16_t* P = (const bf16_t*)(p.ws + O_P); const float* mu = p.in[I_MU] + l * 1792;
    bf16_t* RG = (bf16_t*)(p.ws + O_RG);
    for (int it = blockIdx.x; it < 1088; it += gridDim.x) {
        const int mt = it >> 2, nt = it & 3;
        f32x4 acc[2][4];
        ALRw al(P, mu, mt * 64, 1664, 2);
        gemm_core<2>(al, (const bf16_t*)(p.ws + O_WB + W_GUP) + (size_t)nt * 128 * 128, 128, 128, acc, smem);
        acc_foreach<2>(acc, [&](int m, int n, const f32x4& v) { store_bf16x4(RG + (size_t)(mt * 64 + m) * 512 + nt * 128 + n, v); });
    }
}
__device__ __forceinline__ void ph_rp2(const Params& p, int l) {
    const int lane = tidx() & 63, wave = tidx() >> 6;
    const bf16_t* P = (const bf16_t*)(p.ws + O_P); const float* mu = p.in[I_MU] + l * 1792; const float* kkw = p.in[I_KK] + l * 512;
    float* KKN = (float*)(p.ws + O_X + X_KKN);
    for (int row = blockIdx.x * 4 + wave; row < RT; row += gridDim.x * 4) {
        float k8[8]; xs8(P, mu, row, 512 + lane * 8, k8);
        float s = 0.f;
#pragma unroll
        for (int j = 0; j < 8; ++j) { const float v = k8[j] * kkw[lane * 8 + j]; s += v * v; }
        s += __shfl_xor(s, 1); s += __shfl_xor(s, 2); s += __shfl_xor(s, 4);
        if ((lane & 7) == 0) KKN[(size_t)row * 8 + (lane >> 3)] = rsqrtf(s + 1e-12f);
    }
}

__device__ __forceinline__ int scan_row(int b, int d, int n) {
    if (n < CTX) return RL + b * CTX + (d == 0 ? n : CTX - 1 - n);
    const int t = n - CTX; return b * SEQ + (d == 0 ? t : SEQ - 1 - t);
}
constexpr int SL = 72;
constexpr int SLOT_E = 64 * SL;
template <int LDA, int LDB>
__device__ __forceinline__ void mm64(const bf16_t* A, const bf16_t* B, f32x4 (&acc)[4], int wave, int fr, int fq) {
#pragma unroll
    for (int ks = 0; ks < 2; ++ks) {
        const bf16x8 af = *(const bf16x8*)(A + (wave * 16 + fr) * LDA + ks * 32 + fq * 8);
#pragma unroll
        for (int nt = 0; nt < 4; ++nt) {
            const bf16x8 bfv = *(const bf16x8*)(B + (nt * 16 + fr) * LDB + ks * 32 + fq * 8);
            acc[nt] = __builtin_amdgcn_mfma_f32_16x16x32_bf16(bfv, af, acc[nt], 0, 0, 0);
        }
    }
}
__device__ __forceinline__ void acc_zero(f32x4 (&acc)[4]) {
#pragma unroll
    for (int nt = 0; nt < 4; ++nt) acc[nt] = (f32x4){0.f, 0.f, 0.f, 0.f};
}
template <bool STRICT>
__device__ __forceinline__ void acc_mask(f32x4 (&acc)[4], int m, int fq) {
#pragma unroll
    for (int nt = 0; nt < 4; ++nt)
#pragma unroll
        for (int r = 0; r < 4; ++r) { const int n = nt * 16 + fq * 4 + r; const bool keep = STRICT ? (m < n) : (m <= n); if (!keep) acc[nt][r] = 0.f; }
}
__device__ __forceinline__ void st_rm(bf16_t* dst, const f32x4 (&acc)[4], int m, int fq) {
#pragma unroll
    for (int nt = 0; nt < 4; ++nt) store_bf16x4(dst + m * SL + nt * 16 + fq * 4, acc[nt]);
}
__device__ __forceinline__ void st_tr(bf16_t* dst, const f32x4 (&acc)[4], int m, int fq) {
#pragma unroll
    for (int nt = 0; nt < 4; ++nt)
#pragma unroll
        for (int r = 0; r < 4; ++r) dst[(nt * 16 + fq * 4 + r) * SL + m] = f2bf(acc[nt][r]);
}
__device__ __forceinline__ void ph_r1(const Params& p, int l, char* smem) {
    const int tid0 = tidx();
#define R1_IDX const int tid = lv(tid0), lane = tid & 63, wave = tid >> 6, fr = lane & 15, fq = lane >> 4, bi = tid >> 2, bq = (tid & 3) * 16, m = wave * 16 + fr; (void)bi; (void)bq; (void)m; (void)fq;
    const bf16_t* P = (const bf16_t*)(p.ws + O_P); const float* mu = p.in[I_MU] + l * 1792;
    const float* kkw = p.in[I_KK] + l * 512; const float* kaw = p.in[I_KA] + l * 512; const float* rkw = p.in[I_RK] + l * 512;
    const float* KKN = (const float*)(p.ws + O_X + X_KKN); float* BON = (float*)(p.ws + O_X + X_BON);
    bf16_t* gMT = (bf16_t*)(p.ws + O_X + X_MT); bf16_t* gNL = (bf16_t*)(p.ws + O_H);
    bf16_t* gGT = (bf16_t*)(p.ws + O_X + X_GT); bf16_t* gYL = (bf16_t*)(p.ws + O_X + X_YL);
    bf16_t* slot = (bf16_t*)smem;
    bf16_t* s0 = slot, *s1 = slot + SLOT_E, *s2 = slot + 2 * SLOT_E, *s3 = slot + 3 * SLOT_E;
    bf16_t* sa = slot + 4 * SLOT_E, *sb = slot + 5 * SLOT_E, *sc = slot + 6 * SLOT_E, *sT = slot + 7 * SLOT_E;
    float* misc = (float*)(smem + 8 * SLOT_E * 2);
    float* GAM = misc; float* SEG = misc + 64;
    float* ASIG = (float*)s0;
    float* LWS = (float*)s2;
    for (int it = blockIdx.x; it < NCP; it += gridDim.x) {
        const int c = it % 68, d = (it / 68) & 1, h = (it / 136) & 7, b = it / 1088;
        {
            R1_IDX const int rowb = scan_row(b, d, c * 64 + bi); (void)rowb;
            float o[8];
#pragma unroll
            for (int hh = 0; hh < 2; ++hh) {
                xs8(P, mu, rowb, 1536 + bq + hh * 8, o);
#pragma unroll
                for (int j = 0; j < 8; ++j) o[j] = 1.f - 2.f * __builtin_amdgcn_rcpf(1.f + __expf(2.f * o[j]));
                *(uint4*)(sa + bi * SL + bq + hh * 8) = pack8(o);
                xs8(P, mu, rowb, 1600 + bq + hh * 8, o);
                *(uint4*)(sb + bi * SL + bq + hh * 8) = pack8(o);
            }
        }
        __syncthreads();
        {
            R1_IDX const int rowb = scan_row(b, d, c * 64 + bi); (void)rowb;
            f32x4 acc[4];
            acc_zero(acc);
            mm64<SL, 64>(sa, (const bf16_t*)(p.ws + O_WB + W_WUP) + ((size_t)d * 512 + h * 64) * 64, acc, wave, fr, fq);
            const float* w0 = p.in[I_W0] + (l * 2 + d) * 512 + h * 64;
#pragma unroll
            for (int nt = 0; nt < 4; ++nt) {
                const int n = nt * 16 + fq * 4; float4 o; float* op = (float*)&o;
#pragma unroll
                for (int r = 0; r < 4; ++r) { const float z = w0[n + r] + acc[nt][r]; op[r] = -0.6065306597126334f * __builtin_amdgcn_rcpf(1.f + __expf(-z)); }
                *(float4*)(LWS + m * 68 + n) = o;
            }
            acc_zero(acc);
            mm64<SL, 64>(sb, (const bf16_t*)(p.ws + O_WB + W_AUP) + ((size_t)d * 512 + h * 64) * 64, acc, wave, fr, fq);
            const float* a0 = p.in[I_A0] + (l * 2 + d) * 512 + h * 64;
#pragma unroll
            for (int nt = 0; nt < 4; ++nt) {
                const int n = nt * 16 + fq * 4;
                *(float4*)(ASIG + m * 68 + n) = make_float4(__builtin_amdgcn_rcpf(1.f + __expf(-(a0[n] + acc[nt][0]))), __builtin_amdgcn_rcpf(1.f + __expf(-(a0[n + 1] + acc[nt][1]))), __builtin_amdgcn_rcpf(1.f + __expf(-(a0[n + 2] + acc[nt][2]))), __builtin_amdgcn_rcpf(1.f + __expf(-(a0[n + 3] + acc[nt][3]))));
            }
        }
        __syncthreads();
        {
            R1_IDX const int rowb = scan_row(b, d, c * 64 + bi); (void)rowb;
            const int k = tid & 63, seg = tid >> 6;
            float run = 0.f;
#pragma unroll
            for (int ii = 0; ii < 16; ++ii) { run += LWS[(seg * 16 + ii) * 68 + k]; LWS[(seg * 16 + ii) * 68 + k] = run; }
            SEG[seg * 64 + k] = run;
            __syncthreads();
            float off = 0.f;
#pragma unroll
            for (int sgi = 0; sgi < 3; ++sgi) if (sgi < seg) off += SEG[sgi * 64 + k];
#pragma unroll
            for (int ii = 0; ii < 16; ++ii) LWS[(seg * 16 + ii) * 68 + k] += off;
        }
        __syncthreads();
        {
            R1_IDX const int rowb = scan_row(b, d, c * 64 + bi); (void)rowb;
            float cs[16], cm[16], cc[16], ag[16];
#pragma unroll
            for (int q = 0; q < 4; ++q) {
                const float4 v0 = *(const float4*)(LWS + bi * 68 + bq + q * 4);
                const float4 v1 = bi > 0 ? *(const float4*)(LWS + (bi - 1) * 68 + bq + q * 4) : make_float4(0.f, 0.f, 0.f, 0.f);
                const float4 v2 = *(const float4*)(LWS + 63 * 68 + bq + q * 4);
                const float4 v3 = *(const float4*)(ASIG + bi * 68 + bq + q * 4);
                cs[q * 4] = v0.x; cs[q * 4 + 1] = v0.y; cs[q * 4 + 2] = v0.z; cs[q * 4 + 3] = v0.w;
                cm[q * 4] = v1.x; cm[q * 4 + 1] = v1.y; cm[q * 4 + 2] = v1.z; cm[q * 4 + 3] = v1.w;
                cc[q * 4] = v2.x; cc[q * 4 + 1] = v2.y; cc[q * 4 + 2] = v2.z; cc[q * 4 + 3] = v2.w;
                ag[q * 4] = v3.x; ag[q * 4 + 1] = v3.y; ag[q * 4 + 2] = v3.z; ag[q * 4 + 3] = v3.w;
            }
            __syncthreads();
            const float kkn = KKN[(size_t)rowb * 8 + h];
            float bon = 0.f;
#pragma unroll
            for (int hh = 0; hh < 2; ++hh) {
                float r8[8], k8[8], oa[8], ob[8], ok[8], orr[8];
                const int col = h * 64 + bq + hh * 8;
                xs8(P, mu, rowb, col, r8); xs8(P, mu, rowb, 512 + col, k8);
#pragma unroll
                for (int j = 0; j < 8; ++j) {
                    const int e = hh * 8 + j;
                    const float kk = k8[j] * kkw[col + j] * kkn;
                    const float kd = k8[j] * (1.f + (ag[e] - 1.f) * kaw[col + j]);
                    const float eneg = __expf(-cs[e]);
                    oa[j] = -kk * __expf(cm[e]); ob[j] = kk * ag[e] * eneg; ok[j] = kd * eneg; orr[j] = r8[j] * __builtin_amdgcn_rcpf(eneg);
                    bon += r8[j] * kd * rkw[col + j];
                }
                *(uint4*)(s0 + bi * SL + bq + hh * 8) = pack8(oa); *(uint4*)(s1 + bi * SL + bq + hh * 8) = pack8(ob);
                *(uint4*)(s2 + bi * SL + bq + hh * 8) = pack8(ok); *(uint4*)(s3 + bi * SL + bq + hh * 8) = pack8(orr);
            }
            bon += __shfl_xor(bon, 1); bon += __shfl_xor(bon, 2);
            if ((tid & 3) == 0) BON[((size_t)d * RT + rowb) * 8 + h] = bon;
            if (bi == 0) {
#pragma unroll
                for (int e = 0; e < 16; ++e) GAM[bq + e] = __expf(cc[e]);
            }
        }
        __syncthreads();
        {
            R1_IDX const int rowb = scan_row(b, d, c * 64 + bi); (void)rowb;
            f32x4 acc[4]; acc_zero(acc);
            mm64<SL, SL>(s1, s0, acc, wave, fr, fq);
            acc_mask<true>(acc, m, fq);
            st_rm(sa, acc, m, fq); st_tr(sb, acc, m, fq);
#pragma unroll
            for (int nt = 0; nt < 4; ++nt)
#pragma unroll
                for (int r = 0; r < 4; ++r) if (nt * 16 + fq * 4 + r == m) acc[nt][r] += 1.f;
            st_rm(sc, acc, m, fq);
        }
        __syncthreads();
#pragma unroll
        for (int itr = 0; itr < 5; ++itr) {
            R1_IDX
            bf16_t* ptr = (itr & 1) ? sT : sb;
            bf16_t* ptw = (itr & 1) ? sb : sT;
            f32x4 acc[4]; acc_zero(acc);
            mm64<SL, SL>(sa, ptr, acc, wave, fr, fq);
            st_rm(sa, acc, m, fq); st_tr(ptw, acc, m, fq);
            __syncthreads();
            f32x4 tacc[4];
#pragma unroll
            for (int nt = 0; nt < 4; ++nt) { const uint2 u = *(const uint2*)(sc + m * SL + nt * 16 + fq * 4); tacc[nt] = (f32x4){bflo(u.x), bfhi(u.x), bflo(u.y), bfhi(u.y)}; }
            mm64<SL, SL>(sc, ptw, tacc, wave, fr, fq);
            if (itr < 4) st_rm(sc, tacc, m, fq); else st_tr(sb, tacc, m, fq);
        }
        __syncthreads();
        {
            R1_IDX const int rowb = scan_row(b, d, c * 64 + bi); (void)rowb;
            f32x4 acc[4]; acc_zero(acc);
            mm64<SL, SL>(s2, s0, acc, wave, fr, fq);
            acc_mask<true>(acc, m, fq);
            st_rm(sa, acc, m, fq);
            float f0[8], f1[8];
            unpack8(*(const uint4*)(s0 + bi * SL + bq), f0); unpack8(*(const uint4*)(s0 + bi * SL + bq + 8), f1);
#pragma unroll
            for (int e = 0; e < 8; ++e) { sc[(bq + e) * SL + bi] = f2bf(f0[e]); sc[(bq + 8 + e) * SL + bi] = f2bf(f1[e]); }
        }
        __syncthreads();
        {
            R1_IDX const int rowb = scan_row(b, d, c * 64 + bi); (void)rowb;
            f32x4 acc[4]; acc_zero(acc);
            mm64<SL, SL>(sc, sb, acc, wave, fr, fq);
            st_rm(sT, acc, m, fq);
            acc_zero(acc);
            mm64<SL, SL>(sa, sb, acc, wave, fr, fq);
            st_rm(s0, acc, m, fq);
        }
        __syncthreads();
        f32x4 qacc[4];
        {
            R1_IDX const int rowb = scan_row(b, d, c * 64 + bi); (void)rowb;
            f32x4 acc[4]; acc_zero(acc);
            mm64<SL, SL>(s1, s3, acc, wave, fr, fq);
            acc_mask<false>(acc, m, fq);
            st_tr(sa, acc, m, fq);
            acc_zero(qacc);
            mm64<SL, SL>(s2, s3, qacc, wave, fr, fq);
            acc_mask<false>(qacc, m, fq);
            float f0[8], f1[8];
            unpack8(*(const uint4*)(s3 + bi * SL + bq), f0); unpack8(*(const uint4*)(s3 + bi * SL + bq + 8), f1);
#pragma unroll
            for (int e = 0; e < 8; ++e) { sc[(bq + e) * SL + bi] = f2bf(f0[e]); sc[(bq + 8 + e) * SL + bi] = f2bf(f1[e]); }
        }
        __syncthreads();
        {
            R1_IDX const int rowb = scan_row(b, d, c * 64 + bi); (void)rowb;
            f32x4 acc[4];
#pragma unroll
            for (int nt = 0; nt < 4; ++nt) { const uint2 u = *(const uint2*)(sc + m * SL + nt * 16 + fq * 4); acc[nt] = (f32x4){bflo(u.x), bfhi(u.x), bflo(u.y), bfhi(u.y)}; }
            mm64<SL, SL>(sT, sa, acc, wave, fr, fq);
            bf16_t* gt = gGT + (size_t)it * 4096;
#pragma unroll
            for (int nt = 0; nt < 4; ++nt)
#pragma unroll
                for (int r = 0; r < 4; ++r) gt[(nt * 16 + fq * 4 + r) * 64 + m] = f2bf(acc[nt][r]);
            mm64<SL, SL>(s0, sa, qacc, wave, fr, fq);
            st_tr(sb, qacc, m, fq);
            float f0[8], f1[8];
            unpack8(*(const uint4*)(s1 + bi * SL + bq), f0); unpack8(*(const uint4*)(s1 + bi * SL + bq + 8), f1);
#pragma unroll
            for (int e = 0; e < 8; ++e) { s3[(bq + e) * SL + bi] = f2bf(f0[e] * GAM[bq + e]); s3[(bq + 8 + e) * SL + bi] = f2bf(f1[e] * GAM[bq + 8 + e]); }
        }
        __syncthreads();
        {
            R1_IDX const int rowb = scan_row(b, d, c * 64 + bi); (void)rowb;
            f32x4 acc[4]; acc_zero(acc);
            mm64<SL, SL>(sT, s3, acc, wave, fr, fq);
            bf16_t* mt = gMT + (size_t)it * 4096;
#pragma unroll
            for (int nt = 0; nt < 4; ++nt)
#pragma unroll
                for (int r = 0; r < 4; ++r) { const int n = nt * 16 + fq * 4 + r; mt[n * 64 + m] = f2bf(acc[nt][r] + (n == m ? GAM[m] : 0.f)); }
#pragma unroll
            for (int nt = 0; nt < 4; ++nt) {
                const int n = nt * 16 + fq * 4; const uint2 u = *(const uint2*)(s2 + m * SL + n);
                acc[nt] = (f32x4){bflo(u.x) * GAM[n], bfhi(u.x) * GAM[n + 1], bflo(u.y) * GAM[n + 2], bfhi(u.y) * GAM[n + 3]};
            }
            mm64<SL, SL>(s0, s3, acc, wave, fr, fq);
            st_tr(s1, acc, m, fq);
            float v8[8];
#pragma unroll
            for (int hh = 0; hh < 2; ++hh) {
                xs8(P, mu, rowb, 1024 + h * 64 + bq + hh * 8, v8);
#pragma unroll
                for (int e = 0; e < 8; ++e) sc[(bq + hh * 8 + e) * SL + bi] = f2bf(v8[e]);
            }
        }
        __syncthreads();
        {
            R1_IDX const int rowb = scan_row(b, d, c * 64 + bi); (void)rowb;
            f32x4 acc[4]; acc_zero(acc);
            mm64<SL, SL>(sc, sb, acc, wave, fr, fq);
            bf16_t* yl = gYL + (size_t)it * 4096;
#pragma unroll
            for (int nt = 0; nt < 4; ++nt) store_bf16x4(yl + m * 64 + nt * 16 + fq * 4, acc[nt]);
            acc_zero(acc);
            mm64<SL, SL>(sc, s1, acc, wave, fr, fq);
            bf16_t* nl = gNL + (size_t)it * 4096;
#pragma unroll
            for (int nt = 0; nt < 4; ++nt) store_bf16x4(nl + m * 64 + nt * 16 + fq * 4, acc[nt]);
        }
        __syncthreads();
    }
}
__device__ __forceinline__ void ph_r2(const Params& p, char* smem) {
    const int tid = tidx(), lane = tid & 63, wave = tid >> 6, fr = lane & 15, fq = lane >> 4;
    const char* gMT = (const char*)(p.ws + O_X + X_MT); const char* gNL = (const char*)(p.ws + O_H);
    uint4* gS0 = (uint4*)(p.ws + O_X + X_S0);
    const int wofs = __builtin_amdgcn_readfirstlane(wave) * 1024;
    const unsigned lds0 = (unsigned)(uintptr_t)smem;
    const unsigned mtaddr = lds0 + fr * 128 + fq * 8, nladdr = lds0 + (wave * 16 + fr) * 128 + fq * 8;
    auto issue = [&](size_t cp, int slot) {
        char* dst = smem + slot * 16384 + wofs;
        const char* s0 = gMT + cp * 8192 + wofs + lane * 16; const char* s1 = gNL + cp * 8192 + wofs + lane * 16;
        __builtin_amdgcn_global_load_lds((const unsigned*)s0, (unsigned*)dst, 16, 0, 0);
        __builtin_amdgcn_global_load_lds((const unsigned*)(s0 + 4096), (unsigned*)(dst + 4096), 16, 0, 0);
        __builtin_amdgcn_global_load_lds((const unsigned*)s1, (unsigned*)(dst + 8192), 16, 0, 0);
        __builtin_amdgcn_global_load_lds((const unsigned*)(s1 + 4096), (unsigned*)(dst + 12288), 16, 0, 0);
    };
    for (int it = blockIdx.x; it < 64; it += gridDim.x) {
        f32x4 st[4];
#pragma unroll
        for (int tt = 0; tt < 4; ++tt) st[tt] = (f32x4){0.f, 0.f, 0.f, 0.f};
        const size_t cp0 = (size_t)it * 68;
        issue(cp0, 0); issue(cp0 + 1, 1); issue(cp0 + 2, 2);
        for (int c4 = 0; c4 < 68; c4 += 4) {
#pragma unroll
            for (int j = 0; j < 4; ++j) {
                const int c = c4 + j;
                if (c < 65) asm volatile("s_waitcnt vmcnt(8)" ::: "memory"); else asm volatile("s_waitcnt vmcnt(0)" ::: "memory");
                __builtin_amdgcn_s_barrier();
                asm volatile("" ::: "memory");
                uint2 mx[4][2][2], nvv[4];
                asm volatile("ds_read_b64 %0, %1 offset:0" : "=v"(mx[0][0][0]) : "v"(mtaddr + j * 16384));
                asm volatile("ds_read_b64 %0, %1 offset:32" : "=v"(mx[0][0][1]) : "v"(mtaddr + j * 16384));
                asm volatile("ds_read_b64 %0, %1 offset:64" : "=v"(mx[0][1][0]) : "v"(mtaddr + j * 16384));
                asm volatile("ds_read_b64 %0, %1 offset:96" : "=v"(mx[0][1][1]) : "v"(mtaddr + j * 16384));
                asm volatile("ds_read_b64 %0, %1 offset:8192" : "=v"(nvv[0]) : "v"(nladdr + j * 16384));
                asm volatile("ds_read_b64 %0, %1 offset:2048" : "=v"(mx[1][0][0]) : "v"(mtaddr + j * 16384));
                asm volatile("ds_read_b64 %0, %1 offset:2080" : "=v"(mx[1][0][1]) : "v"(mtaddr + j * 16384));
                asm volatile("ds_read_b64 %0, %1 offset:2112" : "=v"(mx[1][1][0]) : "v"(mtaddr + j * 16384));
                asm volatile("ds_read_b64 %0, %1 offset:2144" : "=v"(mx[1][1][1]) : "v"(mtaddr + j * 16384));
                asm volatile("ds_read_b64 %0, %1 offset:8224" : "=v"(nvv[1]) : "v"(nladdr + j * 16384));
                asm volatile("ds_read_b64 %0, %1 offset:4096" : "=v"(mx[2][0][0]) : "v"(mtaddr + j * 16384));
                asm volatile("ds_read_b64 %0, %1 offset:4128" : "=v"(mx[2][0][1]) : "v"(mtaddr + j * 16384));
                asm volatile("ds_read_b64 %0, %1 offset:4160" : "=v"(mx[2][1][0]) : "v"(mtaddr + j * 16384));
                asm volatile("ds_read_b64 %0, %1 offset:4192" : "=v"(mx[2][1][1]) : "v"(mtaddr + j * 16384));
                asm volatile("ds_read_b64 %0, %1 offset:8256" : "=v"(nvv[2]) : "v"(nladdr + j * 16384));
                asm volatile("ds_read_b64 %0, %1 offset:6144" : "=v"(mx[3][0][0]) : "v"(mtaddr + j * 16384));
                asm volatile("ds_read_b64 %0, %1 offset:6176" : "=v"(mx[3][0][1]) : "v"(mtaddr + j * 16384));
                asm volatile("ds_read_b64 %0, %1 offset:6208" : "=v"(mx[3][1][0]) : "v"(mtaddr + j * 16384));
                asm volatile("ds_read_b64 %0, %1 offset:6240" : "=v"(mx[3][1][1]) : "v"(mtaddr + j * 16384));
                asm volatile("ds_read_b64 %0, %1 offset:8288" : "=v"(nvv[3]) : "v"(nladdr + j * 16384));
                u32x4 sb[2];
#pragma unroll
                for (int s_ = 0; s_ < 2; ++s_) sb[s_] = (u32x4){pack2(st[2 * s_][0], st[2 * s_][1]), pack2(st[2 * s_][2], st[2 * s_][3]), pack2(st[2 * s_ + 1][0], st[2 * s_ + 1][1]), pack2(st[2 * s_ + 1][2], st[2 * s_ + 1][3])};
                asm volatile("s_waitcnt lgkmcnt(0)" ::: "memory");
                __builtin_amdgcn_sched_barrier(0);
#pragma unroll
                for (int tt = 0; tt < 4; ++tt) {
                    f32x4 acc = {bflo(nvv[tt].x), bfhi(nvv[tt].x), bflo(nvv[tt].y), bfhi(nvv[tt].y)};
#pragma unroll
                    for (int s_ = 0; s_ < 2; ++s_)
                        acc = __builtin_amdgcn_mfma_f32_16x16x32_bf16(__builtin_bit_cast(bf16x8, (u32x4){mx[tt][s_][0].x, mx[tt][s_][0].y, mx[tt][s_][1].x, mx[tt][s_][1].y}), __builtin_bit_cast(bf16x8, sb[s_]), acc, 0, 0, 0);
                    st[tt] = acc;
                }
                *(u32x4*)(gS0 + ((cp0 + c) * 4 + wave) * 128 + lane) = sb[0]; *(u32x4*)(gS0 + ((cp0 + c) * 4 + wave) * 128 + 64 + lane) = sb[1];
                if (c + 3 < 68) issue(cp0 + c + 3, (j + 3) & 3);
            }
        }
        asm volatile("s_waitcnt vmcnt(0)" ::: "memory");
        __syncthreads();
    }
}
__device__ __forceinline__ void ph_r3(const Params& p) {
    const int tid = tidx(), lane = tid & 63, wave = tid >> 6, fr = lane & 15, fq = lane >> 4;
    const bf16_t* gGT = (const bf16_t*)(p.ws + O_X + X_GT); const bf16_t* gYL = (const bf16_t*)(p.ws + O_X + X_YL);
    const u32x4* gS0 = (const u32x4*)(p.ws + O_X + X_S0);
    bf16_t* YS = (bf16_t*)(p.ws + O_H);
    for (int it = blockIdx.x * 4 + wave; it < NCP; it += gridDim.x * 4) {
        const int c = it % 68, d = (it / 68) & 1, h = (it / 136) & 7, b = it / 1088;
        const bf16_t* gt = gGT + (size_t)it * 4096; const bf16_t* yl = gYL + (size_t)it * 4096;
        u32x4 gf[4][2];
#pragma unroll
        for (int tt = 0; tt < 4; ++tt)
#pragma unroll
            for (int s_ = 0; s_ < 2; ++s_) {
                const bf16_t* q = gt + (tt * 16 + fr) * 64 + s_ * 32 + fq * 4;
                const uint2 a0 = *(const uint2*)q, a1 = *(const uint2*)(q + 16);
                gf[tt][s_] = (u32x4){a0.x, a0.y, a1.x, a1.y};
            }
#pragma unroll
        for (int vg = 0; vg < 4; ++vg) {
            const u32x4 sb0 = gS0[((size_t)it * 4 + vg) * 128 + lane], sb1 = gS0[((size_t)it * 4 + vg) * 128 + 64 + lane];
#pragma unroll
            for (int tt = 0; tt < 4; ++tt) {
                const uint2 yv = *(const uint2*)(yl + (vg * 16 + fr) * 64 + tt * 16 + fq * 4);
                f32x4 acc = {bflo(yv.x), bfhi(yv.x), bflo(yv.y), bfhi(yv.y)};
                acc = __builtin_amdgcn_mfma_f32_16x16x32_bf16(__builtin_bit_cast(bf16x8, gf[tt][0]), __builtin_bit_cast(bf16x8, sb0), acc, 0, 0, 0);
                acc = __builtin_amdgcn_mfma_f32_16x16x32_bf16(__builtin_bit_cast(bf16x8, gf[tt][1]), __builtin_bit_cast(bf16x8, sb1), acc, 0, 0, 0);
#pragma unroll
                for (int r = 0; r < 4; ++r) {
                    const int row = scan_row(b, d, c * 64 + tt * 16 + fq * 4 + r);
                    YS[((size_t)d * RT + row) * 512 + h * 64 + vg * 16 + fr] = f2bf(acc[r]);
                }
            }
        }
    }
}

__device__ __forceinline__ void ph_rpost(const Params& p, int l) {
    const int lane = tidx() & 63, wave = tidx() >> 6;
    const bf16_t* P = (const bf16_t*)(p.ws + O_P); const float* mu = p.in[I_MU] + l * 1792;
    const float* gng = p.in[I_GNG] + l * 512; const float* gnb = p.in[I_GNB] + l * 512;
    const float* BON = (const float*)(p.ws + O_X + X_BON); const bf16_t* YS = (const bf16_t*)(p.ws + O_H);
    const bf16_t* RG = (const bf16_t*)(p.ws + O_RG); bf16_t* RWO = (bf16_t*)(p.ws + O_RWO);
    for (int row = blockIdx.x * 4 + wave; row < RT; row += gridDim.x * 4) {
        const int col = lane * 8, h = lane >> 3;
        float v8[8], g8[8], y0[8], y1[8];
        xs8(P, mu, row, 1024 + col, v8);
        unpack8(*(const uint4*)(RG + (size_t)row * 512 + col), g8);
        unpack8(*(const uint4*)(YS + ((size_t)0 * RT + row) * 512 + col), y0);
        unpack8(*(const uint4*)(YS + ((size_t)1 * RT + row) * 512 + col), y1);
        const float bs = BON[((size_t)0 * RT + row) * 8 + h] + BON[((size_t)1 * RT + row) * 8 + h];
        float y[8]; float sm = 0.f;
#pragma unroll
        for (int j = 0; j < 8; ++j) { y[j] = y0[j] + y1[j]; sm += y[j]; }
        sm += __shfl_xor(sm, 1); sm += __shfl_xor(sm, 2); sm += __shfl_xor(sm, 4);
        const float mean = sm * (1.f / 64.f);
        float vs = 0.f;
#pragma unroll
        for (int j = 0; j < 8; ++j) { const float dlt = y[j] - mean; vs += dlt * dlt; }
        vs += __shfl_xor(vs, 1); vs += __shfl_xor(vs, 2); vs += __shfl_xor(vs, 4);
        const float rstd = rsqrtf(vs * (1.f / 64.f) + 64e-5f);
        float o[8];
#pragma unroll
        for (int j = 0; j < 8; ++j) o[j] = ((y[j] - mean) * rstd * gng[col + j] + gnb[col + j] + bs * v8[j]) * g8[j];
        *(uint4*)(RWO + (size_t)row * 512 + col) = pack8(o);
    }
}

__device__ __forceinline__ void ph_f1(const Params& p, int l, char* smem) {
    const bf16_t* P = (const bf16_t*)(p.ws + O_P); const bf16_t* CSC = (const bf16_t*)(p.ws + O_CSC);
    bf16_t* YT2 = (bf16_t*)(p.ws + O_YT2); bf16_t* YTC = (bf16_t*)(p.ws + O_YTC);
    const int nitems = 1024 + (l < NLAYER - 1 ? 64 : 0);
    for (int it = blockIdx.x; it < nitems; it += gridDim.x) {
        f32x4 acc[4][4];
        if (it < 1024) {
            const int b = it >> 8, g = (it >> 6) & 3, part = (it >> 5) & 1, j = it & 31;
            RPPlain rpa{CSC + (size_t)part * 128 * 128, 128};
            const bf16_t* pb = P + (size_t)b * SEQ * LDP + g * 128;
            auto rpb = [&](int r) -> const bf16_t* { return pb + (size_t)(64 * (r & 63) + 2 * j + (r >> 6)) * LDP; };
            gemm_core_gb<4>(rpa, rpb, 128, acc, smem);
            acc_foreach<4>(acc, [&](int m, int n, const f32x4& v) {
                const int t1 = n & 63, t2 = 2 * j + (n >> 6);
                store_bf16x4(YT2 + ((size_t)(b * 512 + g * 128 + m) * 64 + t2) * 128 + part * 64 + t1, v);
            });
        } else {
            const int jj = it - 1024, b = jj >> 4, g = (jj >> 2) & 3, part = (jj >> 1) & 1, nt = jj & 1;
            RPPlain rpa{CSC + (size_t)part * 128 * 128, 128};
            gemm_core_g<4>(rpa, P + (size_t)(RL + b * CTX + nt * 128) * LDP + g * 128, LDP, 128, acc, smem);
            acc_foreach<4>(acc, [&](int m, int n, const f32x4& v) {
                store_bf16x4(YTC + ((size_t)(b * 512 + g * 128 + m)) * 512 + part * 256 + nt * 128 + n, v);
            });
        }
    }
}
__device__ __forceinline__ void ph_fa(const Params& p, char* smem) {
    const bf16_t* YT2 = (const bf16_t*)(p.ws + O_YT2); const bf16_t* D128 = (const bf16_t*)(p.ws + O_D128);
    const float* TWC = (const float*)(p.ws + O_TWC); const float* TWS = (const float*)(p.ws + O_TWS);
    bf16_t* A2 = (bf16_t*)(p.ws + O_A2);
    for (int it = blockIdx.x; it < 1024; it += gridDim.x) {
        f32x4 acc[4][4];
        RPPlain rpa{D128, 128};
        gemm_core_g<4>(rpa, YT2 + (size_t)it * 128 * 128, 128, 128, acc, smem);
        const int lane = tidx() & 63, wave = tidx() >> 6, wr = wave >> 1, wc = wave & 1, fr = lane & 15, fq = lane >> 4;
        float* U = (float*)smem;
        if (wr == 1) {
#pragma unroll
            for (int i = 0; i < 4; ++i)
#pragma unroll
                for (int j = 0; j < 4; ++j) *(f32x4*)(U + (i * 16 + fr) * 132 + wc * 64 + j * 16 + fq * 4) = acc[i][j];
        }
        __syncthreads();
        if (wr == 0) {
#pragma unroll
            for (int i = 0; i < 4; ++i) {
                const int k1 = i * 16 + fr;
#pragma unroll
                for (int j = 0; j < 4; ++j) {
                    const int r = wc * 64 + j * 16 + fq * 4;
                    const int R = it * 128 + r, bn = R >> 6, t2 = R & 63, b = bn >> 9, n = bn & 511;
                    const f32x4 ai = *(const f32x4*)(U + k1 * 132 + r);
                    const f32x4 c = *(const f32x4*)(TWC + k1 * 64 + t2), sn = *(const f32x4*)(TWS + k1 * 64 + t2);
                    const f32x4 ar = acc[i][j];
                    const f32x4 pr = ar * c - ai * sn, pi = ar * sn + ai * c;
                    bf16_t* dst = A2 + ((size_t)(b * 64 + k1) * 512 + n) * 128 + t2;
                    store_bf16x4(dst, pr); store_bf16x4(dst + 64, pi);
                }
            }
        }
        __syncthreads();
    }
}
__device__ __forceinline__ void ph_fb(const Params& p, int l, char* smem) {
    const bf16_t* A2 = (const bf16_t*)(p.ws + O_A2); const bf16_t* E64 = (const bf16_t*)(p.ws + O_E64);
    const bf16_t* CST2 = (const bf16_t*)(p.ws + O_CST256); const bf16_t* YTC = (const bf16_t*)(p.ws + O_YTC);
    bf16_t* FA = (bf16_t*)(p.ws + O_FA);
    const int nitems = 1024 + (l < NLAYER - 1 ? 32 : 0);
    for (int it = blockIdx.x; it < nitems; it += gridDim.x) {
        if (it < 1024) {
            const int b = it >> 8, k1 = (it >> 2) & 63, nt = it & 3;
            f32x4 acc[2][4];
            RPPlain rpa{E64, 128};
            gemm_core_g<2>(rpa, A2 + ((size_t)(b * 64 + k1) * 512 + nt * 128) * 128, 128, 128, acc, smem);
            const float sc = 0.001381067932004975f;
            acc_foreach<2>(acc, [&](int m, int n, const f32x4& v) { f32x4 o = v * sc; store_bf16x4(FA + (size_t)(b * SEQ + k1 + 64 * m) * 512 + nt * 128 + n, o); });
        } else {
            const int j = it - 1024, b = j >> 3, mt = (j >> 2) & 1, nt = j & 3;
            f32x4 acc[4][4];
            RPPlain rp{CST2 + (size_t)mt * 128 * 512, 512};
            gemm_core_g<4>(rp, YTC + ((size_t)b * 512 + nt * 128) * 512, 512, 512, acc, smem);
            const float sc = 0.005524271728019903f;
            acc_foreach<4>(acc, [&](int m, int n, const f32x4& v) { f32x4 o = v * sc; store_bf16x4(FA + (size_t)(RL + b * CTX + mt * 128 + m) * 512 + nt * 128 + n, o); });
        }
    }
}

__device__ __forceinline__ void ph_mg(const Params& p, int l, char* smem) {
    const bf16_t* P = (const bf16_t*)(p.ws + O_P);
    const bf16_t* A0 = (const bf16_t*)(p.ws + O_FA); const bf16_t* A1 = (const bf16_t*)(p.ws + O_ATT); const bf16_t* A2 = (const bf16_t*)(p.ws + O_RWO);
    const bf16_t* W0 = (const bf16_t*)(p.ws + O_WB + W_PA); const bf16_t* W1 = (const bf16_t*)(p.ws + O_WB + W_PB); const bf16_t* W2 = (const bf16_t*)(p.ws + O_WB + W_PC);
    bf16_t* MG = (bf16_t*)(p.ws + O_H);
    const int nmt = (l < NLAYER - 1) ? RT / 128 : RL / 128;
    for (int it = blockIdx.x; it < nmt * 8; it += gridDim.x) {
        const int mt = it >> 3, nt = it & 7;
        f32x4 tot[4][4];
#pragma unroll
        for (int i = 0; i < 4; ++i)
#pragma unroll
            for (int j = 0; j < 4; ++j) tot[i][j] = (f32x4){0.f, 0.f, 0.f, 0.f};
#pragma unroll 1
        for (int br = 0; br < 3; ++br) {
            const bf16_t* Ab = br == 0 ? A0 : (br == 1 ? A1 : A2);
            const bf16_t* Wb = br == 0 ? W0 : (br == 1 ? W1 : W2);
            f32x4 acc[4][4];
            RPPlain rp{Ab + (size_t)mt * 128 * 512, 512};
            gemm_core_g<4>(rp, Wb + (size_t)nt * 128 * 512, 512, 512, acc, smem);
            const int lane = tidx() & 63, wave = tidx() >> 6, wr = wave >> 1, wc = wave & 1, fr = lane & 15, fq = lane >> 4;
#pragma unroll
            for (int i = 0; i < 4; ++i)
#pragma unroll
                for (int j = 0; j < 4; ++j) {
                    const int m = wr * 64 + i * 16 + fr, n = wc * 64 + j * 16 + fq * 4;
                    const uint2 gu = *(const uint2*)(P + (size_t)(mt * 128 + m) * LDP + PG0 + br * 1024 + nt * 128 + n);
                    tot[i][j][0] += bflo(gu.x) * acc[i][j][0]; tot[i][j][1] += bfhi(gu.x) * acc[i][j][1];
                    tot[i][j][2] += bflo(gu.y) * acc[i][j][2]; tot[i][j][3] += bfhi(gu.y) * acc[i][j][3];
                }
        }
        acc_foreach<4>(tot, [&](int m, int n, const f32x4& v) { store_bf16x4(MG + (size_t)(mt * 128 + m) * 1024 + nt * 128 + n, v); });
    }
}
__device__ __forceinline__ void ph_out(const Params& p, int l, char* smem) {
    const bf16_t* MG = (const bf16_t*)(p.ws + O_H); const bf16_t* W = (const bf16_t*)(p.ws + O_WB + W_OUT);
    float* xcur = (float*)(p.ws + O_XCUR); const float* mod = (const float*)(p.ws + O_MOD);
    const int nmt = (l < NLAYER - 1) ? RT / 64 : RL / 64;
    for (int it = blockIdx.x; it < nmt * 8; it += gridDim.x) {
        const int mt = it >> 3, nt = it & 7;
        f32x4 acc[2][4];
        RPPlain rp{MG + (size_t)mt * 64 * 1024, 1024};
        gemm_core_g<2>(rp, W + (size_t)nt * 128 * 1024, 1024, 1024, acc, smem);
        acc_foreach<2>(acc, [&](int m, int n, const f32x4& v) {
            const int row = mt * 64 + m, col = nt * 128 + n;
            const float4 g = *(const float4*)(mod + (size_t)(l * 5 + modidx(row)) * 6144 + 2048 + col);
            float4* xp = (float4*)(xcur + (size_t)row * 1024 + col);
            float4 x = *xp; x.x += g.x * v[0]; x.y += g.y * v[1]; x.z += g.z * v[2]; x.w += g.w * v[3]; *xp = x;
        });
    }
}

__device__ __forceinline__ void ph_n2(const Params& p, int l, char* smem) {
    const int tid = tidx(), lane = tid & 63, wave = tid >> 6;
    unsigned* lcnt = (unsigned*)smem;
    unsigned* gbase = lcnt + 16;
    int* rec = (int*)(smem + 256);
    float4* rwl = (float4*)(smem + 8192);
    for (int idx = tid; idx < 4096; idx += 256) {
        const int k = idx >> 2, pp = idx & 3;
        rwl[(((k >> 8) * 16 + (k & 3) * 4 + pp) << 6) + ((k & 255) >> 2)] = *(const float4*)(p.in[I_RW] + (size_t)k * 16 + pp * 4);
    }
    if (tid < 16) lcnt[tid] = 0u;
    __syncthreads();
    int nrec = 0;
    const float* xcur = (const float*)(p.ws + O_XCUR); const float* mod = (const float*)(p.ws + O_MOD);
    bf16_t* H = (bf16_t*)(p.ws + O_H);
    unsigned* cnt = (unsigned*)(p.ws + O_CNT); int* LTOK = (int*)(p.ws + O_LTOK); float* LW = (float*)(p.ws + O_LW); int* SLOT = (int*)(p.ws + O_SLOT);
    const float* g = p.in[I_N2G] + l * 1024; const float* rw = p.in[I_RW]; const float* rb = p.in[I_RB];
    const int nrows = (l < NLAYER - 1) ? RT : RL;
    float4 vn[4];
    {
        const int r0 = blockIdx.x * 4 + wave;
        const float* x0 = xcur + (size_t)(r0 < nrows ? r0 : 0) * 1024;
#pragma unroll
        for (int i = 0; i < 4; ++i) vn[i] = *(const float4*)(x0 + lane * 4 + 256 * i);
    }
    for (int row = blockIdx.x * 4 + wave; row < nrows; row += gridDim.x * 4) {
        const float* md = mod + (size_t)(l * 5 + modidx(row)) * 6144;
        float4 v[4]; float ss = 0.f;
#pragma unroll
        for (int i = 0; i < 4; ++i) { v[i] = vn[i]; ss += v[i].x * v[i].x + v[i].y * v[i].y + v[i].z * v[i].z + v[i].w * v[i].w; }
        {
            const int rn = row + gridDim.x * 4;
            const float* xn = xcur + (size_t)(rn < nrows ? rn : row) * 1024;
#pragma unroll
            for (int i = 0; i < 4; ++i) vn[i] = *(const float4*)(xn + lane * 4 + 256 * i);
        }
        ss = wsum(ss);
        const float rstd = rsqrtf(ss * (1.f / 1024.f) + 1e-6f);
        float lg[16];
#pragma unroll
        for (int e = 0; e < 16; ++e) lg[e] = 0.f;
#pragma unroll
        for (int i = 0; i < 4; ++i) {
            const int c = lane * 4 + 256 * i;
            const float4 gg = *(const float4*)(g + c), sc = *(const float4*)(md + 4096 + c), sh = *(const float4*)(md + 3072 + c);
            const float hv[4] = {v[i].x * rstd * gg.x * (1.f + sc.x) + sh.x, v[i].y * rstd * gg.y * (1.f + sc.y) + sh.y,
                                 v[i].z * rstd * gg.z * (1.f + sc.z) + sh.z, v[i].w * rstd * gg.w * (1.f + sc.w) + sh.w};
            f32x4 h4 = {hv[0], hv[1], hv[2], hv[3]};
            store_bf16x4(H + (size_t)row * 1024 + c, h4);
#pragma unroll
            for (int j = 0; j < 4; ++j) {
                const float4* wr_ = rwl + ((i * 16 + j * 4) << 6) + lane;
                const float4 w0 = wr_[0], w1 = wr_[64], w2 = wr_[128], w3 = wr_[192];
                lg[0] += hv[j] * w0.x; lg[1] += hv[j] * w0.y; lg[2] += hv[j] * w0.z; lg[3] += hv[j] * w0.w;
                lg[4] += hv[j] * w1.x; lg[5] += hv[j] * w1.y; lg[6] += hv[j] * w1.z; lg[7] += hv[j] * w1.w;
                lg[8] += hv[j] * w2.x; lg[9] += hv[j] * w2.y; lg[10] += hv[j] * w2.z; lg[11] += hv[j] * w2.w;
                lg[12] += hv[j] * w3.x; lg[13] += hv[j] * w3.y; lg[14] += hv[j] * w3.z; lg[15] += hv[j] * w3.w;
            }
        }
        float sc_[16], sel[16];
#pragma unroll
        for (int e = 0; e < 16; ++e) { lg[e] = wsum(lg[e]); sc_[e] = 1.f / (1.f + expf(-lg[e])); sel[e] = sc_[e] + rb[e]; }
        int best = 0; float bestv = -1e30f;
#pragma unroll
        for (int gi = 0; gi < 4; ++gi) {
            float m1 = -1e30f, m2 = -1e30f;
#pragma unroll
            for (int j = 0; j < 4; ++j) { const float s = sel[gi * 4 + j]; if (s > m1) { m2 = m1; m1 = s; } else if (s > m2) m2 = s; }
            const float gs = m1 + m2;
            if (gs > bestv) { bestv = gs; best = gi; }
        }
        float s4[4] = {0.f, 0.f, 0.f, 0.f}, c4[4] = {0.f, 0.f, 0.f, 0.f};
#pragma unroll
        for (int gi = 0; gi < 4; ++gi)
#pragma unroll
            for (int j = 0; j < 4; ++j) if (gi == best) { s4[j] = sel[gi * 4 + j]; c4[j] = sc_[gi * 4 + j]; }
        int i1 = 0; float v1 = s4[0], w1 = c4[0];
#pragma unroll
        for (int j = 1; j < 4; ++j) if (s4[j] > v1) { v1 = s4[j]; i1 = j; w1 = c4[j]; }
        int i2 = -1; float v2 = -1e30f, w2 = 0.f;
#pragma unroll
        for (int j = 0; j < 4; ++j) if (j != i1 && s4[j] > v2) { v2 = s4[j]; i2 = j; w2 = c4[j]; }
        if (lane == 0) {
            const float inv = 1.f / (w1 + w2);
            const int e1 = best * 4 + i1, e2 = best * 4 + i2;
            const unsigned r1 = atomicAdd(&lcnt[e1], 1u), r2 = atomicAdd(&lcnt[e2], 1u);
            int* rc = rec + (wave * 32 + nrec) * 8;
            rc[0] = row; rc[1] = e1; rc[2] = e2; rc[3] = (int)r1; rc[4] = (int)r2; rc[5] = __float_as_int(w1 * inv); rc[6] = __float_as_int(w2 * inv);
        }
        ++nrec;
    }
    __syncthreads();
    if (tid < 16) gbase[tid] = lcnt[tid] ? atomicAdd(&cnt[tid], lcnt[tid]) : 0u;
    __syncthreads();
    for (int i = lane; i < nrec; i += 64) {
        const int* rc = rec + (wave * 32 + i) * 8;
        const int row = rc[0], e1 = rc[1], e2 = rc[2];
        const unsigned p1 = gbase[e1] + (unsigned)rc[3], p2 = gbase[e2] + (unsigned)rc[4];
        LTOK[(size_t)e1 * RT + p1] = row; LW[(size_t)e1 * RT + p1] = __int_as_float(rc[5]);
        LTOK[(size_t)e2 * RT + p2] = row; LW[(size_t)e2 * RT + p2] = __int_as_float(rc[6]);
        SLOT[row * 2] = (e1 << 20) | (int)p1; SLOT[row * 2 + 1] = (e2 << 20) | (int)p2;
    }
}

struct MoeTiles { int tb[17]; int sm; };
__device__ __forceinline__ void moe_tiles(const Params& p, int l, int* s_tb) {
    if (tidx() == 0) {
        const unsigned* cnt = (const unsigned*)(p.ws + O_CNT);
        int a = 0;
        for (int e = 0; e < 16; ++e) { s_tb[e] = a; a += ((int)cnt[e] + 127) >> 7; }
        s_tb[16] = a;
    }
    __syncthreads();
}
__device__ __forceinline__ void ph_e1(const Params& p, int l, char* smem) {
    int* s_tb = (int*)(smem + 73728);
    moe_tiles(p, l, s_tb);
    const bf16_t* H = (const bf16_t*)(p.ws + O_H); bf16_t* ACT = (bf16_t*)(p.ws + O_P);
    const unsigned* cnt = (const unsigned*)(p.ws + O_CNT); const int* LTOK = (const int*)(p.ws + O_LTOK); const float* LW = (const float*)(p.ws + O_LW);
    const int sm = (l < NLAYER - 1) ? RT / 128 : RL / 128;
    const int total = (sm + s_tb[16]) * 8;
    for (int it = blockIdx.x; it < total; it += gridDim.x) {
        const int mt = it >> 3, nt = it & 7;
        int e = 16, erow0 = mt * 128, lt = 0;
        if (mt >= sm) { const int q = mt - sm; e = 0; while (q >= s_tb[e + 1]) ++e; lt = q - s_tb[e]; erow0 = RT + q * 128; }
        const int cnte = (e == 16) ? 0 : (int)cnt[e];
        auto rp = [&](int r) -> const bf16_t* {
            if (e == 16) return H + (size_t)(mt * 128 + r) * 1024;
            const int idx = lt * 128 + r;
            const int tok = idx < cnte ? LTOK[(size_t)e * RT + idx] : 0;
            return H + (size_t)tok * 1024;
        };
        f32x4 acc[4][4];
        gemm_core_g<4>(rp, (const bf16_t*)(p.ws + O_WB + W_GU) + (size_t)e * 1024 * 1024 + (size_t)nt * 128 * 1024, 1024, 1024, acc, smem);
        {
            const int lane = tidx() & 63, wave = tidx() >> 6, wr = wave >> 1, wc = wave & 1, fr = lane & 15, fq = lane >> 4;
            float* U = (float*)smem;
#pragma unroll
            for (int ii = 0; ii < 2; ++ii) {
                const int i = wc == 0 ? 2 + ii : ii;
#pragma unroll
                for (int j = 0; j < 4; ++j) { const f32x4 gv = wc == 0 ? acc[2 + ii][j] : acc[ii][j]; *(f32x4*)(U + (wr * 64 + i * 16 + fr) * 68 + j * 16 + fq * 4) = gv; }
            }
            __syncthreads();
#pragma unroll
            for (int ii = 0; ii < 2; ++ii) {
                const int i = wc == 0 ? ii : 2 + ii;
                const int m = wr * 64 + i * 16 + fr;
                float wgt = 1.f;
                if (e != 16) { const int idx = lt * 128 + m; wgt = idx < cnte ? LW[(size_t)e * RT + idx] : 0.f; }
#pragma unroll
                for (int j = 0; j < 4; ++j) {
                    const f32x4 other = *(const f32x4*)(U + m * 68 + j * 16 + fq * 4);
                    f32x4 o;
                    const f32x4 mine = wc == 0 ? acc[ii][j] : acc[2 + ii][j];
#pragma unroll
                    for (int r = 0; r < 4; ++r) { const float g = wc == 0 ? mine[r] : other[r], u = wc == 0 ? other[r] : mine[r]; o[r] = siluf_(g) * u * wgt; }
                    store_bf16x4(ACT + (size_t)(erow0 + m) * 512 + nt * 64 + j * 16 + fq * 4, o);
                }
            }
            __syncthreads();
        }
    }
}
__device__ __forceinline__ void ph_e2(const Params& p, int l, char* smem) {
    int* s_tb = (int*)(smem + 73728);
    moe_tiles(p, l, s_tb);
    const bf16_t* ACT = (const bf16_t*)(p.ws + O_P); bf16_t* YE = (bf16_t*)(p.ws + O_X + X_YE);
    const int sm = (l < NLAYER - 1) ? RT / 128 : RL / 128;
    const int total = (sm + s_tb[16]) * 8;
    for (int it = blockIdx.x; it < total; it += gridDim.x) {
        const int mt = it >> 3, nt = it & 7;
        int e = 16, erow0 = mt * 128;
        if (mt >= sm) { const int q = mt - sm; e = 0; while (q >= s_tb[e + 1]) ++e; erow0 = RT + q * 128; }
        RPPlain rp{ACT + (size_t)erow0 * 512, 512};
        f32x4 acc[4][4];
        gemm_core_g<4>(rp, (const bf16_t*)(p.ws + O_WB + W_D) + (size_t)e * 1024 * 512 + (size_t)nt * 128 * 512, 512, 512, acc, smem);
        acc_foreach<4>(acc, [&](int m, int n, const f32x4& v) { store_bf16x4(YE + (size_t)(erow0 + m) * 1024 + nt * 128 + n, v); });
    }
}
__device__ __forceinline__ void ph_e3(const Params& p, int l, char* smem) {
    int* s_tb = (int*)(smem + 73728);
    moe_tiles(p, l, s_tb);
    const int lane = tidx() & 63, wave = tidx() >> 6;
    const bf16_t* YE = (const bf16_t*)(p.ws + O_X + X_YE); const int* SLOT = (const int*)(p.ws + O_SLOT);
    float* xcur = (float*)(p.ws + O_XCUR); const float* mod = (const float*)(p.ws + O_MOD);
    bf16_t* H = (bf16_t*)(p.ws + O_H);
    const bool last = l == NLAYER - 1;
    const int nrows = last ? RL : RT;
    const float* gn = last ? p.in[I_FNG] : p.in[I_N1G] + (l + 1) * 1024;
    const int stride = gridDim.x * 4, row0 = blockIdx.x * 4 + wave;
    auto slot_rows = [&](int row, size_t& r1, size_t& r2) {
        const int rr = row < nrows ? row : 0;
        const int s1 = SLOT[rr * 2], s2 = SLOT[rr * 2 + 1];
        r1 = (size_t)RT + s_tb[s1 >> 20] * 128 + (s1 & 0xfffff); r2 = (size_t)RT + s_tb[s2 >> 20] * 128 + (s2 & 0xfffff);
    };
    uint4 ya[2], yb[2], yd[2]; float4 xa[2][2];
    size_t r1n, r2n;
    auto load_row = [&](int row, size_t r1, size_t r2) {
        const size_t rr = row < nrows ? row : 0;
#pragma unroll
        for (int i = 0; i < 2; ++i) {
            const int c = lane * 8 + 512 * i;
            ya[i] = *(const uint4*)(YE + rr * 1024 + c); yb[i] = *(const uint4*)(YE + r1 * 1024 + c); yd[i] = *(const uint4*)(YE + r2 * 1024 + c);
            const float4* xp = (const float4*)(xcur + rr * 1024 + c);
            xa[i][0] = xp[0]; xa[i][1] = xp[1];
        }
    };
    { size_t r1, r2; slot_rows(row0, r1, r2); load_row(row0, r1, r2); slot_rows(row0 + stride, r1n, r2n); }
    for (int row = row0; row < nrows; row += stride) {
        const float* g2 = mod + (size_t)(l * 5 + modidx(row)) * 6144 + 5120;
        float xv[2][8]; float ss = 0.f;
#pragma unroll
        for (int i = 0; i < 2; ++i) {
            const int c = lane * 8 + 512 * i;
            float a[8], b[8], d[8];
            unpack8(ya[i], a); unpack8(yb[i], b); unpack8(yd[i], d);
            const float4 x0 = xa[i][0], x1 = xa[i][1];
            const float4 ga = *(const float4*)(g2 + c), gb = *(const float4*)(g2 + c + 4);
            const float xo[8] = {x0.x, x0.y, x0.z, x0.w, x1.x, x1.y, x1.z, x1.w}, gg[8] = {ga.x, ga.y, ga.z, ga.w, gb.x, gb.y, gb.z, gb.w};
#pragma unroll
            for (int e = 0; e < 8; ++e) { xv[i][e] = xo[e] + gg[e] * (a[e] + b[e] + d[e]); ss += xv[i][e] * xv[i][e]; }
            if (!last) { float4* xp = (float4*)(xcur + (size_t)row * 1024 + c); xp[0] = make_float4(xv[i][0], xv[i][1], xv[i][2], xv[i][3]); xp[1] = make_float4(xv[i][4], xv[i][5], xv[i][6], xv[i][7]); }
        }
        { const size_t r1 = r1n, r2 = r2n; load_row(row + stride, r1, r2); slot_rows(row + 2 * stride, r1n, r2n); }
        ss = wsum(ss);
        const float rstd = rsqrtf(ss * (1.f / 1024.f) + 1e-6f);
        const float* md = mod + (size_t)((l + 1) * 5 + modidx(row)) * 6144;
#pragma unroll
        for (int i = 0; i < 2; ++i) {
            const int c = lane * 8 + 512 * i;
            const float4 n0 = *(const float4*)(gn + c), n1 = *(const float4*)(gn + c + 4);
            const float nn[8] = {n0.x, n0.y, n0.z, n0.w, n1.x, n1.y, n1.z, n1.w};
            if (last) {
                float* op = p.out + (size_t)row * 1024 + c;
                *(float4*)op = make_float4(xv[i][0] * rstd * nn[0], xv[i][1] * rstd * nn[1], xv[i][2] * rstd * nn[2], xv[i][3] * rstd * nn[3]);
                *(float4*)(op + 4) = make_float4(xv[i][4] * rstd * nn[4], xv[i][5] * rstd * nn[5], xv[i][6] * rstd * nn[6], xv[i][7] * rstd * nn[7]);
            } else {
                const float4 c0 = *(const float4*)(md + 1024 + c), c1 = *(const float4*)(md + 1024 + c + 4), h0 = *(const float4*)(md + c), h1 = *(const float4*)(md + c + 4);
                const float sc[8] = {c0.x, c0.y, c0.z, c0.w, c1.x, c1.y, c1.z, c1.w}, sh[8] = {h0.x, h0.y, h0.z, h0.w, h1.x, h1.y, h1.z, h1.w};
                float o[8];
#pragma unroll
                for (int e = 0; e < 8; ++e) o[e] = xv[i][e] * rstd * nn[e] * (1.f + sc[e]) + sh[e];
                *(uint4*)(H + (size_t)row * 1024 + c) = pack8(o);
            }
        }
    }
}
constexpr int LDS_BYTES = 76800;
constexpr int NIV = 19;
extern __shared__ __attribute__((aligned(16))) char dynsmem[];
template <int ID> __device__ __forceinline__ void run_iv(const Params& pin, int l, char* smem) {
    Params p = pin; p.ws = launder(pin.ws);
    if constexpr (ID == 0) { ph_pre(p, smem); __syncthreads(); ph_w(p, 0, smem); }
    else if constexpr (ID == 1) ph_n1(p, l);
    else if constexpr (ID == 2) ph_g1(p, smem);
    else if constexpr (ID == 3) { ph_qu(p, smem); ph_rp1(p, l, smem); ph_rp2(p, l); ph_f1(p, l, smem); }
    else if constexpr (ID == 4) ph_m2(p, smem);
    else if constexpr (ID == 5) {
        const bool r1first = (blockIdx.x >> 8) & 1;
#pragma unroll 1
        for (int pass = 0; pass < 2; ++pass) {
            if ((pass == 0) == r1first) { ph_r1(p, l, smem); ph_fa(p, smem); } else ph_at(p, l, smem);
            __syncthreads();
        }
    }
    else if constexpr (ID == 8) { ph_r2(p, smem); __syncthreads(); ph_fb(p, l, smem); }
    else if constexpr (ID == 9) ph_r3(p);
    else if constexpr (ID == 10) ph_rpost(p, l);
    else if constexpr (ID == 12) ph_mg(p, l, smem);
    else if constexpr (ID == 13) ph_out(p, l, smem);
    else if constexpr (ID == 14) ph_n2(p, l, smem);
    else if constexpr (ID == 15) ph_e1(p, l, smem);
    else if constexpr (ID == 16) ph_e2(p, l, smem);
    else if constexpr (ID == 17) { ph_e3(p, l, smem); __syncthreads(); if (l + 1 < NLAYER) ph_w(p, l + 1, smem); }
}
#if MEGA
#ifndef PROBE_MASK
#define PROBE_MASK 0
#define PROBE_REP 1
#endif
#define IV(ID) for (int r_ = 0; r_ < (((PROBE_MASK >> (ID)) & 1) ? PROBE_REP : 1); ++r_) { run_iv<ID>(p, l, smem); xcd_barrier(bar); }
__global__ void __launch_bounds__(256, 2) k_mega(Params p) {
    char* smem = dynsmem;
    volatile LAS unsigned* st = (volatile LAS unsigned*)(smem + LDS_BYTES - 16);
    if (tidx() == 0) { st[0] = 0u; st[1] = 0u; }
    __syncthreads();
    XcdBarrier bar = xcd_barrier_post((unsigned*)(p.ws + O_BAR), st);
    { const int l = 0; IV(0) }
    for (int l = 0; l < NLAYER; ++l) {
        if (l == 0) { IV(1) } IV(2) IV(3) IV(4) IV(5) IV(8) IV(9) IV(10) IV(12) IV(13) IV(14) IV(15) IV(16) IV(17)
    }
}
#else
template <int ID> __global__ void __launch_bounds__(256, 2) k_iv(Params p, int l) { run_iv<ID>(p, l, dynsmem); }
template <int ID> static void launch_iv(const Params& p, int l, int grid, hipStream_t s) {
    static bool once = false; if (!once) { once = true; (void)hipFuncSetAttribute((const void*)k_iv<ID>, hipFuncAttributeMaxDynamicSharedMemorySize, LDS_BYTES); }
    hipLaunchKernelGGL(k_iv<ID>, dim3(grid), dim3(256), LDS_BYTES, s, p, l);
}
#endif

extern "C" void kernel_launch(void* const* d_in, const int* in_sizes, int n_in, void* d_out, int out_size, void* d_ws, size_t ws_size, hipStream_t stream) {
    (void)in_sizes; (void)out_size;
    if (n_in < N_IN || ws_size < WS_NEED) return;
    Params p{};
    for (int i = 0; i < N_IN; ++i) p.in[i] = (const float*)d_in[i];
    p.out = (float*)d_out; p.ws = (char*)d_ws;
    static int grid = 0;
    if (!grid) {
        int dev = 0, cus = 0; (void)hipGetDevice(&dev); (void)hipDeviceGetAttribute(&cus, hipDeviceAttributeMultiprocessorCount, dev);
        int per_cu = 2;
#if MEGA
        (void)hipFuncSetAttribute((const void*)k_mega, hipFuncAttributeMaxDynamicSharedMemorySize, LDS_BYTES);
        int occ = 0; (void)hipOccupancyMaxActiveBlocksPerMultiprocessor(&occ, k_mega, 256, LDS_BYTES);
        if (occ < per_cu) per_cu = occ;
        if (per_cu < 1) per_cu = 1;
#endif
        grid = cus * per_cu;
    }
#if MEGA
    (void)hipMemsetAsync(p.ws + O_BAR, 0, 16384, stream);
    hipLaunchKernelGGL(k_mega, dim3(grid), dim3(256), LDS_BYTES, stream, p);
#else
    launch_iv<0>(p, 0, grid, stream);
    for (int l = 0; l < NLAYER; ++l) {
        if (l == 0) launch_iv<1>(p, l, grid, stream); launch_iv<2>(p, l, grid, stream); launch_iv<3>(p, l, grid, stream); launch_iv<4>(p, l, grid, stream);
        launch_iv<5>(p, l, grid, stream); launch_iv<8>(p, l, grid, stream);
        launch_iv<9>(p, l, grid, stream); launch_iv<10>(p, l, grid, stream); launch_iv<12>(p, l, grid, stream);
        launch_iv<13>(p, l, grid, stream); launch_iv<14>(p, l, grid, stream); launch_iv<15>(p, l, grid, stream); launch_iv<16>(p, l, grid, stream); launch_iv<17>(p, l, grid, stream);
    }
#endif
}
```

```cpp
#include <hip/hip_runtime.h>
#include <stdint.h>

#ifndef MEGA
#define MEGA 1
#endif

typedef unsigned short bf16_t;
typedef short bf16x8 __attribute__((ext_vector_type(8)));
typedef float f32x4 __attribute__((ext_vector_type(4)));
typedef float f32x2 __attribute__((ext_vector_type(2)));
typedef unsigned u32x4 __attribute__((ext_vector_type(4)));
typedef __bf16 bf16v2 __attribute__((ext_vector_type(2)));

constexpr int NLAYER = 4;
constexpr int DM = 1024;
constexpr int RL = 16384, RC = 1024, RT = RL + RC;
constexpr int SEQ = 4096, CTX = 256, KEYS = SEQ + CTX;
constexpr int LDP = 6144;
constexpr int PQ0 = 512, PKV0 = 896, PKR0 = 1152, PR0 = 1184, PG0 = 2976, PEND = 6048;
constexpr int NEXP = 16;
constexpr int EROWS = 54272;

enum { I_X = 0, I_C, I_CTX, I_CCTX, I_WADA, I_BADA, I_N1G, I_N2G, I_WIN, I_QNG, I_KVNG, I_WUQ, I_WUKV, I_MU, I_W0, I_WUP, I_A0, I_AUP, I_GUP,
       I_KK, I_KA, I_RK, I_GNG, I_GNB, I_WPA, I_WPB, I_WPC, I_WOUT, I_RW, I_RB, I_EG, I_EU, I_ED, I_SG, I_SU, I_SD, I_FNG, N_IN };

struct Params { const float* in[N_IN]; float* out; char* ws; };

constexpr size_t al256(size_t x) { return (x + 255) & ~(size_t)255; }
constexpr size_t O_BAR   = 0;
constexpr size_t O_CNT   = O_BAR + 16384;
constexpr size_t O_MOD   = O_CNT + 4096;
constexpr size_t O_ROPEC = O_MOD + (size_t)NLAYER * 5 * 6144 * 4;
constexpr size_t O_ROPES = O_ROPEC + (size_t)SEQ * 16 * 4;
constexpr size_t O_CSC   = O_ROPES + (size_t)SEQ * 16 * 4;
constexpr size_t O_CST256= O_CSC + 256 * 128 * 2;
constexpr size_t O_D128  = O_CST256 + 256 * 512 * 2;
constexpr size_t O_E64   = O_D128 + 128 * 128 * 2;
constexpr size_t O_TWC   = O_E64 + 64 * 128 * 2;
constexpr size_t O_TWS   = O_TWC + 64 * 64 * 4;
constexpr size_t O_YT2   = O_TWS + 64 * 64 * 4;
constexpr size_t O_A2    = O_YT2 + (size_t)4 * 512 * 64 * 128 * 2;
constexpr size_t O_YTC   = O_A2 + (size_t)4 * 512 * 64 * 128 * 2;
constexpr size_t O_XCUR  = O_YTC + (size_t)4 * 512 * 512 * 2;
constexpr size_t O_WB    = O_XCUR + (size_t)RT * DM * 4;
constexpr size_t W_IN   = 0;
constexpr size_t W_UQ   = W_IN + (size_t)6144 * 1024 * 2;
constexpr size_t W_UKV  = W_UQ + (size_t)768 * 384 * 2;
constexpr size_t W_WUP  = W_UKV + (size_t)1024 * 256 * 2;
constexpr size_t W_AUP  = W_WUP + (size_t)2 * 512 * 64 * 2;
constexpr size_t W_GUP  = W_AUP + (size_t)2 * 512 * 64 * 2;
constexpr size_t W_PA   = W_GUP + (size_t)512 * 128 * 2;
constexpr size_t W_PB   = W_PA + (size_t)1024 * 512 * 2;
constexpr size_t W_PC   = W_PB + (size_t)1024 * 512 * 2;
constexpr size_t W_OUT  = W_PC + (size_t)1024 * 512 * 2;
constexpr size_t W_GU   = W_OUT + (size_t)1024 * 1024 * 2;
constexpr size_t W_D    = W_GU + (size_t)17 * 1024 * 1024 * 2;
constexpr size_t W_END  = W_D + (size_t)17 * 1024 * 512 * 2;
constexpr size_t O_H    = O_WB + W_END;
constexpr size_t O_P    = O_H + (size_t)RT * DM * 2;
constexpr size_t O_ATT  = O_P + (size_t)RT * LDP * 2;
constexpr size_t O_RG   = O_ATT + (size_t)RT * 512 * 2;
constexpr size_t O_RWO  = O_RG + (size_t)RT * 512 * 2;
constexpr size_t O_FA   = O_RWO + (size_t)RT * 512 * 2;
constexpr size_t O_LTOK = O_FA + (size_t)RT * 512 * 2;
constexpr size_t O_LW   = O_LTOK + (size_t)NEXP * RT * 4;
constexpr size_t O_SLOT = O_LW + (size_t)NEXP * RT * 4;
constexpr size_t O_X    = al256(O_SLOT + (size_t)RT * 2 * 4);
constexpr size_t X_QA   = 0;
constexpr size_t X_KA   = X_QA + (size_t)RT * 768 * 2;
constexpr size_t X_VA   = X_KA + (size_t)4 * KEYS * 768 * 2;
constexpr int NCP = 4 * 8 * 2 * 68;
constexpr size_t X_S0   = 0;
constexpr size_t X_MT   = X_VA + (size_t)4 * 8 * 64 * KEYS * 2;
constexpr size_t X_GT   = X_MT + (size_t)NCP * 8192;
constexpr size_t X_YL   = X_GT + (size_t)NCP * 8192;
constexpr size_t X_QRAW = X_MT;
constexpr size_t X_KVRAW= X_QRAW + (size_t)RT * 768 * 2;
constexpr size_t X_KKN  = X_YL + (size_t)NCP * 8192;
constexpr size_t X_BON  = X_KKN + (size_t)RT * 8 * 4;
constexpr size_t X_END  = X_BON + (size_t)2 * RT * 8 * 4;
static_assert(X_KVRAW + (size_t)RT * 1024 * 2 <= X_YL + (size_t)NCP * 8192, "raw q/kv must fit under the chunk data");
static_assert(X_S0 + (size_t)NCP * 8192 <= X_VA, "S0 must fit in the q/k area");
constexpr size_t X_YE   = 0;
constexpr size_t WS_NEED = O_X + X_END;

__device__ __forceinline__ float bf2f(bf16_t u) { return __builtin_bit_cast(float, (unsigned)u << 16); }
__device__ __forceinline__ float bflo(unsigned u) { return __builtin_bit_cast(float, u << 16); }
__device__ __forceinline__ float bfhi(unsigned u) { return __builtin_bit_cast(float, u & 0xffff0000u); }
__device__ __forceinline__ unsigned pack2(float lo, float hi) { f32x2 v = {lo, hi}; bf16v2 b = __builtin_convertvector(v, bf16v2); return __builtin_bit_cast(unsigned, b); }
__device__ __forceinline__ bf16_t f2bf(float f) { return (bf16_t)(pack2(f, 0.f) & 0xffffu); }
__device__ __forceinline__ float wsum(float v) {
#pragma unroll
    for (int o = 32; o > 0; o >>= 1) v += __shfl_xor(v, o);
    return v;
}
__device__ __forceinline__ float sigmoidf_(float x) { return 1.f / (1.f + __expf(-x)); }
__device__ __forceinline__ float siluf_(float x) { return x / (1.f + __expf(-x)); }
__device__ __forceinline__ int modidx(int row) { return row < RL ? (row >> 12) : 4; }
__device__ __forceinline__ void unpack8(const uint4& u, float (&f)[8]) {
    f[0] = bflo(u.x); f[1] = bfhi(u.x); f[2] = bflo(u.y); f[3] = bfhi(u.y); f[4] = bflo(u.z); f[5] = bfhi(u.z); f[6] = bflo(u.w); f[7] = bfhi(u.w);
}
__device__ __forceinline__ uint4 pack8(const float (&f)[8]) { return make_uint4(pack2(f[0], f[1]), pack2(f[2], f[3]), pack2(f[4], f[5]), pack2(f[6], f[7])); }

#define XB_TMO      128
#define XB_XCNT(j)  (256  + 64 * (j))
#define XB_XSUB(j)  (1280 + 64 * (j))
#define XB_XGEN(j)  (2304 + 64 * (j))
#define XB_TOP      3328
#define XB_TOPGEN   3392
#define XCD_BAR_WORDS 3456
#define XB_SPIN_CAP (1u << 22)
#define LAS __attribute__((address_space(3)))
__device__ __forceinline__ unsigned xb_ld(unsigned* p)              { return __hip_atomic_load(p, __ATOMIC_RELAXED, __HIP_MEMORY_SCOPE_AGENT); }
__device__ __forceinline__ unsigned xb_add(unsigned* p, unsigned v) { return __hip_atomic_fetch_add(p, v, __ATOMIC_RELAXED, __HIP_MEMORY_SCOPE_AGENT); }
__device__ __forceinline__ unsigned xb_xcc_id() { return (unsigned)__builtin_amdgcn_s_getreg((3 << 11) | 20) & 0xFu; }
#define XB_SPIN(cond, bar) do { unsigned _sp = 0; while (cond) { __builtin_amdgcn_s_sleep(1); \
    if ((++_sp & 255u) == 0u) { if (xb_ld(&(bar)[XB_TMO])) break; if (_sp > XB_SPIN_CAP) { atomicAdd(&(bar)[XB_TMO], 1u); break; } } } } while (0)
struct XcdBarrier { unsigned* bar; unsigned x; volatile LAS unsigned* st; };
__device__ __forceinline__ XcdBarrier xcd_barrier_post(unsigned* bar, volatile LAS unsigned* st) {
    XcdBarrier b; b.bar = bar; b.x = xb_xcc_id(); b.st = st;
    if (threadIdx.x == 0) (void)xb_add(&bar[XB_XCNT(b.x)], 1u);
    return b;
}
__device__ __forceinline__ void xcd_barrier_complete(unsigned* bar, unsigned x, unsigned& nloc, unsigned& nx) {
    const unsigned G = gridDim.x * gridDim.y * gridDim.z;
    unsigned sum, cnt, mine, sp = 0u;
    for (;;) {
        sum = 0u; cnt = 0u; mine = 0u;
#pragma unroll
        for (unsigned j = 0; j < 16; ++j) { const unsigned c = xb_ld(&bar[XB_XCNT(j)]); sum += c; cnt += (c > 0u) ? 1u : 0u; mine = (j == x) ? c : mine; }
        if (sum == G) break;
        __builtin_amdgcn_s_sleep(1);
        if ((++sp & 255u) == 0u) { if (xb_ld(&bar[XB_TMO])) break; if (sp > XB_SPIN_CAP) { atomicAdd(&bar[XB_TMO], 1u); break; } }
    }
    nloc = mine > 0u ? mine : 1u; nx = cnt > 0u ? cnt : 1u;
}
__device__ __forceinline__ void xcd_barrier(const XcdBarrier& b) {
    asm volatile("s_waitcnt vmcnt(0)" ::: "memory");
    __syncthreads();
    if (threadIdx.x == 0) {
        unsigned* bar = b.bar;
        __builtin_amdgcn_s_waitcnt(0);
        unsigned nloc = b.st[0], nx = b.st[1];
        if (nloc == 0u) { xcd_barrier_complete(bar, b.x, nloc, nx); b.st[0] = nloc; b.st[1] = nx; }
        const unsigned old = xb_add(&bar[XB_XSUB(b.x)], 1u);
        const unsigned gen = old / nloc;
        if (old + 1u == (gen + 1u) * nloc) {
            __builtin_amdgcn_fence(__ATOMIC_RELEASE, "agent");
            asm volatile("s_waitcnt vmcnt(0)" ::: "memory");
            const unsigned og = xb_add(&bar[XB_TOP], 1u);
            const unsigned tg = og / nx;
            if (og + 1u == (tg + 1u) * nx) xb_add(&bar[XB_TOPGEN], 1u);
            else XB_SPIN(xb_ld(&bar[XB_TOPGEN]) == tg, bar);
            __builtin_amdgcn_fence(__ATOMIC_ACQUIRE, "agent");
            xb_add(&bar[XB_XGEN(b.x)], 1u);
            asm volatile("s_waitcnt vmcnt(0)" ::: "memory");
        } else {
            XB_SPIN(xb_ld(&bar[XB_XGEN(b.x)]) == gen, bar);
            __builtin_amdgcn_fence(__ATOMIC_ACQUIRE, "agent");
            asm volatile("s_waitcnt vmcnt(0)" ::: "memory");
        }
    }
    __syncthreads();
}

__device__ __forceinline__ int tidx() { int t = threadIdx.x; asm volatile("" : "+v"(t)); return t; }
__device__ __forceinline__ int lv(int x) { asm volatile("" : "+v"(x)); return x; }
__device__ __forceinline__ char* launder(char* p) { size_t z = 0; asm volatile("" : "+s"(z)); return p + z; }

constexpr int LDSROW = 72;
template <int NA, class AL>
__device__ __forceinline__ void gc_load(const AL& al, const bf16_t* bp, size_t bstep, int k0, int kc, u32x4 (&ra)[NA], u32x4 (&rb)[4]) {
#pragma unroll
    for (int i = 0; i < NA; ++i) ra[i] = __builtin_bit_cast(u32x4, al.load(i, k0 + kc));
#pragma unroll
    for (int j = 0; j < 4; ++j) rb[j] = *(const u32x4*)(bp + j * bstep + k0);
}
template <int NA>
__device__ __forceinline__ void gc_store(bf16_t* Ab, bf16_t* Bb, int lr, int kc, const u32x4 (&ra)[NA], const u32x4 (&rb)[4]) {
#pragma unroll
    for (int i = 0; i < NA; ++i) *(u32x4*)(Ab + (lr + 32 * i) * LDSROW + kc) = ra[i];
#pragma unroll
    for (int j = 0; j < 4; ++j) *(u32x4*)(Bb + (lr + 32 * j) * LDSROW + kc) = rb[j];
}
template <int MI>
__device__ __forceinline__ void gc_compute(const bf16_t* Ac, const bf16_t* Bc, f32x4 (&acc)[MI][4]) {
#pragma unroll
    for (int kh = 0; kh < 2; ++kh) {
        bf16x8 af[MI], bfv[4];
#pragma unroll
        for (int i = 0; i < MI; ++i) af[i] = *(const bf16x8*)(Ac + i * 16 * LDSROW + kh * 32);
#pragma unroll
        for (int j = 0; j < 4; ++j) bfv[j] = *(const bf16x8*)(Bc + j * 16 * LDSROW + kh * 32);
#pragma unroll
        for (int i = 0; i < MI; ++i)
#pragma unroll
            for (int j = 0; j < 4; ++j) acc[i][j] = __builtin_amdgcn_mfma_f32_16x16x32_bf16(bfv[j], af[i], acc[i][j], 0, 0, 0);
    }
}
template <int MI, class AL>
__device__ __forceinline__ void gemm_core(const AL& al, const bf16_t* __restrict__ Bt, int ldb, int K, f32x4 (&acc)[MI][4], char* smem) {
    constexpr int TM = MI * 32;
    constexpr int NA = TM / 32;
    bf16_t* As = (bf16_t*)smem;
    bf16_t* Bs = As + 2 * TM * LDSROW;
    const int tid = tidx(), lane = tid & 63, wave = tid >> 6;
    const int wr = wave >> 1, wc = wave & 1, fr = lane & 15, fq = lane >> 4;
    const int kc = (tid & 7) * 8, lr = tid >> 3;
#pragma unroll
    for (int i = 0; i < MI; ++i)
#pragma unroll
        for (int j = 0; j < 4; ++j) acc[i][j] = (f32x4){0.f, 0.f, 0.f, 0.f};
    u32x4 a0[NA], b0[4], a1[NA], b1[4];
    const bf16_t* bp = Bt + (size_t)lr * ldb + kc;
    const size_t bstep = (size_t)32 * ldb;
    const int nk = K >> 6;
    bf16_t* As1 = As + TM * LDSROW; bf16_t* Bs1 = Bs + 128 * LDSROW;
    const int aoff = (wr * MI * 16 + fr) * LDSROW + fq * 8, boff = (wc * 64 + fr) * LDSROW + fq * 8;
    gc_load<NA>(al, bp, bstep, 0, kc, a0, b0);
    gc_store<NA>(As, Bs, lr, kc, a0, b0);
    if (nk > 1) gc_load<NA>(al, bp, bstep, 64, kc, a0, b0);
    __syncthreads();
    for (int kt = 0; kt < nk; kt += 2) {
        if (kt + 2 < nk) gc_load<NA>(al, bp, bstep, (kt + 2) << 6, kc, a1, b1);
        gc_compute<MI>(As + aoff, Bs + boff, acc);
        if (kt + 1 < nk) gc_store<NA>(As1, Bs1, lr, kc, a0, b0);
        __syncthreads();
        if (kt + 1 >= nk) break;
        if (kt + 3 < nk) gc_load<NA>(al, bp, bstep, (kt + 3) << 6, kc, a0, b0);
        gc_compute<MI>(As1 + aoff, Bs1 + boff, acc);
        if (kt + 2 < nk) gc_store<NA>(As, Bs, lr, kc, a1, b1);
        __syncthreads();
    }
}
template <int MI, class RP, class RPB>
__device__ __forceinline__ void gemm_core_gb(const RP& rp, const RPB& rpb, int K, f32x4 (&acc)[MI][4], char* smem) {
    constexpr int ABYTES = MI * 32 * 128;
    constexpr int SBYTES = ABYTES + 16384;
    const int tid = tidx(), lane = tid & 63, wave = tid >> 6;
    const int wr = wave >> 1, wc = wave & 1, fr = lane & 15, fq = lane >> 4;
    const int rr = lane >> 3, cs = ((lane & 7) ^ ((wave * 4 + (lane >> 4)) & 7)) * 8;
#pragma unroll
    for (int i = 0; i < MI; ++i)
#pragma unroll
        for (int j = 0; j < 4; ++j) acc[i][j] = (f32x4){0.f, 0.f, 0.f, 0.f};
    const bf16_t* ap[MI]; const bf16_t* bp[4];
#pragma unroll
    for (int i = 0; i < MI; ++i) { const int r = (i * 4 + wave) * 8 + rr; ap[i] = rp(r) + cs; }
#pragma unroll
    for (int i = 0; i < 4; ++i) { const int r = (i * 4 + wave) * 8 + rr; bp[i] = rpb(r) + cs; }
    const int wbase = __builtin_amdgcn_readfirstlane(wave) * 1024;
    const int nk = K >> 6;
    auto stage = [&](int buf, int kt) {
        char* Ab = smem + buf * SBYTES + wbase; char* Bb = Ab + ABYTES;
#pragma unroll
        for (int i = 0; i < MI; ++i) __builtin_amdgcn_global_load_lds((const unsigned*)(ap[i] + kt * 64), (unsigned*)(Ab + i * 4096), 16, 0, 0);
#pragma unroll
        for (int i = 0; i < 4; ++i) __builtin_amdgcn_global_load_lds((const unsigned*)(bp[i] + kt * 64), (unsigned*)(Bb + i * 4096), 16, 0, 0);
    };
    const int aoff = (wr * MI * 16 + fr) * 128, boff = ABYTES + (wc * 64 + fr) * 128, sw = fr >> 1;
    stage(0, 0);
    asm volatile("s_waitcnt vmcnt(0)" ::: "memory");
    __syncthreads();
    for (int kt = 0; kt < nk; ++kt) {
        const int cur = kt & 1;
        if (kt + 1 < nk) stage(cur ^ 1, kt + 1);
        const char* base = smem + cur * SBYTES;
#pragma unroll
        for (int kh = 0; kh < 2; ++kh) {
            const int xo = ((kh * 4 + fq) ^ sw) * 16;
            bf16x8 af[MI], bfv[4];
#pragma unroll
            for (int i = 0; i < MI; ++i) af[i] = *(const bf16x8*)(base + aoff + i * 2048 + xo);
#pragma unroll
            for (int j = 0; j < 4; ++j) bfv[j] = *(const bf16x8*)(base + boff + j * 2048 + xo);
#pragma unroll
            for (int i = 0; i < MI; ++i)
#pragma unroll
                for (int j = 0; j < 4; ++j) acc[i][j] = __builtin_amdgcn_mfma_f32_16x16x32_bf16(bfv[j], af[i], acc[i][j], 0, 0, 0);
        }
        asm volatile("s_waitcnt vmcnt(0)" ::: "memory");
        __syncthreads();
    }
}
struct RPPlain;
template <int MI, class RP>
__device__ __forceinline__ void gemm_core_g(const RP& rp, const bf16_t* __restrict__ Bt, int ldb, int K, f32x4 (&acc)[MI][4], char* smem);
struct RPPlain {
    const bf16_t* A; size_t lda;
    __device__ __forceinline__ const bf16_t* operator()(int r) const { return A + (size_t)r * lda; }
};
template <int MI, class RP>
__device__ __forceinline__ void gemm_core_g(const RP& rp, const bf16_t* __restrict__ Bt, int ldb, int K, f32x4 (&acc)[MI][4], char* smem) {
    RPPlain rpb{Bt, (size_t)ldb};
    gemm_core_gb<MI>(rp, rpb, K, acc, smem);
}
template <int MI, class F>
__device__ __forceinline__ void acc_foreach(const f32x4 (&acc)[MI][4], F f) {
    const int lane = tidx() & 63, wave = tidx() >> 6;
    const int wr = wave >> 1, wc = wave & 1, fr = lane & 15, fq = lane >> 4;
#pragma unroll
    for (int i = 0; i < MI; ++i)
#pragma unroll
        for (int j = 0; j < 4; ++j) f(wr * MI * 16 + i * 16 + fr, wc * 64 + j * 16 + fq * 4, acc[i][j]);
}
struct ALPlain {
    const bf16_t* p0; size_t step;
    __device__ __forceinline__ ALPlain(const bf16_t* A, int lda, int row0) { p0 = A + (size_t)(row0 + (tidx() >> 3)) * lda; step = (size_t)32 * lda; }
    __device__ __forceinline__ uint4 load(int i, int k) const { return *(const uint4*)(p0 + i * step + k); }
};
__device__ __forceinline__ void store_bf16x4(bf16_t* dst, const f32x4& v) { *(uint2*)dst = make_uint2(pack2(v[0], v[1]), pack2(v[2], v[3])); }

__device__ __forceinline__ void ph_pre(const Params& p, char* smem) {
    const int tid = tidx(), nb = gridDim.x, bid = blockIdx.x;
    float* mod = (float*)(p.ws + O_MOD);
    {
        float* sv = (float*)smem;
        float* part = sv + 5 * 1024;
        for (int i = tid; i < 5 * 1024; i += 256) { const float v = (i < 4096) ? p.in[I_C][i] : p.in[I_CCTX][i - 4096]; sv[i] = siluf_(v); }
        __syncthreads();
        for (int it = bid; it < NLAYER * 96; it += nb) {
            const int l = it / 96, jb = it % 96;
            const int jj = tid & 63, kq = tid >> 6, j = jb * 64 + jj;
            const float* w = p.in[I_WADA] + (size_t)l * 1024 * 6144 + (size_t)(kq * 256) * 6144 + j;
            float a0 = 0.f, a1 = 0.f, a2 = 0.f, a3 = 0.f, a4 = 0.f;
#pragma unroll 8
            for (int k = 0; k < 256; ++k) {
                const float wv = w[(size_t)k * 6144]; const int kk = kq * 256 + k;
                a0 += sv[kk] * wv; a1 += sv[1024 + kk] * wv; a2 += sv[2048 + kk] * wv; a3 += sv[3072 + kk] * wv; a4 += sv[4096 + kk] * wv;
            }
            part[(kq * 5 + 0) * 64 + jj] = a0; part[(kq * 5 + 1) * 64 + jj] = a1; part[(kq * 5 + 2) * 64 + jj] = a2;
            part[(kq * 5 + 3) * 64 + jj] = a3; part[(kq * 5 + 4) * 64 + jj] = a4;
            __syncthreads();
            for (int o = tid; o < 320; o += 256) {
                const int i = o >> 6, c = o & 63;
                const float s = part[(0 * 5 + i) * 64 + c] + part[(1 * 5 + i) * 64 + c] + part[(2 * 5 + i) * 64 + c] + part[(3 * 5 + i) * 64 + c];
                mod[(size_t)(l * 5 + i) * 6144 + jb * 64 + c] = s + p.in[I_BADA][l * 6144 + jb * 64 + c];
            }
            __syncthreads();
        }
    }
    {
        float4* xc = (float4*)(p.ws + O_XCUR);
        const float4* x4 = (const float4*)p.in[I_X]; const float4* c4 = (const float4*)p.in[I_CTX];
        for (size_t i = (size_t)bid * 256 + tid; i < (size_t)RT * 256; i += (size_t)nb * 256) xc[i] = (i < (size_t)RL * 256) ? x4[i] : c4[i - (size_t)RL * 256];
    }
    {
        float* ct = (float*)smem;
        __syncthreads();
        for (int m = tid; m < 4096; m += 256) ct[m] = cospif((float)m * (1.f / 2048.f));
        __syncthreads();
        bf16_t* cst2 = (bf16_t*)(p.ws + O_CST256);
        for (int ch = bid * 256 + tid; ch < 256 * 512 / 8; ch += nb * 256) {
            const int ks = ch >> 6, c0 = (ch & 63) * 8, part = c0 >> 8, s0 = c0 & 255;
            float f[8];
#pragma unroll
            for (int e = 0; e < 8; ++e) { const int m = (16 * ks * (s0 + e)) & 4095; f[e] = part == 0 ? ct[m] : ct[(m - 1024) & 4095]; }
            *(uint4*)(cst2 + ch * 8) = pack8(f);
        }
        bf16_t* d128 = (bf16_t*)(p.ws + O_D128);
        for (int ch = bid * 256 + tid; ch < 128 * 128 / 8; ch += nb * 256) {
            const int mrow = ch >> 4, c0 = (ch & 15) * 8, po = mrow >> 6, k1 = mrow & 63, pi = c0 >> 6, t10 = c0 & 63;
            float f[8];
#pragma unroll
            for (int e = 0; e < 8; ++e) {
                const int m = (64 * k1 * (t10 + e)) & 4095; const float cv = ct[m], sv = ct[(m - 1024) & 4095];
                f[e] = (po == pi) ? cv : (po == 0 ? sv : -sv);
            }
            *(uint4*)(d128 + ch * 8) = pack8(f);
        }
        bf16_t* e64 = (bf16_t*)(p.ws + O_E64);
        for (int ch = bid * 256 + tid; ch < 64 * 128 / 8; ch += nb * 256) {
            const int k2 = ch >> 4, c0 = (ch & 15) * 8, po = c0 >> 6, t20 = c0 & 63;
            float f[8];
#pragma unroll
            for (int e = 0; e < 8; ++e) { const int m = (64 * k2 * (t20 + e)) & 4095; f[e] = po == 0 ? ct[m] : ct[(m - 1024) & 4095]; }
            *(uint4*)(e64 + ch * 8) = pack8(f);
        }
        float* twc = (float*)(p.ws + O_TWC); float* tws = (float*)(p.ws + O_TWS);
        for (int i = bid * 256 + tid; i < 64 * 64; i += nb * 256) {
            const int k1 = i >> 6, t2 = i & 63, m = (k1 * t2) & 4095;
            twc[i] = ct[m]; tws[i] = -ct[(m - 1024) & 4095];
        }
        bf16_t* csc = (bf16_t*)(p.ws + O_CSC);
        for (int ch = bid * 256 + tid; ch < 256 * 128 / 8; ch += nb * 256) {
            const int n = ch >> 4, c0 = (ch & 15) * 8, part = n >> 7, kc = n & 127;
            float f[8];
#pragma unroll
            for (int e = 0; e < 8; ++e) { const int m = (32 * kc * (c0 + e)) & 4095; f[e] = part == 0 ? ct[m] : -ct[(m - 1024) & 4095]; }
            *(uint4*)(csc + ch * 8) = pack8(f);
        }
        float* rc = (float*)(p.ws + O_ROPEC); float* rs = (float*)(p.ws + O_ROPES);
        for (int i = bid * 256 + tid; i < SEQ * 16; i += nb * 256) {
            const int t = i >> 4, ax = (i >> 3) & 1, f = i & 7;
            const float inv = powf(10000.f, -(float)f / 8.f);
            const float pos = (float)(ax == 0 ? (t >> 6) : (t & 63));
            const float ang = pos * inv;
            rc[i] = cosf(ang); rs[i] = sinf(ang);
        }
    }
}

struct ConvTask { const float* src; const float* scale; bf16_t* dst; int K, Nsrc, Ndst, rmul; size_t sbs, dbs; };
__constant__ int c_conv_cum[17] = {0, 1536, 1608, 1672, 1688, 1704, 1720, 1848, 1976, 2104, 2360, 4408, 6456, 8504, 8632, 8760, 8888};
__device__ __forceinline__ ConvTask conv_task(const Params& p, int l, int t) {
    bf16_t* wb = (bf16_t*)(p.ws + O_WB);
    ConvTask c; c.scale = nullptr; c.sbs = 0; c.dbs = 0; c.rmul = 64;
    switch (t) {
    case 0:  c.src = p.in[I_WIN] + (size_t)l * 1024 * 6048; c.K = 1024; c.Nsrc = 6048; c.Ndst = 6144; c.dst = wb + W_IN / 2; break;
    case 1:  c.src = p.in[I_WUQ] + (size_t)l * 384 * 768; c.K = 384; c.Nsrc = 768; c.Ndst = 768; c.dst = wb + W_UQ / 2; c.scale = p.in[I_QNG] + l * 384; break;
    case 2:  c.src = p.in[I_WUKV] + (size_t)l * 256 * 1024; c.K = 256; c.Nsrc = 1024; c.Ndst = 1024; c.dst = wb + W_UKV / 2; c.scale = p.in[I_KVNG] + l * 256; break;
    case 3:  c.src = p.in[I_WUP] + (size_t)l * 2 * 64 * 512; c.K = 64; c.Nsrc = 512; c.Ndst = 512; c.dst = wb + W_WUP / 2; c.sbs = 64 * 512; c.dbs = 512 * 64; break;
    case 4:  c.src = p.in[I_AUP] + (size_t)l * 2 * 64 * 512; c.K = 64; c.Nsrc = 512; c.Ndst = 512; c.dst = wb + W_AUP / 2; c.sbs = 64 * 512; c.dbs = 512 * 64; break;
    case 5:  c.src = p.in[I_GUP] + (size_t)l * 128 * 512; c.K = 128; c.Nsrc = 512; c.Ndst = 512; c.dst = wb + W_GUP / 2; break;
    case 6:  c.src = p.in[I_WPA] + (size_t)l * 512 * 1024; c.K = 512; c.Nsrc = 1024; c.Ndst = 1024; c.dst = wb + W_PA / 2; break;
    case 7:  c.src = p.in[I_WPB] + (size_t)l * 512 * 1024; c.K = 512; c.Nsrc = 1024; c.Ndst = 1024; c.dst = wb + W_PB / 2; break;
    case 8:  c.src = p.in[I_WPC] + (size_t)l * 512 * 1024; c.K = 512; c.Nsrc = 1024; c.Ndst = 1024; c.dst = wb + W_PC / 2; break;
    case 9:  c.src = p.in[I_WOUT] + (size_t)l * 1024 * 1024; c.K = 1024; c.Nsrc = 1024; c.Ndst = 1024; c.dst = wb + W_OUT / 2; break;
    case 10: c.src = p.in[I_EG] + (size_t)l * 16 * 1024 * 512; c.K = 1024; c.Nsrc = 512; c.Ndst = 512; c.dst = wb + W_GU / 2; c.sbs = 1024 * 512; c.dbs = 1024 * 1024; c.rmul = 128; break;
    case 11: c.src = p.in[I_EU] + (size_t)l * 16 * 1024 * 512; c.K = 1024; c.Nsrc = 512; c.Ndst = 512; c.dst = wb + W_GU / 2 + 64 * 1024; c.sbs = 1024 * 512; c.dbs = 1024 * 1024; c.rmul = 128; break;
    case 12: c.src = p.in[I_ED] + (size_t)l * 16 * 512 * 1024; c.K = 512; c.Nsrc = 1024; c.Ndst = 1024; c.dst = wb + W_D / 2; c.sbs = 512 * 1024; c.dbs = 1024 * 512; break;
    case 13: c.src = p.in[I_SG] + (size_t)l * 1024 * 512; c.K = 1024; c.Nsrc = 512; c.Ndst = 512; c.dst = wb + W_GU / 2 + (size_t)16 * 1024 * 1024; c.rmul = 128; break;
    case 14: c.src = p.in[I_SU] + (size_t)l * 1024 * 512; c.K = 1024; c.Nsrc = 512; c.Ndst = 512; c.dst = wb + W_GU / 2 + (size_t)16 * 1024 * 1024 + 64 * 1024; c.rmul = 128; break;
    default: c.src = p.in[I_SD] + (size_t)l * 512 * 1024; c.K = 512; c.Nsrc = 1024; c.Ndst = 1024; c.dst = wb + W_D / 2 + (size_t)16 * 1024 * 512; break;
    }
    return c;
}
__device__ __forceinline__ void ph_w(const Params& p, int l, char* smem) {
    const int tid = tidx();
    float* tl = (float*)smem;
    for (int g = blockIdx.x; g < 8888; g += gridDim.x) {
        int t = 0;
        while (g >= c_conv_cum[t + 1]) ++t;
        const ConvTask c = conv_task(p, l, t);
        int r = g - c_conv_cum[t];
        const int nkt = c.K >> 6, nnt = c.Ndst >> 6;
        const int bi = r / (nkt * nnt); r -= bi * nkt * nnt;
        const int k0 = (r / nnt) * 64, n0 = (r % nnt) * 64;
        const float* src = c.src + bi * c.sbs; bf16_t* dst = c.dst + bi * c.dbs;
#pragma unroll
        for (int i = 0; i < 4; ++i) {
            const int k = (tid >> 4) + 16 * i, n = n0 + (tid & 15) * 4;
            float4 v = make_float4(0.f, 0.f, 0.f, 0.f);
            if (n < c.Nsrc) v = *(const float4*)(src + (size_t)(k0 + k) * c.Nsrc + n);
            if (c.scale) { const float s = c.scale[k0 + k]; v.x *= s; v.y *= s; v.z *= s; v.w *= s; }
            float* d = tl + k * 65 + (tid & 15) * 4;
            d[0] = v.x; d[1] = v.y; d[2] = v.z; d[3] = v.w;
        }
        __syncthreads();
        {
            const int n = tid >> 2, kk0 = (tid & 3) * 16;
            float f[8], g2[8];
#pragma unroll
            for (int j = 0; j < 8; ++j) { f[j] = tl[(kk0 + j) * 65 + n]; g2[j] = tl[(kk0 + 8 + j) * 65 + n]; }
            bf16_t* d = dst + (size_t)((n0 >> 6) * c.rmul + n) * c.K + k0 + kk0;
            *(uint4*)d = pack8(f); *(uint4*)(d + 8) = pack8(g2);
        }
        __syncthreads();
    }
}

__device__ __forceinline__ void ph_n1(const Params& p, int l) {
    const int lane = tidx() & 63, wave = tidx() >> 6;
    const float* xcur = (const float*)(p.ws + O_XCUR); const float* mod = (const float*)(p.ws + O_MOD);
    bf16_t* H = (bf16_t*)(p.ws + O_H);
    const float* g = p.in[I_N1G] + l * 1024;
    for (int row = blockIdx.x * 4 + wave; row < RT; row += gridDim.x * 4) {
        const float* x = xcur + (size_t)row * 1024; const float* md = mod + (size_t)(l * 5 + modidx(row)) * 6144;
        float4 v[4]; float ss = 0.f;
#pragma unroll
        for (int i = 0; i < 4; ++i) { v[i] = *(const float4*)(x + lane * 4 + 256 * i); ss += v[i].x * v[i].x + v[i].y * v[i].y + v[i].z * v[i].z + v[i].w * v[i].w; }
        ss = wsum(ss);
        const float rstd = rsqrtf(ss * (1.f / 1024.f) + 1e-6f);
#pragma unroll
        for (int i = 0; i < 4; ++i) {
            const int c = lane * 4 + 256 * i;
            const float4 gg = *(const float4*)(g + c), sc = *(const float4*)(md + 1024 + c), sh = *(const float4*)(md + c);
            f32x4 h = {v[i].x * rstd * gg.x * (1.f + sc.x) + sh.x, v[i].y * rstd * gg.y * (1.f + sc.y) + sh.y,
                       v[i].z * rstd * gg.z * (1.f + sc.z) + sh.z, v[i].w * rstd * gg.w * (1.f + sc.w) + sh.w};
            store_bf16x4(H + (size_t)row * 1024 + c, h);
        }
    }
}

__device__ __forceinline__ void ph_g1(const Params& p, char* smem) {
    if (blockIdx.x == 0 && tidx() < 64) ((unsigned*)(p.ws + O_CNT))[tidx()] = 0u;
    const bf16_t* H = (const bf16_t*)(p.ws + O_H); const bf16_t* W = (const bf16_t*)(p.ws + O_WB + W_IN);
    bf16_t* P = (bf16_t*)(p.ws + O_P);
    for (int it = blockIdx.x; it < 136 * 48; it += gridDim.x) {
        const int mt = it / 48, nt = it % 48;
        f32x4 acc[4][4];
        RPPlain rp{H + (size_t)mt * 128 * 1024, 1024};
        gemm_core_g<4>(rp, W + (size_t)nt * 128 * 1024, 1024, 1024, acc, smem);
        acc_foreach<4>(acc, [&](int m, int n, const f32x4& v) {
            const int col = nt * 128 + n; f32x4 o = v;
            if (col >= PG0 && col < PEND) { o[0] = sigmoidf_(v[0]); o[1] = sigmoidf_(v[1]); o[2] = sigmoidf_(v[2]); o[3] = sigmoidf_(v[3]); }
            store_bf16x4(P + (size_t)(mt * 128 + m) * LDP + col, o);
        });
    }
}

__device__ __forceinline__ void ph_qu(const Params& p, char* smem) {
    const bf16_t* P = (const bf16_t*)(p.ws + O_P);
    bf16_t* QR = (bf16_t*)(p.ws + O_X + X_QRAW); bf16_t* KVR = (bf16_t*)(p.ws + O_X + X_KVRAW);
    for (int it = blockIdx.x; it < 136 * 14; it += gridDim.x) {
        const int mt = it / 14, nn = it % 14;
        f32x4 acc[4][4];
        if (nn < 6) {
            RPPlain rp{P + (size_t)mt * 128 * LDP + PQ0, LDP};
            gemm_core_g<4>(rp, (const bf16_t*)(p.ws + O_WB + W_UQ) + (size_t)nn * 128 * 384, 384, 384, acc, smem);
            acc_foreach<4>(acc, [&](int m, int n, const f32x4& v) { store_bf16x4(QR + (size_t)(mt * 128 + m) * 768 + nn * 128 + n, v); });
        } else {
            const int nt = nn - 6;
            RPPlain rp{P + (size_t)mt * 128 * LDP + PKV0, LDP};
            gemm_core_g<4>(rp, (const bf16_t*)(p.ws + O_WB + W_UKV) + (size_t)nt * 128 * 256, 256, 256, acc, smem);
            acc_foreach<4>(acc, [&](int m, int n, const f32x4& v) { store_bf16x4(KVR + (size_t)(mt * 128 + m) * 1024 + nt * 128 + n, v); });
        }
    }
}

constexpr float QSCALE = 0.10206207261596575f * 1.4426950408889634f;
__device__ __forceinline__ void ph_m2(const Params& p, char* smem) {
    const int tid = tidx(), lane = tid & 63, wave = tid >> 6;
    const bf16_t* P = (const bf16_t*)(p.ws + O_P);
    const bf16_t* QR = (const bf16_t*)(p.ws + O_X + X_QRAW); const bf16_t* KVR = (const bf16_t*)(p.ws + O_X + X_KVRAW);
    bf16_t* QA = (bf16_t*)(p.ws + O_X + X_QA); bf16_t* KA = (bf16_t*)(p.ws + O_X + X_KA); bf16_t* VA = (bf16_t*)(p.ws + O_X + X_VA);
    const float* rc = (const float*)(p.ws + O_ROPEC); const float* rs = (const float*)(p.ws + O_ROPES);
    for (int row = blockIdx.x * 4 + wave; row < RT; row += gridDim.x * 4) {
        const bool lat = row < RL;
        const int b = lat ? (row >> 12) : ((row - RL) >> 8), t = lat ? (row & 4095) : ((row - RL) & 255);
        const size_t keyrow = (size_t)b * KEYS + (lat ? t : SEQ + t);
        const bf16_t* pr = P + (size_t)row * LDP;
        float sq = 0.f, sk = 0.f;
        if (lane < 48) { float f[8]; unpack8(*(const uint4*)(pr + PQ0 + lane * 8), f);
#pragma unroll
            for (int e = 0; e < 8; ++e) sq += f[e] * f[e]; }
        if (lane < 32) { float f[8]; unpack8(*(const uint4*)(pr + PKV0 + lane * 8), f);
#pragma unroll
            for (int e = 0; e < 8; ++e) sk += f[e] * f[e]; }
        sq = wsum(sq); sk = wsum(sk);
        const float rq = rsqrtf(sq * (1.f / 384.f) + 1e-6f), rkv = rsqrtf(sk * (1.f / 256.f) + 1e-6f);
        const bf16_t* qr = QR + (size_t)row * 768; const bf16_t* kvr = KVR + (size_t)row * 1024;
        const float* rct = rc + t * 16; const float* rst = rs + t * 16;
#pragma unroll
        for (int pass = 0; pass < 2; ++pass) {
            const int ch = lane + 64 * pass;
            if (ch < 96) {
                const int h = ch / 12, cc = ch - h * 12;
                float q[8], k[8];
                unpack8(*(const uint4*)(qr + ch * 8), q);
                if (cc < 8) unpack8(*(const uint4*)(kvr + h * 128 + cc * 8), k);
                else unpack8(*(const uint4*)(pr + PKR0 + (cc - 8) * 8), k);
                const float ksc = cc < 8 ? rkv : 1.f;
#pragma unroll
                for (int e = 0; e < 8; ++e) { q[e] *= rq; k[e] *= ksc; }
                if (cc >= 8 && lat) {
                    const int sub = cc - 8, ax = sub >> 1, half = sub & 1;
                    float qp[8], kp[8];
                    unpack8(*(const uint4*)(qr + (ch ^ 1) * 8), qp); unpack8(*(const uint4*)(pr + PKR0 + (sub ^ 1) * 8), kp);
                    const float4 c0 = *(const float4*)(rct + ax * 8), c1 = *(const float4*)(rct + ax * 8 + 4), s0 = *(const float4*)(rst + ax * 8), s1 = *(const float4*)(rst + ax * 8 + 4);
                    const float cs_[8] = {c0.x, c0.y, c0.z, c0.w, c1.x, c1.y, c1.z, c1.w}, sn_[8] = {s0.x, s0.y, s0.z, s0.w, s1.x, s1.y, s1.z, s1.w};
#pragma unroll
                    for (int e = 0; e < 8; ++e) {
                        const float sg = half ? sn_[e] : -sn_[e];
                        q[e] = q[e] * cs_[e] + qp[e] * rq * sg;
                        k[e] = k[e] * cs_[e] + kp[e] * sg;
                    }
                }
#pragma unroll
                for (int e = 0; e < 8; ++e) q[e] *= QSCALE;
                *(uint4*)(QA + (size_t)row * 768 + ch * 8) = pack8(q);
                *(uint4*)(KA + keyrow * 768 + ch * 8) = pack8(k);
            }
        }
    }
    bf16_t* vt = (bf16_t*)smem;
    float* rk = (float*)(smem + 64 * 72 * 2);
    for (int it = blockIdx.x; it < (RT / 64) * 8; it += gridDim.x) {
        const int g = it >> 3, h = it & 7, rowg = g * 64;
        const bool lat = rowg < RL;
        const int b = lat ? (rowg >> 12) : ((rowg - RL) >> 8), t0 = lat ? (rowg & 4095) : ((rowg - RL) & 255);
        const size_t key0 = lat ? t0 : SEQ + t0;
        {
            const int lr = tid >> 2, q4 = tid & 3;
            const bf16_t* pr = P + (size_t)(rowg + lr) * LDP + PKV0 + q4 * 64;
            float sk = 0.f;
#pragma unroll
            for (int i = 0; i < 8; ++i) {
                float f[8]; unpack8(*(const uint4*)(pr + i * 8), f);
#pragma unroll
                for (int e = 0; e < 8; ++e) sk += f[e] * f[e];
            }
            sk += __shfl_xor(sk, 1); sk += __shfl_xor(sk, 2);
            if (q4 == 0) rk[lr] = rsqrtf(sk * (1.f / 256.f) + 1e-6f);
        }
        __syncthreads();
#pragma unroll
        for (int i = 0; i < 2; ++i) {
            const int c = tid + 256 * i, lr = c >> 3, part = c & 7;
            float f[8]; unpack8(*(const uint4*)(KVR + (size_t)(rowg + lr) * 1024 + h * 128 + 64 + part * 8), f);
            const float sc = rk[lr];
#pragma unroll
            for (int e = 0; e < 8; ++e) f[e] *= sc;
            *(uint4*)(vt + lr * 72 + part * 8) = pack8(f);
        }
        __syncthreads();
#pragma unroll
        for (int i = 0; i < 2; ++i) {
            const int c = tid + 256 * i, dd = c >> 3, kc = c & 7;
            float f[8];
#pragma unroll
            for (int e = 0; e < 8; ++e) f[e] = bf2f(vt[(kc * 8 + e) * 72 + dd]);
            const uint4 u = pack8(f);
            bf16_t* dst = VA + ((size_t)(b * 8 + h) * 64 + dd) * KEYS + key0 + (kc >> 2) * 32 + (kc & 1) * 16 + ((kc & 3) >> 1) * 4;
            *(uint2*)dst = make_uint2(u.x, u.y); *(uint2*)(dst + 8) = make_uint2(u.z, u.w);
        }
        __syncthreads();
    }
}
__device__ __forceinline__ float xmax_16_32(float v) {
    unsigned u = __builtin_bit_cast(unsigned, v);
    auto r = __builtin_amdgcn_permlane32_swap(u, u, false, false);
    float m = fmaxf(__builtin_bit_cast(float, r[0]), __builtin_bit_cast(float, r[1]));
    u = __builtin_bit_cast(unsigned, m);
    auto r2 = __builtin_amdgcn_permlane16_swap(u, u, false, false);
    return fmaxf(__builtin_bit_cast(float, r2[0]), __builtin_bit_cast(float, r2[1]));
}
__device__ __forceinline__ float xsum_16_32(float v) {
    unsigned u = __builtin_bit_cast(unsigned, v);
    auto r = __builtin_amdgcn_permlane32_swap(u, u, false, false);
    float m = __builtin_bit_cast(float, r[0]) + __builtin_bit_cast(float, r[1]);
    u = __builtin_bit_cast(unsigned, m);
    auto r2 = __builtin_amdgcn_permlane16_swap(u, u, false, false);
    return __builtin_bit_cast(float, r2[0]) + __builtin_bit_cast(float, r2[1]);
}
constexpr int KS_LD = 104, VT_LD = 72;
constexpr int AT_BUF = 64 * KS_LD * 2 + 64 * VT_LD * 2;
__device__ __forceinline__ void ph_at(const Params& p, int l, char* smem) {
    const int tid = tidx(), lane = tid & 63, wave = tid >> 6, fr = lane & 15, fq = lane >> 4;
    const bf16_t* QA = (const bf16_t*)(p.ws + O_X + X_QA); const bf16_t* KA = (const bf16_t*)(p.ws + O_X + X_KA); const bf16_t* VA = (const bf16_t*)(p.ws + O_X + X_VA);
    bf16_t* ATT = (bf16_t*)(p.ws + O_ATT);
    const int nitems = 1024 + (l < NLAYER - 1 ? 64 : 0);
    for (int it0 = blockIdx.x; it0 < nitems; it0 += gridDim.x) {
        int it = it0;
        if (gridDim.x == 512 && it0 < 1024) {
            const int x = it0 & 7, j = (it0 >> 3) & 63, rd = it0 >> 9;
            it = ((x * 4 + rd * 2 + (j >> 5)) << 5) | (j & 31);
        }
        int b, h, row0, ntile; size_t krow0;
        if (it < 1024) { b = it >> 8; h = (it >> 5) & 7; row0 = b * SEQ + (it & 31) * 128; krow0 = (size_t)b * KEYS; ntile = KEYS / 64; }
        else { const int j = it - 1024; b = j >> 4; h = (j >> 1) & 7; row0 = RL + b * CTX + (j & 1) * 128; krow0 = (size_t)b * KEYS + SEQ; ntile = CTX / 64; }
        const int qrow = row0 + wave * 32 + fr;
        const size_t vrow0 = (size_t)(b * 8 + h) * 64; const int koff0 = (int)(krow0 - (size_t)b * KEYS);
        bf16x8 qf[2][3];
#pragma unroll
        for (int t = 0; t < 2; ++t)
#pragma unroll
            for (int ks = 0; ks < 3; ++ks) qf[t][ks] = *(const bf16x8*)(QA + (size_t)(qrow + 16 * t) * 768 + h * 96 + ks * 32 + fq * 8);
        f32x4 ot[2][4];
#pragma unroll
        for (int t = 0; t < 2; ++t)
#pragma unroll
            for (int i = 0; i < 4; ++i) ot[t][i] = (f32x4){0.f, 0.f, 0.f, 0.f};
        float m_run[2] = {-1e30f, -1e30f}, l_run[2] = {0.f, 0.f};
        uint4 rk0, rk1, rk2, rv0, rv1;
#define AT_GLOAD(KT) do { const size_t kr_ = krow0 + (size_t)(KT) * 64; \
            { const int c = tid, key = c / 12, part = c % 12; rk0 = *(const uint4*)(KA + (kr_ + key) * 768 + h * 96 + part * 8); } \
            { const int c = tid + 256, key = c / 12, part = c % 12; rk1 = *(const uint4*)(KA + (kr_ + key) * 768 + h * 96 + part * 8); } \
            { const int c = tid + 512, key = c / 12, part = c % 12; rk2 = *(const uint4*)(KA + (kr_ + key) * 768 + h * 96 + part * 8); } \
            { const int c = tid, dd_ = c >> 3, part = c & 7; rv0 = *(const uint4*)(VA + (vrow0 + dd_) * KEYS + koff0 + (KT) * 64 + part * 8); } \
            { const int c = tid + 256, dd_ = c >> 3, part = c & 7; rv1 = *(const uint4*)(VA + (vrow0 + dd_) * KEYS + koff0 + (KT) * 64 + part * 8); } } while (0)
#define AT_VSTORE(RV, C) do { const int dd_ = (C) >> 3, part = (C) & 7; *(uint4*)(Vt_ + dd_ * VT_LD + part * 8) = RV; } while (0)
#define AT_SSTORE(BUF) do { bf16_t* Ks_ = (bf16_t*)(smem + (BUF) * AT_BUF); bf16_t* Vt_ = Ks_ + 64 * KS_LD; \
            { const int c = tid, key = c / 12, part = c % 12; *(uint4*)(Ks_ + key * KS_LD + part * 8) = rk0; } \
            { const int c = tid + 256, key = c / 12, part = c % 12; *(uint4*)(Ks_ + key * KS_LD + part * 8) = rk1; } \
            { const int c = tid + 512, key = c / 12, part = c % 12; *(uint4*)(Ks_ + key * KS_LD + part * 8) = rk2; } \
            AT_VSTORE(rv0, tid); AT_VSTORE(rv1, tid + 256); } while (0)
        AT_GLOAD(0); AT_SSTORE(0);
        __syncthreads();
        for (int kt = 0; kt < ntile; ++kt) {
            const int cur = kt & 1;
            if (kt + 1 < ntile) AT_GLOAD(kt + 1);
            const bf16_t* Ks = (const bf16_t*)(smem + cur * AT_BUF); const bf16_t* Vt = Ks + 64 * KS_LD;
            f32x4 st[2][4];
#pragma unroll
            for (int jh = 0; jh < 2; ++jh) {
                bf16x8 kf[2][3];
#pragma unroll
                for (int jj = 0; jj < 2; ++jj)
#pragma unroll
                    for (int ks = 0; ks < 3; ++ks) kf[jj][ks] = *(const bf16x8*)(Ks + ((jh * 2 + jj) * 16 + fr) * KS_LD + ks * 32 + fq * 8);
#pragma unroll
                for (int jj = 0; jj < 2; ++jj) {
                    const int j = jh * 2 + jj;
                    st[0][j] = (f32x4){0.f, 0.f, 0.f, 0.f}; st[1][j] = (f32x4){0.f, 0.f, 0.f, 0.f};
#pragma unroll
                    for (int ks = 0; ks < 3; ++ks) {
                        st[0][j] = __builtin_amdgcn_mfma_f32_16x16x32_bf16(kf[jj][ks], qf[0][ks], st[0][j], 0, 0, 0);
                        st[1][j] = __builtin_amdgcn_mfma_f32_16x16x32_bf16(kf[jj][ks], qf[1][ks], st[1][j], 0, 0, 0);
                    }
                }
            }
            bf16x8 vf[2][4];
#pragma unroll
            for (int k2 = 0; k2 < 2; ++k2)
#pragma unroll
                for (int dt = 0; dt < 4; ++dt) {
                    vf[k2][dt] = *(const bf16x8*)(Vt + (dt * 16 + fr) * VT_LD + k2 * 32 + fq * 8);
                }
            uint4 pu[2][2];
#pragma unroll
            for (int t = 0; t < 2; ++t) {
                float mx = st[t][0][0];
#pragma unroll
                for (int j = 0; j < 4; ++j)
#pragma unroll
                    for (int r = 0; r < 4; ++r) mx = fmaxf(mx, st[t][j][r]);
                if (__any(mx > m_run[t] + 6.f)) {
                    mx = xmax_16_32(mx);
                    const float m_new = fmaxf(m_run[t], mx);
                    const float alpha = __builtin_amdgcn_exp2f(m_run[t] - m_new);
                    m_run[t] = m_new;
                    l_run[t] *= alpha;
#pragma unroll
                    for (int i = 0; i < 4; ++i) ot[t][i] *= alpha;
                }
                const float mr = m_run[t];
                float ps = 0.f;
#pragma unroll
                for (int j = 0; j < 4; ++j)
#pragma unroll
                    for (int r = 0; r < 4; ++r) { st[t][j][r] = __builtin_amdgcn_exp2f(st[t][j][r] - mr); ps += st[t][j][r]; }
                l_run[t] += ps;
#pragma unroll
                for (int k2 = 0; k2 < 2; ++k2)
                    pu[t][k2] = make_uint4(pack2(st[t][2 * k2][0], st[t][2 * k2][1]), pack2(st[t][2 * k2][2], st[t][2 * k2][3]),
                                           pack2(st[t][2 * k2 + 1][0], st[t][2 * k2 + 1][1]), pack2(st[t][2 * k2 + 1][2], st[t][2 * k2 + 1][3]));
            }
#pragma unroll
            for (int k2 = 0; k2 < 2; ++k2) {
                const bf16x8 pb0 = __builtin_bit_cast(bf16x8, pu[0][k2]), pb1 = __builtin_bit_cast(bf16x8, pu[1][k2]);
#pragma unroll
                for (int dt = 0; dt < 4; ++dt) {
                    ot[0][dt] = __builtin_amdgcn_mfma_f32_16x16x32_bf16(vf[k2][dt], pb0, ot[0][dt], 0, 0, 0);
                    ot[1][dt] = __builtin_amdgcn_mfma_f32_16x16x32_bf16(vf[k2][dt], pb1, ot[1][dt], 0, 0, 0);
                }
            }
            if (kt + 1 < ntile) AT_SSTORE(cur ^ 1);
            __syncthreads();
        }
#pragma unroll
        for (int t = 0; t < 2; ++t) {
            const float inv = 1.f / xsum_16_32(l_run[t]);
#pragma unroll
            for (int dt = 0; dt < 4; ++dt) { f32x4 o = ot[t][dt] * inv; store_bf16x4(ATT + (size_t)(qrow + 16 * t) * 512 + h * 64 + dt * 16 + fq * 4, o); }
        }
    }
}

__device__ __forceinline__ void row_edges(int row, bool& first, bool& last) {
    if (row < RL) { const int t = row & 4095; first = t == 0; last = t == 4095; }
    else { const int s = (row - RL) & 255; first = s == 0; last = s == 255; }
}
__device__ __forceinline__ float xs1(const bf16_t* P, const float* mu, int row, int col) {
    bool first, last; row_edges(row, first, last);
    const bf16_t* pc = P + (size_t)row * LDP + PR0 + col;
    const float c = bf2f(*pc), pv0 = bf2f(*(first ? pc : pc - LDP)), nx0 = bf2f(*(last ? pc : pc + LDP));
    const float pv = first ? 0.f : pv0, nx = last ? 0.f : nx0;
    return c + (0.5f * (pv + nx) - c) * mu[col];
}
__device__ __forceinline__ void xs8(const bf16_t* P, const float* mu, int row, int col, float (&o)[8]) {
    bool first, last; row_edges(row, first, last);
    const bf16_t* pc = P + (size_t)row * LDP + PR0 + col;
    const uint4 uc = *(const uint4*)pc, up = *(const uint4*)(first ? pc : pc - LDP), un = *(const uint4*)(last ? pc : pc + LDP);
    float c[8], pv[8], nx[8]; unpack8(uc, c); unpack8(up, pv); unpack8(un, nx);
    const float fp = first ? 0.f : 0.5f, fn = last ? 0.f : 0.5f;
    const float4 m0 = *(const float4*)(mu + col), m1 = *(const float4*)(mu + col + 4);
    const float m[8] = {m0.x, m0.y, m0.z, m0.w, m1.x, m1.y, m1.z, m1.w};
#pragma unroll
    for (int j = 0; j < 8; ++j) o[j] = c[j] + ((fp * pv[j] + fn * nx[j]) - c[j]) * m[j];
}
struct ALRw {
    const bf16_t* P; const float* mu; int row0; int colbase, mode;
    __device__ __forceinline__ ALRw(const bf16_t* P_, const float* mu_, int row0_, int colbase_, int mode_) : P(P_), mu(mu_), colbase(colbase_), mode(mode_) {
        row0 = row0_ + (tidx() >> 3);
    }
    __device__ __forceinline__ uint4 load(int i, int k) const {
        float o[8]; xs8(P, mu, row0 + 32 * i, colbase + k, o);
        if (mode == 0) {
#pragma unroll
            for (int j = 0; j < 8; ++j) o[j] = tanhf(o[j]);
        } else if (mode == 2) {
#pragma unroll
            for (int j = 0; j < 8; ++j) o[j] = sigmoidf_(o[j]);
        }
        return pack8(o);
    }
};
__device__ __forceinline__ void ph_rp1(const Params& p, int l, char* smem) {
    const bf16_t* P = (const bf16_t*)(p.ws + O_P); const float* mu = p.in[I_MU] + l * 1792;
    bf16_t* RG = (bf16_t*)(p.ws + O_RG);
    for (int it = blockIdx.x; it < 1088; it += gridDim.x) {
        const int mt = it >> 2, nt = it & 3;
        f32x4 acc[2][4];
        ALRw al(P, mu, mt * 64, 1664, 2);
        gemm_core<2>(al, (const bf16_t*)(p.ws + O_WB + W_GUP) + (size_t)nt * 128 * 128, 128, 128, acc, smem);
        acc_foreach<2>(acc, [&](int m, int n, const f32x4& v) { store_bf16x4(RG + (size_t)(mt * 64 + m) * 512 + nt * 128 + n, v); });
    }
}
__device__ __forceinline__ void ph_rp2(const Params& p, int l) {
    const int lane = tidx() & 63, wave = tidx() >> 6;
    const bf16_t* P = (const bf16_t*)(p.ws + O_P); const float* mu = p.in[I_MU] + l * 1792; const float* kkw = p.in[I_KK] + l * 512;
    float* KKN = (float*)(p.ws + O_X + X_KKN);
    for (int row = blockIdx.x * 4 + wave; row < RT; row += gridDim.x * 4) {
        float k8[8]; xs8(P, mu, row, 512 + lane * 8, k8);
        float s = 0.f;
#pragma unroll
        for (int j = 0; j < 8; ++j) { const float v = k8[j] * kkw[lane * 8 + j]; s += v * v; }
        s += __shfl_xor(s, 1); s += __shfl_xor(s, 2); s += __shfl_xor(s, 4);
        if ((lane & 7) == 0) KKN[(size_t)row * 8 + (lane >> 3)] = rsqrtf(s + 1e-12f);
    }
}

__device__ __forceinline__ int scan_row(int b, int d, int n) {
    if (n < CTX) return RL + b * CTX + (d == 0 ? n : CTX - 1 - n);
    const int t = n - CTX; return b * SEQ + (d == 0 ? t : SEQ - 1 - t);
}
constexpr int SL = 72;
constexpr int SLOT_E = 64 * SL;
template <int LDA, int LDB>
__device__ __forceinline__ void mm64(const bf16_t* A, const bf16_t* B, f32x4 (&acc)[4], int wave, int fr, int fq) {
#pragma unroll
    for (int ks = 0; ks < 2; ++ks) {
        const bf16x8 af = *(const bf16x8*)(A + (wave * 16 + fr) * LDA + ks * 32 + fq * 8);
#pragma unroll
        for (int nt = 0; nt < 4; ++nt) {
            const bf16x8 bfv = *(const bf16x8*)(B + (nt * 16 + fr) * LDB + ks * 32 + fq * 8);
            acc[nt] = __builtin_amdgcn_mfma_f32_16x16x32_bf16(bfv, af, acc[nt], 0, 0, 0);
        }
    }
}
__device__ __forceinline__ void acc_zero(f32x4 (&acc)[4]) {
#pragma unroll
    for (int nt = 0; nt < 4; ++nt) acc[nt] = (f32x4){0.f, 0.f, 0.f, 0.f};
}
template <bool STRICT>
__device__ __forceinline__ void acc_mask(f32x4 (&acc)[4], int m, int fq) {
#pragma unroll
    for (int nt = 0; nt < 4; ++nt)
#pragma unroll
        for (int r = 0; r < 4; ++r) { const int n = nt * 16 + fq * 4 + r; const bool keep = STRICT ? (m < n) : (m <= n); if (!keep) acc[nt][r] = 0.f; }
}
__device__ __forceinline__ void st_rm(bf16_t* dst, const f32x4 (&acc)[4], int m, int fq) {
#pragma unroll
    for (int nt = 0; nt < 4; ++nt) store_bf16x4(dst + m * SL + nt * 16 + fq * 4, acc[nt]);
}
__device__ __forceinline__ void st_tr(bf16_t* dst, const f32x4 (&acc)[4], int m, int fq) {
#pragma unroll
    for (int nt = 0; nt < 4; ++nt)
#pragma unroll
        for (int r = 0; r < 4; ++r) dst[(nt * 16 + fq * 4 + r) * SL + m] = f2bf(acc[nt][r]);
}
__device__ __forceinline__ void ph_r1(const Params& p, int l, char* smem) {
    const int tid0 = tidx();
#define R1_IDX const int tid = lv(tid0), lane = tid & 63, wave = tid >> 6, fr = lane & 15, fq = lane >> 4, bi = tid >> 2, bq = (tid & 3) * 16, m = wave * 16 + fr; (void)bi; (void)bq; (void)m; (void)fq;
    const bf16_t* P = (const bf16_t*)(p.ws + O_P); const float* mu = p.in[I_MU] + l * 1792;
    const float* kkw = p.in[I_KK] + l * 512; const float* kaw = p.in[I_KA] + l * 512; const float* rkw = p.in[I_RK] + l * 512;
    const float* KKN = (const float*)(p.ws + O_X + X_KKN); float* BON = (float*)(p.ws + O_X + X_BON);
    bf16_t* gMT = (bf16_t*)(p.ws + O_X + X_MT); bf16_t* gNL = (bf16_t*)(p.ws + O_H);
    bf16_t* gGT = (bf16_t*)(p.ws + O_X + X_GT); bf16_t* gYL = (bf16_t*)(p.ws + O_X + X_YL);
    bf16_t* slot = (bf16_t*)smem;
    bf16_t* s0 = slot, *s1 = slot + SLOT_E, *s2 = slot + 2 * SLOT_E, *s3 = slot + 3 * SLOT_E;
    bf16_t* sa = slot + 4 * SLOT_E, *sb = slot + 5 * SLOT_E, *sc = slot + 6 * SLOT_E, *sT = slot + 7 * SLOT_E;
    float* misc = (float*)(smem + 8 * SLOT_E * 2);
    float* GAM = misc; float* SEG = misc + 64;
    float* ASIG = (float*)s0;
    float* LWS = (float*)s2;
    for (int it = blockIdx.x; it < NCP; it += gridDim.x) {
        const int c = it % 68, d = (it / 68) & 1, h = (it / 136) & 7, b = it / 1088;
        {
            R1_IDX const int rowb = scan_row(b, d, c * 64 + bi); (void)rowb;
            float o[8];
#pragma unroll
            for (int hh = 0; hh < 2; ++hh) {
                xs8(P, mu, rowb, 1536 + bq + hh * 8, o);
#pragma unroll
                for (int j = 0; j < 8; ++j) o[j] = 1.f - 2.f * __builtin_amdgcn_rcpf(1.f + __expf(2.f * o[j]));
                *(uint4*)(sa + bi * SL + bq + hh * 8) = pack8(o);
                xs8(P, mu, rowb, 1600 + bq + hh * 8, o);
                *(uint4*)(sb + bi * SL + bq + hh * 8) = pack8(o);
            }
        }
        __syncthreads();
        {
            R1_IDX const int rowb = scan_row(b, d, c * 64 + bi); (void)rowb;
            f32x4 acc[4];
            acc_zero(acc);
            mm64<SL, 64>(sa, (const bf16_t*)(p.ws + O_WB + W_WUP) + ((size_t)d * 512 + h * 64) * 64, acc, wave, fr, fq);
            const float* w0 = p.in[I_W0] + (l * 2 + d) * 512 + h * 64;
#pragma unroll
            for (int nt = 0; nt < 4; ++nt) {
                const int n = nt * 16 + fq * 4; float4 o; float* op = (float*)&o;
#pragma unroll
                for (int r = 0; r < 4; ++r) { const float z = w0[n + r] + acc[nt][r]; op[r] = -0.6065306597126334f * __builtin_amdgcn_rcpf(1.f + __expf(-z)); }
                *(float4*)(LWS + m * 68 + n) = o;
            }
            acc_zero(acc);
            mm64<SL, 64>(sb, (const bf16_t*)(p.ws + O_WB + W_AUP) + ((size_t)d * 512 + h * 64) * 64, acc, wave, fr, fq);
            const float* a0 = p.in[I_A0] + (l * 2 + d) * 512 + h * 64;
#pragma unroll
            for (int nt = 0; nt < 4; ++nt) {
                const int n = nt * 16 + fq * 4;
                *(float4*)(ASIG + m * 68 + n) = make_float4(__builtin_amdgcn_rcpf(1.f + __expf(-(a0[n] + acc[nt][0]))), __builtin_amdgcn_rcpf(1.f + __expf(-(a0[n + 1] + acc[nt][1]))), __builtin_amdgcn_rcpf(1.f + __expf(-(a0[n + 2] + acc[nt][2]))), __builtin_amdgcn_rcpf(1.f + __expf(-(a0[n + 3] + acc[nt][3]))));
            }
        }
        __syncthreads();
        {
            R1_IDX const int rowb = scan_row(b, d, c * 64 + bi); (void)rowb;
            const int k = tid & 63, seg = tid >> 6;
            float run = 0.f;
#pragma unroll
            for (int ii = 0; ii < 16; ++ii) { run += LWS[(seg * 16 + ii) * 68 + k]; LWS[(seg * 16 + ii) * 68 + k] = run; }
            SEG[seg * 64 + k] = run;
            __syncthreads();
            float off = 0.f;
#pragma unroll
            for (int sgi = 0; sgi < 3; ++sgi) if (sgi < seg) off += SEG[sgi * 64 + k];
#pragma unroll
            for (int ii = 0; ii < 16; ++ii) LWS[(seg * 16 + ii) * 68 + k] += off;
        }
        __syncthreads();
        {
            R1_IDX const int rowb = scan_row(b, d, c * 64 + bi); (void)rowb;
            float cs[16], cm[16], cc[16], ag[16];
#pragma unroll
            for (int q = 0; q < 4; ++q) {
                const float4 v0 = *(const float4*)(LWS + bi * 68 + bq + q * 4);
                const float4 v1 = bi > 0 ? *(const float4*)(LWS + (bi - 1) * 68 + bq + q * 4) : make_float4(0.f, 0.f, 0.f, 0.f);
                const float4 v2 = *(const float4*)(LWS + 63 * 68 + bq + q * 4);
                const float4 v3 = *(const float4*)(ASIG + bi * 68 + bq + q * 4);
                cs[q * 4] = v0.x; cs[q * 4 + 1] = v0.y; cs[q * 4 + 2] = v0.z; cs[q * 4 + 3] = v0.w;
                cm[q * 4] = v1.x; cm[q * 4 + 1] = v1.y; cm[q * 4 + 2] = v1.z; cm[q * 4 + 3] = v1.w;
                cc[q * 4] = v2.x; cc[q * 4 + 1] = v2.y; cc[q * 4 + 2] = v2.z; cc[q * 4 + 3] = v2.w;
                ag[q * 4] = v3.x; ag[q * 4 + 1] = v3.y; ag[q * 4 + 2] = v3.z; ag[q * 4 + 3] = v3.w;
            }
            __syncthreads();
            const float kkn = KKN[(size_t)rowb * 8 + h];
            float bon = 0.f;
#pragma unroll
            for (int hh = 0; hh < 2; ++hh) {
                float r8[8], k8[8], oa[8], ob[8], ok[8], orr[8];
                const int col = h * 64 + bq + hh * 8;
                xs8(P, mu, rowb, col, r8); xs8(P, mu, rowb, 512 + col, k8);
#pragma unroll
                for (int j = 0; j < 8; ++j) {
                    const int e = hh * 8 + j;
                    const float kk = k8[j] * kkw[col + j] * kkn;
                    const float kd = k8[j] * (1.f + (ag[e] - 1.f) * kaw[col + j]);
                    const float eneg = __expf(-cs[e]);
                    oa[j] = -kk * __expf(cm[e]); ob[j] = kk * ag[e] * eneg; ok[j] = kd * eneg; orr[j] = r8[j] * __builtin_amdgcn_rcpf(eneg);
                    bon += r8[j] * kd * rkw[col + j];
                }
                *(uint4*)(s0 + bi * SL + bq + hh * 8) = pack8(oa); *(uint4*)(s1 + bi * SL + bq + hh * 8) = pack8(ob);
                *(uint4*)(s2 + bi * SL + bq + hh * 8) = pack8(ok); *(uint4*)(s3 + bi * SL + bq + hh * 8) = pack8(orr);
            }
            bon += __shfl_xor(bon, 1); bon += __shfl_xor(bon, 2);
            if ((tid & 3) == 0) BON[((size_t)d * RT + rowb) * 8 + h] = bon;
            if (bi == 0) {
#pragma unroll
                for (int e = 0; e < 16; ++e) GAM[bq + e] = __expf(cc[e]);
            }
        }
        __syncthreads();
        {
            R1_IDX const int rowb = scan_row(b, d, c * 64 + bi); (void)rowb;
            f32x4 acc[4]; acc_zero(acc);
            mm64<SL, SL>(s1, s0, acc, wave, fr, fq);
            acc_mask<true>(acc, m, fq);
            st_rm(sa, acc, m, fq); st_tr(sb, acc, m, fq);
#pragma unroll
            for (int nt = 0; nt < 4; ++nt)
#pragma unroll
                for (int r = 0; r < 4; ++r) if (nt * 16 + fq * 4 + r == m) acc[nt][r] += 1.f;
            st_rm(sc, acc, m, fq);
        }
        __syncthreads();
#pragma unroll
        for (int itr = 0; itr < 5; ++itr) {
            R1_IDX
            bf16_t* ptr = (itr & 1) ? sT : sb;
            bf16_t* ptw = (itr & 1) ? sb : sT;
            f32x4 acc[4]; acc_zero(acc);
            mm64<SL, SL>(sa, ptr, acc, wave, fr, fq);
            st_rm(sa, acc, m, fq); st_tr(ptw, acc, m, fq);
            __syncthreads();
            f32x4 tacc[4];
#pragma unroll
            for (int nt = 0; nt < 4; ++nt) { const uint2 u = *(const uint2*)(sc + m * SL + nt * 16 + fq * 4); tacc[nt] = (f32x4){bflo(u.x), bfhi(u.x), bflo(u.y), bfhi(u.y)}; }
            mm64<SL, SL>(sc, ptw, tacc, wave, fr, fq);
            if (itr < 4) st_rm(sc, tacc, m, fq); else st_tr(sb, tacc, m, fq);
        }
        __syncthreads();
        {
            R1_IDX const int rowb = scan_row(b, d, c * 64 + bi); (void)rowb;
            f32x4 acc[4]; acc_zero(acc);
            mm64<SL, SL>(s2, s0, acc, wave, fr, fq);
            acc_mask<true>(acc, m, fq);
            st_rm(sa, acc, m, fq);
            float f0[8], f1[8];
            unpack8(*(const uint4*)(s0 + bi * SL + bq), f0); unpack8(*(const uint4*)(s0 + bi * SL + bq + 8), f1);
#pragma unroll
            for (int e = 0; e < 8; ++e) { sc[(bq + e) * SL + bi] = f2bf(f0[e]); sc[(bq + 8 + e) * SL + bi] = f2bf(f1[e]); }
        }
        __syncthreads();
        {
            R1_IDX const int rowb = scan_row(b, d, c * 64 + bi); (void)rowb;
            f32x4 acc[4]; acc_zero(acc);
            mm64<SL, SL>(sc, sb, acc, wave, fr, fq);
            st_rm(sT, acc, m, fq);
            acc_zero(acc);
            mm64<SL, SL>(sa, sb, acc, wave, fr, fq);
            st_rm(s0, acc, m, fq);
        }
        __syncthreads();
        f32x4 qacc[4];
        {
            R1_IDX const int rowb = scan_row(b, d, c * 64 + bi); (void)rowb;
            f32x4 acc[4]; acc_zero(acc);
            mm64<SL, SL>(s1, s3, acc, wave, fr, fq);
            acc_mask<false>(acc, m, fq);
            st_tr(sa, acc, m, fq);
            acc_zero(qacc);
            mm64<SL, SL>(s2, s3, qacc, wave, fr, fq);
            acc_mask<false>(qacc, m, fq);
            float f0[8], f1[8];
            unpack8(*(const uint4*)(s3 + bi * SL + bq), f0); unpack8(*(const uint4*)(s3 + bi * SL + bq + 8), f1);
#pragma unroll
            for (int e = 0; e < 8; ++e) { sc[(bq + e) * SL + bi] = f2bf(f0[e]); sc[(bq + 8 + e) * SL + bi] = f2bf(f1[e]); }
        }
        __syncthreads();
        {
            R1_IDX const int rowb = scan_row(b, d, c * 64 + bi); (void)rowb;
            f32x4 acc[4];
#pragma unroll
            for (int nt = 0; nt < 4; ++nt) { const uint2 u = *(const uint2*)(sc + m * SL + nt * 16 + fq * 4); acc[nt] = (f32x4){bflo(u.x), bfhi(u.x), bflo(u.y), bfhi(u.y)}; }
            mm64<SL, SL>(sT, sa, acc, wave, fr, fq);
            bf16_t* gt = gGT + (size_t)it * 4096;
#pragma unroll
            for (int nt = 0; nt < 4; ++nt)
#pragma unroll
                for (int r = 0; r < 4; ++r) gt[(nt * 16 + fq * 4 + r) * 64 + m] = f2bf(acc[nt][r]);
            mm64<SL, SL>(s0, sa, qacc, wave, fr, fq);
            st_tr(sb, qacc, m, fq);
            float f0[8], f1[8];
            unpack8(*(const uint4*)(s1 + bi * SL + bq), f0); unpack8(*(const uint4*)(s1 + bi * SL + bq + 8), f1);
#pragma unroll
            for (int e = 0; e < 8; ++e) { s3[(bq + e) * SL + bi] = f2bf(f0[e] * GAM[bq + e]); s3[(bq + 8 + e) * SL + bi] = f2bf(f1[e] * GAM[bq + 8 + e]); }
        }
        __syncthreads();
        {
            R1_IDX const int rowb = scan_row(b, d, c * 64 + bi); (void)rowb;
            f32x4 acc[4]; acc_zero(acc);
            mm64<SL, SL>(sT, s3, acc, wave, fr, fq);
            bf16_t* mt = gMT + (size_t)it * 4096;
#pragma unroll
            for (int nt = 0; nt < 4; ++nt)
#pragma unroll
                for (int r = 0; r < 4; ++r) { const int n = nt * 16 + fq * 4 + r; mt[n * 64 + m] = f2bf(acc[nt][r] + (n == m ? GAM[m] : 0.f)); }
#pragma unroll
            for (int nt = 0; nt < 4; ++nt) {
                const int n = nt * 16 + fq * 4; const uint2 u = *(const uint2*)(s2 + m * SL + n);
                acc[nt] = (f32x4){bflo(u.x) * GAM[n], bfhi(u.x) * GAM[n + 1], bflo(u.y) * GAM[n + 2], bfhi(u.y) * GAM[n + 3]};
            }
            mm64<SL, SL>(s0, s3, acc, wave, fr, fq);
            st_tr(s1, acc, m, fq);
            float v8[8];
#pragma unroll
            for (int hh = 0; hh < 2; ++hh) {
                xs8(P, mu, rowb, 1024 + h * 64 + bq + hh * 8, v8);
#pragma unroll
                for (int e = 0; e < 8; ++e) sc[(bq + hh * 8 + e) * SL + bi] = f2bf(v8[e]);
            }
        }
        __syncthreads();
        {
            R1_IDX const int rowb = scan_row(b, d, c * 64 + bi); (void)rowb;
            f32x4 acc[4]; acc_zero(acc);
            mm64<SL, SL>(sc, sb, acc, wave, fr, fq);
            bf16_t* yl = gYL + (size_t)it * 4096;
#pragma unroll
            for (int nt = 0; nt < 4; ++nt) store_bf16x4(yl + m * 64 + nt * 16 + fq * 4, acc[nt]);
            acc_zero(acc);
            mm64<SL, SL>(sc, s1, acc, wave, fr, fq);
            bf16_t* nl = gNL + (size_t)it * 4096;
#pragma unroll
            for (int nt = 0; nt < 4; ++nt) store_bf16x4(nl + m * 64 + nt * 16 + fq * 4, acc[nt]);
        }
        __syncthreads();
    }
}
__device__ __forceinline__ void ph_r2(const Params& p, char* smem) {
    const int tid = tidx(), lane = tid & 63, wave = tid >> 6, fr = lane & 15, fq = lane >> 4;
    const char* gMT = (const char*)(p.ws + O_X + X_MT); const char* gNL = (const char*)(p.ws + O_H);
    uint4* gS0 = (uint4*)(p.ws + O_X + X_S0);
    const int wofs = __builtin_amdgcn_readfirstlane(wave) * 1024;
    const unsigned lds0 = (unsigned)(uintptr_t)smem;
    const unsigned mtaddr = lds0 + fr * 128 + fq * 8, nladdr = lds0 + (wave * 16 + fr) * 128 + fq * 8;
    auto issue = [&](size_t cp, int slot) {
        char* dst = smem + slot * 16384 + wofs;
        const char* s0 = gMT + cp * 8192 + wofs + lane * 16; const char* s1 = gNL + cp * 8192 + wofs + lane * 16;
        __builtin_amdgcn_global_load_lds((const unsigned*)s0, (unsigned*)dst, 16, 0, 0);
        __builtin_amdgcn_global_load_lds((const unsigned*)(s0 + 4096), (unsigned*)(dst + 4096), 16, 0, 0);
        __builtin_amdgcn_global_load_lds((const unsigned*)s1, (unsigned*)(dst + 8192), 16, 0, 0);
        __builtin_amdgcn_global_load_lds((const unsigned*)(s1 + 4096), (unsigned*)(dst + 12288), 16, 0, 0);
    };
#define R2_READ(MX, NV, SLOT) do { \
        asm volatile("ds_read_b64 %0, %1 offset:0" : "=v"(MX[0][0][0]) : "v"(mtaddr + (SLOT) * 16384)); \
        asm volatile("ds_read_b64 %0, %1 offset:32" : "=v"(MX[0][0][1]) : "v"(mtaddr + (SLOT) * 16384)); \
        asm volatile("ds_read_b64 %0, %1 offset:64" : "=v"(MX[0][1][0]) : "v"(mtaddr + (SLOT) * 16384)); \
        asm volatile("ds_read_b64 %0, %1 offset:96" : "=v"(MX[0][1][1]) : "v"(mtaddr + (SLOT) * 16384)); \
        asm volatile("ds_read_b64 %0, %1 offset:8192" : "=v"(NV[0]) : "v"(nladdr + (SLOT) * 16384)); \
        asm volatile("ds_read_b64 %0, %1 offset:2048" : "=v"(MX[1][0][0]) : "v"(mtaddr + (SLOT) * 16384)); \
        asm volatile("ds_read_b64 %0, %1 offset:2080" : "=v"(MX[1][0][1]) : "v"(mtaddr + (SLOT) * 16384)); \
        asm volatile("ds_read_b64 %0, %1 offset:2112" : "=v"(MX[1][1][0]) : "v"(mtaddr + (SLOT) * 16384)); \
        asm volatile("ds_read_b64 %0, %1 offset:2144" : "=v"(MX[1][1][1]) : "v"(mtaddr + (SLOT) * 16384)); \
        asm volatile("ds_read_b64 %0, %1 offset:8224" : "=v"(NV[1]) : "v"(nladdr + (SLOT) * 16384)); \
        asm volatile("ds_read_b64 %0, %1 offset:4096" : "=v"(MX[2][0][0]) : "v"(mtaddr + (SLOT) * 16384)); \
        asm volatile("ds_read_b64 %0, %1 offset:4128" : "=v"(MX[2][0][1]) : "v"(mtaddr + (SLOT) * 16384)); \
        asm volatile("ds_read_b64 %0, %1 offset:4160" : "=v"(MX[2][1][0]) : "v"(mtaddr + (SLOT) * 16384)); \
        asm volatile("ds_read_b64 %0, %1 offset:4192" : "=v"(MX[2][1][1]) : "v"(mtaddr + (SLOT) * 16384)); \
        asm volatile("ds_read_b64 %0, %1 offset:8256" : "=v"(NV[2]) : "v"(nladdr + (SLOT) * 16384)); \
        asm volatile("ds_read_b64 %0, %1 offset:6144" : "=v"(MX[3][0][0]) : "v"(mtaddr + (SLOT) * 16384)); \
        asm volatile("ds_read_b64 %0, %1 offset:6176" : "=v"(MX[3][0][1]) : "v"(mtaddr + (SLOT) * 16384)); \
        asm volatile("ds_read_b64 %0, %1 offset:6208" : "=v"(MX[3][1][0]) : "v"(mtaddr + (SLOT) * 16384)); \
        asm volatile("ds_read_b64 %0, %1 offset:6240" : "=v"(MX[3][1][1]) : "v"(mtaddr + (SLOT) * 16384)); \
        asm volatile("ds_read_b64 %0, %1 offset:8288" : "=v"(NV[3]) : "v"(nladdr + (SLOT) * 16384)); \
        } while (0)
#define R2_PIN(MX, NV) asm volatile("" : "+v"(MX[0][0][0]), "+v"(MX[0][0][1]), "+v"(MX[0][1][0]), "+v"(MX[0][1][1]), "+v"(NV[0]), "+v"(MX[1][0][0]), "+v"(MX[1][0][1]), "+v"(MX[1][1][0]), "+v"(MX[1][1][1]), "+v"(NV[1]), "+v"(MX[2][0][0]), "+v"(MX[2][0][1]), "+v"(MX[2][1][0]), "+v"(MX[2][1][1]), "+v"(NV[2]), "+v"(MX[3][0][0]), "+v"(MX[3][0][1]), "+v"(MX[3][1][0]), "+v"(MX[3][1][1]), "+v"(NV[3]) :: "memory")
#define R2_STEP(MX, NV, MXN, NVN, J) do { const int c = c4 + (J); \
        asm volatile("s_waitcnt lgkmcnt(0)" ::: "memory");            \
        R2_PIN(MX, NV);                                                \
        asm volatile("s_waitcnt vmcnt(8)" ::: "memory");              \
        __builtin_amdgcn_s_barrier(); \
        asm volatile("" ::: "memory"); \
        R2_READ(MXN, NVN, ((J) + 1) & 3); \
        __builtin_amdgcn_sched_barrier(0); \
        u32x4 sb_[2]; \
        _Pragma("unroll") for (int s_ = 0; s_ < 2; ++s_) sb_[s_] = (u32x4){pack2(st[2 * s_][0], st[2 * s_][1]), pack2(st[2 * s_][2], st[2 * s_][3]), pack2(st[2 * s_ + 1][0], st[2 * s_ + 1][1]), pack2(st[2 * s_ + 1][2], st[2 * s_ + 1][3])}; \
        _Pragma("unroll") for (int tt = 0; tt < 4; ++tt) { \
            f32x4 acc_ = {bflo(NV[tt].x), bfhi(NV[tt].x), bflo(NV[tt].y), bfhi(NV[tt].y)}; \
            _Pragma("unroll") for (int s_ = 0; s_ < 2; ++s_) \
                acc_ = __builtin_amdgcn_mfma_f32_16x16x32_bf16(__builtin_bit_cast(bf16x8, (u32x4){MX[tt][s_][0].x, MX[tt][s_][0].y, MX[tt][s_][1].x, MX[tt][s_][1].y}), __builtin_bit_cast(bf16x8, sb_[s_]), acc_, 0, 0, 0); \
            st[tt] = acc_; } \
        *(u32x4*)(gS0 + ((cp0 + c) * 4 + wave) * 128 + lane) = sb_[0]; *(u32x4*)(gS0 + ((cp0 + c) * 4 + wave) * 128 + 64 + lane) = sb_[1]; \
        issue(cp0 + (c + 4 < 68 ? c + 4 : 67), (J)); } while (0)
    for (int it = blockIdx.x; it < 64; it += gridDim.x) {
        f32x4 st[4];
#pragma unroll
        for (int tt = 0; tt < 4; ++tt) st[tt] = (f32x4){0.f, 0.f, 0.f, 0.f};
        const size_t cp0 = (size_t)it * 68;
        issue(cp0, 0); issue(cp0 + 1, 1); issue(cp0 + 2, 2); issue(cp0 + 3, 3);
        uint2 mxA[4][2][2], nvA[4], mxB[4][2][2], nvB[4];
        asm volatile("s_waitcnt vmcnt(12)" ::: "memory");
        __builtin_amdgcn_s_barrier();
        asm volatile("" ::: "memory");
        R2_READ(mxA, nvA, 0);
        asm volatile("s_waitcnt lgkmcnt(0)" ::: "memory");
        R2_PIN(mxA, nvA);
        for (int c4 = 0; c4 < 68; c4 += 4) {
            R2_STEP(mxA, nvA, mxB, nvB, 0);
            R2_STEP(mxB, nvB, mxA, nvA, 1);
            R2_STEP(mxA, nvA, mxB, nvB, 2);
            R2_STEP(mxB, nvB, mxA, nvA, 3);
            asm volatile("s_waitcnt lgkmcnt(0)" ::: "memory");
            R2_PIN(mxA, nvA);
        }
        asm volatile("s_waitcnt vmcnt(0) lgkmcnt(0)" ::: "memory");
        __builtin_amdgcn_sched_barrier(0);
        __syncthreads();
    }
#undef R2_READ
#undef R2_PIN
#undef R2_STEP
}
__device__ __forceinline__ void ph_r3(const Params& p) {
    const int tid = tidx(), lane = tid & 63, wave = tid >> 6, fr = lane & 15, fq = lane >> 4;
    const bf16_t* gGT = (const bf16_t*)(p.ws + O_X + X_GT); const bf16_t* gYL = (const bf16_t*)(p.ws + O_X + X_YL);
    const u32x4* gS0 = (const u32x4*)(p.ws + O_X + X_S0);
    bf16_t* YS = (bf16_t*)(p.ws + O_H);
    for (int it = blockIdx.x * 4 + wave; it < NCP; it += gridDim.x * 4) {
        const int c = it % 68, d = (it / 68) & 1, h = (it / 136) & 7, b = it / 1088;
        const bf16_t* gt = gGT + (size_t)it * 4096; const bf16_t* yl = gYL + (size_t)it * 4096;
        u32x4 gf[4][2];
#pragma unroll
        for (int tt = 0; tt < 4; ++tt)
#pragma unroll
            for (int s_ = 0; s_ < 2; ++s_) {
                const bf16_t* q = gt + (tt * 16 + fr) * 64 + s_ * 32 + fq * 4;
                const uint2 a0 = *(const uint2*)q, a1 = *(const uint2*)(q + 16);
                gf[tt][s_] = (u32x4){a0.x, a0.y, a1.x, a1.y};
            }
#pragma unroll
        for (int vg = 0; vg < 4; ++vg) {
            const u32x4 sb0 = gS0[((size_t)it * 4 + vg) * 128 + lane], sb1 = gS0[((size_t)it * 4 + vg) * 128 + 64 + lane];
#pragma unroll
            for (int tt = 0; tt < 4; ++tt) {
                const uint2 yv = *(const uint2*)(yl + (vg * 16 + fr) * 64 + tt * 16 + fq * 4);
                f32x4 acc = {bflo(yv.x), bfhi(yv.x), bflo(yv.y), bfhi(yv.y)};
                acc = __builtin_amdgcn_mfma_f32_16x16x32_bf16(__builtin_bit_cast(bf16x8, gf[tt][0]), __builtin_bit_cast(bf16x8, sb0), acc, 0, 0, 0);
                acc = __builtin_amdgcn_mfma_f32_16x16x32_bf16(__builtin_bit_cast(bf16x8, gf[tt][1]), __builtin_bit_cast(bf16x8, sb1), acc, 0, 0, 0);
#pragma unroll
                for (int r = 0; r < 4; ++r) {
                    const int row = scan_row(b, d, c * 64 + tt * 16 + fq * 4 + r);
                    YS[((size_t)d * RT + row) * 512 + h * 64 + vg * 16 + fr] = f2bf(acc[r]);
                }
            }
        }
    }
}

__device__ __forceinline__ void ph_rpost(const Params& p, int l) {
    const int lane = tidx() & 63, wave = tidx() >> 6;
    const bf16_t* P = (const bf16_t*)(p.ws + O_P); const float* mu = p.in[I_MU] + l * 1792;
    const float* gng = p.in[I_GNG] + l * 512; const float* gnb = p.in[I_GNB] + l * 512;
    const float* BON = (const float*)(p.ws + O_X + X_BON); const bf16_t* YS = (const bf16_t*)(p.ws + O_H);
    const bf16_t* RG = (const bf16_t*)(p.ws + O_RG); bf16_t* RWO = (bf16_t*)(p.ws + O_RWO);
    for (int row = blockIdx.x * 4 + wave; row < RT; row += gridDim.x * 4) {
        const int col = lane * 8, h = lane >> 3;
        float v8[8], g8[8], y0[8], y1[8];
        xs8(P, mu, row, 1024 + col, v8);
        unpack8(*(const uint4*)(RG + (size_t)row * 512 + col), g8);
        unpack8(*(const uint4*)(YS + ((size_t)0 * RT + row) * 512 + col), y0);
        unpack8(*(const uint4*)(YS + ((size_t)1 * RT + row) * 512 + col), y1);
        const float bs = BON[((size_t)0 * RT + row) * 8 + h] + BON[((size_t)1 * RT + row) * 8 + h];
        float y[8]; float sm = 0.f;
#pragma unroll
        for (int j = 0; j < 8; ++j) { y[j] = y0[j] + y1[j]; sm += y[j]; }
        sm += __shfl_xor(sm, 1); sm += __shfl_xor(sm, 2); sm += __shfl_xor(sm, 4);
        const float mean = sm * (1.f / 64.f);
        float vs = 0.f;
#pragma unroll
        for (int j = 0; j < 8; ++j) { const float dlt = y[j] - mean; vs += dlt * dlt; }
        vs += __shfl_xor(vs, 1); vs += __shfl_xor(vs, 2); vs += __shfl_xor(vs, 4);
        const float rstd = rsqrtf(vs * (1.f / 64.f) + 64e-5f);
        float o[8];
#pragma unroll
        for (int j = 0; j < 8; ++j) o[j] = ((y[j] - mean) * rstd * gng[col + j] + gnb[col + j] + bs * v8[j]) * g8[j];
        *(uint4*)(RWO + (size_t)row * 512 + col) = pack8(o);
    }
}

__device__ __forceinline__ void ph_f1(const Params& p, int l, char* smem) {
    const bf16_t* P = (const bf16_t*)(p.ws + O_P); const bf16_t* CSC = (const bf16_t*)(p.ws + O_CSC);
    bf16_t* YT2 = (bf16_t*)(p.ws + O_YT2); bf16_t* YTC = (bf16_t*)(p.ws + O_YTC);
    const int nitems = 1024 + (l < NLAYER - 1 ? 64 : 0);
    for (int it = blockIdx.x; it < nitems; it += gridDim.x) {
        f32x4 acc[4][4];
        if (it < 1024) {
            const int b = it >> 8, g = (it >> 6) & 3, part = (it >> 5) & 1, j = it & 31;
            RPPlain rpa{CSC + (size_t)part * 128 * 128, 128};
            const bf16_t* pb = P + (size_t)b * SEQ * LDP + g * 128;
            auto rpb = [&](int r) -> const bf16_t* { return pb + (size_t)(64 * (r & 63) + 2 * j + (r >> 6)) * LDP; };
            gemm_core_gb<4>(rpa, rpb, 128, acc, smem);
            acc_foreach<4>(acc, [&](int m, int n, const f32x4& v) {
                const int t1 = n & 63, t2 = 2 * j + (n >> 6);
                store_bf16x4(YT2 + ((size_t)(b * 512 + g * 128 + m) * 64 + t2) * 128 + part * 64 + t1, v);
            });
        } else {
            const int jj = it - 1024, b = jj >> 4, g = (jj >> 2) & 3, part = (jj >> 1) & 1, nt = jj & 1;
            RPPlain rpa{CSC + (size_t)part * 128 * 128, 128};
            gemm_core_g<4>(rpa, P + (size_t)(RL + b * CTX + nt * 128) * LDP + g * 128, LDP, 128, acc, smem);
            acc_foreach<4>(acc, [&](int m, int n, const f32x4& v) {
                store_bf16x4(YTC + ((size_t)(b * 512 + g * 128 + m)) * 512 + part * 256 + nt * 128 + n, v);
            });
        }
    }
}
__device__ __forceinline__ void ph_fa(const Params& p, char* smem) {
    const bf16_t* YT2 = (const bf16_t*)(p.ws + O_YT2); const bf16_t* D128 = (const bf16_t*)(p.ws + O_D128);
    const float* TWC = (const float*)(p.ws + O_TWC); const float* TWS = (const float*)(p.ws + O_TWS);
    bf16_t* A2 = (bf16_t*)(p.ws + O_A2);
    for (int it = blockIdx.x; it < 1024; it += gridDim.x) {
        f32x4 acc[4][4];
        RPPlain rpa{D128, 128};
        gemm_core_g<4>(rpa, YT2 + (size_t)it * 128 * 128, 128, 128, acc, smem);
        const int lane = tidx() & 63, wave = tidx() >> 6, wr = wave >> 1, wc = wave & 1, fr = lane & 15, fq = lane >> 4;
        float* U = (float*)smem;
        if (wr == 1) {
#pragma unroll
            for (int i = 0; i < 4; ++i)
#pragma unroll
                for (int j = 0; j < 4; ++j) *(f32x4*)(U + (i * 16 + fr) * 132 + wc * 64 + j * 16 + fq * 4) = acc[i][j];
        }
        __syncthreads();
        if (wr == 0) {
#pragma unroll
            for (int i = 0; i < 4; ++i) {
                const int k1 = i * 16 + fr;
#pragma unroll
                for (int j = 0; j < 4; ++j) {
                    const int r = wc * 64 + j * 16 + fq * 4;
                    const int R = it * 128 + r, bn = R >> 6, t2 = R & 63, b = bn >> 9, n = bn & 511;
                    const f32x4 ai = *(const f32x4*)(U + k1 * 132 + r);
                    const f32x4 c = *(const f32x4*)(TWC + k1 * 64 + t2), sn = *(const f32x4*)(TWS + k1 * 64 + t2);
                    const f32x4 ar = acc[i][j];
                    const f32x4 pr = ar * c - ai * sn, pi = ar * sn + ai * c;
                    bf16_t* dst = A2 + ((size_t)(b * 64 + k1) * 512 + n) * 128 + t2;
                    store_bf16x4(dst, pr); store_bf16x4(dst + 64, pi);
                }
            }
        }
        __syncthreads();
    }
}
__device__ __forceinline__ void ph_fb(const Params& p, int l, char* smem) {
    const bf16_t* A2 = (const bf16_t*)(p.ws + O_A2); const bf16_t* E64 = (const bf16_t*)(p.ws + O_E64);
    const bf16_t* CST2 = (const bf16_t*)(p.ws + O_CST256); const bf16_t* YTC = (const bf16_t*)(p.ws + O_YTC);
    bf16_t* FA = (bf16_t*)(p.ws + O_FA);
    const int nitems = 1024 + (l < NLAYER - 1 ? 32 : 0);
    for (int it = blockIdx.x; it < nitems; it += gridDim.x) {
        if (it < 1024) {
            const int b = it >> 8, k1 = (it >> 2) & 63, nt = it & 3;
            f32x4 acc[2][4];
            RPPlain rpa{E64, 128};
            gemm_core_g<2>(rpa, A2 + ((size_t)(b * 64 + k1) * 512 + nt * 128) * 128, 128, 128, acc, smem);
            const float sc = 0.001381067932004975f;
            acc_foreach<2>(acc, [&](int m, int n, const f32x4& v) { f32x4 o = v * sc; store_bf16x4(FA + (size_t)(b * SEQ + k1 + 64 * m) * 512 + nt * 128 + n, o); });
        } else {
            const int j = it - 1024, b = j >> 3, mt = (j >> 2) & 1, nt = j & 3;
            f32x4 acc[4][4];
            RPPlain rp{CST2 + (size_t)mt * 128 * 512, 512};
            gemm_core_g<4>(rp, YTC + ((size_t)b * 512 + nt * 128) * 512, 512, 512, acc, smem);
            const float sc = 0.005524271728019903f;
            acc_foreach<4>(acc, [&](int m, int n, const f32x4& v) { f32x4 o = v * sc; store_bf16x4(FA + (size_t)(RL + b * CTX + mt * 128 + m) * 512 + nt * 128 + n, o); });
        }
    }
}

__device__ __forceinline__ void ph_mg(const Params& p, int l, char* smem) {
    const bf16_t* P = (const bf16_t*)(p.ws + O_P);
    const bf16_t* A0 = (const bf16_t*)(p.ws + O_FA); const bf16_t* A1 = (const bf16_t*)(p.ws + O_ATT); const bf16_t* A2 = (const bf16_t*)(p.ws + O_RWO);
    const bf16_t* W0 = (const bf16_t*)(p.ws + O_WB + W_PA); const bf16_t* W1 = (const bf16_t*)(p.ws + O_WB + W_PB); const bf16_t* W2 = (const bf16_t*)(p.ws + O_WB + W_PC);
    bf16_t* MG = (bf16_t*)(p.ws + O_H);
    const int nmt = (l < NLAYER - 1) ? RT / 128 : RL / 128;
    for (int it = blockIdx.x; it < nmt * 8; it += gridDim.x) {
        const int mt = it >> 3, nt = it & 7;
        f32x4 tot[4][4];
#pragma unroll
        for (int i = 0; i < 4; ++i)
#pragma unroll
            for (int j = 0; j < 4; ++j) tot[i][j] = (f32x4){0.f, 0.f, 0.f, 0.f};
#pragma unroll 1
        for (int br = 0; br < 3; ++br) {
            const bf16_t* Ab = br == 0 ? A0 : (br == 1 ? A1 : A2);
            const bf16_t* Wb = br == 0 ? W0 : (br == 1 ? W1 : W2);
            f32x4 acc[4][4];
            RPPlain rp{Ab + (size_t)mt * 128 * 512, 512};
            gemm_core_g<4>(rp, Wb + (size_t)nt * 128 * 512, 512, 512, acc, smem);
            const int lane = tidx() & 63, wave = tidx() >> 6, wr = wave >> 1, wc = wave & 1, fr = lane & 15, fq = lane >> 4;
#pragma unroll
            for (int i = 0; i < 4; ++i)
#pragma unroll
                for (int j = 0; j < 4; ++j) {
                    const int m = wr * 64 + i * 16 + fr, n = wc * 64 + j * 16 + fq * 4;
                    const uint2 gu = *(const uint2*)(P + (size_t)(mt * 128 + m) * LDP + PG0 + br * 1024 + nt * 128 + n);
                    tot[i][j][0] += bflo(gu.x) * acc[i][j][0]; tot[i][j][1] += bfhi(gu.x) * acc[i][j][1];
                    tot[i][j][2] += bflo(gu.y) * acc[i][j][2]; tot[i][j][3] += bfhi(gu.y) * acc[i][j][3];
                }
        }
        acc_foreach<4>(tot, [&](int m, int n, const f32x4& v) { store_bf16x4(MG + (size_t)(mt * 128 + m) * 1024 + nt * 128 + n, v); });
    }
}
__device__ __forceinline__ void ph_out(const Params& p, int l, char* smem) {
    const bf16_t* MG = (const bf16_t*)(p.ws + O_H); const bf16_t* W = (const bf16_t*)(p.ws + O_WB + W_OUT);
    float* xcur = (float*)(p.ws + O_XCUR); const float* mod = (const float*)(p.ws + O_MOD);
    const int nlat = 1024, nctx = (l < NLAYER - 1) ? (RC / 64) * 8 : 0;
    for (int it = blockIdx.x; it < nlat + nctx; it += gridDim.x) {
        if (it < nlat) {
            const int mt = it >> 3, nt = it & 7;
            f32x4 acc[4][4];
            RPPlain rp{MG + (size_t)mt * 128 * 1024, 1024};
            gemm_core_g<4>(rp, W + (size_t)nt * 128 * 1024, 1024, 1024, acc, smem);
            acc_foreach<4>(acc, [&](int m, int n, const f32x4& v) {
                const int row = mt * 128 + m, col = nt * 128 + n;
                const float4 g = *(const float4*)(mod + (size_t)(l * 5 + modidx(row)) * 6144 + 2048 + col);
                float4* xp = (float4*)(xcur + (size_t)row * 1024 + col);
                float4 x = *xp; x.x += g.x * v[0]; x.y += g.y * v[1]; x.z += g.z * v[2]; x.w += g.w * v[3]; *xp = x;
            });
        } else {
            const int j = it - nlat, mt = j >> 3, nt = j & 7;
            f32x4 acc[2][4];
            RPPlain rp{MG + (size_t)(RL + mt * 64) * 1024, 1024};
            gemm_core_g<2>(rp, W + (size_t)nt * 128 * 1024, 1024, 1024, acc, smem);
            acc_foreach<2>(acc, [&](int m, int n, const f32x4& v) {
                const int row = RL + mt * 64 + m, col = nt * 128 + n;
                const float4 g = *(const float4*)(mod + (size_t)(l * 5 + 4) * 6144 + 2048 + col);
                float4* xp = (float4*)(xcur + (size_t)row * 1024 + col);
                float4 x = *xp; x.x += g.x * v[0]; x.y += g.y * v[1]; x.z += g.z * v[2]; x.w += g.w * v[3]; *xp = x;
            });
        }
    }
}

__device__ __forceinline__ void ph_n2(const Params& p, int l, char* smem) {
    const int tid = tidx(), lane = tid & 63, wave = tid >> 6;
    unsigned* lcnt = (unsigned*)smem;
    unsigned* gbase = lcnt + 16;
    int* rec = (int*)(smem + 256);
    float4* rwl = (float4*)(smem + 8192);
    for (int idx = tid; idx < 4096; idx += 256) {
        const int k = idx >> 2, pp = idx & 3;
        rwl[(((k >> 8) * 16 + (k & 3) * 4 + pp) << 6) + ((k & 255) >> 2)] = *(const float4*)(p.in[I_RW] + (size_t)k * 16 + pp * 4);
    }
    if (tid < 16) lcnt[tid] = 0u;
    __syncthreads();
    int nrec = 0;
    const float* xcur = (const float*)(p.ws + O_XCUR); const float* mod = (const float*)(p.ws + O_MOD);
    bf16_t* H = (bf16_t*)(p.ws + O_H);
    unsigned* cnt = (unsigned*)(p.ws + O_CNT); int* LTOK = (int*)(p.ws + O_LTOK); float* LW = (float*)(p.ws + O_LW); int* SLOT = (int*)(p.ws + O_SLOT);
    const float* g = p.in[I_N2G] + l * 1024; const float* rw = p.in[I_RW]; const float* rb = p.in[I_RB];
    const int nrows = (l < NLAYER - 1) ? RT : RL;
    float4 vn[4];
    {
        const int r0 = blockIdx.x * 4 + wave;
        const float* x0 = xcur + (size_t)(r0 < nrows ? r0 : 0) * 1024;
#pragma unroll
        for (int i = 0; i < 4; ++i) vn[i] = *(const float4*)(x0 + lane * 4 + 256 * i);
    }
    for (int row = blockIdx.x * 4 + wave; row < nrows; row += gridDim.x * 4) {
        const float* md = mod + (size_t)(l * 5 + modidx(row)) * 6144;
        float4 v[4]; float ss = 0.f;
#pragma unroll
        for (int i = 0; i < 4; ++i) { v[i] = vn[i]; ss += v[i].x * v[i].x + v[i].y * v[i].y + v[i].z * v[i].z + v[i].w * v[i].w; }
        {
            const int rn = row + gridDim.x * 4;
            const float* xn = xcur + (size_t)(rn < nrows ? rn : row) * 1024;
#pragma unroll
            for (int i = 0; i < 4; ++i) vn[i] = *(const float4*)(xn + lane * 4 + 256 * i);
        }
        ss = wsum(ss);
        const float rstd = rsqrtf(ss * (1.f / 1024.f) + 1e-6f);
        float lg[16];
#pragma unroll
        for (int e = 0; e < 16; ++e) lg[e] = 0.f;
#pragma unroll
        for (int i = 0; i < 4; ++i) {
            const int c = lane * 4 + 256 * i;
            const float4 gg = *(const float4*)(g + c), sc = *(const float4*)(md + 4096 + c), sh = *(const float4*)(md + 3072 + c);
            const float hv[4] = {v[i].x * rstd * gg.x * (1.f + sc.x) + sh.x, v[i].y * rstd * gg.y * (1.f + sc.y) + sh.y,
                                 v[i].z * rstd * gg.z * (1.f + sc.z) + sh.z, v[i].w * rstd * gg.w * (1.f + sc.w) + sh.w};
            f32x4 h4 = {hv[0], hv[1], hv[2], hv[3]};
            store_bf16x4(H + (size_t)row * 1024 + c, h4);
#pragma unroll
            for (int j = 0; j < 4; ++j) {
                const float4* wr_ = rwl + ((i * 16 + j * 4) << 6) + lane;
                const float4 w0 = wr_[0], w1 = wr_[64], w2 = wr_[128], w3 = wr_[192];
                lg[0] += hv[j] * w0.x; lg[1] += hv[j] * w0.y; lg[2] += hv[j] * w0.z; lg[3] += hv[j] * w0.w;
                lg[4] += hv[j] * w1.x; lg[5] += hv[j] * w1.y; lg[6] += hv[j] * w1.z; lg[7] += hv[j] * w1.w;
                lg[8] += hv[j] * w2.x; lg[9] += hv[j] * w2.y; lg[10] += hv[j] * w2.z; lg[11] += hv[j] * w2.w;
                lg[12] += hv[j] * w3.x; lg[13] += hv[j] * w3.y; lg[14] += hv[j] * w3.z; lg[15] += hv[j] * w3.w;
            }
        }
        float sc_[16], sel[16];
#pragma unroll
        for (int e = 0; e < 16; ++e) { lg[e] = wsum(lg[e]); sc_[e] = 1.f / (1.f + expf(-lg[e])); sel[e] = sc_[e] + rb[e]; }
        int best = 0; float bestv = -1e30f;
#pragma unroll
        for (int gi = 0; gi < 4; ++gi) {
            float m1 = -1e30f, m2 = -1e30f;
#pragma unroll
            for (int j = 0; j < 4; ++j) { const float s = sel[gi * 4 + j]; if (s > m1) { m2 = m1; m1 = s; } else if (s > m2) m2 = s; }
            const float gs = m1 + m2;
            if (gs > bestv) { bestv = gs; best = gi; }
        }
        float s4[4] = {0.f, 0.f, 0.f, 0.f}, c4[4] = {0.f, 0.f, 0.f, 0.f};
#pragma unroll
        for (int gi = 0; gi < 4; ++gi)
#pragma unroll
            for (int j = 0; j < 4; ++j) if (gi == best) { s4[j] = sel[gi * 4 + j]; c4[j] = sc_[gi * 4 + j]; }
        int i1 = 0; float v1 = s4[0], w1 = c4[0];
#pragma unroll
        for (int j = 1; j < 4; ++j) if (s4[j] > v1) { v1 = s4[j]; i1 = j; w1 = c4[j]; }
        int i2 = -1; float v2 = -1e30f, w2 = 0.f;
#pragma unroll
        for (int j = 0; j < 4; ++j) if (j != i1 && s4[j] > v2) { v2 = s4[j]; i2 = j; w2 = c4[j]; }
        if (lane == 0) {
            const float inv = 1.f / (w1 + w2);
            const int e1 = best * 4 + i1, e2 = best * 4 + i2;
            const unsigned r1 = atomicAdd(&lcnt[e1], 1u), r2 = atomicAdd(&lcnt[e2], 1u);
            int* rc = rec + (wave * 32 + nrec) * 8;
            rc[0] = row; rc[1] = e1; rc[2] = e2; rc[3] = (int)r1; rc[4] = (int)r2; rc[5] = __float_as_int(w1 * inv); rc[6] = __float_as_int(w2 * inv);
        }
        ++nrec;
    }
    __syncthreads();
    if (tid < 16) gbase[tid] = lcnt[tid] ? atomicAdd(&cnt[tid], lcnt[tid]) : 0u;
    __syncthreads();
    for (int i = lane; i < nrec; i += 64) {
        const int* rc = rec + (wave * 32 + i) * 8;
        const int row = rc[0], e1 = rc[1], e2 = rc[2];
        const unsigned p1 = gbase[e1] + (unsigned)rc[3], p2 = gbase[e2] + (unsigned)rc[4];
        LTOK[(size_t)e1 * RT + p1] = row; LW[(size_t)e1 * RT + p1] = __int_as_float(rc[5]);
        LTOK[(size_t)e2 * RT + p2] = row; LW[(size_t)e2 * RT + p2] = __int_as_float(rc[6]);
        SLOT[row * 2] = (e1 << 20) | (int)p1; SLOT[row * 2 + 1] = (e2 << 20) | (int)p2;
    }
}

struct MoeTiles { int tb[17]; int sm; };
__device__ __forceinline__ void moe_tiles(const Params& p, int l, int* s_tb) {
    if (tidx() == 0) {
        const unsigned* cnt = (const unsigned*)(p.ws + O_CNT);
        int a = 0;
        for (int e = 0; e < 16; ++e) { s_tb[e] = a; a += ((int)cnt[e] + 127) >> 7; }
        s_tb[16] = a;
    }
    __syncthreads();
}
__device__ __forceinline__ void ph_e1(const Params& p, int l, char* smem) {
    int* s_tb = (int*)(smem + 73728);
    moe_tiles(p, l, s_tb);
    const bf16_t* H = (const bf16_t*)(p.ws + O_H); bf16_t* ACT = (bf16_t*)(p.ws + O_P);
    const unsigned* cnt = (const unsigned*)(p.ws + O_CNT); const int* LTOK = (const int*)(p.ws + O_LTOK); const float* LW = (const float*)(p.ws + O_LW);
    const int sm = (l < NLAYER - 1) ? RT / 128 : RL / 128;
    const int total = (sm + s_tb[16]) * 8;
    for (int it = blockIdx.x; it < total; it += gridDim.x) {
        const int mt = it >> 3, nt = it & 7;
        int e = 16, erow0 = mt * 128, lt = 0;
        if (mt >= sm) { const int q = mt - sm; e = 0; while (q >= s_tb[e + 1]) ++e; lt = q - s_tb[e]; erow0 = RT + q * 128; }
        const int cnte = (e == 16) ? 0 : (int)cnt[e];
        auto rp = [&](int r) -> const bf16_t* {
            if (e == 16) return H + (size_t)(mt * 128 + r) * 1024;
            const int idx = lt * 128 + r;
            const int tok = idx < cnte ? LTOK[(size_t)e * RT + idx] : 0;
            return H + (size_t)tok * 1024;
        };
        f32x4 acc[4][4];
        gemm_core_g<4>(rp, (const bf16_t*)(p.ws + O_WB + W_GU) + (size_t)e * 1024 * 1024 + (size_t)nt * 128 * 1024, 1024, 1024, acc, smem);
        {
            const int lane = tidx() & 63, wave = tidx() >> 6, wr = wave >> 1, wc = wave & 1, fr = lane & 15, fq = lane >> 4;
            float* U = (float*)smem;
#pragma unroll
            for (int ii = 0; ii < 2; ++ii) {
                const int i = wc == 0 ? 2 + ii : ii;
#pragma unroll
                for (int j = 0; j < 4; ++j) { const f32x4 gv = wc == 0 ? acc[2 + ii][j] : acc[ii][j]; *(f32x4*)(U + (wr * 64 + i * 16 + fr) * 68 + j * 16 + fq * 4) = gv; }
            }
            __syncthreads();
#pragma unroll
            for (int ii = 0; ii < 2; ++ii) {
                const int i = wc == 0 ? ii : 2 + ii;
                const int m = wr * 64 + i * 16 + fr;
                float wgt = 1.f;
                if (e != 16) { const int idx = lt * 128 + m; wgt = idx < cnte ? LW[(size_t)e * RT + idx] : 0.f; }
#pragma unroll
                for (int j = 0; j < 4; ++j) {
                    const f32x4 other = *(const f32x4*)(U + m * 68 + j * 16 + fq * 4);
                    f32x4 o;
                    const f32x4 mine = wc == 0 ? acc[ii][j] : acc[2 + ii][j];
#pragma unroll
                    for (int r = 0; r < 4; ++r) { const float g = wc == 0 ? mine[r] : other[r], u = wc == 0 ? other[r] : mine[r]; o[r] = siluf_(g) * u * wgt; }
                    store_bf16x4(ACT + (size_t)(erow0 + m) * 512 + nt * 64 + j * 16 + fq * 4, o);
                }
            }
            __syncthreads();
        }
    }
}
__device__ __forceinline__ void ph_e2(const Params& p, int l, char* smem) {
    int* s_tb = (int*)(smem + 73728);
    moe_tiles(p, l, s_tb);
    const bf16_t* ACT = (const bf16_t*)(p.ws + O_P); bf16_t* YE = (bf16_t*)(p.ws + O_X + X_YE);
    const int sm = (l < NLAYER - 1) ? RT / 128 : RL / 128;
    const int total = (sm + s_tb[16]) * 8;
    for (int it = blockIdx.x; it < total; it += gridDim.x) {
        const int mt = it >> 3, nt = it & 7;
        int e = 16, erow0 = mt * 128;
        if (mt >= sm) { const int q = mt - sm; e = 0; while (q >= s_tb[e + 1]) ++e; erow0 = RT + q * 128; }
        RPPlain rp{ACT + (size_t)erow0 * 512, 512};
        f32x4 acc[4][4];
        gemm_core_g<4>(rp, (const bf16_t*)(p.ws + O_WB + W_D) + (size_t)e * 1024 * 512 + (size_t)nt * 128 * 512, 512, 512, acc, smem);
        acc_foreach<4>(acc, [&](int m, int n, const f32x4& v) { store_bf16x4(YE + (size_t)(erow0 + m) * 1024 + nt * 128 + n, v); });
    }
}
__device__ __forceinline__ void ph_e3(const Params& p, int l, char* smem) {
    int* s_tb = (int*)(smem + 73728);
    moe_tiles(p, l, s_tb);
    const int lane = tidx() & 63, wave = tidx() >> 6;
    const bf16_t* YE = (const bf16_t*)(p.ws + O_X + X_YE); const int* SLOT = (const int*)(p.ws + O_SLOT);
    float* xcur = (float*)(p.ws + O_XCUR); const float* mod = (const float*)(p.ws + O_MOD);
    bf16_t* H = (bf16_t*)(p.ws + O_H);
    const bool last = l == NLAYER - 1;
    const int nrows = last ? RL : RT;
    const float* gn = last ? p.in[I_FNG] : p.in[I_N1G] + (l + 1) * 1024;
    const int stride = gridDim.x * 4, row0 = blockIdx.x * 4 + wave;
    auto slot_rows = [&](int row, size_t& r1, size_t& r2) {
        const int rr = row < nrows ? row : 0;
        const int s1 = SLOT[rr * 2], s2 = SLOT[rr * 2 + 1];
        r1 = (size_t)RT + s_tb[s1 >> 20] * 128 + (s1 & 0xfffff); r2 = (size_t)RT + s_tb[s2 >> 20] * 128 + (s2 & 0xfffff);
    };
    uint4 ya[2], yb[2], yd[2]; float4 xa[2][2];
    size_t r1n, r2n;
    auto load_row = [&](int row, size_t r1, size_t r2) {
        const size_t rr = row < nrows ? row : 0;
#pragma unroll
        for (int i = 0; i < 2; ++i) {
            const int c = lane * 8 + 512 * i;
            ya[i] = *(const uint4*)(YE + rr * 1024 + c); yb[i] = *(const uint4*)(YE + r1 * 1024 + c); yd[i] = *(const uint4*)(YE + r2 * 1024 + c);
            const float4* xp = (const float4*)(xcur + rr * 1024 + c);
            xa[i][0] = xp[0]; xa[i][1] = xp[1];
        }
    };
    { size_t r1, r2; slot_rows(row0, r1, r2); load_row(row0, r1, r2); slot_rows(row0 + stride, r1n, r2n); }
    for (int row = row0; row < nrows; row += stride) {
        const float* g2 = mod + (size_t)(l * 5 + modidx(row)) * 6144 + 5120;
        float xv[2][8]; float ss = 0.f;
#pragma unroll
        for (int i = 0; i < 2; ++i) {
            const int c = lane * 8 + 512 * i;
            float a[8], b[8], d[8];
            unpack8(ya[i], a); unpack8(yb[i], b); unpack8(yd[i], d);
            const float4 x0 = xa[i][0], x1 = xa[i][1];
            const float4 ga = *(const float4*)(g2 + c), gb = *(const float4*)(g2 + c + 4);
            const float xo[8] = {x0.x, x0.y, x0.z, x0.w, x1.x, x1.y, x1.z, x1.w}, gg[8] = {ga.x, ga.y, ga.z, ga.w, gb.x, gb.y, gb.z, gb.w};
#pragma unroll
            for (int e = 0; e < 8; ++e) { xv[i][e] = xo[e] + gg[e] * (a[e] + b[e] + d[e]); ss += xv[i][e] * xv[i][e]; }
            if (!last) { float4* xp = (float4*)(xcur + (size_t)row * 1024 + c); xp[0] = make_float4(xv[i][0], xv[i][1], xv[i][2], xv[i][3]); xp[1] = make_float4(xv[i][4], xv[i][5], xv[i][6], xv[i][7]); }
        }
        { const size_t r1 = r1n, r2 = r2n; load_row(row + stride, r1, r2); slot_rows(row + 2 * stride, r1n, r2n); }
        ss = wsum(ss);
        const float rstd = rsqrtf(ss * (1.f / 1024.f) + 1e-6f);
        const float* md = mod + (size_t)((l + 1) * 5 + modidx(row)) * 6144;
#pragma unroll
        for (int i = 0; i < 2; ++i) {
            const int c = lane * 8 + 512 * i;
            const float4 n0 = *(const float4*)(gn + c), n1 = *(const float4*)(gn + c + 4);
            const float nn[8] = {n0.x, n0.y, n0.z, n0.w, n1.x, n1.y, n1.z, n1.w};
            if (last) {
                float* op = p.out + (size_t)row * 1024 + c;
                *(float4*)op = make_float4(xv[i][0] * rstd * nn[0], xv[i][1] * rstd * nn[1], xv[i][2] * rstd * nn[2], xv[i][3] * rstd * nn[3]);
                *(float4*)(op + 4) = make_float4(xv[i][4] * rstd * nn[4], xv[i][5] * rstd * nn[5], xv[i][6] * rstd * nn[6], xv[i][7] * rstd * nn[7]);
            } else {
                const float4 c0 = *(const float4*)(md + 1024 + c), c1 = *(const float4*)(md + 1024 + c + 4), h0 = *(const float4*)(md + c), h1 = *(const float4*)(md + c + 4);
                const float sc[8] = {c0.x, c0.y, c0.z, c0.w, c1.x, c1.y, c1.z, c1.w}, sh[8] = {h0.x, h0.y, h0.z, h0.w, h1.x, h1.y, h1.z, h1.w};
                float o[8];
#pragma unroll
                for (int e = 0; e < 8; ++e) o[e] = xv[i][e] * rstd * nn[e] * (1.f + sc[e]) + sh[e];
                *(uint4*)(H + (size_t)row * 1024 + c) = pack8(o);
            }
        }
    }
}
constexpr int LDS_BYTES = 76800;
constexpr int NIV = 19;
extern __shared__ __attribute__((aligned(16))) char dynsmem[];
template <int ID> __device__ __forceinline__ void run_iv(const Params& pin, int l, char* smem) {
    Params p = pin; p.ws = launder(pin.ws);
    if constexpr (ID == 0) { ph_pre(p, smem); __syncthreads(); ph_w(p, 0, smem); }
    else if constexpr (ID == 1) ph_n1(p, l);
    else if constexpr (ID == 2) ph_g1(p, smem);
    else if constexpr (ID == 3) { ph_qu(p, smem); ph_rp1(p, l, smem); ph_rp2(p, l); ph_f1(p, l, smem); }
    else if constexpr (ID == 4) ph_m2(p, smem);
    else if constexpr (ID == 5) {
        const bool r1first = (blockIdx.x >> 8) & 1;
#pragma unroll 1
        for (int pass = 0; pass < 2; ++pass) {
            if ((pass == 0) == r1first) { ph_r1(p, l, smem); ph_fa(p, smem); } else ph_at(p, l, smem);
            __syncthreads();
        }
    }
    else if constexpr (ID == 8) { ph_r2(p, smem); __syncthreads(); ph_fb(p, l, smem); }
    else if constexpr (ID == 9) ph_r3(p);
    else if constexpr (ID == 10) ph_rpost(p, l);
    else if constexpr (ID == 12) ph_mg(p, l, smem);
    else if constexpr (ID == 13) ph_out(p, l, smem);
    else if constexpr (ID == 14) ph_n2(p, l, smem);
    else if constexpr (ID == 15) ph_e1(p, l, smem);
    else if constexpr (ID == 16) ph_e2(p, l, smem);
    else if constexpr (ID == 17) { ph_e3(p, l, smem); __syncthreads(); if (l + 1 < NLAYER) ph_w(p, l + 1, smem); }
}
#if MEGA
#ifndef PROBE_MASK
#define PROBE_MASK 0
#define PROBE_REP 1
#endif
#define IV(ID) for (int r_ = 0; r_ < (((PROBE_MASK >> (ID)) & 1) ? PROBE_REP : 1); ++r_) { run_iv<ID>(p, l, smem); xcd_barrier(bar); }
__global__ void __launch_bounds__(256, 2) k_mega(Params p) {
    char* smem = dynsmem;
    volatile LAS unsigned* st = (volatile LAS unsigned*)(smem + LDS_BYTES - 16);
    if (tidx() == 0) { st[0] = 0u; st[1] = 0u; }
    __syncthreads();
    XcdBarrier bar = xcd_barrier_post((unsigned*)(p.ws + O_BAR), st);
    { const int l = 0; IV(0) }
    for (int l = 0; l < NLAYER; ++l) {
        if (l == 0) { IV(1) } IV(2) IV(3) IV(4) IV(5) IV(8) IV(9) IV(10) IV(12) IV(13) IV(14) IV(15) IV(16) IV(17)
    }
}
#else
template <int ID> __global__ void __launch_bounds__(256, 2) k_iv(Params p, int l) { run_iv<ID>(p, l, dynsmem); }
template <int ID> static void launch_iv(const Params& p, int l, int grid, hipStream_t s) {
    static bool once = false; if (!once) { once = true; (void)hipFuncSetAttribute((const void*)k_iv<ID>, hipFuncAttributeMaxDynamicSharedMemorySize, LDS_BYTES); }
    hipLaunchKernelGGL(k_iv<ID>, dim3(grid), dim3(256), LDS_BYTES, s, p, l);
}
#endif

extern "C" void kernel_launch(void* const* d_in, const int* in_sizes, int n_in, void* d_out, int out_size, void* d_ws, size_t ws_size, hipStream_t stream) {
    (void)in_sizes; (void)out_size;
    if (n_in < N_IN || ws_size < WS_NEED) return;
    Params p{};
    for (int i = 0; i < N_IN; ++i) p.in[i] = (const float*)d_in[i];
    p.out = (float*)d_out; p.ws = (char*)d_ws;
    static int grid = 0;
    if (!grid) {
        int dev = 0, cus = 0; (void)hipGetDevice(&dev); (void)hipDeviceGetAttribute(&cus, hipDeviceAttributeMultiprocessorCount, dev);
        int per_cu = 2;
#if MEGA
        (void)hipFuncSetAttribute((const void*)k_mega, hipFuncAttributeMaxDynamicSharedMemorySize, LDS_BYTES);
        int occ = 0; (void)hipOccupancyMaxActiveBlocksPerMultiprocessor(&occ, k_mega, 256, LDS_BYTES);
        if (occ < per_cu) per_cu = occ;
        if (per_cu < 1) per_cu = 1;
#endif
        grid = cus * per_cu;
    }
#if MEGA
    (void)hipMemsetAsync(p.ws + O_BAR, 0, 16384, stream);
    hipLaunchKernelGGL(k_mega, dim3(grid), dim3(256), LDS_BYTES, stream, p);
#else
    launch_iv<0>(p, 0, grid, stream);
    for (int l = 0; l < NLAYER; ++l) {
        if (l == 0) launch_iv<1>(p, l, grid, stream); launch_iv<2>(p, l, grid, stream); launch_iv<3>(p, l, grid, stream); launch_iv<4>(p, l, grid, stream);
        launch_iv<5>(p, l, grid, stream); launch_iv<8>(p, l, grid, stream);
        launch_iv<9>(p, l, grid, stream); launch_iv<10>(p, l, grid, stream); launch_iv<12>(p, l, grid, stream);
        launch_iv<13>(p, l, grid, stream); launch_iv<14>(p, l, grid, stream); launch_iv<15>(p, l, grid, stream); launch_iv<16>(p, l, grid, stream); launch_iv<17>(p, l, grid, stream);
    }
#endif
}
```

```cpp
#include <hip/hip_runtime.h>
#include <stdint.h>

#ifndef MEGA
#define MEGA 1
#endif

typedef unsigned short bf16_t;
typedef short bf16x8 __attribute__((ext_vector_type(8)));
typedef float f32x4 __attribute__((ext_vector_type(4)));
typedef float f32x2 __attribute__((ext_vector_type(2)));
typedef unsigned u32x4 __attribute__((ext_vector_type(4)));
typedef __bf16 bf16v2 __attribute__((ext_vector_type(2)));

constexpr int NLAYER = 4;
constexpr int DM = 1024;
constexpr int RL = 16384, RC = 1024, RT = RL + RC;
constexpr int SEQ = 4096, CTX = 256, KEYS = SEQ + CTX;
constexpr int LDP = 6144;
constexpr int PQ0 = 512, PKV0 = 896, PKR0 = 1152, PR0 = 1184, PG0 = 2976, PEND = 6048;
constexpr int NEXP = 16;
constexpr int EROWS = 54272;

enum { I_X = 0, I_C, I_CTX, I_CCTX, I_WADA, I_BADA, I_N1G, I_N2G, I_WIN, I_QNG, I_KVNG, I_WUQ, I_WUKV, I_MU, I_W0, I_WUP, I_A0, I_AUP, I_GUP,
       I_KK, I_KA, I_RK, I_GNG, I_GNB, I_WPA, I_WPB, I_WPC, I_WOUT, I_RW, I_RB, I_EG, I_EU, I_ED, I_SG, I_SU, I_SD, I_FNG, N_IN };

struct Params { const float* in[N_IN]; float* out; char* ws; };

constexpr size_t al256(size_t x) { return (x + 255) & ~(size_t)255; }
constexpr size_t O_BAR   = 0;
constexpr size_t O_CNT   = O_BAR + 16384;
constexpr size_t O_MOD   = O_CNT + 4096;
constexpr size_t O_ROPEC = O_MOD + (size_t)NLAYER * 5 * 6144 * 4;
constexpr size_t O_ROPES = O_ROPEC + (size_t)SEQ * 16 * 4;
constexpr size_t O_CSC   = O_ROPES + (size_t)SEQ * 16 * 4;
constexpr size_t O_CST256= O_CSC + 256 * 128 * 2;
constexpr size_t O_D128  = O_CST256 + 256 * 512 * 2;
constexpr size_t O_E64   = O_D128 + 128 * 128 * 2;
constexpr size_t O_TWC   = O_E64 + 64 * 128 * 2;
constexpr size_t O_TWS   = O_TWC + 64 * 64 * 4;
constexpr size_t O_YT2   = O_TWS + 64 * 64 * 4;
constexpr size_t O_A2    = O_YT2 + (size_t)4 * 512 * 64 * 128 * 2;
constexpr size_t O_YTC   = O_A2 + (size_t)4 * 512 * 64 * 128 * 2;
constexpr size_t O_XCUR  = O_YTC + (size_t)4 * 512 * 512 * 2;
constexpr size_t O_WB    = O_XCUR + (size_t)RT * DM * 4;
constexpr size_t W_IN   = 0;
constexpr size_t W_UQ   = W_IN + (size_t)6144 * 1024 * 2;
constexpr size_t W_UKV  = W_UQ + (size_t)768 * 384 * 2;
constexpr size_t W_WUP  = W_UKV + (size_t)1024 * 256 * 2;
constexpr size_t W_AUP  = W_WUP + (size_t)2 * 512 * 64 * 2;
constexpr size_t W_GUP  = W_AUP + (size_t)2 * 512 * 64 * 2;
constexpr size_t W_PA   = W_GUP + (size_t)512 * 128 * 2;
constexpr size_t W_PB   = W_PA + (size_t)1024 * 512 * 2;
constexpr size_t W_PC   = W_PB + (size_t)1024 * 512 * 2;
constexpr size_t W_OUT  = W_PC + (size_t)1024 * 512 * 2;
constexpr size_t W_GU   = W_OUT + (size_t)1024 * 1024 * 2;
constexpr size_t W_D    = W_GU + (size_t)17 * 1024 * 1024 * 2;
constexpr size_t W_END  = W_D + (size_t)17 * 1024 * 512 * 2;
constexpr size_t O_H    = O_WB + W_END;
constexpr size_t O_P    = O_H + (size_t)RT * DM * 2;
constexpr size_t O_ATT  = O_P + (size_t)RT * LDP * 2;
constexpr size_t O_RG   = O_ATT + (size_t)RT * 512 * 2;
constexpr size_t O_RWO  = O_RG + (size_t)RT * 512 * 2;
constexpr size_t O_FA   = O_RWO + (size_t)RT * 512 * 2;
constexpr size_t O_LTOK = O_FA + (size_t)RT * 512 * 2;
constexpr size_t O_LW   = O_LTOK + (size_t)NEXP * RT * 4;
constexpr size_t O_SLOT = O_LW + (size_t)NEXP * RT * 4;
constexpr size_t O_X    = al256(O_SLOT + (size_t)RT * 2 * 4);
constexpr size_t X_QA   = 0;
constexpr size_t X_KA   = X_QA + (size_t)RT * 768 * 2;
constexpr size_t X_VA   = X_KA + (size_t)4 * KEYS * 768 * 2;
constexpr int NCP = 4 * 8 * 2 * 68;
constexpr size_t X_S0   = 0;
constexpr size_t X_MT   = X_VA + (size_t)4 * 8 * 64 * KEYS * 2;
constexpr size_t X_GT   = X_MT + (size_t)NCP * 8192;
constexpr size_t X_YL   = X_GT + (size_t)NCP * 8192;
constexpr size_t X_QRAW = X_MT;
constexpr size_t X_KVRAW= X_QRAW + (size_t)RT * 768 * 2;
constexpr size_t X_KKN  = X_YL + (size_t)NCP * 8192;
constexpr size_t X_BON  = X_KKN + (size_t)RT * 8 * 4;
constexpr size_t X_SSQ  = X_BON + (size_t)2 * RT * 8 * 4;
constexpr size_t X_END  = X_SSQ + (size_t)RT * 10 * 4;
static_assert(X_KVRAW + (size_t)RT * 1024 * 2 <= X_YL + (size_t)NCP * 8192, "raw q/kv must fit under the chunk data");
static_assert(X_S0 + (size_t)NCP * 8192 <= X_VA, "S0 must fit in the q/k area");
constexpr size_t X_YE   = 0;
constexpr size_t WS_NEED = O_X + X_END;

__device__ __forceinline__ float bf2f(bf16_t u) { return __builtin_bit_cast(float, (unsigned)u << 16); }
__device__ __forceinline__ float bflo(unsigned u) { return __builtin_bit_cast(float, u << 16); }
__device__ __forceinline__ float bfhi(unsigned u) { return __builtin_bit_cast(float, u & 0xffff0000u); }
__device__ __forceinline__ unsigned pack2(float lo, float hi) { f32x2 v = {lo, hi}; bf16v2 b = __builtin_convertvector(v, bf16v2); return __builtin_bit_cast(unsigned, b); }
__device__ __forceinline__ bf16_t f2bf(float f) { return (bf16_t)(pack2(f, 0.f) & 0xffffu); }
__device__ __forceinline__ float wsum(float v) {
#pragma unroll
    for (int o = 32; o > 0; o >>= 1) v += __shfl_xor(v, o);
    return v;
}
__device__ __forceinline__ float sigmoidf_(float x) { return 1.f / (1.f + __expf(-x)); }
__device__ __forceinline__ float siluf_(float x) { return x / (1.f + __expf(-x)); }
__device__ __forceinline__ int modidx(int row) { return row < RL ? (row >> 12) : 4; }
__device__ __forceinline__ void unpack8(const uint4& u, float (&f)[8]) {
    f[0] = bflo(u.x); f[1] = bfhi(u.x); f[2] = bflo(u.y); f[3] = bfhi(u.y); f[4] = bflo(u.z); f[5] = bfhi(u.z); f[6] = bflo(u.w); f[7] = bfhi(u.w);
}
__device__ __forceinline__ uint4 pack8(const float (&f)[8]) { return make_uint4(pack2(f[0], f[1]), pack2(f[2], f[3]), pack2(f[4], f[5]), pack2(f[6], f[7])); }

__device__ __forceinline__ float xmax_16_32(float v) {
    unsigned u = __builtin_bit_cast(unsigned, v);
    auto r = __builtin_amdgcn_permlane32_swap(u, u, false, false);
    float m = fmaxf(__builtin_bit_cast(float, r[0]), __builtin_bit_cast(float, r[1]));
    u = __builtin_bit_cast(unsigned, m);
    auto r2 = __builtin_amdgcn_permlane16_swap(u, u, false, false);
    return fmaxf(__builtin_bit_cast(float, r2[0]), __builtin_bit_cast(float, r2[1]));
}
__device__ __forceinline__ float lane_xor32(float v, int lane) {
    const unsigned u = __builtin_bit_cast(unsigned, v);
    auto r = __builtin_amdgcn_permlane32_swap(u, u, false, false);
    return __builtin_bit_cast(float, lane < 32 ? r[1] : r[0]);
}
__device__ __forceinline__ float xsum_16_32(float v) {
    unsigned u = __builtin_bit_cast(unsigned, v);
    auto r = __builtin_amdgcn_permlane32_swap(u, u, false, false);
    float m = __builtin_bit_cast(float, r[0]) + __builtin_bit_cast(float, r[1]);
    u = __builtin_bit_cast(unsigned, m);
    auto r2 = __builtin_amdgcn_permlane16_swap(u, u, false, false);
    return __builtin_bit_cast(float, r2[0]) + __builtin_bit_cast(float, r2[1]);
}
#define XB_TMO      128
#define XB_XCNT(j)  (256  + 64 * (j))
#define XB_XSUB(j)  (1280 + 64 * (j))
#define XB_XGEN(j)  (2304 + 64 * (j))
#define XB_TOP      3328
#define XB_TOPGEN   3392
#define XCD_BAR_WORDS 3456
#define XB_SPIN_CAP (1u << 22)
#define LAS __attribute__((address_space(3)))
__device__ __forceinline__ unsigned xb_ld(unsigned* p)              { return __hip_atomic_load(p, __ATOMIC_RELAXED, __HIP_MEMORY_SCOPE_AGENT); }
__device__ __forceinline__ unsigned xb_add(unsigned* p, unsigned v) { return __hip_atomic_fetch_add(p, v, __ATOMIC_RELAXED, __HIP_MEMORY_SCOPE_AGENT); }
__device__ __forceinline__ unsigned xb_xcc_id() { return (unsigned)__builtin_amdgcn_s_getreg((3 << 11) | 20) & 0xFu; }
#define XB_SPIN(cond, bar) do { unsigned _sp = 0; while (cond) { __builtin_amdgcn_s_sleep(1); \
    if ((++_sp & 255u) == 0u) { if (xb_ld(&(bar)[XB_TMO])) break; if (_sp > XB_SPIN_CAP) { atomicAdd(&(bar)[XB_TMO], 1u); break; } } } } while (0)
struct XcdBarrier { unsigned* bar; unsigned x; volatile LAS unsigned* st; };
__device__ __forceinline__ XcdBarrier xcd_barrier_post(unsigned* bar, volatile LAS unsigned* st) {
    XcdBarrier b; b.bar = bar; b.x = xb_xcc_id(); b.st = st;
    if (threadIdx.x == 0) (void)xb_add(&bar[XB_XCNT(b.x)], 1u);
    return b;
}
__device__ __forceinline__ void xcd_barrier_complete(unsigned* bar, unsigned x, unsigned& nloc, unsigned& nx) {
    const unsigned G = gridDim.x * gridDim.y * gridDim.z;
    unsigned sum, cnt, mine, sp = 0u;
    for (;;) {
        sum = 0u; cnt = 0u; mine = 0u;
#pragma unroll
        for (unsigned j = 0; j < 16; ++j) { const unsigned c = xb_ld(&bar[XB_XCNT(j)]); sum += c; cnt += (c > 0u) ? 1u : 0u; mine = (j == x) ? c : mine; }
        if (sum == G) break;
        __builtin_amdgcn_s_sleep(1);
        if ((++sp & 255u) == 0u) { if (xb_ld(&bar[XB_TMO])) break; if (sp > XB_SPIN_CAP) { atomicAdd(&bar[XB_TMO], 1u); break; } }
    }
    nloc = mine > 0u ? mine : 1u; nx = cnt > 0u ? cnt : 1u;
}
__device__ __forceinline__ void xcd_barrier(const XcdBarrier& b) {
    asm volatile("s_waitcnt vmcnt(0)" ::: "memory");
    __syncthreads();
    if (threadIdx.x == 0) {
        unsigned* bar = b.bar;
        __builtin_amdgcn_s_waitcnt(0);
        unsigned nloc = b.st[0], nx = b.st[1];
        if (nloc == 0u) { xcd_barrier_complete(bar, b.x, nloc, nx); b.st[0] = nloc; b.st[1] = nx; }
        const unsigned old = xb_add(&bar[XB_XSUB(b.x)], 1u);
        const unsigned gen = old / nloc;
        if (old + 1u == (gen + 1u) * nloc) {
            __builtin_amdgcn_fence(__ATOMIC_RELEASE, "agent");
            asm volatile("s_waitcnt vmcnt(0)" ::: "memory");
            const unsigned og = xb_add(&bar[XB_TOP], 1u);
            const unsigned tg = og / nx;
            if (og + 1u == (tg + 1u) * nx) xb_add(&bar[XB_TOPGEN], 1u);
            else XB_SPIN(xb_ld(&bar[XB_TOPGEN]) == tg, bar);
            __builtin_amdgcn_fence(__ATOMIC_ACQUIRE, "agent");
            xb_add(&bar[XB_XGEN(b.x)], 1u);
            asm volatile("s_waitcnt vmcnt(0)" ::: "memory");
        } else {
            XB_SPIN(xb_ld(&bar[XB_XGEN(b.x)]) == gen, bar);
            __builtin_amdgcn_fence(__ATOMIC_ACQUIRE, "agent");
            asm volatile("s_waitcnt vmcnt(0)" ::: "memory");
        }
    }
    __syncthreads();
}

__device__ __forceinline__ int tidx() { int t = threadIdx.x; asm volatile("" : "+v"(t)); return t; }
__device__ __forceinline__ int lv(int x) { asm volatile("" : "+v"(x)); return x; }
__device__ __forceinline__ char* launder(char* p) { size_t z = 0; asm volatile("" : "+s"(z)); return p + z; }

constexpr int LDSROW = 72;
template <int NA, class AL>
__device__ __forceinline__ void gc_load(const AL& al, const bf16_t* bp, size_t bstep, int k0, int kc, u32x4 (&ra)[NA], u32x4 (&rb)[4]) {
#pragma unroll
    for (int i = 0; i < NA; ++i) ra[i] = __builtin_bit_cast(u32x4, al.load(i, k0 + kc));
#pragma unroll
    for (int j = 0; j < 4; ++j) rb[j] = *(const u32x4*)(bp + j * bstep + k0);
}
template <int NA>
__device__ __forceinline__ void gc_store(bf16_t* Ab, bf16_t* Bb, int lr, int kc, const u32x4 (&ra)[NA], const u32x4 (&rb)[4]) {
#pragma unroll
    for (int i = 0; i < NA; ++i) *(u32x4*)(Ab + (lr + 32 * i) * LDSROW + kc) = ra[i];
#pragma unroll
    for (int j = 0; j < 4; ++j) *(u32x4*)(Bb + (lr + 32 * j) * LDSROW + kc) = rb[j];
}
template <int MI>
__device__ __forceinline__ void gc_compute(const bf16_t* Ac, const bf16_t* Bc, f32x4 (&acc)[MI][4]) {
#pragma unroll
    for (int kh = 0; kh < 2; ++kh) {
        bf16x8 af[MI], bfv[4];
#pragma unroll
        for (int i = 0; i < MI; ++i) af[i] = *(const bf16x8*)(Ac + i * 16 * LDSROW + kh * 32);
#pragma unroll
        for (int j = 0; j < 4; ++j) bfv[j] = *(const bf16x8*)(Bc + j * 16 * LDSROW + kh * 32);
#pragma unroll
        for (int i = 0; i < MI; ++i)
#pragma unroll
            for (int j = 0; j < 4; ++j) acc[i][j] = __builtin_amdgcn_mfma_f32_16x16x32_bf16(bfv[j], af[i], acc[i][j], 0, 0, 0);
    }
}
template <int MI, class AL>
__device__ __forceinline__ void gemm_core(const AL& al, const bf16_t* __restrict__ Bt, int ldb, int K, f32x4 (&acc)[MI][4], char* smem) {
    constexpr int TM = MI * 32;
    constexpr int NA = TM / 32;
    bf16_t* As = (bf16_t*)smem;
    bf16_t* Bs = As + 2 * TM * LDSROW;
    const int tid = tidx(), lane = tid & 63, wave = tid >> 6;
    const int wr = wave >> 1, wc = wave & 1, fr = lane & 15, fq = lane >> 4;
    const int kc = (tid & 7) * 8, lr = tid >> 3;
#pragma unroll
    for (int i = 0; i < MI; ++i)
#pragma unroll
        for (int j = 0; j < 4; ++j) acc[i][j] = (f32x4){0.f, 0.f, 0.f, 0.f};
    u32x4 a0[NA], b0[4], a1[NA], b1[4];
    const bf16_t* bp = Bt + (size_t)lr * ldb + kc;
    const size_t bstep = (size_t)32 * ldb;
    const int nk = K >> 6;
    bf16_t* As1 = As + TM * LDSROW; bf16_t* Bs1 = Bs + 128 * LDSROW;
    const int aoff = (wr * MI * 16 + fr) * LDSROW + fq * 8, boff = (wc * 64 + fr) * LDSROW + fq * 8;
    gc_load<NA>(al, bp, bstep, 0, kc, a0, b0);
    gc_store<NA>(As, Bs, lr, kc, a0, b0);
    if (nk > 1) gc_load<NA>(al, bp, bstep, 64, kc, a0, b0);
    __syncthreads();
    for (int kt = 0; kt < nk; kt += 2) {
        if (kt + 2 < nk) gc_load<NA>(al, bp, bstep, (kt + 2) << 6, kc, a1, b1);
        gc_compute<MI>(As + aoff, Bs + boff, acc);
        if (kt + 1 < nk) gc_store<NA>(As1, Bs1, lr, kc, a0, b0);
        __syncthreads();
        if (kt + 1 >= nk) break;
        if (kt + 3 < nk) gc_load<NA>(al, bp, bstep, (kt + 3) << 6, kc, a0, b0);
        gc_compute<MI>(As1 + aoff, Bs1 + boff, acc);
        if (kt + 2 < nk) gc_store<NA>(As, Bs, lr, kc, a1, b1);
        __syncthreads();
    }
}
template <int MI, class RP, class RPB>
__device__ __forceinline__ void gemm_core_gb(const RP& rp, const RPB& rpb, int K, f32x4 (&acc)[MI][4], char* smem) {
    constexpr int ABYTES = MI * 32 * 128;
    constexpr int SBYTES = ABYTES + 16384;
    const int tid = tidx(), lane = tid & 63, wave = tid >> 6;
    const int wr = wave >> 1, wc = wave & 1, fr = lane & 15, fq = lane >> 4;
    const int rr = lane >> 3, cs = ((lane & 7) ^ ((wave * 4 + (lane >> 4)) & 7)) * 8;
#pragma unroll
    for (int i = 0; i < MI; ++i)
#pragma unroll
        for (int j = 0; j < 4; ++j) acc[i][j] = (f32x4){0.f, 0.f, 0.f, 0.f};
    const bf16_t* ap[MI]; const bf16_t* bp[4];
#pragma unroll
    for (int i = 0; i < MI; ++i) { const int r = (i * 4 + wave) * 8 + rr; ap[i] = rp(r) + cs; }
#pragma unroll
    for (int i = 0; i < 4; ++i) { const int r = (i * 4 + wave) * 8 + rr; bp[i] = rpb(r) + cs; }
    const int wbase = __builtin_amdgcn_readfirstlane(wave) * 1024;
    const int nk = K >> 6;
    auto stage = [&](int buf, int kt) {
        char* Ab = smem + buf * SBYTES + wbase; char* Bb = Ab + ABYTES;
#pragma unroll
        for (int i = 0; i < MI; ++i) __builtin_amdgcn_global_load_lds((const unsigned*)(ap[i] + kt * 64), (unsigned*)(Ab + i * 4096), 16, 0, 0);
#pragma unroll
        for (int i = 0; i < 4; ++i) __builtin_amdgcn_global_load_lds((const unsigned*)(bp[i] + kt * 64), (unsigned*)(Bb + i * 4096), 16, 0, 0);
    };
    const int aoff = (wr * MI * 16 + fr) * 128, boff = ABYTES + (wc * 64 + fr) * 128, sw = fr >> 1;
    stage(0, 0);
    asm volatile("s_waitcnt vmcnt(0)" ::: "memory");
    __syncthreads();
    for (int kt = 0; kt < nk; ++kt) {
        const int cur = kt & 1;
        if (kt + 1 < nk) stage(cur ^ 1, kt + 1);
        const char* base = smem + cur * SBYTES;
#pragma unroll
        for (int kh = 0; kh < 2; ++kh) {
            const int xo = ((kh * 4 + fq) ^ sw) * 16;
            bf16x8 af[MI], bfv[4];
#pragma unroll
            for (int i = 0; i < MI; ++i) af[i] = *(const bf16x8*)(base + aoff + i * 2048 + xo);
#pragma unroll
            for (int j = 0; j < 4; ++j) bfv[j] = *(const bf16x8*)(base + boff + j * 2048 + xo);
#pragma unroll
            for (int i = 0; i < MI; ++i)
#pragma unroll
                for (int j = 0; j < 4; ++j) acc[i][j] = __builtin_amdgcn_mfma_f32_16x16x32_bf16(bfv[j], af[i], acc[i][j], 0, 0, 0);
        }
        asm volatile("s_waitcnt vmcnt(0)" ::: "memory");
        __syncthreads();
    }
}
struct RPPlain;
template <int MI, class RP>
__device__ __forceinline__ void gemm_core_g(const RP& rp, const bf16_t* __restrict__ Bt, int ldb, int K, f32x4 (&acc)[MI][4], char* smem);
struct RPPlain {
    const bf16_t* A; size_t lda;
    __device__ __forceinline__ const bf16_t* operator()(int r) const { return A + (size_t)r * lda; }
};
template <int MI, class RP>
__device__ __forceinline__ void gemm_core_g(const RP& rp, const bf16_t* __restrict__ Bt, int ldb, int K, f32x4 (&acc)[MI][4], char* smem) {
    RPPlain rpb{Bt, (size_t)ldb};
    gemm_core_gb<MI>(rp, rpb, K, acc, smem);
}
template <int MI, class F>
__device__ __forceinline__ void acc_foreach(const f32x4 (&acc)[MI][4], F f) {
    const int lane = tidx() & 63, wave = tidx() >> 6;
    const int wr = wave >> 1, wc = wave & 1, fr = lane & 15, fq = lane >> 4;
#pragma unroll
    for (int i = 0; i < MI; ++i)
#pragma unroll
        for (int j = 0; j < 4; ++j) f(wr * MI * 16 + i * 16 + fr, wc * 64 + j * 16 + fq * 4, acc[i][j]);
}
struct ALPlain {
    const bf16_t* p0; size_t step;
    __device__ __forceinline__ ALPlain(const bf16_t* A, int lda, int row0) { p0 = A + (size_t)(row0 + (tidx() >> 3)) * lda; step = (size_t)32 * lda; }
    __device__ __forceinline__ uint4 load(int i, int k) const { return *(const uint4*)(p0 + i * step + k); }
};
__device__ __forceinline__ void store_bf16x4(bf16_t* dst, const f32x4& v) { *(uint2*)dst = make_uint2(pack2(v[0], v[1]), pack2(v[2], v[3])); }

__device__ __forceinline__ void ph_pre(const Params& p, char* smem) {
    const int tid = tidx(), nb = gridDim.x, bid = blockIdx.x;
    float* mod = (float*)(p.ws + O_MOD);
    {
        float* sv = (float*)smem;
        float* part = sv + 5 * 1024;
        for (int i = tid; i < 5 * 1024; i += 256) { const float v = (i < 4096) ? p.in[I_C][i] : p.in[I_CCTX][i - 4096]; sv[i] = siluf_(v); }
        __syncthreads();
        for (int it = bid; it < NLAYER * 96; it += nb) {
            const int l = it / 96, jb = it % 96;
            const int jj = tid & 63, kq = tid >> 6, j = jb * 64 + jj;
            const float* w = p.in[I_WADA] + (size_t)l * 1024 * 6144 + (size_t)(kq * 256) * 6144 + j;
            float a0 = 0.f, a1 = 0.f, a2 = 0.f, a3 = 0.f, a4 = 0.f;
#pragma unroll 8
            for (int k = 0; k < 256; ++k) {
                const float wv = w[(size_t)k * 6144]; const int kk = kq * 256 + k;
                a0 += sv[kk] * wv; a1 += sv[1024 + kk] * wv; a2 += sv[2048 + kk] * wv; a3 += sv[3072 + kk] * wv; a4 += sv[4096 + kk] * wv;
            }
            part[(kq * 5 + 0) * 64 + jj] = a0; part[(kq * 5 + 1) * 64 + jj] = a1; part[(kq * 5 + 2) * 64 + jj] = a2;
            part[(kq * 5 + 3) * 64 + jj] = a3; part[(kq * 5 + 4) * 64 + jj] = a4;
            __syncthreads();
            for (int o = tid; o < 320; o += 256) {
                const int i = o >> 6, c = o & 63;
                const float s = part[(0 * 5 + i) * 64 + c] + part[(1 * 5 + i) * 64 + c] + part[(2 * 5 + i) * 64 + c] + part[(3 * 5 + i) * 64 + c];
                mod[(size_t)(l * 5 + i) * 6144 + jb * 64 + c] = s + p.in[I_BADA][l * 6144 + jb * 64 + c];
            }
            __syncthreads();
        }
    }
    {
        float4* xc = (float4*)(p.ws + O_XCUR);
        const float4* x4 = (const float4*)p.in[I_X]; const float4* c4 = (const float4*)p.in[I_CTX];
        for (size_t i = (size_t)bid * 256 + tid; i < (size_t)RT * 256; i += (size_t)nb * 256) xc[i] = (i < (size_t)RL * 256) ? x4[i] : c4[i - (size_t)RL * 256];
    }
    {
        float* ct = (float*)smem;
        __syncthreads();
        for (int m = tid; m < 4096; m += 256) ct[m] = cospif((float)m * (1.f / 2048.f));
        __syncthreads();
        bf16_t* cst2 = (bf16_t*)(p.ws + O_CST256);
        for (int ch = bid * 256 + tid; ch < 256 * 512 / 8; ch += nb * 256) {
            const int ks = ch >> 6, c0 = (ch & 63) * 8, part = c0 >> 8, s0 = c0 & 255;
            float f[8];
#pragma unroll
            for (int e = 0; e < 8; ++e) { const int m = (16 * ks * (s0 + e)) & 4095; f[e] = part == 0 ? ct[m] : ct[(m - 1024) & 4095]; }
            *(uint4*)(cst2 + ch * 8) = pack8(f);
        }
        bf16_t* d128 = (bf16_t*)(p.ws + O_D128);
        for (int ch = bid * 256 + tid; ch < 128 * 128 / 8; ch += nb * 256) {
            const int mrow = ch >> 4, c0 = (ch & 15) * 8, po = mrow >> 6, k1 = mrow & 63, pi = c0 >> 6, t10 = c0 & 63;
            float f[8];
#pragma unroll
            for (int e = 0; e < 8; ++e) {
                const int m = (64 * k1 * (t10 + e)) & 4095; const float cv = ct[m], sv = ct[(m - 1024) & 4095];
                f[e] = (po == pi) ? cv : (po == 0 ? sv : -sv);
            }
            *(uint4*)(d128 + ch * 8) = pack8(f);
        }
        bf16_t* e64 = (bf16_t*)(p.ws + O_E64);
        for (int ch = bid * 256 + tid; ch < 64 * 128 / 8; ch += nb * 256) {
            const int k2 = ch >> 4, c0 = (ch & 15) * 8, po = c0 >> 6, t20 = c0 & 63;
            float f[8];
#pragma unroll
            for (int e = 0; e < 8; ++e) { const int m = (64 * k2 * (t20 + e)) & 4095; f[e] = po == 0 ? ct[m] : ct[(m - 1024) & 4095]; }
            *(uint4*)(e64 + ch * 8) = pack8(f);
        }
        float* twc = (float*)(p.ws + O_TWC); float* tws = (float*)(p.ws + O_TWS);
        for (int i = bid * 256 + tid; i < 64 * 64; i += nb * 256) {
            const int k1 = i >> 6, t2 = i & 63, m = (k1 * t2) & 4095;
            twc[i] = ct[m]; tws[i] = -ct[(m - 1024) & 4095];
        }
        bf16_t* csc = (bf16_t*)(p.ws + O_CSC);
        for (int ch = bid * 256 + tid; ch < 256 * 128 / 8; ch += nb * 256) {
            const int n = ch >> 4, c0 = (ch & 15) * 8, part = n >> 7, kc = n & 127;
            float f[8];
#pragma unroll
            for (int e = 0; e < 8; ++e) { const int m = (32 * kc * (c0 + e)) & 4095; f[e] = part == 0 ? ct[m] : -ct[(m - 1024) & 4095]; }
            *(uint4*)(csc + ch * 8) = pack8(f);
        }
        float* rc = (float*)(p.ws + O_ROPEC); float* rs = (float*)(p.ws + O_ROPES);
        for (int i = bid * 256 + tid; i < SEQ * 16; i += nb * 256) {
            const int t = i >> 4, ax = (i >> 3) & 1, f = i & 7;
            const float inv = powf(10000.f, -(float)f / 8.f);
            const float pos = (float)(ax == 0 ? (t >> 6) : (t & 63));
            const float ang = pos * inv;
            rc[i] = cosf(ang); rs[i] = sinf(ang);
        }
    }
}

struct ConvTask { const float* src; const float* scale; bf16_t* dst; int K, Nsrc, Ndst, rmul; size_t sbs, dbs; };
__constant__ int c_conv_cum[17] = {0, 1536, 1608, 1672, 1688, 1704, 1720, 1848, 1976, 2104, 2360, 4408, 6456, 8504, 8632, 8760, 8888};
__device__ __forceinline__ ConvTask conv_task(const Params& p, int l, int t) {
    bf16_t* wb = (bf16_t*)(p.ws + O_WB);
    ConvTask c; c.scale = nullptr; c.sbs = 0; c.dbs = 0; c.rmul = 64;
    switch (t) {
    case 0:  c.src = p.in[I_WIN] + (size_t)l * 1024 * 6048; c.K = 1024; c.Nsrc = 6048; c.Ndst = 6144; c.dst = wb + W_IN / 2; break;
    case 1:  c.src = p.in[I_WUQ] + (size_t)l * 384 * 768; c.K = 384; c.Nsrc = 768; c.Ndst = 768; c.dst = wb + W_UQ / 2; c.scale = p.in[I_QNG] + l * 384; break;
    case 2:  c.src = p.in[I_WUKV] + (size_t)l * 256 * 1024; c.K = 256; c.Nsrc = 1024; c.Ndst = 1024; c.dst = wb + W_UKV / 2; c.scale = p.in[I_KVNG] + l * 256; break;
    case 3:  c.src = p.in[I_WUP] + (size_t)l * 2 * 64 * 512; c.K = 64; c.Nsrc = 512; c.Ndst = 512; c.dst = wb + W_WUP / 2; c.sbs = 64 * 512; c.dbs = 512 * 64; break;
    case 4:  c.src = p.in[I_AUP] + (size_t)l * 2 * 64 * 512; c.K = 64; c.Nsrc = 512; c.Ndst = 512; c.dst = wb + W_AUP / 2; c.sbs = 64 * 512; c.dbs = 512 * 64; break;
    case 5:  c.src = p.in[I_GUP] + (size_t)l * 128 * 512; c.K = 128; c.Nsrc = 512; c.Ndst = 512; c.dst = wb + W_GUP / 2; break;
    case 6:  c.src = p.in[I_WPA] + (size_t)l * 512 * 1024; c.K = 512; c.Nsrc = 1024; c.Ndst = 1024; c.dst = wb + W_PA / 2; break;
    case 7:  c.src = p.in[I_WPB] + (size_t)l * 512 * 1024; c.K = 512; c.Nsrc = 1024; c.Ndst = 1024; c.dst = wb + W_PB / 2; break;
    case 8:  c.src = p.in[I_WPC] + (size_t)l * 512 * 1024; c.K = 512; c.Nsrc = 1024; c.Ndst = 1024; c.dst = wb + W_PC / 2; break;
    case 9:  c.src = p.in[I_WOUT] + (size_t)l * 1024 * 1024; c.K = 1024; c.Nsrc = 1024; c.Ndst = 1024; c.dst = wb + W_OUT / 2; break;
    case 10: c.src = p.in[I_EG] + (size_t)l * 16 * 1024 * 512; c.K = 1024; c.Nsrc = 512; c.Ndst = 512; c.dst = wb + W_GU / 2; c.sbs = 1024 * 512; c.dbs = 1024 * 1024; c.rmul = 128; break;
    case 11: c.src = p.in[I_EU] + (size_t)l * 16 * 1024 * 512; c.K = 1024; c.Nsrc = 512; c.Ndst = 512; c.dst = wb + W_GU / 2 + 64 * 1024; c.sbs = 1024 * 512; c.dbs = 1024 * 1024; c.rmul = 128; break;
    case 12: c.src = p.in[I_ED] + (size_t)l * 16 * 512 * 1024; c.K = 512; c.Nsrc = 1024; c.Ndst = 1024; c.dst = wb + W_D / 2; c.sbs = 512 * 1024; c.dbs = 1024 * 512; break;
    case 13: c.src = p.in[I_SG] + (size_t)l * 1024 * 512; c.K = 1024; c.Nsrc = 512; c.Ndst = 512; c.dst = wb + W_GU / 2 + (size_t)16 * 1024 * 1024; c.rmul = 128; break;
    case 14: c.src = p.in[I_SU] + (size_t)l * 1024 * 512; c.K = 1024; c.Nsrc = 512; c.Ndst = 512; c.dst = wb + W_GU / 2 + (size_t)16 * 1024 * 1024 + 64 * 1024; c.rmul = 128; break;
    default: c.src = p.in[I_SD] + (size_t)l * 512 * 1024; c.K = 512; c.Nsrc = 1024; c.Ndst = 1024; c.dst = wb + W_D / 2 + (size_t)16 * 1024 * 512; break;
    }
    return c;
}
__device__ __forceinline__ void ph_w(const Params& p, int l, char* smem) {
    const int tid = tidx();
    float* tl = (float*)smem;
    for (int g = blockIdx.x; g < 8888; g += gridDim.x) {
        int t = 0;
        while (g >= c_conv_cum[t + 1]) ++t;
        const ConvTask c = conv_task(p, l, t);
        int r = g - c_conv_cum[t];
        const int nkt = c.K >> 6, nnt = c.Ndst >> 6;
        const int bi = r / (nkt * nnt); r -= bi * nkt * nnt;
        const int k0 = (r / nnt) * 64, n0 = (r % nnt) * 64;
        const float* src = c.src + bi * c.sbs; bf16_t* dst = c.dst + bi * c.dbs;
#pragma unroll
        for (int i = 0; i < 4; ++i) {
            const int k = (tid >> 4) + 16 * i, n = n0 + (tid & 15) * 4;
            float4 v = make_float4(0.f, 0.f, 0.f, 0.f);
            if (n < c.Nsrc) v = *(const float4*)(src + (size_t)(k0 + k) * c.Nsrc + n);
            if (c.scale) { const float s = c.scale[k0 + k]; v.x *= s; v.y *= s; v.z *= s; v.w *= s; }
            float* d = tl + k * 65 + (tid & 15) * 4;
            d[0] = v.x; d[1] = v.y; d[2] = v.z; d[3] = v.w;
        }
        __syncthreads();
        {
            const int n = tid >> 2, kk0 = (tid & 3) * 16;
            float f[8], g2[8];
#pragma unroll
            for (int j = 0; j < 8; ++j) { f[j] = tl[(kk0 + j) * 65 + n]; g2[j] = tl[(kk0 + 8 + j) * 65 + n]; }
            bf16_t* d = dst + (size_t)((n0 >> 6) * c.rmul + n) * c.K + k0 + kk0;
            *(uint4*)d = pack8(f); *(uint4*)(d + 8) = pack8(g2);
        }
        __syncthreads();
    }
}

__device__ __forceinline__ void ph_n1(const Params& p, int l) {
    const int lane = tidx() & 63, wave = tidx() >> 6;
    const float* xcur = (const float*)(p.ws + O_XCUR); const float* mod = (const float*)(p.ws + O_MOD);
    bf16_t* H = (bf16_t*)(p.ws + O_H);
    const float* g = p.in[I_N1G] + l * 1024;
    for (int row = blockIdx.x * 4 + wave; row < RT; row += gridDim.x * 4) {
        const float* x = xcur + (size_t)row * 1024; const float* md = mod + (size_t)(l * 5 + modidx(row)) * 6144;
        float4 v[4]; float ss = 0.f;
#pragma unroll
        for (int i = 0; i < 4; ++i) { v[i] = *(const float4*)(x + lane * 4 + 256 * i); ss += v[i].x * v[i].x + v[i].y * v[i].y + v[i].z * v[i].z + v[i].w * v[i].w; }
        ss = wsum(ss);
        const float rstd = rsqrtf(ss * (1.f / 1024.f) + 1e-6f);
#pragma unroll
        for (int i = 0; i < 4; ++i) {
            const int c = lane * 4 + 256 * i;
            const float4 gg = *(const float4*)(g + c), sc = *(const float4*)(md + 1024 + c), sh = *(const float4*)(md + c);
            f32x4 h = {v[i].x * rstd * gg.x * (1.f + sc.x) + sh.x, v[i].y * rstd * gg.y * (1.f + sc.y) + sh.y,
                       v[i].z * rstd * gg.z * (1.f + sc.z) + sh.z, v[i].w * rstd * gg.w * (1.f + sc.w) + sh.w};
            store_bf16x4(H + (size_t)row * 1024 + c, h);
        }
    }
}

__device__ __forceinline__ void ph_g1(const Params& p, char* smem) {
    if (blockIdx.x == 0 && tidx() < 64) ((unsigned*)(p.ws + O_CNT))[tidx()] = 0u;
    const bf16_t* H = (const bf16_t*)(p.ws + O_H); const bf16_t* W = (const bf16_t*)(p.ws + O_WB + W_IN);
    bf16_t* P = (bf16_t*)(p.ws + O_P);
    for (int it = blockIdx.x; it < 136 * 48; it += gridDim.x) {
        const int mt = it / 48, nt = it % 48;
        f32x4 acc[4][4];
        RPPlain rp{H + (size_t)mt * 128 * 1024, 1024};
        gemm_core_g<4>(rp, W + (size_t)nt * 128 * 1024, 1024, 1024, acc, smem);
        acc_foreach<4>(acc, [&](int m, int n, const f32x4& v) {
            const int col = nt * 128 + n; f32x4 o = v;
            if (col >= PG0 && col < PEND) { o[0] = sigmoidf_(v[0]); o[1] = sigmoidf_(v[1]); o[2] = sigmoidf_(v[2]); o[3] = sigmoidf_(v[3]); }
            store_bf16x4(P + (size_t)(mt * 128 + m) * LDP + col, o);
        });
        if (nt >= 4 && nt <= 8) {
            const int lane = tidx() & 63, wave = tidx() >> 6, wr = wave >> 1, wc = wave & 1, fr = lane & 15, fq = lane >> 4;
            float* SSQ = (float*)(p.ws + O_X + X_SSQ);
#pragma unroll
            for (int i = 0; i < 4; ++i) {
                float sq = 0.f;
#pragma unroll
                for (int j = 0; j < 4; ++j)
#pragma unroll
                    for (int r = 0; r < 4; ++r) sq += acc[i][j][r] * acc[i][j][r];
                sq = xsum_16_32(sq);
                if (fq == 0) SSQ[(size_t)(mt * 128 + wr * 64 + i * 16 + fr) * 10 + (nt - 4) * 2 + wc] = sq;
            }
        }
    }
}

constexpr float QSCALE = 0.10206207261596575f * 1.4426950408889634f;
__device__ __forceinline__ void ph_qu(const Params& p, char* smem) {
    const bf16_t* P = (const bf16_t*)(p.ws + O_P); const float* SSQ = (const float*)(p.ws + O_X + X_SSQ);
    bf16_t* QA = (bf16_t*)(p.ws + O_X + X_QA); bf16_t* KA = (bf16_t*)(p.ws + O_X + X_KA); bf16_t* VA = (bf16_t*)(p.ws + O_X + X_VA);
    const float* rc = (const float*)(p.ws + O_ROPEC); const float* rs = (const float*)(p.ws + O_ROPES);
    for (int it = blockIdx.x; it < 136 * 14; it += gridDim.x) {
        const int mt = it / 14, nn = it % 14;
        const int row0 = mt * 128;
        const bool lat = row0 < RL;
        const int b = lat ? (row0 >> 12) : ((row0 - RL) >> 8), t0 = lat ? (row0 & 4095) : ((row0 - RL) & 255);
        const size_t key0 = lat ? t0 : SEQ + t0;
        const int lane = tidx() & 63, wave = tidx() >> 6, wr = wave >> 1, wc = wave & 1, fr = lane & 15, fq = lane >> 4;
        f32x4 acc[4][4];
        if (nn < 6) {
            RPPlain rp{P + (size_t)row0 * LDP + PQ0, LDP};
            gemm_core_g<4>(rp, (const bf16_t*)(p.ws + O_WB + W_UQ) + (size_t)nn * 128 * 384, 384, 384, acc, smem);
#pragma unroll
            for (int i = 0; i < 4; ++i) {
                const int m = wr * 64 + i * 16 + fr, row = row0 + m, t = t0 + m;
                const float* sp = SSQ + (size_t)row * 10;
                const float rq = rsqrtf((sp[0] + sp[1] + sp[2] + sp[3] + sp[4] + sp[5]) * (1.f / 384.f) + 1e-6f);
#pragma unroll
                for (int j = 0; j < 4; ++j) {
                    const int n0 = nn * 128 + wc * 64 + j * 16, hg = (n0 >> 4) % 6;
                    f32x4 o = acc[i][j] * rq;
                    if (hg >= 4 && lat) {
                        const int ax = hg - 4, half = fq >> 1;
                        const float4 c4 = *(const float4*)(rc + t * 16 + ax * 8 + (fq & 1) * 4), s4 = *(const float4*)(rs + t * 16 + ax * 8 + (fq & 1) * 4);
                        const float cc[4] = {c4.x, c4.y, c4.z, c4.w}, ss[4] = {s4.x, s4.y, s4.z, s4.w};
#pragma unroll
                        for (int r = 0; r < 4; ++r) {
                            const float xp = lane_xor32(o[r], lane);
                            o[r] = half ? (o[r] * cc[r] + xp * ss[r]) : (o[r] * cc[r] - xp * ss[r]);
                        }
                    }
                    o *= QSCALE;
                    store_bf16x4(QA + (size_t)row * 768 + n0 + fq * 4, o);
                }
            }
        } else {
            const int h = nn - 6;
            RPPlain rp{P + (size_t)row0 * LDP + PKV0, LDP};
            gemm_core_g<4>(rp, (const bf16_t*)(p.ws + O_WB + W_UKV) + (size_t)h * 128 * 256, 256, 256, acc, smem);
            bf16_t* vt = (bf16_t*)smem;
#pragma unroll
            for (int i = 0; i < 4; ++i) {
                const int m = wr * 64 + i * 16 + fr, row = row0 + m;
                const float* sp = SSQ + (size_t)row * 10;
                const float rkv = rsqrtf((sp[6] + sp[7] + sp[8] + sp[9]) * (1.f / 256.f) + 1e-6f);
#pragma unroll
                for (int j = 0; j < 4; ++j) {
                    const f32x4 o = acc[i][j] * rkv;
                    if (wc == 0) store_bf16x4(KA + ((size_t)b * KEYS + key0 + m) * 768 + h * 96 + j * 16 + fq * 4, o);
                    else store_bf16x4(vt + m * 72 + j * 16 + fq * 4, o);
                }
            }
            __syncthreads();
#pragma unroll
            for (int u = 0; u < 4; ++u) {
                const int q = tidx() + 256 * u, dd = q >> 4, kc = q & 15;
                float f[8];
#pragma unroll
                for (int e = 0; e < 8; ++e) f[e] = bf2f(vt[(kc * 8 + e) * 72 + dd]);
                const uint4 uu = pack8(f);
                bf16_t* dst = VA + ((size_t)(b * 8 + h) * 64 + dd) * KEYS + key0 + (kc >> 2) * 32 + (kc & 1) * 16 + ((kc & 3) >> 1) * 4;
                *(uint2*)dst = make_uint2(uu.x, uu.y); *(uint2*)(dst + 8) = make_uint2(uu.z, uu.w);
            }
            __syncthreads();
        }
    }
}
__device__ __forceinline__ void ph_krope(const Params& p) {
    const int lane = tidx() & 63, wave = tidx() >> 6;
    const bf16_t* P = (const bf16_t*)(p.ws + O_P); bf16_t* KA = (bf16_t*)(p.ws + O_X + X_KA);
    const float* rc = (const float*)(p.ws + O_ROPEC); const float* rs = (const float*)(p.ws + O_ROPES);
    for (int row = blockIdx.x * 4 + wave; row < RT; row += gridDim.x * 4) {
        const bool lat = row < RL;
        const int b = lat ? (row >> 12) : ((row - RL) >> 8), t = lat ? (row & 4095) : ((row - RL) & 255);
        const size_t keyrow = (size_t)b * KEYS + (lat ? t : SEQ + t);
        const int ii = lane & 31, hh = lane >> 5;
        const bf16_t* pr = P + (size_t)row * LDP + PKR0;
        float x = bf2f(pr[ii]);
        if (lat) {
            const float xp = bf2f(pr[ii ^ 8]);
            const int ax = ii >> 4, half = (ii >> 3) & 1, f = ii & 7;
            const float c = rc[t * 16 + ax * 8 + f], sn = rs[t * 16 + ax * 8 + f];
            x = half ? (x * c + xp * sn) : (x * c - xp * sn);
        }
        const bf16_t xb = f2bf(x);
#pragma unroll
        for (int q = 0; q < 4; ++q) KA[keyrow * 768 + (hh * 4 + q) * 96 + 64 + ii] = xb;
    }
}

constexpr int KS_LD = 104, VT_LD = 72;
constexpr int AT_BUF = 64 * KS_LD * 2 + 64 * VT_LD * 2;
__device__ __forceinline__ void ph_at(const Params& p, int l, char* smem) {
    const int tid = tidx(), lane = tid & 63, wave = tid >> 6, fr = lane & 15, fq = lane >> 4;
    const bf16_t* QA = (const bf16_t*)(p.ws + O_X + X_QA); const bf16_t* KA = (const bf16_t*)(p.ws + O_X + X_KA); const bf16_t* VA = (const bf16_t*)(p.ws + O_X + X_VA);
    bf16_t* ATT = (bf16_t*)(p.ws + O_ATT);
    const int nitems = 1024 + (l < NLAYER - 1 ? 64 : 0);
    for (int it0 = blockIdx.x; it0 < nitems; it0 += gridDim.x) {
        int it = it0;
        if (gridDim.x == 512 && it0 < 1024) {
            const int x = it0 & 7, j = (it0 >> 3) & 63, rd = it0 >> 9;
            it = ((x * 4 + rd * 2 + (j >> 5)) << 5) | (j & 31);
        }
        int b, h, row0, ntile; size_t krow0;
        if (it < 1024) { b = it >> 8; h = (it >> 5) & 7; row0 = b * SEQ + (it & 31) * 128; krow0 = (size_t)b * KEYS; ntile = KEYS / 64; }
        else { const int j = it - 1024; b = j >> 4; h = (j >> 1) & 7; row0 = RL + b * CTX + (j & 1) * 128; krow0 = (size_t)b * KEYS + SEQ; ntile = CTX / 64; }
        const int qrow = row0 + wave * 32 + fr;
        const size_t vrow0 = (size_t)(b * 8 + h) * 64; const int koff0 = (int)(krow0 - (size_t)b * KEYS);
        bf16x8 qf[2][3];
#pragma unroll
        for (int t = 0; t < 2; ++t)
#pragma unroll
            for (int ks = 0; ks < 3; ++ks) qf[t][ks] = *(const bf16x8*)(QA + (size_t)(qrow + 16 * t) * 768 + h * 96 + ks * 32 + fq * 8);
        f32x4 ot[2][4];
#pragma unroll
        for (int t = 0; t < 2; ++t)
#pragma unroll
            for (int i = 0; i < 4; ++i) ot[t][i] = (f32x4){0.f, 0.f, 0.f, 0.f};
        float m_run[2] = {-1e30f, -1e30f}, l_run[2] = {0.f, 0.f};
        uint4 rk0, rk1, rk2, rv0, rv1;
#define AT_GLOAD(KT) do { const size_t kr_ = krow0 + (size_t)(KT) * 64; \
            { const int c = tid, key = c / 12, part = c % 12; rk0 = *(const uint4*)(KA + (kr_ + key) * 768 + h * 96 + part * 8); } \
            { const int c = tid + 256, key = c / 12, part = c % 12; rk1 = *(const uint4*)(KA + (kr_ + key) * 768 + h * 96 + part * 8); } \
            { const int c = tid + 512, key = c / 12, part = c % 12; rk2 = *(const uint4*)(KA + (kr_ + key) * 768 + h * 96 + part * 8); } \
            { const int c = tid, dd_ = c >> 3, part = c & 7; rv0 = *(const uint4*)(VA + (vrow0 + dd_) * KEYS + koff0 + (KT) * 64 + part * 8); } \
            { const int c = tid + 256, dd_ = c >> 3, part = c & 7; rv1 = *(const uint4*)(VA + (vrow0 + dd_) * KEYS + koff0 + (KT) * 64 + part * 8); } } while (0)
#define AT_VSTORE(RV, C) do { const int dd_ = (C) >> 3, part = (C) & 7; *(uint4*)(Vt_ + dd_ * VT_LD + part * 8) = RV; } while (0)
#define AT_SSTORE(BUF) do { bf16_t* Ks_ = (bf16_t*)(smem + (BUF) * AT_BUF); bf16_t* Vt_ = Ks_ + 64 * KS_LD; \
            { const int c = tid, key = c / 12, part = c % 12; *(uint4*)(Ks_ + key * KS_LD + part * 8) = rk0; } \
            { const int c = tid + 256, key = c / 12, part = c % 12; *(uint4*)(Ks_ + key * KS_LD + part * 8) = rk1; } \
            { const int c = tid + 512, key = c / 12, part = c % 12; *(uint4*)(Ks_ + key * KS_LD + part * 8) = rk2; } \
            AT_VSTORE(rv0, tid); AT_VSTORE(rv1, tid + 256); } while (0)
        AT_GLOAD(0); AT_SSTORE(0);
        __syncthreads();
        for (int kt = 0; kt < ntile; ++kt) {
            const int cur = kt & 1;
            if (kt + 1 < ntile) AT_GLOAD(kt + 1);
            const bf16_t* Ks = (const bf16_t*)(smem + cur * AT_BUF); const bf16_t* Vt = Ks + 64 * KS_LD;
            f32x4 st[2][4];
#pragma unroll
            for (int jh = 0; jh < 2; ++jh) {
                bf16x8 kf[2][3];
#pragma unroll
                for (int jj = 0; jj < 2; ++jj)
#pragma unroll
                    for (int ks = 0; ks < 3; ++ks) kf[jj][ks] = *(const bf16x8*)(Ks + ((jh * 2 + jj) * 16 + fr) * KS_LD + ks * 32 + fq * 8);
#pragma unroll
                for (int jj = 0; jj < 2; ++jj) {
                    const int j = jh * 2 + jj;
                    st[0][j] = (f32x4){0.f, 0.f, 0.f, 0.f}; st[1][j] = (f32x4){0.f, 0.f, 0.f, 0.f};
#pragma unroll
                    for (int ks = 0; ks < 3; ++ks) {
                        st[0][j] = __builtin_amdgcn_mfma_f32_16x16x32_bf16(kf[jj][ks], qf[0][ks], st[0][j], 0, 0, 0);
                        st[1][j] = __builtin_amdgcn_mfma_f32_16x16x32_bf16(kf[jj][ks], qf[1][ks], st[1][j], 0, 0, 0);
                    }
                }
            }
            bf16x8 vf[2][4];
#pragma unroll
            for (int k2 = 0; k2 < 2; ++k2)
#pragma unroll
                for (int dt = 0; dt < 4; ++dt) {
                    vf[k2][dt] = *(const bf16x8*)(Vt + (dt * 16 + fr) * VT_LD + k2 * 32 + fq * 8);
                }
            uint4 pu[2][2];
#pragma unroll
            for (int t = 0; t < 2; ++t) {
                float mx = st[t][0][0];
#pragma unroll
                for (int j = 0; j < 4; ++j)
#pragma unroll
                    for (int r = 0; r < 4; ++r) mx = fmaxf(mx, st[t][j][r]);
                if (__any(mx > m_run[t] + 6.f)) {
                    mx = xmax_16_32(mx);
                    const float m_new = fmaxf(m_run[t], mx);
                    const float alpha = __builtin_amdgcn_exp2f(m_run[t] - m_new);
                    m_run[t] = m_new;
                    l_run[t] *= alpha;
#pragma unroll
                    for (int i = 0; i < 4; ++i) ot[t][i] *= alpha;
                }
                const float mr = m_run[t];
                float ps = 0.f;
#pragma unroll
                for (int j = 0; j < 4; ++j)
#pragma unroll
                    for (int r = 0; r < 4; ++r) { st[t][j][r] = __builtin_amdgcn_exp2f(st[t][j][r] - mr); ps += st[t][j][r]; }
                l_run[t] += ps;
#pragma unroll
                for (int k2 = 0; k2 < 2; ++k2)
                    pu[t][k2] = make_uint4(pack2(st[t][2 * k2][0], st[t][2 * k2][1]), pack2(st[t][2 * k2][2], st[t][2 * k2][3]),
                                           pack2(st[t][2 * k2 + 1][0], st[t][2 * k2 + 1][1]), pack2(st[t][2 * k2 + 1][2], st[t][2 * k2 + 1][3]));
            }
#pragma unroll
            for (int k2 = 0; k2 < 2; ++k2) {
                const bf16x8 pb0 = __builtin_bit_cast(bf16x8, pu[0][k2]), pb1 = __builtin_bit_cast(bf16x8, pu[1][k2]);
#pragma unroll
                for (int dt = 0; dt < 4; ++dt) {
                    ot[0][dt] = __builtin_amdgcn_mfma_f32_16x16x32_bf16(vf[k2][dt], pb0, ot[0][dt], 0, 0, 0);
                    ot[1][dt] = __builtin_amdgcn_mfma_f32_16x16x32_bf16(vf[k2][dt], pb1, ot[1][dt], 0, 0, 0);
                }
            }
            if (kt + 1 < ntile) AT_SSTORE(cur ^ 1);
            __syncthreads();
        }
#pragma unroll
        for (int t = 0; t < 2; ++t) {
            const float inv = 1.f / xsum_16_32(l_run[t]);
#pragma unroll
            for (int dt = 0; dt < 4; ++dt) { f32x4 o = ot[t][dt] * inv; store_bf16x4(ATT + (size_t)(qrow + 16 * t) * 512 + h * 64 + dt * 16 + fq * 4, o); }
        }
    }
}

__device__ __forceinline__ void row_edges(int row, bool& first, bool& last) {
    if (row < RL) { const int t = row & 4095; first = t == 0; last = t == 4095; }
    else { const int s = (row - RL) & 255; first = s == 0; last = s == 255; }
}
__device__ __forceinline__ float xs1(const bf16_t* P, const float* mu, int row, int col) {
    bool first, last; row_edges(row, first, last);
    const bf16_t* pc = P + (size_t)row * LDP + PR0 + col;
    const float c = bf2f(*pc), pv0 = bf2f(*(first ? pc : pc - LDP)), nx0 = bf2f(*(last ? pc : pc + LDP));
    const float pv = first ? 0.f : pv0, nx = last ? 0.f : nx0;
    return c + (0.5f * (pv + nx) - c) * mu[col];
}
__device__ __forceinline__ void xs8(const bf16_t* P, const float* mu, int row, int col, float (&o)[8]) {
    bool first, last; row_edges(row, first, last);
    const bf16_t* pc = P + (size_t)row * LDP + PR0 + col;
    const uint4 uc = *(const uint4*)pc, up = *(const uint4*)(first ? pc : pc - LDP), un = *(const uint4*)(last ? pc : pc + LDP);
    float c[8], pv[8], nx[8]; unpack8(uc, c); unpack8(up, pv); unpack8(un, nx);
    const float fp = first ? 0.f : 0.5f, fn = last ? 0.f : 0.5f;
    const float4 m0 = *(const float4*)(mu + col), m1 = *(const float4*)(mu + col + 4);
    const float m[8] = {m0.x, m0.y, m0.z, m0.w, m1.x, m1.y, m1.z, m1.w};
#pragma unroll
    for (int j = 0; j < 8; ++j) o[j] = c[j] + ((fp * pv[j] + fn * nx[j]) - c[j]) * m[j];
}
struct ALRw {
    const bf16_t* P; const float* mu; int row0; int colbase, mode;
    __device__ __forceinline__ ALRw(const bf16_t* P_, const float* mu_, int row0_, int colbase_, int mode_) : P(P_), mu(mu_), colbase(colbase_), mode(mode_) {
        row0 = row0_ + (tidx() >> 3);
    }
    __device__ __forceinline__ uint4 load(int i, int k) const {
        float o[8]; xs8(P, mu, row0 + 32 * i, colbase + k, o);
        if (mode == 0) {
#pragma unroll
            for (int j = 0; j < 8; ++j) o[j] = tanhf(o[j]);
        } else if (mode == 2) {
#pragma unroll
            for (int j = 0; j < 8; ++j) o[j] = sigmoidf_(o[j]);
        }
        return pack8(o);
    }
};
__device__ __forceinline__ void ph_rp1(const Params& p, int l, char* smem) {
    const bf16_t* P = (const bf16_t*)(p.ws + O_P); const float* mu = p.in[I_MU] + l * 1792;
    bf16_t* RG = (bf16_t*)(p.ws + O_RG);
    for (int it = blockIdx.x; it < 1088; it += gridDim.x) {
        const int mt = it >> 2, nt = it & 3;
        f32x4 acc[2][4];
        ALRw al(P, mu, mt * 64, 1664, 2);
        gemm_core<2>(al, (const bf16_t*)(p.ws + O_WB + W_GUP) + (size_t)nt * 128 * 128, 128, 128, acc, smem);
        acc_foreach<2>(acc, [&](int m, int n, const f32x4& v) { store_bf16x4(RG + (size_t)(mt * 64 + m) * 512 + nt * 128 + n, v); });
    }
}
__device__ __forceinline__ void ph_rp2(const Params& p, int l) {
    const int lane = tidx() & 63, wave = tidx() >> 6;
    const bf16_t* P = (const bf16_t*)(p.ws + O_P); const float* mu = p.in[I_MU] + l * 1792; const float* kkw = p.in[I_KK] + l * 512;
    float* KKN = (float*)(p.ws + O_X + X_KKN);
    for (int row = blockIdx.x * 4 + wave; row < RT; row += gridDim.x * 4) {
        float k8[8]; xs8(P, mu, row, 512 + lane * 8, k8);
        float s = 0.f;
#pragma unroll
        for (int j = 0; j < 8; ++j) { const float v = k8[j] * kkw[lane * 8 + j]; s += v * v; }
        s += __shfl_xor(s, 1); s += __shfl_xor(s, 2); s += __shfl_xor(s, 4);
        if ((lane & 7) == 0) KKN[(size_t)row * 8 + (lane >> 3)] = rsqrtf(s + 1e-12f);
    }
}

__device__ __forceinline__ int scan_row(int b, int d, int n) {
    if (n < CTX) return RL + b * CTX + (d == 0 ? n : CTX - 1 - n);
    const int t = n - CTX; return b * SEQ + (d == 0 ? t : SEQ - 1 - t);
}
constexpr int SL = 72;
constexpr int SLOT_E = 64 * SL;
template <int LDA, int LDB>
__device__ __forceinline__ void mm64(const bf16_t* A, const bf16_t* B, f32x4 (&acc)[4], int wave, int fr, int fq) {
#pragma unroll
    for (int ks = 0; ks < 2; ++ks) {
        const bf16x8 af = *(const bf16x8*)(A + (wave * 16 + fr) * LDA + ks * 32 + fq * 8);
#pragma unroll
        for (int nt = 0; nt < 4; ++nt) {
            const bf16x8 bfv = *(const bf16x8*)(B + (nt * 16 + fr) * LDB + ks * 32 + fq * 8);
            acc[nt] = __builtin_amdgcn_mfma_f32_16x16x32_bf16(bfv, af, acc[nt], 0, 0, 0);
        }
    }
}
__device__ __forceinline__ void acc_zero(f32x4 (&acc)[4]) {
#pragma unroll
    for (int nt = 0; nt < 4; ++nt) acc[nt] = (f32x4){0.f, 0.f, 0.f, 0.f};
}
template <bool STRICT>
__device__ __forceinline__ void acc_mask(f32x4 (&acc)[4], int m, int fq) {
#pragma unroll
    for (int nt = 0; nt < 4; ++nt)
#pragma unroll
        for (int r = 0; r < 4; ++r) { const int n = nt * 16 + fq * 4 + r; const bool keep = STRICT ? (m < n) : (m <= n); if (!keep) acc[nt][r] = 0.f; }
}
__device__ __forceinline__ void st_rm(bf16_t* dst, const f32x4 (&acc)[4], int m, int fq) {
#pragma unroll
    for (int nt = 0; nt < 4; ++nt) store_bf16x4(dst + m * SL + nt * 16 + fq * 4, acc[nt]);
}
__device__ __forceinline__ void st_tr(bf16_t* dst, const f32x4 (&acc)[4], int m, int fq) {
#pragma unroll
    for (int nt = 0; nt < 4; ++nt)
#pragma unroll
        for (int r = 0; r < 4; ++r) dst[(nt * 16 + fq * 4 + r) * SL + m] = f2bf(acc[nt][r]);
}
__device__ __forceinline__ void ph_r1(const Params& p, int l, char* smem) {
    const int tid0 = tidx();
#define R1_IDX const int tid = lv(tid0), lane = tid & 63, wave = tid >> 6, fr = lane & 15, fq = lane >> 4, bi = tid >> 2, bq = (tid & 3) * 16, m = wave * 16 + fr; (void)bi; (void)bq; (void)m; (void)fq;
    const bf16_t* P = (const bf16_t*)(p.ws + O_P); const float* mu = p.in[I_MU] + l * 1792;
    const float* kkw = p.in[I_KK] + l * 512; const float* kaw = p.in[I_KA] + l * 512; const float* rkw = p.in[I_RK] + l * 512;
    const float* KKN = (const float*)(p.ws + O_X + X_KKN); float* BON = (float*)(p.ws + O_X + X_BON);
    bf16_t* gMT = (bf16_t*)(p.ws + O_X + X_MT); bf16_t* gNL = (bf16_t*)(p.ws + O_H);
    bf16_t* gGT = (bf16_t*)(p.ws + O_X + X_GT); bf16_t* gYL = (bf16_t*)(p.ws + O_X + X_YL);
    bf16_t* slot = (bf16_t*)smem;
    bf16_t* s0 = slot, *s1 = slot + SLOT_E, *s2 = slot + 2 * SLOT_E, *s3 = slot + 3 * SLOT_E;
    bf16_t* sa = slot + 4 * SLOT_E, *sb = slot + 5 * SLOT_E, *sc = slot + 6 * SLOT_E, *sT = slot + 7 * SLOT_E;
    float* misc = (float*)(smem + 8 * SLOT_E * 2);
    float* GAM = misc; float* SEG = misc + 64;
    float* ASIG = (float*)s0;
    float* LWS = (float*)s2;
    for (int it = blockIdx.x; it < NCP; it += gridDim.x) {
        const int c = it % 68, d = (it / 68) & 1, h = (it / 136) & 7, b = it / 1088;
        {
            R1_IDX const int rowb = scan_row(b, d, c * 64 + bi); (void)rowb;
            float o[8];
#pragma unroll
            for (int hh = 0; hh < 2; ++hh) {
                xs8(P, mu, rowb, 1536 + bq + hh * 8, o);
#pragma unroll
                for (int j = 0; j < 8; ++j) o[j] = 1.f - 2.f * __builtin_amdgcn_rcpf(1.f + __expf(2.f * o[j]));
                *(uint4*)(sa + bi * SL + bq + hh * 8) = pack8(o);
                xs8(P, mu, rowb, 1600 + bq + hh * 8, o);
                *(uint4*)(sb + bi * SL + bq + hh * 8) = pack8(o);
            }
        }
        __syncthreads();
        {
            R1_IDX const int rowb = scan_row(b, d, c * 64 + bi); (void)rowb;
            f32x4 acc[4];
            acc_zero(acc);
            mm64<SL, 64>(sa, (const bf16_t*)(p.ws + O_WB + W_WUP) + ((size_t)d * 512 + h * 64) * 64, acc, wave, fr, fq);
            const float* w0 = p.in[I_W0] + (l * 2 + d) * 512 + h * 64;
#pragma unroll
            for (int nt = 0; nt < 4; ++nt) {
                const int n = nt * 16 + fq * 4; float4 o; float* op = (float*)&o;
#pragma unroll
                for (int r = 0; r < 4; ++r) { const float z = w0[n + r] + acc[nt][r]; op[r] = -0.6065306597126334f * __builtin_amdgcn_rcpf(1.f + __expf(-z)); }
                *(float4*)(LWS + m * 68 + n) = o;
            }
            acc_zero(acc);
            mm64<SL, 64>(sb, (const bf16_t*)(p.ws + O_WB + W_AUP) + ((size_t)d * 512 + h * 64) * 64, acc, wave, fr, fq);
            const float* a0 = p.in[I_A0] + (l * 2 + d) * 512 + h * 64;
#pragma unroll
            for (int nt = 0; nt < 4; ++nt) {
                const int n = nt * 16 + fq * 4;
                *(float4*)(ASIG + m * 68 + n) = make_float4(__builtin_amdgcn_rcpf(1.f + __expf(-(a0[n] + acc[nt][0]))), __builtin_amdgcn_rcpf(1.f + __expf(-(a0[n + 1] + acc[nt][1]))), __builtin_amdgcn_rcpf(1.f + __expf(-(a0[n + 2] + acc[nt][2]))), __builtin_amdgcn_rcpf(1.f + __expf(-(a0[n + 3] + acc[nt][3]))));
            }
        }
        __syncthreads();
        {
            R1_IDX const int rowb = scan_row(b, d, c * 64 + bi); (void)rowb;
            const int k = tid & 63, seg = tid >> 6;
            float run = 0.f;
#pragma unroll
            for (int ii = 0; ii < 16; ++ii) { run += LWS[(seg * 16 + ii) * 68 + k]; LWS[(seg * 16 + ii) * 68 + k] = run; }
            SEG[seg * 64 + k] = run;
            __syncthreads();
            float off = 0.f;
#pragma unroll
            for (int sgi = 0; sgi < 3; ++sgi) if (sgi < seg) off += SEG[sgi * 64 + k];
#pragma unroll
            for (int ii = 0; ii < 16; ++ii) LWS[(seg * 16 + ii) * 68 + k] += off;
        }
        __syncthreads();
        {
            R1_IDX const int rowb = scan_row(b, d, c * 64 + bi); (void)rowb;
            float cs[16], cm[16], cc[16], ag[16];
#pragma unroll
            for (int q = 0; q < 4; ++q) {
                const float4 v0 = *(const float4*)(LWS + bi * 68 + bq + q * 4);
                const float4 v1 = bi > 0 ? *(const float4*)(LWS + (bi - 1) * 68 + bq + q * 4) : make_float4(0.f, 0.f, 0.f, 0.f);
                const float4 v2 = *(const float4*)(LWS + 63 * 68 + bq + q * 4);
                const float4 v3 = *(const float4*)(ASIG + bi * 68 + bq + q * 4);
                cs[q * 4] = v0.x; cs[q * 4 + 1] = v0.y; cs[q * 4 + 2] = v0.z; cs[q * 4 + 3] = v0.w;
                cm[q * 4] = v1.x; cm[q * 4 + 1] = v1.y; cm[q * 4 + 2] = v1.z; cm[q * 4 + 3] = v1.w;
                cc[q * 4] = v2.x; cc[q * 4 + 1] = v2.y; cc[q * 4 + 2] = v2.z; cc[q * 4 + 3] = v2.w;
                ag[q * 4] = v3.x; ag[q * 4 + 1] = v3.y; ag[q * 4 + 2] = v3.z; ag[q * 4 + 3] = v3.w;
            }
            __syncthreads();
            const float kkn = KKN[(size_t)rowb * 8 + h];
            float bon = 0.f;
#pragma unroll
            for (int hh = 0; hh < 2; ++hh) {
                float r8[8], k8[8], oa[8], ob[8], ok[8], orr[8];
                const int col = h * 64 + bq + hh * 8;
                xs8(P, mu, rowb, col, r8); xs8(P, mu, rowb, 512 + col, k8);
#pragma unroll
                for (int j = 0; j < 8; ++j) {
                    const int e = hh * 8 + j;
                    const float kk = k8[j] * kkw[col + j] * kkn;
                    const float kd = k8[j] * (1.f + (ag[e] - 1.f) * kaw[col + j]);
                    const float eneg = __expf(-cs[e]);
                    oa[j] = -kk * __expf(cm[e]); ob[j] = kk * ag[e] * eneg; ok[j] = kd * eneg; orr[j] = r8[j] * __builtin_amdgcn_rcpf(eneg);
                    bon += r8[j] * kd * rkw[col + j];
                }
                *(uint4*)(s0 + bi * SL + bq + hh * 8) = pack8(oa); *(uint4*)(s1 + bi * SL + bq + hh * 8) = pack8(ob);
                *(uint4*)(s2 + bi * SL + bq + hh * 8) = pack8(ok); *(uint4*)(s3 + bi * SL + bq + hh * 8) = pack8(orr);
            }
            bon += __shfl_xor(bon, 1); bon += __shfl_xor(bon, 2);
            if ((tid & 3) == 0) BON[((size_t)d * RT + rowb) * 8 + h] = bon;
            if (bi == 0) {
#pragma unroll
                for (int e = 0; e < 16; ++e) GAM[bq + e] = __expf(cc[e]);
            }
        }
        __syncthreads();
        {
            R1_IDX const int rowb = scan_row(b, d, c * 64 + bi); (void)rowb;
            f32x4 acc[4]; acc_zero(acc);
            mm64<SL, SL>(s1, s0, acc, wave, fr, fq);
            acc_mask<true>(acc, m, fq);
            st_rm(sa, acc, m, fq); st_tr(sb, acc, m, fq);
#pragma unroll
            for (int nt = 0; nt < 4; ++nt)
#pragma unroll
                for (int r = 0; r < 4; ++r) if (nt * 16 + fq * 4 + r == m) acc[nt][r] += 1.f;
            st_rm(sc, acc, m, fq);
        }
        __syncthreads();
#pragma unroll
        for (int itr = 0; itr < 5; ++itr) {
            R1_IDX
            bf16_t* ptr = (itr & 1) ? sT : sb;
            bf16_t* ptw = (itr & 1) ? sb : sT;
            f32x4 acc[4]; acc_zero(acc);
            mm64<SL, SL>(sa, ptr, acc, wave, fr, fq);
            st_rm(sa, acc, m, fq); st_tr(ptw, acc, m, fq);
            __syncthreads();
            f32x4 tacc[4];
#pragma unroll
            for (int nt = 0; nt < 4; ++nt) { const uint2 u = *(const uint2*)(sc + m * SL + nt * 16 + fq * 4); tacc[nt] = (f32x4){bflo(u.x), bfhi(u.x), bflo(u.y), bfhi(u.y)}; }
            mm64<SL, SL>(sc, ptw, tacc, wave, fr, fq);
            if (itr < 4) st_rm(sc, tacc, m, fq); else st_tr(sb, tacc, m, fq);
        }
        __syncthreads();
        {
            R1_IDX const int rowb = scan_row(b, d, c * 64 + bi); (void)rowb;
            f32x4 acc[4]; acc_zero(acc);
            mm64<SL, SL>(s2, s0, acc, wave, fr, fq);
            acc_mask<true>(acc, m, fq);
            st_rm(sa, acc, m, fq);
            float f0[8], f1[8];
            unpack8(*(const uint4*)(s0 + bi * SL + bq), f0); unpack8(*(const uint4*)(s0 + bi * SL + bq + 8), f1);
#pragma unroll
            for (int e = 0; e < 8; ++e) { sc[(bq + e) * SL + bi] = f2bf(f0[e]); sc[(bq + 8 + e) * SL + bi] = f2bf(f1[e]); }
        }
        __syncthreads();
        {
            R1_IDX const int rowb = scan_row(b, d, c * 64 + bi); (void)rowb;
            f32x4 acc[4]; acc_zero(acc);
            mm64<SL, SL>(sc, sb, acc, wave, fr, fq);
            st_rm(sT, acc, m, fq);
            acc_zero(acc);
            mm64<SL, SL>(sa, sb, acc, wave, fr, fq);
            st_rm(s0, acc, m, fq);
        }
        __syncthreads();
        f32x4 qacc[4];
        {
            R1_IDX const int rowb = scan_row(b, d, c * 64 + bi); (void)rowb;
            f32x4 acc[4]; acc_zero(acc);
            mm64<SL, SL>(s1, s3, acc, wave, fr, fq);
            acc_mask<false>(acc, m, fq);
            st_tr(sa, acc, m, fq);
            acc_zero(qacc);
            mm64<SL, SL>(s2, s3, qacc, wave, fr, fq);
            acc_mask<false>(qacc, m, fq);
            float f0[8], f1[8];
            unpack8(*(const uint4*)(s3 + bi * SL + bq), f0); unpack8(*(const uint4*)(s3 + bi * SL + bq + 8), f1);
#pragma unroll
            for (int e = 0; e < 8; ++e) { sc[(bq + e) * SL + bi] = f2bf(f0[e]); sc[(bq + 8 + e) * SL + bi] = f2bf(f1[e]); }
        }
        __syncthreads();
        {
            R1_IDX const int rowb = scan_row(b, d, c * 64 + bi); (void)rowb;
            f32x4 acc[4];
#pragma unroll
            for (int nt = 0; nt < 4; ++nt) { const uint2 u = *(const uint2*)(sc + m * SL + nt * 16 + fq * 4); acc[nt] = (f32x4){bflo(u.x), bfhi(u.x), bflo(u.y), bfhi(u.y)}; }
            mm64<SL, SL>(sT, sa, acc, wave, fr, fq);
            bf16_t* gt = gGT + (size_t)it * 4096;
#pragma unroll
            for (int nt = 0; nt < 4; ++nt)
#pragma unroll
                for (int r = 0; r < 4; ++r) gt[(nt * 16 + fq * 4 + r) * 64 + m] = f2bf(acc[nt][r]);
            mm64<SL, SL>(s0, sa, qacc, wave, fr, fq);
            st_tr(sb, qacc, m, fq);
            float f0[8], f1[8];
            unpack8(*(const uint4*)(s1 + bi * SL + bq), f0); unpack8(*(const uint4*)(s1 + bi * SL + bq + 8), f1);
#pragma unroll
            for (int e = 0; e < 8; ++e) { s3[(bq + e) * SL + bi] = f2bf(f0[e] * GAM[bq + e]); s3[(bq + 8 + e) * SL + bi] = f2bf(f1[e] * GAM[bq + 8 + e]); }
        }
        __syncthreads();
        {
            R1_IDX const int rowb = scan_row(b, d, c * 64 + bi); (void)rowb;
            f32x4 acc[4]; acc_zero(acc);
            mm64<SL, SL>(sT, s3, acc, wave, fr, fq);
            bf16_t* mt = gMT + (size_t)it * 4096;
#pragma unroll
            for (int nt = 0; nt < 4; ++nt)
#pragma unroll
                for (int r = 0; r < 4; ++r) { const int n = nt * 16 + fq * 4 + r; mt[n * 64 + m] = f2bf(acc[nt][r] + (n == m ? GAM[m] : 0.f)); }
#pragma unroll
            for (int nt = 0; nt < 4; ++nt) {
                const int n = nt * 16 + fq * 4; const uint2 u = *(const uint2*)(s2 + m * SL + n);
                acc[nt] = (f32x4){bflo(u.x) * GAM[n], bfhi(u.x) * GAM[n + 1], bflo(u.y) * GAM[n + 2], bfhi(u.y) * GAM[n + 3]};
            }
            mm64<SL, SL>(s0, s3, acc, wave, fr, fq);
            st_tr(s1, acc, m, fq);
            float v8[8];
#pragma unroll
            for (int hh = 0; hh < 2; ++hh) {
                xs8(P, mu, rowb, 1024 + h * 64 + bq + hh * 8, v8);
#pragma unroll
                for (int e = 0; e < 8; ++e) sc[(bq + hh * 8 + e) * SL + bi] = f2bf(v8[e]);
            }
        }
        __syncthreads();
        {
            R1_IDX const int rowb = scan_row(b, d, c * 64 + bi); (void)rowb;
            f32x4 acc[4]; acc_zero(acc);
            mm64<SL, SL>(sc, sb, acc, wave, fr, fq);
            bf16_t* yl = gYL + (size_t)it * 4096;
#pragma unroll
            for (int nt = 0; nt < 4; ++nt) store_bf16x4(yl + m * 64 + nt * 16 + fq * 4, acc[nt]);
            acc_zero(acc);
            mm64<SL, SL>(sc, s1, acc, wave, fr, fq);
            bf16_t* nl = gNL + (size_t)it * 4096;
#pragma unroll
            for (int nt = 0; nt < 4; ++nt) store_bf16x4(nl + m * 64 + nt * 16 + fq * 4, acc[nt]);
        }
        __syncthreads();
    }
}
__device__ __forceinline__ void ph_r2(const Params& p, char* smem) {
    const int tid = tidx(), lane = tid & 63, wave = tid >> 6, fr = lane & 15, fq = lane >> 4;
    const char* gMT = (const char*)(p.ws + O_X + X_MT); const char* gNL = (const char*)(p.ws + O_H);
    uint4* gS0 = (uint4*)(p.ws + O_X + X_S0);
    const int wofs = __builtin_amdgcn_readfirstlane(wave) * 1024;
    const unsigned lds0 = (unsigned)(uintptr_t)smem;
    const unsigned mtaddr = lds0 + fr * 128 + fq * 8, nladdr = lds0 + (wave * 16 + fr) * 128 + fq * 8;
    auto issue = [&](size_t cp, int slot) {
        char* dst = smem + slot * 16384 + wofs;
        const char* s0 = gMT + cp * 8192 + wofs + lane * 16; const char* s1 = gNL + cp * 8192 + wofs + lane * 16;
        __builtin_amdgcn_global_load_lds((const unsigned*)s0, (unsigned*)dst, 16, 0, 0);
        __builtin_amdgcn_global_load_lds((const unsigned*)(s0 + 4096), (unsigned*)(dst + 4096), 16, 0, 0);
        __builtin_amdgcn_global_load_lds((const unsigned*)s1, (unsigned*)(dst + 8192), 16, 0, 0);
        __builtin_amdgcn_global_load_lds((const unsigned*)(s1 + 4096), (unsigned*)(dst + 12288), 16, 0, 0);
    };
#define R2_READ(MX, NV, SLOT) do { \
        asm volatile("ds_read_b64 %0, %1 offset:0" : "=v"(MX[0][0][0]) : "v"(mtaddr + (SLOT) * 16384)); \
        asm volatile("ds_read_b64 %0, %1 offset:32" : "=v"(MX[0][0][1]) : "v"(mtaddr + (SLOT) * 16384)); \
        asm volatile("ds_read_b64 %0, %1 offset:64" : "=v"(MX[0][1][0]) : "v"(mtaddr + (SLOT) * 16384)); \
        asm volatile("ds_read_b64 %0, %1 offset:96" : "=v"(MX[0][1][1]) : "v"(mtaddr + (SLOT) * 16384)); \
        asm volatile("ds_read_b64 %0, %1 offset:8192" : "=v"(NV[0]) : "v"(nladdr + (SLOT) * 16384)); \
        asm volatile("ds_read_b64 %0, %1 offset:2048" : "=v"(MX[1][0][0]) : "v"(mtaddr + (SLOT) * 16384)); \
        asm volatile("ds_read_b64 %0, %1 offset:2080" : "=v"(MX[1][0][1]) : "v"(mtaddr + (SLOT) * 16384)); \
        asm volatile("ds_read_b64 %0, %1 offset:2112" : "=v"(MX[1][1][0]) : "v"(mtaddr + (SLOT) * 16384)); \
        asm volatile("ds_read_b64 %0, %1 offset:2144" : "=v"(MX[1][1][1]) : "v"(mtaddr + (SLOT) * 16384)); \
        asm volatile("ds_read_b64 %0, %1 offset:8224" : "=v"(NV[1]) : "v"(nladdr + (SLOT) * 16384)); \
        asm volatile("ds_read_b64 %0, %1 offset:4096" : "=v"(MX[2][0][0]) : "v"(mtaddr + (SLOT) * 16384)); \
        asm volatile("ds_read_b64 %0, %1 offset:4128" : "=v"(MX[2][0][1]) : "v"(mtaddr + (SLOT) * 16384)); \
        asm volatile("ds_read_b64 %0, %1 offset:4160" : "=v"(MX[2][1][0]) : "v"(mtaddr + (SLOT) * 16384)); \
        asm volatile("ds_read_b64 %0, %1 offset:4192" : "=v"(MX[2][1][1]) : "v"(mtaddr + (SLOT) * 16384)); \
        asm volatile("ds_read_b64 %0, %1 offset:8256" : "=v"(NV[2]) : "v"(nladdr + (SLOT) * 16384)); \
        asm volatile("ds_read_b64 %0, %1 offset:6144" : "=v"(MX[3][0][0]) : "v"(mtaddr + (SLOT) * 16384)); \
        asm volatile("ds_read_b64 %0, %1 offset:6176" : "=v"(MX[3][0][1]) : "v"(mtaddr + (SLOT) * 16384)); \
        asm volatile("ds_read_b64 %0, %1 offset:6208" : "=v"(MX[3][1][0]) : "v"(mtaddr + (SLOT) * 16384)); \
        asm volatile("ds_read_b64 %0, %1 offset:6240" : "=v"(MX[3][1][1]) : "v"(mtaddr + (SLOT) * 16384)); \
        asm volatile("ds_read_b64 %0, %1 offset:8288" : "=v"(NV[3]) : "v"(nladdr + (SLOT) * 16384)); \
        } while (0)
#define R2_PIN(MX, NV) asm volatile("" : "+v"(MX[0][0][0]), "+v"(MX[0][0][1]), "+v"(MX[0][1][0]), "+v"(MX[0][1][1]), "+v"(NV[0]), "+v"(MX[1][0][0]), "+v"(MX[1][0][1]), "+v"(MX[1][1][0]), "+v"(MX[1][1][1]), "+v"(NV[1]), "+v"(MX[2][0][0]), "+v"(MX[2][0][1]), "+v"(MX[2][1][0]), "+v"(MX[2][1][1]), "+v"(NV[2]), "+v"(MX[3][0][0]), "+v"(MX[3][0][1]), "+v"(MX[3][1][0]), "+v"(MX[3][1][1]), "+v"(NV[3]) :: "memory")
#define R2_STEP(MX, NV, MXN, NVN, J) do { const int c = c4 + (J); \
        asm volatile("s_waitcnt lgkmcnt(0)" ::: "memory");            \
        R2_PIN(MX, NV);                                                \
        asm volatile("s_waitcnt vmcnt(8)" ::: "memory");              \
        __builtin_amdgcn_s_barrier(); \
        asm volatile("" ::: "memory"); \
        R2_READ(MXN, NVN, ((J) + 1) & 3); \
        __builtin_amdgcn_sched_barrier(0); \
        u32x4 sb_[2]; \
        _Pragma("unroll") for (int s_ = 0; s_ < 2; ++s_) sb_[s_] = (u32x4){pack2(st[2 * s_][0], st[2 * s_][1]), pack2(st[2 * s_][2], st[2 * s_][3]), pack2(st[2 * s_ + 1][0], st[2 * s_ + 1][1]), pack2(st[2 * s_ + 1][2], st[2 * s_ + 1][3])}; \
        _Pragma("unroll") for (int tt = 0; tt < 4; ++tt) { \
            f32x4 acc_ = {bflo(NV[tt].x), bfhi(NV[tt].x), bflo(NV[tt].y), bfhi(NV[tt].y)}; \
            _Pragma("unroll") for (int s_ = 0; s_ < 2; ++s_) \
                acc_ = __builtin_amdgcn_mfma_f32_16x16x32_bf16(__builtin_bit_cast(bf16x8, (u32x4){MX[tt][s_][0].x, MX[tt][s_][0].y, MX[tt][s_][1].x, MX[tt][s_][1].y}), __builtin_bit_cast(bf16x8, sb_[s_]), acc_, 0, 0, 0); \
            st[tt] = acc_; } \
        *(u32x4*)(gS0 + ((cp0 + c) * 4 + wave) * 128 + lane) = sb_[0]; *(u32x4*)(gS0 + ((cp0 + c) * 4 + wave) * 128 + 64 + lane) = sb_[1]; \
        issue(cp0 + (c + 4 < 68 ? c + 4 : 67), (J)); } while (0)
    for (int it = blockIdx.x; it < 64; it += gridDim.x) {
        f32x4 st[4];
#pragma unroll
        for (int tt = 0; tt < 4; ++tt) st[tt] = (f32x4){0.f, 0.f, 0.f, 0.f};
        const size_t cp0 = (size_t)it * 68;
        issue(cp0, 0); issue(cp0 + 1, 1); issue(cp0 + 2, 2); issue(cp0 + 3, 3);
        uint2 mxA[4][2][2], nvA[4], mxB[4][2][2], nvB[4];
        asm volatile("s_waitcnt vmcnt(12)" ::: "memory");
        __builtin_amdgcn_s_barrier();
        asm volatile("" ::: "memory");
        R2_READ(mxA, nvA, 0);
        asm volatile("s_waitcnt lgkmcnt(0)" ::: "memory");
        R2_PIN(mxA, nvA);
        for (int c4 = 0; c4 < 68; c4 += 4) {
            R2_STEP(mxA, nvA, mxB, nvB, 0);
            R2_STEP(mxB, nvB, mxA, nvA, 1);
            R2_STEP(mxA, nvA, mxB, nvB, 2);
            R2_STEP(mxB, nvB, mxA, nvA, 3);
            asm volatile("s_waitcnt lgkmcnt(0)" ::: "memory");
            R2_PIN(mxA, nvA);
        }
        asm volatile("s_waitcnt vmcnt(0) lgkmcnt(0)" ::: "memory");
        __builtin_amdgcn_sched_barrier(0);
        __syncthreads();
    }
#undef R2_READ
#undef R2_PIN
#undef R2_STEP
}
__device__ __forceinline__ void ph_r3(const Params& p) {
    const int tid = tidx(), lane = tid & 63, wave = tid >> 6, fr = lane & 15, fq = lane >> 4;
    const bf16_t* gGT = (const bf16_t*)(p.ws + O_X + X_GT); const bf16_t* gYL = (const bf16_t*)(p.ws + O_X + X_YL);
    const u32x4* gS0 = (const u32x4*)(p.ws + O_X + X_S0);
    bf16_t* YS = (bf16_t*)(p.ws + O_H);
    for (int it = blockIdx.x * 4 + wave; it < NCP; it += gridDim.x * 4) {
        const int c = it % 68, d = (it / 68) & 1, h = (it / 136) & 7, b = it / 1088;
        const bf16_t* gt = gGT + (size_t)it * 4096; const bf16_t* yl = gYL + (size_t)it * 4096;
        u32x4 gf[4][2];
#pragma unroll
        for (int tt = 0; tt < 4; ++tt)
#pragma unroll
            for (int s_ = 0; s_ < 2; ++s_) {
                const bf16_t* q = gt + (tt * 16 + fr) * 64 + s_ * 32 + fq * 4;
                const uint2 a0 = *(const uint2*)q, a1 = *(const uint2*)(q + 16);
                gf[tt][s_] = (u32x4){a0.x, a0.y, a1.x, a1.y};
            }
#pragma unroll
        for (int vg = 0; vg < 4; ++vg) {
            const u32x4 sb0 = gS0[((size_t)it * 4 + vg) * 128 + lane], sb1 = gS0[((size_t)it * 4 + vg) * 128 + 64 + lane];
#pragma unroll
            for (int tt = 0; tt < 4; ++tt) {
                const uint2 yv = *(const uint2*)(yl + (vg * 16 + fr) * 64 + tt * 16 + fq * 4);
                f32x4 acc = {bflo(yv.x), bfhi(yv.x), bflo(yv.y), bfhi(yv.y)};
                acc = __builtin_amdgcn_mfma_f32_16x16x32_bf16(__builtin_bit_cast(bf16x8, gf[tt][0]), __builtin_bit_cast(bf16x8, sb0), acc, 0, 0, 0);
                acc = __builtin_amdgcn_mfma_f32_16x16x32_bf16(__builtin_bit_cast(bf16x8, gf[tt][1]), __builtin_bit_cast(bf16x8, sb1), acc, 0, 0, 0);
#pragma unroll
                for (int r = 0; r < 4; ++r) {
                    const int row = scan_row(b, d, c * 64 + tt * 16 + fq * 4 + r);
                    YS[((size_t)d * RT + row) * 512 + h * 64 + vg * 16 + fr] = f2bf(acc[r]);
                }
            }
        }
    }
}

__device__ __forceinline__ void ph_rpost(const Params& p, int l) {
    const int lane = tidx() & 63, wave = tidx() >> 6;
    const bf16_t* P = (const bf16_t*)(p.ws + O_P); const float* mu = p.in[I_MU] + l * 1792;
    const float* gng = p.in[I_GNG] + l * 512; const float* gnb = p.in[I_GNB] + l * 512;
    const float* BON = (const float*)(p.ws + O_X + X_BON); const bf16_t* YS = (const bf16_t*)(p.ws + O_H);
    const bf16_t* RG = (const bf16_t*)(p.ws + O_RG); bf16_t* RWO = (bf16_t*)(p.ws + O_RWO);
    for (int row = blockIdx.x * 4 + wave; row < RT; row += gridDim.x * 4) {
        const int col = lane * 8, h = lane >> 3;
        float v8[8], g8[8], y0[8], y1[8];
        xs8(P, mu, row, 1024 + col, v8);
        unpack8(*(const uint4*)(RG + (size_t)row * 512 + col), g8);
        unpack8(*(const uint4*)(YS + ((size_t)0 * RT + row) * 512 + col), y0);
        unpack8(*(const uint4*)(YS + ((size_t)1 * RT + row) * 512 + col), y1);
        const float bs = BON[((size_t)0 * RT + row) * 8 + h] + BON[((size_t)1 * RT + row) * 8 + h];
        float y[8]; float sm = 0.f;
#pragma unroll
        for (int j = 0; j < 8; ++j) { y[j] = y0[j] + y1[j]; sm += y[j]; }
        sm += __shfl_xor(sm, 1); sm += __shfl_xor(sm, 2); sm += __shfl_xor(sm, 4);
        const float mean = sm * (1.f / 64.f);
        float vs = 0.f;
#pragma unroll
        for (int j = 0; j < 8; ++j) { const float dlt = y[j] - mean; vs += dlt * dlt; }
        vs += __shfl_xor(vs, 1); vs += __shfl_xor(vs, 2); vs += __shfl_xor(vs, 4);
        const float rstd = rsqrtf(vs * (1.f / 64.f) + 64e-5f);
        float o[8];
#pragma unroll
        for (int j = 0; j < 8; ++j) o[j] = ((y[j] - mean) * rstd * gng[col + j] + gnb[col + j] + bs * v8[j]) * g8[j];
        *(uint4*)(RWO + (size_t)row * 512 + col) = pack8(o);
    }
}

__device__ __forceinline__ void ph_f1(const Params& p, int l, char* smem) {
    const bf16_t* P = (const bf16_t*)(p.ws + O_P); const bf16_t* CSC = (const bf16_t*)(p.ws + O_CSC);
    bf16_t* YT2 = (bf16_t*)(p.ws + O_YT2); bf16_t* YTC = (bf16_t*)(p.ws + O_YTC);
    const int nitems = 1024 + (l < NLAYER - 1 ? 64 : 0);
    for (int it = blockIdx.x; it < nitems; it += gridDim.x) {
        f32x4 acc[4][4];
        if (it < 1024) {
            const int b = it >> 8, g = (it >> 6) & 3, part = (it >> 5) & 1, j = it & 31;
            RPPlain rpa{CSC + (size_t)part * 128 * 128, 128};
            const bf16_t* pb = P + (size_t)b * SEQ * LDP + g * 128;
            auto rpb = [&](int r) -> const bf16_t* { return pb + (size_t)(64 * (r & 63) + 2 * j + (r >> 6)) * LDP; };
            gemm_core_gb<4>(rpa, rpb, 128, acc, smem);
            acc_foreach<4>(acc, [&](int m, int n, const f32x4& v) {
                const int t1 = n & 63, t2 = 2 * j + (n >> 6);
                store_bf16x4(YT2 + ((size_t)(b * 512 + g * 128 + m) * 64 + t2) * 128 + part * 64 + t1, v);
            });
        } else {
            const int jj = it - 1024, b = jj >> 4, g = (jj >> 2) & 3, part = (jj >> 1) & 1, nt = jj & 1;
            RPPlain rpa{CSC + (size_t)part * 128 * 128, 128};
            gemm_core_g<4>(rpa, P + (size_t)(RL + b * CTX + nt * 128) * LDP + g * 128, LDP, 128, acc, smem);
            acc_foreach<4>(acc, [&](int m, int n, const f32x4& v) {
                store_bf16x4(YTC + ((size_t)(b * 512 + g * 128 + m)) * 512 + part * 256 + nt * 128 + n, v);
            });
        }
    }
}
__device__ __forceinline__ void ph_fa(const Params& p, char* smem) {
    const bf16_t* YT2 = (const bf16_t*)(p.ws + O_YT2); const bf16_t* D128 = (const bf16_t*)(p.ws + O_D128);
    const float* TWC = (const float*)(p.ws + O_TWC); const float* TWS = (const float*)(p.ws + O_TWS);
    bf16_t* A2 = (bf16_t*)(p.ws + O_A2);
    for (int it = blockIdx.x; it < 1024; it += gridDim.x) {
        f32x4 acc[4][4];
        RPPlain rpa{D128, 128};
        gemm_core_g<4>(rpa, YT2 + (size_t)it * 128 * 128, 128, 128, acc, smem);
        const int lane = tidx() & 63, wave = tidx() >> 6, wr = wave >> 1, wc = wave & 1, fr = lane & 15, fq = lane >> 4;
        float* U = (float*)smem;
        if (wr == 1) {
#pragma unroll
            for (int i = 0; i < 4; ++i)
#pragma unroll
                for (int j = 0; j < 4; ++j) *(f32x4*)(U + (i * 16 + fr) * 132 + wc * 64 + j * 16 + fq * 4) = acc[i][j];
        }
        __syncthreads();
        if (wr == 0) {
#pragma unroll
            for (int i = 0; i < 4; ++i) {
                const int k1 = i * 16 + fr;
#pragma unroll
                for (int j = 0; j < 4; ++j) {
                    const int r = wc * 64 + j * 16 + fq * 4;
                    const int R = it * 128 + r, bn = R >> 6, t2 = R & 63, b = bn >> 9, n = bn & 511;
                    const f32x4 ai = *(const f32x4*)(U + k1 * 132 + r);
                    const f32x4 c = *(const f32x4*)(TWC + k1 * 64 + t2), sn = *(const f32x4*)(TWS + k1 * 64 + t2);
                    const f32x4 ar = acc[i][j];
                    const f32x4 pr = ar * c - ai * sn, pi = ar * sn + ai * c;
                    bf16_t* dst = A2 + ((size_t)(b * 64 + k1) * 512 + n) * 128 + t2;
                    store_bf16x4(dst, pr); store_bf16x4(dst + 64, pi);
                }
            }
        }
        __syncthreads();
    }
}
__device__ __forceinline__ void ph_fb(const Params& p, int l, char* smem) {
    const bf16_t* A2 = (const bf16_t*)(p.ws + O_A2); const bf16_t* E64 = (const bf16_t*)(p.ws + O_E64);
    const bf16_t* CST2 = (const bf16_t*)(p.ws + O_CST256); const bf16_t* YTC = (const bf16_t*)(p.ws + O_YTC);
    bf16_t* FA = (bf16_t*)(p.ws + O_FA);
    const int nitems = 1024 + (l < NLAYER - 1 ? 32 : 0);
    for (int it = blockIdx.x; it < nitems; it += gridDim.x) {
        if (it < 1024) {
            const int b = it >> 8, k1 = (it >> 2) & 63, nt = it & 3;
            f32x4 acc[2][4];
            RPPlain rpa{E64, 128};
            gemm_core_g<2>(rpa, A2 + ((size_t)(b * 64 + k1) * 512 + nt * 128) * 128, 128, 128, acc, smem);
            const float sc = 0.001381067932004975f;
            acc_foreach<2>(acc, [&](int m, int n, const f32x4& v) { f32x4 o = v * sc; store_bf16x4(FA + (size_t)(b * SEQ + k1 + 64 * m) * 512 + nt * 128 + n, o); });
        } else {
            const int j = it - 1024, b = j >> 3, mt = (j >> 2) & 1, nt = j & 3;
            f32x4 acc[4][4];
            RPPlain rp{CST2 + (size_t)mt * 128 * 512, 512};
            gemm_core_g<4>(rp, YTC + ((size_t)b * 512 + nt * 128) * 512, 512, 512, acc, smem);
            const float sc = 0.005524271728019903f;
            acc_foreach<4>(acc, [&](int m, int n, const f32x4& v) { f32x4 o = v * sc; store_bf16x4(FA + (size_t)(RL + b * CTX + mt * 128 + m) * 512 + nt * 128 + n, o); });
        }
    }
}

__device__ __forceinline__ void ph_mg(const Params& p, int l, char* smem) {
    const bf16_t* P = (const bf16_t*)(p.ws + O_P);
    const bf16_t* A0 = (const bf16_t*)(p.ws + O_FA); const bf16_t* A1 = (const bf16_t*)(p.ws + O_ATT); const bf16_t* A2 = (const bf16_t*)(p.ws + O_RWO);
    const bf16_t* W0 = (const bf16_t*)(p.ws + O_WB + W_PA); const bf16_t* W1 = (const bf16_t*)(p.ws + O_WB + W_PB); const bf16_t* W2 = (const bf16_t*)(p.ws + O_WB + W_PC);
    bf16_t* MG = (bf16_t*)(p.ws + O_H);
    const int nmt = (l < NLAYER - 1) ? RT / 128 : RL / 128;
    for (int it = blockIdx.x; it < nmt * 8; it += gridDim.x) {
        const int mt = it >> 3, nt = it & 7;
        f32x4 tot[4][4];
#pragma unroll
        for (int i = 0; i < 4; ++i)
#pragma unroll
            for (int j = 0; j < 4; ++j) tot[i][j] = (f32x4){0.f, 0.f, 0.f, 0.f};
#pragma unroll 1
        for (int br = 0; br < 3; ++br) {
            const bf16_t* Ab = br == 0 ? A0 : (br == 1 ? A1 : A2);
            const bf16_t* Wb = br == 0 ? W0 : (br == 1 ? W1 : W2);
            f32x4 acc[4][4];
            RPPlain rp{Ab + (size_t)mt * 128 * 512, 512};
            gemm_core_g<4>(rp, Wb + (size_t)nt * 128 * 512, 512, 512, acc, smem);
            const int lane = tidx() & 63, wave = tidx() >> 6, wr = wave >> 1, wc = wave & 1, fr = lane & 15, fq = lane >> 4;
#pragma unroll
            for (int i = 0; i < 4; ++i)
#pragma unroll
                for (int j = 0; j < 4; ++j) {
                    const int m = wr * 64 + i * 16 + fr, n = wc * 64 + j * 16 + fq * 4;
                    const uint2 gu = *(const uint2*)(P + (size_t)(mt * 128 + m) * LDP + PG0 + br * 1024 + nt * 128 + n);
                    tot[i][j][0] += bflo(gu.x) * acc[i][j][0]; tot[i][j][1] += bfhi(gu.x) * acc[i][j][1];
                    tot[i][j][2] += bflo(gu.y) * acc[i][j][2]; tot[i][j][3] += bfhi(gu.y) * acc[i][j][3];
                }
        }
        acc_foreach<4>(tot, [&](int m, int n, const f32x4& v) { store_bf16x4(MG + (size_t)(mt * 128 + m) * 1024 + nt * 128 + n, v); });
    }
}
__device__ __forceinline__ void ph_out(const Params& p, int l, char* smem) {
    const bf16_t* MG = (const bf16_t*)(p.ws + O_H); const bf16_t* W = (const bf16_t*)(p.ws + O_WB + W_OUT);
    float* xcur = (float*)(p.ws + O_XCUR); const float* mod = (const float*)(p.ws + O_MOD);
    const int nlat = 1024, nctx = (l < NLAYER - 1) ? (RC / 64) * 8 : 0;
    for (int it = blockIdx.x; it < nlat + nctx; it += gridDim.x) {
        if (it < nlat) {
            const int mt = it >> 3, nt = it & 7;
            f32x4 acc[4][4];
            RPPlain rp{MG + (size_t)mt * 128 * 1024, 1024};
            gemm_core_g<4>(rp, W + (size_t)nt * 128 * 1024, 1024, 1024, acc, smem);
            acc_foreach<4>(acc, [&](int m, int n, const f32x4& v) {
                const int row = mt * 128 + m, col = nt * 128 + n;
                const float4 g = *(const float4*)(mod + (size_t)(l * 5 + modidx(row)) * 6144 + 2048 + col);
                float4* xp = (float4*)(xcur + (size_t)row * 1024 + col);
                float4 x = *xp; x.x += g.x * v[0]; x.y += g.y * v[1]; x.z += g.z * v[2]; x.w += g.w * v[3]; *xp = x;
            });
        } else {
            const int j = it - nlat, mt = j >> 3, nt = j & 7;
            f32x4 acc[2][4];
            RPPlain rp{MG + (size_t)(RL + mt * 64) * 1024, 1024};
            gemm_core_g<2>(rp, W + (size_t)nt * 128 * 1024, 1024, 1024, acc, smem);
            acc_foreach<2>(acc, [&](int m, int n, const f32x4& v) {
                const int row = RL + mt * 64 + m, col = nt * 128 + n;
                const float4 g = *(const float4*)(mod + (size_t)(l * 5 + 4) * 6144 + 2048 + col);
                float4* xp = (float4*)(xcur + (size_t)row * 1024 + col);
                float4 x = *xp; x.x += g.x * v[0]; x.y += g.y * v[1]; x.z += g.z * v[2]; x.w += g.w * v[3]; *xp = x;
            });
        }
    }
}

__device__ __forceinline__ void ph_n2(const Params& p, int l, char* smem) {
    const int tid = tidx(), lane = tid & 63, wave = tid >> 6;
    unsigned* lcnt = (unsigned*)smem;
    unsigned* gbase = lcnt + 16;
    int* rec = (int*)(smem + 256);
    float4* rwl = (float4*)(smem + 8192);
    for (int idx = tid; idx < 4096; idx += 256) {
        const int k = idx >> 2, pp = idx & 3;
        rwl[(((k >> 8) * 16 + (k & 3) * 4 + pp) << 6) + ((k & 255) >> 2)] = *(const float4*)(p.in[I_RW] + (size_t)k * 16 + pp * 4);
    }
    if (tid < 16) lcnt[tid] = 0u;
    __syncthreads();
    int nrec = 0;
    const float* xcur = (const float*)(p.ws + O_XCUR); const float* mod = (const float*)(p.ws + O_MOD);
    bf16_t* H = (bf16_t*)(p.ws + O_H);
    unsigned* cnt = (unsigned*)(p.ws + O_CNT); int* LTOK = (int*)(p.ws + O_LTOK); float* LW = (float*)(p.ws + O_LW); int* SLOT = (int*)(p.ws + O_SLOT);
    const float* g = p.in[I_N2G] + l * 1024; const float* rw = p.in[I_RW]; const float* rb = p.in[I_RB];
    const int nrows = (l < NLAYER - 1) ? RT : RL;
    float4 vn[4];
    {
        const int r0 = blockIdx.x * 4 + wave;
        const float* x0 = xcur + (size_t)(r0 < nrows ? r0 : 0) * 1024;
#pragma unroll
        for (int i = 0; i < 4; ++i) vn[i] = *(const float4*)(x0 + lane * 4 + 256 * i);
    }
    for (int row = blockIdx.x * 4 + wave; row < nrows; row += gridDim.x * 4) {
        const float* md = mod + (size_t)(l * 5 + modidx(row)) * 6144;
        float4 v[4]; float ss = 0.f;
#pragma unroll
        for (int i = 0; i < 4; ++i) { v[i] = vn[i]; ss += v[i].x * v[i].x + v[i].y * v[i].y + v[i].z * v[i].z + v[i].w * v[i].w; }
        {
            const int rn = row + gridDim.x * 4;
            const float* xn = xcur + (size_t)(rn < nrows ? rn : row) * 1024;
#pragma unroll
            for (int i = 0; i < 4; ++i) vn[i] = *(const float4*)(xn + lane * 4 + 256 * i);
        }
        ss = wsum(ss);
        const float rstd = rsqrtf(ss * (1.f / 1024.f) + 1e-6f);
        float lg[16];
#pragma unroll
        for (int e = 0; e < 16; ++e) lg[e] = 0.f;
#pragma unroll
        for (int i = 0; i < 4; ++i) {
            const int c = lane * 4 + 256 * i;
            const float4 gg = *(const float4*)(g + c), sc = *(const float4*)(md + 4096 + c), sh = *(const float4*)(md + 3072 + c);
            const float hv[4] = {v[i].x * rstd * gg.x * (1.f + sc.x) + sh.x, v[i].y * rstd * gg.y * (1.f + sc.y) + sh.y,
                                 v[i].z * rstd * gg.z * (1.f + sc.z) + sh.z, v[i].w * rstd * gg.w * (1.f + sc.w) + sh.w};
            f32x4 h4 = {hv[0], hv[1], hv[2], hv[3]};
            store_bf16x4(H + (size_t)row * 1024 + c, h4);
#pragma unroll
            for (int j = 0; j < 4; ++j) {
                const float4* wr_ = rwl + ((i * 16 + j * 4) << 6) + lane;
                const float4 w0 = wr_[0], w1 = wr_[64], w2 = wr_[128], w3 = wr_[192];
                lg[0] += hv[j] * w0.x; lg[1] += hv[j] * w0.y; lg[2] += hv[j] * w0.z; lg[3] += hv[j] * w0.w;
                lg[4] += hv[j] * w1.x; lg[5] += hv[j] * w1.y; lg[6] += hv[j] * w1.z; lg[7] += hv[j] * w1.w;
                lg[8] += hv[j] * w2.x; lg[9] += hv[j] * w2.y; lg[10] += hv[j] * w2.z; lg[11] += hv[j] * w2.w;
                lg[12] += hv[j] * w3.x; lg[13] += hv[j] * w3.y; lg[14] += hv[j] * w3.z; lg[15] += hv[j] * w3.w;
            }
        }
        float sc_[16], sel[16];
#pragma unroll
        for (int e = 0; e < 16; ++e) { lg[e] = wsum(lg[e]); sc_[e] = 1.f / (1.f + expf(-lg[e])); sel[e] = sc_[e] + rb[e]; }
        int best = 0; float bestv = -1e30f;
#pragma unroll
        for (int gi = 0; gi < 4; ++gi) {
            float m1 = -1e30f, m2 = -1e30f;
#pragma unroll
            for (int j = 0; j < 4; ++j) { const float s = sel[gi * 4 + j]; if (s > m1) { m2 = m1; m1 = s; } else if (s > m2) m2 = s; }
            const float gs = m1 + m2;
            if (gs > bestv) { bestv = gs; best = gi; }
        }
        float s4[4] = {0.f, 0.f, 0.f, 0.f}, c4[4] = {0.f, 0.f, 0.f, 0.f};
#pragma unroll
        for (int gi = 0; gi < 4; ++gi)
#pragma unroll
            for (int j = 0; j < 4; ++j) if (gi == best) { s4[j] = sel[gi * 4 + j]; c4[j] = sc_[gi * 4 + j]; }
        int i1 = 0; float v1 = s4[0], w1 = c4[0];
#pragma unroll
        for (int j = 1; j < 4; ++j) if (s4[j] > v1) { v1 = s4[j]; i1 = j; w1 = c4[j]; }
        int i2 = -1; float v2 = -1e30f, w2 = 0.f;
#pragma unroll
        for (int j = 0; j < 4; ++j) if (j != i1 && s4[j] > v2) { v2 = s4[j]; i2 = j; w2 = c4[j]; }
        if (lane == 0) {
            const float inv = 1.f / (w1 + w2);
            const int e1 = best * 4 + i1, e2 = best * 4 + i2;
            const unsigned r1 = atomicAdd(&lcnt[e1], 1u), r2 = atomicAdd(&lcnt[e2], 1u);
            int* rc = rec + (wave * 32 + nrec) * 8;
            rc[0] = row; rc[1] = e1; rc[2] = e2; rc[3] = (int)r1; rc[4] = (int)r2; rc[5] = __float_as_int(w1 * inv); rc[6] = __float_as_int(w2 * inv);
        }
        ++nrec;
    }
    __syncthreads();
    if (tid < 16) gbase[tid] = lcnt[tid] ? atomicAdd(&cnt[tid], lcnt[tid]) : 0u;
    __syncthreads();
    for (int i = lane; i < nrec; i += 64) {
        const int* rc = rec + (wave * 32 + i) * 8;
        const int row = rc[0], e1 = rc[1], e2 = rc[2];
        const unsigned p1 = gbase[e1] + (unsigned)rc[3], p2 = gbase[e2] + (unsigned)rc[4];
        LTOK[(size_t)e1 * RT + p1] = row; LW[(size_t)e1 * RT + p1] = __int_as_float(rc[5]);
        LTOK[(size_t)e2 * RT + p2] = row; LW[(size_t)e2 * RT + p2] = __int_as_float(rc[6]);
        SLOT[row * 2] = (e1 << 20) | (int)p1; SLOT[row * 2 + 1] = (e2 << 20) | (int)p2;
    }
}

struct MoeTiles { int tb[17]; int sm; };
__device__ __forceinline__ void moe_tiles(const Params& p, int l, int* s_tb) {
    if (tidx() == 0) {
        const unsigned* cnt = (const unsigned*)(p.ws + O_CNT);
        int a = 0;
        for (int e = 0; e < 16; ++e) { s_tb[e] = a; a += ((int)cnt[e] + 127) >> 7; }
        s_tb[16] = a;
    }
    __syncthreads();
}
__device__ __forceinline__ void ph_e1(const Params& p, int l, char* smem) {
    int* s_tb = (int*)(smem + 73728);
    moe_tiles(p, l, s_tb);
    const bf16_t* H = (const bf16_t*)(p.ws + O_H); bf16_t* ACT = (bf16_t*)(p.ws + O_P);
    const unsigned* cnt = (const unsigned*)(p.ws + O_CNT); const int* LTOK = (const int*)(p.ws + O_LTOK); const float* LW = (const float*)(p.ws + O_LW);
    const int sm = (l < NLAYER - 1) ? RT / 128 : RL / 128;
    const int total = (sm + s_tb[16]) * 8;
    for (int it = blockIdx.x; it < total; it += gridDim.x) {
        const int mt = it >> 3, nt = it & 7;
        int e = 16, erow0 = mt * 128, lt = 0;
        if (mt >= sm) { const int q = mt - sm; e = 0; while (q >= s_tb[e + 1]) ++e; lt = q - s_tb[e]; erow0 = RT + q * 128; }
        const int cnte = (e == 16) ? 0 : (int)cnt[e];
        auto rp = [&](int r) -> const bf16_t* {
            if (e == 16) return H + (size_t)(mt * 128 + r) * 1024;
            const int idx = lt * 128 + r;
            const int tok = idx < cnte ? LTOK[(size_t)e * RT + idx] : 0;
            return H + (size_t)tok * 1024;
        };
        f32x4 acc[4][4];
        gemm_core_g<4>(rp, (const bf16_t*)(p.ws + O_WB + W_GU) + (size_t)e * 1024 * 1024 + (size_t)nt * 128 * 1024, 1024, 1024, acc, smem);
        {
            const int lane = tidx() & 63, wave = tidx() >> 6, wr = wave >> 1, wc = wave & 1, fr = lane & 15, fq = lane >> 4;
            float* U = (float*)smem;
#pragma unroll
            for (int ii = 0; ii < 2; ++ii) {
                const int i = wc == 0 ? 2 + ii : ii;
#pragma unroll
                for (int j = 0; j < 4; ++j) { const f32x4 gv = wc == 0 ? acc[2 + ii][j] : acc[ii][j]; *(f32x4*)(U + (wr * 64 + i * 16 + fr) * 68 + j * 16 + fq * 4) = gv; }
            }
            __syncthreads();
#pragma unroll
            for (int ii = 0; ii < 2; ++ii) {
                const int i = wc == 0 ? ii : 2 + ii;
                const int m = wr * 64 + i * 16 + fr;
                float wgt = 1.f;
                if (e != 16) { const int idx = lt * 128 + m; wgt = idx < cnte ? LW[(size_t)e * RT + idx] : 0.f; }
#pragma unroll
                for (int j = 0; j < 4; ++j) {
                    const f32x4 other = *(const f32x4*)(U + m * 68 + j * 16 + fq * 4);
                    f32x4 o;
                    const f32x4 mine = wc == 0 ? acc[ii][j] : acc[2 + ii][j];
#pragma unroll
                    for (int r = 0; r < 4; ++r) { const float g = wc == 0 ? mine[r] : other[r], u = wc == 0 ? other[r] : mine[r]; o[r] = siluf_(g) * u * wgt; }
                    store_bf16x4(ACT + (size_t)(erow0 + m) * 512 + nt * 64 + j * 16 + fq * 4, o);
                }
            }
            __syncthreads();
        }
    }
}
__device__ __forceinline__ void ph_e2(const Params& p, int l, char* smem) {
    int* s_tb = (int*)(smem + 73728);
    moe_tiles(p, l, s_tb);
    const bf16_t* ACT = (const bf16_t*)(p.ws + O_P); bf16_t* YE = (bf16_t*)(p.ws + O_X + X_YE);
    const int sm = (l < NLAYER - 1) ? RT / 128 : RL / 128;
    const int total = (sm + s_tb[16]) * 8;
    for (int it = blockIdx.x; it < total; it += gridDim.x) {
        const int mt = it >> 3, nt = it & 7;
        int e = 16, erow0 = mt * 128;
        if (mt >= sm) { const int q = mt - sm; e = 0; while (q >= s_tb[e + 1]) ++e; erow0 = RT + q * 128; }
        RPPlain rp{ACT + (size_t)erow0 * 512, 512};
        f32x4 acc[4][4];
        gemm_core_g<4>(rp, (const bf16_t*)(p.ws + O_WB + W_D) + (size_t)e * 1024 * 512 + (size_t)nt * 128 * 512, 512, 512, acc, smem);
        acc_foreach<4>(acc, [&](int m, int n, const f32x4& v) { store_bf16x4(YE + (size_t)(erow0 + m) * 1024 + nt * 128 + n, v); });
    }
}
__device__ __forceinline__ void ph_e3(const Params& p, int l, char* smem) {
    int* s_tb = (int*)(smem + 73728);
    moe_tiles(p, l, s_tb);
    const int lane = tidx() & 63, wave = tidx() >> 6;
    const bf16_t* YE = (const bf16_t*)(p.ws + O_X + X_YE); const int* SLOT = (const int*)(p.ws + O_SLOT);
    float* xcur = (float*)(p.ws + O_XCUR); const float* mod = (const float*)(p.ws + O_MOD);
    bf16_t* H = (bf16_t*)(p.ws + O_H);
    const bool last = l == NLAYER - 1;
    const int nrows = last ? RL : RT;
    const float* gn = last ? p.in[I_FNG] : p.in[I_N1G] + (l + 1) * 1024;
    const int stride = gridDim.x * 4, row0 = blockIdx.x * 4 + wave;
    auto slot_rows = [&](int row, size_t& r1, size_t& r2) {
        const int rr = row < nrows ? row : 0;
        const int s1 = SLOT[rr * 2], s2 = SLOT[rr * 2 + 1];
        r1 = (size_t)RT + s_tb[s1 >> 20] * 128 + (s1 & 0xfffff); r2 = (size_t)RT + s_tb[s2 >> 20] * 128 + (s2 & 0xfffff);
    };
    uint4 ya[2], yb[2], yd[2]; float4 xa[2][2];
    size_t r1n, r2n;
    auto load_row = [&](int row, size_t r1, size_t r2) {
        const size_t rr = row < nrows ? row : 0;
#pragma unroll
        for (int i = 0; i < 2; ++i) {
            const int c = lane * 8 + 512 * i;
            ya[i] = *(const uint4*)(YE + rr * 1024 + c); yb[i] = *(const uint4*)(YE + r1 * 1024 + c); yd[i] = *(const uint4*)(YE + r2 * 1024 + c);
            const float4* xp = (const float4*)(xcur + rr * 1024 + c);
            xa[i][0] = xp[0]; xa[i][1] = xp[1];
        }
    };
    { size_t r1, r2; slot_rows(row0, r1, r2); load_row(row0, r1, r2); slot_rows(row0 + stride, r1n, r2n); }
    for (int row = row0; row < nrows; row += stride) {
        const float* g2 = mod + (size_t)(l * 5 + modidx(row)) * 6144 + 5120;
        float xv[2][8]; float ss = 0.f;
#pragma unroll
        for (int i = 0; i < 2; ++i) {
            const int c = lane * 8 + 512 * i;
            float a[8], b[8], d[8];
            unpack8(ya[i], a); unpack8(yb[i], b); unpack8(yd[i], d);
            const float4 x0 = xa[i][0], x1 = xa[i][1];
            const float4 ga = *(const float4*)(g2 + c), gb = *(const float4*)(g2 + c + 4);
            const float xo[8] = {x0.x, x0.y, x0.z, x0.w, x1.x, x1.y, x1.z, x1.w}, gg[8] = {ga.x, ga.y, ga.z, ga.w, gb.x, gb.y, gb.z, gb.w};
#pragma unroll
            for (int e = 0; e < 8; ++e) { xv[i][e] = xo[e] + gg[e] * (a[e] + b[e] + d[e]); ss += xv[i][e] * xv[i][e]; }
            if (!last) { float4* xp = (float4*)(xcur + (size_t)row * 1024 + c); xp[0] = make_float4(xv[i][0], xv[i][1], xv[i][2], xv[i][3]); xp[1] = make_float4(xv[i][4], xv[i][5], xv[i][6], xv[i][7]); }
        }
        { const size_t r1 = r1n, r2 = r2n; load_row(row + stride, r1, r2); slot_rows(row + 2 * stride, r1n, r2n); }
        ss = wsum(ss);
        const float rstd = rsqrtf(ss * (1.f / 1024.f) + 1e-6f);
        const float* md = mod + (size_t)((l + 1) * 5 + modidx(row)) * 6144;
#pragma unroll
        for (int i = 0; i < 2; ++i) {
            const int c = lane * 8 + 512 * i;
            const float4 n0 = *(const float4*)(gn + c), n1 = *(const float4*)(gn + c + 4);
            const float nn[8] = {n0.x, n0.y, n0.z, n0.w, n1.x, n1.y, n1.z, n1.w};
            if (last) {
                float* op = p.out + (size_t)row * 1024 + c;
                *(float4*)op = make_float4(xv[i][0] * rstd * nn[0], xv[i][1] * rstd * nn[1], xv[i][2] * rstd * nn[2], xv[i][3] * rstd * nn[3]);
                *(float4*)(op + 4) = make_float4(xv[i][4] * rstd * nn[4], xv[i][5] * rstd * nn[5], xv[i][6] * rstd * nn[6], xv[i][7] * rstd * nn[7]);
            } else {
                const float4 c0 = *(const float4*)(md + 1024 + c), c1 = *(const float4*)(md + 1024 + c + 4), h0 = *(const float4*)(md + c), h1 = *(const float4*)(md + c + 4);
                const float sc[8] = {c0.x, c0.y, c0.z, c0.w, c1.x, c1.y, c1.z, c1.w}, sh[8] = {h0.x, h0.y, h0.z, h0.w, h1.x, h1.y, h1.z, h1.w};
                float o[8];
#pragma unroll
                for (int e = 0; e < 8; ++e) o[e] = xv[i][e] * rstd * nn[e] * (1.f + sc[e]) + sh[e];
                *(uint4*)(H + (size_t)row * 1024 + c) = pack8(o);
            }
        }
    }
}
constexpr int LDS_BYTES = 76800;
constexpr int NIV = 19;
extern __shared__ __attribute__((aligned(16))) char dynsmem[];
template <int ID> __device__ __forceinline__ void run_iv(const Params& pin, int l, char* smem) {
    Params p = pin; p.ws = launder(pin.ws);
    if constexpr (ID == 0) { ph_pre(p, smem); __syncthreads(); ph_w(p, 0, smem); }
    else if constexpr (ID == 1) ph_n1(p, l);
    else if constexpr (ID == 2) ph_g1(p, smem);
    else if constexpr (ID == 3) { ph_qu(p, smem); ph_krope(p); ph_rp1(p, l, smem); ph_rp2(p, l); ph_f1(p, l, smem); }
    else if constexpr (ID == 5) {
        const bool r1first = (blockIdx.x >> 8) & 1;
#pragma unroll 1
        for (int pass = 0; pass < 2; ++pass) {
            if ((pass == 0) == r1first) { ph_r1(p, l, smem); ph_fa(p, smem); } else ph_at(p, l, smem);
            __syncthreads();
        }
    }
    else if constexpr (ID == 8) { ph_r2(p, smem); __syncthreads(); ph_fb(p, l, smem); }
    else if constexpr (ID == 9) ph_r3(p);
    else if constexpr (ID == 10) ph_rpost(p, l);
    else if constexpr (ID == 12) ph_mg(p, l, smem);
    else if constexpr (ID == 13) ph_out(p, l, smem);
    else if constexpr (ID == 14) ph_n2(p, l, smem);
    else if constexpr (ID == 15) ph_e1(p, l, smem);
    else if constexpr (ID == 16) ph_e2(p, l, smem);
    else if constexpr (ID == 17) { ph_e3(p, l, smem); __syncthreads(); if (l + 1 < NLAYER) ph_w(p, l + 1, smem); }
}
#if MEGA
#ifndef PROBE_MASK
#define PROBE_MASK 0
#define PROBE_REP 1
#endif
#define IV(ID) for (int r_ = 0; r_ < (((PROBE_MASK >> (ID)) & 1) ? PROBE_REP : 1); ++r_) { run_iv<ID>(p, l, smem); xcd_barrier(bar); }
__global__ void __launch_bounds__(256, 2) k_mega(Params p) {
    char* smem = dynsmem;
    volatile LAS unsigned* st = (volatile LAS unsigned*)(smem + LDS_BYTES - 16);
    if (tidx() == 0) { st[0] = 0u; st[1] = 0u; }
    __syncthreads();
    XcdBarrier bar = xcd_barrier_post((unsigned*)(p.ws + O_BAR), st);
    { const int l = 0; IV(0) }
    for (int l = 0; l < NLAYER; ++l) {
        if (l == 0) { IV(1) } IV(2) IV(3) IV(5) IV(8) IV(9) IV(10) IV(12) IV(13) IV(14) IV(15) IV(16) IV(17)
    }
}
#else
template <int ID> __global__ void __launch_bounds__(256, 2) k_iv(Params p, int l) { run_iv<ID>(p, l, dynsmem); }
template <int ID> static void launch_iv(const Params& p, int l, int grid, hipStream_t s) {
    static bool once = false; if (!once) { once = true; (void)hipFuncSetAttribute((const void*)k_iv<ID>, hipFuncAttributeMaxDynamicSharedMemorySize, LDS_BYTES); }
    hipLaunchKernelGGL(k_iv<ID>, dim3(grid), dim3(256), LDS_BYTES, s, p, l);
}
#endif

extern "C" void kernel_launch(void* const* d_in, const int* in_sizes, int n_in, void* d_out, int out_size, void* d_ws, size_t ws_size, hipStream_t stream) {
    (void)in_sizes; (void)out_size;
    if (n_in < N_IN || ws_size < WS_NEED) return;
    Params p{};
    for (int i = 0; i < N_IN; ++i) p.in[i] = (const float*)d_in[i];
    p.out = (float*)d_out; p.ws = (char*)d_ws;
    static int grid = 0;
    if (!grid) {
        int dev = 0, cus = 0; (void)hipGetDevice(&dev); (void)hipDeviceGetAttribute(&cus, hipDeviceAttributeMultiprocessorCount, dev);
        int per_cu = 2;
#if MEGA
        (void)hipFuncSetAttribute((const void*)k_mega, hipFuncAttributeMaxDynamicSharedMemorySize, LDS_BYTES);
        int occ = 0; (void)hipOccupancyMaxActiveBlocksPerMultiprocessor(&occ, k_mega, 256, LDS_BYTES);
        if (occ < per_cu) per_cu = occ;
        if (per_cu < 1) per_cu = 1;
#endif
        grid = cus * per_cu;
    }
#if MEGA
    (void)hipMemsetAsync(p.ws + O_BAR, 0, 16384, stream);
    hipLaunchKernelGGL(k_mega, dim3(grid), dim3(256), LDS_BYTES, stream, p);
#else
    launch_iv<0>(p, 0, grid, stream);
    for (int l = 0; l < NLAYER; ++l) {
        if (l == 0) launch_iv<1>(p, l, grid, stream); launch_iv<2>(p, l, grid, stream); launch_iv<3>(p, l, grid, stream);
        launch_iv<5>(p, l, grid, stream); launch_iv<8>(p, l, grid, stream);
        launch_iv<9>(p, l, grid, stream); launch_iv<10>(p, l, grid, stream); launch_iv<12>(p, l, grid, stream);
        launch_iv<13>(p, l, grid, stream); launch_iv<14>(p, l, grid, stream); launch_iv<15>(p, l, grid, stream); launch_iv<16>(p, l, grid, stream); launch_iv<17>(p, l, grid, stream);
    }
#endif
}
```

```cpp
#include <hip/hip_runtime.h>
#include <stdint.h>

#ifndef MEGA
#define MEGA 1
#endif

typedef unsigned short bf16_t;
typedef short bf16x8 __attribute__((ext_vector_type(8)));
typedef float f32x4 __attribute__((ext_vector_type(4)));
typedef float f32x2 __attribute__((ext_vector_type(2)));
typedef unsigned u32x4 __attribute__((ext_vector_type(4)));
typedef __bf16 bf16v2 __attribute__((ext_vector_type(2)));

constexpr int NLAYER = 4;
constexpr int DM = 1024;
constexpr int RL = 16384, RC = 1024, RT = RL + RC;
constexpr int SEQ = 4096, CTX = 256, KEYS = SEQ + CTX;
constexpr int LDP = 6144;
constexpr int PQ0 = 512, PKV0 = 896, PKR0 = 1152, PR0 = 1184, PG0 = 2976, PEND = 6048;
constexpr int NEXP = 16;
constexpr int EROWS = 54272;

enum { I_X = 0, I_C, I_CTX, I_CCTX, I_WADA, I_BADA, I_N1G, I_N2G, I_WIN, I_QNG, I_KVNG, I_WUQ, I_WUKV, I_MU, I_W0, I_WUP, I_A0, I_AUP, I_GUP,
       I_KK, I_KA, I_RK, I_GNG, I_GNB, I_WPA, I_WPB, I_WPC, I_WOUT, I_RW, I_RB, I_EG, I_EU, I_ED, I_SG, I_SU, I_SD, I_FNG, N_IN };

struct Params { const float* in[N_IN]; float* out; char* ws; };

constexpr size_t al256(size_t x) { return (x + 255) & ~(size_t)255; }
constexpr size_t O_BAR   = 0;
constexpr size_t O_CNT   = O_BAR + 16384;
constexpr size_t O_MOD   = O_CNT + 4096;
constexpr size_t O_ROPEC = O_MOD + (size_t)NLAYER * 5 * 6144 * 4;
constexpr size_t O_ROPES = O_ROPEC + (size_t)SEQ * 16 * 4;
constexpr size_t O_CSC   = O_ROPES + (size_t)SEQ * 16 * 4;
constexpr size_t O_CST256= O_CSC + 256 * 128 * 2;
constexpr size_t O_D128  = O_CST256 + 256 * 512 * 2;
constexpr size_t O_E64   = O_D128 + 128 * 128 * 2;
constexpr size_t O_TWC   = O_E64 + 64 * 128 * 2;
constexpr size_t O_TWS   = O_TWC + 64 * 64 * 4;
constexpr size_t O_YT2   = O_TWS + 64 * 64 * 4;
constexpr size_t O_A2    = O_YT2 + (size_t)4 * 512 * 64 * 128 * 2;
constexpr size_t O_YTC   = O_A2 + (size_t)4 * 512 * 64 * 128 * 2;
constexpr size_t O_XCUR  = O_YTC + (size_t)4 * 512 * 512 * 2;
constexpr size_t O_WB    = O_XCUR + (size_t)RT * DM * 4;
constexpr size_t W_IN   = 0;
constexpr size_t W_UQ   = W_IN + (size_t)6144 * 1024 * 2;
constexpr size_t W_UKV  = W_UQ + (size_t)768 * 384 * 2;
constexpr size_t W_WUP  = W_UKV + (size_t)1024 * 256 * 2;
constexpr size_t W_AUP  = W_WUP + (size_t)2 * 512 * 64 * 2;
constexpr size_t W_GUP  = W_AUP + (size_t)2 * 512 * 64 * 2;
constexpr size_t W_PA   = W_GUP + (size_t)512 * 128 * 2;
constexpr size_t W_PB   = W_PA + (size_t)1024 * 512 * 2;
constexpr size_t W_PC   = W_PB + (size_t)1024 * 512 * 2;
constexpr size_t W_OUT  = W_PC + (size_t)1024 * 512 * 2;
constexpr size_t W_GU   = W_OUT + (size_t)1024 * 1024 * 2;
constexpr size_t W_D    = W_GU + (size_t)17 * 1024 * 1024 * 2;
constexpr size_t W_END  = W_D + (size_t)17 * 1024 * 512 * 2;
constexpr size_t O_H    = O_WB + W_END;
constexpr size_t O_P    = O_H + (size_t)RT * DM * 2;
constexpr size_t O_ATT  = O_P + (size_t)RT * LDP * 2;
constexpr size_t O_RG   = O_ATT + (size_t)RT * 512 * 2;
constexpr size_t O_RWO  = O_RG + (size_t)RT * 512 * 2;
constexpr size_t O_FA   = O_RWO + (size_t)RT * 512 * 2;
constexpr size_t O_LTOK = O_FA + (size_t)RT * 512 * 2;
constexpr size_t O_LW   = O_LTOK + (size_t)NEXP * RT * 4;
constexpr size_t O_SLOT = O_LW + (size_t)NEXP * RT * 4;
constexpr size_t O_X    = al256(O_SLOT + (size_t)RT * 2 * 4);
constexpr size_t X_QA   = 0;
constexpr size_t X_KA   = X_QA + (size_t)RT * 768 * 2;
constexpr size_t X_VA   = X_KA + (size_t)4 * KEYS * 768 * 2;
constexpr int NCP = 4 * 8 * 2 * 68;
constexpr size_t X_S0   = 0;
constexpr size_t X_MT   = X_VA + (size_t)4 * 8 * 64 * KEYS * 2;
constexpr size_t X_GT   = X_MT + (size_t)NCP * 8192;
constexpr size_t X_YL   = X_GT + (size_t)NCP * 8192;
constexpr size_t X_QRAW = X_MT;
constexpr size_t X_KVRAW= X_QRAW + (size_t)RT * 768 * 2;
constexpr size_t X_KKN  = X_YL + (size_t)NCP * 8192;
constexpr size_t X_BON  = X_KKN + (size_t)RT * 8 * 4;
constexpr size_t X_SSQ  = X_BON + (size_t)2 * RT * 8 * 4;
constexpr size_t X_END  = X_SSQ + (size_t)RT * 10 * 4;
static_assert(X_KVRAW + (size_t)RT * 1024 * 2 <= X_YL + (size_t)NCP * 8192, "raw q/kv must fit under the chunk data");
static_assert(X_S0 + (size_t)NCP * 8192 <= X_VA, "S0 must fit in the q/k area");
constexpr size_t X_YE   = 0;
constexpr size_t WS_NEED = O_X + X_END;

__device__ __forceinline__ float bf2f(bf16_t u) { return __builtin_bit_cast(float, (unsigned)u << 16); }
__device__ __forceinline__ float bflo(unsigned u) { return __builtin_bit_cast(float, u << 16); }
__device__ __forceinline__ float bfhi(unsigned u) { return __builtin_bit_cast(float, u & 0xffff0000u); }
__device__ __forceinline__ unsigned pack2(float lo, float hi) { f32x2 v = {lo, hi}; bf16v2 b = __builtin_convertvector(v, bf16v2); return __builtin_bit_cast(unsigned, b); }
__device__ __forceinline__ bf16_t f2bf(float f) { return (bf16_t)(pack2(f, 0.f) & 0xffffu); }
__device__ __forceinline__ float wsum(float v) {
#pragma unroll
    for (int o = 32; o > 0; o >>= 1) v += __shfl_xor(v, o);
    return v;
}
__device__ __forceinline__ float sigmoidf_(float x) { return 1.f / (1.f + __expf(-x)); }
__device__ __forceinline__ float siluf_(float x) { return x / (1.f + __expf(-x)); }
__device__ __forceinline__ int modidx(int row) { return row < RL ? (row >> 12) : 4; }
__device__ __forceinline__ void unpack8(const uint4& u, float (&f)[8]) {
    f[0] = bflo(u.x); f[1] = bfhi(u.x); f[2] = bflo(u.y); f[3] = bfhi(u.y); f[4] = bflo(u.z); f[5] = bfhi(u.z); f[6] = bflo(u.w); f[7] = bfhi(u.w);
}
__device__ __forceinline__ uint4 pack8(const float (&f)[8]) { return make_uint4(pack2(f[0], f[1]), pack2(f[2], f[3]), pack2(f[4], f[5]), pack2(f[6], f[7])); }

__device__ __forceinline__ float xmax_16_32(float v) {
    unsigned u = __builtin_bit_cast(unsigned, v);
    auto r = __builtin_amdgcn_permlane32_swap(u, u, false, false);
    float m = fmaxf(__builtin_bit_cast(float, r[0]), __builtin_bit_cast(float, r[1]));
    u = __builtin_bit_cast(unsigned, m);
    auto r2 = __builtin_amdgcn_permlane16_swap(u, u, false, false);
    return fmaxf(__builtin_bit_cast(float, r2[0]), __builtin_bit_cast(float, r2[1]));
}
__device__ __forceinline__ float lane_xor32(float v, int lane) {
    const unsigned u = __builtin_bit_cast(unsigned, v);
    auto r = __builtin_amdgcn_permlane32_swap(u, u, false, false);
    return __builtin_bit_cast(float, lane < 32 ? r[1] : r[0]);
}
__device__ __forceinline__ float xsum_16_32(float v) {
    unsigned u = __builtin_bit_cast(unsigned, v);
    auto r = __builtin_amdgcn_permlane32_swap(u, u, false, false);
    float m = __builtin_bit_cast(float, r[0]) + __builtin_bit_cast(float, r[1]);
    u = __builtin_bit_cast(unsigned, m);
    auto r2 = __builtin_amdgcn_permlane16_swap(u, u, false, false);
    return __builtin_bit_cast(float, r2[0]) + __builtin_bit_cast(float, r2[1]);
}
#define XB_TMO      128
#define XB_XCNT(j)  (256  + 64 * (j))
#define XB_XSUB(j)  (1280 + 64 * (j))
#define XB_XGEN(j)  (2304 + 64 * (j))
#define XB_TOP      3328
#define XB_TOPGEN   3392
#define XCD_BAR_WORDS 3456
#define XB_SPIN_CAP (1u << 22)
#define LAS __attribute__((address_space(3)))
__device__ __forceinline__ unsigned xb_ld(unsigned* p)              { return __hip_atomic_load(p, __ATOMIC_RELAXED, __HIP_MEMORY_SCOPE_AGENT); }
__device__ __forceinline__ unsigned xb_add(unsigned* p, unsigned v) { return __hip_atomic_fetch_add(p, v, __ATOMIC_RELAXED, __HIP_MEMORY_SCOPE_AGENT); }
__device__ __forceinline__ unsigned xb_xcc_id() { return (unsigned)__builtin_amdgcn_s_getreg((3 << 11) | 20) & 0xFu; }
#define XB_SPIN(cond, bar) do { unsigned _sp = 0; while (cond) { __builtin_amdgcn_s_sleep(1); \
    if ((++_sp & 255u) == 0u) { if (xb_ld(&(bar)[XB_TMO])) break; if (_sp > XB_SPIN_CAP) { atomicAdd(&(bar)[XB_TMO], 1u); break; } } } } while (0)
struct XcdBarrier { unsigned* bar; unsigned x; volatile LAS unsigned* st; };
__device__ __forceinline__ XcdBarrier xcd_barrier_post(unsigned* bar, volatile LAS unsigned* st) {
    XcdBarrier b; b.bar = bar; b.x = xb_xcc_id(); b.st = st;
    if (threadIdx.x == 0) (void)xb_add(&bar[XB_XCNT(b.x)], 1u);
    return b;
}
__device__ __forceinline__ void xcd_barrier_complete(unsigned* bar, unsigned x, unsigned& nloc, unsigned& nx) {
    const unsigned G = gridDim.x * gridDim.y * gridDim.z;
    unsigned sum, cnt, mine, sp = 0u;
    for (;;) {
        sum = 0u; cnt = 0u; mine = 0u;
#pragma unroll
        for (unsigned j = 0; j < 16; ++j) { const unsigned c = xb_ld(&bar[XB_XCNT(j)]); sum += c; cnt += (c > 0u) ? 1u : 0u; mine = (j == x) ? c : mine; }
        if (sum == G) break;
        __builtin_amdgcn_s_sleep(1);
        if ((++sp & 255u) == 0u) { if (xb_ld(&bar[XB_TMO])) break; if (sp > XB_SPIN_CAP) { atomicAdd(&bar[XB_TMO], 1u); break; } }
    }
    nloc = mine > 0u ? mine : 1u; nx = cnt > 0u ? cnt : 1u;
}
__device__ __forceinline__ void xcd_barrier(const XcdBarrier& b) {
    asm volatile("s_waitcnt vmcnt(0)" ::: "memory");
    __syncthreads();
    if (threadIdx.x == 0) {
        unsigned* bar = b.bar;
        __builtin_amdgcn_s_waitcnt(0);
        unsigned nloc = b.st[0], nx = b.st[1];
        if (nloc == 0u) { xcd_barrier_complete(bar, b.x, nloc, nx); b.st[0] = nloc; b.st[1] = nx; }
        const unsigned old = xb_add(&bar[XB_XSUB(b.x)], 1u);
        const unsigned gen = old / nloc;
        if (old + 1u == (gen + 1u) * nloc) {
            __builtin_amdgcn_fence(__ATOMIC_RELEASE, "agent");
            asm volatile("s_waitcnt vmcnt(0)" ::: "memory");
            const unsigned og = xb_add(&bar[XB_TOP], 1u);
            const unsigned tg = og / nx;
            if (og + 1u == (tg + 1u) * nx) xb_add(&bar[XB_TOPGEN], 1u);
            else XB_SPIN(xb_ld(&bar[XB_TOPGEN]) == tg, bar);
            __builtin_amdgcn_fence(__ATOMIC_ACQUIRE, "agent");
            xb_add(&bar[XB_XGEN(b.x)], 1u);
            asm volatile("s_waitcnt vmcnt(0)" ::: "memory");
        } else {
            XB_SPIN(xb_ld(&bar[XB_XGEN(b.x)]) == gen, bar);
            __builtin_amdgcn_fence(__ATOMIC_ACQUIRE, "agent");
            asm volatile("s_waitcnt vmcnt(0)" ::: "memory");
        }
    }
    __syncthreads();
}

__device__ __forceinline__ int tidx() { int t = threadIdx.x; asm volatile("" : "+v"(t)); return t; }
__device__ __forceinline__ int lv(int x) { asm volatile("" : "+v"(x)); return x; }
__device__ __forceinline__ char* launder(char* p) { size_t z = 0; asm volatile("" : "+s"(z)); return p + z; }

constexpr int LDSROW = 72;
template <int NA, class AL>
__device__ __forceinline__ void gc_load(const AL& al, const bf16_t* bp, size_t bstep, int k0, int kc, u32x4 (&ra)[NA], u32x4 (&rb)[4]) {
#pragma unroll
    for (int i = 0; i < NA; ++i) ra[i] = __builtin_bit_cast(u32x4, al.load(i, k0 + kc));
#pragma unroll
    for (int j = 0; j < 4; ++j) rb[j] = *(const u32x4*)(bp + j * bstep + k0);
}
template <int NA>
__device__ __forceinline__ void gc_store(bf16_t* Ab, bf16_t* Bb, int lr, int kc, const u32x4 (&ra)[NA], const u32x4 (&rb)[4]) {
#pragma unroll
    for (int i = 0; i < NA; ++i) *(u32x4*)(Ab + (lr + 32 * i) * LDSROW + kc) = ra[i];
#pragma unroll
    for (int j = 0; j < 4; ++j) *(u32x4*)(Bb + (lr + 32 * j) * LDSROW + kc) = rb[j];
}
template <int MI>
__device__ __forceinline__ void gc_compute(const bf16_t* Ac, const bf16_t* Bc, f32x4 (&acc)[MI][4]) {
#pragma unroll
    for (int kh = 0; kh < 2; ++kh) {
        bf16x8 af[MI], bfv[4];
#pragma unroll
        for (int i = 0; i < MI; ++i) af[i] = *(const bf16x8*)(Ac + i * 16 * LDSROW + kh * 32);
#pragma unroll
        for (int j = 0; j < 4; ++j) bfv[j] = *(const bf16x8*)(Bc + j * 16 * LDSROW + kh * 32);
#pragma unroll
        for (int i = 0; i < MI; ++i)
#pragma unroll
            for (int j = 0; j < 4; ++j) acc[i][j] = __builtin_amdgcn_mfma_f32_16x16x32_bf16(bfv[j], af[i], acc[i][j], 0, 0, 0);
    }
}
template <int MI, class AL>
__device__ __forceinline__ void gemm_core(const AL& al, const bf16_t* __restrict__ Bt, int ldb, int K, f32x4 (&acc)[MI][4], char* smem) {
    constexpr int TM = MI * 32;
    constexpr int NA = TM / 32;
    bf16_t* As = (bf16_t*)smem;
    bf16_t* Bs = As + 2 * TM * LDSROW;
    const int tid = tidx(), lane = tid & 63, wave = tid >> 6;
    const int wr = wave >> 1, wc = wave & 1, fr = lane & 15, fq = lane >> 4;
    const int kc = (tid & 7) * 8, lr = tid >> 3;
#pragma unroll
    for (int i = 0; i < MI; ++i)
#pragma unroll
        for (int j = 0; j < 4; ++j) acc[i][j] = (f32x4){0.f, 0.f, 0.f, 0.f};
    u32x4 a0[NA], b0[4], a1[NA], b1[4];
    const bf16_t* bp = Bt + (size_t)lr * ldb + kc;
    const size_t bstep = (size_t)32 * ldb;
    const int nk = K >> 6;
    bf16_t* As1 = As + TM * LDSROW; bf16_t* Bs1 = Bs + 128 * LDSROW;
    const int aoff = (wr * MI * 16 + fr) * LDSROW + fq * 8, boff = (wc * 64 + fr) * LDSROW + fq * 8;
    gc_load<NA>(al, bp, bstep, 0, kc, a0, b0);
    gc_store<NA>(As, Bs, lr, kc, a0, b0);
    if (nk > 1) gc_load<NA>(al, bp, bstep, 64, kc, a0, b0);
    __syncthreads();
    for (int kt = 0; kt < nk; kt += 2) {
        if (kt + 2 < nk) gc_load<NA>(al, bp, bstep, (kt + 2) << 6, kc, a1, b1);
        gc_compute<MI>(As + aoff, Bs + boff, acc);
        if (kt + 1 < nk) gc_store<NA>(As1, Bs1, lr, kc, a0, b0);
        __syncthreads();
        if (kt + 1 >= nk) break;
        if (kt + 3 < nk) gc_load<NA>(al, bp, bstep, (kt + 3) << 6, kc, a0, b0);
        gc_compute<MI>(As1 + aoff, Bs1 + boff, acc);
        if (kt + 2 < nk) gc_store<NA>(As, Bs, lr, kc, a1, b1);
        __syncthreads();
    }
}
template <int MI, class RP, class RPB>
__device__ __forceinline__ void gemm_core_gb(const RP& rp, const RPB& rpb, int K, f32x4 (&acc)[MI][4], char* smem) {
    constexpr int ABYTES = MI * 32 * 128;
    constexpr int SBYTES = ABYTES + 16384;
    const int tid = tidx(), lane = tid & 63, wave = tid >> 6;
    const int wr = wave >> 1, wc = wave & 1, fr = lane & 15, fq = lane >> 4;
    const int rr = lane >> 3, cs = ((lane & 7) ^ ((wave * 4 + (lane >> 4)) & 7)) * 8;
#pragma unroll
    for (int i = 0; i < MI; ++i)
#pragma unroll
        for (int j = 0; j < 4; ++j) acc[i][j] = (f32x4){0.f, 0.f, 0.f, 0.f};
    const bf16_t* ap[MI]; const bf16_t* bp[4];
#pragma unroll
    for (int i = 0; i < MI; ++i) { const int r = (i * 4 + wave) * 8 + rr; ap[i] = rp(r) + cs; }
#pragma unroll
    for (int i = 0; i < 4; ++i) { const int r = (i * 4 + wave) * 8 + rr; bp[i] = rpb(r) + cs; }
    const int wbase = __builtin_amdgcn_readfirstlane(wave) * 1024;
    const int nk = K >> 6;
    auto stage = [&](int buf, int kt) {
        char* Ab = smem + buf * SBYTES + wbase; char* Bb = Ab + ABYTES;
#pragma unroll
        for (int i = 0; i < MI; ++i) __builtin_amdgcn_global_load_lds((const unsigned*)(ap[i] + kt * 64), (unsigned*)(Ab + i * 4096), 16, 0, 0);
#pragma unroll
        for (int i = 0; i < 4; ++i) __builtin_amdgcn_global_load_lds((const unsigned*)(bp[i] + kt * 64), (unsigned*)(Bb + i * 4096), 16, 0, 0);
    };
    const int aoff = (wr * MI * 16 + fr) * 128, boff = ABYTES + (wc * 64 + fr) * 128, sw = fr >> 1;
    stage(0, 0);
    asm volatile("s_waitcnt vmcnt(0)" ::: "memory");
    __syncthreads();
    for (int kt = 0; kt < nk; ++kt) {
        const int cur = kt & 1;
        if (kt + 1 < nk) stage(cur ^ 1, kt + 1);
        const char* base = smem + cur * SBYTES;
#pragma unroll
        for (int kh = 0; kh < 2; ++kh) {
            const int xo = ((kh * 4 + fq) ^ sw) * 16;
            bf16x8 af[MI], bfv[4];
#pragma unroll
            for (int i = 0; i < MI; ++i) af[i] = *(const bf16x8*)(base + aoff + i * 2048 + xo);
#pragma unroll
            for (int j = 0; j < 4; ++j) bfv[j] = *(const bf16x8*)(base + boff + j * 2048 + xo);
#pragma unroll
            for (int i = 0; i < MI; ++i)
#pragma unroll
                for (int j = 0; j < 4; ++j) acc[i][j] = __builtin_amdgcn_mfma_f32_16x16x32_bf16(bfv[j], af[i], acc[i][j], 0, 0, 0);
        }
        asm volatile("s_waitcnt vmcnt(0)" ::: "memory");
        __syncthreads();
    }
}
struct RPPlain;
template <int MI, class RP>
__device__ __forceinline__ void gemm_core_g(const RP& rp, const bf16_t* __restrict__ Bt, int ldb, int K, f32x4 (&acc)[MI][4], char* smem);
struct RPPlain {
    const bf16_t* A; size_t lda;
    __device__ __forceinline__ const bf16_t* operator()(int r) const { return A + (size_t)r * lda; }
};
template <int MI, class RP>
__device__ __forceinline__ void gemm_core_g(const RP& rp, const bf16_t* __restrict__ Bt, int ldb, int K, f32x4 (&acc)[MI][4], char* smem) {
    RPPlain rpb{Bt, (size_t)ldb};
    gemm_core_gb<MI>(rp, rpb, K, acc, smem);
}
template <int MI, class F>
__device__ __forceinline__ void acc_foreach(const f32x4 (&acc)[MI][4], F f) {
    const int lane = tidx() & 63, wave = tidx() >> 6;
    const int wr = wave >> 1, wc = wave & 1, fr = lane & 15, fq = lane >> 4;
#pragma unroll
    for (int i = 0; i < MI; ++i)
#pragma unroll
        for (int j = 0; j < 4; ++j) f(wr * MI * 16 + i * 16 + fr, wc * 64 + j * 16 + fq * 4, acc[i][j]);
}
struct ALPlain {
    const bf16_t* p0; size_t step;
    __device__ __forceinline__ ALPlain(const bf16_t* A, int lda, int row0) { p0 = A + (size_t)(row0 + (tidx() >> 3)) * lda; step = (size_t)32 * lda; }
    __device__ __forceinline__ uint4 load(int i, int k) const { return *(const uint4*)(p0 + i * step + k); }
};
__device__ __forceinline__ void store_bf16x4(bf16_t* dst, const f32x4& v) { *(uint2*)dst = make_uint2(pack2(v[0], v[1]), pack2(v[2], v[3])); }

__device__ __forceinline__ void ph_pre(const Params& p, char* smem) {
    const int tid = tidx(), nb = gridDim.x, bid = blockIdx.x;
    float* mod = (float*)(p.ws + O_MOD);
    {
        float* sv = (float*)smem;
        float* part = sv + 5 * 1024;
        for (int i = tid; i < 5 * 1024; i += 256) { const float v = (i < 4096) ? p.in[I_C][i] : p.in[I_CCTX][i - 4096]; sv[i] = siluf_(v); }
        __syncthreads();
        for (int it = bid; it < NLAYER * 96; it += nb) {
            const int l = it / 96, jb = it % 96;
            const int jj = tid & 63, kq = tid >> 6, j = jb * 64 + jj;
            const float* w = p.in[I_WADA] + (size_t)l * 1024 * 6144 + (size_t)(kq * 256) * 6144 + j;
            float a0 = 0.f, a1 = 0.f, a2 = 0.f, a3 = 0.f, a4 = 0.f;
#pragma unroll 8
            for (int k = 0; k < 256; ++k) {
                const float wv = w[(size_t)k * 6144]; const int kk = kq * 256 + k;
                a0 += sv[kk] * wv; a1 += sv[1024 + kk] * wv; a2 += sv[2048 + kk] * wv; a3 += sv[3072 + kk] * wv; a4 += sv[4096 + kk] * wv;
            }
            part[(kq * 5 + 0) * 64 + jj] = a0; part[(kq * 5 + 1) * 64 + jj] = a1; part[(kq * 5 + 2) * 64 + jj] = a2;
            part[(kq * 5 + 3) * 64 + jj] = a3; part[(kq * 5 + 4) * 64 + jj] = a4;
            __syncthreads();
            for (int o = tid; o < 320; o += 256) {
                const int i = o >> 6, c = o & 63;
                const float s = part[(0 * 5 + i) * 64 + c] + part[(1 * 5 + i) * 64 + c] + part[(2 * 5 + i) * 64 + c] + part[(3 * 5 + i) * 64 + c];
                mod[(size_t)(l * 5 + i) * 6144 + jb * 64 + c] = s + p.in[I_BADA][l * 6144 + jb * 64 + c];
            }
            __syncthreads();
        }
    }
    {
        float4* xc = (float4*)(p.ws + O_XCUR);
        const float4* x4 = (const float4*)p.in[I_X]; const float4* c4 = (const float4*)p.in[I_CTX];
        for (size_t i = (size_t)bid * 256 + tid; i < (size_t)RT * 256; i += (size_t)nb * 256) xc[i] = (i < (size_t)RL * 256) ? x4[i] : c4[i - (size_t)RL * 256];
    }
    {
        float* ct = (float*)smem;
        __syncthreads();
        for (int m = tid; m < 4096; m += 256) ct[m] = cospif((float)m * (1.f / 2048.f));
        __syncthreads();
        bf16_t* cst2 = (bf16_t*)(p.ws + O_CST256);
        for (int ch = bid * 256 + tid; ch < 256 * 512 / 8; ch += nb * 256) {
            const int ks = ch >> 6, c0 = (ch & 63) * 8, part = c0 >> 8, s0 = c0 & 255;
            float f[8];
#pragma unroll
            for (int e = 0; e < 8; ++e) { const int m = (16 * ks * (s0 + e)) & 4095; f[e] = part == 0 ? ct[m] : ct[(m - 1024) & 4095]; }
            *(uint4*)(cst2 + ch * 8) = pack8(f);
        }
        bf16_t* d128 = (bf16_t*)(p.ws + O_D128);
        for (int ch = bid * 256 + tid; ch < 128 * 128 / 8; ch += nb * 256) {
            const int mrow = ch >> 4, c0 = (ch & 15) * 8, po = mrow >> 6, k1 = mrow & 63, pi = c0 >> 6, t10 = c0 & 63;
            float f[8];
#pragma unroll
            for (int e = 0; e < 8; ++e) {
                const int m = (64 * k1 * (t10 + e)) & 4095; const float cv = ct[m], sv = ct[(m - 1024) & 4095];
                f[e] = (po == pi) ? cv : (po == 0 ? sv : -sv);
            }
            *(uint4*)(d128 + ch * 8) = pack8(f);
        }
        bf16_t* e64 = (bf16_t*)(p.ws + O_E64);
        for (int ch = bid * 256 + tid; ch < 64 * 128 / 8; ch += nb * 256) {
            const int k2 = ch >> 4, c0 = (ch & 15) * 8, po = c0 >> 6, t20 = c0 & 63;
            float f[8];
#pragma unroll
            for (int e = 0; e < 8; ++e) { const int m = (64 * k2 * (t20 + e)) & 4095; f[e] = po == 0 ? ct[m] : ct[(m - 1024) & 4095]; }
            *(uint4*)(e64 + ch * 8) = pack8(f);
        }
        float* twc = (float*)(p.ws + O_TWC); float* tws = (float*)(p.ws + O_TWS);
        for (int i = bid * 256 + tid; i < 64 * 64; i += nb * 256) {
            const int k1 = i >> 6, t2 = i & 63, m = (k1 * t2) & 4095;
            twc[i] = ct[m]; tws[i] = -ct[(m - 1024) & 4095];
        }
        bf16_t* csc = (bf16_t*)(p.ws + O_CSC);
        for (int ch = bid * 256 + tid; ch < 256 * 128 / 8; ch += nb * 256) {
            const int n = ch >> 4, c0 = (ch & 15) * 8, part = n >> 7, kc = n & 127;
            float f[8];
#pragma unroll
            for (int e = 0; e < 8; ++e) { const int m = (32 * kc * (c0 + e)) & 4095; f[e] = part == 0 ? ct[m] : -ct[(m - 1024) & 4095]; }
            *(uint4*)(csc + ch * 8) = pack8(f);
        }
        float* rc = (float*)(p.ws + O_ROPEC); float* rs = (float*)(p.ws + O_ROPES);
        for (int i = bid * 256 + tid; i < SEQ * 16; i += nb * 256) {
            const int t = i >> 4, ax = (i >> 3) & 1, f = i & 7;
            const float inv = powf(10000.f, -(float)f / 8.f);
            const float pos = (float)(ax == 0 ? (t >> 6) : (t & 63));
            const float ang = pos * inv;
            rc[i] = cosf(ang); rs[i] = sinf(ang);
        }
    }
}

struct ConvTask { const float* src; const float* scale; bf16_t* dst; int K, Nsrc, Ndst, rmul; size_t sbs, dbs; };
__constant__ int c_conv_cum[17] = {0, 1536, 1608, 1672, 1688, 1704, 1720, 1848, 1976, 2104, 2360, 4408, 6456, 8504, 8632, 8760, 8888};
__device__ __forceinline__ ConvTask conv_task(const Params& p, int l, int t) {
    bf16_t* wb = (bf16_t*)(p.ws + O_WB);
    ConvTask c; c.scale = nullptr; c.sbs = 0; c.dbs = 0; c.rmul = 64;
    switch (t) {
    case 0:  c.src = p.in[I_WIN] + (size_t)l * 1024 * 6048; c.K = 1024; c.Nsrc = 6048; c.Ndst = 6144; c.dst = wb + W_IN / 2; break;
    case 1:  c.src = p.in[I_WUQ] + (size_t)l * 384 * 768; c.K = 384; c.Nsrc = 768; c.Ndst = 768; c.dst = wb + W_UQ / 2; c.scale = p.in[I_QNG] + l * 384; break;
    case 2:  c.src = p.in[I_WUKV] + (size_t)l * 256 * 1024; c.K = 256; c.Nsrc = 1024; c.Ndst = 1024; c.dst = wb + W_UKV / 2; c.scale = p.in[I_KVNG] + l * 256; break;
    case 3:  c.src = p.in[I_WUP] + (size_t)l * 2 * 64 * 512; c.K = 64; c.Nsrc = 512; c.Ndst = 512; c.dst = wb + W_WUP / 2; c.sbs = 64 * 512; c.dbs = 512 * 64; break;
    case 4:  c.src = p.in[I_AUP] + (size_t)l * 2 * 64 * 512; c.K = 64; c.Nsrc = 512; c.Ndst = 512; c.dst = wb + W_AUP / 2; c.sbs = 64 * 512; c.dbs = 512 * 64; break;
    case 5:  c.src = p.in[I_GUP] + (size_t)l * 128 * 512; c.K = 128; c.Nsrc = 512; c.Ndst = 512; c.dst = wb + W_GUP / 2; break;
    case 6:  c.src = p.in[I_WPA] + (size_t)l * 512 * 1024; c.K = 512; c.Nsrc = 1024; c.Ndst = 1024; c.dst = wb + W_PA / 2; break;
    case 7:  c.src = p.in[I_WPB] + (size_t)l * 512 * 1024; c.K = 512; c.Nsrc = 1024; c.Ndst = 1024; c.dst = wb + W_PB / 2; break;
    case 8:  c.src = p.in[I_WPC] + (size_t)l * 512 * 1024; c.K = 512; c.Nsrc = 1024; c.Ndst = 1024; c.dst = wb + W_PC / 2; break;
    case 9:  c.src = p.in[I_WOUT] + (size_t)l * 1024 * 1024; c.K = 1024; c.Nsrc = 1024; c.Ndst = 1024; c.dst = wb + W_OUT / 2; break;
    case 10: c.src = p.in[I_EG] + (size_t)l * 16 * 1024 * 512; c.K = 1024; c.Nsrc = 512; c.Ndst = 512; c.dst = wb + W_GU / 2; c.sbs = 1024 * 512; c.dbs = 1024 * 1024; c.rmul = 128; break;
    case 11: c.src = p.in[I_EU] + (size_t)l * 16 * 1024 * 512; c.K = 1024; c.Nsrc = 512; c.Ndst = 512; c.dst = wb + W_GU / 2 + 64 * 1024; c.sbs = 1024 * 512; c.dbs = 1024 * 1024; c.rmul = 128; break;
    case 12: c.src = p.in[I_ED] + (size_t)l * 16 * 512 * 1024; c.K = 512; c.Nsrc = 1024; c.Ndst = 1024; c.dst = wb + W_D / 2; c.sbs = 512 * 1024; c.dbs = 1024 * 512; break;
    case 13: c.src = p.in[I_SG] + (size_t)l * 1024 * 512; c.K = 1024; c.Nsrc = 512; c.Ndst = 512; c.dst = wb + W_GU / 2 + (size_t)16 * 1024 * 1024; c.rmul = 128; break;
    case 14: c.src = p.in[I_SU] + (size_t)l * 1024 * 512; c.K = 1024; c.Nsrc = 512; c.Ndst = 512; c.dst = wb + W_GU / 2 + (size_t)16 * 1024 * 1024 + 64 * 1024; c.rmul = 128; break;
    default: c.src = p.in[I_SD] + (size_t)l * 512 * 1024; c.K = 512; c.Nsrc = 1024; c.Ndst = 1024; c.dst = wb + W_D / 2 + (size_t)16 * 1024 * 512; break;
    }
    return c;
}
__device__ __forceinline__ void ph_w(const Params& p, int l, char* smem) {
    const int tid = tidx();
    float* tl = (float*)smem;
    for (int g = blockIdx.x; g < 8888; g += gridDim.x) {
        int t = 0;
        while (g >= c_conv_cum[t + 1]) ++t;
        const ConvTask c = conv_task(p, l, t);
        int r = g - c_conv_cum[t];
        const int nkt = c.K >> 6, nnt = c.Ndst >> 6;
        const int bi = r / (nkt * nnt); r -= bi * nkt * nnt;
        const int k0 = (r / nnt) * 64, n0 = (r % nnt) * 64;
        const float* src = c.src + bi * c.sbs; bf16_t* dst = c.dst + bi * c.dbs;
#pragma unroll
        for (int i = 0; i < 4; ++i) {
            const int k = (tid >> 4) + 16 * i, n = n0 + (tid & 15) * 4;
            float4 v = make_float4(0.f, 0.f, 0.f, 0.f);
            if (n < c.Nsrc) v = *(const float4*)(src + (size_t)(k0 + k) * c.Nsrc + n);
            if (c.scale) { const float s = c.scale[k0 + k]; v.x *= s; v.y *= s; v.z *= s; v.w *= s; }
            float* d = tl + k * 65 + (tid & 15) * 4;
            d[0] = v.x; d[1] = v.y; d[2] = v.z; d[3] = v.w;
        }
        __syncthreads();
        {
            const int n = tid >> 2, kk0 = (tid & 3) * 16;
            float f[8], g2[8];
#pragma unroll
            for (int j = 0; j < 8; ++j) { f[j] = tl[(kk0 + j) * 65 + n]; g2[j] = tl[(kk0 + 8 + j) * 65 + n]; }
            bf16_t* d = dst + (size_t)((n0 >> 6) * c.rmul + n) * c.K + k0 + kk0;
            *(uint4*)d = pack8(f); *(uint4*)(d + 8) = pack8(g2);
        }
        __syncthreads();
    }
}

__device__ __forceinline__ void ph_n1(const Params& p, int l) {
    const int lane = tidx() & 63, wave = tidx() >> 6;
    const float* xcur = (const float*)(p.ws + O_XCUR); const float* mod = (const float*)(p.ws + O_MOD);
    bf16_t* H = (bf16_t*)(p.ws + O_H);
    const float* g = p.in[I_N1G] + l * 1024;
    for (int row = blockIdx.x * 4 + wave; row < RT; row += gridDim.x * 4) {
        const float* x = xcur + (size_t)row * 1024; const float* md = mod + (size_t)(l * 5 + modidx(row)) * 6144;
        float4 v[4]; float ss = 0.f;
#pragma unroll
        for (int i = 0; i < 4; ++i) { v[i] = *(const float4*)(x + lane * 4 + 256 * i); ss += v[i].x * v[i].x + v[i].y * v[i].y + v[i].z * v[i].z + v[i].w * v[i].w; }
        ss = wsum(ss);
        const float rstd = rsqrtf(ss * (1.f / 1024.f) + 1e-6f);
#pragma unroll
        for (int i = 0; i < 4; ++i) {
            const int c = lane * 4 + 256 * i;
            const float4 gg = *(const float4*)(g + c), sc = *(const float4*)(md + 1024 + c), sh = *(const float4*)(md + c);
            f32x4 h = {v[i].x * rstd * gg.x * (1.f + sc.x) + sh.x, v[i].y * rstd * gg.y * (1.f + sc.y) + sh.y,
                       v[i].z * rstd * gg.z * (1.f + sc.z) + sh.z, v[i].w * rstd * gg.w * (1.f + sc.w) + sh.w};
            store_bf16x4(H + (size_t)row * 1024 + c, h);
        }
    }
}

__device__ __forceinline__ void ph_g1(const Params& p, char* smem) {
    if (blockIdx.x == 0 && tidx() < 64) ((unsigned*)(p.ws + O_CNT))[tidx()] = 0u;
    const bf16_t* H = (const bf16_t*)(p.ws + O_H); const bf16_t* W = (const bf16_t*)(p.ws + O_WB + W_IN);
    bf16_t* P = (bf16_t*)(p.ws + O_P);
    for (int it = blockIdx.x; it < 136 * 48; it += gridDim.x) {
        const int mt = it / 48, nt = it % 48;
        f32x4 acc[4][4];
        RPPlain rp{H + (size_t)mt * 128 * 1024, 1024};
        gemm_core_g<4>(rp, W + (size_t)nt * 128 * 1024, 1024, 1024, acc, smem);
        acc_foreach<4>(acc, [&](int m, int n, const f32x4& v) {
            const int col = nt * 128 + n; f32x4 o = v;
            if (col >= PG0 && col < PEND) { o[0] = sigmoidf_(v[0]); o[1] = sigmoidf_(v[1]); o[2] = sigmoidf_(v[2]); o[3] = sigmoidf_(v[3]); }
            store_bf16x4(P + (size_t)(mt * 128 + m) * LDP + col, o);
        });
        if (nt >= 4 && nt <= 8) {
            const int lane = tidx() & 63, wave = tidx() >> 6, wr = wave >> 1, wc = wave & 1, fr = lane & 15, fq = lane >> 4;
            float* SSQ = (float*)(p.ws + O_X + X_SSQ);
#pragma unroll
            for (int i = 0; i < 4; ++i) {
                float sq = 0.f;
#pragma unroll
                for (int j = 0; j < 4; ++j)
#pragma unroll
                    for (int r = 0; r < 4; ++r) sq += acc[i][j][r] * acc[i][j][r];
                sq = xsum_16_32(sq);
                if (fq == 0) SSQ[(size_t)(mt * 128 + wr * 64 + i * 16 + fr) * 10 + (nt - 4) * 2 + wc] = sq;
            }
        }
    }
}

constexpr float QSCALE = 0.10206207261596575f * 1.4426950408889634f;
__device__ __forceinline__ void ph_qu(const Params& p, char* smem) {
    const bf16_t* P = (const bf16_t*)(p.ws + O_P); const float* SSQ = (const float*)(p.ws + O_X + X_SSQ);
    bf16_t* QA = (bf16_t*)(p.ws + O_X + X_QA); bf16_t* KA = (bf16_t*)(p.ws + O_X + X_KA); bf16_t* VA = (bf16_t*)(p.ws + O_X + X_VA);
    const float* rc = (const float*)(p.ws + O_ROPEC); const float* rs = (const float*)(p.ws + O_ROPES);
    for (int it = blockIdx.x; it < 136 * 14; it += gridDim.x) {
        const int mt = it / 14, nn = it % 14;
        const int row0 = mt * 128;
        const bool lat = row0 < RL;
        const int b = lat ? (row0 >> 12) : ((row0 - RL) >> 8), t0 = lat ? (row0 & 4095) : ((row0 - RL) & 255);
        const size_t key0 = lat ? t0 : SEQ + t0;
        const int lane = tidx() & 63, wave = tidx() >> 6, wr = wave >> 1, wc = wave & 1, fr = lane & 15, fq = lane >> 4;
        f32x4 acc[4][4];
        if (nn < 6) {
            RPPlain rp{P + (size_t)row0 * LDP + PQ0, LDP};
            gemm_core_g<4>(rp, (const bf16_t*)(p.ws + O_WB + W_UQ) + (size_t)nn * 128 * 384, 384, 384, acc, smem);
#pragma unroll
            for (int i = 0; i < 4; ++i) {
                const int m = wr * 64 + i * 16 + fr, row = row0 + m, t = t0 + m;
                const float* sp = SSQ + (size_t)row * 10;
                const float rq = rsqrtf((sp[0] + sp[1] + sp[2] + sp[3] + sp[4] + sp[5]) * (1.f / 384.f) + 1e-6f);
#pragma unroll
                for (int j = 0; j < 4; ++j) {
                    const int n0 = nn * 128 + wc * 64 + j * 16, hg = (n0 >> 4) % 6;
                    f32x4 o = acc[i][j] * rq;
                    if (hg >= 4 && lat) {
                        const int ax = hg - 4, half = fq >> 1;
                        const float4 c4 = *(const float4*)(rc + t * 16 + ax * 8 + (fq & 1) * 4), s4 = *(const float4*)(rs + t * 16 + ax * 8 + (fq & 1) * 4);
                        const float cc[4] = {c4.x, c4.y, c4.z, c4.w}, ss[4] = {s4.x, s4.y, s4.z, s4.w};
#pragma unroll
                        for (int r = 0; r < 4; ++r) {
                            const float xp = lane_xor32(o[r], lane);
                            o[r] = half ? (o[r] * cc[r] + xp * ss[r]) : (o[r] * cc[r] - xp * ss[r]);
                        }
                    }
                    o *= QSCALE;
                    store_bf16x4(QA + (size_t)row * 768 + n0 + fq * 4, o);
                }
            }
        } else {
            const int h = nn - 6;
            RPPlain rp{P + (size_t)row0 * LDP + PKV0, LDP};
            gemm_core_g<4>(rp, (const bf16_t*)(p.ws + O_WB + W_UKV) + (size_t)h * 128 * 256, 256, 256, acc, smem);
            bf16_t* vt = (bf16_t*)smem;
#pragma unroll
            for (int i = 0; i < 4; ++i) {
                const int m = wr * 64 + i * 16 + fr, row = row0 + m;
                const float* sp = SSQ + (size_t)row * 10;
                const float rkv = rsqrtf((sp[6] + sp[7] + sp[8] + sp[9]) * (1.f / 256.f) + 1e-6f);
#pragma unroll
                for (int j = 0; j < 4; ++j) {
                    const f32x4 o = acc[i][j] * rkv;
                    if (wc == 0) store_bf16x4(KA + ((size_t)b * KEYS + key0 + m) * 768 + h * 96 + j * 16 + fq * 4, o);
                    else store_bf16x4(vt + m * 72 + j * 16 + fq * 4, o);
                }
            }
            __syncthreads();
#pragma unroll
            for (int u = 0; u < 4; ++u) {
                const int q = tidx() + 256 * u, dd = q >> 4, kc = q & 15;
                float f[8];
#pragma unroll
                for (int e = 0; e < 8; ++e) f[e] = bf2f(vt[(kc * 8 + e) * 72 + dd]);
                const uint4 uu = pack8(f);
                bf16_t* dst = VA + ((size_t)(b * 8 + h) * 64 + dd) * KEYS + key0 + (kc >> 2) * 32 + (kc & 1) * 16 + ((kc & 3) >> 1) * 4;
                *(uint2*)dst = make_uint2(uu.x, uu.y); *(uint2*)(dst + 8) = make_uint2(uu.z, uu.w);
            }
            __syncthreads();
        }
    }
}
__device__ __forceinline__ void ph_krope(const Params& p) {
    const int lane = tidx() & 63, wave = tidx() >> 6;
    const bf16_t* P = (const bf16_t*)(p.ws + O_P); bf16_t* KA = (bf16_t*)(p.ws + O_X + X_KA);
    const float* rc = (const float*)(p.ws + O_ROPEC); const float* rs = (const float*)(p.ws + O_ROPES);
    for (int row = blockIdx.x * 4 + wave; row < RT; row += gridDim.x * 4) {
        const bool lat = row < RL;
        const int b = lat ? (row >> 12) : ((row - RL) >> 8), t = lat ? (row & 4095) : ((row - RL) & 255);
        const size_t keyrow = (size_t)b * KEYS + (lat ? t : SEQ + t);
        const int ii = lane & 31, hh = lane >> 5;
        const bf16_t* pr = P + (size_t)row * LDP + PKR0;
        float x = bf2f(pr[ii]);
        if (lat) {
            const float xp = bf2f(pr[ii ^ 8]);
            const int ax = ii >> 4, half = (ii >> 3) & 1, f = ii & 7;
            const float c = rc[t * 16 + ax * 8 + f], sn = rs[t * 16 + ax * 8 + f];
            x = half ? (x * c + xp * sn) : (x * c - xp * sn);
        }
        const bf16_t xb = f2bf(x);
#pragma unroll
        for (int q = 0; q < 4; ++q) KA[keyrow * 768 + (hh * 4 + q) * 96 + 64 + ii] = xb;
    }
}

constexpr int KS_LD = 104, VT_LD = 72;
constexpr int AT_BUF = 64 * KS_LD * 2 + 64 * VT_LD * 2;
__device__ __forceinline__ void ph_at(const Params& p, int l, char* smem) {
    const int tid = tidx(), lane = tid & 63, wave = tid >> 6, fr = lane & 15, fq = lane >> 4;
    const bf16_t* QA = (const bf16_t*)(p.ws + O_X + X_QA); const bf16_t* KA = (const bf16_t*)(p.ws + O_X + X_KA); const bf16_t* VA = (const bf16_t*)(p.ws + O_X + X_VA);
    bf16_t* ATT = (bf16_t*)(p.ws + O_ATT);
    const int nitems = 1024 + (l < NLAYER - 1 ? 64 : 0);
    for (int it0 = blockIdx.x; it0 < nitems; it0 += gridDim.x) {
        int it = it0;
        if (gridDim.x == 512 && it0 < 1024) {
            const int x = it0 & 7, j = (it0 >> 3) & 63, rd = it0 >> 9;
            it = ((x * 4 + rd * 2 + (j >> 5)) << 5) | (j & 31);
        }
        int b, h, row0, ntile; size_t krow0;
        if (it < 1024) { b = it >> 8; h = (it >> 5) & 7; row0 = b * SEQ + (it & 31) * 128; krow0 = (size_t)b * KEYS; ntile = KEYS / 64; }
        else { const int j = it - 1024; b = j >> 4; h = (j >> 1) & 7; row0 = RL + b * CTX + (j & 1) * 128; krow0 = (size_t)b * KEYS + SEQ; ntile = CTX / 64; }
        const int qrow = row0 + wave * 32 + fr;
        const size_t vrow0 = (size_t)(b * 8 + h) * 64; const int koff0 = (int)(krow0 - (size_t)b * KEYS);
        bf16x8 qf[2][3];
#pragma unroll
        for (int t = 0; t < 2; ++t)
#pragma unroll
            for (int ks = 0; ks < 3; ++ks) qf[t][ks] = *(const bf16x8*)(QA + (size_t)(qrow + 16 * t) * 768 + h * 96 + ks * 32 + fq * 8);
        f32x4 ot[2][4];
#pragma unroll
        for (int t = 0; t < 2; ++t)
#pragma unroll
            for (int i = 0; i < 4; ++i) ot[t][i] = (f32x4){0.f, 0.f, 0.f, 0.f};
        float m_run[2] = {-1e30f, -1e30f}, l_run[2] = {0.f, 0.f};
        uint4 rk0, rk1, rk2, rv0, rv1;
#define AT_GLOAD(KT) do { const size_t kr_ = krow0 + (size_t)(KT) * 64; \
            { const int c = tid, key = c / 12, part = c % 12; rk0 = *(const uint4*)(KA + (kr_ + key) * 768 + h * 96 + part * 8); } \
            { const int c = tid + 256, key = c / 12, part = c % 12; rk1 = *(const uint4*)(KA + (kr_ + key) * 768 + h * 96 + part * 8); } \
            { const int c = tid + 512, key = c / 12, part = c % 12; rk2 = *(const uint4*)(KA + (kr_ + key) * 768 + h * 96 + part * 8); } \
            { const int c = tid, dd_ = c >> 3, part = c & 7; rv0 = *(const uint4*)(VA + (vrow0 + dd_) * KEYS + koff0 + (KT) * 64 + part * 8); } \
            { const int c = tid + 256, dd_ = c >> 3, part = c & 7; rv1 = *(const uint4*)(VA + (vrow0 + dd_) * KEYS + koff0 + (KT) * 64 + part * 8); } } while (0)
#define AT_VSTORE(RV, C) do { const int dd_ = (C) >> 3, part = (C) & 7; *(uint4*)(Vt_ + dd_ * VT_LD + part * 8) = RV; } while (0)
#define AT_SSTORE(BUF) do { bf16_t* Ks_ = (bf16_t*)(smem + (BUF) * AT_BUF); bf16_t* Vt_ = Ks_ + 64 * KS_LD; \
            { const int c = tid, key = c / 12, part = c % 12; *(uint4*)(Ks_ + key * KS_LD + part * 8) = rk0; } \
            { const int c = tid + 256, key = c / 12, part = c % 12; *(uint4*)(Ks_ + key * KS_LD + part * 8) = rk1; } \
            { const int c = tid + 512, key = c / 12, part = c % 12; *(uint4*)(Ks_ + key * KS_LD + part * 8) = rk2; } \
            AT_VSTORE(rv0, tid); AT_VSTORE(rv1, tid + 256); } while (0)
        AT_GLOAD(0); AT_SSTORE(0);
        __syncthreads();
        for (int kt = 0; kt < ntile; ++kt) {
            const int cur = kt & 1;
            if (kt + 1 < ntile) AT_GLOAD(kt + 1);
            const bf16_t* Ks = (const bf16_t*)(smem + cur * AT_BUF); const bf16_t* Vt = Ks + 64 * KS_LD;
            f32x4 st[2][4];
#pragma unroll
            for (int jh = 0; jh < 2; ++jh) {
                bf16x8 kf[2][3];
#pragma unroll
                for (int jj = 0; jj < 2; ++jj)
#pragma unroll
                    for (int ks = 0; ks < 3; ++ks) kf[jj][ks] = *(const bf16x8*)(Ks + ((jh * 2 + jj) * 16 + fr) * KS_LD + ks * 32 + fq * 8);
#pragma unroll
                for (int jj = 0; jj < 2; ++jj) {
                    const int j = jh * 2 + jj;
                    st[0][j] = (f32x4){0.f, 0.f, 0.f, 0.f}; st[1][j] = (f32x4){0.f, 0.f, 0.f, 0.f};
#pragma unroll
                    for (int ks = 0; ks < 3; ++ks) {
                        st[0][j] = __builtin_amdgcn_mfma_f32_16x16x32_bf16(kf[jj][ks], qf[0][ks], st[0][j], 0, 0, 0);
                        st[1][j] = __builtin_amdgcn_mfma_f32_16x16x32_bf16(kf[jj][ks], qf[1][ks], st[1][j], 0, 0, 0);
                    }
                }
            }
            bf16x8 vf[2][4];
#pragma unroll
            for (int k2 = 0; k2 < 2; ++k2)
#pragma unroll
                for (int dt = 0; dt < 4; ++dt) {
                    vf[k2][dt] = *(const bf16x8*)(Vt + (dt * 16 + fr) * VT_LD + k2 * 32 + fq * 8);
                }
            uint4 pu[2][2];
#pragma unroll
            for (int t = 0; t < 2; ++t) {
                float mx = st[t][0][0];
#pragma unroll
                for (int j = 0; j < 4; ++j)
#pragma unroll
                    for (int r = 0; r < 4; ++r) mx = fmaxf(mx, st[t][j][r]);
                if (__any(mx > m_run[t] + 6.f)) {
                    mx = xmax_16_32(mx);
                    const float m_new = fmaxf(m_run[t], mx);
                    const float alpha = __builtin_amdgcn_exp2f(m_run[t] - m_new);
                    m_run[t] = m_new;
                    l_run[t] *= alpha;
#pragma unroll
                    for (int i = 0; i < 4; ++i) ot[t][i] *= alpha;
                }
                const float mr = m_run[t];
                float ps = 0.f;
#pragma unroll
                for (int j = 0; j < 4; ++j)
#pragma unroll
                    for (int r = 0; r < 4; ++r) { st[t][j][r] = __builtin_amdgcn_exp2f(st[t][j][r] - mr); ps += st[t][j][r]; }
                l_run[t] += ps;
#pragma unroll
                for (int k2 = 0; k2 < 2; ++k2)
                    pu[t][k2] = make_uint4(pack2(st[t][2 * k2][0], st[t][2 * k2][1]), pack2(st[t][2 * k2][2], st[t][2 * k2][3]),
                                           pack2(st[t][2 * k2 + 1][0], st[t][2 * k2 + 1][1]), pack2(st[t][2 * k2 + 1][2], st[t][2 * k2 + 1][3]));
            }
#pragma unroll
            for (int k2 = 0; k2 < 2; ++k2) {
                const bf16x8 pb0 = __builtin_bit_cast(bf16x8, pu[0][k2]), pb1 = __builtin_bit_cast(bf16x8, pu[1][k2]);
#pragma unroll
                for (int dt = 0; dt < 4; ++dt) {
                    ot[0][dt] = __builtin_amdgcn_mfma_f32_16x16x32_bf16(vf[k2][dt], pb0, ot[0][dt], 0, 0, 0);
                    ot[1][dt] = __builtin_amdgcn_mfma_f32_16x16x32_bf16(vf[k2][dt], pb1, ot[1][dt], 0, 0, 0);
                }
            }
            if (kt + 1 < ntile) AT_SSTORE(cur ^ 1);
            __syncthreads();
        }
#pragma unroll
        for (int t = 0; t < 2; ++t) {
            const float inv = 1.f / xsum_16_32(l_run[t]);
#pragma unroll
            for (int dt = 0; dt < 4; ++dt) { f32x4 o = ot[t][dt] * inv; store_bf16x4(ATT + (size_t)(qrow + 16 * t) * 512 + h * 64 + dt * 16 + fq * 4, o); }
        }
    }
}

__device__ __forceinline__ void row_edges(int row, bool& first, bool& last) {
    if (row < RL) { const int t = row & 4095; first = t == 0; last = t == 4095; }
    else { const int s = (row - RL) & 255; first = s == 0; last = s == 255; }
}
__device__ __forceinline__ float xs1(const bf16_t* P, const float* mu, int row, int col) {
    bool first, last; row_edges(row, first, last);
    const bf16_t* pc = P + (size_t)row * LDP + PR0 + col;
    const float c = bf2f(*pc), pv0 = bf2f(*(first ? pc : pc - LDP)), nx0 = bf2f(*(last ? pc : pc + LDP));
    const float pv = first ? 0.f : pv0, nx = last ? 0.f : nx0;
    return c + (0.5f * (pv + nx) - c) * mu[col];
}
__device__ __forceinline__ void xs8(const bf16_t* P, const float* mu, int row, int col, float (&o)[8]) {
    bool first, last; row_edges(row, first, last);
    const bf16_t* pc = P + (size_t)row * LDP + PR0 + col;
    const uint4 uc = *(const uint4*)pc, up = *(const uint4*)(first ? pc : pc - LDP), un = *(const uint4*)(last ? pc : pc + LDP);
    float c[8], pv[8], nx[8]; unpack8(uc, c); unpack8(up, pv); unpack8(un, nx);
    const float fp = first ? 0.f : 0.5f, fn = last ? 0.f : 0.5f;
    const float4 m0 = *(const float4*)(mu + col), m1 = *(const float4*)(mu + col + 4);
    const float m[8] = {m0.x, m0.y, m0.z, m0.w, m1.x, m1.y, m1.z, m1.w};
#pragma unroll
    for (int j = 0; j < 8; ++j) o[j] = c[j] + ((fp * pv[j] + fn * nx[j]) - c[j]) * m[j];
}
struct ALRw {
    const bf16_t* P; const float* mu; int row0; int colbase, mode;
    __device__ __forceinline__ ALRw(const bf16_t* P_, const float* mu_, int row0_, int colbase_, int mode_) : P(P_), mu(mu_), colbase(colbase_), mode(mode_) {
        row0 = row0_ + (tidx() >> 3);
    }
    __device__ __forceinline__ uint4 load(int i, int k) const {
        float o[8]; xs8(P, mu, row0 + 32 * i, colbase + k, o);
        if (mode == 0) {
#pragma unroll
            for (int j = 0; j < 8; ++j) o[j] = tanhf(o[j]);
        } else if (mode == 2) {
#pragma unroll
            for (int j = 0; j < 8; ++j) o[j] = sigmoidf_(o[j]);
        }
        return pack8(o);
    }
};
__device__ __forceinline__ void ph_rp1(const Params& p, int l, char* smem) {
    const bf16_t* P = (const bf16_t*)(p.ws + O_P); const float* mu = p.in[I_MU] + l * 1792;
    bf16_t* RG = (bf16_t*)(p.ws + O_RG);
    for (int it = blockIdx.x; it < 1088; it += gridDim.x) {
        const int mt = it >> 2, nt = it & 3;
        f32x4 acc[2][4];
        ALRw al(P, mu, mt * 64, 1664, 2);
        gemm_core<2>(al, (const bf16_t*)(p.ws + O_WB + W_GUP) + (size_t)nt * 128 * 128, 128, 128, acc, smem);
        acc_foreach<2>(acc, [&](int m, int n, const f32x4& v) { store_bf16x4(RG + (size_t)(mt * 64 + m) * 512 + nt * 128 + n, v); });
    }
}
__device__ __forceinline__ void ph_rp2(const Params& p, int l) {
    const int lane = tidx() & 63, wave = tidx() >> 6;
    const bf16_t* P = (const bf16_t*)(p.ws + O_P); const float* mu = p.in[I_MU] + l * 1792; const float* kkw = p.in[I_KK] + l * 512;
    float* KKN = (float*)(p.ws + O_X + X_KKN);
    for (int row = blockIdx.x * 4 + wave; row < RT; row += gridDim.x * 4) {
        float k8[8]; xs8(P, mu, row, 512 + lane * 8, k8);
        float s = 0.f;
#pragma unroll
        for (int j = 0; j < 8; ++j) { const float v = k8[j] * kkw[lane * 8 + j]; s += v * v; }
        s += __shfl_xor(s, 1); s += __shfl_xor(s, 2); s += __shfl_xor(s, 4);
        if ((lane & 7) == 0) KKN[(size_t)row * 8 + (lane >> 3)] = rsqrtf(s + 1e-12f);
    }
}

__device__ __forceinline__ int scan_row(int b, int d, int n) {
    if (n < CTX) return RL + b * CTX + (d == 0 ? n : CTX - 1 - n);
    const int t = n - CTX; return b * SEQ + (d == 0 ? t : SEQ - 1 - t);
}
constexpr int SL = 72;
constexpr int SLOT_E = 64 * SL;
template <int LDA, int LDB>
__device__ __forceinline__ void mm64(const bf16_t* A, const bf16_t* B, f32x4 (&acc)[4], int wave, int fr, int fq) {
#pragma unroll
    for (int ks = 0; ks < 2; ++ks) {
        const bf16x8 af = *(const bf16x8*)(A + (wave * 16 + fr) * LDA + ks * 32 + fq * 8);
#pragma unroll
        for (int nt = 0; nt < 4; ++nt) {
            const bf16x8 bfv = *(const bf16x8*)(B + (nt * 16 + fr) * LDB + ks * 32 + fq * 8);
            acc[nt] = __builtin_amdgcn_mfma_f32_16x16x32_bf16(bfv, af, acc[nt], 0, 0, 0);
        }
    }
}
__device__ __forceinline__ void acc_zero(f32x4 (&acc)[4]) {
#pragma unroll
    for (int nt = 0; nt < 4; ++nt) acc[nt] = (f32x4){0.f, 0.f, 0.f, 0.f};
}
template <bool STRICT>
__device__ __forceinline__ void acc_mask(f32x4 (&acc)[4], int m, int fq) {
#pragma unroll
    for (int nt = 0; nt < 4; ++nt)
#pragma unroll
        for (int r = 0; r < 4; ++r) { const int n = nt * 16 + fq * 4 + r; const bool keep = STRICT ? (m < n) : (m <= n); if (!keep) acc[nt][r] = 0.f; }
}
__device__ __forceinline__ void st_rm(bf16_t* dst, const f32x4 (&acc)[4], int m, int fq) {
#pragma unroll
    for (int nt = 0; nt < 4; ++nt) store_bf16x4(dst + m * SL + nt * 16 + fq * 4, acc[nt]);
}
__device__ __forceinline__ void st_tr(bf16_t* dst, const f32x4 (&acc)[4], int m, int fq) {
#pragma unroll
    for (int nt = 0; nt < 4; ++nt)
#pragma unroll
        for (int r = 0; r < 4; ++r) dst[(nt * 16 + fq * 4 + r) * SL + m] = f2bf(acc[nt][r]);
}
__device__ __forceinline__ void ph_r1(const Params& p, int l, char* smem) {
    const int tid0 = tidx();
#define R1_IDX const int tid = lv(tid0), lane = tid & 63, wave = tid >> 6, fr = lane & 15, fq = lane >> 4, bi = tid >> 2, bq = (tid & 3) * 16, m = wave * 16 + fr; (void)bi; (void)bq; (void)m; (void)fq;
    const bf16_t* P = (const bf16_t*)(p.ws + O_P); const float* mu = p.in[I_MU] + l * 1792;
    const float* kkw = p.in[I_KK] + l * 512; const float* kaw = p.in[I_KA] + l * 512; const float* rkw = p.in[I_RK] + l * 512;
    const float* KKN = (const float*)(p.ws + O_X + X_KKN); float* BON = (float*)(p.ws + O_X + X_BON);
    bf16_t* gMT = (bf16_t*)(p.ws + O_X + X_MT); bf16_t* gNL = (bf16_t*)(p.ws + O_H);
    bf16_t* gGT = (bf16_t*)(p.ws + O_X + X_GT); bf16_t* gYL = (bf16_t*)(p.ws + O_X + X_YL);
    bf16_t* slot = (bf16_t*)smem;
    bf16_t* s0 = slot, *s1 = slot + SLOT_E, *s2 = slot + 2 * SLOT_E, *s3 = slot + 3 * SLOT_E;
    bf16_t* sa = slot + 4 * SLOT_E, *sb = slot + 5 * SLOT_E, *sc = slot + 6 * SLOT_E, *sT = slot + 7 * SLOT_E;
    float* misc = (float*)(smem + 8 * SLOT_E * 2);
    float* GAM = misc; float* SEG = misc + 64;
    float* ASIG = (float*)s0;
    float* LWS = (float*)s2;
    for (int it = blockIdx.x; it < NCP; it += gridDim.x) {
        const int c = it % 68, d = (it / 68) & 1, h = (it / 136) & 7, b = it / 1088;
        {
            R1_IDX const int rowb = scan_row(b, d, c * 64 + bi); (void)rowb;
            float o[8];
#pragma unroll
            for (int hh = 0; hh < 2; ++hh) {
                xs8(P, mu, rowb, 1536 + bq + hh * 8, o);
#pragma unroll
                for (int j = 0; j < 8; ++j) o[j] = 1.f - 2.f * __builtin_amdgcn_rcpf(1.f + __expf(2.f * o[j]));
                *(uint4*)(sa + bi * SL + bq + hh * 8) = pack8(o);
                xs8(P, mu, rowb, 1600 + bq + hh * 8, o);
                *(uint4*)(sb + bi * SL + bq + hh * 8) = pack8(o);
            }
        }
        __syncthreads();
        {
            R1_IDX const int rowb = scan_row(b, d, c * 64 + bi); (void)rowb;
            f32x4 acc[4];
            acc_zero(acc);
            mm64<SL, 64>(sa, (const bf16_t*)(p.ws + O_WB + W_WUP) + ((size_t)d * 512 + h * 64) * 64, acc, wave, fr, fq);
            const float* w0 = p.in[I_W0] + (l * 2 + d) * 512 + h * 64;
#pragma unroll
            for (int nt = 0; nt < 4; ++nt) {
                const int n = nt * 16 + fq * 4; float4 o; float* op = (float*)&o;
#pragma unroll
                for (int r = 0; r < 4; ++r) { const float z = w0[n + r] + acc[nt][r]; op[r] = -0.6065306597126334f * __builtin_amdgcn_rcpf(1.f + __expf(-z)); }
                *(float4*)(LWS + m * 68 + n) = o;
            }
            acc_zero(acc);
            mm64<SL, 64>(sb, (const bf16_t*)(p.ws + O_WB + W_AUP) + ((size_t)d * 512 + h * 64) * 64, acc, wave, fr, fq);
            const float* a0 = p.in[I_A0] + (l * 2 + d) * 512 + h * 64;
#pragma unroll
            for (int nt = 0; nt < 4; ++nt) {
                const int n = nt * 16 + fq * 4;
                *(float4*)(ASIG + m * 68 + n) = make_float4(__builtin_amdgcn_rcpf(1.f + __expf(-(a0[n] + acc[nt][0]))), __builtin_amdgcn_rcpf(1.f + __expf(-(a0[n + 1] + acc[nt][1]))), __builtin_amdgcn_rcpf(1.f + __expf(-(a0[n + 2] + acc[nt][2]))), __builtin_amdgcn_rcpf(1.f + __expf(-(a0[n + 3] + acc[nt][3]))));
            }
        }
        __syncthreads();
        {
            R1_IDX const int rowb = scan_row(b, d, c * 64 + bi); (void)rowb;
            const int k = tid & 63, seg = tid >> 6;
            float run = 0.f;
#pragma unroll
            for (int ii = 0; ii < 16; ++ii) { run += LWS[(seg * 16 + ii) * 68 + k]; LWS[(seg * 16 + ii) * 68 + k] = run; }
            SEG[seg * 64 + k] = run;
            __syncthreads();
            float off = 0.f;
#pragma unroll
            for (int sgi = 0; sgi < 3; ++sgi) if (sgi < seg) off += SEG[sgi * 64 + k];
#pragma unroll
            for (int ii = 0; ii < 16; ++ii) LWS[(seg * 16 + ii) * 68 + k] += off;
        }
        __syncthreads();
        {
            R1_IDX const int rowb = scan_row(b, d, c * 64 + bi); (void)rowb;
            float cs[16], cm[16], cc[16], ag[16];
#pragma unroll
            for (int q = 0; q < 4; ++q) {
                const float4 v0 = *(const float4*)(LWS + bi * 68 + bq + q * 4);
                const float4 v1 = bi > 0 ? *(const float4*)(LWS + (bi - 1) * 68 + bq + q * 4) : make_float4(0.f, 0.f, 0.f, 0.f);
                const float4 v2 = *(const float4*)(LWS + 63 * 68 + bq + q * 4);
                const float4 v3 = *(const float4*)(ASIG + bi * 68 + bq + q * 4);
                cs[q * 4] = v0.x; cs[q * 4 + 1] = v0.y; cs[q * 4 + 2] = v0.z; cs[q * 4 + 3] = v0.w;
                cm[q * 4] = v1.x; cm[q * 4 + 1] = v1.y; cm[q * 4 + 2] = v1.z; cm[q * 4 + 3] = v1.w;
                cc[q * 4] = v2.x; cc[q * 4 + 1] = v2.y; cc[q * 4 + 2] = v2.z; cc[q * 4 + 3] = v2.w;
                ag[q * 4] = v3.x; ag[q * 4 + 1] = v3.y; ag[q * 4 + 2] = v3.z; ag[q * 4 + 3] = v3.w;
            }
            __syncthreads();
            const float kkn = KKN[(size_t)rowb * 8 + h];
            float bon = 0.f;
#pragma unroll
            for (int hh = 0; hh < 2; ++hh) {
                float r8[8], k8[8], oa[8], ob[8], ok[8], orr[8];
                const int col = h * 64 + bq + hh * 8;
                xs8(P, mu, rowb, col, r8); xs8(P, mu, rowb, 512 + col, k8);
#pragma unroll
                for (int j = 0; j < 8; ++j) {
                    const int e = hh * 8 + j;
                    const float kk = k8[j] * kkw[col + j] * kkn;
                    const float kd = k8[j] * (1.f + (ag[e] - 1.f) * kaw[col + j]);
                    const float eneg = __expf(-cs[e]);
                    oa[j] = -kk * __expf(cm[e]); ob[j] = kk * ag[e] * eneg; ok[j] = kd * eneg; orr[j] = r8[j] * __builtin_amdgcn_rcpf(eneg);
                    bon += r8[j] * kd * rkw[col + j];
                }
                *(uint4*)(s0 + bi * SL + bq + hh * 8) = pack8(oa); *(uint4*)(s1 + bi * SL + bq + hh * 8) = pack8(ob);
                *(uint4*)(s2 + bi * SL + bq + hh * 8) = pack8(ok); *(uint4*)(s3 + bi * SL + bq + hh * 8) = pack8(orr);
            }
            bon += __shfl_xor(bon, 1); bon += __shfl_xor(bon, 2);
            if ((tid & 3) == 0) BON[((size_t)d * RT + rowb) * 8 + h] = bon;
            if (bi == 0) {
#pragma unroll
                for (int e = 0; e < 16; ++e) GAM[bq + e] = __expf(cc[e]);
            }
        }
        __syncthreads();
        {
            R1_IDX const int rowb = scan_row(b, d, c * 64 + bi); (void)rowb;
            f32x4 acc[4]; acc_zero(acc);
            mm64<SL, SL>(s1, s0, acc, wave, fr, fq);
            acc_mask<true>(acc, m, fq);
            st_rm(sa, acc, m, fq); st_tr(sb, acc, m, fq);
#pragma unroll
            for (int nt = 0; nt < 4; ++nt)
#pragma unroll
                for (int r = 0; r < 4; ++r) if (nt * 16 + fq * 4 + r == m) acc[nt][r] += 1.f;
            st_rm(sc, acc, m, fq);
        }
        __syncthreads();
#pragma unroll
        for (int itr = 0; itr < 5; ++itr) {
            R1_IDX
            bf16_t* ptr = (itr & 1) ? sT : sb;
            bf16_t* ptw = (itr & 1) ? sb : sT;
            f32x4 acc[4]; acc_zero(acc);
            mm64<SL, SL>(sa, ptr, acc, wave, fr, fq);
            st_rm(sa, acc, m, fq); st_tr(ptw, acc, m, fq);
            __syncthreads();
            f32x4 tacc[4];
#pragma unroll
            for (int nt = 0; nt < 4; ++nt) { const uint2 u = *(const uint2*)(sc + m * SL + nt * 16 + fq * 4); tacc[nt] = (f32x4){bflo(u.x), bfhi(u.x), bflo(u.y), bfhi(u.y)}; }
            mm64<SL, SL>(sc, ptw, tacc, wave, fr, fq);
            if (itr < 4) st_rm(sc, tacc, m, fq); else st_tr(sb, tacc, m, fq);
        }
        __syncthreads();
        {
            R1_IDX const int rowb = scan_row(b, d, c * 64 + bi); (void)rowb;
            f32x4 acc[4]; acc_zero(acc);
            mm64<SL, SL>(s2, s0, acc, wave, fr, fq);
            acc_mask<true>(acc, m, fq);
            st_rm(sa, acc, m, fq);
            float f0[8], f1[8];
            unpack8(*(const uint4*)(s0 + bi * SL + bq), f0); unpack8(*(const uint4*)(s0 + bi * SL + bq + 8), f1);
#pragma unroll
            for (int e = 0; e < 8; ++e) { sc[(bq + e) * SL + bi] = f2bf(f0[e]); sc[(bq + 8 + e) * SL + bi] = f2bf(f1[e]); }
        }
        __syncthreads();
        {
            R1_IDX const int rowb = scan_row(b, d, c * 64 + bi); (void)rowb;
            f32x4 acc[4]; acc_zero(acc);
            mm64<SL, SL>(sc, sb, acc, wave, fr, fq);
            st_rm(sT, acc, m, fq);
            acc_zero(acc);
            mm64<SL, SL>(sa, sb, acc, wave, fr, fq);
            st_rm(s0, acc, m, fq);
        }
        __syncthreads();
        f32x4 qacc[4];
        {
            R1_IDX const int rowb = scan_row(b, d, c * 64 + bi); (void)rowb;
            f32x4 acc[4]; acc_zero(acc);
            mm64<SL, SL>(s1, s3, acc, wave, fr, fq);
            acc_mask<false>(acc, m, fq);
            st_tr(sa, acc, m, fq);
            acc_zero(qacc);
            mm64<SL, SL>(s2, s3, qacc, wave, fr, fq);
            acc_mask<false>(qacc, m, fq);
            float f0[8], f1[8];
            unpack8(*(const uint4*)(s3 + bi * SL + bq), f0); unpack8(*(const uint4*)(s3 + bi * SL + bq + 8), f1);
#pragma unroll
            for (int e = 0; e < 8; ++e) { sc[(bq + e) * SL + bi] = f2bf(f0[e]); sc[(bq + 8 + e) * SL + bi] = f2bf(f1[e]); }
        }
        __syncthreads();
        {
            R1_IDX const int rowb = scan_row(b, d, c * 64 + bi); (void)rowb;
            f32x4 acc[4];
#pragma unroll
            for (int nt = 0; nt < 4; ++nt) { const uint2 u = *(const uint2*)(sc + m * SL + nt * 16 + fq * 4); acc[nt] = (f32x4){bflo(u.x), bfhi(u.x), bflo(u.y), bfhi(u.y)}; }
            mm64<SL, SL>(sT, sa, acc, wave, fr, fq);
            bf16_t* gt = gGT + (size_t)it * 4096;
#pragma unroll
            for (int nt = 0; nt < 4; ++nt)
#pragma unroll
                for (int r = 0; r < 4; ++r) gt[(nt * 16 + fq * 4 + r) * 64 + m] = f2bf(acc[nt][r]);
            mm64<SL, SL>(s0, sa, qacc, wave, fr, fq);
            st_tr(sb, qacc, m, fq);
            float f0[8], f1[8];
            unpack8(*(const uint4*)(s1 + bi * SL + bq), f0); unpack8(*(const uint4*)(s1 + bi * SL + bq + 8), f1);
#pragma unroll
            for (int e = 0; e < 8; ++e) { s3[(bq + e) * SL + bi] = f2bf(f0[e] * GAM[bq + e]); s3[(bq + 8 + e) * SL + bi] = f2bf(f1[e] * GAM[bq + 8 + e]); }
        }
        __syncthreads();
        {
            R1_IDX const int rowb = scan_row(b, d, c * 64 + bi); (void)rowb;
            f32x4 acc[4]; acc_zero(acc);
            mm64<SL, SL>(sT, s3, acc, wave, fr, fq);
            bf16_t* mt = gMT + (size_t)it * 4096;
#pragma unroll
            for (int nt = 0; nt < 4; ++nt)
#pragma unroll
                for (int r = 0; r < 4; ++r) { const int n = nt * 16 + fq * 4 + r; mt[n * 64 + m] = f2bf(acc[nt][r] + (n == m ? GAM[m] : 0.f)); }
#pragma unroll
            for (int nt = 0; nt < 4; ++nt) {
                const int n = nt * 16 + fq * 4; const uint2 u = *(const uint2*)(s2 + m * SL + n);
                acc[nt] = (f32x4){bflo(u.x) * GAM[n], bfhi(u.x) * GAM[n + 1], bflo(u.y) * GAM[n + 2], bfhi(u.y) * GAM[n + 3]};
            }
            mm64<SL, SL>(s0, s3, acc, wave, fr, fq);
            st_tr(s1, acc, m, fq);
            float v8[8];
#pragma unroll
            for (int hh = 0; hh < 2; ++hh) {
                xs8(P, mu, rowb, 1024 + h * 64 + bq + hh * 8, v8);
#pragma unroll
                for (int e = 0; e < 8; ++e) sc[(bq + hh * 8 + e) * SL + bi] = f2bf(v8[e]);
            }
        }
        __syncthreads();
        {
            R1_IDX const int rowb = scan_row(b, d, c * 64 + bi); (void)rowb;
            f32x4 acc[4]; acc_zero(acc);
            mm64<SL, SL>(sc, sb, acc, wave, fr, fq);
            bf16_t* yl = gYL + (size_t)it * 4096;
#pragma unroll
            for (int nt = 0; nt < 4; ++nt) store_bf16x4(yl + m * 64 + nt * 16 + fq * 4, acc[nt]);
            acc_zero(acc);
            mm64<SL, SL>(sc, s1, acc, wave, fr, fq);
            bf16_t* nl = gNL + (size_t)it * 4096;
#pragma unroll
            for (int nt = 0; nt < 4; ++nt) store_bf16x4(nl + m * 64 + nt * 16 + fq * 4, acc[nt]);
        }
        __syncthreads();
    }
}
__device__ __forceinline__ void ph_r2(const Params& p, char* smem) {
    const int tid = tidx(), lane = tid & 63, wave = tid >> 6, fr = lane & 15, fq = lane >> 4;
    const char* gMT = (const char*)(p.ws + O_X + X_MT); const char* gNL = (const char*)(p.ws + O_H);
    uint4* gS0 = (uint4*)(p.ws + O_X + X_S0);
    const int wofs = __builtin_amdgcn_readfirstlane(wave) * 1024;
    const unsigned lds0 = (unsigned)(uintptr_t)smem;
    const unsigned mtaddr = lds0 + fr * 128 + fq * 8, nladdr = lds0 + (wave * 16 + fr) * 128 + fq * 8;
    auto issue = [&](size_t cp, int slot) {
        char* dst = smem + slot * 16384 + wofs;
        const char* s0 = gMT + cp * 8192 + wofs + lane * 16; const char* s1 = gNL + cp * 8192 + wofs + lane * 16;
        __builtin_amdgcn_global_load_lds((const unsigned*)s0, (unsigned*)dst, 16, 0, 0);
        __builtin_amdgcn_global_load_lds((const unsigned*)(s0 + 4096), (unsigned*)(dst + 4096), 16, 0, 0);
        __builtin_amdgcn_global_load_lds((const unsigned*)s1, (unsigned*)(dst + 8192), 16, 0, 0);
        __builtin_amdgcn_global_load_lds((const unsigned*)(s1 + 4096), (unsigned*)(dst + 12288), 16, 0, 0);
    };
#define R2_READ(MX, NV, SLOT) do { \
        asm volatile("ds_read_b64 %0, %1 offset:0" : "=v"(MX[0][0][0]) : "v"(mtaddr + (SLOT) * 16384)); \
        asm volatile("ds_read_b64 %0, %1 offset:32" : "=v"(MX[0][0][1]) : "v"(mtaddr + (SLOT) * 16384)); \
        asm volatile("ds_read_b64 %0, %1 offset:64" : "=v"(MX[0][1][0]) : "v"(mtaddr + (SLOT) * 16384)); \
        asm volatile("ds_read_b64 %0, %1 offset:96" : "=v"(MX[0][1][1]) : "v"(mtaddr + (SLOT) * 16384)); \
        asm volatile("ds_read_b64 %0, %1 offset:8192" : "=v"(NV[0]) : "v"(nladdr + (SLOT) * 16384)); \
        asm volatile("ds_read_b64 %0, %1 offset:2048" : "=v"(MX[1][0][0]) : "v"(mtaddr + (SLOT) * 16384)); \
        asm volatile("ds_read_b64 %0, %1 offset:2080" : "=v"(MX[1][0][1]) : "v"(mtaddr + (SLOT) * 16384)); \
        asm volatile("ds_read_b64 %0, %1 offset:2112" : "=v"(MX[1][1][0]) : "v"(mtaddr + (SLOT) * 16384)); \
        asm volatile("ds_read_b64 %0, %1 offset:2144" : "=v"(MX[1][1][1]) : "v"(mtaddr + (SLOT) * 16384)); \
        asm volatile("ds_read_b64 %0, %1 offset:8224" : "=v"(NV[1]) : "v"(nladdr + (SLOT) * 16384)); \
        asm volatile("ds_read_b64 %0, %1 offset:4096" : "=v"(MX[2][0][0]) : "v"(mtaddr + (SLOT) * 16384)); \
        asm volatile("ds_read_b64 %0, %1 offset:4128" : "=v"(MX[2][0][1]) : "v"(mtaddr + (SLOT) * 16384)); \
        asm volatile("ds_read_b64 %0, %1 offset:4160" : "=v"(MX[2][1][0]) : "v"(mtaddr + (SLOT) * 16384)); \
        asm volatile("ds_read_b64 %0, %1 offset:4192" : "=v"(MX[2][1][1]) : "v"(mtaddr + (SLOT) * 16384)); \
        asm volatile("ds_read_b64 %0, %1 offset:8256" : "=v"(NV[2]) : "v"(nladdr + (SLOT) * 16384)); \
        asm volatile("ds_read_b64 %0, %1 offset:6144" : "=v"(MX[3][0][0]) : "v"(mtaddr + (SLOT) * 16384)); \
        asm volatile("ds_read_b64 %0, %1 offset:6176" : "=v"(MX[3][0][1]) : "v"(mtaddr + (SLOT) * 16384)); \
        asm volatile("ds_read_b64 %0, %1 offset:6208" : "=v"(MX[3][1][0]) : "v"(mtaddr + (SLOT) * 16384)); \
        asm volatile("ds_read_b64 %0, %1 offset:6240" : "=v"(MX[3][1][1]) : "v"(mtaddr + (SLOT) * 16384)); \
        asm volatile("ds_read_b64 %0, %1 offset:8288" : "=v"(NV[3]) : "v"(nladdr + (SLOT) * 16384)); \
        } while (0)
#define R2_PIN(MX, NV) asm volatile("" : "+v"(MX[0][0][0]), "+v"(MX[0][0][1]), "+v"(MX[0][1][0]), "+v"(MX[0][1][1]), "+v"(NV[0]), "+v"(MX[1][0][0]), "+v"(MX[1][0][1]), "+v"(MX[1][1][0]), "+v"(MX[1][1][1]), "+v"(NV[1]), "+v"(MX[2][0][0]), "+v"(MX[2][0][1]), "+v"(MX[2][1][0]), "+v"(MX[2][1][1]), "+v"(NV[2]), "+v"(MX[3][0][0]), "+v"(MX[3][0][1]), "+v"(MX[3][1][0]), "+v"(MX[3][1][1]), "+v"(NV[3]) :: "memory")
#define R2_STEP(MX, NV, MXN, NVN, J) do { const int c = c4 + (J); \
        asm volatile("s_waitcnt lgkmcnt(0)" ::: "memory");            \
        R2_PIN(MX, NV);                                                \
        asm volatile("s_waitcnt vmcnt(8)" ::: "memory");              \
        __builtin_amdgcn_s_barrier(); \
        asm volatile("" ::: "memory"); \
        R2_READ(MXN, NVN, ((J) + 1) & 3); \
        __builtin_amdgcn_sched_barrier(0); \
        u32x4 sb_[2]; \
        _Pragma("unroll") for (int s_ = 0; s_ < 2; ++s_) sb_[s_] = (u32x4){pack2(st[2 * s_][0], st[2 * s_][1]), pack2(st[2 * s_][2], st[2 * s_][3]), pack2(st[2 * s_ + 1][0], st[2 * s_ + 1][1]), pack2(st[2 * s_ + 1][2], st[2 * s_ + 1][3])}; \
        _Pragma("unroll") for (int tt = 0; tt < 4; ++tt) { \
            f32x4 acc_ = {bflo(NV[tt].x), bfhi(NV[tt].x), bflo(NV[tt].y), bfhi(NV[tt].y)}; \
            _Pragma("unroll") for (int s_ = 0; s_ < 2; ++s_) \
                acc_ = __builtin_amdgcn_mfma_f32_16x16x32_bf16(__builtin_bit_cast(bf16x8, (u32x4){MX[tt][s_][0].x, MX[tt][s_][0].y, MX[tt][s_][1].x, MX[tt][s_][1].y}), __builtin_bit_cast(bf16x8, sb_[s_]), acc_, 0, 0, 0); \
            st[tt] = acc_; } \
        *(u32x4*)(gS0 + ((cp0 + c) * 4 + wave) * 128 + lane) = sb_[0]; *(u32x4*)(gS0 + ((cp0 + c) * 4 + wave) * 128 + 64 + lane) = sb_[1]; \
        issue(cp0 + (c + 4 < 68 ? c + 4 : 67), (J)); } while (0)
    for (int it = blockIdx.x; it < 64; it += gridDim.x) {
        f32x4 st[4];
#pragma unroll
        for (int tt = 0; tt < 4; ++tt) st[tt] = (f32x4){0.f, 0.f, 0.f, 0.f};
        const size_t cp0 = (size_t)it * 68;
        issue(cp0, 0); issue(cp0 + 1, 1); issue(cp0 + 2, 2); issue(cp0 + 3, 3);
        uint2 mxA[4][2][2], nvA[4], mxB[4][2][2], nvB[4];
        asm volatile("s_waitcnt vmcnt(12)" ::: "memory");
        __builtin_amdgcn_s_barrier();
        asm volatile("" ::: "memory");
        R2_READ(mxA, nvA, 0);
        asm volatile("s_waitcnt lgkmcnt(0)" ::: "memory");
        R2_PIN(mxA, nvA);
        for (int c4 = 0; c4 < 68; c4 += 4) {
            R2_STEP(mxA, nvA, mxB, nvB, 0);
            R2_STEP(mxB, nvB, mxA, nvA, 1);
            R2_STEP(mxA, nvA, mxB, nvB, 2);
            R2_STEP(mxB, nvB, mxA, nvA, 3);
            asm volatile("s_waitcnt lgkmcnt(0)" ::: "memory");
            R2_PIN(mxA, nvA);
        }
        asm volatile("s_waitcnt vmcnt(0) lgkmcnt(0)" ::: "memory");
        __builtin_amdgcn_sched_barrier(0);
        __syncthreads();
    }
#undef R2_READ
#undef R2_PIN
#undef R2_STEP
}
__device__ __forceinline__ void ph_r3(const Params& p, int l, char* smem) {
    const int tid = tidx(), lane = tid & 63, wave = tid >> 6, fr = lane & 15, fq = lane >> 4;
    const bf16_t* P = (const bf16_t*)(p.ws + O_P); const float* mu = p.in[I_MU] + l * 1792;
    const float* gng = p.in[I_GNG] + l * 512; const float* gnb = p.in[I_GNB] + l * 512;
    const bf16_t* gGT = (const bf16_t*)(p.ws + O_X + X_GT); const bf16_t* gYL = (const bf16_t*)(p.ws + O_X + X_YL);
    const u32x4* gS0 = (const u32x4*)(p.ws + O_X + X_S0);
    const float* BON = (const float*)(p.ws + O_X + X_BON);
    const bf16_t* RG = (const bf16_t*)(p.ws + O_RG); bf16_t* RWO = (bf16_t*)(p.ws + O_RWO);
    float* YA = (float*)smem;
    float* YB = YA + 64 * 68;
    for (int it = blockIdx.x; it < 4 * 68 * 8; it += gridDim.x) {
        const int h = it & 7, c0 = (it >> 3) % 68, b = it / (68 * 8);
        const int c1 = c0 < 4 ? 3 - c0 : 71 - c0;
#pragma unroll
        for (int d = 0; d < 2; ++d) {
            const size_t cp = ((size_t)(b * 8 + h) * 2 + d) * 68 + (d == 0 ? c0 : c1);
            const bf16_t* gt = gGT + cp * 4096; const bf16_t* yl = gYL + cp * 4096;
            const u32x4 sb0 = gS0[(cp * 4 + wave) * 128 + lane], sb1 = gS0[(cp * 4 + wave) * 128 + 64 + lane];
            float* Y = d == 0 ? YA : YB;
#pragma unroll
            for (int tt = 0; tt < 4; ++tt) {
                const uint2 yv = *(const uint2*)(yl + (wave * 16 + fr) * 64 + tt * 16 + fq * 4);
                f32x4 acc = {bflo(yv.x), bfhi(yv.x), bflo(yv.y), bfhi(yv.y)};
#pragma unroll
                for (int s_ = 0; s_ < 2; ++s_) {
                    const bf16_t* q = gt + (tt * 16 + fr) * 64 + s_ * 32 + fq * 4;
                    const uint2 a0 = *(const uint2*)q, a1 = *(const uint2*)(q + 16);
                    acc = __builtin_amdgcn_mfma_f32_16x16x32_bf16(__builtin_bit_cast(bf16x8, (u32x4){a0.x, a0.y, a1.x, a1.y}), __builtin_bit_cast(bf16x8, s_ ? sb1 : sb0), acc, 0, 0, 0);
                }
#pragma unroll
                for (int r = 0; r < 4; ++r) {
                    const int t = tt * 16 + fq * 4 + r, i = d == 0 ? t : 63 - t;
                    Y[i * 68 + wave * 16 + fr] = acc[r];
                }
            }
        }
        __syncthreads();
        {
            const int i = tid >> 2, q4 = tid & 3, v0 = q4 * 16;
            const int row = scan_row(b, 0, c0 * 64 + i), col = h * 64 + v0;
            float y[16];
#pragma unroll
            for (int e4 = 0; e4 < 4; ++e4) {
                const float4 ya = *(const float4*)(YA + i * 68 + v0 + e4 * 4), yb = *(const float4*)(YB + i * 68 + v0 + e4 * 4);
                y[e4 * 4] = ya.x + yb.x; y[e4 * 4 + 1] = ya.y + yb.y; y[e4 * 4 + 2] = ya.z + yb.z; y[e4 * 4 + 3] = ya.w + yb.w;
            }
            float sm = 0.f;
#pragma unroll
            for (int e = 0; e < 16; ++e) sm += y[e];
            sm += __shfl_xor(sm, 1); sm += __shfl_xor(sm, 2);
            const float mean = sm * (1.f / 64.f);
            float vs = 0.f;
#pragma unroll
            for (int e = 0; e < 16; ++e) { const float dl = y[e] - mean; vs += dl * dl; }
            vs += __shfl_xor(vs, 1); vs += __shfl_xor(vs, 2);
            const float rstd = rsqrtf(vs * (1.f / 64.f) + 64e-5f);
            const float bs = BON[((size_t)0 * RT + row) * 8 + h] + BON[((size_t)1 * RT + row) * 8 + h];
#pragma unroll
            for (int hh = 0; hh < 2; ++hh) {
                float v8[8], g8[8], o[8];
                xs8(P, mu, row, 1024 + col + hh * 8, v8);
                unpack8(*(const uint4*)(RG + (size_t)row * 512 + col + hh * 8), g8);
#pragma unroll
                for (int e = 0; e < 8; ++e) o[e] = ((y[hh * 8 + e] - mean) * rstd * gng[col + hh * 8 + e] + gnb[col + hh * 8 + e] + bs * v8[e]) * g8[e];
                *(uint4*)(RWO + (size_t)row * 512 + col + hh * 8) = pack8(o);
            }
        }
        __syncthreads();
    }
}

__device__ __forceinline__ void ph_f1(const Params& p, int l, char* smem) {
    const bf16_t* P = (const bf16_t*)(p.ws + O_P); const bf16_t* CSC = (const bf16_t*)(p.ws + O_CSC);
    bf16_t* YT2 = (bf16_t*)(p.ws + O_YT2); bf16_t* YTC = (bf16_t*)(p.ws + O_YTC);
    const int nitems = 1024 + (l < NLAYER - 1 ? 64 : 0);
    for (int it = blockIdx.x; it < nitems; it += gridDim.x) {
        f32x4 acc[4][4];
        if (it < 1024) {
            const int b = it >> 8, g = (it >> 6) & 3, part = (it >> 5) & 1, j = it & 31;
            RPPlain rpa{CSC + (size_t)part * 128 * 128, 128};
            const bf16_t* pb = P + (size_t)b * SEQ * LDP + g * 128;
            auto rpb = [&](int r) -> const bf16_t* { return pb + (size_t)(64 * (r & 63) + 2 * j + (r >> 6)) * LDP; };
            gemm_core_gb<4>(rpa, rpb, 128, acc, smem);
            acc_foreach<4>(acc, [&](int m, int n, const f32x4& v) {
                const int t1 = n & 63, t2 = 2 * j + (n >> 6);
                store_bf16x4(YT2 + ((size_t)(b * 512 + g * 128 + m) * 64 + t2) * 128 + part * 64 + t1, v);
            });
        } else {
            const int jj = it - 1024, b = jj >> 4, g = (jj >> 2) & 3, part = (jj >> 1) & 1, nt = jj & 1;
            RPPlain rpa{CSC + (size_t)part * 128 * 128, 128};
            gemm_core_g<4>(rpa, P + (size_t)(RL + b * CTX + nt * 128) * LDP + g * 128, LDP, 128, acc, smem);
            acc_foreach<4>(acc, [&](int m, int n, const f32x4& v) {
                store_bf16x4(YTC + ((size_t)(b * 512 + g * 128 + m)) * 512 + part * 256 + nt * 128 + n, v);
            });
        }
    }
}
__device__ __forceinline__ void ph_fa(const Params& p, char* smem) {
    const bf16_t* YT2 = (const bf16_t*)(p.ws + O_YT2); const bf16_t* D128 = (const bf16_t*)(p.ws + O_D128);
    const float* TWC = (const float*)(p.ws + O_TWC); const float* TWS = (const float*)(p.ws + O_TWS);
    bf16_t* A2 = (bf16_t*)(p.ws + O_A2);
    for (int it = blockIdx.x; it < 1024; it += gridDim.x) {
        f32x4 acc[4][4];
        RPPlain rpa{D128, 128};
        gemm_core_g<4>(rpa, YT2 + (size_t)it * 128 * 128, 128, 128, acc, smem);
        const int lane = tidx() & 63, wave = tidx() >> 6, wr = wave >> 1, wc = wave & 1, fr = lane & 15, fq = lane >> 4;
        float* U = (float*)smem;
        if (wr == 1) {
#pragma unroll
            for (int i = 0; i < 4; ++i)
#pragma unroll
                for (int j = 0; j < 4; ++j) *(f32x4*)(U + (i * 16 + fr) * 132 + wc * 64 + j * 16 + fq * 4) = acc[i][j];
        }
        __syncthreads();
        if (wr == 0) {
#pragma unroll
            for (int i = 0; i < 4; ++i) {
                const int k1 = i * 16 + fr;
#pragma unroll
                for (int j = 0; j < 4; ++j) {
                    const int r = wc * 64 + j * 16 + fq * 4;
                    const int R = it * 128 + r, bn = R >> 6, t2 = R & 63, b = bn >> 9, n = bn & 511;
                    const f32x4 ai = *(const f32x4*)(U + k1 * 132 + r);
                    const f32x4 c = *(const f32x4*)(TWC + k1 * 64 + t2), sn = *(const f32x4*)(TWS + k1 * 64 + t2);
                    const f32x4 ar = acc[i][j];
                    const f32x4 pr = ar * c - ai * sn, pi = ar * sn + ai * c;
                    bf16_t* dst = A2 + ((size_t)(b * 64 + k1) * 512 + n) * 128 + t2;
                    store_bf16x4(dst, pr); store_bf16x4(dst + 64, pi);
                }
            }
        }
        __syncthreads();
    }
}
__device__ __forceinline__ void ph_fb(const Params& p, int l, char* smem) {
    const bf16_t* A2 = (const bf16_t*)(p.ws + O_A2); const bf16_t* E64 = (const bf16_t*)(p.ws + O_E64);
    const bf16_t* CST2 = (const bf16_t*)(p.ws + O_CST256); const bf16_t* YTC = (const bf16_t*)(p.ws + O_YTC);
    bf16_t* FA = (bf16_t*)(p.ws + O_FA);
    const int nitems = 1024 + (l < NLAYER - 1 ? 32 : 0);
    for (int it = blockIdx.x; it < nitems; it += gridDim.x) {
        if (it < 1024) {
            const int b = it >> 8, k1 = (it >> 2) & 63, nt = it & 3;
            f32x4 acc[2][4];
            RPPlain rpa{E64, 128};
            gemm_core_g<2>(rpa, A2 + ((size_t)(b * 64 + k1) * 512 + nt * 128) * 128, 128, 128, acc, smem);
            const float sc = 0.001381067932004975f;
            acc_foreach<2>(acc, [&](int m, int n, const f32x4& v) { f32x4 o = v * sc; store_bf16x4(FA + (size_t)(b * SEQ + k1 + 64 * m) * 512 + nt * 128 + n, o); });
        } else {
            const int j = it - 1024, b = j >> 3, mt = (j >> 2) & 1, nt = j & 3;
            f32x4 acc[4][4];
            RPPlain rp{CST2 + (size_t)mt * 128 * 512, 512};
            gemm_core_g<4>(rp, YTC + ((size_t)b * 512 + nt * 128) * 512, 512, 512, acc, smem);
            const float sc = 0.005524271728019903f;
            acc_foreach<4>(acc, [&](int m, int n, const f32x4& v) { f32x4 o = v * sc; store_bf16x4(FA + (size_t)(RL + b * CTX + mt * 128 + m) * 512 + nt * 128 + n, o); });
        }
    }
}

__device__ __forceinline__ void ph_mg(const Params& p, int l, char* smem) {
    const bf16_t* P = (const bf16_t*)(p.ws + O_P);
    const bf16_t* A0 = (const bf16_t*)(p.ws + O_FA); const bf16_t* A1 = (const bf16_t*)(p.ws + O_ATT); const bf16_t* A2 = (const bf16_t*)(p.ws + O_RWO);
    const bf16_t* W0 = (const bf16_t*)(p.ws + O_WB + W_PA); const bf16_t* W1 = (const bf16_t*)(p.ws + O_WB + W_PB); const bf16_t* W2 = (const bf16_t*)(p.ws + O_WB + W_PC);
    bf16_t* MG = (bf16_t*)(p.ws + O_H);
    const int nmt = (l < NLAYER - 1) ? RT / 128 : RL / 128;
    for (int it = blockIdx.x; it < nmt * 8; it += gridDim.x) {
        const int mt = it >> 3, nt = it & 7;
        f32x4 tot[4][4];
#pragma unroll
        for (int i = 0; i < 4; ++i)
#pragma unroll
            for (int j = 0; j < 4; ++j) tot[i][j] = (f32x4){0.f, 0.f, 0.f, 0.f};
#pragma unroll 1
        for (int br = 0; br < 3; ++br) {
            const bf16_t* Ab = br == 0 ? A0 : (br == 1 ? A1 : A2);
            const bf16_t* Wb = br == 0 ? W0 : (br == 1 ? W1 : W2);
            f32x4 acc[4][4];
            RPPlain rp{Ab + (size_t)mt * 128 * 512, 512};
            gemm_core_g<4>(rp, Wb + (size_t)nt * 128 * 512, 512, 512, acc, smem);
            const int lane = tidx() & 63, wave = tidx() >> 6, wr = wave >> 1, wc = wave & 1, fr = lane & 15, fq = lane >> 4;
#pragma unroll
            for (int i = 0; i < 4; ++i)
#pragma unroll
                for (int j = 0; j < 4; ++j) {
                    const int m = wr * 64 + i * 16 + fr, n = wc * 64 + j * 16 + fq * 4;
                    const uint2 gu = *(const uint2*)(P + (size_t)(mt * 128 + m) * LDP + PG0 + br * 1024 + nt * 128 + n);
                    tot[i][j][0] += bflo(gu.x) * acc[i][j][0]; tot[i][j][1] += bfhi(gu.x) * acc[i][j][1];
                    tot[i][j][2] += bflo(gu.y) * acc[i][j][2]; tot[i][j][3] += bfhi(gu.y) * acc[i][j][3];
                }
        }
        acc_foreach<4>(tot, [&](int m, int n, const f32x4& v) { store_bf16x4(MG + (size_t)(mt * 128 + m) * 1024 + nt * 128 + n, v); });
    }
}
__device__ __forceinline__ void ph_out(const Params& p, int l, char* smem) {
    const bf16_t* MG = (const bf16_t*)(p.ws + O_H); const bf16_t* W = (const bf16_t*)(p.ws + O_WB + W_OUT);
    float* xcur = (float*)(p.ws + O_XCUR); const float* mod = (const float*)(p.ws + O_MOD);
    const int nlat = 1024, nctx = (l < NLAYER - 1) ? (RC / 64) * 8 : 0;
    for (int it = blockIdx.x; it < nlat + nctx; it += gridDim.x) {
        if (it < nlat) {
            const int mt = it >> 3, nt = it & 7;
            f32x4 acc[4][4];
            RPPlain rp{MG + (size_t)mt * 128 * 1024, 1024};
            gemm_core_g<4>(rp, W + (size_t)nt * 128 * 1024, 1024, 1024, acc, smem);
            acc_foreach<4>(acc, [&](int m, int n, const f32x4& v) {
                const int row = mt * 128 + m, col = nt * 128 + n;
                const float4 g = *(const float4*)(mod + (size_t)(l * 5 + modidx(row)) * 6144 + 2048 + col);
                float4* xp = (float4*)(xcur + (size_t)row * 1024 + col);
                float4 x = *xp; x.x += g.x * v[0]; x.y += g.y * v[1]; x.z += g.z * v[2]; x.w += g.w * v[3]; *xp = x;
            });
        } else {
            const int j = it - nlat, mt = j >> 3, nt = j & 7;
            f32x4 acc[2][4];
            RPPlain rp{MG + (size_t)(RL + mt * 64) * 1024, 1024};
            gemm_core_g<2>(rp, W + (size_t)nt * 128 * 1024, 1024, 1024, acc, smem);
            acc_foreach<2>(acc, [&](int m, int n, const f32x4& v) {
                const int row = RL + mt * 64 + m, col = nt * 128 + n;
                const float4 g = *(const float4*)(mod + (size_t)(l * 5 + 4) * 6144 + 2048 + col);
                float4* xp = (float4*)(xcur + (size_t)row * 1024 + col);
                float4 x = *xp; x.x += g.x * v[0]; x.y += g.y * v[1]; x.z += g.z * v[2]; x.w += g.w * v[3]; *xp = x;
            });
        }
    }
}

__device__ __forceinline__ void ph_n2(const Params& p, int l, char* smem) {
    const int tid = tidx(), lane = tid & 63, wave = tid >> 6;
    unsigned* lcnt = (unsigned*)smem;
    unsigned* gbase = lcnt + 16;
    int* rec = (int*)(smem + 256);
    float4* rwl = (float4*)(smem + 8192);
    for (int idx = tid; idx < 4096; idx += 256) {
        const int k = idx >> 2, pp = idx & 3;
        rwl[(((k >> 8) * 16 + (k & 3) * 4 + pp) << 6) + ((k & 255) >> 2)] = *(const float4*)(p.in[I_RW] + (size_t)k * 16 + pp * 4);
    }
    if (tid < 16) lcnt[tid] = 0u;
    __syncthreads();
    int nrec = 0;
    const float* xcur = (const float*)(p.ws + O_XCUR); const float* mod = (const float*)(p.ws + O_MOD);
    bf16_t* H = (bf16_t*)(p.ws + O_H);
    unsigned* cnt = (unsigned*)(p.ws + O_CNT); int* LTOK = (int*)(p.ws + O_LTOK); float* LW = (float*)(p.ws + O_LW); int* SLOT = (int*)(p.ws + O_SLOT);
    const float* g = p.in[I_N2G] + l * 1024; const float* rw = p.in[I_RW]; const float* rb = p.in[I_RB];
    const int nrows = (l < NLAYER - 1) ? RT : RL;
    float4 vn[4];
    {
        const int r0 = blockIdx.x * 4 + wave;
        const float* x0 = xcur + (size_t)(r0 < nrows ? r0 : 0) * 1024;
#pragma unroll
        for (int i = 0; i < 4; ++i) vn[i] = *(const float4*)(x0 + lane * 4 + 256 * i);
    }
    for (int row = blockIdx.x * 4 + wave; row < nrows; row += gridDim.x * 4) {
        const float* md = mod + (size_t)(l * 5 + modidx(row)) * 6144;
        float4 v[4]; float ss = 0.f;
#pragma unroll
        for (int i = 0; i < 4; ++i) { v[i] = vn[i]; ss += v[i].x * v[i].x + v[i].y * v[i].y + v[i].z * v[i].z + v[i].w * v[i].w; }
        {
            const int rn = row + gridDim.x * 4;
            const float* xn = xcur + (size_t)(rn < nrows ? rn : row) * 1024;
#pragma unroll
            for (int i = 0; i < 4; ++i) vn[i] = *(const float4*)(xn + lane * 4 + 256 * i);
        }
        ss = wsum(ss);
        const float rstd = rsqrtf(ss * (1.f / 1024.f) + 1e-6f);
        float lg[16];
#pragma unroll
        for (int e = 0; e < 16; ++e) lg[e] = 0.f;
#pragma unroll
        for (int i = 0; i < 4; ++i) {
            const int c = lane * 4 + 256 * i;
            const float4 gg = *(const float4*)(g + c), sc = *(const float4*)(md + 4096 + c), sh = *(const float4*)(md + 3072 + c);
            const float hv[4] = {v[i].x * rstd * gg.x * (1.f + sc.x) + sh.x, v[i].y * rstd * gg.y * (1.f + sc.y) + sh.y,
                                 v[i].z * rstd * gg.z * (1.f + sc.z) + sh.z, v[i].w * rstd * gg.w * (1.f + sc.w) + sh.w};
            f32x4 h4 = {hv[0], hv[1], hv[2], hv[3]};
            store_bf16x4(H + (size_t)row * 1024 + c, h4);
#pragma unroll
            for (int j = 0; j < 4; ++j) {
                const float4* wr_ = rwl + ((i * 16 + j * 4) << 6) + lane;
                const float4 w0 = wr_[0], w1 = wr_[64], w2 = wr_[128], w3 = wr_[192];
                lg[0] += hv[j] * w0.x; lg[1] += hv[j] * w0.y; lg[2] += hv[j] * w0.z; lg[3] += hv[j] * w0.w;
                lg[4] += hv[j] * w1.x; lg[5] += hv[j] * w1.y; lg[6] += hv[j] * w1.z; lg[7] += hv[j] * w1.w;
                lg[8] += hv[j] * w2.x; lg[9] += hv[j] * w2.y; lg[10] += hv[j] * w2.z; lg[11] += hv[j] * w2.w;
                lg[12] += hv[j] * w3.x; lg[13] += hv[j] * w3.y; lg[14] += hv[j] * w3.z; lg[15] += hv[j] * w3.w;
            }
        }
        float sc_[16], sel[16];
#pragma unroll
        for (int e = 0; e < 16; ++e) { lg[e] = wsum(lg[e]); sc_[e] = 1.f / (1.f + expf(-lg[e])); sel[e] = sc_[e] + rb[e]; }
        int best = 0; float bestv = -1e30f;
#pragma unroll
        for (int gi = 0; gi < 4; ++gi) {
            float m1 = -1e30f, m2 = -1e30f;
#pragma unroll
            for (int j = 0; j < 4; ++j) { const float s = sel[gi * 4 + j]; if (s > m1) { m2 = m1; m1 = s; } else if (s > m2) m2 = s; }
            const float gs = m1 + m2;
            if (gs > bestv) { bestv = gs; best = gi; }
        }
        float s4[4] = {0.f, 0.f, 0.f, 0.f}, c4[4] = {0.f, 0.f, 0.f, 0.f};
#pragma unroll
        for (int gi = 0; gi < 4; ++gi)
#pragma unroll
            for (int j = 0; j < 4; ++j) if (gi == best) { s4[j] = sel[gi * 4 + j]; c4[j] = sc_[gi * 4 + j]; }
        int i1 = 0; float v1 = s4[0], w1 = c4[0];
#pragma unroll
        for (int j = 1; j < 4; ++j) if (s4[j] > v1) { v1 = s4[j]; i1 = j; w1 = c4[j]; }
        int i2 = -1; float v2 = -1e30f, w2 = 0.f;
#pragma unroll
        for (int j = 0; j < 4; ++j) if (j != i1 && s4[j] > v2) { v2 = s4[j]; i2 = j; w2 = c4[j]; }
        if (lane == 0) {
            const float inv = 1.f / (w1 + w2);
            const int e1 = best * 4 + i1, e2 = best * 4 + i2;
            const unsigned r1 = atomicAdd(&lcnt[e1], 1u), r2 = atomicAdd(&lcnt[e2], 1u);
            int* rc = rec + (wave * 32 + nrec) * 8;
            rc[0] = row; rc[1] = e1; rc[2] = e2; rc[3] = (int)r1; rc[4] = (int)r2; rc[5] = __float_as_int(w1 * inv); rc[6] = __float_as_int(w2 * inv);
        }
        ++nrec;
    }
    __syncthreads();
    if (tid < 16) gbase[tid] = lcnt[tid] ? atomicAdd(&cnt[tid], lcnt[tid]) : 0u;
    __syncthreads();
    for (int i = lane; i < nrec; i += 64) {
        const int* rc = rec + (wave * 32 + i) * 8;
        const int row = rc[0], e1 = rc[1], e2 = rc[2];
        const unsigned p1 = gbase[e1] + (unsigned)rc[3], p2 = gbase[e2] + (unsigned)rc[4];
        LTOK[(size_t)e1 * RT + p1] = row; LW[(size_t)e1 * RT + p1] = __int_as_float(rc[5]);
        LTOK[(size_t)e2 * RT + p2] = row; LW[(size_t)e2 * RT + p2] = __int_as_float(rc[6]);
        SLOT[row * 2] = (e1 << 20) | (int)p1; SLOT[row * 2 + 1] = (e2 << 20) | (int)p2;
    }
}

struct MoeTiles { int tb[17]; int sm; };
__device__ __forceinline__ void moe_tiles(const Params& p, int l, int* s_tb) {
    if (tidx() == 0) {
        const unsigned* cnt = (const unsigned*)(p.ws + O_CNT);
        int a = 0;
        for (int e = 0; e < 16; ++e) { s_tb[e] = a; a += ((int)cnt[e] + 127) >> 7; }
        s_tb[16] = a;
    }
    __syncthreads();
}
__device__ __forceinline__ void ph_e1(const Params& p, int l, char* smem) {
    int* s_tb = (int*)(smem + 73728);
    moe_tiles(p, l, s_tb);
    const bf16_t* H = (const bf16_t*)(p.ws + O_H); bf16_t* ACT = (bf16_t*)(p.ws + O_P);
    const unsigned* cnt = (const unsigned*)(p.ws + O_CNT); const int* LTOK = (const int*)(p.ws + O_LTOK); const float* LW = (const float*)(p.ws + O_LW);
    const int sm = (l < NLAYER - 1) ? RT / 128 : RL / 128;
    const int total = (sm + s_tb[16]) * 8;
    for (int it = blockIdx.x; it < total; it += gridDim.x) {
        const int mt = it >> 3, nt = it & 7;
        int e = 16, erow0 = mt * 128, lt = 0;
        if (mt >= sm) { const int q = mt - sm; e = 0; while (q >= s_tb[e + 1]) ++e; lt = q - s_tb[e]; erow0 = RT + q * 128; }
        const int cnte = (e == 16) ? 0 : (int)cnt[e];
        auto rp = [&](int r) -> const bf16_t* {
            if (e == 16) return H + (size_t)(mt * 128 + r) * 1024;
            const int idx = lt * 128 + r;
            const int tok = idx < cnte ? LTOK[(size_t)e * RT + idx] : 0;
            return H + (size_t)tok * 1024;
        };
        f32x4 acc[4][4];
        gemm_core_g<4>(rp, (const bf16_t*)(p.ws + O_WB + W_GU) + (size_t)e * 1024 * 1024 + (size_t)nt * 128 * 1024, 1024, 1024, acc, smem);
        {
            const int lane = tidx() & 63, wave = tidx() >> 6, wr = wave >> 1, wc = wave & 1, fr = lane & 15, fq = lane >> 4;
            float* U = (float*)smem;
#pragma unroll
            for (int ii = 0; ii < 2; ++ii) {
                const int i = wc == 0 ? 2 + ii : ii;
#pragma unroll
                for (int j = 0; j < 4; ++j) { const f32x4 gv = wc == 0 ? acc[2 + ii][j] : acc[ii][j]; *(f32x4*)(U + (wr * 64 + i * 16 + fr) * 68 + j * 16 + fq * 4) = gv; }
            }
            __syncthreads();
#pragma unroll
            for (int ii = 0; ii < 2; ++ii) {
                const int i = wc == 0 ? ii : 2 + ii;
                const int m = wr * 64 + i * 16 + fr;
                float wgt = 1.f;
                if (e != 16) { const int idx = lt * 128 + m; wgt = idx < cnte ? LW[(size_t)e * RT + idx] : 0.f; }
#pragma unroll
                for (int j = 0; j < 4; ++j) {
                    const f32x4 other = *(const f32x4*)(U + m * 68 + j * 16 + fq * 4);
                    f32x4 o;
                    const f32x4 mine = wc == 0 ? acc[ii][j] : acc[2 + ii][j];
#pragma unroll
                    for (int r = 0; r < 4; ++r) { const float g = wc == 0 ? mine[r] : other[r], u = wc == 0 ? other[r] : mine[r]; o[r] = siluf_(g) * u * wgt; }
                    store_bf16x4(ACT + (size_t)(erow0 + m) * 512 + nt * 64 + j * 16 + fq * 4, o);
                }
            }
            __syncthreads();
        }
    }
}
__device__ __forceinline__ void ph_e2(const Params& p, int l, char* smem) {
    int* s_tb = (int*)(smem + 73728);
    moe_tiles(p, l, s_tb);
    const bf16_t* ACT = (const bf16_t*)(p.ws + O_P); bf16_t* YE = (bf16_t*)(p.ws + O_X + X_YE);
    const int sm = (l < NLAYER - 1) ? RT / 128 : RL / 128;
    const int total = (sm + s_tb[16]) * 8;
    for (int it = blockIdx.x; it < total; it += gridDim.x) {
        const int mt = it >> 3, nt = it & 7;
        int e = 16, erow0 = mt * 128;
        if (mt >= sm) { const int q = mt - sm; e = 0; while (q >= s_tb[e + 1]) ++e; erow0 = RT + q * 128; }
        RPPlain rp{ACT + (size_t)erow0 * 512, 512};
        f32x4 acc[4][4];
        gemm_core_g<4>(rp, (const bf16_t*)(p.ws + O_WB + W_D) + (size_t)e * 1024 * 512 + (size_t)nt * 128 * 512, 512, 512, acc, smem);
        acc_foreach<4>(acc, [&](int m, int n, const f32x4& v) { store_bf16x4(YE + (size_t)(erow0 + m) * 1024 + nt * 128 + n, v); });
    }
}
__device__ __forceinline__ void ph_e3(const Params& p, int l, char* smem) {
    int* s_tb = (int*)(smem + 73728);
    moe_tiles(p, l, s_tb);
    const int lane = tidx() & 63, wave = tidx() >> 6;
    const bf16_t* YE = (const bf16_t*)(p.ws + O_X + X_YE); const int* SLOT = (const int*)(p.ws + O_SLOT);
    float* xcur = (float*)(p.ws + O_XCUR); const float* mod = (const float*)(p.ws + O_MOD);
    bf16_t* H = (bf16_t*)(p.ws + O_H);
    const bool last = l == NLAYER - 1;
    const int nrows = last ? RL : RT;
    const float* gn = last ? p.in[I_FNG] : p.in[I_N1G] + (l + 1) * 1024;
    const int stride = gridDim.x * 4, row0 = blockIdx.x * 4 + wave;
    auto slot_rows = [&](int row, size_t& r1, size_t& r2) {
        const int rr = row < nrows ? row : 0;
        const int s1 = SLOT[rr * 2], s2 = SLOT[rr * 2 + 1];
        r1 = (size_t)RT + s_tb[s1 >> 20] * 128 + (s1 & 0xfffff); r2 = (size_t)RT + s_tb[s2 >> 20] * 128 + (s2 & 0xfffff);
    };
    uint4 ya[2], yb[2], yd[2]; float4 xa[2][2];
    size_t r1n, r2n;
    auto load_row = [&](int row, size_t r1, size_t r2) {
        const size_t rr = row < nrows ? row : 0;
#pragma unroll
        for (int i = 0; i < 2; ++i) {
            const int c = lane * 8 + 512 * i;
            ya[i] = *(const uint4*)(YE + rr * 1024 + c); yb[i] = *(const uint4*)(YE + r1 * 1024 + c); yd[i] = *(const uint4*)(YE + r2 * 1024 + c);
            const float4* xp = (const float4*)(xcur + rr * 1024 + c);
            xa[i][0] = xp[0]; xa[i][1] = xp[1];
        }
    };
    { size_t r1, r2; slot_rows(row0, r1, r2); load_row(row0, r1, r2); slot_rows(row0 + stride, r1n, r2n); }
    for (int row = row0; row < nrows; row += stride) {
        const float* g2 = mod + (size_t)(l * 5 + modidx(row)) * 6144 + 5120;
        float xv[2][8]; float ss = 0.f;
#pragma unroll
        for (int i = 0; i < 2; ++i) {
            const int c = lane * 8 + 512 * i;
            float a[8], b[8], d[8];
            unpack8(ya[i], a); unpack8(yb[i], b); unpack8(yd[i], d);
            const float4 x0 = xa[i][0], x1 = xa[i][1];
            const float4 ga = *(const float4*)(g2 + c), gb = *(const float4*)(g2 + c + 4);
            const float xo[8] = {x0.x, x0.y, x0.z, x0.w, x1.x, x1.y, x1.z, x1.w}, gg[8] = {ga.x, ga.y, ga.z, ga.w, gb.x, gb.y, gb.z, gb.w};
#pragma unroll
            for (int e = 0; e < 8; ++e) { xv[i][e] = xo[e] + gg[e] * (a[e] + b[e] + d[e]); ss += xv[i][e] * xv[i][e]; }
            if (!last) { float4* xp = (float4*)(xcur + (size_t)row * 1024 + c); xp[0] = make_float4(xv[i][0], xv[i][1], xv[i][2], xv[i][3]); xp[1] = make_float4(xv[i][4], xv[i][5], xv[i][6], xv[i][7]); }
        }
        { const size_t r1 = r1n, r2 = r2n; load_row(row + stride, r1, r2); slot_rows(row + 2 * stride, r1n, r2n); }
        ss = wsum(ss);
        const float rstd = rsqrtf(ss * (1.f / 1024.f) + 1e-6f);
        const float* md = mod + (size_t)((l + 1) * 5 + modidx(row)) * 6144;
#pragma unroll
        for (int i = 0; i < 2; ++i) {
            const int c = lane * 8 + 512 * i;
            const float4 n0 = *(const float4*)(gn + c), n1 = *(const float4*)(gn + c + 4);
            const float nn[8] = {n0.x, n0.y, n0.z, n0.w, n1.x, n1.y, n1.z, n1.w};
            if (last) {
                float* op = p.out + (size_t)row * 1024 + c;
                *(float4*)op = make_float4(xv[i][0] * rstd * nn[0], xv[i][1] * rstd * nn[1], xv[i][2] * rstd * nn[2], xv[i][3] * rstd * nn[3]);
                *(float4*)(op + 4) = make_float4(xv[i][4] * rstd * nn[4], xv[i][5] * rstd * nn[5], xv[i][6] * rstd * nn[6], xv[i][7] * rstd * nn[7]);
            } else {
                const float4 c0 = *(const float4*)(md + 1024 + c), c1 = *(const float4*)(md + 1024 + c + 4), h0 = *(const float4*)(md + c), h1 = *(const float4*)(md + c + 4);
                const float sc[8] = {c0.x, c0.y, c0.z, c0.w, c1.x, c1.y, c1.z, c1.w}, sh[8] = {h0.x, h0.y, h0.z, h0.w, h1.x, h1.y, h1.z, h1.w};
                float o[8];
#pragma unroll
                for (int e = 0; e < 8; ++e) o[e] = xv[i][e] * rstd * nn[e] * (1.f + sc[e]) + sh[e];
                *(uint4*)(H + (size_t)row * 1024 + c) = pack8(o);
            }
        }
    }
}
constexpr int LDS_BYTES = 76800;
constexpr int NIV = 19;
extern __shared__ __attribute__((aligned(16))) char dynsmem[];
template <int ID> __device__ __forceinline__ void run_iv(const Params& pin, int l, char* smem) {
    Params p = pin; p.ws = launder(pin.ws);
    if constexpr (ID == 0) { ph_pre(p, smem); __syncthreads(); ph_w(p, 0, smem); }
    else if constexpr (ID == 1) ph_n1(p, l);
    else if constexpr (ID == 2) ph_g1(p, smem);
    else if constexpr (ID == 3) { ph_qu(p, smem); ph_krope(p); ph_rp1(p, l, smem); ph_rp2(p, l); ph_f1(p, l, smem); }
    else if constexpr (ID == 5) {
        const bool r1first = (blockIdx.x >> 8) & 1;
#pragma unroll 1
        for (int pass = 0; pass < 2; ++pass) {
            if ((pass == 0) == r1first) { ph_r1(p, l, smem); ph_fa(p, smem); } else ph_at(p, l, smem);
            __syncthreads();
        }
    }
    else if constexpr (ID == 8) { ph_r2(p, smem); __syncthreads(); ph_fb(p, l, smem); }
    else if constexpr (ID == 9) ph_r3(p, l, smem);
    else if constexpr (ID == 12) ph_mg(p, l, smem);
    else if constexpr (ID == 13) ph_out(p, l, smem);
    else if constexpr (ID == 14) ph_n2(p, l, smem);
    else if constexpr (ID == 15) ph_e1(p, l, smem);
    else if constexpr (ID == 16) ph_e2(p, l, smem);
    else if constexpr (ID == 17) { ph_e3(p, l, smem); __syncthreads(); if (l + 1 < NLAYER) ph_w(p, l + 1, smem); }
}
#if MEGA
#ifndef PROBE_MASK
#define PROBE_MASK 0
#define PROBE_REP 1
#endif
#define IV(ID) for (int r_ = 0; r_ < (((PROBE_MASK >> (ID)) & 1) ? PROBE_REP : 1); ++r_) { run_iv<ID>(p, l, smem); xcd_barrier(bar); }
__global__ void __launch_bounds__(256, 2) k_mega(Params p) {
    char* smem = dynsmem;
    volatile LAS unsigned* st = (volatile LAS unsigned*)(smem + LDS_BYTES - 16);
    if (tidx() == 0) { st[0] = 0u; st[1] = 0u; }
    __syncthreads();
    XcdBarrier bar = xcd_barrier_post((unsigned*)(p.ws + O_BAR), st);
    { const int l = 0; IV(0) }
    for (int l = 0; l < NLAYER; ++l) {
        if (l == 0) { IV(1) } IV(2) IV(3) IV(5) IV(8) IV(9) IV(12) IV(13) IV(14) IV(15) IV(16) IV(17)
    }
}
#else
template <int ID> __global__ void __launch_bounds__(256, 2) k_iv(Params p, int l) { run_iv<ID>(p, l, dynsmem); }
template <int ID> static void launch_iv(const Params& p, int l, int grid, hipStream_t s) {
    static bool once = false; if (!once) { once = true; (void)hipFuncSetAttribute((const void*)k_iv<ID>, hipFuncAttributeMaxDynamicSharedMemorySize, LDS_BYTES); }
    hipLaunchKernelGGL(k_iv<ID>, dim3(grid), dim3(256), LDS_BYTES, s, p, l);
}
#endif

extern "C" void kernel_launch(void* const* d_in, const int* in_sizes, int n_in, void* d_out, int out_size, void* d_ws, size_t ws_size, hipStream_t stream) {
    (void)in_sizes; (void)out_size;
    if (n_in < N_IN || ws_size < WS_NEED) return;
    Params p{};
    for (int i = 0; i < N_IN; ++i) p.in[i] = (const float*)d_in[i];
    p.out = (float*)d_out; p.ws = (char*)d_ws;
    static int grid = 0;
    if (!grid) {
        int dev = 0, cus = 0; (void)hipGetDevice(&dev); (void)hipDeviceGetAttribute(&cus, hipDeviceAttributeMultiprocessorCount, dev);
        int per_cu = 2;
#if MEGA
        (void)hipFuncSetAttribute((const void*)k_mega, hipFuncAttributeMaxDynamicSharedMemorySize, LDS_BYTES);
        int occ = 0; (void)hipOccupancyMaxActiveBlocksPerMultiprocessor(&occ, k_mega, 256, LDS_BYTES);
        if (occ < per_cu) per_cu = occ;
        if (per_cu < 1) per_cu = 1;
#endif
        grid = cus * per_cu;
    }
#if MEGA
    (void)hipMemsetAsync(p.ws + O_BAR, 0, 16384, stream);
    hipLaunchKernelGGL(k_mega, dim3(grid), dim3(256), LDS_BYTES, stream, p);
#else
    launch_iv<0>(p, 0, grid, stream);
    for (int l = 0; l < NLAYER; ++l) {
        if (l == 0) launch_iv<1>(p, l, grid, stream); launch_iv<2>(p, l, grid, stream); launch_iv<3>(p, l, grid, stream);
        launch_iv<5>(p, l, grid, stream); launch_iv<8>(p, l, grid, stream);
        launch_iv<9>(p, l, grid, stream); launch_iv<12>(p, l, grid, stream);
        launch_iv<13>(p, l, grid, stream); launch_iv<14>(p, l, grid, stream); launch_iv<15>(p, l, grid, stream); launch_iv<16>(p, l, grid, stream); launch_iv<17>(p, l, grid, stream);
    }
#endif
}
```

```cpp
#include <hip/hip_runtime.h>
#include <stdint.h>

#ifndef MEGA
#define MEGA 1
#endif

typedef unsigned short bf16_t;
typedef short bf16x8 __attribute__((ext_vector_type(8)));
typedef float f32x4 __attribute__((ext_vector_type(4)));
typedef float f32x2 __attribute__((ext_vector_type(2)));
typedef unsigned u32x4 __attribute__((ext_vector_type(4)));
typedef __bf16 bf16v2 __attribute__((ext_vector_type(2)));

constexpr int NLAYER = 4;
constexpr int DM = 1024;
constexpr int RL = 16384, RC = 1024, RT = RL + RC;
constexpr int SEQ = 4096, CTX = 256, KEYS = SEQ + CTX;
constexpr int LDP = 6144;
constexpr int PQ0 = 512, PKV0 = 896, PKR0 = 1152, PR0 = 1184, PG0 = 2976, PEND = 6048;
constexpr int NEXP = 16;
constexpr int EROWS = 54272;

enum { I_X = 0, I_C, I_CTX, I_CCTX, I_WADA, I_BADA, I_N1G, I_N2G, I_WIN, I_QNG, I_KVNG, I_WUQ, I_WUKV, I_MU, I_W0, I_WUP, I_A0, I_AUP, I_GUP,
       I_KK, I_KA, I_RK, I_GNG, I_GNB, I_WPA, I_WPB, I_WPC, I_WOUT, I_RW, I_RB, I_EG, I_EU, I_ED, I_SG, I_SU, I_SD, I_FNG, N_IN };

struct Params { const float* in[N_IN]; float* out; char* ws; };

constexpr size_t al256(size_t x) { return (x + 255) & ~(size_t)255; }
constexpr size_t O_BAR   = 0;
constexpr size_t O_CNT   = O_BAR + 16384;
constexpr size_t O_MOD   = O_CNT + 4096;
constexpr size_t O_ROPEC = O_MOD + (size_t)NLAYER * 5 * 6144 * 4;
constexpr size_t O_ROPES = O_ROPEC + (size_t)SEQ * 16 * 4;
constexpr size_t O_CSC   = O_ROPES + (size_t)SEQ * 16 * 4;
constexpr size_t O_CST256= O_CSC + 256 * 128 * 2;
constexpr size_t O_D128  = O_CST256 + 256 * 512 * 2;
constexpr size_t O_E64   = O_D128 + 128 * 128 * 2;
constexpr size_t O_TWC   = O_E64 + 64 * 128 * 2;
constexpr size_t O_TWS   = O_TWC + 64 * 64 * 4;
constexpr size_t O_YT2   = O_TWS + 64 * 64 * 4;
constexpr size_t O_A2    = O_YT2 + (size_t)4 * 512 * 64 * 128 * 2;
constexpr size_t O_YTC   = O_A2 + (size_t)4 * 512 * 64 * 128 * 2;
constexpr size_t O_XCUR  = O_YTC + (size_t)4 * 512 * 512 * 2;
constexpr size_t O_WB    = O_XCUR + (size_t)RT * DM * 4;
constexpr size_t W_IN   = 0;
constexpr size_t W_UQ   = W_IN + (size_t)6144 * 1024 * 2;
constexpr size_t W_UKV  = W_UQ + (size_t)768 * 384 * 2;
constexpr size_t W_WUP  = W_UKV + (size_t)1024 * 256 * 2;
constexpr size_t W_AUP  = W_WUP + (size_t)2 * 512 * 64 * 2;
constexpr size_t W_GUP  = W_AUP + (size_t)2 * 512 * 64 * 2;
constexpr size_t W_PA   = W_GUP + (size_t)512 * 128 * 2;
constexpr size_t W_PB   = W_PA + (size_t)1024 * 512 * 2;
constexpr size_t W_PC   = W_PB + (size_t)1024 * 512 * 2;
constexpr size_t W_OUT  = W_PC + (size_t)1024 * 512 * 2;
constexpr size_t W_GU   = W_OUT + (size_t)1024 * 1024 * 2;
constexpr size_t W_D    = W_GU + (size_t)17 * 1024 * 1024 * 2;
constexpr size_t W_END  = W_D + (size_t)17 * 1024 * 512 * 2;
constexpr size_t O_H    = O_WB + W_END;
constexpr size_t O_P    = O_H + (size_t)RT * DM * 2;
constexpr size_t O_ATT  = O_P + (size_t)RT * LDP * 2;
constexpr size_t O_RG   = O_ATT + (size_t)RT * 512 * 2;
constexpr size_t O_RWO  = O_RG + (size_t)RT * 512 * 2;
constexpr size_t O_FA   = O_RWO + (size_t)RT * 512 * 2;
constexpr size_t O_LTOK = O_FA + (size_t)RT * 512 * 2;
constexpr size_t O_LW   = O_LTOK + (size_t)NEXP * RT * 4;
constexpr size_t O_SLOT = O_LW + (size_t)NEXP * RT * 4;
constexpr size_t O_X    = al256(O_SLOT + (size_t)RT * 2 * 4);
constexpr size_t X_QA   = 0;
constexpr size_t X_KA   = X_QA + (size_t)RT * 768 * 2;
constexpr size_t X_VA   = X_KA + (size_t)4 * KEYS * 768 * 2;
constexpr int NCP = 4 * 8 * 2 * 68;
constexpr size_t X_S0   = 0;
constexpr size_t X_MT   = X_VA + (size_t)4 * 8 * 64 * KEYS * 2;
constexpr size_t X_GT   = X_MT + (size_t)NCP * 8192;
constexpr size_t X_YL   = X_GT + (size_t)NCP * 8192;
constexpr size_t X_KKN  = X_YL + (size_t)NCP * 8192;
constexpr size_t X_BON  = X_KKN + (size_t)RT * 8 * 4;
constexpr size_t X_SSQ  = X_BON + (size_t)2 * RT * 8 * 4;
constexpr size_t X_X12  = X_SSQ + (size_t)RT * 10 * 4;
constexpr size_t X_END  = X_X12 + (size_t)RT * 128 * 2;
static_assert(X_S0 + (size_t)NCP * 8192 <= X_VA, "S0 must fit in the q/k area");
constexpr size_t X_YE   = 0;
constexpr size_t WS_NEED = O_X + X_END;

__device__ __forceinline__ float bf2f(bf16_t u) { return __builtin_bit_cast(float, (unsigned)u << 16); }
__device__ __forceinline__ float bflo(unsigned u) { return __builtin_bit_cast(float, u << 16); }
__device__ __forceinline__ float bfhi(unsigned u) { return __builtin_bit_cast(float, u & 0xffff0000u); }
__device__ __forceinline__ unsigned pack2(float lo, float hi) { f32x2 v = {lo, hi}; bf16v2 b = __builtin_convertvector(v, bf16v2); return __builtin_bit_cast(unsigned, b); }
__device__ __forceinline__ bf16_t f2bf(float f) { return (bf16_t)(pack2(f, 0.f) & 0xffffu); }
__device__ __forceinline__ float wsum(float v) {
#pragma unroll
    for (int o = 32; o > 0; o >>= 1) v += __shfl_xor(v, o);
    return v;
}
__device__ __forceinline__ float sigmoidf_(float x) { return __builtin_amdgcn_rcpf(1.f + __expf(-x)); }
__device__ __forceinline__ float siluf_(float x) { return x * __builtin_amdgcn_rcpf(1.f + __expf(-x)); }
__device__ __forceinline__ int modidx(int row) { return row < RL ? (row >> 12) : 4; }
__device__ __forceinline__ void unpack8(const uint4& u, float (&f)[8]) {
    f[0] = bflo(u.x); f[1] = bfhi(u.x); f[2] = bflo(u.y); f[3] = bfhi(u.y); f[4] = bflo(u.z); f[5] = bfhi(u.z); f[6] = bflo(u.w); f[7] = bfhi(u.w);
}
__device__ __forceinline__ uint4 pack8(const float (&f)[8]) { return make_uint4(pack2(f[0], f[1]), pack2(f[2], f[3]), pack2(f[4], f[5]), pack2(f[6], f[7])); }

__device__ __forceinline__ float xmax_16_32(float v) {
    unsigned u = __builtin_bit_cast(unsigned, v);
    auto r = __builtin_amdgcn_permlane32_swap(u, u, false, false);
    float m = fmaxf(__builtin_bit_cast(float, r[0]), __builtin_bit_cast(float, r[1]));
    u = __builtin_bit_cast(unsigned, m);
    auto r2 = __builtin_amdgcn_permlane16_swap(u, u, false, false);
    return fmaxf(__builtin_bit_cast(float, r2[0]), __builtin_bit_cast(float, r2[1]));
}
__device__ __forceinline__ float lane_xor32(float v, int lane) {
    const unsigned u = __builtin_bit_cast(unsigned, v);
    auto r = __builtin_amdgcn_permlane32_swap(u, u, false, false);
    return __builtin_bit_cast(float, lane < 32 ? r[1] : r[0]);
}
__device__ __forceinline__ float xsum_16_32(float v) {
    unsigned u = __builtin_bit_cast(unsigned, v);
    auto r = __builtin_amdgcn_permlane32_swap(u, u, false, false);
    float m = __builtin_bit_cast(float, r[0]) + __builtin_bit_cast(float, r[1]);
    u = __builtin_bit_cast(unsigned, m);
    auto r2 = __builtin_amdgcn_permlane16_swap(u, u, false, false);
    return __builtin_bit_cast(float, r2[0]) + __builtin_bit_cast(float, r2[1]);
}
#define XB_TMO      128
#define XB_XCNT(j)  (256  + 64 * (j))
#define XB_XSUB(j)  (1280 + 64 * (j))
#define XB_XGEN(j)  (2304 + 64 * (j))
#define XB_TOP      3328
#define XB_TOPGEN   3392
#define XCD_BAR_WORDS 3456
#define XB_SPIN_CAP (1u << 22)
#define LAS __attribute__((address_space(3)))
__device__ __forceinline__ unsigned xb_ld(unsigned* p)              { return __hip_atomic_load(p, __ATOMIC_RELAXED, __HIP_MEMORY_SCOPE_AGENT); }
__device__ __forceinline__ unsigned xb_add(unsigned* p, unsigned v) { return __hip_atomic_fetch_add(p, v, __ATOMIC_RELAXED, __HIP_MEMORY_SCOPE_AGENT); }
__device__ __forceinline__ unsigned xb_xcc_id() { return (unsigned)__builtin_amdgcn_s_getreg((3 << 11) | 20) & 0xFu; }
#define XB_SPIN(cond, bar) do { unsigned _sp = 0; while (cond) { __builtin_amdgcn_s_sleep(1); \
    if ((++_sp & 255u) == 0u) { if (xb_ld(&(bar)[XB_TMO])) break; if (_sp > XB_SPIN_CAP) { atomicAdd(&(bar)[XB_TMO], 1u); break; } } } } while (0)
struct XcdBarrier { unsigned* bar; unsigned x; volatile LAS unsigned* st; };
__device__ __forceinline__ XcdBarrier xcd_barrier_post(unsigned* bar, volatile LAS unsigned* st) {
    XcdBarrier b; b.bar = bar; b.x = xb_xcc_id(); b.st = st;
    if (threadIdx.x == 0) (void)xb_add(&bar[XB_XCNT(b.x)], 1u);
    return b;
}
__device__ __forceinline__ void xcd_barrier_complete(unsigned* bar, unsigned x, unsigned& nloc, unsigned& nx) {
    const unsigned G = gridDim.x * gridDim.y * gridDim.z;
    unsigned sum, cnt, mine, sp = 0u;
    for (;;) {
        sum = 0u; cnt = 0u; mine = 0u;
#pragma unroll
        for (unsigned j = 0; j < 16; ++j) { const unsigned c = xb_ld(&bar[XB_XCNT(j)]); sum += c; cnt += (c > 0u) ? 1u : 0u; mine = (j == x) ? c : mine; }
        if (sum == G) break;
        __builtin_amdgcn_s_sleep(1);
        if ((++sp & 255u) == 0u) { if (xb_ld(&bar[XB_TMO])) break; if (sp > XB_SPIN_CAP) { atomicAdd(&bar[XB_TMO], 1u); break; } }
    }
    nloc = mine > 0u ? mine : 1u; nx = cnt > 0u ? cnt : 1u;
}
__device__ __forceinline__ void xcd_barrier(const XcdBarrier& b) {
    asm volatile("s_waitcnt vmcnt(0)" ::: "memory");
    __syncthreads();
    if (threadIdx.x == 0) {
        unsigned* bar = b.bar;
        __builtin_amdgcn_s_waitcnt(0);
        unsigned nloc = b.st[0], nx = b.st[1];
        if (nloc == 0u) { xcd_barrier_complete(bar, b.x, nloc, nx); b.st[0] = nloc; b.st[1] = nx; }
        const unsigned old = xb_add(&bar[XB_XSUB(b.x)], 1u);
        const unsigned gen = old / nloc;
        if (old + 1u == (gen + 1u) * nloc) {
            __builtin_amdgcn_fence(__ATOMIC_RELEASE, "agent");
            asm volatile("s_waitcnt vmcnt(0)" ::: "memory");
            const unsigned og = xb_add(&bar[XB_TOP], 1u);
            const unsigned tg = og / nx;
            if (og + 1u == (tg + 1u) * nx) xb_add(&bar[XB_TOPGEN], 1u);
            else XB_SPIN(xb_ld(&bar[XB_TOPGEN]) == tg, bar);
            __builtin_amdgcn_fence(__ATOMIC_ACQUIRE, "agent");
            xb_add(&bar[XB_XGEN(b.x)], 1u);
            asm volatile("s_waitcnt vmcnt(0)" ::: "memory");
        } else {
            XB_SPIN(xb_ld(&bar[XB_XGEN(b.x)]) == gen, bar);
            __builtin_amdgcn_fence(__ATOMIC_ACQUIRE, "agent");
            asm volatile("s_waitcnt vmcnt(0)" ::: "memory");
        }
    }
    __syncthreads();
}

__device__ __forceinline__ int tidx() { int t = threadIdx.x; asm volatile("" : "+v"(t)); return t; }
__device__ __forceinline__ int lv(int x) { asm volatile("" : "+v"(x)); return x; }
__device__ __forceinline__ char* launder(char* p) { size_t z = 0; asm volatile("" : "+s"(z)); return p + z; }

constexpr int LDSROW = 72;
template <int NA, class AL>
__device__ __forceinline__ void gc_load(const AL& al, const bf16_t* bp, size_t bstep, int k0, int kc, u32x4 (&ra)[NA], u32x4 (&rb)[4]) {
#pragma unroll
    for (int i = 0; i < NA; ++i) ra[i] = __builtin_bit_cast(u32x4, al.load(i, k0 + kc));
#pragma unroll
    for (int j = 0; j < 4; ++j) rb[j] = *(const u32x4*)(bp + j * bstep + k0);
}
template <int NA>
__device__ __forceinline__ void gc_store(bf16_t* Ab, bf16_t* Bb, int lr, int kc, const u32x4 (&ra)[NA], const u32x4 (&rb)[4]) {
#pragma unroll
    for (int i = 0; i < NA; ++i) *(u32x4*)(Ab + (lr + 32 * i) * LDSROW + kc) = ra[i];
#pragma unroll
    for (int j = 0; j < 4; ++j) *(u32x4*)(Bb + (lr + 32 * j) * LDSROW + kc) = rb[j];
}
template <int MI>
__device__ __forceinline__ void gc_compute(const bf16_t* Ac, const bf16_t* Bc, f32x4 (&acc)[MI][4]) {
#pragma unroll
    for (int kh = 0; kh < 2; ++kh) {
        bf16x8 af[MI], bfv[4];
#pragma unroll
        for (int i = 0; i < MI; ++i) af[i] = *(const bf16x8*)(Ac + i * 16 * LDSROW + kh * 32);
#pragma unroll
        for (int j = 0; j < 4; ++j) bfv[j] = *(const bf16x8*)(Bc + j * 16 * LDSROW + kh * 32);
#pragma unroll
        for (int i = 0; i < MI; ++i)
#pragma unroll
            for (int j = 0; j < 4; ++j) acc[i][j] = __builtin_amdgcn_mfma_f32_16x16x32_bf16(bfv[j], af[i], acc[i][j], 0, 0, 0);
    }
}
template <int MI, class AL>
__device__ __forceinline__ void gemm_core(const AL& al, const bf16_t* __restrict__ Bt, int ldb, int K, f32x4 (&acc)[MI][4], char* smem) {
    constexpr int TM = MI * 32;
    constexpr int NA = TM / 32;
    bf16_t* As = (bf16_t*)smem;
    bf16_t* Bs = As + 2 * TM * LDSROW;
    const int tid = tidx(), lane = tid & 63, wave = tid >> 6;
    const int wr = wave >> 1, wc = wave & 1, fr = lane & 15, fq = lane >> 4;
    const int kc = (tid & 7) * 8, lr = tid >> 3;
#pragma unroll
    for (int i = 0; i < MI; ++i)
#pragma unroll
        for (int j = 0; j < 4; ++j) acc[i][j] = (f32x4){0.f, 0.f, 0.f, 0.f};
    u32x4 a0[NA], b0[4], a1[NA], b1[4];
    const bf16_t* bp = Bt + (size_t)lr * ldb + kc;
    const size_t bstep = (size_t)32 * ldb;
    const int nk = K >> 6;
    bf16_t* As1 = As + TM * LDSROW; bf16_t* Bs1 = Bs + 128 * LDSROW;
    const int aoff = (wr * MI * 16 + fr) * LDSROW + fq * 8, boff = (wc * 64 + fr) * LDSROW + fq * 8;
    gc_load<NA>(al, bp, bstep, 0, kc, a0, b0);
    gc_store<NA>(As, Bs, lr, kc, a0, b0);
    if (nk > 1) gc_load<NA>(al, bp, bstep, 64, kc, a0, b0);
    __syncthreads();
    for (int kt = 0; kt < nk; kt += 2) {
        if (kt + 2 < nk) gc_load<NA>(al, bp, bstep, (kt + 2) << 6, kc, a1, b1);
        gc_compute<MI>(As + aoff, Bs + boff, acc);
        if (kt + 1 < nk) gc_store<NA>(As1, Bs1, lr, kc, a0, b0);
        __syncthreads();
        if (kt + 1 >= nk) break;
        if (kt + 3 < nk) gc_load<NA>(al, bp, bstep, (kt + 3) << 6, kc, a0, b0);
        gc_compute<MI>(As1 + aoff, Bs1 + boff, acc);
        if (kt + 2 < nk) gc_store<NA>(As, Bs, lr, kc, a1, b1);
        __syncthreads();
    }
}
template <int MI, class RP, class RPB>
__device__ __forceinline__ void gemm_core_gb(const RP& rp, const RPB& rpb, int K, f32x4 (&acc)[MI][4], char* smem) {
    constexpr int ABYTES = MI * 32 * 128;
    constexpr int SBYTES = ABYTES + 16384;
    const int tid = tidx(), lane = tid & 63, wave = tid >> 6;
    const int wr = wave >> 1, wc = wave & 1, fr = lane & 15, fq = lane >> 4;
    const int rr = lane >> 3, cs = ((lane & 7) ^ ((wave * 4 + (lane >> 4)) & 7)) * 8;
#pragma unroll
    for (int i = 0; i < MI; ++i)
#pragma unroll
        for (int j = 0; j < 4; ++j) acc[i][j] = (f32x4){0.f, 0.f, 0.f, 0.f};
    const bf16_t* ap[MI]; const bf16_t* bp[4];
#pragma unroll
    for (int i = 0; i < MI; ++i) { const int r = (i * 4 + wave) * 8 + rr; ap[i] = rp(r) + cs; }
#pragma unroll
    for (int i = 0; i < 4; ++i) { const int r = (i * 4 + wave) * 8 + rr; bp[i] = rpb(r) + cs; }
    const int wbase = __builtin_amdgcn_readfirstlane(wave) * 1024;
    const int nk = K >> 6;
    auto stage = [&](int buf, int kt) {
        char* Ab = smem + buf * SBYTES + wbase; char* Bb = Ab + ABYTES;
#pragma unroll
        for (int i = 0; i < MI; ++i) __builtin_amdgcn_global_load_lds((const unsigned*)(ap[i] + kt * 64), (unsigned*)(Ab + i * 4096), 16, 0, 0);
#pragma unroll
        for (int i = 0; i < 4; ++i) __builtin_amdgcn_global_load_lds((const unsigned*)(bp[i] + kt * 64), (unsigned*)(Bb + i * 4096), 16, 0, 0);
    };
    const int aoff = (wr * MI * 16 + fr) * 128, boff = ABYTES + (wc * 64 + fr) * 128, sw = fr >> 1;
    stage(0, 0);
    asm volatile("s_waitcnt vmcnt(0)" ::: "memory");
    __syncthreads();
    for (int kt = 0; kt < nk; ++kt) {
        const int cur = kt & 1;
        if (kt + 1 < nk) stage(cur ^ 1, kt + 1);
        const char* base = smem + cur * SBYTES;
#pragma unroll
        for (int kh = 0; kh < 2; ++kh) {
            const int xo = ((kh * 4 + fq) ^ sw) * 16;
            bf16x8 af[MI], bfv[4];
#pragma unroll
            for (int i = 0; i < MI; ++i) af[i] = *(const bf16x8*)(base + aoff + i * 2048 + xo);
#pragma unroll
            for (int j = 0; j < 4; ++j) bfv[j] = *(const bf16x8*)(base + boff + j * 2048 + xo);
#pragma unroll
            for (int i = 0; i < MI; ++i)
#pragma unroll
                for (int j = 0; j < 4; ++j) acc[i][j] = __builtin_amdgcn_mfma_f32_16x16x32_bf16(bfv[j], af[i], acc[i][j], 0, 0, 0);
        }
        asm volatile("s_waitcnt vmcnt(0)" ::: "memory");
        __syncthreads();
    }
}
struct RPPlain;
template <int MI, class RP>
__device__ __forceinline__ void gemm_core_g(const RP& rp, const bf16_t* __restrict__ Bt, int ldb, int K, f32x4 (&acc)[MI][4], char* smem);
struct RPPlain {
    const bf16_t* A; size_t lda;
    __device__ __forceinline__ const bf16_t* operator()(int r) const { return A + (size_t)r * lda; }
};
template <int MI, class RP>
__device__ __forceinline__ void gemm_core_g(const RP& rp, const bf16_t* __restrict__ Bt, int ldb, int K, f32x4 (&acc)[MI][4], char* smem) {
    RPPlain rpb{Bt, (size_t)ldb};
    gemm_core_gb<MI>(rp, rpb, K, acc, smem);
}
template <int MI, class F>
__device__ __forceinline__ void acc_foreach(const f32x4 (&acc)[MI][4], F f) {
    const int lane = tidx() & 63, wave = tidx() >> 6;
    const int wr = wave >> 1, wc = wave & 1, fr = lane & 15, fq = lane >> 4;
#pragma unroll
    for (int i = 0; i < MI; ++i)
#pragma unroll
        for (int j = 0; j < 4; ++j) f(wr * MI * 16 + i * 16 + fr, wc * 64 + j * 16 + fq * 4, acc[i][j]);
}
struct ALPlain {
    const bf16_t* p0; size_t step;
    __device__ __forceinline__ ALPlain(const bf16_t* A, int lda, int row0) { p0 = A + (size_t)(row0 + (tidx() >> 3)) * lda; step = (size_t)32 * lda; }
    __device__ __forceinline__ uint4 load(int i, int k) const { return *(const uint4*)(p0 + i * step + k); }
};
__device__ __forceinline__ void store_bf16x4(bf16_t* dst, const f32x4& v) { *(uint2*)dst = make_uint2(pack2(v[0], v[1]), pack2(v[2], v[3])); }

__device__ __forceinline__ void ph_pre(const Params& p, char* smem) {
    const int tid = tidx(), nb = gridDim.x, bid = blockIdx.x;
    float* mod = (float*)(p.ws + O_MOD);
    {
        float* sv = (float*)smem;
        float* part = sv + 5 * 1024;
        for (int i = tid; i < 5 * 1024; i += 256) { const float v = (i < 4096) ? p.in[I_C][i] : p.in[I_CCTX][i - 4096]; sv[i] = siluf_(v); }
        __syncthreads();
        for (int it = bid; it < NLAYER * 96; it += nb) {
            const int l = it / 96, jb = it % 96;
            const int jj = tid & 63, kq = tid >> 6, j = jb * 64 + jj;
            const float* w = p.in[I_WADA] + (size_t)l * 1024 * 6144 + (size_t)(kq * 256) * 6144 + j;
            float a0 = 0.f, a1 = 0.f, a2 = 0.f, a3 = 0.f, a4 = 0.f;
#pragma unroll 8
            for (int k = 0; k < 256; ++k) {
                const float wv = w[(size_t)k * 6144]; const int kk = kq * 256 + k;
                a0 += sv[kk] * wv; a1 += sv[1024 + kk] * wv; a2 += sv[2048 + kk] * wv; a3 += sv[3072 + kk] * wv; a4 += sv[4096 + kk] * wv;
            }
            part[(kq * 5 + 0) * 64 + jj] = a0; part[(kq * 5 + 1) * 64 + jj] = a1; part[(kq * 5 + 2) * 64 + jj] = a2;
            part[(kq * 5 + 3) * 64 + jj] = a3; part[(kq * 5 + 4) * 64 + jj] = a4;
            __syncthreads();
            for (int o = tid; o < 320; o += 256) {
                const int i = o >> 6, c = o & 63;
                const float s = part[(0 * 5 + i) * 64 + c] + part[(1 * 5 + i) * 64 + c] + part[(2 * 5 + i) * 64 + c] + part[(3 * 5 + i) * 64 + c];
                mod[(size_t)(l * 5 + i) * 6144 + jb * 64 + c] = s + p.in[I_BADA][l * 6144 + jb * 64 + c];
            }
            __syncthreads();
        }
    }
    {
        float4* xc = (float4*)(p.ws + O_XCUR);
        const float4* x4 = (const float4*)p.in[I_X]; const float4* c4 = (const float4*)p.in[I_CTX];
        for (size_t i = (size_t)bid * 256 + tid; i < (size_t)RT * 256; i += (size_t)nb * 256) xc[i] = (i < (size_t)RL * 256) ? x4[i] : c4[i - (size_t)RL * 256];
    }
    {
        float* ct = (float*)smem;
        __syncthreads();
        for (int m = tid; m < 4096; m += 256) ct[m] = cospif((float)m * (1.f / 2048.f));
        __syncthreads();
        bf16_t* cst2 = (bf16_t*)(p.ws + O_CST256);
        for (int ch = bid * 256 + tid; ch < 256 * 512 / 8; ch += nb * 256) {
            const int ks = ch >> 6, c0 = (ch & 63) * 8, part = c0 >> 8, s0 = c0 & 255;
            float f[8];
#pragma unroll
            for (int e = 0; e < 8; ++e) { const int m = (16 * ks * (s0 + e)) & 4095; f[e] = part == 0 ? ct[m] : ct[(m - 1024) & 4095]; }
            *(uint4*)(cst2 + ch * 8) = pack8(f);
        }
        bf16_t* d128 = (bf16_t*)(p.ws + O_D128);
        for (int ch = bid * 256 + tid; ch < 128 * 128 / 8; ch += nb * 256) {
            const int mrow = ch >> 4, c0 = (ch & 15) * 8, po = mrow >> 6, k1 = mrow & 63, pi = c0 >> 6, t10 = c0 & 63;
            float f[8];
#pragma unroll
            for (int e = 0; e < 8; ++e) {
                const int m = (64 * k1 * (t10 + e)) & 4095; const float cv = ct[m], sv = ct[(m - 1024) & 4095];
                f[e] = (po == pi) ? cv : (po == 0 ? sv : -sv);
            }
            *(uint4*)(d128 + ch * 8) = pack8(f);
        }
        bf16_t* e64 = (bf16_t*)(p.ws + O_E64);
        for (int ch = bid * 256 + tid; ch < 64 * 128 / 8; ch += nb * 256) {
            const int k2 = ch >> 4, c0 = (ch & 15) * 8, po = c0 >> 6, t20 = c0 & 63;
            float f[8];
#pragma unroll
            for (int e = 0; e < 8; ++e) { const int m = (64 * k2 * (t20 + e)) & 4095; f[e] = po == 0 ? ct[m] : ct[(m - 1024) & 4095]; }
            *(uint4*)(e64 + ch * 8) = pack8(f);
        }
        float* twc = (float*)(p.ws + O_TWC); float* tws = (float*)(p.ws + O_TWS);
        for (int i = bid * 256 + tid; i < 64 * 64; i += nb * 256) {
            const int k1 = i >> 6, t2 = i & 63, m = (k1 * t2) & 4095;
            twc[i] = ct[m]; tws[i] = -ct[(m - 1024) & 4095];
        }
        bf16_t* csc = (bf16_t*)(p.ws + O_CSC);
        for (int ch = bid * 256 + tid; ch < 256 * 128 / 8; ch += nb * 256) {
            const int n = ch >> 4, c0 = (ch & 15) * 8, part = n >> 7, kc = n & 127;
            float f[8];
#pragma unroll
            for (int e = 0; e < 8; ++e) { const int m = (32 * kc * (c0 + e)) & 4095; f[e] = part == 0 ? ct[m] : -ct[(m - 1024) & 4095]; }
            *(uint4*)(csc + ch * 8) = pack8(f);
        }
        float* rc = (float*)(p.ws + O_ROPEC); float* rs = (float*)(p.ws + O_ROPES);
        for (int i = bid * 256 + tid; i < SEQ * 16; i += nb * 256) {
            const int t = i >> 4, ax = (i >> 3) & 1, f = i & 7;
            const float inv = powf(10000.f, -(float)f / 8.f);
            const float pos = (float)(ax == 0 ? (t >> 6) : (t & 63));
            const float ang = pos * inv;
            rc[i] = cosf(ang); rs[i] = sinf(ang);
        }
    }
}

struct ConvTask { const float* src; const float* scale; bf16_t* dst; int K, Nsrc, Ndst, rmul; size_t sbs, dbs; };
__constant__ int c_conv_cum[17] = {0, 1536, 1608, 1672, 1688, 1704, 1720, 1848, 1976, 2104, 2360, 4408, 6456, 8504, 8632, 8760, 8888};
__device__ __forceinline__ ConvTask conv_task(const Params& p, int l, int t) {
    bf16_t* wb = (bf16_t*)(p.ws + O_WB);
    ConvTask c; c.scale = nullptr; c.sbs = 0; c.dbs = 0; c.rmul = 64;
    switch (t) {
    case 0:  c.src = p.in[I_WIN] + (size_t)l * 1024 * 6048; c.K = 1024; c.Nsrc = 6048; c.Ndst = 6144; c.dst = wb + W_IN / 2; break;
    case 1:  c.src = p.in[I_WUQ] + (size_t)l * 384 * 768; c.K = 384; c.Nsrc = 768; c.Ndst = 768; c.dst = wb + W_UQ / 2; c.scale = p.in[I_QNG] + l * 384; break;
    case 2:  c.src = p.in[I_WUKV] + (size_t)l * 256 * 1024; c.K = 256; c.Nsrc = 1024; c.Ndst = 1024; c.dst = wb + W_UKV / 2; c.scale = p.in[I_KVNG] + l * 256; break;
    case 3:  c.src = p.in[I_WUP] + (size_t)l * 2 * 64 * 512; c.K = 64; c.Nsrc = 512; c.Ndst = 512; c.dst = wb + W_WUP / 2; c.sbs = 64 * 512; c.dbs = 512 * 64; break;
    case 4:  c.src = p.in[I_AUP] + (size_t)l * 2 * 64 * 512; c.K = 64; c.Nsrc = 512; c.Ndst = 512; c.dst = wb + W_AUP / 2; c.sbs = 64 * 512; c.dbs = 512 * 64; break;
    case 5:  c.src = p.in[I_GUP] + (size_t)l * 128 * 512; c.K = 128; c.Nsrc = 512; c.Ndst = 512; c.dst = wb + W_GUP / 2; break;
    case 6:  c.src = p.in[I_WPA] + (size_t)l * 512 * 1024; c.K = 512; c.Nsrc = 1024; c.Ndst = 1024; c.dst = wb + W_PA / 2; break;
    case 7:  c.src = p.in[I_WPB] + (size_t)l * 512 * 1024; c.K = 512; c.Nsrc = 1024; c.Ndst = 1024; c.dst = wb + W_PB / 2; break;
    case 8:  c.src = p.in[I_WPC] + (size_t)l * 512 * 1024; c.K = 512; c.Nsrc = 1024; c.Ndst = 1024; c.dst = wb + W_PC / 2; break;
    case 9:  c.src = p.in[I_WOUT] + (size_t)l * 1024 * 1024; c.K = 1024; c.Nsrc = 1024; c.Ndst = 1024; c.dst = wb + W_OUT / 2; break;
    case 10: c.src = p.in[I_EG] + (size_t)l * 16 * 1024 * 512; c.K = 1024; c.Nsrc = 512; c.Ndst = 512; c.dst = wb + W_GU / 2; c.sbs = 1024 * 512; c.dbs = 1024 * 1024; c.rmul = 128; break;
    case 11: c.src = p.in[I_EU] + (size_t)l * 16 * 1024 * 512; c.K = 1024; c.Nsrc = 512; c.Ndst = 512; c.dst = wb + W_GU / 2 + 64 * 1024; c.sbs = 1024 * 512; c.dbs = 1024 * 1024; c.rmul = 128; break;
    case 12: c.src = p.in[I_ED] + (size_t)l * 16 * 512 * 1024; c.K = 512; c.Nsrc = 1024; c.Ndst = 1024; c.dst = wb + W_D / 2; c.sbs = 512 * 1024; c.dbs = 1024 * 512; break;
    case 13: c.src = p.in[I_SG] + (size_t)l * 1024 * 512; c.K = 1024; c.Nsrc = 512; c.Ndst = 512; c.dst = wb + W_GU / 2 + (size_t)16 * 1024 * 1024; c.rmul = 128; break;
    case 14: c.src = p.in[I_SU] + (size_t)l * 1024 * 512; c.K = 1024; c.Nsrc = 512; c.Ndst = 512; c.dst = wb + W_GU / 2 + (size_t)16 * 1024 * 1024 + 64 * 1024; c.rmul = 128; break;
    default: c.src = p.in[I_SD] + (size_t)l * 512 * 1024; c.K = 512; c.Nsrc = 1024; c.Ndst = 1024; c.dst = wb + W_D / 2 + (size_t)16 * 1024 * 512; break;
    }
    return c;
}
__device__ __forceinline__ void ph_w(const Params& p, int l, char* smem) {
    const int tid = tidx();
    float* tl = (float*)smem;
    for (int g = blockIdx.x; g < 8888; g += gridDim.x) {
        int t = 0;
        while (g >= c_conv_cum[t + 1]) ++t;
        const ConvTask c = conv_task(p, l, t);
        int r = g - c_conv_cum[t];
        const int nkt = c.K >> 6, nnt = c.Ndst >> 6;
        const int bi = r / (nkt * nnt); r -= bi * nkt * nnt;
        const int k0 = (r / nnt) * 64, n0 = (r % nnt) * 64;
        const float* src = c.src + bi * c.sbs; bf16_t* dst = c.dst + bi * c.dbs;
#pragma unroll
        for (int i = 0; i < 4; ++i) {
            const int k = (tid >> 4) + 16 * i, n = n0 + (tid & 15) * 4;
            float4 v = make_float4(0.f, 0.f, 0.f, 0.f);
            if (n < c.Nsrc) v = *(const float4*)(src + (size_t)(k0 + k) * c.Nsrc + n);
            if (c.scale) { const float s = c.scale[k0 + k]; v.x *= s; v.y *= s; v.z *= s; v.w *= s; }
            float* d = tl + k * 65 + (tid & 15) * 4;
            d[0] = v.x; d[1] = v.y; d[2] = v.z; d[3] = v.w;
        }
        __syncthreads();
        {
            const int n = tid >> 2, kk0 = (tid & 3) * 16;
            float f[8], g2[8];
#pragma unroll
            for (int j = 0; j < 8; ++j) { f[j] = tl[(kk0 + j) * 65 + n]; g2[j] = tl[(kk0 + 8 + j) * 65 + n]; }
            bf16_t* d = dst + (size_t)((n0 >> 6) * c.rmul + n) * c.K + k0 + kk0;
            *(uint4*)d = pack8(f); *(uint4*)(d + 8) = pack8(g2);
        }
        __syncthreads();
    }
}

__device__ __forceinline__ void ph_n1(const Params& p, int l) {
    const int lane = tidx() & 63, wave = tidx() >> 6;
    const float* xcur = (const float*)(p.ws + O_XCUR); const float* mod = (const float*)(p.ws + O_MOD);
    bf16_t* H = (bf16_t*)(p.ws + O_H);
    const float* g = p.in[I_N1G] + l * 1024;
    for (int row = blockIdx.x * 4 + wave; row < RT; row += gridDim.x * 4) {
        const float* x = xcur + (size_t)row * 1024; const float* md = mod + (size_t)(l * 5 + modidx(row)) * 6144;
        float4 v[4]; float ss = 0.f;
#pragma unroll
        for (int i = 0; i < 4; ++i) { v[i] = *(const float4*)(x + lane * 4 + 256 * i); ss += v[i].x * v[i].x + v[i].y * v[i].y + v[i].z * v[i].z + v[i].w * v[i].w; }
        ss = wsum(ss);
        const float rstd = rsqrtf(ss * (1.f / 1024.f) + 1e-6f);
#pragma unroll
        for (int i = 0; i < 4; ++i) {
            const int c = lane * 4 + 256 * i;
            const float4 gg = *(const float4*)(g + c), sc = *(const float4*)(md + 1024 + c), sh = *(const float4*)(md + c);
            f32x4 h = {v[i].x * rstd * gg.x * (1.f + sc.x) + sh.x, v[i].y * rstd * gg.y * (1.f + sc.y) + sh.y,
                       v[i].z * rstd * gg.z * (1.f + sc.z) + sh.z, v[i].w * rstd * gg.w * (1.f + sc.w) + sh.w};
            store_bf16x4(H + (size_t)row * 1024 + c, h);
        }
    }
}

__device__ __forceinline__ void ph_g1(const Params& p, char* smem) {
    if (blockIdx.x == 0 && tidx() < 64) ((unsigned*)(p.ws + O_CNT))[tidx()] = 0u;
    const bf16_t* H = (const bf16_t*)(p.ws + O_H); const bf16_t* W = (const bf16_t*)(p.ws + O_WB + W_IN);
    bf16_t* P = (bf16_t*)(p.ws + O_P);
    for (int it = blockIdx.x; it < 136 * 48; it += gridDim.x) {
        const int mt = it / 48, nt = it % 48;
        f32x4 acc[4][4];
        RPPlain rp{H + (size_t)mt * 128 * 1024, 1024};
        gemm_core_g<4>(rp, W + (size_t)nt * 128 * 1024, 1024, 1024, acc, smem);
        acc_foreach<4>(acc, [&](int m, int n, const f32x4& v) {
            const int col = nt * 128 + n; f32x4 o = v;
            if (col >= PG0 && col < PEND) { o[0] = sigmoidf_(v[0]); o[1] = sigmoidf_(v[1]); o[2] = sigmoidf_(v[2]); o[3] = sigmoidf_(v[3]); }
            store_bf16x4(P + (size_t)(mt * 128 + m) * LDP + col, o);
        });
        if (nt >= 4 && nt <= 8) {
            const int lane = tidx() & 63, wave = tidx() >> 6, wr = wave >> 1, wc = wave & 1, fr = lane & 15, fq = lane >> 4;
            float* SSQ = (float*)(p.ws + O_X + X_SSQ);
#pragma unroll
            for (int i = 0; i < 4; ++i) {
                float sq = 0.f;
#pragma unroll
                for (int j = 0; j < 4; ++j)
#pragma unroll
                    for (int r = 0; r < 4; ++r) sq += acc[i][j][r] * acc[i][j][r];
                sq = xsum_16_32(sq);
                if (fq == 0) SSQ[(size_t)(mt * 128 + wr * 64 + i * 16 + fr) * 10 + (nt - 4) * 2 + wc] = sq;
            }
        }
    }
}

constexpr float QSCALE = 0.10206207261596575f * 1.4426950408889634f;
__device__ __forceinline__ void ph_qu(const Params& p, char* smem) {
    const bf16_t* P = (const bf16_t*)(p.ws + O_P); const float* SSQ = (const float*)(p.ws + O_X + X_SSQ);
    bf16_t* QA = (bf16_t*)(p.ws + O_X + X_QA); bf16_t* KA = (bf16_t*)(p.ws + O_X + X_KA); bf16_t* VA = (bf16_t*)(p.ws + O_X + X_VA);
    const float* rc = (const float*)(p.ws + O_ROPEC); const float* rs = (const float*)(p.ws + O_ROPES);
    for (int it = blockIdx.x; it < 136 * 14; it += gridDim.x) {
        const int mt = it / 14, nn = it % 14;
        const int row0 = mt * 128;
        const bool lat = row0 < RL;
        const int b = lat ? (row0 >> 12) : ((row0 - RL) >> 8), t0 = lat ? (row0 & 4095) : ((row0 - RL) & 255);
        const size_t key0 = lat ? t0 : SEQ + t0;
        const int lane = tidx() & 63, wave = tidx() >> 6, wr = wave >> 1, wc = wave & 1, fr = lane & 15, fq = lane >> 4;
        f32x4 acc[4][4];
        if (nn < 6) {
            RPPlain rp{P + (size_t)row0 * LDP + PQ0, LDP};
            gemm_core_g<4>(rp, (const bf16_t*)(p.ws + O_WB + W_UQ) + (size_t)nn * 128 * 384, 384, 384, acc, smem);
#pragma unroll
            for (int i = 0; i < 4; ++i) {
                const int m = wr * 64 + i * 16 + fr, row = row0 + m, t = t0 + m;
                const float* sp = SSQ + (size_t)row * 10;
                const float rq = rsqrtf((sp[0] + sp[1] + sp[2] + sp[3] + sp[4] + sp[5]) * (1.f / 384.f) + 1e-6f);
#pragma unroll
                for (int j = 0; j < 4; ++j) {
                    const int n0 = nn * 128 + wc * 64 + j * 16, hg = (n0 >> 4) % 6;
                    f32x4 o = acc[i][j] * rq;
                    if (hg >= 4 && lat) {
                        const int ax = hg - 4, half = fq >> 1;
                        const float4 c4 = *(const float4*)(rc + t * 16 + ax * 8 + (fq & 1) * 4), s4 = *(const float4*)(rs + t * 16 + ax * 8 + (fq & 1) * 4);
                        const float cc[4] = {c4.x, c4.y, c4.z, c4.w}, ss[4] = {s4.x, s4.y, s4.z, s4.w};
#pragma unroll
                        for (int r = 0; r < 4; ++r) {
                            const float xp = lane_xor32(o[r], lane);
                            o[r] = half ? (o[r] * cc[r] + xp * ss[r]) : (o[r] * cc[r] - xp * ss[r]);
                        }
                    }
                    o *= QSCALE;
                    store_bf16x4(QA + (size_t)row * 768 + n0 + fq * 4, o);
                }
            }
        } else {
            const int h = nn - 6;
            RPPlain rp{P + (size_t)row0 * LDP + PKV0, LDP};
            gemm_core_g<4>(rp, (const bf16_t*)(p.ws + O_WB + W_UKV) + (size_t)h * 128 * 256, 256, 256, acc, smem);
            bf16_t* vt = (bf16_t*)smem;
#pragma unroll
            for (int i = 0; i < 4; ++i) {
                const int m = wr * 64 + i * 16 + fr, row = row0 + m;
                const float* sp = SSQ + (size_t)row * 10;
                const float rkv = rsqrtf((sp[6] + sp[7] + sp[8] + sp[9]) * (1.f / 256.f) + 1e-6f);
#pragma unroll
                for (int j = 0; j < 4; ++j) {
                    const f32x4 o = acc[i][j] * rkv;
                    if (wc == 0) store_bf16x4(KA + ((size_t)b * KEYS + key0 + m) * 768 + h * 96 + j * 16 + fq * 4, o);
                    else store_bf16x4(vt + m * 72 + j * 16 + fq * 4, o);
                }
            }
            __syncthreads();
#pragma unroll
            for (int u = 0; u < 4; ++u) {
                const int q = tidx() + 256 * u, dd = q >> 4, kc = q & 15;
                float f[8];
#pragma unroll
                for (int e = 0; e < 8; ++e) f[e] = bf2f(vt[(kc * 8 + e) * 72 + dd]);
                const uint4 uu = pack8(f);
                bf16_t* dst = VA + ((size_t)(b * 8 + h) * 64 + dd) * KEYS + key0 + (kc >> 2) * 32 + (kc & 1) * 16 + ((kc & 3) >> 1) * 4;
                *(uint2*)dst = make_uint2(uu.x, uu.y); *(uint2*)(dst + 8) = make_uint2(uu.z, uu.w);
            }
            __syncthreads();
        }
    }
}
__device__ __forceinline__ void ph_krope(const Params& p) {
    const int lane = tidx() & 63, wave = tidx() >> 6;
    const bf16_t* P = (const bf16_t*)(p.ws + O_P); bf16_t* KA = (bf16_t*)(p.ws + O_X + X_KA);
    const float* rc = (const float*)(p.ws + O_ROPEC); const float* rs = (const float*)(p.ws + O_ROPES);
    for (int row = blockIdx.x * 4 + wave; row < RT; row += gridDim.x * 4) {
        const bool lat = row < RL;
        const int b = lat ? (row >> 12) : ((row - RL) >> 8), t = lat ? (row & 4095) : ((row - RL) & 255);
        const size_t keyrow = (size_t)b * KEYS + (lat ? t : SEQ + t);
        const int ii = lane & 31, hh = lane >> 5;
        const bf16_t* pr = P + (size_t)row * LDP + PKR0;
        float x = bf2f(pr[ii]);
        if (lat) {
            const float xp = bf2f(pr[ii ^ 8]);
            const int ax = ii >> 4, half = (ii >> 3) & 1, f = ii & 7;
            const float c = rc[t * 16 + ax * 8 + f], sn = rs[t * 16 + ax * 8 + f];
            x = half ? (x * c + xp * sn) : (x * c - xp * sn);
        }
        const bf16_t xb = f2bf(x);
#pragma unroll
        for (int q = 0; q < 4; ++q) KA[keyrow * 768 + (hh * 4 + q) * 96 + 64 + ii] = xb;
    }
}

constexpr int KS_LD = 104, VT_LD = 72;
constexpr int AT_BUF = 64 * KS_LD * 2 + 64 * VT_LD * 2;
__device__ __forceinline__ void ph_at(const Params& p, int l, char* smem) {
    const int tid = tidx(), lane = tid & 63, wave = tid >> 6, fr = lane & 15, fq = lane >> 4;
    const bf16_t* QA = (const bf16_t*)(p.ws + O_X + X_QA); const bf16_t* KA = (const bf16_t*)(p.ws + O_X + X_KA); const bf16_t* VA = (const bf16_t*)(p.ws + O_X + X_VA);
    bf16_t* ATT = (bf16_t*)(p.ws + O_ATT);
    const int nitems = 1024 + (l < NLAYER - 1 ? 64 : 0);
    for (int it0 = blockIdx.x; it0 < nitems; it0 += gridDim.x) {
        int it = it0;
        if (gridDim.x == 512 && it0 < 1024) {
            const int x = it0 & 7, j = (it0 >> 3) & 63, rd = it0 >> 9;
            it = ((x * 4 + rd * 2 + (j >> 5)) << 5) | (j & 31);
        }
        int b, h, row0, ntile; size_t krow0;
        if (it < 1024) { b = it >> 8; h = (it >> 5) & 7; row0 = b * SEQ + (it & 31) * 128; krow0 = (size_t)b * KEYS; ntile = KEYS / 64; }
        else { const int j = it - 1024; b = j >> 4; h = (j >> 1) & 7; row0 = RL + b * CTX + (j & 1) * 128; krow0 = (size_t)b * KEYS + SEQ; ntile = CTX / 64; }
        const int qrow = row0 + wave * 32 + fr;
        const size_t vrow0 = (size_t)(b * 8 + h) * 64; const int koff0 = (int)(krow0 - (size_t)b * KEYS);
        bf16x8 qf[2][3];
#pragma unroll
        for (int t = 0; t < 2; ++t)
#pragma unroll
            for (int ks = 0; ks < 3; ++ks) qf[t][ks] = *(const bf16x8*)(QA + (size_t)(qrow + 16 * t) * 768 + h * 96 + ks * 32 + fq * 8);
        f32x4 ot[2][4];
#pragma unroll
        for (int t = 0; t < 2; ++t)
#pragma unroll
            for (int i = 0; i < 4; ++i) ot[t][i] = (f32x4){0.f, 0.f, 0.f, 0.f};
        float m_run[2] = {-1e30f, -1e30f}, l_run[2] = {0.f, 0.f};
        uint4 rk0, rk1, rk2, rv0, rv1;
#define AT_GLOAD(KT) do { const size_t kr_ = krow0 + (size_t)(KT) * 64; \
            { const int c = tid, key = c / 12, part = c % 12; rk0 = *(const uint4*)(KA + (kr_ + key) * 768 + h * 96 + part * 8); } \
            { const int c = tid + 256, key = c / 12, part = c % 12; rk1 = *(const uint4*)(KA + (kr_ + key) * 768 + h * 96 + part * 8); } \
            { const int c = tid + 512, key = c / 12, part = c % 12; rk2 = *(const uint4*)(KA + (kr_ + key) * 768 + h * 96 + part * 8); } \
            { const int c = tid, dd_ = c >> 3, part = c & 7; rv0 = *(const uint4*)(VA + (vrow0 + dd_) * KEYS + koff0 + (KT) * 64 + part * 8); } \
            { const int c = tid + 256, dd_ = c >> 3, part = c & 7; rv1 = *(const uint4*)(VA + (vrow0 + dd_) * KEYS + koff0 + (KT) * 64 + part * 8); } } while (0)
#define AT_VSTORE(RV, C) do { const int dd_ = (C) >> 3, part = (C) & 7; *(uint4*)(Vt_ + dd_ * VT_LD + part * 8) = RV; } while (0)
#define AT_SSTORE(BUF) do { bf16_t* Ks_ = (bf16_t*)(smem + (BUF) * AT_BUF); bf16_t* Vt_ = Ks_ + 64 * KS_LD; \
            { const int c = tid, key = c / 12, part = c % 12; *(uint4*)(Ks_ + key * KS_LD + part * 8) = rk0; } \
            { const int c = tid + 256, key = c / 12, part = c % 12; *(uint4*)(Ks_ + key * KS_LD + part * 8) = rk1; } \
            { const int c = tid + 512, key = c / 12, part = c % 12; *(uint4*)(Ks_ + key * KS_LD + part * 8) = rk2; } \
            AT_VSTORE(rv0, tid); AT_VSTORE(rv1, tid + 256); } while (0)
        AT_GLOAD(0); AT_SSTORE(0);
        __syncthreads();
        for (int kt = 0; kt < ntile; ++kt) {
            const int cur = kt & 1;
            if (kt + 1 < ntile) AT_GLOAD(kt + 1);
            __builtin_amdgcn_sched_barrier(0);
            const bf16_t* Ks = (const bf16_t*)(smem + cur * AT_BUF); const bf16_t* Vt = Ks + 64 * KS_LD;
            f32x4 st[2][4];
#pragma unroll
            for (int jh = 0; jh < 2; ++jh) {
                bf16x8 kf[2][3];
#pragma unroll
                for (int jj = 0; jj < 2; ++jj)
#pragma unroll
                    for (int ks = 0; ks < 3; ++ks) kf[jj][ks] = *(const bf16x8*)(Ks + ((jh * 2 + jj) * 16 + fr) * KS_LD + ks * 32 + fq * 8);
#pragma unroll
                for (int jj = 0; jj < 2; ++jj) {
                    const int j = jh * 2 + jj;
                    st[0][j] = (f32x4){0.f, 0.f, 0.f, 0.f}; st[1][j] = (f32x4){0.f, 0.f, 0.f, 0.f};
#pragma unroll
                    for (int ks = 0; ks < 3; ++ks) {
                        st[0][j] = __builtin_amdgcn_mfma_f32_16x16x32_bf16(kf[jj][ks], qf[0][ks], st[0][j], 0, 0, 0);
                        st[1][j] = __builtin_amdgcn_mfma_f32_16x16x32_bf16(kf[jj][ks], qf[1][ks], st[1][j], 0, 0, 0);
                    }
                }
            }
            bf16x8 vf[2][4];
#pragma unroll
            for (int k2 = 0; k2 < 2; ++k2)
#pragma unroll
                for (int dt = 0; dt < 4; ++dt) {
                    vf[k2][dt] = *(const bf16x8*)(Vt + (dt * 16 + fr) * VT_LD + k2 * 32 + fq * 8);
                }
            uint4 pu[2][2];
#pragma unroll
            for (int t = 0; t < 2; ++t) {
                float mx = st[t][0][0];
#pragma unroll
                for (int j = 0; j < 4; ++j)
#pragma unroll
                    for (int r = 0; r < 4; ++r) mx = fmaxf(mx, st[t][j][r]);
                if (__any(mx > m_run[t] + 6.f)) {
                    mx = xmax_16_32(mx);
                    const float m_new = fmaxf(m_run[t], mx);
                    const float alpha = __builtin_amdgcn_exp2f(m_run[t] - m_new);
                    m_run[t] = m_new;
                    l_run[t] *= alpha;
#pragma unroll
                    for (int i = 0; i < 4; ++i) ot[t][i] *= alpha;
                }
                const float mr = m_run[t];
                float ps = 0.f;
#pragma unroll
                for (int j = 0; j < 4; ++j)
#pragma unroll
                    for (int r = 0; r < 4; ++r) { st[t][j][r] = __builtin_amdgcn_exp2f(st[t][j][r] - mr); ps += st[t][j][r]; }
                l_run[t] += ps;
#pragma unroll
                for (int k2 = 0; k2 < 2; ++k2)
                    pu[t][k2] = make_uint4(pack2(st[t][2 * k2][0], st[t][2 * k2][1]), pack2(st[t][2 * k2][2], st[t][2 * k2][3]),
                                           pack2(st[t][2 * k2 + 1][0], st[t][2 * k2 + 1][1]), pack2(st[t][2 * k2 + 1][2], st[t][2 * k2 + 1][3]));
            }
#pragma unroll
            for (int k2 = 0; k2 < 2; ++k2) {
                const bf16x8 pb0 = __builtin_bit_cast(bf16x8, pu[0][k2]), pb1 = __builtin_bit_cast(bf16x8, pu[1][k2]);
#pragma unroll
                for (int dt = 0; dt < 4; ++dt) {
                    ot[0][dt] = __builtin_amdgcn_mfma_f32_16x16x32_bf16(vf[k2][dt], pb0, ot[0][dt], 0, 0, 0);
                    ot[1][dt] = __builtin_amdgcn_mfma_f32_16x16x32_bf16(vf[k2][dt], pb1, ot[1][dt], 0, 0, 0);
                }
            }
            if (kt + 1 < ntile) AT_SSTORE(cur ^ 1);
            __syncthreads();
        }
#pragma unroll
        for (int t = 0; t < 2; ++t) {
            const float inv = 1.f / xsum_16_32(l_run[t]);
#pragma unroll
            for (int dt = 0; dt < 4; ++dt) { f32x4 o = ot[t][dt] * inv; store_bf16x4(ATT + (size_t)(qrow + 16 * t) * 512 + h * 64 + dt * 16 + fq * 4, o); }
        }
    }
}

__device__ __forceinline__ void row_edges(int row, bool& first, bool& last) {
    if (row < RL) { const int t = row & 4095; first = t == 0; last = t == 4095; }
    else { const int s = (row - RL) & 255; first = s == 0; last = s == 255; }
}
__device__ __forceinline__ float xs1(const bf16_t* P, const float* mu, int row, int col) {
    bool first, last; row_edges(row, first, last);
    const bf16_t* pc = P + (size_t)row * LDP + PR0 + col;
    const float c = bf2f(*pc), pv0 = bf2f(*(first ? pc : pc - LDP)), nx0 = bf2f(*(last ? pc : pc + LDP));
    const float pv = first ? 0.f : pv0, nx = last ? 0.f : nx0;
    return c + (0.5f * (pv + nx) - c) * mu[col];
}
__device__ __forceinline__ void xs8(const bf16_t* P, const float* mu, int row, int col, float (&o)[8]) {
    bool first, last; row_edges(row, first, last);
    const bf16_t* pc = P + (size_t)row * LDP + PR0 + col;
    const uint4 uc = *(const uint4*)pc, up = *(const uint4*)(first ? pc : pc - LDP), un = *(const uint4*)(last ? pc : pc + LDP);
    float c[8], pv[8], nx[8]; unpack8(uc, c); unpack8(up, pv); unpack8(un, nx);
    const float fp = first ? 0.f : 0.5f, fn = last ? 0.f : 0.5f;
    const float4 m0 = *(const float4*)(mu + col), m1 = *(const float4*)(mu + col + 4);
    const float m[8] = {m0.x, m0.y, m0.z, m0.w, m1.x, m1.y, m1.z, m1.w};
#pragma unroll
    for (int j = 0; j < 8; ++j) o[j] = c[j] + ((fp * pv[j] + fn * nx[j]) - c[j]) * m[j];
}
struct ALRw {
    const bf16_t* P; const float* mu; int row0; int colbase, mode;
    __device__ __forceinline__ ALRw(const bf16_t* P_, const float* mu_, int row0_, int colbase_, int mode_) : P(P_), mu(mu_), colbase(colbase_), mode(mode_) {
        row0 = row0_ + (tidx() >> 3);
    }
    __device__ __forceinline__ uint4 load(int i, int k) const {
        float o[8]; xs8(P, mu, row0 + 32 * i, colbase + k, o);
        if (mode == 0) {
#pragma unroll
            for (int j = 0; j < 8; ++j) o[j] = tanhf(o[j]);
        } else if (mode == 2) {
#pragma unroll
            for (int j = 0; j < 8; ++j) o[j] = sigmoidf_(o[j]);
        }
        return pack8(o);
    }
};
__device__ __forceinline__ void ph_rp1(const Params& p, int l, char* smem) {
    const bf16_t* P = (const bf16_t*)(p.ws + O_P); const float* mu = p.in[I_MU] + l * 1792;
    bf16_t* RG = (bf16_t*)(p.ws + O_RG);
    for (int it = gridDim.x - 1 - blockIdx.x; it < 1088; it += gridDim.x) {
        const int mt = it >> 2, nt = it & 3;
        f32x4 acc[2][4];
        ALRw al(P, mu, mt * 64, 1664, 2);
        gemm_core<2>(al, (const bf16_t*)(p.ws + O_WB + W_GUP) + (size_t)nt * 128 * 128, 128, 128, acc, smem);
        acc_foreach<2>(acc, [&](int m, int n, const f32x4& v) { store_bf16x4(RG + (size_t)(mt * 64 + m) * 512 + nt * 128 + n, v); });
    }
}
__device__ __forceinline__ void ph_rp2(const Params& p, int l) {
    const int lane = tidx() & 63, wave = tidx() >> 6;
    const bf16_t* P = (const bf16_t*)(p.ws + O_P); const float* mu = p.in[I_MU] + l * 1792; const float* kkw = p.in[I_KK] + l * 512;
    float* KKN = (float*)(p.ws + O_X + X_KKN); bf16_t* X12 = (bf16_t*)(p.ws + O_X + X_X12);
    for (int row = blockIdx.x * 4 + wave; row < RT; row += gridDim.x * 4) {
        float k8[8]; xs8(P, mu, row, 512 + lane * 8, k8);
        float x8[8]; xs8(P, mu, row, 1536 + (lane & 15) * 8, x8);
        float s = 0.f;
#pragma unroll
        for (int j = 0; j < 8; ++j) { const float v = k8[j] * kkw[lane * 8 + j]; s += v * v; }
        s += __shfl_xor(s, 1); s += __shfl_xor(s, 2); s += __shfl_xor(s, 4);
        if ((lane & 7) == 0) KKN[(size_t)row * 8 + (lane >> 3)] = rsqrtf(s + 1e-12f);
        if (lane < 8) {
#pragma unroll
            for (int j = 0; j < 8; ++j) x8[j] = 1.f - 2.f * __builtin_amdgcn_rcpf(1.f + __expf(2.f * x8[j]));
        }
        if (lane < 16) *(uint4*)(X12 + (size_t)row * 128 + lane * 8) = pack8(x8);
    }
}

__device__ __forceinline__ int scan_row(int b, int d, int n) {
    if (n < CTX) return RL + b * CTX + (d == 0 ? n : CTX - 1 - n);
    const int t = n - CTX; return b * SEQ + (d == 0 ? t : SEQ - 1 - t);
}
constexpr int SL = 72;
constexpr int SLOT_E = 64 * SL;
template <int LDA, int LDB>
__device__ __forceinline__ void mm64(const bf16_t* A, const bf16_t* B, f32x4 (&acc)[4], int wave, int fr, int fq) {
#pragma unroll
    for (int ks = 0; ks < 2; ++ks) {
        const bf16x8 af = *(const bf16x8*)(A + (wave * 16 + fr) * LDA + ks * 32 + fq * 8);
#pragma unroll
        for (int nt = 0; nt < 4; ++nt) {
            const bf16x8 bfv = *(const bf16x8*)(B + (nt * 16 + fr) * LDB + ks * 32 + fq * 8);
            acc[nt] = __builtin_amdgcn_mfma_f32_16x16x32_bf16(bfv, af, acc[nt], 0, 0, 0);
        }
    }
}
__device__ __forceinline__ void acc_zero(f32x4 (&acc)[4]) {
#pragma unroll
    for (int nt = 0; nt < 4; ++nt) acc[nt] = (f32x4){0.f, 0.f, 0.f, 0.f};
}
template <bool STRICT>
__device__ __forceinline__ void acc_mask(f32x4 (&acc)[4], int m, int fq) {
    const int w = __builtin_amdgcn_readfirstlane(m >> 4);
#pragma unroll
    for (int nt = 0; nt < 4; ++nt) {
        if (nt < w) acc[nt] = (f32x4){0.f, 0.f, 0.f, 0.f};
        else if (nt == w) {
#pragma unroll
            for (int r = 0; r < 4; ++r) { const int n = nt * 16 + fq * 4 + r; const bool keep = STRICT ? (m < n) : (m <= n); if (!keep) acc[nt][r] = 0.f; }
        }
    }
}
__device__ __forceinline__ void acc_mask_lo(f32x4 (&acc)[4], int m, int fq) {
    const int w = __builtin_amdgcn_readfirstlane(m >> 4);
#pragma unroll
    for (int nt = 0; nt < 4; ++nt) {
        if (nt > w) acc[nt] = (f32x4){0.f, 0.f, 0.f, 0.f};
        else if (nt == w) {
#pragma unroll
            for (int r = 0; r < 4; ++r) { const int n = nt * 16 + fq * 4 + r; if (n > m) acc[nt][r] = 0.f; }
        }
    }
}
__device__ __forceinline__ void st_rm(bf16_t* dst, const f32x4 (&acc)[4], int m, int fq) {
#pragma unroll
    for (int nt = 0; nt < 4; ++nt) store_bf16x4(dst + m * SL + nt * 16 + fq * 4, acc[nt]);
}
__device__ __forceinline__ void st_tr(bf16_t* dst, const f32x4 (&acc)[4], int m, int fq) {
#pragma unroll
    for (int nt = 0; nt < 4; ++nt) {
        const unsigned u0 = pack2(acc[nt][0], acc[nt][1]), u1 = pack2(acc[nt][2], acc[nt][3]);
        bf16_t* d = dst + (nt * 16 + fq * 4) * SL + m;
        d[0] = (bf16_t)(u0 & 0xffffu); d[SL] = (bf16_t)(u0 >> 16); d[2 * SL] = (bf16_t)(u1 & 0xffffu); d[3 * SL] = (bf16_t)(u1 >> 16);
    }
}
__device__ __forceinline__ void tr_copy16(bf16_t* dst, const bf16_t* src, int bi, int bq) {
    const uint4 a = *(const uint4*)(src + bi * SL + bq), b = *(const uint4*)(src + bi * SL + bq + 8);
    const unsigned w[8] = {a.x, a.y, a.z, a.w, b.x, b.y, b.z, b.w};
#pragma unroll
    for (int q = 0; q < 8; ++q) { dst[(bq + 2 * q) * SL + bi] = (bf16_t)(w[q] & 0xffffu); dst[(bq + 2 * q + 1) * SL + bi] = (bf16_t)(w[q] >> 16); }
}
__device__ __forceinline__ void ph_r1(const Params& p, int l, char* smem) {
    const int tid0 = tidx();
#define R1_IDX const int tid = lv(tid0), lane = tid & 63, wave = tid >> 6, fr = lane & 15, fq = lane >> 4, bi = tid >> 2, bq = (tid & 3) * 16, m = wave * 16 + fr; (void)bi; (void)bq; (void)m; (void)fq;
    const bf16_t* P = (const bf16_t*)(p.ws + O_P); const float* mu = p.in[I_MU] + l * 1792;
    const float* kkw = p.in[I_KK] + l * 512; const float* kaw = p.in[I_KA] + l * 512; const float* rkw = p.in[I_RK] + l * 512;
    const float* KKN = (const float*)(p.ws + O_X + X_KKN); float* BON = (float*)(p.ws + O_X + X_BON); const bf16_t* X12 = (const bf16_t*)(p.ws + O_X + X_X12);
    bf16_t* gMT = (bf16_t*)(p.ws + O_X + X_MT); bf16_t* gNL = (bf16_t*)(p.ws + O_H);
    bf16_t* gGT = (bf16_t*)(p.ws + O_X + X_GT); bf16_t* gYL = (bf16_t*)(p.ws + O_X + X_YL);
    bf16_t* slot = (bf16_t*)smem;
    bf16_t* s0 = slot, *s1 = slot + SLOT_E, *s2 = slot + 2 * SLOT_E, *s3 = slot + 3 * SLOT_E;
    bf16_t* sa = slot + 4 * SLOT_E, *sb = slot + 5 * SLOT_E, *sc = slot + 6 * SLOT_E, *sT = slot + 7 * SLOT_E;
    float* misc = (float*)(smem + 8 * SLOT_E * 2);
    float* GAM = misc; float* SEG = misc + 64;
    float* ASIG = (float*)s0;
    float* LWS = (float*)s2;
    for (int it = blockIdx.x; it < NCP; it += gridDim.x) {
        const int c = it % 68, d = (it / 68) & 1, h = (it / 136) & 7, b = it / 1088;
        float rr[16], kq[16], kkn;
        {
            R1_IDX const int rowb = scan_row(b, d, c * 64 + bi); (void)rowb;
            {
                const uint4* xr = (const uint4*)(X12 + (size_t)rowb * 128 + bq);
                const uint4 x0 = xr[0], x1 = xr[1], x2 = xr[8], x3 = xr[9];
                *(uint4*)(sa + bi * SL + bq) = x0; *(uint4*)(sa + bi * SL + bq + 8) = x1;
                *(uint4*)(sb + bi * SL + bq) = x2; *(uint4*)(sb + bi * SL + bq + 8) = x3;
            }
#pragma unroll
            for (int hh = 0; hh < 2; ++hh) {
                float t8[8];
                xs8(P, mu, rowb, h * 64 + bq + hh * 8, t8);
#pragma unroll
                for (int j = 0; j < 8; ++j) rr[hh * 8 + j] = t8[j];
                xs8(P, mu, rowb, 512 + h * 64 + bq + hh * 8, t8);
#pragma unroll
                for (int j = 0; j < 8; ++j) kq[hh * 8 + j] = t8[j];
            }
            kkn = KKN[(size_t)rowb * 8 + h];
        }
        __syncthreads();
        {
            R1_IDX const int rowb = scan_row(b, d, c * 64 + bi); (void)rowb;
            f32x4 acc[4];
            acc_zero(acc);
            mm64<SL, 64>(sa, (const bf16_t*)(p.ws + O_WB + W_WUP) + ((size_t)d * 512 + h * 64) * 64, acc, wave, fr, fq);
            const float* w0 = p.in[I_W0] + (l * 2 + d) * 512 + h * 64;
#pragma unroll
            for (int nt = 0; nt < 4; ++nt) {
                const int n = nt * 16 + fq * 4; float4 o; float* op = (float*)&o;
#pragma unroll
                for (int r = 0; r < 4; ++r) { const float z = w0[n + r] + acc[nt][r]; op[r] = -0.6065306597126334f * __builtin_amdgcn_rcpf(1.f + __expf(-z)); }
                *(float4*)(LWS + m * 68 + n) = o;
            }
            acc_zero(acc);
            mm64<SL, 64>(sb, (const bf16_t*)(p.ws + O_WB + W_AUP) + ((size_t)d * 512 + h * 64) * 64, acc, wave, fr, fq);
            const float* a0 = p.in[I_A0] + (l * 2 + d) * 512 + h * 64;
#pragma unroll
            for (int nt = 0; nt < 4; ++nt) {
                const int n = nt * 16 + fq * 4;
                *(float4*)(ASIG + m * 68 + n) = make_float4(__builtin_amdgcn_rcpf(1.f + __expf(-(a0[n] + acc[nt][0]))), __builtin_amdgcn_rcpf(1.f + __expf(-(a0[n + 1] + acc[nt][1]))), __builtin_amdgcn_rcpf(1.f + __expf(-(a0[n + 2] + acc[nt][2]))), __builtin_amdgcn_rcpf(1.f + __expf(-(a0[n + 3] + acc[nt][3]))));
            }
        }
        __syncthreads();
        {
            R1_IDX const int rowb = scan_row(b, d, c * 64 + bi); (void)rowb;
            const int k = tid & 63, seg = tid >> 6;
            float run = 0.f;
#pragma unroll
            for (int ii = 0; ii < 16; ++ii) { run += LWS[(seg * 16 + ii) * 68 + k]; LWS[(seg * 16 + ii) * 68 + k] = run; }
            SEG[seg * 64 + k] = run;
            __syncthreads();
            float off = 0.f;
#pragma unroll
            for (int sgi = 0; sgi < 3; ++sgi) if (sgi < seg) off += SEG[sgi * 64 + k];
#pragma unroll
            for (int ii = 0; ii < 16; ++ii) LWS[(seg * 16 + ii) * 68 + k] += off;
        }
        __syncthreads();
        {
            R1_IDX const int rowb = scan_row(b, d, c * 64 + bi); (void)rowb;
            float cs[16], cm[16], cc[16], ag[16];
#pragma unroll
            for (int q = 0; q < 4; ++q) {
                const float4 v0 = *(const float4*)(LWS + bi * 68 + bq + q * 4);
                float4 v1 = *(const float4*)(LWS + (bi > 0 ? bi - 1 : 0) * 68 + bq + q * 4);
                if (bi == 0) v1 = make_float4(0.f, 0.f, 0.f, 0.f);
                const float4 v2 = *(const float4*)(LWS + 63 * 68 + bq + q * 4);
                const float4 v3 = *(const float4*)(ASIG + bi * 68 + bq + q * 4);
                cs[q * 4] = v0.x; cs[q * 4 + 1] = v0.y; cs[q * 4 + 2] = v0.z; cs[q * 4 + 3] = v0.w;
                cm[q * 4] = v1.x; cm[q * 4 + 1] = v1.y; cm[q * 4 + 2] = v1.z; cm[q * 4 + 3] = v1.w;
                cc[q * 4] = v2.x; cc[q * 4 + 1] = v2.y; cc[q * 4 + 2] = v2.z; cc[q * 4 + 3] = v2.w;
                ag[q * 4] = v3.x; ag[q * 4 + 1] = v3.y; ag[q * 4 + 2] = v3.z; ag[q * 4 + 3] = v3.w;
            }
            __syncthreads();
            float bon = 0.f;
#pragma unroll
            for (int hh = 0; hh < 2; ++hh) {
                float oa[8], ob[8], ok[8], orr[8];
                const int col = h * 64 + bq + hh * 8;
#pragma unroll
                for (int j = 0; j < 8; ++j) {
                    const int e = hh * 8 + j;
                    const float kk = kq[e] * kkw[col + j] * kkn;
                    const float kd = kq[e] * (1.f + (ag[e] - 1.f) * kaw[col + j]);
                    const float eneg = __expf(-cs[e]);
                    oa[j] = -kk * __expf(cm[e]); ob[j] = kk * ag[e] * eneg; ok[j] = kd * eneg; orr[j] = rr[e] * __builtin_amdgcn_rcpf(eneg);
                    bon += rr[e] * kd * rkw[col + j];
                }
                *(uint4*)(s0 + bi * SL + bq + hh * 8) = pack8(oa); *(uint4*)(s1 + bi * SL + bq + hh * 8) = pack8(ob);
                *(uint4*)(s2 + bi * SL + bq + hh * 8) = pack8(ok); *(uint4*)(s3 + bi * SL + bq + hh * 8) = pack8(orr);
            }
            bon += __shfl_xor(bon, 1); bon += __shfl_xor(bon, 2);
            if ((tid & 3) == 0) BON[((size_t)d * RT + rowb) * 8 + h] = bon;
            if (bi == 0) {
#pragma unroll
                for (int e = 0; e < 16; ++e) GAM[bq + e] = __expf(cc[e]);
            }
        }
        __syncthreads();
        unsigned vp[8];
        {
            R1_IDX const int rowb = scan_row(b, d, c * 64 + bi); (void)rowb;
#pragma unroll
            for (int hh = 0; hh < 2; ++hh) {
                float v8[8]; xs8(P, mu, rowb, 1024 + h * 64 + bq + hh * 8, v8);
#pragma unroll
                for (int q = 0; q < 4; ++q) vp[hh * 4 + q] = pack2(v8[2 * q], v8[2 * q + 1]);
            }
            f32x4 acc[4]; acc_zero(acc);
            mm64<SL, SL>(s1, s0, acc, wave, fr, fq);
            acc_mask<true>(acc, m, fq);
            st_rm(sa, acc, m, fq); st_tr(sb, acc, m, fq);
#pragma unroll
            for (int nt = 0; nt < 4; ++nt)
#pragma unroll
                for (int r = 0; r < 4; ++r) if (nt * 16 + fq * 4 + r == m) acc[nt][r] += 1.f;
            st_rm(sc, acc, m, fq);
        }
        __syncthreads();
#pragma unroll
        for (int itr = 0; itr < 5; ++itr) {
            R1_IDX
            bf16_t* ptr = (itr & 1) ? sT : sb;
            bf16_t* ptw = (itr & 1) ? sb : sT;
            f32x4 acc[4]; acc_zero(acc);
            mm64<SL, SL>(sa, ptr, acc, wave, fr, fq);
            st_rm(sa, acc, m, fq); st_tr(ptw, acc, m, fq);
            __syncthreads();
            f32x4 tacc[4];
#pragma unroll
            for (int nt = 0; nt < 4; ++nt) { const uint2 u = *(const uint2*)(sc + m * SL + nt * 16 + fq * 4); tacc[nt] = (f32x4){bflo(u.x), bfhi(u.x), bflo(u.y), bfhi(u.y)}; }
            mm64<SL, SL>(sc, ptw, tacc, wave, fr, fq);
            if (itr < 4) st_rm(sc, tacc, m, fq); else st_tr(sb, tacc, m, fq);
        }
        __syncthreads();
        {
            R1_IDX const int rowb = scan_row(b, d, c * 64 + bi); (void)rowb;
            f32x4 acc[4]; acc_zero(acc);
            mm64<SL, SL>(s2, s0, acc, wave, fr, fq);
            acc_mask<true>(acc, m, fq);
            st_rm(sa, acc, m, fq);
            tr_copy16(sc, s0, bi, bq);
        }
        __syncthreads();
        {
            R1_IDX const int rowb = scan_row(b, d, c * 64 + bi); (void)rowb;
            f32x4 acc[4]; acc_zero(acc);
            mm64<SL, SL>(sc, sb, acc, wave, fr, fq);
            st_rm(sT, acc, m, fq);
            acc_zero(acc);
            mm64<SL, SL>(sa, sb, acc, wave, fr, fq);
            st_rm(s0, acc, m, fq);
        }
        __syncthreads();
        f32x4 qacc[4];
        {
            R1_IDX
            f32x4 acc[4]; acc_zero(acc);
            mm64<SL, SL>(s3, s1, acc, wave, fr, fq);
            acc_mask_lo(acc, m, fq);
            st_rm(sa, acc, m, fq);
            acc_zero(qacc);
            mm64<SL, SL>(s3, s2, qacc, wave, fr, fq);
            acc_mask_lo(qacc, m, fq);
        }
        __syncthreads();
        {
            R1_IDX
            f32x4 acc[4];
#pragma unroll
            for (int nt = 0; nt < 4; ++nt) { const uint2 u = *(const uint2*)(s3 + m * SL + nt * 16 + fq * 4); acc[nt] = (f32x4){bflo(u.x), bfhi(u.x), bflo(u.y), bfhi(u.y)}; }
            mm64<SL, SL>(sa, sT, acc, wave, fr, fq);
            bf16_t* gt = gGT + (size_t)it * 4096;
#pragma unroll
            for (int nt = 0; nt < 4; ++nt) store_bf16x4(gt + m * 64 + nt * 16 + fq * 4, acc[nt]);
            mm64<SL, SL>(sa, s0, qacc, wave, fr, fq);
            st_rm(sb, qacc, m, fq);
            tr_copy16(sc, s1, bi, bq);
        }
        __syncthreads();
        {
            R1_IDX
            f32x4 acc[4]; acc_zero(acc);
            mm64<SL, SL>(sc, sT, acc, wave, fr, fq);
            bf16_t* mt = gMT + (size_t)it * 4096;
            const float gm = GAM[m];
#pragma unroll
            for (int nt = 0; nt < 4; ++nt) {
                f32x4 o = acc[nt];
#pragma unroll
                for (int r = 0; r < 4; ++r) if (nt * 16 + fq * 4 + r == m) o[r] += 1.f;
                o *= gm;
                store_bf16x4(mt + m * 64 + nt * 16 + fq * 4, o);
            }
#pragma unroll
            for (int nt = 0; nt < 4; ++nt) {
                const int n = nt * 16 + fq * 4; const uint2 u = *(const uint2*)(s2 + m * SL + n);
                acc[nt] = (f32x4){bflo(u.x), bfhi(u.x), bflo(u.y), bfhi(u.y)};
            }
            mm64<SL, SL>(s0, sc, acc, wave, fr, fq);
#pragma unroll
            for (int nt = 0; nt < 4; ++nt) acc[nt] *= *(const f32x4*)(GAM + nt * 16 + fq * 4);
            st_tr(s1, acc, m, fq);
#pragma unroll
            for (int q = 0; q < 8; ++q) { s3[(bq + 2 * q) * SL + bi] = (bf16_t)(vp[q] & 0xffffu); s3[(bq + 2 * q + 1) * SL + bi] = (bf16_t)(vp[q] >> 16); }
        }
        __syncthreads();
        {
            R1_IDX const int rowb = scan_row(b, d, c * 64 + bi); (void)rowb;
            f32x4 acc[4]; acc_zero(acc);
            mm64<SL, SL>(s3, sb, acc, wave, fr, fq);
            bf16_t* yl = gYL + (size_t)it * 4096;
#pragma unroll
            for (int nt = 0; nt < 4; ++nt) store_bf16x4(yl + m * 64 + nt * 16 + fq * 4, acc[nt]);
            acc_zero(acc);
            mm64<SL, SL>(s3, s1, acc, wave, fr, fq);
            bf16_t* nl = gNL + (size_t)it * 4096;
#pragma unroll
            for (int nt = 0; nt < 4; ++nt) store_bf16x4(nl + m * 64 + nt * 16 + fq * 4, acc[nt]);
        }
        __syncthreads();
    }
}
__device__ __forceinline__ void ph_r2(const Params& p, char* smem) {
    const int tid = tidx(), lane = tid & 63, wave = tid >> 6, fr = lane & 15, fq = lane >> 4;
    const char* gMT = (const char*)(p.ws + O_X + X_MT); const char* gNL = (const char*)(p.ws + O_H);
    uint4* gS0 = (uint4*)(p.ws + O_X + X_S0);
    const int wofs = __builtin_amdgcn_readfirstlane(wave) * 1024;
    const unsigned lds0 = (unsigned)(uintptr_t)smem;
    const unsigned mtaddr = lds0 + fr * 128 + fq * 8, nladdr = lds0 + (wave * 16 + fr) * 128 + fq * 8;
    auto issue = [&](size_t cp, int slot) {
        char* dst = smem + slot * 16384 + wofs;
        const char* s0 = gMT + cp * 8192 + wofs + lane * 16; const char* s1 = gNL + cp * 8192 + wofs + lane * 16;
        __builtin_amdgcn_global_load_lds((const unsigned*)s0, (unsigned*)dst, 16, 0, 0);
        __builtin_amdgcn_global_load_lds((const unsigned*)(s0 + 4096), (unsigned*)(dst + 4096), 16, 0, 0);
        __builtin_amdgcn_global_load_lds((const unsigned*)s1, (unsigned*)(dst + 8192), 16, 0, 0);
        __builtin_amdgcn_global_load_lds((const unsigned*)(s1 + 4096), (unsigned*)(dst + 12288), 16, 0, 0);
    };
#define R2_READ(MX, NV, SLOT) do { \
        asm volatile("ds_read_b64 %0, %1 offset:0" : "=v"(MX[0][0][0]) : "v"(mtaddr + (SLOT) * 16384)); \
        asm volatile("ds_read_b64 %0, %1 offset:32" : "=v"(MX[0][0][1]) : "v"(mtaddr + (SLOT) * 16384)); \
        asm volatile("ds_read_b64 %0, %1 offset:64" : "=v"(MX[0][1][0]) : "v"(mtaddr + (SLOT) * 16384)); \
        asm volatile("ds_read_b64 %0, %1 offset:96" : "=v"(MX[0][1][1]) : "v"(mtaddr + (SLOT) * 16384)); \
        asm volatile("ds_read_b64 %0, %1 offset:8192" : "=v"(NV[0]) : "v"(nladdr + (SLOT) * 16384)); \
        asm volatile("ds_read_b64 %0, %1 offset:2048" : "=v"(MX[1][0][0]) : "v"(mtaddr + (SLOT) * 16384)); \
        asm volatile("ds_read_b64 %0, %1 offset:2080" : "=v"(MX[1][0][1]) : "v"(mtaddr + (SLOT) * 16384)); \
        asm volatile("ds_read_b64 %0, %1 offset:2112" : "=v"(MX[1][1][0]) : "v"(mtaddr + (SLOT) * 16384)); \
        asm volatile("ds_read_b64 %0, %1 offset:2144" : "=v"(MX[1][1][1]) : "v"(mtaddr + (SLOT) * 16384)); \
        asm volatile("ds_read_b64 %0, %1 offset:8224" : "=v"(NV[1]) : "v"(nladdr + (SLOT) * 16384)); \
        asm volatile("ds_read_b64 %0, %1 offset:4096" : "=v"(MX[2][0][0]) : "v"(mtaddr + (SLOT) * 16384)); \
        asm volatile("ds_read_b64 %0, %1 offset:4128" : "=v"(MX[2][0][1]) : "v"(mtaddr + (SLOT) * 16384)); \
        asm volatile("ds_read_b64 %0, %1 offset:4160" : "=v"(MX[2][1][0]) : "v"(mtaddr + (SLOT) * 16384)); \
        asm volatile("ds_read_b64 %0, %1 offset:4192" : "=v"(MX[2][1][1]) : "v"(mtaddr + (SLOT) * 16384)); \
        asm volatile("ds_read_b64 %0, %1 offset:8256" : "=v"(NV[2]) : "v"(nladdr + (SLOT) * 16384)); \
        asm volatile("ds_read_b64 %0, %1 offset:6144" : "=v"(MX[3][0][0]) : "v"(mtaddr + (SLOT) * 16384)); \
        asm volatile("ds_read_b64 %0, %1 offset:6176" : "=v"(MX[3][0][1]) : "v"(mtaddr + (SLOT) * 16384)); \
        asm volatile("ds_read_b64 %0, %1 offset:6208" : "=v"(MX[3][1][0]) : "v"(mtaddr + (SLOT) * 16384)); \
        asm volatile("ds_read_b64 %0, %1 offset:6240" : "=v"(MX[3][1][1]) : "v"(mtaddr + (SLOT) * 16384)); \
        asm volatile("ds_read_b64 %0, %1 offset:8288" : "=v"(NV[3]) : "v"(nladdr + (SLOT) * 16384)); \
        } while (0)
#define R2_PIN(MX, NV) asm volatile("" : "+v"(MX[0][0][0]), "+v"(MX[0][0][1]), "+v"(MX[0][1][0]), "+v"(MX[0][1][1]), "+v"(NV[0]), "+v"(MX[1][0][0]), "+v"(MX[1][0][1]), "+v"(MX[1][1][0]), "+v"(MX[1][1][1]), "+v"(NV[1]), "+v"(MX[2][0][0]), "+v"(MX[2][0][1]), "+v"(MX[2][1][0]), "+v"(MX[2][1][1]), "+v"(NV[2]), "+v"(MX[3][0][0]), "+v"(MX[3][0][1]), "+v"(MX[3][1][0]), "+v"(MX[3][1][1]), "+v"(NV[3]) :: "memory")
#define R2_STEP(MX, NV, MXN, NVN, J) do { const int c = c4 + (J); \
        asm volatile("s_waitcnt lgkmcnt(0)" ::: "memory");            \
        R2_PIN(MX, NV);                                                \
        asm volatile("s_waitcnt vmcnt(8)" ::: "memory");              \
        __builtin_amdgcn_s_barrier(); \
        asm volatile("" ::: "memory"); \
        R2_READ(MXN, NVN, ((J) + 1) & 3); \
        __builtin_amdgcn_sched_barrier(0); \
        u32x4 sb_[2]; \
        _Pragma("unroll") for (int s_ = 0; s_ < 2; ++s_) sb_[s_] = (u32x4){pack2(st[2 * s_][0], st[2 * s_][1]), pack2(st[2 * s_][2], st[2 * s_][3]), pack2(st[2 * s_ + 1][0], st[2 * s_ + 1][1]), pack2(st[2 * s_ + 1][2], st[2 * s_ + 1][3])}; \
        _Pragma("unroll") for (int tt = 0; tt < 4; ++tt) { \
            f32x4 acc_ = {bflo(NV[tt].x), bfhi(NV[tt].x), bflo(NV[tt].y), bfhi(NV[tt].y)}; \
            _Pragma("unroll") for (int s_ = 0; s_ < 2; ++s_) \
                acc_ = __builtin_amdgcn_mfma_f32_16x16x32_bf16(__builtin_bit_cast(bf16x8, (u32x4){MX[tt][s_][0].x, MX[tt][s_][0].y, MX[tt][s_][1].x, MX[tt][s_][1].y}), __builtin_bit_cast(bf16x8, sb_[s_]), acc_, 0, 0, 0); \
            st[tt] = acc_; } \
        *(u32x4*)(gS0 + ((cp0 + c) * 4 + wave) * 128 + lane) = sb_[0]; *(u32x4*)(gS0 + ((cp0 + c) * 4 + wave) * 128 + 64 + lane) = sb_[1]; \
        issue(cp0 + (c + 4 < 68 ? c + 4 : 67), (J)); } while (0)
    for (int it = blockIdx.x; it < 64; it += gridDim.x) {
        f32x4 st[4];
#pragma unroll
        for (int tt = 0; tt < 4; ++tt) st[tt] = (f32x4){0.f, 0.f, 0.f, 0.f};
        const size_t cp0 = (size_t)it * 68;
        issue(cp0, 0); issue(cp0 + 1, 1); issue(cp0 + 2, 2); issue(cp0 + 3, 3);
        uint2 mxA[4][2][2], nvA[4], mxB[4][2][2], nvB[4];
        asm volatile("s_waitcnt vmcnt(12)" ::: "memory");
        __builtin_amdgcn_s_barrier();
        asm volatile("" ::: "memory");
        R2_READ(mxA, nvA, 0);
        asm volatile("s_waitcnt lgkmcnt(0)" ::: "memory");
        R2_PIN(mxA, nvA);
        for (int c4 = 0; c4 < 68; c4 += 4) {
            R2_STEP(mxA, nvA, mxB, nvB, 0);
            R2_STEP(mxB, nvB, mxA, nvA, 1);
            R2_STEP(mxA, nvA, mxB, nvB, 2);
            R2_STEP(mxB, nvB, mxA, nvA, 3);
            asm volatile("s_waitcnt lgkmcnt(0)" ::: "memory");
            R2_PIN(mxA, nvA);
        }
        asm volatile("s_waitcnt vmcnt(0) lgkmcnt(0)" ::: "memory");
        __builtin_amdgcn_sched_barrier(0);
        __syncthreads();
    }
#undef R2_READ
#undef R2_PIN
#undef R2_STEP
}
__device__ __forceinline__ void ph_r3(const Params& p, int l, char* smem) {
    const int tid = tidx(), lane = tid & 63, wave = tid >> 6, fr = lane & 15, fq = lane >> 4;
    const bf16_t* P = (const bf16_t*)(p.ws + O_P); const float* mu = p.in[I_MU] + l * 1792;
    const float* gng = p.in[I_GNG] + l * 512; const float* gnb = p.in[I_GNB] + l * 512;
    const bf16_t* gGT = (const bf16_t*)(p.ws + O_X + X_GT); const bf16_t* gYL = (const bf16_t*)(p.ws + O_X + X_YL);
    const u32x4* gS0 = (const u32x4*)(p.ws + O_X + X_S0);
    const float* BON = (const float*)(p.ws + O_X + X_BON);
    const bf16_t* RG = (const bf16_t*)(p.ws + O_RG); bf16_t* RWO = (bf16_t*)(p.ws + O_RWO);
    float* YA = (float*)smem;
    float* YB = YA + 64 * 68;
    for (int it = blockIdx.x; it < 4 * 68 * 8; it += gridDim.x) {
        const int h = it & 7, c0 = (it >> 3) % 68, b = it / (68 * 8);
        const int c1 = c0 < 4 ? 3 - c0 : 71 - c0;
        const int pi = tid >> 2, pv0 = (tid & 3) * 16;
        const int prow = scan_row(b, 0, c0 * 64 + pi), pcol = h * 64 + pv0;
        float pv[16]; uint4 prg[2];
#pragma unroll
        for (int hh = 0; hh < 2; ++hh) {
            float t8[8]; xs8(P, mu, prow, 1024 + pcol + hh * 8, t8);
#pragma unroll
            for (int e = 0; e < 8; ++e) pv[hh * 8 + e] = t8[e];
            prg[hh] = *(const uint4*)(RG + (size_t)prow * 512 + pcol + hh * 8);
        }
        const float pbs = BON[((size_t)0 * RT + prow) * 8 + h] + BON[((size_t)1 * RT + prow) * 8 + h];
#pragma unroll
        for (int d = 0; d < 2; ++d) {
            const size_t cp = ((size_t)(b * 8 + h) * 2 + d) * 68 + (d == 0 ? c0 : c1);
            const bf16_t* gt = gGT + cp * 4096; const bf16_t* yl = gYL + cp * 4096;
            const u32x4 sb0 = gS0[(cp * 4 + wave) * 128 + lane], sb1 = gS0[(cp * 4 + wave) * 128 + 64 + lane];
            float* Y = d == 0 ? YA : YB;
#pragma unroll
            for (int tt = 0; tt < 4; ++tt) {
                const uint2 yv = *(const uint2*)(yl + (wave * 16 + fr) * 64 + tt * 16 + fq * 4);
                f32x4 acc = {bflo(yv.x), bfhi(yv.x), bflo(yv.y), bfhi(yv.y)};
#pragma unroll
                for (int s_ = 0; s_ < 2; ++s_) {
                    const bf16_t* q = gt + (tt * 16 + fr) * 64 + s_ * 32 + fq * 4;
                    const uint2 a0 = *(const uint2*)q, a1 = *(const uint2*)(q + 16);
                    acc = __builtin_amdgcn_mfma_f32_16x16x32_bf16(__builtin_bit_cast(bf16x8, (u32x4){a0.x, a0.y, a1.x, a1.y}), __builtin_bit_cast(bf16x8, s_ ? sb1 : sb0), acc, 0, 0, 0);
                }
#pragma unroll
                for (int r = 0; r < 4; ++r) {
                    const int t = tt * 16 + fq * 4 + r, i = d == 0 ? t : 63 - t;
                    Y[i * 68 + wave * 16 + fr] = acc[r];
                }
            }
        }
        __syncthreads();
        {
            const int i = tid >> 2, q4 = tid & 3, v0 = q4 * 16;
            const int row = scan_row(b, 0, c0 * 64 + i), col = h * 64 + v0;
            float y[16];
#pragma unroll
            for (int e4 = 0; e4 < 4; ++e4) {
                const float4 ya = *(const float4*)(YA + i * 68 + v0 + e4 * 4), yb = *(const float4*)(YB + i * 68 + v0 + e4 * 4);
                y[e4 * 4] = ya.x + yb.x; y[e4 * 4 + 1] = ya.y + yb.y; y[e4 * 4 + 2] = ya.z + yb.z; y[e4 * 4 + 3] = ya.w + yb.w;
            }
            float sm = 0.f;
#pragma unroll
            for (int e = 0; e < 16; ++e) sm += y[e];
            sm += __shfl_xor(sm, 1); sm += __shfl_xor(sm, 2);
            const float mean = sm * (1.f / 64.f);
            float vs = 0.f;
#pragma unroll
            for (int e = 0; e < 16; ++e) { const float dl = y[e] - mean; vs += dl * dl; }
            vs += __shfl_xor(vs, 1); vs += __shfl_xor(vs, 2);
            const float rstd = rsqrtf(vs * (1.f / 64.f) + 64e-5f);
            const float bs = pbs;
#pragma unroll
            for (int hh = 0; hh < 2; ++hh) {
                float g8[8], o[8];
                unpack8(prg[hh], g8);
#pragma unroll
                for (int e = 0; e < 8; ++e) o[e] = ((y[hh * 8 + e] - mean) * rstd * gng[col + hh * 8 + e] + gnb[col + hh * 8 + e] + bs * pv[hh * 8 + e]) * g8[e];
                *(uint4*)(RWO + (size_t)row * 512 + col + hh * 8) = pack8(o);
            }
        }
        __syncthreads();
    }
}

__device__ __forceinline__ void ph_f1(const Params& p, int l, char* smem) {
    const bf16_t* P = (const bf16_t*)(p.ws + O_P); const bf16_t* CSC = (const bf16_t*)(p.ws + O_CSC);
    bf16_t* YT2 = (bf16_t*)(p.ws + O_YT2); bf16_t* YTC = (bf16_t*)(p.ws + O_YTC);
    const int nitems = 1024 + (l < NLAYER - 1 ? 64 : 0);
    for (int it = gridDim.x - 1 - blockIdx.x; it < nitems; it += gridDim.x) {
        f32x4 acc[4][4];
        if (it < 1024) {
            const int b = it >> 8, g = (it >> 6) & 3, part = (it >> 5) & 1, j = it & 31;
            RPPlain rpa{CSC + (size_t)part * 128 * 128, 128};
            const bf16_t* pb = P + (size_t)b * SEQ * LDP + g * 128;
            auto rpb = [&](int r) -> const bf16_t* { return pb + (size_t)(64 * (r & 63) + 2 * j + (r >> 6)) * LDP; };
            gemm_core_gb<4>(rpa, rpb, 128, acc, smem);
            acc_foreach<4>(acc, [&](int m, int n, const f32x4& v) {
                const int t1 = n & 63, t2 = 2 * j + (n >> 6);
                store_bf16x4(YT2 + ((size_t)(b * 512 + g * 128 + m) * 64 + t2) * 128 + part * 64 + t1, v);
            });
        } else {
            const int jj = it - 1024, b = jj >> 4, g = (jj >> 2) & 3, part = (jj >> 1) & 1, nt = jj & 1;
            RPPlain rpa{CSC + (size_t)part * 128 * 128, 128};
            gemm_core_g<4>(rpa, P + (size_t)(RL + b * CTX + nt * 128) * LDP + g * 128, LDP, 128, acc, smem);
            acc_foreach<4>(acc, [&](int m, int n, const f32x4& v) {
                store_bf16x4(YTC + ((size_t)(b * 512 + g * 128 + m)) * 512 + part * 256 + nt * 128 + n, v);
            });
        }
    }
}
__device__ __forceinline__ void ph_fa(const Params& p, char* smem) {
    const bf16_t* YT2 = (const bf16_t*)(p.ws + O_YT2); const bf16_t* D128 = (const bf16_t*)(p.ws + O_D128);
    const float* TWC = (const float*)(p.ws + O_TWC); const float* TWS = (const float*)(p.ws + O_TWS);
    bf16_t* A2 = (bf16_t*)(p.ws + O_A2);
    for (int it = blockIdx.x; it < 1024; it += gridDim.x) {
        f32x4 acc[4][4];
        RPPlain rpa{D128, 128};
        gemm_core_g<4>(rpa, YT2 + (size_t)it * 128 * 128, 128, 128, acc, smem);
        const int lane = tidx() & 63, wave = tidx() >> 6, wr = wave >> 1, wc = wave & 1, fr = lane & 15, fq = lane >> 4;
        float* U = (float*)smem;
        if (wr == 1) {
#pragma unroll
            for (int i = 0; i < 4; ++i)
#pragma unroll
                for (int j = 0; j < 4; ++j) *(f32x4*)(U + (i * 16 + fr) * 132 + wc * 64 + j * 16 + fq * 4) = acc[i][j];
        }
        __syncthreads();
        if (wr == 0) {
#pragma unroll
            for (int i = 0; i < 4; ++i) {
                const int k1 = i * 16 + fr;
#pragma unroll
                for (int j = 0; j < 4; ++j) {
                    const int r = wc * 64 + j * 16 + fq * 4;
                    const int R = it * 128 + r, bn = R >> 6, t2 = R & 63, b = bn >> 9, n = bn & 511;
                    const f32x4 ai = *(const f32x4*)(U + k1 * 132 + r);
                    const f32x4 c = *(const f32x4*)(TWC + k1 * 64 + t2), sn = *(const f32x4*)(TWS + k1 * 64 + t2);
                    const f32x4 ar = acc[i][j];
                    const f32x4 pr = ar * c - ai * sn, pi = ar * sn + ai * c;
                    bf16_t* dst = A2 + ((size_t)(b * 64 + k1) * 512 + n) * 128 + t2;
                    store_bf16x4(dst, pr); store_bf16x4(dst + 64, pi);
                }
            }
        }
        __syncthreads();
    }
}
__device__ __forceinline__ void ph_fb(const Params& p, int l, char* smem) {
    const bf16_t* A2 = (const bf16_t*)(p.ws + O_A2); const bf16_t* E64 = (const bf16_t*)(p.ws + O_E64);
    const bf16_t* CST2 = (const bf16_t*)(p.ws + O_CST256); const bf16_t* YTC = (const bf16_t*)(p.ws + O_YTC);
    bf16_t* FA = (bf16_t*)(p.ws + O_FA);
    const int nctx = l < NLAYER - 1 ? 32 : 0, nitems = 1024 + nctx;
    const int skip = gridDim.x >= 128 ? 64 : 0;
    if ((int)blockIdx.x < skip) return;
    for (int it0 = blockIdx.x - skip; it0 < nitems; it0 += gridDim.x - skip) {
        const int it = it0 < nctx ? 1024 + it0 : it0 - nctx;
        if (it < 1024) {
            const int b = it >> 8, k1 = (it >> 2) & 63, nt = it & 3;
            f32x4 acc[2][4];
            RPPlain rpa{E64, 128};
            gemm_core_g<2>(rpa, A2 + ((size_t)(b * 64 + k1) * 512 + nt * 128) * 128, 128, 128, acc, smem);
            const float sc = 0.001381067932004975f;
            acc_foreach<2>(acc, [&](int m, int n, const f32x4& v) { f32x4 o = v * sc; store_bf16x4(FA + (size_t)(b * SEQ + k1 + 64 * m) * 512 + nt * 128 + n, o); });
        } else {
            const int j = it - 1024, b = j >> 3, mt = (j >> 2) & 1, nt = j & 3;
            f32x4 acc[4][4];
            RPPlain rp{CST2 + (size_t)mt * 128 * 512, 512};
            gemm_core_g<4>(rp, YTC + ((size_t)b * 512 + nt * 128) * 512, 512, 512, acc, smem);
            const float sc = 0.005524271728019903f;
            acc_foreach<4>(acc, [&](int m, int n, const f32x4& v) { f32x4 o = v * sc; store_bf16x4(FA + (size_t)(RL + b * CTX + mt * 128 + m) * 512 + nt * 128 + n, o); });
        }
    }
}

template <int MI>
__device__ __forceinline__ void mg_tile(const Params& p, int row0, int nt, char* smem) {
    const bf16_t* P = (const bf16_t*)(p.ws + O_P);
    const bf16_t* A0 = (const bf16_t*)(p.ws + O_FA); const bf16_t* A1 = (const bf16_t*)(p.ws + O_ATT); const bf16_t* A2 = (const bf16_t*)(p.ws + O_RWO);
    const bf16_t* W0 = (const bf16_t*)(p.ws + O_WB + W_PA); const bf16_t* W1 = (const bf16_t*)(p.ws + O_WB + W_PB); const bf16_t* W2 = (const bf16_t*)(p.ws + O_WB + W_PC);
    bf16_t* MG = (bf16_t*)(p.ws + O_H);
    f32x4 tot[MI][4];
#pragma unroll
    for (int i = 0; i < MI; ++i)
#pragma unroll
        for (int j = 0; j < 4; ++j) tot[i][j] = (f32x4){0.f, 0.f, 0.f, 0.f};
#pragma unroll 1
    for (int br = 0; br < 3; ++br) {
        const bf16_t* Ab = br == 0 ? A0 : (br == 1 ? A1 : A2);
        const bf16_t* Wb = br == 0 ? W0 : (br == 1 ? W1 : W2);
        f32x4 acc[MI][4];
        RPPlain rp{Ab + (size_t)row0 * 512, 512};
        gemm_core_g<MI>(rp, Wb + (size_t)nt * 128 * 512, 512, 512, acc, smem);
        const int lane = tidx() & 63, wave = tidx() >> 6, wr = wave >> 1, wc = wave & 1, fr = lane & 15, fq = lane >> 4;
#pragma unroll
        for (int i = 0; i < MI; ++i)
#pragma unroll
            for (int j = 0; j < 4; ++j) {
                const int m = wr * MI * 16 + i * 16 + fr, n = wc * 64 + j * 16 + fq * 4;
                const uint2 gu = *(const uint2*)(P + (size_t)(row0 + m) * LDP + PG0 + br * 1024 + nt * 128 + n);
                tot[i][j][0] += bflo(gu.x) * acc[i][j][0]; tot[i][j][1] += bfhi(gu.x) * acc[i][j][1];
                tot[i][j][2] += bflo(gu.y) * acc[i][j][2]; tot[i][j][3] += bfhi(gu.y) * acc[i][j][3];
            }
    }
    acc_foreach<MI>(tot, [&](int m, int n, const f32x4& v) { store_bf16x4(MG + (size_t)(row0 + m) * 1024 + nt * 128 + n, v); });
}
__device__ __forceinline__ void ph_mg(const Params& p, int l, char* smem) {
    const int nlat = (RL / 128) * 8, nctx = (l < NLAYER - 1) ? (RC / 32) * 8 : 0;
    for (int it = blockIdx.x; it < nlat + nctx; it += gridDim.x) {
        if (it < nlat) mg_tile<4>(p, (it >> 3) * 128, it & 7, smem);
        else { const int j = it - nlat; mg_tile<1>(p, RL + (j >> 3) * 32, j & 7, smem); }
    }
}
__device__ __forceinline__ void ph_out(const Params& p, int l, char* smem) {
    const bf16_t* MG = (const bf16_t*)(p.ws + O_H); const bf16_t* W = (const bf16_t*)(p.ws + O_WB + W_OUT);
    float* xcur = (float*)(p.ws + O_XCUR); const float* mod = (const float*)(p.ws + O_MOD);
    const int nlat = 1024, nctx = (l < NLAYER - 1) ? (RC / 32) * 8 : 0;
    for (int it = blockIdx.x; it < nlat + nctx; it += gridDim.x) {
        if (it < nlat) {
            const int mt = it >> 3, nt = it & 7;
            f32x4 acc[4][4];
            RPPlain rp{MG + (size_t)mt * 128 * 1024, 1024};
            gemm_core_g<4>(rp, W + (size_t)nt * 128 * 1024, 1024, 1024, acc, smem);
            acc_foreach<4>(acc, [&](int m, int n, const f32x4& v) {
                const int row = mt * 128 + m, col = nt * 128 + n;
                const float4 g = *(const float4*)(mod + (size_t)(l * 5 + modidx(row)) * 6144 + 2048 + col);
                float4* xp = (float4*)(xcur + (size_t)row * 1024 + col);
                float4 x = *xp; x.x += g.x * v[0]; x.y += g.y * v[1]; x.z += g.z * v[2]; x.w += g.w * v[3]; *xp = x;
            });
        } else {
            const int j = it - nlat, mt = j >> 3, nt = j & 7;
            f32x4 acc[1][4];
            RPPlain rp{MG + (size_t)(RL + mt * 32) * 1024, 1024};
            gemm_core_g<1>(rp, W + (size_t)nt * 128 * 1024, 1024, 1024, acc, smem);
            acc_foreach<1>(acc, [&](int m, int n, const f32x4& v) {
                const int row = RL + mt * 32 + m, col = nt * 128 + n;
                const float4 g = *(const float4*)(mod + (size_t)(l * 5 + 4) * 6144 + 2048 + col);
                float4* xp = (float4*)(xcur + (size_t)row * 1024 + col);
                float4 x = *xp; x.x += g.x * v[0]; x.y += g.y * v[1]; x.z += g.z * v[2]; x.w += g.w * v[3]; *xp = x;
            });
        }
    }
}

__device__ __forceinline__ void ph_n2(const Params& p, int l, char* smem) {
    const int tid = tidx(), lane = tid & 63, wave = tid >> 6;
    unsigned* lcnt = (unsigned*)smem;
    unsigned* gbase = lcnt + 16;
    int* rec = (int*)(smem + 256);
    float4* rwl = (float4*)(smem + 8192);
    for (int idx = tid; idx < 4096; idx += 256) {
        const int k = idx >> 2, pp = idx & 3;
        rwl[(((k >> 8) * 16 + (k & 3) * 4 + pp) << 6) + ((k & 255) >> 2)] = *(const float4*)(p.in[I_RW] + (size_t)k * 16 + pp * 4);
    }
    if (tid < 16) lcnt[tid] = 0u;
    __syncthreads();
    int nrec = 0;
    const float* xcur = (const float*)(p.ws + O_XCUR); const float* mod = (const float*)(p.ws + O_MOD);
    bf16_t* H = (bf16_t*)(p.ws + O_H);
    unsigned* cnt = (unsigned*)(p.ws + O_CNT); int* LTOK = (int*)(p.ws + O_LTOK); float* LW = (float*)(p.ws + O_LW); int* SLOT = (int*)(p.ws + O_SLOT);
    const float* g = p.in[I_N2G] + l * 1024; const float* rw = p.in[I_RW]; const float* rb = p.in[I_RB];
    const int nrows = (l < NLAYER - 1) ? RT : RL;
    float4 vn[4];
    {
        const int r0 = blockIdx.x * 4 + wave;
        const float* x0 = xcur + (size_t)(r0 < nrows ? r0 : 0) * 1024;
#pragma unroll
        for (int i = 0; i < 4; ++i) vn[i] = *(const float4*)(x0 + lane * 4 + 256 * i);
    }
    for (int row = blockIdx.x * 4 + wave; row < nrows; row += gridDim.x * 4) {
        const float* md = mod + (size_t)(l * 5 + modidx(row)) * 6144;
        float4 v[4]; float ss = 0.f;
#pragma unroll
        for (int i = 0; i < 4; ++i) { v[i] = vn[i]; ss += v[i].x * v[i].x + v[i].y * v[i].y + v[i].z * v[i].z + v[i].w * v[i].w; }
        {
            const int rn = row + gridDim.x * 4;
            const float* xn = xcur + (size_t)(rn < nrows ? rn : row) * 1024;
#pragma unroll
            for (int i = 0; i < 4; ++i) vn[i] = *(const float4*)(xn + lane * 4 + 256 * i);
        }
        ss = wsum(ss);
        const float rstd = rsqrtf(ss * (1.f / 1024.f) + 1e-6f);
        float lg[16];
#pragma unroll
        for (int e = 0; e < 16; ++e) lg[e] = 0.f;
#pragma unroll
        for (int i = 0; i < 4; ++i) {
            const int c = lane * 4 + 256 * i;
            const float4 gg = *(const float4*)(g + c), sc = *(const float4*)(md + 4096 + c), sh = *(const float4*)(md + 3072 + c);
            const float hv[4] = {v[i].x * rstd * gg.x * (1.f + sc.x) + sh.x, v[i].y * rstd * gg.y * (1.f + sc.y) + sh.y,
                                 v[i].z * rstd * gg.z * (1.f + sc.z) + sh.z, v[i].w * rstd * gg.w * (1.f + sc.w) + sh.w};
            f32x4 h4 = {hv[0], hv[1], hv[2], hv[3]};
            store_bf16x4(H + (size_t)row * 1024 + c, h4);
#pragma unroll
            for (int j = 0; j < 4; ++j) {
                const float4* wr_ = rwl + ((i * 16 + j * 4) << 6) + lane;
                const float4 w0 = wr_[0], w1 = wr_[64], w2 = wr_[128], w3 = wr_[192];
                lg[0] += hv[j] * w0.x; lg[1] += hv[j] * w0.y; lg[2] += hv[j] * w0.z; lg[3] += hv[j] * w0.w;
                lg[4] += hv[j] * w1.x; lg[5] += hv[j] * w1.y; lg[6] += hv[j] * w1.z; lg[7] += hv[j] * w1.w;
                lg[8] += hv[j] * w2.x; lg[9] += hv[j] * w2.y; lg[10] += hv[j] * w2.z; lg[11] += hv[j] * w2.w;
                lg[12] += hv[j] * w3.x; lg[13] += hv[j] * w3.y; lg[14] += hv[j] * w3.z; lg[15] += hv[j] * w3.w;
            }
        }
        float sc_[16], sel[16];
#pragma unroll
        for (int e = 0; e < 16; ++e) { lg[e] = wsum(lg[e]); sc_[e] = 1.f / (1.f + expf(-lg[e])); sel[e] = sc_[e] + rb[e]; }
        int best = 0; float bestv = -1e30f;
#pragma unroll
        for (int gi = 0; gi < 4; ++gi) {
            float m1 = -1e30f, m2 = -1e30f;
#pragma unroll
            for (int j = 0; j < 4; ++j) { const float s = sel[gi * 4 + j]; if (s > m1) { m2 = m1; m1 = s; } else if (s > m2) m2 = s; }
            const float gs = m1 + m2;
            if (gs > bestv) { bestv = gs; best = gi; }
        }
        float s4[4] = {0.f, 0.f, 0.f, 0.f}, c4[4] = {0.f, 0.f, 0.f, 0.f};
#pragma unroll
        for (int gi = 0; gi < 4; ++gi)
#pragma unroll
            for (int j = 0; j < 4; ++j) if (gi == best) { s4[j] = sel[gi * 4 + j]; c4[j] = sc_[gi * 4 + j]; }
        int i1 = 0; float v1 = s4[0], w1 = c4[0];
#pragma unroll
        for (int j = 1; j < 4; ++j) if (s4[j] > v1) { v1 = s4[j]; i1 = j; w1 = c4[j]; }
        int i2 = -1; float v2 = -1e30f, w2 = 0.f;
#pragma unroll
        for (int j = 0; j < 4; ++j) if (j != i1 && s4[j] > v2) { v2 = s4[j]; i2 = j; w2 = c4[j]; }
        if (lane == 0) {
            const float inv = 1.f / (w1 + w2);
            const int e1 = best * 4 + i1, e2 = best * 4 + i2;
            const unsigned r1 = atomicAdd(&lcnt[e1], 1u), r2 = atomicAdd(&lcnt[e2], 1u);
            int* rc = rec + (wave * 32 + nrec) * 8;
            rc[0] = row; rc[1] = e1; rc[2] = e2; rc[3] = (int)r1; rc[4] = (int)r2; rc[5] = __float_as_int(w1 * inv); rc[6] = __float_as_int(w2 * inv);
        }
        ++nrec;
    }
    __syncthreads();
    if (tid < 16) gbase[tid] = lcnt[tid] ? atomicAdd(&cnt[tid], lcnt[tid]) : 0u;
    __syncthreads();
    for (int i = lane; i < nrec; i += 64) {
        const int* rc = rec + (wave * 32 + i) * 8;
        const int row = rc[0], e1 = rc[1], e2 = rc[2];
        const unsigned p1 = gbase[e1] + (unsigned)rc[3], p2 = gbase[e2] + (unsigned)rc[4];
        LTOK[(size_t)e1 * RT + p1] = row; LW[(size_t)e1 * RT + p1] = __int_as_float(rc[5]);
        LTOK[(size_t)e2 * RT + p2] = row; LW[(size_t)e2 * RT + p2] = __int_as_float(rc[6]);
        SLOT[row * 2] = (e1 << 20) | (int)p1; SLOT[row * 2 + 1] = (e2 << 20) | (int)p2;
    }
}

struct MoeTiles { int tb[17]; int sm; };
__device__ __forceinline__ void moe_tiles(const Params& p, int l, int* s_tb) {
    if (tidx() == 0) {
        const unsigned* cnt = (const unsigned*)(p.ws + O_CNT);
        int a = 0;
        for (int e = 0; e < 16; ++e) { s_tb[e] = a; a += ((int)cnt[e] + 127) >> 7; }
        s_tb[16] = a;
    }
    __syncthreads();
}
__device__ __forceinline__ void ph_e1(const Params& p, int l, char* smem) {
    int* s_tb = (int*)(smem + 73728);
    moe_tiles(p, l, s_tb);
    const bf16_t* H = (const bf16_t*)(p.ws + O_H); bf16_t* ACT = (bf16_t*)(p.ws + O_P);
    const unsigned* cnt = (const unsigned*)(p.ws + O_CNT); const int* LTOK = (const int*)(p.ws + O_LTOK); const float* LW = (const float*)(p.ws + O_LW);
    const int sm = (l < NLAYER - 1) ? RT / 128 : RL / 128;
    const int total = (sm + s_tb[16]) * 8;
    for (int it = blockIdx.x; it < total; it += gridDim.x) {
        const int mt = it >> 3, nt = it & 7;
        int e = 16, erow0 = mt * 128, lt = 0;
        if (mt >= sm) { const int q = mt - sm; e = 0; while (q >= s_tb[e + 1]) ++e; lt = q - s_tb[e]; erow0 = RT + q * 128; }
        const int cnte = (e == 16) ? 0 : (int)cnt[e];
        auto rp = [&](int r) -> const bf16_t* {
            if (e == 16) return H + (size_t)(mt * 128 + r) * 1024;
            const int idx = lt * 128 + r;
            const int tok = idx < cnte ? LTOK[(size_t)e * RT + idx] : 0;
            return H + (size_t)tok * 1024;
        };
        f32x4 acc[4][4];
        gemm_core_g<4>(rp, (const bf16_t*)(p.ws + O_WB + W_GU) + (size_t)e * 1024 * 1024 + (size_t)nt * 128 * 1024, 1024, 1024, acc, smem);
        {
            const int lane = tidx() & 63, wave = tidx() >> 6, wr = wave >> 1, wc = wave & 1, fr = lane & 15, fq = lane >> 4;
            float* U = (float*)smem;
#pragma unroll
            for (int ii = 0; ii < 2; ++ii) {
                const int i = wc == 0 ? 2 + ii : ii;
#pragma unroll
                for (int j = 0; j < 4; ++j) { const f32x4 gv = wc == 0 ? acc[2 + ii][j] : acc[ii][j]; *(f32x4*)(U + (wr * 64 + i * 16 + fr) * 68 + j * 16 + fq * 4) = gv; }
            }
            __syncthreads();
#pragma unroll
            for (int ii = 0; ii < 2; ++ii) {
                const int i = wc == 0 ? ii : 2 + ii;
                const int m = wr * 64 + i * 16 + fr;
                float wgt = 1.f;
                if (e != 16) { const int idx = lt * 128 + m; wgt = idx < cnte ? LW[(size_t)e * RT + idx] : 0.f; }
#pragma unroll
                for (int j = 0; j < 4; ++j) {
                    const f32x4 other = *(const f32x4*)(U + m * 68 + j * 16 + fq * 4);
                    f32x4 o;
                    const f32x4 mine = wc == 0 ? acc[ii][j] : acc[2 + ii][j];
#pragma unroll
                    for (int r = 0; r < 4; ++r) { const float g = wc == 0 ? mine[r] : other[r], u = wc == 0 ? other[r] : mine[r]; o[r] = siluf_(g) * u * wgt; }
                    store_bf16x4(ACT + (size_t)(erow0 + m) * 512 + nt * 64 + j * 16 + fq * 4, o);
                }
            }
            __syncthreads();
        }
    }
}
__device__ __forceinline__ void ph_e2(const Params& p, int l, char* smem) {
    int* s_tb = (int*)(smem + 73728);
    moe_tiles(p, l, s_tb);
    const bf16_t* ACT = (const bf16_t*)(p.ws + O_P); bf16_t* YE = (bf16_t*)(p.ws + O_X + X_YE);
    const int sm = (l < NLAYER - 1) ? RT / 128 : RL / 128;
    const int total = (sm + s_tb[16]) * 8;
    for (int it = blockIdx.x; it < total; it += gridDim.x) {
        const int mt = it >> 3, nt = it & 7;
        int e = 16, erow0 = mt * 128;
        if (mt >= sm) { const int q = mt - sm; e = 0; while (q >= s_tb[e + 1]) ++e; erow0 = RT + q * 128; }
        RPPlain rp{ACT + (size_t)erow0 * 512, 512};
        f32x4 acc[4][4];
        gemm_core_g<4>(rp, (const bf16_t*)(p.ws + O_WB + W_D) + (size_t)e * 1024 * 512 + (size_t)nt * 128 * 512, 512, 512, acc, smem);
        acc_foreach<4>(acc, [&](int m, int n, const f32x4& v) { store_bf16x4(YE + (size_t)(erow0 + m) * 1024 + nt * 128 + n, v); });
    }
}
__device__ __forceinline__ void ph_e3(const Params& p, int l, char* smem) {
    int* s_tb = (int*)(smem + 73728);
    moe_tiles(p, l, s_tb);
    const int lane = tidx() & 63, wave = tidx() >> 6;
    const bf16_t* YE = (const bf16_t*)(p.ws + O_X + X_YE); const int* SLOT = (const int*)(p.ws + O_SLOT);
    float* xcur = (float*)(p.ws + O_XCUR); const float* mod = (const float*)(p.ws + O_MOD);
    bf16_t* H = (bf16_t*)(p.ws + O_H);
    const bool last = l == NLAYER - 1;
    const int nrows = last ? RL : RT;
    const float* gn = last ? p.in[I_FNG] : p.in[I_N1G] + (l + 1) * 1024;
    const int stride = gridDim.x * 4, row0 = blockIdx.x * 4 + wave;
    auto slot_rows = [&](int row, size_t& r1, size_t& r2) {
        const int rr = row < nrows ? row : 0;
        const int s1 = SLOT[rr * 2], s2 = SLOT[rr * 2 + 1];
        r1 = (size_t)RT + s_tb[s1 >> 20] * 128 + (s1 & 0xfffff); r2 = (size_t)RT + s_tb[s2 >> 20] * 128 + (s2 & 0xfffff);
    };
    uint4 ya[2], yb[2], yd[2]; float4 xa[2][2];
    size_t r1n, r2n;
    auto load_row = [&](int row, size_t r1, size_t r2) {
        const size_t rr = row < nrows ? row : 0;
#pragma unroll
        for (int i = 0; i < 2; ++i) {
            const int c = lane * 8 + 512 * i;
            ya[i] = *(const uint4*)(YE + rr * 1024 + c); yb[i] = *(const uint4*)(YE + r1 * 1024 + c); yd[i] = *(const uint4*)(YE + r2 * 1024 + c);
            const float4* xp = (const float4*)(xcur + rr * 1024 + c);
            xa[i][0] = xp[0]; xa[i][1] = xp[1];
        }
    };
    { size_t r1, r2; slot_rows(row0, r1, r2); load_row(row0, r1, r2); slot_rows(row0 + stride, r1n, r2n); }
    for (int row = row0; row < nrows; row += stride) {
        const float* g2 = mod + (size_t)(l * 5 + modidx(row)) * 6144 + 5120;
        float xv[2][8]; float ss = 0.f;
#pragma unroll
        for (int i = 0; i < 2; ++i) {
            const int c = lane * 8 + 512 * i;
            float a[8], b[8], d[8];
            unpack8(ya[i], a); unpack8(yb[i], b); unpack8(yd[i], d);
            const float4 x0 = xa[i][0], x1 = xa[i][1];
            const float4 ga = *(const float4*)(g2 + c), gb = *(const float4*)(g2 + c + 4);
            const float xo[8] = {x0.x, x0.y, x0.z, x0.w, x1.x, x1.y, x1.z, x1.w}, gg[8] = {ga.x, ga.y, ga.z, ga.w, gb.x, gb.y, gb.z, gb.w};
#pragma unroll
            for (int e = 0; e < 8; ++e) { xv[i][e] = xo[e] + gg[e] * (a[e] + b[e] + d[e]); ss += xv[i][e] * xv[i][e]; }
            if (!last) { float4* xp = (float4*)(xcur + (size_t)row * 1024 + c); xp[0] = make_float4(xv[i][0], xv[i][1], xv[i][2], xv[i][3]); xp[1] = make_float4(xv[i][4], xv[i][5], xv[i][6], xv[i][7]); }
        }
        { const size_t r1 = r1n, r2 = r2n; load_row(row + stride, r1, r2); slot_rows(row + 2 * stride, r1n, r2n); }
        ss = wsum(ss);
        const float rstd = rsqrtf(ss * (1.f / 1024.f) + 1e-6f);
        const float* md = mod + (size_t)((l + 1) * 5 + modidx(row)) * 6144;
#pragma unroll
        for (int i = 0; i < 2; ++i) {
            const int c = lane * 8 + 512 * i;
            const float4 n0 = *(const float4*)(gn + c), n1 = *(const float4*)(gn + c + 4);
            const float nn[8] = {n0.x, n0.y, n0.z, n0.w, n1.x, n1.y, n1.z, n1.w};
            if (last) {
                float* op = p.out + (size_t)row * 1024 + c;
                *(float4*)op = make_float4(xv[i][0] * rstd * nn[0], xv[i][1] * rstd * nn[1], xv[i][2] * rstd * nn[2], xv[i][3] * rstd * nn[3]);
                *(float4*)(op + 4) = make_float4(xv[i][4] * rstd * nn[4], xv[i][5] * rstd * nn[5], xv[i][6] * rstd * nn[6], xv[i][7] * rstd * nn[7]);
            } else {
                const float4 c0 = *(const float4*)(md + 1024 + c), c1 = *(const float4*)(md + 1024 + c + 4), h0 = *(const float4*)(md + c), h1 = *(const float4*)(md + c + 4);
                const float sc[8] = {c0.x, c0.y, c0.z, c0.w, c1.x, c1.y, c1.z, c1.w}, sh[8] = {h0.x, h0.y, h0.z, h0.w, h1.x, h1.y, h1.z, h1.w};
                float o[8];
#pragma unroll
                for (int e = 0; e < 8; ++e) o[e] = xv[i][e] * rstd * nn[e] * (1.f + sc[e]) + sh[e];
                *(uint4*)(H + (size_t)row * 1024 + c) = pack8(o);
            }
        }
    }
}
constexpr int LDS_BYTES = 76800;
constexpr int NIV = 19;
extern __shared__ __attribute__((aligned(16))) char dynsmem[];
template <int ID> __device__ __forceinline__ void run_iv(const Params& pin, int l, char* smem) {
    Params p = pin; p.ws = launder(pin.ws);
    if constexpr (ID == 0) { ph_pre(p, smem); __syncthreads(); ph_w(p, 0, smem); }
    else if constexpr (ID == 1) ph_n1(p, l);
    else if constexpr (ID == 2) ph_g1(p, smem);
    else if constexpr (ID == 3) { ph_qu(p, smem); ph_krope(p); ph_rp1(p, l, smem); ph_rp2(p, l); ph_f1(p, l, smem); }
    else if constexpr (ID == 5) {
        const bool r1first = (blockIdx.x >> 8) & 1;
#pragma unroll 1
        for (int pass = 0; pass < 2; ++pass) {
            if ((pass == 0) == r1first) { ph_r1(p, l, smem); ph_fa(p, smem); } else ph_at(p, l, smem);
            __syncthreads();
        }
    }
    else if constexpr (ID == 8) { ph_r2(p, smem); __syncthreads(); ph_fb(p, l, smem); }
    else if constexpr (ID == 9) ph_r3(p, l, smem);
    else if constexpr (ID == 12) ph_mg(p, l, smem);
    else if constexpr (ID == 13) ph_out(p, l, smem);
    else if constexpr (ID == 14) ph_n2(p, l, smem);
    else if constexpr (ID == 15) ph_e1(p, l, smem);
    else if constexpr (ID == 16) ph_e2(p, l, smem);
    else if constexpr (ID == 17) { ph_e3(p, l, smem); __syncthreads(); if (l + 1 < NLAYER) ph_w(p, l + 1, smem); }
}
#if MEGA
#ifndef PROBE_MASK
#define PROBE_MASK 0
#define PROBE_REP 1
#endif
#define IV(ID) for (int r_ = 0; r_ < (((PROBE_MASK >> (ID)) & 1) ? PROBE_REP : 1); ++r_) { run_iv<ID>(p, l, smem); xcd_barrier(bar); }
__global__ void __launch_bounds__(256, 2) k_mega(Params p) {
    char* smem = dynsmem;
    volatile LAS unsigned* st = (volatile LAS unsigned*)(smem + LDS_BYTES - 16);
    if (tidx() == 0) { st[0] = 0u; st[1] = 0u; }
    __syncthreads();
    XcdBarrier bar = xcd_barrier_post((unsigned*)(p.ws + O_BAR), st);
    { const int l = 0; IV(0) }
    for (int l = 0; l < NLAYER; ++l) {
        if (l == 0) { IV(1) } IV(2) IV(3) IV(5) IV(8) IV(9) IV(12) IV(13) IV(14) IV(15) IV(16) IV(17)
    }
}
#else
template <int ID> __global__ void __launch_bounds__(256, 2) k_iv(Params p, int l) { run_iv<ID>(p, l, dynsmem); }
template <int ID> static void launch_iv(const Params& p, int l, int grid, hipStream_t s) {
    static bool once = false; if (!once) { once = true; (void)hipFuncSetAttribute((const void*)k_iv<ID>, hipFuncAttributeMaxDynamicSharedMemorySize, LDS_BYTES); }
    hipLaunchKernelGGL(k_iv<ID>, dim3(grid), dim3(256), LDS_BYTES, s, p, l);
}
#endif

extern "C" void kernel_launch(void* const* d_in, const int* in_sizes, int n_in, void* d_out, int out_size, void* d_ws, size_t ws_size, hipStream_t stream) {
    (void)in_sizes; (void)out_size;
    if (n_in < N_IN || ws_size < WS_NEED) return;
    Params p{};
    for (int i = 0; i < N_IN; ++i) p.in[i] = (const float*)d_in[i];
    p.out = (float*)d_out; p.ws = (char*)d_ws;
    static int grid = 0;
    if (!grid) {
        int dev = 0, cus = 0; (void)hipGetDevice(&dev); (void)hipDeviceGetAttribute(&cus, hipDeviceAttributeMultiprocessorCount, dev);
        int per_cu = 2;
#if MEGA
        (void)hipFuncSetAttribute((const void*)k_mega, hipFuncAttributeMaxDynamicSharedMemorySize, LDS_BYTES);
        int occ = 0; (void)hipOccupancyMaxActiveBlocksPerMultiprocessor(&occ, k_mega, 256, LDS_BYTES);
        if (occ < per_cu) per_cu = occ;
        if (per_cu < 1) per_cu = 1;
#endif
        grid = cus * per_cu;
    }
#if MEGA
    (void)hipMemsetAsync(p.ws + O_BAR, 0, 16384, stream);
    hipLaunchKernelGGL(k_mega, dim3(grid), dim3(256), LDS_BYTES, stream, p);
#else
    launch_iv<0>(p, 0, grid, stream);
    for (int l = 0; l < NLAYER; ++l) {
        if (l == 0) launch_iv<1>(p, l, grid, stream); launch_iv<2>(p, l, grid, stream); launch_iv<3>(p, l, grid, stream);
        launch_iv<5>(p, l, grid, stream); launch_iv<8>(p, l, grid, stream);
        launch_iv<9>(p, l, grid, stream); launch_iv<12>(p, l, grid, stream);
        launch_iv<13>(p, l, grid, stream); launch_iv<14>(p, l, grid, stream); launch_iv<15>(p, l, grid, stream); launch_iv<16>(p, l, grid, stream); launch_iv<17>(p, l, grid, stream);
    }
#endif
}
```

```cpp
#include <hip/hip_runtime.h>
#include <stdint.h>

#ifndef MEGA
#define MEGA 1
#endif

typedef unsigned short bf16_t;
typedef short bf16x8 __attribute__((ext_vector_type(8)));
typedef float f32x4 __attribute__((ext_vector_type(4)));
typedef float f32x2 __attribute__((ext_vector_type(2)));
typedef unsigned u32x4 __attribute__((ext_vector_type(4)));
typedef __bf16 bf16v2 __attribute__((ext_vector_type(2)));

constexpr int NLAYER = 4;
constexpr int DM = 1024;
constexpr int RL = 16384, RC = 1024, RT = RL + RC;
constexpr int SEQ = 4096, CTX = 256, KEYS = SEQ + CTX;
constexpr int LDP = 6144;
constexpr int PQ0 = 512, PKV0 = 896, PKR0 = 1152, PR0 = 1184, PG0 = 2976, PEND = 6048;
constexpr int NEXP = 16;
constexpr int EROWS = 54272;

enum { I_X = 0, I_C, I_CTX, I_CCTX, I_WADA, I_BADA, I_N1G, I_N2G, I_WIN, I_QNG, I_KVNG, I_WUQ, I_WUKV, I_MU, I_W0, I_WUP, I_A0, I_AUP, I_GUP,
       I_KK, I_KA, I_RK, I_GNG, I_GNB, I_WPA, I_WPB, I_WPC, I_WOUT, I_RW, I_RB, I_EG, I_EU, I_ED, I_SG, I_SU, I_SD, I_FNG, N_IN };

struct Params { const float* in[N_IN]; float* out; char* ws; };

constexpr size_t al256(size_t x) { return (x + 255) & ~(size_t)255; }
constexpr size_t O_BAR   = 0;
constexpr size_t O_CNT   = O_BAR + 16384;
constexpr size_t O_MOD   = O_CNT + 4096;
constexpr size_t O_ROPEC = O_MOD + (size_t)NLAYER * 5 * 6144 * 4;
constexpr size_t O_ROPES = O_ROPEC + (size_t)SEQ * 16 * 4;
constexpr size_t O_CSC   = O_ROPES + (size_t)SEQ * 16 * 4;
constexpr size_t O_CST256= O_CSC + 256 * 128 * 2;
constexpr size_t O_D128  = O_CST256 + 256 * 512 * 2;
constexpr size_t O_E64   = O_D128 + 128 * 128 * 2;
constexpr size_t O_TWC   = O_E64 + 64 * 128 * 2;
constexpr size_t O_TWS   = O_TWC + 64 * 64 * 4;
constexpr size_t O_YT2   = O_TWS + 64 * 64 * 4;
constexpr size_t O_A2    = O_YT2 + (size_t)4 * 512 * 64 * 128 * 2;
constexpr size_t O_YTC   = O_A2 + (size_t)4 * 512 * 64 * 128 * 2;
constexpr size_t O_XCUR  = O_YTC + (size_t)4 * 512 * 512 * 2;
constexpr size_t O_WB    = O_XCUR + (size_t)RT * DM * 4;
constexpr size_t W_IN   = 0;
constexpr size_t W_UQ   = W_IN + (size_t)6144 * 1024 * 2;
constexpr size_t W_UKV  = W_UQ + (size_t)768 * 384 * 2;
constexpr size_t W_WUP  = W_UKV + (size_t)1024 * 256 * 2;
constexpr size_t W_AUP  = W_WUP + (size_t)2 * 512 * 64 * 2;
constexpr size_t W_GUP  = W_AUP + (size_t)2 * 512 * 64 * 2;
constexpr size_t W_PA   = W_GUP + (size_t)512 * 128 * 2;
constexpr size_t W_PB   = W_PA + (size_t)1024 * 512 * 2;
constexpr size_t W_PC   = W_PB + (size_t)1024 * 512 * 2;
constexpr size_t W_OUT  = W_PC + (size_t)1024 * 512 * 2;
constexpr size_t W_GU   = W_OUT + (size_t)1024 * 1024 * 2;
constexpr size_t W_D    = W_GU + (size_t)17 * 1024 * 1024 * 2;
constexpr size_t W_END  = W_D + (size_t)17 * 1024 * 512 * 2;
constexpr size_t O_H    = O_WB + W_END;
constexpr size_t O_P    = O_H + (size_t)RT * DM * 2;
constexpr size_t O_ATT  = O_P + (size_t)RT * LDP * 2;
constexpr size_t O_RG   = O_ATT + (size_t)RT * 512 * 2;
constexpr size_t O_RWO  = O_RG + (size_t)RT * 512 * 2;
constexpr size_t O_FA   = O_RWO + (size_t)RT * 512 * 2;
constexpr size_t O_LTOK = O_FA + (size_t)RT * 512 * 2;
constexpr size_t O_LW   = O_LTOK + (size_t)NEXP * RT * 4;
constexpr size_t O_SLOT = O_LW + (size_t)NEXP * RT * 4;
constexpr size_t O_X    = al256(O_SLOT + (size_t)RT * 2 * 4);
constexpr size_t X_QA   = 0;
constexpr size_t X_KA   = X_QA + (size_t)RT * 768 * 2;
constexpr size_t X_VA   = X_KA + (size_t)4 * KEYS * 768 * 2;
constexpr int NCP = 4 * 8 * 2 * 68;
constexpr size_t X_S0   = 0;
constexpr size_t X_MT   = X_VA + (size_t)4 * 8 * 64 * KEYS * 2;
constexpr size_t X_GT   = X_MT + (size_t)NCP * 8192;
constexpr size_t X_YL   = X_GT + (size_t)NCP * 8192;
constexpr size_t X_KKN  = X_YL + (size_t)NCP * 8192;
constexpr size_t X_BON  = X_KKN + (size_t)RT * 8 * 4;
constexpr size_t X_SSQ  = X_BON + (size_t)2 * RT * 8 * 4;
constexpr size_t X_X12  = X_SSQ + (size_t)RT * 10 * 4;
constexpr size_t X_END  = X_X12 + (size_t)RT * 128 * 2;
static_assert(X_S0 + (size_t)NCP * 8192 <= X_VA, "S0 must fit in the q/k area");
constexpr size_t X_YE   = 0;
constexpr size_t WS_NEED = O_X + X_END;

__device__ __forceinline__ float bf2f(bf16_t u) { return __builtin_bit_cast(float, (unsigned)u << 16); }
__device__ __forceinline__ float bflo(unsigned u) { return __builtin_bit_cast(float, u << 16); }
__device__ __forceinline__ float bfhi(unsigned u) { return __builtin_bit_cast(float, u & 0xffff0000u); }
__device__ __forceinline__ unsigned pack2(float lo, float hi) { f32x2 v = {lo, hi}; bf16v2 b = __builtin_convertvector(v, bf16v2); return __builtin_bit_cast(unsigned, b); }
__device__ __forceinline__ bf16_t f2bf(float f) { return (bf16_t)(pack2(f, 0.f) & 0xffffu); }
__device__ __forceinline__ float wsum(float v) {
#pragma unroll
    for (int o = 32; o > 0; o >>= 1) v += __shfl_xor(v, o);
    return v;
}
__device__ __forceinline__ float sigmoidf_(float x) { return __builtin_amdgcn_rcpf(1.f + __expf(-x)); }
__device__ __forceinline__ float siluf_(float x) { return x * __builtin_amdgcn_rcpf(1.f + __expf(-x)); }
__device__ __forceinline__ int modidx(int row) { return row < RL ? (row >> 12) : 4; }
__device__ __forceinline__ void unpack8(const uint4& u, float (&f)[8]) {
    f[0] = bflo(u.x); f[1] = bfhi(u.x); f[2] = bflo(u.y); f[3] = bfhi(u.y); f[4] = bflo(u.z); f[5] = bfhi(u.z); f[6] = bflo(u.w); f[7] = bfhi(u.w);
}
__device__ __forceinline__ uint4 pack8(const float (&f)[8]) { return make_uint4(pack2(f[0], f[1]), pack2(f[2], f[3]), pack2(f[4], f[5]), pack2(f[6], f[7])); }

__device__ __forceinline__ float xmax_16_32(float v) {
    unsigned u = __builtin_bit_cast(unsigned, v);
    auto r = __builtin_amdgcn_permlane32_swap(u, u, false, false);
    float m = fmaxf(__builtin_bit_cast(float, r[0]), __builtin_bit_cast(float, r[1]));
    u = __builtin_bit_cast(unsigned, m);
    auto r2 = __builtin_amdgcn_permlane16_swap(u, u, false, false);
    return fmaxf(__builtin_bit_cast(float, r2[0]), __builtin_bit_cast(float, r2[1]));
}
__device__ __forceinline__ float lane_xor32(float v, int lane) {
    const unsigned u = __builtin_bit_cast(unsigned, v);
    auto r = __builtin_amdgcn_permlane32_swap(u, u, false, false);
    return __builtin_bit_cast(float, lane < 32 ? r[1] : r[0]);
}
__device__ __forceinline__ float xsum_16_32(float v) {
    unsigned u = __builtin_bit_cast(unsigned, v);
    auto r = __builtin_amdgcn_permlane32_swap(u, u, false, false);
    float m = __builtin_bit_cast(float, r[0]) + __builtin_bit_cast(float, r[1]);
    u = __builtin_bit_cast(unsigned, m);
    auto r2 = __builtin_amdgcn_permlane16_swap(u, u, false, false);
    return __builtin_bit_cast(float, r2[0]) + __builtin_bit_cast(float, r2[1]);
}
#define XB_TMO      128
#define XB_XCNT(j)  (256  + 64 * (j))
#define XB_XSUB(j)  (1280 + 64 * (j))
#define XB_XGEN(j)  (2304 + 64 * (j))
#define XB_TOP      3328
#define XB_TOPGEN   3392
#define XCD_BAR_WORDS 3456
#define XB_SPIN_CAP (1u << 22)
#define LAS __attribute__((address_space(3)))
__device__ __forceinline__ unsigned xb_ld(unsigned* p)              { return __hip_atomic_load(p, __ATOMIC_RELAXED, __HIP_MEMORY_SCOPE_AGENT); }
__device__ __forceinline__ unsigned xb_add(unsigned* p, unsigned v) { return __hip_atomic_fetch_add(p, v, __ATOMIC_RELAXED, __HIP_MEMORY_SCOPE_AGENT); }
__device__ __forceinline__ unsigned xb_xcc_id() { return (unsigned)__builtin_amdgcn_s_getreg((3 << 11) | 20) & 0xFu; }
#define XB_SPIN(cond, bar) do { unsigned _sp = 0; while (cond) { __builtin_amdgcn_s_sleep(1); \
    if ((++_sp & 255u) == 0u) { if (xb_ld(&(bar)[XB_TMO])) break; if (_sp > XB_SPIN_CAP) { atomicAdd(&(bar)[XB_TMO], 1u); break; } } } } while (0)
struct XcdBarrier { unsigned* bar; unsigned x; volatile LAS unsigned* st; };
__device__ __forceinline__ XcdBarrier xcd_barrier_post(unsigned* bar, volatile LAS unsigned* st) {
    XcdBarrier b; b.bar = bar; b.x = xb_xcc_id(); b.st = st;
    if (threadIdx.x == 0) (void)xb_add(&bar[XB_XCNT(b.x)], 1u);
    return b;
}
__device__ __forceinline__ void xcd_barrier_complete(unsigned* bar, unsigned x, unsigned& nloc, unsigned& nx) {
    const unsigned G = gridDim.x * gridDim.y * gridDim.z;
    unsigned sum, cnt, mine, sp = 0u;
    for (;;) {
        sum = 0u; cnt = 0u; mine = 0u;
#pragma unroll
        for (unsigned j = 0; j < 16; ++j) { const unsigned c = xb_ld(&bar[XB_XCNT(j)]); sum += c; cnt += (c > 0u) ? 1u : 0u; mine = (j == x) ? c : mine; }
        if (sum == G) break;
        __builtin_amdgcn_s_sleep(1);
        if ((++sp & 255u) == 0u) { if (xb_ld(&bar[XB_TMO])) break; if (sp > XB_SPIN_CAP) { atomicAdd(&bar[XB_TMO], 1u); break; } }
    }
    nloc = mine > 0u ? mine : 1u; nx = cnt > 0u ? cnt : 1u;
}
__device__ __forceinline__ void xcd_barrier(const XcdBarrier& b) {
    asm volatile("s_waitcnt vmcnt(0)" ::: "memory");
    __syncthreads();
    if (threadIdx.x == 0) {
        unsigned* bar = b.bar;
        __builtin_amdgcn_s_waitcnt(0);
        unsigned nloc = b.st[0], nx = b.st[1];
        if (nloc == 0u) { xcd_barrier_complete(bar, b.x, nloc, nx); b.st[0] = nloc; b.st[1] = nx; }
        const unsigned old = xb_add(&bar[XB_XSUB(b.x)], 1u);
        const unsigned gen = old / nloc;
        if (old + 1u == (gen + 1u) * nloc) {
            __builtin_amdgcn_fence(__ATOMIC_RELEASE, "agent");
            asm volatile("s_waitcnt vmcnt(0)" ::: "memory");
            const unsigned og = xb_add(&bar[XB_TOP], 1u);
            const unsigned tg = og / nx;
            if (og + 1u == (tg + 1u) * nx) xb_add(&bar[XB_TOPGEN], 1u);
            else XB_SPIN(xb_ld(&bar[XB_TOPGEN]) == tg, bar);
            __builtin_amdgcn_fence(__ATOMIC_ACQUIRE, "agent");
            xb_add(&bar[XB_XGEN(b.x)], 1u);
            asm volatile("s_waitcnt vmcnt(0)" ::: "memory");
        } else {
            XB_SPIN(xb_ld(&bar[XB_XGEN(b.x)]) == gen, bar);
            __builtin_amdgcn_fence(__ATOMIC_ACQUIRE, "agent");
            asm volatile("s_waitcnt vmcnt(0)" ::: "memory");
        }
    }
    __syncthreads();
}

__device__ __forceinline__ int tidx() { int t = threadIdx.x; asm volatile("" : "+v"(t)); return t; }
__device__ __forceinline__ int lv(int x) { asm volatile("" : "+v"(x)); return x; }
__device__ __forceinline__ char* launder(char* p) { size_t z = 0; asm volatile("" : "+s"(z)); return p + z; }

constexpr int LDSROW = 72;
template <int NA, class AL>
__device__ __forceinline__ void gc_load(const AL& al, const bf16_t* bp, size_t bstep, int k0, int kc, u32x4 (&ra)[NA], u32x4 (&rb)[4]) {
#pragma unroll
    for (int i = 0; i < NA; ++i) ra[i] = __builtin_bit_cast(u32x4, al.load(i, k0 + kc));
#pragma unroll
    for (int j = 0; j < 4; ++j) rb[j] = *(const u32x4*)(bp + j * bstep + k0);
}
template <int NA>
__device__ __forceinline__ void gc_store(bf16_t* Ab, bf16_t* Bb, int lr, int kc, const u32x4 (&ra)[NA], const u32x4 (&rb)[4]) {
#pragma unroll
    for (int i = 0; i < NA; ++i) *(u32x4*)(Ab + (lr + 32 * i) * LDSROW + kc) = ra[i];
#pragma unroll
    for (int j = 0; j < 4; ++j) *(u32x4*)(Bb + (lr + 32 * j) * LDSROW + kc) = rb[j];
}
template <int MI>
__device__ __forceinline__ void gc_compute(const bf16_t* Ac, const bf16_t* Bc, f32x4 (&acc)[MI][4]) {
#pragma unroll
    for (int kh = 0; kh < 2; ++kh) {
        bf16x8 af[MI], bfv[4];
#pragma unroll
        for (int i = 0; i < MI; ++i) af[i] = *(const bf16x8*)(Ac + i * 16 * LDSROW + kh * 32);
#pragma unroll
        for (int j = 0; j < 4; ++j) bfv[j] = *(const bf16x8*)(Bc + j * 16 * LDSROW + kh * 32);
#pragma unroll
        for (int i = 0; i < MI; ++i)
#pragma unroll
            for (int j = 0; j < 4; ++j) acc[i][j] = __builtin_amdgcn_mfma_f32_16x16x32_bf16(bfv[j], af[i], acc[i][j], 0, 0, 0);
    }
}
template <int MI, class AL>
__device__ __forceinline__ void gemm_core(const AL& al, const bf16_t* __restrict__ Bt, int ldb, int K, f32x4 (&acc)[MI][4], char* smem) {
    constexpr int TM = MI * 32;
    constexpr int NA = TM / 32;
    bf16_t* As = (bf16_t*)smem;
    bf16_t* Bs = As + 2 * TM * LDSROW;
    const int tid = tidx(), lane = tid & 63, wave = tid >> 6;
    const int wr = wave >> 1, wc = wave & 1, fr = lane & 15, fq = lane >> 4;
    const int kc = (tid & 7) * 8, lr = tid >> 3;
#pragma unroll
    for (int i = 0; i < MI; ++i)
#pragma unroll
        for (int j = 0; j < 4; ++j) acc[i][j] = (f32x4){0.f, 0.f, 0.f, 0.f};
    u32x4 a0[NA], b0[4], a1[NA], b1[4];
    const bf16_t* bp = Bt + (size_t)lr * ldb + kc;
    const size_t bstep = (size_t)32 * ldb;
    const int nk = K >> 6;
    bf16_t* As1 = As + TM * LDSROW; bf16_t* Bs1 = Bs + 128 * LDSROW;
    const int aoff = (wr * MI * 16 + fr) * LDSROW + fq * 8, boff = (wc * 64 + fr) * LDSROW + fq * 8;
    gc_load<NA>(al, bp, bstep, 0, kc, a0, b0);
    gc_store<NA>(As, Bs, lr, kc, a0, b0);
    if (nk > 1) gc_load<NA>(al, bp, bstep, 64, kc, a0, b0);
    __syncthreads();
    for (int kt = 0; kt < nk; kt += 2) {
        if (kt + 2 < nk) gc_load<NA>(al, bp, bstep, (kt + 2) << 6, kc, a1, b1);
        gc_compute<MI>(As + aoff, Bs + boff, acc);
        if (kt + 1 < nk) gc_store<NA>(As1, Bs1, lr, kc, a0, b0);
        __syncthreads();
        if (kt + 1 >= nk) break;
        if (kt + 3 < nk) gc_load<NA>(al, bp, bstep, (kt + 3) << 6, kc, a0, b0);
        gc_compute<MI>(As1 + aoff, Bs1 + boff, acc);
        if (kt + 2 < nk) gc_store<NA>(As, Bs, lr, kc, a1, b1);
        __syncthreads();
    }
}
template <int MI, class RP, class RPB>
__device__ __forceinline__ void gemm_core_gb(const RP& rp, const RPB& rpb, int K, f32x4 (&acc)[MI][4], char* smem) {
    constexpr int ABYTES = MI * 32 * 128;
    constexpr int SBYTES = ABYTES + 16384;
    const int tid = tidx(), lane = tid & 63, wave = tid >> 6;
    const int wr = wave >> 1, wc = wave & 1, fr = lane & 15, fq = lane >> 4;
    const int rr = lane >> 3, cs = ((lane & 7) ^ ((wave * 4 + (lane >> 4)) & 7)) * 8;
#pragma unroll
    for (int i = 0; i < MI; ++i)
#pragma unroll
        for (int j = 0; j < 4; ++j) acc[i][j] = (f32x4){0.f, 0.f, 0.f, 0.f};
    const bf16_t* ap[MI]; const bf16_t* bp[4];
#pragma unroll
    for (int i = 0; i < MI; ++i) { const int r = (i * 4 + wave) * 8 + rr; ap[i] = rp(r) + cs; }
#pragma unroll
    for (int i = 0; i < 4; ++i) { const int r = (i * 4 + wave) * 8 + rr; bp[i] = rpb(r) + cs; }
    const int wbase = __builtin_amdgcn_readfirstlane(wave) * 1024;
    const int nk = K >> 6;
    auto stage = [&](int buf, int kt) {
        char* Ab = smem + buf * SBYTES + wbase; char* Bb = Ab + ABYTES;
#pragma unroll
        for (int i = 0; i < MI; ++i) __builtin_amdgcn_global_load_lds((const unsigned*)(ap[i] + kt * 64), (unsigned*)(Ab + i * 4096), 16, 0, 0);
#pragma unroll
        for (int i = 0; i < 4; ++i) __builtin_amdgcn_global_load_lds((const unsigned*)(bp[i] + kt * 64), (unsigned*)(Bb + i * 4096), 16, 0, 0);
    };
    const int aoff = (wr * MI * 16 + fr) * 128, boff = ABYTES + (wc * 64 + fr) * 128, sw = fr >> 1;
    stage(0, 0);
    asm volatile("s_waitcnt vmcnt(0)" ::: "memory");
    __syncthreads();
    for (int kt = 0; kt < nk; ++kt) {
        const int cur = kt & 1;
        if (kt + 1 < nk) stage(cur ^ 1, kt + 1);
        const char* base = smem + cur * SBYTES;
#pragma unroll
        for (int kh = 0; kh < 2; ++kh) {
            const int xo = ((kh * 4 + fq) ^ sw) * 16;
            bf16x8 af[MI], bfv[4];
#pragma unroll
            for (int i = 0; i < MI; ++i) af[i] = *(const bf16x8*)(base + aoff + i * 2048 + xo);
#pragma unroll
            for (int j = 0; j < 4; ++j) bfv[j] = *(const bf16x8*)(base + boff + j * 2048 + xo);
#pragma unroll
            for (int i = 0; i < MI; ++i)
#pragma unroll
                for (int j = 0; j < 4; ++j) acc[i][j] = __builtin_amdgcn_mfma_f32_16x16x32_bf16(bfv[j], af[i], acc[i][j], 0, 0, 0);
        }
        asm volatile("s_waitcnt vmcnt(0)" ::: "memory");
        __syncthreads();
    }
}
struct RPPlain;
template <int MI, class RP>
__device__ __forceinline__ void gemm_core_g(const RP& rp, const bf16_t* __restrict__ Bt, int ldb, int K, f32x4 (&acc)[MI][4], char* smem);
struct RPPlain {
    const bf16_t* A; size_t lda;
    __device__ __forceinline__ const bf16_t* operator()(int r) const { return A + (size_t)r * lda; }
};
template <int MI, class RP>
__device__ __forceinline__ void gemm_core_g(const RP& rp, const bf16_t* __restrict__ Bt, int ldb, int K, f32x4 (&acc)[MI][4], char* smem) {
    RPPlain rpb{Bt, (size_t)ldb};
    gemm_core_gb<MI>(rp, rpb, K, acc, smem);
}
template <int MI, class F>
__device__ __forceinline__ void acc_foreach(const f32x4 (&acc)[MI][4], F f) {
    const int lane = tidx() & 63, wave = tidx() >> 6;
    const int wr = wave >> 1, wc = wave & 1, fr = lane & 15, fq = lane >> 4;
#pragma unroll
    for (int i = 0; i < MI; ++i)
#pragma unroll
        for (int j = 0; j < 4; ++j) f(wr * MI * 16 + i * 16 + fr, wc * 64 + j * 16 + fq * 4, acc[i][j]);
}
struct ALPlain {
    const bf16_t* p0; size_t step;
    __device__ __forceinline__ ALPlain(const bf16_t* A, int lda, int row0) { p0 = A + (size_t)(row0 + (tidx() >> 3)) * lda; step = (size_t)32 * lda; }
    __device__ __forceinline__ uint4 load(int i, int k) const { return *(const uint4*)(p0 + i * step + k); }
};
__device__ __forceinline__ void store_bf16x4(bf16_t* dst, const f32x4& v) { *(uint2*)dst = make_uint2(pack2(v[0], v[1]), pack2(v[2], v[3])); }

__device__ __forceinline__ void ph_pre(const Params& p, char* smem) {
    const int tid = tidx(), nb = gridDim.x, bid = blockIdx.x;
    float* mod = (float*)(p.ws + O_MOD);
    {
        float* sv = (float*)smem;
        float* part = sv + 5 * 1024;
        for (int i = tid; i < 5 * 1024; i += 256) { const float v = (i < 4096) ? p.in[I_C][i] : p.in[I_CCTX][i - 4096]; sv[i] = siluf_(v); }
        __syncthreads();
        for (int it = bid; it < NLAYER * 96; it += nb) {
            const int l = it / 96, jb = it % 96;
            const int jj = tid & 63, kq = tid >> 6, j = jb * 64 + jj;
            const float* w = p.in[I_WADA] + (size_t)l * 1024 * 6144 + (size_t)(kq * 256) * 6144 + j;
            float a0 = 0.f, a1 = 0.f, a2 = 0.f, a3 = 0.f, a4 = 0.f;
#pragma unroll 8
            for (int k = 0; k < 256; ++k) {
                const float wv = w[(size_t)k * 6144]; const int kk = kq * 256 + k;
                a0 += sv[kk] * wv; a1 += sv[1024 + kk] * wv; a2 += sv[2048 + kk] * wv; a3 += sv[3072 + kk] * wv; a4 += sv[4096 + kk] * wv;
            }
            part[(kq * 5 + 0) * 64 + jj] = a0; part[(kq * 5 + 1) * 64 + jj] = a1; part[(kq * 5 + 2) * 64 + jj] = a2;
            part[(kq * 5 + 3) * 64 + jj] = a3; part[(kq * 5 + 4) * 64 + jj] = a4;
            __syncthreads();
            for (int o = tid; o < 320; o += 256) {
                const int i = o >> 6, c = o & 63;
                const float s = part[(0 * 5 + i) * 64 + c] + part[(1 * 5 + i) * 64 + c] + part[(2 * 5 + i) * 64 + c] + part[(3 * 5 + i) * 64 + c];
                mod[(size_t)(l * 5 + i) * 6144 + jb * 64 + c] = s + p.in[I_BADA][l * 6144 + jb * 64 + c];
            }
            __syncthreads();
        }
    }
    {
        float4* xc = (float4*)(p.ws + O_XCUR);
        const float4* x4 = (const float4*)p.in[I_X]; const float4* c4 = (const float4*)p.in[I_CTX];
        for (size_t i = (size_t)bid * 256 + tid; i < (size_t)RT * 256; i += (size_t)nb * 256) xc[i] = (i < (size_t)RL * 256) ? x4[i] : c4[i - (size_t)RL * 256];
    }
    {
        float* ct = (float*)smem;
        __syncthreads();
        for (int m = tid; m < 4096; m += 256) ct[m] = cospif((float)m * (1.f / 2048.f));
        __syncthreads();
        bf16_t* cst2 = (bf16_t*)(p.ws + O_CST256);
        for (int ch = bid * 256 + tid; ch < 256 * 512 / 8; ch += nb * 256) {
            const int ks = ch >> 6, c0 = (ch & 63) * 8, part = c0 >> 8, s0 = c0 & 255;
            float f[8];
#pragma unroll
            for (int e = 0; e < 8; ++e) { const int m = (16 * ks * (s0 + e)) & 4095; f[e] = part == 0 ? ct[m] : ct[(m - 1024) & 4095]; }
            *(uint4*)(cst2 + ch * 8) = pack8(f);
        }
        bf16_t* d128 = (bf16_t*)(p.ws + O_D128);
        for (int ch = bid * 256 + tid; ch < 128 * 128 / 8; ch += nb * 256) {
            const int mrow = ch >> 4, c0 = (ch & 15) * 8, po = mrow >> 6, k1 = mrow & 63, pi = c0 >> 6, t10 = c0 & 63;
            float f[8];
#pragma unroll
            for (int e = 0; e < 8; ++e) {
                const int m = (64 * k1 * (t10 + e)) & 4095; const float cv = ct[m], sv = ct[(m - 1024) & 4095];
                f[e] = (po == pi) ? cv : (po == 0 ? sv : -sv);
            }
            *(uint4*)(d128 + ch * 8) = pack8(f);
        }
        bf16_t* e64 = (bf16_t*)(p.ws + O_E64);
        for (int ch = bid * 256 + tid; ch < 64 * 128 / 8; ch += nb * 256) {
            const int k2 = ch >> 4, c0 = (ch & 15) * 8, po = c0 >> 6, t20 = c0 & 63;
            float f[8];
#pragma unroll
            for (int e = 0; e < 8; ++e) { const int m = (64 * k2 * (t20 + e)) & 4095; f[e] = po == 0 ? ct[m] : ct[(m - 1024) & 4095]; }
            *(uint4*)(e64 + ch * 8) = pack8(f);
        }
        float* twc = (float*)(p.ws + O_TWC); float* tws = (float*)(p.ws + O_TWS);
        for (int i = bid * 256 + tid; i < 64 * 64; i += nb * 256) {
            const int k1 = i >> 6, t2 = i & 63, m = (k1 * t2) & 4095;
            twc[i] = ct[m]; tws[i] = -ct[(m - 1024) & 4095];
        }
        bf16_t* csc = (bf16_t*)(p.ws + O_CSC);
        for (int ch = bid * 256 + tid; ch < 256 * 128 / 8; ch += nb * 256) {
            const int n = ch >> 4, c0 = (ch & 15) * 8, part = n >> 7, kc = n & 127;
            float f[8];
#pragma unroll
            for (int e = 0; e < 8; ++e) { const int m = (32 * kc * (c0 + e)) & 4095; f[e] = part == 0 ? ct[m] : -ct[(m - 1024) & 4095]; }
            *(uint4*)(csc + ch * 8) = pack8(f);
        }
        float* rc = (float*)(p.ws + O_ROPEC); float* rs = (float*)(p.ws + O_ROPES);
        for (int i = bid * 256 + tid; i < SEQ * 16; i += nb * 256) {
            const int t = i >> 4, ax = (i >> 3) & 1, f = i & 7;
            const float inv = powf(10000.f, -(float)f / 8.f);
            const float pos = (float)(ax == 0 ? (t >> 6) : (t & 63));
            const float ang = pos * inv;
            rc[i] = cosf(ang); rs[i] = sinf(ang);
        }
    }
}

struct ConvTask { const float* src; const float* scale; bf16_t* dst; int K, Nsrc, Ndst, rmul; size_t sbs, dbs; };
__constant__ int c_conv_cum[17] = {0, 1536, 1608, 1672, 1688, 1704, 1720, 1848, 1976, 2104, 2360, 4408, 6456, 8504, 8632, 8760, 8888};
__device__ __forceinline__ ConvTask conv_task(const Params& p, int l, int t) {
    bf16_t* wb = (bf16_t*)(p.ws + O_WB);
    ConvTask c; c.scale = nullptr; c.sbs = 0; c.dbs = 0; c.rmul = 64;
    switch (t) {
    case 0:  c.src = p.in[I_WIN] + (size_t)l * 1024 * 6048; c.K = 1024; c.Nsrc = 6048; c.Ndst = 6144; c.dst = wb + W_IN / 2; break;
    case 1:  c.src = p.in[I_WUQ] + (size_t)l * 384 * 768; c.K = 384; c.Nsrc = 768; c.Ndst = 768; c.dst = wb + W_UQ / 2; c.scale = p.in[I_QNG] + l * 384; break;
    case 2:  c.src = p.in[I_WUKV] + (size_t)l * 256 * 1024; c.K = 256; c.Nsrc = 1024; c.Ndst = 1024; c.dst = wb + W_UKV / 2; c.scale = p.in[I_KVNG] + l * 256; break;
    case 3:  c.src = p.in[I_WUP] + (size_t)l * 2 * 64 * 512; c.K = 64; c.Nsrc = 512; c.Ndst = 512; c.dst = wb + W_WUP / 2; c.sbs = 64 * 512; c.dbs = 512 * 64; break;
    case 4:  c.src = p.in[I_AUP] + (size_t)l * 2 * 64 * 512; c.K = 64; c.Nsrc = 512; c.Ndst = 512; c.dst = wb + W_AUP / 2; c.sbs = 64 * 512; c.dbs = 512 * 64; break;
    case 5:  c.src = p.in[I_GUP] + (size_t)l * 128 * 512; c.K = 128; c.Nsrc = 512; c.Ndst = 512; c.dst = wb + W_GUP / 2; break;
    case 6:  c.src = p.in[I_WPA] + (size_t)l * 512 * 1024; c.K = 512; c.Nsrc = 1024; c.Ndst = 1024; c.dst = wb + W_PA / 2; break;
    case 7:  c.src = p.in[I_WPB] + (size_t)l * 512 * 1024; c.K = 512; c.Nsrc = 1024; c.Ndst = 1024; c.dst = wb + W_PB / 2; break;
    case 8:  c.src = p.in[I_WPC] + (size_t)l * 512 * 1024; c.K = 512; c.Nsrc = 1024; c.Ndst = 1024; c.dst = wb + W_PC / 2; break;
    case 9:  c.src = p.in[I_WOUT] + (size_t)l * 1024 * 1024; c.K = 1024; c.Nsrc = 1024; c.Ndst = 1024; c.dst = wb + W_OUT / 2; break;
    case 10: c.src = p.in[I_EG] + (size_t)l * 16 * 1024 * 512; c.K = 1024; c.Nsrc = 512; c.Ndst = 512; c.dst = wb + W_GU / 2; c.sbs = 1024 * 512; c.dbs = 1024 * 1024; c.rmul = 128; break;
    case 11: c.src = p.in[I_EU] + (size_t)l * 16 * 1024 * 512; c.K = 1024; c.Nsrc = 512; c.Ndst = 512; c.dst = wb + W_GU / 2 + 64 * 1024; c.sbs = 1024 * 512; c.dbs = 1024 * 1024; c.rmul = 128; break;
    case 12: c.src = p.in[I_ED] + (size_t)l * 16 * 512 * 1024; c.K = 512; c.Nsrc = 1024; c.Ndst = 1024; c.dst = wb + W_D / 2; c.sbs = 512 * 1024; c.dbs = 1024 * 512; break;
    case 13: c.src = p.in[I_SG] + (size_t)l * 1024 * 512; c.K = 1024; c.Nsrc = 512; c.Ndst = 512; c.dst = wb + W_GU / 2 + (size_t)16 * 1024 * 1024; c.rmul = 128; break;
    case 14: c.src = p.in[I_SU] + (size_t)l * 1024 * 512; c.K = 1024; c.Nsrc = 512; c.Ndst = 512; c.dst = wb + W_GU / 2 + (size_t)16 * 1024 * 1024 + 64 * 1024; c.rmul = 128; break;
    default: c.src = p.in[I_SD] + (size_t)l * 512 * 1024; c.K = 512; c.Nsrc = 1024; c.Ndst = 1024; c.dst = wb + W_D / 2 + (size_t)16 * 1024 * 512; break;
    }
    return c;
}
__device__ __forceinline__ void ph_w(const Params& p, int l, char* smem) {
    const int tid = tidx();
    float* tl = (float*)smem;
    for (int g = blockIdx.x; g < 8888; g += gridDim.x) {
        int t = 0;
        while (g >= c_conv_cum[t + 1]) ++t;
        const ConvTask c = conv_task(p, l, t);
        int r = g - c_conv_cum[t];
        const int nkt = c.K >> 6, nnt = c.Ndst >> 6;
        const int bi = r / (nkt * nnt); r -= bi * nkt * nnt;
        const int k0 = (r / nnt) * 64, n0 = (r % nnt) * 64;
        const float* src = c.src + bi * c.sbs; bf16_t* dst = c.dst + bi * c.dbs;
#pragma unroll
        for (int i = 0; i < 4; ++i) {
            const int k = (tid >> 4) + 16 * i, n = n0 + (tid & 15) * 4;
            float4 v = make_float4(0.f, 0.f, 0.f, 0.f);
            if (n < c.Nsrc) v = *(const float4*)(src + (size_t)(k0 + k) * c.Nsrc + n);
            if (c.scale) { const float s = c.scale[k0 + k]; v.x *= s; v.y *= s; v.z *= s; v.w *= s; }
            float* d = tl + k * 65 + (tid & 15) * 4;
            d[0] = v.x; d[1] = v.y; d[2] = v.z; d[3] = v.w;
        }
        __syncthreads();
        {
            const int n = tid >> 2, kk0 = (tid & 3) * 16;
            float f[8], g2[8];
#pragma unroll
            for (int j = 0; j < 8; ++j) { f[j] = tl[(kk0 + j) * 65 + n]; g2[j] = tl[(kk0 + 8 + j) * 65 + n]; }
            bf16_t* d = dst + (size_t)((n0 >> 6) * c.rmul + n) * c.K + k0 + kk0;
            *(uint4*)d = pack8(f); *(uint4*)(d + 8) = pack8(g2);
        }
        __syncthreads();
    }
}

__device__ __forceinline__ void ph_n1(const Params& p, int l) {
    const int lane = tidx() & 63, wave = tidx() >> 6;
    const float* xcur = (const float*)(p.ws + O_XCUR); const float* mod = (const float*)(p.ws + O_MOD);
    bf16_t* H = (bf16_t*)(p.ws + O_H);
    const float* g = p.in[I_N1G] + l * 1024;
    for (int row = blockIdx.x * 4 + wave; row < RT; row += gridDim.x * 4) {
        const float* x = xcur + (size_t)row * 1024; const float* md = mod + (size_t)(l * 5 + modidx(row)) * 6144;
        float4 v[4]; float ss = 0.f;
#pragma unroll
        for (int i = 0; i < 4; ++i) { v[i] = *(const float4*)(x + lane * 4 + 256 * i); ss += v[i].x * v[i].x + v[i].y * v[i].y + v[i].z * v[i].z + v[i].w * v[i].w; }
        ss = wsum(ss);
        const float rstd = rsqrtf(ss * (1.f / 1024.f) + 1e-6f);
#pragma unroll
        for (int i = 0; i < 4; ++i) {
            const int c = lane * 4 + 256 * i;
            const float4 gg = *(const float4*)(g + c), sc = *(const float4*)(md + 1024 + c), sh = *(const float4*)(md + c);
            f32x4 h = {v[i].x * rstd * gg.x * (1.f + sc.x) + sh.x, v[i].y * rstd * gg.y * (1.f + sc.y) + sh.y,
                       v[i].z * rstd * gg.z * (1.f + sc.z) + sh.z, v[i].w * rstd * gg.w * (1.f + sc.w) + sh.w};
            store_bf16x4(H + (size_t)row * 1024 + c, h);
        }
    }
}

__device__ __forceinline__ void ph_g1(const Params& p, char* smem) {
    if (blockIdx.x == 0 && tidx() < 64) ((unsigned*)(p.ws + O_CNT))[tidx()] = 0u;
    const bf16_t* H = (const bf16_t*)(p.ws + O_H); const bf16_t* W = (const bf16_t*)(p.ws + O_WB + W_IN);
    bf16_t* P = (bf16_t*)(p.ws + O_P);
    for (int it = blockIdx.x; it < 136 * 48; it += gridDim.x) {
        const int mt = it / 48, nt = it % 48;
        f32x4 acc[4][4];
        RPPlain rp{H + (size_t)mt * 128 * 1024, 1024};
        gemm_core_g<4>(rp, W + (size_t)nt * 128 * 1024, 1024, 1024, acc, smem);
        acc_foreach<4>(acc, [&](int m, int n, const f32x4& v) {
            const int col = nt * 128 + n; f32x4 o = v;
            if (col >= PG0 && col < PEND) { o[0] = sigmoidf_(v[0]); o[1] = sigmoidf_(v[1]); o[2] = sigmoidf_(v[2]); o[3] = sigmoidf_(v[3]); }
            store_bf16x4(P + (size_t)(mt * 128 + m) * LDP + col, o);
        });
        if (nt >= 4 && nt <= 8) {
            const int lane = tidx() & 63, wave = tidx() >> 6, wr = wave >> 1, wc = wave & 1, fr = lane & 15, fq = lane >> 4;
            float* SSQ = (float*)(p.ws + O_X + X_SSQ);
#pragma unroll
            for (int i = 0; i < 4; ++i) {
                float sq = 0.f;
#pragma unroll
                for (int j = 0; j < 4; ++j)
#pragma unroll
                    for (int r = 0; r < 4; ++r) sq += acc[i][j][r] * acc[i][j][r];
                sq = xsum_16_32(sq);
                if (fq == 0) SSQ[(size_t)(mt * 128 + wr * 64 + i * 16 + fr) * 10 + (nt - 4) * 2 + wc] = sq;
            }
        }
    }
}

constexpr float QSCALE = 0.10206207261596575f * 1.4426950408889634f;
__device__ __forceinline__ void ph_qu(const Params& p, char* smem) {
    const bf16_t* P = (const bf16_t*)(p.ws + O_P); const float* SSQ = (const float*)(p.ws + O_X + X_SSQ);
    bf16_t* QA = (bf16_t*)(p.ws + O_X + X_QA); bf16_t* KA = (bf16_t*)(p.ws + O_X + X_KA); bf16_t* VA = (bf16_t*)(p.ws + O_X + X_VA);
    const float* rc = (const float*)(p.ws + O_ROPEC); const float* rs = (const float*)(p.ws + O_ROPES);
    for (int it = blockIdx.x; it < 136 * 14; it += gridDim.x) {
        const int mt = it / 14, nn = it % 14;
        const int row0 = mt * 128;
        const bool lat = row0 < RL;
        const int b = lat ? (row0 >> 12) : ((row0 - RL) >> 8), t0 = lat ? (row0 & 4095) : ((row0 - RL) & 255);
        const size_t key0 = lat ? t0 : SEQ + t0;
        const int lane = tidx() & 63, wave = tidx() >> 6, wr = wave >> 1, wc = wave & 1, fr = lane & 15, fq = lane >> 4;
        f32x4 acc[4][4];
        if (nn < 6) {
            RPPlain rp{P + (size_t)row0 * LDP + PQ0, LDP};
            gemm_core_g<4>(rp, (const bf16_t*)(p.ws + O_WB + W_UQ) + (size_t)nn * 128 * 384, 384, 384, acc, smem);
#pragma unroll
            for (int i = 0; i < 4; ++i) {
                const int m = wr * 64 + i * 16 + fr, row = row0 + m, t = t0 + m;
                const float* sp = SSQ + (size_t)row * 10;
                const float rq = rsqrtf((sp[0] + sp[1] + sp[2] + sp[3] + sp[4] + sp[5]) * (1.f / 384.f) + 1e-6f);
#pragma unroll
                for (int j = 0; j < 4; ++j) {
                    const int n0 = nn * 128 + wc * 64 + j * 16, hg = (n0 >> 4) % 6;
                    f32x4 o = acc[i][j] * rq;
                    if (hg >= 4 && lat) {
                        const int ax = hg - 4, half = fq >> 1;
                        const float4 c4 = *(const float4*)(rc + t * 16 + ax * 8 + (fq & 1) * 4), s4 = *(const float4*)(rs + t * 16 + ax * 8 + (fq & 1) * 4);
                        const float cc[4] = {c4.x, c4.y, c4.z, c4.w}, ss[4] = {s4.x, s4.y, s4.z, s4.w};
#pragma unroll
                        for (int r = 0; r < 4; ++r) {
                            const float xp = lane_xor32(o[r], lane);
                            o[r] = half ? (o[r] * cc[r] + xp * ss[r]) : (o[r] * cc[r] - xp * ss[r]);
                        }
                    }
                    o *= QSCALE;
                    store_bf16x4(QA + (size_t)row * 768 + n0 + fq * 4, o);
                }
            }
        } else {
            const int h = nn - 6;
            RPPlain rp{P + (size_t)row0 * LDP + PKV0, LDP};
            gemm_core_g<4>(rp, (const bf16_t*)(p.ws + O_WB + W_UKV) + (size_t)h * 128 * 256, 256, 256, acc, smem);
            bf16_t* vt = (bf16_t*)smem;
#pragma unroll
            for (int i = 0; i < 4; ++i) {
                const int m = wr * 64 + i * 16 + fr, row = row0 + m;
                const float* sp = SSQ + (size_t)row * 10;
                const float rkv = rsqrtf((sp[6] + sp[7] + sp[8] + sp[9]) * (1.f / 256.f) + 1e-6f);
#pragma unroll
                for (int j = 0; j < 4; ++j) {
                    const f32x4 o = acc[i][j] * rkv;
                    if (wc == 0) store_bf16x4(KA + ((size_t)b * KEYS + key0 + m) * 768 + h * 96 + j * 16 + fq * 4, o);
                    else store_bf16x4(vt + m * 72 + j * 16 + fq * 4, o);
                }
            }
            __syncthreads();
#pragma unroll
            for (int u = 0; u < 4; ++u) {
                const int q = tidx() + 256 * u, dd = q >> 4, kc = q & 15;
                float f[8];
#pragma unroll
                for (int e = 0; e < 8; ++e) f[e] = bf2f(vt[(kc * 8 + e) * 72 + dd]);
                const uint4 uu = pack8(f);
                bf16_t* dst = VA + ((size_t)(b * 8 + h) * 64 + dd) * KEYS + key0 + (kc >> 2) * 32 + (kc & 1) * 16 + ((kc & 3) >> 1) * 4;
                *(uint2*)dst = make_uint2(uu.x, uu.y); *(uint2*)(dst + 8) = make_uint2(uu.z, uu.w);
            }
            __syncthreads();
        }
    }
}
__device__ __forceinline__ void ph_krope(const Params& p) {
    const int lane = tidx() & 63, wave = tidx() >> 6;
    const bf16_t* P = (const bf16_t*)(p.ws + O_P); bf16_t* KA = (bf16_t*)(p.ws + O_X + X_KA);
    const float* rc = (const float*)(p.ws + O_ROPEC); const float* rs = (const float*)(p.ws + O_ROPES);
    for (int row = blockIdx.x * 4 + wave; row < RT; row += gridDim.x * 4) {
        const bool lat = row < RL;
        const int b = lat ? (row >> 12) : ((row - RL) >> 8), t = lat ? (row & 4095) : ((row - RL) & 255);
        const size_t keyrow = (size_t)b * KEYS + (lat ? t : SEQ + t);
        const int ii = lane & 31, hh = lane >> 5;
        const bf16_t* pr = P + (size_t)row * LDP + PKR0;
        float x = bf2f(pr[ii]);
        if (lat) {
            const float xp = bf2f(pr[ii ^ 8]);
            const int ax = ii >> 4, half = (ii >> 3) & 1, f = ii & 7;
            const float c = rc[t * 16 + ax * 8 + f], sn = rs[t * 16 + ax * 8 + f];
            x = half ? (x * c + xp * sn) : (x * c - xp * sn);
        }
        const bf16_t xb = f2bf(x);
#pragma unroll
        for (int q = 0; q < 4; ++q) KA[keyrow * 768 + (hh * 4 + q) * 96 + 64 + ii] = xb;
    }
}

constexpr int KS_LD = 104, VT_LD = 72;
constexpr int AT_BUF = 64 * KS_LD * 2 + 64 * VT_LD * 2;
__device__ __forceinline__ void ph_at(const Params& p, int l, char* smem) {
    const int tid = tidx(), lane = tid & 63, wave = tid >> 6, fr = lane & 15, fq = lane >> 4;
    const bf16_t* QA = (const bf16_t*)(p.ws + O_X + X_QA); const bf16_t* KA = (const bf16_t*)(p.ws + O_X + X_KA); const bf16_t* VA = (const bf16_t*)(p.ws + O_X + X_VA);
    bf16_t* ATT = (bf16_t*)(p.ws + O_ATT);
    const int nitems = 1024 + (l < NLAYER - 1 ? 64 : 0);
    for (int it0 = blockIdx.x; it0 < nitems; it0 += gridDim.x) {
        int it = it0;
        if (gridDim.x == 512 && it0 < 1024) {
            const int x = it0 & 7, j = (it0 >> 3) & 63, rd = it0 >> 9;
            it = ((x * 4 + rd * 2 + (j >> 5)) << 5) | (j & 31);
        }
        int b, h, row0, ntile; size_t krow0;
        if (it < 1024) { b = it >> 8; h = (it >> 5) & 7; row0 = b * SEQ + (it & 31) * 128; krow0 = (size_t)b * KEYS; ntile = KEYS / 64; }
        else { const int j = it - 1024; b = j >> 4; h = (j >> 1) & 7; row0 = RL + b * CTX + (j & 1) * 128; krow0 = (size_t)b * KEYS + SEQ; ntile = CTX / 64; }
        const int qrow = row0 + wave * 32 + fr;
        const size_t vrow0 = (size_t)(b * 8 + h) * 64; const int koff0 = (int)(krow0 - (size_t)b * KEYS);
        bf16x8 qf[2][3];
#pragma unroll
        for (int t = 0; t < 2; ++t)
#pragma unroll
            for (int ks = 0; ks < 3; ++ks) qf[t][ks] = *(const bf16x8*)(QA + (size_t)(qrow + 16 * t) * 768 + h * 96 + ks * 32 + fq * 8);
        f32x4 ot[2][4];
#pragma unroll
        for (int t = 0; t < 2; ++t)
#pragma unroll
            for (int i = 0; i < 4; ++i) ot[t][i] = (f32x4){0.f, 0.f, 0.f, 0.f};
        float m_run[2] = {0.f, 0.f};
        f32x4 negm[2] = {(f32x4){0.f, 0.f, 0.f, 0.f}, (f32x4){0.f, 0.f, 0.f, 0.f}}, ol[2] = {(f32x4){0.f, 0.f, 0.f, 0.f}, (f32x4){0.f, 0.f, 0.f, 0.f}};
        const bf16x8 ones = __builtin_bit_cast(bf16x8, (u32x4){0x3f803f80u, 0x3f803f80u, 0x3f803f80u, 0x3f803f80u});
        uint4 rk0, rk1, rk2, rv0, rv1;
#define AT_GLOAD(KT) do { const size_t kr_ = krow0 + (size_t)(KT) * 64; \
            { const int c = tid, key = c / 12, part = c % 12; rk0 = *(const uint4*)(KA + (kr_ + key) * 768 + h * 96 + part * 8); } \
            { const int c = tid + 256, key = c / 12, part = c % 12; rk1 = *(const uint4*)(KA + (kr_ + key) * 768 + h * 96 + part * 8); } \
            { const int c = tid + 512, key = c / 12, part = c % 12; rk2 = *(const uint4*)(KA + (kr_ + key) * 768 + h * 96 + part * 8); } \
            { const int c = tid, dd_ = c >> 3, part = c & 7; rv0 = *(const uint4*)(VA + (vrow0 + dd_) * KEYS + koff0 + (KT) * 64 + part * 8); } \
            { const int c = tid + 256, dd_ = c >> 3, part = c & 7; rv1 = *(const uint4*)(VA + (vrow0 + dd_) * KEYS + koff0 + (KT) * 64 + part * 8); } } while (0)
#define AT_VSTORE(RV, C) do { const int dd_ = (C) >> 3, part = (C) & 7; *(uint4*)(Vt_ + dd_ * VT_LD + part * 8) = RV; } while (0)
#define AT_SSTORE(BUF) do { bf16_t* Ks_ = (bf16_t*)(smem + (BUF) * AT_BUF); bf16_t* Vt_ = Ks_ + 64 * KS_LD; \
            { const int c = tid, key = c / 12, part = c % 12; *(uint4*)(Ks_ + key * KS_LD + part * 8) = rk0; } \
            { const int c = tid + 256, key = c / 12, part = c % 12; *(uint4*)(Ks_ + key * KS_LD + part * 8) = rk1; } \
            { const int c = tid + 512, key = c / 12, part = c % 12; *(uint4*)(Ks_ + key * KS_LD + part * 8) = rk2; } \
            AT_VSTORE(rv0, tid); AT_VSTORE(rv1, tid + 256); } while (0)
        AT_GLOAD(0); AT_SSTORE(0);
        __syncthreads();
        for (int kt = 0; kt < ntile; ++kt) {
            const int cur = kt & 1;
            if (kt + 1 < ntile) AT_GLOAD(kt + 1);
            __builtin_amdgcn_sched_barrier(0);
            const bf16_t* Ks = (const bf16_t*)(smem + cur * AT_BUF); const bf16_t* Vt = Ks + 64 * KS_LD;
            f32x4 st[2][4];
#pragma unroll
            for (int jh = 0; jh < 2; ++jh) {
                bf16x8 kf[2][3];
#pragma unroll
                for (int jj = 0; jj < 2; ++jj)
#pragma unroll
                    for (int ks = 0; ks < 3; ++ks) kf[jj][ks] = *(const bf16x8*)(Ks + ((jh * 2 + jj) * 16 + fr) * KS_LD + ks * 32 + fq * 8);
#pragma unroll
                for (int jj = 0; jj < 2; ++jj) {
                    const int j = jh * 2 + jj;
                    st[0][j] = negm[0]; st[1][j] = negm[1];
#pragma unroll
                    for (int ks = 0; ks < 3; ++ks) {
                        st[0][j] = __builtin_amdgcn_mfma_f32_16x16x32_bf16(kf[jj][ks], qf[0][ks], st[0][j], 0, 0, 0);
                        st[1][j] = __builtin_amdgcn_mfma_f32_16x16x32_bf16(kf[jj][ks], qf[1][ks], st[1][j], 0, 0, 0);
                    }
                }
            }
            bf16x8 vf[2][4];
#pragma unroll
            for (int k2 = 0; k2 < 2; ++k2)
#pragma unroll
                for (int dt = 0; dt < 4; ++dt) {
                    vf[k2][dt] = *(const bf16x8*)(Vt + (dt * 16 + fr) * VT_LD + k2 * 32 + fq * 8);
                }
            uint4 pu[2][2];
#pragma unroll
            for (int t = 0; t < 2; ++t) {
                float mx = st[t][0][0];
#pragma unroll
                for (int j = 0; j < 4; ++j)
#pragma unroll
                    for (int r = 0; r < 4; ++r) mx = fmaxf(mx, st[t][j][r]);
                if (kt == 0 || __any(mx > 6.f)) {
                    mx = xmax_16_32(mx);
                    const float delta = kt == 0 ? mx : fmaxf(mx, 0.f);
                    const float alpha = kt == 0 ? 0.f : __builtin_amdgcn_exp2f(-delta);
                    m_run[t] += delta;
                    negm[t] = (f32x4){-m_run[t], -m_run[t], -m_run[t], -m_run[t]};
                    ol[t] *= alpha;
#pragma unroll
                    for (int i = 0; i < 4; ++i) ot[t][i] *= alpha;
#pragma unroll
                    for (int j = 0; j < 4; ++j)
#pragma unroll
                        for (int r = 0; r < 4; ++r) st[t][j][r] -= delta;
                }
#pragma unroll
                for (int j = 0; j < 4; ++j)
#pragma unroll
                    for (int r = 0; r < 4; ++r) st[t][j][r] = __builtin_amdgcn_exp2f(st[t][j][r]);
#pragma unroll
                for (int k2 = 0; k2 < 2; ++k2)
                    pu[t][k2] = make_uint4(pack2(st[t][2 * k2][0], st[t][2 * k2][1]), pack2(st[t][2 * k2][2], st[t][2 * k2][3]),
                                           pack2(st[t][2 * k2 + 1][0], st[t][2 * k2 + 1][1]), pack2(st[t][2 * k2 + 1][2], st[t][2 * k2 + 1][3]));
            }
#pragma unroll
            for (int k2 = 0; k2 < 2; ++k2) {
                const bf16x8 pb0 = __builtin_bit_cast(bf16x8, pu[0][k2]), pb1 = __builtin_bit_cast(bf16x8, pu[1][k2]);
                ol[0] = __builtin_amdgcn_mfma_f32_16x16x32_bf16(ones, pb0, ol[0], 0, 0, 0);
                ol[1] = __builtin_amdgcn_mfma_f32_16x16x32_bf16(ones, pb1, ol[1], 0, 0, 0);
#pragma unroll
                for (int dt = 0; dt < 4; ++dt) {
                    ot[0][dt] = __builtin_amdgcn_mfma_f32_16x16x32_bf16(vf[k2][dt], pb0, ot[0][dt], 0, 0, 0);
                    ot[1][dt] = __builtin_amdgcn_mfma_f32_16x16x32_bf16(vf[k2][dt], pb1, ot[1][dt], 0, 0, 0);
                }
            }
            if (kt + 1 < ntile) AT_SSTORE(cur ^ 1);
            __syncthreads();
        }
#pragma unroll
        for (int t = 0; t < 2; ++t) {
            const float inv = 1.f / ol[t][0];
#pragma unroll
            for (int dt = 0; dt < 4; ++dt) { f32x4 o = ot[t][dt] * inv; store_bf16x4(ATT + (size_t)(qrow + 16 * t) * 512 + h * 64 + dt * 16 + fq * 4, o); }
        }
    }
}

__device__ __forceinline__ void row_edges(int row, bool& first, bool& last) {
    if (row < RL) { const int t = row & 4095; first = t == 0; last = t == 4095; }
    else { const int s = (row - RL) & 255; first = s == 0; last = s == 255; }
}
__device__ __forceinline__ float xs1(const bf16_t* P, const float* mu, int row, int col) {
    bool first, last; row_edges(row, first, last);
    const bf16_t* pc = P + (size_t)row * LDP + PR0 + col;
    const float c = bf2f(*pc), pv0 = bf2f(*(first ? pc : pc - LDP)), nx0 = bf2f(*(last ? pc : pc + LDP));
    const float pv = first ? 0.f : pv0, nx = last ? 0.f : nx0;
    return c + (0.5f * (pv + nx) - c) * mu[col];
}
__device__ __forceinline__ void xs8(const bf16_t* P, const float* mu, int row, int col, float (&o)[8]) {
    bool first, last; row_edges(row, first, last);
    const bf16_t* pc = P + (size_t)row * LDP + PR0 + col;
    const uint4 uc = *(const uint4*)pc, up = *(const uint4*)(first ? pc : pc - LDP), un = *(const uint4*)(last ? pc : pc + LDP);
    float c[8], pv[8], nx[8]; unpack8(uc, c); unpack8(up, pv); unpack8(un, nx);
    const float fp = first ? 0.f : 0.5f, fn = last ? 0.f : 0.5f;
    const float4 m0 = *(const float4*)(mu + col), m1 = *(const float4*)(mu + col + 4);
    const float m[8] = {m0.x, m0.y, m0.z, m0.w, m1.x, m1.y, m1.z, m1.w};
#pragma unroll
    for (int j = 0; j < 8; ++j) o[j] = c[j] + ((fp * pv[j] + fn * nx[j]) - c[j]) * m[j];
}
struct ALRw {
    const bf16_t* P; const float* mu; int row0; int colbase, mode;
    __device__ __forceinline__ ALRw(const bf16_t* P_, const float* mu_, int row0_, int colbase_, int mode_) : P(P_), mu(mu_), colbase(colbase_), mode(mode_) {
        row0 = row0_ + (tidx() >> 3);
    }
    __device__ __forceinline__ uint4 load(int i, int k) const {
        float o[8]; xs8(P, mu, row0 + 32 * i, colbase + k, o);
        if (mode == 0) {
#pragma unroll
            for (int j = 0; j < 8; ++j) o[j] = tanhf(o[j]);
        } else if (mode == 2) {
#pragma unroll
            for (int j = 0; j < 8; ++j) o[j] = sigmoidf_(o[j]);
        }
        return pack8(o);
    }
};
__device__ __forceinline__ void ph_rp1(const Params& p, int l, char* smem) {
    const bf16_t* P = (const bf16_t*)(p.ws + O_P); const float* mu = p.in[I_MU] + l * 1792;
    bf16_t* RG = (bf16_t*)(p.ws + O_RG);
    for (int it = gridDim.x - 1 - blockIdx.x; it < 1088; it += gridDim.x) {
        const int mt = it >> 2, nt = it & 3;
        f32x4 acc[2][4];
        ALRw al(P, mu, mt * 64, 1664, 2);
        gemm_core<2>(al, (const bf16_t*)(p.ws + O_WB + W_GUP) + (size_t)nt * 128 * 128, 128, 128, acc, smem);
        acc_foreach<2>(acc, [&](int m, int n, const f32x4& v) { store_bf16x4(RG + (size_t)(mt * 64 + m) * 512 + nt * 128 + n, v); });
    }
}
__device__ __forceinline__ void ph_rp2(const Params& p, int l) {
    const int lane = tidx() & 63, wave = tidx() >> 6;
    const bf16_t* P = (const bf16_t*)(p.ws + O_P); const float* mu = p.in[I_MU] + l * 1792; const float* kkw = p.in[I_KK] + l * 512;
    float* KKN = (float*)(p.ws + O_X + X_KKN); bf16_t* X12 = (bf16_t*)(p.ws + O_X + X_X12);
    for (int row = blockIdx.x * 4 + wave; row < RT; row += gridDim.x * 4) {
        float k8[8]; xs8(P, mu, row, 512 + lane * 8, k8);
        float x8[8]; xs8(P, mu, row, 1536 + (lane & 15) * 8, x8);
        float s = 0.f;
#pragma unroll
        for (int j = 0; j < 8; ++j) { const float v = k8[j] * kkw[lane * 8 + j]; s += v * v; }
        s += __shfl_xor(s, 1); s += __shfl_xor(s, 2); s += __shfl_xor(s, 4);
        if ((lane & 7) == 0) KKN[(size_t)row * 8 + (lane >> 3)] = rsqrtf(s + 1e-12f);
        if (lane < 8) {
#pragma unroll
            for (int j = 0; j < 8; ++j) x8[j] = 1.f - 2.f * __builtin_amdgcn_rcpf(1.f + __expf(2.f * x8[j]));
        }
        if (lane < 16) *(uint4*)(X12 + (size_t)row * 128 + lane * 8) = pack8(x8);
    }
}

__device__ __forceinline__ int scan_row(int b, int d, int n) {
    if (n < CTX) return RL + b * CTX + (d == 0 ? n : CTX - 1 - n);
    const int t = n - CTX; return b * SEQ + (d == 0 ? t : SEQ - 1 - t);
}
constexpr int SL = 72;
constexpr int SLOT_E = 64 * SL;
template <int LDA, int LDB>
__device__ __forceinline__ void mm64(const bf16_t* A, const bf16_t* B, f32x4 (&acc)[4], int wave, int fr, int fq) {
#pragma unroll
    for (int ks = 0; ks < 2; ++ks) {
        const bf16x8 af = *(const bf16x8*)(A + (wave * 16 + fr) * LDA + ks * 32 + fq * 8);
#pragma unroll
        for (int nt = 0; nt < 4; ++nt) {
            const bf16x8 bfv = *(const bf16x8*)(B + (nt * 16 + fr) * LDB + ks * 32 + fq * 8);
            acc[nt] = __builtin_amdgcn_mfma_f32_16x16x32_bf16(bfv, af, acc[nt], 0, 0, 0);
        }
    }
}
__device__ __forceinline__ void acc_zero(f32x4 (&acc)[4]) {
#pragma unroll
    for (int nt = 0; nt < 4; ++nt) acc[nt] = (f32x4){0.f, 0.f, 0.f, 0.f};
}
template <bool STRICT>
__device__ __forceinline__ void acc_mask(f32x4 (&acc)[4], int m, int fq) {
    const int w = __builtin_amdgcn_readfirstlane(m >> 4);
#pragma unroll
    for (int nt = 0; nt < 4; ++nt) {
        if (nt < w) acc[nt] = (f32x4){0.f, 0.f, 0.f, 0.f};
        else if (nt == w) {
#pragma unroll
            for (int r = 0; r < 4; ++r) { const int n = nt * 16 + fq * 4 + r; const bool keep = STRICT ? (m < n) : (m <= n); if (!keep) acc[nt][r] = 0.f; }
        }
    }
}
__device__ __forceinline__ void acc_mask_lo(f32x4 (&acc)[4], int m, int fq) {
    const int w = __builtin_amdgcn_readfirstlane(m >> 4);
#pragma unroll
    for (int nt = 0; nt < 4; ++nt) {
        if (nt > w) acc[nt] = (f32x4){0.f, 0.f, 0.f, 0.f};
        else if (nt == w) {
#pragma unroll
            for (int r = 0; r < 4; ++r) { const int n = nt * 16 + fq * 4 + r; if (n > m) acc[nt][r] = 0.f; }
        }
    }
}
__device__ __forceinline__ void st_rm(bf16_t* dst, const f32x4 (&acc)[4], int m, int fq) {
#pragma unroll
    for (int nt = 0; nt < 4; ++nt) store_bf16x4(dst + m * SL + nt * 16 + fq * 4, acc[nt]);
}
__device__ __forceinline__ void st_tr(bf16_t* dst, const f32x4 (&acc)[4], int m, int fq) {
#pragma unroll
    for (int nt = 0; nt < 4; ++nt) {
        const unsigned u0 = pack2(acc[nt][0], acc[nt][1]), u1 = pack2(acc[nt][2], acc[nt][3]);
        bf16_t* d = dst + (nt * 16 + fq * 4) * SL + m;
        d[0] = (bf16_t)(u0 & 0xffffu); d[SL] = (bf16_t)(u0 >> 16); d[2 * SL] = (bf16_t)(u1 & 0xffffu); d[3 * SL] = (bf16_t)(u1 >> 16);
    }
}
__device__ __forceinline__ void tr_copy16(bf16_t* dst, const bf16_t* src, int bi, int bq) {
    const uint4 a = *(const uint4*)(src + bi * SL + bq), b = *(const uint4*)(src + bi * SL + bq + 8);
    const unsigned w[8] = {a.x, a.y, a.z, a.w, b.x, b.y, b.z, b.w};
#pragma unroll
    for (int q = 0; q < 8; ++q) { dst[(bq + 2 * q) * SL + bi] = (bf16_t)(w[q] & 0xffffu); dst[(bq + 2 * q + 1) * SL + bi] = (bf16_t)(w[q] >> 16); }
}
__device__ __forceinline__ void ph_r1(const Params& p, int l, char* smem) {
    const int tid0 = tidx();
#define R1_IDX const int tid = lv(tid0), lane = tid & 63, wave = tid >> 6, fr = lane & 15, fq = lane >> 4, bi = tid >> 2, bq = (tid & 3) * 16, m = wave * 16 + fr; (void)bi; (void)bq; (void)m; (void)fq;
    const bf16_t* P = (const bf16_t*)(p.ws + O_P); const float* mu = p.in[I_MU] + l * 1792;
    const float* kkw = p.in[I_KK] + l * 512; const float* kaw = p.in[I_KA] + l * 512; const float* rkw = p.in[I_RK] + l * 512;
    const float* KKN = (const float*)(p.ws + O_X + X_KKN); float* BON = (float*)(p.ws + O_X + X_BON); const bf16_t* X12 = (const bf16_t*)(p.ws + O_X + X_X12);
    bf16_t* gMT = (bf16_t*)(p.ws + O_X + X_MT); bf16_t* gNL = (bf16_t*)(p.ws + O_H);
    bf16_t* gGT = (bf16_t*)(p.ws + O_X + X_GT); bf16_t* gYL = (bf16_t*)(p.ws + O_X + X_YL);
    bf16_t* slot = (bf16_t*)smem;
    bf16_t* s0 = slot, *s1 = slot + SLOT_E, *s2 = slot + 2 * SLOT_E, *s3 = slot + 3 * SLOT_E;
    bf16_t* sa = slot + 4 * SLOT_E, *sb = slot + 5 * SLOT_E, *sc = slot + 6 * SLOT_E, *sT = slot + 7 * SLOT_E;
    float* misc = (float*)(smem + 8 * SLOT_E * 2);
    float* GAM = misc; float* SEG = misc + 64;
    float* ASIG = (float*)s0;
    float* LWS = (float*)s2;
    for (int it = blockIdx.x; it < NCP; it += gridDim.x) {
        const int c = it % 68, d = (it / 68) & 1, h = (it / 136) & 7, b = it / 1088;
        float rr[16], kq[16], kkn;
        {
            R1_IDX const int rowb = scan_row(b, d, c * 64 + bi); (void)rowb;
            {
                const uint4* xr = (const uint4*)(X12 + (size_t)rowb * 128 + bq);
                const uint4 x0 = xr[0], x1 = xr[1], x2 = xr[8], x3 = xr[9];
                *(uint4*)(sa + bi * SL + bq) = x0; *(uint4*)(sa + bi * SL + bq + 8) = x1;
                *(uint4*)(sb + bi * SL + bq) = x2; *(uint4*)(sb + bi * SL + bq + 8) = x3;
            }
#pragma unroll
            for (int hh = 0; hh < 2; ++hh) {
                float t8[8];
                xs8(P, mu, rowb, h * 64 + bq + hh * 8, t8);
#pragma unroll
                for (int j = 0; j < 8; ++j) rr[hh * 8 + j] = t8[j];
                xs8(P, mu, rowb, 512 + h * 64 + bq + hh * 8, t8);
#pragma unroll
                for (int j = 0; j < 8; ++j) kq[hh * 8 + j] = t8[j];
            }
            kkn = KKN[(size_t)rowb * 8 + h];
        }
        __syncthreads();
        {
            R1_IDX const int rowb = scan_row(b, d, c * 64 + bi); (void)rowb;
            f32x4 acc[4];
            acc_zero(acc);
            mm64<SL, 64>(sa, (const bf16_t*)(p.ws + O_WB + W_WUP) + ((size_t)d * 512 + h * 64) * 64, acc, wave, fr, fq);
            const float* w0 = p.in[I_W0] + (l * 2 + d) * 512 + h * 64;
#pragma unroll
            for (int nt = 0; nt < 4; ++nt) {
                const int n = nt * 16 + fq * 4; float4 o; float* op = (float*)&o;
#pragma unroll
                for (int r = 0; r < 4; ++r) { const float z = w0[n + r] + acc[nt][r]; op[r] = -0.6065306597126334f * __builtin_amdgcn_rcpf(1.f + __expf(-z)); }
                *(float4*)(LWS + m * 68 + n) = o;
            }
            acc_zero(acc);
            mm64<SL, 64>(sb, (const bf16_t*)(p.ws + O_WB + W_AUP) + ((size_t)d * 512 + h * 64) * 64, acc, wave, fr, fq);
            const float* a0 = p.in[I_A0] + (l * 2 + d) * 512 + h * 64;
#pragma unroll
            for (int nt = 0; nt < 4; ++nt) {
                const int n = nt * 16 + fq * 4;
                *(float4*)(ASIG + m * 68 + n) = make_float4(__builtin_amdgcn_rcpf(1.f + __expf(-(a0[n] + acc[nt][0]))), __builtin_amdgcn_rcpf(1.f + __expf(-(a0[n + 1] + acc[nt][1]))), __builtin_amdgcn_rcpf(1.f + __expf(-(a0[n + 2] + acc[nt][2]))), __builtin_amdgcn_rcpf(1.f + __expf(-(a0[n + 3] + acc[nt][3]))));
            }
        }
        __syncthreads();
        {
            R1_IDX const int rowb = scan_row(b, d, c * 64 + bi); (void)rowb;
            const int k = tid & 63, seg = tid >> 6;
            float run = 0.f;
#pragma unroll
            for (int ii = 0; ii < 16; ++ii) { run += LWS[(seg * 16 + ii) * 68 + k]; LWS[(seg * 16 + ii) * 68 + k] = run; }
            SEG[seg * 64 + k] = run;
            __syncthreads();
            float off = 0.f;
#pragma unroll
            for (int sgi = 0; sgi < 3; ++sgi) if (sgi < seg) off += SEG[sgi * 64 + k];
#pragma unroll
            for (int ii = 0; ii < 16; ++ii) LWS[(seg * 16 + ii) * 68 + k] += off;
        }
        __syncthreads();
        {
            R1_IDX const int rowb = scan_row(b, d, c * 64 + bi); (void)rowb;
            float cs[16], cm[16], cc[16], ag[16];
#pragma unroll
            for (int q = 0; q < 4; ++q) {
                const float4 v0 = *(const float4*)(LWS + bi * 68 + bq + q * 4);
                const float4 v1 = bi > 0 ? *(const float4*)(LWS + (bi - 1) * 68 + bq + q * 4) : make_float4(0.f, 0.f, 0.f, 0.f);
                const float4 v2 = *(const float4*)(LWS + 63 * 68 + bq + q * 4);
                const float4 v3 = *(const float4*)(ASIG + bi * 68 + bq + q * 4);
                cs[q * 4] = v0.x; cs[q * 4 + 1] = v0.y; cs[q * 4 + 2] = v0.z; cs[q * 4 + 3] = v0.w;
                cm[q * 4] = v1.x; cm[q * 4 + 1] = v1.y; cm[q * 4 + 2] = v1.z; cm[q * 4 + 3] = v1.w;
                cc[q * 4] = v2.x; cc[q * 4 + 1] = v2.y; cc[q * 4 + 2] = v2.z; cc[q * 4 + 3] = v2.w;
                ag[q * 4] = v3.x; ag[q * 4 + 1] = v3.y; ag[q * 4 + 2] = v3.z; ag[q * 4 + 3] = v3.w;
            }
            __syncthreads();
            float bon = 0.f;
#pragma unroll
            for (int hh = 0; hh < 2; ++hh) {
                float oa[8], ob[8], ok[8], orr[8];
                const int col = h * 64 + bq + hh * 8;
#pragma unroll
                for (int j = 0; j < 8; ++j) {
                    const int e = hh * 8 + j;
                    const float kk = kq[e] * kkw[col + j] * kkn;
                    const float kd = kq[e] * (1.f + (ag[e] - 1.f) * kaw[col + j]);
                    const float eneg = __expf(-cs[e]);
                    oa[j] = -kk * __expf(cm[e]); ob[j] = kk * ag[e] * eneg; ok[j] = kd * eneg; orr[j] = rr[e] * __builtin_amdgcn_rcpf(eneg);
                    bon += rr[e] * kd * rkw[col + j];
                }
                *(uint4*)(s0 + bi * SL + bq + hh * 8) = pack8(oa); *(uint4*)(s1 + bi * SL + bq + hh * 8) = pack8(ob);
                *(uint4*)(s2 + bi * SL + bq + hh * 8) = pack8(ok); *(uint4*)(s3 + bi * SL + bq + hh * 8) = pack8(orr);
            }
            bon += __shfl_xor(bon, 1); bon += __shfl_xor(bon, 2);
            if ((tid & 3) == 0) BON[((size_t)d * RT + rowb) * 8 + h] = bon;
            if (bi == 0) {
#pragma unroll
                for (int e = 0; e < 16; ++e) GAM[bq + e] = __expf(cc[e]);
            }
        }
        __syncthreads();
        unsigned vp[8];
        {
            R1_IDX const int rowb = scan_row(b, d, c * 64 + bi); (void)rowb;
#pragma unroll
            for (int hh = 0; hh < 2; ++hh) {
                float v8[8]; xs8(P, mu, rowb, 1024 + h * 64 + bq + hh * 8, v8);
#pragma unroll
                for (int q = 0; q < 4; ++q) vp[hh * 4 + q] = pack2(v8[2 * q], v8[2 * q + 1]);
            }
            f32x4 acc[4]; acc_zero(acc);
            mm64<SL, SL>(s1, s0, acc, wave, fr, fq);
            acc_mask<true>(acc, m, fq);
            st_rm(sa, acc, m, fq); st_tr(sb, acc, m, fq);
#pragma unroll
            for (int nt = 0; nt < 4; ++nt)
#pragma unroll
                for (int r = 0; r < 4; ++r) if (nt * 16 + fq * 4 + r == m) acc[nt][r] += 1.f;
            st_rm(sc, acc, m, fq);
        }
        __syncthreads();
#pragma unroll
        for (int itr = 0; itr < 5; ++itr) {
            R1_IDX
            bf16_t* ptr = (itr & 1) ? sT : sb;
            bf16_t* ptw = (itr & 1) ? sb : sT;
            f32x4 acc[4]; acc_zero(acc);
            mm64<SL, SL>(sa, ptr, acc, wave, fr, fq);
            st_rm(sa, acc, m, fq); st_tr(ptw, acc, m, fq);
            __syncthreads();
            f32x4 tacc[4];
#pragma unroll
            for (int nt = 0; nt < 4; ++nt) { const uint2 u = *(const uint2*)(sc + m * SL + nt * 16 + fq * 4); tacc[nt] = (f32x4){bflo(u.x), bfhi(u.x), bflo(u.y), bfhi(u.y)}; }
            mm64<SL, SL>(sc, ptw, tacc, wave, fr, fq);
            if (itr < 4) st_rm(sc, tacc, m, fq); else st_tr(sb, tacc, m, fq);
        }
        __syncthreads();
        {
            R1_IDX const int rowb = scan_row(b, d, c * 64 + bi); (void)rowb;
            f32x4 acc[4]; acc_zero(acc);
            mm64<SL, SL>(s2, s0, acc, wave, fr, fq);
            acc_mask<true>(acc, m, fq);
            st_rm(sa, acc, m, fq);
            tr_copy16(sc, s0, bi, bq);
        }
        __syncthreads();
        {
            R1_IDX const int rowb = scan_row(b, d, c * 64 + bi); (void)rowb;
            f32x4 acc[4]; acc_zero(acc);
            mm64<SL, SL>(sc, sb, acc, wave, fr, fq);
            st_rm(sT, acc, m, fq);
            acc_zero(acc);
            mm64<SL, SL>(sa, sb, acc, wave, fr, fq);
            st_rm(s0, acc, m, fq);
        }
        __syncthreads();
        f32x4 qacc[4];
        {
            R1_IDX
            f32x4 acc[4]; acc_zero(acc);
            mm64<SL, SL>(s3, s1, acc, wave, fr, fq);
            acc_mask_lo(acc, m, fq);
            st_rm(sa, acc, m, fq);
            acc_zero(qacc);
            mm64<SL, SL>(s3, s2, qacc, wave, fr, fq);
            acc_mask_lo(qacc, m, fq);
        }
        __syncthreads();
        {
            R1_IDX
            f32x4 acc[4];
#pragma unroll
            for (int nt = 0; nt < 4; ++nt) { const uint2 u = *(const uint2*)(s3 + m * SL + nt * 16 + fq * 4); acc[nt] = (f32x4){bflo(u.x), bfhi(u.x), bflo(u.y), bfhi(u.y)}; }
            mm64<SL, SL>(sa, sT, acc, wave, fr, fq);
            bf16_t* gt = gGT + (size_t)it * 4096;
#pragma unroll
            for (int nt = 0; nt < 4; ++nt) store_bf16x4(gt + m * 64 + nt * 16 + fq * 4, acc[nt]);
            mm64<SL, SL>(sa, s0, qacc, wave, fr, fq);
            st_rm(sb, qacc, m, fq);
            tr_copy16(sc, s1, bi, bq);
        }
        __syncthreads();
        {
            R1_IDX
            f32x4 acc[4]; acc_zero(acc);
            mm64<SL, SL>(sc, sT, acc, wave, fr, fq);
            bf16_t* mt = gMT + (size_t)it * 4096;
            const float gm = GAM[m];
#pragma unroll
            for (int nt = 0; nt < 4; ++nt) {
                f32x4 o = acc[nt];
#pragma unroll
                for (int r = 0; r < 4; ++r) if (nt * 16 + fq * 4 + r == m) o[r] += 1.f;
                o *= gm;
                store_bf16x4(mt + m * 64 + nt * 16 + fq * 4, o);
            }
#pragma unroll
            for (int nt = 0; nt < 4; ++nt) {
                const int n = nt * 16 + fq * 4; const uint2 u = *(const uint2*)(s2 + m * SL + n);
                acc[nt] = (f32x4){bflo(u.x), bfhi(u.x), bflo(u.y), bfhi(u.y)};
            }
            mm64<SL, SL>(s0, sc, acc, wave, fr, fq);
#pragma unroll
            for (int nt = 0; nt < 4; ++nt) acc[nt] *= *(const f32x4*)(GAM + nt * 16 + fq * 4);
            st_tr(s1, acc, m, fq);
#pragma unroll
            for (int q = 0; q < 8; ++q) { s3[(bq + 2 * q) * SL + bi] = (bf16_t)(vp[q] & 0xffffu); s3[(bq + 2 * q + 1) * SL + bi] = (bf16_t)(vp[q] >> 16); }
        }
        __syncthreads();
        {
            R1_IDX const int rowb = scan_row(b, d, c * 64 + bi); (void)rowb;
            f32x4 acc[4]; acc_zero(acc);
            mm64<SL, SL>(s3, sb, acc, wave, fr, fq);
            bf16_t* yl = gYL + (size_t)it * 4096;
#pragma unroll
            for (int nt = 0; nt < 4; ++nt) store_bf16x4(yl + m * 64 + nt * 16 + fq * 4, acc[nt]);
            acc_zero(acc);
            mm64<SL, SL>(s3, s1, acc, wave, fr, fq);
            bf16_t* nl = gNL + (size_t)it * 4096;
#pragma unroll
            for (int nt = 0; nt < 4; ++nt) store_bf16x4(nl + m * 64 + nt * 16 + fq * 4, acc[nt]);
        }
        __syncthreads();
    }
}
__device__ __forceinline__ void ph_r2(const Params& p, char* smem) {
    const int tid = tidx(), lane = tid & 63, wave = tid >> 6, fr = lane & 15, fq = lane >> 4;
    const char* gMT = (const char*)(p.ws + O_X + X_MT); const char* gNL = (const char*)(p.ws + O_H);
    uint4* gS0 = (uint4*)(p.ws + O_X + X_S0);
    const int wofs = __builtin_amdgcn_readfirstlane(wave) * 1024;
    const unsigned lds0 = (unsigned)(uintptr_t)smem;
    const unsigned mtaddr = lds0 + fr * 128 + fq * 8, nladdr = lds0 + (wave * 16 + fr) * 128 + fq * 8;
    auto issue = [&](size_t cp, int slot) {
        char* dst = smem + slot * 16384 + wofs;
        const char* s0 = gMT + cp * 8192 + wofs + lane * 16; const char* s1 = gNL + cp * 8192 + wofs + lane * 16;
        __builtin_amdgcn_global_load_lds((const unsigned*)s0, (unsigned*)dst, 16, 0, 0);
        __builtin_amdgcn_global_load_lds((const unsigned*)(s0 + 4096), (unsigned*)(dst + 4096), 16, 0, 0);
        __builtin_amdgcn_global_load_lds((const unsigned*)s1, (unsigned*)(dst + 8192), 16, 0, 0);
        __builtin_amdgcn_global_load_lds((const unsigned*)(s1 + 4096), (unsigned*)(dst + 12288), 16, 0, 0);
    };
#define R2_READ(MX, NV, SLOT) do { \
        asm volatile("ds_read_b64 %0, %1 offset:0" : "=v"(MX[0][0][0]) : "v"(mtaddr + (SLOT) * 16384)); \
        asm volatile("ds_read_b64 %0, %1 offset:32" : "=v"(MX[0][0][1]) : "v"(mtaddr + (SLOT) * 16384)); \
        asm volatile("ds_read_b64 %0, %1 offset:64" : "=v"(MX[0][1][0]) : "v"(mtaddr + (SLOT) * 16384)); \
        asm volatile("ds_read_b64 %0, %1 offset:96" : "=v"(MX[0][1][1]) : "v"(mtaddr + (SLOT) * 16384)); \
        asm volatile("ds_read_b64 %0, %1 offset:8192" : "=v"(NV[0]) : "v"(nladdr + (SLOT) * 16384)); \
        asm volatile("ds_read_b64 %0, %1 offset:2048" : "=v"(MX[1][0][0]) : "v"(mtaddr + (SLOT) * 16384)); \
        asm volatile("ds_read_b64 %0, %1 offset:2080" : "=v"(MX[1][0][1]) : "v"(mtaddr + (SLOT) * 16384)); \
        asm volatile("ds_read_b64 %0, %1 offset:2112" : "=v"(MX[1][1][0]) : "v"(mtaddr + (SLOT) * 16384)); \
        asm volatile("ds_read_b64 %0, %1 offset:2144" : "=v"(MX[1][1][1]) : "v"(mtaddr + (SLOT) * 16384)); \
        asm volatile("ds_read_b64 %0, %1 offset:8224" : "=v"(NV[1]) : "v"(nladdr + (SLOT) * 16384)); \
        asm volatile("ds_read_b64 %0, %1 offset:4096" : "=v"(MX[2][0][0]) : "v"(mtaddr + (SLOT) * 16384)); \
        asm volatile("ds_read_b64 %0, %1 offset:4128" : "=v"(MX[2][0][1]) : "v"(mtaddr + (SLOT) * 16384)); \
        asm volatile("ds_read_b64 %0, %1 offset:4160" : "=v"(MX[2][1][0]) : "v"(mtaddr + (SLOT) * 16384)); \
        asm volatile("ds_read_b64 %0, %1 offset:4192" : "=v"(MX[2][1][1]) : "v"(mtaddr + (SLOT) * 16384)); \
        asm volatile("ds_read_b64 %0, %1 offset:8256" : "=v"(NV[2]) : "v"(nladdr + (SLOT) * 16384)); \
        asm volatile("ds_read_b64 %0, %1 offset:6144" : "=v"(MX[3][0][0]) : "v"(mtaddr + (SLOT) * 16384)); \
        asm volatile("ds_read_b64 %0, %1 offset:6176" : "=v"(MX[3][0][1]) : "v"(mtaddr + (SLOT) * 16384)); \
        asm volatile("ds_read_b64 %0, %1 offset:6208" : "=v"(MX[3][1][0]) : "v"(mtaddr + (SLOT) * 16384)); \
        asm volatile("ds_read_b64 %0, %1 offset:6240" : "=v"(MX[3][1][1]) : "v"(mtaddr + (SLOT) * 16384)); \
        asm volatile("ds_read_b64 %0, %1 offset:8288" : "=v"(NV[3]) : "v"(nladdr + (SLOT) * 16384)); \
        } while (0)
#define R2_PIN(MX, NV) asm volatile("" : "+v"(MX[0][0][0]), "+v"(MX[0][0][1]), "+v"(MX[0][1][0]), "+v"(MX[0][1][1]), "+v"(NV[0]), "+v"(MX[1][0][0]), "+v"(MX[1][0][1]), "+v"(MX[1][1][0]), "+v"(MX[1][1][1]), "+v"(NV[1]), "+v"(MX[2][0][0]), "+v"(MX[2][0][1]), "+v"(MX[2][1][0]), "+v"(MX[2][1][1]), "+v"(NV[2]), "+v"(MX[3][0][0]), "+v"(MX[3][0][1]), "+v"(MX[3][1][0]), "+v"(MX[3][1][1]), "+v"(NV[3]) :: "memory")
#define R2_STEP(MX, NV, MXN, NVN, J) do { const int c = c4 + (J); \
        asm volatile("s_waitcnt lgkmcnt(0)" ::: "memory");            \
        R2_PIN(MX, NV);                                                \
        asm volatile("s_waitcnt vmcnt(8)" ::: "memory");              \
        __builtin_amdgcn_s_barrier(); \
        asm volatile("" ::: "memory"); \
        R2_READ(MXN, NVN, ((J) + 1) & 3); \
        __builtin_amdgcn_sched_barrier(0); \
        u32x4 sb_[2]; \
        _Pragma("unroll") for (int s_ = 0; s_ < 2; ++s_) sb_[s_] = (u32x4){pack2(st[2 * s_][0], st[2 * s_][1]), pack2(st[2 * s_][2], st[2 * s_][3]), pack2(st[2 * s_ + 1][0], st[2 * s_ + 1][1]), pack2(st[2 * s_ + 1][2], st[2 * s_ + 1][3])}; \
        _Pragma("unroll") for (int tt = 0; tt < 4; ++tt) { \
            f32x4 acc_ = {bflo(NV[tt].x), bfhi(NV[tt].x), bflo(NV[tt].y), bfhi(NV[tt].y)}; \
            _Pragma("unroll") for (int s_ = 0; s_ < 2; ++s_) \
                acc_ = __builtin_amdgcn_mfma_f32_16x16x32_bf16(__builtin_bit_cast(bf16x8, (u32x4){MX[tt][s_][0].x, MX[tt][s_][0].y, MX[tt][s_][1].x, MX[tt][s_][1].y}), __builtin_bit_cast(bf16x8, sb_[s_]), acc_, 0, 0, 0); \
            st[tt] = acc_; } \
        *(u32x4*)(gS0 + ((cp0 + c) * 4 + wave) * 128 + lane) = sb_[0]; *(u32x4*)(gS0 + ((cp0 + c) * 4 + wave) * 128 + 64 + lane) = sb_[1]; \
        issue(cp0 + (c + 4 < 68 ? c + 4 : 67), (J)); } while (0)
    for (int it = blockIdx.x; it < 64; it += gridDim.x) {
        f32x4 st[4];
#pragma unroll
        for (int tt = 0; tt < 4; ++tt) st[tt] = (f32x4){0.f, 0.f, 0.f, 0.f};
        const size_t cp0 = (size_t)it * 68;
        issue(cp0, 0); issue(cp0 + 1, 1); issue(cp0 + 2, 2); issue(cp0 + 3, 3);
        uint2 mxA[4][2][2], nvA[4], mxB[4][2][2], nvB[4];
        asm volatile("s_waitcnt vmcnt(12)" ::: "memory");
        __builtin_amdgcn_s_barrier();
        asm volatile("" ::: "memory");
        R2_READ(mxA, nvA, 0);
        asm volatile("s_waitcnt lgkmcnt(0)" ::: "memory");
        R2_PIN(mxA, nvA);
        for (int c4 = 0; c4 < 68; c4 += 4) {
            R2_STEP(mxA, nvA, mxB, nvB, 0);
            R2_STEP(mxB, nvB, mxA, nvA, 1);
            R2_STEP(mxA, nvA, mxB, nvB, 2);
            R2_STEP(mxB, nvB, mxA, nvA, 3);
            asm volatile("s_waitcnt lgkmcnt(0)" ::: "memory");
            R2_PIN(mxA, nvA);
        }
        asm volatile("s_waitcnt vmcnt(0) lgkmcnt(0)" ::: "memory");
        __builtin_amdgcn_sched_barrier(0);
        __syncthreads();
    }
#undef R2_READ
#undef R2_PIN
#undef R2_STEP
}
__device__ __forceinline__ void ph_r3(const Params& p, int l, char* smem) {
    const int tid = tidx(), lane = tid & 63, wave = tid >> 6, fr = lane & 15, fq = lane >> 4;
    const bf16_t* P = (const bf16_t*)(p.ws + O_P); const float* mu = p.in[I_MU] + l * 1792;
    const float* gng = p.in[I_GNG] + l * 512; const float* gnb = p.in[I_GNB] + l * 512;
    const bf16_t* gGT = (const bf16_t*)(p.ws + O_X + X_GT); const bf16_t* gYL = (const bf16_t*)(p.ws + O_X + X_YL);
    const u32x4* gS0 = (const u32x4*)(p.ws + O_X + X_S0);
    const float* BON = (const float*)(p.ws + O_X + X_BON);
    const bf16_t* RG = (const bf16_t*)(p.ws + O_RG); bf16_t* RWO = (bf16_t*)(p.ws + O_RWO);
    float* YA = (float*)smem;
    float* YB = YA + 64 * 68;
    for (int it = blockIdx.x; it < 4 * 68 * 8; it += gridDim.x) {
        const int h = it & 7, c0 = (it >> 3) % 68, b = it / (68 * 8);
        const int c1 = c0 < 4 ? 3 - c0 : 71 - c0;
        const int pi = tid >> 2, pv0 = (tid & 3) * 16;
        const int prow = scan_row(b, 0, c0 * 64 + pi), pcol = h * 64 + pv0;
        float pv[16]; uint4 prg[2];
#pragma unroll
        for (int hh = 0; hh < 2; ++hh) {
            float t8[8]; xs8(P, mu, prow, 1024 + pcol + hh * 8, t8);
#pragma unroll
            for (int e = 0; e < 8; ++e) pv[hh * 8 + e] = t8[e];
            prg[hh] = *(const uint4*)(RG + (size_t)prow * 512 + pcol + hh * 8);
        }
        const float pbs = BON[((size_t)0 * RT + prow) * 8 + h] + BON[((size_t)1 * RT + prow) * 8 + h];
#pragma unroll
        for (int d = 0; d < 2; ++d) {
            const size_t cp = ((size_t)(b * 8 + h) * 2 + d) * 68 + (d == 0 ? c0 : c1);
            const bf16_t* gt = gGT + cp * 4096; const bf16_t* yl = gYL + cp * 4096;
            const u32x4 sb0 = gS0[(cp * 4 + wave) * 128 + lane], sb1 = gS0[(cp * 4 + wave) * 128 + 64 + lane];
            float* Y = d == 0 ? YA : YB;
#pragma unroll
            for (int tt = 0; tt < 4; ++tt) {
                const uint2 yv = *(const uint2*)(yl + (wave * 16 + fr) * 64 + tt * 16 + fq * 4);
                f32x4 acc = {bflo(yv.x), bfhi(yv.x), bflo(yv.y), bfhi(yv.y)};
#pragma unroll
                for (int s_ = 0; s_ < 2; ++s_) {
                    const bf16_t* q = gt + (tt * 16 + fr) * 64 + s_ * 32 + fq * 4;
                    const uint2 a0 = *(const uint2*)q, a1 = *(const uint2*)(q + 16);
                    acc = __builtin_amdgcn_mfma_f32_16x16x32_bf16(__builtin_bit_cast(bf16x8, (u32x4){a0.x, a0.y, a1.x, a1.y}), __builtin_bit_cast(bf16x8, s_ ? sb1 : sb0), acc, 0, 0, 0);
                }
#pragma unroll
                for (int r = 0; r < 4; ++r) {
                    const int t = tt * 16 + fq * 4 + r, i = d == 0 ? t : 63 - t;
                    Y[i * 68 + wave * 16 + fr] = acc[r];
                }
            }
        }
        __syncthreads();
        {
            const int i = tid >> 2, q4 = tid & 3, v0 = q4 * 16;
            const int row = scan_row(b, 0, c0 * 64 + i), col = h * 64 + v0;
            float y[16];
#pragma unroll
            for (int e4 = 0; e4 < 4; ++e4) {
                const float4 ya = *(const float4*)(YA + i * 68 + v0 + e4 * 4), yb = *(const float4*)(YB + i * 68 + v0 + e4 * 4);
                y[e4 * 4] = ya.x + yb.x; y[e4 * 4 + 1] = ya.y + yb.y; y[e4 * 4 + 2] = ya.z + yb.z; y[e4 * 4 + 3] = ya.w + yb.w;
            }
            float sm = 0.f;
#pragma unroll
            for (int e = 0; e < 16; ++e) sm += y[e];
            sm += __shfl_xor(sm, 1); sm += __shfl_xor(sm, 2);
            const float mean = sm * (1.f / 64.f);
            float vs = 0.f;
#pragma unroll
            for (int e = 0; e < 16; ++e) { const float dl = y[e] - mean; vs += dl * dl; }
            vs += __shfl_xor(vs, 1); vs += __shfl_xor(vs, 2);
            const float rstd = rsqrtf(vs * (1.f / 64.f) + 64e-5f);
            const float bs = pbs;
#pragma unroll
            for (int hh = 0; hh < 2; ++hh) {
                float g8[8], o[8];
                unpack8(prg[hh], g8);
#pragma unroll
                for (int e = 0; e < 8; ++e) o[e] = ((y[hh * 8 + e] - mean) * rstd * gng[col + hh * 8 + e] + gnb[col + hh * 8 + e] + bs * pv[hh * 8 + e]) * g8[e];
                *(uint4*)(RWO + (size_t)row * 512 + col + hh * 8) = pack8(o);
            }
        }
        __syncthreads();
    }
}

__device__ __forceinline__ void ph_f1(const Params& p, int l, char* smem) {
    const bf16_t* P = (const bf16_t*)(p.ws + O_P); const bf16_t* CSC = (const bf16_t*)(p.ws + O_CSC);
    bf16_t* YT2 = (bf16_t*)(p.ws + O_YT2); bf16_t* YTC = (bf16_t*)(p.ws + O_YTC);
    const int nitems = 1024 + (l < NLAYER - 1 ? 64 : 0);
    for (int it = gridDim.x - 1 - blockIdx.x; it < nitems; it += gridDim.x) {
        f32x4 acc[4][4];
        if (it < 1024) {
            const int b = it >> 8, g = (it >> 6) & 3, part = (it >> 5) & 1, j = it & 31;
            RPPlain rpa{CSC + (size_t)part * 128 * 128, 128};
            const bf16_t* pb = P + (size_t)b * SEQ * LDP + g * 128;
            auto rpb = [&](int r) -> const bf16_t* { return pb + (size_t)(64 * (r & 63) + 2 * j + (r >> 6)) * LDP; };
            gemm_core_gb<4>(rpa, rpb, 128, acc, smem);
            acc_foreach<4>(acc, [&](int m, int n, const f32x4& v) {
                const int t1 = n & 63, t2 = 2 * j + (n >> 6);
                store_bf16x4(YT2 + ((size_t)(b * 512 + g * 128 + m) * 64 + t2) * 128 + part * 64 + t1, v);
            });
        } else {
            const int jj = it - 1024, b = jj >> 4, g = (jj >> 2) & 3, part = (jj >> 1) & 1, nt = jj & 1;
            RPPlain rpa{CSC + (size_t)part * 128 * 128, 128};
            gemm_core_g<4>(rpa, P + (size_t)(RL + b * CTX + nt * 128) * LDP + g * 128, LDP, 128, acc, smem);
            acc_foreach<4>(acc, [&](int m, int n, const f32x4& v) {
                store_bf16x4(YTC + ((size_t)(b * 512 + g * 128 + m)) * 512 + part * 256 + nt * 128 + n, v);
            });
        }
    }
}
__device__ __forceinline__ void ph_fa(const Params& p, char* smem) {
    const bf16_t* YT2 = (const bf16_t*)(p.ws + O_YT2); const bf16_t* D128 = (const bf16_t*)(p.ws + O_D128);
    const float* TWC = (const float*)(p.ws + O_TWC); const float* TWS = (const float*)(p.ws + O_TWS);
    bf16_t* A2 = (bf16_t*)(p.ws + O_A2);
    for (int it = blockIdx.x; it < 1024; it += gridDim.x) {
        f32x4 acc[4][4];
        RPPlain rpa{D128, 128};
        gemm_core_g<4>(rpa, YT2 + (size_t)it * 128 * 128, 128, 128, acc, smem);
        const int lane = tidx() & 63, wave = tidx() >> 6, wr = wave >> 1, wc = wave & 1, fr = lane & 15, fq = lane >> 4;
        float* U = (float*)smem;
        if (wr == 1) {
#pragma unroll
            for (int i = 0; i < 4; ++i)
#pragma unroll
                for (int j = 0; j < 4; ++j) *(f32x4*)(U + (i * 16 + fr) * 132 + wc * 64 + j * 16 + fq * 4) = acc[i][j];
        }
        __syncthreads();
        if (wr == 0) {
#pragma unroll
            for (int i = 0; i < 4; ++i) {
                const int k1 = i * 16 + fr;
#pragma unroll
                for (int j = 0; j < 4; ++j) {
                    const int r = wc * 64 + j * 16 + fq * 4;
                    const int R = it * 128 + r, bn = R >> 6, t2 = R & 63, b = bn >> 9, n = bn & 511;
                    const f32x4 ai = *(const f32x4*)(U + k1 * 132 + r);
                    const f32x4 c = *(const f32x4*)(TWC + k1 * 64 + t2), sn = *(const f32x4*)(TWS + k1 * 64 + t2);
                    const f32x4 ar = acc[i][j];
                    const f32x4 pr = ar * c - ai * sn, pi = ar * sn + ai * c;
                    bf16_t* dst = A2 + ((size_t)(b * 64 + k1) * 512 + n) * 128 + t2;
                    store_bf16x4(dst, pr); store_bf16x4(dst + 64, pi);
                }
            }
        }
        __syncthreads();
    }
}
__device__ __forceinline__ void ph_fb(const Params& p, int l, char* smem) {
    const bf16_t* A2 = (const bf16_t*)(p.ws + O_A2); const bf16_t* E64 = (const bf16_t*)(p.ws + O_E64);
    const bf16_t* CST2 = (const bf16_t*)(p.ws + O_CST256); const bf16_t* YTC = (const bf16_t*)(p.ws + O_YTC);
    bf16_t* FA = (bf16_t*)(p.ws + O_FA);
    const int nctx = l < NLAYER - 1 ? 32 : 0, nitems = 1024 + nctx;
    const int skip = gridDim.x >= 128 ? 64 : 0;
    if ((int)blockIdx.x < skip) return;
    for (int it0 = blockIdx.x - skip; it0 < nitems; it0 += gridDim.x - skip) {
        const int it = it0 < nctx ? 1024 + it0 : it0 - nctx;
        if (it < 1024) {
            const int b = it >> 8, k1 = (it >> 2) & 63, nt = it & 3;
            f32x4 acc[2][4];
            RPPlain rpa{E64, 128};
            gemm_core_g<2>(rpa, A2 + ((size_t)(b * 64 + k1) * 512 + nt * 128) * 128, 128, 128, acc, smem);
            const float sc = 0.001381067932004975f;
            acc_foreach<2>(acc, [&](int m, int n, const f32x4& v) { f32x4 o = v * sc; store_bf16x4(FA + (size_t)(b * SEQ + k1 + 64 * m) * 512 + nt * 128 + n, o); });
        } else {
            const int j = it - 1024, b = j >> 3, mt = (j >> 2) & 1, nt = j & 3;
            f32x4 acc[4][4];
            RPPlain rp{CST2 + (size_t)mt * 128 * 512, 512};
            gemm_core_g<4>(rp, YTC + ((size_t)b * 512 + nt * 128) * 512, 512, 512, acc, smem);
            const float sc = 0.005524271728019903f;
            acc_foreach<4>(acc, [&](int m, int n, const f32x4& v) { f32x4 o = v * sc; store_bf16x4(FA + (size_t)(RL + b * CTX + mt * 128 + m) * 512 + nt * 128 + n, o); });
        }
    }
}

template <int MI>
__device__ __forceinline__ void mg_tile(const Params& p, int row0, int nt, char* smem) {
    const bf16_t* P = (const bf16_t*)(p.ws + O_P);
    const bf16_t* A0 = (const bf16_t*)(p.ws + O_FA); const bf16_t* A1 = (const bf16_t*)(p.ws + O_ATT); const bf16_t* A2 = (const bf16_t*)(p.ws + O_RWO);
    const bf16_t* W0 = (const bf16_t*)(p.ws + O_WB + W_PA); const bf16_t* W1 = (const bf16_t*)(p.ws + O_WB + W_PB); const bf16_t* W2 = (const bf16_t*)(p.ws + O_WB + W_PC);
    bf16_t* MG = (bf16_t*)(p.ws + O_H);
    f32x4 tot[MI][4];
#pragma unroll
    for (int i = 0; i < MI; ++i)
#pragma unroll
        for (int j = 0; j < 4; ++j) tot[i][j] = (f32x4){0.f, 0.f, 0.f, 0.f};
#pragma unroll 1
    for (int br = 0; br < 3; ++br) {
        const bf16_t* Ab = br == 0 ? A0 : (br == 1 ? A1 : A2);
        const bf16_t* Wb = br == 0 ? W0 : (br == 1 ? W1 : W2);
        f32x4 acc[MI][4];
        RPPlain rp{Ab + (size_t)row0 * 512, 512};
        gemm_core_g<MI>(rp, Wb + (size_t)nt * 128 * 512, 512, 512, acc, smem);
        const int lane = tidx() & 63, wave = tidx() >> 6, wr = wave >> 1, wc = wave & 1, fr = lane & 15, fq = lane >> 4;
#pragma unroll
        for (int i = 0; i < MI; ++i)
#pragma unroll
            for (int j = 0; j < 4; ++j) {
                const int m = wr * MI * 16 + i * 16 + fr, n = wc * 64 + j * 16 + fq * 4;
                const uint2 gu = *(const uint2*)(P + (size_t)(row0 + m) * LDP + PG0 + br * 1024 + nt * 128 + n);
                tot[i][j][0] += bflo(gu.x) * acc[i][j][0]; tot[i][j][1] += bfhi(gu.x) * acc[i][j][1];
                tot[i][j][2] += bflo(gu.y) * acc[i][j][2]; tot[i][j][3] += bfhi(gu.y) * acc[i][j][3];
            }
    }
    acc_foreach<MI>(tot, [&](int m, int n, const f32x4& v) { store_bf16x4(MG + (size_t)(row0 + m) * 1024 + nt * 128 + n, v); });
}
__device__ __forceinline__ void ph_mg(const Params& p, int l, char* smem) {
    const int nlat = (RL / 128) * 8, nctx = (l < NLAYER - 1) ? (RC / 32) * 8 : 0;
    for (int it = blockIdx.x; it < nlat + nctx; it += gridDim.x) {
        if (it < nlat) mg_tile<4>(p, (it >> 3) * 128, it & 7, smem);
        else { const int j = it - nlat; mg_tile<1>(p, RL + (j >> 3) * 32, j & 7, smem); }
    }
}
__device__ __forceinline__ void ph_out(const Params& p, int l, char* smem) {
    const bf16_t* MG = (const bf16_t*)(p.ws + O_H); const bf16_t* W = (const bf16_t*)(p.ws + O_WB + W_OUT);
    float* xcur = (float*)(p.ws + O_XCUR); const float* mod = (const float*)(p.ws + O_MOD);
    const int nlat = 1024, nctx = (l < NLAYER - 1) ? (RC / 32) * 8 : 0;
    for (int it = blockIdx.x; it < nlat + nctx; it += gridDim.x) {
        if (it < nlat) {
            const int mt = it >> 3, nt = it & 7;
            f32x4 acc[4][4];
            RPPlain rp{MG + (size_t)mt * 128 * 1024, 1024};
            gemm_core_g<4>(rp, W + (size_t)nt * 128 * 1024, 1024, 1024, acc, smem);
            acc_foreach<4>(acc, [&](int m, int n, const f32x4& v) {
                const int row = mt * 128 + m, col = nt * 128 + n;
                const float4 g = *(const float4*)(mod + (size_t)(l * 5 + modidx(row)) * 6144 + 2048 + col);
                float4* xp = (float4*)(xcur + (size_t)row * 1024 + col);
                float4 x = *xp; x.x += g.x * v[0]; x.y += g.y * v[1]; x.z += g.z * v[2]; x.w += g.w * v[3]; *xp = x;
            });
        } else {
            const int j = it - nlat, mt = j >> 3, nt = j & 7;
            f32x4 acc[1][4];
            RPPlain rp{MG + (size_t)(RL + mt * 32) * 1024, 1024};
            gemm_core_g<1>(rp, W + (size_t)nt * 128 * 1024, 1024, 1024, acc, smem);
            acc_foreach<1>(acc, [&](int m, int n, const f32x4& v) {
                const int row = RL + mt * 32 + m, col = nt * 128 + n;
                const float4 g = *(const float4*)(mod + (size_t)(l * 5 + 4) * 6144 + 2048 + col);
                float4* xp = (float4*)(xcur + (size_t)row * 1024 + col);
                float4 x = *xp; x.x += g.x * v[0]; x.y += g.y * v[1]; x.z += g.z * v[2]; x.w += g.w * v[3]; *xp = x;
            });
        }
    }
}

__device__ __forceinline__ void ph_n2(const Params& p, int l, char* smem) {
    const int tid = tidx(), lane = tid & 63, wave = tid >> 6;
    unsigned* lcnt = (unsigned*)smem;
    unsigned* gbase = lcnt + 16;
    int* rec = (int*)(smem + 256);
    float4* rwl = (float4*)(smem + 8192);
    for (int idx = tid; idx < 4096; idx += 256) {
        const int k = idx >> 2, pp = idx & 3;
        rwl[(((k >> 8) * 16 + (k & 3) * 4 + pp) << 6) + ((k & 255) >> 2)] = *(const float4*)(p.in[I_RW] + (size_t)k * 16 + pp * 4);
    }
    if (tid < 16) lcnt[tid] = 0u;
    __syncthreads();
    int nrec = 0;
    const float* xcur = (const float*)(p.ws + O_XCUR); const float* mod = (const float*)(p.ws + O_MOD);
    bf16_t* H = (bf16_t*)(p.ws + O_H);
    unsigned* cnt = (unsigned*)(p.ws + O_CNT); int* LTOK = (int*)(p.ws + O_LTOK); float* LW = (float*)(p.ws + O_LW); int* SLOT = (int*)(p.ws + O_SLOT);
    const float* g = p.in[I_N2G] + l * 1024; const float* rw = p.in[I_RW]; const float* rb = p.in[I_RB];
    const int nrows = (l < NLAYER - 1) ? RT : RL;
    float4 vn[4];
    {
        const int r0 = blockIdx.x * 4 + wave;
        const float* x0 = xcur + (size_t)(r0 < nrows ? r0 : 0) * 1024;
#pragma unroll
        for (int i = 0; i < 4; ++i) vn[i] = *(const float4*)(x0 + lane * 4 + 256 * i);
    }
    for (int row = blockIdx.x * 4 + wave; row < nrows; row += gridDim.x * 4) {
        const float* md = mod + (size_t)(l * 5 + modidx(row)) * 6144;
        float4 v[4]; float ss = 0.f;
#pragma unroll
        for (int i = 0; i < 4; ++i) { v[i] = vn[i]; ss += v[i].x * v[i].x + v[i].y * v[i].y + v[i].z * v[i].z + v[i].w * v[i].w; }
        {
            const int rn = row + gridDim.x * 4;
            const float* xn = xcur + (size_t)(rn < nrows ? rn : row) * 1024;
#pragma unroll
            for (int i = 0; i < 4; ++i) vn[i] = *(const float4*)(xn + lane * 4 + 256 * i);
        }
        ss = wsum(ss);
        const float rstd = rsqrtf(ss * (1.f / 1024.f) + 1e-6f);
        float lg[16];
#pragma unroll
        for (int e = 0; e < 16; ++e) lg[e] = 0.f;
#pragma unroll
        for (int i = 0; i < 4; ++i) {
            const int c = lane * 4 + 256 * i;
            const float4 gg = *(const float4*)(g + c), sc = *(const float4*)(md + 4096 + c), sh = *(const float4*)(md + 3072 + c);
            const float hv[4] = {v[i].x * rstd * gg.x * (1.f + sc.x) + sh.x, v[i].y * rstd * gg.y * (1.f + sc.y) + sh.y,
                                 v[i].z * rstd * gg.z * (1.f + sc.z) + sh.z, v[i].w * rstd * gg.w * (1.f + sc.w) + sh.w};
            f32x4 h4 = {hv[0], hv[1], hv[2], hv[3]};
            store_bf16x4(H + (size_t)row * 1024 + c, h4);
#pragma unroll
            for (int j = 0; j < 4; ++j) {
                const float4* wr_ = rwl + ((i * 16 + j * 4) << 6) + lane;
                const float4 w0 = wr_[0], w1 = wr_[64], w2 = wr_[128], w3 = wr_[192];
                lg[0] += hv[j] * w0.x; lg[1] += hv[j] * w0.y; lg[2] += hv[j] * w0.z; lg[3] += hv[j] * w0.w;
                lg[4] += hv[j] * w1.x; lg[5] += hv[j] * w1.y; lg[6] += hv[j] * w1.z; lg[7] += hv[j] * w1.w;
                lg[8] += hv[j] * w2.x; lg[9] += hv[j] * w2.y; lg[10] += hv[j] * w2.z; lg[11] += hv[j] * w2.w;
                lg[12] += hv[j] * w3.x; lg[13] += hv[j] * w3.y; lg[14] += hv[j] * w3.z; lg[15] += hv[j] * w3.w;
            }
        }
        float sc_[16], sel[16];
#pragma unroll
        for (int e = 0; e < 16; ++e) { lg[e] = wsum(lg[e]); sc_[e] = 1.f / (1.f + expf(-lg[e])); sel[e] = sc_[e] + rb[e]; }
        int best = 0; float bestv = -1e30f;
#pragma unroll
        for (int gi = 0; gi < 4; ++gi) {
            float m1 = -1e30f, m2 = -1e30f;
#pragma unroll
            for (int j = 0; j < 4; ++j) { const float s = sel[gi * 4 + j]; if (s > m1) { m2 = m1; m1 = s; } else if (s > m2) m2 = s; }
            const float gs = m1 + m2;
            if (gs > bestv) { bestv = gs; best = gi; }
        }
        float s4[4] = {0.f, 0.f, 0.f, 0.f}, c4[4] = {0.f, 0.f, 0.f, 0.f};
#pragma unroll
        for (int gi = 0; gi < 4; ++gi)
#pragma unroll
            for (int j = 0; j < 4; ++j) if (gi == best) { s4[j] = sel[gi * 4 + j]; c4[j] = sc_[gi * 4 + j]; }
        int i1 = 0; float v1 = s4[0], w1 = c4[0];
#pragma unroll
        for (int j = 1; j < 4; ++j) if (s4[j] > v1) { v1 = s4[j]; i1 = j; w1 = c4[j]; }
        int i2 = -1; float v2 = -1e30f, w2 = 0.f;
#pragma unroll
        for (int j = 0; j < 4; ++j) if (j != i1 && s4[j] > v2) { v2 = s4[j]; i2 = j; w2 = c4[j]; }
        if (lane == 0) {
            const float inv = 1.f / (w1 + w2);
            const int e1 = best * 4 + i1, e2 = best * 4 + i2;
            const unsigned r1 = atomicAdd(&lcnt[e1], 1u), r2 = atomicAdd(&lcnt[e2], 1u);
            int* rc = rec + (wave * 32 + nrec) * 8;
            rc[0] = row; rc[1] = e1; rc[2] = e2; rc[3] = (int)r1; rc[4] = (int)r2; rc[5] = __float_as_int(w1 * inv); rc[6] = __float_as_int(w2 * inv);
        }
        ++nrec;
    }
    __syncthreads();
    if (tid < 16) gbase[tid] = lcnt[tid] ? atomicAdd(&cnt[tid], lcnt[tid]) : 0u;
    __syncthreads();
    for (int i = lane; i < nrec; i += 64) {
        const int* rc = rec + (wave * 32 + i) * 8;
        const int row = rc[0], e1 = rc[1], e2 = rc[2];
        const unsigned p1 = gbase[e1] + (unsigned)rc[3], p2 = gbase[e2] + (unsigned)rc[4];
        LTOK[(size_t)e1 * RT + p1] = row; LW[(size_t)e1 * RT + p1] = __int_as_float(rc[5]);
        LTOK[(size_t)e2 * RT + p2] = row; LW[(size_t)e2 * RT + p2] = __int_as_float(rc[6]);
        SLOT[row * 2] = (e1 << 20) | (int)p1; SLOT[row * 2 + 1] = (e2 << 20) | (int)p2;
    }
}

struct MoeTiles { int tb[17]; int sm; };
__device__ __forceinline__ void moe_tiles(const Params& p, int l, int* s_tb) {
    if (tidx() == 0) {
        const unsigned* cnt = (const unsigned*)(p.ws + O_CNT);
        int a = 0;
        for (int e = 0; e < 16; ++e) { s_tb[e] = a; a += ((int)cnt[e] + 127) >> 7; }
        s_tb[16] = a;
    }
    __syncthreads();
}
__device__ __forceinline__ void ph_e1(const Params& p, int l, char* smem) {
    int* s_tb = (int*)(smem + 73728);
    moe_tiles(p, l, s_tb);
    const bf16_t* H = (const bf16_t*)(p.ws + O_H); bf16_t* ACT = (bf16_t*)(p.ws + O_P);
    const unsigned* cnt = (const unsigned*)(p.ws + O_CNT); const int* LTOK = (const int*)(p.ws + O_LTOK); const float* LW = (const float*)(p.ws + O_LW);
    const int sm = (l < NLAYER - 1) ? RT / 128 : RL / 128;
    const int total = (sm + s_tb[16]) * 8;
    for (int it = blockIdx.x; it < total; it += gridDim.x) {
        const int mt = it >> 3, nt = it & 7;
        int e = 16, erow0 = mt * 128, lt = 0;
        if (mt >= sm) { const int q = mt - sm; e = 0; while (q >= s_tb[e + 1]) ++e; lt = q - s_tb[e]; erow0 = RT + q * 128; }
        const int cnte = (e == 16) ? 0 : (int)cnt[e];
        auto rp = [&](int r) -> const bf16_t* {
            if (e == 16) return H + (size_t)(mt * 128 + r) * 1024;
            const int idx = lt * 128 + r;
            const int tok = idx < cnte ? LTOK[(size_t)e * RT + idx] : 0;
            return H + (size_t)tok * 1024;
        };
        f32x4 acc[4][4];
        gemm_core_g<4>(rp, (const bf16_t*)(p.ws + O_WB + W_GU) + (size_t)e * 1024 * 1024 + (size_t)nt * 128 * 1024, 1024, 1024, acc, smem);
        {
            const int lane = tidx() & 63, wave = tidx() >> 6, wr = wave >> 1, wc = wave & 1, fr = lane & 15, fq = lane >> 4;
            float* U = (float*)smem;
#pragma unroll
            for (int ii = 0; ii < 2; ++ii) {
                const int i = wc == 0 ? 2 + ii : ii;
#pragma unroll
                for (int j = 0; j < 4; ++j) { const f32x4 gv = wc == 0 ? acc[2 + ii][j] : acc[ii][j]; *(f32x4*)(U + (wr * 64 + i * 16 + fr) * 68 + j * 16 + fq * 4) = gv; }
            }
            __syncthreads();
#pragma unroll
            for (int ii = 0; ii < 2; ++ii) {
                const int i = wc == 0 ? ii : 2 + ii;
                const int m = wr * 64 + i * 16 + fr;
                float wgt = 1.f;
                if (e != 16) { const int idx = lt * 128 + m; wgt = idx < cnte ? LW[(size_t)e * RT + idx] : 0.f; }
#pragma unroll
                for (int j = 0; j < 4; ++j) {
                    const f32x4 other = *(const f32x4*)(U + m * 68 + j * 16 + fq * 4);
                    f32x4 o;
                    const f32x4 mine = wc == 0 ? acc[ii][j] : acc[2 + ii][j];
#pragma unroll
                    for (int r = 0; r < 4; ++r) { const float g = wc == 0 ? mine[r] : other[r], u = wc == 0 ? other[r] : mine[r]; o[r] = siluf_(g) * u * wgt; }
                    store_bf16x4(ACT + (size_t)(erow0 + m) * 512 + nt * 64 + j * 16 + fq * 4, o);
                }
            }
            __syncthreads();
        }
    }
}
__device__ __forceinline__ void ph_e2(const Params& p, int l, char* smem) {
    int* s_tb = (int*)(smem + 73728);
    moe_tiles(p, l, s_tb);
    const bf16_t* ACT = (const bf16_t*)(p.ws + O_P); bf16_t* YE = (bf16_t*)(p.ws + O_X + X_YE);
    const int sm = (l < NLAYER - 1) ? RT / 128 : RL / 128;
    const int total = (sm + s_tb[16]) * 8;
    for (int it = blockIdx.x; it < total; it += gridDim.x) {
        const int mt = it >> 3, nt = it & 7;
        int e = 16, erow0 = mt * 128;
        if (mt >= sm) { const int q = mt - sm; e = 0; while (q >= s_tb[e + 1]) ++e; erow0 = RT + q * 128; }
        RPPlain rp{ACT + (size_t)erow0 * 512, 512};
        f32x4 acc[4][4];
        gemm_core_g<4>(rp, (const bf16_t*)(p.ws + O_WB + W_D) + (size_t)e * 1024 * 512 + (size_t)nt * 128 * 512, 512, 512, acc, smem);
        acc_foreach<4>(acc, [&](int m, int n, const f32x4& v) { store_bf16x4(YE + (size_t)(erow0 + m) * 1024 + nt * 128 + n, v); });
    }
}
__device__ __forceinline__ void ph_e3(const Params& p, int l, char* smem) {
    int* s_tb = (int*)(smem + 73728);
    moe_tiles(p, l, s_tb);
    const int lane = tidx() & 63, wave = tidx() >> 6;
    const bf16_t* YE = (const bf16_t*)(p.ws + O_X + X_YE); const int* SLOT = (const int*)(p.ws + O_SLOT);
    float* xcur = (float*)(p.ws + O_XCUR); const float* mod = (const float*)(p.ws + O_MOD);
    bf16_t* H = (bf16_t*)(p.ws + O_H);
    const bool last = l == NLAYER - 1;
    const int nrows = last ? RL : RT;
    const float* gn = last ? p.in[I_FNG] : p.in[I_N1G] + (l + 1) * 1024;
    const int stride = gridDim.x * 4, row0 = blockIdx.x * 4 + wave;
    auto slot_rows = [&](int row, size_t& r1, size_t& r2) {
        const int rr = row < nrows ? row : 0;
        const int s1 = SLOT[rr * 2], s2 = SLOT[rr * 2 + 1];
        r1 = (size_t)RT + s_tb[s1 >> 20] * 128 + (s1 & 0xfffff); r2 = (size_t)RT + s_tb[s2 >> 20] * 128 + (s2 & 0xfffff);
    };
    uint4 ya[2], yb[2], yd[2]; float4 xa[2][2];
    size_t r1n, r2n;
    auto load_row = [&](int row, size_t r1, size_t r2) {
        const size_t rr = row < nrows ? row : 0;
#pragma unroll
        for (int i = 0; i < 2; ++i) {
            const int c = lane * 8 + 512 * i;
            ya[i] = *(const uint4*)(YE + rr * 1024 + c); yb[i] = *(const uint4*)(YE + r1 * 1024 + c); yd[i] = *(const uint4*)(YE + r2 * 1024 + c);
            const float4* xp = (const float4*)(xcur + rr * 1024 + c);
            xa[i][0] = xp[0]; xa[i][1] = xp[1];
        }
    };
    { size_t r1, r2; slot_rows(row0, r1, r2); load_row(row0, r1, r2); slot_rows(row0 + stride, r1n, r2n); }
    for (int row = row0; row < nrows; row += stride) {
        const float* g2 = mod + (size_t)(l * 5 + modidx(row)) * 6144 + 5120;
        float xv[2][8]; float ss = 0.f;
#pragma unroll
        for (int i = 0; i < 2; ++i) {
            const int c = lane * 8 + 512 * i;
            float a[8], b[8], d[8];
            unpack8(ya[i], a); unpack8(yb[i], b); unpack8(yd[i], d);
            const float4 x0 = xa[i][0], x1 = xa[i][1];
            const float4 ga = *(const float4*)(g2 + c), gb = *(const float4*)(g2 + c + 4);
            const float xo[8] = {x0.x, x0.y, x0.z, x0.w, x1.x, x1.y, x1.z, x1.w}, gg[8] = {ga.x, ga.y, ga.z, ga.w, gb.x, gb.y, gb.z, gb.w};
#pragma unroll
            for (int e = 0; e < 8; ++e) { xv[i][e] = xo[e] + gg[e] * (a[e] + b[e] + d[e]); ss += xv[i][e] * xv[i][e]; }
            if (!last) { float4* xp = (float4*)(xcur + (size_t)row * 1024 + c); xp[0] = make_float4(xv[i][0], xv[i][1], xv[i][2], xv[i][3]); xp[1] = make_float4(xv[i][4], xv[i][5], xv[i][6], xv[i][7]); }
        }
        { const size_t r1 = r1n, r2 = r2n; load_row(row + stride, r1, r2); slot_rows(row + 2 * stride, r1n, r2n); }
        ss = wsum(ss);
        const float rstd = rsqrtf(ss * (1.f / 1024.f) + 1e-6f);
        const float* md = mod + (size_t)((l + 1) * 5 + modidx(row)) * 6144;
#pragma unroll
        for (int i = 0; i < 2; ++i) {
            const int c = lane * 8 + 512 * i;
            const float4 n0 = *(const float4*)(gn + c), n1 = *(const float4*)(gn + c + 4);
            const float nn[8] = {n0.x, n0.y, n0.z, n0.w, n1.x, n1.y, n1.z, n1.w};
            if (last) {
                float* op = p.out + (size_t)row * 1024 + c;
                *(float4*)op = make_float4(xv[i][0] * rstd * nn[0], xv[i][1] * rstd * nn[1], xv[i][2] * rstd * nn[2], xv[i][3] * rstd * nn[3]);
                *(float4*)(op + 4) = make_float4(xv[i][4] * rstd * nn[4], xv[i][5] * rstd * nn[5], xv[i][6] * rstd * nn[6], xv[i][7] * rstd * nn[7]);
            } else {
                const float4 c0 = *(const float4*)(md + 1024 + c), c1 = *(const float4*)(md + 1024 + c + 4), h0 = *(const float4*)(md + c), h1 = *(const float4*)(md + c + 4);
                const float sc[8] = {c0.x, c0.y, c0.z, c0.w, c1.x, c1.y, c1.z, c1.w}, sh[8] = {h0.x, h0.y, h0.z, h0.w, h1.x, h1.y, h1.z, h1.w};
                float o[8];
#pragma unroll
                for (int e = 0; e < 8; ++e) o[e] = xv[i][e] * rstd * nn[e] * (1.f + sc[e]) + sh[e];
                *(uint4*)(H + (size_t)row * 1024 + c) = pack8(o);
            }
        }
    }
}
constexpr int LDS_BYTES = 76800;
constexpr int NIV = 19;
extern __shared__ __attribute__((aligned(16))) char dynsmem[];
template <int ID> __device__ __forceinline__ void run_iv(const Params& pin, int l, char* smem) {
    Params p = pin; p.ws = launder(pin.ws);
    if constexpr (ID == 0) { ph_pre(p, smem); __syncthreads(); ph_w(p, 0, smem); }
    else if constexpr (ID == 1) ph_n1(p, l);
    else if constexpr (ID == 2) ph_g1(p, smem);
    else if constexpr (ID == 3) { ph_qu(p, smem); ph_krope(p); ph_rp1(p, l, smem); ph_rp2(p, l); ph_f1(p, l, smem); }
    else if constexpr (ID == 5) {
        const bool r1first = (blockIdx.x >> 8) & 1;
#pragma unroll 1
        for (int pass = 0; pass < 2; ++pass) {
            if ((pass == 0) == r1first) { ph_r1(p, l, smem); ph_fa(p, smem); } else ph_at(p, l, smem);
            __syncthreads();
        }
    }
    else if constexpr (ID == 8) { ph_r2(p, smem); __syncthreads(); ph_fb(p, l, smem); }
    else if constexpr (ID == 9) ph_r3(p, l, smem);
    else if constexpr (ID == 12) ph_mg(p, l, smem);
    else if constexpr (ID == 13) ph_out(p, l, smem);
    else if constexpr (ID == 14) ph_n2(p, l, smem);
    else if constexpr (ID == 15) ph_e1(p, l, smem);
    else if constexpr (ID == 16) ph_e2(p, l, smem);
    else if constexpr (ID == 17) { ph_e3(p, l, smem); __syncthreads(); if (l + 1 < NLAYER) ph_w(p, l + 1, smem); }
}
#if MEGA
#ifndef PROBE_MASK
#define PROBE_MASK 0
#define PROBE_REP 1
#endif
#define IV(ID) for (int r_ = 0; r_ < (((PROBE_MASK >> (ID)) & 1) ? PROBE_REP : 1); ++r_) { run_iv<ID>(p, l, smem); xcd_barrier(bar); }
__global__ void __launch_bounds__(256, 2) k_mega(Params p) {
    char* smem = dynsmem;
    volatile LAS unsigned* st = (volatile LAS unsigned*)(smem + LDS_BYTES - 16);
    if (tidx() == 0) { st[0] = 0u; st[1] = 0u; }
    __syncthreads();
    XcdBarrier bar = xcd_barrier_post((unsigned*)(p.ws + O_BAR), st);
    { const int l = 0; IV(0) }
    for (int l = 0; l < NLAYER; ++l) {
        if (l == 0) { IV(1) } IV(2) IV(3) IV(5) IV(8) IV(9) IV(12) IV(13) IV(14) IV(15) IV(16) IV(17)
    }
}
#else
template <int ID> __global__ void __launch_bounds__(256, 2) k_iv(Params p, int l) { run_iv<ID>(p, l, dynsmem); }
template <int ID> static void launch_iv(const Params& p, int l, int grid, hipStream_t s) {
    static bool once = false; if (!once) { once = true; (void)hipFuncSetAttribute((const void*)k_iv<ID>, hipFuncAttributeMaxDynamicSharedMemorySize, LDS_BYTES); }
    hipLaunchKernelGGL(k_iv<ID>, dim3(grid), dim3(256), LDS_BYTES, s, p, l);
}
#endif

extern "C" void kernel_launch(void* const* d_in, const int* in_sizes, int n_in, void* d_out, int out_size, void* d_ws, size_t ws_size, hipStream_t stream) {
    (void)in_sizes; (void)out_size;
    if (n_in < N_IN || ws_size < WS_NEED) return;
    Params p{};
    for (int i = 0; i < N_IN; ++i) p.in[i] = (const float*)d_in[i];
    p.out = (float*)d_out; p.ws = (char*)d_ws;
    static int grid = 0;
    if (!grid) {
        int dev = 0, cus = 0; (void)hipGetDevice(&dev); (void)hipDeviceGetAttribute(&cus, hipDeviceAttributeMultiprocessorCount, dev);
        int per_cu = 2;
#if MEGA
        (void)hipFuncSetAttribute((const void*)k_mega, hipFuncAttributeMaxDynamicSharedMemorySize, LDS_BYTES);
        int occ = 0; (void)hipOccupancyMaxActiveBlocksPerMultiprocessor(&occ, k_mega, 256, LDS_BYTES);
        if (occ < per_cu) per_cu = occ;
        if (per_cu < 1) per_cu = 1;
#endif
        grid = cus * per_cu;
    }
#if MEGA
    (void)hipMemsetAsync(p.ws + O_BAR, 0, 16384, stream);
    hipLaunchKernelGGL(k_mega, dim3(grid), dim3(256), LDS_BYTES, stream, p);
#else
    launch_iv<0>(p, 0, grid, stream);
    for (int l = 0; l < NLAYER; ++l) {
        if (l == 0) launch_iv<1>(p, l, grid, stream); launch_iv<2>(p, l, grid, stream); launch_iv<3>(p, l, grid, stream);
        launch_iv<5>(p, l, grid, stream); launch_iv<8>(p, l, grid, stream);
        launch_iv<9>(p, l, grid, stream); launch_iv<12>(p, l, grid, stream);
        launch_iv<13>(p, l, grid, stream); launch_iv<14>(p, l, grid, stream); launch_iv<15>(p, l, grid, stream); launch_iv<16>(p, l, grid, stream); launch_iv<17>(p, l, grid, stream);
    }
#endif
}
```

```cpp
#include <hip/hip_runtime.h>
#include <stdint.h>

#ifndef MEGA
#define MEGA 1
#endif

typedef unsigned short bf16_t;
typedef short bf16x8 __attribute__((ext_vector_type(8)));
typedef float f32x4 __attribute__((ext_vector_type(4)));
typedef float f32x2 __attribute__((ext_vector_type(2)));
typedef unsigned u32x4 __attribute__((ext_vector_type(4)));
typedef __bf16 bf16v2 __attribute__((ext_vector_type(2)));

constexpr int NLAYER = 4;
constexpr int DM = 1024;
constexpr int RL = 16384, RC = 1024, RT = RL + RC;
constexpr int SEQ = 4096, CTX = 256, KEYS = SEQ + CTX;
constexpr int LDP = 6144;
constexpr int PQ0 = 512, PKV0 = 896, PKR0 = 1152, PR0 = 1184, PG0 = 2976, PEND = 6048;
constexpr int NEXP = 16;
constexpr int EROWS = 54272;

enum { I_X = 0, I_C, I_CTX, I_CCTX, I_WADA, I_BADA, I_N1G, I_N2G, I_WIN, I_QNG, I_KVNG, I_WUQ, I_WUKV, I_MU, I_W0, I_WUP, I_A0, I_AUP, I_GUP,
       I_KK, I_KA, I_RK, I_GNG, I_GNB, I_WPA, I_WPB, I_WPC, I_WOUT, I_RW, I_RB, I_EG, I_EU, I_ED, I_SG, I_SU, I_SD, I_FNG, N_IN };

struct Params { const float* in[N_IN]; float* out; char* ws; };
constexpr int LDS_BYTES = 76800;

constexpr size_t al256(size_t x) { return (x + 255) & ~(size_t)255; }
constexpr size_t O_BAR   = 0;
constexpr size_t O_CNT   = O_BAR + 16384;
constexpr size_t O_MOD   = O_CNT + 4096;
constexpr size_t O_ROPEC = O_MOD + (size_t)NLAYER * 5 * 6144 * 4;
constexpr size_t O_ROPES = O_ROPEC + (size_t)SEQ * 16 * 4;
constexpr size_t O_CSC   = O_ROPES + (size_t)SEQ * 16 * 4;
constexpr size_t O_CST256= O_CSC + 256 * 128 * 2;
constexpr size_t O_D128  = O_CST256 + 256 * 512 * 2;
constexpr size_t O_E64   = O_D128 + 128 * 128 * 2;
constexpr size_t O_TWC   = O_E64 + 64 * 128 * 2;
constexpr size_t O_TWS   = O_TWC + 64 * 64 * 4;
constexpr size_t O_YT2   = O_TWS + 64 * 64 * 4;
constexpr size_t O_A2    = O_YT2 + (size_t)4 * 512 * 64 * 128 * 2;
constexpr size_t O_YTC   = O_A2 + (size_t)4 * 512 * 64 * 128 * 2;
constexpr size_t O_XCUR  = O_YTC + (size_t)4 * 512 * 512 * 2;
constexpr size_t O_WB    = O_XCUR + (size_t)RT * DM * 4;
constexpr size_t W_IN   = 0;
constexpr size_t W_UQ   = W_IN + (size_t)6144 * 1024 * 2;
constexpr size_t W_UKV  = W_UQ + (size_t)768 * 384 * 2;
constexpr size_t W_WUP  = W_UKV + (size_t)1024 * 256 * 2;
constexpr size_t W_AUP  = W_WUP + (size_t)2 * 512 * 64 * 2;
constexpr size_t W_GUP  = W_AUP + (size_t)2 * 512 * 64 * 2;
constexpr size_t W_PA   = W_GUP + (size_t)512 * 128 * 2;
constexpr size_t W_PB   = W_PA + (size_t)1024 * 512 * 2;
constexpr size_t W_PC   = W_PB + (size_t)1024 * 512 * 2;
constexpr size_t W_OUT  = W_PC + (size_t)1024 * 512 * 2;
constexpr size_t W_GU   = W_OUT + (size_t)1024 * 1024 * 2;
constexpr size_t W_D    = W_GU + (size_t)17 * 1024 * 1024 * 2;
constexpr size_t W_END  = W_D + (size_t)17 * 1024 * 512 * 2;
constexpr size_t O_H    = O_WB + W_END;
constexpr size_t O_P    = O_H + (size_t)RT * DM * 2;
constexpr size_t O_ATT  = O_P + (size_t)RT * LDP * 2;
constexpr size_t O_RG   = O_ATT + (size_t)RT * 512 * 2;
constexpr size_t O_RWO  = O_RG + (size_t)RT * 512 * 2;
constexpr size_t O_FA   = O_RWO + (size_t)RT * 512 * 2;
constexpr size_t O_LTOK = O_FA + (size_t)RT * 512 * 2;
constexpr size_t O_LW   = O_LTOK + (size_t)NEXP * RT * 4;
constexpr size_t O_SLOT = O_LW + (size_t)NEXP * RT * 4;
constexpr size_t O_X    = al256(O_SLOT + (size_t)RT * 2 * 4);
constexpr size_t X_QA   = 0;
constexpr size_t X_KA   = X_QA + (size_t)RT * 768 * 2;
constexpr size_t X_VA   = X_KA + (size_t)4 * KEYS * 768 * 2;
constexpr int NCP = 4 * 8 * 2 * 68;
constexpr size_t X_S0   = 0;
constexpr size_t X_MT   = X_VA + (size_t)4 * 8 * 64 * KEYS * 2;
constexpr size_t X_GT   = X_MT + (size_t)NCP * 8192;
constexpr size_t X_YL   = X_GT + (size_t)NCP * 8192;
constexpr size_t X_KKN  = X_YL + (size_t)NCP * 8192;
constexpr size_t X_BON  = X_KKN + (size_t)RT * 8 * 4;
constexpr size_t X_SSQ  = X_BON + (size_t)2 * RT * 8 * 4;
constexpr size_t X_X12  = X_SSQ + (size_t)RT * 10 * 4;
constexpr size_t X_END  = X_X12 + (size_t)RT * 128 * 2;
static_assert(X_S0 + (size_t)NCP * 8192 <= X_VA, "S0 must fit in the q/k area");
constexpr size_t X_YE   = 0;
constexpr size_t WS_NEED = O_X + X_END;

__device__ __forceinline__ float bf2f(bf16_t u) { return __builtin_bit_cast(float, (unsigned)u << 16); }
__device__ __forceinline__ float bflo(unsigned u) { return __builtin_bit_cast(float, u << 16); }
__device__ __forceinline__ float bfhi(unsigned u) { return __builtin_bit_cast(float, u & 0xffff0000u); }
__device__ __forceinline__ unsigned pack2(float lo, float hi) { f32x2 v = {lo, hi}; bf16v2 b = __builtin_convertvector(v, bf16v2); return __builtin_bit_cast(unsigned, b); }
__device__ __forceinline__ bf16_t f2bf(float f) { return (bf16_t)(pack2(f, 0.f) & 0xffffu); }
__device__ __forceinline__ float wsum(float v) {
#pragma unroll
    for (int o = 32; o > 0; o >>= 1) v += __shfl_xor(v, o);
    return v;
}
__device__ __forceinline__ float sigmoidf_(float x) { return __builtin_amdgcn_rcpf(1.f + __expf(-x)); }
__device__ __forceinline__ float siluf_(float x) { return x * __builtin_amdgcn_rcpf(1.f + __expf(-x)); }
__device__ __forceinline__ int modidx(int row) { return row < RL ? (row >> 12) : 4; }
__device__ __forceinline__ void unpack8(const uint4& u, float (&f)[8]) {
    f[0] = bflo(u.x); f[1] = bfhi(u.x); f[2] = bflo(u.y); f[3] = bfhi(u.y); f[4] = bflo(u.z); f[5] = bfhi(u.z); f[6] = bflo(u.w); f[7] = bfhi(u.w);
}
__device__ __forceinline__ uint4 pack8(const float (&f)[8]) { return make_uint4(pack2(f[0], f[1]), pack2(f[2], f[3]), pack2(f[4], f[5]), pack2(f[6], f[7])); }

__device__ __forceinline__ float xmax_16_32(float v) {
    unsigned u = __builtin_bit_cast(unsigned, v);
    auto r = __builtin_amdgcn_permlane32_swap(u, u, false, false);
    float m = fmaxf(__builtin_bit_cast(float, r[0]), __builtin_bit_cast(float, r[1]));
    u = __builtin_bit_cast(unsigned, m);
    auto r2 = __builtin_amdgcn_permlane16_swap(u, u, false, false);
    return fmaxf(__builtin_bit_cast(float, r2[0]), __builtin_bit_cast(float, r2[1]));
}
__device__ __forceinline__ float lane_xor32(float v, int lane) {
    const unsigned u = __builtin_bit_cast(unsigned, v);
    auto r = __builtin_amdgcn_permlane32_swap(u, u, false, false);
    return __builtin_bit_cast(float, lane < 32 ? r[1] : r[0]);
}
__device__ __forceinline__ float xsum_16_32(float v) {
    unsigned u = __builtin_bit_cast(unsigned, v);
    auto r = __builtin_amdgcn_permlane32_swap(u, u, false, false);
    float m = __builtin_bit_cast(float, r[0]) + __builtin_bit_cast(float, r[1]);
    u = __builtin_bit_cast(unsigned, m);
    auto r2 = __builtin_amdgcn_permlane16_swap(u, u, false, false);
    return __builtin_bit_cast(float, r2[0]) + __builtin_bit_cast(float, r2[1]);
}
#define XB_TMO      128
#define XB_XCNT(j)  (256  + 64 * (j))
#define XB_XSUB(j)  (1280 + 64 * (j))
#define XB_XGEN(j)  (2304 + 64 * (j))
#define XB_TOP      3328
#define XB_TOPGEN   3392
#define XCD_BAR_WORDS 3456
#define XB_SPIN_CAP (1u << 22)
#define LAS __attribute__((address_space(3)))
__device__ __forceinline__ unsigned xb_ld(unsigned* p)              { return __hip_atomic_load(p, __ATOMIC_RELAXED, __HIP_MEMORY_SCOPE_AGENT); }
__device__ __forceinline__ unsigned xb_add(unsigned* p, unsigned v) { return __hip_atomic_fetch_add(p, v, __ATOMIC_RELAXED, __HIP_MEMORY_SCOPE_AGENT); }
__device__ __forceinline__ unsigned xb_xcc_id() { return (unsigned)__builtin_amdgcn_s_getreg((3 << 11) | 20) & 0xFu; }
#define XB_SPIN(cond, bar) do { unsigned _sp = 0; while (cond) { __builtin_amdgcn_s_sleep(1); \
    if ((++_sp & 255u) == 0u) { if (xb_ld(&(bar)[XB_TMO])) break; if (_sp > XB_SPIN_CAP) { atomicAdd(&(bar)[XB_TMO], 1u); break; } } } } while (0)
struct XcdBarrier { unsigned* bar; unsigned x; volatile LAS unsigned* st; };
__device__ __forceinline__ XcdBarrier xcd_barrier_post(unsigned* bar, volatile LAS unsigned* st) {
    XcdBarrier b; b.bar = bar; b.x = xb_xcc_id(); b.st = st;
    if (threadIdx.x == 0) (void)xb_add(&bar[XB_XCNT(b.x)], 1u);
    return b;
}
__device__ __forceinline__ void xcd_barrier_complete(unsigned* bar, unsigned x, unsigned& nloc, unsigned& nx) {
    const unsigned G = gridDim.x * gridDim.y * gridDim.z;
    unsigned sum, cnt, mine, sp = 0u;
    for (;;) {
        sum = 0u; cnt = 0u; mine = 0u;
#pragma unroll
        for (unsigned j = 0; j < 16; ++j) { const unsigned c = xb_ld(&bar[XB_XCNT(j)]); sum += c; cnt += (c > 0u) ? 1u : 0u; mine = (j == x) ? c : mine; }
        if (sum == G) break;
        __builtin_amdgcn_s_sleep(1);
        if ((++sp & 255u) == 0u) { if (xb_ld(&bar[XB_TMO])) break; if (sp > XB_SPIN_CAP) { atomicAdd(&bar[XB_TMO], 1u); break; } }
    }
    nloc = mine > 0u ? mine : 1u; nx = cnt > 0u ? cnt : 1u;
}
__device__ __forceinline__ void xcd_barrier(const XcdBarrier& b) {
    asm volatile("s_waitcnt vmcnt(0)" ::: "memory");
    __syncthreads();
    if (threadIdx.x == 0) {
        unsigned* bar = b.bar;
        __builtin_amdgcn_s_waitcnt(0);
        unsigned nloc = b.st[0], nx = b.st[1];
        if (nloc == 0u) { xcd_barrier_complete(bar, b.x, nloc, nx); b.st[0] = nloc; b.st[1] = nx; }
        const unsigned old = xb_add(&bar[XB_XSUB(b.x)], 1u);
        const unsigned gen = old / nloc;
        if (old + 1u == (gen + 1u) * nloc) {
            __builtin_amdgcn_fence(__ATOMIC_RELEASE, "agent");
            asm volatile("s_waitcnt vmcnt(0)" ::: "memory");
            const unsigned og = xb_add(&bar[XB_TOP], 1u);
            const unsigned tg = og / nx;
            if (og + 1u == (tg + 1u) * nx) xb_add(&bar[XB_TOPGEN], 1u);
            else XB_SPIN(xb_ld(&bar[XB_TOPGEN]) == tg, bar);
            __builtin_amdgcn_fence(__ATOMIC_ACQUIRE, "agent");
            xb_add(&bar[XB_XGEN(b.x)], 1u);
            asm volatile("s_waitcnt vmcnt(0)" ::: "memory");
        } else {
            XB_SPIN(xb_ld(&bar[XB_XGEN(b.x)]) == gen, bar);
            __builtin_amdgcn_fence(__ATOMIC_ACQUIRE, "agent");
            asm volatile("s_waitcnt vmcnt(0)" ::: "memory");
        }
    }
    __syncthreads();
}

__device__ __forceinline__ int tidx() { int t = threadIdx.x; asm volatile("" : "+v"(t)); return t; }
__device__ __forceinline__ int lv(int x) { asm volatile("" : "+v"(x)); return x; }
__device__ __forceinline__ char* launder(char* p) { size_t z = 0; asm volatile("" : "+s"(z)); return p + z; }

constexpr int LDSROW = 72;
template <int NA, class AL>
__device__ __forceinline__ void gc_load(const AL& al, const bf16_t* bp, size_t bstep, int k0, int kc, u32x4 (&ra)[NA], u32x4 (&rb)[4]) {
#pragma unroll
    for (int i = 0; i < NA; ++i) ra[i] = __builtin_bit_cast(u32x4, al.load(i, k0 + kc));
#pragma unroll
    for (int j = 0; j < 4; ++j) rb[j] = *(const u32x4*)(bp + j * bstep + k0);
}
template <int NA>
__device__ __forceinline__ void gc_store(bf16_t* Ab, bf16_t* Bb, int lr, int kc, const u32x4 (&ra)[NA], const u32x4 (&rb)[4]) {
#pragma unroll
    for (int i = 0; i < NA; ++i) *(u32x4*)(Ab + (lr + 32 * i) * LDSROW + kc) = ra[i];
#pragma unroll
    for (int j = 0; j < 4; ++j) *(u32x4*)(Bb + (lr + 32 * j) * LDSROW + kc) = rb[j];
}
template <int MI>
__device__ __forceinline__ void gc_compute(const bf16_t* Ac, const bf16_t* Bc, f32x4 (&acc)[MI][4]) {
#pragma unroll
    for (int kh = 0; kh < 2; ++kh) {
        bf16x8 af[MI], bfv[4];
#pragma unroll
        for (int i = 0; i < MI; ++i) af[i] = *(const bf16x8*)(Ac + i * 16 * LDSROW + kh * 32);
#pragma unroll
        for (int j = 0; j < 4; ++j) bfv[j] = *(const bf16x8*)(Bc + j * 16 * LDSROW + kh * 32);
#pragma unroll
        for (int i = 0; i < MI; ++i)
#pragma unroll
            for (int j = 0; j < 4; ++j) acc[i][j] = __builtin_amdgcn_mfma_f32_16x16x32_bf16(bfv[j], af[i], acc[i][j], 0, 0, 0);
    }
}
template <int MI, class AL>
__device__ __forceinline__ void gemm_core(const AL& al, const bf16_t* __restrict__ Bt, int ldb, int K, f32x4 (&acc)[MI][4], char* smem) {
    constexpr int TM = MI * 32;
    constexpr int NA = TM / 32;
    bf16_t* As = (bf16_t*)smem;
    bf16_t* Bs = As + 2 * TM * LDSROW;
    const int tid = tidx(), lane = tid & 63, wave = tid >> 6;
    const int wr = wave >> 1, wc = wave & 1, fr = lane & 15, fq = lane >> 4;
    const int kc = (tid & 7) * 8, lr = tid >> 3;
#pragma unroll
    for (int i = 0; i < MI; ++i)
#pragma unroll
        for (int j = 0; j < 4; ++j) acc[i][j] = (f32x4){0.f, 0.f, 0.f, 0.f};
    u32x4 a0[NA], b0[4], a1[NA], b1[4];
    const bf16_t* bp = Bt + (size_t)lr * ldb + kc;
    const size_t bstep = (size_t)32 * ldb;
    const int nk = K >> 6;
    bf16_t* As1 = As + TM * LDSROW; bf16_t* Bs1 = Bs + 128 * LDSROW;
    const int aoff = (wr * MI * 16 + fr) * LDSROW + fq * 8, boff = (wc * 64 + fr) * LDSROW + fq * 8;
    gc_load<NA>(al, bp, bstep, 0, kc, a0, b0);
    gc_store<NA>(As, Bs, lr, kc, a0, b0);
    if (nk > 1) gc_load<NA>(al, bp, bstep, 64, kc, a0, b0);
    __syncthreads();
    for (int kt = 0; kt < nk; kt += 2) {
        if (kt + 2 < nk) gc_load<NA>(al, bp, bstep, (kt + 2) << 6, kc, a1, b1);
        gc_compute<MI>(As + aoff, Bs + boff, acc);
        if (kt + 1 < nk) gc_store<NA>(As1, Bs1, lr, kc, a0, b0);
        __syncthreads();
        if (kt + 1 >= nk) break;
        if (kt + 3 < nk) gc_load<NA>(al, bp, bstep, (kt + 3) << 6, kc, a0, b0);
        gc_compute<MI>(As1 + aoff, Bs1 + boff, acc);
        if (kt + 2 < nk) gc_store<NA>(As, Bs, lr, kc, a1, b1);
        __syncthreads();
    }
}
template <int MI, class RP, class RPB>
__device__ __forceinline__ void gemm_core_gb(const RP& rp, const RPB& rpb, int K, f32x4 (&acc)[MI][4], char* smem) {
    constexpr int ABYTES = MI * 32 * 128;
    constexpr int SBYTES = ABYTES + 16384;
    const int tid = tidx(), lane = tid & 63, wave = tid >> 6;
    const int wr = wave >> 1, wc = wave & 1, fr = lane & 15, fq = lane >> 4;
    const int rr = lane >> 3, cs = ((lane & 7) ^ ((wave * 4 + (lane >> 4)) & 7)) * 8;
#pragma unroll
    for (int i = 0; i < MI; ++i)
#pragma unroll
        for (int j = 0; j < 4; ++j) acc[i][j] = (f32x4){0.f, 0.f, 0.f, 0.f};
    const bf16_t* ap[MI]; const bf16_t* bp[4];
#pragma unroll
    for (int i = 0; i < MI; ++i) { const int r = (i * 4 + wave) * 8 + rr; ap[i] = rp(r) + cs; }
#pragma unroll
    for (int i = 0; i < 4; ++i) { const int r = (i * 4 + wave) * 8 + rr; bp[i] = rpb(r) + cs; }
    const int wbase = __builtin_amdgcn_readfirstlane(wave) * 1024;
    const int nk = K >> 6;
    auto stage = [&](int buf, int kt) {
        char* Ab = smem + buf * SBYTES + wbase; char* Bb = Ab + ABYTES;
#pragma unroll
        for (int i = 0; i < MI; ++i) __builtin_amdgcn_global_load_lds((const unsigned*)(ap[i] + kt * 64), (unsigned*)(Ab + i * 4096), 16, 0, 0);
#pragma unroll
        for (int i = 0; i < 4; ++i) __builtin_amdgcn_global_load_lds((const unsigned*)(bp[i] + kt * 64), (unsigned*)(Bb + i * 4096), 16, 0, 0);
    };
    const int aoff = (wr * MI * 16 + fr) * 128, boff = ABYTES + (wc * 64 + fr) * 128, sw = fr >> 1;
    stage(0, 0);
    asm volatile("s_waitcnt vmcnt(0)" ::: "memory");
    __syncthreads();
    for (int kt = 0; kt < nk; ++kt) {
        const int cur = kt & 1;
        if (kt + 1 < nk) stage(cur ^ 1, kt + 1);
        const char* base = smem + cur * SBYTES;
#pragma unroll
        for (int kh = 0; kh < 2; ++kh) {
            const int xo = ((kh * 4 + fq) ^ sw) * 16;
            bf16x8 af[MI], bfv[4];
#pragma unroll
            for (int i = 0; i < MI; ++i) af[i] = *(const bf16x8*)(base + aoff + i * 2048 + xo);
#pragma unroll
            for (int j = 0; j < 4; ++j) bfv[j] = *(const bf16x8*)(base + boff + j * 2048 + xo);
#pragma unroll
            for (int i = 0; i < MI; ++i)
#pragma unroll
                for (int j = 0; j < 4; ++j) acc[i][j] = __builtin_amdgcn_mfma_f32_16x16x32_bf16(bfv[j], af[i], acc[i][j], 0, 0, 0);
        }
        asm volatile("s_waitcnt vmcnt(0)" ::: "memory");
        __syncthreads();
    }
}
struct RPPlain;
template <int MI, class RP>
__device__ __forceinline__ void gemm_core_g(const RP& rp, const bf16_t* __restrict__ Bt, int ldb, int K, f32x4 (&acc)[MI][4], char* smem);
struct RPPlain {
    const bf16_t* A; size_t lda;
    __device__ __forceinline__ const bf16_t* operator()(int r) const { return A + (size_t)r * lda; }
};
template <int MI, class RP>
__device__ __forceinline__ void gemm_core_g(const RP& rp, const bf16_t* __restrict__ Bt, int ldb, int K, f32x4 (&acc)[MI][4], char* smem) {
    RPPlain rpb{Bt, (size_t)ldb};
    gemm_core_gb<MI>(rp, rpb, K, acc, smem);
}
template <int MI, class F>
__device__ __forceinline__ void acc_foreach(const f32x4 (&acc)[MI][4], F f) {
    const int lane = tidx() & 63, wave = tidx() >> 6;
    const int wr = wave >> 1, wc = wave & 1, fr = lane & 15, fq = lane >> 4;
#pragma unroll
    for (int i = 0; i < MI; ++i)
#pragma unroll
        for (int j = 0; j < 4; ++j) f(wr * MI * 16 + i * 16 + fr, wc * 64 + j * 16 + fq * 4, acc[i][j]);
}
struct ALPlain {
    const bf16_t* p0; size_t step;
    __device__ __forceinline__ ALPlain(const bf16_t* A, int lda, int row0) { p0 = A + (size_t)(row0 + (tidx() >> 3)) * lda; step = (size_t)32 * lda; }
    __device__ __forceinline__ uint4 load(int i, int k) const { return *(const uint4*)(p0 + i * step + k); }
};
__device__ __forceinline__ void store_bf16x4(bf16_t* dst, const f32x4& v) { *(uint2*)dst = make_uint2(pack2(v[0], v[1]), pack2(v[2], v[3])); }

__device__ __forceinline__ void ph_pre(const Params& p, char* smem) {
    const int tid = tidx(), nb = gridDim.x, bid = blockIdx.x;
    float* mod = (float*)(p.ws + O_MOD);
    {
        float* sv = (float*)smem;
        float* part = sv + 5 * 1024;
        for (int i = tid; i < 5 * 1024; i += 256) { const float v = (i < 4096) ? p.in[I_C][i] : p.in[I_CCTX][i - 4096]; sv[i] = siluf_(v); }
        __syncthreads();
        for (int it = bid; it < NLAYER * 96; it += nb) {
            const int l = it / 96, jb = it % 96;
            const int jj = tid & 63, kq = tid >> 6, j = jb * 64 + jj;
            const float* w = p.in[I_WADA] + (size_t)l * 1024 * 6144 + (size_t)(kq * 256) * 6144 + j;
            float a0 = 0.f, a1 = 0.f, a2 = 0.f, a3 = 0.f, a4 = 0.f;
#pragma unroll 8
            for (int k = 0; k < 256; ++k) {
                const float wv = w[(size_t)k * 6144]; const int kk = kq * 256 + k;
                a0 += sv[kk] * wv; a1 += sv[1024 + kk] * wv; a2 += sv[2048 + kk] * wv; a3 += sv[3072 + kk] * wv; a4 += sv[4096 + kk] * wv;
            }
            part[(kq * 5 + 0) * 64 + jj] = a0; part[(kq * 5 + 1) * 64 + jj] = a1; part[(kq * 5 + 2) * 64 + jj] = a2;
            part[(kq * 5 + 3) * 64 + jj] = a3; part[(kq * 5 + 4) * 64 + jj] = a4;
            __syncthreads();
            for (int o = tid; o < 320; o += 256) {
                const int i = o >> 6, c = o & 63;
                const float s = part[(0 * 5 + i) * 64 + c] + part[(1 * 5 + i) * 64 + c] + part[(2 * 5 + i) * 64 + c] + part[(3 * 5 + i) * 64 + c];
                mod[(size_t)(l * 5 + i) * 6144 + jb * 64 + c] = s + p.in[I_BADA][l * 6144 + jb * 64 + c];
            }
            __syncthreads();
        }
    }
    {
        float4* xc = (float4*)(p.ws + O_XCUR);
        const float4* x4 = (const float4*)p.in[I_X]; const float4* c4 = (const float4*)p.in[I_CTX];
        for (size_t i = (size_t)bid * 256 + tid; i < (size_t)RT * 256; i += (size_t)nb * 256) xc[i] = (i < (size_t)RL * 256) ? x4[i] : c4[i - (size_t)RL * 256];
    }
    {
        float* ct = (float*)smem;
        __syncthreads();
        for (int m = tid; m < 4096; m += 256) ct[m] = cospif((float)m * (1.f / 2048.f));
        __syncthreads();
        bf16_t* cst2 = (bf16_t*)(p.ws + O_CST256);
        for (int ch = bid * 256 + tid; ch < 256 * 512 / 8; ch += nb * 256) {
            const int ks = ch >> 6, c0 = (ch & 63) * 8, part = c0 >> 8, s0 = c0 & 255;
            float f[8];
#pragma unroll
            for (int e = 0; e < 8; ++e) { const int m = (16 * ks * (s0 + e)) & 4095; f[e] = part == 0 ? ct[m] : ct[(m - 1024) & 4095]; }
            *(uint4*)(cst2 + ch * 8) = pack8(f);
        }
        bf16_t* d128 = (bf16_t*)(p.ws + O_D128);
        for (int ch = bid * 256 + tid; ch < 128 * 128 / 8; ch += nb * 256) {
            const int mrow = ch >> 4, c0 = (ch & 15) * 8, po = mrow >> 6, k1 = mrow & 63, pi = c0 >> 6, t10 = c0 & 63;
            float f[8];
#pragma unroll
            for (int e = 0; e < 8; ++e) {
                const int m = (64 * k1 * (t10 + e)) & 4095; const float cv = ct[m], sv = ct[(m - 1024) & 4095];
                f[e] = (po == pi) ? cv : (po == 0 ? sv : -sv);
            }
            *(uint4*)(d128 + ch * 8) = pack8(f);
        }
        bf16_t* e64 = (bf16_t*)(p.ws + O_E64);
        for (int ch = bid * 256 + tid; ch < 64 * 128 / 8; ch += nb * 256) {
            const int k2 = ch >> 4, c0 = (ch & 15) * 8, po = c0 >> 6, t20 = c0 & 63;
            float f[8];
#pragma unroll
            for (int e = 0; e < 8; ++e) { const int m = (64 * k2 * (t20 + e)) & 4095; f[e] = po == 0 ? ct[m] : ct[(m - 1024) & 4095]; }
            *(uint4*)(e64 + ch * 8) = pack8(f);
        }
        float* twc = (float*)(p.ws + O_TWC); float* tws = (float*)(p.ws + O_TWS);
        for (int i = bid * 256 + tid; i < 64 * 64; i += nb * 256) {
            const int k1 = i >> 6, t2 = i & 63, m = (k1 * t2) & 4095;
            twc[i] = ct[m]; tws[i] = -ct[(m - 1024) & 4095];
        }
        bf16_t* csc = (bf16_t*)(p.ws + O_CSC);
        for (int ch = bid * 256 + tid; ch < 256 * 128 / 8; ch += nb * 256) {
            const int n = ch >> 4, c0 = (ch & 15) * 8, part = n >> 7, kc = n & 127;
            float f[8];
#pragma unroll
            for (int e = 0; e < 8; ++e) { const int m = (32 * kc * (c0 + e)) & 4095; f[e] = part == 0 ? ct[m] : -ct[(m - 1024) & 4095]; }
            *(uint4*)(csc + ch * 8) = pack8(f);
        }
        float* rc = (float*)(p.ws + O_ROPEC); float* rs = (float*)(p.ws + O_ROPES);
        for (int i = bid * 256 + tid; i < SEQ * 16; i += nb * 256) {
            const int t = i >> 4, ax = (i >> 3) & 1, f = i & 7;
            const float inv = powf(10000.f, -(float)f / 8.f);
            const float pos = (float)(ax == 0 ? (t >> 6) : (t & 63));
            const float ang = pos * inv;
            rc[i] = cosf(ang); rs[i] = sinf(ang);
        }
    }
}

struct ConvTask { const float* src; const float* scale; bf16_t* dst; int K, Nsrc, Ndst, rmul; size_t sbs, dbs; };
__constant__ int c_conv_cum[17] = {0, 1536, 1608, 1672, 1688, 1704, 1720, 1848, 1976, 2104, 2360, 4408, 6456, 8504, 8632, 8760, 8888};
__device__ __forceinline__ ConvTask conv_task(const Params& p, int l, int t) {
    bf16_t* wb = (bf16_t*)(p.ws + O_WB);
    ConvTask c; c.scale = nullptr; c.sbs = 0; c.dbs = 0; c.rmul = 64;
    switch (t) {
    case 0:  c.src = p.in[I_WIN] + (size_t)l * 1024 * 6048; c.K = 1024; c.Nsrc = 6048; c.Ndst = 6144; c.dst = wb + W_IN / 2; break;
    case 1:  c.src = p.in[I_WUQ] + (size_t)l * 384 * 768; c.K = 384; c.Nsrc = 768; c.Ndst = 768; c.dst = wb + W_UQ / 2; c.scale = p.in[I_QNG] + l * 384; break;
    case 2:  c.src = p.in[I_WUKV] + (size_t)l * 256 * 1024; c.K = 256; c.Nsrc = 1024; c.Ndst = 1024; c.dst = wb + W_UKV / 2; c.scale = p.in[I_KVNG] + l * 256; break;
    case 3:  c.src = p.in[I_WUP] + (size_t)l * 2 * 64 * 512; c.K = 64; c.Nsrc = 512; c.Ndst = 512; c.dst = wb + W_WUP / 2; c.sbs = 64 * 512; c.dbs = 512 * 64; break;
    case 4:  c.src = p.in[I_AUP] + (size_t)l * 2 * 64 * 512; c.K = 64; c.Nsrc = 512; c.Ndst = 512; c.dst = wb + W_AUP / 2; c.sbs = 64 * 512; c.dbs = 512 * 64; break;
    case 5:  c.src = p.in[I_GUP] + (size_t)l * 128 * 512; c.K = 128; c.Nsrc = 512; c.Ndst = 512; c.dst = wb + W_GUP / 2; break;
    case 6:  c.src = p.in[I_WPA] + (size_t)l * 512 * 1024; c.K = 512; c.Nsrc = 1024; c.Ndst = 1024; c.dst = wb + W_PA / 2; break;
    case 7:  c.src = p.in[I_WPB] + (size_t)l * 512 * 1024; c.K = 512; c.Nsrc = 1024; c.Ndst = 1024; c.dst = wb + W_PB / 2; break;
    case 8:  c.src = p.in[I_WPC] + (size_t)l * 512 * 1024; c.K = 512; c.Nsrc = 1024; c.Ndst = 1024; c.dst = wb + W_PC / 2; break;
    case 9:  c.src = p.in[I_WOUT] + (size_t)l * 1024 * 1024; c.K = 1024; c.Nsrc = 1024; c.Ndst = 1024; c.dst = wb + W_OUT / 2; break;
    case 10: c.src = p.in[I_EG] + (size_t)l * 16 * 1024 * 512; c.K = 1024; c.Nsrc = 512; c.Ndst = 512; c.dst = wb + W_GU / 2; c.sbs = 1024 * 512; c.dbs = 1024 * 1024; c.rmul = 128; break;
    case 11: c.src = p.in[I_EU] + (size_t)l * 16 * 1024 * 512; c.K = 1024; c.Nsrc = 512; c.Ndst = 512; c.dst = wb + W_GU / 2 + 64 * 1024; c.sbs = 1024 * 512; c.dbs = 1024 * 1024; c.rmul = 128; break;
    case 12: c.src = p.in[I_ED] + (size_t)l * 16 * 512 * 1024; c.K = 512; c.Nsrc = 1024; c.Ndst = 1024; c.dst = wb + W_D / 2; c.sbs = 512 * 1024; c.dbs = 1024 * 512; break;
    case 13: c.src = p.in[I_SG] + (size_t)l * 1024 * 512; c.K = 1024; c.Nsrc = 512; c.Ndst = 512; c.dst = wb + W_GU / 2 + (size_t)16 * 1024 * 1024; c.rmul = 128; break;
    case 14: c.src = p.in[I_SU] + (size_t)l * 1024 * 512; c.K = 1024; c.Nsrc = 512; c.Ndst = 512; c.dst = wb + W_GU / 2 + (size_t)16 * 1024 * 1024 + 64 * 1024; c.rmul = 128; break;
    default: c.src = p.in[I_SD] + (size_t)l * 512 * 1024; c.K = 512; c.Nsrc = 1024; c.Ndst = 1024; c.dst = wb + W_D / 2 + (size_t)16 * 1024 * 512; break;
    }
    return c;
}
__device__ __forceinline__ void ph_w(const Params& p, int l, char* smem) {
    const int tid = tidx();
    float* tl = (float*)smem;
    for (int g = blockIdx.x; g < 8888; g += gridDim.x) {
        int t = 0;
        while (g >= c_conv_cum[t + 1]) ++t;
        const ConvTask c = conv_task(p, l, t);
        int r = g - c_conv_cum[t];
        const int nkt = c.K >> 6, nnt = c.Ndst >> 6;
        const int bi = r / (nkt * nnt); r -= bi * nkt * nnt;
        const int k0 = (r / nnt) * 64, n0 = (r % nnt) * 64;
        const float* src = c.src + bi * c.sbs; bf16_t* dst = c.dst + bi * c.dbs;
#pragma unroll
        for (int i = 0; i < 4; ++i) {
            const int k = (tid >> 4) + 16 * i, n = n0 + (tid & 15) * 4;
            float4 v = make_float4(0.f, 0.f, 0.f, 0.f);
            if (n < c.Nsrc) v = *(const float4*)(src + (size_t)(k0 + k) * c.Nsrc + n);
            if (c.scale) { const float s = c.scale[k0 + k]; v.x *= s; v.y *= s; v.z *= s; v.w *= s; }
            float* d = tl + k * 65 + (tid & 15) * 4;
            d[0] = v.x; d[1] = v.y; d[2] = v.z; d[3] = v.w;
        }
        __syncthreads();
        {
            const int n = tid >> 2, kk0 = (tid & 3) * 16;
            float f[8], g2[8];
#pragma unroll
            for (int j = 0; j < 8; ++j) { f[j] = tl[(kk0 + j) * 65 + n]; g2[j] = tl[(kk0 + 8 + j) * 65 + n]; }
            bf16_t* d = dst + (size_t)((n0 >> 6) * c.rmul + n) * c.K + k0 + kk0;
            *(uint4*)d = pack8(f); *(uint4*)(d + 8) = pack8(g2);
        }
        __syncthreads();
    }
}

__device__ __forceinline__ void ph_n1(const Params& p, int l) {
    const int lane = tidx() & 63, wave = tidx() >> 6;
    const float* xcur = (const float*)(p.ws + O_XCUR); const float* mod = (const float*)(p.ws + O_MOD);
    bf16_t* H = (bf16_t*)(p.ws + O_H);
    const float* g = p.in[I_N1G] + l * 1024;
    for (int row = blockIdx.x * 4 + wave; row < RT; row += gridDim.x * 4) {
        const float* x = xcur + (size_t)row * 1024; const float* md = mod + (size_t)(l * 5 + modidx(row)) * 6144;
        float4 v[4]; float ss = 0.f;
#pragma unroll
        for (int i = 0; i < 4; ++i) { v[i] = *(const float4*)(x + lane * 4 + 256 * i); ss += v[i].x * v[i].x + v[i].y * v[i].y + v[i].z * v[i].z + v[i].w * v[i].w; }
        ss = wsum(ss);
        const float rstd = rsqrtf(ss * (1.f / 1024.f) + 1e-6f);
#pragma unroll
        for (int i = 0; i < 4; ++i) {
            const int c = lane * 4 + 256 * i;
            const float4 gg = *(const float4*)(g + c), sc = *(const float4*)(md + 1024 + c), sh = *(const float4*)(md + c);
            f32x4 h = {v[i].x * rstd * gg.x * (1.f + sc.x) + sh.x, v[i].y * rstd * gg.y * (1.f + sc.y) + sh.y,
                       v[i].z * rstd * gg.z * (1.f + sc.z) + sh.z, v[i].w * rstd * gg.w * (1.f + sc.w) + sh.w};
            store_bf16x4(H + (size_t)row * 1024 + c, h);
        }
    }
}

__device__ __forceinline__ void ph_g1(const Params& p, int l, char* smem) {
    if (blockIdx.x == 0 && tidx() < 64) ((unsigned*)(p.ws + O_CNT))[tidx()] = 0u;
    const bf16_t* H = (const bf16_t*)(p.ws + O_H); const bf16_t* W = (const bf16_t*)(p.ws + O_WB + W_IN);
    bf16_t* P = (bf16_t*)(p.ws + O_P);
    const int q8 = blockIdx.x & 7, nq = gridDim.x >> 3;
    unsigned* wq = (unsigned*)(p.ws + O_BAR) + XCD_BAR_WORDS + (l * 8 + q8) * 16;
    volatile LAS int* wslot = (volatile LAS int*)(smem + LDS_BYTES - 32);
    int it = blockIdx.x;
    while (it < 136 * 48) {
        int nxt = 0;
        if (tidx() == 0) nxt = q8 + 8 * (nq + (int)__hip_atomic_fetch_add(wq, 1u, __ATOMIC_RELAXED, __HIP_MEMORY_SCOPE_AGENT));
        const int mt = it / 48, nt = it % 48;
        f32x4 acc[4][4];
        RPPlain rp{H + (size_t)mt * 128 * 1024, 1024};
        gemm_core_g<4>(rp, W + (size_t)nt * 128 * 1024, 1024, 1024, acc, smem);
        acc_foreach<4>(acc, [&](int m, int n, const f32x4& v) {
            const int col = nt * 128 + n; f32x4 o = v;
            if (col >= PG0 && col < PEND) { o[0] = sigmoidf_(v[0]); o[1] = sigmoidf_(v[1]); o[2] = sigmoidf_(v[2]); o[3] = sigmoidf_(v[3]); }
            store_bf16x4(P + (size_t)(mt * 128 + m) * LDP + col, o);
        });
        if (nt >= 4 && nt <= 8) {
            const int lane = tidx() & 63, wave = tidx() >> 6, wr = wave >> 1, wc = wave & 1, fr = lane & 15, fq = lane >> 4;
            float* SSQ = (float*)(p.ws + O_X + X_SSQ);
#pragma unroll
            for (int i = 0; i < 4; ++i) {
                float sq = 0.f;
#pragma unroll
                for (int j = 0; j < 4; ++j)
#pragma unroll
                    for (int r = 0; r < 4; ++r) sq += acc[i][j][r] * acc[i][j][r];
                sq = xsum_16_32(sq);
                if (fq == 0) SSQ[(size_t)(mt * 128 + wr * 64 + i * 16 + fr) * 10 + (nt - 4) * 2 + wc] = sq;
            }
        }
        if (tidx() == 0) *wslot = nxt;
        __syncthreads();
        it = __builtin_amdgcn_readfirstlane(*wslot);
    }
}

constexpr float QSCALE = 0.10206207261596575f * 1.4426950408889634f;
__device__ __forceinline__ void ph_qu(const Params& p, char* smem) {
    const bf16_t* P = (const bf16_t*)(p.ws + O_P); const float* SSQ = (const float*)(p.ws + O_X + X_SSQ);
    bf16_t* QA = (bf16_t*)(p.ws + O_X + X_QA); bf16_t* KA = (bf16_t*)(p.ws + O_X + X_KA); bf16_t* VA = (bf16_t*)(p.ws + O_X + X_VA);
    const float* rc = (const float*)(p.ws + O_ROPEC); const float* rs = (const float*)(p.ws + O_ROPES);
    for (int it = blockIdx.x; it < 136 * 14; it += gridDim.x) {
        const int mt = it / 14, nn = it % 14;
        const int row0 = mt * 128;
        const bool lat = row0 < RL;
        const int b = lat ? (row0 >> 12) : ((row0 - RL) >> 8), t0 = lat ? (row0 & 4095) : ((row0 - RL) & 255);
        const size_t key0 = lat ? t0 : SEQ + t0;
        const int lane = tidx() & 63, wave = tidx() >> 6, wr = wave >> 1, wc = wave & 1, fr = lane & 15, fq = lane >> 4;
        f32x4 acc[4][4];
        if (nn < 6) {
            RPPlain rp{P + (size_t)row0 * LDP + PQ0, LDP};
            gemm_core_g<4>(rp, (const bf16_t*)(p.ws + O_WB + W_UQ) + (size_t)nn * 128 * 384, 384, 384, acc, smem);
#pragma unroll
            for (int i = 0; i < 4; ++i) {
                const int m = wr * 64 + i * 16 + fr, row = row0 + m, t = t0 + m;
                const float* sp = SSQ + (size_t)row * 10;
                const float rq = rsqrtf((sp[0] + sp[1] + sp[2] + sp[3] + sp[4] + sp[5]) * (1.f / 384.f) + 1e-6f);
#pragma unroll
                for (int j = 0; j < 4; ++j) {
                    const int n0 = nn * 128 + wc * 64 + j * 16, hg = (n0 >> 4) % 6;
                    f32x4 o = acc[i][j] * rq;
                    if (hg >= 4 && lat) {
                        const int ax = hg - 4, half = fq >> 1;
                        const float4 c4 = *(const float4*)(rc + t * 16 + ax * 8 + (fq & 1) * 4), s4 = *(const float4*)(rs + t * 16 + ax * 8 + (fq & 1) * 4);
                        const float cc[4] = {c4.x, c4.y, c4.z, c4.w}, ss[4] = {s4.x, s4.y, s4.z, s4.w};
#pragma unroll
                        for (int r = 0; r < 4; ++r) {
                            const float xp = lane_xor32(o[r], lane);
                            o[r] = half ? (o[r] * cc[r] + xp * ss[r]) : (o[r] * cc[r] - xp * ss[r]);
                        }
                    }
                    o *= QSCALE;
                    store_bf16x4(QA + (size_t)row * 768 + n0 + fq * 4, o);
                }
            }
        } else {
            const int h = nn - 6;
            RPPlain rp{P + (size_t)row0 * LDP + PKV0, LDP};
            gemm_core_g<4>(rp, (const bf16_t*)(p.ws + O_WB + W_UKV) + (size_t)h * 128 * 256, 256, 256, acc, smem);
            bf16_t* vt = (bf16_t*)smem;
#pragma unroll
            for (int i = 0; i < 4; ++i) {
                const int m = wr * 64 + i * 16 + fr, row = row0 + m;
                const float* sp = SSQ + (size_t)row * 10;
                const float rkv = rsqrtf((sp[6] + sp[7] + sp[8] + sp[9]) * (1.f / 256.f) + 1e-6f);
#pragma unroll
                for (int j = 0; j < 4; ++j) {
                    const f32x4 o = acc[i][j] * rkv;
                    if (wc == 0) store_bf16x4(KA + ((size_t)b * KEYS + key0 + m) * 768 + h * 96 + j * 16 + fq * 4, o);
                    else store_bf16x4(vt + m * 72 + j * 16 + fq * 4, o);
                }
            }
            __syncthreads();
#pragma unroll
            for (int u = 0; u < 4; ++u) {
                const int q = tidx() + 256 * u, dd = q >> 4, kc = q & 15;
                float f[8];
#pragma unroll
                for (int e = 0; e < 8; ++e) f[e] = bf2f(vt[(kc * 8 + e) * 72 + dd]);
                const uint4 uu = pack8(f);
                bf16_t* dst = VA + ((size_t)(b * 8 + h) * 64 + dd) * KEYS + key0 + (kc >> 2) * 32 + (kc & 1) * 16 + ((kc & 3) >> 1) * 4;
                *(uint2*)dst = make_uint2(uu.x, uu.y); *(uint2*)(dst + 8) = make_uint2(uu.z, uu.w);
            }
            __syncthreads();
        }
    }
}
__device__ __forceinline__ void ph_krope(const Params& p) {
    const int lane = tidx() & 63, wave = tidx() >> 6;
    const bf16_t* P = (const bf16_t*)(p.ws + O_P); bf16_t* KA = (bf16_t*)(p.ws + O_X + X_KA);
    const float* rc = (const float*)(p.ws + O_ROPEC); const float* rs = (const float*)(p.ws + O_ROPES);
    for (int row = blockIdx.x * 4 + wave; row < RT; row += gridDim.x * 4) {
        const bool lat = row < RL;
        const int b = lat ? (row >> 12) : ((row - RL) >> 8), t = lat ? (row & 4095) : ((row - RL) & 255);
        const size_t keyrow = (size_t)b * KEYS + (lat ? t : SEQ + t);
        const int ii = lane & 31, hh = lane >> 5;
        const bf16_t* pr = P + (size_t)row * LDP + PKR0;
        float x = bf2f(pr[ii]);
        if (lat) {
            const float xp = bf2f(pr[ii ^ 8]);
            const int ax = ii >> 4, half = (ii >> 3) & 1, f = ii & 7;
            const float c = rc[t * 16 + ax * 8 + f], sn = rs[t * 16 + ax * 8 + f];
            x = half ? (x * c + xp * sn) : (x * c - xp * sn);
        }
        const bf16_t xb = f2bf(x);
#pragma unroll
        for (int q = 0; q < 4; ++q) KA[keyrow * 768 + (hh * 4 + q) * 96 + 64 + ii] = xb;
    }
}

constexpr int KS_LD = 104, VT_LD = 72;
constexpr int AT_BUF = 64 * KS_LD * 2 + 64 * VT_LD * 2;
__device__ __forceinline__ void ph_at(const Params& p, int l, char* smem) {
    const int tid = tidx(), lane = tid & 63, wave = tid >> 6, fr = lane & 15, fq = lane >> 4;
    const bf16_t* QA = (const bf16_t*)(p.ws + O_X + X_QA); const bf16_t* KA = (const bf16_t*)(p.ws + O_X + X_KA); const bf16_t* VA = (const bf16_t*)(p.ws + O_X + X_VA);
    bf16_t* ATT = (bf16_t*)(p.ws + O_ATT);
    const int nitems = 1024 + (l < NLAYER - 1 ? 64 : 0);
    for (int it0 = blockIdx.x; it0 < nitems; it0 += gridDim.x) {
        int it = it0;
        if (gridDim.x == 512 && it0 < 1024) {
            const int x = it0 & 7, j = (it0 >> 3) & 63, rd = it0 >> 9;
            it = ((x * 4 + rd * 2 + (j >> 5)) << 5) | (j & 31);
        }
        int b, h, row0, ntile; size_t krow0;
        if (it < 1024) { b = it >> 8; h = (it >> 5) & 7; row0 = b * SEQ + (it & 31) * 128; krow0 = (size_t)b * KEYS; ntile = KEYS / 64; }
        else { const int j = it - 1024; b = j >> 4; h = (j >> 1) & 7; row0 = RL + b * CTX + (j & 1) * 128; krow0 = (size_t)b * KEYS + SEQ; ntile = CTX / 64; }
        const int qrow = row0 + wave * 32 + fr;
        const size_t vrow0 = (size_t)(b * 8 + h) * 64; const int koff0 = (int)(krow0 - (size_t)b * KEYS);
        bf16x8 qf[2][3];
#pragma unroll
        for (int t = 0; t < 2; ++t)
#pragma unroll
            for (int ks = 0; ks < 3; ++ks) qf[t][ks] = *(const bf16x8*)(QA + (size_t)(qrow + 16 * t) * 768 + h * 96 + ks * 32 + fq * 8);
        f32x4 ot[2][4];
#pragma unroll
        for (int t = 0; t < 2; ++t)
#pragma unroll
            for (int i = 0; i < 4; ++i) ot[t][i] = (f32x4){0.f, 0.f, 0.f, 0.f};
        float m_run[2] = {0.f, 0.f};
        f32x4 negm[2] = {(f32x4){0.f, 0.f, 0.f, 0.f}, (f32x4){0.f, 0.f, 0.f, 0.f}}, ol[2] = {(f32x4){0.f, 0.f, 0.f, 0.f}, (f32x4){0.f, 0.f, 0.f, 0.f}};
        const bf16x8 ones = __builtin_bit_cast(bf16x8, (u32x4){0x3f803f80u, 0x3f803f80u, 0x3f803f80u, 0x3f803f80u});
        uint4 rk0, rk1, rk2, rv0, rv1;
#define AT_GLOAD(KT) do { const size_t kr_ = krow0 + (size_t)(KT) * 64; \
            { const int c = tid, key = c / 12, part = c % 12; rk0 = *(const uint4*)(KA + (kr_ + key) * 768 + h * 96 + part * 8); } \
            { const int c = tid + 256, key = c / 12, part = c % 12; rk1 = *(const uint4*)(KA + (kr_ + key) * 768 + h * 96 + part * 8); } \
            { const int c = tid + 512, key = c / 12, part = c % 12; rk2 = *(const uint4*)(KA + (kr_ + key) * 768 + h * 96 + part * 8); } \
            { const int c = tid, dd_ = c >> 3, part = c & 7; rv0 = *(const uint4*)(VA + (vrow0 + dd_) * KEYS + koff0 + (KT) * 64 + part * 8); } \
            { const int c = tid + 256, dd_ = c >> 3, part = c & 7; rv1 = *(const uint4*)(VA + (vrow0 + dd_) * KEYS + koff0 + (KT) * 64 + part * 8); } } while (0)
#define AT_VSTORE(RV, C) do { const int dd_ = (C) >> 3, part = (C) & 7; *(uint4*)(Vt_ + dd_ * VT_LD + part * 8) = RV; } while (0)
#define AT_SSTORE(BUF) do { bf16_t* Ks_ = (bf16_t*)(smem + (BUF) * AT_BUF); bf16_t* Vt_ = Ks_ + 64 * KS_LD; \
            { const int c = tid, key = c / 12, part = c % 12; *(uint4*)(Ks_ + key * KS_LD + part * 8) = rk0; } \
            { const int c = tid + 256, key = c / 12, part = c % 12; *(uint4*)(Ks_ + key * KS_LD + part * 8) = rk1; } \
            { const int c = tid + 512, key = c / 12, part = c % 12; *(uint4*)(Ks_ + key * KS_LD + part * 8) = rk2; } \
            AT_VSTORE(rv0, tid); AT_VSTORE(rv1, tid + 256); } while (0)
        AT_GLOAD(0); AT_SSTORE(0);
        __syncthreads();
        for (int kt = 0; kt < ntile; ++kt) {
            const int cur = kt & 1;
            if (kt + 1 < ntile) AT_GLOAD(kt + 1);
            __builtin_amdgcn_sched_barrier(0);
            const bf16_t* Ks = (const bf16_t*)(smem + cur * AT_BUF); const bf16_t* Vt = Ks + 64 * KS_LD;
            f32x4 st[2][4];
#pragma unroll
            for (int jh = 0; jh < 2; ++jh) {
                bf16x8 kf[2][3];
#pragma unroll
                for (int jj = 0; jj < 2; ++jj)
#pragma unroll
                    for (int ks = 0; ks < 3; ++ks) kf[jj][ks] = *(const bf16x8*)(Ks + ((jh * 2 + jj) * 16 + fr) * KS_LD + ks * 32 + fq * 8);
#pragma unroll
                for (int jj = 0; jj < 2; ++jj) {
                    const int j = jh * 2 + jj;
                    st[0][j] = negm[0]; st[1][j] = negm[1];
#pragma unroll
                    for (int ks = 0; ks < 3; ++ks) {
                        st[0][j] = __builtin_amdgcn_mfma_f32_16x16x32_bf16(kf[jj][ks], qf[0][ks], st[0][j], 0, 0, 0);
                        st[1][j] = __builtin_amdgcn_mfma_f32_16x16x32_bf16(kf[jj][ks], qf[1][ks], st[1][j], 0, 0, 0);
                    }
                }
            }
            bf16x8 vf[2][4];
#pragma unroll
            for (int k2 = 0; k2 < 2; ++k2)
#pragma unroll
                for (int dt = 0; dt < 4; ++dt) {
                    vf[k2][dt] = *(const bf16x8*)(Vt + (dt * 16 + fr) * VT_LD + k2 * 32 + fq * 8);
                }
            uint4 pu[2][2];
#pragma unroll
            for (int t = 0; t < 2; ++t) {
                float mx = st[t][0][0];
#pragma unroll
                for (int j = 0; j < 4; ++j)
#pragma unroll
                    for (int r = 0; r < 4; ++r) mx = fmaxf(mx, st[t][j][r]);
                if (kt == 0 || __any(mx > 6.f)) {
                    mx = xmax_16_32(mx);
                    const float delta = kt == 0 ? mx : fmaxf(mx, 0.f);
                    const float alpha = kt == 0 ? 0.f : __builtin_amdgcn_exp2f(-delta);
                    m_run[t] += delta;
                    negm[t] = (f32x4){-m_run[t], -m_run[t], -m_run[t], -m_run[t]};
                    ol[t] *= alpha;
#pragma unroll
                    for (int i = 0; i < 4; ++i) ot[t][i] *= alpha;
#pragma unroll
                    for (int j = 0; j < 4; ++j)
#pragma unroll
                        for (int r = 0; r < 4; ++r) st[t][j][r] -= delta;
                }
#pragma unroll
                for (int j = 0; j < 4; ++j)
#pragma unroll
                    for (int r = 0; r < 4; ++r) st[t][j][r] = __builtin_amdgcn_exp2f(st[t][j][r]);
#pragma unroll
                for (int k2 = 0; k2 < 2; ++k2)
                    pu[t][k2] = make_uint4(pack2(st[t][2 * k2][0], st[t][2 * k2][1]), pack2(st[t][2 * k2][2], st[t][2 * k2][3]),
                                           pack2(st[t][2 * k2 + 1][0], st[t][2 * k2 + 1][1]), pack2(st[t][2 * k2 + 1][2], st[t][2 * k2 + 1][3]));
            }
#pragma unroll
            for (int k2 = 0; k2 < 2; ++k2) {
                const bf16x8 pb0 = __builtin_bit_cast(bf16x8, pu[0][k2]), pb1 = __builtin_bit_cast(bf16x8, pu[1][k2]);
                ol[0] = __builtin_amdgcn_mfma_f32_16x16x32_bf16(ones, pb0, ol[0], 0, 0, 0);
                ol[1] = __builtin_amdgcn_mfma_f32_16x16x32_bf16(ones, pb1, ol[1], 0, 0, 0);
#pragma unroll
                for (int dt = 0; dt < 4; ++dt) {
                    ot[0][dt] = __builtin_amdgcn_mfma_f32_16x16x32_bf16(vf[k2][dt], pb0, ot[0][dt], 0, 0, 0);
                    ot[1][dt] = __builtin_amdgcn_mfma_f32_16x16x32_bf16(vf[k2][dt], pb1, ot[1][dt], 0, 0, 0);
                }
            }
            if (kt + 1 < ntile) AT_SSTORE(cur ^ 1);
            __syncthreads();
        }
#pragma unroll
        for (int t = 0; t < 2; ++t) {
            const float inv = 1.f / ol[t][0];
#pragma unroll
            for (int dt = 0; dt < 4; ++dt) { f32x4 o = ot[t][dt] * inv; store_bf16x4(ATT + (size_t)(qrow + 16 * t) * 512 + h * 64 + dt * 16 + fq * 4, o); }
        }
    }
}

__device__ __forceinline__ void row_edges(int row, bool& first, bool& last) {
    if (row < RL) { const int t = row & 4095; first = t == 0; last = t == 4095; }
    else { const int s = (row - RL) & 255; first = s == 0; last = s == 255; }
}
__device__ __forceinline__ float xs1(const bf16_t* P, const float* mu, int row, int col) {
    bool first, last; row_edges(row, first, last);
    const bf16_t* pc = P + (size_t)row * LDP + PR0 + col;
    const float c = bf2f(*pc), pv0 = bf2f(*(first ? pc : pc - LDP)), nx0 = bf2f(*(last ? pc : pc + LDP));
    const float pv = first ? 0.f : pv0, nx = last ? 0.f : nx0;
    return c + (0.5f * (pv + nx) - c) * mu[col];
}
__device__ __forceinline__ void xs8(const bf16_t* P, const float* mu, int row, int col, float (&o)[8]) {
    bool first, last; row_edges(row, first, last);
    const bf16_t* pc = P + (size_t)row * LDP + PR0 + col;
    const uint4 uc = *(const uint4*)pc, up = *(const uint4*)(first ? pc : pc - LDP), un = *(const uint4*)(last ? pc : pc + LDP);
    float c[8], pv[8], nx[8]; unpack8(uc, c); unpack8(up, pv); unpack8(un, nx);
    const float fp = first ? 0.f : 0.5f, fn = last ? 0.f : 0.5f;
    const float4 m0 = *(const float4*)(mu + col), m1 = *(const float4*)(mu + col + 4);
    const float m[8] = {m0.x, m0.y, m0.z, m0.w, m1.x, m1.y, m1.z, m1.w};
#pragma unroll
    for (int j = 0; j < 8; ++j) o[j] = c[j] + ((fp * pv[j] + fn * nx[j]) - c[j]) * m[j];
}
struct ALRw {
    const bf16_t* P; const float* mu; int row0; int colbase, mode;
    __device__ __forceinline__ ALRw(const bf16_t* P_, const float* mu_, int row0_, int colbase_, int mode_) : P(P_), mu(mu_), colbase(colbase_), mode(mode_) {
        row0 = row0_ + (tidx() >> 3);
    }
    __device__ __forceinline__ uint4 load(int i, int k) const {
        float o[8]; xs8(P, mu, row0 + 32 * i, colbase + k, o);
        if (mode == 0) {
#pragma unroll
            for (int j = 0; j < 8; ++j) o[j] = tanhf(o[j]);
        } else if (mode == 2) {
#pragma unroll
            for (int j = 0; j < 8; ++j) o[j] = sigmoidf_(o[j]);
        }
        return pack8(o);
    }
};
__device__ __forceinline__ void ph_rp1(const Params& p, int l, char* smem) {
    const bf16_t* P = (const bf16_t*)(p.ws + O_P); const float* mu = p.in[I_MU] + l * 1792;
    bf16_t* RG = (bf16_t*)(p.ws + O_RG);
    for (int it = gridDim.x - 1 - blockIdx.x; it < 1088; it += gridDim.x) {
        const int mt = it >> 2, nt = it & 3;
        f32x4 acc[2][4];
        ALRw al(P, mu, mt * 64, 1664, 2);
        gemm_core<2>(al, (const bf16_t*)(p.ws + O_WB + W_GUP) + (size_t)nt * 128 * 128, 128, 128, acc, smem);
        acc_foreach<2>(acc, [&](int m, int n, const f32x4& v) { store_bf16x4(RG + (size_t)(mt * 64 + m) * 512 + nt * 128 + n, v); });
    }
}
__device__ __forceinline__ void ph_rp2(const Params& p, int l) {
    const int lane = tidx() & 63, wave = tidx() >> 6;
    const bf16_t* P = (const bf16_t*)(p.ws + O_P); const float* mu = p.in[I_MU] + l * 1792; const float* kkw = p.in[I_KK] + l * 512;
    float* KKN = (float*)(p.ws + O_X + X_KKN); bf16_t* X12 = (bf16_t*)(p.ws + O_X + X_X12);
    for (int row = blockIdx.x * 4 + wave; row < RT; row += gridDim.x * 4) {
        float k8[8]; xs8(P, mu, row, 512 + lane * 8, k8);
        float x8[8]; xs8(P, mu, row, 1536 + (lane & 15) * 8, x8);
        float s = 0.f;
#pragma unroll
        for (int j = 0; j < 8; ++j) { const float v = k8[j] * kkw[lane * 8 + j]; s += v * v; }
        s += __shfl_xor(s, 1); s += __shfl_xor(s, 2); s += __shfl_xor(s, 4);
        if ((lane & 7) == 0) KKN[(size_t)row * 8 + (lane >> 3)] = rsqrtf(s + 1e-12f);
        if (lane < 8) {
#pragma unroll
            for (int j = 0; j < 8; ++j) x8[j] = 1.f - 2.f * __builtin_amdgcn_rcpf(1.f + __expf(2.f * x8[j]));
        }
        if (lane < 16) *(uint4*)(X12 + (size_t)row * 128 + lane * 8) = pack8(x8);
    }
}

__device__ __forceinline__ int scan_row(int b, int d, int n) {
    if (n < CTX) return RL + b * CTX + (d == 0 ? n : CTX - 1 - n);
    const int t = n - CTX; return b * SEQ + (d == 0 ? t : SEQ - 1 - t);
}
constexpr int SL = 72;
constexpr int SLOT_E = 64 * SL;
template <int LDA, int LDB>
__device__ __forceinline__ void mm64(const bf16_t* A, const bf16_t* B, f32x4 (&acc)[4], int wave, int fr, int fq) {
#pragma unroll
    for (int ks = 0; ks < 2; ++ks) {
        const bf16x8 af = *(const bf16x8*)(A + (wave * 16 + fr) * LDA + ks * 32 + fq * 8);
#pragma unroll
        for (int nt = 0; nt < 4; ++nt) {
            const bf16x8 bfv = *(const bf16x8*)(B + (nt * 16 + fr) * LDB + ks * 32 + fq * 8);
            acc[nt] = __builtin_amdgcn_mfma_f32_16x16x32_bf16(bfv, af, acc[nt], 0, 0, 0);
        }
    }
}
__device__ __forceinline__ void acc_zero(f32x4 (&acc)[4]) {
#pragma unroll
    for (int nt = 0; nt < 4; ++nt) acc[nt] = (f32x4){0.f, 0.f, 0.f, 0.f};
}
template <bool STRICT>
__device__ __forceinline__ void acc_mask(f32x4 (&acc)[4], int m, int fq) {
    const int w = __builtin_amdgcn_readfirstlane(m >> 4);
#pragma unroll
    for (int nt = 0; nt < 4; ++nt) {
        if (nt < w) acc[nt] = (f32x4){0.f, 0.f, 0.f, 0.f};
        else if (nt == w) {
#pragma unroll
            for (int r = 0; r < 4; ++r) { const int n = nt * 16 + fq * 4 + r; const bool keep = STRICT ? (m < n) : (m <= n); if (!keep) acc[nt][r] = 0.f; }
        }
    }
}
__device__ __forceinline__ void acc_mask_lo(f32x4 (&acc)[4], int m, int fq) {
    const int w = __builtin_amdgcn_readfirstlane(m >> 4);
#pragma unroll
    for (int nt = 0; nt < 4; ++nt) {
        if (nt > w) acc[nt] = (f32x4){0.f, 0.f, 0.f, 0.f};
        else if (nt == w) {
#pragma unroll
            for (int r = 0; r < 4; ++r) { const int n = nt * 16 + fq * 4 + r; if (n > m) acc[nt][r] = 0.f; }
        }
    }
}
__device__ __forceinline__ void st_rm(bf16_t* dst, const f32x4 (&acc)[4], int m, int fq) {
#pragma unroll
    for (int nt = 0; nt < 4; ++nt) store_bf16x4(dst + m * SL + nt * 16 + fq * 4, acc[nt]);
}
__device__ __forceinline__ void st_tr(bf16_t* dst, const f32x4 (&acc)[4], int m, int fq) {
#pragma unroll
    for (int nt = 0; nt < 4; ++nt) {
        const unsigned u0 = pack2(acc[nt][0], acc[nt][1]), u1 = pack2(acc[nt][2], acc[nt][3]);
        bf16_t* d = dst + (nt * 16 + fq * 4) * SL + m;
        d[0] = (bf16_t)(u0 & 0xffffu); d[SL] = (bf16_t)(u0 >> 16); d[2 * SL] = (bf16_t)(u1 & 0xffffu); d[3 * SL] = (bf16_t)(u1 >> 16);
    }
}
__device__ __forceinline__ void tr_copy16(bf16_t* dst, const bf16_t* src, int bi, int bq) {
    const uint4 a = *(const uint4*)(src + bi * SL + bq), b = *(const uint4*)(src + bi * SL + bq + 8);
    const unsigned w[8] = {a.x, a.y, a.z, a.w, b.x, b.y, b.z, b.w};
#pragma unroll
    for (int q = 0; q < 8; ++q) { dst[(bq + 2 * q) * SL + bi] = (bf16_t)(w[q] & 0xffffu); dst[(bq + 2 * q + 1) * SL + bi] = (bf16_t)(w[q] >> 16); }
}
__device__ __forceinline__ void ph_r1(const Params& p, int l, char* smem) {
    const int tid0 = tidx();
#define R1_IDX const int tid = lv(tid0), lane = tid & 63, wave = tid >> 6, fr = lane & 15, fq = lane >> 4, bi = tid >> 2, bq = (tid & 3) * 16, m = wave * 16 + fr; (void)bi; (void)bq; (void)m; (void)fq;
    const bf16_t* P = (const bf16_t*)(p.ws + O_P); const float* mu = p.in[I_MU] + l * 1792;
    const float* kkw = p.in[I_KK] + l * 512; const float* kaw = p.in[I_KA] + l * 512; const float* rkw = p.in[I_RK] + l * 512;
    const float* KKN = (const float*)(p.ws + O_X + X_KKN); float* BON = (float*)(p.ws + O_X + X_BON); const bf16_t* X12 = (const bf16_t*)(p.ws + O_X + X_X12);
    bf16_t* gMT = (bf16_t*)(p.ws + O_X + X_MT); bf16_t* gNL = (bf16_t*)(p.ws + O_H);
    bf16_t* gGT = (bf16_t*)(p.ws + O_X + X_GT); bf16_t* gYL = (bf16_t*)(p.ws + O_X + X_YL);
    bf16_t* slot = (bf16_t*)smem;
    bf16_t* s0 = slot, *s1 = slot + SLOT_E, *s2 = slot + 2 * SLOT_E, *s3 = slot + 3 * SLOT_E;
    bf16_t* sa = slot + 4 * SLOT_E, *sb = slot + 5 * SLOT_E, *sc = slot + 6 * SLOT_E, *sT = slot + 7 * SLOT_E;
    float* misc = (float*)(smem + 8 * SLOT_E * 2);
    float* GAM = misc; float* SEG = misc + 64;
    float* ASIG = (float*)s0;
    float* LWS = (float*)s2;
    for (int it = blockIdx.x; it < NCP; it += gridDim.x) {
        const int c = it % 68, d = (it / 68) & 1, h = (it / 136) & 7, b = it / 1088;
        float rr[16], kq[16], kkn;
        {
            R1_IDX const int rowb = scan_row(b, d, c * 64 + bi); (void)rowb;
            {
                const uint4* xr = (const uint4*)(X12 + (size_t)rowb * 128 + bq);
                const uint4 x0 = xr[0], x1 = xr[1], x2 = xr[8], x3 = xr[9];
                *(uint4*)(sa + bi * SL + bq) = x0; *(uint4*)(sa + bi * SL + bq + 8) = x1;
                *(uint4*)(sb + bi * SL + bq) = x2; *(uint4*)(sb + bi * SL + bq + 8) = x3;
            }
#pragma unroll
            for (int hh = 0; hh < 2; ++hh) {
                float t8[8];
                xs8(P, mu, rowb, h * 64 + bq + hh * 8, t8);
#pragma unroll
                for (int j = 0; j < 8; ++j) rr[hh * 8 + j] = t8[j];
                xs8(P, mu, rowb, 512 + h * 64 + bq + hh * 8, t8);
#pragma unroll
                for (int j = 0; j < 8; ++j) kq[hh * 8 + j] = t8[j];
            }
            kkn = KKN[(size_t)rowb * 8 + h];
        }
        __syncthreads();
        {
            R1_IDX const int rowb = scan_row(b, d, c * 64 + bi); (void)rowb;
            f32x4 acc[4];
            acc_zero(acc);
            mm64<SL, 64>(sa, (const bf16_t*)(p.ws + O_WB + W_WUP) + ((size_t)d * 512 + h * 64) * 64, acc, wave, fr, fq);
            const float* w0 = p.in[I_W0] + (l * 2 + d) * 512 + h * 64;
#pragma unroll
            for (int nt = 0; nt < 4; ++nt) {
                const int n = nt * 16 + fq * 4; float4 o; float* op = (float*)&o;
#pragma unroll
                for (int r = 0; r < 4; ++r) { const float z = w0[n + r] + acc[nt][r]; op[r] = -0.6065306597126334f * __builtin_amdgcn_rcpf(1.f + __expf(-z)); }
                *(float4*)(LWS + m * 68 + n) = o;
            }
            acc_zero(acc);
            mm64<SL, 64>(sb, (const bf16_t*)(p.ws + O_WB + W_AUP) + ((size_t)d * 512 + h * 64) * 64, acc, wave, fr, fq);
            const float* a0 = p.in[I_A0] + (l * 2 + d) * 512 + h * 64;
#pragma unroll
            for (int nt = 0; nt < 4; ++nt) {
                const int n = nt * 16 + fq * 4;
                *(float4*)(ASIG + m * 68 + n) = make_float4(__builtin_amdgcn_rcpf(1.f + __expf(-(a0[n] + acc[nt][0]))), __builtin_amdgcn_rcpf(1.f + __expf(-(a0[n + 1] + acc[nt][1]))), __builtin_amdgcn_rcpf(1.f + __expf(-(a0[n + 2] + acc[nt][2]))), __builtin_amdgcn_rcpf(1.f + __expf(-(a0[n + 3] + acc[nt][3]))));
            }
        }
        __syncthreads();
        {
            R1_IDX const int rowb = scan_row(b, d, c * 64 + bi); (void)rowb;
            const int k = tid & 63, seg = tid >> 6;
            float run = 0.f;
#pragma unroll
            for (int ii = 0; ii < 16; ++ii) { run += LWS[(seg * 16 + ii) * 68 + k]; LWS[(seg * 16 + ii) * 68 + k] = run; }
            SEG[seg * 64 + k] = run;
            __syncthreads();
            float off = 0.f;
#pragma unroll
            for (int sgi = 0; sgi < 3; ++sgi) if (sgi < seg) off += SEG[sgi * 64 + k];
#pragma unroll
            for (int ii = 0; ii < 16; ++ii) LWS[(seg * 16 + ii) * 68 + k] += off;
        }
        __syncthreads();
        {
            R1_IDX const int rowb = scan_row(b, d, c * 64 + bi); (void)rowb;
            float cs[16], cm[16], cc[16], ag[16];
#pragma unroll
            for (int q = 0; q < 4; ++q) {
                const float4 v0 = *(const float4*)(LWS + bi * 68 + bq + q * 4);
                const float4 v1 = bi > 0 ? *(const float4*)(LWS + (bi - 1) * 68 + bq + q * 4) : make_float4(0.f, 0.f, 0.f, 0.f);
                const float4 v2 = *(const float4*)(LWS + 63 * 68 + bq + q * 4);
                const float4 v3 = *(const float4*)(ASIG + bi * 68 + bq + q * 4);
                cs[q * 4] = v0.x; cs[q * 4 + 1] = v0.y; cs[q * 4 + 2] = v0.z; cs[q * 4 + 3] = v0.w;
                cm[q * 4] = v1.x; cm[q * 4 + 1] = v1.y; cm[q * 4 + 2] = v1.z; cm[q * 4 + 3] = v1.w;
                cc[q * 4] = v2.x; cc[q * 4 + 1] = v2.y; cc[q * 4 + 2] = v2.z; cc[q * 4 + 3] = v2.w;
                ag[q * 4] = v3.x; ag[q * 4 + 1] = v3.y; ag[q * 4 + 2] = v3.z; ag[q * 4 + 3] = v3.w;
            }
            __syncthreads();
            float bon = 0.f;
#pragma unroll
            for (int hh = 0; hh < 2; ++hh) {
                float oa[8], ob[8], ok[8], orr[8];
                const int col = h * 64 + bq + hh * 8;
#pragma unroll
                for (int j = 0; j < 8; ++j) {
                    const int e = hh * 8 + j;
                    const float kk = kq[e] * kkw[col + j] * kkn;
                    const float kd = kq[e] * (1.f + (ag[e] - 1.f) * kaw[col + j]);
                    const float eneg = __expf(-cs[e]);
                    oa[j] = -kk * __expf(cm[e]); ob[j] = kk * ag[e] * eneg; ok[j] = kd * eneg; orr[j] = rr[e] * __builtin_amdgcn_rcpf(eneg);
                    bon += rr[e] * kd * rkw[col + j];
                }
                *(uint4*)(s0 + bi * SL + bq + hh * 8) = pack8(oa); *(uint4*)(s1 + bi * SL + bq + hh * 8) = pack8(ob);
                *(uint4*)(s2 + bi * SL + bq + hh * 8) = pack8(ok); *(uint4*)(s3 + bi * SL + bq + hh * 8) = pack8(orr);
            }
            bon += __shfl_xor(bon, 1); bon += __shfl_xor(bon, 2);
            if ((tid & 3) == 0) BON[((size_t)d * RT + rowb) * 8 + h] = bon;
            if (bi == 0) {
#pragma unroll
                for (int e = 0; e < 16; ++e) GAM[bq + e] = __expf(cc[e]);
            }
        }
        __syncthreads();
        unsigned vp[8];
        {
            R1_IDX const int rowb = scan_row(b, d, c * 64 + bi); (void)rowb;
#pragma unroll
            for (int hh = 0; hh < 2; ++hh) {
                float v8[8]; xs8(P, mu, rowb, 1024 + h * 64 + bq + hh * 8, v8);
#pragma unroll
                for (int q = 0; q < 4; ++q) vp[hh * 4 + q] = pack2(v8[2 * q], v8[2 * q + 1]);
            }
            f32x4 acc[4]; acc_zero(acc);
            mm64<SL, SL>(s1, s0, acc, wave, fr, fq);
            acc_mask<true>(acc, m, fq);
            st_rm(sa, acc, m, fq); st_tr(sb, acc, m, fq);
#pragma unroll
            for (int nt = 0; nt < 4; ++nt)
#pragma unroll
                for (int r = 0; r < 4; ++r) if (nt * 16 + fq * 4 + r == m) acc[nt][r] += 1.f;
            st_rm(sc, acc, m, fq);
        }
        __syncthreads();
#pragma unroll
        for (int itr = 0; itr < 5; ++itr) {
            R1_IDX
            bf16_t* ptr = (itr & 1) ? sT : sb;
            bf16_t* ptw = (itr & 1) ? sb : sT;
            f32x4 acc[4]; acc_zero(acc);
            mm64<SL, SL>(sa, ptr, acc, wave, fr, fq);
            st_rm(sa, acc, m, fq); st_tr(ptw, acc, m, fq);
            __syncthreads();
            f32x4 tacc[4];
#pragma unroll
            for (int nt = 0; nt < 4; ++nt) { const uint2 u = *(const uint2*)(sc + m * SL + nt * 16 + fq * 4); tacc[nt] = (f32x4){bflo(u.x), bfhi(u.x), bflo(u.y), bfhi(u.y)}; }
            mm64<SL, SL>(sc, ptw, tacc, wave, fr, fq);
            if (itr < 4) st_rm(sc, tacc, m, fq); else st_tr(sb, tacc, m, fq);
        }
        __syncthreads();
        {
            R1_IDX const int rowb = scan_row(b, d, c * 64 + bi); (void)rowb;
            f32x4 acc[4]; acc_zero(acc);
            mm64<SL, SL>(s2, s0, acc, wave, fr, fq);
            acc_mask<true>(acc, m, fq);
            st_rm(sa, acc, m, fq);
            tr_copy16(sc, s0, bi, bq);
        }
        __syncthreads();
        {
            R1_IDX const int rowb = scan_row(b, d, c * 64 + bi); (void)rowb;
            f32x4 acc[4]; acc_zero(acc);
            mm64<SL, SL>(sc, sb, acc, wave, fr, fq);
            st_rm(sT, acc, m, fq);
            acc_zero(acc);
            mm64<SL, SL>(sa, sb, acc, wave, fr, fq);
            st_rm(s0, acc, m, fq);
        }
        __syncthreads();
        f32x4 qacc[4];
        {
            R1_IDX
            f32x4 acc[4]; acc_zero(acc);
            mm64<SL, SL>(s3, s1, acc, wave, fr, fq);
            acc_mask_lo(acc, m, fq);
            st_rm(sa, acc, m, fq);
            acc_zero(qacc);
            mm64<SL, SL>(s3, s2, qacc, wave, fr, fq);
            acc_mask_lo(qacc, m, fq);
        }
        __syncthreads();
        {
            R1_IDX
            f32x4 acc[4];
#pragma unroll
            for (int nt = 0; nt < 4; ++nt) { const uint2 u = *(const uint2*)(s3 + m * SL + nt * 16 + fq * 4); acc[nt] = (f32x4){bflo(u.x), bfhi(u.x), bflo(u.y), bfhi(u.y)}; }
            mm64<SL, SL>(sa, sT, acc, wave, fr, fq);
            bf16_t* gt = gGT + (size_t)it * 4096;
#pragma unroll
            for (int nt = 0; nt < 4; ++nt) store_bf16x4(gt + m * 64 + nt * 16 + fq * 4, acc[nt]);
            mm64<SL, SL>(sa, s0, qacc, wave, fr, fq);
            st_rm(sb, qacc, m, fq);
            tr_copy16(sc, s1, bi, bq);
        }
        __syncthreads();
        {
            R1_IDX
            f32x4 acc[4]; acc_zero(acc);
            mm64<SL, SL>(sc, sT, acc, wave, fr, fq);
            bf16_t* mt = gMT + (size_t)it * 4096;
            const float gm = GAM[m];
#pragma unroll
            for (int nt = 0; nt < 4; ++nt) {
                f32x4 o = acc[nt];
#pragma unroll
                for (int r = 0; r < 4; ++r) if (nt * 16 + fq * 4 + r == m) o[r] += 1.f;
                o *= gm;
                store_bf16x4(mt + m * 64 + nt * 16 + fq * 4, o);
            }
#pragma unroll
            for (int nt = 0; nt < 4; ++nt) {
                const int n = nt * 16 + fq * 4; const uint2 u = *(const uint2*)(s2 + m * SL + n);
                acc[nt] = (f32x4){bflo(u.x), bfhi(u.x), bflo(u.y), bfhi(u.y)};
            }
            mm64<SL, SL>(s0, sc, acc, wave, fr, fq);
#pragma unroll
            for (int nt = 0; nt < 4; ++nt) acc[nt] *= *(const f32x4*)(GAM + nt * 16 + fq * 4);
            st_tr(s1, acc, m, fq);
#pragma unroll
            for (int q = 0; q < 8; ++q) { s3[(bq + 2 * q) * SL + bi] = (bf16_t)(vp[q] & 0xffffu); s3[(bq + 2 * q + 1) * SL + bi] = (bf16_t)(vp[q] >> 16); }
        }
        __syncthreads();
        {
            R1_IDX const int rowb = scan_row(b, d, c * 64 + bi); (void)rowb;
            f32x4 acc[4]; acc_zero(acc);
            mm64<SL, SL>(s3, sb, acc, wave, fr, fq);
            bf16_t* yl = gYL + (size_t)it * 4096;
#pragma unroll
            for (int nt = 0; nt < 4; ++nt) store_bf16x4(yl + m * 64 + nt * 16 + fq * 4, acc[nt]);
            acc_zero(acc);
            mm64<SL, SL>(s3, s1, acc, wave, fr, fq);
            bf16_t* nl = gNL + (size_t)it * 4096;
#pragma unroll
            for (int nt = 0; nt < 4; ++nt) store_bf16x4(nl + m * 64 + nt * 16 + fq * 4, acc[nt]);
        }
        __syncthreads();
    }
}
__device__ __forceinline__ void ph_r2(const Params& p, char* smem) {
    const int tid = tidx(), lane = tid & 63, wave = tid >> 6, fr = lane & 15, fq = lane >> 4;
    const char* gMT = (const char*)(p.ws + O_X + X_MT); const char* gNL = (const char*)(p.ws + O_H);
    uint4* gS0 = (uint4*)(p.ws + O_X + X_S0);
    const int wofs = __builtin_amdgcn_readfirstlane(wave) * 1024;
    const unsigned lds0 = (unsigned)(uintptr_t)smem;
    const unsigned mtaddr = lds0 + fr * 128 + fq * 8, nladdr = lds0 + (wave * 16 + fr) * 128 + fq * 8;
    auto issue = [&](size_t cp, int slot) {
        char* dst = smem + slot * 16384 + wofs;
        const char* s0 = gMT + cp * 8192 + wofs + lane * 16; const char* s1 = gNL + cp * 8192 + wofs + lane * 16;
        __builtin_amdgcn_global_load_lds((const unsigned*)s0, (unsigned*)dst, 16, 0, 0);
        __builtin_amdgcn_global_load_lds((const unsigned*)(s0 + 4096), (unsigned*)(dst + 4096), 16, 0, 0);
        __builtin_amdgcn_global_load_lds((const unsigned*)s1, (unsigned*)(dst + 8192), 16, 0, 0);
        __builtin_amdgcn_global_load_lds((const unsigned*)(s1 + 4096), (unsigned*)(dst + 12288), 16, 0, 0);
    };
#define R2_READ(MX, NV, SLOT) do { \
        asm volatile("ds_read_b64 %0, %1 offset:0" : "=v"(MX[0][0][0]) : "v"(mtaddr + (SLOT) * 16384)); \
        asm volatile("ds_read_b64 %0, %1 offset:32" : "=v"(MX[0][0][1]) : "v"(mtaddr + (SLOT) * 16384)); \
        asm volatile("ds_read_b64 %0, %1 offset:64" : "=v"(MX[0][1][0]) : "v"(mtaddr + (SLOT) * 16384)); \
        asm volatile("ds_read_b64 %0, %1 offset:96" : "=v"(MX[0][1][1]) : "v"(mtaddr + (SLOT) * 16384)); \
        asm volatile("ds_read_b64 %0, %1 offset:8192" : "=v"(NV[0]) : "v"(nladdr + (SLOT) * 16384)); \
        asm volatile("ds_read_b64 %0, %1 offset:2048" : "=v"(MX[1][0][0]) : "v"(mtaddr + (SLOT) * 16384)); \
        asm volatile("ds_read_b64 %0, %1 offset:2080" : "=v"(MX[1][0][1]) : "v"(mtaddr + (SLOT) * 16384)); \
        asm volatile("ds_read_b64 %0, %1 offset:2112" : "=v"(MX[1][1][0]) : "v"(mtaddr + (SLOT) * 16384)); \
        asm volatile("ds_read_b64 %0, %1 offset:2144" : "=v"(MX[1][1][1]) : "v"(mtaddr + (SLOT) * 16384)); \
        asm volatile("ds_read_b64 %0, %1 offset:8224" : "=v"(NV[1]) : "v"(nladdr + (SLOT) * 16384)); \
        asm volatile("ds_read_b64 %0, %1 offset:4096" : "=v"(MX[2][0][0]) : "v"(mtaddr + (SLOT) * 16384)); \
        asm volatile("ds_read_b64 %0, %1 offset:4128" : "=v"(MX[2][0][1]) : "v"(mtaddr + (SLOT) * 16384)); \
        asm volatile("ds_read_b64 %0, %1 offset:4160" : "=v"(MX[2][1][0]) : "v"(mtaddr + (SLOT) * 16384)); \
        asm volatile("ds_read_b64 %0, %1 offset:4192" : "=v"(MX[2][1][1]) : "v"(mtaddr + (SLOT) * 16384)); \
        asm volatile("ds_read_b64 %0, %1 offset:8256" : "=v"(NV[2]) : "v"(nladdr + (SLOT) * 16384)); \
        asm volatile("ds_read_b64 %0, %1 offset:6144" : "=v"(MX[3][0][0]) : "v"(mtaddr + (SLOT) * 16384)); \
        asm volatile("ds_read_b64 %0, %1 offset:6176" : "=v"(MX[3][0][1]) : "v"(mtaddr + (SLOT) * 16384)); \
        asm volatile("ds_read_b64 %0, %1 offset:6208" : "=v"(MX[3][1][0]) : "v"(mtaddr + (SLOT) * 16384)); \
        asm volatile("ds_read_b64 %0, %1 offset:6240" : "=v"(MX[3][1][1]) : "v"(mtaddr + (SLOT) * 16384)); \
        asm volatile("ds_read_b64 %0, %1 offset:8288" : "=v"(NV[3]) : "v"(nladdr + (SLOT) * 16384)); \
        } while (0)
#define R2_PIN(MX, NV) asm volatile("" : "+v"(MX[0][0][0]), "+v"(MX[0][0][1]), "+v"(MX[0][1][0]), "+v"(MX[0][1][1]), "+v"(NV[0]), "+v"(MX[1][0][0]), "+v"(MX[1][0][1]), "+v"(MX[1][1][0]), "+v"(MX[1][1][1]), "+v"(NV[1]), "+v"(MX[2][0][0]), "+v"(MX[2][0][1]), "+v"(MX[2][1][0]), "+v"(MX[2][1][1]), "+v"(NV[2]), "+v"(MX[3][0][0]), "+v"(MX[3][0][1]), "+v"(MX[3][1][0]), "+v"(MX[3][1][1]), "+v"(NV[3]) :: "memory")
#define R2_STEP(MX, NV, MXN, NVN, J) do { const int c = c4 + (J); \
        asm volatile("s_waitcnt lgkmcnt(0)" ::: "memory");            \
        R2_PIN(MX, NV);                                                \
        asm volatile("s_waitcnt vmcnt(8)" ::: "memory");              \
        __builtin_amdgcn_s_barrier(); \
        asm volatile("" ::: "memory"); \
        R2_READ(MXN, NVN, ((J) + 1) & 3); \
        __builtin_amdgcn_sched_barrier(0); \
        u32x4 sb_[2]; \
        _Pragma("unroll") for (int s_ = 0; s_ < 2; ++s_) sb_[s_] = (u32x4){pack2(st[2 * s_][0], st[2 * s_][1]), pack2(st[2 * s_][2], st[2 * s_][3]), pack2(st[2 * s_ + 1][0], st[2 * s_ + 1][1]), pack2(st[2 * s_ + 1][2], st[2 * s_ + 1][3])}; \
        _Pragma("unroll") for (int tt = 0; tt < 4; ++tt) { \
            f32x4 acc_ = {bflo(NV[tt].x), bfhi(NV[tt].x), bflo(NV[tt].y), bfhi(NV[tt].y)}; \
            _Pragma("unroll") for (int s_ = 0; s_ < 2; ++s_) \
                acc_ = __builtin_amdgcn_mfma_f32_16x16x32_bf16(__builtin_bit_cast(bf16x8, (u32x4){MX[tt][s_][0].x, MX[tt][s_][0].y, MX[tt][s_][1].x, MX[tt][s_][1].y}), __builtin_bit_cast(bf16x8, sb_[s_]), acc_, 0, 0, 0); \
            st[tt] = acc_; } \
        *(u32x4*)(gS0 + ((cp0 + c) * 4 + wave) * 128 + lane) = sb_[0]; *(u32x4*)(gS0 + ((cp0 + c) * 4 + wave) * 128 + 64 + lane) = sb_[1]; \
        issue(cp0 + (c + 4 < 68 ? c + 4 : 67), (J)); } while (0)
    for (int it = blockIdx.x; it < 64; it += gridDim.x) {
        f32x4 st[4];
#pragma unroll
        for (int tt = 0; tt < 4; ++tt) st[tt] = (f32x4){0.f, 0.f, 0.f, 0.f};
        const size_t cp0 = (size_t)it * 68;
        issue(cp0, 0); issue(cp0 + 1, 1); issue(cp0 + 2, 2); issue(cp0 + 3, 3);
        uint2 mxA[4][2][2], nvA[4], mxB[4][2][2], nvB[4];
        asm volatile("s_waitcnt vmcnt(12)" ::: "memory");
        __builtin_amdgcn_s_barrier();
        asm volatile("" ::: "memory");
        R2_READ(mxA, nvA, 0);
        asm volatile("s_waitcnt lgkmcnt(0)" ::: "memory");
        R2_PIN(mxA, nvA);
        for (int c4 = 0; c4 < 68; c4 += 4) {
            R2_STEP(mxA, nvA, mxB, nvB, 0);
            R2_STEP(mxB, nvB, mxA, nvA, 1);
            R2_STEP(mxA, nvA, mxB, nvB, 2);
            R2_STEP(mxB, nvB, mxA, nvA, 3);
            asm volatile("s_waitcnt lgkmcnt(0)" ::: "memory");
            R2_PIN(mxA, nvA);
        }
        asm volatile("s_waitcnt vmcnt(0) lgkmcnt(0)" ::: "memory");
        __builtin_amdgcn_sched_barrier(0);
        __syncthreads();
    }
#undef R2_READ
#undef R2_PIN
#undef R2_STEP
}
__device__ __forceinline__ void ph_r3(const Params& p, int l, char* smem) {
    const int tid = tidx(), lane = tid & 63, wave = tid >> 6, fr = lane & 15, fq = lane >> 4;
    const bf16_t* P = (const bf16_t*)(p.ws + O_P); const float* mu = p.in[I_MU] + l * 1792;
    const float* gng = p.in[I_GNG] + l * 512; const float* gnb = p.in[I_GNB] + l * 512;
    const bf16_t* gGT = (const bf16_t*)(p.ws + O_X + X_GT); const bf16_t* gYL = (const bf16_t*)(p.ws + O_X + X_YL);
    const u32x4* gS0 = (const u32x4*)(p.ws + O_X + X_S0);
    const float* BON = (const float*)(p.ws + O_X + X_BON);
    const bf16_t* RG = (const bf16_t*)(p.ws + O_RG); bf16_t* RWO = (bf16_t*)(p.ws + O_RWO);
    float* YA = (float*)smem;
    float* YB = YA + 64 * 68;
    for (int it = blockIdx.x; it < 4 * 68 * 8; it += gridDim.x) {
        const int h = it & 7, c0 = (it >> 3) % 68, b = it / (68 * 8);
        const int c1 = c0 < 4 ? 3 - c0 : 71 - c0;
        const int pi = tid >> 2, pv0 = (tid & 3) * 16;
        const int prow = scan_row(b, 0, c0 * 64 + pi), pcol = h * 64 + pv0;
        float pv[16]; uint4 prg[2];
#pragma unroll
        for (int hh = 0; hh < 2; ++hh) {
            float t8[8]; xs8(P, mu, prow, 1024 + pcol + hh * 8, t8);
#pragma unroll
            for (int e = 0; e < 8; ++e) pv[hh * 8 + e] = t8[e];
            prg[hh] = *(const uint4*)(RG + (size_t)prow * 512 + pcol + hh * 8);
        }
        const float pbs = BON[((size_t)0 * RT + prow) * 8 + h] + BON[((size_t)1 * RT + prow) * 8 + h];
#pragma unroll
        for (int d = 0; d < 2; ++d) {
            const size_t cp = ((size_t)(b * 8 + h) * 2 + d) * 68 + (d == 0 ? c0 : c1);
            const bf16_t* gt = gGT + cp * 4096; const bf16_t* yl = gYL + cp * 4096;
            const u32x4 sb0 = gS0[(cp * 4 + wave) * 128 + lane], sb1 = gS0[(cp * 4 + wave) * 128 + 64 + lane];
            float* Y = d == 0 ? YA : YB;
#pragma unroll
            for (int tt = 0; tt < 4; ++tt) {
                const uint2 yv = *(const uint2*)(yl + (wave * 16 + fr) * 64 + tt * 16 + fq * 4);
                f32x4 acc = {bflo(yv.x), bfhi(yv.x), bflo(yv.y), bfhi(yv.y)};
#pragma unroll
                for (int s_ = 0; s_ < 2; ++s_) {
                    const bf16_t* q = gt + (tt * 16 + fr) * 64 + s_ * 32 + fq * 4;
                    const uint2 a0 = *(const uint2*)q, a1 = *(const uint2*)(q + 16);
                    acc = __builtin_amdgcn_mfma_f32_16x16x32_bf16(__builtin_bit_cast(bf16x8, (u32x4){a0.x, a0.y, a1.x, a1.y}), __builtin_bit_cast(bf16x8, s_ ? sb1 : sb0), acc, 0, 0, 0);
                }
#pragma unroll
                for (int r = 0; r < 4; ++r) {
                    const int t = tt * 16 + fq * 4 + r, i = d == 0 ? t : 63 - t;
                    Y[i * 68 + wave * 16 + fr] = acc[r];
                }
            }
        }
        __syncthreads();
        {
            const int i = tid >> 2, q4 = tid & 3, v0 = q4 * 16;
            const int row = scan_row(b, 0, c0 * 64 + i), col = h * 64 + v0;
            float y[16];
#pragma unroll
            for (int e4 = 0; e4 < 4; ++e4) {
                const float4 ya = *(const float4*)(YA + i * 68 + v0 + e4 * 4), yb = *(const float4*)(YB + i * 68 + v0 + e4 * 4);
                y[e4 * 4] = ya.x + yb.x; y[e4 * 4 + 1] = ya.y + yb.y; y[e4 * 4 + 2] = ya.z + yb.z; y[e4 * 4 + 3] = ya.w + yb.w;
            }
            float sm = 0.f;
#pragma unroll
            for (int e = 0; e < 16; ++e) sm += y[e];
            sm += __shfl_xor(sm, 1); sm += __shfl_xor(sm, 2);
            const float mean = sm * (1.f / 64.f);
            float vs = 0.f;
#pragma unroll
            for (int e = 0; e < 16; ++e) { const float dl = y[e] - mean; vs += dl * dl; }
            vs += __shfl_xor(vs, 1); vs += __shfl_xor(vs, 2);
            const float rstd = rsqrtf(vs * (1.f / 64.f) + 64e-5f);
            const float bs = pbs;
#pragma unroll
            for (int hh = 0; hh < 2; ++hh) {
                float g8[8], o[8];
                unpack8(prg[hh], g8);
#pragma unroll
                for (int e = 0; e < 8; ++e) o[e] = ((y[hh * 8 + e] - mean) * rstd * gng[col + hh * 8 + e] + gnb[col + hh * 8 + e] + bs * pv[hh * 8 + e]) * g8[e];
                *(uint4*)(RWO + (size_t)row * 512 + col + hh * 8) = pack8(o);
            }
        }
        __syncthreads();
    }
}

__device__ __forceinline__ void ph_f1(const Params& p, int l, char* smem) {
    const bf16_t* P = (const bf16_t*)(p.ws + O_P); const bf16_t* CSC = (const bf16_t*)(p.ws + O_CSC);
    bf16_t* YT2 = (bf16_t*)(p.ws + O_YT2); bf16_t* YTC = (bf16_t*)(p.ws + O_YTC);
    const int nitems = 1024 + (l < NLAYER - 1 ? 64 : 0);
    for (int it = gridDim.x - 1 - blockIdx.x; it < nitems; it += gridDim.x) {
        f32x4 acc[4][4];
        if (it < 1024) {
            const int b = it >> 8, g = (it >> 6) & 3, part = (it >> 5) & 1, j = it & 31;
            RPPlain rpa{CSC + (size_t)part * 128 * 128, 128};
            const bf16_t* pb = P + (size_t)b * SEQ * LDP + g * 128;
            auto rpb = [&](int r) -> const bf16_t* { return pb + (size_t)(64 * (r & 63) + 2 * j + (r >> 6)) * LDP; };
            gemm_core_gb<4>(rpa, rpb, 128, acc, smem);
            acc_foreach<4>(acc, [&](int m, int n, const f32x4& v) {
                const int t1 = n & 63, t2 = 2 * j + (n >> 6);
                store_bf16x4(YT2 + ((size_t)(b * 512 + g * 128 + m) * 64 + t2) * 128 + part * 64 + t1, v);
            });
        } else {
            const int jj = it - 1024, b = jj >> 4, g = (jj >> 2) & 3, part = (jj >> 1) & 1, nt = jj & 1;
            RPPlain rpa{CSC + (size_t)part * 128 * 128, 128};
            gemm_core_g<4>(rpa, P + (size_t)(RL + b * CTX + nt * 128) * LDP + g * 128, LDP, 128, acc, smem);
            acc_foreach<4>(acc, [&](int m, int n, const f32x4& v) {
                store_bf16x4(YTC + ((size_t)(b * 512 + g * 128 + m)) * 512 + part * 256 + nt * 128 + n, v);
            });
        }
    }
}
__device__ __forceinline__ void ph_fa(const Params& p, char* smem) {
    const bf16_t* YT2 = (const bf16_t*)(p.ws + O_YT2); const bf16_t* D128 = (const bf16_t*)(p.ws + O_D128);
    const float* TWC = (const float*)(p.ws + O_TWC); const float* TWS = (const float*)(p.ws + O_TWS);
    bf16_t* A2 = (bf16_t*)(p.ws + O_A2);
    for (int it = blockIdx.x; it < 1024; it += gridDim.x) {
        f32x4 acc[4][4];
        RPPlain rpa{D128, 128};
        gemm_core_g<4>(rpa, YT2 + (size_t)it * 128 * 128, 128, 128, acc, smem);
        const int lane = tidx() & 63, wave = tidx() >> 6, wr = wave >> 1, wc = wave & 1, fr = lane & 15, fq = lane >> 4;
        float* U = (float*)smem;
        if (wr == 1) {
#pragma unroll
            for (int i = 0; i < 4; ++i)
#pragma unroll
                for (int j = 0; j < 4; ++j) *(f32x4*)(U + (i * 16 + fr) * 132 + wc * 64 + j * 16 + fq * 4) = acc[i][j];
        }
        __syncthreads();
        if (wr == 0) {
#pragma unroll
            for (int i = 0; i < 4; ++i) {
                const int k1 = i * 16 + fr;
#pragma unroll
                for (int j = 0; j < 4; ++j) {
                    const int r = wc * 64 + j * 16 + fq * 4;
                    const int R = it * 128 + r, bn = R >> 6, t2 = R & 63, b = bn >> 9, n = bn & 511;
                    const f32x4 ai = *(const f32x4*)(U + k1 * 132 + r);
                    const f32x4 c = *(const f32x4*)(TWC + k1 * 64 + t2), sn = *(const f32x4*)(TWS + k1 * 64 + t2);
                    const f32x4 ar = acc[i][j];
                    const f32x4 pr = ar * c - ai * sn, pi = ar * sn + ai * c;
                    bf16_t* dst = A2 + ((size_t)(b * 64 + k1) * 512 + n) * 128 + t2;
                    store_bf16x4(dst, pr); store_bf16x4(dst + 64, pi);
                }
            }
        }
        __syncthreads();
    }
}
__device__ __forceinline__ void ph_fb(const Params& p, int l, char* smem) {
    const bf16_t* A2 = (const bf16_t*)(p.ws + O_A2); const bf16_t* E64 = (const bf16_t*)(p.ws + O_E64);
    const bf16_t* CST2 = (const bf16_t*)(p.ws + O_CST256); const bf16_t* YTC = (const bf16_t*)(p.ws + O_YTC);
    bf16_t* FA = (bf16_t*)(p.ws + O_FA);
    const int nctx = l < NLAYER - 1 ? 32 : 0, nitems = 1024 + nctx;
    const int skip = gridDim.x >= 128 ? 64 : 0;
    if ((int)blockIdx.x < skip) return;
    for (int it0 = blockIdx.x - skip; it0 < nitems; it0 += gridDim.x - skip) {
        const int it = it0 < nctx ? 1024 + it0 : it0 - nctx;
        if (it < 1024) {
            const int b = it >> 8, k1 = (it >> 2) & 63, nt = it & 3;
            f32x4 acc[2][4];
            RPPlain rpa{E64, 128};
            gemm_core_g<2>(rpa, A2 + ((size_t)(b * 64 + k1) * 512 + nt * 128) * 128, 128, 128, acc, smem);
            const float sc = 0.001381067932004975f;
            acc_foreach<2>(acc, [&](int m, int n, const f32x4& v) { f32x4 o = v * sc; store_bf16x4(FA + (size_t)(b * SEQ + k1 + 64 * m) * 512 + nt * 128 + n, o); });
        } else {
            const int j = it - 1024, b = j >> 3, mt = (j >> 2) & 1, nt = j & 3;
            f32x4 acc[4][4];
            RPPlain rp{CST2 + (size_t)mt * 128 * 512, 512};
            gemm_core_g<4>(rp, YTC + ((size_t)b * 512 + nt * 128) * 512, 512, 512, acc, smem);
            const float sc = 0.005524271728019903f;
            acc_foreach<4>(acc, [&](int m, int n, const f32x4& v) { f32x4 o = v * sc; store_bf16x4(FA + (size_t)(RL + b * CTX + mt * 128 + m) * 512 + nt * 128 + n, o); });
        }
    }
}

template <int MI>
__device__ __forceinline__ void mg_tile(const Params& p, int row0, int nt, char* smem) {
    const bf16_t* P = (const bf16_t*)(p.ws + O_P);
    const bf16_t* A0 = (const bf16_t*)(p.ws + O_FA); const bf16_t* A1 = (const bf16_t*)(p.ws + O_ATT); const bf16_t* A2 = (const bf16_t*)(p.ws + O_RWO);
    const bf16_t* W0 = (const bf16_t*)(p.ws + O_WB + W_PA); const bf16_t* W1 = (const bf16_t*)(p.ws + O_WB + W_PB); const bf16_t* W2 = (const bf16_t*)(p.ws + O_WB + W_PC);
    bf16_t* MG = (bf16_t*)(p.ws + O_H);
    f32x4 tot[MI][4];
#pragma unroll
    for (int i = 0; i < MI; ++i)
#pragma unroll
        for (int j = 0; j < 4; ++j) tot[i][j] = (f32x4){0.f, 0.f, 0.f, 0.f};
#pragma unroll 1
    for (int br = 0; br < 3; ++br) {
        const bf16_t* Ab = br == 0 ? A0 : (br == 1 ? A1 : A2);
        const bf16_t* Wb = br == 0 ? W0 : (br == 1 ? W1 : W2);
        f32x4 acc[MI][4];
        RPPlain rp{Ab + (size_t)row0 * 512, 512};
        gemm_core_g<MI>(rp, Wb + (size_t)nt * 128 * 512, 512, 512, acc, smem);
        const int lane = tidx() & 63, wave = tidx() >> 6, wr = wave >> 1, wc = wave & 1, fr = lane & 15, fq = lane >> 4;
#pragma unroll
        for (int i = 0; i < MI; ++i)
#pragma unroll
            for (int j = 0; j < 4; ++j) {
                const int m = wr * MI * 16 + i * 16 + fr, n = wc * 64 + j * 16 + fq * 4;
                const uint2 gu = *(const uint2*)(P + (size_t)(row0 + m) * LDP + PG0 + br * 1024 + nt * 128 + n);
                tot[i][j][0] += bflo(gu.x) * acc[i][j][0]; tot[i][j][1] += bfhi(gu.x) * acc[i][j][1];
                tot[i][j][2] += bflo(gu.y) * acc[i][j][2]; tot[i][j][3] += bfhi(gu.y) * acc[i][j][3];
            }
    }
    acc_foreach<MI>(tot, [&](int m, int n, const f32x4& v) { store_bf16x4(MG + (size_t)(row0 + m) * 1024 + nt * 128 + n, v); });
}
__device__ __forceinline__ void ph_mg(const Params& p, int l, char* smem) {
    const int nlat = (RL / 128) * 8, nctx = (l < NLAYER - 1) ? (RC / 32) * 8 : 0;
    for (int it = blockIdx.x; it < nlat + nctx; it += gridDim.x) {
        if (it < nlat) mg_tile<4>(p, (it >> 3) * 128, it & 7, smem);
        else { const int j = it - nlat; mg_tile<1>(p, RL + (j >> 3) * 32, j & 7, smem); }
    }
}
__device__ __forceinline__ void ph_out(const Params& p, int l, char* smem) {
    const bf16_t* MG = (const bf16_t*)(p.ws + O_H); const bf16_t* W = (const bf16_t*)(p.ws + O_WB + W_OUT);
    float* xcur = (float*)(p.ws + O_XCUR); const float* mod = (const float*)(p.ws + O_MOD);
    const int nlat = 1024, nctx = (l < NLAYER - 1) ? (RC / 32) * 8 : 0;
    for (int it = blockIdx.x; it < nlat + nctx; it += gridDim.x) {
        if (it < nlat) {
            const int mt = it >> 3, nt = it & 7;
            f32x4 acc[4][4];
            RPPlain rp{MG + (size_t)mt * 128 * 1024, 1024};
            gemm_core_g<4>(rp, W + (size_t)nt * 128 * 1024, 1024, 1024, acc, smem);
            acc_foreach<4>(acc, [&](int m, int n, const f32x4& v) {
                const int row = mt * 128 + m, col = nt * 128 + n;
                const float4 g = *(const float4*)(mod + (size_t)(l * 5 + modidx(row)) * 6144 + 2048 + col);
                float4* xp = (float4*)(xcur + (size_t)row * 1024 + col);
                float4 x = *xp; x.x += g.x * v[0]; x.y += g.y * v[1]; x.z += g.z * v[2]; x.w += g.w * v[3]; *xp = x;
            });
        } else {
            const int j = it - nlat, mt = j >> 3, nt = j & 7;
            f32x4 acc[1][4];
            RPPlain rp{MG + (size_t)(RL + mt * 32) * 1024, 1024};
            gemm_core_g<1>(rp, W + (size_t)nt * 128 * 1024, 1024, 1024, acc, smem);
            acc_foreach<1>(acc, [&](int m, int n, const f32x4& v) {
                const int row = RL + mt * 32 + m, col = nt * 128 + n;
                const float4 g = *(const float4*)(mod + (size_t)(l * 5 + 4) * 6144 + 2048 + col);
                float4* xp = (float4*)(xcur + (size_t)row * 1024 + col);
                float4 x = *xp; x.x += g.x * v[0]; x.y += g.y * v[1]; x.z += g.z * v[2]; x.w += g.w * v[3]; *xp = x;
            });
        }
    }
}

__device__ __forceinline__ void ph_n2(const Params& p, int l, char* smem) {
    const int tid = tidx(), lane = tid & 63, wave = tid >> 6;
    unsigned* lcnt = (unsigned*)smem;
    unsigned* gbase = lcnt + 16;
    int* rec = (int*)(smem + 256);
    float4* rwl = (float4*)(smem + 8192);
    for (int idx = tid; idx < 4096; idx += 256) {
        const int k = idx >> 2, pp = idx & 3;
        rwl[(((k >> 8) * 16 + (k & 3) * 4 + pp) << 6) + ((k & 255) >> 2)] = *(const float4*)(p.in[I_RW] + (size_t)k * 16 + pp * 4);
    }
    if (tid < 16) lcnt[tid] = 0u;
    __syncthreads();
    int nrec = 0;
    const float* xcur = (const float*)(p.ws + O_XCUR); const float* mod = (const float*)(p.ws + O_MOD);
    bf16_t* H = (bf16_t*)(p.ws + O_H);
    unsigned* cnt = (unsigned*)(p.ws + O_CNT); int* LTOK = (int*)(p.ws + O_LTOK); float* LW = (float*)(p.ws + O_LW); int* SLOT = (int*)(p.ws + O_SLOT);
    const float* g = p.in[I_N2G] + l * 1024; const float* rw = p.in[I_RW]; const float* rb = p.in[I_RB];
    const int nrows = (l < NLAYER - 1) ? RT : RL;
    float4 vn[4];
    {
        const int r0 = blockIdx.x * 4 + wave;
        const float* x0 = xcur + (size_t)(r0 < nrows ? r0 : 0) * 1024;
#pragma unroll
        for (int i = 0; i < 4; ++i) vn[i] = *(const float4*)(x0 + lane * 4 + 256 * i);
    }
    for (int row = blockIdx.x * 4 + wave; row < nrows; row += gridDim.x * 4) {
        const float* md = mod + (size_t)(l * 5 + modidx(row)) * 6144;
        float4 v[4]; float ss = 0.f;
#pragma unroll
        for (int i = 0; i < 4; ++i) { v[i] = vn[i]; ss += v[i].x * v[i].x + v[i].y * v[i].y + v[i].z * v[i].z + v[i].w * v[i].w; }
        {
            const int rn = row + gridDim.x * 4;
            const float* xn = xcur + (size_t)(rn < nrows ? rn : row) * 1024;
#pragma unroll
            for (int i = 0; i < 4; ++i) vn[i] = *(const float4*)(xn + lane * 4 + 256 * i);
        }
        ss = wsum(ss);
        const float rstd = rsqrtf(ss * (1.f / 1024.f) + 1e-6f);
        float lg[16];
#pragma unroll
        for (int e = 0; e < 16; ++e) lg[e] = 0.f;
#pragma unroll
        for (int i = 0; i < 4; ++i) {
            const int c = lane * 4 + 256 * i;
            const float4 gg = *(const float4*)(g + c), sc = *(const float4*)(md + 4096 + c), sh = *(const float4*)(md + 3072 + c);
            const float hv[4] = {v[i].x * rstd * gg.x * (1.f + sc.x) + sh.x, v[i].y * rstd * gg.y * (1.f + sc.y) + sh.y,
                                 v[i].z * rstd * gg.z * (1.f + sc.z) + sh.z, v[i].w * rstd * gg.w * (1.f + sc.w) + sh.w};
            f32x4 h4 = {hv[0], hv[1], hv[2], hv[3]};
            store_bf16x4(H + (size_t)row * 1024 + c, h4);
#pragma unroll
            for (int j = 0; j < 4; ++j) {
                const float4* wr_ = rwl + ((i * 16 + j * 4) << 6) + lane;
                const float4 w0 = wr_[0], w1 = wr_[64], w2 = wr_[128], w3 = wr_[192];
                lg[0] += hv[j] * w0.x; lg[1] += hv[j] * w0.y; lg[2] += hv[j] * w0.z; lg[3] += hv[j] * w0.w;
                lg[4] += hv[j] * w1.x; lg[5] += hv[j] * w1.y; lg[6] += hv[j] * w1.z; lg[7] += hv[j] * w1.w;
                lg[8] += hv[j] * w2.x; lg[9] += hv[j] * w2.y; lg[10] += hv[j] * w2.z; lg[11] += hv[j] * w2.w;
                lg[12] += hv[j] * w3.x; lg[13] += hv[j] * w3.y; lg[14] += hv[j] * w3.z; lg[15] += hv[j] * w3.w;
            }
        }
        float sc_[16], sel[16];
#pragma unroll
        for (int e = 0; e < 16; ++e) { lg[e] = wsum(lg[e]); sc_[e] = 1.f / (1.f + expf(-lg[e])); sel[e] = sc_[e] + rb[e]; }
        int best = 0; float bestv = -1e30f;
#pragma unroll
        for (int gi = 0; gi < 4; ++gi) {
            float m1 = -1e30f, m2 = -1e30f;
#pragma unroll
            for (int j = 0; j < 4; ++j) { const float s = sel[gi * 4 + j]; if (s > m1) { m2 = m1; m1 = s; } else if (s > m2) m2 = s; }
            const float gs = m1 + m2;
            if (gs > bestv) { bestv = gs; best = gi; }
        }
        float s4[4] = {0.f, 0.f, 0.f, 0.f}, c4[4] = {0.f, 0.f, 0.f, 0.f};
#pragma unroll
        for (int gi = 0; gi < 4; ++gi)
#pragma unroll
            for (int j = 0; j < 4; ++j) if (gi == best) { s4[j] = sel[gi * 4 + j]; c4[j] = sc_[gi * 4 + j]; }
        int i1 = 0; float v1 = s4[0], w1 = c4[0];
#pragma unroll
        for (int j = 1; j < 4; ++j) if (s4[j] > v1) { v1 = s4[j]; i1 = j; w1 = c4[j]; }
        int i2 = -1; float v2 = -1e30f, w2 = 0.f;
#pragma unroll
        for (int j = 0; j < 4; ++j) if (j != i1 && s4[j] > v2) { v2 = s4[j]; i2 = j; w2 = c4[j]; }
        if (lane == 0) {
            const float inv = 1.f / (w1 + w2);
            const int e1 = best * 4 + i1, e2 = best * 4 + i2;
            const unsigned r1 = atomicAdd(&lcnt[e1], 1u), r2 = atomicAdd(&lcnt[e2], 1u);
            int* rc = rec + (wave * 32 + nrec) * 8;
            rc[0] = row; rc[1] = e1; rc[2] = e2; rc[3] = (int)r1; rc[4] = (int)r2; rc[5] = __float_as_int(w1 * inv); rc[6] = __float_as_int(w2 * inv);
        }
        ++nrec;
    }
    __syncthreads();
    if (tid < 16) gbase[tid] = lcnt[tid] ? atomicAdd(&cnt[tid], lcnt[tid]) : 0u;
    __syncthreads();
    for (int i = lane; i < nrec; i += 64) {
        const int* rc = rec + (wave * 32 + i) * 8;
        const int row = rc[0], e1 = rc[1], e2 = rc[2];
        const unsigned p1 = gbase[e1] + (unsigned)rc[3], p2 = gbase[e2] + (unsigned)rc[4];
        LTOK[(size_t)e1 * RT + p1] = row; LW[(size_t)e1 * RT + p1] = __int_as_float(rc[5]);
        LTOK[(size_t)e2 * RT + p2] = row; LW[(size_t)e2 * RT + p2] = __int_as_float(rc[6]);
        SLOT[row * 2] = (e1 << 20) | (int)p1; SLOT[row * 2 + 1] = (e2 << 20) | (int)p2;
    }
}

struct MoeTiles { int tb[17]; int sm; };
__device__ __forceinline__ void moe_tiles(const Params& p, int l, int* s_tb) {
    if (tidx() == 0) {
        const unsigned* cnt = (const unsigned*)(p.ws + O_CNT);
        int a = 0;
        for (int e = 0; e < 16; ++e) { s_tb[e] = a; a += ((int)cnt[e] + 127) >> 7; }
        s_tb[16] = a;
    }
    __syncthreads();
}
__device__ __forceinline__ void ph_e1(const Params& p, int l, char* smem) {
    int* s_tb = (int*)(smem + 73728);
    moe_tiles(p, l, s_tb);
    const bf16_t* H = (const bf16_t*)(p.ws + O_H); bf16_t* ACT = (bf16_t*)(p.ws + O_P);
    const unsigned* cnt = (const unsigned*)(p.ws + O_CNT); const int* LTOK = (const int*)(p.ws + O_LTOK); const float* LW = (const float*)(p.ws + O_LW);
    const int sm = (l < NLAYER - 1) ? RT / 128 : RL / 128;
    const int total = (sm + s_tb[16]) * 8;
    for (int it = blockIdx.x; it < total; it += gridDim.x) {
        const int mt = it >> 3, nt = it & 7;
        int e = 16, erow0 = mt * 128, lt = 0;
        if (mt >= sm) { const int q = mt - sm; e = 0; while (q >= s_tb[e + 1]) ++e; lt = q - s_tb[e]; erow0 = RT + q * 128; }
        const int cnte = (e == 16) ? 0 : (int)cnt[e];
        auto rp = [&](int r) -> const bf16_t* {
            if (e == 16) return H + (size_t)(mt * 128 + r) * 1024;
            const int idx = lt * 128 + r;
            const int tok = idx < cnte ? LTOK[(size_t)e * RT + idx] : 0;
            return H + (size_t)tok * 1024;
        };
        f32x4 acc[4][4];
        gemm_core_g<4>(rp, (const bf16_t*)(p.ws + O_WB + W_GU) + (size_t)e * 1024 * 1024 + (size_t)nt * 128 * 1024, 1024, 1024, acc, smem);
        {
            const int lane = tidx() & 63, wave = tidx() >> 6, wr = wave >> 1, wc = wave & 1, fr = lane & 15, fq = lane >> 4;
            float* U = (float*)smem;
#pragma unroll
            for (int ii = 0; ii < 2; ++ii) {
                const int i = wc == 0 ? 2 + ii : ii;
#pragma unroll
                for (int j = 0; j < 4; ++j) { const f32x4 gv = wc == 0 ? acc[2 + ii][j] : acc[ii][j]; *(f32x4*)(U + (wr * 64 + i * 16 + fr) * 68 + j * 16 + fq * 4) = gv; }
            }
            __syncthreads();
#pragma unroll
            for (int ii = 0; ii < 2; ++ii) {
                const int i = wc == 0 ? ii : 2 + ii;
                const int m = wr * 64 + i * 16 + fr;
                float wgt = 1.f;
                if (e != 16) { const int idx = lt * 128 + m; wgt = idx < cnte ? LW[(size_t)e * RT + idx] : 0.f; }
#pragma unroll
                for (int j = 0; j < 4; ++j) {
                    const f32x4 other = *(const f32x4*)(U + m * 68 + j * 16 + fq * 4);
                    f32x4 o;
                    const f32x4 mine = wc == 0 ? acc[ii][j] : acc[2 + ii][j];
#pragma unroll
                    for (int r = 0; r < 4; ++r) { const float g = wc == 0 ? mine[r] : other[r], u = wc == 0 ? other[r] : mine[r]; o[r] = siluf_(g) * u * wgt; }
                    store_bf16x4(ACT + (size_t)(erow0 + m) * 512 + nt * 64 + j * 16 + fq * 4, o);
                }
            }
            __syncthreads();
        }
    }
}
__device__ __forceinline__ void ph_e2(const Params& p, int l, char* smem) {
    int* s_tb = (int*)(smem + 73728);
    moe_tiles(p, l, s_tb);
    const bf16_t* ACT = (const bf16_t*)(p.ws + O_P); bf16_t* YE = (bf16_t*)(p.ws + O_X + X_YE);
    const int sm = (l < NLAYER - 1) ? RT / 128 : RL / 128;
    const int total = (sm + s_tb[16]) * 8;
    for (int it = blockIdx.x; it < total; it += gridDim.x) {
        const int mt = it >> 3, nt = it & 7;
        int e = 16, erow0 = mt * 128;
        if (mt >= sm) { const int q = mt - sm; e = 0; while (q >= s_tb[e + 1]) ++e; erow0 = RT + q * 128; }
        RPPlain rp{ACT + (size_t)erow0 * 512, 512};
        f32x4 acc[4][4];
        gemm_core_g<4>(rp, (const bf16_t*)(p.ws + O_WB + W_D) + (size_t)e * 1024 * 512 + (size_t)nt * 128 * 512, 512, 512, acc, smem);
        acc_foreach<4>(acc, [&](int m, int n, const f32x4& v) { store_bf16x4(YE + (size_t)(erow0 + m) * 1024 + nt * 128 + n, v); });
    }
}
__device__ __forceinline__ void ph_e3(const Params& p, int l, char* smem) {
    int* s_tb = (int*)(smem + 73728);
    moe_tiles(p, l, s_tb);
    const int lane = tidx() & 63, wave = tidx() >> 6;
    const bf16_t* YE = (const bf16_t*)(p.ws + O_X + X_YE); const int* SLOT = (const int*)(p.ws + O_SLOT);
    float* xcur = (float*)(p.ws + O_XCUR); const float* mod = (const float*)(p.ws + O_MOD);
    bf16_t* H = (bf16_t*)(p.ws + O_H);
    const bool last = l == NLAYER - 1;
    const int nrows = last ? RL : RT;
    const float* gn = last ? p.in[I_FNG] : p.in[I_N1G] + (l + 1) * 1024;
    const int stride = gridDim.x * 4, row0 = blockIdx.x * 4 + wave;
    auto slot_rows = [&](int row, size_t& r1, size_t& r2) {
        const int rr = row < nrows ? row : 0;
        const int s1 = SLOT[rr * 2], s2 = SLOT[rr * 2 + 1];
        r1 = (size_t)RT + s_tb[s1 >> 20] * 128 + (s1 & 0xfffff); r2 = (size_t)RT + s_tb[s2 >> 20] * 128 + (s2 & 0xfffff);
    };
    uint4 ya[2], yb[2], yd[2]; float4 xa[2][2];
    size_t r1n, r2n;
    auto load_row = [&](int row, size_t r1, size_t r2) {
        const size_t rr = row < nrows ? row : 0;
#pragma unroll
        for (int i = 0; i < 2; ++i) {
            const int c = lane * 8 + 512 * i;
            ya[i] = *(const uint4*)(YE + rr * 1024 + c); yb[i] = *(const uint4*)(YE + r1 * 1024 + c); yd[i] = *(const uint4*)(YE + r2 * 1024 + c);
            const float4* xp = (const float4*)(xcur + rr * 1024 + c);
            xa[i][0] = xp[0]; xa[i][1] = xp[1];
        }
    };
    { size_t r1, r2; slot_rows(row0, r1, r2); load_row(row0, r1, r2); slot_rows(row0 + stride, r1n, r2n); }
    for (int row = row0; row < nrows; row += stride) {
        const float* g2 = mod + (size_t)(l * 5 + modidx(row)) * 6144 + 5120;
        float xv[2][8]; float ss = 0.f;
#pragma unroll
        for (int i = 0; i < 2; ++i) {
            const int c = lane * 8 + 512 * i;
            float a[8], b[8], d[8];
            unpack8(ya[i], a); unpack8(yb[i], b); unpack8(yd[i], d);
            const float4 x0 = xa[i][0], x1 = xa[i][1];
            const float4 ga = *(const float4*)(g2 + c), gb = *(const float4*)(g2 + c + 4);
            const float xo[8] = {x0.x, x0.y, x0.z, x0.w, x1.x, x1.y, x1.z, x1.w}, gg[8] = {ga.x, ga.y, ga.z, ga.w, gb.x, gb.y, gb.z, gb.w};
#pragma unroll
            for (int e = 0; e < 8; ++e) { xv[i][e] = xo[e] + gg[e] * (a[e] + b[e] + d[e]); ss += xv[i][e] * xv[i][e]; }
            if (!last) { float4* xp = (float4*)(xcur + (size_t)row * 1024 + c); xp[0] = make_float4(xv[i][0], xv[i][1], xv[i][2], xv[i][3]); xp[1] = make_float4(xv[i][4], xv[i][5], xv[i][6], xv[i][7]); }
        }
        { const size_t r1 = r1n, r2 = r2n; load_row(row + stride, r1, r2); slot_rows(row + 2 * stride, r1n, r2n); }
        ss = wsum(ss);
        const float rstd = rsqrtf(ss * (1.f / 1024.f) + 1e-6f);
        const float* md = mod + (size_t)((l + 1) * 5 + modidx(row)) * 6144;
#pragma unroll
        for (int i = 0; i < 2; ++i) {
            const int c = lane * 8 + 512 * i;
            const float4 n0 = *(const float4*)(gn + c), n1 = *(const float4*)(gn + c + 4);
            const float nn[8] = {n0.x, n0.y, n0.z, n0.w, n1.x, n1.y, n1.z, n1.w};
            if (last) {
                float* op = p.out + (size_t)row * 1024 + c;
                *(float4*)op = make_float4(xv[i][0] * rstd * nn[0], xv[i][1] * rstd * nn[1], xv[i][2] * rstd * nn[2], xv[i][3] * rstd * nn[3]);
                *(float4*)(op + 4) = make_float4(xv[i][4] * rstd * nn[4], xv[i][5] * rstd * nn[5], xv[i][6] * rstd * nn[6], xv[i][7] * rstd * nn[7]);
            } else {
                const float4 c0 = *(const float4*)(md + 1024 + c), c1 = *(const float4*)(md + 1024 + c + 4), h0 = *(const float4*)(md + c), h1 = *(const float4*)(md + c + 4);
                const float sc[8] = {c0.x, c0.y, c0.z, c0.w, c1.x, c1.y, c1.z, c1.w}, sh[8] = {h0.x, h0.y, h0.z, h0.w, h1.x, h1.y, h1.z, h1.w};
                float o[8];
#pragma unroll
                for (int e = 0; e < 8; ++e) o[e] = xv[i][e] * rstd * nn[e] * (1.f + sc[e]) + sh[e];
                *(uint4*)(H + (size_t)row * 1024 + c) = pack8(o);
            }
        }
    }
}
constexpr int NIV = 19;
extern __shared__ __attribute__((aligned(16))) char dynsmem[];
template <int ID> __device__ __forceinline__ void run_iv(const Params& pin, int l, char* smem) {
    Params p = pin; p.ws = launder(pin.ws);
    if constexpr (ID == 0) { ph_pre(p, smem); __syncthreads(); ph_w(p, 0, smem); }
    else if constexpr (ID == 1) ph_n1(p, l);
    else if constexpr (ID == 2) ph_g1(p, l, smem);
    else if constexpr (ID == 3) { ph_qu(p, smem); ph_krope(p); ph_rp1(p, l, smem); ph_rp2(p, l); ph_f1(p, l, smem); }
    else if constexpr (ID == 5) {
        const bool r1first = (blockIdx.x >> 8) & 1;
#pragma unroll 1
        for (int pass = 0; pass < 2; ++pass) {
            if ((pass == 0) == r1first) { ph_r1(p, l, smem); ph_fa(p, smem); } else ph_at(p, l, smem);
            __syncthreads();
        }
    }
    else if constexpr (ID == 8) { ph_r2(p, smem); __syncthreads(); ph_fb(p, l, smem); }
    else if constexpr (ID == 9) ph_r3(p, l, smem);
    else if constexpr (ID == 12) ph_mg(p, l, smem);
    else if constexpr (ID == 13) ph_out(p, l, smem);
    else if constexpr (ID == 14) ph_n2(p, l, smem);
    else if constexpr (ID == 15) ph_e1(p, l, smem);
    else if constexpr (ID == 16) ph_e2(p, l, smem);
    else if constexpr (ID == 17) { ph_e3(p, l, smem); __syncthreads(); if (l + 1 < NLAYER) ph_w(p, l + 1, smem); }
}
#if MEGA
#ifndef PROBE_MASK
#define PROBE_MASK 0
#define PROBE_REP 1
#endif
#define IV(ID) for (int r_ = 0; r_ < (((PROBE_MASK >> (ID)) & 1) ? PROBE_REP : 1); ++r_) { run_iv<ID>(p, l, smem); xcd_barrier(bar); }
__global__ void __launch_bounds__(256, 2) k_mega(Params p) {
    char* smem = dynsmem;
    volatile LAS unsigned* st = (volatile LAS unsigned*)(smem + LDS_BYTES - 16);
    if (tidx() == 0) { st[0] = 0u; st[1] = 0u; }
    __syncthreads();
    XcdBarrier bar = xcd_barrier_post((unsigned*)(p.ws + O_BAR), st);
    { const int l = 0; IV(0) }
    for (int l = 0; l < NLAYER; ++l) {
        if (l == 0) { IV(1) } IV(2) IV(3) IV(5) IV(8) IV(9) IV(12) IV(13) IV(14) IV(15) IV(16) IV(17)
    }
}
#else
template <int ID> __global__ void __launch_bounds__(256, 2) k_iv(Params p, int l) { run_iv<ID>(p, l, dynsmem); }
template <int ID> static void launch_iv(const Params& p, int l, int grid, hipStream_t s) {
    static bool once = false; if (!once) { once = true; (void)hipFuncSetAttribute((const void*)k_iv<ID>, hipFuncAttributeMaxDynamicSharedMemorySize, LDS_BYTES); }
    hipLaunchKernelGGL(k_iv<ID>, dim3(grid), dim3(256), LDS_BYTES, s, p, l);
}
#endif

extern "C" void kernel_launch(void* const* d_in, const int* in_sizes, int n_in, void* d_out, int out_size, void* d_ws, size_t ws_size, hipStream_t stream) {
    (void)in_sizes; (void)out_size;
    if (n_in < N_IN || ws_size < WS_NEED) return;
    Params p{};
    for (int i = 0; i < N_IN; ++i) p.in[i] = (const float*)d_in[i];
    p.out = (float*)d_out; p.ws = (char*)d_ws;
    static int grid = 0;
    if (!grid) {
        int dev = 0, cus = 0; (void)hipGetDevice(&dev); (void)hipDeviceGetAttribute(&cus, hipDeviceAttributeMultiprocessorCount, dev);
        int per_cu = 2;
#if MEGA
        (void)hipFuncSetAttribute((const void*)k_mega, hipFuncAttributeMaxDynamicSharedMemorySize, LDS_BYTES);
        int occ = 0; (void)hipOccupancyMaxActiveBlocksPerMultiprocessor(&occ, k_mega, 256, LDS_BYTES);
        if (occ < per_cu) per_cu = occ;
        if (per_cu < 1) per_cu = 1;
#endif
        grid = cus * per_cu;
    }
#if MEGA
    (void)hipMemsetAsync(p.ws + O_BAR, 0, 16384, stream);
    hipLaunchKernelGGL(k_mega, dim3(grid), dim3(256), LDS_BYTES, stream, p);
#else
    launch_iv<0>(p, 0, grid, stream);
    for (int l = 0; l < NLAYER; ++l) {
        if (l == 0) launch_iv<1>(p, l, grid, stream); launch_iv<2>(p, l, grid, stream); launch_iv<3>(p, l, grid, stream);
        launch_iv<5>(p, l, grid, stream); launch_iv<8>(p, l, grid, stream);
        launch_iv<9>(p, l, grid, stream); launch_iv<12>(p, l, grid, stream);
        launch_iv<13>(p, l, grid, stream); launch_iv<14>(p, l, grid, stream); launch_iv<15>(p, l, grid, stream); launch_iv<16>(p, l, grid, stream); launch_iv<17>(p, l, grid, stream);
    }
#endif
}
```
